# Optimizing an MI355X kernel written in HIP

```python
import math
import jax
import jax.numpy as jnp
from jax import lax
import numpy as np

D_MODEL = 2048
BATCH = 2
SEQ = 4096
DEPTH = 1

GRID_W = 64
N_ATTN_HEADS = 8
ATTN_WIDTH = D_MODEL // 2
HEAD_DIM = ATTN_WIDTH // N_ATTN_HEADS
HYENA_WIDTH = D_MODEL - ATTN_WIDTH
N_HYENA_GROUPS = 8
HYENA_ORDER = 2
N_DIRS = 2
SHORT_CONV_W = 3
FILTER_EMB = 33
FILTER_HIDDEN = 64
DECAY_TARGET = 1e-2
FAST_DECAY_PCT = 0.3
SLOW_DECAY_PCT = 1.5
WIN_ROWS_MAX = 8
WIN_COLS = 16
N_EXPERTS = 16
EC_CAPACITY_FACTOR = 2
EXPERT_FF = 1024
IN_WIDTH = 3 * ATTN_WIDTH + (HYENA_ORDER + 1) * HYENA_WIDTH
RMS_EPS = 1e-6

kernel_name = 'hybrid_na2d_hyena_ecmoe_block'


def rms_norm(x, g):
    xf = x.astype(jnp.float32)
    y = xf * lax.rsqrt(jnp.mean(xf * xf, axis=-1, keepdims=True) + RMS_EPS)
    return (y * g.astype(jnp.float32)).astype(x.dtype)


def group_rms_norm(y, g, n_groups):
    b, s, w = y.shape
    yg = y.reshape(b, s, n_groups, w // n_groups)
    return rms_norm(yg, g.reshape(n_groups, w // n_groups)).reshape(b, s, w)


def neighbourhood_attention(q, k, v, rpb):
    b, s, h, hd = q.shape
    rows = s // GRID_W
    win_r = min(WIN_ROWS_MAX, rows)
    r = jnp.arange(rows)
    c = jnp.arange(GRID_W)
    key_rows = jnp.clip(r - win_r // 2, 0, rows - win_r)[:, None] + jnp.arange(win_r)[None, :]
    c0 = jnp.clip(c - WIN_COLS // 2, 0, GRID_W - WIN_COLS)
    in_win = (c[None, :] >= c0[:, None]) & (c[None, :] < c0[:, None] + WIN_COLS)
    dr_idx = key_rows - r[:, None] + WIN_ROWS_MAX - 1
    dc_idx = jnp.clip(c[None, :] - c[:, None] + WIN_COLS - 1, 0, 2 * WIN_COLS - 2)
    bias = rpb[:, dr_idx[:, None, :, None], dc_idx[None, :, None, :]].astype(jnp.float32)
    qg = q.reshape(b, rows, GRID_W, h, hd)
    kb = k.reshape(b, rows, GRID_W, h, hd)[:, key_rows]
    vb = v.reshape(b, rows, GRID_W, h, hd)[:, key_rows]
    scores = jnp.einsum('brqhd,brwkhd->bhrqwk', qg, kb).astype(jnp.float32) * (hd ** -0.5) + bias[None]
    scores = jnp.where(in_win[None, None, None, :, None, :], scores, -jnp.inf)
    probs = jax.nn.softmax(scores.reshape(b, h, rows, GRID_W, win_r * GRID_W), axis=-1)
    probs = probs.reshape(b, h, rows, GRID_W, win_r, GRID_W).astype(v.dtype)
    out = jnp.einsum('bhrqwk,brwkhd->brqhd', probs, vb)
    return out.reshape(b, s, h * hd)


def sinusoidal_position_features(length):
    t = jnp.linspace(0.0, 1.0, length, dtype=jnp.float32)[:, None]
    bands = (FILTER_EMB - 1) // 2
    w = 2.0 * math.pi * jnp.arange(length, dtype=jnp.float32)[:, None] / length
    f = jnp.linspace(1e-4, bands - 1, bands, dtype=jnp.float32)[None, :]
    z = jnp.concatenate([t, jnp.cos(f * w), -jnp.sin(f * w)], axis=-1)
    return t, z


def implicit_filters(length, w1, b1, w2, b2, w3, freq):
    f32 = jnp.float32
    t, z = sinusoidal_position_features(length)
    fr = freq.astype(f32)
    hid = jnp.sin(fr * (z @ w1.astype(f32) + b1.astype(f32)))
    hid = jnp.sin(fr * (hid @ w2.astype(f32) + b2.astype(f32)))
    filt = (hid @ w3.astype(f32)).reshape(length, HYENA_ORDER, N_DIRS, HYENA_WIDTH)
    max_decay = math.log(DECAY_TARGET) / FAST_DECAY_PCT
    min_decay = math.log(DECAY_TARGET) / SLOW_DECAY_PCT
    deltas = jnp.abs(jnp.linspace(min_decay, max_decay, HYENA_WIDTH, dtype=f32))
    window = jnp.exp(-t * deltas[None, :])
    return filt * window[:, None, None, :]


def bidirectional_fft_conv(u, h_fwd, h_bwd, skip):
    length = u.shape[1]
    n = 2 * length
    taps = jnp.concatenate([h_fwd, jnp.zeros_like(h_fwd[:1]), h_bwd[:0:-1]], axis=0)
    uf = u.astype(jnp.float32)
    spec = jnp.fft.rfft(uf, n=n, axis=1) * jnp.fft.rfft(taps, n=n, axis=0)[None]
    y = jnp.fft.irfft(spec, n=n, axis=1)[:, :length]
    return (y + uf * skip.astype(jnp.float32)).astype(u.dtype)


def short_conv(u, w, bias):
    length = u.shape[1]
    half = SHORT_CONV_W // 2
    up = jnp.pad(u, ((0, 0), (half, SHORT_CONV_W - 1 - half), (0, 0)))
    out = bias
    for j in range(SHORT_CONV_W):
        out = out + up[:, j:j + length] * w[j]
    return out


def hyena_mixer(u, conv_w, conv_b, filters, filt_bias):
    u = short_conv(u, conv_w, conv_b)
    z = u[..., HYENA_ORDER * HYENA_WIDTH:]
    for o in range(HYENA_ORDER):
        gate = u[..., o * HYENA_WIDTH:(o + 1) * HYENA_WIDTH]
        z = gate * bidirectional_fft_conv(z, filters[:, o, 0], filters[:, o, 1], filt_bias[o])
    return z


def expert_choice_moe(h, w_router, w_gate, w_up, w_down):
    b, s, d = h.shape
    cap = EC_CAPACITY_FACTOR * s // N_EXPERTS
    logits = jnp.einsum('bsd,de->bse', h, w_router).astype(jnp.float32)
    affinity = jax.nn.softmax(logits, axis=-1)
    gate, idx = lax.top_k(jnp.swapaxes(affinity, 1, 2), cap)
    xg = jax.vmap(lambda hb, ib: hb[ib])(h, idx)
    a = jnp.einsum('becd,edf->becf', xg, w_gate)
    up = jnp.einsum('becd,edf->becf', xg, w_up)
    ye = jnp.einsum('becf,efd->becd', jax.nn.silu(a) * up, w_down)
    ye = ye * gate[..., None].astype(ye.dtype)
    return jax.vmap(lambda yb, ib: jnp.zeros((s, d), yb.dtype).at[ib.reshape(-1)].add(yb.reshape(-1, d)))(ye, idx)


def setup_inputs(seed: int = 0) -> dict:
    key = jax.random.key(seed)
    ks = jax.random.split(key, 24)
    f32 = jnp.float32

    def nrm(k, shape, scale):
        return jax.random.normal(k, shape, f32) * scale

    def gain(k, shape):
        return 1.0 + nrm(k, shape, 0.01)

    L = DEPTH
    return {
        'x': nrm(ks[0], (BATCH, SEQ, D_MODEL), 1.0),
        'mix_norm_g': gain(ks[1], (L, D_MODEL)),
        'w_in': nrm(ks[2], (L, D_MODEL, IN_WIDTH), D_MODEL ** -0.5),
        'q_norm_g': gain(ks[3], (L, HEAD_DIM)),
        'k_norm_g': gain(ks[4], (L, HEAD_DIM)),
        'rpb': nrm(ks[5], (L, N_ATTN_HEADS, 2 * WIN_ROWS_MAX - 1, 2 * WIN_COLS - 1), 0.02),
        'conv_w': nrm(ks[6], (L, SHORT_CONV_W, (HYENA_ORDER + 1) * HYENA_WIDTH), SHORT_CONV_W ** -0.5),
        'conv_b': nrm(ks[7], (L, (HYENA_ORDER + 1) * HYENA_WIDTH), 0.02),
        'filt_w1': nrm(ks[8], (L, FILTER_EMB, FILTER_HIDDEN), FILTER_EMB ** -0.5),
        'filt_b1': nrm(ks[9], (L, FILTER_HIDDEN), 0.02),
        'filt_w2': nrm(ks[10], (L, FILTER_HIDDEN, FILTER_HIDDEN), FILTER_HIDDEN ** -0.5),
        'filt_b2': nrm(ks[11], (L, FILTER_HIDDEN), 0.02),
        'filt_w3': nrm(ks[12], (L, FILTER_HIDDEN, HYENA_ORDER * N_DIRS * HYENA_WIDTH), FILTER_HIDDEN ** -0.5),
        'filt_freq': gain(ks[13], (L, FILTER_HIDDEN)),
        'filt_bias': nrm(ks[14], (L, HYENA_ORDER, HYENA_WIDTH), 0.5),
        'attn_out_g': gain(ks[15], (L, ATTN_WIDTH)),
        'hyena_out_g': gain(ks[16], (L, HYENA_WIDTH)),
        'w_out': nrm(ks[17], (L, D_MODEL, D_MODEL), D_MODEL ** -0.5),
        'ffn_norm_g': gain(ks[18], (L, D_MODEL)),
        'w_router': nrm(ks[19], (L, D_MODEL, N_EXPERTS), D_MODEL ** -0.5),
        'w_gate': nrm(ks[20], (L, N_EXPERTS, D_MODEL, EXPERT_FF), D_MODEL ** -0.5),
        'w_up': nrm(ks[21], (L, N_EXPERTS, D_MODEL, EXPERT_FF), D_MODEL ** -0.5),
        'w_down': nrm(ks[22], (L, N_EXPERTS, EXPERT_FF, D_MODEL), EXPERT_FF ** -0.5),
    }


def reference(x, mix_norm_g, w_in, q_norm_g, k_norm_g, rpb, conv_w, conv_b, filt_w1, filt_b1, filt_w2, filt_b2, filt_w3, filt_freq, filt_bias, attn_out_g, hyena_out_g, w_out, ffn_norm_g, w_router, w_gate, w_up, w_down):
    b, s, _ = x.shape
    for i in range(DEPTH):
        h = rms_norm(x, mix_norm_g[i])
        proj = jnp.einsum('bsd,de->bse', h, w_in[i])
        q, k, v = jnp.split(proj[..., :3 * ATTN_WIDTH], 3, axis=-1)
        q = rms_norm(q.reshape(b, s, N_ATTN_HEADS, HEAD_DIM), q_norm_g[i])
        k = rms_norm(k.reshape(b, s, N_ATTN_HEADS, HEAD_DIM), k_norm_g[i])
        v = v.reshape(b, s, N_ATTN_HEADS, HEAD_DIM)
        attn = neighbourhood_attention(q, k, v, rpb[i])
        filters = implicit_filters(s, filt_w1[i], filt_b1[i], filt_w2[i], filt_b2[i], filt_w3[i], filt_freq[i])
        hy = hyena_mixer(proj[..., 3 * ATTN_WIDTH:], conv_w[i], conv_b[i], filters, filt_bias[i])
        mixed = jnp.concatenate([group_rms_norm(attn, attn_out_g[i], N_ATTN_HEADS),
                                 group_rms_norm(hy, hyena_out_g[i], N_HYENA_GROUPS)], axis=-1)
        x = x + jnp.einsum('bsd,de->bse', mixed, w_out[i])
        x = x + expert_choice_moe(rms_norm(x, ffn_norm_g[i]), w_router[i], w_gate[i], w_up[i], w_down[i])
    return x
```

```cpp
#include <hip/hip_runtime.h>
#include <hip/hip_cooperative_groups.h>
#include <cstdio>
#include <cstdint>
namespace cg = cooperative_groups;

#ifndef MK_N_LAUNCHES
#define MK_N_LAUNCHES 1
#endif

namespace pg8 {
#define PG8_LAS __attribute__((address_space(3)))
typedef unsigned short bf16_t;
typedef short bf16x8 __attribute__((ext_vector_type(8)));
typedef float f32x4 __attribute__((ext_vector_type(4)));
typedef unsigned u32x4 __attribute__((ext_vector_type(4)));
typedef unsigned u32x2 __attribute__((ext_vector_type(2)));
constexpr int BM = 256, BK = 64, HALF = 128, HTB = HALF * BK * 2, STAGE_BYTES = 8 * HTB, NXCD = 8, WGM = 8;

__host__ __device__ __forceinline__ int lds_byte(int r, int c) { const int st = (r >> 4) * 2 + (c >> 5), rr = r & 15, cc = c & 31, ob = rr * 64 + cc * 2; return st * 1024 + (ob ^ (((ob >> 9) & 1) << 5)); }
__host__ __device__ __forceinline__ void stage_rc(int b, int& R, int& C) { const int st = b / 1024, sb = b % 1024, swz = sb ^ (((sb >> 9) & 1) << 5); R = (st >> 1) * 16 + swz / 64; C = (st & 1) * 32 + (swz % 64) / 2; }
__host__ __device__ __forceinline__ int perm32(int rho) { const int n = rho >> 4, i = rho & 15; return 8 * (i >> 2) + 4 * n + (i & 3); }

struct Unit { int pm, pn, g; const char* a; const char* b; };

__device__ __forceinline__ unsigned cvt_pk_bf16(float lo, float hi) { unsigned r; asm volatile("v_cvt_pk_bf16_f32 %0, %1, %2" : "=v"(r) : "v"(lo), "v"(hi)); return r; }

struct DenseOrder {
    int nM, nN, nwg, G, c, K, pn0; const char* A; const char* Bt;
    __device__ void init(const void* A_, const void* Bt_, int M, int N, int K_, int pn0_, int G_, int c_) { A = (const char*)A_; Bt = (const char*)Bt_; nM = M / BM; nN = N / BM; nwg = nM * nN; G = G_; c = c_; K = K_; pn0 = pn0_; }
    __device__ bool next(int i, Unit& u) const {
        const long L = (long)i * G + c; if (L >= nwg) return false;
        int wgid = (int)L; { const int q = nwg / NXCD, r = nwg % NXCD, xcd = wgid % NXCD, off = wgid / NXCD; wgid = (xcd < r ? xcd * (q + 1) : r * (q + 1) + (xcd - r) * q) + off; }
        const int nig = WGM * nN, gid = wgid / nig, fm = gid * WGM, gsz = (nM - fm) < WGM ? (nM - fm) : WGM;
        u.pm = fm + ((wgid % nig) % gsz); u.pn = pn0 + (wgid % nig) / gsz; u.g = 0;
        u.a = A + (size_t)u.pm * BM * K * 2; u.b = Bt + (size_t)u.pn * BM * K * 2; return true;
    }
};
struct MoeOrder {
    int G, c, K; const char* A; const char* Bt;
    __device__ void init(const void* A_, const void* Bt_, int K_, int G_, int c_) { A = (const char*)A_; Bt = (const char*)Bt_; K = K_; G = G_; c = c_; }
    __device__ bool next(int i, Unit& u) const {
        const int L = i * G + c; if (L >= 512) return false;
        const int pn = L & 7, pm = (L >> 3) & 1, b = (L >> 4) & 1, e = L >> 5;
        u.pm = pm; u.pn = pn; u.g = b * 16 + e;
        u.a = A + (size_t)(u.g * 512 + pm * BM) * K * 2; u.b = Bt + (size_t)(e * 2048 + pn * BM) * K * 2; return true;
    }
};

struct EpiBf16 {
    static constexpr bool PERM = true, SWAP = false;
    bf16_t* O; int ldc; int grows; const float* rscale;
    __device__ __forceinline__ void operator()(const f32x4 (&acc)[2][2][4][2], const Unit& u, int wr, int wc, int fr, int fq) const {
        const int row0 = u.g * grows + u.pm * BM + wr * 64 + fr, col0 = u.pn * BM + wc * 32 + 8 * fq;
#pragma unroll
        for (int ai = 0; ai < 2; ++ai)
#pragma unroll
            for (int m = 0; m < 4; ++m) { const int row = row0 + ai * HALF + m * 16; bf16_t* rowp = O + (size_t)row * ldc + col0; const float sc = rscale ? rscale[row] : 1.f;
#pragma unroll
                for (int bj = 0; bj < 2; ++bj) { const f32x4 v0 = acc[ai][bj][m][0] * sc, v1 = acc[ai][bj][m][1] * sc;
                    u32x4 w; w.x = cvt_pk_bf16(v0[0], v0[1]); w.y = cvt_pk_bf16(v0[2], v0[3]); w.z = cvt_pk_bf16(v1[0], v1[1]); w.w = cvt_pk_bf16(v1[2], v1[3]);
                    *(u32x4*)(rowp + bj * HALF) = w; } }
    }
};
struct EpiSwiGLU {
    static constexpr bool PERM = true, SWAP = false;
    bf16_t* O;
    __device__ __forceinline__ void operator()(const f32x4 (&acc)[2][2][4][2], const Unit& u, int wr, int wc, int fr, int fq) const {
        const int row0 = u.g * 512 + u.pm * BM + wr * 64 + fr, col0 = u.pn * HALF + wc * 32 + 8 * fq;
#pragma unroll
        for (int ai = 0; ai < 2; ++ai)
#pragma unroll
            for (int m = 0; m < 4; ++m) { bf16_t* rowp = O + (size_t)(row0 + ai * HALF + m * 16) * 1024 + col0;
                float r[8];
#pragma unroll
                for (int n = 0; n < 2; ++n)
#pragma unroll
                    for (int e = 0; e < 4; ++e) { const float g = acc[ai][0][m][n][e], up = acc[ai][1][m][n][e]; r[n * 4 + e] = g / (1.f + __expf(-g)) * up; }
                u32x4 w; w.x = cvt_pk_bf16(r[0], r[1]); w.y = cvt_pk_bf16(r[2], r[3]); w.z = cvt_pk_bf16(r[4], r[5]); w.w = cvt_pk_bf16(r[6], r[7]);
                *(u32x4*)rowp = w; }
    }
};
struct EpiResF32 {
    static constexpr bool PERM = false, SWAP = false;
    const float* res; float* out; int ldc;
    __device__ __forceinline__ void operator()(const f32x4 (&acc)[2][2][4][2], const Unit& u, int wr, int wc, int fr, int fq) const {
        const int row0 = u.pm * BM + wr * 64 + fr, col0 = u.pn * BM + wc * 32 + 4 * fq;
#pragma unroll
        for (int ai = 0; ai < 2; ++ai)
#pragma unroll
            for (int m = 0; m < 4; ++m) { const size_t off = (size_t)(row0 + ai * HALF + m * 16) * ldc + col0;
#pragma unroll
                for (int bj = 0; bj < 2; ++bj)
#pragma unroll
                    for (int n = 0; n < 2; ++n) { const f32x4 r = *(const f32x4*)(res + off + bj * HALF + n * 16); *(f32x4*)(out + off + bj * HALF + n * 16) = r + acc[ai][bj][m][n]; } }
    }
};
struct EpiTransBf16 {
    static constexpr bool PERM = false, SWAP = true;
    bf16_t* O; int ldt; int pn_base;
    __device__ __forceinline__ void operator()(const f32x4 (&acc)[2][2][4][2], const Unit& u, int wr, int wc, int fr, int fq) const {
        const int ch0 = (u.pn - pn_base) * BM + wc * 32 + fr, t0 = u.pm * BM + wr * 64 + 4 * fq;
#pragma unroll
        for (int bj = 0; bj < 2; ++bj)
#pragma unroll
            for (int n = 0; n < 2; ++n) { bf16_t* chp = O + (size_t)(ch0 + bj * HALF + n * 16) * ldt + t0;
#pragma unroll
                for (int ai = 0; ai < 2; ++ai)
#pragma unroll
                    for (int m = 0; m < 4; ++m) { const f32x4 v = acc[ai][bj][m][n]; u32x2 w; w.x = cvt_pk_bf16(v[0], v[1]); w.y = cvt_pk_bf16(v[2], v[3]); *(u32x2*)(chp + ai * HALF + m * 16) = w; } }
    }
};

template <class Epi, class Sched, bool ALIGN_EPI = false>
__device__ __forceinline__ void gemm_phase(PG8_LAS unsigned char* lds, const int K, const Sched& S, const Epi& E) {
    const int tid = threadIdx.x, wid = __builtin_amdgcn_readfirstlane(tid >> 6), lane = tid & 63, wr = wid >> 2, wc = wid & 3, fr = lane & 15, fq = lane >> 4;
    const int nt = K / BK;
    unsigned voffA[2], voffB[2];
#pragma unroll
    for (int i = 0; i < 2; ++i) { int R, C; stage_rc(tid * 16 + i * 8192, R, C); const int Rb = Epi::PERM ? ((R & ~31) + perm32(R & 31)) : R;
        voffA[i] = (unsigned)(R * K + C) * 2u; voffB[i] = (unsigned)(Rb * K + C) * 2u; }
    const size_t kstep = (size_t)(BK * 2);
    const size_t hstep = (size_t)HALF * K * 2;
    const unsigned ldsw = (unsigned)wid * 1024u;
    const int aoff = lds_byte(wr * 64 + fr, fq * 8), boff = lds_byte(wc * 32 + fr, fq * 8);
#define PG8_SA(b, h) (((b) * 2 + (h)) * HTB)
#define PG8_SB(b, h) ((4 + (b) * 2 + (h)) * HTB)
#define PG8_STAGE(bufoff, gbase, voff) do { _Pragma("unroll") for (int _i = 0; _i < 2; ++_i) \
        __builtin_amdgcn_global_load_lds((const unsigned*)((const char*)(gbase) + (voff)[_i]), (PG8_LAS unsigned*)(lds + (bufoff) + ldsw + _i * 8192), 16, 0, 0); } while (0)
#define PG8_LDA(dst, b, h) do { _Pragma("unroll") for (int m = 0; m < 4; ++m) _Pragma("unroll") for (int k = 0; k < 2; ++k) dst[m][k] = *(const PG8_LAS bf16x8*)(lds + PG8_SA(b, h) + aoff + m * 2048 + k * 1024); } while (0)
#define PG8_LDB(dst, b, h) do { _Pragma("unroll") for (int n = 0; n < 2; ++n) _Pragma("unroll") for (int k = 0; k < 2; ++k) dst[n][k] = *(const PG8_LAS bf16x8*)(lds + PG8_SB(b, h) + boff + n * 2048 + k * 1024); } while (0)
#define PG8_MMA(ai, bj, At, Bt) do { __builtin_amdgcn_s_setprio(1); _Pragma("unroll") for (int m = 0; m < 4; ++m) _Pragma("unroll") for (int n = 0; n < 2; ++n) _Pragma("unroll") for (int k = 0; k < 2; ++k) \
        acc[ai][bj][m][n] = Epi::SWAP ? __builtin_amdgcn_mfma_f32_16x16x32_bf16(At[m][k], Bt[n][k], acc[ai][bj][m][n], 0, 0, 0) : __builtin_amdgcn_mfma_f32_16x16x32_bf16(Bt[n][k], At[m][k], acc[ai][bj][m][n], 0, 0, 0); __builtin_amdgcn_s_setprio(0); } while (0)
#define PG8_WAIT_V(n) asm volatile("s_waitcnt vmcnt(" #n ")" ::: "memory")
#define PG8_WAIT_L(n) asm volatile("s_waitcnt lgkmcnt(" #n ")" ::: "memory")
#define PG8_BAR __builtin_amdgcn_s_barrier()
#define PG8_SCHED __builtin_amdgcn_sched_barrier(0)
    Unit cur, nxt; int ui = 0;
    if (!S.next(0, cur)) return;
    f32x4 acc[2][2][4][2];
#pragma unroll
    for (int a = 0; a < 2; ++a)
#pragma unroll
        for (int b = 0; b < 2; ++b)
#pragma unroll
            for (int m = 0; m < 4; ++m)
#pragma unroll
                for (int n = 0; n < 2; ++n) acc[a][b][m][n] = (f32x4){0.f, 0.f, 0.f, 0.f};
    bf16x8 At[4][2], B0[2][2], B1[2][2];
    const char* cA = cur.a; const char* cB = cur.b;
    PG8_STAGE(PG8_SB(0, 0), cB, voffB); PG8_STAGE(PG8_SB(0, 1), cB + hstep, voffB); PG8_STAGE(PG8_SA(0, 0), cA, voffA); PG8_STAGE(PG8_SA(0, 1), cA + hstep, voffA);
    if (wr == 1) PG8_BAR;
    PG8_WAIT_V(2); PG8_BAR;
    PG8_STAGE(PG8_SB(1, 0), cB + kstep, voffB); PG8_STAGE(PG8_SA(1, 0), cA + kstep, voffA); PG8_STAGE(PG8_SB(1, 1), cB + hstep + kstep, voffB);
    PG8_WAIT_V(6); PG8_BAR;
    for (;;) {
        const bool has_next = S.next(ui + 1, nxt);
        const char* nA = has_next ? nxt.a : cA; const char* nB = has_next ? nxt.b : cB;
        for (int t = 0; t < nt; t += 2) {
            const bool last = (t == nt - 2);
            const char* a1 = cA + (size_t)(t + 1) * kstep;
            const char* a2 = last ? nA : cA + (size_t)(t + 2) * kstep; const char* b2 = last ? nB : cB + (size_t)(t + 2) * kstep;
            const char* a3 = a2 + kstep; const char* b3 = b2 + kstep;
            PG8_LDB(B0, 0, 0); PG8_LDB(B1, 0, 1); PG8_SCHED; PG8_LDA(At, 0, 0); PG8_STAGE(PG8_SA(1, 1), a1 + hstep, voffA);
            PG8_WAIT_V(8); PG8_WAIT_L(0); PG8_BAR; PG8_MMA(0, 0, At, B0); PG8_MMA(0, 1, At, B1); PG8_BAR; PG8_SCHED;
            PG8_LDA(At, 0, 1); PG8_STAGE(PG8_SB(0, 0), b2, voffB); PG8_STAGE(PG8_SB(0, 1), b2 + hstep, voffB); PG8_STAGE(PG8_SA(0, 0), a2, voffA);
            PG8_WAIT_V(8); PG8_WAIT_L(0); PG8_BAR; PG8_MMA(1, 0, At, B0); PG8_MMA(1, 1, At, B1); PG8_BAR; PG8_SCHED;
            PG8_LDB(B0, 1, 0); PG8_LDB(B1, 1, 1); PG8_SCHED; PG8_LDA(At, 1, 0); PG8_STAGE(PG8_SA(0, 1), a2 + hstep, voffA);
            PG8_WAIT_V(8); PG8_WAIT_L(0); PG8_BAR; PG8_MMA(0, 0, At, B0); PG8_MMA(0, 1, At, B1); PG8_BAR; PG8_SCHED;
            PG8_LDA(At, 1, 1); PG8_STAGE(PG8_SB(1, 0), b3, voffB); PG8_STAGE(PG8_SB(1, 1), b3 + hstep, voffB); PG8_STAGE(PG8_SA(1, 0), a3, voffA);
            PG8_WAIT_V(8); PG8_WAIT_L(0); PG8_BAR; PG8_MMA(1, 0, At, B0); PG8_MMA(1, 1, At, B1); PG8_BAR; PG8_SCHED;
        }
        if constexpr (ALIGN_EPI) { if (wr == 0) PG8_BAR; }
        E(acc, cur, wr, wc, fr, fq);
        if (!has_next) break;
#pragma unroll
        for (int a = 0; a < 2; ++a)
#pragma unroll
            for (int b = 0; b < 2; ++b)
#pragma unroll
                for (int m = 0; m < 4; ++m)
#pragma unroll
                    for (int n = 0; n < 2; ++n) acc[a][b][m][n] = (f32x4){0.f, 0.f, 0.f, 0.f};
        cur = nxt; cA = nA; cB = nB; ++ui;
        if constexpr (ALIGN_EPI) { if (wr == 1) PG8_BAR; }
    }
    PG8_WAIT_V(0);
    if constexpr (!ALIGN_EPI) { if (wr == 0) PG8_BAR; }
    PG8_BAR;
#undef PG8_SA
#undef PG8_SB
#undef PG8_STAGE
#undef PG8_LDA
#undef PG8_LDB
#undef PG8_MMA
#undef PG8_WAIT_V
#undef PG8_WAIT_L
#undef PG8_BAR
#undef PG8_SCHED
}
}

constexpr int NB = 2, SEQ = 4096, DM = 2048, MT = NB * SEQ;
constexpr int NH = 8, HD = 128, AW = 1024, HW = 1024, INW = 6144;
constexpr int GW = 64, NROWS = 64, WR = 8, WC = 16;
constexpr int NE = 16, CAP = 512, FF = 1024;
constexpr int FEMB = 33, FHID = 64;
constexpr float EPS = 1e-6f;
constexpr int NWAVES = 8, NTHREADS = 512;

constexpr size_t MiB = 1u << 20;
constexpr size_t WS_CTL = 0, CTL_ZERO_BYTES = 1 * MiB;
constexpr size_t WS_WIN = 2 * MiB;
constexpr size_t WS_WOUT = 26 * MiB;
constexpr size_t WS_WGU = 34 * MiB;
constexpr size_t WS_WD = 162 * MiB;
constexpr size_t WS_W3T = 226 * MiB;
constexpr size_t WS_HID2 = 227 * MiB;
constexpr size_t WS_HB = 228 * MiB;
constexpr size_t WS_QK = 260 * MiB;
constexpr size_t WS_XT = 292 * MiB;
constexpr size_t WS_UC = 356 * MiB;
constexpr size_t WS_TAPS = 404 * MiB;
constexpr size_t WS_HYT = 436 * MiB;
constexpr size_t WS_MIXED = 452 * MiB;
constexpr size_t WS_AFF = 484 * MiB;
constexpr size_t WS_IDX = 485 * MiB;
constexpr size_t WS_GATE = 486 * MiB;
constexpr size_t WS_SEL = 487 * MiB;
constexpr size_t WS_Z1T = 488 * MiB;
constexpr size_t WS_XG = WS_XT;
constexpr size_t WS_ACT = WS_UC;
constexpr size_t WS_YE = WS_TAPS;
constexpr size_t WS_END = 504 * MiB;

constexpr int LDS_BYTES = 163840;

#define GAS __attribute__((address_space(1)))
#define LAS __attribute__((address_space(3)))
typedef unsigned short bf16;
typedef unsigned v4u __attribute__((ext_vector_type(4)));
typedef unsigned v2u __attribute__((ext_vector_type(2)));
typedef float f32x4 __attribute__((ext_vector_type(4)));
#define LDS_WAIT() asm volatile("s_waitcnt lgkmcnt(0)" ::: "memory")
#define VM_WAIT() asm volatile("s_waitcnt vmcnt(0)" ::: "memory")
__device__ __forceinline__ unsigned f2bf(float f) { unsigned u = __builtin_bit_cast(unsigned, f); return (u + 0x7fffu + ((u >> 16) & 1u)) >> 16; }
__device__ __forceinline__ unsigned pk2(float lo, float hi) { return f2bf(lo) | (f2bf(hi) << 16); }
__device__ __forceinline__ float bf2f(unsigned h) { return __builtin_bit_cast(float, h << 16); }
__device__ __forceinline__ float bflo(unsigned w) { return __builtin_bit_cast(float, w << 16); }
__device__ __forceinline__ float bfhi(unsigned w) { return __builtin_bit_cast(float, w & 0xffff0000u); }
__device__ __forceinline__ float wave_sum(float v) {
#pragma unroll
    for (int o = 1; o < 64; o <<= 1) v += __shfl_xor(v, o);
    return v;
}

struct Frame {
    LAS unsigned char* lds;
    int tid, lane, wave, G, bid;
    const float* in[23]; float* out; unsigned char* ws;
};
#define GW_ID(F) ((F).bid * NWAVES + (F).wave)
#define GW_N(F) ((F).G * NWAVES)

__device__ __forceinline__ void p0_transpose_item(const float* W, int K, int N, bf16* WT, int row_base, int k0, int n0, LAS float* scr, int lane) {
#pragma unroll 8
    for (int i = 0; i < 32; ++i) { const int kk = 2 * i + (lane >> 5); scr[kk * 33 + (lane & 31)] = W[(size_t)(k0 + kk) * N + n0 + (lane & 31)]; }
    LDS_WAIT(); asm volatile("" ::: "memory");
    const int c = lane & 7;
#pragma unroll
    for (int j = 0; j < 4; ++j) { const int n = (lane >> 3) + 8 * j; const LAS float* s = scr + (8 * c) * 33 + n;
        v4u o; o.x = pk2(s[0 * 33], s[1 * 33]); o.y = pk2(s[2 * 33], s[3 * 33]); o.z = pk2(s[4 * 33], s[5 * 33]); o.w = pk2(s[6 * 33], s[7 * 33]);
        *(GAS v4u*)(WT + (size_t)(row_base + n) * K + k0 + 8 * c) = o; }
    LDS_WAIT(); asm volatile("" ::: "memory");
}
__device__ __forceinline__ void phase_p0(Frame& F) {
    LAS float* scr = (LAS float*)(F.lds + F.wave * 16384);
    const int gw = GW_ID(F), NGW = GW_N(F);
    bf16* WinT = (bf16*)(F.ws + WS_WIN); bf16* WoutT = (bf16*)(F.ws + WS_WOUT); bf16* WguT = (bf16*)(F.ws + WS_WGU); bf16* WdT = (bf16*)(F.ws + WS_WD); bf16* W3T = (bf16*)(F.ws + WS_W3T);
    constexpr int I_IN = (DM / 64) * (INW / 32), I_OUT = (DM / 64) * (DM / 32), I_G = (DM / 64) * (FF / 32), I_D = (FF / 64) * (DM / 32), I_3 = 1 * (4096 / 32);
    constexpr int NITEMS = I_IN + I_OUT + 2 * NE * I_G + NE * I_D + I_3;
    for (int it = gw; it < NITEMS; it += NGW) {
        int r = it;
        if (r < I_IN) { const int nblk = INW / 32, kb = r / nblk, nb = r % nblk; p0_transpose_item(F.in[2], DM, INW, WinT, 32 * nb, 64 * kb, 32 * nb, scr, F.lane); continue; } r -= I_IN;
        if (r < I_OUT) { const int nblk = DM / 32, kb = r / nblk, nb = r % nblk; p0_transpose_item(F.in[17], DM, DM, WoutT, 32 * nb, 64 * kb, 32 * nb, scr, F.lane); continue; } r -= I_OUT;
        if (r < 2 * NE * I_G) { const int which = r / (NE * I_G); r %= NE * I_G; const int e = r / I_G; r %= I_G; const int nblk = FF / 32, kb = r / nblk, nb = r % nblk, f0 = 32 * nb;
            const float* W = (which ? F.in[21] : F.in[20]) + (size_t)e * DM * FF;
            const int row_base = e * 2048 + (f0 >> 7) * 256 + which * 128 + (f0 & 127);
            p0_transpose_item(W, DM, FF, WguT, row_base, 64 * kb, f0, scr, F.lane); continue; } r -= 2 * NE * I_G;
        if (r < NE * I_D) { const int e = r / I_D; r %= I_D; const int nblk = DM / 32, kb = r / nblk, nb = r % nblk;
            p0_transpose_item(F.in[22] + (size_t)e * FF * DM, FF, DM, WdT, e * 2048 + 32 * nb, 64 * kb, 32 * nb, scr, F.lane); continue; } r -= NE * I_D;
        { const int nb = r; p0_transpose_item(F.in[12], FHID, 4096, W3T, 32 * nb, 0, 32 * nb, scr, F.lane); }
    }
    bf16* HB = (bf16*)(F.ws + WS_HB);
    const float* x = F.in[0]; const float* g = F.in[1];
    for (int m = gw; m < MT; m += NGW) {
        const GAS f32x4* xr = (const GAS f32x4*)(x + (size_t)m * DM) + F.lane;
        f32x4 v[8]; float s = 0.f;
#pragma unroll
        for (int j = 0; j < 8; ++j) { v[j] = xr[64 * j]; s += (v[j].x * v[j].x + v[j].y * v[j].y) + (v[j].z * v[j].z + v[j].w * v[j].w); }
        const float r = rsqrtf(wave_sum(s) * (1.f / DM) + EPS);
        GAS v2u* o8 = (GAS v2u*)(HB + (size_t)m * DM) + F.lane;
#pragma unroll
        for (int j = 0; j < 8; ++j) { const f32x4 gg = *((const GAS f32x4*)g + F.lane + 64 * j); v2u o; o.x = pk2(v[j].x * r * gg.x, v[j].y * r * gg.y); o.y = pk2(v[j].z * r * gg.z, v[j].w * r * gg.w); o8[64 * j] = o; }
    }
    float* HID2 = (float*)(F.ws + WS_HID2);
    LAS float* sc2 = (LAS float*)(F.lds + F.wave * 16384);
    const float* w1 = F.in[8]; const float* b1 = F.in[9]; const float* w2 = F.in[10]; const float* b2 = F.in[11]; const float* fr = F.in[13];
    for (int l = gw; l < SEQ; l += NGW) {
        const int j = F.lane;
        float zv = 0.f;
        if (j == 0) zv = (float)l / (float)(SEQ - 1);
        else if (j < FEMB) { const int k = (j - 1) & 15; const float f = 1e-4f + (float)k * ((15.0f - 1e-4f) / 15.0f); const float wv = 6.283185307179586f * (float)l / (float)SEQ; zv = (j <= 16) ? cosf(f * wv) : -sinf(f * wv); }
        sc2[j] = zv; LDS_WAIT(); asm volatile("" ::: "memory");
        float a = b1[j];
        for (int i = 0; i < FEMB; ++i) a += sc2[i] * w1[i * FHID + j];
        const float h1 = sinf(fr[j] * a);
        sc2[64 + j] = h1; LDS_WAIT(); asm volatile("" ::: "memory");
        float c = b2[j];
        for (int i = 0; i < FHID; ++i) c += sc2[64 + i] * w2[i * FHID + j];
        HID2[l * FHID + j] = sinf(fr[j] * c);
        LDS_WAIT(); asm volatile("" ::: "memory");
    }
}

__device__ __forceinline__ void phase_filters_naive(Frame& F) {
    const float* HID2 = (const float*)(F.ws + WS_HID2); const float* w3 = F.in[12]; const float* fbias = F.in[14]; bf16* TAPS = (bf16*)(F.ws + WS_TAPS);
    const size_t total = (size_t)SEQ * 4096;
    for (size_t i = (size_t)F.bid * NTHREADS + F.tid; i < total; i += (size_t)F.G * NTHREADS) {
        const int col = (int)(i & 4095), l = (int)(i >> 12);
        float a = 0.f;
        for (int k = 0; k < FHID; ++k) a += HID2[l * FHID + k] * w3[(size_t)k * 4096 + col];
        const int c = col & 1023, dir = (col >> 10) & 1, o = col >> 11;
        const float mind = -4.605170185988091f / 1.5f, maxd = -4.605170185988091f / 0.3f;
        const float delta = fabsf(mind + (maxd - mind) * ((float)c / 1023.0f));
        const float t = (float)l / (float)(SEQ - 1);
        float v = a * expf(-t * delta);
        bf16* tp = TAPS + ((size_t)c * 2 + o) * 8192;
        if (dir == 0) { if (l == 0) v += fbias[o * 1024 + c]; tp[4096 + l] = (bf16)f2bf(v); }
        else { if (l > 0) tp[4096 - l] = (bf16)f2bf(v); else tp[0] = 0; }
    }
}
__device__ __forceinline__ void phase_hyena_naive(Frame& F, int o) {
    const bf16* UC = (const bf16*)(F.ws + WS_UC); const bf16* TAPS = (const bf16*)(F.ws + WS_TAPS);
    bf16* Z1T = (bf16*)(F.ws + WS_Z1T); bf16* HYT = (bf16*)(F.ws + WS_HYT);
    const bf16* Zin = o == 0 ? UC + (size_t)2048 * MT : Z1T; const bf16* gate = UC + (size_t)(o * 1024) * MT; bf16* OUT = o == 0 ? Z1T : HYT;
    const size_t total = (size_t)1024 * MT;
    for (size_t i = (size_t)F.bid * NTHREADS + F.tid; i < total; i += (size_t)F.G * NTHREADS) {
        const int c = (int)(i >> 13), m = (int)(i & 8191), b = m >> 12, t = m & 4095;
        const bf16* z = Zin + (size_t)c * MT + b * SEQ; const bf16* tp = TAPS + ((size_t)c * 2 + o) * 8192 + 4096 + t;
        float acc = 0.f;
        for (int s = 0; s < SEQ; ++s) acc += bf2f(tp[-s]) * bf2f(z[s]);
        OUT[(size_t)c * MT + m] = (bf16)f2bf(bf2f(gate[(size_t)c * MT + m]) * acc);
    }
}
__device__ __forceinline__ void phase_attn_naive(Frame& F) {
    const bf16* QK = (const bf16*)(F.ws + WS_QK); const bf16* VT = (const bf16*)(F.ws + WS_XT); bf16* MIXED = (bf16*)(F.ws + WS_MIXED);
    const float* rpb = F.in[5]; const float* og = F.in[15];
    const int lane = F.lane;
    for (int w = GW_ID(F); w < MT * NH; w += GW_N(F)) {
        const int m = w >> 3, h = w & 7, b = m / SEQ, s = m % SEQ, r = s / GW, c = s % GW;
        int kr0 = r - WR / 2; kr0 = kr0 < 0 ? 0 : (kr0 > NROWS - WR ? NROWS - WR : kr0);
        int c0 = c - WC / 2; c0 = c0 < 0 ? 0 : (c0 > GW - WC ? GW - WC : c0);
        const bf16* q = QK + (size_t)m * 2048 + h * HD;
        const float q0 = bf2f(q[lane]), q1 = bf2f(q[lane + 64]);
        float mx = -INFINITY, l = 0.f, a0 = 0.f, a1 = 0.f;
        for (int i = 0; i < WR; ++i) for (int j = 0; j < WC; ++j) {
            const int kr = kr0 + i, kc = c0 + j; const size_t km = (size_t)b * SEQ + kr * GW + kc;
            const bf16* kp = QK + km * 2048 + 1024 + h * HD;
            const float d = wave_sum(q0 * bf2f(kp[lane]) + q1 * bf2f(kp[lane + 64]));
            const int dr = kr - r + WR - 1; int dc = kc - c + WC - 1; dc = dc < 0 ? 0 : (dc > 2 * WC - 2 ? 2 * WC - 2 : dc);
            const float sc = d * 0.08838834764831845f + rpb[(h * (2 * WR - 1) + dr) * (2 * WC - 1) + dc];
            const float mn = fmaxf(mx, sc), corr = __expf(mx - mn), pw = __expf(sc - mn);
            const float v0 = bf2f(VT[(size_t)(h * HD + lane) * MT + km]), v1 = bf2f(VT[(size_t)(h * HD + lane + 64) * MT + km]);
            l = l * corr + pw; a0 = a0 * corr + pw * v0; a1 = a1 * corr + pw * v1; mx = mn;
        }
        a0 /= l; a1 /= l;
        const float rr = rsqrtf(wave_sum(a0 * a0 + a1 * a1) * (1.f / HD) + EPS);
        bf16* o = MIXED + (size_t)m * DM + h * HD;
        o[lane] = (bf16)f2bf(a0 * rr * og[h * HD + lane]); o[lane + 64] = (bf16)f2bf(a1 * rr * og[h * HD + lane + 64]);
    }
}

__device__ __forceinline__ void phase_p15(Frame& F) {
    bf16* QK = (bf16*)(F.ws + WS_QK); const float* qg = F.in[3]; const float* kg = F.in[4];
    for (int m = GW_ID(F); m < MT; m += GW_N(F)) {
        GAS v4u* rowp = (GAS v4u*)(QK + (size_t)m * 2048) + F.lane;
#pragma unroll
        for (int j = 0; j < 4; ++j) {
            v4u w = rowp[64 * j];
            float f[8] = {bflo(w.x), bfhi(w.x), bflo(w.y), bfhi(w.y), bflo(w.z), bfhi(w.z), bflo(w.w), bfhi(w.w)};
            float ss = 0.f;
#pragma unroll
            for (int e = 0; e < 8; ++e) ss += f[e] * f[e];
            ss += __shfl_xor(ss, 1); ss += __shfl_xor(ss, 2); ss += __shfl_xor(ss, 4); ss += __shfl_xor(ss, 8);
            const float r = rsqrtf(ss * (1.f / HD) + EPS);
            const int col = 512 * j + 8 * F.lane, d = col & 127; const float* g = (col < 1024 ? qg : kg) + d;
#pragma unroll
            for (int e = 0; e < 8; ++e) f[e] = f[e] * r * g[e];
            w.x = pk2(f[0], f[1]); w.y = pk2(f[2], f[3]); w.z = pk2(f[4], f[5]); w.w = pk2(f[6], f[7]);
            rowp[64 * j] = w;
        }
    }
    const bf16* XT = (const bf16*)(F.ws + WS_XT) + (size_t)1024 * MT; bf16* UC = (bf16*)(F.ws + WS_UC);
    const float* cw = F.in[6]; const float* cb = F.in[7];
    const size_t nchunks = (size_t)3072 * MT / 8;
    for (size_t i = (size_t)F.bid * NTHREADS + F.tid; i < nchunks; i += (size_t)F.G * NTHREADS) {
        const int ch = (int)(i >> 10), m0 = (int)(i & 1023) * 8, s0 = m0 & 4095;
        const bf16* up = XT + (size_t)ch * MT + m0;
        const v4u w = *(const GAS v4u*)up;
        float f[10];
        f[1] = bflo(w.x); f[2] = bfhi(w.x); f[3] = bflo(w.y); f[4] = bfhi(w.y); f[5] = bflo(w.z); f[6] = bfhi(w.z); f[7] = bflo(w.w); f[8] = bfhi(w.w);
        f[0] = s0 > 0 ? bf2f(up[-1]) : 0.f; f[9] = s0 + 8 < SEQ ? bf2f(up[8]) : 0.f;
        const float w0 = cw[ch], w1 = cw[3072 + ch], w2 = cw[6144 + ch], bb = cb[ch];
        float o[8];
#pragma unroll
        for (int e = 0; e < 8; ++e) o[e] = bb + w0 * f[e] + w1 * f[e + 1] + w2 * f[e + 2];
        v4u ov; ov.x = pk2(o[0], o[1]); ov.y = pk2(o[2], o[3]); ov.z = pk2(o[4], o[5]); ov.w = pk2(o[6], o[7]);
        *(GAS v4u*)(UC + (size_t)ch * MT + m0) = ov;
    }
}
__device__ __forceinline__ void phase_p25(Frame& F) {
    const bf16* HYT = (const bf16*)(F.ws + WS_HYT); bf16* MIXED = (bf16*)(F.ws + WS_MIXED); const float* hg = F.in[16];
    LAS float* tile = (LAS float*)F.lds;
    LAS float* rs = (LAS float*)(F.lds + 128 * 65 * 4);
    for (int it = F.bid; it < 8 * (MT / 64); it += F.G) {
        const int gi = it & 7, m0 = (it >> 3) * 64;
        { const int ch = F.tid >> 2, t0 = (F.tid & 3) * 16; const bf16* p = HYT + (size_t)(gi * 128 + ch) * MT + m0 + t0;
          const v4u a = *(const GAS v4u*)p, b = *(const GAS v4u*)(p + 8);
          LAS float* d = tile + ch * 65 + t0;
          d[0] = bflo(a.x); d[1] = bfhi(a.x); d[2] = bflo(a.y); d[3] = bfhi(a.y); d[4] = bflo(a.z); d[5] = bfhi(a.z); d[6] = bflo(a.w); d[7] = bfhi(a.w);
          d[8] = bflo(b.x); d[9] = bfhi(b.x); d[10] = bflo(b.y); d[11] = bfhi(b.y); d[12] = bflo(b.z); d[13] = bfhi(b.z); d[14] = bflo(b.w); d[15] = bfhi(b.w); }
        __syncthreads();
        {
          const int t = F.tid >> 3, c0 = (F.tid & 7) * 16; float ss = 0.f;
#pragma unroll
          for (int c = 0; c < 16; ++c) { const float v = tile[(c0 + c) * 65 + t]; ss += v * v; }
          ss += __shfl_xor(ss, 1); ss += __shfl_xor(ss, 2); ss += __shfl_xor(ss, 4);
          if ((F.tid & 7) == 0) rs[t] = rsqrtf(ss * (1.f / 128) + EPS); }
        __syncthreads();
        {
          const int t = F.tid >> 3, c0 = (F.tid & 7) * 16; const float r = rs[t]; float o[16];
#pragma unroll
          for (int c = 0; c < 16; ++c) o[c] = tile[(c0 + c) * 65 + t] * r * hg[gi * 128 + c0 + c];
          v4u a, b; a.x = pk2(o[0], o[1]); a.y = pk2(o[2], o[3]); a.z = pk2(o[4], o[5]); a.w = pk2(o[6], o[7]); b.x = pk2(o[8], o[9]); b.y = pk2(o[10], o[11]); b.z = pk2(o[12], o[13]); b.w = pk2(o[14], o[15]);
          bf16* q = MIXED + (size_t)(m0 + t) * DM + AW + gi * 128 + c0; *(GAS v4u*)q = a; *(GAS v4u*)(q + 8) = b; }
        __syncthreads();
    }
}
__device__ __forceinline__ void phase_p35(Frame& F) {
    LAS float* wrT = (LAS float*)F.lds;
    const float* wr = F.in[19]; const float* g = F.in[18];
    for (int i = F.tid; i < DM * NE; i += NTHREADS) { const int d = i >> 4, e = i & 15; wrT[e * DM + d] = wr[i]; }
    __syncthreads();
    bf16* HB = (bf16*)(F.ws + WS_HB); float* AFF = (float*)(F.ws + WS_AFF); const float* x1 = F.out;
    for (int m = GW_ID(F); m < MT; m += GW_N(F)) {
        const GAS f32x4* xr = (const GAS f32x4*)(x1 + (size_t)m * DM) + F.lane;
        f32x4 v[8]; float s = 0.f;
#pragma unroll
        for (int j = 0; j < 8; ++j) { v[j] = xr[64 * j]; s += (v[j].x * v[j].x + v[j].y * v[j].y) + (v[j].z * v[j].z + v[j].w * v[j].w); }
        const float r = rsqrtf(wave_sum(s) * (1.f / DM) + EPS);
        GAS v2u* o8 = (GAS v2u*)(HB + (size_t)m * DM) + F.lane;
#pragma unroll
        for (int j = 0; j < 8; ++j) { const f32x4 gg = *((const GAS f32x4*)g + F.lane + 64 * j); v[j].x *= r * gg.x; v[j].y *= r * gg.y; v[j].z *= r * gg.z; v[j].w *= r * gg.w;
            v2u o; o.x = pk2(v[j].x, v[j].y); o.y = pk2(v[j].z, v[j].w); o8[64 * j] = o; }
        float mine = 0.f;
#pragma unroll 1
        for (int e = 0; e < NE; ++e) { float a = 0.f;
#pragma unroll
            for (int j = 0; j < 8; ++j) { const f32x4 w = *((const LAS f32x4*)(wrT + e * DM) + F.lane + 64 * j); a += (v[j].x * w.x + v[j].y * w.y) + (v[j].z * w.z + v[j].w * w.w); }
            a = wave_sum(a); mine = (F.lane == e) ? a : mine; }
        float mx = mine;
        mx = fmaxf(mx, __shfl_xor(mx, 1)); mx = fmaxf(mx, __shfl_xor(mx, 2)); mx = fmaxf(mx, __shfl_xor(mx, 4)); mx = fmaxf(mx, __shfl_xor(mx, 8));
        const float ex = expf(mine - mx); float den = ex;
        den += __shfl_xor(den, 1); den += __shfl_xor(den, 2); den += __shfl_xor(den, 4); den += __shfl_xor(den, 8);
        const int b = m / SEQ, sidx = m % SEQ;
        if (F.lane < NE) AFF[((size_t)b * NE + F.lane) * SEQ + sidx] = ex / den;
    }
    __syncthreads();
}
__device__ __forceinline__ void phase_p4(Frame& F) {
    LAS float* a = (LAS float*)F.lds;
    LAS int* rk = (LAS int*)(F.lds + 16384);
    const float* AFF = (const float*)(F.ws + WS_AFF); int* IDX = (int*)(F.ws + WS_IDX); float* GATE = (float*)(F.ws + WS_GATE); int* SEL = (int*)(F.ws + WS_SEL);
    const bf16* HB = (const bf16*)(F.ws + WS_HB); bf16* XG = (bf16*)(F.ws + WS_XG);
    for (int it = F.bid; it < NB * NE * 8; it += F.G) {
        const int be = it >> 3, ch = it & 7, b = be / NE, e = be % NE;
        const float* ap = AFF + (size_t)be * SEQ;
        for (int i = F.tid; i < SEQ / 4; i += NTHREADS) *((LAS f32x4*)a + i) = *((const GAS f32x4*)ap + i);
        __syncthreads();
        const int s = ch * 512 + F.tid; const float v = a[s]; int rank = 0;
        for (int i = 0; i < SEQ; i += 4) { const f32x4 u = *(const LAS f32x4*)(a + i);
            rank += (u.x > v || (u.x == v && i < s)) ? 1 : 0; rank += (u.y > v || (u.y == v && i + 1 < s)) ? 1 : 0;
            rank += (u.z > v || (u.z == v && i + 2 < s)) ? 1 : 0; rank += (u.w > v || (u.w == v && i + 3 < s)) ? 1 : 0; }
        rk[F.tid] = rank;
        const int m = b * SEQ + s;
        if (rank < CAP) { IDX[be * CAP + rank] = m; GATE[be * CAP + rank] = v; }
        SEL[(size_t)m * NE + e] = rank < CAP ? rank : -1;
        __syncthreads();
        for (int t = F.wave; t < 512; t += NWAVES) { const int r = rk[t]; if (r < CAP) {
            const GAS v4u* src = (const GAS v4u*)(HB + (size_t)(b * SEQ + ch * 512 + t) * DM) + F.lane; GAS v4u* dst = (GAS v4u*)(XG + (size_t)(be * CAP + r) * DM) + F.lane;
#pragma unroll
            for (int j = 0; j < 4; ++j) dst[64 * j] = src[64 * j]; } }
        __syncthreads();
    }
}
__device__ __forceinline__ void phase_p7(Frame& F) {
    const int* SEL = (const int*)(F.ws + WS_SEL); const float* GATE = (const float*)(F.ws + WS_GATE); const bf16* YE = (const bf16*)(F.ws + WS_YE);
    for (int m = GW_ID(F); m < MT; m += GW_N(F)) {
        const int b = m / SEQ;
        GAS f32x4* orow = (GAS f32x4*)(F.out + (size_t)m * DM);
        f32x4 acc[8];
#pragma unroll
        for (int j = 0; j < 8; ++j) acc[j] = orow[2 * F.lane + (j & 1) + 128 * (j >> 1)];
        for (int e = 0; e < NE; ++e) { const int slot = SEL[(size_t)m * NE + e]; if (slot >= 0) {
            const GAS v4u* yr = (const GAS v4u*)(YE + (size_t)((b * NE + e) * CAP + slot) * DM) + F.lane;
#pragma unroll
            for (int jj = 0; jj < 4; ++jj) { const v4u w = yr[64 * jj];
                acc[2 * jj].x += bflo(w.x); acc[2 * jj].y += bfhi(w.x); acc[2 * jj].z += bflo(w.y); acc[2 * jj].w += bfhi(w.y);
                acc[2 * jj + 1].x += bflo(w.z); acc[2 * jj + 1].y += bfhi(w.z); acc[2 * jj + 1].z += bflo(w.w); acc[2 * jj + 1].w += bfhi(w.w); } } }
#pragma unroll
        for (int j = 0; j < 8; ++j) orow[2 * F.lane + (j & 1) + 128 * (j >> 1)] = acc[j];
    }
    (void)GATE;
}

struct Args { const float* in[23]; float* out; unsigned char* ws; int ph_lo, ph_hi; };
enum Phase { PH_P0 = 0, PH_G1, PH_FILT, PH_P15, PH_ATTN, PH_HY0, PH_HY1, PH_P25, PH_OUT, PH_P35, PH_P4, PH_UP, PH_DOWN, PH_P7, PH_COUNT };

__global__ void __launch_bounds__(NTHREADS, 2) mk_fwd(Args args) {
    extern __shared__ __attribute__((aligned(16))) unsigned char lds_raw[];
    Frame F;
    F.lds = (LAS unsigned char*)lds_raw;
    F.tid = threadIdx.x; F.lane = F.tid & 63; F.wave = __builtin_amdgcn_readfirstlane(F.tid >> 6); F.G = gridDim.x; F.bid = blockIdx.x;
#pragma unroll
    for (int i = 0; i < 23; ++i) F.in[i] = args.in[i];
    F.out = args.out; F.ws = args.ws;
    const int lo = args.ph_lo, hi = args.ph_hi;
#define IN(k) (lo <= (k) && (k) < hi)
#if MK_N_LAUNCHES == 1
    cg::grid_group grid = cg::this_grid();
#define SEAM(k) do { if (IN(k) && IN((k) + 1)) grid.sync(); } while (0)
#else
#define SEAM(k) do { } while (0)
#endif
    if (IN(PH_P0)) { phase_p0(F); } SEAM(PH_P0);
    if (IN(PH_G1)) {
        __syncthreads();
        { pg8::DenseOrder S; S.init(F.ws + WS_HB, F.ws + WS_WIN, MT, 2048, DM, 0, F.G, F.bid);
          pg8::EpiBf16 E{(pg8::bf16_t*)(F.ws + WS_QK), 2048, 0, nullptr};
          pg8::gemm_phase<pg8::EpiBf16, pg8::DenseOrder, true>(F.lds, DM, S, E); }
        { pg8::DenseOrder S; S.init(F.ws + WS_HB, F.ws + WS_WIN, MT, 4096, DM, 8, F.G, F.bid);
          pg8::EpiTransBf16 E{(pg8::bf16_t*)(F.ws + WS_XT), MT, 8};
          pg8::gemm_phase<pg8::EpiTransBf16, pg8::DenseOrder, true>(F.lds, DM, S, E); }
    } SEAM(PH_G1);
    if (IN(PH_FILT)) { phase_filters_naive(F); } SEAM(PH_FILT);
    if (IN(PH_P15)) { phase_p15(F); } SEAM(PH_P15);
    if (IN(PH_ATTN)) { phase_attn_naive(F); } SEAM(PH_ATTN);
    if (IN(PH_HY0)) { phase_hyena_naive(F, 0); } SEAM(PH_HY0);
    if (IN(PH_HY1)) { phase_hyena_naive(F, 1); } SEAM(PH_HY1);
    if (IN(PH_P25)) { __syncthreads(); phase_p25(F); } SEAM(PH_P25);
    if (IN(PH_OUT)) {
        __syncthreads();
        pg8::DenseOrder S; S.init(F.ws + WS_MIXED, F.ws + WS_WOUT, MT, DM, DM, 0, F.G, F.bid);
        pg8::EpiResF32 E{F.in[0], F.out, DM};
        pg8::gemm_phase<pg8::EpiResF32, pg8::DenseOrder, false>(F.lds, DM, S, E);
    } SEAM(PH_OUT);
    if (IN(PH_P35)) { __syncthreads(); phase_p35(F); } SEAM(PH_P35);
    if (IN(PH_P4)) { __syncthreads(); phase_p4(F); } SEAM(PH_P4);
    if (IN(PH_UP)) {
        __syncthreads();
        pg8::MoeOrder S; S.init(F.ws + WS_XG, F.ws + WS_WGU, DM, F.G, F.bid);
        pg8::EpiSwiGLU E{(pg8::bf16_t*)(F.ws + WS_ACT)};
        pg8::gemm_phase<pg8::EpiSwiGLU, pg8::MoeOrder, true>(F.lds, DM, S, E);
    } SEAM(PH_UP);
    if (IN(PH_DOWN)) {
        __syncthreads();
        pg8::MoeOrder S; S.init(F.ws + WS_ACT, F.ws + WS_WD, FF, F.G, F.bid);
        pg8::EpiBf16 E{(pg8::bf16_t*)(F.ws + WS_YE), DM, 512, (const float*)(F.ws + WS_GATE)};
        pg8::gemm_phase<pg8::EpiBf16, pg8::MoeOrder, true>(F.lds, FF, S, E);
    } SEAM(PH_DOWN);
    if (IN(PH_P7)) { phase_p7(F); }
#undef IN
#undef SEAM
}

extern "C" void kernel_launch(void* const* d_in, const int* in_sizes, int n_in, void* d_out, int out_size, void* d_ws, size_t ws_size, hipStream_t stream) {
    static int grid = 0;
    if (grid == 0) {
        if (n_in != 23 || ws_size < WS_END) { fprintf(stderr, "kernel_launch: unexpected inputs (n_in %d, ws %zu)\n", n_in, ws_size); grid = -1; return; }
        if (hipFuncSetAttribute((const void*)mk_fwd, hipFuncAttributeMaxDynamicSharedMemorySize, LDS_BYTES) != hipSuccess) { fprintf(stderr, "kernel_launch: hipFuncSetAttribute failed\n"); grid = -1; return; }
        int dev = 0, cus = 0, per_cu = 0;
        hipGetDevice(&dev); hipDeviceGetAttribute(&cus, hipDeviceAttributeMultiprocessorCount, dev);
        hipOccupancyMaxActiveBlocksPerMultiprocessor(&per_cu, (const void*)mk_fwd, NTHREADS, LDS_BYTES);
        (void)hipGetLastError();
        if (per_cu < 1) { fprintf(stderr, "kernel_launch: occupancy query says %d blocks/CU\n", per_cu); }
        grid = cus;
    }
    if (grid < 0) return;
    Args a{};
    for (int i = 0; i < 23; ++i) a.in[i] = (const float*)d_in[i];
    a.out = (float*)d_out; a.ws = (unsigned char*)d_ws;
#if MK_N_LAUNCHES == 1
    a.ph_lo = 0; a.ph_hi = PH_COUNT;
    void* kargs[] = {&a};
    hipError_t e = hipLaunchCooperativeKernel((const void*)mk_fwd, dim3(grid), dim3(NTHREADS), kargs, LDS_BYTES, stream);
    if (e != hipSuccess) fprintf(stderr, "cooperative launch failed: %s (grid %d)\n", hipGetErrorString(e), grid);
#else
    for (int p = 0; p < PH_COUNT; ++p) { a.ph_lo = p; a.ph_hi = p + 1; hipLaunchKernelGGL(mk_fwd, dim3(grid), dim3(NTHREADS), LDS_BYTES, stream, a); }
#endif
}
```

```cpp
#include <hip/hip_runtime.h>
#include <hip/hip_cooperative_groups.h>
#include <cstdio>
#include <cstdint>
namespace cg = cooperative_groups;

#ifndef MK_N_LAUNCHES
#define MK_N_LAUNCHES 1
#endif

namespace pg8 {
#define PG8_LAS __attribute__((address_space(3)))
typedef unsigned short bf16_t;
typedef short bf16x8 __attribute__((ext_vector_type(8)));
typedef float f32x4 __attribute__((ext_vector_type(4)));
typedef unsigned u32x4 __attribute__((ext_vector_type(4)));
typedef unsigned u32x2 __attribute__((ext_vector_type(2)));
constexpr int BM = 256, BK = 64, HALF = 128, HTB = HALF * BK * 2, STAGE_BYTES = 8 * HTB, NXCD = 8, WGM = 8;

__host__ __device__ __forceinline__ int lds_byte(int r, int c) { const int st = (r >> 4) * 2 + (c >> 5), rr = r & 15, cc = c & 31, ob = rr * 64 + cc * 2; return st * 1024 + (ob ^ (((ob >> 9) & 1) << 5)); }
__host__ __device__ __forceinline__ void stage_rc(int b, int& R, int& C) { const int st = b / 1024, sb = b % 1024, swz = sb ^ (((sb >> 9) & 1) << 5); R = (st >> 1) * 16 + swz / 64; C = (st & 1) * 32 + (swz % 64) / 2; }
__host__ __device__ __forceinline__ int perm32(int rho) { const int n = rho >> 4, i = rho & 15; return 8 * (i >> 2) + 4 * n + (i & 3); }

struct Unit { int pm, pn, g; const char* a; const char* b; };

__device__ __forceinline__ unsigned cvt_pk_bf16(float lo, float hi) { unsigned r; asm volatile("v_cvt_pk_bf16_f32 %0, %1, %2" : "=v"(r) : "v"(lo), "v"(hi)); return r; }

struct DenseOrder {
    int nM, nN, nwg, G, c, K, pn0; const char* A; const char* Bt;
    __device__ void init(const void* A_, const void* Bt_, int M, int N, int K_, int pn0_, int G_, int c_) { A = (const char*)A_; Bt = (const char*)Bt_; nM = M / BM; nN = N / BM; nwg = nM * nN; G = G_; c = c_; K = K_; pn0 = pn0_; }
    __device__ bool next(int i, Unit& u) const {
        const long L = (long)i * G + c; if (L >= nwg) return false;
        int wgid = (int)L; { const int q = nwg / NXCD, r = nwg % NXCD, xcd = wgid % NXCD, off = wgid / NXCD; wgid = (xcd < r ? xcd * (q + 1) : r * (q + 1) + (xcd - r) * q) + off; }
        const int nig = WGM * nN, gid = wgid / nig, fm = gid * WGM, gsz = (nM - fm) < WGM ? (nM - fm) : WGM;
        u.pm = fm + ((wgid % nig) % gsz); u.pn = pn0 + (wgid % nig) / gsz; u.g = 0;
        u.a = A + (size_t)u.pm * BM * K * 2; u.b = Bt + (size_t)u.pn * BM * K * 2; return true;
    }
};
struct MoeOrder {
    int G, c, K; const char* A; const char* Bt;
    __device__ void init(const void* A_, const void* Bt_, int K_, int G_, int c_) { A = (const char*)A_; Bt = (const char*)Bt_; K = K_; G = G_; c = c_; }
    __device__ bool next(int i, Unit& u) const {
        const int L = i * G + c; if (L >= 512) return false;
        const int pn = L & 7, pm = (L >> 3) & 1, b = (L >> 4) & 1, e = L >> 5;
        u.pm = pm; u.pn = pn; u.g = b * 16 + e;
        u.a = A + (size_t)(u.g * 512 + pm * BM) * K * 2; u.b = Bt + (size_t)(e * 2048 + pn * BM) * K * 2; return true;
    }
};

struct EpiBf16 {
    static constexpr bool PERM = true, SWAP = false;
    bf16_t* O; int ldc; int grows; const float* rscale;
    __device__ __forceinline__ void operator()(const f32x4 (&acc)[2][2][4][2], const Unit& u, int wr, int wc, int fr, int fq) const {
        const int row0 = u.g * grows + u.pm * BM + wr * 64 + fr, col0 = u.pn * BM + wc * 32 + 8 * fq;
#pragma unroll
        for (int ai = 0; ai < 2; ++ai)
#pragma unroll
            for (int m = 0; m < 4; ++m) { const int row = row0 + ai * HALF + m * 16; bf16_t* rowp = O + (size_t)row * ldc + col0; const float sc = rscale ? rscale[row] : 1.f;
#pragma unroll
                for (int bj = 0; bj < 2; ++bj) { const f32x4 v0 = acc[ai][bj][m][0] * sc, v1 = acc[ai][bj][m][1] * sc;
                    u32x4 w; w.x = cvt_pk_bf16(v0[0], v0[1]); w.y = cvt_pk_bf16(v0[2], v0[3]); w.z = cvt_pk_bf16(v1[0], v1[1]); w.w = cvt_pk_bf16(v1[2], v1[3]);
                    *(u32x4*)(rowp + bj * HALF) = w; } }
    }
};
struct EpiSwiGLU {
    static constexpr bool PERM = true, SWAP = false;
    bf16_t* O;
    __device__ __forceinline__ void operator()(const f32x4 (&acc)[2][2][4][2], const Unit& u, int wr, int wc, int fr, int fq) const {
        const int row0 = u.g * 512 + u.pm * BM + wr * 64 + fr, col0 = u.pn * HALF + wc * 32 + 8 * fq;
#pragma unroll
        for (int ai = 0; ai < 2; ++ai)
#pragma unroll
            for (int m = 0; m < 4; ++m) { bf16_t* rowp = O + (size_t)(row0 + ai * HALF + m * 16) * 1024 + col0;
                float r[8];
#pragma unroll
                for (int n = 0; n < 2; ++n)
#pragma unroll
                    for (int e = 0; e < 4; ++e) { const float g = acc[ai][0][m][n][e], up = acc[ai][1][m][n][e]; r[n * 4 + e] = g / (1.f + __expf(-g)) * up; }
                u32x4 w; w.x = cvt_pk_bf16(r[0], r[1]); w.y = cvt_pk_bf16(r[2], r[3]); w.z = cvt_pk_bf16(r[4], r[5]); w.w = cvt_pk_bf16(r[6], r[7]);
                *(u32x4*)rowp = w; }
    }
};
struct EpiResF32 {
    static constexpr bool PERM = false, SWAP = false;
    const float* res; float* out; int ldc;
    __device__ __forceinline__ void operator()(const f32x4 (&acc)[2][2][4][2], const Unit& u, int wr, int wc, int fr, int fq) const {
        const int row0 = u.pm * BM + wr * 64 + fr, col0 = u.pn * BM + wc * 32 + 4 * fq;
#pragma unroll
        for (int ai = 0; ai < 2; ++ai)
#pragma unroll
            for (int m = 0; m < 4; ++m) { const size_t off = (size_t)(row0 + ai * HALF + m * 16) * ldc + col0;
#pragma unroll
                for (int bj = 0; bj < 2; ++bj)
#pragma unroll
                    for (int n = 0; n < 2; ++n) { const f32x4 r = *(const f32x4*)(res + off + bj * HALF + n * 16); *(f32x4*)(out + off + bj * HALF + n * 16) = r + acc[ai][bj][m][n]; } }
    }
};
struct EpiTransBf16 {
    static constexpr bool PERM = false, SWAP = true;
    bf16_t* O; int ldt; int pn_base;
    __device__ __forceinline__ void operator()(const f32x4 (&acc)[2][2][4][2], const Unit& u, int wr, int wc, int fr, int fq) const {
        const int ch0 = (u.pn - pn_base) * BM + wc * 32 + fr, t0 = u.pm * BM + wr * 64 + 4 * fq;
#pragma unroll
        for (int bj = 0; bj < 2; ++bj)
#pragma unroll
            for (int n = 0; n < 2; ++n) { bf16_t* chp = O + (size_t)(ch0 + bj * HALF + n * 16) * ldt + t0;
#pragma unroll
                for (int ai = 0; ai < 2; ++ai)
#pragma unroll
                    for (int m = 0; m < 4; ++m) { const f32x4 v = acc[ai][bj][m][n]; u32x2 w; w.x = cvt_pk_bf16(v[0], v[1]); w.y = cvt_pk_bf16(v[2], v[3]); *(u32x2*)(chp + ai * HALF + m * 16) = w; } }
    }
};

template <class Epi, class Sched, bool ALIGN_EPI = false>
__device__ __forceinline__ void gemm_phase(PG8_LAS unsigned char* lds, const int K, const Sched& S, const Epi& E) {
    const int tid = threadIdx.x, wid = __builtin_amdgcn_readfirstlane(tid >> 6), lane = tid & 63, wr = wid >> 2, wc = wid & 3, fr = lane & 15, fq = lane >> 4;
    const int nt = K / BK;
    unsigned voffA[2], voffB[2];
#pragma unroll
    for (int i = 0; i < 2; ++i) { int R, C; stage_rc(tid * 16 + i * 8192, R, C); const int Rb = Epi::PERM ? ((R & ~31) + perm32(R & 31)) : R;
        voffA[i] = (unsigned)(R * K + C) * 2u; voffB[i] = (unsigned)(Rb * K + C) * 2u; }
    const size_t kstep = (size_t)(BK * 2);
    const size_t hstep = (size_t)HALF * K * 2;
    const unsigned ldsw = (unsigned)wid * 1024u;
    const int aoff = lds_byte(wr * 64 + fr, fq * 8), boff = lds_byte(wc * 32 + fr, fq * 8);
#define PG8_SA(b, h) (((b) * 2 + (h)) * HTB)
#define PG8_SB(b, h) ((4 + (b) * 2 + (h)) * HTB)
#define PG8_STAGE(bufoff, gbase, voff) do { _Pragma("unroll") for (int _i = 0; _i < 2; ++_i) \
        __builtin_amdgcn_global_load_lds((const unsigned*)((const char*)(gbase) + (voff)[_i]), (PG8_LAS unsigned*)(lds + (bufoff) + ldsw + _i * 8192), 16, 0, 0); } while (0)
#define PG8_LDA(dst, b, h) do { _Pragma("unroll") for (int m = 0; m < 4; ++m) _Pragma("unroll") for (int k = 0; k < 2; ++k) dst[m][k] = *(const PG8_LAS bf16x8*)(lds + PG8_SA(b, h) + aoff + m * 2048 + k * 1024); } while (0)
#define PG8_LDB(dst, b, h) do { _Pragma("unroll") for (int n = 0; n < 2; ++n) _Pragma("unroll") for (int k = 0; k < 2; ++k) dst[n][k] = *(const PG8_LAS bf16x8*)(lds + PG8_SB(b, h) + boff + n * 2048 + k * 1024); } while (0)
#define PG8_MMA(ai, bj, At, Bt) do { __builtin_amdgcn_s_setprio(1); _Pragma("unroll") for (int m = 0; m < 4; ++m) _Pragma("unroll") for (int n = 0; n < 2; ++n) _Pragma("unroll") for (int k = 0; k < 2; ++k) \
        acc[ai][bj][m][n] = Epi::SWAP ? __builtin_amdgcn_mfma_f32_16x16x32_bf16(At[m][k], Bt[n][k], acc[ai][bj][m][n], 0, 0, 0) : __builtin_amdgcn_mfma_f32_16x16x32_bf16(Bt[n][k], At[m][k], acc[ai][bj][m][n], 0, 0, 0); __builtin_amdgcn_s_setprio(0); } while (0)
#define PG8_WAIT_V(n) asm volatile("s_waitcnt vmcnt(" #n ")" ::: "memory")
#define PG8_WAIT_L(n) asm volatile("s_waitcnt lgkmcnt(" #n ")" ::: "memory")
#define PG8_BAR __builtin_amdgcn_s_barrier()
#define PG8_SCHED __builtin_amdgcn_sched_barrier(0)
    Unit cur, nxt; int ui = 0;
    if (!S.next(0, cur)) return;
    f32x4 acc[2][2][4][2];
#pragma unroll
    for (int a = 0; a < 2; ++a)
#pragma unroll
        for (int b = 0; b < 2; ++b)
#pragma unroll
            for (int m = 0; m < 4; ++m)
#pragma unroll
                for (int n = 0; n < 2; ++n) acc[a][b][m][n] = (f32x4){0.f, 0.f, 0.f, 0.f};
    bf16x8 At[4][2], B0[2][2], B1[2][2];
    const char* cA = cur.a; const char* cB = cur.b;
    PG8_STAGE(PG8_SB(0, 0), cB, voffB); PG8_STAGE(PG8_SB(0, 1), cB + hstep, voffB); PG8_STAGE(PG8_SA(0, 0), cA, voffA); PG8_STAGE(PG8_SA(0, 1), cA + hstep, voffA);
    if (wr == 1) PG8_BAR;
    PG8_WAIT_V(2); PG8_BAR;
    PG8_STAGE(PG8_SB(1, 0), cB + kstep, voffB); PG8_STAGE(PG8_SA(1, 0), cA + kstep, voffA); PG8_STAGE(PG8_SB(1, 1), cB + hstep + kstep, voffB);
    PG8_WAIT_V(6); PG8_BAR;
    for (;;) {
        const bool has_next = S.next(ui + 1, nxt);
        const char* nA = has_next ? nxt.a : cA; const char* nB = has_next ? nxt.b : cB;
        for (int t = 0; t < nt; t += 2) {
            const bool last = (t == nt - 2);
            const char* a1 = cA + (size_t)(t + 1) * kstep;
            const char* a2 = last ? nA : cA + (size_t)(t + 2) * kstep; const char* b2 = last ? nB : cB + (size_t)(t + 2) * kstep;
            const char* a3 = a2 + kstep; const char* b3 = b2 + kstep;
            PG8_LDB(B0, 0, 0); PG8_LDB(B1, 0, 1); PG8_SCHED; PG8_LDA(At, 0, 0); PG8_STAGE(PG8_SA(1, 1), a1 + hstep, voffA);
            PG8_WAIT_V(8); PG8_WAIT_L(0); PG8_BAR; PG8_MMA(0, 0, At, B0); PG8_MMA(0, 1, At, B1); PG8_BAR; PG8_SCHED;
            PG8_LDA(At, 0, 1); PG8_STAGE(PG8_SB(0, 0), b2, voffB); PG8_STAGE(PG8_SB(0, 1), b2 + hstep, voffB); PG8_STAGE(PG8_SA(0, 0), a2, voffA);
            PG8_WAIT_V(8); PG8_WAIT_L(0); PG8_BAR; PG8_MMA(1, 0, At, B0); PG8_MMA(1, 1, At, B1); PG8_BAR; PG8_SCHED;
            PG8_LDB(B0, 1, 0); PG8_LDB(B1, 1, 1); PG8_SCHED; PG8_LDA(At, 1, 0); PG8_STAGE(PG8_SA(0, 1), a2 + hstep, voffA);
            PG8_WAIT_V(8); PG8_WAIT_L(0); PG8_BAR; PG8_MMA(0, 0, At, B0); PG8_MMA(0, 1, At, B1); PG8_BAR; PG8_SCHED;
            PG8_LDA(At, 1, 1); PG8_STAGE(PG8_SB(1, 0), b3, voffB); PG8_STAGE(PG8_SB(1, 1), b3 + hstep, voffB); PG8_STAGE(PG8_SA(1, 0), a3, voffA);
            PG8_WAIT_V(8); PG8_WAIT_L(0); PG8_BAR; PG8_MMA(1, 0, At, B0); PG8_MMA(1, 1, At, B1); PG8_BAR; PG8_SCHED;
        }
        if constexpr (ALIGN_EPI) { if (wr == 0) PG8_BAR; }
        E(acc, cur, wr, wc, fr, fq);
        if (!has_next) break;
#pragma unroll
        for (int a = 0; a < 2; ++a)
#pragma unroll
            for (int b = 0; b < 2; ++b)
#pragma unroll
                for (int m = 0; m < 4; ++m)
#pragma unroll
                    for (int n = 0; n < 2; ++n) acc[a][b][m][n] = (f32x4){0.f, 0.f, 0.f, 0.f};
        cur = nxt; cA = nA; cB = nB; ++ui;
        if constexpr (ALIGN_EPI) { if (wr == 1) PG8_BAR; }
    }
    PG8_WAIT_V(0);
    if constexpr (!ALIGN_EPI) { if (wr == 0) PG8_BAR; }
    PG8_BAR;
#undef PG8_SA
#undef PG8_SB
#undef PG8_STAGE
#undef PG8_LDA
#undef PG8_LDB
#undef PG8_MMA
#undef PG8_WAIT_V
#undef PG8_WAIT_L
#undef PG8_BAR
#undef PG8_SCHED
}
}

constexpr int NB = 2, SEQ = 4096, DM = 2048, MT = NB * SEQ;
constexpr int NH = 8, HD = 128, AW = 1024, HW = 1024, INW = 6144;
constexpr int GW = 64, NROWS = 64, WR = 8, WC = 16;
constexpr int NE = 16, CAP = 512, FF = 1024;
constexpr int FEMB = 33, FHID = 64;
constexpr float EPS = 1e-6f;
constexpr int NWAVES = 8, NTHREADS = 512;

constexpr size_t MiB = 1u << 20;
constexpr size_t WS_CTL = 0, CTL_ZERO_BYTES = 1 * MiB;
constexpr size_t WS_WIN = 2 * MiB;
constexpr size_t WS_WOUT = 26 * MiB;
constexpr size_t WS_WGU = 34 * MiB;
constexpr size_t WS_WD = 162 * MiB;
constexpr size_t WS_W3T = 226 * MiB;
constexpr size_t WS_HID2 = 227 * MiB;
constexpr size_t WS_HB = 228 * MiB;
constexpr size_t WS_QK = 260 * MiB;
constexpr size_t WS_XT = 292 * MiB;
constexpr size_t WS_UC = 356 * MiB;
constexpr size_t WS_TAPS = 404 * MiB;
constexpr size_t WS_HYT = 436 * MiB;
constexpr size_t WS_MIXED = 452 * MiB;
constexpr size_t WS_AFF = 484 * MiB;
constexpr size_t WS_IDX = 485 * MiB;
constexpr size_t WS_GATE = 486 * MiB;
constexpr size_t WS_SEL = 487 * MiB;
constexpr size_t WS_Z1T = 488 * MiB;
constexpr size_t WS_XG = WS_XT;
constexpr size_t WS_ACT = WS_UC;
constexpr size_t WS_YE = WS_TAPS;
constexpr size_t WS_END = 504 * MiB;

constexpr int LDS_BYTES = 163840;

#define GAS __attribute__((address_space(1)))
#define LAS __attribute__((address_space(3)))
typedef unsigned short bf16;
typedef unsigned v4u __attribute__((ext_vector_type(4)));
typedef unsigned v2u __attribute__((ext_vector_type(2)));
typedef float f32x4 __attribute__((ext_vector_type(4)));
#define LDS_WAIT() asm volatile("s_waitcnt lgkmcnt(0)" ::: "memory")
#define VM_WAIT() asm volatile("s_waitcnt vmcnt(0)" ::: "memory")
__device__ __forceinline__ unsigned f2bf(float f) { unsigned u = __builtin_bit_cast(unsigned, f); return (u + 0x7fffu + ((u >> 16) & 1u)) >> 16; }
__device__ __forceinline__ unsigned pk2(float lo, float hi) { return f2bf(lo) | (f2bf(hi) << 16); }
__device__ __forceinline__ float bf2f(unsigned h) { return __builtin_bit_cast(float, h << 16); }
__device__ __forceinline__ float bflo(unsigned w) { return __builtin_bit_cast(float, w << 16); }
__device__ __forceinline__ float bfhi(unsigned w) { return __builtin_bit_cast(float, w & 0xffff0000u); }
__device__ __forceinline__ float wave_sum(float v) {
#pragma unroll
    for (int o = 1; o < 64; o <<= 1) v += __shfl_xor(v, o);
    return v;
}

struct Frame {
    LAS unsigned char* lds;
    int tid, lane, wave, G, bid;
    const float* in[23]; float* out; unsigned char* ws;
};
#define GW_ID(F) ((F).bid * NWAVES + (F).wave)
#define GW_N(F) ((F).G * NWAVES)

__device__ __forceinline__ void p0_transpose_item(const float* W, int K, int N, bf16* WT, int row_base, int k0, int n0, LAS float* scr, int lane) {
#pragma unroll 8
    for (int i = 0; i < 32; ++i) { const int kk = 2 * i + (lane >> 5); scr[kk * 33 + (lane & 31)] = W[(size_t)(k0 + kk) * N + n0 + (lane & 31)]; }
    LDS_WAIT(); asm volatile("" ::: "memory");
    const int c = lane & 7;
#pragma unroll
    for (int j = 0; j < 4; ++j) { const int n = (lane >> 3) + 8 * j; const LAS float* s = scr + (8 * c) * 33 + n;
        v4u o; o.x = pk2(s[0 * 33], s[1 * 33]); o.y = pk2(s[2 * 33], s[3 * 33]); o.z = pk2(s[4 * 33], s[5 * 33]); o.w = pk2(s[6 * 33], s[7 * 33]);
        *(GAS v4u*)(WT + (size_t)(row_base + n) * K + k0 + 8 * c) = o; }
    LDS_WAIT(); asm volatile("" ::: "memory");
}
__device__ __forceinline__ void phase_p0(Frame& F) {
    LAS float* scr = (LAS float*)(F.lds + F.wave * 16384);
    const int gw = GW_ID(F), NGW = GW_N(F);
    bf16* WinT = (bf16*)(F.ws + WS_WIN); bf16* WoutT = (bf16*)(F.ws + WS_WOUT); bf16* WguT = (bf16*)(F.ws + WS_WGU); bf16* WdT = (bf16*)(F.ws + WS_WD); bf16* W3T = (bf16*)(F.ws + WS_W3T);
    constexpr int I_IN = (DM / 64) * (INW / 32), I_OUT = (DM / 64) * (DM / 32), I_G = (DM / 64) * (FF / 32), I_D = (FF / 64) * (DM / 32), I_3 = 1 * (4096 / 32);
    constexpr int NITEMS = I_IN + I_OUT + 2 * NE * I_G + NE * I_D + I_3;
    for (int it = gw; it < NITEMS; it += NGW) {
        int r = it;
        if (r < I_IN) { const int nblk = INW / 32, kb = r / nblk, nb = r % nblk; p0_transpose_item(F.in[2], DM, INW, WinT, 32 * nb, 64 * kb, 32 * nb, scr, F.lane); continue; } r -= I_IN;
        if (r < I_OUT) { const int nblk = DM / 32, kb = r / nblk, nb = r % nblk; p0_transpose_item(F.in[17], DM, DM, WoutT, 32 * nb, 64 * kb, 32 * nb, scr, F.lane); continue; } r -= I_OUT;
        if (r < 2 * NE * I_G) { const int which = r / (NE * I_G); r %= NE * I_G; const int e = r / I_G; r %= I_G; const int nblk = FF / 32, kb = r / nblk, nb = r % nblk, f0 = 32 * nb;
            const float* W = (which ? F.in[21] : F.in[20]) + (size_t)e * DM * FF;
            const int row_base = e * 2048 + (f0 >> 7) * 256 + which * 128 + (f0 & 127);
            p0_transpose_item(W, DM, FF, WguT, row_base, 64 * kb, f0, scr, F.lane); continue; } r -= 2 * NE * I_G;
        if (r < NE * I_D) { const int e = r / I_D; r %= I_D; const int nblk = DM / 32, kb = r / nblk, nb = r % nblk;
            p0_transpose_item(F.in[22] + (size_t)e * FF * DM, FF, DM, WdT, e * 2048 + 32 * nb, 64 * kb, 32 * nb, scr, F.lane); continue; } r -= NE * I_D;
        { const int nb = r; p0_transpose_item(F.in[12], FHID, 4096, W3T, 32 * nb, 0, 32 * nb, scr, F.lane); }
    }
    bf16* HB = (bf16*)(F.ws + WS_HB);
    const float* x = F.in[0]; const float* g = F.in[1];
    for (int m = gw; m < MT; m += NGW) {
        const GAS f32x4* xr = (const GAS f32x4*)(x + (size_t)m * DM) + F.lane;
        f32x4 v[8]; float s = 0.f;
#pragma unroll
        for (int j = 0; j < 8; ++j) { v[j] = xr[64 * j]; s += (v[j].x * v[j].x + v[j].y * v[j].y) + (v[j].z * v[j].z + v[j].w * v[j].w); }
        const float r = rsqrtf(wave_sum(s) * (1.f / DM) + EPS);
        GAS v2u* o8 = (GAS v2u*)(HB + (size_t)m * DM) + F.lane;
#pragma unroll
        for (int j = 0; j < 8; ++j) { const f32x4 gg = *((const GAS f32x4*)g + F.lane + 64 * j); v2u o; o.x = pk2(v[j].x * r * gg.x, v[j].y * r * gg.y); o.y = pk2(v[j].z * r * gg.z, v[j].w * r * gg.w); o8[64 * j] = o; }
    }
    float* HID2 = (float*)(F.ws + WS_HID2);
    LAS float* sc2 = (LAS float*)(F.lds + F.wave * 16384);
    const float* w1 = F.in[8]; const float* b1 = F.in[9]; const float* w2 = F.in[10]; const float* b2 = F.in[11]; const float* fr = F.in[13];
    for (int l = gw; l < SEQ; l += NGW) {
        const int j = F.lane;
        float zv = 0.f;
        if (j == 0) zv = (float)l / (float)(SEQ - 1);
        else if (j < FEMB) { const int k = (j - 1) & 15; const float f = 1e-4f + (float)k * ((15.0f - 1e-4f) / 15.0f); const float wv = 6.283185307179586f * (float)l / (float)SEQ; zv = (j <= 16) ? cosf(f * wv) : -sinf(f * wv); }
        sc2[j] = zv; LDS_WAIT(); asm volatile("" ::: "memory");
        float a = b1[j];
        for (int i = 0; i < FEMB; ++i) a += sc2[i] * w1[i * FHID + j];
        const float h1 = sinf(fr[j] * a);
        sc2[64 + j] = h1; LDS_WAIT(); asm volatile("" ::: "memory");
        float c = b2[j];
        for (int i = 0; i < FHID; ++i) c += sc2[64 + i] * w2[i * FHID + j];
        HID2[l * FHID + j] = sinf(fr[j] * c);
        LDS_WAIT(); asm volatile("" ::: "memory");
    }
}

__device__ __forceinline__ void phase_filters_naive(Frame& F) {
    const float* HID2 = (const float*)(F.ws + WS_HID2); const float* w3 = F.in[12]; const float* fbias = F.in[14]; bf16* TAPS = (bf16*)(F.ws + WS_TAPS);
    const size_t total = (size_t)SEQ * 4096;
    for (size_t i = (size_t)F.bid * NTHREADS + F.tid; i < total; i += (size_t)F.G * NTHREADS) {
        const int col = (int)(i & 4095), l = (int)(i >> 12);
        float a = 0.f;
        for (int k = 0; k < FHID; ++k) a += HID2[l * FHID + k] * w3[(size_t)k * 4096 + col];
        const int c = col & 1023, dir = (col >> 10) & 1, o = col >> 11;
        const float mind = -4.605170185988091f / 1.5f, maxd = -4.605170185988091f / 0.3f;
        const float delta = fabsf(mind + (maxd - mind) * ((float)c / 1023.0f));
        const float t = (float)l / (float)(SEQ - 1);
        float v = a * expf(-t * delta);
        bf16* tp = TAPS + ((size_t)c * 2 + o) * 8192;
        if (dir == 0) { if (l == 0) v += fbias[o * 1024 + c]; tp[4096 + l] = (bf16)f2bf(v); }
        else { if (l > 0) tp[4096 - l] = (bf16)f2bf(v); else tp[0] = 0; }
    }
}
__device__ __forceinline__ void phase_hyena_naive(Frame& F, int o) {
    const bf16* UC = (const bf16*)(F.ws + WS_UC); const bf16* TAPS = (const bf16*)(F.ws + WS_TAPS);
    bf16* Z1T = (bf16*)(F.ws + WS_Z1T); bf16* HYT = (bf16*)(F.ws + WS_HYT);
    const bf16* Zin = o == 0 ? UC + (size_t)2048 * MT : Z1T; const bf16* gate = UC + (size_t)(o * 1024) * MT; bf16* OUT = o == 0 ? Z1T : HYT;
    const size_t total = (size_t)1024 * MT;
    for (size_t i = (size_t)F.bid * NTHREADS + F.tid; i < total; i += (size_t)F.G * NTHREADS) {
        const int c = (int)(i >> 13), m = (int)(i & 8191), b = m >> 12, t = m & 4095;
        const bf16* z = Zin + (size_t)c * MT + b * SEQ; const bf16* tp = TAPS + ((size_t)c * 2 + o) * 8192 + 4096 + t;
        float acc = 0.f;
        for (int s = 0; s < SEQ; ++s) acc += bf2f(tp[-s]) * bf2f(z[s]);
        OUT[(size_t)c * MT + m] = (bf16)f2bf(bf2f(gate[(size_t)c * MT + m]) * acc);
    }
}
__device__ __forceinline__ void phase_attn_naive(Frame& F) {
    const bf16* QK = (const bf16*)(F.ws + WS_QK); const bf16* VT = (const bf16*)(F.ws + WS_XT); bf16* MIXED = (bf16*)(F.ws + WS_MIXED);
    const float* rpb = F.in[5]; const float* og = F.in[15];
    const int lane = F.lane;
    for (int w = GW_ID(F); w < MT * NH; w += GW_N(F)) {
        const int m = w >> 3, h = w & 7, b = m / SEQ, s = m % SEQ, r = s / GW, c = s % GW;
        int kr0 = r - WR / 2; kr0 = kr0 < 0 ? 0 : (kr0 > NROWS - WR ? NROWS - WR : kr0);
        int c0 = c - WC / 2; c0 = c0 < 0 ? 0 : (c0 > GW - WC ? GW - WC : c0);
        const bf16* q = QK + (size_t)m * 2048 + h * HD;
        const float q0 = bf2f(q[lane]), q1 = bf2f(q[lane + 64]);
        float mx = -INFINITY, l = 0.f, a0 = 0.f, a1 = 0.f;
        for (int i = 0; i < WR; ++i) for (int j = 0; j < WC; ++j) {
            const int kr = kr0 + i, kc = c0 + j; const size_t km = (size_t)b * SEQ + kr * GW + kc;
            const bf16* kp = QK + km * 2048 + 1024 + h * HD;
            const float d = wave_sum(q0 * bf2f(kp[lane]) + q1 * bf2f(kp[lane + 64]));
            const int dr = kr - r + WR - 1; int dc = kc - c + WC - 1; dc = dc < 0 ? 0 : (dc > 2 * WC - 2 ? 2 * WC - 2 : dc);
            const float sc = d * 0.08838834764831845f + rpb[(h * (2 * WR - 1) + dr) * (2 * WC - 1) + dc];
            const float mn = fmaxf(mx, sc), corr = __expf(mx - mn), pw = __expf(sc - mn);
            const float v0 = bf2f(VT[(size_t)(h * HD + lane) * MT + km]), v1 = bf2f(VT[(size_t)(h * HD + lane + 64) * MT + km]);
            l = l * corr + pw; a0 = a0 * corr + pw * v0; a1 = a1 * corr + pw * v1; mx = mn;
        }
        a0 /= l; a1 /= l;
        const float rr = rsqrtf(wave_sum(a0 * a0 + a1 * a1) * (1.f / HD) + EPS);
        bf16* o = MIXED + (size_t)m * DM + h * HD;
        o[lane] = (bf16)f2bf(a0 * rr * og[h * HD + lane]); o[lane + 64] = (bf16)f2bf(a1 * rr * og[h * HD + lane + 64]);
    }
}


typedef short bf16x8 __attribute__((ext_vector_type(8)));
typedef float f32x16 __attribute__((ext_vector_type(16)));
__device__ __forceinline__ void phase_filters(Frame& F) {
    const float* HID2 = (const float*)(F.ws + WS_HID2); const bf16* W3T = (const bf16*)(F.ws + WS_W3T); const float* fbias = F.in[14]; bf16* TAPS = (bf16*)(F.ws + WS_TAPS);
    const int n = F.lane & 31, hh = F.lane >> 5;
    for (int it = GW_ID(F); it < 128 * 128; it += GW_N(F)) {
        const int col0 = (it >> 7) * 32, l0 = (it & 127) * 32;
        f32x16 acc;
#pragma unroll
        for (int i = 0; i < 16; ++i) acc[i] = 0.f;
#pragma unroll
        for (int ks = 0; ks < 4; ++ks) {
            const bf16x8 a = *(const GAS bf16x8*)(W3T + (size_t)(col0 + n) * FHID + 16 * ks + 8 * hh);
            const GAS f32x4* hp = (const GAS f32x4*)(HID2 + (size_t)(l0 + n) * FHID + 16 * ks + 8 * hh);
            const f32x4 h0 = hp[0], h1 = hp[1];
            v4u bw; bw.x = pk2(h0.x, h0.y); bw.y = pk2(h0.z, h0.w); bw.z = pk2(h1.x, h1.y); bw.w = pk2(h1.z, h1.w);
            acc = __builtin_amdgcn_mfma_f32_32x32x16_bf16(a, __builtin_bit_cast(bf16x8, bw), acc, 0, 0, 0);
        }
        const int l = l0 + n; const float t = (float)l / (float)(SEQ - 1);
        const int dir = (col0 >> 10) & 1, o = col0 >> 11;
        const float mind = -4.605170185988091f / 1.5f, maxd = -4.605170185988091f / 0.3f;
#pragma unroll
        for (int i = 0; i < 16; ++i) {
            const int c = (col0 & 1023) + (i & 3) + 8 * (i >> 2) + 4 * hh;
            const float delta = fabsf(mind + (maxd - mind) * ((float)c / 1023.0f));
            float v = acc[i] * __expf(-t * delta);
            bf16* tp = TAPS + ((size_t)c * 2 + o) * 8192;
            if (dir == 0) { if (l == 0) v += fbias[o * 1024 + c]; tp[4096 + l] = (bf16)f2bf(v); }
            else { if (l > 0) tp[4096 - l] = (bf16)f2bf(v); else tp[0] = 0; }
        }
    }
}

constexpr int HY_TAPS_BYTES = 4 * 16384, HY_ZB_ENT = 6080, HY_ZB_BYTES = HY_ZB_ENT * 2;
__device__ __forceinline__ unsigned hy_zb_off(int idx0  ) { const int q = idx0 >> 3; return (unsigned)((q ^ ((q >> 4) & 3)) << 4); }
template <int MASK>
__device__ __forceinline__ void hy_segment(f32x16 (&acc)[4], const LAS bf16* taps, const LAS unsigned char* zb, int g0, int g1, int n, int hh) {
#pragma unroll 2
    for (int g = g0; g < g1; ++g) {
        const LAS bf16* tp = taps + 1 + 16 * g + 8 * hh + n;
        bf16x8 a;
#pragma unroll
        for (int j = 0; j < 8; ++j) a[j] = (short)tp[j];
#pragma unroll
        for (int tau = 0; tau < 4; ++tau) if (MASK & (1 << tau)) {
            const bf16x8 b = *(const LAS bf16x8*)(zb + hy_zb_off(992 - 1024 * tau - 32 * n + 16 * g + 8 * hh));
            acc[tau] = __builtin_amdgcn_mfma_f32_32x32x16_bf16(a, b, acc[tau], 0, 0, 0);
        }
    }
}
__device__ __forceinline__ void hy_stage_taps(Frame& F, int c0, int o) {
    const bf16* TAPS = (const bf16*)(F.ws + WS_TAPS);
#pragma unroll
    for (int j = 0; j < 8; ++j) { const int ch = F.tid + NTHREADS * j, ci = ch >> 10, w = ch & 1023;
        *((LAS v4u*)(F.lds) + ch) = *((const GAS v4u*)(TAPS + ((size_t)(c0 + ci) * 2 + o) * 8192) + w); }
}
__device__ __forceinline__ void phase_hyena(Frame& F) {
    const bf16* UC = (const bf16*)(F.ws + WS_UC); bf16* HYT = (bf16*)(F.ws + WS_HYT);
    const int n = F.lane & 31, hh = F.lane >> 5, ci = F.wave >> 1, b = F.wave & 1;
    const LAS bf16* taps = (const LAS bf16*)(F.lds + ci * 16384);
    LAS unsigned char* zb = F.lds + HY_TAPS_BYTES + F.wave * HY_ZB_BYTES;
    for (int cg = F.bid; cg < 256; cg += F.G) {
        const int c0 = cg * 4, c = c0 + ci;
        __syncthreads();
        hy_stage_taps(F, c0, 0);
        { const bf16* zsrc = UC + (size_t)(2048 + c) * MT + b * SEQ;
#pragma unroll
          for (int j = 0; j < 8; ++j) { const int u = F.lane + 64 * j; const v4u w = *((const GAS v4u*)zsrc + u);
              v4u r; r.x = (w.w >> 16) | (w.w << 16); r.y = (w.z >> 16) | (w.z << 16); r.z = (w.y >> 16) | (w.y << 16); r.w = (w.x >> 16) | (w.x << 16);
              *(LAS v4u*)(zb + hy_zb_off(8 * (635 - u))) = r; }
          const v4u zero = {0u, 0u, 0u, 0u};
          for (int q = F.lane; q < 124; q += 64) { *(LAS v4u*)(zb + hy_zb_off(8 * q)) = zero; *(LAS v4u*)(zb + hy_zb_off(8 * (636 + q))) = zero; } }
        __syncthreads();
#pragma unroll 1
        for (int o = 0; o < 2; ++o) {
            f32x16 acc[4];
#pragma unroll
            for (int tau = 0; tau < 4; ++tau)
#pragma unroll
                for (int i = 0; i < 16; ++i) acc[tau][i] = 0.f;
            hy_segment<1>(acc, taps, zb, 0, 64, n, hh);
            hy_segment<3>(acc, taps, zb, 64, 128, n, hh);
            hy_segment<7>(acc, taps, zb, 128, 192, n, hh);
            hy_segment<15>(acc, taps, zb, 192, 318, n, hh);
            hy_segment<14>(acc, taps, zb, 318, 382, n, hh);
            hy_segment<12>(acc, taps, zb, 382, 446, n, hh);
            hy_segment<8>(acc, taps, zb, 446, 510, n, hh);
            const bf16* gate = UC + (size_t)(o * 1024 + c) * MT + b * SEQ;
            if (o == 0) {
                LDS_WAIT();
#pragma unroll
                for (int tau = 0; tau < 4; ++tau)
#pragma unroll
                    for (int rg = 0; rg < 4; ++rg) { const int t0 = 1024 * tau + 32 * n + 8 * rg + 4 * hh;
                        const v2u gw = *(const GAS v2u*)(gate + t0);
                        const float z0 = bflo(gw.x) * acc[tau][4 * rg + 0], z1 = bfhi(gw.x) * acc[tau][4 * rg + 1], z2 = bflo(gw.y) * acc[tau][4 * rg + 2], z3 = bfhi(gw.y) * acc[tau][4 * rg + 3];
                        v2u w; w.x = pk2(z3, z2); w.y = pk2(z1, z0);
                        *(LAS v2u*)(zb + hy_zb_off(8 * (635 - (t0 >> 3))) + (hh ? 0 : 8)) = w; }
                __syncthreads();
                hy_stage_taps(F, c0, 1);
                __syncthreads();
            } else {
                bf16* outp = HYT + (size_t)c * MT + b * SEQ;
#pragma unroll
                for (int tau = 0; tau < 4; ++tau)
#pragma unroll
                    for (int rg = 0; rg < 4; ++rg) { const int t0 = 1024 * tau + 32 * n + 8 * rg + 4 * hh;
                        const v2u gw = *(const GAS v2u*)(gate + t0);
                        v2u w; w.x = pk2(bflo(gw.x) * acc[tau][4 * rg + 0], bfhi(gw.x) * acc[tau][4 * rg + 1]); w.y = pk2(bflo(gw.y) * acc[tau][4 * rg + 2], bfhi(gw.y) * acc[tau][4 * rg + 3]);
                        *(GAS v2u*)(outp + t0) = w; }
            }
        }
    }
    __syncthreads();
}

__device__ __forceinline__ void phase_attn(Frame& F) {
    const bf16* QK = (const bf16*)(F.ws + WS_QK); const bf16* VT = (const bf16*)(F.ws + WS_XT); bf16* MIXED = (bf16*)(F.ws + WS_MIXED);
    const float* rpb = F.in[5]; const float* og = F.in[15];
    LAS float* rp = (LAS float*)(F.lds + F.wave * 2048);
    const int n = F.lane & 31, hh = F.lane >> 5;
    for (int task = GW_ID(F); task < NB * NH * NROWS * 2; task += GW_N(F)) {
        const int wq = task & 1, r = (task >> 1) & 63, h = (task >> 7) & 7, b = task >> 10;
        for (int i = F.lane; i < 15 * 31; i += 64) rp[i] = rpb[h * 465 + i];
        const int mq = b * SEQ + r * GW + 32 * wq + n, qc = 32 * wq + n;
        int c0 = qc - WC / 2; c0 = c0 < 0 ? 0 : (c0 > GW - WC ? GW - WC : c0);
        int kr0 = r - WR / 2; kr0 = kr0 < 0 ? 0 : (kr0 > NROWS - WR ? NROWS - WR : kr0);
        bf16x8 qf[8];
#pragma unroll
        for (int ks = 0; ks < 8; ++ks) qf[ks] = *(const GAS bf16x8*)(QK + (size_t)mq * 2048 + h * HD + 16 * ks + 8 * hh);
        f32x16 O[4];
#pragma unroll
        for (int dt = 0; dt < 4; ++dt)
#pragma unroll
            for (int i = 0; i < 16; ++i) O[dt][i] = 0.f;
        float lsum = 0.f;
        LDS_WAIT();
#pragma unroll 1
        for (int tile = 0; tile < 16; ++tile) {
            const int kr = kr0 + (tile >> 1), kt = tile & 1, dr = kr - r + WR - 1;
            const int mk0 = b * SEQ + kr * GW + 32 * kt;
            f32x16 S;
#pragma unroll
            for (int i = 0; i < 16; ++i) S[i] = 0.f;
#pragma unroll
            for (int ks = 0; ks < 8; ++ks) { const bf16x8 kf = *(const GAS bf16x8*)(QK + (size_t)(mk0 + n) * 2048 + 1024 + h * HD + 16 * ks + 8 * hh);
                S = __builtin_amdgcn_mfma_f32_32x32x16_bf16(kf, qf[ks], S, 0, 0, 0); }
            float p[16];
#pragma unroll
            for (int i = 0; i < 16; ++i) { const int kc = 32 * kt + (i & 3) + 8 * (i >> 2) + 4 * hh; const bool valid = (kc >= c0) && (kc < c0 + WC);
                int dc = kc - qc + WC - 1; dc = dc < 0 ? 0 : (dc > 2 * WC - 2 ? 2 * WC - 2 : dc);
                const float e = __expf(S[i] * 0.08838834764831845f + rp[dr * 31 + dc]); p[i] = valid ? e : 0.f; lsum += p[i]; }
            v4u pw0, pw1;
            pw0.x = pk2(p[0], p[1]); pw0.y = pk2(p[2], p[3]); pw0.z = pk2(p[4], p[5]); pw0.w = pk2(p[6], p[7]);
            pw1.x = pk2(p[8], p[9]); pw1.y = pk2(p[10], p[11]); pw1.z = pk2(p[12], p[13]); pw1.w = pk2(p[14], p[15]);
            const bf16x8 pf0 = __builtin_bit_cast(bf16x8, pw0), pf1 = __builtin_bit_cast(bf16x8, pw1);
#pragma unroll
            for (int dt = 0; dt < 4; ++dt) {
                const bf16* vrow = VT + (size_t)(h * HD + 32 * dt + n) * MT + mk0 + 4 * hh;
                const v2u a0 = *(const GAS v2u*)(vrow), a1 = *(const GAS v2u*)(vrow + 8), a2 = *(const GAS v2u*)(vrow + 16), a3 = *(const GAS v2u*)(vrow + 24);
                v4u f0, f1; f0.x = a0.x; f0.y = a0.y; f0.z = a1.x; f0.w = a1.y; f1.x = a2.x; f1.y = a2.y; f1.z = a3.x; f1.w = a3.y;
                O[dt] = __builtin_amdgcn_mfma_f32_32x32x16_bf16(__builtin_bit_cast(bf16x8, f0), pf0, O[dt], 0, 0, 0);
                O[dt] = __builtin_amdgcn_mfma_f32_32x32x16_bf16(__builtin_bit_cast(bf16x8, f1), pf1, O[dt], 0, 0, 0);
            }
        }
        lsum += __shfl_xor(lsum, 32);
        const float il = 1.f / lsum;
        float ss = 0.f;
#pragma unroll
        for (int dt = 0; dt < 4; ++dt)
#pragma unroll
            for (int i = 0; i < 16; ++i) { O[dt][i] *= il; ss += O[dt][i] * O[dt][i]; }
        ss += __shfl_xor(ss, 32);
        const float rr = rsqrtf(ss * (1.f / HD) + EPS);
        bf16* orow = MIXED + (size_t)mq * DM + h * HD;
#pragma unroll
        for (int dt = 0; dt < 4; ++dt)
#pragma unroll
            for (int rg = 0; rg < 4; ++rg) { const int d = 32 * dt + 8 * rg + 4 * hh; const f32x4 gg = *(const GAS f32x4*)(og + h * HD + d);
                v2u w; w.x = pk2(O[dt][4 * rg + 0] * rr * gg.x, O[dt][4 * rg + 1] * rr * gg.y); w.y = pk2(O[dt][4 * rg + 2] * rr * gg.z, O[dt][4 * rg + 3] * rr * gg.w);
                *(GAS v2u*)(orow + d) = w; }
        LDS_WAIT();
    }
}

__device__ __forceinline__ void phase_p15(Frame& F) {
    bf16* QK = (bf16*)(F.ws + WS_QK); const float* qg = F.in[3]; const float* kg = F.in[4];
    for (int m = GW_ID(F); m < MT; m += GW_N(F)) {
        GAS v4u* rowp = (GAS v4u*)(QK + (size_t)m * 2048) + F.lane;
#pragma unroll
        for (int j = 0; j < 4; ++j) {
            v4u w = rowp[64 * j];
            float f[8] = {bflo(w.x), bfhi(w.x), bflo(w.y), bfhi(w.y), bflo(w.z), bfhi(w.z), bflo(w.w), bfhi(w.w)};
            float ss = 0.f;
#pragma unroll
            for (int e = 0; e < 8; ++e) ss += f[e] * f[e];
            ss += __shfl_xor(ss, 1); ss += __shfl_xor(ss, 2); ss += __shfl_xor(ss, 4); ss += __shfl_xor(ss, 8);
            const float r = rsqrtf(ss * (1.f / HD) + EPS);
            const int col = 512 * j + 8 * F.lane, d = col & 127; const float* g = (col < 1024 ? qg : kg) + d;
#pragma unroll
            for (int e = 0; e < 8; ++e) f[e] = f[e] * r * g[e];
            w.x = pk2(f[0], f[1]); w.y = pk2(f[2], f[3]); w.z = pk2(f[4], f[5]); w.w = pk2(f[6], f[7]);
            rowp[64 * j] = w;
        }
    }
    const bf16* XT = (const bf16*)(F.ws + WS_XT) + (size_t)1024 * MT; bf16* UC = (bf16*)(F.ws + WS_UC);
    const float* cw = F.in[6]; const float* cb = F.in[7];
    const size_t nchunks = (size_t)3072 * MT / 8;
    for (size_t i = (size_t)F.bid * NTHREADS + F.tid; i < nchunks; i += (size_t)F.G * NTHREADS) {
        const int ch = (int)(i >> 10), m0 = (int)(i & 1023) * 8, s0 = m0 & 4095;
        const bf16* up = XT + (size_t)ch * MT + m0;
        const v4u w = *(const GAS v4u*)up;
        float f[10];
        f[1] = bflo(w.x); f[2] = bfhi(w.x); f[3] = bflo(w.y); f[4] = bfhi(w.y); f[5] = bflo(w.z); f[6] = bfhi(w.z); f[7] = bflo(w.w); f[8] = bfhi(w.w);
        f[0] = s0 > 0 ? bf2f(up[-1]) : 0.f; f[9] = s0 + 8 < SEQ ? bf2f(up[8]) : 0.f;
        const float w0 = cw[ch], w1 = cw[3072 + ch], w2 = cw[6144 + ch], bb = cb[ch];
        float o[8];
#pragma unroll
        for (int e = 0; e < 8; ++e) o[e] = bb + w0 * f[e] + w1 * f[e + 1] + w2 * f[e + 2];
        v4u ov; ov.x = pk2(o[0], o[1]); ov.y = pk2(o[2], o[3]); ov.z = pk2(o[4], o[5]); ov.w = pk2(o[6], o[7]);
        *(GAS v4u*)(UC + (size_t)ch * MT + m0) = ov;
    }
}
__device__ __forceinline__ void phase_p25(Frame& F) {
    const bf16* HYT = (const bf16*)(F.ws + WS_HYT); bf16* MIXED = (bf16*)(F.ws + WS_MIXED); const float* hg = F.in[16];
    LAS float* tile = (LAS float*)F.lds;
    LAS float* rs = (LAS float*)(F.lds + 128 * 65 * 4);
    for (int it = F.bid; it < 8 * (MT / 64); it += F.G) {
        const int gi = it & 7, m0 = (it >> 3) * 64;
        { const int ch = F.tid >> 2, t0 = (F.tid & 3) * 16; const bf16* p = HYT + (size_t)(gi * 128 + ch) * MT + m0 + t0;
          const v4u a = *(const GAS v4u*)p, b = *(const GAS v4u*)(p + 8);
          LAS float* d = tile + ch * 65 + t0;
          d[0] = bflo(a.x); d[1] = bfhi(a.x); d[2] = bflo(a.y); d[3] = bfhi(a.y); d[4] = bflo(a.z); d[5] = bfhi(a.z); d[6] = bflo(a.w); d[7] = bfhi(a.w);
          d[8] = bflo(b.x); d[9] = bfhi(b.x); d[10] = bflo(b.y); d[11] = bfhi(b.y); d[12] = bflo(b.z); d[13] = bfhi(b.z); d[14] = bflo(b.w); d[15] = bfhi(b.w); }
        __syncthreads();
        {
          const int t = F.tid >> 3, c0 = (F.tid & 7) * 16; float ss = 0.f;
#pragma unroll
          for (int c = 0; c < 16; ++c) { const float v = tile[(c0 + c) * 65 + t]; ss += v * v; }
          ss += __shfl_xor(ss, 1); ss += __shfl_xor(ss, 2); ss += __shfl_xor(ss, 4);
          if ((F.tid & 7) == 0) rs[t] = rsqrtf(ss * (1.f / 128) + EPS); }
        __syncthreads();
        {
          const int t = F.tid >> 3, c0 = (F.tid & 7) * 16; const float r = rs[t]; float o[16];
#pragma unroll
          for (int c = 0; c < 16; ++c) o[c] = tile[(c0 + c) * 65 + t] * r * hg[gi * 128 + c0 + c];
          v4u a, b; a.x = pk2(o[0], o[1]); a.y = pk2(o[2], o[3]); a.z = pk2(o[4], o[5]); a.w = pk2(o[6], o[7]); b.x = pk2(o[8], o[9]); b.y = pk2(o[10], o[11]); b.z = pk2(o[12], o[13]); b.w = pk2(o[14], o[15]);
          bf16* q = MIXED + (size_t)(m0 + t) * DM + AW + gi * 128 + c0; *(GAS v4u*)q = a; *(GAS v4u*)(q + 8) = b; }
        __syncthreads();
    }
}
__device__ __forceinline__ void phase_p35(Frame& F) {
    LAS float* wrT = (LAS float*)F.lds;
    const float* wr = F.in[19]; const float* g = F.in[18];
    for (int i = F.tid; i < DM * NE; i += NTHREADS) { const int d = i >> 4, e = i & 15; wrT[e * DM + d] = wr[i]; }
    __syncthreads();
    bf16* HB = (bf16*)(F.ws + WS_HB); float* AFF = (float*)(F.ws + WS_AFF); const float* x1 = F.out;
    for (int m = GW_ID(F); m < MT; m += GW_N(F)) {
        const GAS f32x4* xr = (const GAS f32x4*)(x1 + (size_t)m * DM) + F.lane;
        f32x4 v[8]; float s = 0.f;
#pragma unroll
        for (int j = 0; j < 8; ++j) { v[j] = xr[64 * j]; s += (v[j].x * v[j].x + v[j].y * v[j].y) + (v[j].z * v[j].z + v[j].w * v[j].w); }
        const float r = rsqrtf(wave_sum(s) * (1.f / DM) + EPS);
        GAS v2u* o8 = (GAS v2u*)(HB + (size_t)m * DM) + F.lane;
#pragma unroll
        for (int j = 0; j < 8; ++j) { const f32x4 gg = *((const GAS f32x4*)g + F.lane + 64 * j); v[j].x *= r * gg.x; v[j].y *= r * gg.y; v[j].z *= r * gg.z; v[j].w *= r * gg.w;
            v2u o; o.x = pk2(v[j].x, v[j].y); o.y = pk2(v[j].z, v[j].w); o8[64 * j] = o; }
        float mine = 0.f;
#pragma unroll 1
        for (int e = 0; e < NE; ++e) { float a = 0.f;
#pragma unroll
            for (int j = 0; j < 8; ++j) { const f32x4 w = *((const LAS f32x4*)(wrT + e * DM) + F.lane + 64 * j); a += (v[j].x * w.x + v[j].y * w.y) + (v[j].z * w.z + v[j].w * w.w); }
            a = wave_sum(a); mine = (F.lane == e) ? a : mine; }
        float mx = mine;
        mx = fmaxf(mx, __shfl_xor(mx, 1)); mx = fmaxf(mx, __shfl_xor(mx, 2)); mx = fmaxf(mx, __shfl_xor(mx, 4)); mx = fmaxf(mx, __shfl_xor(mx, 8));
        const float ex = expf(mine - mx); float den = ex;
        den += __shfl_xor(den, 1); den += __shfl_xor(den, 2); den += __shfl_xor(den, 4); den += __shfl_xor(den, 8);
        const int b = m / SEQ, sidx = m % SEQ;
        if (F.lane < NE) AFF[((size_t)b * NE + F.lane) * SEQ + sidx] = ex / den;
    }
    __syncthreads();
}
__device__ __forceinline__ void phase_p4(Frame& F) {
    LAS float* a = (LAS float*)F.lds;
    LAS int* rk = (LAS int*)(F.lds + 16384);
    const float* AFF = (const float*)(F.ws + WS_AFF); int* IDX = (int*)(F.ws + WS_IDX); float* GATE = (float*)(F.ws + WS_GATE); int* SEL = (int*)(F.ws + WS_SEL);
    const bf16* HB = (const bf16*)(F.ws + WS_HB); bf16* XG = (bf16*)(F.ws + WS_XG);
    for (int it = F.bid; it < NB * NE * 8; it += F.G) {
        const int be = it >> 3, ch = it & 7, b = be / NE, e = be % NE;
        const float* ap = AFF + (size_t)be * SEQ;
        for (int i = F.tid; i < SEQ / 4; i += NTHREADS) *((LAS f32x4*)a + i) = *((const GAS f32x4*)ap + i);
        __syncthreads();
        const int s = ch * 512 + F.tid; const float v = a[s]; int rank = 0;
        for (int i = 0; i < SEQ; i += 4) { const f32x4 u = *(const LAS f32x4*)(a + i);
            rank += (u.x > v || (u.x == v && i < s)) ? 1 : 0; rank += (u.y > v || (u.y == v && i + 1 < s)) ? 1 : 0;
            rank += (u.z > v || (u.z == v && i + 2 < s)) ? 1 : 0; rank += (u.w > v || (u.w == v && i + 3 < s)) ? 1 : 0; }
        rk[F.tid] = rank;
        const int m = b * SEQ + s;
        if (rank < CAP) { IDX[be * CAP + rank] = m; GATE[be * CAP + rank] = v; }
        SEL[(size_t)m * NE + e] = rank < CAP ? rank : -1;
        __syncthreads();
        for (int t = F.wave; t < 512; t += NWAVES) { const int r = rk[t]; if (r < CAP) {
            const GAS v4u* src = (const GAS v4u*)(HB + (size_t)(b * SEQ + ch * 512 + t) * DM) + F.lane; GAS v4u* dst = (GAS v4u*)(XG + (size_t)(be * CAP + r) * DM) + F.lane;
#pragma unroll
            for (int j = 0; j < 4; ++j) dst[64 * j] = src[64 * j]; } }
        __syncthreads();
    }
}
__device__ __forceinline__ void phase_p7(Frame& F) {
    const int* SEL = (const int*)(F.ws + WS_SEL); const float* GATE = (const float*)(F.ws + WS_GATE); const bf16* YE = (const bf16*)(F.ws + WS_YE);
    for (int m = GW_ID(F); m < MT; m += GW_N(F)) {
        const int b = m / SEQ;
        GAS f32x4* orow = (GAS f32x4*)(F.out + (size_t)m * DM);
        f32x4 acc[8];
#pragma unroll
        for (int j = 0; j < 8; ++j) acc[j] = orow[2 * F.lane + (j & 1) + 128 * (j >> 1)];
        for (int e = 0; e < NE; ++e) { const int slot = SEL[(size_t)m * NE + e]; if (slot >= 0) {
            const GAS v4u* yr = (const GAS v4u*)(YE + (size_t)((b * NE + e) * CAP + slot) * DM) + F.lane;
#pragma unroll
            for (int jj = 0; jj < 4; ++jj) { const v4u w = yr[64 * jj];
                acc[2 * jj].x += bflo(w.x); acc[2 * jj].y += bfhi(w.x); acc[2 * jj].z += bflo(w.y); acc[2 * jj].w += bfhi(w.y);
                acc[2 * jj + 1].x += bflo(w.z); acc[2 * jj + 1].y += bfhi(w.z); acc[2 * jj + 1].z += bflo(w.w); acc[2 * jj + 1].w += bfhi(w.w); } } }
#pragma unroll
        for (int j = 0; j < 8; ++j) orow[2 * F.lane + (j & 1) + 128 * (j >> 1)] = acc[j];
    }
    (void)GATE;
}

struct Args { const float* in[23]; float* out; unsigned char* ws; int ph_lo, ph_hi; };
enum Phase { PH_P0 = 0, PH_G1, PH_FILT, PH_P15, PH_ATTN, PH_P25, PH_OUT, PH_P35, PH_P4, PH_UP, PH_DOWN, PH_P7, PH_COUNT };

__global__ void __launch_bounds__(NTHREADS, 2) mk_fwd(Args args) {
    extern __shared__ __attribute__((aligned(16))) unsigned char lds_raw[];
    Frame F;
    F.lds = (LAS unsigned char*)lds_raw;
    F.tid = threadIdx.x; F.lane = F.tid & 63; F.wave = __builtin_amdgcn_readfirstlane(F.tid >> 6); F.G = gridDim.x; F.bid = blockIdx.x;
#pragma unroll
    for (int i = 0; i < 23; ++i) F.in[i] = args.in[i];
    F.out = args.out; F.ws = args.ws;
    const int lo = args.ph_lo, hi = args.ph_hi;
#define IN(k) (lo <= (k) && (k) < hi)
#if MK_N_LAUNCHES == 1
    cg::grid_group grid = cg::this_grid();
#define SEAM(k) do { if (IN(k) && IN((k) + 1)) grid.sync(); } while (0)
#else
#define SEAM(k) do { } while (0)
#endif
    if (IN(PH_P0)) { phase_p0(F); } SEAM(PH_P0);
    if (IN(PH_G1)) {
        __syncthreads();
        { pg8::DenseOrder S; S.init(F.ws + WS_HB, F.ws + WS_WIN, MT, 2048, DM, 0, F.G, F.bid);
          pg8::EpiBf16 E{(pg8::bf16_t*)(F.ws + WS_QK), 2048, 0, nullptr};
          pg8::gemm_phase<pg8::EpiBf16, pg8::DenseOrder, true>(F.lds, DM, S, E); }
        { pg8::DenseOrder S; S.init(F.ws + WS_HB, F.ws + WS_WIN, MT, 4096, DM, 8, F.G, F.bid);
          pg8::EpiTransBf16 E{(pg8::bf16_t*)(F.ws + WS_XT), MT, 8};
          pg8::gemm_phase<pg8::EpiTransBf16, pg8::DenseOrder, true>(F.lds, DM, S, E); }
    } SEAM(PH_G1);
    if (IN(PH_FILT)) { phase_filters(F); } SEAM(PH_FILT);
    if (IN(PH_P15)) { phase_p15(F); } SEAM(PH_P15);
    if (IN(PH_ATTN)) { __syncthreads(); phase_hyena(F); phase_attn(F); } SEAM(PH_ATTN);
    if (IN(PH_P25)) { __syncthreads(); phase_p25(F); } SEAM(PH_P25);
    if (IN(PH_OUT)) {
        __syncthreads();
        pg8::DenseOrder S; S.init(F.ws + WS_MIXED, F.ws + WS_WOUT, MT, DM, DM, 0, F.G, F.bid);
        pg8::EpiResF32 E{F.in[0], F.out, DM};
        pg8::gemm_phase<pg8::EpiResF32, pg8::DenseOrder, false>(F.lds, DM, S, E);
    } SEAM(PH_OUT);
    if (IN(PH_P35)) { __syncthreads(); phase_p35(F); } SEAM(PH_P35);
    if (IN(PH_P4)) { __syncthreads(); phase_p4(F); } SEAM(PH_P4);
    if (IN(PH_UP)) {
        __syncthreads();
        pg8::MoeOrder S; S.init(F.ws + WS_XG, F.ws + WS_WGU, DM, F.G, F.bid);
        pg8::EpiSwiGLU E{(pg8::bf16_t*)(F.ws + WS_ACT)};
        pg8::gemm_phase<pg8::EpiSwiGLU, pg8::MoeOrder, true>(F.lds, DM, S, E);
    } SEAM(PH_UP);
    if (IN(PH_DOWN)) {
        __syncthreads();
        pg8::MoeOrder S; S.init(F.ws + WS_ACT, F.ws + WS_WD, FF, F.G, F.bid);
        pg8::EpiBf16 E{(pg8::bf16_t*)(F.ws + WS_YE), DM, 512, (const float*)(F.ws + WS_GATE)};
        pg8::gemm_phase<pg8::EpiBf16, pg8::MoeOrder, true>(F.lds, FF, S, E);
    } SEAM(PH_DOWN);
    if (IN(PH_P7)) { phase_p7(F); }
#undef IN
#undef SEAM
}

extern "C" void kernel_launch(void* const* d_in, const int* in_sizes, int n_in, void* d_out, int out_size, void* d_ws, size_t ws_size, hipStream_t stream) {
    static int grid = 0;
    if (grid == 0) {
        if (n_in != 23 || ws_size < WS_END) { fprintf(stderr, "kernel_launch: unexpected inputs (n_in %d, ws %zu)\n", n_in, ws_size); grid = -1; return; }
        if (hipFuncSetAttribute((const void*)mk_fwd, hipFuncAttributeMaxDynamicSharedMemorySize, LDS_BYTES) != hipSuccess) { fprintf(stderr, "kernel_launch: hipFuncSetAttribute failed\n"); grid = -1; return; }
        int dev = 0, cus = 0, per_cu = 0;
        hipGetDevice(&dev); hipDeviceGetAttribute(&cus, hipDeviceAttributeMultiprocessorCount, dev);
        hipOccupancyMaxActiveBlocksPerMultiprocessor(&per_cu, (const void*)mk_fwd, NTHREADS, LDS_BYTES);
        (void)hipGetLastError();
        if (per_cu < 1) { fprintf(stderr, "kernel_launch: occupancy query says %d blocks/CU\n", per_cu); }
        grid = cus;
    }
    if (grid < 0) return;
    Args a{};
    for (int i = 0; i < 23; ++i) a.in[i] = (const float*)d_in[i];
    a.out = (float*)d_out; a.ws = (unsigned char*)d_ws;
#if MK_N_LAUNCHES == 1
    a.ph_lo = 0; a.ph_hi = PH_COUNT;
    void* kargs[] = {&a};
    hipError_t e = hipLaunchCooperativeKernel((const void*)mk_fwd, dim3(grid), dim3(NTHREADS), kargs, LDS_BYTES, stream);
    if (e != hipSuccess) fprintf(stderr, "cooperative launch failed: %s (grid %d)\n", hipGetErrorString(e), grid);
#else
    for (int p = 0; p < PH_COUNT; ++p) { a.ph_lo = p; a.ph_hi = p + 1; hipLaunchKernelGGL(mk_fwd, dim3(grid), dim3(NTHREADS), LDS_BYTES, stream, a); }
#endif
}
```

```cpp
#include <hip/hip_runtime.h>
#include <hip/hip_cooperative_groups.h>
#include <cstdio>
#include <cstdint>
namespace cg = cooperative_groups;

#ifndef MK_N_LAUNCHES
#define MK_N_LAUNCHES 1
#endif

namespace pg8 {
#define PG8_LAS __attribute__((address_space(3)))
typedef unsigned short bf16_t;
typedef short bf16x8 __attribute__((ext_vector_type(8)));
typedef float f32x4 __attribute__((ext_vector_type(4)));
typedef unsigned u32x4 __attribute__((ext_vector_type(4)));
typedef unsigned u32x2 __attribute__((ext_vector_type(2)));
constexpr int BM = 256, BK = 64, HALF = 128, HTB = HALF * BK * 2, STAGE_BYTES = 8 * HTB, NXCD = 8, WGM = 8;

__host__ __device__ __forceinline__ int lds_byte(int r, int c) { const int st = (r >> 4) * 2 + (c >> 5), rr = r & 15, cc = c & 31, ob = rr * 64 + cc * 2; return st * 1024 + (ob ^ (((ob >> 9) & 1) << 5)); }
__host__ __device__ __forceinline__ void stage_rc(int b, int& R, int& C) { const int st = b / 1024, sb = b % 1024, swz = sb ^ (((sb >> 9) & 1) << 5); R = (st >> 1) * 16 + swz / 64; C = (st & 1) * 32 + (swz % 64) / 2; }
__host__ __device__ __forceinline__ int perm32(int rho) { const int n = rho >> 4, i = rho & 15; return 8 * (i >> 2) + 4 * n + (i & 3); }

struct Unit { int pm, pn, g; const char* a; const char* b; };

__device__ __forceinline__ unsigned cvt_pk_bf16(float lo, float hi) { unsigned r; asm volatile("v_cvt_pk_bf16_f32 %0, %1, %2" : "=v"(r) : "v"(lo), "v"(hi)); return r; }

struct DenseOrder {
    int nM, nN, nwg, G, c, K, pn0; const char* A; const char* Bt;
    __device__ void init(const void* A_, const void* Bt_, int M, int N, int K_, int pn0_, int G_, int c_) { A = (const char*)A_; Bt = (const char*)Bt_; nM = M / BM; nN = N / BM; nwg = nM * nN; G = G_; c = c_; K = K_; pn0 = pn0_; }
    __device__ bool next(int i, Unit& u) const {
        const long L = (long)i * G + c; if (L >= nwg) return false;
        int wgid = (int)L; { const int q = nwg / NXCD, r = nwg % NXCD, xcd = wgid % NXCD, off = wgid / NXCD; wgid = (xcd < r ? xcd * (q + 1) : r * (q + 1) + (xcd - r) * q) + off; }
        const int nig = WGM * nN, gid = wgid / nig, fm = gid * WGM, gsz = (nM - fm) < WGM ? (nM - fm) : WGM;
        u.pm = fm + ((wgid % nig) % gsz); u.pn = pn0 + (wgid % nig) / gsz; u.g = 0;
        u.a = A + (size_t)u.pm * BM * K * 2; u.b = Bt + (size_t)u.pn * BM * K * 2; return true;
    }
};
struct MoeOrder {
    int G, c, K; const char* A; const char* Bt;
    __device__ void init(const void* A_, const void* Bt_, int K_, int G_, int c_) { A = (const char*)A_; Bt = (const char*)Bt_; K = K_; G = G_; c = c_; }
    __device__ bool next(int i, Unit& u) const {
        const int L = i * G + c; if (L >= 512) return false;
        const int pn = L & 7, pm = (L >> 3) & 1, b = (L >> 4) & 1, e = L >> 5;
        u.pm = pm; u.pn = pn; u.g = b * 16 + e;
        u.a = A + (size_t)(u.g * 512 + pm * BM) * K * 2; u.b = Bt + (size_t)(e * 2048 + pn * BM) * K * 2; return true;
    }
};

struct EpiBf16 {
    static constexpr bool PERM = true, SWAP = false;
    bf16_t* O; int ldc; int grows; const float* rscale;
    __device__ __forceinline__ void operator()(const f32x4 (&acc)[2][2][4][2], const Unit& u, int wr, int wc, int fr, int fq) const {
        const int row0 = u.g * grows + u.pm * BM + wr * 64 + fr, col0 = u.pn * BM + wc * 32 + 8 * fq;
#pragma unroll
        for (int ai = 0; ai < 2; ++ai)
#pragma unroll
            for (int m = 0; m < 4; ++m) { const int row = row0 + ai * HALF + m * 16; bf16_t* rowp = O + (size_t)row * ldc + col0; const float sc = rscale ? rscale[row] : 1.f;
#pragma unroll
                for (int bj = 0; bj < 2; ++bj) { const f32x4 v0 = acc[ai][bj][m][0] * sc, v1 = acc[ai][bj][m][1] * sc;
                    u32x4 w; w.x = cvt_pk_bf16(v0[0], v0[1]); w.y = cvt_pk_bf16(v0[2], v0[3]); w.z = cvt_pk_bf16(v1[0], v1[1]); w.w = cvt_pk_bf16(v1[2], v1[3]);
                    *(u32x4*)(rowp + bj * HALF) = w; } }
    }
};
struct EpiSwiGLU {
    static constexpr bool PERM = true, SWAP = false;
    bf16_t* O;
    __device__ __forceinline__ void operator()(const f32x4 (&acc)[2][2][4][2], const Unit& u, int wr, int wc, int fr, int fq) const {
        const int row0 = u.g * 512 + u.pm * BM + wr * 64 + fr, col0 = u.pn * HALF + wc * 32 + 8 * fq;
#pragma unroll
        for (int ai = 0; ai < 2; ++ai)
#pragma unroll
            for (int m = 0; m < 4; ++m) { bf16_t* rowp = O + (size_t)(row0 + ai * HALF + m * 16) * 1024 + col0;
                float r[8];
#pragma unroll
                for (int n = 0; n < 2; ++n)
#pragma unroll
                    for (int e = 0; e < 4; ++e) { const float g = acc[ai][0][m][n][e], up = acc[ai][1][m][n][e]; r[n * 4 + e] = g / (1.f + __expf(-g)) * up; }
                u32x4 w; w.x = cvt_pk_bf16(r[0], r[1]); w.y = cvt_pk_bf16(r[2], r[3]); w.z = cvt_pk_bf16(r[4], r[5]); w.w = cvt_pk_bf16(r[6], r[7]);
                *(u32x4*)rowp = w; }
    }
};
struct EpiResF32 {
    static constexpr bool PERM = false, SWAP = false;
    const float* res; float* out; int ldc;
    __device__ __forceinline__ void operator()(const f32x4 (&acc)[2][2][4][2], const Unit& u, int wr, int wc, int fr, int fq) const {
        const int row0 = u.pm * BM + wr * 64 + fr, col0 = u.pn * BM + wc * 32 + 4 * fq;
#pragma unroll
        for (int ai = 0; ai < 2; ++ai)
#pragma unroll
            for (int m = 0; m < 4; ++m) { const size_t off = (size_t)(row0 + ai * HALF + m * 16) * ldc + col0;
#pragma unroll
                for (int bj = 0; bj < 2; ++bj)
#pragma unroll
                    for (int n = 0; n < 2; ++n) { const f32x4 r = *(const f32x4*)(res + off + bj * HALF + n * 16); *(f32x4*)(out + off + bj * HALF + n * 16) = r + acc[ai][bj][m][n]; } }
    }
};
struct EpiTransBf16 {
    static constexpr bool PERM = false, SWAP = true;
    bf16_t* O; int ldt; int pn_base;
    __device__ __forceinline__ void operator()(const f32x4 (&acc)[2][2][4][2], const Unit& u, int wr, int wc, int fr, int fq) const {
        const int ch0 = (u.pn - pn_base) * BM + wc * 32 + fr, t0 = u.pm * BM + wr * 64 + 4 * fq;
#pragma unroll
        for (int bj = 0; bj < 2; ++bj)
#pragma unroll
            for (int n = 0; n < 2; ++n) { bf16_t* chp = O + (size_t)(ch0 + bj * HALF + n * 16) * ldt + t0;
#pragma unroll
                for (int ai = 0; ai < 2; ++ai)
#pragma unroll
                    for (int m = 0; m < 4; ++m) { const f32x4 v = acc[ai][bj][m][n]; u32x2 w; w.x = cvt_pk_bf16(v[0], v[1]); w.y = cvt_pk_bf16(v[2], v[3]); *(u32x2*)(chp + ai * HALF + m * 16) = w; } }
    }
};

template <class Epi, class Sched, bool ALIGN_EPI = false>
__device__ __forceinline__ void gemm_phase(PG8_LAS unsigned char* lds, const int K, const Sched& S, const Epi& E) {
    const int tid = threadIdx.x, wid = __builtin_amdgcn_readfirstlane(tid >> 6), lane = tid & 63, wr = wid >> 2, wc = wid & 3, fr = lane & 15, fq = lane >> 4;
    const int nt = K / BK;
    unsigned voffA[2], voffB[2];
#pragma unroll
    for (int i = 0; i < 2; ++i) { int R, C; stage_rc(tid * 16 + i * 8192, R, C); const int Rb = Epi::PERM ? ((R & ~31) + perm32(R & 31)) : R;
        voffA[i] = (unsigned)(R * K + C) * 2u; voffB[i] = (unsigned)(Rb * K + C) * 2u; }
    const size_t kstep = (size_t)(BK * 2);
    const size_t hstep = (size_t)HALF * K * 2;
    const unsigned ldsw = (unsigned)wid * 1024u;
    const int aoff = lds_byte(wr * 64 + fr, fq * 8), boff = lds_byte(wc * 32 + fr, fq * 8);
#define PG8_SA(b, h) (((b) * 2 + (h)) * HTB)
#define PG8_SB(b, h) ((4 + (b) * 2 + (h)) * HTB)
#define PG8_STAGE(bufoff, gbase, voff) do { _Pragma("unroll") for (int _i = 0; _i < 2; ++_i) \
        __builtin_amdgcn_global_load_lds((const unsigned*)((const char*)(gbase) + (voff)[_i]), (PG8_LAS unsigned*)(lds + (bufoff) + ldsw + _i * 8192), 16, 0, 0); } while (0)
#define PG8_LDA(dst, b, h) do { _Pragma("unroll") for (int m = 0; m < 4; ++m) _Pragma("unroll") for (int k = 0; k < 2; ++k) dst[m][k] = *(const PG8_LAS bf16x8*)(lds + PG8_SA(b, h) + aoff + m * 2048 + k * 1024); } while (0)
#define PG8_LDB(dst, b, h) do { _Pragma("unroll") for (int n = 0; n < 2; ++n) _Pragma("unroll") for (int k = 0; k < 2; ++k) dst[n][k] = *(const PG8_LAS bf16x8*)(lds + PG8_SB(b, h) + boff + n * 2048 + k * 1024); } while (0)
#define PG8_MMA(ai, bj, At, Bt) do { __builtin_amdgcn_s_setprio(1); _Pragma("unroll") for (int m = 0; m < 4; ++m) _Pragma("unroll") for (int n = 0; n < 2; ++n) _Pragma("unroll") for (int k = 0; k < 2; ++k) \
        acc[ai][bj][m][n] = Epi::SWAP ? __builtin_amdgcn_mfma_f32_16x16x32_bf16(At[m][k], Bt[n][k], acc[ai][bj][m][n], 0, 0, 0) : __builtin_amdgcn_mfma_f32_16x16x32_bf16(Bt[n][k], At[m][k], acc[ai][bj][m][n], 0, 0, 0); __builtin_amdgcn_s_setprio(0); } while (0)
#define PG8_WAIT_V(n) asm volatile("s_waitcnt vmcnt(" #n ")" ::: "memory")
#define PG8_WAIT_L(n) asm volatile("s_waitcnt lgkmcnt(" #n ")" ::: "memory")
#define PG8_BAR __builtin_amdgcn_s_barrier()
#define PG8_SCHED __builtin_amdgcn_sched_barrier(0)
    Unit cur, nxt; int ui = 0;
    if (!S.next(0, cur)) return;
    f32x4 acc[2][2][4][2];
#pragma unroll
    for (int a = 0; a < 2; ++a)
#pragma unroll
        for (int b = 0; b < 2; ++b)
#pragma unroll
            for (int m = 0; m < 4; ++m)
#pragma unroll
                for (int n = 0; n < 2; ++n) acc[a][b][m][n] = (f32x4){0.f, 0.f, 0.f, 0.f};
    bf16x8 At[4][2], B0[2][2], B1[2][2];
    const char* cA = cur.a; const char* cB = cur.b;
    PG8_STAGE(PG8_SB(0, 0), cB, voffB); PG8_STAGE(PG8_SB(0, 1), cB + hstep, voffB); PG8_STAGE(PG8_SA(0, 0), cA, voffA); PG8_STAGE(PG8_SA(0, 1), cA + hstep, voffA);
    if (wr == 1) PG8_BAR;
    PG8_WAIT_V(2); PG8_BAR;
    PG8_STAGE(PG8_SB(1, 0), cB + kstep, voffB); PG8_STAGE(PG8_SA(1, 0), cA + kstep, voffA); PG8_STAGE(PG8_SB(1, 1), cB + hstep + kstep, voffB);
    PG8_WAIT_V(6); PG8_BAR;
    for (;;) {
        const bool has_next = S.next(ui + 1, nxt);
        const char* nA = has_next ? nxt.a : cA; const char* nB = has_next ? nxt.b : cB;
        for (int t = 0; t < nt; t += 2) {
            const bool last = (t == nt - 2);
            const char* a1 = cA + (size_t)(t + 1) * kstep;
            const char* a2 = last ? nA : cA + (size_t)(t + 2) * kstep; const char* b2 = last ? nB : cB + (size_t)(t + 2) * kstep;
            const char* a3 = a2 + kstep; const char* b3 = b2 + kstep;
            PG8_LDB(B0, 0, 0); PG8_LDB(B1, 0, 1); PG8_SCHED; PG8_LDA(At, 0, 0); PG8_STAGE(PG8_SA(1, 1), a1 + hstep, voffA);
            PG8_WAIT_V(8); PG8_WAIT_L(0); PG8_BAR; PG8_MMA(0, 0, At, B0); PG8_MMA(0, 1, At, B1); PG8_BAR; PG8_SCHED;
            PG8_LDA(At, 0, 1); PG8_STAGE(PG8_SB(0, 0), b2, voffB); PG8_STAGE(PG8_SB(0, 1), b2 + hstep, voffB); PG8_STAGE(PG8_SA(0, 0), a2, voffA);
            PG8_WAIT_V(8); PG8_WAIT_L(0); PG8_BAR; PG8_MMA(1, 0, At, B0); PG8_MMA(1, 1, At, B1); PG8_BAR; PG8_SCHED;
            PG8_LDB(B0, 1, 0); PG8_LDB(B1, 1, 1); PG8_SCHED; PG8_LDA(At, 1, 0); PG8_STAGE(PG8_SA(0, 1), a2 + hstep, voffA);
            PG8_WAIT_V(8); PG8_WAIT_L(0); PG8_BAR; PG8_MMA(0, 0, At, B0); PG8_MMA(0, 1, At, B1); PG8_BAR; PG8_SCHED;
            PG8_LDA(At, 1, 1); PG8_STAGE(PG8_SB(1, 0), b3, voffB); PG8_STAGE(PG8_SB(1, 1), b3 + hstep, voffB); PG8_STAGE(PG8_SA(1, 0), a3, voffA);
            PG8_WAIT_V(8); PG8_WAIT_L(0); PG8_BAR; PG8_MMA(1, 0, At, B0); PG8_MMA(1, 1, At, B1); PG8_BAR; PG8_SCHED;
        }
        if constexpr (ALIGN_EPI) { if (wr == 0) PG8_BAR; }
        E(acc, cur, wr, wc, fr, fq);
        if (!has_next) break;
#pragma unroll
        for (int a = 0; a < 2; ++a)
#pragma unroll
            for (int b = 0; b < 2; ++b)
#pragma unroll
                for (int m = 0; m < 4; ++m)
#pragma unroll
                    for (int n = 0; n < 2; ++n) acc[a][b][m][n] = (f32x4){0.f, 0.f, 0.f, 0.f};
        cur = nxt; cA = nA; cB = nB; ++ui;
        if constexpr (ALIGN_EPI) { if (wr == 1) PG8_BAR; }
    }
    PG8_WAIT_V(0);
    if constexpr (!ALIGN_EPI) { if (wr == 0) PG8_BAR; }
    PG8_BAR;
#undef PG8_SA
#undef PG8_SB
#undef PG8_STAGE
#undef PG8_LDA
#undef PG8_LDB
#undef PG8_MMA
#undef PG8_WAIT_V
#undef PG8_WAIT_L
#undef PG8_BAR
#undef PG8_SCHED
}
}

constexpr int NB = 2, SEQ = 4096, DM = 2048, MT = NB * SEQ;
constexpr int NH = 8, HD = 128, AW = 1024, HW = 1024, INW = 6144;
constexpr int GW = 64, NROWS = 64, WR = 8, WC = 16;
constexpr int NE = 16, CAP = 512, FF = 1024;
constexpr int FEMB = 33, FHID = 64;
constexpr float EPS = 1e-6f;
constexpr int NWAVES = 8, NTHREADS = 512;

constexpr size_t MiB = 1u << 20;
constexpr size_t WS_CTL = 0, CTL_ZERO_BYTES = 1 * MiB;
constexpr size_t WS_WIN = 2 * MiB;
constexpr size_t WS_WOUT = 26 * MiB;
constexpr size_t WS_WGU = 34 * MiB;
constexpr size_t WS_WD = 162 * MiB;
constexpr size_t WS_W3T = 226 * MiB;
constexpr size_t WS_HID2 = 227 * MiB;
constexpr size_t WS_HB = 228 * MiB;
constexpr size_t WS_QK = 260 * MiB;
constexpr size_t WS_XT = 292 * MiB;
constexpr size_t WS_UC = 356 * MiB;
constexpr size_t WS_TAPS = 404 * MiB;
constexpr size_t WS_HYT = 436 * MiB;
constexpr size_t WS_MIXED = 452 * MiB;
constexpr size_t WS_AFF = 484 * MiB;
constexpr size_t WS_IDX = 485 * MiB;
constexpr size_t WS_GATE = 486 * MiB;
constexpr size_t WS_SEL = 487 * MiB;
constexpr size_t WS_Z1T = 488 * MiB;
constexpr size_t WS_XG = WS_XT;
constexpr size_t WS_ACT = WS_UC;
constexpr size_t WS_YE = WS_TAPS;
constexpr size_t WS_END = 504 * MiB;

constexpr int LDS_BYTES = 163840, LDS_MISC_OFF = 163840 - 128;

#define GAS __attribute__((address_space(1)))
#define LAS __attribute__((address_space(3)))
typedef unsigned short bf16;
typedef unsigned v4u __attribute__((ext_vector_type(4)));
typedef unsigned v2u __attribute__((ext_vector_type(2)));
typedef float f32x4 __attribute__((ext_vector_type(4)));
#define LDS_WAIT() asm volatile("s_waitcnt lgkmcnt(0)" ::: "memory")
#define VM_WAIT() asm volatile("s_waitcnt vmcnt(0)" ::: "memory")
__device__ __forceinline__ unsigned f2bf(float f) { unsigned u = __builtin_bit_cast(unsigned, f); return (u + 0x7fffu + ((u >> 16) & 1u)) >> 16; }
__device__ __forceinline__ unsigned pk2(float lo, float hi) { return f2bf(lo) | (f2bf(hi) << 16); }
__device__ __forceinline__ float bf2f(unsigned h) { return __builtin_bit_cast(float, h << 16); }
__device__ __forceinline__ float bflo(unsigned w) { return __builtin_bit_cast(float, w << 16); }
__device__ __forceinline__ float bfhi(unsigned w) { return __builtin_bit_cast(float, w & 0xffff0000u); }
__device__ __forceinline__ float wave_sum(float v) {
#pragma unroll
    for (int o = 1; o < 64; o <<= 1) v += __shfl_xor(v, o);
    return v;
}


#define XB_TMO      128
#define XB_XCNT(j)  (256  + 64 * (j))
#define XB_XSUB(j)  (1280 + 64 * (j))
#define XB_XGEN(j)  (2304 + 64 * (j))
#define XB_TOP      3328
#define XB_TOPGEN   3392
#define XCD_BAR_WORDS 3456
#define XB_SPIN_CAP (1u << 22)
__device__ __forceinline__ unsigned xb_ld(unsigned* p)              { return __hip_atomic_load(p, __ATOMIC_RELAXED, __HIP_MEMORY_SCOPE_AGENT); }
__device__ __forceinline__ unsigned xb_add(unsigned* p, unsigned v) { return __hip_atomic_fetch_add(p, v, __ATOMIC_RELAXED, __HIP_MEMORY_SCOPE_AGENT); }
__device__ __forceinline__ unsigned xb_xcc_id() { return (unsigned)__builtin_amdgcn_s_getreg((3 << 11) | 20) & 0xFu; }
#define XB_SPIN(cond, bar) do { unsigned _sp = 0; while (cond) { __builtin_amdgcn_s_sleep(1); \
    if ((++_sp & 255u) == 0u) { if (xb_ld(&(bar)[XB_TMO])) break; if (_sp > XB_SPIN_CAP) { atomicAdd(&(bar)[XB_TMO], 1u); break; } } } } while (0)
struct XcdBarrier { unsigned* bar; unsigned x; volatile LAS unsigned* st; };
__device__ __forceinline__ XcdBarrier xcd_barrier_post(unsigned* bar, volatile LAS unsigned* st) {
    XcdBarrier b; b.bar = bar; b.x = xb_xcc_id(); b.st = st;
    if (threadIdx.x == 0) (void)xb_add(&bar[XB_XCNT(b.x)], 1u);
    return b;
}
__device__ __forceinline__ void xcd_barrier_complete(unsigned* bar, unsigned x, unsigned& nloc, unsigned& nx) {
    const unsigned G = gridDim.x * gridDim.y * gridDim.z;
    unsigned sum, cnt, mine, sp = 0u;
    for (;;) {
        sum = 0u; cnt = 0u; mine = 0u;
#pragma unroll
        for (unsigned j = 0; j < 16; ++j) { const unsigned c = xb_ld(&bar[XB_XCNT(j)]); sum += c; cnt += (c > 0u) ? 1u : 0u; mine = (j == x) ? c : mine; }
        if (sum == G) break;
        __builtin_amdgcn_s_sleep(1);
        if ((++sp & 255u) == 0u) { if (xb_ld(&bar[XB_TMO])) break; if (sp > XB_SPIN_CAP) { atomicAdd(&bar[XB_TMO], 1u); break; } }
    }
    nloc = mine > 0u ? mine : 1u; nx = cnt > 0u ? cnt : 1u;
}
__device__ __forceinline__ void xcd_barrier(const XcdBarrier& b) {
    asm volatile("s_waitcnt vmcnt(0)" ::: "memory");
    __syncthreads();
    if (threadIdx.x == 0) {
        unsigned* bar = b.bar;
        __builtin_amdgcn_s_waitcnt(0);
        unsigned nloc = b.st[0], nx = b.st[1];
        if (nloc == 0u) { xcd_barrier_complete(bar, b.x, nloc, nx); b.st[0] = nloc; b.st[1] = nx; }
        const unsigned old = xb_add(&bar[XB_XSUB(b.x)], 1u);
        const unsigned gen = old / nloc;
        if (old + 1u == (gen + 1u) * nloc) {
            __builtin_amdgcn_fence(__ATOMIC_RELEASE, "agent");
            asm volatile("s_waitcnt vmcnt(0)" ::: "memory");
            const unsigned og = xb_add(&bar[XB_TOP], 1u);
            const unsigned tg = og / nx;
            if (og + 1u == (tg + 1u) * nx) xb_add(&bar[XB_TOPGEN], 1u);
            else XB_SPIN(xb_ld(&bar[XB_TOPGEN]) == tg, bar);
            __builtin_amdgcn_fence(__ATOMIC_ACQUIRE, "agent");
            xb_add(&bar[XB_XGEN(b.x)], 1u);
            asm volatile("s_waitcnt vmcnt(0)" ::: "memory");
        } else {
            XB_SPIN(xb_ld(&bar[XB_XGEN(b.x)]) == gen, bar);
            __builtin_amdgcn_fence(__ATOMIC_ACQUIRE, "agent");
            asm volatile("s_waitcnt vmcnt(0)" ::: "memory");
        }
    }
    __syncthreads();
}

struct Frame {
    LAS unsigned char* lds;
    int tid, lane, wave, G, bid;
    const float* in[23]; float* out; unsigned char* ws;
};
#define GW_ID(F) ((F).bid * NWAVES + (F).wave)
#define GW_N(F) ((F).G * NWAVES)

__device__ __forceinline__ void p0_transpose_item(const float* W, int K, int N, bf16* WT, int row_base, int k0, int n0, LAS float* scr, int lane) {
#pragma unroll 8
    for (int i = 0; i < 32; ++i) { const int kk = 2 * i + (lane >> 5); scr[kk * 33 + (lane & 31)] = W[(size_t)(k0 + kk) * N + n0 + (lane & 31)]; }
    LDS_WAIT(); asm volatile("" ::: "memory");
    const int c = lane & 7;
#pragma unroll
    for (int j = 0; j < 4; ++j) { const int n = (lane >> 3) + 8 * j; const LAS float* s = scr + (8 * c) * 33 + n;
        v4u o; o.x = pk2(s[0 * 33], s[1 * 33]); o.y = pk2(s[2 * 33], s[3 * 33]); o.z = pk2(s[4 * 33], s[5 * 33]); o.w = pk2(s[6 * 33], s[7 * 33]);
        *(GAS v4u*)(WT + (size_t)(row_base + n) * K + k0 + 8 * c) = o; }
    LDS_WAIT(); asm volatile("" ::: "memory");
}
__device__ __forceinline__ void phase_p0(Frame& F) {
    LAS float* scr = (LAS float*)(F.lds + F.wave * 16384);
    const int gw = GW_ID(F), NGW = GW_N(F);
    bf16* WinT = (bf16*)(F.ws + WS_WIN); bf16* WoutT = (bf16*)(F.ws + WS_WOUT); bf16* WguT = (bf16*)(F.ws + WS_WGU); bf16* WdT = (bf16*)(F.ws + WS_WD); bf16* W3T = (bf16*)(F.ws + WS_W3T);
    constexpr int I_IN = (DM / 64) * (INW / 32), I_OUT = (DM / 64) * (DM / 32), I_G = (DM / 64) * (FF / 32), I_D = (FF / 64) * (DM / 32), I_3 = 1 * (4096 / 32);
    constexpr int NITEMS = I_IN + I_OUT + 2 * NE * I_G + NE * I_D + I_3;
    for (int it = gw; it < NITEMS; it += NGW) {
        int r = it;
        if (r < I_IN) { const int nblk = INW / 32, kb = r / nblk, nb = r % nblk; p0_transpose_item(F.in[2], DM, INW, WinT, 32 * nb, 64 * kb, 32 * nb, scr, F.lane); continue; } r -= I_IN;
        if (r < I_OUT) { const int nblk = DM / 32, kb = r / nblk, nb = r % nblk; p0_transpose_item(F.in[17], DM, DM, WoutT, 32 * nb, 64 * kb, 32 * nb, scr, F.lane); continue; } r -= I_OUT;
        if (r < 2 * NE * I_G) { const int which = r / (NE * I_G); r %= NE * I_G; const int e = r / I_G; r %= I_G; const int nblk = FF / 32, kb = r / nblk, nb = r % nblk, f0 = 32 * nb;
            const float* W = (which ? F.in[21] : F.in[20]) + (size_t)e * DM * FF;
            const int row_base = e * 2048 + (f0 >> 7) * 256 + which * 128 + (f0 & 127);
            p0_transpose_item(W, DM, FF, WguT, row_base, 64 * kb, f0, scr, F.lane); continue; } r -= 2 * NE * I_G;
        if (r < NE * I_D) { const int e = r / I_D; r %= I_D; const int nblk = DM / 32, kb = r / nblk, nb = r % nblk;
            p0_transpose_item(F.in[22] + (size_t)e * FF * DM, FF, DM, WdT, e * 2048 + 32 * nb, 64 * kb, 32 * nb, scr, F.lane); continue; } r -= NE * I_D;
        { const int nb = r; p0_transpose_item(F.in[12], FHID, 4096, W3T, 32 * nb, 0, 32 * nb, scr, F.lane); }
    }
    bf16* HB = (bf16*)(F.ws + WS_HB);
    const float* x = F.in[0]; const float* g = F.in[1];
    for (int m = gw; m < MT; m += NGW) {
        const GAS f32x4* xr = (const GAS f32x4*)(x + (size_t)m * DM) + F.lane;
        f32x4 v[8]; float s = 0.f;
#pragma unroll
        for (int j = 0; j < 8; ++j) { v[j] = xr[64 * j]; s += (v[j].x * v[j].x + v[j].y * v[j].y) + (v[j].z * v[j].z + v[j].w * v[j].w); }
        const float r = rsqrtf(wave_sum(s) * (1.f / DM) + EPS);
        GAS v2u* o8 = (GAS v2u*)(HB + (size_t)m * DM) + F.lane;
#pragma unroll
        for (int j = 0; j < 8; ++j) { const f32x4 gg = *((const GAS f32x4*)g + F.lane + 64 * j); v2u o; o.x = pk2(v[j].x * r * gg.x, v[j].y * r * gg.y); o.y = pk2(v[j].z * r * gg.z, v[j].w * r * gg.w); o8[64 * j] = o; }
    }
    float* HID2 = (float*)(F.ws + WS_HID2);
    LAS float* sc2 = (LAS float*)(F.lds + F.wave * 16384);
    const float* w1 = F.in[8]; const float* b1 = F.in[9]; const float* w2 = F.in[10]; const float* b2 = F.in[11]; const float* fr = F.in[13];
    for (int l = gw; l < SEQ; l += NGW) {
        const int j = F.lane;
        float zv = 0.f;
        if (j == 0) zv = (float)l / (float)(SEQ - 1);
        else if (j < FEMB) { const int k = (j - 1) & 15; const float f = 1e-4f + (float)k * ((15.0f - 1e-4f) / 15.0f); const float wv = 6.283185307179586f * (float)l / (float)SEQ; zv = (j <= 16) ? cosf(f * wv) : -sinf(f * wv); }
        sc2[j] = zv; LDS_WAIT(); asm volatile("" ::: "memory");
        float a = b1[j];
        for (int i = 0; i < FEMB; ++i) a += sc2[i] * w1[i * FHID + j];
        const float h1 = sinf(fr[j] * a);
        sc2[64 + j] = h1; LDS_WAIT(); asm volatile("" ::: "memory");
        float c = b2[j];
        for (int i = 0; i < FHID; ++i) c += sc2[64 + i] * w2[i * FHID + j];
        HID2[l * FHID + j] = sinf(fr[j] * c);
        LDS_WAIT(); asm volatile("" ::: "memory");
    }
}

__device__ __forceinline__ void phase_filters_naive(Frame& F) {
    const float* HID2 = (const float*)(F.ws + WS_HID2); const float* w3 = F.in[12]; const float* fbias = F.in[14]; bf16* TAPS = (bf16*)(F.ws + WS_TAPS);
    const size_t total = (size_t)SEQ * 4096;
    for (size_t i = (size_t)F.bid * NTHREADS + F.tid; i < total; i += (size_t)F.G * NTHREADS) {
        const int col = (int)(i & 4095), l = (int)(i >> 12);
        float a = 0.f;
        for (int k = 0; k < FHID; ++k) a += HID2[l * FHID + k] * w3[(size_t)k * 4096 + col];
        const int c = col & 1023, dir = (col >> 10) & 1, o = col >> 11;
        const float mind = -4.605170185988091f / 1.5f, maxd = -4.605170185988091f / 0.3f;
        const float delta = fabsf(mind + (maxd - mind) * ((float)c / 1023.0f));
        const float t = (float)l / (float)(SEQ - 1);
        float v = a * expf(-t * delta);
        bf16* tp = TAPS + ((size_t)c * 2 + o) * 8192;
        if (dir == 0) { if (l == 0) v += fbias[o * 1024 + c]; tp[4096 + l] = (bf16)f2bf(v); }
        else { if (l > 0) tp[4096 - l] = (bf16)f2bf(v); else tp[0] = 0; }
    }
}
__device__ __forceinline__ void phase_hyena_naive(Frame& F, int o) {
    const bf16* UC = (const bf16*)(F.ws + WS_UC); const bf16* TAPS = (const bf16*)(F.ws + WS_TAPS);
    bf16* Z1T = (bf16*)(F.ws + WS_Z1T); bf16* HYT = (bf16*)(F.ws + WS_HYT);
    const bf16* Zin = o == 0 ? UC + (size_t)2048 * MT : Z1T; const bf16* gate = UC + (size_t)(o * 1024) * MT; bf16* OUT = o == 0 ? Z1T : HYT;
    const size_t total = (size_t)1024 * MT;
    for (size_t i = (size_t)F.bid * NTHREADS + F.tid; i < total; i += (size_t)F.G * NTHREADS) {
        const int c = (int)(i >> 13), m = (int)(i & 8191), b = m >> 12, t = m & 4095;
        const bf16* z = Zin + (size_t)c * MT + b * SEQ; const bf16* tp = TAPS + ((size_t)c * 2 + o) * 8192 + 4096 + t;
        float acc = 0.f;
        for (int s = 0; s < SEQ; ++s) acc += bf2f(tp[-s]) * bf2f(z[s]);
        OUT[(size_t)c * MT + m] = (bf16)f2bf(bf2f(gate[(size_t)c * MT + m]) * acc);
    }
}
__device__ __forceinline__ void phase_attn_naive(Frame& F) {
    const bf16* QK = (const bf16*)(F.ws + WS_QK); const bf16* VT = (const bf16*)(F.ws + WS_XT); bf16* MIXED = (bf16*)(F.ws + WS_MIXED);
    const float* rpb = F.in[5]; const float* og = F.in[15];
    const int lane = F.lane;
    for (int w = GW_ID(F); w < MT * NH; w += GW_N(F)) {
        const int m = w >> 3, h = w & 7, b = m / SEQ, s = m % SEQ, r = s / GW, c = s % GW;
        int kr0 = r - WR / 2; kr0 = kr0 < 0 ? 0 : (kr0 > NROWS - WR ? NROWS - WR : kr0);
        int c0 = c - WC / 2; c0 = c0 < 0 ? 0 : (c0 > GW - WC ? GW - WC : c0);
        const bf16* q = QK + (size_t)m * 2048 + h * HD;
        const float q0 = bf2f(q[lane]), q1 = bf2f(q[lane + 64]);
        float mx = -INFINITY, l = 0.f, a0 = 0.f, a1 = 0.f;
        for (int i = 0; i < WR; ++i) for (int j = 0; j < WC; ++j) {
            const int kr = kr0 + i, kc = c0 + j; const size_t km = (size_t)b * SEQ + kr * GW + kc;
            const bf16* kp = QK + km * 2048 + 1024 + h * HD;
            const float d = wave_sum(q0 * bf2f(kp[lane]) + q1 * bf2f(kp[lane + 64]));
            const int dr = kr - r + WR - 1; int dc = kc - c + WC - 1; dc = dc < 0 ? 0 : (dc > 2 * WC - 2 ? 2 * WC - 2 : dc);
            const float sc = d * 0.08838834764831845f + rpb[(h * (2 * WR - 1) + dr) * (2 * WC - 1) + dc];
            const float mn = fmaxf(mx, sc), corr = __expf(mx - mn), pw = __expf(sc - mn);
            const float v0 = bf2f(VT[(size_t)(h * HD + lane) * MT + km]), v1 = bf2f(VT[(size_t)(h * HD + lane + 64) * MT + km]);
            l = l * corr + pw; a0 = a0 * corr + pw * v0; a1 = a1 * corr + pw * v1; mx = mn;
        }
        a0 /= l; a1 /= l;
        const float rr = rsqrtf(wave_sum(a0 * a0 + a1 * a1) * (1.f / HD) + EPS);
        bf16* o = MIXED + (size_t)m * DM + h * HD;
        o[lane] = (bf16)f2bf(a0 * rr * og[h * HD + lane]); o[lane + 64] = (bf16)f2bf(a1 * rr * og[h * HD + lane + 64]);
    }
}


typedef short bf16x8 __attribute__((ext_vector_type(8)));
typedef float f32x16 __attribute__((ext_vector_type(16)));
__device__ __forceinline__ void phase_filters(Frame& F) {
    const float* HID2 = (const float*)(F.ws + WS_HID2); const bf16* W3T = (const bf16*)(F.ws + WS_W3T); const float* fbias = F.in[14]; bf16* TAPS = (bf16*)(F.ws + WS_TAPS);
    const int n = F.lane & 31, hh = F.lane >> 5;
    for (int it = GW_ID(F); it < 128 * 128; it += GW_N(F)) {
        const int col0 = (it >> 7) * 32, l0 = (it & 127) * 32;
        f32x16 acc;
#pragma unroll
        for (int i = 0; i < 16; ++i) acc[i] = 0.f;
#pragma unroll
        for (int ks = 0; ks < 4; ++ks) {
            const bf16x8 a = *(const GAS bf16x8*)(W3T + (size_t)(col0 + n) * FHID + 16 * ks + 8 * hh);
            const GAS f32x4* hp = (const GAS f32x4*)(HID2 + (size_t)(l0 + n) * FHID + 16 * ks + 8 * hh);
            const f32x4 h0 = hp[0], h1 = hp[1];
            v4u bw; bw.x = pk2(h0.x, h0.y); bw.y = pk2(h0.z, h0.w); bw.z = pk2(h1.x, h1.y); bw.w = pk2(h1.z, h1.w);
            acc = __builtin_amdgcn_mfma_f32_32x32x16_bf16(a, __builtin_bit_cast(bf16x8, bw), acc, 0, 0, 0);
        }
        const int l = l0 + n; const float t = (float)l / (float)(SEQ - 1);
        const int dir = (col0 >> 10) & 1, o = col0 >> 11;
        const float mind = -4.605170185988091f / 1.5f, maxd = -4.605170185988091f / 0.3f;
#pragma unroll
        for (int i = 0; i < 16; ++i) {
            const int c = (col0 & 1023) + (i & 3) + 8 * (i >> 2) + 4 * hh;
            const float delta = fabsf(mind + (maxd - mind) * ((float)c / 1023.0f));
            float v = acc[i] * __expf(-t * delta);
            bf16* tp = TAPS + ((size_t)c * 2 + o) * 8192;
            if (dir == 0) { if (l == 0) v += fbias[o * 1024 + c]; tp[4096 + l] = (bf16)f2bf(v); }
            else { if (l > 0) tp[4096 - l] = (bf16)f2bf(v); else tp[0] = 0; }
        }
    }
}

constexpr int HY_TAPS_BYTES = 4 * 16384, HY_ZB_ENT = 6080, HY_ZB_BYTES = HY_ZB_ENT * 2;
__device__ __forceinline__ unsigned hy_zb_off(int idx0  ) { const int q = idx0 >> 3; return (unsigned)((q ^ ((q >> 4) & 3)) << 4); }
template <int MASK>
__device__ __forceinline__ void hy_segment(f32x16 (&acc)[4], const LAS bf16* taps, const LAS unsigned char* zb, int g0, int g1, int n, int hh) {
    const unsigned sh = (n & 1) ? 0u : 2u;
#pragma unroll 2
    for (int g = g0; g < g1; ++g) {
        const volatile LAS unsigned* dp = (const volatile LAS unsigned*)taps + ((1 + 8 * hh + n) >> 1) + 8 * g;
        const unsigned d0 = dp[0], d1 = dp[1], d2 = dp[2], d3 = dp[3], d4 = dp[4];
        v4u aw; aw.x = __builtin_amdgcn_alignbyte(d1, d0, sh); aw.y = __builtin_amdgcn_alignbyte(d2, d1, sh); aw.z = __builtin_amdgcn_alignbyte(d3, d2, sh); aw.w = __builtin_amdgcn_alignbyte(d4, d3, sh);
        const bf16x8 a = __builtin_bit_cast(bf16x8, aw);
#pragma unroll
        for (int tau = 0; tau < 4; ++tau) if (MASK & (1 << tau)) {
            const bf16x8 b = *(const LAS bf16x8*)(zb + hy_zb_off(992 - 1024 * tau - 32 * n + 16 * g + 8 * hh));
            acc[tau] = __builtin_amdgcn_mfma_f32_32x32x16_bf16(a, b, acc[tau], 0, 0, 0);
        }
    }
}
__device__ __forceinline__ void hy_stage_taps(Frame& F, int c0, int o) {
    const bf16* TAPS = (const bf16*)(F.ws + WS_TAPS);
#pragma unroll
    for (int j = 0; j < 8; ++j) { const int ch = F.tid + NTHREADS * j, ci = ch >> 10, w = ch & 1023;
        *((LAS v4u*)(F.lds) + ch) = *((const GAS v4u*)(TAPS + ((size_t)(c0 + ci) * 2 + o) * 8192) + w); }
}
__device__ __forceinline__ void phase_hyena(Frame& F) {
    const bf16* UC = (const bf16*)(F.ws + WS_UC); bf16* HYT = (bf16*)(F.ws + WS_HYT);
    const int n = F.lane & 31, hh = F.lane >> 5, ci = F.wave >> 1, b = F.wave & 1;
    const LAS bf16* taps = (const LAS bf16*)(F.lds + ci * 16384);
    LAS unsigned char* zb = F.lds + HY_TAPS_BYTES + F.wave * HY_ZB_BYTES;
    for (int cg = F.bid; cg < 256; cg += F.G) {
        const int c0 = cg * 4, c = c0 + ci;
        __syncthreads();
        hy_stage_taps(F, c0, 0);
        { const bf16* zsrc = UC + (size_t)(2048 + c) * MT + b * SEQ;
#pragma unroll
          for (int j = 0; j < 8; ++j) { const int u = F.lane + 64 * j; const v4u w = *((const GAS v4u*)zsrc + u);
              v4u r; r.x = (w.w >> 16) | (w.w << 16); r.y = (w.z >> 16) | (w.z << 16); r.z = (w.y >> 16) | (w.y << 16); r.w = (w.x >> 16) | (w.x << 16);
              *(LAS v4u*)(zb + hy_zb_off(8 * (635 - u))) = r; }
          const v4u zero = {0u, 0u, 0u, 0u};
          for (int q = F.lane; q < 124; q += 64) { *(LAS v4u*)(zb + hy_zb_off(8 * q)) = zero; *(LAS v4u*)(zb + hy_zb_off(8 * (636 + q))) = zero; } }
        __syncthreads();
#pragma unroll 1
        for (int o = 0; o < 2; ++o) {
            f32x16 acc[4];
#pragma unroll
            for (int tau = 0; tau < 4; ++tau)
#pragma unroll
                for (int i = 0; i < 16; ++i) acc[tau][i] = 0.f;
            hy_segment<1>(acc, taps, zb, 0, 64, n, hh);
            hy_segment<3>(acc, taps, zb, 64, 128, n, hh);
            hy_segment<7>(acc, taps, zb, 128, 192, n, hh);
            hy_segment<15>(acc, taps, zb, 192, 318, n, hh);
            hy_segment<14>(acc, taps, zb, 318, 382, n, hh);
            hy_segment<12>(acc, taps, zb, 382, 446, n, hh);
            hy_segment<8>(acc, taps, zb, 446, 510, n, hh);
            const bf16* gate = UC + (size_t)(o * 1024 + c) * MT + b * SEQ;
            if (o == 0) {
                LDS_WAIT();
#pragma unroll
                for (int tau = 0; tau < 4; ++tau)
#pragma unroll
                    for (int rg = 0; rg < 4; ++rg) { const int t0 = 1024 * tau + 32 * n + 8 * rg + 4 * hh;
                        const v2u gw = *(const GAS v2u*)(gate + t0);
                        const float z0 = bflo(gw.x) * acc[tau][4 * rg + 0], z1 = bfhi(gw.x) * acc[tau][4 * rg + 1], z2 = bflo(gw.y) * acc[tau][4 * rg + 2], z3 = bfhi(gw.y) * acc[tau][4 * rg + 3];
                        v2u w; w.x = pk2(z3, z2); w.y = pk2(z1, z0);
                        *(LAS v2u*)(zb + hy_zb_off(8 * (635 - (t0 >> 3))) + (hh ? 0 : 8)) = w; }
                __syncthreads();
                hy_stage_taps(F, c0, 1);
                __syncthreads();
            } else {
                bf16* outp = HYT + (size_t)c * MT + b * SEQ;
#pragma unroll
                for (int tau = 0; tau < 4; ++tau)
#pragma unroll
                    for (int rg = 0; rg < 4; ++rg) { const int t0 = 1024 * tau + 32 * n + 8 * rg + 4 * hh;
                        const v2u gw = *(const GAS v2u*)(gate + t0);
                        v2u w; w.x = pk2(bflo(gw.x) * acc[tau][4 * rg + 0], bfhi(gw.x) * acc[tau][4 * rg + 1]); w.y = pk2(bflo(gw.y) * acc[tau][4 * rg + 2], bfhi(gw.y) * acc[tau][4 * rg + 3]);
                        *(GAS v2u*)(outp + t0) = w; }
            }
        }
    }
    __syncthreads();
}

__device__ __forceinline__ void phase_attn(Frame& F) {
    const bf16* QK = (const bf16*)(F.ws + WS_QK); const bf16* VT = (const bf16*)(F.ws + WS_XT); bf16* MIXED = (bf16*)(F.ws + WS_MIXED);
    const float* rpb = F.in[5]; const float* og = F.in[15];
    LAS float* rp = (LAS float*)(F.lds + F.wave * 2048);
    const int n = F.lane & 31, hh = F.lane >> 5;
    for (int task = GW_ID(F); task < NB * NH * NROWS * 2; task += GW_N(F)) {
        const int wq = task & 1, r = (task >> 1) & 63, h = (task >> 7) & 7, b = task >> 10;
        for (int i = F.lane; i < 15 * 31; i += 64) rp[i] = rpb[h * 465 + i];
        const int mq = b * SEQ + r * GW + 32 * wq + n, qc = 32 * wq + n;
        int c0 = qc - WC / 2; c0 = c0 < 0 ? 0 : (c0 > GW - WC ? GW - WC : c0);
        int kr0 = r - WR / 2; kr0 = kr0 < 0 ? 0 : (kr0 > NROWS - WR ? NROWS - WR : kr0);
        bf16x8 qf[8];
#pragma unroll
        for (int ks = 0; ks < 8; ++ks) qf[ks] = *(const GAS bf16x8*)(QK + (size_t)mq * 2048 + h * HD + 16 * ks + 8 * hh);
        f32x16 O[4];
#pragma unroll
        for (int dt = 0; dt < 4; ++dt)
#pragma unroll
            for (int i = 0; i < 16; ++i) O[dt][i] = 0.f;
        float lsum = 0.f;
        LDS_WAIT();
#pragma unroll 1
        for (int tile = 0; tile < 16; ++tile) {
            const int kr = kr0 + (tile >> 1), kt = tile & 1, dr = kr - r + WR - 1;
            const int mk0 = b * SEQ + kr * GW + 32 * kt;
            f32x16 S;
#pragma unroll
            for (int i = 0; i < 16; ++i) S[i] = 0.f;
#pragma unroll
            for (int ks = 0; ks < 8; ++ks) { const bf16x8 kf = *(const GAS bf16x8*)(QK + (size_t)(mk0 + n) * 2048 + 1024 + h * HD + 16 * ks + 8 * hh);
                S = __builtin_amdgcn_mfma_f32_32x32x16_bf16(kf, qf[ks], S, 0, 0, 0); }
            float p[16];
#pragma unroll
            for (int i = 0; i < 16; ++i) { const int kc = 32 * kt + (i & 3) + 8 * (i >> 2) + 4 * hh; const bool valid = (kc >= c0) && (kc < c0 + WC);
                int dc = kc - qc + WC - 1; dc = dc < 0 ? 0 : (dc > 2 * WC - 2 ? 2 * WC - 2 : dc);
                const float e = __expf(S[i] * 0.08838834764831845f + rp[dr * 31 + dc]); p[i] = valid ? e : 0.f; lsum += p[i]; }
            v4u pw0, pw1;
            pw0.x = pk2(p[0], p[1]); pw0.y = pk2(p[2], p[3]); pw0.z = pk2(p[4], p[5]); pw0.w = pk2(p[6], p[7]);
            pw1.x = pk2(p[8], p[9]); pw1.y = pk2(p[10], p[11]); pw1.z = pk2(p[12], p[13]); pw1.w = pk2(p[14], p[15]);
            const bf16x8 pf0 = __builtin_bit_cast(bf16x8, pw0), pf1 = __builtin_bit_cast(bf16x8, pw1);
#pragma unroll
            for (int dt = 0; dt < 4; ++dt) {
                const bf16* vrow = VT + (size_t)(h * HD + 32 * dt + n) * MT + mk0 + 4 * hh;
                const v2u a0 = *(const GAS v2u*)(vrow), a1 = *(const GAS v2u*)(vrow + 8), a2 = *(const GAS v2u*)(vrow + 16), a3 = *(const GAS v2u*)(vrow + 24);
                v4u f0, f1; f0.x = a0.x; f0.y = a0.y; f0.z = a1.x; f0.w = a1.y; f1.x = a2.x; f1.y = a2.y; f1.z = a3.x; f1.w = a3.y;
                O[dt] = __builtin_amdgcn_mfma_f32_32x32x16_bf16(__builtin_bit_cast(bf16x8, f0), pf0, O[dt], 0, 0, 0);
                O[dt] = __builtin_amdgcn_mfma_f32_32x32x16_bf16(__builtin_bit_cast(bf16x8, f1), pf1, O[dt], 0, 0, 0);
            }
        }
        lsum += __shfl_xor(lsum, 32);
        const float il = 1.f / lsum;
        float ss = 0.f;
#pragma unroll
        for (int dt = 0; dt < 4; ++dt)
#pragma unroll
            for (int i = 0; i < 16; ++i) { O[dt][i] *= il; ss += O[dt][i] * O[dt][i]; }
        ss += __shfl_xor(ss, 32);
        const float rr = rsqrtf(ss * (1.f / HD) + EPS);
        bf16* orow = MIXED + (size_t)mq * DM + h * HD;
#pragma unroll
        for (int dt = 0; dt < 4; ++dt)
#pragma unroll
            for (int rg = 0; rg < 4; ++rg) { const int d = 32 * dt + 8 * rg + 4 * hh; const f32x4 gg = *(const GAS f32x4*)(og + h * HD + d);
                v2u w; w.x = pk2(O[dt][4 * rg + 0] * rr * gg.x, O[dt][4 * rg + 1] * rr * gg.y); w.y = pk2(O[dt][4 * rg + 2] * rr * gg.z, O[dt][4 * rg + 3] * rr * gg.w);
                *(GAS v2u*)(orow + d) = w; }
        LDS_WAIT();
    }
}

__device__ __forceinline__ void phase_p15(Frame& F) {
    bf16* QK = (bf16*)(F.ws + WS_QK); const float* qg = F.in[3]; const float* kg = F.in[4];
    for (int m = GW_ID(F); m < MT; m += GW_N(F)) {
        GAS v4u* rowp = (GAS v4u*)(QK + (size_t)m * 2048) + F.lane;
#pragma unroll
        for (int j = 0; j < 4; ++j) {
            v4u w = rowp[64 * j];
            float f[8] = {bflo(w.x), bfhi(w.x), bflo(w.y), bfhi(w.y), bflo(w.z), bfhi(w.z), bflo(w.w), bfhi(w.w)};
            float ss = 0.f;
#pragma unroll
            for (int e = 0; e < 8; ++e) ss += f[e] * f[e];
            ss += __shfl_xor(ss, 1); ss += __shfl_xor(ss, 2); ss += __shfl_xor(ss, 4); ss += __shfl_xor(ss, 8);
            const float r = rsqrtf(ss * (1.f / HD) + EPS);
            const int col = 512 * j + 8 * F.lane, d = col & 127; const float* g = (col < 1024 ? qg : kg) + d;
#pragma unroll
            for (int e = 0; e < 8; ++e) f[e] = f[e] * r * g[e];
            w.x = pk2(f[0], f[1]); w.y = pk2(f[2], f[3]); w.z = pk2(f[4], f[5]); w.w = pk2(f[6], f[7]);
            rowp[64 * j] = w;
        }
    }
    const bf16* XT = (const bf16*)(F.ws + WS_XT) + (size_t)1024 * MT; bf16* UC = (bf16*)(F.ws + WS_UC);
    const float* cw = F.in[6]; const float* cb = F.in[7];
    const size_t nchunks = (size_t)3072 * MT / 8;
    for (size_t i = (size_t)F.bid * NTHREADS + F.tid; i < nchunks; i += (size_t)F.G * NTHREADS) {
        const int ch = (int)(i >> 10), m0 = (int)(i & 1023) * 8, s0 = m0 & 4095;
        const bf16* up = XT + (size_t)ch * MT + m0;
        const v4u w = *(const GAS v4u*)up;
        float f[10];
        f[1] = bflo(w.x); f[2] = bfhi(w.x); f[3] = bflo(w.y); f[4] = bfhi(w.y); f[5] = bflo(w.z); f[6] = bfhi(w.z); f[7] = bflo(w.w); f[8] = bfhi(w.w);
        f[0] = s0 > 0 ? bf2f(up[-1]) : 0.f; f[9] = s0 + 8 < SEQ ? bf2f(up[8]) : 0.f;
        const float w0 = cw[ch], w1 = cw[3072 + ch], w2 = cw[6144 + ch], bb = cb[ch];
        float o[8];
#pragma unroll
        for (int e = 0; e < 8; ++e) o[e] = bb + w0 * f[e] + w1 * f[e + 1] + w2 * f[e + 2];
        v4u ov; ov.x = pk2(o[0], o[1]); ov.y = pk2(o[2], o[3]); ov.z = pk2(o[4], o[5]); ov.w = pk2(o[6], o[7]);
        *(GAS v4u*)(UC + (size_t)ch * MT + m0) = ov;
    }
}
__device__ __forceinline__ void phase_p25(Frame& F) {
    const bf16* HYT = (const bf16*)(F.ws + WS_HYT); bf16* MIXED = (bf16*)(F.ws + WS_MIXED); const float* hg = F.in[16];
    LAS float* tile = (LAS float*)F.lds;
    LAS float* rs = (LAS float*)(F.lds + 128 * 65 * 4);
    for (int it = F.bid; it < 8 * (MT / 64); it += F.G) {
        const int gi = it & 7, m0 = (it >> 3) * 64;
        { const int ch = F.tid >> 2, t0 = (F.tid & 3) * 16; const bf16* p = HYT + (size_t)(gi * 128 + ch) * MT + m0 + t0;
          const v4u a = *(const GAS v4u*)p, b = *(const GAS v4u*)(p + 8);
          LAS float* d = tile + ch * 65 + t0;
          d[0] = bflo(a.x); d[1] = bfhi(a.x); d[2] = bflo(a.y); d[3] = bfhi(a.y); d[4] = bflo(a.z); d[5] = bfhi(a.z); d[6] = bflo(a.w); d[7] = bfhi(a.w);
          d[8] = bflo(b.x); d[9] = bfhi(b.x); d[10] = bflo(b.y); d[11] = bfhi(b.y); d[12] = bflo(b.z); d[13] = bfhi(b.z); d[14] = bflo(b.w); d[15] = bfhi(b.w); }
        __syncthreads();
        {
          const int t = F.tid >> 3, c0 = (F.tid & 7) * 16; float ss = 0.f;
#pragma unroll
          for (int c = 0; c < 16; ++c) { const float v = tile[(c0 + c) * 65 + t]; ss += v * v; }
          ss += __shfl_xor(ss, 1); ss += __shfl_xor(ss, 2); ss += __shfl_xor(ss, 4);
          if ((F.tid & 7) == 0) rs[t] = rsqrtf(ss * (1.f / 128) + EPS); }
        __syncthreads();
        {
          const int t = F.tid >> 3, c0 = (F.tid & 7) * 16; const float r = rs[t]; float o[16];
#pragma unroll
          for (int c = 0; c < 16; ++c) o[c] = tile[(c0 + c) * 65 + t] * r * hg[gi * 128 + c0 + c];
          v4u a, b; a.x = pk2(o[0], o[1]); a.y = pk2(o[2], o[3]); a.z = pk2(o[4], o[5]); a.w = pk2(o[6], o[7]); b.x = pk2(o[8], o[9]); b.y = pk2(o[10], o[11]); b.z = pk2(o[12], o[13]); b.w = pk2(o[14], o[15]);
          bf16* q = MIXED + (size_t)(m0 + t) * DM + AW + gi * 128 + c0; *(GAS v4u*)q = a; *(GAS v4u*)(q + 8) = b; }
        __syncthreads();
    }
}
__device__ __forceinline__ void phase_p35(Frame& F) {
    LAS float* wrT = (LAS float*)F.lds;
    const float* wr = F.in[19]; const float* g = F.in[18];
    for (int i = F.tid; i < DM * NE; i += NTHREADS) { const int d = i >> 4, e = i & 15; wrT[e * DM + d] = wr[i]; }
    __syncthreads();
    bf16* HB = (bf16*)(F.ws + WS_HB); float* AFF = (float*)(F.ws + WS_AFF); const float* x1 = F.out;
    for (int m = GW_ID(F); m < MT; m += GW_N(F)) {
        const GAS f32x4* xr = (const GAS f32x4*)(x1 + (size_t)m * DM) + F.lane;
        f32x4 v[8]; float s = 0.f;
#pragma unroll
        for (int j = 0; j < 8; ++j) { v[j] = xr[64 * j]; s += (v[j].x * v[j].x + v[j].y * v[j].y) + (v[j].z * v[j].z + v[j].w * v[j].w); }
        const float r = rsqrtf(wave_sum(s) * (1.f / DM) + EPS);
        GAS v2u* o8 = (GAS v2u*)(HB + (size_t)m * DM) + F.lane;
#pragma unroll
        for (int j = 0; j < 8; ++j) { const f32x4 gg = *((const GAS f32x4*)g + F.lane + 64 * j); v[j].x *= r * gg.x; v[j].y *= r * gg.y; v[j].z *= r * gg.z; v[j].w *= r * gg.w;
            v2u o; o.x = pk2(v[j].x, v[j].y); o.y = pk2(v[j].z, v[j].w); o8[64 * j] = o; }
        float mine = 0.f;
#pragma unroll 1
        for (int e = 0; e < NE; ++e) { float a = 0.f;
#pragma unroll
            for (int j = 0; j < 8; ++j) { const f32x4 w = *((const LAS f32x4*)(wrT + e * DM) + F.lane + 64 * j); a += (v[j].x * w.x + v[j].y * w.y) + (v[j].z * w.z + v[j].w * w.w); }
            a = wave_sum(a); mine = (F.lane == e) ? a : mine; }
        float mx = mine;
        mx = fmaxf(mx, __shfl_xor(mx, 1)); mx = fmaxf(mx, __shfl_xor(mx, 2)); mx = fmaxf(mx, __shfl_xor(mx, 4)); mx = fmaxf(mx, __shfl_xor(mx, 8));
        const float ex = expf(mine - mx); float den = ex;
        den += __shfl_xor(den, 1); den += __shfl_xor(den, 2); den += __shfl_xor(den, 4); den += __shfl_xor(den, 8);
        const int b = m / SEQ, sidx = m % SEQ;
        if (F.lane < NE) AFF[((size_t)b * NE + F.lane) * SEQ + sidx] = ex / den;
    }
    __syncthreads();
}
__device__ __forceinline__ void phase_p4(Frame& F) {
    LAS float* a = (LAS float*)F.lds;
    LAS int* rk = (LAS int*)(F.lds + 16384);
    const float* AFF = (const float*)(F.ws + WS_AFF); int* IDX = (int*)(F.ws + WS_IDX); float* GATE = (float*)(F.ws + WS_GATE); int* SEL = (int*)(F.ws + WS_SEL);
    const bf16* HB = (const bf16*)(F.ws + WS_HB); bf16* XG = (bf16*)(F.ws + WS_XG);
    for (int it = F.bid; it < NB * NE * 8; it += F.G) {
        const int be = it >> 3, ch = it & 7, b = be / NE, e = be % NE;
        const float* ap = AFF + (size_t)be * SEQ;
        for (int i = F.tid; i < SEQ / 4; i += NTHREADS) *((LAS f32x4*)a + i) = *((const GAS f32x4*)ap + i);
        __syncthreads();
        const int s = ch * 512 + F.tid; const float v = a[s]; int rank = 0;
        for (int i = 0; i < SEQ; i += 4) { const f32x4 u = *(const LAS f32x4*)(a + i);
            rank += (u.x > v || (u.x == v && i < s)) ? 1 : 0; rank += (u.y > v || (u.y == v && i + 1 < s)) ? 1 : 0;
            rank += (u.z > v || (u.z == v && i + 2 < s)) ? 1 : 0; rank += (u.w > v || (u.w == v && i + 3 < s)) ? 1 : 0; }
        rk[F.tid] = rank;
        const int m = b * SEQ + s;
        if (rank < CAP) { IDX[be * CAP + rank] = m; GATE[be * CAP + rank] = v; }
        SEL[(size_t)m * NE + e] = rank < CAP ? rank : -1;
        __syncthreads();
        for (int t = F.wave; t < 512; t += NWAVES) { const int r = rk[t]; if (r < CAP) {
            const GAS v4u* src = (const GAS v4u*)(HB + (size_t)(b * SEQ + ch * 512 + t) * DM) + F.lane; GAS v4u* dst = (GAS v4u*)(XG + (size_t)(be * CAP + r) * DM) + F.lane;
#pragma unroll
            for (int j = 0; j < 4; ++j) dst[64 * j] = src[64 * j]; } }
        __syncthreads();
    }
}
__device__ __forceinline__ void phase_p7(Frame& F) {
    const int* SEL = (const int*)(F.ws + WS_SEL); const float* GATE = (const float*)(F.ws + WS_GATE); const bf16* YE = (const bf16*)(F.ws + WS_YE);
    for (int m = GW_ID(F); m < MT; m += GW_N(F)) {
        const int b = m / SEQ;
        GAS f32x4* orow = (GAS f32x4*)(F.out + (size_t)m * DM);
        f32x4 acc[8];
#pragma unroll
        for (int j = 0; j < 8; ++j) acc[j] = orow[2 * F.lane + (j & 1) + 128 * (j >> 1)];
        for (int e = 0; e < NE; ++e) { const int slot = SEL[(size_t)m * NE + e]; if (slot >= 0) {
            const GAS v4u* yr = (const GAS v4u*)(YE + (size_t)((b * NE + e) * CAP + slot) * DM) + F.lane;
#pragma unroll
            for (int jj = 0; jj < 4; ++jj) { const v4u w = yr[64 * jj];
                acc[2 * jj].x += bflo(w.x); acc[2 * jj].y += bfhi(w.x); acc[2 * jj].z += bflo(w.y); acc[2 * jj].w += bfhi(w.y);
                acc[2 * jj + 1].x += bflo(w.z); acc[2 * jj + 1].y += bfhi(w.z); acc[2 * jj + 1].z += bflo(w.w); acc[2 * jj + 1].w += bfhi(w.w); } } }
#pragma unroll
        for (int j = 0; j < 8; ++j) orow[2 * F.lane + (j & 1) + 128 * (j >> 1)] = acc[j];
    }
    (void)GATE;
}

struct Args { const float* in[23]; float* out; unsigned char* ws; int ph_lo, ph_hi; };
enum Phase { PH_P0 = 0, PH_G1, PH_FILT, PH_P15, PH_ATTN, PH_P25, PH_OUT, PH_P35, PH_P4, PH_UP, PH_DOWN, PH_P7, PH_COUNT };

__global__ void __launch_bounds__(NTHREADS, 2) mk_fwd(Args args) {
    extern __shared__ __attribute__((aligned(16))) unsigned char lds_raw[];
    Frame F;
    F.lds = (LAS unsigned char*)lds_raw;
    F.tid = threadIdx.x; F.lane = F.tid & 63; F.wave = __builtin_amdgcn_readfirstlane(F.tid >> 6); F.G = gridDim.x; F.bid = blockIdx.x;
#pragma unroll
    for (int i = 0; i < 23; ++i) F.in[i] = args.in[i];
    F.out = args.out; F.ws = args.ws;
    const int lo = args.ph_lo, hi = args.ph_hi;
#define IN(k) (lo <= (k) && (k) < hi)
#if MK_N_LAUNCHES == 1
    { volatile LAS unsigned* misc = (volatile LAS unsigned*)(F.lds + LDS_MISC_OFF); if (F.tid < 16) misc[F.tid] = 0u; }
    __syncthreads();
    XcdBarrier bar = xcd_barrier_post((unsigned*)(F.ws + WS_CTL) + 4096, (volatile LAS unsigned*)(F.lds + LDS_MISC_OFF) + 8);
#define SEAM(k) do { if (IN(k) && IN((k) + 1)) xcd_barrier(bar); } while (0)
#else
#define SEAM(k) do { } while (0)
#endif
    if (IN(PH_P0)) { phase_p0(F); } SEAM(PH_P0);
    if (IN(PH_G1)) {
        __syncthreads();
        { pg8::DenseOrder S; S.init(F.ws + WS_HB, F.ws + WS_WIN, MT, 2048, DM, 0, F.G, F.bid);
          pg8::EpiBf16 E{(pg8::bf16_t*)(F.ws + WS_QK), 2048, 0, nullptr};
          pg8::gemm_phase<pg8::EpiBf16, pg8::DenseOrder, true>(F.lds, DM, S, E); }
        { pg8::DenseOrder S; S.init(F.ws + WS_HB, F.ws + WS_WIN, MT, 4096, DM, 8, F.G, F.bid);
          pg8::EpiTransBf16 E{(pg8::bf16_t*)(F.ws + WS_XT), MT, 8};
          pg8::gemm_phase<pg8::EpiTransBf16, pg8::DenseOrder, true>(F.lds, DM, S, E); }
    } SEAM(PH_G1);
    if (IN(PH_FILT)) { phase_filters(F); } SEAM(PH_FILT);
    if (IN(PH_P15)) { phase_p15(F); } SEAM(PH_P15);
    if (IN(PH_ATTN)) { __syncthreads(); phase_hyena(F); phase_attn(F); } SEAM(PH_ATTN);
    if (IN(PH_P25)) { __syncthreads(); phase_p25(F); } SEAM(PH_P25);
    if (IN(PH_OUT)) {
        __syncthreads();
        pg8::DenseOrder S; S.init(F.ws + WS_MIXED, F.ws + WS_WOUT, MT, DM, DM, 0, F.G, F.bid);
        pg8::EpiResF32 E{F.in[0], F.out, DM};
        pg8::gemm_phase<pg8::EpiResF32, pg8::DenseOrder, false>(F.lds, DM, S, E);
    } SEAM(PH_OUT);
    if (IN(PH_P35)) { __syncthreads(); phase_p35(F); } SEAM(PH_P35);
    if (IN(PH_P4)) { __syncthreads(); phase_p4(F); } SEAM(PH_P4);
    if (IN(PH_UP)) {
        __syncthreads();
        pg8::MoeOrder S; S.init(F.ws + WS_XG, F.ws + WS_WGU, DM, F.G, F.bid);
        pg8::EpiSwiGLU E{(pg8::bf16_t*)(F.ws + WS_ACT)};
        pg8::gemm_phase<pg8::EpiSwiGLU, pg8::MoeOrder, true>(F.lds, DM, S, E);
    } SEAM(PH_UP);
    if (IN(PH_DOWN)) {
        __syncthreads();
        pg8::MoeOrder S; S.init(F.ws + WS_ACT, F.ws + WS_WD, FF, F.G, F.bid);
        pg8::EpiBf16 E{(pg8::bf16_t*)(F.ws + WS_YE), DM, 512, (const float*)(F.ws + WS_GATE)};
        pg8::gemm_phase<pg8::EpiBf16, pg8::MoeOrder, true>(F.lds, FF, S, E);
    } SEAM(PH_DOWN);
    if (IN(PH_P7)) { phase_p7(F); }
#undef IN
#undef SEAM
}

extern "C" void kernel_launch(void* const* d_in, const int* in_sizes, int n_in, void* d_out, int out_size, void* d_ws, size_t ws_size, hipStream_t stream) {
    static int grid = 0;
    if (grid == 0) {
        if (n_in != 23 || ws_size < WS_END) { fprintf(stderr, "kernel_launch: unexpected inputs (n_in %d, ws %zu)\n", n_in, ws_size); grid = -1; return; }
        if (hipFuncSetAttribute((const void*)mk_fwd, hipFuncAttributeMaxDynamicSharedMemorySize, LDS_BYTES) != hipSuccess) { fprintf(stderr, "kernel_launch: hipFuncSetAttribute failed\n"); grid = -1; return; }
        int dev = 0, cus = 0, per_cu = 0;
        hipGetDevice(&dev); hipDeviceGetAttribute(&cus, hipDeviceAttributeMultiprocessorCount, dev);
        hipOccupancyMaxActiveBlocksPerMultiprocessor(&per_cu, (const void*)mk_fwd, NTHREADS, LDS_BYTES);
        (void)hipGetLastError();
        if (per_cu < 1) { fprintf(stderr, "kernel_launch: occupancy query says %d blocks/CU\n", per_cu); }
        grid = cus;
    }
    if (grid < 0) return;
    Args a{};
    for (int i = 0; i < 23; ++i) a.in[i] = (const float*)d_in[i];
    a.out = (float*)d_out; a.ws = (unsigned char*)d_ws;
#if MK_N_LAUNCHES == 1
    if (hipMemsetAsync((char*)d_ws + WS_CTL, 0, CTL_ZERO_BYTES, stream) != hipSuccess) { fprintf(stderr, "kernel_launch: memset failed\n"); return; }
    a.ph_lo = 0; a.ph_hi = PH_COUNT;
    void* kargs[] = {&a};
    hipError_t e = hipLaunchCooperativeKernel((const void*)mk_fwd, dim3(grid), dim3(NTHREADS), kargs, LDS_BYTES, stream);
    if (e != hipSuccess) fprintf(stderr, "cooperative launch failed: %s (grid %d)\n", hipGetErrorString(e), grid);
#else
    for (int p = 0; p < PH_COUNT; ++p) { a.ph_lo = p; a.ph_hi = p + 1; hipLaunchKernelGGL(mk_fwd, dim3(grid), dim3(NTHREADS), LDS_BYTES, stream, a); }
#endif
}
```

```cpp
#include <hip/hip_runtime.h>
#include <hip/hip_cooperative_groups.h>
#include <cstdio>
#include <cstdint>
namespace cg = cooperative_groups;

#ifndef REP_PHASE
#define REP_PHASE -1
#define REP_N 1
#define REP_SUB 0
#endif
#ifndef MK_N_LAUNCHES
#define MK_N_LAUNCHES 1
#endif

namespace pg8 {
#define PG8_LAS __attribute__((address_space(3)))
typedef unsigned short bf16_t;
typedef short bf16x8 __attribute__((ext_vector_type(8)));
typedef float f32x4 __attribute__((ext_vector_type(4)));
typedef unsigned u32x4 __attribute__((ext_vector_type(4)));
typedef unsigned u32x2 __attribute__((ext_vector_type(2)));
constexpr int BM = 256, BK = 64, HALF = 128, HTB = HALF * BK * 2, STAGE_BYTES = 8 * HTB, NXCD = 8, WGM = 8;

__host__ __device__ __forceinline__ int lds_byte(int r, int c) { const int st = (r >> 4) * 2 + (c >> 5), rr = r & 15, cc = c & 31, ob = rr * 64 + cc * 2; return st * 1024 + (ob ^ (((ob >> 9) & 1) << 5)); }
__host__ __device__ __forceinline__ void stage_rc(int b, int& R, int& C) { const int st = b / 1024, sb = b % 1024, swz = sb ^ (((sb >> 9) & 1) << 5); R = (st >> 1) * 16 + swz / 64; C = (st & 1) * 32 + (swz % 64) / 2; }
__host__ __device__ __forceinline__ int perm32(int rho) { const int n = rho >> 4, i = rho & 15; return 8 * (i >> 2) + 4 * n + (i & 3); }

struct Unit { int pm, pn, g; const char* a; const char* b; };

__device__ __forceinline__ unsigned cvt_pk_bf16(float lo, float hi) { unsigned r; asm volatile("v_cvt_pk_bf16_f32 %0, %1, %2" : "=v"(r) : "v"(lo), "v"(hi)); return r; }

struct DenseOrder {
    int nM, nN, nwg, G, c, K, pn0; const char* A; const char* Bt;
    __device__ void init(const void* A_, const void* Bt_, int M, int N, int K_, int pn0_, int G_, int c_) { A = (const char*)A_; Bt = (const char*)Bt_; nM = M / BM; nN = N / BM; nwg = nM * nN; G = G_; c = c_; K = K_; pn0 = pn0_; }
    __device__ bool next(int i, Unit& u) const {
        const long L = (long)i * G + c; if (L >= nwg) return false;
        int wgid = (int)L; { const int q = nwg / NXCD, r = nwg % NXCD, xcd = wgid % NXCD, off = wgid / NXCD; wgid = (xcd < r ? xcd * (q + 1) : r * (q + 1) + (xcd - r) * q) + off; }
        const int nig = WGM * nN, gid = wgid / nig, fm = gid * WGM, gsz = (nM - fm) < WGM ? (nM - fm) : WGM;
        u.pm = fm + ((wgid % nig) % gsz); u.pn = pn0 + (wgid % nig) / gsz; u.g = 0;
        u.a = A + (size_t)u.pm * BM * K * 2; u.b = Bt + (size_t)u.pn * BM * K * 2; return true;
    }
};
struct MoeOrder {
    int G, c, K; bool gather; const char* A; const char* Bt;
    __device__ void init(const void* A_, const void* Bt_, int K_, int G_, int c_, bool gather_) { A = (const char*)A_; Bt = (const char*)Bt_; K = K_; G = G_; c = c_; gather = gather_; }
    __device__ bool next(int i, Unit& u) const {
        const int L = i * G + c; if (L >= 512) return false;
        const int pn = L & 7, pm = (L >> 3) & 1, b = (L >> 4) & 1, e = L >> 5;
        u.pm = pm; u.pn = pn; u.g = b * 16 + e;
        u.a = gather ? A : A + (size_t)(u.g * 512 + pm * BM) * K * 2; u.b = Bt + (size_t)(e * 2048 + pn * BM) * K * 2; return true;
    }
};

struct EpiBf16 {
    static constexpr bool PERM = true, SWAP = false;
    bf16_t* O; int ldc; int grows; const float* rscale;
    __device__ __forceinline__ void operator()(const f32x4 (&acc)[2][2][4][2], const Unit& u, int wr, int wc, int fr, int fq) const {
        const int row0 = u.g * grows + u.pm * BM + wr * 64 + fr, col0 = u.pn * BM + wc * 32 + 8 * fq;
#pragma unroll
        for (int ai = 0; ai < 2; ++ai)
#pragma unroll
            for (int m = 0; m < 4; ++m) { const int row = row0 + ai * HALF + m * 16; bf16_t* rowp = O + (size_t)row * ldc + col0; const float sc = rscale ? rscale[row] : 1.f;
#pragma unroll
                for (int bj = 0; bj < 2; ++bj) { const f32x4 v0 = acc[ai][bj][m][0] * sc, v1 = acc[ai][bj][m][1] * sc;
                    u32x4 w; w.x = cvt_pk_bf16(v0[0], v0[1]); w.y = cvt_pk_bf16(v0[2], v0[3]); w.z = cvt_pk_bf16(v1[0], v1[1]); w.w = cvt_pk_bf16(v1[2], v1[3]);
                    *(u32x4*)(rowp + bj * HALF) = w; } }
    }
};
struct EpiSwiGLU {
    static constexpr bool PERM = true, SWAP = false;
    bf16_t* O;
    __device__ __forceinline__ void operator()(const f32x4 (&acc)[2][2][4][2], const Unit& u, int wr, int wc, int fr, int fq) const {
        const int row0 = u.g * 512 + u.pm * BM + wr * 64 + fr, col0 = u.pn * HALF + wc * 32 + 8 * fq;
#pragma unroll
        for (int ai = 0; ai < 2; ++ai)
#pragma unroll
            for (int m = 0; m < 4; ++m) { bf16_t* rowp = O + (size_t)(row0 + ai * HALF + m * 16) * 1024 + col0;
                float r[8];
#pragma unroll
                for (int n = 0; n < 2; ++n)
#pragma unroll
                    for (int e = 0; e < 4; ++e) { const float g = acc[ai][0][m][n][e], up = acc[ai][1][m][n][e]; r[n * 4 + e] = g / (1.f + __expf(-g)) * up; }
                u32x4 w; w.x = cvt_pk_bf16(r[0], r[1]); w.y = cvt_pk_bf16(r[2], r[3]); w.z = cvt_pk_bf16(r[4], r[5]); w.w = cvt_pk_bf16(r[6], r[7]);
                *(u32x4*)rowp = w; }
    }
};
struct EpiResF32 {
    static constexpr bool PERM = false, SWAP = false;
    const float* res; float* out; int ldc;
    __device__ __forceinline__ void operator()(const f32x4 (&acc)[2][2][4][2], const Unit& u, int wr, int wc, int fr, int fq) const {
        const int row0 = u.pm * BM + wr * 64 + fr, col0 = u.pn * BM + wc * 32 + 4 * fq;
#pragma unroll
        for (int ai = 0; ai < 2; ++ai)
#pragma unroll
            for (int m = 0; m < 4; ++m) { const size_t off = (size_t)(row0 + ai * HALF + m * 16) * ldc + col0;
#pragma unroll
                for (int bj = 0; bj < 2; ++bj)
#pragma unroll
                    for (int n = 0; n < 2; ++n) { const f32x4 r = *(const f32x4*)(res + off + bj * HALF + n * 16); *(f32x4*)(out + off + bj * HALF + n * 16) = r + acc[ai][bj][m][n]; } }
    }
};
struct EpiTransBf16 {
    static constexpr bool PERM = false, SWAP = true;
    bf16_t* O; int ldt; int pn_base;
    __device__ __forceinline__ void operator()(const f32x4 (&acc)[2][2][4][2], const Unit& u, int wr, int wc, int fr, int fq) const {
        const int ch0 = (u.pn - pn_base) * BM + wc * 32 + fr, t0 = u.pm * BM + wr * 64 + 4 * fq;
#pragma unroll
        for (int bj = 0; bj < 2; ++bj)
#pragma unroll
            for (int n = 0; n < 2; ++n) { bf16_t* chp = O + (size_t)(ch0 + bj * HALF + n * 16) * ldt + t0;
#pragma unroll
                for (int ai = 0; ai < 2; ++ai)
#pragma unroll
                    for (int m = 0; m < 4; ++m) { const f32x4 v = acc[ai][bj][m][n]; u32x2 w; w.x = cvt_pk_bf16(v[0], v[1]); w.y = cvt_pk_bf16(v[2], v[3]); *(u32x2*)(chp + ai * HALF + m * 16) = w; } }
    }
};

template <class Epi, class Sched, bool ALIGN_EPI = false, bool GATHER = false>
__device__ __forceinline__ void gemm_phase(PG8_LAS unsigned char* lds, const int K, const Sched& S, const Epi& E, const PG8_LAS int* ridx = nullptr) {
    const int tid = threadIdx.x, wid = __builtin_amdgcn_readfirstlane(tid >> 6), lane = tid & 63, wr = wid >> 2, wc = wid & 3, fr = lane & 15, fq = lane >> 4;
    const int nt = K / BK;
    unsigned vA0[2], vA1[2], vN0[2], vN1[2], voffB[2]; int stR[2], stC[2];
    const size_t kstep = (size_t)(BK * 2);
    const size_t hstep = (size_t)HALF * K * 2;
#pragma unroll
    for (int i = 0; i < 2; ++i) { int R, C; stage_rc(tid * 16 + i * 8192, R, C); const int Rb = Epi::PERM ? ((R & ~31) + perm32(R & 31)) : R; stR[i] = R; stC[i] = C;
        voffB[i] = (unsigned)(Rb * K + C) * 2u;
        if constexpr (GATHER) { vA0[i] = (unsigned)(ridx[R] * K + C) * 2u; vA1[i] = (unsigned)(ridx[HALF + R] * K + C) * 2u; }
        else { vA0[i] = (unsigned)(R * K + C) * 2u; vA1[i] = vA0[i] + (unsigned)hstep; }
        vN0[i] = vA0[i]; vN1[i] = vA1[i]; }
    const unsigned ldsw = (unsigned)wid * 1024u;
    const int aoff = lds_byte(wr * 64 + fr, fq * 8), boff = lds_byte(wc * 32 + fr, fq * 8);
#define PG8_SA(b, h) (((b) * 2 + (h)) * HTB)
#define PG8_SB(b, h) ((4 + (b) * 2 + (h)) * HTB)
#define PG8_STAGE(bufoff, gbase, voff) do { _Pragma("unroll") for (int _i = 0; _i < 2; ++_i) \
        __builtin_amdgcn_global_load_lds((const unsigned*)((const char*)(gbase) + (voff)[_i]), (PG8_LAS unsigned*)(lds + (bufoff) + ldsw + _i * 8192), 16, 0, 0); } while (0)
#define PG8_LDA(dst, b, h) do { _Pragma("unroll") for (int m = 0; m < 4; ++m) _Pragma("unroll") for (int k = 0; k < 2; ++k) dst[m][k] = *(const PG8_LAS bf16x8*)(lds + PG8_SA(b, h) + aoff + m * 2048 + k * 1024); } while (0)
#define PG8_LDB(dst, b, h) do { _Pragma("unroll") for (int n = 0; n < 2; ++n) _Pragma("unroll") for (int k = 0; k < 2; ++k) dst[n][k] = *(const PG8_LAS bf16x8*)(lds + PG8_SB(b, h) + boff + n * 2048 + k * 1024); } while (0)
#define PG8_MMA(ai, bj, At, Bt) do { __builtin_amdgcn_s_setprio(1); _Pragma("unroll") for (int m = 0; m < 4; ++m) _Pragma("unroll") for (int n = 0; n < 2; ++n) _Pragma("unroll") for (int k = 0; k < 2; ++k) \
        acc[ai][bj][m][n] = Epi::SWAP ? __builtin_amdgcn_mfma_f32_16x16x32_bf16(At[m][k], Bt[n][k], acc[ai][bj][m][n], 0, 0, 0) : __builtin_amdgcn_mfma_f32_16x16x32_bf16(Bt[n][k], At[m][k], acc[ai][bj][m][n], 0, 0, 0); __builtin_amdgcn_s_setprio(0); } while (0)
#define PG8_WAIT_V(n) asm volatile("s_waitcnt vmcnt(" #n ")" ::: "memory")
#define PG8_WAIT_L(n) asm volatile("s_waitcnt lgkmcnt(" #n ")" ::: "memory")
#define PG8_BAR __builtin_amdgcn_s_barrier()
#define PG8_SCHED __builtin_amdgcn_sched_barrier(0)
    Unit cur, nxt; int ui = 0;
    if (!S.next(0, cur)) return;
    f32x4 acc[2][2][4][2];
#pragma unroll
    for (int a = 0; a < 2; ++a)
#pragma unroll
        for (int b = 0; b < 2; ++b)
#pragma unroll
            for (int m = 0; m < 4; ++m)
#pragma unroll
                for (int n = 0; n < 2; ++n) acc[a][b][m][n] = (f32x4){0.f, 0.f, 0.f, 0.f};
    bf16x8 At[4][2], B0[2][2], B1[2][2];
    const char* cA = cur.a; const char* cB = cur.b;
    PG8_STAGE(PG8_SB(0, 0), cB, voffB); PG8_STAGE(PG8_SB(0, 1), cB + hstep, voffB); PG8_STAGE(PG8_SA(0, 0), cA, vA0); PG8_STAGE(PG8_SA(0, 1), cA, vA1);
    if (wr == 1) PG8_BAR;
    PG8_WAIT_V(2); PG8_BAR;
    PG8_STAGE(PG8_SB(1, 0), cB + kstep, voffB); PG8_STAGE(PG8_SA(1, 0), cA + kstep, vA0); PG8_STAGE(PG8_SB(1, 1), cB + hstep + kstep, voffB);
    PG8_WAIT_V(6); PG8_BAR;
    for (;;) {
        const bool has_next = S.next(ui + 1, nxt);
        const char* nA = has_next ? nxt.a : cA; const char* nB = has_next ? nxt.b : cB;
        if constexpr (GATHER) { if (has_next) {
#pragma unroll
            for (int i = 0; i < 2; ++i) { vN0[i] = (unsigned)(ridx[(ui + 1) * 256 + stR[i]] * K + stC[i]) * 2u; vN1[i] = (unsigned)(ridx[(ui + 1) * 256 + HALF + stR[i]] * K + stC[i]) * 2u; } } }
        for (int t = 0; t < nt; t += 2) {
            const bool last = (t == nt - 2);
            const char* a1 = cA + (size_t)(t + 1) * kstep;
            const char* a2 = last ? nA : cA + (size_t)(t + 2) * kstep; const char* b2 = last ? nB : cB + (size_t)(t + 2) * kstep;
            const char* a3 = a2 + kstep; const char* b3 = b2 + kstep;
            unsigned w0[2], w1[2];
#pragma unroll
            for (int i = 0; i < 2; ++i) { w0[i] = last ? vN0[i] : vA0[i]; w1[i] = last ? vN1[i] : vA1[i]; }
            PG8_LDB(B0, 0, 0); PG8_LDB(B1, 0, 1); PG8_SCHED; PG8_LDA(At, 0, 0); PG8_STAGE(PG8_SA(1, 1), a1, vA1);
            PG8_WAIT_V(8); PG8_WAIT_L(0); PG8_BAR; PG8_MMA(0, 0, At, B0); PG8_MMA(0, 1, At, B1); PG8_BAR; PG8_SCHED;
            PG8_LDA(At, 0, 1); PG8_STAGE(PG8_SB(0, 0), b2, voffB); PG8_STAGE(PG8_SB(0, 1), b2 + hstep, voffB); PG8_STAGE(PG8_SA(0, 0), a2, w0);
            PG8_WAIT_V(8); PG8_WAIT_L(0); PG8_BAR; PG8_MMA(1, 0, At, B0); PG8_MMA(1, 1, At, B1); PG8_BAR; PG8_SCHED;
            PG8_LDB(B0, 1, 0); PG8_LDB(B1, 1, 1); PG8_SCHED; PG8_LDA(At, 1, 0); PG8_STAGE(PG8_SA(0, 1), a2, w1);
            PG8_WAIT_V(8); PG8_WAIT_L(0); PG8_BAR; PG8_MMA(0, 0, At, B0); PG8_MMA(0, 1, At, B1); PG8_BAR; PG8_SCHED;
            PG8_LDA(At, 1, 1); PG8_STAGE(PG8_SB(1, 0), b3, voffB); PG8_STAGE(PG8_SB(1, 1), b3 + hstep, voffB); PG8_STAGE(PG8_SA(1, 0), a3, w0);
            PG8_WAIT_V(8); PG8_WAIT_L(0); PG8_BAR; PG8_MMA(1, 0, At, B0); PG8_MMA(1, 1, At, B1); PG8_BAR; PG8_SCHED;
        }
        if constexpr (ALIGN_EPI) { if (wr == 0) PG8_BAR; }
        E(acc, cur, wr, wc, fr, fq);
        if (!has_next) break;
#pragma unroll
        for (int a = 0; a < 2; ++a)
#pragma unroll
            for (int b = 0; b < 2; ++b)
#pragma unroll
                for (int m = 0; m < 4; ++m)
#pragma unroll
                    for (int n = 0; n < 2; ++n) acc[a][b][m][n] = (f32x4){0.f, 0.f, 0.f, 0.f};
        cur = nxt; cA = nA; cB = nB; ++ui;
#pragma unroll
        for (int i = 0; i < 2; ++i) { vA0[i] = vN0[i]; vA1[i] = vN1[i]; }
        if constexpr (ALIGN_EPI) { if (wr == 1) PG8_BAR; }
    }
    PG8_WAIT_V(0);
    if constexpr (!ALIGN_EPI) { if (wr == 0) PG8_BAR; }
    PG8_BAR;
#undef PG8_SA
#undef PG8_SB
#undef PG8_STAGE
#undef PG8_LDA
#undef PG8_LDB
#undef PG8_MMA
#undef PG8_WAIT_V
#undef PG8_WAIT_L
#undef PG8_BAR
#undef PG8_SCHED
}
}

constexpr int NB = 2, SEQ = 4096, DM = 2048, MT = NB * SEQ;
constexpr int NH = 8, HD = 128, AW = 1024, HW = 1024, INW = 6144;
constexpr int GW = 64, NROWS = 64, WR = 8, WC = 16;
constexpr int NE = 16, CAP = 512, FF = 1024;
constexpr int FEMB = 33, FHID = 64;
constexpr float EPS = 1e-6f;
constexpr int NWAVES = 8, NTHREADS = 512;

constexpr size_t MiB = 1u << 20;
constexpr size_t WS_CTL = 0, CTL_ZERO_BYTES = 1 * MiB;
constexpr size_t WS_WIN = 2 * MiB;
constexpr size_t WS_WOUT = 26 * MiB;
constexpr size_t WS_WGU = 34 * MiB;
constexpr size_t WS_WD = 162 * MiB;
constexpr size_t WS_W3T = 226 * MiB;
constexpr size_t WS_HID2 = 227 * MiB;
constexpr size_t WS_HB = 228 * MiB;
constexpr size_t WS_QK = 260 * MiB;
constexpr size_t WS_XT = 292 * MiB;
constexpr size_t WS_UC = 356 * MiB;
constexpr size_t WS_TAPS = 404 * MiB;
constexpr size_t WS_HYT = 436 * MiB;
constexpr size_t WS_MIXED = 452 * MiB;
constexpr size_t WS_AFF = 484 * MiB;
constexpr size_t WS_IDX = 485 * MiB;
constexpr size_t WS_GATE = 486 * MiB;
constexpr size_t WS_SEL = 487 * MiB;
constexpr size_t WS_Z1T = 488 * MiB;
constexpr size_t WS_XG = WS_XT;
constexpr size_t WS_ACT = WS_UC;
constexpr size_t WS_YE = WS_TAPS;
constexpr size_t WS_END = 504 * MiB;

constexpr int LDS_BYTES = 163840, LDS_MISC_OFF = 163840 - 128;

#define GAS __attribute__((address_space(1)))
#define LAS __attribute__((address_space(3)))
typedef unsigned short bf16;
typedef unsigned v4u __attribute__((ext_vector_type(4)));
typedef unsigned v2u __attribute__((ext_vector_type(2)));
typedef float f32x4 __attribute__((ext_vector_type(4)));
#define LDS_WAIT() asm volatile("s_waitcnt lgkmcnt(0)" ::: "memory")
#define VM_WAIT() asm volatile("s_waitcnt vmcnt(0)" ::: "memory")
__device__ __forceinline__ unsigned f2bf(float f) { unsigned u = __builtin_bit_cast(unsigned, f); return (u + 0x7fffu + ((u >> 16) & 1u)) >> 16; }
__device__ __forceinline__ unsigned pk2(float lo, float hi) { return f2bf(lo) | (f2bf(hi) << 16); }
__device__ __forceinline__ float bf2f(unsigned h) { return __builtin_bit_cast(float, h << 16); }
__device__ __forceinline__ float bflo(unsigned w) { return __builtin_bit_cast(float, w << 16); }
__device__ __forceinline__ float bfhi(unsigned w) { return __builtin_bit_cast(float, w & 0xffff0000u); }
__device__ __forceinline__ float wave_sum(float v) {
#pragma unroll
    for (int o = 1; o < 64; o <<= 1) v += __shfl_xor(v, o);
    return v;
}


#define XB_TMO      128
#define XB_XCNT(j)  (256  + 64 * (j))
#define XB_XSUB(j)  (1280 + 64 * (j))
#define XB_XGEN(j)  (2304 + 64 * (j))
#define XB_TOP      3328
#define XB_TOPGEN   3392
#define XCD_BAR_WORDS 3456
#define XB_SPIN_CAP (1u << 22)
__device__ __forceinline__ unsigned xb_ld(unsigned* p)              { return __hip_atomic_load(p, __ATOMIC_RELAXED, __HIP_MEMORY_SCOPE_AGENT); }
__device__ __forceinline__ unsigned xb_add(unsigned* p, unsigned v) { return __hip_atomic_fetch_add(p, v, __ATOMIC_RELAXED, __HIP_MEMORY_SCOPE_AGENT); }
__device__ __forceinline__ unsigned xb_xcc_id() { return (unsigned)__builtin_amdgcn_s_getreg((3 << 11) | 20) & 0xFu; }
#define XB_SPIN(cond, bar) do { unsigned _sp = 0; while (cond) { __builtin_amdgcn_s_sleep(1); \
    if ((++_sp & 255u) == 0u) { if (xb_ld(&(bar)[XB_TMO])) break; if (_sp > XB_SPIN_CAP) { atomicAdd(&(bar)[XB_TMO], 1u); break; } } } } while (0)
struct XcdBarrier { unsigned* bar; unsigned x; volatile LAS unsigned* st; };
__device__ __forceinline__ XcdBarrier xcd_barrier_post(unsigned* bar, volatile LAS unsigned* st) {
    XcdBarrier b; b.bar = bar; b.x = xb_xcc_id(); b.st = st;
    if (threadIdx.x == 0) (void)xb_add(&bar[XB_XCNT(b.x)], 1u);
    return b;
}
__device__ __forceinline__ void xcd_barrier_complete(unsigned* bar, unsigned x, unsigned& nloc, unsigned& nx) {
    const unsigned G = gridDim.x * gridDim.y * gridDim.z;
    unsigned sum, cnt, mine, sp = 0u;
    for (;;) {
        sum = 0u; cnt = 0u; mine = 0u;
#pragma unroll
        for (unsigned j = 0; j < 16; ++j) { const unsigned c = xb_ld(&bar[XB_XCNT(j)]); sum += c; cnt += (c > 0u) ? 1u : 0u; mine = (j == x) ? c : mine; }
        if (sum == G) break;
        __builtin_amdgcn_s_sleep(1);
        if ((++sp & 255u) == 0u) { if (xb_ld(&bar[XB_TMO])) break; if (sp > XB_SPIN_CAP) { atomicAdd(&bar[XB_TMO], 1u); break; } }
    }
    nloc = mine > 0u ? mine : 1u; nx = cnt > 0u ? cnt : 1u;
}
__device__ __forceinline__ void xcd_barrier(const XcdBarrier& b) {
    asm volatile("s_waitcnt vmcnt(0)" ::: "memory");
    __syncthreads();
    if (threadIdx.x == 0) {
        unsigned* bar = b.bar;
        __builtin_amdgcn_s_waitcnt(0);
        unsigned nloc = b.st[0], nx = b.st[1];
        if (nloc == 0u) { xcd_barrier_complete(bar, b.x, nloc, nx); b.st[0] = nloc; b.st[1] = nx; }
        const unsigned old = xb_add(&bar[XB_XSUB(b.x)], 1u);
        const unsigned gen = old / nloc;
        if (old + 1u == (gen + 1u) * nloc) {
            __builtin_amdgcn_fence(__ATOMIC_RELEASE, "agent");
            asm volatile("s_waitcnt vmcnt(0)" ::: "memory");
            const unsigned og = xb_add(&bar[XB_TOP], 1u);
            const unsigned tg = og / nx;
            if (og + 1u == (tg + 1u) * nx) xb_add(&bar[XB_TOPGEN], 1u);
            else XB_SPIN(xb_ld(&bar[XB_TOPGEN]) == tg, bar);
            __builtin_amdgcn_fence(__ATOMIC_ACQUIRE, "agent");
            xb_add(&bar[XB_XGEN(b.x)], 1u);
            asm volatile("s_waitcnt vmcnt(0)" ::: "memory");
        } else {
            XB_SPIN(xb_ld(&bar[XB_XGEN(b.x)]) == gen, bar);
            __builtin_amdgcn_fence(__ATOMIC_ACQUIRE, "agent");
            asm volatile("s_waitcnt vmcnt(0)" ::: "memory");
        }
    }
    __syncthreads();
}

struct Frame {
    LAS unsigned char* lds;
    int tid, lane, wave, G, bid;
    const float* in[23]; float* out; unsigned char* ws;
};
#define GW_ID(F) ((F).bid * NWAVES + (F).wave)
#define GW_N(F) ((F).G * NWAVES)

__device__ __forceinline__ void p0_transpose_item(const float* W, int K, int N, bf16* WT, int row_base, int k0, int n0, LAS float* scr, int lane) {
#pragma unroll 8
    for (int i = 0; i < 32; ++i) { const int kk = 2 * i + (lane >> 5); scr[kk * 33 + (lane & 31)] = W[(size_t)(k0 + kk) * N + n0 + (lane & 31)]; }
    LDS_WAIT(); asm volatile("" ::: "memory");
    const int c = lane & 7;
#pragma unroll
    for (int j = 0; j < 4; ++j) { const int n = (lane >> 3) + 8 * j; const LAS float* s = scr + (8 * c) * 33 + n;
        v4u o; o.x = pk2(s[0 * 33], s[1 * 33]); o.y = pk2(s[2 * 33], s[3 * 33]); o.z = pk2(s[4 * 33], s[5 * 33]); o.w = pk2(s[6 * 33], s[7 * 33]);
        *(GAS v4u*)(WT + (size_t)(row_base + n) * K + k0 + 8 * c) = o; }
    LDS_WAIT(); asm volatile("" ::: "memory");
}
__device__ __forceinline__ void phase_p0(Frame& F) {
    LAS float* scr = (LAS float*)(F.lds + F.wave * 16384);
    const int gw = GW_ID(F), NGW = GW_N(F);
    bf16* WinT = (bf16*)(F.ws + WS_WIN); bf16* WoutT = (bf16*)(F.ws + WS_WOUT); bf16* WguT = (bf16*)(F.ws + WS_WGU); bf16* WdT = (bf16*)(F.ws + WS_WD); bf16* W3T = (bf16*)(F.ws + WS_W3T);
    constexpr int I_IN = (DM / 64) * (INW / 32), I_OUT = (DM / 64) * (DM / 32), I_G = (DM / 64) * (FF / 32), I_D = (FF / 64) * (DM / 32), I_3 = 1 * (4096 / 32);
    constexpr int NITEMS = I_IN + I_OUT + 2 * NE * I_G + NE * I_D + I_3;
    for (int it = gw; it < NITEMS; it += NGW) {
        int r = it;
        if (r < I_IN) { const int nblk = INW / 32, kb = r / nblk, nb = r % nblk; p0_transpose_item(F.in[2], DM, INW, WinT, 32 * nb, 64 * kb, 32 * nb, scr, F.lane); continue; } r -= I_IN;
        if (r < I_OUT) { const int nblk = DM / 32, kb = r / nblk, nb = r % nblk; p0_transpose_item(F.in[17], DM, DM, WoutT, 32 * nb, 64 * kb, 32 * nb, scr, F.lane); continue; } r -= I_OUT;
        if (r < 2 * NE * I_G) { const int which = r / (NE * I_G); r %= NE * I_G; const int e = r / I_G; r %= I_G; const int nblk = FF / 32, kb = r / nblk, nb = r % nblk, f0 = 32 * nb;
            const float* W = (which ? F.in[21] : F.in[20]) + (size_t)e * DM * FF;
            const int row_base = e * 2048 + (f0 >> 7) * 256 + which * 128 + (f0 & 127);
            p0_transpose_item(W, DM, FF, WguT, row_base, 64 * kb, f0, scr, F.lane); continue; } r -= 2 * NE * I_G;
        if (r < NE * I_D) { const int e = r / I_D; r %= I_D; const int nblk = DM / 32, kb = r / nblk, nb = r % nblk;
            p0_transpose_item(F.in[22] + (size_t)e * FF * DM, FF, DM, WdT, e * 2048 + 32 * nb, 64 * kb, 32 * nb, scr, F.lane); continue; } r -= NE * I_D;
        { const int nb = r; p0_transpose_item(F.in[12], FHID, 4096, W3T, 32 * nb, 0, 32 * nb, scr, F.lane); }
    }
    bf16* HB = (bf16*)(F.ws + WS_HB);
    const float* x = F.in[0]; const float* g = F.in[1];
    for (int m = gw; m < MT; m += NGW) {
        const GAS f32x4* xr = (const GAS f32x4*)(x + (size_t)m * DM) + F.lane;
        f32x4 v[8]; float s = 0.f;
#pragma unroll
        for (int j = 0; j < 8; ++j) { v[j] = xr[64 * j]; s += (v[j].x * v[j].x + v[j].y * v[j].y) + (v[j].z * v[j].z + v[j].w * v[j].w); }
        const float r = rsqrtf(wave_sum(s) * (1.f / DM) + EPS);
        GAS v2u* o8 = (GAS v2u*)(HB + (size_t)m * DM) + F.lane;
#pragma unroll
        for (int j = 0; j < 8; ++j) { const f32x4 gg = *((const GAS f32x4*)g + F.lane + 64 * j); v2u o; o.x = pk2(v[j].x * r * gg.x, v[j].y * r * gg.y); o.y = pk2(v[j].z * r * gg.z, v[j].w * r * gg.w); o8[64 * j] = o; }
    }
    float* HID2 = (float*)(F.ws + WS_HID2);
    LAS float* sc2 = (LAS float*)(F.lds + F.wave * 16384);
    const float* w1 = F.in[8]; const float* b1 = F.in[9]; const float* w2 = F.in[10]; const float* b2 = F.in[11]; const float* fr = F.in[13];
    for (int l = gw; l < SEQ; l += NGW) {
        const int j = F.lane;
        float zv = 0.f;
        if (j == 0) zv = (float)l / (float)(SEQ - 1);
        else if (j < FEMB) { const int k = (j - 1) & 15; const float f = 1e-4f + (float)k * ((15.0f - 1e-4f) / 15.0f); const float wv = 6.283185307179586f * (float)l / (float)SEQ; zv = (j <= 16) ? cosf(f * wv) : -sinf(f * wv); }
        sc2[j] = zv; LDS_WAIT(); asm volatile("" ::: "memory");
        float a = b1[j];
        for (int i = 0; i < FEMB; ++i) a += sc2[i] * w1[i * FHID + j];
        const float h1 = sinf(fr[j] * a);
        sc2[64 + j] = h1; LDS_WAIT(); asm volatile("" ::: "memory");
        float c = b2[j];
        for (int i = 0; i < FHID; ++i) c += sc2[64 + i] * w2[i * FHID + j];
        HID2[l * FHID + j] = sinf(fr[j] * c);
        LDS_WAIT(); asm volatile("" ::: "memory");
    }
}

__device__ __forceinline__ void phase_filters_naive(Frame& F) {
    const float* HID2 = (const float*)(F.ws + WS_HID2); const float* w3 = F.in[12]; const float* fbias = F.in[14]; bf16* TAPS = (bf16*)(F.ws + WS_TAPS);
    const size_t total = (size_t)SEQ * 4096;
    for (size_t i = (size_t)F.bid * NTHREADS + F.tid; i < total; i += (size_t)F.G * NTHREADS) {
        const int col = (int)(i & 4095), l = (int)(i >> 12);
        float a = 0.f;
        for (int k = 0; k < FHID; ++k) a += HID2[l * FHID + k] * w3[(size_t)k * 4096 + col];
        const int c = col & 1023, dir = (col >> 10) & 1, o = col >> 11;
        const float mind = -4.605170185988091f / 1.5f, maxd = -4.605170185988091f / 0.3f;
        const float delta = fabsf(mind + (maxd - mind) * ((float)c / 1023.0f));
        const float t = (float)l / (float)(SEQ - 1);
        float v = a * expf(-t * delta);
        bf16* tp = TAPS + ((size_t)c * 2 + o) * 8192;
        if (dir == 0) { if (l == 0) v += fbias[o * 1024 + c]; tp[4096 + l] = (bf16)f2bf(v); }
        else { if (l > 0) tp[4096 - l] = (bf16)f2bf(v); else tp[0] = 0; }
    }
}
__device__ __forceinline__ void phase_hyena_naive(Frame& F, int o) {
    const bf16* UC = (const bf16*)(F.ws + WS_UC); const bf16* TAPS = (const bf16*)(F.ws + WS_TAPS);
    bf16* Z1T = (bf16*)(F.ws + WS_Z1T); bf16* HYT = (bf16*)(F.ws + WS_HYT);
    const bf16* Zin = o == 0 ? UC + (size_t)2048 * MT : Z1T; const bf16* gate = UC + (size_t)(o * 1024) * MT; bf16* OUT = o == 0 ? Z1T : HYT;
    const size_t total = (size_t)1024 * MT;
    for (size_t i = (size_t)F.bid * NTHREADS + F.tid; i < total; i += (size_t)F.G * NTHREADS) {
        const int c = (int)(i >> 13), m = (int)(i & 8191), b = m >> 12, t = m & 4095;
        const bf16* z = Zin + (size_t)c * MT + b * SEQ; const bf16* tp = TAPS + ((size_t)c * 2 + o) * 8192 + 4096 + t;
        float acc = 0.f;
        for (int s = 0; s < SEQ; ++s) acc += bf2f(tp[-s]) * bf2f(z[s]);
        OUT[(size_t)c * MT + m] = (bf16)f2bf(bf2f(gate[(size_t)c * MT + m]) * acc);
    }
}
__device__ __forceinline__ void phase_attn_naive(Frame& F) {
    const bf16* QK = (const bf16*)(F.ws + WS_QK); const bf16* VT = (const bf16*)(F.ws + WS_XT); bf16* MIXED = (bf16*)(F.ws + WS_MIXED);
    const float* rpb = F.in[5]; const float* og = F.in[15];
    const int lane = F.lane;
    for (int w = GW_ID(F); w < MT * NH; w += GW_N(F)) {
        const int m = w >> 3, h = w & 7, b = m / SEQ, s = m % SEQ, r = s / GW, c = s % GW;
        int kr0 = r - WR / 2; kr0 = kr0 < 0 ? 0 : (kr0 > NROWS - WR ? NROWS - WR : kr0);
        int c0 = c - WC / 2; c0 = c0 < 0 ? 0 : (c0 > GW - WC ? GW - WC : c0);
        const bf16* q = QK + (size_t)m * 2048 + h * HD;
        const float q0 = bf2f(q[lane]), q1 = bf2f(q[lane + 64]);
        float mx = -INFINITY, l = 0.f, a0 = 0.f, a1 = 0.f;
        for (int i = 0; i < WR; ++i) for (int j = 0; j < WC; ++j) {
            const int kr = kr0 + i, kc = c0 + j; const size_t km = (size_t)b * SEQ + kr * GW + kc;
            const bf16* kp = QK + km * 2048 + 1024 + h * HD;
            const float d = wave_sum(q0 * bf2f(kp[lane]) + q1 * bf2f(kp[lane + 64]));
            const int dr = kr - r + WR - 1; int dc = kc - c + WC - 1; dc = dc < 0 ? 0 : (dc > 2 * WC - 2 ? 2 * WC - 2 : dc);
            const float sc = d * 0.08838834764831845f + rpb[(h * (2 * WR - 1) + dr) * (2 * WC - 1) + dc];
            const float mn = fmaxf(mx, sc), corr = __expf(mx - mn), pw = __expf(sc - mn);
            const float v0 = bf2f(VT[(size_t)(h * HD + lane) * MT + km]), v1 = bf2f(VT[(size_t)(h * HD + lane + 64) * MT + km]);
            l = l * corr + pw; a0 = a0 * corr + pw * v0; a1 = a1 * corr + pw * v1; mx = mn;
        }
        a0 /= l; a1 /= l;
        const float rr = rsqrtf(wave_sum(a0 * a0 + a1 * a1) * (1.f / HD) + EPS);
        bf16* o = MIXED + (size_t)m * DM + h * HD;
        o[lane] = (bf16)f2bf(a0 * rr * og[h * HD + lane]); o[lane + 64] = (bf16)f2bf(a1 * rr * og[h * HD + lane + 64]);
    }
}


typedef short bf16x8 __attribute__((ext_vector_type(8)));
typedef float f32x16 __attribute__((ext_vector_type(16)));
__device__ __forceinline__ void phase_filters(Frame& F) {
    const float* HID2 = (const float*)(F.ws + WS_HID2); const bf16* W3T = (const bf16*)(F.ws + WS_W3T); const float* fbias = F.in[14]; bf16* TAPS = (bf16*)(F.ws + WS_TAPS);
    const int n = F.lane & 31, hh = F.lane >> 5;
    for (int it = GW_ID(F); it < 128 * 128; it += GW_N(F)) {
        const int col0 = (it >> 7) * 32, l0 = (it & 127) * 32;
        f32x16 acc;
#pragma unroll
        for (int i = 0; i < 16; ++i) acc[i] = 0.f;
#pragma unroll
        for (int ks = 0; ks < 4; ++ks) {
            const bf16x8 a = *(const GAS bf16x8*)(W3T + (size_t)(col0 + n) * FHID + 16 * ks + 8 * hh);
            const GAS f32x4* hp = (const GAS f32x4*)(HID2 + (size_t)(l0 + n) * FHID + 16 * ks + 8 * hh);
            const f32x4 h0 = hp[0], h1 = hp[1];
            v4u bw; bw.x = pk2(h0.x, h0.y); bw.y = pk2(h0.z, h0.w); bw.z = pk2(h1.x, h1.y); bw.w = pk2(h1.z, h1.w);
            acc = __builtin_amdgcn_mfma_f32_32x32x16_bf16(a, __builtin_bit_cast(bf16x8, bw), acc, 0, 0, 0);
        }
        const int l = l0 + n; const float t = (float)l / (float)(SEQ - 1);
        const int dir = (col0 >> 10) & 1, o = col0 >> 11;
        const float mind = -4.605170185988091f / 1.5f, maxd = -4.605170185988091f / 0.3f;
#pragma unroll
        for (int i = 0; i < 16; ++i) {
            const int c = (col0 & 1023) + (i & 3) + 8 * (i >> 2) + 4 * hh;
            const float delta = fabsf(mind + (maxd - mind) * ((float)c / 1023.0f));
            float v = acc[i] * __expf(-t * delta);
            bf16* tp = TAPS + ((size_t)c * 2 + o) * 8192;
            if (dir == 0) { if (l == 0) v += fbias[o * 1024 + c]; tp[4096 + l] = (bf16)f2bf(v); }
            else { if (l > 0) tp[4096 - l] = (bf16)f2bf(v); else tp[0] = 0; }
        }
    }
}

constexpr int HY_TAPS_BYTES = 4 * 16384, HY_ZB_ENT = 6080, HY_ZB_BYTES = HY_ZB_ENT * 2;
__device__ __forceinline__ unsigned hy_zb_off(int idx0  ) { const int q = idx0 >> 3; return (unsigned)((q ^ ((q >> 4) & 3)) << 4); }
template <int MASK>
__device__ __forceinline__ void hy_segment(f32x16 (&acc)[4], const LAS bf16* taps, const LAS unsigned char* zb, int g0, int g1, int n, int hh) {
    const unsigned sh = (n & 1) ? 0u : 2u;
#pragma unroll 2
    for (int g = g0; g < g1; ++g) {
        const volatile LAS unsigned* dp = (const volatile LAS unsigned*)taps + ((1 + 8 * hh + n) >> 1) + 8 * g;
        const unsigned d0 = dp[0], d1 = dp[1], d2 = dp[2], d3 = dp[3], d4 = dp[4];
        v4u aw; aw.x = __builtin_amdgcn_alignbyte(d1, d0, sh); aw.y = __builtin_amdgcn_alignbyte(d2, d1, sh); aw.z = __builtin_amdgcn_alignbyte(d3, d2, sh); aw.w = __builtin_amdgcn_alignbyte(d4, d3, sh);
        const bf16x8 a = __builtin_bit_cast(bf16x8, aw);
#pragma unroll
        for (int tau = 0; tau < 4; ++tau) if (MASK & (1 << tau)) {
            const bf16x8 b = *(const LAS bf16x8*)(zb + hy_zb_off(992 - 1024 * tau - 32 * n + 16 * g + 8 * hh));
            acc[tau] = __builtin_amdgcn_mfma_f32_32x32x16_bf16(a, b, acc[tau], 0, 0, 0);
        }
    }
}
__device__ __forceinline__ void hy_stage_taps(Frame& F, int c0, int o) {
    const bf16* TAPS = (const bf16*)(F.ws + WS_TAPS);
#pragma unroll
    for (int j = 0; j < 8; ++j) { const int ch = F.tid + NTHREADS * j, ci = ch >> 10, w = ch & 1023;
        *((LAS v4u*)(F.lds) + ch) = *((const GAS v4u*)(TAPS + ((size_t)(c0 + ci) * 2 + o) * 8192) + w); }
}
__device__ __forceinline__ void phase_hyena(Frame& F) {
    const bf16* UC = (const bf16*)(F.ws + WS_UC); bf16* HYT = (bf16*)(F.ws + WS_HYT);
    const int n = F.lane & 31, hh = F.lane >> 5, ci = F.wave >> 1, b = F.wave & 1;
    const LAS bf16* taps = (const LAS bf16*)(F.lds + ci * 16384);
    LAS unsigned char* zb = F.lds + HY_TAPS_BYTES + F.wave * HY_ZB_BYTES;
    for (int cg = F.bid; cg < 256; cg += F.G) {
        const int c0 = cg * 4, c = c0 + ci;
        __syncthreads();
        hy_stage_taps(F, c0, 0);
        { const bf16* zsrc = UC + (size_t)(2048 + c) * MT + b * SEQ;
#pragma unroll
          for (int j = 0; j < 8; ++j) { const int u = F.lane + 64 * j; const v4u w = *((const GAS v4u*)zsrc + u);
              v4u r; r.x = (w.w >> 16) | (w.w << 16); r.y = (w.z >> 16) | (w.z << 16); r.z = (w.y >> 16) | (w.y << 16); r.w = (w.x >> 16) | (w.x << 16);
              *(LAS v4u*)(zb + hy_zb_off(8 * (635 - u))) = r; }
          const v4u zero = {0u, 0u, 0u, 0u};
          for (int q = F.lane; q < 124; q += 64) { *(LAS v4u*)(zb + hy_zb_off(8 * q)) = zero; *(LAS v4u*)(zb + hy_zb_off(8 * (636 + q))) = zero; } }
        __syncthreads();
#pragma unroll 1
        for (int o = 0; o < 2; ++o) {
            f32x16 acc[4];
#pragma unroll
            for (int tau = 0; tau < 4; ++tau)
#pragma unroll
                for (int i = 0; i < 16; ++i) acc[tau][i] = 0.f;
            hy_segment<1>(acc, taps, zb, 0, 64, n, hh);
            hy_segment<3>(acc, taps, zb, 64, 128, n, hh);
            hy_segment<7>(acc, taps, zb, 128, 192, n, hh);
            hy_segment<15>(acc, taps, zb, 192, 318, n, hh);
            hy_segment<14>(acc, taps, zb, 318, 382, n, hh);
            hy_segment<12>(acc, taps, zb, 382, 446, n, hh);
            hy_segment<8>(acc, taps, zb, 446, 510, n, hh);
            const bf16* gate = UC + (size_t)(o * 1024 + c) * MT + b * SEQ;
            if (o == 0) {
                LDS_WAIT();
#pragma unroll
                for (int tau = 0; tau < 4; ++tau)
#pragma unroll
                    for (int rg = 0; rg < 4; ++rg) { const int t0 = 1024 * tau + 32 * n + 8 * rg + 4 * hh;
                        const v2u gw = *(const GAS v2u*)(gate + t0);
                        const float z0 = bflo(gw.x) * acc[tau][4 * rg + 0], z1 = bfhi(gw.x) * acc[tau][4 * rg + 1], z2 = bflo(gw.y) * acc[tau][4 * rg + 2], z3 = bfhi(gw.y) * acc[tau][4 * rg + 3];
                        v2u w; w.x = pk2(z3, z2); w.y = pk2(z1, z0);
                        *(LAS v2u*)(zb + hy_zb_off(8 * (635 - (t0 >> 3))) + (hh ? 0 : 8)) = w; }
                __syncthreads();
                hy_stage_taps(F, c0, 1);
                __syncthreads();
            } else {
                bf16* outp = HYT + (size_t)c * MT + b * SEQ;
#pragma unroll
                for (int tau = 0; tau < 4; ++tau)
#pragma unroll
                    for (int rg = 0; rg < 4; ++rg) { const int t0 = 1024 * tau + 32 * n + 8 * rg + 4 * hh;
                        const v2u gw = *(const GAS v2u*)(gate + t0);
                        v2u w; w.x = pk2(bflo(gw.x) * acc[tau][4 * rg + 0], bfhi(gw.x) * acc[tau][4 * rg + 1]); w.y = pk2(bflo(gw.y) * acc[tau][4 * rg + 2], bfhi(gw.y) * acc[tau][4 * rg + 3]);
                        *(GAS v2u*)(outp + t0) = w; }
            }
        }
    }
    __syncthreads();
}

__device__ __forceinline__ void phase_attn(Frame& F) {
    const bf16* QK = (const bf16*)(F.ws + WS_QK); const bf16* VT = (const bf16*)(F.ws + WS_XT); bf16* MIXED = (bf16*)(F.ws + WS_MIXED);
    const float* rpb = F.in[5]; const float* og = F.in[15];
    LAS float* rp = (LAS float*)(F.lds + F.wave * 2048);
    const int n = F.lane & 31, hh = F.lane >> 5;
    for (int task = GW_ID(F); task < NB * NH * NROWS * 2; task += GW_N(F)) {
        const int wq = task & 1, r = (task >> 1) & 63, h = (task >> 7) & 7, b = task >> 10;
        for (int i = F.lane; i < 15 * 31; i += 64) rp[i] = rpb[h * 465 + i];
        const int mq = b * SEQ + r * GW + 32 * wq + n, qc = 32 * wq + n;
        int c0 = qc - WC / 2; c0 = c0 < 0 ? 0 : (c0 > GW - WC ? GW - WC : c0);
        int kr0 = r - WR / 2; kr0 = kr0 < 0 ? 0 : (kr0 > NROWS - WR ? NROWS - WR : kr0);
        bf16x8 qf[8];
#pragma unroll
        for (int ks = 0; ks < 8; ++ks) qf[ks] = *(const GAS bf16x8*)(QK + (size_t)mq * 2048 + h * HD + 16 * ks + 8 * hh);
        f32x16 O[4];
#pragma unroll
        for (int dt = 0; dt < 4; ++dt)
#pragma unroll
            for (int i = 0; i < 16; ++i) O[dt][i] = 0.f;
        float lsum = 0.f;
        LDS_WAIT();
#pragma unroll 1
        for (int tile = 0; tile < 16; ++tile) {
            const int kr = kr0 + (tile >> 1), kt = tile & 1, dr = kr - r + WR - 1;
            const int mk0 = b * SEQ + kr * GW + 32 * kt;
            f32x16 S;
#pragma unroll
            for (int i = 0; i < 16; ++i) S[i] = 0.f;
#pragma unroll
            for (int ks = 0; ks < 8; ++ks) { const bf16x8 kf = *(const GAS bf16x8*)(QK + (size_t)(mk0 + n) * 2048 + 1024 + h * HD + 16 * ks + 8 * hh);
                S = __builtin_amdgcn_mfma_f32_32x32x16_bf16(kf, qf[ks], S, 0, 0, 0); }
            float p[16];
#pragma unroll
            for (int i = 0; i < 16; ++i) { const int kc = 32 * kt + (i & 3) + 8 * (i >> 2) + 4 * hh; const bool valid = (kc >= c0) && (kc < c0 + WC);
                int dc = kc - qc + WC - 1; dc = dc < 0 ? 0 : (dc > 2 * WC - 2 ? 2 * WC - 2 : dc);
                const float e = __expf(S[i] * 0.08838834764831845f + rp[dr * 31 + dc]); p[i] = valid ? e : 0.f; lsum += p[i]; }
            v4u pw0, pw1;
            pw0.x = pk2(p[0], p[1]); pw0.y = pk2(p[2], p[3]); pw0.z = pk2(p[4], p[5]); pw0.w = pk2(p[6], p[7]);
            pw1.x = pk2(p[8], p[9]); pw1.y = pk2(p[10], p[11]); pw1.z = pk2(p[12], p[13]); pw1.w = pk2(p[14], p[15]);
            const bf16x8 pf0 = __builtin_bit_cast(bf16x8, pw0), pf1 = __builtin_bit_cast(bf16x8, pw1);
#pragma unroll
            for (int dt = 0; dt < 4; ++dt) {
                const bf16* vrow = VT + (size_t)(h * HD + 32 * dt + n) * MT + mk0 + 4 * hh;
                const v2u a0 = *(const GAS v2u*)(vrow), a1 = *(const GAS v2u*)(vrow + 8), a2 = *(const GAS v2u*)(vrow + 16), a3 = *(const GAS v2u*)(vrow + 24);
                v4u f0, f1; f0.x = a0.x; f0.y = a0.y; f0.z = a1.x; f0.w = a1.y; f1.x = a2.x; f1.y = a2.y; f1.z = a3.x; f1.w = a3.y;
                O[dt] = __builtin_amdgcn_mfma_f32_32x32x16_bf16(__builtin_bit_cast(bf16x8, f0), pf0, O[dt], 0, 0, 0);
                O[dt] = __builtin_amdgcn_mfma_f32_32x32x16_bf16(__builtin_bit_cast(bf16x8, f1), pf1, O[dt], 0, 0, 0);
            }
        }
        lsum += __shfl_xor(lsum, 32);
        const float il = 1.f / lsum;
        float ss = 0.f;
#pragma unroll
        for (int dt = 0; dt < 4; ++dt)
#pragma unroll
            for (int i = 0; i < 16; ++i) { O[dt][i] *= il; ss += O[dt][i] * O[dt][i]; }
        ss += __shfl_xor(ss, 32);
        const float rr = rsqrtf(ss * (1.f / HD) + EPS);
        bf16* orow = MIXED + (size_t)mq * DM + h * HD;
#pragma unroll
        for (int dt = 0; dt < 4; ++dt)
#pragma unroll
            for (int rg = 0; rg < 4; ++rg) { const int d = 32 * dt + 8 * rg + 4 * hh; const f32x4 gg = *(const GAS f32x4*)(og + h * HD + d);
                v2u w; w.x = pk2(O[dt][4 * rg + 0] * rr * gg.x, O[dt][4 * rg + 1] * rr * gg.y); w.y = pk2(O[dt][4 * rg + 2] * rr * gg.z, O[dt][4 * rg + 3] * rr * gg.w);
                *(GAS v2u*)(orow + d) = w; }
        LDS_WAIT();
    }
}

__device__ __forceinline__ void phase_p15(Frame& F) {
    bf16* QK = (bf16*)(F.ws + WS_QK); const float* qg = F.in[3]; const float* kg = F.in[4];
    for (int m = GW_ID(F); m < MT; m += GW_N(F)) {
        GAS v4u* rowp = (GAS v4u*)(QK + (size_t)m * 2048) + F.lane;
#pragma unroll
        for (int j = 0; j < 4; ++j) {
            v4u w = rowp[64 * j];
            float f[8] = {bflo(w.x), bfhi(w.x), bflo(w.y), bfhi(w.y), bflo(w.z), bfhi(w.z), bflo(w.w), bfhi(w.w)};
            float ss = 0.f;
#pragma unroll
            for (int e = 0; e < 8; ++e) ss += f[e] * f[e];
            ss += __shfl_xor(ss, 1); ss += __shfl_xor(ss, 2); ss += __shfl_xor(ss, 4); ss += __shfl_xor(ss, 8);
            const float r = rsqrtf(ss * (1.f / HD) + EPS);
            const int col = 512 * j + 8 * F.lane, d = col & 127; const float* g = (col < 1024 ? qg : kg) + d;
#pragma unroll
            for (int e = 0; e < 8; ++e) f[e] = f[e] * r * g[e];
            w.x = pk2(f[0], f[1]); w.y = pk2(f[2], f[3]); w.z = pk2(f[4], f[5]); w.w = pk2(f[6], f[7]);
            rowp[64 * j] = w;
        }
    }
    const bf16* XT = (const bf16*)(F.ws + WS_XT) + (size_t)1024 * MT; bf16* UC = (bf16*)(F.ws + WS_UC);
    const float* cw = F.in[6]; const float* cb = F.in[7];
    const size_t nchunks = (size_t)3072 * MT / 8;
    for (size_t i = (size_t)F.bid * NTHREADS + F.tid; i < nchunks; i += (size_t)F.G * NTHREADS) {
        const int ch = (int)(i >> 10), m0 = (int)(i & 1023) * 8, s0 = m0 & 4095;
        const bf16* up = XT + (size_t)ch * MT + m0;
        const v4u w = *(const GAS v4u*)up;
        float f[10];
        f[1] = bflo(w.x); f[2] = bfhi(w.x); f[3] = bflo(w.y); f[4] = bfhi(w.y); f[5] = bflo(w.z); f[6] = bfhi(w.z); f[7] = bflo(w.w); f[8] = bfhi(w.w);
        f[0] = s0 > 0 ? bf2f(up[-1]) : 0.f; f[9] = s0 + 8 < SEQ ? bf2f(up[8]) : 0.f;
        const float w0 = cw[ch], w1 = cw[3072 + ch], w2 = cw[6144 + ch], bb = cb[ch];
        float o[8];
#pragma unroll
        for (int e = 0; e < 8; ++e) o[e] = bb + w0 * f[e] + w1 * f[e + 1] + w2 * f[e + 2];
        v4u ov; ov.x = pk2(o[0], o[1]); ov.y = pk2(o[2], o[3]); ov.z = pk2(o[4], o[5]); ov.w = pk2(o[6], o[7]);
        *(GAS v4u*)(UC + (size_t)ch * MT + m0) = ov;
    }
}
__device__ __forceinline__ void phase_p25(Frame& F) {
    const bf16* HYT = (const bf16*)(F.ws + WS_HYT); bf16* MIXED = (bf16*)(F.ws + WS_MIXED); const float* hg = F.in[16];
    LAS float* tile = (LAS float*)F.lds;
    LAS float* rs = (LAS float*)(F.lds + 128 * 65 * 4);
    for (int it = F.bid; it < 8 * (MT / 64); it += F.G) {
        const int gi = it & 7, m0 = (it >> 3) * 64;
        { const int ch = F.tid >> 2, t0 = (F.tid & 3) * 16; const bf16* p = HYT + (size_t)(gi * 128 + ch) * MT + m0 + t0;
          const v4u a = *(const GAS v4u*)p, b = *(const GAS v4u*)(p + 8);
          LAS float* d = tile + ch * 65 + t0;
          d[0] = bflo(a.x); d[1] = bfhi(a.x); d[2] = bflo(a.y); d[3] = bfhi(a.y); d[4] = bflo(a.z); d[5] = bfhi(a.z); d[6] = bflo(a.w); d[7] = bfhi(a.w);
          d[8] = bflo(b.x); d[9] = bfhi(b.x); d[10] = bflo(b.y); d[11] = bfhi(b.y); d[12] = bflo(b.z); d[13] = bfhi(b.z); d[14] = bflo(b.w); d[15] = bfhi(b.w); }
        __syncthreads();
        {
          const int t = F.tid >> 3, c0 = (F.tid & 7) * 16; float ss = 0.f;
#pragma unroll
          for (int c = 0; c < 16; ++c) { const float v = tile[(c0 + c) * 65 + t]; ss += v * v; }
          ss += __shfl_xor(ss, 1); ss += __shfl_xor(ss, 2); ss += __shfl_xor(ss, 4);
          if ((F.tid & 7) == 0) rs[t] = rsqrtf(ss * (1.f / 128) + EPS); }
        __syncthreads();
        {
          const int t = F.tid >> 3, c0 = (F.tid & 7) * 16; const float r = rs[t]; float o[16];
#pragma unroll
          for (int c = 0; c < 16; ++c) o[c] = tile[(c0 + c) * 65 + t] * r * hg[gi * 128 + c0 + c];
          v4u a, b; a.x = pk2(o[0], o[1]); a.y = pk2(o[2], o[3]); a.z = pk2(o[4], o[5]); a.w = pk2(o[6], o[7]); b.x = pk2(o[8], o[9]); b.y = pk2(o[10], o[11]); b.z = pk2(o[12], o[13]); b.w = pk2(o[14], o[15]);
          bf16* q = MIXED + (size_t)(m0 + t) * DM + AW + gi * 128 + c0; *(GAS v4u*)q = a; *(GAS v4u*)(q + 8) = b; }
        __syncthreads();
    }
}
__device__ __forceinline__ void phase_p35(Frame& F) {
    LAS float* wrT = (LAS float*)F.lds;
    const float* wr = F.in[19]; const float* g = F.in[18];
    for (int i = F.tid; i < DM * NE; i += NTHREADS) { const int d = i >> 4, e = i & 15; wrT[e * DM + d] = wr[i]; }
    __syncthreads();
    bf16* HB = (bf16*)(F.ws + WS_HB); float* AFF = (float*)(F.ws + WS_AFF); const float* x1 = F.out;
    for (int m = GW_ID(F); m < MT; m += GW_N(F)) {
        const GAS f32x4* xr = (const GAS f32x4*)(x1 + (size_t)m * DM) + F.lane;
        f32x4 v[8]; float s = 0.f;
#pragma unroll
        for (int j = 0; j < 8; ++j) { v[j] = xr[64 * j]; s += (v[j].x * v[j].x + v[j].y * v[j].y) + (v[j].z * v[j].z + v[j].w * v[j].w); }
        const float r = rsqrtf(wave_sum(s) * (1.f / DM) + EPS);
        GAS v2u* o8 = (GAS v2u*)(HB + (size_t)m * DM) + F.lane;
#pragma unroll
        for (int j = 0; j < 8; ++j) { const f32x4 gg = *((const GAS f32x4*)g + F.lane + 64 * j); v[j].x *= r * gg.x; v[j].y *= r * gg.y; v[j].z *= r * gg.z; v[j].w *= r * gg.w;
            v2u o; o.x = pk2(v[j].x, v[j].y); o.y = pk2(v[j].z, v[j].w); o8[64 * j] = o; }
        float mine = 0.f;
#pragma unroll 1
        for (int e = 0; e < NE; ++e) { float a = 0.f;
#pragma unroll
            for (int j = 0; j < 8; ++j) { const f32x4 w = *((const LAS f32x4*)(wrT + e * DM) + F.lane + 64 * j); a += (v[j].x * w.x + v[j].y * w.y) + (v[j].z * w.z + v[j].w * w.w); }
            a = wave_sum(a); mine = (F.lane == e) ? a : mine; }
        float mx = mine;
        mx = fmaxf(mx, __shfl_xor(mx, 1)); mx = fmaxf(mx, __shfl_xor(mx, 2)); mx = fmaxf(mx, __shfl_xor(mx, 4)); mx = fmaxf(mx, __shfl_xor(mx, 8));
        const float ex = expf(mine - mx); float den = ex;
        den += __shfl_xor(den, 1); den += __shfl_xor(den, 2); den += __shfl_xor(den, 4); den += __shfl_xor(den, 8);
        const int b = m / SEQ, sidx = m % SEQ;
        if (F.lane < NE) AFF[((size_t)b * NE + F.lane) * SEQ + sidx] = ex / den;
    }
    __syncthreads();
}
__device__ __forceinline__ void phase_p4(Frame& F) {
    LAS unsigned* key = (LAS unsigned*)F.lds;
    LAS unsigned* hist = (LAS unsigned*)(F.lds + 16384);
    LAS unsigned* wsum = (LAS unsigned*)(F.lds + 16384 + 1024);
    const float* AFF = (const float*)(F.ws + WS_AFF); int* IDX = (int*)(F.ws + WS_IDX); float* GATE = (float*)(F.ws + WS_GATE); int* SEL = (int*)(F.ws + WS_SEL);
    for (int be = F.bid; be < NB * NE; be += F.G) {
        const int b = be / NE, e = be % NE;
        __syncthreads();
        const GAS v4u* ap = (const GAS v4u*)(AFF + (size_t)be * SEQ);
        const v4u k0 = ap[2 * F.tid], k1 = ap[2 * F.tid + 1];
        unsigned kk[8] = {k0.x, k0.y, k0.z, k0.w, k1.x, k1.y, k1.z, k1.w};
        unsigned prefix = 0u, mask = 0u, remaining = CAP;
#pragma unroll 1
        for (int pass = 0; pass < 4; ++pass) {
            const int shift = 24 - 8 * pass;
            if (F.tid < 256) hist[F.tid] = 0u;
            __syncthreads();
#pragma unroll
            for (int i = 0; i < 8; ++i) if ((kk[i] & mask) == prefix) __hip_atomic_fetch_add(&hist[(kk[i] >> shift) & 255u], 1u, __ATOMIC_RELAXED, __HIP_MEMORY_SCOPE_WORKGROUP);
            __syncthreads();
            if (F.tid < 256) {
                unsigned above = 0u;
                for (int j = F.tid + 1; j < 256; ++j) above += hist[j];
                const unsigned mine = hist[F.tid];
                if (above < remaining && remaining <= above + mine) { wsum[8] = (unsigned)F.tid; wsum[9] = above; }
            }
            __syncthreads();
            const unsigned d = wsum[8], above = wsum[9];
            prefix |= d << shift; mask |= 255u << shift; remaining -= above;
            __syncthreads();
        }
        const unsigned thr = prefix;
        unsigned cnt = 0u;
#pragma unroll
        for (int i = 0; i < 8; ++i) cnt += (kk[i] > thr ? 0x10000u : 0u) + (kk[i] == thr ? 1u : 0u);
        unsigned incl = cnt;
#pragma unroll
        for (int o = 1; o < 64; o <<= 1) { const unsigned t = __shfl_up(incl, o); if (F.lane >= o) incl += t; }
        if (F.lane == 63) wsum[F.wave] = incl;
        __syncthreads();
        unsigned base = 0u;
        for (int w = 0; w < F.wave; ++w) base += wsum[w];
        unsigned run = base + incl - cnt;
#pragma unroll
        for (int i = 0; i < 8; ++i) {
            const unsigned gt_before = run >> 16, tie_before = run & 0xffffu;
            const bool isgt = kk[i] > thr, istie = kk[i] == thr;
            const bool sel = isgt || (istie && tie_before < remaining);
            const unsigned slot = gt_before + (tie_before < remaining ? tie_before : remaining);
            const int s = 8 * F.tid + i, m = b * SEQ + s;
            if (sel) { IDX[be * CAP + slot] = m; GATE[be * CAP + slot] = __builtin_bit_cast(float, kk[i]); }
            SEL[(size_t)m * NE + e] = sel ? (int)slot : -1;
            run += (isgt ? 0x10000u : 0u) + (istie ? 1u : 0u);
        }
    }
    __syncthreads();
}
__device__ __forceinline__ void phase_p7(Frame& F) {
    const int* SEL = (const int*)(F.ws + WS_SEL); const float* GATE = (const float*)(F.ws + WS_GATE); const bf16* YE = (const bf16*)(F.ws + WS_YE);
    for (int m = GW_ID(F); m < MT; m += GW_N(F)) {
        const int b = m / SEQ;
        GAS f32x4* orow = (GAS f32x4*)(F.out + (size_t)m * DM);
        f32x4 acc[8];
#pragma unroll
        for (int j = 0; j < 8; ++j) acc[j] = orow[2 * F.lane + (j & 1) + 128 * (j >> 1)];
        for (int e = 0; e < NE; ++e) { const int slot = SEL[(size_t)m * NE + e]; if (slot >= 0) {
            const GAS v4u* yr = (const GAS v4u*)(YE + (size_t)((b * NE + e) * CAP + slot) * DM) + F.lane;
#pragma unroll
            for (int jj = 0; jj < 4; ++jj) { const v4u w = yr[64 * jj];
                acc[2 * jj].x += bflo(w.x); acc[2 * jj].y += bfhi(w.x); acc[2 * jj].z += bflo(w.y); acc[2 * jj].w += bfhi(w.y);
                acc[2 * jj + 1].x += bflo(w.z); acc[2 * jj + 1].y += bfhi(w.z); acc[2 * jj + 1].z += bflo(w.w); acc[2 * jj + 1].w += bfhi(w.w); } } }
#pragma unroll
        for (int j = 0; j < 8; ++j) orow[2 * F.lane + (j & 1) + 128 * (j >> 1)] = acc[j];
    }
    (void)GATE;
}

struct Args { const float* in[23]; float* out; unsigned char* ws; int ph_lo, ph_hi; };
enum Phase { PH_P0 = 0, PH_G1, PH_FILT, PH_P15, PH_ATTN, PH_P25, PH_OUT, PH_P35, PH_P4, PH_UP, PH_DOWN, PH_P7, PH_COUNT };

__global__ void __launch_bounds__(NTHREADS, 2) mk_fwd(Args args) {
    extern __shared__ __attribute__((aligned(16))) unsigned char lds_raw[];
    Frame F;
    F.lds = (LAS unsigned char*)lds_raw;
    F.tid = threadIdx.x; F.lane = F.tid & 63; F.wave = __builtin_amdgcn_readfirstlane(F.tid >> 6); F.G = gridDim.x; F.bid = blockIdx.x;
#pragma unroll
    for (int i = 0; i < 23; ++i) F.in[i] = args.in[i];
    F.out = args.out; F.ws = args.ws;
    const int lo = args.ph_lo, hi = args.ph_hi;
#define IN(k) (lo <= (k) && (k) < hi)
#define REPS(k) for (int rep_ = 0; rep_ < ((k) == REP_PHASE ? REP_N : 1); ++rep_)
#if MK_N_LAUNCHES == 1
    { volatile LAS unsigned* misc = (volatile LAS unsigned*)(F.lds + LDS_MISC_OFF); if (F.tid < 16) misc[F.tid] = 0u; }
    __syncthreads();
    XcdBarrier bar = xcd_barrier_post((unsigned*)(F.ws + WS_CTL) + 4096, (volatile LAS unsigned*)(F.lds + LDS_MISC_OFF) + 8);
#define SEAM(k) do { if (IN(k) && IN((k) + 1)) xcd_barrier(bar); } while (0)
#else
#define SEAM(k) do { } while (0)
#endif
    if (IN(PH_P0)) REPS(PH_P0) { phase_p0(F); } SEAM(PH_P0);
    if (IN(PH_G1)) REPS(PH_G1) {
        __syncthreads();
        { pg8::DenseOrder S; S.init(F.ws + WS_HB, F.ws + WS_WIN, MT, 2048, DM, 0, F.G, F.bid);
          pg8::EpiBf16 E{(pg8::bf16_t*)(F.ws + WS_QK), 2048, 0, nullptr};
          pg8::gemm_phase<pg8::EpiBf16, pg8::DenseOrder, true>(F.lds, DM, S, E); }
        { pg8::DenseOrder S; S.init(F.ws + WS_HB, F.ws + WS_WIN, MT, 4096, DM, 8, F.G, F.bid);
          pg8::EpiTransBf16 E{(pg8::bf16_t*)(F.ws + WS_XT), MT, 8};
          pg8::gemm_phase<pg8::EpiTransBf16, pg8::DenseOrder, true>(F.lds, DM, S, E); }
    } SEAM(PH_G1);
    if (IN(PH_FILT)) REPS(PH_FILT) { phase_filters(F); } SEAM(PH_FILT);
    if (IN(PH_P15)) { phase_p15(F); } SEAM(PH_P15);
    if (IN(PH_ATTN)) { __syncthreads(); for (int rep_ = 0; rep_ < ((PH_ATTN == REP_PHASE && REP_SUB != 2) ? REP_N : 1); ++rep_) phase_hyena(F); for (int rep_ = 0; rep_ < ((PH_ATTN == REP_PHASE && REP_SUB != 1) ? REP_N : 1); ++rep_) phase_attn(F); } SEAM(PH_ATTN);
    if (IN(PH_P25)) REPS(PH_P25) { __syncthreads(); phase_p25(F); } SEAM(PH_P25);
    if (IN(PH_OUT)) REPS(PH_OUT) {
        __syncthreads();
        pg8::DenseOrder S; S.init(F.ws + WS_MIXED, F.ws + WS_WOUT, MT, DM, DM, 0, F.G, F.bid);
        pg8::EpiResF32 E{F.in[0], F.out, DM};
        pg8::gemm_phase<pg8::EpiResF32, pg8::DenseOrder, false>(F.lds, DM, S, E);
    } SEAM(PH_OUT);
    if (IN(PH_P35)) REPS(PH_P35) { __syncthreads(); phase_p35(F); } SEAM(PH_P35);
    if (IN(PH_P4)) REPS(PH_P4) { __syncthreads(); phase_p4(F); } SEAM(PH_P4);
    if (IN(PH_UP)) REPS(PH_UP) {
        __syncthreads();
        pg8::MoeOrder S; S.init(F.ws + WS_HB, F.ws + WS_WGU, DM, F.G, F.bid, true);
        LAS int* ridx = (LAS int*)(F.lds + 131072);
        { const int* IDX = (const int*)(F.ws + WS_IDX); pg8::Unit u;
          for (int i = 0; S.next(i, u); ++i) if (F.tid < 256) ridx[i * 256 + F.tid] = IDX[u.g * CAP + u.pm * 256 + F.tid]; }
        __syncthreads();
        pg8::EpiSwiGLU E{(pg8::bf16_t*)(F.ws + WS_ACT)};
        pg8::gemm_phase<pg8::EpiSwiGLU, pg8::MoeOrder, true, true>(F.lds, DM, S, E, ridx);
    } SEAM(PH_UP);
    if (IN(PH_DOWN)) REPS(PH_DOWN) {
        __syncthreads();
        pg8::MoeOrder S; S.init(F.ws + WS_ACT, F.ws + WS_WD, FF, F.G, F.bid, false);
        pg8::EpiBf16 E{(pg8::bf16_t*)(F.ws + WS_YE), DM, 512, (const float*)(F.ws + WS_GATE)};
        pg8::gemm_phase<pg8::EpiBf16, pg8::MoeOrder, true>(F.lds, FF, S, E);
    } SEAM(PH_DOWN);
    if (IN(PH_P7)) { phase_p7(F); }
#undef IN
#undef SEAM
}

extern "C" void kernel_launch(void* const* d_in, const int* in_sizes, int n_in, void* d_out, int out_size, void* d_ws, size_t ws_size, hipStream_t stream) {
    static int grid = 0;
    if (grid == 0) {
        if (n_in != 23 || ws_size < WS_END) { fprintf(stderr, "kernel_launch: unexpected inputs (n_in %d, ws %zu)\n", n_in, ws_size); grid = -1; return; }
        if (hipFuncSetAttribute((const void*)mk_fwd, hipFuncAttributeMaxDynamicSharedMemorySize, LDS_BYTES) != hipSuccess) { fprintf(stderr, "kernel_launch: hipFuncSetAttribute failed\n"); grid = -1; return; }
        int dev = 0, cus = 0, per_cu = 0;
        hipGetDevice(&dev); hipDeviceGetAttribute(&cus, hipDeviceAttributeMultiprocessorCount, dev);
        hipOccupancyMaxActiveBlocksPerMultiprocessor(&per_cu, (const void*)mk_fwd, NTHREADS, LDS_BYTES);
        (void)hipGetLastError();
        if (per_cu < 1) { fprintf(stderr, "kernel_launch: occupancy query says %d blocks/CU\n", per_cu); }
        grid = cus;
    }
    if (grid < 0) return;
    Args a{};
    for (int i = 0; i < 23; ++i) a.in[i] = (const float*)d_in[i];
    a.out = (float*)d_out; a.ws = (unsigned char*)d_ws;
#if MK_N_LAUNCHES == 1
    if (hipMemsetAsync((char*)d_ws + WS_CTL, 0, CTL_ZERO_BYTES, stream) != hipSuccess) { fprintf(stderr, "kernel_launch: memset failed\n"); return; }
    a.ph_lo = 0; a.ph_hi = PH_COUNT;
    void* kargs[] = {&a};
    hipError_t e = hipLaunchCooperativeKernel((const void*)mk_fwd, dim3(grid), dim3(NTHREADS), kargs, LDS_BYTES, stream);
    if (e != hipSuccess) fprintf(stderr, "cooperative launch failed: %s (grid %d)\n", hipGetErrorString(e), grid);
#else
    for (int p = 0; p < PH_COUNT; ++p) { a.ph_lo = p; a.ph_hi = p + 1; hipLaunchKernelGGL(mk_fwd, dim3(grid), dim3(NTHREADS), LDS_BYTES, stream, a); }
#endif
}
```

```cpp
#include <hip/hip_runtime.h>
#include <hip/hip_cooperative_groups.h>
#include <cstdio>
#include <cstdint>
namespace cg = cooperative_groups;

#ifndef REP_PHASE
#define REP_PHASE -1
#define REP_N 1
#define REP_SUB 0
#endif
#ifndef MK_N_LAUNCHES
#define MK_N_LAUNCHES 1
#endif

namespace pg8 {
#define PG8_LAS __attribute__((address_space(3)))
typedef unsigned short bf16_t;
typedef short bf16x8 __attribute__((ext_vector_type(8)));
typedef float f32x4 __attribute__((ext_vector_type(4)));
typedef unsigned u32x4 __attribute__((ext_vector_type(4)));
typedef unsigned u32x2 __attribute__((ext_vector_type(2)));
constexpr int BM = 256, BK = 64, HALF = 128, HTB = HALF * BK * 2, STAGE_BYTES = 8 * HTB, NXCD = 8, WGM = 8;

__host__ __device__ __forceinline__ int lds_byte(int r, int c) { const int st = (r >> 4) * 2 + (c >> 5), rr = r & 15, cc = c & 31, ob = rr * 64 + cc * 2; return st * 1024 + (ob ^ (((ob >> 9) & 1) << 5)); }
__host__ __device__ __forceinline__ void stage_rc(int b, int& R, int& C) { const int st = b / 1024, sb = b % 1024, swz = sb ^ (((sb >> 9) & 1) << 5); R = (st >> 1) * 16 + swz / 64; C = (st & 1) * 32 + (swz % 64) / 2; }
__host__ __device__ __forceinline__ int perm32(int rho) { const int n = rho >> 4, i = rho & 15; return 8 * (i >> 2) + 4 * n + (i & 3); }

struct Unit { int pm, pn, g; const char* a; const char* b; };

__device__ __forceinline__ unsigned cvt_pk_bf16(float lo, float hi) { unsigned r; asm volatile("v_cvt_pk_bf16_f32 %0, %1, %2" : "=v"(r) : "v"(lo), "v"(hi)); return r; }

struct DenseOrder {
    int nM, nN, nwg, G, c, K, pn0; const char* A; const char* Bt;
    __device__ void init(const void* A_, const void* Bt_, int M, int N, int K_, int pn0_, int G_, int c_) { A = (const char*)A_; Bt = (const char*)Bt_; nM = M / BM; nN = N / BM; nwg = nM * nN; G = G_; c = c_; K = K_; pn0 = pn0_; }
    __device__ bool next(int i, Unit& u) const {
        const long L = (long)i * G + c; if (L >= nwg) return false;
        int wgid = (int)L; { const int q = nwg / NXCD, r = nwg % NXCD, xcd = wgid % NXCD, off = wgid / NXCD; wgid = (xcd < r ? xcd * (q + 1) : r * (q + 1) + (xcd - r) * q) + off; }
        const int nig = WGM * nN, gid = wgid / nig, fm = gid * WGM, gsz = (nM - fm) < WGM ? (nM - fm) : WGM;
        u.pm = fm + ((wgid % nig) % gsz); u.pn = pn0 + (wgid % nig) / gsz; u.g = 0;
        u.a = A + (size_t)u.pm * BM * K * 2; u.b = Bt + (size_t)u.pn * BM * K * 2; return true;
    }
};
struct MoeOrder {
    int G, c, K; bool gather; const char* A; const char* Bt;
    __device__ void init(const void* A_, const void* Bt_, int K_, int G_, int c_, bool gather_) { A = (const char*)A_; Bt = (const char*)Bt_; K = K_; G = G_; c = c_; gather = gather_; }
    __device__ bool next(int i, Unit& u) const {
        const int L = i * G + c; if (L >= 512) return false;
        const int pn = L & 7, pm = (L >> 3) & 1, b = (L >> 4) & 1, e = L >> 5;
        u.pm = pm; u.pn = pn; u.g = b * 16 + e;
        u.a = gather ? A : A + (size_t)(u.g * 512 + pm * BM) * K * 2; u.b = Bt + (size_t)(e * 2048 + pn * BM) * K * 2; return true;
    }
};

struct EpiBf16 {
    static constexpr bool PERM = true, SWAP = false;
    bf16_t* O; int ldc; int grows; const float* rscale;
    __device__ __forceinline__ void operator()(const f32x4 (&acc)[2][2][4][2], const Unit& u, int wr, int wc, int fr, int fq) const {
        const int row0 = u.g * grows + u.pm * BM + wr * 64 + fr, col0 = u.pn * BM + wc * 32 + 8 * fq;
#pragma unroll
        for (int ai = 0; ai < 2; ++ai)
#pragma unroll
            for (int m = 0; m < 4; ++m) { const int row = row0 + ai * HALF + m * 16; bf16_t* rowp = O + (size_t)row * ldc + col0; const float sc = rscale ? rscale[row] : 1.f;
#pragma unroll
                for (int bj = 0; bj < 2; ++bj) { const f32x4 v0 = acc[ai][bj][m][0] * sc, v1 = acc[ai][bj][m][1] * sc;
                    u32x4 w; w.x = cvt_pk_bf16(v0[0], v0[1]); w.y = cvt_pk_bf16(v0[2], v0[3]); w.z = cvt_pk_bf16(v1[0], v1[1]); w.w = cvt_pk_bf16(v1[2], v1[3]);
                    *(u32x4*)(rowp + bj * HALF) = w; } }
    }
};
struct EpiSwiGLU {
    static constexpr bool PERM = true, SWAP = false;
    bf16_t* O;
    __device__ __forceinline__ void operator()(const f32x4 (&acc)[2][2][4][2], const Unit& u, int wr, int wc, int fr, int fq) const {
        const int row0 = u.g * 512 + u.pm * BM + wr * 64 + fr, col0 = u.pn * HALF + wc * 32 + 8 * fq;
#pragma unroll
        for (int ai = 0; ai < 2; ++ai)
#pragma unroll
            for (int m = 0; m < 4; ++m) { bf16_t* rowp = O + (size_t)(row0 + ai * HALF + m * 16) * 1024 + col0;
                float r[8];
#pragma unroll
                for (int n = 0; n < 2; ++n)
#pragma unroll
                    for (int e = 0; e < 4; ++e) { const float g = acc[ai][0][m][n][e], up = acc[ai][1][m][n][e]; r[n * 4 + e] = g / (1.f + __expf(-g)) * up; }
                u32x4 w; w.x = cvt_pk_bf16(r[0], r[1]); w.y = cvt_pk_bf16(r[2], r[3]); w.z = cvt_pk_bf16(r[4], r[5]); w.w = cvt_pk_bf16(r[6], r[7]);
                *(u32x4*)rowp = w; }
    }
};
struct EpiResF32 {
    static constexpr bool PERM = false, SWAP = false;
    const float* res; float* out; int ldc;
    __device__ __forceinline__ void operator()(const f32x4 (&acc)[2][2][4][2], const Unit& u, int wr, int wc, int fr, int fq) const {
        const int row0 = u.pm * BM + wr * 64 + fr, col0 = u.pn * BM + wc * 32 + 4 * fq;
#pragma unroll
        for (int ai = 0; ai < 2; ++ai)
#pragma unroll
            for (int m = 0; m < 4; ++m) { const size_t off = (size_t)(row0 + ai * HALF + m * 16) * ldc + col0;
#pragma unroll
                for (int bj = 0; bj < 2; ++bj)
#pragma unroll
                    for (int n = 0; n < 2; ++n) { const f32x4 r = *(const f32x4*)(res + off + bj * HALF + n * 16); *(f32x4*)(out + off + bj * HALF + n * 16) = r + acc[ai][bj][m][n]; } }
    }
};
struct EpiTransBf16 {
    static constexpr bool PERM = false, SWAP = true;
    bf16_t* O; int ldt; int pn_base;
    __device__ __forceinline__ void operator()(const f32x4 (&acc)[2][2][4][2], const Unit& u, int wr, int wc, int fr, int fq) const {
        const int ch0 = (u.pn - pn_base) * BM + wc * 32 + fr, t0 = u.pm * BM + wr * 64 + 4 * fq;
#pragma unroll
        for (int bj = 0; bj < 2; ++bj)
#pragma unroll
            for (int n = 0; n < 2; ++n) { bf16_t* chp = O + (size_t)(ch0 + bj * HALF + n * 16) * ldt + t0;
#pragma unroll
                for (int ai = 0; ai < 2; ++ai)
#pragma unroll
                    for (int m = 0; m < 4; ++m) { const f32x4 v = acc[ai][bj][m][n]; u32x2 w; w.x = cvt_pk_bf16(v[0], v[1]); w.y = cvt_pk_bf16(v[2], v[3]); *(u32x2*)(chp + ai * HALF + m * 16) = w; } }
    }
};

template <class Epi, class Sched, bool ALIGN_EPI = false, bool GATHER = false>
__device__ __forceinline__ void gemm_phase(PG8_LAS unsigned char* lds, const int K, const Sched& S, const Epi& E, const PG8_LAS int* ridx = nullptr) {
    const int tid = threadIdx.x, wid = __builtin_amdgcn_readfirstlane(tid >> 6), lane = tid & 63, wr = wid >> 2, wc = wid & 3, fr = lane & 15, fq = lane >> 4;
    const int nt = K / BK;
    unsigned vA0[2], vA1[2], vN0[2], vN1[2], voffB[2]; int stR[2], stC[2];
    const size_t kstep = (size_t)(BK * 2);
    const size_t hstep = (size_t)HALF * K * 2;
#pragma unroll
    for (int i = 0; i < 2; ++i) { int R, C; stage_rc(tid * 16 + i * 8192, R, C); const int Rb = Epi::PERM ? ((R & ~31) + perm32(R & 31)) : R; stR[i] = R; stC[i] = C;
        voffB[i] = (unsigned)(Rb * K + C) * 2u;
        if constexpr (GATHER) { vA0[i] = (unsigned)(ridx[R] * K + C) * 2u; vA1[i] = (unsigned)(ridx[HALF + R] * K + C) * 2u; }
        else { vA0[i] = (unsigned)(R * K + C) * 2u; vA1[i] = vA0[i] + (unsigned)hstep; }
        vN0[i] = vA0[i]; vN1[i] = vA1[i]; }
    const unsigned ldsw = (unsigned)wid * 1024u;
    const int aoff = lds_byte(wr * 64 + fr, fq * 8), boff = lds_byte(wc * 32 + fr, fq * 8);
#define PG8_SA(b, h) (((b) * 2 + (h)) * HTB)
#define PG8_SB(b, h) ((4 + (b) * 2 + (h)) * HTB)
#define PG8_STAGE(bufoff, gbase, voff) do { _Pragma("unroll") for (int _i = 0; _i < 2; ++_i) \
        __builtin_amdgcn_global_load_lds((const unsigned*)((const char*)(gbase) + (voff)[_i]), (PG8_LAS unsigned*)(lds + (bufoff) + ldsw + _i * 8192), 16, 0, 0); } while (0)
#define PG8_LDA(dst, b, h) do { _Pragma("unroll") for (int m = 0; m < 4; ++m) _Pragma("unroll") for (int k = 0; k < 2; ++k) dst[m][k] = *(const PG8_LAS bf16x8*)(lds + PG8_SA(b, h) + aoff + m * 2048 + k * 1024); } while (0)
#define PG8_LDB(dst, b, h) do { _Pragma("unroll") for (int n = 0; n < 2; ++n) _Pragma("unroll") for (int k = 0; k < 2; ++k) dst[n][k] = *(const PG8_LAS bf16x8*)(lds + PG8_SB(b, h) + boff + n * 2048 + k * 1024); } while (0)
#define PG8_MMA(ai, bj, At, Bt) do { __builtin_amdgcn_s_setprio(1); _Pragma("unroll") for (int m = 0; m < 4; ++m) _Pragma("unroll") for (int n = 0; n < 2; ++n) _Pragma("unroll") for (int k = 0; k < 2; ++k) \
        acc[ai][bj][m][n] = Epi::SWAP ? __builtin_amdgcn_mfma_f32_16x16x32_bf16(At[m][k], Bt[n][k], acc[ai][bj][m][n], 0, 0, 0) : __builtin_amdgcn_mfma_f32_16x16x32_bf16(Bt[n][k], At[m][k], acc[ai][bj][m][n], 0, 0, 0); __builtin_amdgcn_s_setprio(0); } while (0)
#define PG8_WAIT_V(n) asm volatile("s_waitcnt vmcnt(" #n ")" ::: "memory")
#define PG8_WAIT_L(n) asm volatile("s_waitcnt lgkmcnt(" #n ")" ::: "memory")
#define PG8_BAR __builtin_amdgcn_s_barrier()
#define PG8_SCHED __builtin_amdgcn_sched_barrier(0)
    Unit cur, nxt; int ui = 0;
    if (!S.next(0, cur)) return;
    f32x4 acc[2][2][4][2];
#pragma unroll
    for (int a = 0; a < 2; ++a)
#pragma unroll
        for (int b = 0; b < 2; ++b)
#pragma unroll
            for (int m = 0; m < 4; ++m)
#pragma unroll
                for (int n = 0; n < 2; ++n) acc[a][b][m][n] = (f32x4){0.f, 0.f, 0.f, 0.f};
    bf16x8 At[4][2], B0[2][2], B1[2][2];
    const char* cA = cur.a; const char* cB = cur.b;
    PG8_STAGE(PG8_SB(0, 0), cB, voffB); PG8_STAGE(PG8_SB(0, 1), cB + hstep, voffB); PG8_STAGE(PG8_SA(0, 0), cA, vA0); PG8_STAGE(PG8_SA(0, 1), cA, vA1);
    if (wr == 1) PG8_BAR;
    PG8_WAIT_V(2); PG8_BAR;
    PG8_STAGE(PG8_SB(1, 0), cB + kstep, voffB); PG8_STAGE(PG8_SA(1, 0), cA + kstep, vA0); PG8_STAGE(PG8_SB(1, 1), cB + hstep + kstep, voffB);
    PG8_WAIT_V(6); PG8_BAR;
    for (;;) {
        const bool has_next = S.next(ui + 1, nxt);
        const char* nA = has_next ? nxt.a : cA; const char* nB = has_next ? nxt.b : cB;
        if constexpr (GATHER) { if (has_next) {
#pragma unroll
            for (int i = 0; i < 2; ++i) { vN0[i] = (unsigned)(ridx[(ui + 1) * 256 + stR[i]] * K + stC[i]) * 2u; vN1[i] = (unsigned)(ridx[(ui + 1) * 256 + HALF + stR[i]] * K + stC[i]) * 2u; } } }
        for (int t = 0; t < nt; t += 2) {
            const bool last = (t == nt - 2);
            const char* a1 = cA + (size_t)(t + 1) * kstep;
            const char* a2 = last ? nA : cA + (size_t)(t + 2) * kstep; const char* b2 = last ? nB : cB + (size_t)(t + 2) * kstep;
            const char* a3 = a2 + kstep; const char* b3 = b2 + kstep;
            unsigned w0[2], w1[2];
#pragma unroll
            for (int i = 0; i < 2; ++i) { w0[i] = last ? vN0[i] : vA0[i]; w1[i] = last ? vN1[i] : vA1[i]; }
            PG8_LDB(B0, 0, 0); PG8_LDB(B1, 0, 1); PG8_SCHED; PG8_LDA(At, 0, 0); PG8_STAGE(PG8_SA(1, 1), a1, vA1);
            PG8_WAIT_V(8); PG8_WAIT_L(0); PG8_BAR; PG8_MMA(0, 0, At, B0); PG8_MMA(0, 1, At, B1); PG8_BAR; PG8_SCHED;
            PG8_LDA(At, 0, 1); PG8_STAGE(PG8_SB(0, 0), b2, voffB); PG8_STAGE(PG8_SB(0, 1), b2 + hstep, voffB); PG8_STAGE(PG8_SA(0, 0), a2, w0);
            PG8_WAIT_V(8); PG8_WAIT_L(0); PG8_BAR; PG8_MMA(1, 0, At, B0); PG8_MMA(1, 1, At, B1); PG8_BAR; PG8_SCHED;
            PG8_LDB(B0, 1, 0); PG8_LDB(B1, 1, 1); PG8_SCHED; PG8_LDA(At, 1, 0); PG8_STAGE(PG8_SA(0, 1), a2, w1);
            PG8_WAIT_V(8); PG8_WAIT_L(0); PG8_BAR; PG8_MMA(0, 0, At, B0); PG8_MMA(0, 1, At, B1); PG8_BAR; PG8_SCHED;
            PG8_LDA(At, 1, 1); PG8_STAGE(PG8_SB(1, 0), b3, voffB); PG8_STAGE(PG8_SB(1, 1), b3 + hstep, voffB); PG8_STAGE(PG8_SA(1, 0), a3, w0);
            PG8_WAIT_V(8); PG8_WAIT_L(0); PG8_BAR; PG8_MMA(1, 0, At, B0); PG8_MMA(1, 1, At, B1); PG8_BAR; PG8_SCHED;
        }
        if constexpr (ALIGN_EPI) { if (wr == 0) PG8_BAR; }
        E(acc, cur, wr, wc, fr, fq);
        if (!has_next) break;
#pragma unroll
        for (int a = 0; a < 2; ++a)
#pragma unroll
            for (int b = 0; b < 2; ++b)
#pragma unroll
                for (int m = 0; m < 4; ++m)
#pragma unroll
                    for (int n = 0; n < 2; ++n) acc[a][b][m][n] = (f32x4){0.f, 0.f, 0.f, 0.f};
        cur = nxt; cA = nA; cB = nB; ++ui;
#pragma unroll
        for (int i = 0; i < 2; ++i) { vA0[i] = vN0[i]; vA1[i] = vN1[i]; }
        if constexpr (ALIGN_EPI) { if (wr == 1) PG8_BAR; }
    }
    PG8_WAIT_V(0);
    if constexpr (!ALIGN_EPI) { if (wr == 0) PG8_BAR; }
    PG8_BAR;
#undef PG8_SA
#undef PG8_SB
#undef PG8_STAGE
#undef PG8_LDA
#undef PG8_LDB
#undef PG8_MMA
#undef PG8_WAIT_V
#undef PG8_WAIT_L
#undef PG8_BAR
#undef PG8_SCHED
}
}

constexpr int NB = 2, SEQ = 4096, DM = 2048, MT = NB * SEQ;
constexpr int NH = 8, HD = 128, AW = 1024, HW = 1024, INW = 6144;
constexpr int GW = 64, NROWS = 64, WR = 8, WC = 16;
constexpr int NE = 16, CAP = 512, FF = 1024;
constexpr int FEMB = 33, FHID = 64;
constexpr float EPS = 1e-6f;
constexpr int NWAVES = 8, NTHREADS = 512;

constexpr size_t MiB = 1u << 20;
constexpr size_t WS_CTL = 0, CTL_ZERO_BYTES = 1 * MiB;
constexpr size_t WS_WIN = 2 * MiB;
constexpr size_t WS_WOUT = 26 * MiB;
constexpr size_t WS_WGU = 34 * MiB;
constexpr size_t WS_WD = 162 * MiB;
constexpr size_t WS_W3T = 226 * MiB;
constexpr size_t WS_HID2 = 227 * MiB;
constexpr size_t WS_HB = 228 * MiB;
constexpr size_t WS_QK = 260 * MiB;
constexpr size_t WS_XT = 292 * MiB;
constexpr size_t WS_UC = 356 * MiB;
constexpr size_t WS_TAPS = 404 * MiB;
constexpr size_t WS_HYT = 436 * MiB;
constexpr size_t WS_MIXED = 452 * MiB;
constexpr size_t WS_AFF = 484 * MiB;
constexpr size_t WS_IDX = 485 * MiB;
constexpr size_t WS_GATE = 486 * MiB;
constexpr size_t WS_SEL = 487 * MiB;
constexpr size_t WS_Z1T = 488 * MiB;
constexpr size_t WS_XG = WS_XT;
constexpr size_t WS_ACT = WS_UC;
constexpr size_t WS_YE = WS_TAPS;
constexpr size_t WS_END = 504 * MiB;

constexpr int LDS_BYTES = 163840, LDS_MISC_OFF = 163840 - 128;

#define GAS __attribute__((address_space(1)))
#define LAS __attribute__((address_space(3)))
typedef unsigned short bf16;
typedef unsigned v4u __attribute__((ext_vector_type(4)));
typedef unsigned v2u __attribute__((ext_vector_type(2)));
typedef float f32x4 __attribute__((ext_vector_type(4)));
#define LDS_WAIT() asm volatile("s_waitcnt lgkmcnt(0)" ::: "memory")
#define VM_WAIT() asm volatile("s_waitcnt vmcnt(0)" ::: "memory")
__device__ __forceinline__ unsigned f2bf(float f) { unsigned u = __builtin_bit_cast(unsigned, f); return (u + 0x7fffu + ((u >> 16) & 1u)) >> 16; }
__device__ __forceinline__ unsigned pk2(float lo, float hi) { return f2bf(lo) | (f2bf(hi) << 16); }
__device__ __forceinline__ float bf2f(unsigned h) { return __builtin_bit_cast(float, h << 16); }
__device__ __forceinline__ float bflo(unsigned w) { return __builtin_bit_cast(float, w << 16); }
__device__ __forceinline__ float bfhi(unsigned w) { return __builtin_bit_cast(float, w & 0xffff0000u); }
__device__ __forceinline__ float wave_sum(float v) {
#pragma unroll
    for (int o = 1; o < 64; o <<= 1) v += __shfl_xor(v, o);
    return v;
}


#define XB_TMO      128
#define XB_XCNT(j)  (256  + 64 * (j))
#define XB_XSUB(j)  (1280 + 64 * (j))
#define XB_XGEN(j)  (2304 + 64 * (j))
#define XB_TOP      3328
#define XB_TOPGEN   3392
#define XCD_BAR_WORDS 3456
#define XB_SPIN_CAP (1u << 22)
__device__ __forceinline__ unsigned xb_ld(unsigned* p)              { return __hip_atomic_load(p, __ATOMIC_RELAXED, __HIP_MEMORY_SCOPE_AGENT); }
__device__ __forceinline__ unsigned xb_add(unsigned* p, unsigned v) { return __hip_atomic_fetch_add(p, v, __ATOMIC_RELAXED, __HIP_MEMORY_SCOPE_AGENT); }
__device__ __forceinline__ unsigned xb_xcc_id() { return (unsigned)__builtin_amdgcn_s_getreg((3 << 11) | 20) & 0xFu; }
#define XB_SPIN(cond, bar) do { unsigned _sp = 0; while (cond) { __builtin_amdgcn_s_sleep(1); \
    if ((++_sp & 255u) == 0u) { if (xb_ld(&(bar)[XB_TMO])) break; if (_sp > XB_SPIN_CAP) { atomicAdd(&(bar)[XB_TMO], 1u); break; } } } } while (0)
struct XcdBarrier { unsigned* bar; unsigned x; volatile LAS unsigned* st; };
__device__ __forceinline__ XcdBarrier xcd_barrier_post(unsigned* bar, volatile LAS unsigned* st) {
    XcdBarrier b; b.bar = bar; b.x = xb_xcc_id(); b.st = st;
    if (threadIdx.x == 0) (void)xb_add(&bar[XB_XCNT(b.x)], 1u);
    return b;
}
__device__ __forceinline__ void xcd_barrier_complete(unsigned* bar, unsigned x, unsigned& nloc, unsigned& nx) {
    const unsigned G = gridDim.x * gridDim.y * gridDim.z;
    unsigned sum, cnt, mine, sp = 0u;
    for (;;) {
        sum = 0u; cnt = 0u; mine = 0u;
#pragma unroll
        for (unsigned j = 0; j < 16; ++j) { const unsigned c = xb_ld(&bar[XB_XCNT(j)]); sum += c; cnt += (c > 0u) ? 1u : 0u; mine = (j == x) ? c : mine; }
        if (sum == G) break;
        __builtin_amdgcn_s_sleep(1);
        if ((++sp & 255u) == 0u) { if (xb_ld(&bar[XB_TMO])) break; if (sp > XB_SPIN_CAP) { atomicAdd(&bar[XB_TMO], 1u); break; } }
    }
    nloc = mine > 0u ? mine : 1u; nx = cnt > 0u ? cnt : 1u;
}
__device__ __forceinline__ void xcd_barrier(const XcdBarrier& b) {
    asm volatile("s_waitcnt vmcnt(0)" ::: "memory");
    __syncthreads();
    if (threadIdx.x == 0) {
        unsigned* bar = b.bar;
        __builtin_amdgcn_s_waitcnt(0);
        unsigned nloc = b.st[0], nx = b.st[1];
        if (nloc == 0u) { xcd_barrier_complete(bar, b.x, nloc, nx); b.st[0] = nloc; b.st[1] = nx; }
        const unsigned old = xb_add(&bar[XB_XSUB(b.x)], 1u);
        const unsigned gen = old / nloc;
        if (old + 1u == (gen + 1u) * nloc) {
            __builtin_amdgcn_fence(__ATOMIC_RELEASE, "agent");
            asm volatile("s_waitcnt vmcnt(0)" ::: "memory");
            const unsigned og = xb_add(&bar[XB_TOP], 1u);
            const unsigned tg = og / nx;
            if (og + 1u == (tg + 1u) * nx) xb_add(&bar[XB_TOPGEN], 1u);
            else XB_SPIN(xb_ld(&bar[XB_TOPGEN]) == tg, bar);
            __builtin_amdgcn_fence(__ATOMIC_ACQUIRE, "agent");
            xb_add(&bar[XB_XGEN(b.x)], 1u);
            asm volatile("s_waitcnt vmcnt(0)" ::: "memory");
        } else {
            XB_SPIN(xb_ld(&bar[XB_XGEN(b.x)]) == gen, bar);
            __builtin_amdgcn_fence(__ATOMIC_ACQUIRE, "agent");
            asm volatile("s_waitcnt vmcnt(0)" ::: "memory");
        }
    }
    __syncthreads();
}

struct Frame {
    LAS unsigned char* lds;
    int tid, lane, wave, G, bid;
    const float* in[23]; float* out; unsigned char* ws;
};
#define GW_ID(F) ((F).bid * NWAVES + (F).wave)
#define GW_N(F) ((F).G * NWAVES)

__device__ __forceinline__ void p0_transpose_item(const float* W, int K, int N, bf16* WT, int row_base, int k0, int n0, LAS float* scr, int lane) {
#pragma unroll 8
    for (int i = 0; i < 32; ++i) { const int kk = 2 * i + (lane >> 5); scr[kk * 33 + (lane & 31)] = W[(size_t)(k0 + kk) * N + n0 + (lane & 31)]; }
    LDS_WAIT(); asm volatile("" ::: "memory");
    const int c = lane & 7;
#pragma unroll
    for (int j = 0; j < 4; ++j) { const int n = (lane >> 3) + 8 * j; const LAS float* s = scr + (8 * c) * 33 + n;
        v4u o; o.x = pk2(s[0 * 33], s[1 * 33]); o.y = pk2(s[2 * 33], s[3 * 33]); o.z = pk2(s[4 * 33], s[5 * 33]); o.w = pk2(s[6 * 33], s[7 * 33]);
        *(GAS v4u*)(WT + (size_t)(row_base + n) * K + k0 + 8 * c) = o; }
    LDS_WAIT(); asm volatile("" ::: "memory");
}
__device__ __forceinline__ void phase_p0(Frame& F) {
    LAS float* scr = (LAS float*)(F.lds + F.wave * 16384);
    const int gw = GW_ID(F), NGW = GW_N(F);
    bf16* WinT = (bf16*)(F.ws + WS_WIN); bf16* WoutT = (bf16*)(F.ws + WS_WOUT); bf16* WguT = (bf16*)(F.ws + WS_WGU); bf16* WdT = (bf16*)(F.ws + WS_WD); bf16* W3T = (bf16*)(F.ws + WS_W3T);
    constexpr int I_IN = (DM / 64) * (INW / 32), I_OUT = (DM / 64) * (DM / 32), I_G = (DM / 64) * (FF / 32), I_D = (FF / 64) * (DM / 32), I_3 = 1 * (4096 / 32);
    constexpr int NITEMS = I_IN + I_OUT + 2 * NE * I_G + NE * I_D + I_3;
    for (int it = gw; it < NITEMS; it += NGW) {
        int r = it;
        if (r < I_IN) { const int nblk = INW / 32, kb = r / nblk, nb = r % nblk; p0_transpose_item(F.in[2], DM, INW, WinT, 32 * nb, 64 * kb, 32 * nb, scr, F.lane); continue; } r -= I_IN;
        if (r < I_OUT) { const int nblk = DM / 32, kb = r / nblk, nb = r % nblk; p0_transpose_item(F.in[17], DM, DM, WoutT, 32 * nb, 64 * kb, 32 * nb, scr, F.lane); continue; } r -= I_OUT;
        if (r < 2 * NE * I_G) { const int which = r / (NE * I_G); r %= NE * I_G; const int e = r / I_G; r %= I_G; const int nblk = FF / 32, kb = r / nblk, nb = r % nblk, f0 = 32 * nb;
            const float* W = (which ? F.in[21] : F.in[20]) + (size_t)e * DM * FF;
            const int row_base = e * 2048 + (f0 >> 7) * 256 + which * 128 + (f0 & 127);
            p0_transpose_item(W, DM, FF, WguT, row_base, 64 * kb, f0, scr, F.lane); continue; } r -= 2 * NE * I_G;
        if (r < NE * I_D) { const int e = r / I_D; r %= I_D; const int nblk = DM / 32, kb = r / nblk, nb = r % nblk;
            p0_transpose_item(F.in[22] + (size_t)e * FF * DM, FF, DM, WdT, e * 2048 + 32 * nb, 64 * kb, 32 * nb, scr, F.lane); continue; } r -= NE * I_D;
        { const int nb = r; p0_transpose_item(F.in[12], FHID, 4096, W3T, 32 * nb, 0, 32 * nb, scr, F.lane); }
    }
    bf16* HB = (bf16*)(F.ws + WS_HB);
    const float* x = F.in[0]; const float* g = F.in[1];
    for (int m = gw; m < MT; m += NGW) {
        const GAS f32x4* xr = (const GAS f32x4*)(x + (size_t)m * DM) + F.lane;
        f32x4 v[8]; float s = 0.f;
#pragma unroll
        for (int j = 0; j < 8; ++j) { v[j] = xr[64 * j]; s += (v[j].x * v[j].x + v[j].y * v[j].y) + (v[j].z * v[j].z + v[j].w * v[j].w); }
        const float r = rsqrtf(wave_sum(s) * (1.f / DM) + EPS);
        GAS v2u* o8 = (GAS v2u*)(HB + (size_t)m * DM) + F.lane;
#pragma unroll
        for (int j = 0; j < 8; ++j) { const f32x4 gg = *((const GAS f32x4*)g + F.lane + 64 * j); v2u o; o.x = pk2(v[j].x * r * gg.x, v[j].y * r * gg.y); o.y = pk2(v[j].z * r * gg.z, v[j].w * r * gg.w); o8[64 * j] = o; }
    }
    float* HID2 = (float*)(F.ws + WS_HID2);
    LAS float* sc2 = (LAS float*)(F.lds + F.wave * 16384);
    const float* w1 = F.in[8]; const float* b1 = F.in[9]; const float* w2 = F.in[10]; const float* b2 = F.in[11]; const float* fr = F.in[13];
    for (int l = gw; l < SEQ; l += NGW) {
        const int j = F.lane;
        float zv = 0.f;
        if (j == 0) zv = (float)l / (float)(SEQ - 1);
        else if (j < FEMB) { const int k = (j - 1) & 15; const float f = 1e-4f + (float)k * ((15.0f - 1e-4f) / 15.0f); const float wv = 6.283185307179586f * (float)l / (float)SEQ; zv = (j <= 16) ? cosf(f * wv) : -sinf(f * wv); }
        sc2[j] = zv; LDS_WAIT(); asm volatile("" ::: "memory");
        float a = b1[j];
        for (int i = 0; i < FEMB; ++i) a += sc2[i] * w1[i * FHID + j];
        const float h1 = sinf(fr[j] * a);
        sc2[64 + j] = h1; LDS_WAIT(); asm volatile("" ::: "memory");
        float c = b2[j];
        for (int i = 0; i < FHID; ++i) c += sc2[64 + i] * w2[i * FHID + j];
        HID2[l * FHID + j] = sinf(fr[j] * c);
        LDS_WAIT(); asm volatile("" ::: "memory");
    }
}

__device__ __forceinline__ void phase_filters_naive(Frame& F) {
    const float* HID2 = (const float*)(F.ws + WS_HID2); const float* w3 = F.in[12]; const float* fbias = F.in[14]; bf16* TAPS = (bf16*)(F.ws + WS_TAPS);
    const size_t total = (size_t)SEQ * 4096;
    for (size_t i = (size_t)F.bid * NTHREADS + F.tid; i < total; i += (size_t)F.G * NTHREADS) {
        const int col = (int)(i & 4095), l = (int)(i >> 12);
        float a = 0.f;
        for (int k = 0; k < FHID; ++k) a += HID2[l * FHID + k] * w3[(size_t)k * 4096 + col];
        const int c = col & 1023, dir = (col >> 10) & 1, o = col >> 11;
        const float mind = -4.605170185988091f / 1.5f, maxd = -4.605170185988091f / 0.3f;
        const float delta = fabsf(mind + (maxd - mind) * ((float)c / 1023.0f));
        const float t = (float)l / (float)(SEQ - 1);
        float v = a * expf(-t * delta);
        bf16* tp = TAPS + ((size_t)c * 2 + o) * 8192;
        if (dir == 0) { if (l == 0) v += fbias[o * 1024 + c]; tp[4096 + l] = (bf16)f2bf(v); }
        else { if (l > 0) tp[4096 - l] = (bf16)f2bf(v); else tp[0] = 0; }
    }
}
__device__ __forceinline__ void phase_hyena_naive(Frame& F, int o) {
    const bf16* UC = (const bf16*)(F.ws + WS_UC); const bf16* TAPS = (const bf16*)(F.ws + WS_TAPS);
    bf16* Z1T = (bf16*)(F.ws + WS_Z1T); bf16* HYT = (bf16*)(F.ws + WS_HYT);
    const bf16* Zin = o == 0 ? UC + (size_t)2048 * MT : Z1T; const bf16* gate = UC + (size_t)(o * 1024) * MT; bf16* OUT = o == 0 ? Z1T : HYT;
    const size_t total = (size_t)1024 * MT;
    for (size_t i = (size_t)F.bid * NTHREADS + F.tid; i < total; i += (size_t)F.G * NTHREADS) {
        const int c = (int)(i >> 13), m = (int)(i & 8191), b = m >> 12, t = m & 4095;
        const bf16* z = Zin + (size_t)c * MT + b * SEQ; const bf16* tp = TAPS + ((size_t)c * 2 + o) * 8192 + 4096 + t;
        float acc = 0.f;
        for (int s = 0; s < SEQ; ++s) acc += bf2f(tp[-s]) * bf2f(z[s]);
        OUT[(size_t)c * MT + m] = (bf16)f2bf(bf2f(gate[(size_t)c * MT + m]) * acc);
    }
}
__device__ __forceinline__ void phase_attn_naive(Frame& F) {
    const bf16* QK = (const bf16*)(F.ws + WS_QK); const bf16* VT = (const bf16*)(F.ws + WS_XT); bf16* MIXED = (bf16*)(F.ws + WS_MIXED);
    const float* rpb = F.in[5]; const float* og = F.in[15];
    const int lane = F.lane;
    for (int w = GW_ID(F); w < MT * NH; w += GW_N(F)) {
        const int m = w >> 3, h = w & 7, b = m / SEQ, s = m % SEQ, r = s / GW, c = s % GW;
        int kr0 = r - WR / 2; kr0 = kr0 < 0 ? 0 : (kr0 > NROWS - WR ? NROWS - WR : kr0);
        int c0 = c - WC / 2; c0 = c0 < 0 ? 0 : (c0 > GW - WC ? GW - WC : c0);
        const bf16* q = QK + (size_t)m * 2048 + h * HD;
        const float q0 = bf2f(q[lane]), q1 = bf2f(q[lane + 64]);
        float mx = -INFINITY, l = 0.f, a0 = 0.f, a1 = 0.f;
        for (int i = 0; i < WR; ++i) for (int j = 0; j < WC; ++j) {
            const int kr = kr0 + i, kc = c0 + j; const size_t km = (size_t)b * SEQ + kr * GW + kc;
            const bf16* kp = QK + km * 2048 + 1024 + h * HD;
            const float d = wave_sum(q0 * bf2f(kp[lane]) + q1 * bf2f(kp[lane + 64]));
            const int dr = kr - r + WR - 1; int dc = kc - c + WC - 1; dc = dc < 0 ? 0 : (dc > 2 * WC - 2 ? 2 * WC - 2 : dc);
            const float sc = d * 0.08838834764831845f + rpb[(h * (2 * WR - 1) + dr) * (2 * WC - 1) + dc];
            const float mn = fmaxf(mx, sc), corr = __expf(mx - mn), pw = __expf(sc - mn);
            const float v0 = bf2f(VT[(size_t)(h * HD + lane) * MT + km]), v1 = bf2f(VT[(size_t)(h * HD + lane + 64) * MT + km]);
            l = l * corr + pw; a0 = a0 * corr + pw * v0; a1 = a1 * corr + pw * v1; mx = mn;
        }
        a0 /= l; a1 /= l;
        const float rr = rsqrtf(wave_sum(a0 * a0 + a1 * a1) * (1.f / HD) + EPS);
        bf16* o = MIXED + (size_t)m * DM + h * HD;
        o[lane] = (bf16)f2bf(a0 * rr * og[h * HD + lane]); o[lane + 64] = (bf16)f2bf(a1 * rr * og[h * HD + lane + 64]);
    }
}


typedef short bf16x8 __attribute__((ext_vector_type(8)));
typedef float f32x16 __attribute__((ext_vector_type(16)));
__device__ __forceinline__ void phase_filters(Frame& F) {
    const float* HID2 = (const float*)(F.ws + WS_HID2); const bf16* W3T = (const bf16*)(F.ws + WS_W3T); const float* fbias = F.in[14]; bf16* TAPS = (bf16*)(F.ws + WS_TAPS);
    const int n = F.lane & 31, hh = F.lane >> 5;
    for (int it = GW_ID(F); it < 128 * 128; it += GW_N(F)) {
        const int col0 = (it >> 7) * 32, l0 = (it & 127) * 32;
        f32x16 acc;
#pragma unroll
        for (int i = 0; i < 16; ++i) acc[i] = 0.f;
#pragma unroll
        for (int ks = 0; ks < 4; ++ks) {
            const bf16x8 a = *(const GAS bf16x8*)(W3T + (size_t)(col0 + n) * FHID + 16 * ks + 8 * hh);
            const GAS f32x4* hp = (const GAS f32x4*)(HID2 + (size_t)(l0 + n) * FHID + 16 * ks + 8 * hh);
            const f32x4 h0 = hp[0], h1 = hp[1];
            v4u bw; bw.x = pk2(h0.x, h0.y); bw.y = pk2(h0.z, h0.w); bw.z = pk2(h1.x, h1.y); bw.w = pk2(h1.z, h1.w);
            acc = __builtin_amdgcn_mfma_f32_32x32x16_bf16(a, __builtin_bit_cast(bf16x8, bw), acc, 0, 0, 0);
        }
        const int l = l0 + n; const float t = (float)l / (float)(SEQ - 1);
        const int dir = (col0 >> 10) & 1, o = col0 >> 11;
        const float mind = -4.605170185988091f / 1.5f, maxd = -4.605170185988091f / 0.3f;
#pragma unroll
        for (int i = 0; i < 16; ++i) {
            const int c = (col0 & 1023) + (i & 3) + 8 * (i >> 2) + 4 * hh;
            const float delta = fabsf(mind + (maxd - mind) * ((float)c / 1023.0f));
            float v = acc[i] * __expf(-t * delta);
            bf16* tp = TAPS + ((size_t)c * 2 + o) * 8192;
            if (dir == 0) { if (l == 0) v += fbias[o * 1024 + c]; tp[4096 + l] = (bf16)f2bf(v); }
            else { if (l > 0) tp[4096 - l] = (bf16)f2bf(v); else tp[0] = 0; }
        }
    }
}

constexpr int HY_TAPS_BYTES = 4 * 16384, HY_ZB_ENT = 6080, HY_ZB_BYTES = HY_ZB_ENT * 2;
__device__ __forceinline__ unsigned hy_zb_off(int idx0  ) { const int q = idx0 >> 3; return (unsigned)((q ^ ((q >> 4) & 3)) << 4); }
template <int MASK>
__device__ __forceinline__ void hy_segment(f32x16 (&acc)[4], const LAS bf16* taps, const LAS unsigned char* zb, int g0, int g1, int n, int hh) {
    const unsigned sh = (n & 1) ? 0u : 2u;
#pragma unroll 2
    for (int g = g0; g < g1; ++g) {
        const volatile LAS unsigned* dp = (const volatile LAS unsigned*)taps + ((1 + 8 * hh + n) >> 1) + 8 * g;
        const unsigned d0 = dp[0], d1 = dp[1], d2 = dp[2], d3 = dp[3], d4 = dp[4];
        v4u aw; aw.x = __builtin_amdgcn_alignbyte(d1, d0, sh); aw.y = __builtin_amdgcn_alignbyte(d2, d1, sh); aw.z = __builtin_amdgcn_alignbyte(d3, d2, sh); aw.w = __builtin_amdgcn_alignbyte(d4, d3, sh);
        const bf16x8 a = __builtin_bit_cast(bf16x8, aw);
#pragma unroll
        for (int tau = 0; tau < 4; ++tau) if (MASK & (1 << tau)) {
            const bf16x8 b = *(const LAS bf16x8*)(zb + hy_zb_off(992 - 1024 * tau - 32 * n + 16 * g + 8 * hh));
            acc[tau] = __builtin_amdgcn_mfma_f32_32x32x16_bf16(a, b, acc[tau], 0, 0, 0);
        }
    }
}
__device__ __forceinline__ void hy_stage_taps(Frame& F, int c0, int o) {
    const bf16* TAPS = (const bf16*)(F.ws + WS_TAPS);
#pragma unroll
    for (int j = 0; j < 8; ++j) { const int ch = F.tid + NTHREADS * j, ci = ch >> 10, w = ch & 1023;
        *((LAS v4u*)(F.lds) + ch) = *((const GAS v4u*)(TAPS + ((size_t)(c0 + ci) * 2 + o) * 8192) + w); }
}
__device__ __forceinline__ void phase_hyena(Frame& F) {
    const bf16* UC = (const bf16*)(F.ws + WS_UC); bf16* HYT = (bf16*)(F.ws + WS_HYT);
    const int n = F.lane & 31, hh = F.lane >> 5, ci = F.wave >> 1, b = F.wave & 1;
    const LAS bf16* taps = (const LAS bf16*)(F.lds + ci * 16384);
    LAS unsigned char* zb = F.lds + HY_TAPS_BYTES + F.wave * HY_ZB_BYTES;
    for (int cg = F.bid; cg < 256; cg += F.G) {
        const int c0 = cg * 4, c = c0 + ci;
        __syncthreads();
        hy_stage_taps(F, c0, 0);
        { const bf16* zsrc = UC + (size_t)(2048 + c) * MT + b * SEQ;
#pragma unroll
          for (int j = 0; j < 8; ++j) { const int u = F.lane + 64 * j; const v4u w = *((const GAS v4u*)zsrc + u);
              v4u r; r.x = (w.w >> 16) | (w.w << 16); r.y = (w.z >> 16) | (w.z << 16); r.z = (w.y >> 16) | (w.y << 16); r.w = (w.x >> 16) | (w.x << 16);
              *(LAS v4u*)(zb + hy_zb_off(8 * (635 - u))) = r; }
          const v4u zero = {0u, 0u, 0u, 0u};
          for (int q = F.lane; q < 124; q += 64) { *(LAS v4u*)(zb + hy_zb_off(8 * q)) = zero; *(LAS v4u*)(zb + hy_zb_off(8 * (636 + q))) = zero; } }
        __syncthreads();
#pragma unroll 1
        for (int o = 0; o < 2; ++o) {
            f32x16 acc[4];
#pragma unroll
            for (int tau = 0; tau < 4; ++tau)
#pragma unroll
                for (int i = 0; i < 16; ++i) acc[tau][i] = 0.f;
            hy_segment<1>(acc, taps, zb, 0, 64, n, hh);
            hy_segment<3>(acc, taps, zb, 64, 128, n, hh);
            hy_segment<7>(acc, taps, zb, 128, 192, n, hh);
            hy_segment<15>(acc, taps, zb, 192, 318, n, hh);
            hy_segment<14>(acc, taps, zb, 318, 382, n, hh);
            hy_segment<12>(acc, taps, zb, 382, 446, n, hh);
            hy_segment<8>(acc, taps, zb, 446, 510, n, hh);
            const bf16* gate = UC + (size_t)(o * 1024 + c) * MT + b * SEQ;
            if (o == 0) {
                LDS_WAIT();
#pragma unroll
                for (int tau = 0; tau < 4; ++tau)
#pragma unroll
                    for (int rg = 0; rg < 4; ++rg) { const int t0 = 1024 * tau + 32 * n + 8 * rg + 4 * hh;
                        const v2u gw = *(const GAS v2u*)(gate + t0);
                        const float z0 = bflo(gw.x) * acc[tau][4 * rg + 0], z1 = bfhi(gw.x) * acc[tau][4 * rg + 1], z2 = bflo(gw.y) * acc[tau][4 * rg + 2], z3 = bfhi(gw.y) * acc[tau][4 * rg + 3];
                        v2u w; w.x = pk2(z3, z2); w.y = pk2(z1, z0);
                        *(LAS v2u*)(zb + hy_zb_off(8 * (635 - (t0 >> 3))) + (hh ? 0 : 8)) = w; }
                __syncthreads();
                hy_stage_taps(F, c0, 1);
                __syncthreads();
            } else {
                bf16* outp = HYT + (size_t)c * MT + b * SEQ;
#pragma unroll
                for (int tau = 0; tau < 4; ++tau)
#pragma unroll
                    for (int rg = 0; rg < 4; ++rg) { const int t0 = 1024 * tau + 32 * n + 8 * rg + 4 * hh;
                        const v2u gw = *(const GAS v2u*)(gate + t0);
                        v2u w; w.x = pk2(bflo(gw.x) * acc[tau][4 * rg + 0], bfhi(gw.x) * acc[tau][4 * rg + 1]); w.y = pk2(bflo(gw.y) * acc[tau][4 * rg + 2], bfhi(gw.y) * acc[tau][4 * rg + 3]);
                        *(GAS v2u*)(outp + t0) = w; }
            }
        }
    }
    __syncthreads();
}

__device__ __forceinline__ void phase_attn(Frame& F) {
    const bf16* QK = (const bf16*)(F.ws + WS_QK); const bf16* VT = (const bf16*)(F.ws + WS_XT); bf16* MIXED = (bf16*)(F.ws + WS_MIXED);
    const float* rpb = F.in[5]; const float* og = F.in[15];
    LAS float* rp = (LAS float*)(F.lds + F.wave * 2048);
    const int n = F.lane & 31, hh = F.lane >> 5;
    for (int task = GW_ID(F); task < NB * NH * NROWS * 2; task += GW_N(F)) {
        const int wq = task & 1, r = (task >> 1) & 63, h = (task >> 7) & 7, b = task >> 10;
        for (int i = F.lane; i < 15 * 31; i += 64) rp[i] = rpb[h * 465 + i];
        const int mq = b * SEQ + r * GW + 32 * wq + n, qc = 32 * wq + n;
        int c0 = qc - WC / 2; c0 = c0 < 0 ? 0 : (c0 > GW - WC ? GW - WC : c0);
        int kr0 = r - WR / 2; kr0 = kr0 < 0 ? 0 : (kr0 > NROWS - WR ? NROWS - WR : kr0);
        bf16x8 qf[8];
#pragma unroll
        for (int ks = 0; ks < 8; ++ks) qf[ks] = *(const GAS bf16x8*)(QK + (size_t)mq * 2048 + h * HD + 16 * ks + 8 * hh);
        f32x16 O[4];
#pragma unroll
        for (int dt = 0; dt < 4; ++dt)
#pragma unroll
            for (int i = 0; i < 16; ++i) O[dt][i] = 0.f;
        float lsum = 0.f;
        LDS_WAIT();
#pragma unroll 1
        for (int tile = 0; tile < 16; ++tile) {
            const int kr = kr0 + (tile >> 1), kt = tile & 1, dr = kr - r + WR - 1;
            const int mk0 = b * SEQ + kr * GW + 32 * kt;
            f32x16 S;
#pragma unroll
            for (int i = 0; i < 16; ++i) S[i] = 0.f;
#pragma unroll
            for (int ks = 0; ks < 8; ++ks) { const bf16x8 kf = *(const GAS bf16x8*)(QK + (size_t)(mk0 + n) * 2048 + 1024 + h * HD + 16 * ks + 8 * hh);
                S = __builtin_amdgcn_mfma_f32_32x32x16_bf16(kf, qf[ks], S, 0, 0, 0); }
            float p[16];
#pragma unroll
            for (int i = 0; i < 16; ++i) { const int kc = 32 * kt + (i & 3) + 8 * (i >> 2) + 4 * hh; const bool valid = (kc >= c0) && (kc < c0 + WC);
                int dc = kc - qc + WC - 1; dc = dc < 0 ? 0 : (dc > 2 * WC - 2 ? 2 * WC - 2 : dc);
                const float e = __expf(S[i] * 0.08838834764831845f + rp[dr * 31 + dc]); p[i] = valid ? e : 0.f; lsum += p[i]; }
            v4u pw0, pw1;
            pw0.x = pk2(p[0], p[1]); pw0.y = pk2(p[2], p[3]); pw0.z = pk2(p[4], p[5]); pw0.w = pk2(p[6], p[7]);
            pw1.x = pk2(p[8], p[9]); pw1.y = pk2(p[10], p[11]); pw1.z = pk2(p[12], p[13]); pw1.w = pk2(p[14], p[15]);
            const bf16x8 pf0 = __builtin_bit_cast(bf16x8, pw0), pf1 = __builtin_bit_cast(bf16x8, pw1);
#pragma unroll
            for (int dt = 0; dt < 4; ++dt) {
                const bf16* vrow = VT + (size_t)(h * HD + 32 * dt + n) * MT + mk0 + 4 * hh;
                const v2u a0 = *(const GAS v2u*)(vrow), a1 = *(const GAS v2u*)(vrow + 8), a2 = *(const GAS v2u*)(vrow + 16), a3 = *(const GAS v2u*)(vrow + 24);
                v4u f0, f1; f0.x = a0.x; f0.y = a0.y; f0.z = a1.x; f0.w = a1.y; f1.x = a2.x; f1.y = a2.y; f1.z = a3.x; f1.w = a3.y;
                O[dt] = __builtin_amdgcn_mfma_f32_32x32x16_bf16(__builtin_bit_cast(bf16x8, f0), pf0, O[dt], 0, 0, 0);
                O[dt] = __builtin_amdgcn_mfma_f32_32x32x16_bf16(__builtin_bit_cast(bf16x8, f1), pf1, O[dt], 0, 0, 0);
            }
        }
        lsum += __shfl_xor(lsum, 32);
        const float il = 1.f / lsum;
        float ss = 0.f;
#pragma unroll
        for (int dt = 0; dt < 4; ++dt)
#pragma unroll
            for (int i = 0; i < 16; ++i) { O[dt][i] *= il; ss += O[dt][i] * O[dt][i]; }
        ss += __shfl_xor(ss, 32);
        const float rr = rsqrtf(ss * (1.f / HD) + EPS);
        bf16* orow = MIXED + (size_t)mq * DM + h * HD;
#pragma unroll
        for (int dt = 0; dt < 4; ++dt)
#pragma unroll
            for (int rg = 0; rg < 4; ++rg) { const int d = 32 * dt + 8 * rg + 4 * hh; const f32x4 gg = *(const GAS f32x4*)(og + h * HD + d);
                v2u w; w.x = pk2(O[dt][4 * rg + 0] * rr * gg.x, O[dt][4 * rg + 1] * rr * gg.y); w.y = pk2(O[dt][4 * rg + 2] * rr * gg.z, O[dt][4 * rg + 3] * rr * gg.w);
                *(GAS v2u*)(orow + d) = w; }
        LDS_WAIT();
    }
}


constexpr int AT_KBYTES = 16384, AT_VPITCH = 136, AT_VBYTES = 128 * AT_VPITCH, AT_STAGE = AT_KBYTES + AT_VBYTES, AT_RP_OFF = 2 * AT_STAGE;
__device__ __forceinline__ void phase_attn2(Frame& F) {
    const bf16* QK = (const bf16*)(F.ws + WS_QK); const bf16* VT = (const bf16*)(F.ws + WS_XT); bf16* MIXED = (bf16*)(F.ws + WS_MIXED);
    const float* rpb = F.in[5]; const float* og = F.in[15];
    LAS float* rp = (LAS float*)(F.lds + AT_RP_OFF + F.wave * 2048);
    const int n = F.lane & 31, hh = F.lane >> 5;
    for (int unit = F.bid; unit < NB * NH * 16; unit += F.G) {
        const int rq = unit & 15, h = (unit >> 4) & 7, b = unit >> 7, r0 = 4 * rq;
        const int r = r0 + (F.wave >> 1), wq = F.wave & 1;
        int kmin = r0 - WR / 2; kmin = kmin < 0 ? 0 : (kmin > NROWS - WR ? NROWS - WR : kmin);
        int kmax = r0 + 3 - WR / 2; kmax = (kmax < 0 ? 0 : (kmax > NROWS - WR ? NROWS - WR : kmax)) + WR - 1;
        int kr0 = r - WR / 2; kr0 = kr0 < 0 ? 0 : (kr0 > NROWS - WR ? NROWS - WR : kr0);
        const int nrows = kmax - kmin + 1;
        __syncthreads();
        for (int i = F.lane; i < 15 * 31; i += 64) rp[i] = rpb[h * 465 + i];
        const int mq = b * SEQ + r * GW + 32 * wq + n, qc = 32 * wq + n;
        int c0 = qc - WC / 2; c0 = c0 < 0 ? 0 : (c0 > GW - WC ? GW - WC : c0);
        bf16x8 qf[8];
#pragma unroll
        for (int ks = 0; ks < 8; ++ks) qf[ks] = *(const GAS bf16x8*)(QK + (size_t)mq * 2048 + h * HD + 16 * ks + 8 * hh);
        f32x16 O[4];
#pragma unroll
        for (int dt = 0; dt < 4; ++dt)
#pragma unroll
            for (int i = 0; i < 16; ++i) O[dt][i] = 0.f;
        float lsum = 0.f;
        v4u sk[2], sv[2];
        auto gload = [&](int kr) {
#pragma unroll
            for (int j = 0; j < 2; ++j) { const int id = F.tid + 512 * j;
                sk[j] = *(const GAS v4u*)(QK + (size_t)(b * SEQ + kr * GW + (id >> 4)) * 2048 + 1024 + h * HD + 8 * (id & 15));
                sv[j] = *(const GAS v4u*)(VT + (size_t)(h * HD + (id >> 3)) * MT + b * SEQ + kr * GW + 8 * (id & 7)); }
        };
        auto lstore = [&](int buf) {
            LAS unsigned char* kb = F.lds + buf * AT_STAGE; LAS unsigned char* vb = kb + AT_KBYTES;
#pragma unroll
            for (int j = 0; j < 2; ++j) { const int id = F.tid + 512 * j; const int key = id >> 4, c = id & 15;
                *(LAS v4u*)(kb + key * 256 + ((c ^ (key & 15)) << 4)) = sk[j];
                const int d = id >> 3, cv = id & 7; LAS v2u* vp = (LAS v2u*)(vb + d * AT_VPITCH + cv * 16);
                v2u lo, hi; lo.x = sv[j].x; lo.y = sv[j].y; hi.x = sv[j].z; hi.y = sv[j].w; vp[0] = lo; vp[1] = hi; }
        };
        gload(kmin); lstore(0);
        __syncthreads();
#pragma unroll 1
        for (int j = 0; j < nrows; ++j) {
            const int kr = kmin + j, buf = j & 1;
            if (j + 1 < nrows) gload(kr + 1);
            if (kr >= kr0 && kr < kr0 + WR) {
                const LAS unsigned char* kb = F.lds + buf * AT_STAGE; const LAS unsigned char* vb = kb + AT_KBYTES;
                const int dr = kr - r + WR - 1;
#pragma unroll
                for (int kt = 0; kt < 2; ++kt) {
                    f32x16 S;
#pragma unroll
                    for (int i = 0; i < 16; ++i) S[i] = 0.f;
                    const int key = 32 * kt + n;
#pragma unroll
                    for (int ks = 0; ks < 8; ++ks) { const bf16x8 kf = *(const LAS bf16x8*)(kb + key * 256 + (((2 * ks + hh) ^ (key & 15)) << 4));
                        S = __builtin_amdgcn_mfma_f32_32x32x16_bf16(kf, qf[ks], S, 0, 0, 0); }
                    float p[16];
#pragma unroll
                    for (int i = 0; i < 16; ++i) { const int kc = 32 * kt + (i & 3) + 8 * (i >> 2) + 4 * hh; const bool valid = (kc >= c0) && (kc < c0 + WC);
                        int dc = kc - qc + WC - 1; dc = dc < 0 ? 0 : (dc > 2 * WC - 2 ? 2 * WC - 2 : dc);
                        const float e = __expf(S[i] * 0.08838834764831845f + rp[dr * 31 + dc]); p[i] = valid ? e : 0.f; lsum += p[i]; }
                    v4u pw0, pw1;
                    pw0.x = pk2(p[0], p[1]); pw0.y = pk2(p[2], p[3]); pw0.z = pk2(p[4], p[5]); pw0.w = pk2(p[6], p[7]);
                    pw1.x = pk2(p[8], p[9]); pw1.y = pk2(p[10], p[11]); pw1.z = pk2(p[12], p[13]); pw1.w = pk2(p[14], p[15]);
                    const bf16x8 pf0 = __builtin_bit_cast(bf16x8, pw0), pf1 = __builtin_bit_cast(bf16x8, pw1);
#pragma unroll
                    for (int dt = 0; dt < 4; ++dt) {
                        const LAS unsigned char* vrow = vb + (32 * dt + n) * AT_VPITCH + (32 * kt + 4 * hh) * 2;
                        const v2u a0 = *(const LAS v2u*)(vrow), a1 = *(const LAS v2u*)(vrow + 16), a2 = *(const LAS v2u*)(vrow + 32), a3 = *(const LAS v2u*)(vrow + 48);
                        v4u f0, f1; f0.x = a0.x; f0.y = a0.y; f0.z = a1.x; f0.w = a1.y; f1.x = a2.x; f1.y = a2.y; f1.z = a3.x; f1.w = a3.y;
                        O[dt] = __builtin_amdgcn_mfma_f32_32x32x16_bf16(__builtin_bit_cast(bf16x8, f0), pf0, O[dt], 0, 0, 0);
                        O[dt] = __builtin_amdgcn_mfma_f32_32x32x16_bf16(__builtin_bit_cast(bf16x8, f1), pf1, O[dt], 0, 0, 0);
                    }
                }
            }
            if (j + 1 < nrows) lstore(buf ^ 1);
            __syncthreads();
        }
        lsum += __shfl_xor(lsum, 32);
        const float il = 1.f / lsum;
        float ss = 0.f;
#pragma unroll
        for (int dt = 0; dt < 4; ++dt)
#pragma unroll
            for (int i = 0; i < 16; ++i) { O[dt][i] *= il; ss += O[dt][i] * O[dt][i]; }
        ss += __shfl_xor(ss, 32);
        const float rr = rsqrtf(ss * (1.f / HD) + EPS);
        bf16* orow = MIXED + (size_t)mq * DM + h * HD;
#pragma unroll
        for (int dt = 0; dt < 4; ++dt)
#pragma unroll
            for (int rg = 0; rg < 4; ++rg) { const int d = 32 * dt + 8 * rg + 4 * hh; const f32x4 gg = *(const GAS f32x4*)(og + h * HD + d);
                v2u w; w.x = pk2(O[dt][4 * rg + 0] * rr * gg.x, O[dt][4 * rg + 1] * rr * gg.y); w.y = pk2(O[dt][4 * rg + 2] * rr * gg.z, O[dt][4 * rg + 3] * rr * gg.w);
                *(GAS v2u*)(orow + d) = w; }
    }
    __syncthreads();
}

__device__ __forceinline__ void phase_p15(Frame& F) {
    bf16* QK = (bf16*)(F.ws + WS_QK); const float* qg = F.in[3]; const float* kg = F.in[4];
    for (int m = GW_ID(F); m < MT; m += GW_N(F)) {
        GAS v4u* rowp = (GAS v4u*)(QK + (size_t)m * 2048) + F.lane;
#pragma unroll
        for (int j = 0; j < 4; ++j) {
            v4u w = rowp[64 * j];
            float f[8] = {bflo(w.x), bfhi(w.x), bflo(w.y), bfhi(w.y), bflo(w.z), bfhi(w.z), bflo(w.w), bfhi(w.w)};
            float ss = 0.f;
#pragma unroll
            for (int e = 0; e < 8; ++e) ss += f[e] * f[e];
            ss += __shfl_xor(ss, 1); ss += __shfl_xor(ss, 2); ss += __shfl_xor(ss, 4); ss += __shfl_xor(ss, 8);
            const float r = rsqrtf(ss * (1.f / HD) + EPS);
            const int col = 512 * j + 8 * F.lane, d = col & 127; const float* g = (col < 1024 ? qg : kg) + d;
#pragma unroll
            for (int e = 0; e < 8; ++e) f[e] = f[e] * r * g[e];
            w.x = pk2(f[0], f[1]); w.y = pk2(f[2], f[3]); w.z = pk2(f[4], f[5]); w.w = pk2(f[6], f[7]);
            rowp[64 * j] = w;
        }
    }
    const bf16* XT = (const bf16*)(F.ws + WS_XT) + (size_t)1024 * MT; bf16* UC = (bf16*)(F.ws + WS_UC);
    const float* cw = F.in[6]; const float* cb = F.in[7];
    const size_t nchunks = (size_t)3072 * MT / 8;
    for (size_t i = (size_t)F.bid * NTHREADS + F.tid; i < nchunks; i += (size_t)F.G * NTHREADS) {
        const int ch = (int)(i >> 10), m0 = (int)(i & 1023) * 8, s0 = m0 & 4095;
        const bf16* up = XT + (size_t)ch * MT + m0;
        const v4u w = *(const GAS v4u*)up;
        float f[10];
        f[1] = bflo(w.x); f[2] = bfhi(w.x); f[3] = bflo(w.y); f[4] = bfhi(w.y); f[5] = bflo(w.z); f[6] = bfhi(w.z); f[7] = bflo(w.w); f[8] = bfhi(w.w);
        f[0] = s0 > 0 ? bf2f(up[-1]) : 0.f; f[9] = s0 + 8 < SEQ ? bf2f(up[8]) : 0.f;
        const float w0 = cw[ch], w1 = cw[3072 + ch], w2 = cw[6144 + ch], bb = cb[ch];
        float o[8];
#pragma unroll
        for (int e = 0; e < 8; ++e) o[e] = bb + w0 * f[e] + w1 * f[e + 1] + w2 * f[e + 2];
        v4u ov; ov.x = pk2(o[0], o[1]); ov.y = pk2(o[2], o[3]); ov.z = pk2(o[4], o[5]); ov.w = pk2(o[6], o[7]);
        *(GAS v4u*)(UC + (size_t)ch * MT + m0) = ov;
    }
}
__device__ __forceinline__ void phase_p25(Frame& F) {
    const bf16* HYT = (const bf16*)(F.ws + WS_HYT); bf16* MIXED = (bf16*)(F.ws + WS_MIXED); const float* hg = F.in[16];
    LAS float* tile = (LAS float*)F.lds;
    LAS float* rs = (LAS float*)(F.lds + 128 * 65 * 4);
    for (int it = F.bid; it < 8 * (MT / 64); it += F.G) {
        const int gi = it & 7, m0 = (it >> 3) * 64;
        { const int ch = F.tid >> 2, t0 = (F.tid & 3) * 16; const bf16* p = HYT + (size_t)(gi * 128 + ch) * MT + m0 + t0;
          const v4u a = *(const GAS v4u*)p, b = *(const GAS v4u*)(p + 8);
          LAS float* d = tile + ch * 65 + t0;
          d[0] = bflo(a.x); d[1] = bfhi(a.x); d[2] = bflo(a.y); d[3] = bfhi(a.y); d[4] = bflo(a.z); d[5] = bfhi(a.z); d[6] = bflo(a.w); d[7] = bfhi(a.w);
          d[8] = bflo(b.x); d[9] = bfhi(b.x); d[10] = bflo(b.y); d[11] = bfhi(b.y); d[12] = bflo(b.z); d[13] = bfhi(b.z); d[14] = bflo(b.w); d[15] = bfhi(b.w); }
        __syncthreads();
        {
          const int t = F.tid >> 3, c0 = (F.tid & 7) * 16; float ss = 0.f;
#pragma unroll
          for (int c = 0; c < 16; ++c) { const float v = tile[(c0 + c) * 65 + t]; ss += v * v; }
          ss += __shfl_xor(ss, 1); ss += __shfl_xor(ss, 2); ss += __shfl_xor(ss, 4);
          if ((F.tid & 7) == 0) rs[t] = rsqrtf(ss * (1.f / 128) + EPS); }
        __syncthreads();
        {
          const int t = F.tid >> 3, c0 = (F.tid & 7) * 16; const float r = rs[t]; float o[16];
#pragma unroll
          for (int c = 0; c < 16; ++c) o[c] = tile[(c0 + c) * 65 + t] * r * hg[gi * 128 + c0 + c];
          v4u a, b; a.x = pk2(o[0], o[1]); a.y = pk2(o[2], o[3]); a.z = pk2(o[4], o[5]); a.w = pk2(o[6], o[7]); b.x = pk2(o[8], o[9]); b.y = pk2(o[10], o[11]); b.z = pk2(o[12], o[13]); b.w = pk2(o[14], o[15]);
          bf16* q = MIXED + (size_t)(m0 + t) * DM + AW + gi * 128 + c0; *(GAS v4u*)q = a; *(GAS v4u*)(q + 8) = b; }
        __syncthreads();
    }
}
__device__ __forceinline__ void phase_p35(Frame& F) {
    LAS float* wrT = (LAS float*)F.lds;
    const float* wr = F.in[19]; const float* g = F.in[18];
    for (int i = F.tid; i < DM * NE; i += NTHREADS) { const int d = i >> 4, e = i & 15; wrT[e * DM + d] = wr[i]; }
    __syncthreads();
    bf16* HB = (bf16*)(F.ws + WS_HB); float* AFF = (float*)(F.ws + WS_AFF); const float* x1 = F.out;
    for (int m = GW_ID(F); m < MT; m += GW_N(F)) {
        const GAS f32x4* xr = (const GAS f32x4*)(x1 + (size_t)m * DM) + F.lane;
        f32x4 v[8]; float s = 0.f;
#pragma unroll
        for (int j = 0; j < 8; ++j) { v[j] = xr[64 * j]; s += (v[j].x * v[j].x + v[j].y * v[j].y) + (v[j].z * v[j].z + v[j].w * v[j].w); }
        const float r = rsqrtf(wave_sum(s) * (1.f / DM) + EPS);
        GAS v2u* o8 = (GAS v2u*)(HB + (size_t)m * DM) + F.lane;
#pragma unroll
        for (int j = 0; j < 8; ++j) { const f32x4 gg = *((const GAS f32x4*)g + F.lane + 64 * j); v[j].x *= r * gg.x; v[j].y *= r * gg.y; v[j].z *= r * gg.z; v[j].w *= r * gg.w;
            v2u o; o.x = pk2(v[j].x, v[j].y); o.y = pk2(v[j].z, v[j].w); o8[64 * j] = o; }
        float mine = 0.f;
#pragma unroll 1
        for (int e = 0; e < NE; ++e) { float a = 0.f;
#pragma unroll
            for (int j = 0; j < 8; ++j) { const f32x4 w = *((const LAS f32x4*)(wrT + e * DM) + F.lane + 64 * j); a += (v[j].x * w.x + v[j].y * w.y) + (v[j].z * w.z + v[j].w * w.w); }
            a = wave_sum(a); mine = (F.lane == e) ? a : mine; }
        float mx = mine;
        mx = fmaxf(mx, __shfl_xor(mx, 1)); mx = fmaxf(mx, __shfl_xor(mx, 2)); mx = fmaxf(mx, __shfl_xor(mx, 4)); mx = fmaxf(mx, __shfl_xor(mx, 8));
        const float ex = expf(mine - mx); float den = ex;
        den += __shfl_xor(den, 1); den += __shfl_xor(den, 2); den += __shfl_xor(den, 4); den += __shfl_xor(den, 8);
        const int b = m / SEQ, sidx = m % SEQ;
        if (F.lane < NE) AFF[((size_t)b * NE + F.lane) * SEQ + sidx] = ex / den;
    }
    __syncthreads();
}
__device__ __forceinline__ void phase_p4(Frame& F) {
    LAS unsigned* key = (LAS unsigned*)F.lds;
    LAS unsigned* hist = (LAS unsigned*)(F.lds + 16384);
    LAS unsigned* wsum = (LAS unsigned*)(F.lds + 16384 + 1024);
    const float* AFF = (const float*)(F.ws + WS_AFF); int* IDX = (int*)(F.ws + WS_IDX); float* GATE = (float*)(F.ws + WS_GATE); int* SEL = (int*)(F.ws + WS_SEL);
    for (int be = F.bid; be < NB * NE; be += F.G) {
        const int b = be / NE, e = be % NE;
        __syncthreads();
        const GAS v4u* ap = (const GAS v4u*)(AFF + (size_t)be * SEQ);
        const v4u k0 = ap[2 * F.tid], k1 = ap[2 * F.tid + 1];
        unsigned kk[8] = {k0.x, k0.y, k0.z, k0.w, k1.x, k1.y, k1.z, k1.w};
        unsigned prefix = 0u, mask = 0u, remaining = CAP;
#pragma unroll 1
        for (int pass = 0; pass < 4; ++pass) {
            const int shift = 24 - 8 * pass;
            if (F.tid < 256) hist[F.tid] = 0u;
            __syncthreads();
#pragma unroll
            for (int i = 0; i < 8; ++i) if ((kk[i] & mask) == prefix) __hip_atomic_fetch_add(&hist[(kk[i] >> shift) & 255u], 1u, __ATOMIC_RELAXED, __HIP_MEMORY_SCOPE_WORKGROUP);
            __syncthreads();
            if (F.tid < 256) {
                unsigned above = 0u;
                for (int j = F.tid + 1; j < 256; ++j) above += hist[j];
                const unsigned mine = hist[F.tid];
                if (above < remaining && remaining <= above + mine) { wsum[8] = (unsigned)F.tid; wsum[9] = above; }
            }
            __syncthreads();
            const unsigned d = wsum[8], above = wsum[9];
            prefix |= d << shift; mask |= 255u << shift; remaining -= above;
            __syncthreads();
        }
        const unsigned thr = prefix;
        unsigned cnt = 0u;
#pragma unroll
        for (int i = 0; i < 8; ++i) cnt += (kk[i] > thr ? 0x10000u : 0u) + (kk[i] == thr ? 1u : 0u);
        unsigned incl = cnt;
#pragma unroll
        for (int o = 1; o < 64; o <<= 1) { const unsigned t = __shfl_up(incl, o); if (F.lane >= o) incl += t; }
        if (F.lane == 63) wsum[F.wave] = incl;
        __syncthreads();
        unsigned base = 0u;
        for (int w = 0; w < F.wave; ++w) base += wsum[w];
        unsigned run = base + incl - cnt;
#pragma unroll
        for (int i = 0; i < 8; ++i) {
            const unsigned gt_before = run >> 16, tie_before = run & 0xffffu;
            const bool isgt = kk[i] > thr, istie = kk[i] == thr;
            const bool sel = isgt || (istie && tie_before < remaining);
            const unsigned slot = gt_before + (tie_before < remaining ? tie_before : remaining);
            const int s = 8 * F.tid + i, m = b * SEQ + s;
            if (sel) { IDX[be * CAP + slot] = m; GATE[be * CAP + slot] = __builtin_bit_cast(float, kk[i]); }
            SEL[(size_t)m * NE + e] = sel ? (int)slot : -1;
            run += (isgt ? 0x10000u : 0u) + (istie ? 1u : 0u);
        }
    }
    __syncthreads();
}
__device__ __forceinline__ void phase_p7(Frame& F) {
    const int* SEL = (const int*)(F.ws + WS_SEL); const float* GATE = (const float*)(F.ws + WS_GATE); const bf16* YE = (const bf16*)(F.ws + WS_YE);
    for (int m = GW_ID(F); m < MT; m += GW_N(F)) {
        const int b = m / SEQ;
        GAS f32x4* orow = (GAS f32x4*)(F.out + (size_t)m * DM);
        f32x4 acc[8];
#pragma unroll
        for (int j = 0; j < 8; ++j) acc[j] = orow[2 * F.lane + (j & 1) + 128 * (j >> 1)];
        for (int e = 0; e < NE; ++e) { const int slot = SEL[(size_t)m * NE + e]; if (slot >= 0) {
            const GAS v4u* yr = (const GAS v4u*)(YE + (size_t)((b * NE + e) * CAP + slot) * DM) + F.lane;
#pragma unroll
            for (int jj = 0; jj < 4; ++jj) { const v4u w = yr[64 * jj];
                acc[2 * jj].x += bflo(w.x); acc[2 * jj].y += bfhi(w.x); acc[2 * jj].z += bflo(w.y); acc[2 * jj].w += bfhi(w.y);
                acc[2 * jj + 1].x += bflo(w.z); acc[2 * jj + 1].y += bfhi(w.z); acc[2 * jj + 1].z += bflo(w.w); acc[2 * jj + 1].w += bfhi(w.w); } } }
#pragma unroll
        for (int j = 0; j < 8; ++j) orow[2 * F.lane + (j & 1) + 128 * (j >> 1)] = acc[j];
    }
    (void)GATE;
}

struct Args { const float* in[23]; float* out; unsigned char* ws; int ph_lo, ph_hi; };
enum Phase { PH_P0 = 0, PH_G1, PH_FILT, PH_P15, PH_ATTN, PH_P25, PH_OUT, PH_P35, PH_P4, PH_UP, PH_DOWN, PH_P7, PH_COUNT };

__global__ void __launch_bounds__(NTHREADS, 2) mk_fwd(Args args) {
    extern __shared__ __attribute__((aligned(16))) unsigned char lds_raw[];
    Frame F;
    F.lds = (LAS unsigned char*)lds_raw;
    F.tid = threadIdx.x; F.lane = F.tid & 63; F.wave = __builtin_amdgcn_readfirstlane(F.tid >> 6); F.G = gridDim.x; F.bid = blockIdx.x;
#pragma unroll
    for (int i = 0; i < 23; ++i) F.in[i] = args.in[i];
    F.out = args.out; F.ws = args.ws;
    const int lo = args.ph_lo, hi = args.ph_hi;
#define IN(k) (lo <= (k) && (k) < hi)
#define REPS(k) for (int rep_ = 0; rep_ < ((k) == REP_PHASE ? REP_N : 1); ++rep_)
#if MK_N_LAUNCHES == 1
    { volatile LAS unsigned* misc = (volatile LAS unsigned*)(F.lds + LDS_MISC_OFF); if (F.tid < 16) misc[F.tid] = 0u; }
    __syncthreads();
    XcdBarrier bar = xcd_barrier_post((unsigned*)(F.ws + WS_CTL) + 4096, (volatile LAS unsigned*)(F.lds + LDS_MISC_OFF) + 8);
#define SEAM(k) do { if (IN(k) && IN((k) + 1)) xcd_barrier(bar); } while (0)
#else
#define SEAM(k) do { } while (0)
#endif
    if (IN(PH_P0)) REPS(PH_P0) { phase_p0(F); } SEAM(PH_P0);
    if (IN(PH_G1)) REPS(PH_G1) {
        __syncthreads();
        { pg8::DenseOrder S; S.init(F.ws + WS_HB, F.ws + WS_WIN, MT, 2048, DM, 0, F.G, F.bid);
          pg8::EpiBf16 E{(pg8::bf16_t*)(F.ws + WS_QK), 2048, 0, nullptr};
          pg8::gemm_phase<pg8::EpiBf16, pg8::DenseOrder, true>(F.lds, DM, S, E); }
        { pg8::DenseOrder S; S.init(F.ws + WS_HB, F.ws + WS_WIN, MT, 4096, DM, 8, F.G, F.bid);
          pg8::EpiTransBf16 E{(pg8::bf16_t*)(F.ws + WS_XT), MT, 8};
          pg8::gemm_phase<pg8::EpiTransBf16, pg8::DenseOrder, true>(F.lds, DM, S, E); }
    } SEAM(PH_G1);
    if (IN(PH_FILT)) REPS(PH_FILT) { phase_filters(F); } SEAM(PH_FILT);
    if (IN(PH_P15)) { phase_p15(F); } SEAM(PH_P15);
    if (IN(PH_ATTN)) { __syncthreads(); for (int rep_ = 0; rep_ < ((PH_ATTN == REP_PHASE && REP_SUB != 2) ? REP_N : 1); ++rep_) phase_hyena(F); for (int rep_ = 0; rep_ < ((PH_ATTN == REP_PHASE && REP_SUB != 1) ? REP_N : 1); ++rep_) phase_attn2(F); } SEAM(PH_ATTN);
    if (IN(PH_P25)) REPS(PH_P25) { __syncthreads(); phase_p25(F); } SEAM(PH_P25);
    if (IN(PH_OUT)) REPS(PH_OUT) {
        __syncthreads();
        pg8::DenseOrder S; S.init(F.ws + WS_MIXED, F.ws + WS_WOUT, MT, DM, DM, 0, F.G, F.bid);
        pg8::EpiResF32 E{F.in[0], F.out, DM};
        pg8::gemm_phase<pg8::EpiResF32, pg8::DenseOrder, false>(F.lds, DM, S, E);
    } SEAM(PH_OUT);
    if (IN(PH_P35)) REPS(PH_P35) { __syncthreads(); phase_p35(F); } SEAM(PH_P35);
    if (IN(PH_P4)) REPS(PH_P4) { __syncthreads(); phase_p4(F); } SEAM(PH_P4);
    if (IN(PH_UP)) REPS(PH_UP) {
        __syncthreads();
        pg8::MoeOrder S; S.init(F.ws + WS_HB, F.ws + WS_WGU, DM, F.G, F.bid, true);
        LAS int* ridx = (LAS int*)(F.lds + 131072);
        { const int* IDX = (const int*)(F.ws + WS_IDX); pg8::Unit u;
          for (int i = 0; S.next(i, u); ++i) if (F.tid < 256) ridx[i * 256 + F.tid] = IDX[u.g * CAP + u.pm * 256 + F.tid]; }
        __syncthreads();
        pg8::EpiSwiGLU E{(pg8::bf16_t*)(F.ws + WS_ACT)};
        pg8::gemm_phase<pg8::EpiSwiGLU, pg8::MoeOrder, true, true>(F.lds, DM, S, E, ridx);
    } SEAM(PH_UP);
    if (IN(PH_DOWN)) REPS(PH_DOWN) {
        __syncthreads();
        pg8::MoeOrder S; S.init(F.ws + WS_ACT, F.ws + WS_WD, FF, F.G, F.bid, false);
        pg8::EpiBf16 E{(pg8::bf16_t*)(F.ws + WS_YE), DM, 512, (const float*)(F.ws + WS_GATE)};
        pg8::gemm_phase<pg8::EpiBf16, pg8::MoeOrder, true>(F.lds, FF, S, E);
    } SEAM(PH_DOWN);
    if (IN(PH_P7)) { phase_p7(F); }
#undef IN
#undef SEAM
}

extern "C" void kernel_launch(void* const* d_in, const int* in_sizes, int n_in, void* d_out, int out_size, void* d_ws, size_t ws_size, hipStream_t stream) {
    static int grid = 0;
    if (grid == 0) {
        if (n_in != 23 || ws_size < WS_END) { fprintf(stderr, "kernel_launch: unexpected inputs (n_in %d, ws %zu)\n", n_in, ws_size); grid = -1; return; }
        if (hipFuncSetAttribute((const void*)mk_fwd, hipFuncAttributeMaxDynamicSharedMemorySize, LDS_BYTES) != hipSuccess) { fprintf(stderr, "kernel_launch: hipFuncSetAttribute failed\n"); grid = -1; return; }
        int dev = 0, cus = 0, per_cu = 0;
        hipGetDevice(&dev); hipDeviceGetAttribute(&cus, hipDeviceAttributeMultiprocessorCount, dev);
        hipOccupancyMaxActiveBlocksPerMultiprocessor(&per_cu, (const void*)mk_fwd, NTHREADS, LDS_BYTES);
        (void)hipGetLastError();
        if (per_cu < 1) { fprintf(stderr, "kernel_launch: occupancy query says %d blocks/CU\n", per_cu); }
        grid = cus;
    }
    if (grid < 0) return;
    Args a{};
    for (int i = 0; i < 23; ++i) a.in[i] = (const float*)d_in[i];
    a.out = (float*)d_out; a.ws = (unsigned char*)d_ws;
#if MK_N_LAUNCHES == 1
    if (hipMemsetAsync((char*)d_ws + WS_CTL, 0, CTL_ZERO_BYTES, stream) != hipSuccess) { fprintf(stderr, "kernel_launch: memset failed\n"); return; }
    a.ph_lo = 0; a.ph_hi = PH_COUNT;
    void* kargs[] = {&a};
    hipError_t e = hipLaunchCooperativeKernel((const void*)mk_fwd, dim3(grid), dim3(NTHREADS), kargs, LDS_BYTES, stream);
    if (e != hipSuccess) fprintf(stderr, "cooperative launch failed: %s (grid %d)\n", hipGetErrorString(e), grid);
#else
    for (int p = 0; p < PH_COUNT; ++p) { a.ph_lo = p; a.ph_hi = p + 1; hipLaunchKernelGGL(mk_fwd, dim3(grid), dim3(NTHREADS), LDS_BYTES, stream, a); }
#endif
}
```

```cpp
#include <hip/hip_runtime.h>
#include <hip/hip_cooperative_groups.h>
#include <cstdio>
#include <cstdint>
namespace cg = cooperative_groups;

#ifndef REP_PHASE
#define REP_PHASE -1
#define REP_N 1
#define REP_SUB 0
#endif
#ifndef MK_N_LAUNCHES
#define MK_N_LAUNCHES 1
#endif

namespace pg8 {
#define PG8_LAS __attribute__((address_space(3)))
typedef unsigned short bf16_t;
typedef short bf16x8 __attribute__((ext_vector_type(8)));
typedef float f32x4 __attribute__((ext_vector_type(4)));
typedef unsigned u32x4 __attribute__((ext_vector_type(4)));
typedef unsigned u32x2 __attribute__((ext_vector_type(2)));
constexpr int BM = 256, BK = 64, HALF = 128, HTB = HALF * BK * 2, STAGE_BYTES = 8 * HTB, NXCD = 8, WGM = 8;

__host__ __device__ __forceinline__ int lds_byte(int r, int c) { const int st = (r >> 4) * 2 + (c >> 5), rr = r & 15, cc = c & 31, ob = rr * 64 + cc * 2; return st * 1024 + (ob ^ (((ob >> 9) & 1) << 5)); }
__host__ __device__ __forceinline__ void stage_rc(int b, int& R, int& C) { const int st = b / 1024, sb = b % 1024, swz = sb ^ (((sb >> 9) & 1) << 5); R = (st >> 1) * 16 + swz / 64; C = (st & 1) * 32 + (swz % 64) / 2; }
__host__ __device__ __forceinline__ int perm32(int rho) { const int n = rho >> 4, i = rho & 15; return 8 * (i >> 2) + 4 * n + (i & 3); }

struct Unit { int pm, pn, g; const char* a; const char* b; };

__device__ __forceinline__ unsigned cvt_pk_bf16(float lo, float hi) { unsigned r; asm volatile("v_cvt_pk_bf16_f32 %0, %1, %2" : "=v"(r) : "v"(lo), "v"(hi)); return r; }

struct DenseOrder {
    int nM, nN, nwg, G, c, K, pn0; const char* A; const char* Bt;
    __device__ void init(const void* A_, const void* Bt_, int M, int N, int K_, int pn0_, int G_, int c_) { A = (const char*)A_; Bt = (const char*)Bt_; nM = M / BM; nN = N / BM; nwg = nM * nN; G = G_; c = c_; K = K_; pn0 = pn0_; }
    __device__ bool next(int i, Unit& u) const {
        const long L = (long)i * G + c; if (L >= nwg) return false;
        int wgid = (int)L; { const int q = nwg / NXCD, r = nwg % NXCD, xcd = wgid % NXCD, off = wgid / NXCD; wgid = (xcd < r ? xcd * (q + 1) : r * (q + 1) + (xcd - r) * q) + off; }
        const int nig = WGM * nN, gid = wgid / nig, fm = gid * WGM, gsz = (nM - fm) < WGM ? (nM - fm) : WGM;
        u.pm = fm + ((wgid % nig) % gsz); u.pn = pn0 + (wgid % nig) / gsz; u.g = 0;
        u.a = A + (size_t)u.pm * BM * K * 2; u.b = Bt + (size_t)u.pn * BM * K * 2; return true;
    }
};
struct MoeOrder {
    int G, c, K; bool gather; const char* A; const char* Bt;
    __device__ void init(const void* A_, const void* Bt_, int K_, int G_, int c_, bool gather_) { A = (const char*)A_; Bt = (const char*)Bt_; K = K_; G = G_; c = c_; gather = gather_; }
    __device__ bool next(int i, Unit& u) const {
        const int L = i * G + c; if (L >= 512) return false;
        const int pn = L & 7, pm = (L >> 3) & 1, b = (L >> 4) & 1, e = L >> 5;
        u.pm = pm; u.pn = pn; u.g = b * 16 + e;
        u.a = gather ? A : A + (size_t)(u.g * 512 + pm * BM) * K * 2; u.b = Bt + (size_t)(e * 2048 + pn * BM) * K * 2; return true;
    }
};

struct EpiBf16 {
    static constexpr bool PERM = true, SWAP = false;
    bf16_t* O; int ldc; int grows; const float* rscale;
    __device__ __forceinline__ void operator()(const f32x4 (&acc)[2][2][4][2], const Unit& u, int wr, int wc, int fr, int fq) const {
        const int row0 = u.g * grows + u.pm * BM + wr * 64 + fr, col0 = u.pn * BM + wc * 32 + 8 * fq;
#pragma unroll
        for (int ai = 0; ai < 2; ++ai)
#pragma unroll
            for (int m = 0; m < 4; ++m) { const int row = row0 + ai * HALF + m * 16; bf16_t* rowp = O + (size_t)row * ldc + col0; const float sc = rscale ? rscale[row] : 1.f;
#pragma unroll
                for (int bj = 0; bj < 2; ++bj) { const f32x4 v0 = acc[ai][bj][m][0] * sc, v1 = acc[ai][bj][m][1] * sc;
                    u32x4 w; w.x = cvt_pk_bf16(v0[0], v0[1]); w.y = cvt_pk_bf16(v0[2], v0[3]); w.z = cvt_pk_bf16(v1[0], v1[1]); w.w = cvt_pk_bf16(v1[2], v1[3]);
                    *(u32x4*)(rowp + bj * HALF) = w; } }
    }
};
struct EpiSwiGLU {
    static constexpr bool PERM = true, SWAP = false;
    bf16_t* O;
    __device__ __forceinline__ void operator()(const f32x4 (&acc)[2][2][4][2], const Unit& u, int wr, int wc, int fr, int fq) const {
        const int row0 = u.g * 512 + u.pm * BM + wr * 64 + fr, col0 = u.pn * HALF + wc * 32 + 8 * fq;
#pragma unroll
        for (int ai = 0; ai < 2; ++ai)
#pragma unroll
            for (int m = 0; m < 4; ++m) { bf16_t* rowp = O + (size_t)(row0 + ai * HALF + m * 16) * 1024 + col0;
                float r[8];
#pragma unroll
                for (int n = 0; n < 2; ++n)
#pragma unroll
                    for (int e = 0; e < 4; ++e) { const float g = acc[ai][0][m][n][e], up = acc[ai][1][m][n][e]; r[n * 4 + e] = g / (1.f + __expf(-g)) * up; }
                u32x4 w; w.x = cvt_pk_bf16(r[0], r[1]); w.y = cvt_pk_bf16(r[2], r[3]); w.z = cvt_pk_bf16(r[4], r[5]); w.w = cvt_pk_bf16(r[6], r[7]);
                *(u32x4*)rowp = w; }
    }
};
struct EpiResF32 {
    static constexpr bool PERM = false, SWAP = false;
    const float* res; float* out; int ldc;
    __device__ __forceinline__ void operator()(const f32x4 (&acc)[2][2][4][2], const Unit& u, int wr, int wc, int fr, int fq) const {
        const int row0 = u.pm * BM + wr * 64 + fr, col0 = u.pn * BM + wc * 32 + 4 * fq;
#pragma unroll
        for (int ai = 0; ai < 2; ++ai)
#pragma unroll
            for (int m = 0; m < 4; ++m) { const size_t off = (size_t)(row0 + ai * HALF + m * 16) * ldc + col0;
#pragma unroll
                for (int bj = 0; bj < 2; ++bj)
#pragma unroll
                    for (int n = 0; n < 2; ++n) { const f32x4 r = *(const f32x4*)(res + off + bj * HALF + n * 16); *(f32x4*)(out + off + bj * HALF + n * 16) = r + acc[ai][bj][m][n]; } }
    }
};
struct EpiTransBf16 {
    static constexpr bool PERM = false, SWAP = true;
    bf16_t* O; int ldt; int pn_base;
    __device__ __forceinline__ void operator()(const f32x4 (&acc)[2][2][4][2], const Unit& u, int wr, int wc, int fr, int fq) const {
        const int ch0 = (u.pn - pn_base) * BM + wc * 32 + fr, t0 = u.pm * BM + wr * 64 + 4 * fq;
#pragma unroll
        for (int bj = 0; bj < 2; ++bj)
#pragma unroll
            for (int n = 0; n < 2; ++n) { bf16_t* chp = O + (size_t)(ch0 + bj * HALF + n * 16) * ldt + t0;
#pragma unroll
                for (int ai = 0; ai < 2; ++ai)
#pragma unroll
                    for (int m = 0; m < 4; ++m) { const f32x4 v = acc[ai][bj][m][n]; u32x2 w; w.x = cvt_pk_bf16(v[0], v[1]); w.y = cvt_pk_bf16(v[2], v[3]); *(u32x2*)(chp + ai * HALF + m * 16) = w; } }
    }
};

template <class Epi, class Sched, bool ALIGN_EPI = false, bool GATHER = false>
__device__ __forceinline__ void gemm_phase(PG8_LAS unsigned char* lds, const int K, const Sched& S, const Epi& E, const PG8_LAS int* ridx = nullptr) {
    const int tid = threadIdx.x, wid = __builtin_amdgcn_readfirstlane(tid >> 6), lane = tid & 63, wr = wid >> 2, wc = wid & 3, fr = lane & 15, fq = lane >> 4;
    const int nt = K / BK;
    unsigned vA0[2], vA1[2], vN0[2], vN1[2], voffB[2]; int stR[2], stC[2];
    const size_t kstep = (size_t)(BK * 2);
    const size_t hstep = (size_t)HALF * K * 2;
#pragma unroll
    for (int i = 0; i < 2; ++i) { int R, C; stage_rc(tid * 16 + i * 8192, R, C); const int Rb = Epi::PERM ? ((R & ~31) + perm32(R & 31)) : R; stR[i] = R; stC[i] = C;
        voffB[i] = (unsigned)(Rb * K + C) * 2u;
        if constexpr (GATHER) { vA0[i] = (unsigned)(ridx[R] * K + C) * 2u; vA1[i] = (unsigned)(ridx[HALF + R] * K + C) * 2u; }
        else { vA0[i] = (unsigned)(R * K + C) * 2u; vA1[i] = vA0[i] + (unsigned)hstep; }
        vN0[i] = vA0[i]; vN1[i] = vA1[i]; }
    const unsigned ldsw = (unsigned)wid * 1024u;
    const int aoff = lds_byte(wr * 64 + fr, fq * 8), boff = lds_byte(wc * 32 + fr, fq * 8);
#define PG8_SA(b, h) (((b) * 2 + (h)) * HTB)
#define PG8_SB(b, h) ((4 + (b) * 2 + (h)) * HTB)
#define PG8_STAGE(bufoff, gbase, voff) do { _Pragma("unroll") for (int _i = 0; _i < 2; ++_i) \
        __builtin_amdgcn_global_load_lds((const unsigned*)((const char*)(gbase) + (voff)[_i]), (PG8_LAS unsigned*)(lds + (bufoff) + ldsw + _i * 8192), 16, 0, 0); } while (0)
#define PG8_LDA(dst, b, h) do { _Pragma("unroll") for (int m = 0; m < 4; ++m) _Pragma("unroll") for (int k = 0; k < 2; ++k) dst[m][k] = *(const PG8_LAS bf16x8*)(lds + PG8_SA(b, h) + aoff + m * 2048 + k * 1024); } while (0)
#define PG8_LDB(dst, b, h) do { _Pragma("unroll") for (int n = 0; n < 2; ++n) _Pragma("unroll") for (int k = 0; k < 2; ++k) dst[n][k] = *(const PG8_LAS bf16x8*)(lds + PG8_SB(b, h) + boff + n * 2048 + k * 1024); } while (0)
#define PG8_MMA(ai, bj, At, Bt) do { __builtin_amdgcn_s_setprio(1); _Pragma("unroll") for (int m = 0; m < 4; ++m) _Pragma("unroll") for (int n = 0; n < 2; ++n) _Pragma("unroll") for (int k = 0; k < 2; ++k) \
        acc[ai][bj][m][n] = Epi::SWAP ? __builtin_amdgcn_mfma_f32_16x16x32_bf16(At[m][k], Bt[n][k], acc[ai][bj][m][n], 0, 0, 0) : __builtin_amdgcn_mfma_f32_16x16x32_bf16(Bt[n][k], At[m][k], acc[ai][bj][m][n], 0, 0, 0); __builtin_amdgcn_s_setprio(0); } while (0)
#define PG8_WAIT_V(n) asm volatile("s_waitcnt vmcnt(" #n ")" ::: "memory")
#define PG8_WAIT_L(n) asm volatile("s_waitcnt lgkmcnt(" #n ")" ::: "memory")
#define PG8_BAR __builtin_amdgcn_s_barrier()
#define PG8_SCHED __builtin_amdgcn_sched_barrier(0)
    Unit cur, nxt; int ui = 0;
    if (!S.next(0, cur)) return;
    f32x4 acc[2][2][4][2];
#pragma unroll
    for (int a = 0; a < 2; ++a)
#pragma unroll
        for (int b = 0; b < 2; ++b)
#pragma unroll
            for (int m = 0; m < 4; ++m)
#pragma unroll
                for (int n = 0; n < 2; ++n) acc[a][b][m][n] = (f32x4){0.f, 0.f, 0.f, 0.f};
    bf16x8 At[4][2], B0[2][2], B1[2][2];
    const char* cA = cur.a; const char* cB = cur.b;
    PG8_STAGE(PG8_SB(0, 0), cB, voffB); PG8_STAGE(PG8_SB(0, 1), cB + hstep, voffB); PG8_STAGE(PG8_SA(0, 0), cA, vA0); PG8_STAGE(PG8_SA(0, 1), cA, vA1);
    if (wr == 1) PG8_BAR;
    PG8_WAIT_V(2); PG8_BAR;
    PG8_STAGE(PG8_SB(1, 0), cB + kstep, voffB); PG8_STAGE(PG8_SA(1, 0), cA + kstep, vA0); PG8_STAGE(PG8_SB(1, 1), cB + hstep + kstep, voffB);
    PG8_WAIT_V(6); PG8_BAR;
    for (;;) {
        const bool has_next = S.next(ui + 1, nxt);
        const char* nA = has_next ? nxt.a : cA; const char* nB = has_next ? nxt.b : cB;
        if constexpr (GATHER) { if (has_next) {
#pragma unroll
            for (int i = 0; i < 2; ++i) { vN0[i] = (unsigned)(ridx[(ui + 1) * 256 + stR[i]] * K + stC[i]) * 2u; vN1[i] = (unsigned)(ridx[(ui + 1) * 256 + HALF + stR[i]] * K + stC[i]) * 2u; } } }
        for (int t = 0; t < nt; t += 2) {
            const bool last = (t == nt - 2);
            const char* a1 = cA + (size_t)(t + 1) * kstep;
            const char* a2 = last ? nA : cA + (size_t)(t + 2) * kstep; const char* b2 = last ? nB : cB + (size_t)(t + 2) * kstep;
            const char* a3 = a2 + kstep; const char* b3 = b2 + kstep;
            unsigned w0[2], w1[2];
#pragma unroll
            for (int i = 0; i < 2; ++i) { w0[i] = last ? vN0[i] : vA0[i]; w1[i] = last ? vN1[i] : vA1[i]; }
            PG8_LDB(B0, 0, 0); PG8_LDB(B1, 0, 1); PG8_SCHED; PG8_LDA(At, 0, 0); PG8_STAGE(PG8_SA(1, 1), a1, vA1);
            PG8_WAIT_V(8); PG8_WAIT_L(0); PG8_BAR; PG8_MMA(0, 0, At, B0); PG8_MMA(0, 1, At, B1); PG8_BAR; PG8_SCHED;
            PG8_LDA(At, 0, 1); PG8_STAGE(PG8_SB(0, 0), b2, voffB); PG8_STAGE(PG8_SB(0, 1), b2 + hstep, voffB); PG8_STAGE(PG8_SA(0, 0), a2, w0);
            PG8_WAIT_V(8); PG8_WAIT_L(0); PG8_BAR; PG8_MMA(1, 0, At, B0); PG8_MMA(1, 1, At, B1); PG8_BAR; PG8_SCHED;
            PG8_LDB(B0, 1, 0); PG8_LDB(B1, 1, 1); PG8_SCHED; PG8_LDA(At, 1, 0); PG8_STAGE(PG8_SA(0, 1), a2, w1);
            PG8_WAIT_V(8); PG8_WAIT_L(0); PG8_BAR; PG8_MMA(0, 0, At, B0); PG8_MMA(0, 1, At, B1); PG8_BAR; PG8_SCHED;
            PG8_LDA(At, 1, 1); PG8_STAGE(PG8_SB(1, 0), b3, voffB); PG8_STAGE(PG8_SB(1, 1), b3 + hstep, voffB); PG8_STAGE(PG8_SA(1, 0), a3, w0);
            PG8_WAIT_V(8); PG8_WAIT_L(0); PG8_BAR; PG8_MMA(1, 0, At, B0); PG8_MMA(1, 1, At, B1); PG8_BAR; PG8_SCHED;
        }
        if constexpr (ALIGN_EPI) { if (wr == 0) PG8_BAR; }
        E(acc, cur, wr, wc, fr, fq);
        if (!has_next) break;
#pragma unroll
        for (int a = 0; a < 2; ++a)
#pragma unroll
            for (int b = 0; b < 2; ++b)
#pragma unroll
                for (int m = 0; m < 4; ++m)
#pragma unroll
                    for (int n = 0; n < 2; ++n) acc[a][b][m][n] = (f32x4){0.f, 0.f, 0.f, 0.f};
        cur = nxt; cA = nA; cB = nB; ++ui;
#pragma unroll
        for (int i = 0; i < 2; ++i) { vA0[i] = vN0[i]; vA1[i] = vN1[i]; }
        if constexpr (ALIGN_EPI) { if (wr == 1) PG8_BAR; }
    }
    PG8_WAIT_V(0);
    if constexpr (!ALIGN_EPI) { if (wr == 0) PG8_BAR; }
    PG8_BAR;
#undef PG8_SA
#undef PG8_SB
#undef PG8_STAGE
#undef PG8_LDA
#undef PG8_LDB
#undef PG8_MMA
#undef PG8_WAIT_V
#undef PG8_WAIT_L
#undef PG8_BAR
#undef PG8_SCHED
}
}

constexpr int NB = 2, SEQ = 4096, DM = 2048, MT = NB * SEQ;
constexpr int NH = 8, HD = 128, AW = 1024, HW = 1024, INW = 6144;
constexpr int GW = 64, NROWS = 64, WR = 8, WC = 16;
constexpr int NE = 16, CAP = 512, FF = 1024;
constexpr int FEMB = 33, FHID = 64;
constexpr float EPS = 1e-6f;
constexpr int NWAVES = 8, NTHREADS = 512;

constexpr size_t MiB = 1u << 20;
constexpr size_t WS_CTL = 0, CTL_ZERO_BYTES = 1 * MiB;
constexpr size_t WS_WIN = 2 * MiB;
constexpr size_t WS_WOUT = 26 * MiB;
constexpr size_t WS_WGU = 34 * MiB;
constexpr size_t WS_WD = 162 * MiB;
constexpr size_t WS_W3T = 226 * MiB;
constexpr size_t WS_HID2 = 227 * MiB;
constexpr size_t WS_HB = 228 * MiB;
constexpr size_t WS_QK = 260 * MiB;
constexpr size_t WS_XT = 292 * MiB;
constexpr size_t WS_UC = 356 * MiB;
constexpr size_t WS_TAPS = 404 * MiB;
constexpr size_t WS_HYT = 436 * MiB;
constexpr size_t WS_MIXED = 452 * MiB;
constexpr size_t WS_AFF = 484 * MiB;
constexpr size_t WS_IDX = 485 * MiB;
constexpr size_t WS_GATE = 486 * MiB;
constexpr size_t WS_SEL = 487 * MiB;
constexpr size_t WS_Z1T = 488 * MiB;
constexpr size_t WS_XG = WS_XT;
constexpr size_t WS_ACT = WS_UC;
constexpr size_t WS_YE = WS_TAPS;
constexpr size_t WS_END = 504 * MiB;

constexpr int LDS_BYTES = 163840, LDS_MISC_OFF = 163840 - 128;

#define GAS __attribute__((address_space(1)))
#define LAS __attribute__((address_space(3)))
typedef unsigned short bf16;
typedef unsigned v4u __attribute__((ext_vector_type(4)));
typedef unsigned v2u __attribute__((ext_vector_type(2)));
typedef float f32x4 __attribute__((ext_vector_type(4)));
#define LDS_WAIT() asm volatile("s_waitcnt lgkmcnt(0)" ::: "memory")
#define VM_WAIT() asm volatile("s_waitcnt vmcnt(0)" ::: "memory")
__device__ __forceinline__ unsigned f2bf(float f) { unsigned u = __builtin_bit_cast(unsigned, f); return (u + 0x7fffu + ((u >> 16) & 1u)) >> 16; }
__device__ __forceinline__ unsigned pk2(float lo, float hi) { return f2bf(lo) | (f2bf(hi) << 16); }
__device__ __forceinline__ float bf2f(unsigned h) { return __builtin_bit_cast(float, h << 16); }
__device__ __forceinline__ float bflo(unsigned w) { return __builtin_bit_cast(float, w << 16); }
__device__ __forceinline__ float bfhi(unsigned w) { return __builtin_bit_cast(float, w & 0xffff0000u); }
__device__ __forceinline__ float wave_sum(float v) {
#pragma unroll
    for (int o = 1; o < 64; o <<= 1) v += __shfl_xor(v, o);
    return v;
}


#define XB_TMO      128
#define XB_XCNT(j)  (256  + 64 * (j))
#define XB_XSUB(j)  (1280 + 64 * (j))
#define XB_XGEN(j)  (2304 + 64 * (j))
#define XB_TOP      3328
#define XB_TOPGEN   3392
#define XCD_BAR_WORDS 3456
#define XB_SPIN_CAP (1u << 22)
__device__ __forceinline__ unsigned xb_ld(unsigned* p)              { return __hip_atomic_load(p, __ATOMIC_RELAXED, __HIP_MEMORY_SCOPE_AGENT); }
__device__ __forceinline__ unsigned xb_add(unsigned* p, unsigned v) { return __hip_atomic_fetch_add(p, v, __ATOMIC_RELAXED, __HIP_MEMORY_SCOPE_AGENT); }
__device__ __forceinline__ unsigned xb_xcc_id() { return (unsigned)__builtin_amdgcn_s_getreg((3 << 11) | 20) & 0xFu; }
#define XB_SPIN(cond, bar) do { unsigned _sp = 0; while (cond) { __builtin_amdgcn_s_sleep(1); \
    if ((++_sp & 255u) == 0u) { if (xb_ld(&(bar)[XB_TMO])) break; if (_sp > XB_SPIN_CAP) { atomicAdd(&(bar)[XB_TMO], 1u); break; } } } } while (0)
struct XcdBarrier { unsigned* bar; unsigned x; volatile LAS unsigned* st; };
__device__ __forceinline__ XcdBarrier xcd_barrier_post(unsigned* bar, volatile LAS unsigned* st) {
    XcdBarrier b; b.bar = bar; b.x = xb_xcc_id(); b.st = st;
    if (threadIdx.x == 0) (void)xb_add(&bar[XB_XCNT(b.x)], 1u);
    return b;
}
__device__ __forceinline__ void xcd_barrier_complete(unsigned* bar, unsigned x, unsigned& nloc, unsigned& nx) {
    const unsigned G = gridDim.x * gridDim.y * gridDim.z;
    unsigned sum, cnt, mine, sp = 0u;
    for (;;) {
        sum = 0u; cnt = 0u; mine = 0u;
#pragma unroll
        for (unsigned j = 0; j < 16; ++j) { const unsigned c = xb_ld(&bar[XB_XCNT(j)]); sum += c; cnt += (c > 0u) ? 1u : 0u; mine = (j == x) ? c : mine; }
        if (sum == G) break;
        __builtin_amdgcn_s_sleep(1);
        if ((++sp & 255u) == 0u) { if (xb_ld(&bar[XB_TMO])) break; if (sp > XB_SPIN_CAP) { atomicAdd(&bar[XB_TMO], 1u); break; } }
    }
    nloc = mine > 0u ? mine : 1u; nx = cnt > 0u ? cnt : 1u;
}
__device__ __forceinline__ void xcd_barrier(const XcdBarrier& b) {
    asm volatile("s_waitcnt vmcnt(0)" ::: "memory");
    __syncthreads();
    if (threadIdx.x == 0) {
        unsigned* bar = b.bar;
        __builtin_amdgcn_s_waitcnt(0);
        unsigned nloc = b.st[0], nx = b.st[1];
        if (nloc == 0u) { xcd_barrier_complete(bar, b.x, nloc, nx); b.st[0] = nloc; b.st[1] = nx; }
        const unsigned old = xb_add(&bar[XB_XSUB(b.x)], 1u);
        const unsigned gen = old / nloc;
        if (old + 1u == (gen + 1u) * nloc) {
            __builtin_amdgcn_fence(__ATOMIC_RELEASE, "agent");
            asm volatile("s_waitcnt vmcnt(0)" ::: "memory");
            const unsigned og = xb_add(&bar[XB_TOP], 1u);
            const unsigned tg = og / nx;
            if (og + 1u == (tg + 1u) * nx) xb_add(&bar[XB_TOPGEN], 1u);
            else XB_SPIN(xb_ld(&bar[XB_TOPGEN]) == tg, bar);
            __builtin_amdgcn_fence(__ATOMIC_ACQUIRE, "agent");
            xb_add(&bar[XB_XGEN(b.x)], 1u);
            asm volatile("s_waitcnt vmcnt(0)" ::: "memory");
        } else {
            XB_SPIN(xb_ld(&bar[XB_XGEN(b.x)]) == gen, bar);
            __builtin_amdgcn_fence(__ATOMIC_ACQUIRE, "agent");
            asm volatile("s_waitcnt vmcnt(0)" ::: "memory");
        }
    }
    __syncthreads();
}

struct Frame {
    LAS unsigned char* lds;
    int tid, lane, wave, G, bid;
    const float* in[23]; float* out; unsigned char* ws;
};
#define GW_ID(F) ((F).bid * NWAVES + (F).wave)
#define GW_N(F) ((F).G * NWAVES)

__device__ __forceinline__ void p0_transpose_item(const float* W, int K, int N, bf16* WT, int row_base, int k0, int n0, LAS float* scr, int lane) {
#pragma unroll 8
    for (int i = 0; i < 32; ++i) { const int kk = 2 * i + (lane >> 5); scr[kk * 33 + (lane & 31)] = W[(size_t)(k0 + kk) * N + n0 + (lane & 31)]; }
    LDS_WAIT(); asm volatile("" ::: "memory");
    const int c = lane & 7;
#pragma unroll
    for (int j = 0; j < 4; ++j) { const int n = (lane >> 3) + 8 * j; const LAS float* s = scr + (8 * c) * 33 + n;
        v4u o; o.x = pk2(s[0 * 33], s[1 * 33]); o.y = pk2(s[2 * 33], s[3 * 33]); o.z = pk2(s[4 * 33], s[5 * 33]); o.w = pk2(s[6 * 33], s[7 * 33]);
        *(GAS v4u*)(WT + (size_t)(row_base + n) * K + k0 + 8 * c) = o; }
    LDS_WAIT(); asm volatile("" ::: "memory");
}
__device__ __forceinline__ void phase_p0(Frame& F) {
    LAS float* scr = (LAS float*)(F.lds + F.wave * 16384);
    const int gw = GW_ID(F), NGW = GW_N(F);
    bf16* WinT = (bf16*)(F.ws + WS_WIN); bf16* WoutT = (bf16*)(F.ws + WS_WOUT); bf16* W3T = (bf16*)(F.ws + WS_W3T);
    constexpr int I_IN = (DM / 64) * (INW / 32), I_OUT = (DM / 64) * (DM / 32), I_3 = 1 * (4096 / 32);
    constexpr int NITEMS = I_IN + I_OUT + I_3;
    for (int it = gw; it < NITEMS; it += NGW) {
        int r = it;
        if (r < I_IN) { const int nblk = INW / 32, kb = r / nblk, nb = r % nblk; p0_transpose_item(F.in[2], DM, INW, WinT, 32 * nb, 64 * kb, 32 * nb, scr, F.lane); continue; } r -= I_IN;
        if (r < I_OUT) { const int nblk = DM / 32, kb = r / nblk, nb = r % nblk; p0_transpose_item(F.in[17], DM, DM, WoutT, 32 * nb, 64 * kb, 32 * nb, scr, F.lane); continue; } r -= I_OUT;
        { const int nb = r; p0_transpose_item(F.in[12], FHID, 4096, W3T, 32 * nb, 0, 32 * nb, scr, F.lane); }
    }
    bf16* HB = (bf16*)(F.ws + WS_HB);
    const float* x = F.in[0]; const float* g = F.in[1];
    for (int m = gw; m < MT; m += NGW) {
        const GAS f32x4* xr = (const GAS f32x4*)(x + (size_t)m * DM) + F.lane;
        f32x4 v[8]; float s = 0.f;
#pragma unroll
        for (int j = 0; j < 8; ++j) { v[j] = xr[64 * j]; s += (v[j].x * v[j].x + v[j].y * v[j].y) + (v[j].z * v[j].z + v[j].w * v[j].w); }
        const float r = rsqrtf(wave_sum(s) * (1.f / DM) + EPS);
        GAS v2u* o8 = (GAS v2u*)(HB + (size_t)m * DM) + F.lane;
#pragma unroll
        for (int j = 0; j < 8; ++j) { const f32x4 gg = *((const GAS f32x4*)g + F.lane + 64 * j); v2u o; o.x = pk2(v[j].x * r * gg.x, v[j].y * r * gg.y); o.y = pk2(v[j].z * r * gg.z, v[j].w * r * gg.w); o8[64 * j] = o; }
    }
    float* HID2 = (float*)(F.ws + WS_HID2);
    LAS float* sc2 = (LAS float*)(F.lds + F.wave * 16384);
    const float* w1 = F.in[8]; const float* b1 = F.in[9]; const float* w2 = F.in[10]; const float* b2 = F.in[11]; const float* fr = F.in[13];
    for (int l = gw; l < SEQ; l += NGW) {
        const int j = F.lane;
        float zv = 0.f;
        if (j == 0) zv = (float)l / (float)(SEQ - 1);
        else if (j < FEMB) { const int k = (j - 1) & 15; const float f = 1e-4f + (float)k * ((15.0f - 1e-4f) / 15.0f); const float wv = 6.283185307179586f * (float)l / (float)SEQ; zv = (j <= 16) ? cosf(f * wv) : -sinf(f * wv); }
        sc2[j] = zv; LDS_WAIT(); asm volatile("" ::: "memory");
        float a = b1[j];
        for (int i = 0; i < FEMB; ++i) a += sc2[i] * w1[i * FHID + j];
        const float h1 = sinf(fr[j] * a);
        sc2[64 + j] = h1; LDS_WAIT(); asm volatile("" ::: "memory");
        float c = b2[j];
        for (int i = 0; i < FHID; ++i) c += sc2[64 + i] * w2[i * FHID + j];
        HID2[l * FHID + j] = sinf(fr[j] * c);
        LDS_WAIT(); asm volatile("" ::: "memory");
    }
}

__device__ __forceinline__ void phase_filters_naive(Frame& F) {
    const float* HID2 = (const float*)(F.ws + WS_HID2); const float* w3 = F.in[12]; const float* fbias = F.in[14]; bf16* TAPS = (bf16*)(F.ws + WS_TAPS);
    const size_t total = (size_t)SEQ * 4096;
    for (size_t i = (size_t)F.bid * NTHREADS + F.tid; i < total; i += (size_t)F.G * NTHREADS) {
        const int col = (int)(i & 4095), l = (int)(i >> 12);
        float a = 0.f;
        for (int k = 0; k < FHID; ++k) a += HID2[l * FHID + k] * w3[(size_t)k * 4096 + col];
        const int c = col & 1023, dir = (col >> 10) & 1, o = col >> 11;
        const float mind = -4.605170185988091f / 1.5f, maxd = -4.605170185988091f / 0.3f;
        const float delta = fabsf(mind + (maxd - mind) * ((float)c / 1023.0f));
        const float t = (float)l / (float)(SEQ - 1);
        float v = a * expf(-t * delta);
        bf16* tp = TAPS + ((size_t)c * 2 + o) * 8192;
        if (dir == 0) { if (l == 0) v += fbias[o * 1024 + c]; tp[4096 + l] = (bf16)f2bf(v); }
        else { if (l > 0) tp[4096 - l] = (bf16)f2bf(v); else tp[0] = 0; }
    }
}
__device__ __forceinline__ void phase_hyena_naive(Frame& F, int o) {
    const bf16* UC = (const bf16*)(F.ws + WS_UC); const bf16* TAPS = (const bf16*)(F.ws + WS_TAPS);
    bf16* Z1T = (bf16*)(F.ws + WS_Z1T); bf16* HYT = (bf16*)(F.ws + WS_HYT);
    const bf16* Zin = o == 0 ? UC + (size_t)2048 * MT : Z1T; const bf16* gate = UC + (size_t)(o * 1024) * MT; bf16* OUT = o == 0 ? Z1T : HYT;
    const size_t total = (size_t)1024 * MT;
    for (size_t i = (size_t)F.bid * NTHREADS + F.tid; i < total; i += (size_t)F.G * NTHREADS) {
        const int c = (int)(i >> 13), m = (int)(i & 8191), b = m >> 12, t = m & 4095;
        const bf16* z = Zin + (size_t)c * MT + b * SEQ; const bf16* tp = TAPS + ((size_t)c * 2 + o) * 8192 + 4096 + t;
        float acc = 0.f;
        for (int s = 0; s < SEQ; ++s) acc += bf2f(tp[-s]) * bf2f(z[s]);
        OUT[(size_t)c * MT + m] = (bf16)f2bf(bf2f(gate[(size_t)c * MT + m]) * acc);
    }
}
__device__ __forceinline__ void phase_attn_naive(Frame& F) {
    const bf16* QK = (const bf16*)(F.ws + WS_QK); const bf16* VT = (const bf16*)(F.ws + WS_XT); bf16* MIXED = (bf16*)(F.ws + WS_MIXED);
    const float* rpb = F.in[5]; const float* og = F.in[15];
    const int lane = F.lane;
    for (int w = GW_ID(F); w < MT * NH; w += GW_N(F)) {
        const int m = w >> 3, h = w & 7, b = m / SEQ, s = m % SEQ, r = s / GW, c = s % GW;
        int kr0 = r - WR / 2; kr0 = kr0 < 0 ? 0 : (kr0 > NROWS - WR ? NROWS - WR : kr0);
        int c0 = c - WC / 2; c0 = c0 < 0 ? 0 : (c0 > GW - WC ? GW - WC : c0);
        const bf16* q = QK + (size_t)m * 2048 + h * HD;
        const float q0 = bf2f(q[lane]), q1 = bf2f(q[lane + 64]);
        float mx = -INFINITY, l = 0.f, a0 = 0.f, a1 = 0.f;
        for (int i = 0; i < WR; ++i) for (int j = 0; j < WC; ++j) {
            const int kr = kr0 + i, kc = c0 + j; const size_t km = (size_t)b * SEQ + kr * GW + kc;
            const bf16* kp = QK + km * 2048 + 1024 + h * HD;
            const float d = wave_sum(q0 * bf2f(kp[lane]) + q1 * bf2f(kp[lane + 64]));
            const int dr = kr - r + WR - 1; int dc = kc - c + WC - 1; dc = dc < 0 ? 0 : (dc > 2 * WC - 2 ? 2 * WC - 2 : dc);
            const float sc = d * 0.08838834764831845f + rpb[(h * (2 * WR - 1) + dr) * (2 * WC - 1) + dc];
            const float mn = fmaxf(mx, sc), corr = __expf(mx - mn), pw = __expf(sc - mn);
            const float v0 = bf2f(VT[(size_t)(h * HD + lane) * MT + km]), v1 = bf2f(VT[(size_t)(h * HD + lane + 64) * MT + km]);
            l = l * corr + pw; a0 = a0 * corr + pw * v0; a1 = a1 * corr + pw * v1; mx = mn;
        }
        a0 /= l; a1 /= l;
        const float rr = rsqrtf(wave_sum(a0 * a0 + a1 * a1) * (1.f / HD) + EPS);
        bf16* o = MIXED + (size_t)m * DM + h * HD;
        o[lane] = (bf16)f2bf(a0 * rr * og[h * HD + lane]); o[lane + 64] = (bf16)f2bf(a1 * rr * og[h * HD + lane + 64]);
    }
}


typedef short bf16x8 __attribute__((ext_vector_type(8)));
typedef float f32x16 __attribute__((ext_vector_type(16)));
__device__ __forceinline__ void phase_filters(Frame& F) {
    const float* HID2 = (const float*)(F.ws + WS_HID2); const bf16* W3T = (const bf16*)(F.ws + WS_W3T); const float* fbias = F.in[14]; bf16* TAPS = (bf16*)(F.ws + WS_TAPS);
    const int n = F.lane & 31, hh = F.lane >> 5;
    for (int it = GW_ID(F); it < 128 * 128; it += GW_N(F)) {
        const int col0 = (it >> 7) * 32, l0 = (it & 127) * 32;
        f32x16 acc;
#pragma unroll
        for (int i = 0; i < 16; ++i) acc[i] = 0.f;
#pragma unroll
        for (int ks = 0; ks < 4; ++ks) {
            const bf16x8 a = *(const GAS bf16x8*)(W3T + (size_t)(col0 + n) * FHID + 16 * ks + 8 * hh);
            const GAS f32x4* hp = (const GAS f32x4*)(HID2 + (size_t)(l0 + n) * FHID + 16 * ks + 8 * hh);
            const f32x4 h0 = hp[0], h1 = hp[1];
            v4u bw; bw.x = pk2(h0.x, h0.y); bw.y = pk2(h0.z, h0.w); bw.z = pk2(h1.x, h1.y); bw.w = pk2(h1.z, h1.w);
            acc = __builtin_amdgcn_mfma_f32_32x32x16_bf16(a, __builtin_bit_cast(bf16x8, bw), acc, 0, 0, 0);
        }
        const int l = l0 + n; const float t = (float)l / (float)(SEQ - 1);
        const int dir = (col0 >> 10) & 1, o = col0 >> 11;
        const float mind = -4.605170185988091f / 1.5f, maxd = -4.605170185988091f / 0.3f;
#pragma unroll
        for (int i = 0; i < 16; ++i) {
            const int c = (col0 & 1023) + (i & 3) + 8 * (i >> 2) + 4 * hh;
            const float delta = fabsf(mind + (maxd - mind) * ((float)c / 1023.0f));
            float v = acc[i] * __expf(-t * delta);
            bf16* tp = TAPS + ((size_t)c * 2 + o) * 8192;
            if (dir == 0) { if (l == 0) v += fbias[o * 1024 + c]; tp[4096 + l] = (bf16)f2bf(v); }
            else { if (l > 0) tp[4096 - l] = (bf16)f2bf(v); else tp[0] = 0; }
        }
    }
}

constexpr int HY_TAPS_BYTES = 4 * 16384, HY_ZB_ENT = 6080, HY_ZB_BYTES = HY_ZB_ENT * 2;
__device__ __forceinline__ unsigned hy_zb_off(int idx0  ) { const int q = idx0 >> 3; return (unsigned)((q ^ ((q >> 4) & 3)) << 4); }
template <int MASK>
__device__ __forceinline__ void hy_segment(f32x16 (&acc)[2][4], const LAS bf16* taps, const LAS unsigned char* zb0, int g0, int g1, int n, int hh) {
    const unsigned sh = (n & 1) ? 0u : 2u;
#pragma unroll 2
    for (int g = g0; g < g1; ++g) {
        const volatile LAS unsigned* dp = (const volatile LAS unsigned*)taps + ((1 + 8 * hh + n) >> 1) + 8 * g;
        const unsigned d0 = dp[0], d1 = dp[1], d2 = dp[2], d3 = dp[3], d4 = dp[4];
        v4u aw; aw.x = __builtin_amdgcn_alignbyte(d1, d0, sh); aw.y = __builtin_amdgcn_alignbyte(d2, d1, sh); aw.z = __builtin_amdgcn_alignbyte(d3, d2, sh); aw.w = __builtin_amdgcn_alignbyte(d4, d3, sh);
        const bf16x8 a = __builtin_bit_cast(bf16x8, aw);
        const int q0 = 124 - 4 * n + 2 * g + hh;
        const LAS unsigned char* pm = zb0 + ((q0 ^ ((q0 >> 4) & 3)) << 4) - 6144;
#pragma unroll
        for (int tau = 0; tau < 4; ++tau) if (MASK & (1 << tau)) {
#pragma unroll
            for (int b = 0; b < 2; ++b) {
                const bf16x8 bf = *(const LAS bf16x8*)(pm + 2048 * (3 - tau) + b * HY_ZB_BYTES);
                acc[b][tau] = __builtin_amdgcn_mfma_f32_32x32x16_bf16(a, bf, acc[b][tau], 0, 0, 0);
            }
        }
    }
}
__device__ __forceinline__ void hy_stage_taps(Frame& F, int c0, int o) {
    const bf16* TAPS = (const bf16*)(F.ws + WS_TAPS);
#pragma unroll
    for (int j = 0; j < 8; ++j) { const int ch = F.tid + NTHREADS * j, ci = ch >> 10, w = ch & 1023;
        *((LAS v4u*)(F.lds) + ch) = *((const GAS v4u*)(TAPS + ((size_t)(c0 + ci) * 2 + o) * 8192) + w); }
}
__device__ __forceinline__ void conv_item64(const float* W, int N, bf16* WT, int K, size_t row_base, int k0, int n0, int lane) {
    const GAS float* src = (const GAS float*)(W + (size_t)k0 * N + n0 + lane);
    float v[64];
#pragma unroll
    for (int kk = 0; kk < 64; ++kk) v[kk] = src[(size_t)kk * N];
    GAS v4u* dst = (GAS v4u*)(WT + (row_base + lane) * (size_t)K + k0);
#pragma unroll
    for (int j = 0; j < 8; ++j) { v4u o; o.x = pk2(v[8 * j], v[8 * j + 1]); o.y = pk2(v[8 * j + 2], v[8 * j + 3]); o.z = pk2(v[8 * j + 4], v[8 * j + 5]); o.w = pk2(v[8 * j + 6], v[8 * j + 7]); dst[j] = o; }
}
constexpr int MOE_ITEMS_GU = 2 * NE * 32 * 16, MOE_ITEMS_D = NE * 16 * 32, MOE_ITEMS = MOE_ITEMS_GU + MOE_ITEMS_D;
__device__ __forceinline__ void moe_conv_item(Frame& F, int it) {
    bf16* WguT = (bf16*)(F.ws + WS_WGU); bf16* WdT = (bf16*)(F.ws + WS_WD);
    if (it < MOE_ITEMS_GU) { const int which = it >> 13, e = (it >> 9) & 15, kb = (it >> 4) & 31, nb = it & 15, f0 = 64 * nb;
        const float* W = (which ? F.in[21] : F.in[20]) + (size_t)e * DM * FF;
        conv_item64(W, FF, WguT, DM, (size_t)e * 2048 + (f0 >> 7) * 256 + which * 128 + (f0 & 127), 64 * kb, f0, F.lane);
    } else { const int r = it - MOE_ITEMS_GU, e = r >> 9, kb = (r >> 5) & 15, nb = r & 31;
        conv_item64(F.in[22] + (size_t)e * FF * DM, DM, WdT, FF, (size_t)e * 2048 + 64 * nb, 64 * kb, 64 * nb, F.lane); }
}
__device__ __forceinline__ void phase_hyena(Frame& F) {
    const bf16* UC = (const bf16*)(F.ws + WS_UC); bf16* HYT = (bf16*)(F.ws + WS_HYT);
    const int n = F.lane & 31, hh = F.lane >> 5;
    const bool compute = F.wave < 4;
    const int nhelp = F.G * 4, hw = F.bid * 4 + (F.wave - 4);
    int sec = 0;
    for (int cg = F.bid; cg < 256; cg += F.G) {
        const int c0 = cg * 4;
        __syncthreads();
        hy_stage_taps(F, c0, 0);
        {
          const int ci = F.wave >> 1, b = F.wave & 1; LAS unsigned char* zb = F.lds + HY_TAPS_BYTES + F.wave * HY_ZB_BYTES;
          const bf16* zsrc = UC + (size_t)(2048 + c0 + ci) * MT + b * SEQ;
#pragma unroll
          for (int j = 0; j < 8; ++j) { const int u = F.lane + 64 * j; const v4u w = *((const GAS v4u*)zsrc + u);
              v4u r; r.x = (w.w >> 16) | (w.w << 16); r.y = (w.z >> 16) | (w.z << 16); r.z = (w.y >> 16) | (w.y << 16); r.w = (w.x >> 16) | (w.x << 16);
              *(LAS v4u*)(zb + hy_zb_off(8 * (635 - u))) = r; }
          const v4u zero = {0u, 0u, 0u, 0u};
          for (int q = F.lane; q < 124; q += 64) { *(LAS v4u*)(zb + hy_zb_off(8 * q)) = zero; *(LAS v4u*)(zb + hy_zb_off(8 * (636 + q))) = zero; } }
        __syncthreads();
#pragma unroll 1
        for (int o = 0; o < 2; ++o) {
            if (compute) {
                const int ci = F.wave, c = c0 + ci;
                const LAS bf16* taps = (const LAS bf16*)(F.lds + ci * 16384);
                LAS unsigned char* zb0 = F.lds + HY_TAPS_BYTES + (2 * ci) * HY_ZB_BYTES;
                f32x16 acc[2][4];
#pragma unroll
                for (int b = 0; b < 2; ++b)
#pragma unroll
                    for (int tau = 0; tau < 4; ++tau)
#pragma unroll
                        for (int i = 0; i < 16; ++i) acc[b][tau][i] = 0.f;
                hy_segment<1>(acc, taps, zb0, 0, 64, n, hh);
                hy_segment<3>(acc, taps, zb0, 64, 128, n, hh);
                hy_segment<7>(acc, taps, zb0, 128, 192, n, hh);
                hy_segment<15>(acc, taps, zb0, 192, 318, n, hh);
                hy_segment<14>(acc, taps, zb0, 318, 382, n, hh);
                hy_segment<12>(acc, taps, zb0, 382, 446, n, hh);
                hy_segment<8>(acc, taps, zb0, 446, 510, n, hh);
                LDS_WAIT();
                int n2 = n, h2 = hh; asm volatile("" : "+v"(n2), "+v"(h2));
#pragma unroll
                for (int b = 0; b < 2; ++b) {
                    const bf16* gate = UC + (size_t)(o * 1024 + c) * MT + b * SEQ;
                    LAS unsigned char* zb = zb0 + b * HY_ZB_BYTES; bf16* outp = HYT + (size_t)c * MT + b * SEQ;
#pragma unroll
                    for (int tau = 0; tau < 4; ++tau) { asm volatile("" ::: "memory");
#pragma unroll
                        for (int rg = 0; rg < 4; ++rg) { const int t0 = 1024 * tau + 32 * n2 + 8 * rg + 4 * h2;
                            const v2u gw = *(const GAS v2u*)(gate + t0);
                            const float z0 = bflo(gw.x) * acc[b][tau][4 * rg + 0], z1 = bfhi(gw.x) * acc[b][tau][4 * rg + 1], z2 = bflo(gw.y) * acc[b][tau][4 * rg + 2], z3 = bfhi(gw.y) * acc[b][tau][4 * rg + 3];
                            if (o == 0) { v2u w; w.x = pk2(z3, z2); w.y = pk2(z1, z0);
                                *(LAS v2u*)(zb + hy_zb_off(8 * (635 - (t0 >> 3))) + (h2 ? 0 : 8)) = w; }
                            else { v2u w; w.x = pk2(z0, z1); w.y = pk2(z2, z3); *(GAS v2u*)(outp + t0) = w; } } }
                }
            } else {
                const int lo_it = sec * (MOE_ITEMS / 2), hi_it = lo_it + MOE_ITEMS / 2;
                if (sec < 2) for (int it = lo_it + hw; it < hi_it; it += nhelp) moe_conv_item(F, it);
            }
            ++sec;
            if (o == 0) {
                __syncthreads();
                hy_stage_taps(F, c0, 1);
                __syncthreads();
            }
        }
    }
    for (; sec < 2; ++sec) if (!compute) { const int lo_it = sec * (MOE_ITEMS / 2), hi_it = lo_it + MOE_ITEMS / 2; for (int it = lo_it + hw; it < hi_it; it += nhelp) moe_conv_item(F, it); }
    __syncthreads();
}

__device__ __forceinline__ void phase_attn(Frame& F) {
    const bf16* QK = (const bf16*)(F.ws + WS_QK); const bf16* VT = (const bf16*)(F.ws + WS_XT); bf16* MIXED = (bf16*)(F.ws + WS_MIXED);
    const float* rpb = F.in[5]; const float* og = F.in[15];
    LAS float* rp = (LAS float*)(F.lds + F.wave * 2048);
    const int n = F.lane & 31, hh = F.lane >> 5;
    for (int task = GW_ID(F); task < NB * NH * NROWS * 2; task += GW_N(F)) {
        const int wq = task & 1, r = (task >> 1) & 63, h = (task >> 7) & 7, b = task >> 10;
        for (int i = F.lane; i < 15 * 31; i += 64) rp[i] = rpb[h * 465 + i];
        const int mq = b * SEQ + r * GW + 32 * wq + n, qc = 32 * wq + n;
        int c0 = qc - WC / 2; c0 = c0 < 0 ? 0 : (c0 > GW - WC ? GW - WC : c0);
        int kr0 = r - WR / 2; kr0 = kr0 < 0 ? 0 : (kr0 > NROWS - WR ? NROWS - WR : kr0);
        bf16x8 qf[8];
#pragma unroll
        for (int ks = 0; ks < 8; ++ks) qf[ks] = *(const GAS bf16x8*)(QK + (size_t)mq * 2048 + h * HD + 16 * ks + 8 * hh);
        f32x16 O[4];
#pragma unroll
        for (int dt = 0; dt < 4; ++dt)
#pragma unroll
            for (int i = 0; i < 16; ++i) O[dt][i] = 0.f;
        float lsum = 0.f;
        LDS_WAIT();
#pragma unroll 1
        for (int tile = 0; tile < 16; ++tile) {
            const int kr = kr0 + (tile >> 1), kt = tile & 1, dr = kr - r + WR - 1;
            const int mk0 = b * SEQ + kr * GW + 32 * kt;
            f32x16 S;
#pragma unroll
            for (int i = 0; i < 16; ++i) S[i] = 0.f;
#pragma unroll
            for (int ks = 0; ks < 8; ++ks) { const bf16x8 kf = *(const GAS bf16x8*)(QK + (size_t)(mk0 + n) * 2048 + 1024 + h * HD + 16 * ks + 8 * hh);
                S = __builtin_amdgcn_mfma_f32_32x32x16_bf16(kf, qf[ks], S, 0, 0, 0); }
            float p[16];
#pragma unroll
            for (int i = 0; i < 16; ++i) { const int kc = 32 * kt + (i & 3) + 8 * (i >> 2) + 4 * hh; const bool valid = (kc >= c0) && (kc < c0 + WC);
                int dc = kc - qc + WC - 1; dc = dc < 0 ? 0 : (dc > 2 * WC - 2 ? 2 * WC - 2 : dc);
                const float e = __expf(S[i] * 0.08838834764831845f + rp[dr * 31 + dc]); p[i] = valid ? e : 0.f; lsum += p[i]; }
            v4u pw0, pw1;
            pw0.x = pk2(p[0], p[1]); pw0.y = pk2(p[2], p[3]); pw0.z = pk2(p[4], p[5]); pw0.w = pk2(p[6], p[7]);
            pw1.x = pk2(p[8], p[9]); pw1.y = pk2(p[10], p[11]); pw1.z = pk2(p[12], p[13]); pw1.w = pk2(p[14], p[15]);
            const bf16x8 pf0 = __builtin_bit_cast(bf16x8, pw0), pf1 = __builtin_bit_cast(bf16x8, pw1);
#pragma unroll
            for (int dt = 0; dt < 4; ++dt) {
                const bf16* vrow = VT + (size_t)(h * HD + 32 * dt + n) * MT + mk0 + 4 * hh;
                const v2u a0 = *(const GAS v2u*)(vrow), a1 = *(const GAS v2u*)(vrow + 8), a2 = *(const GAS v2u*)(vrow + 16), a3 = *(const GAS v2u*)(vrow + 24);
                v4u f0, f1; f0.x = a0.x; f0.y = a0.y; f0.z = a1.x; f0.w = a1.y; f1.x = a2.x; f1.y = a2.y; f1.z = a3.x; f1.w = a3.y;
                O[dt] = __builtin_amdgcn_mfma_f32_32x32x16_bf16(__builtin_bit_cast(bf16x8, f0), pf0, O[dt], 0, 0, 0);
                O[dt] = __builtin_amdgcn_mfma_f32_32x32x16_bf16(__builtin_bit_cast(bf16x8, f1), pf1, O[dt], 0, 0, 0);
            }
        }
        lsum += __shfl_xor(lsum, 32);
        const float il = 1.f / lsum;
        float ss = 0.f;
#pragma unroll
        for (int dt = 0; dt < 4; ++dt)
#pragma unroll
            for (int i = 0; i < 16; ++i) { O[dt][i] *= il; ss += O[dt][i] * O[dt][i]; }
        ss += __shfl_xor(ss, 32);
        const float rr = rsqrtf(ss * (1.f / HD) + EPS);
        bf16* orow = MIXED + (size_t)mq * DM + h * HD;
#pragma unroll
        for (int dt = 0; dt < 4; ++dt)
#pragma unroll
            for (int rg = 0; rg < 4; ++rg) { const int d = 32 * dt + 8 * rg + 4 * hh; const f32x4 gg = *(const GAS f32x4*)(og + h * HD + d);
                v2u w; w.x = pk2(O[dt][4 * rg + 0] * rr * gg.x, O[dt][4 * rg + 1] * rr * gg.y); w.y = pk2(O[dt][4 * rg + 2] * rr * gg.z, O[dt][4 * rg + 3] * rr * gg.w);
                *(GAS v2u*)(orow + d) = w; }
        LDS_WAIT();
    }
}


constexpr int AT_KBYTES = 16384, AT_VPITCH = 136, AT_VBYTES = 128 * AT_VPITCH, AT_STAGE = AT_KBYTES + AT_VBYTES, AT_RP_OFF = 2 * AT_STAGE;
__device__ __forceinline__ void phase_attn2(Frame& F) {
    const bf16* QK = (const bf16*)(F.ws + WS_QK); const bf16* VT = (const bf16*)(F.ws + WS_XT); bf16* MIXED = (bf16*)(F.ws + WS_MIXED);
    const float* rpb = F.in[5]; const float* og = F.in[15];
    LAS float* rp = (LAS float*)(F.lds + AT_RP_OFF + F.wave * 2048);
    const int n = F.lane & 31, hh = F.lane >> 5;
    for (int unit = F.bid; unit < NB * NH * 16; unit += F.G) {
        const int rq = unit & 15, h = (unit >> 4) & 7, b = unit >> 7, r0 = 4 * rq;
        const int r = r0 + (F.wave >> 1), wq = F.wave & 1;
        int kmin = r0 - WR / 2; kmin = kmin < 0 ? 0 : (kmin > NROWS - WR ? NROWS - WR : kmin);
        int kmax = r0 + 3 - WR / 2; kmax = (kmax < 0 ? 0 : (kmax > NROWS - WR ? NROWS - WR : kmax)) + WR - 1;
        int kr0 = r - WR / 2; kr0 = kr0 < 0 ? 0 : (kr0 > NROWS - WR ? NROWS - WR : kr0);
        const int nrows = kmax - kmin + 1;
        __syncthreads();
        for (int i = F.lane; i < 15 * 31; i += 64) rp[i] = rpb[h * 465 + i];
        const int mq = b * SEQ + r * GW + 32 * wq + n, qc = 32 * wq + n;
        int c0 = qc - WC / 2; c0 = c0 < 0 ? 0 : (c0 > GW - WC ? GW - WC : c0);
        bf16x8 qf[8];
#pragma unroll
        for (int ks = 0; ks < 8; ++ks) qf[ks] = *(const GAS bf16x8*)(QK + (size_t)mq * 2048 + h * HD + 16 * ks + 8 * hh);
        f32x16 O[4];
#pragma unroll
        for (int dt = 0; dt < 4; ++dt)
#pragma unroll
            for (int i = 0; i < 16; ++i) O[dt][i] = 0.f;
        float lsum = 0.f;
        v4u sk[2], sv[2];
        auto gload = [&](int kr) {
#pragma unroll
            for (int j = 0; j < 2; ++j) { const int id = F.tid + 512 * j;
                sk[j] = *(const GAS v4u*)(QK + (size_t)(b * SEQ + kr * GW + (id >> 4)) * 2048 + 1024 + h * HD + 8 * (id & 15));
                sv[j] = *(const GAS v4u*)(VT + (size_t)(h * HD + (id >> 3)) * MT + b * SEQ + kr * GW + 8 * (id & 7)); }
        };
        auto lstore = [&](int buf) {
            LAS unsigned char* kb = F.lds + buf * AT_STAGE; LAS unsigned char* vb = kb + AT_KBYTES;
#pragma unroll
            for (int j = 0; j < 2; ++j) { const int id = F.tid + 512 * j; const int key = id >> 4, c = id & 15;
                *(LAS v4u*)(kb + key * 256 + ((c ^ (key & 15)) << 4)) = sk[j];
                const int d = id >> 3, cv = id & 7; LAS v2u* vp = (LAS v2u*)(vb + d * AT_VPITCH + cv * 16);
                v2u lo, hi; lo.x = sv[j].x; lo.y = sv[j].y; hi.x = sv[j].z; hi.y = sv[j].w; vp[0] = lo; vp[1] = hi; }
        };
        gload(kmin); lstore(0);
        __syncthreads();
#pragma unroll 1
        for (int j = 0; j < nrows; ++j) {
            const int kr = kmin + j, buf = j & 1;
            if (j + 1 < nrows) gload(kr + 1);
            if (kr >= kr0 && kr < kr0 + WR) {
                const LAS unsigned char* kb = F.lds + buf * AT_STAGE; const LAS unsigned char* vb = kb + AT_KBYTES;
                const int dr = kr - r + WR - 1;
#pragma unroll
                for (int kt = 0; kt < 2; ++kt) {
                    f32x16 S;
#pragma unroll
                    for (int i = 0; i < 16; ++i) S[i] = 0.f;
                    const int key = 32 * kt + n;
#pragma unroll
                    for (int ks = 0; ks < 8; ++ks) { const bf16x8 kf = *(const LAS bf16x8*)(kb + key * 256 + (((2 * ks + hh) ^ (key & 15)) << 4));
                        S = __builtin_amdgcn_mfma_f32_32x32x16_bf16(kf, qf[ks], S, 0, 0, 0); }
                    float p[16];
#pragma unroll
                    for (int i = 0; i < 16; ++i) { const int kc = 32 * kt + (i & 3) + 8 * (i >> 2) + 4 * hh; const bool valid = (kc >= c0) && (kc < c0 + WC);
                        int dc = kc - qc + WC - 1; dc = dc < 0 ? 0 : (dc > 2 * WC - 2 ? 2 * WC - 2 : dc);
                        const float e = __expf(S[i] * 0.08838834764831845f + rp[dr * 31 + dc]); p[i] = valid ? e : 0.f; lsum += p[i]; }
                    v4u pw0, pw1;
                    pw0.x = pk2(p[0], p[1]); pw0.y = pk2(p[2], p[3]); pw0.z = pk2(p[4], p[5]); pw0.w = pk2(p[6], p[7]);
                    pw1.x = pk2(p[8], p[9]); pw1.y = pk2(p[10], p[11]); pw1.z = pk2(p[12], p[13]); pw1.w = pk2(p[14], p[15]);
                    const bf16x8 pf0 = __builtin_bit_cast(bf16x8, pw0), pf1 = __builtin_bit_cast(bf16x8, pw1);
#pragma unroll
                    for (int dt = 0; dt < 4; ++dt) {
                        const LAS unsigned char* vrow = vb + (32 * dt + n) * AT_VPITCH + (32 * kt + 4 * hh) * 2;
                        const v2u a0 = *(const LAS v2u*)(vrow), a1 = *(const LAS v2u*)(vrow + 16), a2 = *(const LAS v2u*)(vrow + 32), a3 = *(const LAS v2u*)(vrow + 48);
                        v4u f0, f1; f0.x = a0.x; f0.y = a0.y; f0.z = a1.x; f0.w = a1.y; f1.x = a2.x; f1.y = a2.y; f1.z = a3.x; f1.w = a3.y;
                        O[dt] = __builtin_amdgcn_mfma_f32_32x32x16_bf16(__builtin_bit_cast(bf16x8, f0), pf0, O[dt], 0, 0, 0);
                        O[dt] = __builtin_amdgcn_mfma_f32_32x32x16_bf16(__builtin_bit_cast(bf16x8, f1), pf1, O[dt], 0, 0, 0);
                    }
                }
            }
            if (j + 1 < nrows) lstore(buf ^ 1);
            __syncthreads();
        }
        lsum += __shfl_xor(lsum, 32);
        const float il = 1.f / lsum;
        float ss = 0.f;
#pragma unroll
        for (int dt = 0; dt < 4; ++dt)
#pragma unroll
            for (int i = 0; i < 16; ++i) { O[dt][i] *= il; ss += O[dt][i] * O[dt][i]; }
        ss += __shfl_xor(ss, 32);
        const float rr = rsqrtf(ss * (1.f / HD) + EPS);
        bf16* orow = MIXED + (size_t)mq * DM + h * HD;
#pragma unroll
        for (int dt = 0; dt < 4; ++dt)
#pragma unroll
            for (int rg = 0; rg < 4; ++rg) { const int d = 32 * dt + 8 * rg + 4 * hh; const f32x4 gg = *(const GAS f32x4*)(og + h * HD + d);
                v2u w; w.x = pk2(O[dt][4 * rg + 0] * rr * gg.x, O[dt][4 * rg + 1] * rr * gg.y); w.y = pk2(O[dt][4 * rg + 2] * rr * gg.z, O[dt][4 * rg + 3] * rr * gg.w);
                *(GAS v2u*)(orow + d) = w; }
    }
    __syncthreads();
}

__device__ __forceinline__ void phase_p15(Frame& F) {
    bf16* QK = (bf16*)(F.ws + WS_QK); const float* qg = F.in[3]; const float* kg = F.in[4];
    for (int m = GW_ID(F); m < MT; m += GW_N(F)) {
        GAS v4u* rowp = (GAS v4u*)(QK + (size_t)m * 2048) + F.lane;
#pragma unroll
        for (int j = 0; j < 4; ++j) {
            v4u w = rowp[64 * j];
            float f[8] = {bflo(w.x), bfhi(w.x), bflo(w.y), bfhi(w.y), bflo(w.z), bfhi(w.z), bflo(w.w), bfhi(w.w)};
            float ss = 0.f;
#pragma unroll
            for (int e = 0; e < 8; ++e) ss += f[e] * f[e];
            ss += __shfl_xor(ss, 1); ss += __shfl_xor(ss, 2); ss += __shfl_xor(ss, 4); ss += __shfl_xor(ss, 8);
            const float r = rsqrtf(ss * (1.f / HD) + EPS);
            const int col = 512 * j + 8 * F.lane, d = col & 127; const float* g = (col < 1024 ? qg : kg) + d;
#pragma unroll
            for (int e = 0; e < 8; ++e) f[e] = f[e] * r * g[e];
            w.x = pk2(f[0], f[1]); w.y = pk2(f[2], f[3]); w.z = pk2(f[4], f[5]); w.w = pk2(f[6], f[7]);
            rowp[64 * j] = w;
        }
    }
    const bf16* XT = (const bf16*)(F.ws + WS_XT) + (size_t)1024 * MT; bf16* UC = (bf16*)(F.ws + WS_UC);
    const float* cw = F.in[6]; const float* cb = F.in[7];
    const size_t nchunks = (size_t)3072 * MT / 8;
    for (size_t i = (size_t)F.bid * NTHREADS + F.tid; i < nchunks; i += (size_t)F.G * NTHREADS) {
        const int ch = (int)(i >> 10), m0 = (int)(i & 1023) * 8, s0 = m0 & 4095;
        const bf16* up = XT + (size_t)ch * MT + m0;
        const v4u w = *(const GAS v4u*)up;
        float f[10];
        f[1] = bflo(w.x); f[2] = bfhi(w.x); f[3] = bflo(w.y); f[4] = bfhi(w.y); f[5] = bflo(w.z); f[6] = bfhi(w.z); f[7] = bflo(w.w); f[8] = bfhi(w.w);
        f[0] = s0 > 0 ? bf2f(up[-1]) : 0.f; f[9] = s0 + 8 < SEQ ? bf2f(up[8]) : 0.f;
        const float w0 = cw[ch], w1 = cw[3072 + ch], w2 = cw[6144 + ch], bb = cb[ch];
        float o[8];
#pragma unroll
        for (int e = 0; e < 8; ++e) o[e] = bb + w0 * f[e] + w1 * f[e + 1] + w2 * f[e + 2];
        v4u ov; ov.x = pk2(o[0], o[1]); ov.y = pk2(o[2], o[3]); ov.z = pk2(o[4], o[5]); ov.w = pk2(o[6], o[7]);
        *(GAS v4u*)(UC + (size_t)ch * MT + m0) = ov;
    }
}
__device__ __forceinline__ void phase_p25(Frame& F) {
    const bf16* HYT = (const bf16*)(F.ws + WS_HYT); bf16* MIXED = (bf16*)(F.ws + WS_MIXED); const float* hg = F.in[16];
    LAS float* tile = (LAS float*)F.lds;
    LAS float* rs = (LAS float*)(F.lds + 128 * 65 * 4);
    for (int it = F.bid; it < 8 * (MT / 64); it += F.G) {
        const int gi = it & 7, m0 = (it >> 3) * 64;
        { const int ch = F.tid >> 2, t0 = (F.tid & 3) * 16; const bf16* p = HYT + (size_t)(gi * 128 + ch) * MT + m0 + t0;
          const v4u a = *(const GAS v4u*)p, b = *(const GAS v4u*)(p + 8);
          LAS float* d = tile + ch * 65 + t0;
          d[0] = bflo(a.x); d[1] = bfhi(a.x); d[2] = bflo(a.y); d[3] = bfhi(a.y); d[4] = bflo(a.z); d[5] = bfhi(a.z); d[6] = bflo(a.w); d[7] = bfhi(a.w);
          d[8] = bflo(b.x); d[9] = bfhi(b.x); d[10] = bflo(b.y); d[11] = bfhi(b.y); d[12] = bflo(b.z); d[13] = bfhi(b.z); d[14] = bflo(b.w); d[15] = bfhi(b.w); }
        __syncthreads();
        {
          const int t = F.tid >> 3, c0 = (F.tid & 7) * 16; float ss = 0.f;
#pragma unroll
          for (int c = 0; c < 16; ++c) { const float v = tile[(c0 + c) * 65 + t]; ss += v * v; }
          ss += __shfl_xor(ss, 1); ss += __shfl_xor(ss, 2); ss += __shfl_xor(ss, 4);
          if ((F.tid & 7) == 0) rs[t] = rsqrtf(ss * (1.f / 128) + EPS); }
        __syncthreads();
        {
          const int t = F.tid >> 3, c0 = (F.tid & 7) * 16; const float r = rs[t]; float o[16];
#pragma unroll
          for (int c = 0; c < 16; ++c) o[c] = tile[(c0 + c) * 65 + t] * r * hg[gi * 128 + c0 + c];
          v4u a, b; a.x = pk2(o[0], o[1]); a.y = pk2(o[2], o[3]); a.z = pk2(o[4], o[5]); a.w = pk2(o[6], o[7]); b.x = pk2(o[8], o[9]); b.y = pk2(o[10], o[11]); b.z = pk2(o[12], o[13]); b.w = pk2(o[14], o[15]);
          bf16* q = MIXED + (size_t)(m0 + t) * DM + AW + gi * 128 + c0; *(GAS v4u*)q = a; *(GAS v4u*)(q + 8) = b; }
        __syncthreads();
    }
}
__device__ __forceinline__ void phase_p35(Frame& F) {
    LAS float* wrT = (LAS float*)F.lds;
    const float* wr = F.in[19]; const float* g = F.in[18];
    for (int i = F.tid; i < DM * NE; i += NTHREADS) { const int d = i >> 4, e = i & 15; wrT[e * DM + d] = wr[i]; }
    __syncthreads();
    bf16* HB = (bf16*)(F.ws + WS_HB); float* AFF = (float*)(F.ws + WS_AFF); const float* x1 = F.out;
    for (int m = GW_ID(F); m < MT; m += GW_N(F)) {
        const GAS f32x4* xr = (const GAS f32x4*)(x1 + (size_t)m * DM) + F.lane;
        f32x4 v[8]; float s = 0.f;
#pragma unroll
        for (int j = 0; j < 8; ++j) { v[j] = xr[64 * j]; s += (v[j].x * v[j].x + v[j].y * v[j].y) + (v[j].z * v[j].z + v[j].w * v[j].w); }
        const float r = rsqrtf(wave_sum(s) * (1.f / DM) + EPS);
        GAS v2u* o8 = (GAS v2u*)(HB + (size_t)m * DM) + F.lane;
#pragma unroll
        for (int j = 0; j < 8; ++j) { const f32x4 gg = *((const GAS f32x4*)g + F.lane + 64 * j); v[j].x *= r * gg.x; v[j].y *= r * gg.y; v[j].z *= r * gg.z; v[j].w *= r * gg.w;
            v2u o; o.x = pk2(v[j].x, v[j].y); o.y = pk2(v[j].z, v[j].w); o8[64 * j] = o; }
        float mine = 0.f;
#pragma unroll 1
        for (int e = 0; e < NE; ++e) { float a = 0.f;
#pragma unroll
            for (int j = 0; j < 8; ++j) { const f32x4 w = *((const LAS f32x4*)(wrT + e * DM) + F.lane + 64 * j); a += (v[j].x * w.x + v[j].y * w.y) + (v[j].z * w.z + v[j].w * w.w); }
            a = wave_sum(a); mine = (F.lane == e) ? a : mine; }
        float mx = mine;
        mx = fmaxf(mx, __shfl_xor(mx, 1)); mx = fmaxf(mx, __shfl_xor(mx, 2)); mx = fmaxf(mx, __shfl_xor(mx, 4)); mx = fmaxf(mx, __shfl_xor(mx, 8));
        const float ex = expf(mine - mx); float den = ex;
        den += __shfl_xor(den, 1); den += __shfl_xor(den, 2); den += __shfl_xor(den, 4); den += __shfl_xor(den, 8);
        const int b = m / SEQ, sidx = m % SEQ;
        if (F.lane < NE) AFF[((size_t)b * NE + F.lane) * SEQ + sidx] = ex / den;
    }
    __syncthreads();
}
__device__ __forceinline__ void phase_p4(Frame& F) {
    LAS unsigned* key = (LAS unsigned*)F.lds;
    LAS unsigned* hist = (LAS unsigned*)(F.lds + 16384);
    LAS unsigned* wsum = (LAS unsigned*)(F.lds + 16384 + 1024);
    const float* AFF = (const float*)(F.ws + WS_AFF); int* IDX = (int*)(F.ws + WS_IDX); float* GATE = (float*)(F.ws + WS_GATE); int* SEL = (int*)(F.ws + WS_SEL);
    for (int be = F.bid; be < NB * NE; be += F.G) {
        const int b = be / NE, e = be % NE;
        __syncthreads();
        const GAS v4u* ap = (const GAS v4u*)(AFF + (size_t)be * SEQ);
        const v4u k0 = ap[2 * F.tid], k1 = ap[2 * F.tid + 1];
        unsigned kk[8] = {k0.x, k0.y, k0.z, k0.w, k1.x, k1.y, k1.z, k1.w};
        unsigned prefix = 0u, mask = 0u, remaining = CAP;
#pragma unroll 1
        for (int pass = 0; pass < 4; ++pass) {
            const int shift = 24 - 8 * pass;
            if (F.tid < 256) hist[F.tid] = 0u;
            __syncthreads();
#pragma unroll
            for (int i = 0; i < 8; ++i) if ((kk[i] & mask) == prefix) __hip_atomic_fetch_add(&hist[(kk[i] >> shift) & 255u], 1u, __ATOMIC_RELAXED, __HIP_MEMORY_SCOPE_WORKGROUP);
            __syncthreads();
            if (F.tid < 256) {
                unsigned above = 0u;
                for (int j = F.tid + 1; j < 256; ++j) above += hist[j];
                const unsigned mine = hist[F.tid];
                if (above < remaining && remaining <= above + mine) { wsum[8] = (unsigned)F.tid; wsum[9] = above; }
            }
            __syncthreads();
            const unsigned d = wsum[8], above = wsum[9];
            prefix |= d << shift; mask |= 255u << shift; remaining -= above;
            __syncthreads();
        }
        const unsigned thr = prefix;
        unsigned cnt = 0u;
#pragma unroll
        for (int i = 0; i < 8; ++i) cnt += (kk[i] > thr ? 0x10000u : 0u) + (kk[i] == thr ? 1u : 0u);
        unsigned incl = cnt;
#pragma unroll
        for (int o = 1; o < 64; o <<= 1) { const unsigned t = __shfl_up(incl, o); if (F.lane >= o) incl += t; }
        if (F.lane == 63) wsum[F.wave] = incl;
        __syncthreads();
        unsigned base = 0u;
        for (int w = 0; w < F.wave; ++w) base += wsum[w];
        unsigned run = base + incl - cnt;
#pragma unroll
        for (int i = 0; i < 8; ++i) {
            const unsigned gt_before = run >> 16, tie_before = run & 0xffffu;
            const bool isgt = kk[i] > thr, istie = kk[i] == thr;
            const bool sel = isgt || (istie && tie_before < remaining);
            const unsigned slot = gt_before + (tie_before < remaining ? tie_before : remaining);
            const int s = 8 * F.tid + i, m = b * SEQ + s;
            if (sel) { IDX[be * CAP + slot] = m; GATE[be * CAP + slot] = __builtin_bit_cast(float, kk[i]); }
            SEL[(size_t)m * NE + e] = sel ? (int)slot : -1;
            run += (isgt ? 0x10000u : 0u) + (istie ? 1u : 0u);
        }
    }
    __syncthreads();
}
__device__ __forceinline__ void phase_p7(Frame& F) {
    const int* SEL = (const int*)(F.ws + WS_SEL); const float* GATE = (const float*)(F.ws + WS_GATE); const bf16* YE = (const bf16*)(F.ws + WS_YE);
    for (int m = GW_ID(F); m < MT; m += GW_N(F)) {
        const int b = m / SEQ;
        GAS f32x4* orow = (GAS f32x4*)(F.out + (size_t)m * DM);
        f32x4 acc[8];
#pragma unroll
        for (int j = 0; j < 8; ++j) acc[j] = orow[2 * F.lane + (j & 1) + 128 * (j >> 1)];
        for (int e = 0; e < NE; ++e) { const int slot = SEL[(size_t)m * NE + e]; if (slot >= 0) {
            const GAS v4u* yr = (const GAS v4u*)(YE + (size_t)((b * NE + e) * CAP + slot) * DM) + F.lane;
#pragma unroll
            for (int jj = 0; jj < 4; ++jj) { const v4u w = yr[64 * jj];
                acc[2 * jj].x += bflo(w.x); acc[2 * jj].y += bfhi(w.x); acc[2 * jj].z += bflo(w.y); acc[2 * jj].w += bfhi(w.y);
                acc[2 * jj + 1].x += bflo(w.z); acc[2 * jj + 1].y += bfhi(w.z); acc[2 * jj + 1].z += bflo(w.w); acc[2 * jj + 1].w += bfhi(w.w); } } }
#pragma unroll
        for (int j = 0; j < 8; ++j) orow[2 * F.lane + (j & 1) + 128 * (j >> 1)] = acc[j];
    }
    (void)GATE;
}

struct Args { const float* in[23]; float* out; unsigned char* ws; int ph_lo, ph_hi; };
enum Phase { PH_P0 = 0, PH_G1, PH_FILT, PH_P15, PH_ATTN, PH_P25, PH_OUT, PH_P35, PH_P4, PH_UP, PH_DOWN, PH_P7, PH_COUNT };

__global__ void __launch_bounds__(NTHREADS, 2) mk_fwd(Args args) {
    extern __shared__ __attribute__((aligned(16))) unsigned char lds_raw[];
    Frame F;
    F.lds = (LAS unsigned char*)lds_raw;
    F.tid = threadIdx.x; F.lane = F.tid & 63; F.wave = __builtin_amdgcn_readfirstlane(F.tid >> 6); F.G = gridDim.x; F.bid = blockIdx.x;
#pragma unroll
    for (int i = 0; i < 23; ++i) F.in[i] = args.in[i];
    F.out = args.out; F.ws = args.ws;
    const int lo = args.ph_lo, hi = args.ph_hi;
#define IN(k) (lo <= (k) && (k) < hi)
#define REPS(k) for (int rep_ = 0; rep_ < ((k) == REP_PHASE ? REP_N : 1); ++rep_)
#if MK_N_LAUNCHES == 1
    { volatile LAS unsigned* misc = (volatile LAS unsigned*)(F.lds + LDS_MISC_OFF); if (F.tid < 16) misc[F.tid] = 0u; }
    __syncthreads();
    XcdBarrier bar = xcd_barrier_post((unsigned*)(F.ws + WS_CTL) + 4096, (volatile LAS unsigned*)(F.lds + LDS_MISC_OFF) + 8);
#define SEAM(k) do { if (IN(k) && IN((k) + 1)) xcd_barrier(bar); } while (0)
#else
#define SEAM(k) do { } while (0)
#endif
    if (IN(PH_P0)) REPS(PH_P0) { phase_p0(F); } SEAM(PH_P0);
    if (IN(PH_G1)) REPS(PH_G1) {
        __syncthreads();
        { pg8::DenseOrder S; S.init(F.ws + WS_HB, F.ws + WS_WIN, MT, 2048, DM, 0, F.G, F.bid);
          pg8::EpiBf16 E{(pg8::bf16_t*)(F.ws + WS_QK), 2048, 0, nullptr};
          pg8::gemm_phase<pg8::EpiBf16, pg8::DenseOrder, true>(F.lds, DM, S, E); }
        { pg8::DenseOrder S; S.init(F.ws + WS_HB, F.ws + WS_WIN, MT, 4096, DM, 8, F.G, F.bid);
          pg8::EpiTransBf16 E{(pg8::bf16_t*)(F.ws + WS_XT), MT, 8};
          pg8::gemm_phase<pg8::EpiTransBf16, pg8::DenseOrder, true>(F.lds, DM, S, E); }
    } SEAM(PH_G1);
    if (IN(PH_FILT)) REPS(PH_FILT) { phase_filters(F); } SEAM(PH_FILT);
    if (IN(PH_P15)) { phase_p15(F); } SEAM(PH_P15);
    if (IN(PH_ATTN)) { __syncthreads(); for (int rep_ = 0; rep_ < ((PH_ATTN == REP_PHASE && REP_SUB != 2) ? REP_N : 1); ++rep_) phase_hyena(F); for (int rep_ = 0; rep_ < ((PH_ATTN == REP_PHASE && REP_SUB != 1) ? REP_N : 1); ++rep_) phase_attn2(F); } SEAM(PH_ATTN);
    if (IN(PH_P25)) REPS(PH_P25) { __syncthreads(); phase_p25(F); } SEAM(PH_P25);
    if (IN(PH_OUT)) REPS(PH_OUT) {
        __syncthreads();
        pg8::DenseOrder S; S.init(F.ws + WS_MIXED, F.ws + WS_WOUT, MT, DM, DM, 0, F.G, F.bid);
        pg8::EpiResF32 E{F.in[0], F.out, DM};
        pg8::gemm_phase<pg8::EpiResF32, pg8::DenseOrder, false>(F.lds, DM, S, E);
    } SEAM(PH_OUT);
    if (IN(PH_P35)) REPS(PH_P35) { __syncthreads(); phase_p35(F); } SEAM(PH_P35);
    if (IN(PH_P4)) REPS(PH_P4) { __syncthreads(); phase_p4(F); } SEAM(PH_P4);
    if (IN(PH_UP)) REPS(PH_UP) {
        __syncthreads();
        pg8::MoeOrder S; S.init(F.ws + WS_HB, F.ws + WS_WGU, DM, F.G, F.bid, true);
        LAS int* ridx = (LAS int*)(F.lds + 131072);
        { const int* IDX = (const int*)(F.ws + WS_IDX); pg8::Unit u;
          for (int i = 0; S.next(i, u); ++i) if (F.tid < 256) ridx[i * 256 + F.tid] = IDX[u.g * CAP + u.pm * 256 + F.tid]; }
        __syncthreads();
        pg8::EpiSwiGLU E{(pg8::bf16_t*)(F.ws + WS_ACT)};
        pg8::gemm_phase<pg8::EpiSwiGLU, pg8::MoeOrder, true, true>(F.lds, DM, S, E, ridx);
    } SEAM(PH_UP);
    if (IN(PH_DOWN)) REPS(PH_DOWN) {
        __syncthreads();
        pg8::MoeOrder S; S.init(F.ws + WS_ACT, F.ws + WS_WD, FF, F.G, F.bid, false);
        pg8::EpiBf16 E{(pg8::bf16_t*)(F.ws + WS_YE), DM, 512, (const float*)(F.ws + WS_GATE)};
        pg8::gemm_phase<pg8::EpiBf16, pg8::MoeOrder, true>(F.lds, FF, S, E);
    } SEAM(PH_DOWN);
    if (IN(PH_P7)) { phase_p7(F); }
#undef IN
#undef SEAM
}

extern "C" void kernel_launch(void* const* d_in, const int* in_sizes, int n_in, void* d_out, int out_size, void* d_ws, size_t ws_size, hipStream_t stream) {
    static int grid = 0;
    if (grid == 0) {
        if (n_in != 23 || ws_size < WS_END) { fprintf(stderr, "kernel_launch: unexpected inputs (n_in %d, ws %zu)\n", n_in, ws_size); grid = -1; return; }
        if (hipFuncSetAttribute((const void*)mk_fwd, hipFuncAttributeMaxDynamicSharedMemorySize, LDS_BYTES) != hipSuccess) { fprintf(stderr, "kernel_launch: hipFuncSetAttribute failed\n"); grid = -1; return; }
        int dev = 0, cus = 0, per_cu = 0;
        hipGetDevice(&dev); hipDeviceGetAttribute(&cus, hipDeviceAttributeMultiprocessorCount, dev);
        hipOccupancyMaxActiveBlocksPerMultiprocessor(&per_cu, (const void*)mk_fwd, NTHREADS, LDS_BYTES);
        (void)hipGetLastError();
        if (per_cu < 1) { fprintf(stderr, "kernel_launch: occupancy query says %d blocks/CU\n", per_cu); }
        grid = cus;
    }
    if (grid < 0) return;
    Args a{};
    for (int i = 0; i < 23; ++i) a.in[i] = (const float*)d_in[i];
    a.out = (float*)d_out; a.ws = (unsigned char*)d_ws;
#if MK_N_LAUNCHES == 1
    if (hipMemsetAsync((char*)d_ws + WS_CTL, 0, CTL_ZERO_BYTES, stream) != hipSuccess) { fprintf(stderr, "kernel_launch: memset failed\n"); return; }
    a.ph_lo = 0; a.ph_hi = PH_COUNT;
    void* kargs[] = {&a};
    hipError_t e = hipLaunchCooperativeKernel((const void*)mk_fwd, dim3(grid), dim3(NTHREADS), kargs, LDS_BYTES, stream);
    if (e != hipSuccess) fprintf(stderr, "cooperative launch failed: %s (grid %d)\n", hipGetErrorString(e), grid);
#else
    for (int p = 0; p < PH_COUNT; ++p) { a.ph_lo = p; a.ph_hi = p + 1; hipLaunchKernelGGL(mk_fwd, dim3(grid), dim3(NTHREADS), LDS_BYTES, stream, a); }
#endif
}
```

```cpp
#include <hip/hip_runtime.h>
#include <hip/hip_cooperative_groups.h>
#include <cstdio>
#include <cstdint>
namespace cg = cooperative_groups;

#ifndef REP_PHASE
#define REP_PHASE -1
#define REP_N 1
#define REP_SUB 0
#endif
#ifndef MK_N_LAUNCHES
#define MK_N_LAUNCHES 1
#endif

namespace pg8 {
#define PG8_LAS __attribute__((address_space(3)))
typedef unsigned short bf16_t;
typedef short bf16x8 __attribute__((ext_vector_type(8)));
typedef float f32x4 __attribute__((ext_vector_type(4)));
typedef unsigned u32x4 __attribute__((ext_vector_type(4)));
typedef unsigned u32x2 __attribute__((ext_vector_type(2)));
constexpr int BM = 256, BK = 64, HALF = 128, HTB = HALF * BK * 2, STAGE_BYTES = 8 * HTB, NXCD = 8, WGM = 8;

__host__ __device__ __forceinline__ int lds_byte(int r, int c) { const int st = (r >> 4) * 2 + (c >> 5), rr = r & 15, cc = c & 31, ob = rr * 64 + cc * 2; return st * 1024 + (ob ^ (((ob >> 9) & 1) << 5)); }
__host__ __device__ __forceinline__ void stage_rc(int b, int& R, int& C) { const int st = b / 1024, sb = b % 1024, swz = sb ^ (((sb >> 9) & 1) << 5); R = (st >> 1) * 16 + swz / 64; C = (st & 1) * 32 + (swz % 64) / 2; }
__host__ __device__ __forceinline__ int perm32(int rho) { const int n = rho >> 4, i = rho & 15; return 8 * (i >> 2) + 4 * n + (i & 3); }

struct Unit { int pm, pn, g; const char* a; const char* b; };

__device__ __forceinline__ unsigned cvt_pk_bf16(float lo, float hi) { unsigned r; asm volatile("v_cvt_pk_bf16_f32 %0, %1, %2" : "=v"(r) : "v"(lo), "v"(hi)); return r; }

struct DenseOrder {
    static constexpr bool CHUNK_B = false;
    int nM, nN, nwg, G, c, K, pn0; const char* A; const char* Bt;
    __device__ void init(const void* A_, const void* Bt_, int M, int N, int K_, int pn0_, int G_, int c_) { A = (const char*)A_; Bt = (const char*)Bt_; nM = M / BM; nN = N / BM; nwg = nM * nN; G = G_; c = c_; K = K_; pn0 = pn0_; }
    __device__ bool next(int i, Unit& u) const {
        const long L = (long)i * G + c; if (L >= nwg) return false;
        int wgid = (int)L; { const int q = nwg / NXCD, r = nwg % NXCD, xcd = wgid % NXCD, off = wgid / NXCD; wgid = (xcd < r ? xcd * (q + 1) : r * (q + 1) + (xcd - r) * q) + off; }
        const int nig = WGM * nN, gid = wgid / nig, fm = gid * WGM, gsz = (nM - fm) < WGM ? (nM - fm) : WGM;
        u.pm = fm + ((wgid % nig) % gsz); u.pn = pn0 + (wgid % nig) / gsz; u.g = 0;
        u.a = A + (size_t)u.pm * BM * K * 2; u.b = Bt + (size_t)u.pn * BM * K * 2; return true;
    }
};
struct MoeOrder {
    static constexpr bool CHUNK_B = true;
    int G, c, K; bool gather; const char* A; const char* Bt;
    __device__ void init(const void* A_, const void* Bt_, int K_, int G_, int c_, bool gather_) { A = (const char*)A_; Bt = (const char*)Bt_; K = K_; G = G_; c = c_; gather = gather_; }
    __device__ bool next(int i, Unit& u) const {
        const int L = i * G + c; if (L >= 512) return false;
        const int pn = L & 7, pm = (L >> 3) & 1, b = (L >> 4) & 1, e = L >> 5;
        u.pm = pm; u.pn = pn; u.g = b * 16 + e;
        u.a = gather ? A : A + (size_t)(u.g * 512 + pm * BM) * K * 2; u.b = Bt + (size_t)e * 2048 * K * 2 + (size_t)pn * BM * 16; return true;
    }
};

struct EpiBf16 {
    static constexpr bool PERM = true, SWAP = false;
    bf16_t* O; int ldc; int grows; const float* rscale;
    __device__ __forceinline__ void operator()(const f32x4 (&acc)[2][2][4][2], const Unit& u, int wr, int wc, int fr, int fq) const {
        const int row0 = u.g * grows + u.pm * BM + wr * 64 + fr, col0 = u.pn * BM + wc * 32 + 8 * fq;
#pragma unroll
        for (int ai = 0; ai < 2; ++ai)
#pragma unroll
            for (int m = 0; m < 4; ++m) { const int row = row0 + ai * HALF + m * 16; bf16_t* rowp = O + (size_t)row * ldc + col0; const float sc = rscale ? rscale[row] : 1.f;
#pragma unroll
                for (int bj = 0; bj < 2; ++bj) { const f32x4 v0 = acc[ai][bj][m][0] * sc, v1 = acc[ai][bj][m][1] * sc;
                    u32x4 w; w.x = cvt_pk_bf16(v0[0], v0[1]); w.y = cvt_pk_bf16(v0[2], v0[3]); w.z = cvt_pk_bf16(v1[0], v1[1]); w.w = cvt_pk_bf16(v1[2], v1[3]);
                    *(u32x4*)(rowp + bj * HALF) = w; } }
    }
};
struct EpiSwiGLU {
    static constexpr bool PERM = true, SWAP = false;
    bf16_t* O;
    __device__ __forceinline__ void operator()(const f32x4 (&acc)[2][2][4][2], const Unit& u, int wr, int wc, int fr, int fq) const {
        const int row0 = u.g * 512 + u.pm * BM + wr * 64 + fr, col0 = u.pn * HALF + wc * 32 + 8 * fq;
#pragma unroll
        for (int ai = 0; ai < 2; ++ai)
#pragma unroll
            for (int m = 0; m < 4; ++m) { bf16_t* rowp = O + (size_t)(row0 + ai * HALF + m * 16) * 1024 + col0;
                float r[8];
#pragma unroll
                for (int n = 0; n < 2; ++n)
#pragma unroll
                    for (int e = 0; e < 4; ++e) { const float g = acc[ai][0][m][n][e], up = acc[ai][1][m][n][e]; r[n * 4 + e] = g / (1.f + __expf(-g)) * up; }
                u32x4 w; w.x = cvt_pk_bf16(r[0], r[1]); w.y = cvt_pk_bf16(r[2], r[3]); w.z = cvt_pk_bf16(r[4], r[5]); w.w = cvt_pk_bf16(r[6], r[7]);
                *(u32x4*)rowp = w; }
    }
};
struct EpiResF32 {
    static constexpr bool PERM = false, SWAP = false;
    const float* res; float* out; int ldc;
    __device__ __forceinline__ void operator()(const f32x4 (&acc)[2][2][4][2], const Unit& u, int wr, int wc, int fr, int fq) const {
        const int row0 = u.pm * BM + wr * 64 + fr, col0 = u.pn * BM + wc * 32 + 4 * fq;
#pragma unroll
        for (int ai = 0; ai < 2; ++ai)
#pragma unroll
            for (int m = 0; m < 4; ++m) { const size_t off = (size_t)(row0 + ai * HALF + m * 16) * ldc + col0;
#pragma unroll
                for (int bj = 0; bj < 2; ++bj)
#pragma unroll
                    for (int n = 0; n < 2; ++n) { const f32x4 r = *(const f32x4*)(res + off + bj * HALF + n * 16); *(f32x4*)(out + off + bj * HALF + n * 16) = r + acc[ai][bj][m][n]; } }
    }
};
struct EpiTransBf16 {
    static constexpr bool PERM = false, SWAP = true;
    bf16_t* O; int ldt; int pn_base;
    __device__ __forceinline__ void operator()(const f32x4 (&acc)[2][2][4][2], const Unit& u, int wr, int wc, int fr, int fq) const {
        const int ch0 = (u.pn - pn_base) * BM + wc * 32 + fr, t0 = u.pm * BM + wr * 64 + 4 * fq;
#pragma unroll
        for (int bj = 0; bj < 2; ++bj)
#pragma unroll
            for (int n = 0; n < 2; ++n) { bf16_t* chp = O + (size_t)(ch0 + bj * HALF + n * 16) * ldt + t0;
#pragma unroll
                for (int ai = 0; ai < 2; ++ai)
#pragma unroll
                    for (int m = 0; m < 4; ++m) { const f32x4 v = acc[ai][bj][m][n]; u32x2 w; w.x = cvt_pk_bf16(v[0], v[1]); w.y = cvt_pk_bf16(v[2], v[3]); *(u32x2*)(chp + ai * HALF + m * 16) = w; } }
    }
};

template <class Epi, class Sched, bool ALIGN_EPI = false, bool GATHER = false>
__device__ __forceinline__ void gemm_phase(PG8_LAS unsigned char* lds, const int K, const Sched& S, const Epi& E, const PG8_LAS int* ridx = nullptr) {
    const int tid = threadIdx.x, wid = __builtin_amdgcn_readfirstlane(tid >> 6), lane = tid & 63, wr = wid >> 2, wc = wid & 3, fr = lane & 15, fq = lane >> 4;
    const int nt = K / BK;
    unsigned vA0[2], vA1[2], vN0[2], vN1[2], voffB[2]; int stR[2], stC[2];
    const size_t kstep = (size_t)(BK * 2);
    const size_t hstep = (size_t)HALF * K * 2;
    const size_t kstepB = Sched::CHUNK_B ? (size_t)(BK / 8) * 2048 * 16 : kstep, hstepB = Sched::CHUNK_B ? (size_t)HALF * 16 : hstep;
#pragma unroll
    for (int i = 0; i < 2; ++i) { int R, C; stage_rc(tid * 16 + i * 8192, R, C); const int Rb = Epi::PERM ? ((R & ~31) + perm32(R & 31)) : R; stR[i] = R; stC[i] = C;
        voffB[i] = Sched::CHUNK_B ? (unsigned)(((C >> 3) * 2048 + Rb) * 16) : (unsigned)(Rb * K + C) * 2u;
        if constexpr (GATHER) { vA0[i] = (unsigned)(ridx[R] * K + C) * 2u; vA1[i] = (unsigned)(ridx[HALF + R] * K + C) * 2u; }
        else { vA0[i] = (unsigned)(R * K + C) * 2u; vA1[i] = vA0[i] + (unsigned)hstep; }
        vN0[i] = vA0[i]; vN1[i] = vA1[i]; }
    const unsigned ldsw = (unsigned)wid * 1024u;
    const int aoff = lds_byte(wr * 64 + fr, fq * 8), boff = lds_byte(wc * 32 + fr, fq * 8);
#define PG8_SA(b, h) (((b) * 2 + (h)) * HTB)
#define PG8_SB(b, h) ((4 + (b) * 2 + (h)) * HTB)
#define PG8_STAGE(bufoff, gbase, voff) do { _Pragma("unroll") for (int _i = 0; _i < 2; ++_i) \
        __builtin_amdgcn_global_load_lds((const unsigned*)((const char*)(gbase) + (voff)[_i]), (PG8_LAS unsigned*)(lds + (bufoff) + ldsw + _i * 8192), 16, 0, 0); } while (0)
#define PG8_LDA(dst, b, h) do { _Pragma("unroll") for (int m = 0; m < 4; ++m) _Pragma("unroll") for (int k = 0; k < 2; ++k) dst[m][k] = *(const PG8_LAS bf16x8*)(lds + PG8_SA(b, h) + aoff + m * 2048 + k * 1024); } while (0)
#define PG8_LDB(dst, b, h) do { _Pragma("unroll") for (int n = 0; n < 2; ++n) _Pragma("unroll") for (int k = 0; k < 2; ++k) dst[n][k] = *(const PG8_LAS bf16x8*)(lds + PG8_SB(b, h) + boff + n * 2048 + k * 1024); } while (0)
#define PG8_MMA(ai, bj, At, Bt) do { __builtin_amdgcn_s_setprio(1); _Pragma("unroll") for (int m = 0; m < 4; ++m) _Pragma("unroll") for (int n = 0; n < 2; ++n) _Pragma("unroll") for (int k = 0; k < 2; ++k) \
        acc[ai][bj][m][n] = Epi::SWAP ? __builtin_amdgcn_mfma_f32_16x16x32_bf16(At[m][k], Bt[n][k], acc[ai][bj][m][n], 0, 0, 0) : __builtin_amdgcn_mfma_f32_16x16x32_bf16(Bt[n][k], At[m][k], acc[ai][bj][m][n], 0, 0, 0); __builtin_amdgcn_s_setprio(0); } while (0)
#define PG8_WAIT_V(n) asm volatile("s_waitcnt vmcnt(" #n ")" ::: "memory")
#define PG8_WAIT_L(n) asm volatile("s_waitcnt lgkmcnt(" #n ")" ::: "memory")
#define PG8_BAR __builtin_amdgcn_s_barrier()
#define PG8_SCHED __builtin_amdgcn_sched_barrier(0)
    Unit cur, nxt; int ui = 0;
    if (!S.next(0, cur)) return;
    f32x4 acc[2][2][4][2];
#pragma unroll
    for (int a = 0; a < 2; ++a)
#pragma unroll
        for (int b = 0; b < 2; ++b)
#pragma unroll
            for (int m = 0; m < 4; ++m)
#pragma unroll
                for (int n = 0; n < 2; ++n) acc[a][b][m][n] = (f32x4){0.f, 0.f, 0.f, 0.f};
    bf16x8 At[4][2], B0[2][2], B1[2][2];
    const char* cA = cur.a; const char* cB = cur.b;
    PG8_STAGE(PG8_SB(0, 0), cB, voffB); PG8_STAGE(PG8_SB(0, 1), cB + hstepB, voffB); PG8_STAGE(PG8_SA(0, 0), cA, vA0); PG8_STAGE(PG8_SA(0, 1), cA, vA1);
    if (wr == 1) PG8_BAR;
    PG8_WAIT_V(2); PG8_BAR;
    PG8_STAGE(PG8_SB(1, 0), cB + kstepB, voffB); PG8_STAGE(PG8_SA(1, 0), cA + kstep, vA0); PG8_STAGE(PG8_SB(1, 1), cB + hstepB + kstepB, voffB);
    PG8_WAIT_V(6); PG8_BAR;
    for (;;) {
        const bool has_next = S.next(ui + 1, nxt);
        const char* nA = has_next ? nxt.a : cA; const char* nB = has_next ? nxt.b : cB;
        if constexpr (GATHER) { if (has_next) {
#pragma unroll
            for (int i = 0; i < 2; ++i) { vN0[i] = (unsigned)(ridx[(ui + 1) * 256 + stR[i]] * K + stC[i]) * 2u; vN1[i] = (unsigned)(ridx[(ui + 1) * 256 + HALF + stR[i]] * K + stC[i]) * 2u; } } }
        for (int t = 0; t < nt; t += 2) {
            const bool last = (t == nt - 2);
            const char* a1 = cA + (size_t)(t + 1) * kstep;
            const char* a2 = last ? nA : cA + (size_t)(t + 2) * kstep; const char* b2 = last ? nB : cB + (size_t)(t + 2) * kstepB;
            const char* a3 = a2 + kstep; const char* b3 = b2 + kstepB;
            unsigned w0[2], w1[2];
#pragma unroll
            for (int i = 0; i < 2; ++i) { w0[i] = last ? vN0[i] : vA0[i]; w1[i] = last ? vN1[i] : vA1[i]; }
            PG8_LDB(B0, 0, 0); PG8_LDB(B1, 0, 1); PG8_SCHED; PG8_LDA(At, 0, 0); PG8_STAGE(PG8_SA(1, 1), a1, vA1);
            PG8_WAIT_V(8); PG8_WAIT_L(0); PG8_BAR; PG8_MMA(0, 0, At, B0); PG8_MMA(0, 1, At, B1); PG8_BAR; PG8_SCHED;
            PG8_LDA(At, 0, 1); PG8_STAGE(PG8_SB(0, 0), b2, voffB); PG8_STAGE(PG8_SB(0, 1), b2 + hstepB, voffB); PG8_STAGE(PG8_SA(0, 0), a2, w0);
            PG8_WAIT_V(8); PG8_WAIT_L(0); PG8_BAR; PG8_MMA(1, 0, At, B0); PG8_MMA(1, 1, At, B1); PG8_BAR; PG8_SCHED;
            PG8_LDB(B0, 1, 0); PG8_LDB(B1, 1, 1); PG8_SCHED; PG8_LDA(At, 1, 0); PG8_STAGE(PG8_SA(0, 1), a2, w1);
            PG8_WAIT_V(8); PG8_WAIT_L(0); PG8_BAR; PG8_MMA(0, 0, At, B0); PG8_MMA(0, 1, At, B1); PG8_BAR; PG8_SCHED;
            PG8_LDA(At, 1, 1); PG8_STAGE(PG8_SB(1, 0), b3, voffB); PG8_STAGE(PG8_SB(1, 1), b3 + hstepB, voffB); PG8_STAGE(PG8_SA(1, 0), a3, w0);
            PG8_WAIT_V(8); PG8_WAIT_L(0); PG8_BAR; PG8_MMA(1, 0, At, B0); PG8_MMA(1, 1, At, B1); PG8_BAR; PG8_SCHED;
        }
        if constexpr (ALIGN_EPI) { if (wr == 0) PG8_BAR; }
        E(acc, cur, wr, wc, fr, fq);
        if (!has_next) break;
#pragma unroll
        for (int a = 0; a < 2; ++a)
#pragma unroll
            for (int b = 0; b < 2; ++b)
#pragma unroll
                for (int m = 0; m < 4; ++m)
#pragma unroll
                    for (int n = 0; n < 2; ++n) acc[a][b][m][n] = (f32x4){0.f, 0.f, 0.f, 0.f};
        cur = nxt; cA = nA; cB = nB; ++ui;
#pragma unroll
        for (int i = 0; i < 2; ++i) { vA0[i] = vN0[i]; vA1[i] = vN1[i]; }
        if constexpr (ALIGN_EPI) { if (wr == 1) PG8_BAR; }
    }
    PG8_WAIT_V(0);
    if constexpr (!ALIGN_EPI) { if (wr == 0) PG8_BAR; }
    PG8_BAR;
#undef PG8_SA
#undef PG8_SB
#undef PG8_STAGE
#undef PG8_LDA
#undef PG8_LDB
#undef PG8_MMA
#undef PG8_WAIT_V
#undef PG8_WAIT_L
#undef PG8_BAR
#undef PG8_SCHED
}
}

constexpr int NB = 2, SEQ = 4096, DM = 2048, MT = NB * SEQ;
constexpr int NH = 8, HD = 128, AW = 1024, HW = 1024, INW = 6144;
constexpr int GW = 64, NROWS = 64, WR = 8, WC = 16;
constexpr int NE = 16, CAP = 512, FF = 1024;
constexpr int FEMB = 33, FHID = 64;
constexpr float EPS = 1e-6f;
constexpr int NWAVES = 8, NTHREADS = 512;

constexpr size_t MiB = 1u << 20;
constexpr size_t WS_CTL = 0, CTL_ZERO_BYTES = 1 * MiB;
constexpr size_t WS_WIN = 2 * MiB;
constexpr size_t WS_WOUT = 26 * MiB;
constexpr size_t WS_WGU = 34 * MiB;
constexpr size_t WS_WD = 162 * MiB;
constexpr size_t WS_W3T = 226 * MiB;
constexpr size_t WS_HID2 = 227 * MiB;
constexpr size_t WS_HB = 228 * MiB;
constexpr size_t WS_QK = 260 * MiB;
constexpr size_t WS_XT = 292 * MiB;
constexpr size_t WS_UC = 356 * MiB;
constexpr size_t WS_TAPS = 404 * MiB;
constexpr size_t WS_HYT = 436 * MiB;
constexpr size_t WS_MIXED = 452 * MiB;
constexpr size_t WS_AFF = 484 * MiB;
constexpr size_t WS_IDX = 485 * MiB;
constexpr size_t WS_GATE = 486 * MiB;
constexpr size_t WS_SEL = 487 * MiB;
constexpr size_t WS_Z1T = 488 * MiB;
constexpr size_t WS_XG = WS_XT;
constexpr size_t WS_ACT = WS_UC;
constexpr size_t WS_YE = WS_TAPS;
constexpr size_t WS_END = 504 * MiB;

constexpr int LDS_BYTES = 163840, LDS_MISC_OFF = 163840 - 128;

#define GAS __attribute__((address_space(1)))
#define LAS __attribute__((address_space(3)))
typedef unsigned short bf16;
typedef unsigned v4u __attribute__((ext_vector_type(4)));
typedef unsigned v2u __attribute__((ext_vector_type(2)));
typedef float f32x4 __attribute__((ext_vector_type(4)));
#define LDS_WAIT() asm volatile("s_waitcnt lgkmcnt(0)" ::: "memory")
#define VM_WAIT() asm volatile("s_waitcnt vmcnt(0)" ::: "memory")
__device__ __forceinline__ unsigned f2bf(float f) { unsigned u = __builtin_bit_cast(unsigned, f); return (u + 0x7fffu + ((u >> 16) & 1u)) >> 16; }
__device__ __forceinline__ unsigned pk2(float lo, float hi) { return f2bf(lo) | (f2bf(hi) << 16); }
__device__ __forceinline__ float bf2f(unsigned h) { return __builtin_bit_cast(float, h << 16); }
__device__ __forceinline__ float bflo(unsigned w) { return __builtin_bit_cast(float, w << 16); }
__device__ __forceinline__ float bfhi(unsigned w) { return __builtin_bit_cast(float, w & 0xffff0000u); }
__device__ __forceinline__ float wave_sum(float v) {
#pragma unroll
    for (int o = 1; o < 64; o <<= 1) v += __shfl_xor(v, o);
    return v;
}


#define XB_TMO      128
#define XB_XCNT(j)  (256  + 64 * (j))
#define XB_XSUB(j)  (1280 + 64 * (j))
#define XB_XGEN(j)  (2304 + 64 * (j))
#define XB_TOP      3328
#define XB_TOPGEN   3392
#define XCD_BAR_WORDS 3456
#define XB_SPIN_CAP (1u << 22)
__device__ __forceinline__ unsigned xb_ld(unsigned* p)              { return __hip_atomic_load(p, __ATOMIC_RELAXED, __HIP_MEMORY_SCOPE_AGENT); }
__device__ __forceinline__ unsigned xb_add(unsigned* p, unsigned v) { return __hip_atomic_fetch_add(p, v, __ATOMIC_RELAXED, __HIP_MEMORY_SCOPE_AGENT); }
__device__ __forceinline__ unsigned xb_xcc_id() { return (unsigned)__builtin_amdgcn_s_getreg((3 << 11) | 20) & 0xFu; }
#define XB_SPIN(cond, bar) do { unsigned _sp = 0; while (cond) { __builtin_amdgcn_s_sleep(1); \
    if ((++_sp & 255u) == 0u) { if (xb_ld(&(bar)[XB_TMO])) break; if (_sp > XB_SPIN_CAP) { atomicAdd(&(bar)[XB_TMO], 1u); break; } } } } while (0)
struct XcdBarrier { unsigned* bar; unsigned x; volatile LAS unsigned* st; };
__device__ __forceinline__ XcdBarrier xcd_barrier_post(unsigned* bar, volatile LAS unsigned* st) {
    XcdBarrier b; b.bar = bar; b.x = xb_xcc_id(); b.st = st;
    if (threadIdx.x == 0) (void)xb_add(&bar[XB_XCNT(b.x)], 1u);
    return b;
}
__device__ __forceinline__ void xcd_barrier_complete(unsigned* bar, unsigned x, unsigned& nloc, unsigned& nx) {
    const unsigned G = gridDim.x * gridDim.y * gridDim.z;
    unsigned sum, cnt, mine, sp = 0u;
    for (;;) {
        sum = 0u; cnt = 0u; mine = 0u;
#pragma unroll
        for (unsigned j = 0; j < 16; ++j) { const unsigned c = xb_ld(&bar[XB_XCNT(j)]); sum += c; cnt += (c > 0u) ? 1u : 0u; mine = (j == x) ? c : mine; }
        if (sum == G) break;
        __builtin_amdgcn_s_sleep(1);
        if ((++sp & 255u) == 0u) { if (xb_ld(&bar[XB_TMO])) break; if (sp > XB_SPIN_CAP) { atomicAdd(&bar[XB_TMO], 1u); break; } }
    }
    nloc = mine > 0u ? mine : 1u; nx = cnt > 0u ? cnt : 1u;
}
__device__ __forceinline__ void xcd_barrier(const XcdBarrier& b) {
    asm volatile("s_waitcnt vmcnt(0)" ::: "memory");
    __syncthreads();
    if (threadIdx.x == 0) {
        unsigned* bar = b.bar;
        __builtin_amdgcn_s_waitcnt(0);
        unsigned nloc = b.st[0], nx = b.st[1];
        if (nloc == 0u) { xcd_barrier_complete(bar, b.x, nloc, nx); b.st[0] = nloc; b.st[1] = nx; }
        const unsigned old = xb_add(&bar[XB_XSUB(b.x)], 1u);
        const unsigned gen = old / nloc;
        if (old + 1u == (gen + 1u) * nloc) {
            __builtin_amdgcn_fence(__ATOMIC_RELEASE, "agent");
            asm volatile("s_waitcnt vmcnt(0)" ::: "memory");
            const unsigned og = xb_add(&bar[XB_TOP], 1u);
            const unsigned tg = og / nx;
            if (og + 1u == (tg + 1u) * nx) xb_add(&bar[XB_TOPGEN], 1u);
            else XB_SPIN(xb_ld(&bar[XB_TOPGEN]) == tg, bar);
            __builtin_amdgcn_fence(__ATOMIC_ACQUIRE, "agent");
            xb_add(&bar[XB_XGEN(b.x)], 1u);
            asm volatile("s_waitcnt vmcnt(0)" ::: "memory");
        } else {
            XB_SPIN(xb_ld(&bar[XB_XGEN(b.x)]) == gen, bar);
            __builtin_amdgcn_fence(__ATOMIC_ACQUIRE, "agent");
            asm volatile("s_waitcnt vmcnt(0)" ::: "memory");
        }
    }
    __syncthreads();
}

struct Frame {
    LAS unsigned char* lds;
    int tid, lane, wave, G, bid;
    const float* in[23]; float* out; unsigned char* ws;
};
#define GW_ID(F) ((F).bid * NWAVES + (F).wave)
#define GW_N(F) ((F).G * NWAVES)

__device__ __forceinline__ void p0_transpose_item(const float* W, int K, int N, bf16* WT, int row_base, int k0, int n0, LAS float* scr, int lane) {
#pragma unroll 8
    for (int i = 0; i < 32; ++i) { const int kk = 2 * i + (lane >> 5); scr[kk * 33 + (lane & 31)] = W[(size_t)(k0 + kk) * N + n0 + (lane & 31)]; }
    LDS_WAIT(); asm volatile("" ::: "memory");
    const int c = lane & 7;
#pragma unroll
    for (int j = 0; j < 4; ++j) { const int n = (lane >> 3) + 8 * j; const LAS float* s = scr + (8 * c) * 33 + n;
        v4u o; o.x = pk2(s[0 * 33], s[1 * 33]); o.y = pk2(s[2 * 33], s[3 * 33]); o.z = pk2(s[4 * 33], s[5 * 33]); o.w = pk2(s[6 * 33], s[7 * 33]);
        *(GAS v4u*)(WT + (size_t)(row_base + n) * K + k0 + 8 * c) = o; }
    LDS_WAIT(); asm volatile("" ::: "memory");
}
__device__ __forceinline__ void phase_p0(Frame& F) {
    LAS float* scr = (LAS float*)(F.lds + F.wave * 16384);
    const int gw = GW_ID(F), NGW = GW_N(F);
    bf16* WinT = (bf16*)(F.ws + WS_WIN); bf16* WoutT = (bf16*)(F.ws + WS_WOUT); bf16* W3T = (bf16*)(F.ws + WS_W3T);
    constexpr int I_IN = (DM / 64) * (INW / 32), I_OUT = (DM / 64) * (DM / 32), I_3 = 1 * (4096 / 32);
    constexpr int NITEMS = I_IN + I_OUT + I_3;
    for (int it = gw; it < NITEMS; it += NGW) {
        int r = it;
        if (r < I_IN) { const int nblk = INW / 32, kb = r / nblk, nb = r % nblk; p0_transpose_item(F.in[2], DM, INW, WinT, 32 * nb, 64 * kb, 32 * nb, scr, F.lane); continue; } r -= I_IN;
        if (r < I_OUT) { const int nblk = DM / 32, kb = r / nblk, nb = r % nblk; p0_transpose_item(F.in[17], DM, DM, WoutT, 32 * nb, 64 * kb, 32 * nb, scr, F.lane); continue; } r -= I_OUT;
        { const int nb = r; p0_transpose_item(F.in[12], FHID, 4096, W3T, 32 * nb, 0, 32 * nb, scr, F.lane); }
    }
    bf16* HB = (bf16*)(F.ws + WS_HB);
    const float* x = F.in[0]; const float* g = F.in[1];
    for (int m = gw; m < MT; m += NGW) {
        const GAS f32x4* xr = (const GAS f32x4*)(x + (size_t)m * DM) + F.lane;
        f32x4 v[8]; float s = 0.f;
#pragma unroll
        for (int j = 0; j < 8; ++j) { v[j] = xr[64 * j]; s += (v[j].x * v[j].x + v[j].y * v[j].y) + (v[j].z * v[j].z + v[j].w * v[j].w); }
        const float r = rsqrtf(wave_sum(s) * (1.f / DM) + EPS);
        GAS v2u* o8 = (GAS v2u*)(HB + (size_t)m * DM) + F.lane;
#pragma unroll
        for (int j = 0; j < 8; ++j) { const f32x4 gg = *((const GAS f32x4*)g + F.lane + 64 * j); v2u o; o.x = pk2(v[j].x * r * gg.x, v[j].y * r * gg.y); o.y = pk2(v[j].z * r * gg.z, v[j].w * r * gg.w); o8[64 * j] = o; }
    }
    float* HID2 = (float*)(F.ws + WS_HID2);
    LAS float* sc2 = (LAS float*)(F.lds + F.wave * 16384);
    const float* w1 = F.in[8]; const float* b1 = F.in[9]; const float* w2 = F.in[10]; const float* b2 = F.in[11]; const float* fr = F.in[13];
    for (int l = gw; l < SEQ; l += NGW) {
        const int j = F.lane;
        float zv = 0.f;
        if (j == 0) zv = (float)l / (float)(SEQ - 1);
        else if (j < FEMB) { const int k = (j - 1) & 15; const float f = 1e-4f + (float)k * ((15.0f - 1e-4f) / 15.0f); const float wv = 6.283185307179586f * (float)l / (float)SEQ; zv = (j <= 16) ? cosf(f * wv) : -sinf(f * wv); }
        sc2[j] = zv; LDS_WAIT(); asm volatile("" ::: "memory");
        float a = b1[j];
        for (int i = 0; i < FEMB; ++i) a += sc2[i] * w1[i * FHID + j];
        const float h1 = sinf(fr[j] * a);
        sc2[64 + j] = h1; LDS_WAIT(); asm volatile("" ::: "memory");
        float c = b2[j];
        for (int i = 0; i < FHID; ++i) c += sc2[64 + i] * w2[i * FHID + j];
        HID2[l * FHID + j] = sinf(fr[j] * c);
        LDS_WAIT(); asm volatile("" ::: "memory");
    }
}

__device__ __forceinline__ void phase_filters_naive(Frame& F) {
    const float* HID2 = (const float*)(F.ws + WS_HID2); const float* w3 = F.in[12]; const float* fbias = F.in[14]; bf16* TAPS = (bf16*)(F.ws + WS_TAPS);
    const size_t total = (size_t)SEQ * 4096;
    for (size_t i = (size_t)F.bid * NTHREADS + F.tid; i < total; i += (size_t)F.G * NTHREADS) {
        const int col = (int)(i & 4095), l = (int)(i >> 12);
        float a = 0.f;
        for (int k = 0; k < FHID; ++k) a += HID2[l * FHID + k] * w3[(size_t)k * 4096 + col];
        const int c = col & 1023, dir = (col >> 10) & 1, o = col >> 11;
        const float mind = -4.605170185988091f / 1.5f, maxd = -4.605170185988091f / 0.3f;
        const float delta = fabsf(mind + (maxd - mind) * ((float)c / 1023.0f));
        const float t = (float)l / (float)(SEQ - 1);
        float v = a * expf(-t * delta);
        bf16* tp = TAPS + ((size_t)c * 2 + o) * 8192;
        if (dir == 0) { if (l == 0) v += fbias[o * 1024 + c]; tp[4096 + l] = (bf16)f2bf(v); }
        else { if (l > 0) tp[4096 - l] = (bf16)f2bf(v); else tp[0] = 0; }
    }
}
__device__ __forceinline__ void phase_hyena_naive(Frame& F, int o) {
    const bf16* UC = (const bf16*)(F.ws + WS_UC); const bf16* TAPS = (const bf16*)(F.ws + WS_TAPS);
    bf16* Z1T = (bf16*)(F.ws + WS_Z1T); bf16* HYT = (bf16*)(F.ws + WS_HYT);
    const bf16* Zin = o == 0 ? UC + (size_t)2048 * MT : Z1T; const bf16* gate = UC + (size_t)(o * 1024) * MT; bf16* OUT = o == 0 ? Z1T : HYT;
    const size_t total = (size_t)1024 * MT;
    for (size_t i = (size_t)F.bid * NTHREADS + F.tid; i < total; i += (size_t)F.G * NTHREADS) {
        const int c = (int)(i >> 13), m = (int)(i & 8191), b = m >> 12, t = m & 4095;
        const bf16* z = Zin + (size_t)c * MT + b * SEQ; const bf16* tp = TAPS + ((size_t)c * 2 + o) * 8192 + 4096 + t;
        float acc = 0.f;
        for (int s = 0; s < SEQ; ++s) acc += bf2f(tp[-s]) * bf2f(z[s]);
        OUT[(size_t)c * MT + m] = (bf16)f2bf(bf2f(gate[(size_t)c * MT + m]) * acc);
    }
}
__device__ __forceinline__ void phase_attn_naive(Frame& F) {
    const bf16* QK = (const bf16*)(F.ws + WS_QK); const bf16* VT = (const bf16*)(F.ws + WS_XT); bf16* MIXED = (bf16*)(F.ws + WS_MIXED);
    const float* rpb = F.in[5]; const float* og = F.in[15];
    const int lane = F.lane;
    for (int w = GW_ID(F); w < MT * NH; w += GW_N(F)) {
        const int m = w >> 3, h = w & 7, b = m / SEQ, s = m % SEQ, r = s / GW, c = s % GW;
        int kr0 = r - WR / 2; kr0 = kr0 < 0 ? 0 : (kr0 > NROWS - WR ? NROWS - WR : kr0);
        int c0 = c - WC / 2; c0 = c0 < 0 ? 0 : (c0 > GW - WC ? GW - WC : c0);
        const bf16* q = QK + (size_t)m * 2048 + h * HD;
        const float q0 = bf2f(q[lane]), q1 = bf2f(q[lane + 64]);
        float mx = -INFINITY, l = 0.f, a0 = 0.f, a1 = 0.f;
        for (int i = 0; i < WR; ++i) for (int j = 0; j < WC; ++j) {
            const int kr = kr0 + i, kc = c0 + j; const size_t km = (size_t)b * SEQ + kr * GW + kc;
            const bf16* kp = QK + km * 2048 + 1024 + h * HD;
            const float d = wave_sum(q0 * bf2f(kp[lane]) + q1 * bf2f(kp[lane + 64]));
            const int dr = kr - r + WR - 1; int dc = kc - c + WC - 1; dc = dc < 0 ? 0 : (dc > 2 * WC - 2 ? 2 * WC - 2 : dc);
            const float sc = d * 0.08838834764831845f + rpb[(h * (2 * WR - 1) + dr) * (2 * WC - 1) + dc];
            const float mn = fmaxf(mx, sc), corr = __expf(mx - mn), pw = __expf(sc - mn);
            const float v0 = bf2f(VT[(size_t)(h * HD + lane) * MT + km]), v1 = bf2f(VT[(size_t)(h * HD + lane + 64) * MT + km]);
            l = l * corr + pw; a0 = a0 * corr + pw * v0; a1 = a1 * corr + pw * v1; mx = mn;
        }
        a0 /= l; a1 /= l;
        const float rr = rsqrtf(wave_sum(a0 * a0 + a1 * a1) * (1.f / HD) + EPS);
        bf16* o = MIXED + (size_t)m * DM + h * HD;
        o[lane] = (bf16)f2bf(a0 * rr * og[h * HD + lane]); o[lane + 64] = (bf16)f2bf(a1 * rr * og[h * HD + lane + 64]);
    }
}


typedef short bf16x8 __attribute__((ext_vector_type(8)));
typedef float f32x16 __attribute__((ext_vector_type(16)));
__device__ __forceinline__ void phase_filters(Frame& F) {
    const float* HID2 = (const float*)(F.ws + WS_HID2); const bf16* W3T = (const bf16*)(F.ws + WS_W3T); const float* fbias = F.in[14]; bf16* TAPS = (bf16*)(F.ws + WS_TAPS);
    const int n = F.lane & 31, hh = F.lane >> 5;
    for (int it = GW_ID(F); it < 128 * 128; it += GW_N(F)) {
        const int col0 = (it >> 7) * 32, l0 = (it & 127) * 32;
        f32x16 acc;
#pragma unroll
        for (int i = 0; i < 16; ++i) acc[i] = 0.f;
#pragma unroll
        for (int ks = 0; ks < 4; ++ks) {
            const bf16x8 a = *(const GAS bf16x8*)(W3T + (size_t)(col0 + n) * FHID + 16 * ks + 8 * hh);
            const GAS f32x4* hp = (const GAS f32x4*)(HID2 + (size_t)(l0 + n) * FHID + 16 * ks + 8 * hh);
            const f32x4 h0 = hp[0], h1 = hp[1];
            v4u bw; bw.x = pk2(h0.x, h0.y); bw.y = pk2(h0.z, h0.w); bw.z = pk2(h1.x, h1.y); bw.w = pk2(h1.z, h1.w);
            acc = __builtin_amdgcn_mfma_f32_32x32x16_bf16(a, __builtin_bit_cast(bf16x8, bw), acc, 0, 0, 0);
        }
        const int l = l0 + n; const float t = (float)l / (float)(SEQ - 1);
        const int dir = (col0 >> 10) & 1, o = col0 >> 11;
        const float mind = -4.605170185988091f / 1.5f, maxd = -4.605170185988091f / 0.3f;
#pragma unroll
        for (int i = 0; i < 16; ++i) {
            const int c = (col0 & 1023) + (i & 3) + 8 * (i >> 2) + 4 * hh;
            const float delta = fabsf(mind + (maxd - mind) * ((float)c / 1023.0f));
            float v = acc[i] * __expf(-t * delta);
            bf16* tp = TAPS + ((size_t)c * 2 + o) * 8192;
            if (dir == 0) { if (l == 0) v += fbias[o * 1024 + c]; tp[4096 + l] = (bf16)f2bf(v); }
            else { if (l > 0) tp[4096 - l] = (bf16)f2bf(v); else tp[0] = 0; }
        }
    }
}

constexpr int HY_TAPS_BYTES = 4 * 16384, HY_ZB_ENT = 6080, HY_ZB_BYTES = HY_ZB_ENT * 2;
__device__ __forceinline__ unsigned hy_zb_off(int idx0  ) { const int q = idx0 >> 3; return (unsigned)((q ^ ((q >> 4) & 3)) << 4); }
template <int MASK>
__device__ __forceinline__ void hy_loadB(bf16x8 (&bf)[4], const LAS unsigned char* zb0, int g, int b, int n, int hh) {
    const int q0 = 124 - 4 * n + 2 * g + hh;
    const LAS unsigned char* pm = zb0 + ((q0 ^ ((q0 >> 4) & 3)) << 4) - 6144 + b * HY_ZB_BYTES;
#pragma unroll
    for (int tau = 0; tau < 4; ++tau) if (MASK & (1 << tau)) bf[tau] = *(const LAS bf16x8*)(pm + 2048 * (3 - tau));
}
__device__ __forceinline__ void hy_loadA(unsigned (&d)[5], const LAS bf16* taps, int g, int n, int hh) {
    const volatile LAS unsigned* dp = (const volatile LAS unsigned*)taps + ((1 + 8 * hh + n) >> 1) + 8 * g;
#pragma unroll
    for (int i = 0; i < 5; ++i) d[i] = dp[i];
}
template <int MASK>
__device__ __forceinline__ void hy_mma(f32x16 (&acc)[4], const bf16x8 a, const bf16x8 (&bf)[4]) {
#pragma unroll
    for (int tau = 0; tau < 4; ++tau) if (MASK & (1 << tau)) acc[tau] = __builtin_amdgcn_mfma_f32_32x32x16_bf16(a, bf[tau], acc[tau], 0, 0, 0);
}
template <int MASK>
__device__ __forceinline__ void hy_segment(f32x16 (&acc)[2][4], const LAS bf16* taps, const LAS unsigned char* zb0, int g0, int g1, int n, int hh) {
    const unsigned sh = (n & 1) ? 0u : 2u;
    unsigned d[5]; bf16x8 b0[4], b1[4];
    hy_loadA(d, taps, g0, n, hh); hy_loadB<MASK>(b0, zb0, g0, 0, n, hh);
#pragma unroll 1
    for (int g = g0; g < g1; ++g) {
        hy_loadB<MASK>(b1, zb0, g, 1, n, hh); __builtin_amdgcn_sched_barrier(0);
        v4u aw; aw.x = __builtin_amdgcn_alignbyte(d[1], d[0], sh); aw.y = __builtin_amdgcn_alignbyte(d[2], d[1], sh); aw.z = __builtin_amdgcn_alignbyte(d[3], d[2], sh); aw.w = __builtin_amdgcn_alignbyte(d[4], d[3], sh);
        const bf16x8 a = __builtin_bit_cast(bf16x8, aw);
        hy_mma<MASK>(acc[0], a, b0); __builtin_amdgcn_sched_barrier(0);
        hy_loadA(d, taps, g + 1, n, hh); hy_loadB<MASK>(b0, zb0, g + 1, 0, n, hh); __builtin_amdgcn_sched_barrier(0);
        hy_mma<MASK>(acc[1], a, b1); __builtin_amdgcn_sched_barrier(0);
    }
}
__device__ __forceinline__ void hy_stage_taps(Frame& F, int c0, int o) {
    const bf16* TAPS = (const bf16*)(F.ws + WS_TAPS);
#pragma unroll
    for (int j = 0; j < 8; ++j) { const int ch = F.tid + NTHREADS * j, ci = ch >> 10, w = ch & 1023;
        *((LAS v4u*)(F.lds) + ch) = *((const GAS v4u*)(TAPS + ((size_t)(c0 + ci) * 2 + o) * 8192) + w); }
}
__device__ __forceinline__ void conv_item64(const float* W, int N, bf16* WTe, int row_base, int k0, int n0, int lane) {
    const GAS float* src = (const GAS float*)(W + (size_t)k0 * N + n0 + lane);
    float v[64];
#pragma unroll
    for (int kk = 0; kk < 64; ++kk) v[kk] = src[(size_t)kk * N];
    GAS v4u* dst = (GAS v4u*)WTe + (size_t)(k0 >> 3) * 2048 + row_base + lane;
#pragma unroll
    for (int j = 0; j < 8; ++j) { v4u o; o.x = pk2(v[8 * j], v[8 * j + 1]); o.y = pk2(v[8 * j + 2], v[8 * j + 3]); o.z = pk2(v[8 * j + 4], v[8 * j + 5]); o.w = pk2(v[8 * j + 6], v[8 * j + 7]); dst[(size_t)j * 2048] = o; }
}
constexpr int MOE_ITEMS_GU = 2 * NE * 32 * 16, MOE_ITEMS_D = NE * 16 * 32, MOE_ITEMS = MOE_ITEMS_GU + MOE_ITEMS_D;
#ifndef MOE_P0_ITEMS
#define MOE_P0_ITEMS 0
#endif
constexpr int MOE_HELP_ITEMS = MOE_ITEMS - MOE_P0_ITEMS;
__device__ __forceinline__ void moe_conv_item(Frame& F, int it) {
    bf16* WguT = (bf16*)(F.ws + WS_WGU); bf16* WdT = (bf16*)(F.ws + WS_WD);
    if (it < MOE_ITEMS_GU) { const int which = it >> 13, e = (it >> 9) & 15, kb = (it >> 4) & 31, nb = it & 15, f0 = 64 * nb;
        const float* W = (which ? F.in[21] : F.in[20]) + (size_t)e * DM * FF;
        conv_item64(W, FF, WguT + (size_t)e * 2048 * DM, (f0 >> 7) * 256 + which * 128 + (f0 & 127), 64 * kb, f0, F.lane);
    } else { const int r = it - MOE_ITEMS_GU, e = r >> 9, kb = (r >> 5) & 15, nb = r & 31;
        conv_item64(F.in[22] + (size_t)e * FF * DM, DM, WdT + (size_t)e * 2048 * FF, 64 * nb, 64 * kb, 64 * nb, F.lane); }
}
__device__ __forceinline__ void phase_hyena(Frame& F) {
    const bf16* UC = (const bf16*)(F.ws + WS_UC); bf16* HYT = (bf16*)(F.ws + WS_HYT);
    const int n = F.lane & 31, hh = F.lane >> 5;
    const bool compute = F.wave < 4;
    const int nhelp = F.G * 4, hw = F.bid * 4 + (F.wave - 4);
    int sec = 0;
    for (int cg = F.bid; cg < 256; cg += F.G) {
        const int c0 = cg * 4;
        __syncthreads();
        hy_stage_taps(F, c0, 0);
        {
          const int ci = F.wave >> 1, b = F.wave & 1; LAS unsigned char* zb = F.lds + HY_TAPS_BYTES + F.wave * HY_ZB_BYTES;
          const bf16* zsrc = UC + (size_t)(2048 + c0 + ci) * MT + b * SEQ;
#pragma unroll
          for (int j = 0; j < 8; ++j) { const int u = F.lane + 64 * j; const v4u w = *((const GAS v4u*)zsrc + u);
              v4u r; r.x = (w.w >> 16) | (w.w << 16); r.y = (w.z >> 16) | (w.z << 16); r.z = (w.y >> 16) | (w.y << 16); r.w = (w.x >> 16) | (w.x << 16);
              *(LAS v4u*)(zb + hy_zb_off(8 * (635 - u))) = r; }
          const v4u zero = {0u, 0u, 0u, 0u};
          for (int q = F.lane; q < 124; q += 64) { *(LAS v4u*)(zb + hy_zb_off(8 * q)) = zero; *(LAS v4u*)(zb + hy_zb_off(8 * (636 + q))) = zero; } }
        __syncthreads();
#pragma unroll 1
        for (int o = 0; o < 2; ++o) {
            if (compute) {
                const int ci = F.wave, c = c0 + ci;
                const LAS bf16* taps = (const LAS bf16*)(F.lds + ci * 16384);
                LAS unsigned char* zb0 = F.lds + HY_TAPS_BYTES + (2 * ci) * HY_ZB_BYTES;
                f32x16 acc[2][4];
#pragma unroll
                for (int b = 0; b < 2; ++b)
#pragma unroll
                    for (int tau = 0; tau < 4; ++tau)
#pragma unroll
                        for (int i = 0; i < 16; ++i) acc[b][tau][i] = 0.f;
                hy_segment<1>(acc, taps, zb0, 0, 64, n, hh);
                hy_segment<3>(acc, taps, zb0, 64, 128, n, hh);
                hy_segment<7>(acc, taps, zb0, 128, 192, n, hh);
                hy_segment<15>(acc, taps, zb0, 192, 318, n, hh);
                hy_segment<14>(acc, taps, zb0, 318, 382, n, hh);
                hy_segment<12>(acc, taps, zb0, 382, 446, n, hh);
                hy_segment<8>(acc, taps, zb0, 446, 510, n, hh);
                LDS_WAIT();
                int n2 = n, h2 = hh; asm volatile("" : "+v"(n2), "+v"(h2));
#pragma unroll
                for (int b = 0; b < 2; ++b) {
                    const bf16* gate = UC + (size_t)(o * 1024 + c) * MT + b * SEQ;
                    LAS unsigned char* zb = zb0 + b * HY_ZB_BYTES; bf16* outp = HYT + (size_t)c * MT + b * SEQ;
#pragma unroll
                    for (int tau = 0; tau < 4; ++tau) { asm volatile("" ::: "memory");
#pragma unroll
                        for (int rg = 0; rg < 4; ++rg) { const int t0 = 1024 * tau + 32 * n2 + 8 * rg + 4 * h2;
                            const v2u gw = *(const GAS v2u*)(gate + t0);
                            const float z0 = bflo(gw.x) * acc[b][tau][4 * rg + 0], z1 = bfhi(gw.x) * acc[b][tau][4 * rg + 1], z2 = bflo(gw.y) * acc[b][tau][4 * rg + 2], z3 = bfhi(gw.y) * acc[b][tau][4 * rg + 3];
                            if (o == 0) { v2u w; w.x = pk2(z3, z2); w.y = pk2(z1, z0);
                                *(LAS v2u*)(zb + hy_zb_off(8 * (635 - (t0 >> 3))) + (h2 ? 0 : 8)) = w; }
                            else { v2u w; w.x = pk2(z0, z1); w.y = pk2(z2, z3); *(GAS v2u*)(outp + t0) = w; } } }
                }
            } else {
                const int lo_it = MOE_P0_ITEMS + sec * (MOE_HELP_ITEMS / 2), hi_it = lo_it + MOE_HELP_ITEMS / 2;
                if (sec < 2) for (int it = lo_it + hw; it < hi_it; it += nhelp) moe_conv_item(F, it);
            }
            ++sec;
            if (o == 0) {
                __syncthreads();
                hy_stage_taps(F, c0, 1);
                __syncthreads();
            }
        }
    }
    for (; sec < 2; ++sec) if (!compute) { const int lo_it = MOE_P0_ITEMS + sec * (MOE_HELP_ITEMS / 2), hi_it = lo_it + MOE_HELP_ITEMS / 2; for (int it = lo_it + hw; it < hi_it; it += nhelp) moe_conv_item(F, it); }
    __syncthreads();
}

__device__ __forceinline__ void phase_attn(Frame& F) {
    const bf16* QK = (const bf16*)(F.ws + WS_QK); const bf16* VT = (const bf16*)(F.ws + WS_XT); bf16* MIXED = (bf16*)(F.ws + WS_MIXED);
    const float* rpb = F.in[5]; const float* og = F.in[15];
    LAS float* rp = (LAS float*)(F.lds + F.wave * 2048);
    const int n = F.lane & 31, hh = F.lane >> 5;
    for (int task = GW_ID(F); task < NB * NH * NROWS * 2; task += GW_N(F)) {
        const int wq = task & 1, r = (task >> 1) & 63, h = (task >> 7) & 7, b = task >> 10;
        for (int i = F.lane; i < 15 * 31; i += 64) rp[i] = rpb[h * 465 + i];
        const int mq = b * SEQ + r * GW + 32 * wq + n, qc = 32 * wq + n;
        int c0 = qc - WC / 2; c0 = c0 < 0 ? 0 : (c0 > GW - WC ? GW - WC : c0);
        int kr0 = r - WR / 2; kr0 = kr0 < 0 ? 0 : (kr0 > NROWS - WR ? NROWS - WR : kr0);
        bf16x8 qf[8];
#pragma unroll
        for (int ks = 0; ks < 8; ++ks) qf[ks] = *(const GAS bf16x8*)(QK + (size_t)mq * 2048 + h * HD + 16 * ks + 8 * hh);
        f32x16 O[4];
#pragma unroll
        for (int dt = 0; dt < 4; ++dt)
#pragma unroll
            for (int i = 0; i < 16; ++i) O[dt][i] = 0.f;
        float lsum = 0.f;
        LDS_WAIT();
#pragma unroll 1
        for (int tile = 0; tile < 16; ++tile) {
            const int kr = kr0 + (tile >> 1), kt = tile & 1, dr = kr - r + WR - 1;
            const int mk0 = b * SEQ + kr * GW + 32 * kt;
            f32x16 S;
#pragma unroll
            for (int i = 0; i < 16; ++i) S[i] = 0.f;
#pragma unroll
            for (int ks = 0; ks < 8; ++ks) { const bf16x8 kf = *(const GAS bf16x8*)(QK + (size_t)(mk0 + n) * 2048 + 1024 + h * HD + 16 * ks + 8 * hh);
                S = __builtin_amdgcn_mfma_f32_32x32x16_bf16(kf, qf[ks], S, 0, 0, 0); }
            float p[16];
#pragma unroll
            for (int i = 0; i < 16; ++i) { const int kc = 32 * kt + (i & 3) + 8 * (i >> 2) + 4 * hh; const bool valid = (kc >= c0) && (kc < c0 + WC);
                int dc = kc - qc + WC - 1; dc = dc < 0 ? 0 : (dc > 2 * WC - 2 ? 2 * WC - 2 : dc);
                const float e = __expf(S[i] * 0.08838834764831845f + rp[dr * 31 + dc]); p[i] = valid ? e : 0.f; lsum += p[i]; }
            v4u pw0, pw1;
            pw0.x = pk2(p[0], p[1]); pw0.y = pk2(p[2], p[3]); pw0.z = pk2(p[4], p[5]); pw0.w = pk2(p[6], p[7]);
            pw1.x = pk2(p[8], p[9]); pw1.y = pk2(p[10], p[11]); pw1.z = pk2(p[12], p[13]); pw1.w = pk2(p[14], p[15]);
            const bf16x8 pf0 = __builtin_bit_cast(bf16x8, pw0), pf1 = __builtin_bit_cast(bf16x8, pw1);
#pragma unroll
            for (int dt = 0; dt < 4; ++dt) {
                const bf16* vrow = VT + (size_t)(h * HD + 32 * dt + n) * MT + mk0 + 4 * hh;
                const v2u a0 = *(const GAS v2u*)(vrow), a1 = *(const GAS v2u*)(vrow + 8), a2 = *(const GAS v2u*)(vrow + 16), a3 = *(const GAS v2u*)(vrow + 24);
                v4u f0, f1; f0.x = a0.x; f0.y = a0.y; f0.z = a1.x; f0.w = a1.y; f1.x = a2.x; f1.y = a2.y; f1.z = a3.x; f1.w = a3.y;
                O[dt] = __builtin_amdgcn_mfma_f32_32x32x16_bf16(__builtin_bit_cast(bf16x8, f0), pf0, O[dt], 0, 0, 0);
                O[dt] = __builtin_amdgcn_mfma_f32_32x32x16_bf16(__builtin_bit_cast(bf16x8, f1), pf1, O[dt], 0, 0, 0);
            }
        }
        lsum += __shfl_xor(lsum, 32);
        const float il = 1.f / lsum;
        float ss = 0.f;
#pragma unroll
        for (int dt = 0; dt < 4; ++dt)
#pragma unroll
            for (int i = 0; i < 16; ++i) { O[dt][i] *= il; ss += O[dt][i] * O[dt][i]; }
        ss += __shfl_xor(ss, 32);
        const float rr = rsqrtf(ss * (1.f / HD) + EPS);
        bf16* orow = MIXED + (size_t)mq * DM + h * HD;
#pragma unroll
        for (int dt = 0; dt < 4; ++dt)
#pragma unroll
            for (int rg = 0; rg < 4; ++rg) { const int d = 32 * dt + 8 * rg + 4 * hh; const f32x4 gg = *(const GAS f32x4*)(og + h * HD + d);
                v2u w; w.x = pk2(O[dt][4 * rg + 0] * rr * gg.x, O[dt][4 * rg + 1] * rr * gg.y); w.y = pk2(O[dt][4 * rg + 2] * rr * gg.z, O[dt][4 * rg + 3] * rr * gg.w);
                *(GAS v2u*)(orow + d) = w; }
        LDS_WAIT();
    }
}


constexpr int AT_KBYTES = 16384, AT_VPITCH = 136, AT_VBYTES = 128 * AT_VPITCH, AT_STAGE = AT_KBYTES + AT_VBYTES, AT_RP_OFF = 2 * AT_STAGE;
__device__ __forceinline__ void phase_attn2(Frame& F) {
    const bf16* QK = (const bf16*)(F.ws + WS_QK); const bf16* VT = (const bf16*)(F.ws + WS_XT); bf16* MIXED = (bf16*)(F.ws + WS_MIXED);
    const float* rpb = F.in[5]; const float* og = F.in[15];
    LAS float* rp = (LAS float*)(F.lds + AT_RP_OFF + F.wave * 2048);
    const int n = F.lane & 31, hh = F.lane >> 5;
    for (int unit = F.bid; unit < NB * NH * 16; unit += F.G) {
        const int rq = unit & 15, h = (unit >> 4) & 7, b = unit >> 7, r0 = 4 * rq;
        const int r = r0 + (F.wave >> 1), wq = F.wave & 1;
        int kmin = r0 - WR / 2; kmin = kmin < 0 ? 0 : (kmin > NROWS - WR ? NROWS - WR : kmin);
        int kmax = r0 + 3 - WR / 2; kmax = (kmax < 0 ? 0 : (kmax > NROWS - WR ? NROWS - WR : kmax)) + WR - 1;
        int kr0 = r - WR / 2; kr0 = kr0 < 0 ? 0 : (kr0 > NROWS - WR ? NROWS - WR : kr0);
        const int nrows = kmax - kmin + 1;
        __syncthreads();
        for (int i = F.lane; i < 15 * 31; i += 64) rp[i] = rpb[h * 465 + i];
        const int mq = b * SEQ + r * GW + 32 * wq + n, qc = 32 * wq + n;
        int c0 = qc - WC / 2; c0 = c0 < 0 ? 0 : (c0 > GW - WC ? GW - WC : c0);
        bf16x8 qf[8];
#pragma unroll
        for (int ks = 0; ks < 8; ++ks) qf[ks] = *(const GAS bf16x8*)(QK + (size_t)mq * 2048 + h * HD + 16 * ks + 8 * hh);
        f32x16 O[4];
#pragma unroll
        for (int dt = 0; dt < 4; ++dt)
#pragma unroll
            for (int i = 0; i < 16; ++i) O[dt][i] = 0.f;
        float lsum = 0.f;
        v4u sk[2], sv[2];
        auto gload = [&](int kr) {
#pragma unroll
            for (int j = 0; j < 2; ++j) { const int id = F.tid + 512 * j;
                sk[j] = *(const GAS v4u*)(QK + (size_t)(b * SEQ + kr * GW + (id >> 4)) * 2048 + 1024 + h * HD + 8 * (id & 15));
                sv[j] = *(const GAS v4u*)(VT + (size_t)(h * HD + (id >> 3)) * MT + b * SEQ + kr * GW + 8 * (id & 7)); }
        };
        auto lstore = [&](int buf) {
            LAS unsigned char* kb = F.lds + buf * AT_STAGE; LAS unsigned char* vb = kb + AT_KBYTES;
#pragma unroll
            for (int j = 0; j < 2; ++j) { const int id = F.tid + 512 * j; const int key = id >> 4, c = id & 15;
                *(LAS v4u*)(kb + key * 256 + ((c ^ (key & 15)) << 4)) = sk[j];
                const int d = id >> 3, cv = id & 7; LAS v2u* vp = (LAS v2u*)(vb + d * AT_VPITCH + cv * 16);
                v2u lo, hi; lo.x = sv[j].x; lo.y = sv[j].y; hi.x = sv[j].z; hi.y = sv[j].w; vp[0] = lo; vp[1] = hi; }
        };
        gload(kmin); lstore(0);
        __syncthreads();
#pragma unroll 1
        for (int j = 0; j < nrows; ++j) {
            const int kr = kmin + j, buf = j & 1;
            if (j + 1 < nrows) gload(kr + 1);
            if (kr >= kr0 && kr < kr0 + WR) {
                const LAS unsigned char* kb = F.lds + buf * AT_STAGE; const LAS unsigned char* vb = kb + AT_KBYTES;
                const int dr = kr - r + WR - 1;
#pragma unroll
                for (int kt = 0; kt < 2; ++kt) {
                    f32x16 S;
#pragma unroll
                    for (int i = 0; i < 16; ++i) S[i] = 0.f;
                    const int key = 32 * kt + n;
#pragma unroll
                    for (int ks = 0; ks < 8; ++ks) { const bf16x8 kf = *(const LAS bf16x8*)(kb + key * 256 + (((2 * ks + hh) ^ (key & 15)) << 4));
                        S = __builtin_amdgcn_mfma_f32_32x32x16_bf16(kf, qf[ks], S, 0, 0, 0); }
                    float p[16];
#pragma unroll
                    for (int i = 0; i < 16; ++i) { const int kc = 32 * kt + (i & 3) + 8 * (i >> 2) + 4 * hh; const bool valid = (kc >= c0) && (kc < c0 + WC);
                        int dc = kc - qc + WC - 1; dc = dc < 0 ? 0 : (dc > 2 * WC - 2 ? 2 * WC - 2 : dc);
                        const float e = __expf(S[i] * 0.08838834764831845f + rp[dr * 31 + dc]); p[i] = valid ? e : 0.f; lsum += p[i]; }
                    v4u pw0, pw1;
                    pw0.x = pk2(p[0], p[1]); pw0.y = pk2(p[2], p[3]); pw0.z = pk2(p[4], p[5]); pw0.w = pk2(p[6], p[7]);
                    pw1.x = pk2(p[8], p[9]); pw1.y = pk2(p[10], p[11]); pw1.z = pk2(p[12], p[13]); pw1.w = pk2(p[14], p[15]);
                    const bf16x8 pf0 = __builtin_bit_cast(bf16x8, pw0), pf1 = __builtin_bit_cast(bf16x8, pw1);
#pragma unroll
                    for (int dt = 0; dt < 4; ++dt) {
                        const LAS unsigned char* vrow = vb + (32 * dt + n) * AT_VPITCH + (32 * kt + 4 * hh) * 2;
                        const v2u a0 = *(const LAS v2u*)(vrow), a1 = *(const LAS v2u*)(vrow + 16), a2 = *(const LAS v2u*)(vrow + 32), a3 = *(const LAS v2u*)(vrow + 48);
                        v4u f0, f1; f0.x = a0.x; f0.y = a0.y; f0.z = a1.x; f0.w = a1.y; f1.x = a2.x; f1.y = a2.y; f1.z = a3.x; f1.w = a3.y;
                        O[dt] = __builtin_amdgcn_mfma_f32_32x32x16_bf16(__builtin_bit_cast(bf16x8, f0), pf0, O[dt], 0, 0, 0);
                        O[dt] = __builtin_amdgcn_mfma_f32_32x32x16_bf16(__builtin_bit_cast(bf16x8, f1), pf1, O[dt], 0, 0, 0);
                    }
                }
            }
            if (j + 1 < nrows) lstore(buf ^ 1);
            __syncthreads();
        }
        lsum += __shfl_xor(lsum, 32);
        const float il = 1.f / lsum;
        float ss = 0.f;
#pragma unroll
        for (int dt = 0; dt < 4; ++dt)
#pragma unroll
            for (int i = 0; i < 16; ++i) { O[dt][i] *= il; ss += O[dt][i] * O[dt][i]; }
        ss += __shfl_xor(ss, 32);
        const float rr = rsqrtf(ss * (1.f / HD) + EPS);
        bf16* orow = MIXED + (size_t)mq * DM + h * HD;
#pragma unroll
        for (int dt = 0; dt < 4; ++dt)
#pragma unroll
            for (int rg = 0; rg < 4; ++rg) { const int d = 32 * dt + 8 * rg + 4 * hh; const f32x4 gg = *(const GAS f32x4*)(og + h * HD + d);
                v2u w; w.x = pk2(O[dt][4 * rg + 0] * rr * gg.x, O[dt][4 * rg + 1] * rr * gg.y); w.y = pk2(O[dt][4 * rg + 2] * rr * gg.z, O[dt][4 * rg + 3] * rr * gg.w);
                *(GAS v2u*)(orow + d) = w; }
    }
    __syncthreads();
}

__device__ __forceinline__ void phase_p15(Frame& F) {
    bf16* QK = (bf16*)(F.ws + WS_QK); const float* qg = F.in[3]; const float* kg = F.in[4];
    for (int m = GW_ID(F); m < MT; m += GW_N(F)) {
        GAS v4u* rowp = (GAS v4u*)(QK + (size_t)m * 2048) + F.lane;
#pragma unroll
        for (int j = 0; j < 4; ++j) {
            v4u w = rowp[64 * j];
            float f[8] = {bflo(w.x), bfhi(w.x), bflo(w.y), bfhi(w.y), bflo(w.z), bfhi(w.z), bflo(w.w), bfhi(w.w)};
            float ss = 0.f;
#pragma unroll
            for (int e = 0; e < 8; ++e) ss += f[e] * f[e];
            ss += __shfl_xor(ss, 1); ss += __shfl_xor(ss, 2); ss += __shfl_xor(ss, 4); ss += __shfl_xor(ss, 8);
            const float r = rsqrtf(ss * (1.f / HD) + EPS);
            const int col = 512 * j + 8 * F.lane, d = col & 127; const float* g = (col < 1024 ? qg : kg) + d;
#pragma unroll
            for (int e = 0; e < 8; ++e) f[e] = f[e] * r * g[e];
            w.x = pk2(f[0], f[1]); w.y = pk2(f[2], f[3]); w.z = pk2(f[4], f[5]); w.w = pk2(f[6], f[7]);
            rowp[64 * j] = w;
        }
    }
    const bf16* XT = (const bf16*)(F.ws + WS_XT) + (size_t)1024 * MT; bf16* UC = (bf16*)(F.ws + WS_UC);
    const float* cw = F.in[6]; const float* cb = F.in[7];
    const size_t nchunks = (size_t)3072 * MT / 8;
    for (size_t i = (size_t)F.bid * NTHREADS + F.tid; i < nchunks; i += (size_t)F.G * NTHREADS) {
        const int ch = (int)(i >> 10), m0 = (int)(i & 1023) * 8, s0 = m0 & 4095;
        const bf16* up = XT + (size_t)ch * MT + m0;
        const v4u w = *(const GAS v4u*)up;
        float f[10];
        f[1] = bflo(w.x); f[2] = bfhi(w.x); f[3] = bflo(w.y); f[4] = bfhi(w.y); f[5] = bflo(w.z); f[6] = bfhi(w.z); f[7] = bflo(w.w); f[8] = bfhi(w.w);
        f[0] = s0 > 0 ? bf2f(up[-1]) : 0.f; f[9] = s0 + 8 < SEQ ? bf2f(up[8]) : 0.f;
        const float w0 = cw[ch], w1 = cw[3072 + ch], w2 = cw[6144 + ch], bb = cb[ch];
        float o[8];
#pragma unroll
        for (int e = 0; e < 8; ++e) o[e] = bb + w0 * f[e] + w1 * f[e + 1] + w2 * f[e + 2];
        v4u ov; ov.x = pk2(o[0], o[1]); ov.y = pk2(o[2], o[3]); ov.z = pk2(o[4], o[5]); ov.w = pk2(o[6], o[7]);
        *(GAS v4u*)(UC + (size_t)ch * MT + m0) = ov;
    }
}
__device__ __forceinline__ void phase_p25(Frame& F) {
    const bf16* HYT = (const bf16*)(F.ws + WS_HYT); bf16* MIXED = (bf16*)(F.ws + WS_MIXED); const float* hg = F.in[16];
    LAS float* tile = (LAS float*)F.lds;
    LAS float* rs = (LAS float*)(F.lds + 128 * 65 * 4);
    for (int it = F.bid; it < 8 * (MT / 64); it += F.G) {
        const int gi = it & 7, m0 = (it >> 3) * 64;
        { const int ch = F.tid >> 2, t0 = (F.tid & 3) * 16; const bf16* p = HYT + (size_t)(gi * 128 + ch) * MT + m0 + t0;
          const v4u a = *(const GAS v4u*)p, b = *(const GAS v4u*)(p + 8);
          LAS float* d = tile + ch * 65 + t0;
          d[0] = bflo(a.x); d[1] = bfhi(a.x); d[2] = bflo(a.y); d[3] = bfhi(a.y); d[4] = bflo(a.z); d[5] = bfhi(a.z); d[6] = bflo(a.w); d[7] = bfhi(a.w);
          d[8] = bflo(b.x); d[9] = bfhi(b.x); d[10] = bflo(b.y); d[11] = bfhi(b.y); d[12] = bflo(b.z); d[13] = bfhi(b.z); d[14] = bflo(b.w); d[15] = bfhi(b.w); }
        __syncthreads();
        {
          const int t = F.tid >> 3, c0 = (F.tid & 7) * 16; float ss = 0.f;
#pragma unroll
          for (int c = 0; c < 16; ++c) { const float v = tile[(c0 + c) * 65 + t]; ss += v * v; }
          ss += __shfl_xor(ss, 1); ss += __shfl_xor(ss, 2); ss += __shfl_xor(ss, 4);
          if ((F.tid & 7) == 0) rs[t] = rsqrtf(ss * (1.f / 128) + EPS); }
        __syncthreads();
        {
          const int t = F.tid >> 3, c0 = (F.tid & 7) * 16; const float r = rs[t]; float o[16];
#pragma unroll
          for (int c = 0; c < 16; ++c) o[c] = tile[(c0 + c) * 65 + t] * r * hg[gi * 128 + c0 + c];
          v4u a, b; a.x = pk2(o[0], o[1]); a.y = pk2(o[2], o[3]); a.z = pk2(o[4], o[5]); a.w = pk2(o[6], o[7]); b.x = pk2(o[8], o[9]); b.y = pk2(o[10], o[11]); b.z = pk2(o[12], o[13]); b.w = pk2(o[14], o[15]);
          bf16* q = MIXED + (size_t)(m0 + t) * DM + AW + gi * 128 + c0; *(GAS v4u*)q = a; *(GAS v4u*)(q + 8) = b; }
        __syncthreads();
    }
}
__device__ __forceinline__ void phase_p35(Frame& F) {
    LAS float* wrT = (LAS float*)F.lds;
    const float* wr = F.in[19]; const float* g = F.in[18];
    for (int i = F.tid; i < DM * NE; i += NTHREADS) { const int d = i >> 4, e = i & 15; wrT[e * DM + d] = wr[i]; }
    __syncthreads();
    bf16* HB = (bf16*)(F.ws + WS_HB); float* AFF = (float*)(F.ws + WS_AFF); const float* x1 = F.out;
    for (int m = GW_ID(F); m < MT; m += GW_N(F)) {
        const GAS f32x4* xr = (const GAS f32x4*)(x1 + (size_t)m * DM) + F.lane;
        f32x4 v[8]; float s = 0.f;
#pragma unroll
        for (int j = 0; j < 8; ++j) { v[j] = xr[64 * j]; s += (v[j].x * v[j].x + v[j].y * v[j].y) + (v[j].z * v[j].z + v[j].w * v[j].w); }
        const float r = rsqrtf(wave_sum(s) * (1.f / DM) + EPS);
        GAS v2u* o8 = (GAS v2u*)(HB + (size_t)m * DM) + F.lane;
#pragma unroll
        for (int j = 0; j < 8; ++j) { const f32x4 gg = *((const GAS f32x4*)g + F.lane + 64 * j); v[j].x *= r * gg.x; v[j].y *= r * gg.y; v[j].z *= r * gg.z; v[j].w *= r * gg.w;
            v2u o; o.x = pk2(v[j].x, v[j].y); o.y = pk2(v[j].z, v[j].w); o8[64 * j] = o; }
        float mine = 0.f;
#pragma unroll 1
        for (int e = 0; e < NE; ++e) { float a = 0.f;
#pragma unroll
            for (int j = 0; j < 8; ++j) { const f32x4 w = *((const LAS f32x4*)(wrT + e * DM) + F.lane + 64 * j); a += (v[j].x * w.x + v[j].y * w.y) + (v[j].z * w.z + v[j].w * w.w); }
            a = wave_sum(a); mine = (F.lane == e) ? a : mine; }
        float mx = mine;
        mx = fmaxf(mx, __shfl_xor(mx, 1)); mx = fmaxf(mx, __shfl_xor(mx, 2)); mx = fmaxf(mx, __shfl_xor(mx, 4)); mx = fmaxf(mx, __shfl_xor(mx, 8));
        const float ex = expf(mine - mx); float den = ex;
        den += __shfl_xor(den, 1); den += __shfl_xor(den, 2); den += __shfl_xor(den, 4); den += __shfl_xor(den, 8);
        const int b = m / SEQ, sidx = m % SEQ;
        if (F.lane < NE) AFF[((size_t)b * NE + F.lane) * SEQ + sidx] = ex / den;
    }
    __syncthreads();
}
__device__ __forceinline__ void phase_p4(Frame& F) {
    LAS unsigned* key = (LAS unsigned*)F.lds;
    LAS unsigned* hist = (LAS unsigned*)(F.lds + 16384);
    LAS unsigned* wsum = (LAS unsigned*)(F.lds + 16384 + 1024);
    const float* AFF = (const float*)(F.ws + WS_AFF); int* IDX = (int*)(F.ws + WS_IDX); float* GATE = (float*)(F.ws + WS_GATE); int* SEL = (int*)(F.ws + WS_SEL);
    for (int be = F.bid; be < NB * NE; be += F.G) {
        const int b = be / NE, e = be % NE;
        __syncthreads();
        const GAS v4u* ap = (const GAS v4u*)(AFF + (size_t)be * SEQ);
        const v4u k0 = ap[2 * F.tid], k1 = ap[2 * F.tid + 1];
        unsigned kk[8] = {k0.x, k0.y, k0.z, k0.w, k1.x, k1.y, k1.z, k1.w};
        unsigned prefix = 0u, mask = 0u, remaining = CAP;
#pragma unroll 1
        for (int pass = 0; pass < 4; ++pass) {
            const int shift = 24 - 8 * pass;
            if (F.tid < 256) hist[F.tid] = 0u;
            __syncthreads();
#pragma unroll
            for (int i = 0; i < 8; ++i) if ((kk[i] & mask) == prefix) __hip_atomic_fetch_add(&hist[(kk[i] >> shift) & 255u], 1u, __ATOMIC_RELAXED, __HIP_MEMORY_SCOPE_WORKGROUP);
            __syncthreads();
            if (F.tid < 256) {
                unsigned above = 0u;
                for (int j = F.tid + 1; j < 256; ++j) above += hist[j];
                const unsigned mine = hist[F.tid];
                if (above < remaining && remaining <= above + mine) { wsum[8] = (unsigned)F.tid; wsum[9] = above; }
            }
            __syncthreads();
            const unsigned d = wsum[8], above = wsum[9];
            prefix |= d << shift; mask |= 255u << shift; remaining -= above;
            __syncthreads();
        }
        const unsigned thr = prefix;
        unsigned cnt = 0u;
#pragma unroll
        for (int i = 0; i < 8; ++i) cnt += (kk[i] > thr ? 0x10000u : 0u) + (kk[i] == thr ? 1u : 0u);
        unsigned incl = cnt;
#pragma unroll
        for (int o = 1; o < 64; o <<= 1) { const unsigned t = __shfl_up(incl, o); if (F.lane >= o) incl += t; }
        if (F.lane == 63) wsum[F.wave] = incl;
        __syncthreads();
        unsigned base = 0u;
        for (int w = 0; w < F.wave; ++w) base += wsum[w];
        unsigned run = base + incl - cnt;
#pragma unroll
        for (int i = 0; i < 8; ++i) {
            const unsigned gt_before = run >> 16, tie_before = run & 0xffffu;
            const bool isgt = kk[i] > thr, istie = kk[i] == thr;
            const bool sel = isgt || (istie && tie_before < remaining);
            const unsigned slot = gt_before + (tie_before < remaining ? tie_before : remaining);
            const int s = 8 * F.tid + i, m = b * SEQ + s;
            if (sel) { IDX[be * CAP + slot] = m; GATE[be * CAP + slot] = __builtin_bit_cast(float, kk[i]); }
            SEL[(size_t)m * NE + e] = sel ? (int)slot : -1;
            run += (isgt ? 0x10000u : 0u) + (istie ? 1u : 0u);
        }
    }
    __syncthreads();
}
__device__ __forceinline__ void phase_p7(Frame& F) {
    const int* SEL = (const int*)(F.ws + WS_SEL); const float* GATE = (const float*)(F.ws + WS_GATE); const bf16* YE = (const bf16*)(F.ws + WS_YE);
    for (int m = GW_ID(F); m < MT; m += GW_N(F)) {
        const int b = m / SEQ;
        GAS f32x4* orow = (GAS f32x4*)(F.out + (size_t)m * DM);
        f32x4 acc[8];
#pragma unroll
        for (int j = 0; j < 8; ++j) acc[j] = orow[2 * F.lane + (j & 1) + 128 * (j >> 1)];
        for (int e = 0; e < NE; ++e) { const int slot = SEL[(size_t)m * NE + e]; if (slot >= 0) {
            const GAS v4u* yr = (const GAS v4u*)(YE + (size_t)((b * NE + e) * CAP + slot) * DM) + F.lane;
#pragma unroll
            for (int jj = 0; jj < 4; ++jj) { const v4u w = yr[64 * jj];
                acc[2 * jj].x += bflo(w.x); acc[2 * jj].y += bfhi(w.x); acc[2 * jj].z += bflo(w.y); acc[2 * jj].w += bfhi(w.y);
                acc[2 * jj + 1].x += bflo(w.z); acc[2 * jj + 1].y += bfhi(w.z); acc[2 * jj + 1].z += bflo(w.w); acc[2 * jj + 1].w += bfhi(w.w); } } }
#pragma unroll
        for (int j = 0; j < 8; ++j) orow[2 * F.lane + (j & 1) + 128 * (j >> 1)] = acc[j];
    }
    (void)GATE;
}

struct Args { const float* in[23]; float* out; unsigned char* ws; int ph_lo, ph_hi; };
enum Phase { PH_P0 = 0, PH_G1, PH_FILT, PH_P15, PH_ATTN, PH_P25, PH_OUT, PH_P35, PH_P4, PH_UP, PH_DOWN, PH_P7, PH_COUNT };

__global__ void __launch_bounds__(NTHREADS, 2) mk_fwd(Args args) {
    extern __shared__ __attribute__((aligned(16))) unsigned char lds_raw[];
    Frame F;
    F.lds = (LAS unsigned char*)lds_raw;
    F.tid = threadIdx.x; F.lane = F.tid & 63; F.wave = __builtin_amdgcn_readfirstlane(F.tid >> 6); F.G = gridDim.x; F.bid = blockIdx.x;
#pragma unroll
    for (int i = 0; i < 23; ++i) F.in[i] = args.in[i];
    F.out = args.out; F.ws = args.ws;
    const int lo = args.ph_lo, hi = args.ph_hi;
#define IN(k) (lo <= (k) && (k) < hi)
#define REPS(k) for (int rep_ = 0; rep_ < ((k) == REP_PHASE ? REP_N : 1); ++rep_)
#if MK_N_LAUNCHES == 1
    { volatile LAS unsigned* misc = (volatile LAS unsigned*)(F.lds + LDS_MISC_OFF); if (F.tid < 16) misc[F.tid] = 0u; }
    __syncthreads();
    XcdBarrier bar = xcd_barrier_post((unsigned*)(F.ws + WS_CTL) + 4096, (volatile LAS unsigned*)(F.lds + LDS_MISC_OFF) + 8);
#define SEAM(k) do { if (IN(k) && IN((k) + 1)) xcd_barrier(bar); } while (0)
#else
#define SEAM(k) do { } while (0)
#endif
    if (IN(PH_P0)) REPS(PH_P0) { phase_p0(F); for (int it = GW_ID(F); it < MOE_P0_ITEMS; it += GW_N(F)) moe_conv_item(F, it); } SEAM(PH_P0);
    if (IN(PH_G1)) REPS(PH_G1) {
        __syncthreads();
        { pg8::DenseOrder S; S.init(F.ws + WS_HB, F.ws + WS_WIN, MT, 2048, DM, 0, F.G, F.bid);
          pg8::EpiBf16 E{(pg8::bf16_t*)(F.ws + WS_QK), 2048, 0, nullptr};
          pg8::gemm_phase<pg8::EpiBf16, pg8::DenseOrder, true>(F.lds, DM, S, E); }
        { pg8::DenseOrder S; S.init(F.ws + WS_HB, F.ws + WS_WIN, MT, 4096, DM, 8, F.G, F.bid);
          pg8::EpiTransBf16 E{(pg8::bf16_t*)(F.ws + WS_XT), MT, 8};
          pg8::gemm_phase<pg8::EpiTransBf16, pg8::DenseOrder, true>(F.lds, DM, S, E); }
    } SEAM(PH_G1);
    if (IN(PH_FILT)) REPS(PH_FILT) { phase_filters(F); } SEAM(PH_FILT);
    if (IN(PH_P15)) { phase_p15(F); } SEAM(PH_P15);
    if (IN(PH_ATTN)) { __syncthreads(); for (int rep_ = 0; rep_ < ((PH_ATTN == REP_PHASE && REP_SUB != 2) ? REP_N : 1); ++rep_) phase_hyena(F); for (int rep_ = 0; rep_ < ((PH_ATTN == REP_PHASE && REP_SUB != 1) ? REP_N : 1); ++rep_) phase_attn2(F); } SEAM(PH_ATTN);
    if (IN(PH_P25)) REPS(PH_P25) { __syncthreads(); phase_p25(F); } SEAM(PH_P25);
    if (IN(PH_OUT)) REPS(PH_OUT) {
        __syncthreads();
        pg8::DenseOrder S; S.init(F.ws + WS_MIXED, F.ws + WS_WOUT, MT, DM, DM, 0, F.G, F.bid);
        pg8::EpiResF32 E{F.in[0], F.out, DM};
        pg8::gemm_phase<pg8::EpiResF32, pg8::DenseOrder, false>(F.lds, DM, S, E);
    } SEAM(PH_OUT);
    if (IN(PH_P35)) REPS(PH_P35) { __syncthreads(); phase_p35(F); } SEAM(PH_P35);
    if (IN(PH_P4)) REPS(PH_P4) { __syncthreads(); phase_p4(F); } SEAM(PH_P4);
    if (IN(PH_UP)) REPS(PH_UP) {
        __syncthreads();
        pg8::MoeOrder S; S.init(F.ws + WS_HB, F.ws + WS_WGU, DM, F.G, F.bid, true);
        LAS int* ridx = (LAS int*)(F.lds + 131072);
        { const int* IDX = (const int*)(F.ws + WS_IDX); pg8::Unit u;
          for (int i = 0; S.next(i, u); ++i) if (F.tid < 256) ridx[i * 256 + F.tid] = IDX[u.g * CAP + u.pm * 256 + F.tid]; }
        __syncthreads();
        pg8::EpiSwiGLU E{(pg8::bf16_t*)(F.ws + WS_ACT)};
        pg8::gemm_phase<pg8::EpiSwiGLU, pg8::MoeOrder, true, true>(F.lds, DM, S, E, ridx);
    } SEAM(PH_UP);
    if (IN(PH_DOWN)) REPS(PH_DOWN) {
        __syncthreads();
        pg8::MoeOrder S; S.init(F.ws + WS_ACT, F.ws + WS_WD, FF, F.G, F.bid, false);
        pg8::EpiBf16 E{(pg8::bf16_t*)(F.ws + WS_YE), DM, 512, (const float*)(F.ws + WS_GATE)};
        pg8::gemm_phase<pg8::EpiBf16, pg8::MoeOrder, true>(F.lds, FF, S, E);
    } SEAM(PH_DOWN);
    if (IN(PH_P7)) { phase_p7(F); }
#undef IN
#undef SEAM
}

extern "C" void kernel_launch(void* const* d_in, const int* in_sizes, int n_in, void* d_out, int out_size, void* d_ws, size_t ws_size, hipStream_t stream) {
    static int grid = 0;
    if (grid == 0) {
        if (n_in != 23 || ws_size < WS_END) { fprintf(stderr, "kernel_launch: unexpected inputs (n_in %d, ws %zu)\n", n_in, ws_size); grid = -1; return; }
        if (hipFuncSetAttribute((const void*)mk_fwd, hipFuncAttributeMaxDynamicSharedMemorySize, LDS_BYTES) != hipSuccess) { fprintf(stderr, "kernel_launch: hipFuncSetAttribute failed\n"); grid = -1; return; }
        int dev = 0, cus = 0, per_cu = 0;
        hipGetDevice(&dev); hipDeviceGetAttribute(&cus, hipDeviceAttributeMultiprocessorCount, dev);
        hipOccupancyMaxActiveBlocksPerMultiprocessor(&per_cu, (const void*)mk_fwd, NTHREADS, LDS_BYTES);
        (void)hipGetLastError();
        if (per_cu < 1) { fprintf(stderr, "kernel_launch: occupancy query says %d blocks/CU\n", per_cu); }
        grid = cus;
    }
    if (grid < 0) return;
    Args a{};
    for (int i = 0; i < 23; ++i) a.in[i] = (const float*)d_in[i];
    a.out = (float*)d_out; a.ws = (unsigned char*)d_ws;
#if MK_N_LAUNCHES == 1
    if (hipMemsetAsync((char*)d_ws + WS_CTL, 0, CTL_ZERO_BYTES, stream) != hipSuccess) { fprintf(stderr, "kernel_launch: memset failed\n"); return; }
    a.ph_lo = 0; a.ph_hi = PH_COUNT;
    void* kargs[] = {&a};
    hipError_t e = hipLaunchCooperativeKernel((const void*)mk_fwd, dim3(grid), dim3(NTHREADS), kargs, LDS_BYTES, stream);
    if (e != hipSuccess) fprintf(stderr, "cooperative launch failed: %s (grid %d)\n", hipGetErrorString(e), grid);
#else
    for (int p = 0; p < PH_COUNT; ++p) { a.ph_lo = p; a.ph_hi = p + 1; hipLaunchKernelGGL(mk_fwd, dim3(grid), dim3(NTHREADS), LDS_BYTES, stream, a); }
#endif
}
```

```cpp
#include <hip/hip_runtime.h>
#include <hip/hip_cooperative_groups.h>
#include <cstdio>
#include <cstdint>
namespace cg = cooperative_groups;

#ifndef REP_PHASE
#define REP_PHASE -1
#define REP_N 1
#define REP_SUB 0
#endif
#ifndef MK_N_LAUNCHES
#define MK_N_LAUNCHES 1
#endif

namespace pg8 {
#define PG8_LAS __attribute__((address_space(3)))
typedef unsigned short bf16_t;
typedef short bf16x8 __attribute__((ext_vector_type(8)));
typedef float f32x4 __attribute__((ext_vector_type(4)));
typedef unsigned u32x4 __attribute__((ext_vector_type(4)));
typedef unsigned u32x2 __attribute__((ext_vector_type(2)));
constexpr int BM = 256, BK = 64, HALF = 128, HTB = HALF * BK * 2, STAGE_BYTES = 8 * HTB, NXCD = 8, WGM = 8;

__host__ __device__ __forceinline__ int lds_byte(int r, int c) { const int st = (r >> 4) * 2 + (c >> 5), rr = r & 15, cc = c & 31, ob = rr * 64 + cc * 2; return st * 1024 + (ob ^ (((ob >> 9) & 1) << 5)); }
__host__ __device__ __forceinline__ void stage_rc(int b, int& R, int& C) { const int st = b / 1024, sb = b % 1024, swz = sb ^ (((sb >> 9) & 1) << 5); R = (st >> 1) * 16 + swz / 64; C = (st & 1) * 32 + (swz % 64) / 2; }
__host__ __device__ __forceinline__ int perm32(int rho) { const int n = rho >> 4, i = rho & 15; return 8 * (i >> 2) + 4 * n + (i & 3); }

struct Unit { int pm, pn, g; const char* a; const char* b; };

__device__ __forceinline__ unsigned cvt_pk_bf16(float lo, float hi) { unsigned r; asm volatile("v_cvt_pk_bf16_f32 %0, %1, %2" : "=v"(r) : "v"(lo), "v"(hi)); return r; }

struct DenseOrder {
    static constexpr bool CHUNK_B = false;
    int nM, nN, nwg, G, c, K, pn0; const char* A; const char* Bt;
    __device__ void init(const void* A_, const void* Bt_, int M, int N, int K_, int pn0_, int G_, int c_) { A = (const char*)A_; Bt = (const char*)Bt_; nM = M / BM; nN = N / BM; nwg = nM * nN; G = G_; c = c_; K = K_; pn0 = pn0_; }
    __device__ bool next(int i, Unit& u) const {
        const long L = (long)i * G + c; if (L >= nwg) return false;
        int wgid = (int)L; { const int q = nwg / NXCD, r = nwg % NXCD, xcd = wgid % NXCD, off = wgid / NXCD; wgid = (xcd < r ? xcd * (q + 1) : r * (q + 1) + (xcd - r) * q) + off; }
        const int nig = WGM * nN, gid = wgid / nig, fm = gid * WGM, gsz = (nM - fm) < WGM ? (nM - fm) : WGM;
        u.pm = fm + ((wgid % nig) % gsz); u.pn = pn0 + (wgid % nig) / gsz; u.g = 0;
        u.a = A + (size_t)u.pm * BM * K * 2; u.b = Bt + (size_t)u.pn * BM * K * 2; return true;
    }
};
struct MoeOrder {
    static constexpr bool CHUNK_B = true;
    int G, c, K; bool gather; const char* A; const char* Bt;
    __device__ void init(const void* A_, const void* Bt_, int K_, int G_, int c_, bool gather_) { A = (const char*)A_; Bt = (const char*)Bt_; K = K_; G = G_; c = c_; gather = gather_; }
    __device__ bool next(int i, Unit& u) const {
        const int L = i * G + c; if (L >= 512) return false;
        const int pn = L & 7, pm = (L >> 3) & 1, b = (L >> 4) & 1, e = L >> 5;
        u.pm = pm; u.pn = pn; u.g = b * 16 + e;
        u.a = gather ? A : A + (size_t)(u.g * 512 + pm * BM) * K * 2; u.b = Bt + (size_t)e * 2048 * K * 2 + (size_t)pn * BM * 16; return true;
    }
};

struct EpiBf16 {
    static constexpr bool PERM = true, SWAP = false;
    bf16_t* O; int ldc; int grows; const float* rscale;
    __device__ __forceinline__ void operator()(const f32x4 (&acc)[2][2][4][2], const Unit& u, int wr, int wc, int fr, int fq) const {
        const int row0 = u.g * grows + u.pm * BM + wr * 64 + fr, col0 = u.pn * BM + wc * 32 + 8 * fq;
#pragma unroll
        for (int ai = 0; ai < 2; ++ai)
#pragma unroll
            for (int m = 0; m < 4; ++m) { const int row = row0 + ai * HALF + m * 16; bf16_t* rowp = O + (size_t)row * ldc + col0; const float sc = rscale ? rscale[row] : 1.f;
#pragma unroll
                for (int bj = 0; bj < 2; ++bj) { const f32x4 v0 = acc[ai][bj][m][0] * sc, v1 = acc[ai][bj][m][1] * sc;
                    u32x4 w; w.x = cvt_pk_bf16(v0[0], v0[1]); w.y = cvt_pk_bf16(v0[2], v0[3]); w.z = cvt_pk_bf16(v1[0], v1[1]); w.w = cvt_pk_bf16(v1[2], v1[3]);
                    *(u32x4*)(rowp + bj * HALF) = w; } }
    }
};
struct EpiSwiGLU {
    static constexpr bool PERM = true, SWAP = false;
    bf16_t* O;
    __device__ __forceinline__ void operator()(const f32x4 (&acc)[2][2][4][2], const Unit& u, int wr, int wc, int fr, int fq) const {
        const int row0 = u.g * 512 + u.pm * BM + wr * 64 + fr, col0 = u.pn * HALF + wc * 32 + 8 * fq;
#pragma unroll
        for (int ai = 0; ai < 2; ++ai)
#pragma unroll
            for (int m = 0; m < 4; ++m) { bf16_t* rowp = O + (size_t)(row0 + ai * HALF + m * 16) * 1024 + col0;
                float r[8];
#pragma unroll
                for (int n = 0; n < 2; ++n)
#pragma unroll
                    for (int e = 0; e < 4; ++e) { const float g = acc[ai][0][m][n][e], up = acc[ai][1][m][n][e]; r[n * 4 + e] = g / (1.f + __expf(-g)) * up; }
                u32x4 w; w.x = cvt_pk_bf16(r[0], r[1]); w.y = cvt_pk_bf16(r[2], r[3]); w.z = cvt_pk_bf16(r[4], r[5]); w.w = cvt_pk_bf16(r[6], r[7]);
                *(u32x4*)rowp = w; }
    }
};
struct EpiResF32 {
    static constexpr bool PERM = false, SWAP = false;
    const float* res; float* out; int ldc;
    __device__ __forceinline__ void operator()(const f32x4 (&acc)[2][2][4][2], const Unit& u, int wr, int wc, int fr, int fq) const {
        const int row0 = u.pm * BM + wr * 64 + fr, col0 = u.pn * BM + wc * 32 + 4 * fq;
#pragma unroll
        for (int ai = 0; ai < 2; ++ai)
#pragma unroll
            for (int m = 0; m < 4; ++m) { const size_t off = (size_t)(row0 + ai * HALF + m * 16) * ldc + col0;
#pragma unroll
                for (int bj = 0; bj < 2; ++bj)
#pragma unroll
                    for (int n = 0; n < 2; ++n) { const f32x4 r = *(const f32x4*)(res + off + bj * HALF + n * 16); *(f32x4*)(out + off + bj * HALF + n * 16) = r + acc[ai][bj][m][n]; } }
    }
};
struct EpiTransBf16 {
    static constexpr bool PERM = false, SWAP = true;
    bf16_t* O; int ldt; int pn_base;
    __device__ __forceinline__ void operator()(const f32x4 (&acc)[2][2][4][2], const Unit& u, int wr, int wc, int fr, int fq) const {
        const int ch0 = (u.pn - pn_base) * BM + wc * 32 + fr, t0 = u.pm * BM + wr * 64 + 4 * fq;
#pragma unroll
        for (int bj = 0; bj < 2; ++bj)
#pragma unroll
            for (int n = 0; n < 2; ++n) { bf16_t* chp = O + (size_t)(ch0 + bj * HALF + n * 16) * ldt + t0;
#pragma unroll
                for (int ai = 0; ai < 2; ++ai)
#pragma unroll
                    for (int m = 0; m < 4; ++m) { const f32x4 v = acc[ai][bj][m][n]; u32x2 w; w.x = cvt_pk_bf16(v[0], v[1]); w.y = cvt_pk_bf16(v[2], v[3]); *(u32x2*)(chp + ai * HALF + m * 16) = w; } }
    }
};

template <class Epi, class Sched, bool ALIGN_EPI = false, bool GATHER = false>
__device__ __forceinline__ void gemm_phase(PG8_LAS unsigned char* lds, const int K, const Sched& S, const Epi& E, const PG8_LAS int* ridx = nullptr) {
    const int tid = threadIdx.x, wid = __builtin_amdgcn_readfirstlane(tid >> 6), lane = tid & 63, wr = wid >> 2, wc = wid & 3, fr = lane & 15, fq = lane >> 4;
    const int nt = K / BK;
    unsigned vA0[2], vA1[2], vN0[2], vN1[2], voffB[2]; int stR[2], stC[2];
    const size_t kstep = (size_t)(BK * 2);
    const size_t hstep = (size_t)HALF * K * 2;
    const size_t kstepB = Sched::CHUNK_B ? (size_t)(BK / 8) * 2048 * 16 : kstep, hstepB = Sched::CHUNK_B ? (size_t)HALF * 16 : hstep;
#pragma unroll
    for (int i = 0; i < 2; ++i) { int R, C; stage_rc(tid * 16 + i * 8192, R, C); const int Rb = Epi::PERM ? ((R & ~31) + perm32(R & 31)) : R; stR[i] = R; stC[i] = C;
        voffB[i] = Sched::CHUNK_B ? (unsigned)(((C >> 3) * 2048 + Rb) * 16) : (unsigned)(Rb * K + C) * 2u;
        if constexpr (GATHER) { vA0[i] = (unsigned)(ridx[R] * K + C) * 2u; vA1[i] = (unsigned)(ridx[HALF + R] * K + C) * 2u; }
        else { vA0[i] = (unsigned)(R * K + C) * 2u; vA1[i] = vA0[i] + (unsigned)hstep; }
        vN0[i] = vA0[i]; vN1[i] = vA1[i]; }
    const unsigned ldsw = (unsigned)wid * 1024u;
    const int aoff = lds_byte(wr * 64 + fr, fq * 8), boff = lds_byte(wc * 32 + fr, fq * 8);
#define PG8_SA(b, h) (((b) * 2 + (h)) * HTB)
#define PG8_SB(b, h) ((4 + (b) * 2 + (h)) * HTB)
#define PG8_STAGE(bufoff, gbase, voff) do { _Pragma("unroll") for (int _i = 0; _i < 2; ++_i) \
        __builtin_amdgcn_global_load_lds((const unsigned*)((const char*)(gbase) + (voff)[_i]), (PG8_LAS unsigned*)(lds + (bufoff) + ldsw + _i * 8192), 16, 0, 0); } while (0)
#define PG8_LDA(dst, b, h) do { _Pragma("unroll") for (int m = 0; m < 4; ++m) _Pragma("unroll") for (int k = 0; k < 2; ++k) dst[m][k] = *(const PG8_LAS bf16x8*)(lds + PG8_SA(b, h) + aoff + m * 2048 + k * 1024); } while (0)
#define PG8_LDB(dst, b, h) do { _Pragma("unroll") for (int n = 0; n < 2; ++n) _Pragma("unroll") for (int k = 0; k < 2; ++k) dst[n][k] = *(const PG8_LAS bf16x8*)(lds + PG8_SB(b, h) + boff + n * 2048 + k * 1024); } while (0)
#define PG8_MMA(ai, bj, At, Bt) do { __builtin_amdgcn_s_setprio(1); _Pragma("unroll") for (int m = 0; m < 4; ++m) _Pragma("unroll") for (int n = 0; n < 2; ++n) _Pragma("unroll") for (int k = 0; k < 2; ++k) \
        acc[ai][bj][m][n] = Epi::SWAP ? __builtin_amdgcn_mfma_f32_16x16x32_bf16(At[m][k], Bt[n][k], acc[ai][bj][m][n], 0, 0, 0) : __builtin_amdgcn_mfma_f32_16x16x32_bf16(Bt[n][k], At[m][k], acc[ai][bj][m][n], 0, 0, 0); __builtin_amdgcn_s_setprio(0); } while (0)
#define PG8_WAIT_V(n) asm volatile("s_waitcnt vmcnt(" #n ")" ::: "memory")
#define PG8_WAIT_L(n) asm volatile("s_waitcnt lgkmcnt(" #n ")" ::: "memory")
#define PG8_BAR __builtin_amdgcn_s_barrier()
#define PG8_SCHED __builtin_amdgcn_sched_barrier(0)
    Unit cur, nxt; int ui = 0;
    if (!S.next(0, cur)) return;
    f32x4 acc[2][2][4][2];
#pragma unroll
    for (int a = 0; a < 2; ++a)
#pragma unroll
        for (int b = 0; b < 2; ++b)
#pragma unroll
            for (int m = 0; m < 4; ++m)
#pragma unroll
                for (int n = 0; n < 2; ++n) acc[a][b][m][n] = (f32x4){0.f, 0.f, 0.f, 0.f};
    bf16x8 At[4][2], B0[2][2], B1[2][2];
    const char* cA = cur.a; const char* cB = cur.b;
    PG8_STAGE(PG8_SB(0, 0), cB, voffB); PG8_STAGE(PG8_SB(0, 1), cB + hstepB, voffB); PG8_STAGE(PG8_SA(0, 0), cA, vA0); PG8_STAGE(PG8_SA(0, 1), cA, vA1);
    if (wr == 1) PG8_BAR;
    PG8_WAIT_V(2); PG8_BAR;
    PG8_STAGE(PG8_SB(1, 0), cB + kstepB, voffB); PG8_STAGE(PG8_SA(1, 0), cA + kstep, vA0); PG8_STAGE(PG8_SB(1, 1), cB + hstepB + kstepB, voffB);
    PG8_WAIT_V(6); PG8_BAR;
    for (;;) {
        const bool has_next = S.next(ui + 1, nxt);
        const char* nA = has_next ? nxt.a : cA; const char* nB = has_next ? nxt.b : cB;
        if constexpr (GATHER) { if (has_next) {
#pragma unroll
            for (int i = 0; i < 2; ++i) { vN0[i] = (unsigned)(ridx[(ui + 1) * 256 + stR[i]] * K + stC[i]) * 2u; vN1[i] = (unsigned)(ridx[(ui + 1) * 256 + HALF + stR[i]] * K + stC[i]) * 2u; } } }
        for (int t = 0; t < nt; t += 2) {
            const bool last = (t == nt - 2);
            const char* a1 = cA + (size_t)(t + 1) * kstep;
            const char* a2 = last ? nA : cA + (size_t)(t + 2) * kstep; const char* b2 = last ? nB : cB + (size_t)(t + 2) * kstepB;
            const char* a3 = a2 + kstep; const char* b3 = b2 + kstepB;
            unsigned w0[2], w1[2];
#pragma unroll
            for (int i = 0; i < 2; ++i) { w0[i] = last ? vN0[i] : vA0[i]; w1[i] = last ? vN1[i] : vA1[i]; }
            PG8_LDB(B0, 0, 0); PG8_LDB(B1, 0, 1); PG8_SCHED; PG8_LDA(At, 0, 0); PG8_STAGE(PG8_SA(1, 1), a1, vA1);
            PG8_WAIT_V(8); PG8_WAIT_L(0); PG8_BAR; PG8_MMA(0, 0, At, B0); PG8_MMA(0, 1, At, B1); PG8_BAR; PG8_SCHED;
            PG8_LDA(At, 0, 1); PG8_STAGE(PG8_SB(0, 0), b2, voffB); PG8_STAGE(PG8_SB(0, 1), b2 + hstepB, voffB); PG8_STAGE(PG8_SA(0, 0), a2, w0);
            PG8_WAIT_V(8); PG8_WAIT_L(0); PG8_BAR; PG8_MMA(1, 0, At, B0); PG8_MMA(1, 1, At, B1); PG8_BAR; PG8_SCHED;
            PG8_LDB(B0, 1, 0); PG8_LDB(B1, 1, 1); PG8_SCHED; PG8_LDA(At, 1, 0); PG8_STAGE(PG8_SA(0, 1), a2, w1);
            PG8_WAIT_V(8); PG8_WAIT_L(0); PG8_BAR; PG8_MMA(0, 0, At, B0); PG8_MMA(0, 1, At, B1); PG8_BAR; PG8_SCHED;
            PG8_LDA(At, 1, 1); PG8_STAGE(PG8_SB(1, 0), b3, voffB); PG8_STAGE(PG8_SB(1, 1), b3 + hstepB, voffB); PG8_STAGE(PG8_SA(1, 0), a3, w0);
            PG8_WAIT_V(8); PG8_WAIT_L(0); PG8_BAR; PG8_MMA(1, 0, At, B0); PG8_MMA(1, 1, At, B1); PG8_BAR; PG8_SCHED;
        }
        if constexpr (ALIGN_EPI) { if (wr == 0) PG8_BAR; }
        E(acc, cur, wr, wc, fr, fq);
        if (!has_next) break;
#pragma unroll
        for (int a = 0; a < 2; ++a)
#pragma unroll
            for (int b = 0; b < 2; ++b)
#pragma unroll
                for (int m = 0; m < 4; ++m)
#pragma unroll
                    for (int n = 0; n < 2; ++n) acc[a][b][m][n] = (f32x4){0.f, 0.f, 0.f, 0.f};
        cur = nxt; cA = nA; cB = nB; ++ui;
#pragma unroll
        for (int i = 0; i < 2; ++i) { vA0[i] = vN0[i]; vA1[i] = vN1[i]; }
        if constexpr (ALIGN_EPI) { if (wr == 1) PG8_BAR; }
    }
    PG8_WAIT_V(0);
    if constexpr (!ALIGN_EPI) { if (wr == 0) PG8_BAR; }
    PG8_BAR;
#undef PG8_SA
#undef PG8_SB
#undef PG8_STAGE
#undef PG8_LDA
#undef PG8_LDB
#undef PG8_MMA
#undef PG8_WAIT_V
#undef PG8_WAIT_L
#undef PG8_BAR
#undef PG8_SCHED
}
}

constexpr int NB = 2, SEQ = 4096, DM = 2048, MT = NB * SEQ;
constexpr int NH = 8, HD = 128, AW = 1024, HW = 1024, INW = 6144;
constexpr int GW = 64, NROWS = 64, WR = 8, WC = 16;
constexpr int NE = 16, CAP = 512, FF = 1024;
constexpr int FEMB = 33, FHID = 64;
constexpr float EPS = 1e-6f;
constexpr int NWAVES = 8, NTHREADS = 512;

constexpr size_t MiB = 1u << 20;
constexpr size_t WS_CTL = 0, CTL_ZERO_BYTES = 1 * MiB;
constexpr size_t WS_WIN = 2 * MiB;
constexpr size_t WS_WOUT = 26 * MiB;
constexpr size_t WS_WGU = 34 * MiB;
constexpr size_t WS_WD = 162 * MiB;
constexpr size_t WS_W3T = 226 * MiB;
constexpr size_t WS_HID2 = 227 * MiB;
constexpr size_t WS_HB = 228 * MiB;
constexpr size_t WS_QK = 260 * MiB;
constexpr size_t WS_XT = 292 * MiB;
constexpr size_t WS_UC = 356 * MiB;
constexpr size_t WS_TAPS = 404 * MiB;
constexpr size_t WS_HYT = 436 * MiB;
constexpr size_t WS_MIXED = 452 * MiB;
constexpr size_t WS_AFF = 484 * MiB;
constexpr size_t WS_IDX = 485 * MiB;
constexpr size_t WS_GATE = 486 * MiB;
constexpr size_t WS_SEL = 487 * MiB;
constexpr size_t WS_Z1T = 488 * MiB;
constexpr size_t WS_XG = WS_XT;
constexpr size_t WS_ACT = WS_UC;
constexpr size_t WS_YE = WS_TAPS;
constexpr size_t WS_END = 504 * MiB;

constexpr int LDS_BYTES = 163840, LDS_MISC_OFF = 163840 - 128;

#define GAS __attribute__((address_space(1)))
#define LAS __attribute__((address_space(3)))
typedef unsigned short bf16;
typedef unsigned v4u __attribute__((ext_vector_type(4)));
typedef unsigned v2u __attribute__((ext_vector_type(2)));
typedef float f32x4 __attribute__((ext_vector_type(4)));
#define LDS_WAIT() asm volatile("s_waitcnt lgkmcnt(0)" ::: "memory")
#define VM_WAIT() asm volatile("s_waitcnt vmcnt(0)" ::: "memory")
__device__ __forceinline__ unsigned f2bf(float f) { unsigned u = __builtin_bit_cast(unsigned, f); return (u + 0x7fffu + ((u >> 16) & 1u)) >> 16; }
__device__ __forceinline__ unsigned pk2(float lo, float hi) { return f2bf(lo) | (f2bf(hi) << 16); }
__device__ __forceinline__ float bf2f(unsigned h) { return __builtin_bit_cast(float, h << 16); }
__device__ __forceinline__ float bflo(unsigned w) { return __builtin_bit_cast(float, w << 16); }
__device__ __forceinline__ float bfhi(unsigned w) { return __builtin_bit_cast(float, w & 0xffff0000u); }
__device__ __forceinline__ float wave_sum(float v) {
#pragma unroll
    for (int o = 1; o < 64; o <<= 1) v += __shfl_xor(v, o);
    return v;
}


#define XB_TMO      128
#define XB_XCNT(j)  (256  + 64 * (j))
#define XB_XSUB(j)  (1280 + 64 * (j))
#define XB_XGEN(j)  (2304 + 64 * (j))
#define XB_TOP      3328
#define XB_TOPGEN   3392
#define XCD_BAR_WORDS 3456
#define XB_SPIN_CAP (1u << 22)
__device__ __forceinline__ unsigned xb_ld(unsigned* p)              { return __hip_atomic_load(p, __ATOMIC_RELAXED, __HIP_MEMORY_SCOPE_AGENT); }
__device__ __forceinline__ unsigned xb_add(unsigned* p, unsigned v) { return __hip_atomic_fetch_add(p, v, __ATOMIC_RELAXED, __HIP_MEMORY_SCOPE_AGENT); }
__device__ __forceinline__ unsigned xb_xcc_id() { return (unsigned)__builtin_amdgcn_s_getreg((3 << 11) | 20) & 0xFu; }
#define XB_SPIN(cond, bar) do { unsigned _sp = 0; while (cond) { __builtin_amdgcn_s_sleep(1); \
    if ((++_sp & 255u) == 0u) { if (xb_ld(&(bar)[XB_TMO])) break; if (_sp > XB_SPIN_CAP) { atomicAdd(&(bar)[XB_TMO], 1u); break; } } } } while (0)
struct XcdBarrier { unsigned* bar; unsigned x; volatile LAS unsigned* st; };
__device__ __forceinline__ XcdBarrier xcd_barrier_post(unsigned* bar, volatile LAS unsigned* st) {
    XcdBarrier b; b.bar = bar; b.x = xb_xcc_id(); b.st = st;
    if (threadIdx.x == 0) (void)xb_add(&bar[XB_XCNT(b.x)], 1u);
    return b;
}
__device__ __forceinline__ void xcd_barrier_complete(unsigned* bar, unsigned x, unsigned& nloc, unsigned& nx) {
    const unsigned G = gridDim.x * gridDim.y * gridDim.z;
    unsigned sum, cnt, mine, sp = 0u;
    for (;;) {
        sum = 0u; cnt = 0u; mine = 0u;
#pragma unroll
        for (unsigned j = 0; j < 16; ++j) { const unsigned c = xb_ld(&bar[XB_XCNT(j)]); sum += c; cnt += (c > 0u) ? 1u : 0u; mine = (j == x) ? c : mine; }
        if (sum == G) break;
        __builtin_amdgcn_s_sleep(1);
        if ((++sp & 255u) == 0u) { if (xb_ld(&bar[XB_TMO])) break; if (sp > XB_SPIN_CAP) { atomicAdd(&bar[XB_TMO], 1u); break; } }
    }
    nloc = mine > 0u ? mine : 1u; nx = cnt > 0u ? cnt : 1u;
}
__device__ __forceinline__ void xcd_barrier(const XcdBarrier& b) {
    asm volatile("s_waitcnt vmcnt(0)" ::: "memory");
    __syncthreads();
    if (threadIdx.x == 0) {
        unsigned* bar = b.bar;
        __builtin_amdgcn_s_waitcnt(0);
        unsigned nloc = b.st[0], nx = b.st[1];
        if (nloc == 0u) { xcd_barrier_complete(bar, b.x, nloc, nx); b.st[0] = nloc; b.st[1] = nx; }
        const unsigned old = xb_add(&bar[XB_XSUB(b.x)], 1u);
        const unsigned gen = old / nloc;
        if (old + 1u == (gen + 1u) * nloc) {
            __builtin_amdgcn_fence(__ATOMIC_RELEASE, "agent");
            asm volatile("s_waitcnt vmcnt(0)" ::: "memory");
            const unsigned og = xb_add(&bar[XB_TOP], 1u);
            const unsigned tg = og / nx;
            if (og + 1u == (tg + 1u) * nx) xb_add(&bar[XB_TOPGEN], 1u);
            else XB_SPIN(xb_ld(&bar[XB_TOPGEN]) == tg, bar);
            __builtin_amdgcn_fence(__ATOMIC_ACQUIRE, "agent");
            xb_add(&bar[XB_XGEN(b.x)], 1u);
            asm volatile("s_waitcnt vmcnt(0)" ::: "memory");
        } else {
            XB_SPIN(xb_ld(&bar[XB_XGEN(b.x)]) == gen, bar);
            __builtin_amdgcn_fence(__ATOMIC_ACQUIRE, "agent");
            asm volatile("s_waitcnt vmcnt(0)" ::: "memory");
        }
    }
    __syncthreads();
}

struct Frame {
    LAS unsigned char* lds;
    int tid, lane, wave, G, bid;
    const float* in[23]; float* out; unsigned char* ws;
};
#define GW_ID(F) ((F).bid * NWAVES + (F).wave)
#define GW_N(F) ((F).G * NWAVES)

__device__ __forceinline__ void p0_transpose_item(const float* W, int K, int N, bf16* WT, int row_base, int k0, int n0, LAS float* scr, int lane) {
#pragma unroll 8
    for (int i = 0; i < 32; ++i) { const int kk = 2 * i + (lane >> 5); scr[kk * 33 + (lane & 31)] = W[(size_t)(k0 + kk) * N + n0 + (lane & 31)]; }
    LDS_WAIT(); asm volatile("" ::: "memory");
    const int c = lane & 7;
#pragma unroll
    for (int j = 0; j < 4; ++j) { const int n = (lane >> 3) + 8 * j; const LAS float* s = scr + (8 * c) * 33 + n;
        v4u o; o.x = pk2(s[0 * 33], s[1 * 33]); o.y = pk2(s[2 * 33], s[3 * 33]); o.z = pk2(s[4 * 33], s[5 * 33]); o.w = pk2(s[6 * 33], s[7 * 33]);
        *(GAS v4u*)(WT + (size_t)(row_base + n) * K + k0 + 8 * c) = o; }
    LDS_WAIT(); asm volatile("" ::: "memory");
}
__device__ __forceinline__ void phase_p0(Frame& F) {
    LAS float* scr = (LAS float*)(F.lds + F.wave * 16384);
    const int gw = GW_ID(F), NGW = GW_N(F);
    bf16* WinT = (bf16*)(F.ws + WS_WIN); bf16* WoutT = (bf16*)(F.ws + WS_WOUT); bf16* W3T = (bf16*)(F.ws + WS_W3T);
    constexpr int I_IN = (DM / 64) * (INW / 32), I_OUT = (DM / 64) * (DM / 32), I_3 = 1 * (4096 / 32);
    constexpr int NITEMS = I_IN + I_OUT + I_3;
    for (int it = gw; it < NITEMS; it += NGW) {
        int r = it;
        if (r < I_IN) { const int nblk = INW / 32, kb = r / nblk, nb = r % nblk; p0_transpose_item(F.in[2], DM, INW, WinT, 32 * nb, 64 * kb, 32 * nb, scr, F.lane); continue; } r -= I_IN;
        if (r < I_OUT) { const int nblk = DM / 32, kb = r / nblk, nb = r % nblk; p0_transpose_item(F.in[17], DM, DM, WoutT, 32 * nb, 64 * kb, 32 * nb, scr, F.lane); continue; } r -= I_OUT;
        { const int nb = r; p0_transpose_item(F.in[12], FHID, 4096, W3T, 32 * nb, 0, 32 * nb, scr, F.lane); }
    }
    bf16* HB = (bf16*)(F.ws + WS_HB);
    const float* x = F.in[0]; const float* g = F.in[1];
    for (int m = gw; m < MT; m += NGW) {
        const GAS f32x4* xr = (const GAS f32x4*)(x + (size_t)m * DM) + F.lane;
        f32x4 v[8]; float s = 0.f;
#pragma unroll
        for (int j = 0; j < 8; ++j) { v[j] = xr[64 * j]; s += (v[j].x * v[j].x + v[j].y * v[j].y) + (v[j].z * v[j].z + v[j].w * v[j].w); }
        const float r = rsqrtf(wave_sum(s) * (1.f / DM) + EPS);
        GAS v2u* o8 = (GAS v2u*)(HB + (size_t)m * DM) + F.lane;
#pragma unroll
        for (int j = 0; j < 8; ++j) { const f32x4 gg = *((const GAS f32x4*)g + F.lane + 64 * j); v2u o; o.x = pk2(v[j].x * r * gg.x, v[j].y * r * gg.y); o.y = pk2(v[j].z * r * gg.z, v[j].w * r * gg.w); o8[64 * j] = o; }
    }
    float* HID2 = (float*)(F.ws + WS_HID2);
    LAS float* sc2 = (LAS float*)(F.lds + F.wave * 16384);
    const float* w1 = F.in[8]; const float* b1 = F.in[9]; const float* w2 = F.in[10]; const float* b2 = F.in[11]; const float* fr = F.in[13];
    for (int l = gw; l < SEQ; l += NGW) {
        const int j = F.lane;
        float zv = 0.f;
        if (j == 0) zv = (float)l / (float)(SEQ - 1);
        else if (j < FEMB) { const int k = (j - 1) & 15; const float f = 1e-4f + (float)k * ((15.0f - 1e-4f) / 15.0f); const float wv = 6.283185307179586f * (float)l / (float)SEQ; zv = (j <= 16) ? cosf(f * wv) : -sinf(f * wv); }
        sc2[j] = zv; LDS_WAIT(); asm volatile("" ::: "memory");
        float a = b1[j];
        for (int i = 0; i < FEMB; ++i) a += sc2[i] * w1[i * FHID + j];
        const float h1 = sinf(fr[j] * a);
        sc2[64 + j] = h1; LDS_WAIT(); asm volatile("" ::: "memory");
        float c = b2[j];
        for (int i = 0; i < FHID; ++i) c += sc2[64 + i] * w2[i * FHID + j];
        HID2[l * FHID + j] = sinf(fr[j] * c);
        LDS_WAIT(); asm volatile("" ::: "memory");
    }
}

__device__ __forceinline__ void phase_filters_naive(Frame& F) {
    const float* HID2 = (const float*)(F.ws + WS_HID2); const float* w3 = F.in[12]; const float* fbias = F.in[14]; bf16* TAPS = (bf16*)(F.ws + WS_TAPS);
    const size_t total = (size_t)SEQ * 4096;
    for (size_t i = (size_t)F.bid * NTHREADS + F.tid; i < total; i += (size_t)F.G * NTHREADS) {
        const int col = (int)(i & 4095), l = (int)(i >> 12);
        float a = 0.f;
        for (int k = 0; k < FHID; ++k) a += HID2[l * FHID + k] * w3[(size_t)k * 4096 + col];
        const int c = col & 1023, dir = (col >> 10) & 1, o = col >> 11;
        const float mind = -4.605170185988091f / 1.5f, maxd = -4.605170185988091f / 0.3f;
        const float delta = fabsf(mind + (maxd - mind) * ((float)c / 1023.0f));
        const float t = (float)l / (float)(SEQ - 1);
        float v = a * expf(-t * delta);
        bf16* tp = TAPS + ((size_t)c * 2 + o) * 8192;
        if (dir == 0) { if (l == 0) v += fbias[o * 1024 + c]; tp[4096 + l] = (bf16)f2bf(v); }
        else { if (l > 0) tp[4096 - l] = (bf16)f2bf(v); else tp[0] = 0; }
    }
}
__device__ __forceinline__ void phase_hyena_naive(Frame& F, int o) {
    const bf16* UC = (const bf16*)(F.ws + WS_UC); const bf16* TAPS = (const bf16*)(F.ws + WS_TAPS);
    bf16* Z1T = (bf16*)(F.ws + WS_Z1T); bf16* HYT = (bf16*)(F.ws + WS_HYT);
    const bf16* Zin = o == 0 ? UC + (size_t)2048 * MT : Z1T; const bf16* gate = UC + (size_t)(o * 1024) * MT; bf16* OUT = o == 0 ? Z1T : HYT;
    const size_t total = (size_t)1024 * MT;
    for (size_t i = (size_t)F.bid * NTHREADS + F.tid; i < total; i += (size_t)F.G * NTHREADS) {
        const int c = (int)(i >> 13), m = (int)(i & 8191), b = m >> 12, t = m & 4095;
        const bf16* z = Zin + (size_t)c * MT + b * SEQ; const bf16* tp = TAPS + ((size_t)c * 2 + o) * 8192 + 4096 + t;
        float acc = 0.f;
        for (int s = 0; s < SEQ; ++s) acc += bf2f(tp[-s]) * bf2f(z[s]);
        OUT[(size_t)c * MT + m] = (bf16)f2bf(bf2f(gate[(size_t)c * MT + m]) * acc);
    }
}
__device__ __forceinline__ void phase_attn_naive(Frame& F) {
    const bf16* QK = (const bf16*)(F.ws + WS_QK); const bf16* VT = (const bf16*)(F.ws + WS_XT); bf16* MIXED = (bf16*)(F.ws + WS_MIXED);
    const float* rpb = F.in[5]; const float* og = F.in[15];
    const int lane = F.lane;
    for (int w = GW_ID(F); w < MT * NH; w += GW_N(F)) {
        const int m = w >> 3, h = w & 7, b = m / SEQ, s = m % SEQ, r = s / GW, c = s % GW;
        int kr0 = r - WR / 2; kr0 = kr0 < 0 ? 0 : (kr0 > NROWS - WR ? NROWS - WR : kr0);
        int c0 = c - WC / 2; c0 = c0 < 0 ? 0 : (c0 > GW - WC ? GW - WC : c0);
        const bf16* q = QK + (size_t)m * 2048 + h * HD;
        const float q0 = bf2f(q[lane]), q1 = bf2f(q[lane + 64]);
        float mx = -INFINITY, l = 0.f, a0 = 0.f, a1 = 0.f;
        for (int i = 0; i < WR; ++i) for (int j = 0; j < WC; ++j) {
            const int kr = kr0 + i, kc = c0 + j; const size_t km = (size_t)b * SEQ + kr * GW + kc;
            const bf16* kp = QK + km * 2048 + 1024 + h * HD;
            const float d = wave_sum(q0 * bf2f(kp[lane]) + q1 * bf2f(kp[lane + 64]));
            const int dr = kr - r + WR - 1; int dc = kc - c + WC - 1; dc = dc < 0 ? 0 : (dc > 2 * WC - 2 ? 2 * WC - 2 : dc);
            const float sc = d * 0.08838834764831845f + rpb[(h * (2 * WR - 1) + dr) * (2 * WC - 1) + dc];
            const float mn = fmaxf(mx, sc), corr = __expf(mx - mn), pw = __expf(sc - mn);
            const float v0 = bf2f(VT[(size_t)(h * HD + lane) * MT + km]), v1 = bf2f(VT[(size_t)(h * HD + lane + 64) * MT + km]);
            l = l * corr + pw; a0 = a0 * corr + pw * v0; a1 = a1 * corr + pw * v1; mx = mn;
        }
        a0 /= l; a1 /= l;
        const float rr = rsqrtf(wave_sum(a0 * a0 + a1 * a1) * (1.f / HD) + EPS);
        bf16* o = MIXED + (size_t)m * DM + h * HD;
        o[lane] = (bf16)f2bf(a0 * rr * og[h * HD + lane]); o[lane + 64] = (bf16)f2bf(a1 * rr * og[h * HD + lane + 64]);
    }
}


typedef short bf16x8 __attribute__((ext_vector_type(8)));
typedef float f32x16 __attribute__((ext_vector_type(16)));
__device__ __forceinline__ void phase_filters(Frame& F) {
    const float* HID2 = (const float*)(F.ws + WS_HID2); const bf16* W3T = (const bf16*)(F.ws + WS_W3T); const float* fbias = F.in[14]; bf16* TAPS = (bf16*)(F.ws + WS_TAPS);
    const int n = F.lane & 31, hh = F.lane >> 5;
    for (int it = GW_ID(F); it < 128 * 128; it += GW_N(F)) {
        const int col0 = (it >> 7) * 32, l0 = (it & 127) * 32;
        f32x16 acc;
#pragma unroll
        for (int i = 0; i < 16; ++i) acc[i] = 0.f;
#pragma unroll
        for (int ks = 0; ks < 4; ++ks) {
            const bf16x8 a = *(const GAS bf16x8*)(W3T + (size_t)(col0 + n) * FHID + 16 * ks + 8 * hh);
            const GAS f32x4* hp = (const GAS f32x4*)(HID2 + (size_t)(l0 + n) * FHID + 16 * ks + 8 * hh);
            const f32x4 h0 = hp[0], h1 = hp[1];
            v4u bw; bw.x = pk2(h0.x, h0.y); bw.y = pk2(h0.z, h0.w); bw.z = pk2(h1.x, h1.y); bw.w = pk2(h1.z, h1.w);
            acc = __builtin_amdgcn_mfma_f32_32x32x16_bf16(a, __builtin_bit_cast(bf16x8, bw), acc, 0, 0, 0);
        }
        const int l = l0 + n; const float t = (float)l / (float)(SEQ - 1);
        const int dir = (col0 >> 10) & 1, o = col0 >> 11;
        const float mind = -4.605170185988091f / 1.5f, maxd = -4.605170185988091f / 0.3f;
#pragma unroll
        for (int i = 0; i < 16; ++i) {
            const int c = (col0 & 1023) + (i & 3) + 8 * (i >> 2) + 4 * hh;
            const float delta = fabsf(mind + (maxd - mind) * ((float)c / 1023.0f));
            float v = acc[i] * __expf(-t * delta);
            bf16* tp = TAPS + ((size_t)c * 2 + o) * 8192;
            if (dir == 0) { if (l == 0) v += fbias[o * 1024 + c]; tp[4096 + l] = (bf16)f2bf(v); }
            else { if (l > 0) tp[4096 - l] = (bf16)f2bf(v); else tp[0] = 0; }
        }
    }
}

constexpr int HY_TAPS_BYTES = 4 * 16384, HY_ZB_ENT = 6080, HY_ZB_BYTES = HY_ZB_ENT * 2;
__device__ __forceinline__ unsigned hy_zb_off(int idx0  ) { const int q = idx0 >> 3; return (unsigned)((q ^ ((q >> 4) & 3)) << 4); }
template <int MASK>
__device__ __forceinline__ void hy_loadB(bf16x8 (&bf)[4], const LAS unsigned char* zb0, int g, int b, int n, int hh) {
    const int q0 = 124 - 4 * n + 2 * g + hh;
    const LAS unsigned char* pm = zb0 + ((q0 ^ ((q0 >> 4) & 3)) << 4) - 6144 + b * HY_ZB_BYTES;
#pragma unroll
    for (int tau = 0; tau < 4; ++tau) if (MASK & (1 << tau)) bf[tau] = *(const LAS bf16x8*)(pm + 2048 * (3 - tau));
}
__device__ __forceinline__ void hy_loadA(unsigned (&d)[5], const LAS bf16* taps, int g, int n, int hh) {
    const volatile LAS unsigned* dp = (const volatile LAS unsigned*)taps + ((1 + 8 * hh + n) >> 1) + 8 * g;
#pragma unroll
    for (int i = 0; i < 5; ++i) d[i] = dp[i];
}
template <int MASK>
__device__ __forceinline__ void hy_mma(f32x16 (&acc)[4], const bf16x8 a, const bf16x8 (&bf)[4]) {
#pragma unroll
    for (int tau = 0; tau < 4; ++tau) if (MASK & (1 << tau)) acc[tau] = __builtin_amdgcn_mfma_f32_32x32x16_bf16(a, bf[tau], acc[tau], 0, 0, 0);
}
#define HY_ALIGN(a, d) do { v4u aw_; aw_.x = __builtin_amdgcn_alignbyte(d[1], d[0], sh); aw_.y = __builtin_amdgcn_alignbyte(d[2], d[1], sh); aw_.z = __builtin_amdgcn_alignbyte(d[3], d[2], sh); aw_.w = __builtin_amdgcn_alignbyte(d[4], d[3], sh); a = __builtin_bit_cast(bf16x8, aw_); } while (0)
template <int MASK>
__device__ __forceinline__ void hy_segment(f32x16 (&acc)[2][4], const LAS bf16* taps, const LAS unsigned char* zb0, int g0, int g1, int n, int hh) {
    const unsigned sh = (n & 1) ? 0u : 2u;
    unsigned d[5]; bf16x8 a, a0[4], a1[4], b0[4], b1[4];
    hy_loadA(d, taps, g0, n, hh); hy_loadB<MASK>(a0, zb0, g0, 0, n, hh); hy_loadB<MASK>(a1, zb0, g0, 1, n, hh);
#define HY_INTERLEAVE() do { __builtin_amdgcn_sched_group_barrier(0x2, 4, 0); _Pragma("unroll") for (int i_ = 0; i_ < 8; ++i_) { __builtin_amdgcn_sched_group_barrier(0x8, 1, 0); __builtin_amdgcn_sched_group_barrier(0x100, 2, 0); __builtin_amdgcn_sched_group_barrier(0x2, 2, 0); } } while (0)
#pragma unroll 1
    for (int g = g0; g < g1; g += 2) {
        HY_ALIGN(a, d);
        hy_loadA(d, taps, g + 1, n, hh); hy_loadB<MASK>(b0, zb0, g + 1, 0, n, hh); hy_loadB<MASK>(b1, zb0, g + 1, 1, n, hh);
        hy_mma<MASK>(acc[0], a, a0); hy_mma<MASK>(acc[1], a, a1);
        HY_INTERLEAVE(); __builtin_amdgcn_sched_barrier(0);
        HY_ALIGN(a, d);
        hy_loadA(d, taps, g + 2, n, hh); hy_loadB<MASK>(a0, zb0, g + 2, 0, n, hh); hy_loadB<MASK>(a1, zb0, g + 2, 1, n, hh);
        hy_mma<MASK>(acc[0], a, b0); hy_mma<MASK>(acc[1], a, b1);
        HY_INTERLEAVE(); __builtin_amdgcn_sched_barrier(0);
    }
}
__device__ __forceinline__ void hy_stage_taps(Frame& F, int c0, int o) {
    const bf16* TAPS = (const bf16*)(F.ws + WS_TAPS);
    int tid = F.tid; asm volatile("" : "+v"(tid));
#pragma unroll
    for (int j = 0; j < 8; ++j) { const int ch = tid + NTHREADS * j, ci = ch >> 10, w = ch & 1023;
        *((LAS v4u*)(F.lds) + ch) = *((const GAS v4u*)(TAPS + ((size_t)(c0 + ci) * 2 + o) * 8192) + w); }
}
__device__ __forceinline__ void conv_item64(const float* W, int N, bf16* WTe, int row_base, int k0, int n0, int lane) {
    const GAS float* src = (const GAS float*)(W + (size_t)k0 * N + n0 + lane);
    float v[64];
#pragma unroll
    for (int kk = 0; kk < 64; ++kk) v[kk] = src[(size_t)kk * N];
    GAS v4u* dst = (GAS v4u*)WTe + (size_t)(k0 >> 3) * 2048 + row_base + lane;
#pragma unroll
    for (int j = 0; j < 8; ++j) { v4u o; o.x = pk2(v[8 * j], v[8 * j + 1]); o.y = pk2(v[8 * j + 2], v[8 * j + 3]); o.z = pk2(v[8 * j + 4], v[8 * j + 5]); o.w = pk2(v[8 * j + 6], v[8 * j + 7]); dst[(size_t)j * 2048] = o; }
}
constexpr int MOE_ITEMS_GU = 2 * NE * 32 * 16, MOE_ITEMS_D = NE * 16 * 32, MOE_ITEMS = MOE_ITEMS_GU + MOE_ITEMS_D;
#ifndef MOE_P0_ITEMS
#define MOE_P0_ITEMS 0
#endif
constexpr int MOE_HELP_ITEMS = MOE_ITEMS - MOE_P0_ITEMS;
__device__ __forceinline__ void moe_conv_item(Frame& F, int it) {
    bf16* WguT = (bf16*)(F.ws + WS_WGU); bf16* WdT = (bf16*)(F.ws + WS_WD);
    if (it < MOE_ITEMS_GU) { const int which = it >> 13, e = (it >> 9) & 15, kb = (it >> 4) & 31, nb = it & 15, f0 = 64 * nb;
        const float* W = (which ? F.in[21] : F.in[20]) + (size_t)e * DM * FF;
        conv_item64(W, FF, WguT + (size_t)e * 2048 * DM, (f0 >> 7) * 256 + which * 128 + (f0 & 127), 64 * kb, f0, F.lane);
    } else { const int r = it - MOE_ITEMS_GU, e = r >> 9, kb = (r >> 5) & 15, nb = r & 31;
        conv_item64(F.in[22] + (size_t)e * FF * DM, DM, WdT + (size_t)e * 2048 * FF, 64 * nb, 64 * kb, 64 * nb, F.lane); }
}
__device__ __forceinline__ void phase_hyena(Frame& F) {
    const bf16* UC = (const bf16*)(F.ws + WS_UC); bf16* HYT = (bf16*)(F.ws + WS_HYT);
    const int n = F.lane & 31, hh = F.lane >> 5;
    const bool compute = F.wave < 4;
    const int nhelp = F.G * 4, hw = F.bid * 4 + (F.wave - 4);
    int sec = 0;
    for (int cg = F.bid; cg < 256; cg += F.G) {
        const int c0 = cg * 4;
        __syncthreads();
        hy_stage_taps(F, c0, 0);
        {
          const int ci = F.wave >> 1, b = F.wave & 1; LAS unsigned char* zb = F.lds + HY_TAPS_BYTES + F.wave * HY_ZB_BYTES;
          const bf16* zsrc = UC + (size_t)(2048 + c0 + ci) * MT + b * SEQ;
#pragma unroll
          for (int j = 0; j < 8; ++j) { const int u = F.lane + 64 * j; const v4u w = *((const GAS v4u*)zsrc + u);
              v4u r; r.x = (w.w >> 16) | (w.w << 16); r.y = (w.z >> 16) | (w.z << 16); r.z = (w.y >> 16) | (w.y << 16); r.w = (w.x >> 16) | (w.x << 16);
              *(LAS v4u*)(zb + hy_zb_off(8 * (635 - u))) = r; }
          const v4u zero = {0u, 0u, 0u, 0u};
          for (int q = F.lane; q < 124; q += 64) { *(LAS v4u*)(zb + hy_zb_off(8 * q)) = zero; *(LAS v4u*)(zb + hy_zb_off(8 * (636 + q))) = zero; } }
        __syncthreads();
#pragma unroll 1
        for (int o = 0; o < 2; ++o) {
            if (compute) {
                const int ci = F.wave, c = c0 + ci;
                const LAS bf16* taps = (const LAS bf16*)(F.lds + ci * 16384);
                LAS unsigned char* zb0 = F.lds + HY_TAPS_BYTES + (2 * ci) * HY_ZB_BYTES;
                f32x16 acc[2][4];
#pragma unroll
                for (int b = 0; b < 2; ++b)
#pragma unroll
                    for (int tau = 0; tau < 4; ++tau)
#pragma unroll
                        for (int i = 0; i < 16; ++i) acc[b][tau][i] = 0.f;
                hy_segment<1>(acc, taps, zb0, 0, 64, n, hh);
                hy_segment<3>(acc, taps, zb0, 64, 128, n, hh);
                hy_segment<7>(acc, taps, zb0, 128, 192, n, hh);
                hy_segment<15>(acc, taps, zb0, 192, 318, n, hh);
                hy_segment<14>(acc, taps, zb0, 318, 382, n, hh);
                hy_segment<12>(acc, taps, zb0, 382, 446, n, hh);
                hy_segment<8>(acc, taps, zb0, 446, 510, n, hh);
                LDS_WAIT();
                int n2 = n, h2 = hh; asm volatile("" : "+v"(n2), "+v"(h2));
#pragma unroll
                for (int b = 0; b < 2; ++b) {
                    const bf16* gate = UC + (size_t)(o * 1024 + c) * MT + b * SEQ;
                    LAS unsigned char* zb = zb0 + b * HY_ZB_BYTES; bf16* outp = HYT + (size_t)c * MT + b * SEQ;
#pragma unroll
                    for (int tau = 0; tau < 4; ++tau) { asm volatile("" ::: "memory");
#pragma unroll
                        for (int rg = 0; rg < 4; ++rg) { const int t0 = 1024 * tau + 32 * n2 + 8 * rg + 4 * h2;
                            const v2u gw = *(const GAS v2u*)(gate + t0);
                            const float z0 = bflo(gw.x) * acc[b][tau][4 * rg + 0], z1 = bfhi(gw.x) * acc[b][tau][4 * rg + 1], z2 = bflo(gw.y) * acc[b][tau][4 * rg + 2], z3 = bfhi(gw.y) * acc[b][tau][4 * rg + 3];
                            if (o == 0) { v2u w; w.x = pk2(z3, z2); w.y = pk2(z1, z0);
                                *(LAS v2u*)(zb + hy_zb_off(8 * (635 - (t0 >> 3))) + (h2 ? 0 : 8)) = w; }
                            else { v2u w; w.x = pk2(z0, z1); w.y = pk2(z2, z3); *(GAS v2u*)(outp + t0) = w; } } }
                }
            } else {
                const int lo_it = MOE_P0_ITEMS + sec * (MOE_HELP_ITEMS / 2), hi_it = lo_it + MOE_HELP_ITEMS / 2;
                if (sec < 2) for (int it = lo_it + hw; it < hi_it; it += nhelp) moe_conv_item(F, it);
            }
            ++sec;
            if (o == 0) {
                __syncthreads();
                hy_stage_taps(F, c0, 1);
                __syncthreads();
            }
        }
    }
    for (; sec < 2; ++sec) if (!compute) { const int lo_it = MOE_P0_ITEMS + sec * (MOE_HELP_ITEMS / 2), hi_it = lo_it + MOE_HELP_ITEMS / 2; for (int it = lo_it + hw; it < hi_it; it += nhelp) moe_conv_item(F, it); }
    __syncthreads();
}

__device__ __forceinline__ void phase_attn(Frame& F) {
    const bf16* QK = (const bf16*)(F.ws + WS_QK); const bf16* VT = (const bf16*)(F.ws + WS_XT); bf16* MIXED = (bf16*)(F.ws + WS_MIXED);
    const float* rpb = F.in[5]; const float* og = F.in[15];
    LAS float* rp = (LAS float*)(F.lds + F.wave * 2048);
    const int n = F.lane & 31, hh = F.lane >> 5;
    for (int task = GW_ID(F); task < NB * NH * NROWS * 2; task += GW_N(F)) {
        const int wq = task & 1, r = (task >> 1) & 63, h = (task >> 7) & 7, b = task >> 10;
        for (int i = F.lane; i < 15 * 31; i += 64) rp[i] = rpb[h * 465 + i];
        const int mq = b * SEQ + r * GW + 32 * wq + n, qc = 32 * wq + n;
        int c0 = qc - WC / 2; c0 = c0 < 0 ? 0 : (c0 > GW - WC ? GW - WC : c0);
        int kr0 = r - WR / 2; kr0 = kr0 < 0 ? 0 : (kr0 > NROWS - WR ? NROWS - WR : kr0);
        bf16x8 qf[8];
#pragma unroll
        for (int ks = 0; ks < 8; ++ks) qf[ks] = *(const GAS bf16x8*)(QK + (size_t)mq * 2048 + h * HD + 16 * ks + 8 * hh);
        f32x16 O[4];
#pragma unroll
        for (int dt = 0; dt < 4; ++dt)
#pragma unroll
            for (int i = 0; i < 16; ++i) O[dt][i] = 0.f;
        float lsum = 0.f;
        LDS_WAIT();
#pragma unroll 1
        for (int tile = 0; tile < 16; ++tile) {
            const int kr = kr0 + (tile >> 1), kt = tile & 1, dr = kr - r + WR - 1;
            const int mk0 = b * SEQ + kr * GW + 32 * kt;
            f32x16 S;
#pragma unroll
            for (int i = 0; i < 16; ++i) S[i] = 0.f;
#pragma unroll
            for (int ks = 0; ks < 8; ++ks) { const bf16x8 kf = *(const GAS bf16x8*)(QK + (size_t)(mk0 + n) * 2048 + 1024 + h * HD + 16 * ks + 8 * hh);
                S = __builtin_amdgcn_mfma_f32_32x32x16_bf16(kf, qf[ks], S, 0, 0, 0); }
            float p[16];
#pragma unroll
            for (int i = 0; i < 16; ++i) { const int kc = 32 * kt + (i & 3) + 8 * (i >> 2) + 4 * hh; const bool valid = (kc >= c0) && (kc < c0 + WC);
                int dc = kc - qc + WC - 1; dc = dc < 0 ? 0 : (dc > 2 * WC - 2 ? 2 * WC - 2 : dc);
                const float e = __expf(S[i] * 0.08838834764831845f + rp[dr * 31 + dc]); p[i] = valid ? e : 0.f; lsum += p[i]; }
            v4u pw0, pw1;
            pw0.x = pk2(p[0], p[1]); pw0.y = pk2(p[2], p[3]); pw0.z = pk2(p[4], p[5]); pw0.w = pk2(p[6], p[7]);
            pw1.x = pk2(p[8], p[9]); pw1.y = pk2(p[10], p[11]); pw1.z = pk2(p[12], p[13]); pw1.w = pk2(p[14], p[15]);
            const bf16x8 pf0 = __builtin_bit_cast(bf16x8, pw0), pf1 = __builtin_bit_cast(bf16x8, pw1);
#pragma unroll
            for (int dt = 0; dt < 4; ++dt) {
                const bf16* vrow = VT + (size_t)(h * HD + 32 * dt + n) * MT + mk0 + 4 * hh;
                const v2u a0 = *(const GAS v2u*)(vrow), a1 = *(const GAS v2u*)(vrow + 8), a2 = *(const GAS v2u*)(vrow + 16), a3 = *(const GAS v2u*)(vrow + 24);
                v4u f0, f1; f0.x = a0.x; f0.y = a0.y; f0.z = a1.x; f0.w = a1.y; f1.x = a2.x; f1.y = a2.y; f1.z = a3.x; f1.w = a3.y;
                O[dt] = __builtin_amdgcn_mfma_f32_32x32x16_bf16(__builtin_bit_cast(bf16x8, f0), pf0, O[dt], 0, 0, 0);
                O[dt] = __builtin_amdgcn_mfma_f32_32x32x16_bf16(__builtin_bit_cast(bf16x8, f1), pf1, O[dt], 0, 0, 0);
            }
        }
        lsum += __shfl_xor(lsum, 32);
        const float il = 1.f / lsum;
        float ss = 0.f;
#pragma unroll
        for (int dt = 0; dt < 4; ++dt)
#pragma unroll
            for (int i = 0; i < 16; ++i) { O[dt][i] *= il; ss += O[dt][i] * O[dt][i]; }
        ss += __shfl_xor(ss, 32);
        const float rr = rsqrtf(ss * (1.f / HD) + EPS);
        bf16* orow = MIXED + (size_t)mq * DM + h * HD;
#pragma unroll
        for (int dt = 0; dt < 4; ++dt)
#pragma unroll
            for (int rg = 0; rg < 4; ++rg) { const int d = 32 * dt + 8 * rg + 4 * hh; const f32x4 gg = *(const GAS f32x4*)(og + h * HD + d);
                v2u w; w.x = pk2(O[dt][4 * rg + 0] * rr * gg.x, O[dt][4 * rg + 1] * rr * gg.y); w.y = pk2(O[dt][4 * rg + 2] * rr * gg.z, O[dt][4 * rg + 3] * rr * gg.w);
                *(GAS v2u*)(orow + d) = w; }
        LDS_WAIT();
    }
}


constexpr int AT_KBYTES = 16384, AT_VPITCH = 136, AT_VBYTES = 128 * AT_VPITCH, AT_STAGE = AT_KBYTES + AT_VBYTES, AT_RP_OFF = 2 * AT_STAGE;
__device__ __forceinline__ void phase_attn2(Frame& F) {
    const bf16* QK = (const bf16*)(F.ws + WS_QK); const bf16* VT = (const bf16*)(F.ws + WS_XT); bf16* MIXED = (bf16*)(F.ws + WS_MIXED);
    const float* rpb = F.in[5]; const float* og = F.in[15];
    LAS float* rp = (LAS float*)(F.lds + AT_RP_OFF + F.wave * 2048);
    const int n = F.lane & 31, hh = F.lane >> 5;
    for (int unit = F.bid; unit < NB * NH * 16; unit += F.G) {
        const int rq = unit & 15, h = (unit >> 4) & 7, b = unit >> 7, r0 = 4 * rq;
        const int r = r0 + (F.wave >> 1), wq = F.wave & 1;
        int kmin = r0 - WR / 2; kmin = kmin < 0 ? 0 : (kmin > NROWS - WR ? NROWS - WR : kmin);
        int kmax = r0 + 3 - WR / 2; kmax = (kmax < 0 ? 0 : (kmax > NROWS - WR ? NROWS - WR : kmax)) + WR - 1;
        int kr0 = r - WR / 2; kr0 = kr0 < 0 ? 0 : (kr0 > NROWS - WR ? NROWS - WR : kr0);
        const int nrows = kmax - kmin + 1;
        __syncthreads();
        for (int i = F.lane; i < 15 * 31; i += 64) rp[i] = rpb[h * 465 + i];
        const int mq = b * SEQ + r * GW + 32 * wq + n, qc = 32 * wq + n;
        int c0 = qc - WC / 2; c0 = c0 < 0 ? 0 : (c0 > GW - WC ? GW - WC : c0);
        bf16x8 qf[8];
#pragma unroll
        for (int ks = 0; ks < 8; ++ks) qf[ks] = *(const GAS bf16x8*)(QK + (size_t)mq * 2048 + h * HD + 16 * ks + 8 * hh);
        f32x16 O[4];
#pragma unroll
        for (int dt = 0; dt < 4; ++dt)
#pragma unroll
            for (int i = 0; i < 16; ++i) O[dt][i] = 0.f;
        float lsum = 0.f;
        v4u sk[2], sv[2];
        auto gload = [&](int kr) {
#pragma unroll
            for (int j = 0; j < 2; ++j) { const int id = F.tid + 512 * j;
                sk[j] = *(const GAS v4u*)(QK + (size_t)(b * SEQ + kr * GW + (id >> 4)) * 2048 + 1024 + h * HD + 8 * (id & 15));
                sv[j] = *(const GAS v4u*)(VT + (size_t)(h * HD + (id >> 3)) * MT + b * SEQ + kr * GW + 8 * (id & 7)); }
        };
        auto lstore = [&](int buf) {
            LAS unsigned char* kb = F.lds + buf * AT_STAGE; LAS unsigned char* vb = kb + AT_KBYTES;
#pragma unroll
            for (int j = 0; j < 2; ++j) { const int id = F.tid + 512 * j; const int key = id >> 4, c = id & 15;
                *(LAS v4u*)(kb + key * 256 + ((c ^ (key & 15)) << 4)) = sk[j];
                const int d = id >> 3, cv = id & 7; LAS v2u* vp = (LAS v2u*)(vb + d * AT_VPITCH + cv * 16);
                v2u lo, hi; lo.x = sv[j].x; lo.y = sv[j].y; hi.x = sv[j].z; hi.y = sv[j].w; vp[0] = lo; vp[1] = hi; }
        };
        gload(kmin); lstore(0);
        __syncthreads();
#pragma unroll 1
        for (int j = 0; j < nrows; ++j) {
            const int kr = kmin + j, buf = j & 1;
            if (j + 1 < nrows) gload(kr + 1);
            if (kr >= kr0 && kr < kr0 + WR) {
                const LAS unsigned char* kb = F.lds + buf * AT_STAGE; const LAS unsigned char* vb = kb + AT_KBYTES;
                const int dr = kr - r + WR - 1;
#pragma unroll
                for (int kt = 0; kt < 2; ++kt) {
                    f32x16 S;
#pragma unroll
                    for (int i = 0; i < 16; ++i) S[i] = 0.f;
                    const int key = 32 * kt + n;
#pragma unroll
                    for (int ks = 0; ks < 8; ++ks) { const bf16x8 kf = *(const LAS bf16x8*)(kb + key * 256 + (((2 * ks + hh) ^ (key & 15)) << 4));
                        S = __builtin_amdgcn_mfma_f32_32x32x16_bf16(kf, qf[ks], S, 0, 0, 0); }
                    float p[16];
#pragma unroll
                    for (int i = 0; i < 16; ++i) { const int kc = 32 * kt + (i & 3) + 8 * (i >> 2) + 4 * hh; const bool valid = (kc >= c0) && (kc < c0 + WC);
                        int dc = kc - qc + WC - 1; dc = dc < 0 ? 0 : (dc > 2 * WC - 2 ? 2 * WC - 2 : dc);
                        const float e = __expf(S[i] * 0.08838834764831845f + rp[dr * 31 + dc]); p[i] = valid ? e : 0.f; lsum += p[i]; }
                    v4u pw0, pw1;
                    pw0.x = pk2(p[0], p[1]); pw0.y = pk2(p[2], p[3]); pw0.z = pk2(p[4], p[5]); pw0.w = pk2(p[6], p[7]);
                    pw1.x = pk2(p[8], p[9]); pw1.y = pk2(p[10], p[11]); pw1.z = pk2(p[12], p[13]); pw1.w = pk2(p[14], p[15]);
                    const bf16x8 pf0 = __builtin_bit_cast(bf16x8, pw0), pf1 = __builtin_bit_cast(bf16x8, pw1);
#pragma unroll
                    for (int dt = 0; dt < 4; ++dt) {
                        const LAS unsigned char* vrow = vb + (32 * dt + n) * AT_VPITCH + (32 * kt + 4 * hh) * 2;
                        const v2u a0 = *(const LAS v2u*)(vrow), a1 = *(const LAS v2u*)(vrow + 16), a2 = *(const LAS v2u*)(vrow + 32), a3 = *(const LAS v2u*)(vrow + 48);
                        v4u f0, f1; f0.x = a0.x; f0.y = a0.y; f0.z = a1.x; f0.w = a1.y; f1.x = a2.x; f1.y = a2.y; f1.z = a3.x; f1.w = a3.y;
                        O[dt] = __builtin_amdgcn_mfma_f32_32x32x16_bf16(__builtin_bit_cast(bf16x8, f0), pf0, O[dt], 0, 0, 0);
                        O[dt] = __builtin_amdgcn_mfma_f32_32x32x16_bf16(__builtin_bit_cast(bf16x8, f1), pf1, O[dt], 0, 0, 0);
                    }
                }
            }
            if (j + 1 < nrows) lstore(buf ^ 1);
            __syncthreads();
        }
        lsum += __shfl_xor(lsum, 32);
        const float il = 1.f / lsum;
        float ss = 0.f;
#pragma unroll
        for (int dt = 0; dt < 4; ++dt)
#pragma unroll
            for (int i = 0; i < 16; ++i) { O[dt][i] *= il; ss += O[dt][i] * O[dt][i]; }
        ss += __shfl_xor(ss, 32);
        const float rr = rsqrtf(ss * (1.f / HD) + EPS);
        bf16* orow = MIXED + (size_t)mq * DM + h * HD;
#pragma unroll
        for (int dt = 0; dt < 4; ++dt)
#pragma unroll
            for (int rg = 0; rg < 4; ++rg) { const int d = 32 * dt + 8 * rg + 4 * hh; const f32x4 gg = *(const GAS f32x4*)(og + h * HD + d);
                v2u w; w.x = pk2(O[dt][4 * rg + 0] * rr * gg.x, O[dt][4 * rg + 1] * rr * gg.y); w.y = pk2(O[dt][4 * rg + 2] * rr * gg.z, O[dt][4 * rg + 3] * rr * gg.w);
                *(GAS v2u*)(orow + d) = w; }
    }
    __syncthreads();
}

__device__ __forceinline__ void phase_p15(Frame& F) {
    bf16* QK = (bf16*)(F.ws + WS_QK); const float* qg = F.in[3]; const float* kg = F.in[4];
    for (int m = GW_ID(F); m < MT; m += GW_N(F)) {
        GAS v4u* rowp = (GAS v4u*)(QK + (size_t)m * 2048) + F.lane;
#pragma unroll
        for (int j = 0; j < 4; ++j) {
            v4u w = rowp[64 * j];
            float f[8] = {bflo(w.x), bfhi(w.x), bflo(w.y), bfhi(w.y), bflo(w.z), bfhi(w.z), bflo(w.w), bfhi(w.w)};
            float ss = 0.f;
#pragma unroll
            for (int e = 0; e < 8; ++e) ss += f[e] * f[e];
            ss += __shfl_xor(ss, 1); ss += __shfl_xor(ss, 2); ss += __shfl_xor(ss, 4); ss += __shfl_xor(ss, 8);
            const float r = rsqrtf(ss * (1.f / HD) + EPS);
            const int col = 512 * j + 8 * F.lane, d = col & 127; const float* g = (col < 1024 ? qg : kg) + d;
#pragma unroll
            for (int e = 0; e < 8; ++e) f[e] = f[e] * r * g[e];
            w.x = pk2(f[0], f[1]); w.y = pk2(f[2], f[3]); w.z = pk2(f[4], f[5]); w.w = pk2(f[6], f[7]);
            rowp[64 * j] = w;
        }
    }
    const bf16* XT = (const bf16*)(F.ws + WS_XT) + (size_t)1024 * MT; bf16* UC = (bf16*)(F.ws + WS_UC);
    const float* cw = F.in[6]; const float* cb = F.in[7];
    const size_t nchunks = (size_t)3072 * MT / 8;
    for (size_t i = (size_t)F.bid * NTHREADS + F.tid; i < nchunks; i += (size_t)F.G * NTHREADS) {
        const int ch = (int)(i >> 10), m0 = (int)(i & 1023) * 8, s0 = m0 & 4095;
        const bf16* up = XT + (size_t)ch * MT + m0;
        const v4u w = *(const GAS v4u*)up;
        float f[10];
        f[1] = bflo(w.x); f[2] = bfhi(w.x); f[3] = bflo(w.y); f[4] = bfhi(w.y); f[5] = bflo(w.z); f[6] = bfhi(w.z); f[7] = bflo(w.w); f[8] = bfhi(w.w);
        f[0] = s0 > 0 ? bf2f(up[-1]) : 0.f; f[9] = s0 + 8 < SEQ ? bf2f(up[8]) : 0.f;
        const float w0 = cw[ch], w1 = cw[3072 + ch], w2 = cw[6144 + ch], bb = cb[ch];
        float o[8];
#pragma unroll
        for (int e = 0; e < 8; ++e) o[e] = bb + w0 * f[e] + w1 * f[e + 1] + w2 * f[e + 2];
        v4u ov; ov.x = pk2(o[0], o[1]); ov.y = pk2(o[2], o[3]); ov.z = pk2(o[4], o[5]); ov.w = pk2(o[6], o[7]);
        *(GAS v4u*)(UC + (size_t)ch * MT + m0) = ov;
    }
}
__device__ __forceinline__ void phase_p25(Frame& F) {
    const bf16* HYT = (const bf16*)(F.ws + WS_HYT); bf16* MIXED = (bf16*)(F.ws + WS_MIXED); const float* hg = F.in[16];
    LAS float* tile = (LAS float*)F.lds;
    LAS float* rs = (LAS float*)(F.lds + 128 * 65 * 4);
    for (int it = F.bid; it < 8 * (MT / 64); it += F.G) {
        const int gi = it & 7, m0 = (it >> 3) * 64;
        { const int ch = F.tid >> 2, t0 = (F.tid & 3) * 16; const bf16* p = HYT + (size_t)(gi * 128 + ch) * MT + m0 + t0;
          const v4u a = *(const GAS v4u*)p, b = *(const GAS v4u*)(p + 8);
          LAS float* d = tile + ch * 65 + t0;
          d[0] = bflo(a.x); d[1] = bfhi(a.x); d[2] = bflo(a.y); d[3] = bfhi(a.y); d[4] = bflo(a.z); d[5] = bfhi(a.z); d[6] = bflo(a.w); d[7] = bfhi(a.w);
          d[8] = bflo(b.x); d[9] = bfhi(b.x); d[10] = bflo(b.y); d[11] = bfhi(b.y); d[12] = bflo(b.z); d[13] = bfhi(b.z); d[14] = bflo(b.w); d[15] = bfhi(b.w); }
        __syncthreads();
        {
          const int t = F.tid >> 3, c0 = (F.tid & 7) * 16; float ss = 0.f;
#pragma unroll
          for (int c = 0; c < 16; ++c) { const float v = tile[(c0 + c) * 65 + t]; ss += v * v; }
          ss += __shfl_xor(ss, 1); ss += __shfl_xor(ss, 2); ss += __shfl_xor(ss, 4);
          if ((F.tid & 7) == 0) rs[t] = rsqrtf(ss * (1.f / 128) + EPS); }
        __syncthreads();
        {
          const int t = F.tid >> 3, c0 = (F.tid & 7) * 16; const float r = rs[t]; float o[16];
#pragma unroll
          for (int c = 0; c < 16; ++c) o[c] = tile[(c0 + c) * 65 + t] * r * hg[gi * 128 + c0 + c];
          v4u a, b; a.x = pk2(o[0], o[1]); a.y = pk2(o[2], o[3]); a.z = pk2(o[4], o[5]); a.w = pk2(o[6], o[7]); b.x = pk2(o[8], o[9]); b.y = pk2(o[10], o[11]); b.z = pk2(o[12], o[13]); b.w = pk2(o[14], o[15]);
          bf16* q = MIXED + (size_t)(m0 + t) * DM + AW + gi * 128 + c0; *(GAS v4u*)q = a; *(GAS v4u*)(q + 8) = b; }
        __syncthreads();
    }
}
__device__ __forceinline__ void phase_p35(Frame& F) {
    LAS float* wrT = (LAS float*)F.lds;
    const float* wr = F.in[19]; const float* g = F.in[18];
    for (int i = F.tid; i < DM * NE; i += NTHREADS) { const int d = i >> 4, e = i & 15; wrT[e * DM + d] = wr[i]; }
    __syncthreads();
    bf16* HB = (bf16*)(F.ws + WS_HB); float* AFF = (float*)(F.ws + WS_AFF); const float* x1 = F.out;
    for (int m = GW_ID(F); m < MT; m += GW_N(F)) {
        const GAS f32x4* xr = (const GAS f32x4*)(x1 + (size_t)m * DM) + F.lane;
        f32x4 v[8]; float s = 0.f;
#pragma unroll
        for (int j = 0; j < 8; ++j) { v[j] = xr[64 * j]; s += (v[j].x * v[j].x + v[j].y * v[j].y) + (v[j].z * v[j].z + v[j].w * v[j].w); }
        const float r = rsqrtf(wave_sum(s) * (1.f / DM) + EPS);
        GAS v2u* o8 = (GAS v2u*)(HB + (size_t)m * DM) + F.lane;
#pragma unroll
        for (int j = 0; j < 8; ++j) { const f32x4 gg = *((const GAS f32x4*)g + F.lane + 64 * j); v[j].x *= r * gg.x; v[j].y *= r * gg.y; v[j].z *= r * gg.z; v[j].w *= r * gg.w;
            v2u o; o.x = pk2(v[j].x, v[j].y); o.y = pk2(v[j].z, v[j].w); o8[64 * j] = o; }
        float mine = 0.f;
#pragma unroll 1
        for (int e = 0; e < NE; ++e) { float a = 0.f;
#pragma unroll
            for (int j = 0; j < 8; ++j) { const f32x4 w = *((const LAS f32x4*)(wrT + e * DM) + F.lane + 64 * j); a += (v[j].x * w.x + v[j].y * w.y) + (v[j].z * w.z + v[j].w * w.w); }
            a = wave_sum(a); mine = (F.lane == e) ? a : mine; }
        float mx = mine;
        mx = fmaxf(mx, __shfl_xor(mx, 1)); mx = fmaxf(mx, __shfl_xor(mx, 2)); mx = fmaxf(mx, __shfl_xor(mx, 4)); mx = fmaxf(mx, __shfl_xor(mx, 8));
        const float ex = expf(mine - mx); float den = ex;
        den += __shfl_xor(den, 1); den += __shfl_xor(den, 2); den += __shfl_xor(den, 4); den += __shfl_xor(den, 8);
        const int b = m / SEQ, sidx = m % SEQ;
        if (F.lane < NE) AFF[((size_t)b * NE + F.lane) * SEQ + sidx] = ex / den;
    }
    __syncthreads();
}
__device__ __forceinline__ void phase_p4(Frame& F) {
    LAS unsigned* key = (LAS unsigned*)F.lds;
    LAS unsigned* hist = (LAS unsigned*)(F.lds + 16384);
    LAS unsigned* wsum = (LAS unsigned*)(F.lds + 16384 + 1024);
    const float* AFF = (const float*)(F.ws + WS_AFF); int* IDX = (int*)(F.ws + WS_IDX); float* GATE = (float*)(F.ws + WS_GATE); int* SEL = (int*)(F.ws + WS_SEL);
    for (int be = F.bid; be < NB * NE; be += F.G) {
        const int b = be / NE, e = be % NE;
        __syncthreads();
        const GAS v4u* ap = (const GAS v4u*)(AFF + (size_t)be * SEQ);
        const v4u k0 = ap[2 * F.tid], k1 = ap[2 * F.tid + 1];
        unsigned kk[8] = {k0.x, k0.y, k0.z, k0.w, k1.x, k1.y, k1.z, k1.w};
        unsigned prefix = 0u, mask = 0u, remaining = CAP;
#pragma unroll 1
        for (int pass = 0; pass < 4; ++pass) {
            const int shift = 24 - 8 * pass;
            if (F.tid < 256) hist[F.tid] = 0u;
            __syncthreads();
#pragma unroll
            for (int i = 0; i < 8; ++i) if ((kk[i] & mask) == prefix) __hip_atomic_fetch_add(&hist[(kk[i] >> shift) & 255u], 1u, __ATOMIC_RELAXED, __HIP_MEMORY_SCOPE_WORKGROUP);
            __syncthreads();
            if (F.tid < 256) {
                unsigned above = 0u;
                for (int j = F.tid + 1; j < 256; ++j) above += hist[j];
                const unsigned mine = hist[F.tid];
                if (above < remaining && remaining <= above + mine) { wsum[8] = (unsigned)F.tid; wsum[9] = above; }
            }
            __syncthreads();
            const unsigned d = wsum[8], above = wsum[9];
            prefix |= d << shift; mask |= 255u << shift; remaining -= above;
            __syncthreads();
        }
        const unsigned thr = prefix;
        unsigned cnt = 0u;
#pragma unroll
        for (int i = 0; i < 8; ++i) cnt += (kk[i] > thr ? 0x10000u : 0u) + (kk[i] == thr ? 1u : 0u);
        unsigned incl = cnt;
#pragma unroll
        for (int o = 1; o < 64; o <<= 1) { const unsigned t = __shfl_up(incl, o); if (F.lane >= o) incl += t; }
        if (F.lane == 63) wsum[F.wave] = incl;
        __syncthreads();
        unsigned base = 0u;
        for (int w = 0; w < F.wave; ++w) base += wsum[w];
        unsigned run = base + incl - cnt;
#pragma unroll
        for (int i = 0; i < 8; ++i) {
            const unsigned gt_before = run >> 16, tie_before = run & 0xffffu;
            const bool isgt = kk[i] > thr, istie = kk[i] == thr;
            const bool sel = isgt || (istie && tie_before < remaining);
            const unsigned slot = gt_before + (tie_before < remaining ? tie_before : remaining);
            const int s = 8 * F.tid + i, m = b * SEQ + s;
            if (sel) { IDX[be * CAP + slot] = m; GATE[be * CAP + slot] = __builtin_bit_cast(float, kk[i]); }
            SEL[(size_t)m * NE + e] = sel ? (int)slot : -1;
            run += (isgt ? 0x10000u : 0u) + (istie ? 1u : 0u);
        }
    }
    __syncthreads();
}
__device__ __forceinline__ void phase_p7(Frame& F) {
    const int* SEL = (const int*)(F.ws + WS_SEL); const float* GATE = (const float*)(F.ws + WS_GATE); const bf16* YE = (const bf16*)(F.ws + WS_YE);
    for (int m = GW_ID(F); m < MT; m += GW_N(F)) {
        const int b = m / SEQ;
        GAS f32x4* orow = (GAS f32x4*)(F.out + (size_t)m * DM);
        f32x4 acc[8];
#pragma unroll
        for (int j = 0; j < 8; ++j) acc[j] = orow[2 * F.lane + (j & 1) + 128 * (j >> 1)];
        for (int e = 0; e < NE; ++e) { const int slot = SEL[(size_t)m * NE + e]; if (slot >= 0) {
            const GAS v4u* yr = (const GAS v4u*)(YE + (size_t)((b * NE + e) * CAP + slot) * DM) + F.lane;
#pragma unroll
            for (int jj = 0; jj < 4; ++jj) { const v4u w = yr[64 * jj];
                acc[2 * jj].x += bflo(w.x); acc[2 * jj].y += bfhi(w.x); acc[2 * jj].z += bflo(w.y); acc[2 * jj].w += bfhi(w.y);
                acc[2 * jj + 1].x += bflo(w.z); acc[2 * jj + 1].y += bfhi(w.z); acc[2 * jj + 1].z += bflo(w.w); acc[2 * jj + 1].w += bfhi(w.w); } } }
#pragma unroll
        for (int j = 0; j < 8; ++j) orow[2 * F.lane + (j & 1) + 128 * (j >> 1)] = acc[j];
    }
    (void)GATE;
}

struct Args { const float* in[23]; float* out; unsigned char* ws; int ph_lo, ph_hi; };
enum Phase { PH_P0 = 0, PH_G1, PH_FILT, PH_P15, PH_ATTN, PH_P25, PH_OUT, PH_P35, PH_P4, PH_UP, PH_DOWN, PH_P7, PH_COUNT };

__global__ void __launch_bounds__(NTHREADS, 2) mk_fwd(Args args) {
    extern __shared__ __attribute__((aligned(16))) unsigned char lds_raw[];
    Frame F;
    F.lds = (LAS unsigned char*)lds_raw;
    F.tid = threadIdx.x; F.lane = F.tid & 63; F.wave = __builtin_amdgcn_readfirstlane(F.tid >> 6); F.G = gridDim.x; F.bid = blockIdx.x;
#pragma unroll
    for (int i = 0; i < 23; ++i) F.in[i] = args.in[i];
    F.out = args.out; F.ws = args.ws;
    const int lo = args.ph_lo, hi = args.ph_hi;
#define IN(k) (lo <= (k) && (k) < hi)
#define REPS(k) for (int rep_ = 0; rep_ < ((k) == REP_PHASE ? REP_N : 1); ++rep_)
#if MK_N_LAUNCHES == 1
    { volatile LAS unsigned* misc = (volatile LAS unsigned*)(F.lds + LDS_MISC_OFF); if (F.tid < 16) misc[F.tid] = 0u; }
    __syncthreads();
    XcdBarrier bar = xcd_barrier_post((unsigned*)(F.ws + WS_CTL) + 4096, (volatile LAS unsigned*)(F.lds + LDS_MISC_OFF) + 8);
#define SEAM(k) do { if (IN(k) && IN((k) + 1)) xcd_barrier(bar); } while (0)
#else
#define SEAM(k) do { } while (0)
#endif
    if (IN(PH_P0)) REPS(PH_P0) { phase_p0(F); for (int it = GW_ID(F); it < MOE_P0_ITEMS; it += GW_N(F)) moe_conv_item(F, it); } SEAM(PH_P0);
    if (IN(PH_G1)) REPS(PH_G1) {
        __syncthreads();
        { pg8::DenseOrder S; S.init(F.ws + WS_HB, F.ws + WS_WIN, MT, 2048, DM, 0, F.G, F.bid);
          pg8::EpiBf16 E{(pg8::bf16_t*)(F.ws + WS_QK), 2048, 0, nullptr};
          pg8::gemm_phase<pg8::EpiBf16, pg8::DenseOrder, true>(F.lds, DM, S, E); }
        { pg8::DenseOrder S; S.init(F.ws + WS_HB, F.ws + WS_WIN, MT, 4096, DM, 8, F.G, F.bid);
          pg8::EpiTransBf16 E{(pg8::bf16_t*)(F.ws + WS_XT), MT, 8};
          pg8::gemm_phase<pg8::EpiTransBf16, pg8::DenseOrder, true>(F.lds, DM, S, E); }
    } SEAM(PH_G1);
    if (IN(PH_FILT)) REPS(PH_FILT) { phase_filters(F); } SEAM(PH_FILT);
    if (IN(PH_P15)) { phase_p15(F); } SEAM(PH_P15);
    if (IN(PH_ATTN)) { __syncthreads(); for (int rep_ = 0; rep_ < ((PH_ATTN == REP_PHASE && REP_SUB != 2) ? REP_N : 1); ++rep_) phase_hyena(F); for (int rep_ = 0; rep_ < ((PH_ATTN == REP_PHASE && REP_SUB != 1) ? REP_N : 1); ++rep_) phase_attn2(F); } SEAM(PH_ATTN);
    if (IN(PH_P25)) REPS(PH_P25) { __syncthreads(); phase_p25(F); } SEAM(PH_P25);
    if (IN(PH_OUT)) REPS(PH_OUT) {
        __syncthreads();
        pg8::DenseOrder S; S.init(F.ws + WS_MIXED, F.ws + WS_WOUT, MT, DM, DM, 0, F.G, F.bid);
        pg8::EpiResF32 E{F.in[0], F.out, DM};
        pg8::gemm_phase<pg8::EpiResF32, pg8::DenseOrder, false>(F.lds, DM, S, E);
    } SEAM(PH_OUT);
    if (IN(PH_P35)) REPS(PH_P35) { __syncthreads(); phase_p35(F); } SEAM(PH_P35);
    if (IN(PH_P4)) REPS(PH_P4) { __syncthreads(); phase_p4(F); } SEAM(PH_P4);
    if (IN(PH_UP)) REPS(PH_UP) {
        __syncthreads();
        pg8::MoeOrder S; S.init(F.ws + WS_HB, F.ws + WS_WGU, DM, F.G, F.bid, true);
        LAS int* ridx = (LAS int*)(F.lds + 131072);
        { const int* IDX = (const int*)(F.ws + WS_IDX); pg8::Unit u;
          for (int i = 0; S.next(i, u); ++i) if (F.tid < 256) ridx[i * 256 + F.tid] = IDX[u.g * CAP + u.pm * 256 + F.tid]; }
        __syncthreads();
        pg8::EpiSwiGLU E{(pg8::bf16_t*)(F.ws + WS_ACT)};
        pg8::gemm_phase<pg8::EpiSwiGLU, pg8::MoeOrder, true, true>(F.lds, DM, S, E, ridx);
    } SEAM(PH_UP);
    if (IN(PH_DOWN)) REPS(PH_DOWN) {
        __syncthreads();
        pg8::MoeOrder S; S.init(F.ws + WS_ACT, F.ws + WS_WD, FF, F.G, F.bid, false);
        pg8::EpiBf16 E{(pg8::bf16_t*)(F.ws + WS_YE), DM, 512, (const float*)(F.ws + WS_GATE)};
        pg8::gemm_phase<pg8::EpiBf16, pg8::MoeOrder, true>(F.lds, FF, S, E);
    } SEAM(PH_DOWN);
    if (IN(PH_P7)) { phase_p7(F); }
#undef IN
#undef SEAM
}

extern "C" void kernel_launch(void* const* d_in, const int* in_sizes, int n_in, void* d_out, int out_size, void* d_ws, size_t ws_size, hipStream_t stream) {
    static int grid = 0;
    if (grid == 0) {
        if (n_in != 23 || ws_size < WS_END) { fprintf(stderr, "kernel_launch: unexpected inputs (n_in %d, ws %zu)\n", n_in, ws_size); grid = -1; return; }
        if (hipFuncSetAttribute((const void*)mk_fwd, hipFuncAttributeMaxDynamicSharedMemorySize, LDS_BYTES) != hipSuccess) { fprintf(stderr, "kernel_launch: hipFuncSetAttribute failed\n"); grid = -1; return; }
        int dev = 0, cus = 0, per_cu = 0;
        hipGetDevice(&dev); hipDeviceGetAttribute(&cus, hipDeviceAttributeMultiprocessorCount, dev);
        hipOccupancyMaxActiveBlocksPerMultiprocessor(&per_cu, (const void*)mk_fwd, NTHREADS, LDS_BYTES);
        (void)hipGetLastError();
        if (per_cu < 1) { fprintf(stderr, "kernel_launch: occupancy query says %d blocks/CU\n", per_cu); }
        grid = cus;
    }
    if (grid < 0) return;
    Args a{};
    for (int i = 0; i < 23; ++i) a.in[i] = (const float*)d_in[i];
    a.out = (float*)d_out; a.ws = (unsigned char*)d_ws;
#if MK_N_LAUNCHES == 1
    if (hipMemsetAsync((char*)d_ws + WS_CTL, 0, CTL_ZERO_BYTES, stream) != hipSuccess) { fprintf(stderr, "kernel_launch: memset failed\n"); return; }
    a.ph_lo = 0; a.ph_hi = PH_COUNT;
    void* kargs[] = {&a};
    hipError_t e = hipLaunchCooperativeKernel((const void*)mk_fwd, dim3(grid), dim3(NTHREADS), kargs, LDS_BYTES, stream);
    if (e != hipSuccess) fprintf(stderr, "cooperative launch failed: %s (grid %d)\n", hipGetErrorString(e), grid);
#else
    for (int p = 0; p < PH_COUNT; ++p) { a.ph_lo = p; a.ph_hi = p + 1; hipLaunchKernelGGL(mk_fwd, dim3(grid), dim3(NTHREADS), LDS_BYTES, stream, a); }
#endif
}
```

```cpp
#include <hip/hip_runtime.h>
#include <hip/hip_cooperative_groups.h>
#include <cstdio>
#include <cstdint>
namespace cg = cooperative_groups;

#ifndef REP_PHASE
#define REP_PHASE -1
#define REP_N 1
#define REP_SUB 0
#endif
#ifndef MK_N_LAUNCHES
#define MK_N_LAUNCHES 1
#endif

namespace pg8 {
#define PG8_LAS __attribute__((address_space(3)))
typedef unsigned short bf16_t;
typedef short bf16x8 __attribute__((ext_vector_type(8)));
typedef float f32x4 __attribute__((ext_vector_type(4)));
typedef unsigned u32x4 __attribute__((ext_vector_type(4)));
typedef unsigned u32x2 __attribute__((ext_vector_type(2)));
constexpr int BM = 256, BK = 64, HALF = 128, HTB = HALF * BK * 2, STAGE_BYTES = 8 * HTB, NXCD = 8, WGM = 8;

__host__ __device__ __forceinline__ int lds_byte(int r, int c) { const int st = (r >> 4) * 2 + (c >> 5), rr = r & 15, cc = c & 31, ob = rr * 64 + cc * 2; return st * 1024 + (ob ^ (((ob >> 9) & 1) << 5)); }
__host__ __device__ __forceinline__ void stage_rc(int b, int& R, int& C) { const int st = b / 1024, sb = b % 1024, swz = sb ^ (((sb >> 9) & 1) << 5); R = (st >> 1) * 16 + swz / 64; C = (st & 1) * 32 + (swz % 64) / 2; }
__host__ __device__ __forceinline__ int perm32(int rho) { const int n = rho >> 4, i = rho & 15; return 8 * (i >> 2) + 4 * n + (i & 3); }

struct Unit { int pm, pn, g; const char* a; const char* b; };

__device__ __forceinline__ unsigned cvt_pk_bf16(float lo, float hi) { unsigned r; asm volatile("v_cvt_pk_bf16_f32 %0, %1, %2" : "=v"(r) : "v"(lo), "v"(hi)); return r; }

struct DenseOrder {
    static constexpr bool CHUNK_B = false;
    int nM, nN, nwg, G, c, K, pn0; const char* A; const char* Bt;
    __device__ void init(const void* A_, const void* Bt_, int M, int N, int K_, int pn0_, int G_, int c_) { A = (const char*)A_; Bt = (const char*)Bt_; nM = M / BM; nN = N / BM; nwg = nM * nN; G = G_; c = c_; K = K_; pn0 = pn0_; }
    __device__ bool next(int i, Unit& u) const {
        const long L = (long)i * G + c; if (L >= nwg) return false;
        int wgid = (int)L; { const int q = nwg / NXCD, r = nwg % NXCD, xcd = wgid % NXCD, off = wgid / NXCD; wgid = (xcd < r ? xcd * (q + 1) : r * (q + 1) + (xcd - r) * q) + off; }
        const int nig = WGM * nN, gid = wgid / nig, fm = gid * WGM, gsz = (nM - fm) < WGM ? (nM - fm) : WGM;
        u.pm = fm + ((wgid % nig) % gsz); u.pn = pn0 + (wgid % nig) / gsz; u.g = 0;
        u.a = A + (size_t)u.pm * BM * K * 2; u.b = Bt + (size_t)u.pn * BM * K * 2; return true;
    }
};
struct MoeOrder {
    static constexpr bool CHUNK_B = true;
    int G, c, K; bool gather; const char* A; const char* Bt;
    __device__ void init(const void* A_, const void* Bt_, int K_, int G_, int c_, bool gather_) { A = (const char*)A_; Bt = (const char*)Bt_; K = K_; G = G_; c = c_; gather = gather_; }
    __device__ bool next(int i, Unit& u) const {
        const int L = i * G + c; if (L >= 512) return false;
        const int pn = L & 7, pm = (L >> 3) & 1, b = (L >> 4) & 1, e = L >> 5;
        u.pm = pm; u.pn = pn; u.g = b * 16 + e;
        u.a = gather ? A : A + (size_t)(u.g * 512 + pm * BM) * K * 2; u.b = Bt + (size_t)e * 2048 * K * 2 + (size_t)pn * BM * 16; return true;
    }
};

struct EpiBf16 {
    static constexpr bool PERM = true, SWAP = false;
    bf16_t* O; int ldc; int grows; const float* rscale;
    __device__ __forceinline__ void operator()(const f32x4 (&acc)[2][2][4][2], const Unit& u, int wr, int wc, int fr, int fq) const {
        const int row0 = u.g * grows + u.pm * BM + wr * 64 + fr, col0 = u.pn * BM + wc * 32 + 8 * fq;
#pragma unroll
        for (int ai = 0; ai < 2; ++ai)
#pragma unroll
            for (int m = 0; m < 4; ++m) { const int row = row0 + ai * HALF + m * 16; bf16_t* rowp = O + (size_t)row * ldc + col0; const float sc = rscale ? rscale[row] : 1.f;
#pragma unroll
                for (int bj = 0; bj < 2; ++bj) { const f32x4 v0 = acc[ai][bj][m][0] * sc, v1 = acc[ai][bj][m][1] * sc;
                    u32x4 w; w.x = cvt_pk_bf16(v0[0], v0[1]); w.y = cvt_pk_bf16(v0[2], v0[3]); w.z = cvt_pk_bf16(v1[0], v1[1]); w.w = cvt_pk_bf16(v1[2], v1[3]);
                    *(u32x4*)(rowp + bj * HALF) = w; } }
    }
};
struct EpiSwiGLU {
    static constexpr bool PERM = true, SWAP = false;
    bf16_t* O;
    __device__ __forceinline__ void operator()(const f32x4 (&acc)[2][2][4][2], const Unit& u, int wr, int wc, int fr, int fq) const {
        const int row0 = u.g * 512 + u.pm * BM + wr * 64 + fr, col0 = u.pn * HALF + wc * 32 + 8 * fq;
#pragma unroll
        for (int ai = 0; ai < 2; ++ai)
#pragma unroll
            for (int m = 0; m < 4; ++m) { bf16_t* rowp = O + (size_t)(row0 + ai * HALF + m * 16) * 1024 + col0;
                float r[8];
#pragma unroll
                for (int n = 0; n < 2; ++n)
#pragma unroll
                    for (int e = 0; e < 4; ++e) { const float g = acc[ai][0][m][n][e], up = acc[ai][1][m][n][e]; r[n * 4 + e] = g / (1.f + __expf(-g)) * up; }
                u32x4 w; w.x = cvt_pk_bf16(r[0], r[1]); w.y = cvt_pk_bf16(r[2], r[3]); w.z = cvt_pk_bf16(r[4], r[5]); w.w = cvt_pk_bf16(r[6], r[7]);
                *(u32x4*)rowp = w; }
    }
};
struct EpiResF32 {
    static constexpr bool PERM = false, SWAP = false;
    const float* res; float* out; int ldc;
    __device__ __forceinline__ void operator()(const f32x4 (&acc)[2][2][4][2], const Unit& u, int wr, int wc, int fr, int fq) const {
        const int row0 = u.pm * BM + wr * 64 + fr, col0 = u.pn * BM + wc * 32 + 4 * fq;
#pragma unroll
        for (int ai = 0; ai < 2; ++ai)
#pragma unroll
            for (int m = 0; m < 4; ++m) { const size_t off = (size_t)(row0 + ai * HALF + m * 16) * ldc + col0;
#pragma unroll
                for (int bj = 0; bj < 2; ++bj)
#pragma unroll
                    for (int n = 0; n < 2; ++n) { const f32x4 r = *(const f32x4*)(res + off + bj * HALF + n * 16); *(f32x4*)(out + off + bj * HALF + n * 16) = r + acc[ai][bj][m][n]; } }
    }
};
struct EpiTransBf16 {
    static constexpr bool PERM = false, SWAP = true;
    bf16_t* O; int ldt; int pn_base;
    __device__ __forceinline__ void operator()(const f32x4 (&acc)[2][2][4][2], const Unit& u, int wr, int wc, int fr, int fq) const {
        const int ch0 = (u.pn - pn_base) * BM + wc * 32 + fr, t0 = u.pm * BM + wr * 64 + 4 * fq;
#pragma unroll
        for (int bj = 0; bj < 2; ++bj)
#pragma unroll
            for (int n = 0; n < 2; ++n) { bf16_t* chp = O + (size_t)(ch0 + bj * HALF + n * 16) * ldt + t0;
#pragma unroll
                for (int ai = 0; ai < 2; ++ai)
#pragma unroll
                    for (int m = 0; m < 4; ++m) { const f32x4 v = acc[ai][bj][m][n]; u32x2 w; w.x = cvt_pk_bf16(v[0], v[1]); w.y = cvt_pk_bf16(v[2], v[3]); *(u32x2*)(chp + ai * HALF + m * 16) = w; } }
    }
};

template <class Epi, class Sched, bool ALIGN_EPI = false, bool GATHER = false>
__device__ __forceinline__ void gemm_phase(PG8_LAS unsigned char* lds, const int K, const Sched& S, const Epi& E, const PG8_LAS int* ridx = nullptr) {
    const int tid = threadIdx.x, wid = __builtin_amdgcn_readfirstlane(tid >> 6), lane = tid & 63, wr = wid >> 2, wc = wid & 3, fr = lane & 15, fq = lane >> 4;
    const int nt = K / BK;
    unsigned vA0[2], vA1[2], vN0[2], vN1[2], voffB[2]; int stR[2], stC[2];
    const size_t kstep = (size_t)(BK * 2);
    const size_t hstep = (size_t)HALF * K * 2;
    const size_t kstepB = Sched::CHUNK_B ? (size_t)(BK / 8) * 2048 * 16 : kstep, hstepB = Sched::CHUNK_B ? (size_t)HALF * 16 : hstep;
#pragma unroll
    for (int i = 0; i < 2; ++i) { int R, C; stage_rc(tid * 16 + i * 8192, R, C); const int Rb = Epi::PERM ? ((R & ~31) + perm32(R & 31)) : R; stR[i] = R; stC[i] = C;
        voffB[i] = Sched::CHUNK_B ? (unsigned)(((C >> 3) * 2048 + Rb) * 16) : (unsigned)(Rb * K + C) * 2u;
        if constexpr (GATHER) { vA0[i] = (unsigned)(ridx[R] * K + C) * 2u; vA1[i] = (unsigned)(ridx[HALF + R] * K + C) * 2u; }
        else { vA0[i] = (unsigned)(R * K + C) * 2u; vA1[i] = vA0[i] + (unsigned)hstep; }
        vN0[i] = vA0[i]; vN1[i] = vA1[i]; }
    const unsigned ldsw = (unsigned)wid * 1024u;
    const int aoff = lds_byte(wr * 64 + fr, fq * 8), boff = lds_byte(wc * 32 + fr, fq * 8);
#define PG8_SA(b, h) (((b) * 2 + (h)) * HTB)
#define PG8_SB(b, h) ((4 + (b) * 2 + (h)) * HTB)
#define PG8_STAGE(bufoff, gbase, voff) do { _Pragma("unroll") for (int _i = 0; _i < 2; ++_i) \
        __builtin_amdgcn_global_load_lds((const unsigned*)((const char*)(gbase) + (voff)[_i]), (PG8_LAS unsigned*)(lds + (bufoff) + ldsw + _i * 8192), 16, 0, 0); } while (0)
#define PG8_LDA(dst, b, h) do { _Pragma("unroll") for (int m = 0; m < 4; ++m) _Pragma("unroll") for (int k = 0; k < 2; ++k) dst[m][k] = *(const PG8_LAS bf16x8*)(lds + PG8_SA(b, h) + aoff + m * 2048 + k * 1024); } while (0)
#define PG8_LDB(dst, b, h) do { _Pragma("unroll") for (int n = 0; n < 2; ++n) _Pragma("unroll") for (int k = 0; k < 2; ++k) dst[n][k] = *(const PG8_LAS bf16x8*)(lds + PG8_SB(b, h) + boff + n * 2048 + k * 1024); } while (0)
#define PG8_MMA(ai, bj, At, Bt) do { __builtin_amdgcn_s_setprio(1); _Pragma("unroll") for (int m = 0; m < 4; ++m) _Pragma("unroll") for (int n = 0; n < 2; ++n) _Pragma("unroll") for (int k = 0; k < 2; ++k) \
        acc[ai][bj][m][n] = Epi::SWAP ? __builtin_amdgcn_mfma_f32_16x16x32_bf16(At[m][k], Bt[n][k], acc[ai][bj][m][n], 0, 0, 0) : __builtin_amdgcn_mfma_f32_16x16x32_bf16(Bt[n][k], At[m][k], acc[ai][bj][m][n], 0, 0, 0); __builtin_amdgcn_s_setprio(0); } while (0)
#define PG8_WAIT_V(n) asm volatile("s_waitcnt vmcnt(" #n ")" ::: "memory")
#define PG8_WAIT_L(n) asm volatile("s_waitcnt lgkmcnt(" #n ")" ::: "memory")
#define PG8_BAR __builtin_amdgcn_s_barrier()
#define PG8_SCHED __builtin_amdgcn_sched_barrier(0)
    Unit cur, nxt; int ui = 0;
    if (!S.next(0, cur)) return;
    f32x4 acc[2][2][4][2];
#pragma unroll
    for (int a = 0; a < 2; ++a)
#pragma unroll
        for (int b = 0; b < 2; ++b)
#pragma unroll
            for (int m = 0; m < 4; ++m)
#pragma unroll
                for (int n = 0; n < 2; ++n) acc[a][b][m][n] = (f32x4){0.f, 0.f, 0.f, 0.f};
    bf16x8 At[4][2], B0[2][2], B1[2][2];
    const char* cA = cur.a; const char* cB = cur.b;
    PG8_STAGE(PG8_SB(0, 0), cB, voffB); PG8_STAGE(PG8_SB(0, 1), cB + hstepB, voffB); PG8_STAGE(PG8_SA(0, 0), cA, vA0); PG8_STAGE(PG8_SA(0, 1), cA, vA1);
    if (wr == 1) PG8_BAR;
    PG8_WAIT_V(2); PG8_BAR;
    PG8_STAGE(PG8_SB(1, 0), cB + kstepB, voffB); PG8_STAGE(PG8_SA(1, 0), cA + kstep, vA0); PG8_STAGE(PG8_SB(1, 1), cB + hstepB + kstepB, voffB);
    PG8_WAIT_V(6); PG8_BAR;
    for (;;) {
        const bool has_next = S.next(ui + 1, nxt);
        const char* nA = has_next ? nxt.a : cA; const char* nB = has_next ? nxt.b : cB;
        if constexpr (GATHER) { if (has_next) {
#pragma unroll
            for (int i = 0; i < 2; ++i) { vN0[i] = (unsigned)(ridx[(ui + 1) * 256 + stR[i]] * K + stC[i]) * 2u; vN1[i] = (unsigned)(ridx[(ui + 1) * 256 + HALF + stR[i]] * K + stC[i]) * 2u; } } }
        for (int t = 0; t < nt; t += 2) {
            const bool last = (t == nt - 2);
            const char* a1 = cA + (size_t)(t + 1) * kstep;
            const char* a2 = last ? nA : cA + (size_t)(t + 2) * kstep; const char* b2 = last ? nB : cB + (size_t)(t + 2) * kstepB;
            const char* a3 = a2 + kstep; const char* b3 = b2 + kstepB;
            unsigned w0[2], w1[2];
#pragma unroll
            for (int i = 0; i < 2; ++i) { w0[i] = last ? vN0[i] : vA0[i]; w1[i] = last ? vN1[i] : vA1[i]; }
            PG8_LDB(B0, 0, 0); PG8_LDB(B1, 0, 1); PG8_SCHED; PG8_LDA(At, 0, 0); PG8_STAGE(PG8_SA(1, 1), a1, vA1);
            PG8_WAIT_V(8); PG8_WAIT_L(0); PG8_BAR; PG8_MMA(0, 0, At, B0); PG8_MMA(0, 1, At, B1); PG8_BAR; PG8_SCHED;
            PG8_LDA(At, 0, 1); PG8_STAGE(PG8_SB(0, 0), b2, voffB); PG8_STAGE(PG8_SB(0, 1), b2 + hstepB, voffB); PG8_STAGE(PG8_SA(0, 0), a2, w0);
            PG8_WAIT_V(8); PG8_WAIT_L(0); PG8_BAR; PG8_MMA(1, 0, At, B0); PG8_MMA(1, 1, At, B1); PG8_BAR; PG8_SCHED;
            PG8_LDB(B0, 1, 0); PG8_LDB(B1, 1, 1); PG8_SCHED; PG8_LDA(At, 1, 0); PG8_STAGE(PG8_SA(0, 1), a2, w1);
            PG8_WAIT_V(8); PG8_WAIT_L(0); PG8_BAR; PG8_MMA(0, 0, At, B0); PG8_MMA(0, 1, At, B1); PG8_BAR; PG8_SCHED;
            PG8_LDA(At, 1, 1); PG8_STAGE(PG8_SB(1, 0), b3, voffB); PG8_STAGE(PG8_SB(1, 1), b3 + hstepB, voffB); PG8_STAGE(PG8_SA(1, 0), a3, w0);
            PG8_WAIT_V(8); PG8_WAIT_L(0); PG8_BAR; PG8_MMA(1, 0, At, B0); PG8_MMA(1, 1, At, B1); PG8_BAR; PG8_SCHED;
        }
        if constexpr (ALIGN_EPI) { if (wr == 0) PG8_BAR; }
        E(acc, cur, wr, wc, fr, fq);
        if (!has_next) break;
#pragma unroll
        for (int a = 0; a < 2; ++a)
#pragma unroll
            for (int b = 0; b < 2; ++b)
#pragma unroll
                for (int m = 0; m < 4; ++m)
#pragma unroll
                    for (int n = 0; n < 2; ++n) acc[a][b][m][n] = (f32x4){0.f, 0.f, 0.f, 0.f};
        cur = nxt; cA = nA; cB = nB; ++ui;
#pragma unroll
        for (int i = 0; i < 2; ++i) { vA0[i] = vN0[i]; vA1[i] = vN1[i]; }
        if constexpr (ALIGN_EPI) { if (wr == 1) PG8_BAR; }
    }
    PG8_WAIT_V(0);
    if constexpr (!ALIGN_EPI) { if (wr == 0) PG8_BAR; }
    PG8_BAR;
#undef PG8_SA
#undef PG8_SB
#undef PG8_STAGE
#undef PG8_LDA
#undef PG8_LDB
#undef PG8_MMA
#undef PG8_WAIT_V
#undef PG8_WAIT_L
#undef PG8_BAR
#undef PG8_SCHED
}
}

constexpr int NB = 2, SEQ = 4096, DM = 2048, MT = NB * SEQ;
constexpr int NH = 8, HD = 128, AW = 1024, HW = 1024, INW = 6144;
constexpr int GW = 64, NROWS = 64, WR = 8, WC = 16;
constexpr int NE = 16, CAP = 512, FF = 1024;
constexpr int FEMB = 33, FHID = 64;
constexpr float EPS = 1e-6f;
constexpr int NWAVES = 8, NTHREADS = 512;

constexpr size_t MiB = 1u << 20;
constexpr size_t WS_CTL = 0, CTL_ZERO_BYTES = 1 * MiB;
constexpr size_t WS_WIN = 2 * MiB;
constexpr size_t WS_WOUT = 26 * MiB;
constexpr size_t WS_WGU = 34 * MiB;
constexpr size_t WS_WD = 162 * MiB;
constexpr size_t WS_W3T = 226 * MiB;
constexpr size_t WS_HID2 = 227 * MiB;
constexpr size_t WS_HB = 228 * MiB;
constexpr size_t WS_QK = 260 * MiB;
constexpr size_t WS_XT = 292 * MiB;
constexpr size_t WS_UC = 356 * MiB;
constexpr size_t WS_TAPS = 404 * MiB;
constexpr size_t WS_HYT = 436 * MiB;
constexpr size_t WS_MIXED = 452 * MiB;
constexpr size_t WS_AFF = 484 * MiB;
constexpr size_t WS_IDX = 485 * MiB;
constexpr size_t WS_GATE = 486 * MiB;
constexpr size_t WS_SEL = 487 * MiB;
constexpr size_t WS_Z1T = 488 * MiB;
constexpr size_t WS_XG = WS_XT;
constexpr size_t WS_ACT = WS_UC;
constexpr size_t WS_YE = WS_TAPS;
constexpr size_t WS_END = 504 * MiB;

constexpr int LDS_BYTES = 163840, LDS_MISC_OFF = 163840 - 128;

#define GAS __attribute__((address_space(1)))
#define LAS __attribute__((address_space(3)))
typedef unsigned short bf16;
typedef unsigned v4u __attribute__((ext_vector_type(4)));
typedef unsigned v2u __attribute__((ext_vector_type(2)));
typedef float f32x4 __attribute__((ext_vector_type(4)));
#define LDS_WAIT() asm volatile("s_waitcnt lgkmcnt(0)" ::: "memory")
#define VM_WAIT() asm volatile("s_waitcnt vmcnt(0)" ::: "memory")
__device__ __forceinline__ unsigned f2bf(float f) { unsigned u = __builtin_bit_cast(unsigned, f); return (u + 0x7fffu + ((u >> 16) & 1u)) >> 16; }
__device__ __forceinline__ unsigned pk2(float lo, float hi) { return f2bf(lo) | (f2bf(hi) << 16); }
__device__ __forceinline__ float bf2f(unsigned h) { return __builtin_bit_cast(float, h << 16); }
__device__ __forceinline__ float bflo(unsigned w) { return __builtin_bit_cast(float, w << 16); }
__device__ __forceinline__ float bfhi(unsigned w) { return __builtin_bit_cast(float, w & 0xffff0000u); }
__device__ __forceinline__ float wave_sum(float v) {
#pragma unroll
    for (int o = 1; o < 64; o <<= 1) v += __shfl_xor(v, o);
    return v;
}


#define XB_TMO      128
#define XB_XCNT(j)  (256  + 64 * (j))
#define XB_XSUB(j)  (1280 + 64 * (j))
#define XB_XGEN(j)  (2304 + 64 * (j))
#define XB_TOP      3328
#define XB_TOPGEN   3392
#define XCD_BAR_WORDS 3456
#define XB_SPIN_CAP (1u << 22)
__device__ __forceinline__ unsigned xb_ld(unsigned* p)              { return __hip_atomic_load(p, __ATOMIC_RELAXED, __HIP_MEMORY_SCOPE_AGENT); }
__device__ __forceinline__ unsigned xb_add(unsigned* p, unsigned v) { return __hip_atomic_fetch_add(p, v, __ATOMIC_RELAXED, __HIP_MEMORY_SCOPE_AGENT); }
__device__ __forceinline__ unsigned xb_xcc_id() { return (unsigned)__builtin_amdgcn_s_getreg((3 << 11) | 20) & 0xFu; }
#define XB_SPIN(cond, bar) do { unsigned _sp = 0; while (cond) { __builtin_amdgcn_s_sleep(1); \
    if ((++_sp & 255u) == 0u) { if (xb_ld(&(bar)[XB_TMO])) break; if (_sp > XB_SPIN_CAP) { atomicAdd(&(bar)[XB_TMO], 1u); break; } } } } while (0)
struct XcdBarrier { unsigned* bar; unsigned x; volatile LAS unsigned* st; };
__device__ __forceinline__ XcdBarrier xcd_barrier_post(unsigned* bar, volatile LAS unsigned* st) {
    XcdBarrier b; b.bar = bar; b.x = xb_xcc_id(); b.st = st;
    if (threadIdx.x == 0) (void)xb_add(&bar[XB_XCNT(b.x)], 1u);
    return b;
}
__device__ __forceinline__ void xcd_barrier_complete(unsigned* bar, unsigned x, unsigned& nloc, unsigned& nx) {
    const unsigned G = gridDim.x * gridDim.y * gridDim.z;
    unsigned sum, cnt, mine, sp = 0u;
    for (;;) {
        sum = 0u; cnt = 0u; mine = 0u;
#pragma unroll
        for (unsigned j = 0; j < 16; ++j) { const unsigned c = xb_ld(&bar[XB_XCNT(j)]); sum += c; cnt += (c > 0u) ? 1u : 0u; mine = (j == x) ? c : mine; }
        if (sum == G) break;
        __builtin_amdgcn_s_sleep(1);
        if ((++sp & 255u) == 0u) { if (xb_ld(&bar[XB_TMO])) break; if (sp > XB_SPIN_CAP) { atomicAdd(&bar[XB_TMO], 1u); break; } }
    }
    nloc = mine > 0u ? mine : 1u; nx = cnt > 0u ? cnt : 1u;
}
__device__ __forceinline__ void xcd_barrier(const XcdBarrier& b) {
    asm volatile("s_waitcnt vmcnt(0)" ::: "memory");
    __syncthreads();
    if (threadIdx.x == 0) {
        unsigned* bar = b.bar;
        __builtin_amdgcn_s_waitcnt(0);
        unsigned nloc = b.st[0], nx = b.st[1];
        if (nloc == 0u) { xcd_barrier_complete(bar, b.x, nloc, nx); b.st[0] = nloc; b.st[1] = nx; }
        const unsigned old = xb_add(&bar[XB_XSUB(b.x)], 1u);
        const unsigned gen = old / nloc;
        if (old + 1u == (gen + 1u) * nloc) {
            __builtin_amdgcn_fence(__ATOMIC_RELEASE, "agent");
            asm volatile("s_waitcnt vmcnt(0)" ::: "memory");
            const unsigned og = xb_add(&bar[XB_TOP], 1u);
            const unsigned tg = og / nx;
            if (og + 1u == (tg + 1u) * nx) xb_add(&bar[XB_TOPGEN], 1u);
            else XB_SPIN(xb_ld(&bar[XB_TOPGEN]) == tg, bar);
            __builtin_amdgcn_fence(__ATOMIC_ACQUIRE, "agent");
            xb_add(&bar[XB_XGEN(b.x)], 1u);
            asm volatile("s_waitcnt vmcnt(0)" ::: "memory");
        } else {
            XB_SPIN(xb_ld(&bar[XB_XGEN(b.x)]) == gen, bar);
            __builtin_amdgcn_fence(__ATOMIC_ACQUIRE, "agent");
            asm volatile("s_waitcnt vmcnt(0)" ::: "memory");
        }
    }
    __syncthreads();
}

struct Frame {
    LAS unsigned char* lds;
    int tid, lane, wave, G, bid;
    const float* in[23]; float* out; unsigned char* ws;
};
#define GW_ID(F) ((F).bid * NWAVES + (F).wave)
#define GW_N(F) ((F).G * NWAVES)

__device__ __forceinline__ void p0_transpose_item(const float* W, int K, int N, bf16* WT, int row_base, int k0, int n0, LAS float* scr, int lane) {
#pragma unroll 8
    for (int i = 0; i < 32; ++i) { const int kk = 2 * i + (lane >> 5); scr[kk * 33 + (lane & 31)] = W[(size_t)(k0 + kk) * N + n0 + (lane & 31)]; }
    LDS_WAIT(); asm volatile("" ::: "memory");
    const int c = lane & 7;
#pragma unroll
    for (int j = 0; j < 4; ++j) { const int n = (lane >> 3) + 8 * j; const LAS float* s = scr + (8 * c) * 33 + n;
        v4u o; o.x = pk2(s[0 * 33], s[1 * 33]); o.y = pk2(s[2 * 33], s[3 * 33]); o.z = pk2(s[4 * 33], s[5 * 33]); o.w = pk2(s[6 * 33], s[7 * 33]);
        *(GAS v4u*)(WT + (size_t)(row_base + n) * K + k0 + 8 * c) = o; }
    LDS_WAIT(); asm volatile("" ::: "memory");
}
__device__ __forceinline__ void phase_p0(Frame& F) {
    LAS float* scr = (LAS float*)(F.lds + F.wave * 16384);
    const int gw = GW_ID(F), NGW = GW_N(F);
    bf16* WinT = (bf16*)(F.ws + WS_WIN); bf16* WoutT = (bf16*)(F.ws + WS_WOUT); bf16* W3T = (bf16*)(F.ws + WS_W3T);
    constexpr int I_IN = (DM / 64) * (INW / 32), I_OUT = (DM / 64) * (DM / 32), I_3 = 1 * (4096 / 32);
    constexpr int NITEMS = I_IN + I_OUT + I_3;
    for (int it = gw; it < NITEMS; it += NGW) {
        int r = it;
        if (r < I_IN) { const int nblk = INW / 32, kb = r / nblk, nb = r % nblk; p0_transpose_item(F.in[2], DM, INW, WinT, 32 * nb, 64 * kb, 32 * nb, scr, F.lane); continue; } r -= I_IN;
        if (r < I_OUT) { const int nblk = DM / 32, kb = r / nblk, nb = r % nblk; p0_transpose_item(F.in[17], DM, DM, WoutT, 32 * nb, 64 * kb, 32 * nb, scr, F.lane); continue; } r -= I_OUT;
        { const int nb = r; p0_transpose_item(F.in[12], FHID, 4096, W3T, 32 * nb, 0, 32 * nb, scr, F.lane); }
    }
    bf16* HB = (bf16*)(F.ws + WS_HB);
    const float* x = F.in[0]; const float* g = F.in[1];
    for (int m = gw; m < MT; m += NGW) {
        const GAS f32x4* xr = (const GAS f32x4*)(x + (size_t)m * DM) + F.lane;
        f32x4 v[8]; float s = 0.f;
#pragma unroll
        for (int j = 0; j < 8; ++j) { v[j] = xr[64 * j]; s += (v[j].x * v[j].x + v[j].y * v[j].y) + (v[j].z * v[j].z + v[j].w * v[j].w); }
        const float r = rsqrtf(wave_sum(s) * (1.f / DM) + EPS);
        GAS v2u* o8 = (GAS v2u*)(HB + (size_t)m * DM) + F.lane;
#pragma unroll
        for (int j = 0; j < 8; ++j) { const f32x4 gg = *((const GAS f32x4*)g + F.lane + 64 * j); v2u o; o.x = pk2(v[j].x * r * gg.x, v[j].y * r * gg.y); o.y = pk2(v[j].z * r * gg.z, v[j].w * r * gg.w); o8[64 * j] = o; }
    }
    float* HID2 = (float*)(F.ws + WS_HID2);
    LAS float* sc2 = (LAS float*)(F.lds + F.wave * 16384);
    const float* w1 = F.in[8]; const float* b1 = F.in[9]; const float* w2 = F.in[10]; const float* b2 = F.in[11]; const float* fr = F.in[13];
    for (int l = gw; l < SEQ; l += NGW) {
        const int j = F.lane;
        float zv = 0.f;
        if (j == 0) zv = (float)l / (float)(SEQ - 1);
        else if (j < FEMB) { const int k = (j - 1) & 15; const float f = 1e-4f + (float)k * ((15.0f - 1e-4f) / 15.0f); const float wv = 6.283185307179586f * (float)l / (float)SEQ; zv = (j <= 16) ? cosf(f * wv) : -sinf(f * wv); }
        sc2[j] = zv; LDS_WAIT(); asm volatile("" ::: "memory");
        float a = b1[j];
        for (int i = 0; i < FEMB; ++i) a += sc2[i] * w1[i * FHID + j];
        const float h1 = sinf(fr[j] * a);
        sc2[64 + j] = h1; LDS_WAIT(); asm volatile("" ::: "memory");
        float c = b2[j];
        for (int i = 0; i < FHID; ++i) c += sc2[64 + i] * w2[i * FHID + j];
        HID2[l * FHID + j] = sinf(fr[j] * c);
        LDS_WAIT(); asm volatile("" ::: "memory");
    }
}

__device__ __forceinline__ void phase_filters_naive(Frame& F) {
    const float* HID2 = (const float*)(F.ws + WS_HID2); const float* w3 = F.in[12]; const float* fbias = F.in[14]; bf16* TAPS = (bf16*)(F.ws + WS_TAPS);
    const size_t total = (size_t)SEQ * 4096;
    for (size_t i = (size_t)F.bid * NTHREADS + F.tid; i < total; i += (size_t)F.G * NTHREADS) {
        const int col = (int)(i & 4095), l = (int)(i >> 12);
        float a = 0.f;
        for (int k = 0; k < FHID; ++k) a += HID2[l * FHID + k] * w3[(size_t)k * 4096 + col];
        const int c = col & 1023, dir = (col >> 10) & 1, o = col >> 11;
        const float mind = -4.605170185988091f / 1.5f, maxd = -4.605170185988091f / 0.3f;
        const float delta = fabsf(mind + (maxd - mind) * ((float)c / 1023.0f));
        const float t = (float)l / (float)(SEQ - 1);
        float v = a * expf(-t * delta);
        bf16* tp = TAPS + ((size_t)c * 2 + o) * 8192;
        if (dir == 0) { if (l == 0) v += fbias[o * 1024 + c]; tp[4096 + l] = (bf16)f2bf(v); }
        else { if (l > 0) tp[4096 - l] = (bf16)f2bf(v); else tp[0] = 0; }
    }
}
__device__ __forceinline__ void phase_hyena_naive(Frame& F, int o) {
    const bf16* UC = (const bf16*)(F.ws + WS_UC); const bf16* TAPS = (const bf16*)(F.ws + WS_TAPS);
    bf16* Z1T = (bf16*)(F.ws + WS_Z1T); bf16* HYT = (bf16*)(F.ws + WS_HYT);
    const bf16* Zin = o == 0 ? UC + (size_t)2048 * MT : Z1T; const bf16* gate = UC + (size_t)(o * 1024) * MT; bf16* OUT = o == 0 ? Z1T : HYT;
    const size_t total = (size_t)1024 * MT;
    for (size_t i = (size_t)F.bid * NTHREADS + F.tid; i < total; i += (size_t)F.G * NTHREADS) {
        const int c = (int)(i >> 13), m = (int)(i & 8191), b = m >> 12, t = m & 4095;
        const bf16* z = Zin + (size_t)c * MT + b * SEQ; const bf16* tp = TAPS + ((size_t)c * 2 + o) * 8192 + 4096 + t;
        float acc = 0.f;
        for (int s = 0; s < SEQ; ++s) acc += bf2f(tp[-s]) * bf2f(z[s]);
        OUT[(size_t)c * MT + m] = (bf16)f2bf(bf2f(gate[(size_t)c * MT + m]) * acc);
    }
}
__device__ __forceinline__ void phase_attn_naive(Frame& F) {
    const bf16* QK = (const bf16*)(F.ws + WS_QK); const bf16* VT = (const bf16*)(F.ws + WS_XT); bf16* MIXED = (bf16*)(F.ws + WS_MIXED);
    const float* rpb = F.in[5]; const float* og = F.in[15];
    const int lane = F.lane;
    for (int w = GW_ID(F); w < MT * NH; w += GW_N(F)) {
        const int m = w >> 3, h = w & 7, b = m / SEQ, s = m % SEQ, r = s / GW, c = s % GW;
        int kr0 = r - WR / 2; kr0 = kr0 < 0 ? 0 : (kr0 > NROWS - WR ? NROWS - WR : kr0);
        int c0 = c - WC / 2; c0 = c0 < 0 ? 0 : (c0 > GW - WC ? GW - WC : c0);
        const bf16* q = QK + (size_t)m * 2048 + h * HD;
        const float q0 = bf2f(q[lane]), q1 = bf2f(q[lane + 64]);
        float mx = -INFINITY, l = 0.f, a0 = 0.f, a1 = 0.f;
        for (int i = 0; i < WR; ++i) for (int j = 0; j < WC; ++j) {
            const int kr = kr0 + i, kc = c0 + j; const size_t km = (size_t)b * SEQ + kr * GW + kc;
            const bf16* kp = QK + km * 2048 + 1024 + h * HD;
            const float d = wave_sum(q0 * bf2f(kp[lane]) + q1 * bf2f(kp[lane + 64]));
            const int dr = kr - r + WR - 1; int dc = kc - c + WC - 1; dc = dc < 0 ? 0 : (dc > 2 * WC - 2 ? 2 * WC - 2 : dc);
            const float sc = d * 0.08838834764831845f + rpb[(h * (2 * WR - 1) + dr) * (2 * WC - 1) + dc];
            const float mn = fmaxf(mx, sc), corr = __expf(mx - mn), pw = __expf(sc - mn);
            const float v0 = bf2f(VT[(size_t)(h * HD + lane) * MT + km]), v1 = bf2f(VT[(size_t)(h * HD + lane + 64) * MT + km]);
            l = l * corr + pw; a0 = a0 * corr + pw * v0; a1 = a1 * corr + pw * v1; mx = mn;
        }
        a0 /= l; a1 /= l;
        const float rr = rsqrtf(wave_sum(a0 * a0 + a1 * a1) * (1.f / HD) + EPS);
        bf16* o = MIXED + (size_t)m * DM + h * HD;
        o[lane] = (bf16)f2bf(a0 * rr * og[h * HD + lane]); o[lane + 64] = (bf16)f2bf(a1 * rr * og[h * HD + lane + 64]);
    }
}


typedef short bf16x8 __attribute__((ext_vector_type(8)));
typedef float f32x16 __attribute__((ext_vector_type(16)));
__device__ __forceinline__ void phase_filters(Frame& F) {
    const float* HID2 = (const float*)(F.ws + WS_HID2); const bf16* W3T = (const bf16*)(F.ws + WS_W3T); const float* fbias = F.in[14]; bf16* TAPS = (bf16*)(F.ws + WS_TAPS);
    const int n = F.lane & 31, hh = F.lane >> 5;
    for (int it = GW_ID(F); it < 128 * 128; it += GW_N(F)) {
        const int col0 = (it >> 7) * 32, l0 = (it & 127) * 32;
        f32x16 acc;
#pragma unroll
        for (int i = 0; i < 16; ++i) acc[i] = 0.f;
#pragma unroll
        for (int ks = 0; ks < 4; ++ks) {
            const bf16x8 a = *(const GAS bf16x8*)(W3T + (size_t)(col0 + n) * FHID + 16 * ks + 8 * hh);
            const GAS f32x4* hp = (const GAS f32x4*)(HID2 + (size_t)(l0 + n) * FHID + 16 * ks + 8 * hh);
            const f32x4 h0 = hp[0], h1 = hp[1];
            v4u bw; bw.x = pk2(h0.x, h0.y); bw.y = pk2(h0.z, h0.w); bw.z = pk2(h1.x, h1.y); bw.w = pk2(h1.z, h1.w);
            acc = __builtin_amdgcn_mfma_f32_32x32x16_bf16(a, __builtin_bit_cast(bf16x8, bw), acc, 0, 0, 0);
        }
        const int l = l0 + n; const float t = (float)l / (float)(SEQ - 1);
        const int dir = (col0 >> 10) & 1, o = col0 >> 11;
        const float mind = -4.605170185988091f / 1.5f, maxd = -4.605170185988091f / 0.3f;
#pragma unroll
        for (int i = 0; i < 16; ++i) {
            const int c = (col0 & 1023) + (i & 3) + 8 * (i >> 2) + 4 * hh;
            const float delta = fabsf(mind + (maxd - mind) * ((float)c / 1023.0f));
            float v = acc[i] * __expf(-t * delta);
            bf16* tp = TAPS + ((size_t)c * 2 + o) * 8192;
            if (dir == 0) { if (l == 0) v += fbias[o * 1024 + c]; tp[4096 + l] = (bf16)f2bf(v); }
            else { if (l > 0) tp[4096 - l] = (bf16)f2bf(v); else tp[0] = 0; }
        }
    }
}

constexpr int HY_TAPS_BYTES = 4 * 16384, HY_ZB_ENT = 6080, HY_ZB_BYTES = HY_ZB_ENT * 2;
__device__ __forceinline__ unsigned hy_zb_off(int idx0  ) { const int q = idx0 >> 3; return (unsigned)((q ^ ((q >> 4) & 3)) << 4); }
template <int MASK>
__device__ __forceinline__ void hy_loadB(bf16x8 (&bf)[4], const LAS unsigned char* zb0, int g, int b, int n, int hh) {
    const int q0 = 124 - 4 * n + 2 * g + hh;
    const LAS unsigned char* pm = zb0 + ((q0 ^ ((q0 >> 4) & 3)) << 4) - 6144 + b * HY_ZB_BYTES;
#pragma unroll
    for (int tau = 0; tau < 4; ++tau) if (MASK & (1 << tau)) bf[tau] = *(const LAS bf16x8*)(pm + 2048 * (3 - tau));
}
__device__ __forceinline__ void hy_loadA(unsigned (&d)[5], const LAS bf16* taps, int g, int n, int hh) {
    const volatile LAS unsigned* dp = (const volatile LAS unsigned*)taps + ((1 + 8 * hh + n) >> 1) + 8 * g;
#pragma unroll
    for (int i = 0; i < 5; ++i) d[i] = dp[i];
}
template <int MASK>
__device__ __forceinline__ void hy_mma(f32x16 (&acc)[4], const bf16x8 a, const bf16x8 (&bf)[4]) {
#pragma unroll
    for (int tau = 0; tau < 4; ++tau) if (MASK & (1 << tau)) acc[tau] = __builtin_amdgcn_mfma_f32_32x32x16_bf16(a, bf[tau], acc[tau], 0, 0, 0);
}
#define HY_ALIGN(a, d) do { v4u aw_; aw_.x = __builtin_amdgcn_alignbyte(d[1], d[0], sh); aw_.y = __builtin_amdgcn_alignbyte(d[2], d[1], sh); aw_.z = __builtin_amdgcn_alignbyte(d[3], d[2], sh); aw_.w = __builtin_amdgcn_alignbyte(d[4], d[3], sh); a = __builtin_bit_cast(bf16x8, aw_); } while (0)
#define HY_INTERLEAVE(nv) do { __builtin_amdgcn_sched_group_barrier(0x2, nv, 0); _Pragma("unroll") for (int i_ = 0; i_ < 4; ++i_) { __builtin_amdgcn_sched_group_barrier(0x8, 1, 0); __builtin_amdgcn_sched_group_barrier(0x100, 3, 0); __builtin_amdgcn_sched_group_barrier(0x2, 3, 0); } } while (0)
template <int MASK>
__device__ __forceinline__ void hy_segment(f32x16 (&acc)[2][4], const LAS bf16* taps, const LAS unsigned char* zb0, int g0, int g1, int n, int hh) {
    const unsigned sh = (n & 1) ? 0u : 2u;
    unsigned d[5]; bf16x8 a, b0[4], b1[4];
    hy_loadA(d, taps, g0, n, hh); hy_loadB<MASK>(b0, zb0, g0, 0, n, hh);
#pragma unroll 1
    for (int g = g0; g < g1; ++g) {
        HY_ALIGN(a, d);
        hy_loadB<MASK>(b1, zb0, g, 1, n, hh);
        hy_mma<MASK>(acc[0], a, b0);
        HY_INTERLEAVE(4); __builtin_amdgcn_sched_barrier(0);
        hy_loadA(d, taps, g + 1, n, hh); hy_loadB<MASK>(b0, zb0, g + 1, 0, n, hh);
        hy_mma<MASK>(acc[1], a, b1);
        HY_INTERLEAVE(0); __builtin_amdgcn_sched_barrier(0);
    }
}
__device__ __forceinline__ void hy_stage_taps(Frame& F, int c0, int o) {
    const bf16* TAPS = (const bf16*)(F.ws + WS_TAPS);
    int tid = F.tid; asm volatile("" : "+v"(tid));
#pragma unroll
    for (int j = 0; j < 8; ++j) { const int ch = tid + NTHREADS * j, ci = ch >> 10, w = ch & 1023;
        *((LAS v4u*)(F.lds) + ch) = *((const GAS v4u*)(TAPS + ((size_t)(c0 + ci) * 2 + o) * 8192) + w); }
}
__device__ __forceinline__ void conv_item64(const float* W, int N, bf16* WTe, int row_base, int k0, int n0, int lane) {
    const GAS float* src = (const GAS float*)(W + (size_t)k0 * N + n0 + lane);
    float v[64];
#pragma unroll
    for (int kk = 0; kk < 64; ++kk) v[kk] = src[(size_t)kk * N];
    GAS v4u* dst = (GAS v4u*)WTe + (size_t)(k0 >> 3) * 2048 + row_base + lane;
#pragma unroll
    for (int j = 0; j < 8; ++j) { v4u o; o.x = pk2(v[8 * j], v[8 * j + 1]); o.y = pk2(v[8 * j + 2], v[8 * j + 3]); o.z = pk2(v[8 * j + 4], v[8 * j + 5]); o.w = pk2(v[8 * j + 6], v[8 * j + 7]); dst[(size_t)j * 2048] = o; }
}
constexpr int MOE_ITEMS_GU = 2 * NE * 32 * 16, MOE_ITEMS_D = NE * 16 * 32, MOE_ITEMS = MOE_ITEMS_GU + MOE_ITEMS_D;
#ifndef MOE_P0_ITEMS
#define MOE_P0_ITEMS 0
#endif
constexpr int MOE_HELP_ITEMS = MOE_ITEMS - MOE_P0_ITEMS;
__device__ __forceinline__ void moe_conv_item(Frame& F, int it) {
    bf16* WguT = (bf16*)(F.ws + WS_WGU); bf16* WdT = (bf16*)(F.ws + WS_WD);
    if (it < MOE_ITEMS_GU) { const int which = it >> 13, e = (it >> 9) & 15, kb = (it >> 4) & 31, nb = it & 15, f0 = 64 * nb;
        const float* W = (which ? F.in[21] : F.in[20]) + (size_t)e * DM * FF;
        conv_item64(W, FF, WguT + (size_t)e * 2048 * DM, (f0 >> 7) * 256 + which * 128 + (f0 & 127), 64 * kb, f0, F.lane);
    } else { const int r = it - MOE_ITEMS_GU, e = r >> 9, kb = (r >> 5) & 15, nb = r & 31;
        conv_item64(F.in[22] + (size_t)e * FF * DM, DM, WdT + (size_t)e * 2048 * FF, 64 * nb, 64 * kb, 64 * nb, F.lane); }
}
__device__ __forceinline__ void phase_hyena(Frame& F) {
    const bf16* XH = (const bf16*)(F.ws + WS_XT) + (size_t)1024 * MT;
    const float* cw = F.in[6]; const float* cb = F.in[7];
    bf16* HYT = (bf16*)(F.ws + WS_HYT);
    const int n = F.lane & 31, hh = F.lane >> 5;
    const bool compute = F.wave < 4;
    const int nhelp = F.G * 4, hw = F.bid * 4 + (F.wave - 4);
    int sec = 0;
    for (int cg = F.bid; cg < 256; cg += F.G) {
        const int c0 = cg * 4;
        __syncthreads();
        hy_stage_taps(F, c0, 0);
        {
          const int ci = F.wave >> 1, b = F.wave & 1; LAS unsigned char* zb = F.lds + HY_TAPS_BYTES + F.wave * HY_ZB_BYTES;
          const int zch = 2048 + c0 + ci; const bf16* zsrc = XH + (size_t)zch * MT + b * SEQ;
          const float w0 = cw[zch], w1 = cw[3072 + zch], w2 = cw[6144 + zch], bb = cb[zch];
#pragma unroll
          for (int j = 0; j < 8; ++j) { const int u = F.lane + 64 * j; const v4u w = *((const GAS v4u*)zsrc + u);
              float f[10];
              f[1] = bflo(w.x); f[2] = bfhi(w.x); f[3] = bflo(w.y); f[4] = bfhi(w.y); f[5] = bflo(w.z); f[6] = bfhi(w.z); f[7] = bflo(w.w); f[8] = bfhi(w.w);
              f[0] = u > 0 ? bf2f(zsrc[8 * u - 1]) : 0.f; f[9] = u < 511 ? bf2f(zsrc[8 * u + 8]) : 0.f;
              float z[8];
#pragma unroll
              for (int e = 0; e < 8; ++e) z[e] = bb + w0 * f[e] + w1 * f[e + 1] + w2 * f[e + 2];
              v4u r; r.x = pk2(z[7], z[6]); r.y = pk2(z[5], z[4]); r.z = pk2(z[3], z[2]); r.w = pk2(z[1], z[0]);
              *(LAS v4u*)(zb + hy_zb_off(8 * (635 - u))) = r; }
          const v4u zero = {0u, 0u, 0u, 0u};
          for (int q = F.lane; q < 124; q += 64) { *(LAS v4u*)(zb + hy_zb_off(8 * q)) = zero; *(LAS v4u*)(zb + hy_zb_off(8 * (636 + q))) = zero; } }
        __syncthreads();
#pragma unroll 1
        for (int o = 0; o < 2; ++o) {
            if (compute) {
                const int ci = F.wave, c = c0 + ci;
                const LAS bf16* taps = (const LAS bf16*)(F.lds + ci * 16384);
                LAS unsigned char* zb0 = F.lds + HY_TAPS_BYTES + (2 * ci) * HY_ZB_BYTES;
                f32x16 acc[2][4];
#pragma unroll
                for (int b = 0; b < 2; ++b)
#pragma unroll
                    for (int tau = 0; tau < 4; ++tau)
#pragma unroll
                        for (int i = 0; i < 16; ++i) acc[b][tau][i] = 0.f;
                hy_segment<1>(acc, taps, zb0, 0, 64, n, hh);
                hy_segment<3>(acc, taps, zb0, 64, 128, n, hh);
                hy_segment<7>(acc, taps, zb0, 128, 192, n, hh);
                hy_segment<15>(acc, taps, zb0, 192, 318, n, hh);
                hy_segment<14>(acc, taps, zb0, 318, 382, n, hh);
                hy_segment<12>(acc, taps, zb0, 382, 446, n, hh);
                hy_segment<8>(acc, taps, zb0, 446, 510, n, hh);
                LDS_WAIT();
                int n2 = n, h2 = hh; asm volatile("" : "+v"(n2), "+v"(h2));
#pragma unroll
                for (int b = 0; b < 2; ++b) {
                    const int gch = o * 1024 + c; const bf16* gate = XH + (size_t)gch * MT + b * SEQ;
                    const float w0 = cw[gch], w1 = cw[3072 + gch], w2 = cw[6144 + gch], bb = cb[gch];
                    LAS unsigned char* zb = zb0 + b * HY_ZB_BYTES; bf16* outp = HYT + (size_t)c * MT + b * SEQ;
#pragma unroll
                    for (int tau = 0; tau < 4; ++tau) { asm volatile("" ::: "memory");
#pragma unroll
                        for (int rg = 0; rg < 4; ++rg) { const int t0 = 1024 * tau + 32 * n2 + 8 * rg + 4 * h2;
                            const v2u gw = *(const GAS v2u*)(gate + t0);
                            const float gl = t0 > 0 ? bf2f(gate[t0 - 1]) : 0.f, gr = t0 + 4 < SEQ ? bf2f(gate[t0 + 4]) : 0.f;
                            const float r0 = bflo(gw.x), r1 = bfhi(gw.x), r2 = bflo(gw.y), r3 = bfhi(gw.y);
                            const float z0 = (bb + w0 * gl + w1 * r0 + w2 * r1) * acc[b][tau][4 * rg + 0], z1 = (bb + w0 * r0 + w1 * r1 + w2 * r2) * acc[b][tau][4 * rg + 1],
                                        z2 = (bb + w0 * r1 + w1 * r2 + w2 * r3) * acc[b][tau][4 * rg + 2], z3 = (bb + w0 * r2 + w1 * r3 + w2 * gr) * acc[b][tau][4 * rg + 3];
                            if (o == 0) { v2u w; w.x = pk2(z3, z2); w.y = pk2(z1, z0);
                                *(LAS v2u*)(zb + hy_zb_off(8 * (635 - (t0 >> 3))) + (h2 ? 0 : 8)) = w; }
                            else { v2u w; w.x = pk2(z0, z1); w.y = pk2(z2, z3); *(GAS v2u*)(outp + t0) = w; } } }
                }
            } else {
                const int lo_it = MOE_P0_ITEMS + sec * (MOE_HELP_ITEMS / 2), hi_it = lo_it + MOE_HELP_ITEMS / 2;
                if (sec < 2) for (int it = lo_it + hw; it < hi_it; it += nhelp) moe_conv_item(F, it);
            }
            ++sec;
            if (o == 0) {
                __syncthreads();
                hy_stage_taps(F, c0, 1);
                __syncthreads();
            }
        }
    }
    for (; sec < 2; ++sec) if (!compute) { const int lo_it = MOE_P0_ITEMS + sec * (MOE_HELP_ITEMS / 2), hi_it = lo_it + MOE_HELP_ITEMS / 2; for (int it = lo_it + hw; it < hi_it; it += nhelp) moe_conv_item(F, it); }
    __syncthreads();
}

__device__ __forceinline__ void phase_attn(Frame& F) {
    const bf16* QK = (const bf16*)(F.ws + WS_QK); const bf16* VT = (const bf16*)(F.ws + WS_XT); bf16* MIXED = (bf16*)(F.ws + WS_MIXED);
    const float* rpb = F.in[5]; const float* og = F.in[15];
    LAS float* rp = (LAS float*)(F.lds + F.wave * 2048);
    const int n = F.lane & 31, hh = F.lane >> 5;
    for (int task = GW_ID(F); task < NB * NH * NROWS * 2; task += GW_N(F)) {
        const int wq = task & 1, r = (task >> 1) & 63, h = (task >> 7) & 7, b = task >> 10;
        for (int i = F.lane; i < 15 * 31; i += 64) rp[i] = rpb[h * 465 + i];
        const int mq = b * SEQ + r * GW + 32 * wq + n, qc = 32 * wq + n;
        int c0 = qc - WC / 2; c0 = c0 < 0 ? 0 : (c0 > GW - WC ? GW - WC : c0);
        int kr0 = r - WR / 2; kr0 = kr0 < 0 ? 0 : (kr0 > NROWS - WR ? NROWS - WR : kr0);
        bf16x8 qf[8];
#pragma unroll
        for (int ks = 0; ks < 8; ++ks) qf[ks] = *(const GAS bf16x8*)(QK + (size_t)mq * 2048 + h * HD + 16 * ks + 8 * hh);
        f32x16 O[4];
#pragma unroll
        for (int dt = 0; dt < 4; ++dt)
#pragma unroll
            for (int i = 0; i < 16; ++i) O[dt][i] = 0.f;
        float lsum = 0.f;
        LDS_WAIT();
#pragma unroll 1
        for (int tile = 0; tile < 16; ++tile) {
            const int kr = kr0 + (tile >> 1), kt = tile & 1, dr = kr - r + WR - 1;
            const int mk0 = b * SEQ + kr * GW + 32 * kt;
            f32x16 S;
#pragma unroll
            for (int i = 0; i < 16; ++i) S[i] = 0.f;
#pragma unroll
            for (int ks = 0; ks < 8; ++ks) { const bf16x8 kf = *(const GAS bf16x8*)(QK + (size_t)(mk0 + n) * 2048 + 1024 + h * HD + 16 * ks + 8 * hh);
                S = __builtin_amdgcn_mfma_f32_32x32x16_bf16(kf, qf[ks], S, 0, 0, 0); }
            float p[16];
#pragma unroll
            for (int i = 0; i < 16; ++i) { const int kc = 32 * kt + (i & 3) + 8 * (i >> 2) + 4 * hh; const bool valid = (kc >= c0) && (kc < c0 + WC);
                int dc = kc - qc + WC - 1; dc = dc < 0 ? 0 : (dc > 2 * WC - 2 ? 2 * WC - 2 : dc);
                const float e = __expf(S[i] * 0.08838834764831845f + rp[dr * 31 + dc]); p[i] = valid ? e : 0.f; lsum += p[i]; }
            v4u pw0, pw1;
            pw0.x = pk2(p[0], p[1]); pw0.y = pk2(p[2], p[3]); pw0.z = pk2(p[4], p[5]); pw0.w = pk2(p[6], p[7]);
            pw1.x = pk2(p[8], p[9]); pw1.y = pk2(p[10], p[11]); pw1.z = pk2(p[12], p[13]); pw1.w = pk2(p[14], p[15]);
            const bf16x8 pf0 = __builtin_bit_cast(bf16x8, pw0), pf1 = __builtin_bit_cast(bf16x8, pw1);
#pragma unroll
            for (int dt = 0; dt < 4; ++dt) {
                const bf16* vrow = VT + (size_t)(h * HD + 32 * dt + n) * MT + mk0 + 4 * hh;
                const v2u a0 = *(const GAS v2u*)(vrow), a1 = *(const GAS v2u*)(vrow + 8), a2 = *(const GAS v2u*)(vrow + 16), a3 = *(const GAS v2u*)(vrow + 24);
                v4u f0, f1; f0.x = a0.x; f0.y = a0.y; f0.z = a1.x; f0.w = a1.y; f1.x = a2.x; f1.y = a2.y; f1.z = a3.x; f1.w = a3.y;
                O[dt] = __builtin_amdgcn_mfma_f32_32x32x16_bf16(__builtin_bit_cast(bf16x8, f0), pf0, O[dt], 0, 0, 0);
                O[dt] = __builtin_amdgcn_mfma_f32_32x32x16_bf16(__builtin_bit_cast(bf16x8, f1), pf1, O[dt], 0, 0, 0);
            }
        }
        lsum += __shfl_xor(lsum, 32);
        const float il = 1.f / lsum;
        float ss = 0.f;
#pragma unroll
        for (int dt = 0; dt < 4; ++dt)
#pragma unroll
            for (int i = 0; i < 16; ++i) { O[dt][i] *= il; ss += O[dt][i] * O[dt][i]; }
        ss += __shfl_xor(ss, 32);
        const float rr = rsqrtf(ss * (1.f / HD) + EPS);
        bf16* orow = MIXED + (size_t)mq * DM + h * HD;
#pragma unroll
        for (int dt = 0; dt < 4; ++dt)
#pragma unroll
            for (int rg = 0; rg < 4; ++rg) { const int d = 32 * dt + 8 * rg + 4 * hh; const f32x4 gg = *(const GAS f32x4*)(og + h * HD + d);
                v2u w; w.x = pk2(O[dt][4 * rg + 0] * rr * gg.x, O[dt][4 * rg + 1] * rr * gg.y); w.y = pk2(O[dt][4 * rg + 2] * rr * gg.z, O[dt][4 * rg + 3] * rr * gg.w);
                *(GAS v2u*)(orow + d) = w; }
        LDS_WAIT();
    }
}


constexpr int AT_KBYTES = 16384, AT_VPITCH = 136, AT_VBYTES = 128 * AT_VPITCH, AT_STAGE = AT_KBYTES + AT_VBYTES, AT_RP_OFF = 2 * AT_STAGE;
__device__ __forceinline__ void phase_attn2(Frame& F) {
    const bf16* QK = (const bf16*)(F.ws + WS_QK); const bf16* VT = (const bf16*)(F.ws + WS_XT); bf16* MIXED = (bf16*)(F.ws + WS_MIXED);
    const float* rpb = F.in[5]; const float* og = F.in[15]; const float* qg = F.in[3]; const float* kg = F.in[4];
    LAS float* rp = (LAS float*)(F.lds + AT_RP_OFF + F.wave * 2048);
    LAS float* gtab = (LAS float*)(F.lds + AT_RP_OFF + 8 * 2048);
    if (F.tid < HD) gtab[F.tid] = qg[F.tid] * kg[F.tid];
    const int n = F.lane & 31, hh = F.lane >> 5;
    for (int unit = F.bid; unit < NB * NH * 16; unit += F.G) {
        const int rq = unit & 15, h = (unit >> 4) & 7, b = unit >> 7, r0 = 4 * rq;
        const int r = r0 + (F.wave >> 1), wq = F.wave & 1;
        int kmin = r0 - WR / 2; kmin = kmin < 0 ? 0 : (kmin > NROWS - WR ? NROWS - WR : kmin);
        int kmax = r0 + 3 - WR / 2; kmax = (kmax < 0 ? 0 : (kmax > NROWS - WR ? NROWS - WR : kmax)) + WR - 1;
        int kr0 = r - WR / 2; kr0 = kr0 < 0 ? 0 : (kr0 > NROWS - WR ? NROWS - WR : kr0);
        const int nrows = kmax - kmin + 1;
        __syncthreads();
        for (int i = F.lane; i < 15 * 31; i += 64) rp[i] = rpb[h * 465 + i];
        const int mq = b * SEQ + r * GW + 32 * wq + n, qc = 32 * wq + n;
        int c0 = qc - WC / 2; c0 = c0 < 0 ? 0 : (c0 > GW - WC ? GW - WC : c0);
        bf16x8 qf[8];
#pragma unroll
        for (int ks = 0; ks < 8; ++ks) qf[ks] = *(const GAS bf16x8*)(QK + (size_t)mq * 2048 + h * HD + 16 * ks + 8 * hh);
        float qscale;
        {
          f32x16 D;
#pragma unroll
          for (int i = 0; i < 16; ++i) D[i] = 0.f;
#pragma unroll
          for (int ks = 0; ks < 8; ++ks) D = __builtin_amdgcn_mfma_f32_32x32x16_bf16(qf[ks], qf[ks], D, 0, 0, 0);
          float dsel = 0.f; const int isel = (n & 3) + 4 * (n >> 3);
#pragma unroll
          for (int i = 0; i < 16; ++i) dsel = (i == isel) ? D[i] : dsel;
          const float other = __shfl_xor(dsel, 32);
          const float ssq = (((n >> 2) & 1) == hh) ? dsel : other;
          qscale = 0.08838834764831845f * rsqrtf(ssq * (1.f / HD) + EPS); }
        f32x16 O[4];
#pragma unroll
        for (int dt = 0; dt < 4; ++dt)
#pragma unroll
            for (int i = 0; i < 16; ++i) O[dt][i] = 0.f;
        float lsum = 0.f;
        v4u sk[2], sv[2];

        auto gload = [&](int kr) {
#pragma unroll
            for (int j = 0; j < 2; ++j) { const int id = F.tid + 512 * j;
                sk[j] = *(const GAS v4u*)(QK + (size_t)(b * SEQ + kr * GW + (id >> 4)) * 2048 + 1024 + h * HD + 8 * (id & 15));
                sv[j] = *(const GAS v4u*)(VT + (size_t)(h * HD + (id >> 3)) * MT + b * SEQ + kr * GW + 8 * (id & 7)); }
        };
        auto lstore = [&](int buf) {
            LAS unsigned char* kb = F.lds + buf * AT_STAGE; LAS unsigned char* vb = kb + AT_KBYTES;
#pragma unroll
            for (int j = 0; j < 2; ++j) { const int id = F.tid + 512 * j; const int key = id >> 4, c = id & 15;
                float f[8] = {bflo(sk[j].x), bfhi(sk[j].x), bflo(sk[j].y), bfhi(sk[j].y), bflo(sk[j].z), bfhi(sk[j].z), bflo(sk[j].w), bfhi(sk[j].w)};
                float ss = 0.f;
#pragma unroll
                for (int e = 0; e < 8; ++e) ss += f[e] * f[e];
                ss += __shfl_xor(ss, 1); ss += __shfl_xor(ss, 2); ss += __shfl_xor(ss, 4); ss += __shfl_xor(ss, 8);
                const float rk = rsqrtf(ss * (1.f / HD) + EPS);
                const f32x4 ga = *(const LAS f32x4*)(gtab + 8 * c), gb = *(const LAS f32x4*)(gtab + 8 * c + 4);
                v4u kn; kn.x = pk2(f[0] * rk * ga.x, f[1] * rk * ga.y); kn.y = pk2(f[2] * rk * ga.z, f[3] * rk * ga.w); kn.z = pk2(f[4] * rk * gb.x, f[5] * rk * gb.y); kn.w = pk2(f[6] * rk * gb.z, f[7] * rk * gb.w);
                *(LAS v4u*)(kb + key * 256 + ((c ^ (key & 15)) << 4)) = kn;
                const int d = id >> 3, cv = id & 7; LAS v2u* vp = (LAS v2u*)(vb + d * AT_VPITCH + cv * 16);
                v2u lo, hi; lo.x = sv[j].x; lo.y = sv[j].y; hi.x = sv[j].z; hi.y = sv[j].w; vp[0] = lo; vp[1] = hi; }
        };
        gload(kmin); lstore(0);
        __syncthreads();
#pragma unroll 1
        for (int j = 0; j < nrows; ++j) {
            const int kr = kmin + j, buf = j & 1;
            if (j + 1 < nrows) gload(kr + 1);
            if (kr >= kr0 && kr < kr0 + WR) {
                const LAS unsigned char* kb = F.lds + buf * AT_STAGE; const LAS unsigned char* vb = kb + AT_KBYTES;
                const int dr = kr - r + WR - 1;
                int c0v = c0, qcv = qc; asm volatile("" : "+v"(c0v), "+v"(qcv));
#pragma unroll
                for (int kt = 0; kt < 2; ++kt) {
                    f32x16 S;
#pragma unroll
                    for (int i = 0; i < 16; ++i) S[i] = 0.f;
                    const int key = 32 * kt + n;
#pragma unroll
                    for (int ks = 0; ks < 8; ++ks) { const bf16x8 kf = *(const LAS bf16x8*)(kb + key * 256 + (((2 * ks + hh) ^ (key & 15)) << 4));
                        S = __builtin_amdgcn_mfma_f32_32x32x16_bf16(kf, qf[ks], S, 0, 0, 0); }
                    float p[16];
#pragma unroll
                    for (int i = 0; i < 16; ++i) { const int kc = 32 * kt + (i & 3) + 8 * (i >> 2) + 4 * hh; const bool valid = (kc >= c0v) && (kc < c0v + WC);
                        int dc = kc - qcv + WC - 1; dc = dc < 0 ? 0 : (dc > 2 * WC - 2 ? 2 * WC - 2 : dc);
                        const float e = __expf(S[i] * qscale + rp[dr * 31 + dc]); p[i] = valid ? e : 0.f; lsum += p[i]; }
                    v4u pw0, pw1;
                    pw0.x = pk2(p[0], p[1]); pw0.y = pk2(p[2], p[3]); pw0.z = pk2(p[4], p[5]); pw0.w = pk2(p[6], p[7]);
                    pw1.x = pk2(p[8], p[9]); pw1.y = pk2(p[10], p[11]); pw1.z = pk2(p[12], p[13]); pw1.w = pk2(p[14], p[15]);
                    const bf16x8 pf0 = __builtin_bit_cast(bf16x8, pw0), pf1 = __builtin_bit_cast(bf16x8, pw1);
#pragma unroll
                    for (int dt = 0; dt < 4; ++dt) {
                        const LAS unsigned char* vrow = vb + (32 * dt + n) * AT_VPITCH + (32 * kt + 4 * hh) * 2;
                        const v2u a0 = *(const LAS v2u*)(vrow), a1 = *(const LAS v2u*)(vrow + 16), a2 = *(const LAS v2u*)(vrow + 32), a3 = *(const LAS v2u*)(vrow + 48);
                        v4u f0, f1; f0.x = a0.x; f0.y = a0.y; f0.z = a1.x; f0.w = a1.y; f1.x = a2.x; f1.y = a2.y; f1.z = a3.x; f1.w = a3.y;
                        O[dt] = __builtin_amdgcn_mfma_f32_32x32x16_bf16(__builtin_bit_cast(bf16x8, f0), pf0, O[dt], 0, 0, 0);
                        O[dt] = __builtin_amdgcn_mfma_f32_32x32x16_bf16(__builtin_bit_cast(bf16x8, f1), pf1, O[dt], 0, 0, 0);
                    }
                }
            }
            if (j + 1 < nrows) lstore(buf ^ 1);
            __syncthreads();
        }
        lsum += __shfl_xor(lsum, 32);
        const float il = 1.f / lsum;
        float ss = 0.f;
#pragma unroll
        for (int dt = 0; dt < 4; ++dt)
#pragma unroll
            for (int i = 0; i < 16; ++i) { O[dt][i] *= il; ss += O[dt][i] * O[dt][i]; }
        ss += __shfl_xor(ss, 32);
        const float rr = rsqrtf(ss * (1.f / HD) + EPS);
        bf16* orow = MIXED + (size_t)mq * DM + h * HD;
#pragma unroll
        for (int dt = 0; dt < 4; ++dt)
#pragma unroll
            for (int rg = 0; rg < 4; ++rg) { const int d = 32 * dt + 8 * rg + 4 * hh; const f32x4 gg = *(const GAS f32x4*)(og + h * HD + d);
                v2u w; w.x = pk2(O[dt][4 * rg + 0] * rr * gg.x, O[dt][4 * rg + 1] * rr * gg.y); w.y = pk2(O[dt][4 * rg + 2] * rr * gg.z, O[dt][4 * rg + 3] * rr * gg.w);
                *(GAS v2u*)(orow + d) = w; }
    }
    __syncthreads();
}

__device__ __forceinline__ void phase_p15(Frame& F) {
    bf16* QK = (bf16*)(F.ws + WS_QK); const float* qg = F.in[3]; const float* kg = F.in[4];
    for (int m = GW_ID(F); m < MT; m += GW_N(F)) {
        GAS v4u* rowp = (GAS v4u*)(QK + (size_t)m * 2048) + F.lane;
#pragma unroll
        for (int j = 0; j < 4; ++j) {
            v4u w = rowp[64 * j];
            float f[8] = {bflo(w.x), bfhi(w.x), bflo(w.y), bfhi(w.y), bflo(w.z), bfhi(w.z), bflo(w.w), bfhi(w.w)};
            float ss = 0.f;
#pragma unroll
            for (int e = 0; e < 8; ++e) ss += f[e] * f[e];
            ss += __shfl_xor(ss, 1); ss += __shfl_xor(ss, 2); ss += __shfl_xor(ss, 4); ss += __shfl_xor(ss, 8);
            const float r = rsqrtf(ss * (1.f / HD) + EPS);
            const int col = 512 * j + 8 * F.lane, d = col & 127; const float* g = (col < 1024 ? qg : kg) + d;
#pragma unroll
            for (int e = 0; e < 8; ++e) f[e] = f[e] * r * g[e];
            w.x = pk2(f[0], f[1]); w.y = pk2(f[2], f[3]); w.z = pk2(f[4], f[5]); w.w = pk2(f[6], f[7]);
            rowp[64 * j] = w;
        }
    }
    const bf16* XT = (const bf16*)(F.ws + WS_XT) + (size_t)1024 * MT; bf16* UC = (bf16*)(F.ws + WS_UC);
    const float* cw = F.in[6]; const float* cb = F.in[7];
    const size_t nchunks = (size_t)3072 * MT / 8;
    for (size_t i = (size_t)F.bid * NTHREADS + F.tid; i < nchunks; i += (size_t)F.G * NTHREADS) {
        const int ch = (int)(i >> 10), m0 = (int)(i & 1023) * 8, s0 = m0 & 4095;
        const bf16* up = XT + (size_t)ch * MT + m0;
        const v4u w = *(const GAS v4u*)up;
        float f[10];
        f[1] = bflo(w.x); f[2] = bfhi(w.x); f[3] = bflo(w.y); f[4] = bfhi(w.y); f[5] = bflo(w.z); f[6] = bfhi(w.z); f[7] = bflo(w.w); f[8] = bfhi(w.w);
        f[0] = s0 > 0 ? bf2f(up[-1]) : 0.f; f[9] = s0 + 8 < SEQ ? bf2f(up[8]) : 0.f;
        const float w0 = cw[ch], w1 = cw[3072 + ch], w2 = cw[6144 + ch], bb = cb[ch];
        float o[8];
#pragma unroll
        for (int e = 0; e < 8; ++e) o[e] = bb + w0 * f[e] + w1 * f[e + 1] + w2 * f[e + 2];
        v4u ov; ov.x = pk2(o[0], o[1]); ov.y = pk2(o[2], o[3]); ov.z = pk2(o[4], o[5]); ov.w = pk2(o[6], o[7]);
        *(GAS v4u*)(UC + (size_t)ch * MT + m0) = ov;
    }
}
__device__ __forceinline__ void phase_p25(Frame& F) {
    const bf16* HYT = (const bf16*)(F.ws + WS_HYT); bf16* MIXED = (bf16*)(F.ws + WS_MIXED); const float* hg = F.in[16];
    LAS float* tile = (LAS float*)F.lds;
    LAS float* rs = (LAS float*)(F.lds + 128 * 65 * 4);
    for (int it = F.bid; it < 8 * (MT / 64); it += F.G) {
        const int gi = it & 7, m0 = (it >> 3) * 64;
        { const int ch = F.tid >> 2, t0 = (F.tid & 3) * 16; const bf16* p = HYT + (size_t)(gi * 128 + ch) * MT + m0 + t0;
          const v4u a = *(const GAS v4u*)p, b = *(const GAS v4u*)(p + 8);
          LAS float* d = tile + ch * 65 + t0;
          d[0] = bflo(a.x); d[1] = bfhi(a.x); d[2] = bflo(a.y); d[3] = bfhi(a.y); d[4] = bflo(a.z); d[5] = bfhi(a.z); d[6] = bflo(a.w); d[7] = bfhi(a.w);
          d[8] = bflo(b.x); d[9] = bfhi(b.x); d[10] = bflo(b.y); d[11] = bfhi(b.y); d[12] = bflo(b.z); d[13] = bfhi(b.z); d[14] = bflo(b.w); d[15] = bfhi(b.w); }
        __syncthreads();
        {
          const int t = F.tid >> 3, c0 = (F.tid & 7) * 16; float ss = 0.f;
#pragma unroll
          for (int c = 0; c < 16; ++c) { const float v = tile[(c0 + c) * 65 + t]; ss += v * v; }
          ss += __shfl_xor(ss, 1); ss += __shfl_xor(ss, 2); ss += __shfl_xor(ss, 4);
          if ((F.tid & 7) == 0) rs[t] = rsqrtf(ss * (1.f / 128) + EPS); }
        __syncthreads();
        {
          const int t = F.tid >> 3, c0 = (F.tid & 7) * 16; const float r = rs[t]; float o[16];
#pragma unroll
          for (int c = 0; c < 16; ++c) o[c] = tile[(c0 + c) * 65 + t] * r * hg[gi * 128 + c0 + c];
          v4u a, b; a.x = pk2(o[0], o[1]); a.y = pk2(o[2], o[3]); a.z = pk2(o[4], o[5]); a.w = pk2(o[6], o[7]); b.x = pk2(o[8], o[9]); b.y = pk2(o[10], o[11]); b.z = pk2(o[12], o[13]); b.w = pk2(o[14], o[15]);
          bf16* q = MIXED + (size_t)(m0 + t) * DM + AW + gi * 128 + c0; *(GAS v4u*)q = a; *(GAS v4u*)(q + 8) = b; }
        __syncthreads();
    }
}
__device__ __forceinline__ void phase_p35(Frame& F) {
    LAS float* wrT = (LAS float*)F.lds;
    const float* wr = F.in[19]; const float* g = F.in[18];
    for (int i = F.tid; i < DM * NE; i += NTHREADS) { const int d = i >> 4, e = i & 15; wrT[e * DM + d] = wr[i]; }
    __syncthreads();
    bf16* HB = (bf16*)(F.ws + WS_HB); float* AFF = (float*)(F.ws + WS_AFF); const float* x1 = F.out;
    for (int m = GW_ID(F); m < MT; m += GW_N(F)) {
        const GAS f32x4* xr = (const GAS f32x4*)(x1 + (size_t)m * DM) + F.lane;
        f32x4 v[8]; float s = 0.f;
#pragma unroll
        for (int j = 0; j < 8; ++j) { v[j] = xr[64 * j]; s += (v[j].x * v[j].x + v[j].y * v[j].y) + (v[j].z * v[j].z + v[j].w * v[j].w); }
        const float r = rsqrtf(wave_sum(s) * (1.f / DM) + EPS);
        GAS v2u* o8 = (GAS v2u*)(HB + (size_t)m * DM) + F.lane;
#pragma unroll
        for (int j = 0; j < 8; ++j) { const f32x4 gg = *((const GAS f32x4*)g + F.lane + 64 * j); v[j].x *= r * gg.x; v[j].y *= r * gg.y; v[j].z *= r * gg.z; v[j].w *= r * gg.w;
            v2u o; o.x = pk2(v[j].x, v[j].y); o.y = pk2(v[j].z, v[j].w); o8[64 * j] = o; }
        float mine = 0.f;
#pragma unroll 1
        for (int e = 0; e < NE; ++e) { float a = 0.f;
#pragma unroll
            for (int j = 0; j < 8; ++j) { const f32x4 w = *((const LAS f32x4*)(wrT + e * DM) + F.lane + 64 * j); a += (v[j].x * w.x + v[j].y * w.y) + (v[j].z * w.z + v[j].w * w.w); }
            a = wave_sum(a); mine = (F.lane == e) ? a : mine; }
        float mx = mine;
        mx = fmaxf(mx, __shfl_xor(mx, 1)); mx = fmaxf(mx, __shfl_xor(mx, 2)); mx = fmaxf(mx, __shfl_xor(mx, 4)); mx = fmaxf(mx, __shfl_xor(mx, 8));
        const float ex = expf(mine - mx); float den = ex;
        den += __shfl_xor(den, 1); den += __shfl_xor(den, 2); den += __shfl_xor(den, 4); den += __shfl_xor(den, 8);
        const int b = m / SEQ, sidx = m % SEQ;
        if (F.lane < NE) AFF[((size_t)b * NE + F.lane) * SEQ + sidx] = ex / den;
    }
    __syncthreads();
}
__device__ __forceinline__ void phase_p4(Frame& F) {
    LAS unsigned* key = (LAS unsigned*)F.lds;
    LAS unsigned* hist = (LAS unsigned*)(F.lds + 16384);
    LAS unsigned* wsum = (LAS unsigned*)(F.lds + 16384 + 1024);
    const float* AFF = (const float*)(F.ws + WS_AFF); int* IDX = (int*)(F.ws + WS_IDX); float* GATE = (float*)(F.ws + WS_GATE); int* SEL = (int*)(F.ws + WS_SEL);
    for (int be = F.bid; be < NB * NE; be += F.G) {
        const int b = be / NE, e = be % NE;
        __syncthreads();
        const GAS v4u* ap = (const GAS v4u*)(AFF + (size_t)be * SEQ);
        const v4u k0 = ap[2 * F.tid], k1 = ap[2 * F.tid + 1];
        unsigned kk[8] = {k0.x, k0.y, k0.z, k0.w, k1.x, k1.y, k1.z, k1.w};
        unsigned prefix = 0u, mask = 0u, remaining = CAP;
#pragma unroll 1
        for (int pass = 0; pass < 4; ++pass) {
            const int shift = 24 - 8 * pass;
            if (F.tid < 256) hist[F.tid] = 0u;
            __syncthreads();
#pragma unroll
            for (int i = 0; i < 8; ++i) if ((kk[i] & mask) == prefix) __hip_atomic_fetch_add(&hist[(kk[i] >> shift) & 255u], 1u, __ATOMIC_RELAXED, __HIP_MEMORY_SCOPE_WORKGROUP);
            __syncthreads();
            if (F.tid < 256) {
                unsigned above = 0u;
                for (int j = F.tid + 1; j < 256; ++j) above += hist[j];
                const unsigned mine = hist[F.tid];
                if (above < remaining && remaining <= above + mine) { wsum[8] = (unsigned)F.tid; wsum[9] = above; }
            }
            __syncthreads();
            const unsigned d = wsum[8], above = wsum[9];
            prefix |= d << shift; mask |= 255u << shift; remaining -= above;
            __syncthreads();
        }
        const unsigned thr = prefix;
        unsigned cnt = 0u;
#pragma unroll
        for (int i = 0; i < 8; ++i) cnt += (kk[i] > thr ? 0x10000u : 0u) + (kk[i] == thr ? 1u : 0u);
        unsigned incl = cnt;
#pragma unroll
        for (int o = 1; o < 64; o <<= 1) { const unsigned t = __shfl_up(incl, o); if (F.lane >= o) incl += t; }
        if (F.lane == 63) wsum[F.wave] = incl;
        __syncthreads();
        unsigned base = 0u;
        for (int w = 0; w < F.wave; ++w) base += wsum[w];
        unsigned run = base + incl - cnt;
#pragma unroll
        for (int i = 0; i < 8; ++i) {
            const unsigned gt_before = run >> 16, tie_before = run & 0xffffu;
            const bool isgt = kk[i] > thr, istie = kk[i] == thr;
            const bool sel = isgt || (istie && tie_before < remaining);
            const unsigned slot = gt_before + (tie_before < remaining ? tie_before : remaining);
            const int s = 8 * F.tid + i, m = b * SEQ + s;
            if (sel) { IDX[be * CAP + slot] = m; GATE[be * CAP + slot] = __builtin_bit_cast(float, kk[i]); }
            SEL[(size_t)m * NE + e] = sel ? (int)slot : -1;
            run += (isgt ? 0x10000u : 0u) + (istie ? 1u : 0u);
        }
    }
    __syncthreads();
}
__device__ __forceinline__ void phase_p7(Frame& F) {
    const int* SEL = (const int*)(F.ws + WS_SEL); const float* GATE = (const float*)(F.ws + WS_GATE); const bf16* YE = (const bf16*)(F.ws + WS_YE);
    for (int m = GW_ID(F); m < MT; m += GW_N(F)) {
        const int b = m / SEQ;
        GAS f32x4* orow = (GAS f32x4*)(F.out + (size_t)m * DM);
        f32x4 acc[8];
#pragma unroll
        for (int j = 0; j < 8; ++j) acc[j] = orow[2 * F.lane + (j & 1) + 128 * (j >> 1)];
        for (int e = 0; e < NE; ++e) { const int slot = SEL[(size_t)m * NE + e]; if (slot >= 0) {
            const GAS v4u* yr = (const GAS v4u*)(YE + (size_t)((b * NE + e) * CAP + slot) * DM) + F.lane;
#pragma unroll
            for (int jj = 0; jj < 4; ++jj) { const v4u w = yr[64 * jj];
                acc[2 * jj].x += bflo(w.x); acc[2 * jj].y += bfhi(w.x); acc[2 * jj].z += bflo(w.y); acc[2 * jj].w += bfhi(w.y);
                acc[2 * jj + 1].x += bflo(w.z); acc[2 * jj + 1].y += bfhi(w.z); acc[2 * jj + 1].z += bflo(w.w); acc[2 * jj + 1].w += bfhi(w.w); } } }
#pragma unroll
        for (int j = 0; j < 8; ++j) orow[2 * F.lane + (j & 1) + 128 * (j >> 1)] = acc[j];
    }
    (void)GATE;
}

struct Args { const float* in[23]; float* out; unsigned char* ws; int ph_lo, ph_hi; };
enum Phase { PH_P0 = 0, PH_G1, PH_FILT, PH_ATTN, PH_P25, PH_OUT, PH_P35, PH_P4, PH_UP, PH_DOWN, PH_P7, PH_COUNT };

__global__ void __launch_bounds__(NTHREADS, 2) mk_fwd(Args args) {
    extern __shared__ __attribute__((aligned(16))) unsigned char lds_raw[];
    Frame F;
    F.lds = (LAS unsigned char*)lds_raw;
    F.tid = threadIdx.x; F.lane = F.tid & 63; F.wave = __builtin_amdgcn_readfirstlane(F.tid >> 6); F.G = gridDim.x; F.bid = blockIdx.x;
#pragma unroll
    for (int i = 0; i < 23; ++i) F.in[i] = args.in[i];
    F.out = args.out; F.ws = args.ws;
    const int lo = args.ph_lo, hi = args.ph_hi;
#define IN(k) (lo <= (k) && (k) < hi)
#define REPS(k) for (int rep_ = 0; rep_ < ((k) == REP_PHASE ? REP_N : 1); ++rep_)
#if MK_N_LAUNCHES == 1
    { volatile LAS unsigned* misc = (volatile LAS unsigned*)(F.lds + LDS_MISC_OFF); if (F.tid < 16) misc[F.tid] = 0u; }
    __syncthreads();
    XcdBarrier bar = xcd_barrier_post((unsigned*)(F.ws + WS_CTL) + 4096, (volatile LAS unsigned*)(F.lds + LDS_MISC_OFF) + 8);
#define SEAM(k) do { if (IN(k) && IN((k) + 1)) xcd_barrier(bar); } while (0)
#else
#define SEAM(k) do { } while (0)
#endif
    if (IN(PH_P0)) REPS(PH_P0) { phase_p0(F); for (int it = GW_ID(F); it < MOE_P0_ITEMS; it += GW_N(F)) moe_conv_item(F, it); } SEAM(PH_P0);
    if (IN(PH_G1)) REPS(PH_G1) {
        __syncthreads();
        { pg8::DenseOrder S; S.init(F.ws + WS_HB, F.ws + WS_WIN, MT, 2048, DM, 0, F.G, F.bid);
          pg8::EpiBf16 E{(pg8::bf16_t*)(F.ws + WS_QK), 2048, 0, nullptr};
          pg8::gemm_phase<pg8::EpiBf16, pg8::DenseOrder, true>(F.lds, DM, S, E); }
        { pg8::DenseOrder S; S.init(F.ws + WS_HB, F.ws + WS_WIN, MT, 4096, DM, 8, F.G, F.bid);
          pg8::EpiTransBf16 E{(pg8::bf16_t*)(F.ws + WS_XT), MT, 8};
          pg8::gemm_phase<pg8::EpiTransBf16, pg8::DenseOrder, true>(F.lds, DM, S, E); }
    } SEAM(PH_G1);
    if (IN(PH_FILT)) REPS(PH_FILT) { phase_filters(F); } SEAM(PH_FILT);
    if (IN(PH_ATTN)) { __syncthreads(); for (int rep_ = 0; rep_ < ((PH_ATTN == REP_PHASE && REP_SUB != 2) ? REP_N : 1); ++rep_) phase_hyena(F); for (int rep_ = 0; rep_ < ((PH_ATTN == REP_PHASE && REP_SUB != 1) ? REP_N : 1); ++rep_) phase_attn2(F); } SEAM(PH_ATTN);
    if (IN(PH_P25)) REPS(PH_P25) { __syncthreads(); phase_p25(F); } SEAM(PH_P25);
    if (IN(PH_OUT)) REPS(PH_OUT) {
        __syncthreads();
        pg8::DenseOrder S; S.init(F.ws + WS_MIXED, F.ws + WS_WOUT, MT, DM, DM, 0, F.G, F.bid);
        pg8::EpiResF32 E{F.in[0], F.out, DM};
        pg8::gemm_phase<pg8::EpiResF32, pg8::DenseOrder, false>(F.lds, DM, S, E);
    } SEAM(PH_OUT);
    if (IN(PH_P35)) REPS(PH_P35) { __syncthreads(); phase_p35(F); } SEAM(PH_P35);
    if (IN(PH_P4)) REPS(PH_P4) { __syncthreads(); phase_p4(F); } SEAM(PH_P4);
    if (IN(PH_UP)) REPS(PH_UP) {
        __syncthreads();
        pg8::MoeOrder S; S.init(F.ws + WS_HB, F.ws + WS_WGU, DM, F.G, F.bid, true);
        LAS int* ridx = (LAS int*)(F.lds + 131072);
        { const int* IDX = (const int*)(F.ws + WS_IDX); pg8::Unit u;
          for (int i = 0; S.next(i, u); ++i) if (F.tid < 256) ridx[i * 256 + F.tid] = IDX[u.g * CAP + u.pm * 256 + F.tid]; }
        __syncthreads();
        pg8::EpiSwiGLU E{(pg8::bf16_t*)(F.ws + WS_ACT)};
        pg8::gemm_phase<pg8::EpiSwiGLU, pg8::MoeOrder, true, true>(F.lds, DM, S, E, ridx);
    } SEAM(PH_UP);
    if (IN(PH_DOWN)) REPS(PH_DOWN) {
        __syncthreads();
        pg8::MoeOrder S; S.init(F.ws + WS_ACT, F.ws + WS_WD, FF, F.G, F.bid, false);
        pg8::EpiBf16 E{(pg8::bf16_t*)(F.ws + WS_YE), DM, 512, (const float*)(F.ws + WS_GATE)};
        pg8::gemm_phase<pg8::EpiBf16, pg8::MoeOrder, true>(F.lds, FF, S, E);
    } SEAM(PH_DOWN);
    if (IN(PH_P7)) { phase_p7(F); }
#undef IN
#undef SEAM
}

extern "C" void kernel_launch(void* const* d_in, const int* in_sizes, int n_in, void* d_out, int out_size, void* d_ws, size_t ws_size, hipStream_t stream) {
    static int grid = 0;
    if (grid == 0) {
        if (n_in != 23 || ws_size < WS_END) { fprintf(stderr, "kernel_launch: unexpected inputs (n_in %d, ws %zu)\n", n_in, ws_size); grid = -1; return; }
        if (hipFuncSetAttribute((const void*)mk_fwd, hipFuncAttributeMaxDynamicSharedMemorySize, LDS_BYTES) != hipSuccess) { fprintf(stderr, "kernel_launch: hipFuncSetAttribute failed\n"); grid = -1; return; }
        int dev = 0, cus = 0, per_cu = 0;
        hipGetDevice(&dev); hipDeviceGetAttribute(&cus, hipDeviceAttributeMultiprocessorCount, dev);
        hipOccupancyMaxActiveBlocksPerMultiprocessor(&per_cu, (const void*)mk_fwd, NTHREADS, LDS_BYTES);
        (void)hipGetLastError();
        if (per_cu < 1) { fprintf(stderr, "kernel_launch: occupancy query says %d blocks/CU\n", per_cu); }
        grid = cus;
    }
    if (grid < 0) return;
    Args a{};
    for (int i = 0; i < 23; ++i) a.in[i] = (const float*)d_in[i];
    a.out = (float*)d_out; a.ws = (unsigned char*)d_ws;
#if MK_N_LAUNCHES == 1
    if (hipMemsetAsync((char*)d_ws + WS_CTL, 0, CTL_ZERO_BYTES, stream) != hipSuccess) { fprintf(stderr, "kernel_launch: memset failed\n"); return; }
    a.ph_lo = 0; a.ph_hi = PH_COUNT;
    void* kargs[] = {&a};
    hipError_t e = hipLaunchCooperativeKernel((const void*)mk_fwd, dim3(grid), dim3(NTHREADS), kargs, LDS_BYTES, stream);
    if (e != hipSuccess) fprintf(stderr, "cooperative launch failed: %s (grid %d)\n", hipGetErrorString(e), grid);
#else
    for (int p = 0; p < PH_COUNT; ++p) { a.ph_lo = p; a.ph_hi = p + 1; hipLaunchKernelGGL(mk_fwd, dim3(grid), dim3(NTHREADS), LDS_BYTES, stream, a); }
#endif
}
```

```cpp
#include <hip/hip_runtime.h>
#include <hip/hip_cooperative_groups.h>
#include <cstdio>
#include <cstdint>
namespace cg = cooperative_groups;

#ifndef REP_PHASE
#define REP_PHASE -1
#define REP_N 1
#define REP_SUB 0
#endif
#ifndef MK_N_LAUNCHES
#define MK_N_LAUNCHES 1
#endif

namespace pg8 {
#define PG8_LAS __attribute__((address_space(3)))
typedef unsigned short bf16_t;
typedef short bf16x8 __attribute__((ext_vector_type(8)));
typedef float f32x4 __attribute__((ext_vector_type(4)));
typedef unsigned u32x4 __attribute__((ext_vector_type(4)));
typedef unsigned u32x2 __attribute__((ext_vector_type(2)));
constexpr int BM = 256, BK = 64, HALF = 128, HTB = HALF * BK * 2, STAGE_BYTES = 8 * HTB, NXCD = 8, WGM = 8;

__host__ __device__ __forceinline__ int lds_byte(int r, int c) { const int st = (r >> 4) * 2 + (c >> 5), rr = r & 15, cc = c & 31, ob = rr * 64 + cc * 2; return st * 1024 + (ob ^ (((ob >> 9) & 1) << 5)); }
__host__ __device__ __forceinline__ void stage_rc(int b, int& R, int& C) { const int st = b / 1024, sb = b % 1024, swz = sb ^ (((sb >> 9) & 1) << 5); R = (st >> 1) * 16 + swz / 64; C = (st & 1) * 32 + (swz % 64) / 2; }
__host__ __device__ __forceinline__ int perm32(int rho) { const int n = rho >> 4, i = rho & 15; return 8 * (i >> 2) + 4 * n + (i & 3); }

struct Unit { int pm, pn, g; const char* a; const char* b; };

__device__ __forceinline__ unsigned cvt_pk_bf16(float lo, float hi) { unsigned r; asm volatile("v_cvt_pk_bf16_f32 %0, %1, %2" : "=v"(r) : "v"(lo), "v"(hi)); return r; }

struct DenseOrder {
    static constexpr bool CHUNK_B = false;
    int nM, nN, nwg, G, c, K, pn0; const char* A; const char* Bt;
    __device__ void init(const void* A_, const void* Bt_, int M, int N, int K_, int pn0_, int G_, int c_) { A = (const char*)A_; Bt = (const char*)Bt_; nM = M / BM; nN = N / BM; nwg = nM * nN; G = G_; c = c_; K = K_; pn0 = pn0_; }
    __device__ bool next(int i, Unit& u) const {
        const long L = (long)i * G + c; if (L >= nwg) return false;
        int wgid = (int)L; { const int q = nwg / NXCD, r = nwg % NXCD, xcd = wgid % NXCD, off = wgid / NXCD; wgid = (xcd < r ? xcd * (q + 1) : r * (q + 1) + (xcd - r) * q) + off; }
        const int nig = WGM * nN, gid = wgid / nig, fm = gid * WGM, gsz = (nM - fm) < WGM ? (nM - fm) : WGM;
        u.pm = fm + ((wgid % nig) % gsz); u.pn = pn0 + (wgid % nig) / gsz; u.g = 0;
        u.a = A + (size_t)u.pm * BM * K * 2; u.b = Bt + (size_t)u.pn * BM * K * 2; return true;
    }
};
struct MoeOrder {
    static constexpr bool CHUNK_B = true;
    int G, c, K; bool gather; const char* A; const char* Bt;
    __device__ void init(const void* A_, const void* Bt_, int K_, int G_, int c_, bool gather_) { A = (const char*)A_; Bt = (const char*)Bt_; K = K_; G = G_; c = c_; gather = gather_; }
    __device__ bool next(int i, Unit& u) const {
        const int L = i * G + c; if (L >= 512) return false;
        const int pn = L & 7, pm = (L >> 3) & 1, b = (L >> 4) & 1, e = L >> 5;
        u.pm = pm; u.pn = pn; u.g = b * 16 + e;
        u.a = gather ? A : A + (size_t)(u.g * 512 + pm * BM) * K * 2; u.b = Bt + (size_t)e * 2048 * K * 2 + (size_t)pn * BM * 16; return true;
    }
};

struct EpiBf16 {
    static constexpr bool PERM = true, SWAP = false;
    bf16_t* O; int ldc; int grows; const float* rscale;
    __device__ __forceinline__ void operator()(const f32x4 (&acc)[2][2][4][2], const Unit& u, int wr, int wc, int fr, int fq) const {
        const int row0 = u.g * grows + u.pm * BM + wr * 64 + fr, col0 = u.pn * BM + wc * 32 + 8 * fq;
#pragma unroll
        for (int ai = 0; ai < 2; ++ai)
#pragma unroll
            for (int m = 0; m < 4; ++m) { const int row = row0 + ai * HALF + m * 16; bf16_t* rowp = O + (size_t)row * ldc + col0; const float sc = rscale ? rscale[row] : 1.f;
#pragma unroll
                for (int bj = 0; bj < 2; ++bj) { const f32x4 v0 = acc[ai][bj][m][0] * sc, v1 = acc[ai][bj][m][1] * sc;
                    u32x4 w; w.x = cvt_pk_bf16(v0[0], v0[1]); w.y = cvt_pk_bf16(v0[2], v0[3]); w.z = cvt_pk_bf16(v1[0], v1[1]); w.w = cvt_pk_bf16(v1[2], v1[3]);
                    *(u32x4*)(rowp + bj * HALF) = w; } }
    }
};
struct EpiSwiGLU {
    static constexpr bool PERM = true, SWAP = false;
    bf16_t* O;
    __device__ __forceinline__ void operator()(const f32x4 (&acc)[2][2][4][2], const Unit& u, int wr, int wc, int fr, int fq) const {
        const int row0 = u.g * 512 + u.pm * BM + wr * 64 + fr, col0 = u.pn * HALF + wc * 32 + 8 * fq;
#pragma unroll
        for (int ai = 0; ai < 2; ++ai)
#pragma unroll
            for (int m = 0; m < 4; ++m) { bf16_t* rowp = O + (size_t)(row0 + ai * HALF + m * 16) * 1024 + col0;
                float r[8];
#pragma unroll
                for (int n = 0; n < 2; ++n)
#pragma unroll
                    for (int e = 0; e < 4; ++e) { const float g = acc[ai][0][m][n][e], up = acc[ai][1][m][n][e]; r[n * 4 + e] = g / (1.f + __expf(-g)) * up; }
                u32x4 w; w.x = cvt_pk_bf16(r[0], r[1]); w.y = cvt_pk_bf16(r[2], r[3]); w.z = cvt_pk_bf16(r[4], r[5]); w.w = cvt_pk_bf16(r[6], r[7]);
                *(u32x4*)rowp = w; }
    }
};
struct EpiResF32 {
    static constexpr bool PERM = false, SWAP = false;
    const float* res; float* out; int ldc;
    __device__ __forceinline__ void operator()(const f32x4 (&acc)[2][2][4][2], const Unit& u, int wr, int wc, int fr, int fq) const {
        const int row0 = u.pm * BM + wr * 64 + fr, col0 = u.pn * BM + wc * 32 + 4 * fq;
#pragma unroll
        for (int ai = 0; ai < 2; ++ai)
#pragma unroll
            for (int m = 0; m < 4; ++m) { const size_t off = (size_t)(row0 + ai * HALF + m * 16) * ldc + col0;
#pragma unroll
                for (int bj = 0; bj < 2; ++bj)
#pragma unroll
                    for (int n = 0; n < 2; ++n) { const f32x4 r = *(const f32x4*)(res + off + bj * HALF + n * 16); *(f32x4*)(out + off + bj * HALF + n * 16) = r + acc[ai][bj][m][n]; } }
    }
};
struct EpiTransBf16 {
    static constexpr bool PERM = false, SWAP = true;
    bf16_t* O; int ldt; int pn_base;
    __device__ __forceinline__ void operator()(const f32x4 (&acc)[2][2][4][2], const Unit& u, int wr, int wc, int fr, int fq) const {
        const int ch0 = (u.pn - pn_base) * BM + wc * 32 + fr, t0 = u.pm * BM + wr * 64 + 4 * fq;
#pragma unroll
        for (int bj = 0; bj < 2; ++bj)
#pragma unroll
            for (int n = 0; n < 2; ++n) { bf16_t* chp = O + (size_t)(ch0 + bj * HALF + n * 16) * ldt + t0;
#pragma unroll
                for (int ai = 0; ai < 2; ++ai)
#pragma unroll
                    for (int m = 0; m < 4; ++m) { const f32x4 v = acc[ai][bj][m][n]; u32x2 w; w.x = cvt_pk_bf16(v[0], v[1]); w.y = cvt_pk_bf16(v[2], v[3]); *(u32x2*)(chp + ai * HALF + m * 16) = w; } }
    }
};

template <class Epi, class Sched, bool ALIGN_EPI = false, bool GATHER = false>
__device__ __forceinline__ void gemm_phase(PG8_LAS unsigned char* lds, const int K, const Sched& S, const Epi& E, const PG8_LAS int* ridx = nullptr) {
    const int tid = threadIdx.x, wid = __builtin_amdgcn_readfirstlane(tid >> 6), lane = tid & 63, wr = wid >> 2, wc = wid & 3, fr = lane & 15, fq = lane >> 4;
    const int nt = K / BK;
    unsigned vA0[2], vA1[2], vN0[2], vN1[2], voffB[2]; int stR[2], stC[2];
    const size_t kstep = (size_t)(BK * 2);
    const size_t hstep = (size_t)HALF * K * 2;
    const size_t kstepB = Sched::CHUNK_B ? (size_t)(BK / 8) * 2048 * 16 : kstep, hstepB = Sched::CHUNK_B ? (size_t)HALF * 16 : hstep;
#pragma unroll
    for (int i = 0; i < 2; ++i) { int R, C; stage_rc(tid * 16 + i * 8192, R, C); const int Rb = Epi::PERM ? ((R & ~31) + perm32(R & 31)) : R; stR[i] = R; stC[i] = C;
        voffB[i] = Sched::CHUNK_B ? (unsigned)(((C >> 3) * 2048 + Rb) * 16) : (unsigned)(Rb * K + C) * 2u;
        if constexpr (GATHER) { vA0[i] = (unsigned)(ridx[R] * K + C) * 2u; vA1[i] = (unsigned)(ridx[HALF + R] * K + C) * 2u; }
        else { vA0[i] = (unsigned)(R * K + C) * 2u; vA1[i] = vA0[i] + (unsigned)hstep; }
        vN0[i] = vA0[i]; vN1[i] = vA1[i]; }
    const unsigned ldsw = (unsigned)wid * 1024u;
    const int aoff = lds_byte(wr * 64 + fr, fq * 8), boff = lds_byte(wc * 32 + fr, fq * 8);
#define PG8_SA(b, h) (((b) * 2 + (h)) * HTB)
#define PG8_SB(b, h) ((4 + (b) * 2 + (h)) * HTB)
#define PG8_STAGE(bufoff, gbase, voff) do { _Pragma("unroll") for (int _i = 0; _i < 2; ++_i) \
        __builtin_amdgcn_global_load_lds((const unsigned*)((const char*)(gbase) + (voff)[_i]), (PG8_LAS unsigned*)(lds + (bufoff) + ldsw + _i * 8192), 16, 0, 0); } while (0)
#define PG8_LDA(dst, b, h) do { _Pragma("unroll") for (int m = 0; m < 4; ++m) _Pragma("unroll") for (int k = 0; k < 2; ++k) dst[m][k] = *(const PG8_LAS bf16x8*)(lds + PG8_SA(b, h) + aoff + m * 2048 + k * 1024); } while (0)
#define PG8_LDB(dst, b, h) do { _Pragma("unroll") for (int n = 0; n < 2; ++n) _Pragma("unroll") for (int k = 0; k < 2; ++k) dst[n][k] = *(const PG8_LAS bf16x8*)(lds + PG8_SB(b, h) + boff + n * 2048 + k * 1024); } while (0)
#define PG8_MMA(ai, bj, At, Bt) do { __builtin_amdgcn_s_setprio(1); _Pragma("unroll") for (int m = 0; m < 4; ++m) _Pragma("unroll") for (int n = 0; n < 2; ++n) _Pragma("unroll") for (int k = 0; k < 2; ++k) \
        acc[ai][bj][m][n] = Epi::SWAP ? __builtin_amdgcn_mfma_f32_16x16x32_bf16(At[m][k], Bt[n][k], acc[ai][bj][m][n], 0, 0, 0) : __builtin_amdgcn_mfma_f32_16x16x32_bf16(Bt[n][k], At[m][k], acc[ai][bj][m][n], 0, 0, 0); __builtin_amdgcn_s_setprio(0); } while (0)
#define PG8_WAIT_V(n) asm volatile("s_waitcnt vmcnt(" #n ")" ::: "memory")
#define PG8_WAIT_L(n) asm volatile("s_waitcnt lgkmcnt(" #n ")" ::: "memory")
#define PG8_BAR __builtin_amdgcn_s_barrier()
#define PG8_SCHED __builtin_amdgcn_sched_barrier(0)
    Unit cur, nxt; int ui = 0;
    if (!S.next(0, cur)) return;
    f32x4 acc[2][2][4][2];
#pragma unroll
    for (int a = 0; a < 2; ++a)
#pragma unroll
        for (int b = 0; b < 2; ++b)
#pragma unroll
            for (int m = 0; m < 4; ++m)
#pragma unroll
                for (int n = 0; n < 2; ++n) acc[a][b][m][n] = (f32x4){0.f, 0.f, 0.f, 0.f};
    bf16x8 At[4][2], B0[2][2], B1[2][2];
    const char* cA = cur.a; const char* cB = cur.b;
    PG8_STAGE(PG8_SB(0, 0), cB, voffB); PG8_STAGE(PG8_SB(0, 1), cB + hstepB, voffB); PG8_STAGE(PG8_SA(0, 0), cA, vA0); PG8_STAGE(PG8_SA(0, 1), cA, vA1);
    if (wr == 1) PG8_BAR;
    PG8_WAIT_V(2); PG8_BAR;
    PG8_STAGE(PG8_SB(1, 0), cB + kstepB, voffB); PG8_STAGE(PG8_SA(1, 0), cA + kstep, vA0); PG8_STAGE(PG8_SB(1, 1), cB + hstepB + kstepB, voffB);
    PG8_WAIT_V(6); PG8_BAR;
    for (;;) {
        const bool has_next = S.next(ui + 1, nxt);
        const char* nA = has_next ? nxt.a : cA; const char* nB = has_next ? nxt.b : cB;
        if constexpr (GATHER) { if (has_next) {
#pragma unroll
            for (int i = 0; i < 2; ++i) { vN0[i] = (unsigned)(ridx[(ui + 1) * 256 + stR[i]] * K + stC[i]) * 2u; vN1[i] = (unsigned)(ridx[(ui + 1) * 256 + HALF + stR[i]] * K + stC[i]) * 2u; } } }
        for (int t = 0; t < nt; t += 2) {
            const bool last = (t == nt - 2);
            const char* a1 = cA + (size_t)(t + 1) * kstep;
            const char* a2 = last ? nA : cA + (size_t)(t + 2) * kstep; const char* b2 = last ? nB : cB + (size_t)(t + 2) * kstepB;
            const char* a3 = a2 + kstep; const char* b3 = b2 + kstepB;
            unsigned w0[2], w1[2];
#pragma unroll
            for (int i = 0; i < 2; ++i) { w0[i] = last ? vN0[i] : vA0[i]; w1[i] = last ? vN1[i] : vA1[i]; }
            PG8_LDB(B0, 0, 0); PG8_LDB(B1, 0, 1); PG8_SCHED; PG8_LDA(At, 0, 0); PG8_STAGE(PG8_SA(1, 1), a1, vA1);
            PG8_WAIT_V(8); PG8_WAIT_L(0); PG8_BAR; PG8_MMA(0, 0, At, B0); PG8_MMA(0, 1, At, B1); PG8_BAR; PG8_SCHED;
            PG8_LDA(At, 0, 1); PG8_STAGE(PG8_SB(0, 0), b2, voffB); PG8_STAGE(PG8_SB(0, 1), b2 + hstepB, voffB); PG8_STAGE(PG8_SA(0, 0), a2, w0);
            PG8_WAIT_V(8); PG8_WAIT_L(0); PG8_BAR; PG8_MMA(1, 0, At, B0); PG8_MMA(1, 1, At, B1); PG8_BAR; PG8_SCHED;
            PG8_LDB(B0, 1, 0); PG8_LDB(B1, 1, 1); PG8_SCHED; PG8_LDA(At, 1, 0); PG8_STAGE(PG8_SA(0, 1), a2, w1);
            PG8_WAIT_V(8); PG8_WAIT_L(0); PG8_BAR; PG8_MMA(0, 0, At, B0); PG8_MMA(0, 1, At, B1); PG8_BAR; PG8_SCHED;
            PG8_LDA(At, 1, 1); PG8_STAGE(PG8_SB(1, 0), b3, voffB); PG8_STAGE(PG8_SB(1, 1), b3 + hstepB, voffB); PG8_STAGE(PG8_SA(1, 0), a3, w0);
            PG8_WAIT_V(8); PG8_WAIT_L(0); PG8_BAR; PG8_MMA(1, 0, At, B0); PG8_MMA(1, 1, At, B1); PG8_BAR; PG8_SCHED;
        }
        if constexpr (ALIGN_EPI) { if (wr == 0) PG8_BAR; }
        E(acc, cur, wr, wc, fr, fq);
        if (!has_next) break;
#pragma unroll
        for (int a = 0; a < 2; ++a)
#pragma unroll
            for (int b = 0; b < 2; ++b)
#pragma unroll
                for (int m = 0; m < 4; ++m)
#pragma unroll
                    for (int n = 0; n < 2; ++n) acc[a][b][m][n] = (f32x4){0.f, 0.f, 0.f, 0.f};
        cur = nxt; cA = nA; cB = nB; ++ui;
#pragma unroll
        for (int i = 0; i < 2; ++i) { vA0[i] = vN0[i]; vA1[i] = vN1[i]; }
        if constexpr (ALIGN_EPI) { if (wr == 1) PG8_BAR; }
    }
    PG8_WAIT_V(0);
    if constexpr (!ALIGN_EPI) { if (wr == 0) PG8_BAR; }
    PG8_BAR;
#undef PG8_SA
#undef PG8_SB
#undef PG8_STAGE
#undef PG8_LDA
#undef PG8_LDB
#undef PG8_MMA
#undef PG8_WAIT_V
#undef PG8_WAIT_L
#undef PG8_BAR
#undef PG8_SCHED
}
}

constexpr int NB = 2, SEQ = 4096, DM = 2048, MT = NB * SEQ;
constexpr int NH = 8, HD = 128, AW = 1024, HW = 1024, INW = 6144;
constexpr int GW = 64, NROWS = 64, WR = 8, WC = 16;
constexpr int NE = 16, CAP = 512, FF = 1024;
constexpr int FEMB = 33, FHID = 64;
constexpr float EPS = 1e-6f;
constexpr int NWAVES = 8, NTHREADS = 512;

constexpr size_t MiB = 1u << 20;
constexpr size_t WS_CTL = 0, CTL_ZERO_BYTES = 1 * MiB;
constexpr size_t WS_WIN = 2 * MiB;
constexpr size_t WS_WOUT = 26 * MiB;
constexpr size_t WS_WGU = 34 * MiB;
constexpr size_t WS_WD = 162 * MiB;
constexpr size_t WS_W3T = 226 * MiB;
constexpr size_t WS_HID2 = 227 * MiB;
constexpr size_t WS_HB = 228 * MiB;
constexpr size_t WS_QK = 260 * MiB;
constexpr size_t WS_XT = 292 * MiB;
constexpr size_t WS_UC = 356 * MiB;
constexpr size_t WS_TAPS = 404 * MiB;
constexpr size_t WS_HYT = 436 * MiB;
constexpr size_t WS_MIXED = 452 * MiB;
constexpr size_t WS_AFF = 484 * MiB;
constexpr size_t WS_IDX = 485 * MiB;
constexpr size_t WS_GATE = 486 * MiB;
constexpr size_t WS_SEL = 487 * MiB;
constexpr size_t WS_Z1T = 488 * MiB;
constexpr size_t WS_XG = WS_XT;
constexpr size_t WS_ACT = WS_UC;
constexpr size_t WS_YE = WS_TAPS;
constexpr size_t WS_END = 504 * MiB;

constexpr int LDS_BYTES = 163840, LDS_MISC_OFF = 163840 - 128;

#define GAS __attribute__((address_space(1)))
#define LAS __attribute__((address_space(3)))
typedef unsigned short bf16;
typedef unsigned v4u __attribute__((ext_vector_type(4)));
typedef unsigned v2u __attribute__((ext_vector_type(2)));
typedef float f32x4 __attribute__((ext_vector_type(4)));
#define LDS_WAIT() asm volatile("s_waitcnt lgkmcnt(0)" ::: "memory")
#define VM_WAIT() asm volatile("s_waitcnt vmcnt(0)" ::: "memory")
__device__ __forceinline__ unsigned f2bf(float f) { unsigned u = __builtin_bit_cast(unsigned, f); return (u + 0x7fffu + ((u >> 16) & 1u)) >> 16; }
__device__ __forceinline__ unsigned pk2(float lo, float hi) { unsigned r; asm("v_cvt_pk_bf16_f32 %0, %1, %2" : "=v"(r) : "v"(lo), "v"(hi)); return r; }
__device__ __forceinline__ float bf2f(unsigned h) { return __builtin_bit_cast(float, h << 16); }
__device__ __forceinline__ float bflo(unsigned w) { return __builtin_bit_cast(float, w << 16); }
__device__ __forceinline__ float bfhi(unsigned w) { return __builtin_bit_cast(float, w & 0xffff0000u); }
__device__ __forceinline__ float wave_sum(float v) {
#pragma unroll
    for (int o = 1; o < 64; o <<= 1) v += __shfl_xor(v, o);
    return v;
}


#define XB_TMO      128
#define XB_XCNT(j)  (256  + 64 * (j))
#define XB_XSUB(j)  (1280 + 64 * (j))
#define XB_XGEN(j)  (2304 + 64 * (j))
#define XB_TOP      3328
#define XB_TOPGEN   3392
#define XCD_BAR_WORDS 3456
#define XB_SPIN_CAP (1u << 22)
__device__ __forceinline__ unsigned xb_ld(unsigned* p)              { return __hip_atomic_load(p, __ATOMIC_RELAXED, __HIP_MEMORY_SCOPE_AGENT); }
__device__ __forceinline__ unsigned xb_add(unsigned* p, unsigned v) { return __hip_atomic_fetch_add(p, v, __ATOMIC_RELAXED, __HIP_MEMORY_SCOPE_AGENT); }
__device__ __forceinline__ unsigned xb_xcc_id() { return (unsigned)__builtin_amdgcn_s_getreg((3 << 11) | 20) & 0xFu; }
#define XB_SPIN(cond, bar) do { unsigned _sp = 0; while (cond) { __builtin_amdgcn_s_sleep(1); \
    if ((++_sp & 255u) == 0u) { if (xb_ld(&(bar)[XB_TMO])) break; if (_sp > XB_SPIN_CAP) { atomicAdd(&(bar)[XB_TMO], 1u); break; } } } } while (0)
struct XcdBarrier { unsigned* bar; unsigned x; volatile LAS unsigned* st; };
__device__ __forceinline__ XcdBarrier xcd_barrier_post(unsigned* bar, volatile LAS unsigned* st) {
    XcdBarrier b; b.bar = bar; b.x = xb_xcc_id(); b.st = st;
    if (threadIdx.x == 0) (void)xb_add(&bar[XB_XCNT(b.x)], 1u);
    return b;
}
__device__ __forceinline__ void xcd_barrier_complete(unsigned* bar, unsigned x, unsigned& nloc, unsigned& nx) {
    const unsigned G = gridDim.x * gridDim.y * gridDim.z;
    unsigned sum, cnt, mine, sp = 0u;
    for (;;) {
        sum = 0u; cnt = 0u; mine = 0u;
#pragma unroll
        for (unsigned j = 0; j < 16; ++j) { const unsigned c = xb_ld(&bar[XB_XCNT(j)]); sum += c; cnt += (c > 0u) ? 1u : 0u; mine = (j == x) ? c : mine; }
        if (sum == G) break;
        __builtin_amdgcn_s_sleep(1);
        if ((++sp & 255u) == 0u) { if (xb_ld(&bar[XB_TMO])) break; if (sp > XB_SPIN_CAP) { atomicAdd(&bar[XB_TMO], 1u); break; } }
    }
    nloc = mine > 0u ? mine : 1u; nx = cnt > 0u ? cnt : 1u;
}
__device__ __forceinline__ void xcd_barrier(const XcdBarrier& b) {
    asm volatile("s_waitcnt vmcnt(0)" ::: "memory");
    __syncthreads();
    if (threadIdx.x == 0) {
        unsigned* bar = b.bar;
        __builtin_amdgcn_s_waitcnt(0);
        unsigned nloc = b.st[0], nx = b.st[1];
        if (nloc == 0u) { xcd_barrier_complete(bar, b.x, nloc, nx); b.st[0] = nloc; b.st[1] = nx; }
        const unsigned old = xb_add(&bar[XB_XSUB(b.x)], 1u);
        const unsigned gen = old / nloc;
        if (old + 1u == (gen + 1u) * nloc) {
            __builtin_amdgcn_fence(__ATOMIC_RELEASE, "agent");
            asm volatile("s_waitcnt vmcnt(0)" ::: "memory");
            const unsigned og = xb_add(&bar[XB_TOP], 1u);
            const unsigned tg = og / nx;
            if (og + 1u == (tg + 1u) * nx) xb_add(&bar[XB_TOPGEN], 1u);
            else XB_SPIN(xb_ld(&bar[XB_TOPGEN]) == tg, bar);
            __builtin_amdgcn_fence(__ATOMIC_ACQUIRE, "agent");
            xb_add(&bar[XB_XGEN(b.x)], 1u);
            asm volatile("s_waitcnt vmcnt(0)" ::: "memory");
        } else {
            XB_SPIN(xb_ld(&bar[XB_XGEN(b.x)]) == gen, bar);
            __builtin_amdgcn_fence(__ATOMIC_ACQUIRE, "agent");
            asm volatile("s_waitcnt vmcnt(0)" ::: "memory");
        }
    }
    __syncthreads();
}

struct Frame {
    LAS unsigned char* lds;
    int tid, lane, wave, G, bid;
    const float* in[23]; float* out; unsigned char* ws;
};
#define GW_ID(F) ((F).bid * NWAVES + (F).wave)
#define GW_N(F) ((F).G * NWAVES)

__device__ __forceinline__ void p0_transpose_item(const float* W, int K, int N, bf16* WT, int row_base, int k0, int n0, LAS float* scr, int lane) {
#pragma unroll 8
    for (int i = 0; i < 32; ++i) { const int kk = 2 * i + (lane >> 5); scr[kk * 33 + (lane & 31)] = W[(size_t)(k0 + kk) * N + n0 + (lane & 31)]; }
    LDS_WAIT(); asm volatile("" ::: "memory");
    const int c = lane & 7;
#pragma unroll
    for (int j = 0; j < 4; ++j) { const int n = (lane >> 3) + 8 * j; const LAS float* s = scr + (8 * c) * 33 + n;
        v4u o; o.x = pk2(s[0 * 33], s[1 * 33]); o.y = pk2(s[2 * 33], s[3 * 33]); o.z = pk2(s[4 * 33], s[5 * 33]); o.w = pk2(s[6 * 33], s[7 * 33]);
        *(GAS v4u*)(WT + (size_t)(row_base + n) * K + k0 + 8 * c) = o; }
    LDS_WAIT(); asm volatile("" ::: "memory");
}
__device__ __forceinline__ void phase_p0(Frame& F) {
    LAS float* scr = (LAS float*)(F.lds + F.wave * 16384);
    const int gw = GW_ID(F), NGW = GW_N(F);
    bf16* WinT = (bf16*)(F.ws + WS_WIN); bf16* WoutT = (bf16*)(F.ws + WS_WOUT); bf16* W3T = (bf16*)(F.ws + WS_W3T);
    constexpr int I_IN = (DM / 64) * (INW / 32), I_OUT = (DM / 64) * (DM / 32), I_3 = 1 * (4096 / 32);
    constexpr int NITEMS = I_IN + I_OUT + I_3;
    for (int it = gw; it < NITEMS; it += NGW) {
        int r = it;
        if (r < I_IN) { const int nblk = INW / 32, kb = r / nblk, nb = r % nblk; p0_transpose_item(F.in[2], DM, INW, WinT, 32 * nb, 64 * kb, 32 * nb, scr, F.lane); continue; } r -= I_IN;
        if (r < I_OUT) { const int nblk = DM / 32, kb = r / nblk, nb = r % nblk; p0_transpose_item(F.in[17], DM, DM, WoutT, 32 * nb, 64 * kb, 32 * nb, scr, F.lane); continue; } r -= I_OUT;
        { const int nb = r; p0_transpose_item(F.in[12], FHID, 4096, W3T, 32 * nb, 0, 32 * nb, scr, F.lane); }
    }
    bf16* HB = (bf16*)(F.ws + WS_HB);
    const float* x = F.in[0]; const float* g = F.in[1];
    for (int m = gw; m < MT; m += NGW) {
        const GAS f32x4* xr = (const GAS f32x4*)(x + (size_t)m * DM) + F.lane;
        f32x4 v[8]; float s = 0.f;
#pragma unroll
        for (int j = 0; j < 8; ++j) { v[j] = xr[64 * j]; s += (v[j].x * v[j].x + v[j].y * v[j].y) + (v[j].z * v[j].z + v[j].w * v[j].w); }
        const float r = rsqrtf(wave_sum(s) * (1.f / DM) + EPS);
        GAS v2u* o8 = (GAS v2u*)(HB + (size_t)m * DM) + F.lane;
#pragma unroll
        for (int j = 0; j < 8; ++j) { const f32x4 gg = *((const GAS f32x4*)g + F.lane + 64 * j); v2u o; o.x = pk2(v[j].x * r * gg.x, v[j].y * r * gg.y); o.y = pk2(v[j].z * r * gg.z, v[j].w * r * gg.w); o8[64 * j] = o; }
    }
    float* HID2 = (float*)(F.ws + WS_HID2);
    LAS float* sc2 = (LAS float*)(F.lds + F.wave * 16384);
    const float* w1 = F.in[8]; const float* b1 = F.in[9]; const float* w2 = F.in[10]; const float* b2 = F.in[11]; const float* fr = F.in[13];
    for (int l = gw; l < SEQ; l += NGW) {
        const int j = F.lane;
        float zv = 0.f;
        if (j == 0) zv = (float)l / (float)(SEQ - 1);
        else if (j < FEMB) { const int k = (j - 1) & 15; const float f = 1e-4f + (float)k * ((15.0f - 1e-4f) / 15.0f); const float wv = 6.283185307179586f * (float)l / (float)SEQ; zv = (j <= 16) ? cosf(f * wv) : -sinf(f * wv); }
        sc2[j] = zv; LDS_WAIT(); asm volatile("" ::: "memory");
        float a = b1[j];
        for (int i = 0; i < FEMB; ++i) a += sc2[i] * w1[i * FHID + j];
        const float h1 = sinf(fr[j] * a);
        sc2[64 + j] = h1; LDS_WAIT(); asm volatile("" ::: "memory");
        float c = b2[j];
        for (int i = 0; i < FHID; ++i) c += sc2[64 + i] * w2[i * FHID + j];
        HID2[l * FHID + j] = sinf(fr[j] * c);
        LDS_WAIT(); asm volatile("" ::: "memory");
    }
}

__device__ __forceinline__ void phase_filters_naive(Frame& F) {
    const float* HID2 = (const float*)(F.ws + WS_HID2); const float* w3 = F.in[12]; const float* fbias = F.in[14]; bf16* TAPS = (bf16*)(F.ws + WS_TAPS);
    const size_t total = (size_t)SEQ * 4096;
    for (size_t i = (size_t)F.bid * NTHREADS + F.tid; i < total; i += (size_t)F.G * NTHREADS) {
        const int col = (int)(i & 4095), l = (int)(i >> 12);
        float a = 0.f;
        for (int k = 0; k < FHID; ++k) a += HID2[l * FHID + k] * w3[(size_t)k * 4096 + col];
        const int c = col & 1023, dir = (col >> 10) & 1, o = col >> 11;
        const float mind = -4.605170185988091f / 1.5f, maxd = -4.605170185988091f / 0.3f;
        const float delta = fabsf(mind + (maxd - mind) * ((float)c / 1023.0f));
        const float t = (float)l / (float)(SEQ - 1);
        float v = a * expf(-t * delta);
        bf16* tp = TAPS + ((size_t)c * 2 + o) * 8192;
        if (dir == 0) { if (l == 0) v += fbias[o * 1024 + c]; tp[4096 + l] = (bf16)f2bf(v); }
        else { if (l > 0) tp[4096 - l] = (bf16)f2bf(v); else tp[0] = 0; }
    }
}
__device__ __forceinline__ void phase_hyena_naive(Frame& F, int o) {
    const bf16* UC = (const bf16*)(F.ws + WS_UC); const bf16* TAPS = (const bf16*)(F.ws + WS_TAPS);
    bf16* Z1T = (bf16*)(F.ws + WS_Z1T); bf16* HYT = (bf16*)(F.ws + WS_HYT);
    const bf16* Zin = o == 0 ? UC + (size_t)2048 * MT : Z1T; const bf16* gate = UC + (size_t)(o * 1024) * MT; bf16* OUT = o == 0 ? Z1T : HYT;
    const size_t total = (size_t)1024 * MT;
    for (size_t i = (size_t)F.bid * NTHREADS + F.tid; i < total; i += (size_t)F.G * NTHREADS) {
        const int c = (int)(i >> 13), m = (int)(i & 8191), b = m >> 12, t = m & 4095;
        const bf16* z = Zin + (size_t)c * MT + b * SEQ; const bf16* tp = TAPS + ((size_t)c * 2 + o) * 8192 + 4096 + t;
        float acc = 0.f;
        for (int s = 0; s < SEQ; ++s) acc += bf2f(tp[-s]) * bf2f(z[s]);
        OUT[(size_t)c * MT + m] = (bf16)f2bf(bf2f(gate[(size_t)c * MT + m]) * acc);
    }
}
__device__ __forceinline__ void phase_attn_naive(Frame& F) {
    const bf16* QK = (const bf16*)(F.ws + WS_QK); const bf16* VT = (const bf16*)(F.ws + WS_XT); bf16* MIXED = (bf16*)(F.ws + WS_MIXED);
    const float* rpb = F.in[5]; const float* og = F.in[15];
    const int lane = F.lane;
    for (int w = GW_ID(F); w < MT * NH; w += GW_N(F)) {
        const int m = w >> 3, h = w & 7, b = m / SEQ, s = m % SEQ, r = s / GW, c = s % GW;
        int kr0 = r - WR / 2; kr0 = kr0 < 0 ? 0 : (kr0 > NROWS - WR ? NROWS - WR : kr0);
        int c0 = c - WC / 2; c0 = c0 < 0 ? 0 : (c0 > GW - WC ? GW - WC : c0);
        const bf16* q = QK + (size_t)m * 2048 + h * HD;
        const float q0 = bf2f(q[lane]), q1 = bf2f(q[lane + 64]);
        float mx = -INFINITY, l = 0.f, a0 = 0.f, a1 = 0.f;
        for (int i = 0; i < WR; ++i) for (int j = 0; j < WC; ++j) {
            const int kr = kr0 + i, kc = c0 + j; const size_t km = (size_t)b * SEQ + kr * GW + kc;
            const bf16* kp = QK + km * 2048 + 1024 + h * HD;
            const float d = wave_sum(q0 * bf2f(kp[lane]) + q1 * bf2f(kp[lane + 64]));
            const int dr = kr - r + WR - 1; int dc = kc - c + WC - 1; dc = dc < 0 ? 0 : (dc > 2 * WC - 2 ? 2 * WC - 2 : dc);
            const float sc = d * 0.08838834764831845f + rpb[(h * (2 * WR - 1) + dr) * (2 * WC - 1) + dc];
            const float mn = fmaxf(mx, sc), corr = __expf(mx - mn), pw = __expf(sc - mn);
            const float v0 = bf2f(VT[(size_t)(h * HD + lane) * MT + km]), v1 = bf2f(VT[(size_t)(h * HD + lane + 64) * MT + km]);
            l = l * corr + pw; a0 = a0 * corr + pw * v0; a1 = a1 * corr + pw * v1; mx = mn;
        }
        a0 /= l; a1 /= l;
        const float rr = rsqrtf(wave_sum(a0 * a0 + a1 * a1) * (1.f / HD) + EPS);
        bf16* o = MIXED + (size_t)m * DM + h * HD;
        o[lane] = (bf16)f2bf(a0 * rr * og[h * HD + lane]); o[lane + 64] = (bf16)f2bf(a1 * rr * og[h * HD + lane + 64]);
    }
}


typedef short bf16x8 __attribute__((ext_vector_type(8)));
typedef float f32x16 __attribute__((ext_vector_type(16)));
__device__ __forceinline__ void phase_filters(Frame& F) {
    const float* HID2 = (const float*)(F.ws + WS_HID2); const bf16* W3T = (const bf16*)(F.ws + WS_W3T); const float* fbias = F.in[14]; bf16* TAPS = (bf16*)(F.ws + WS_TAPS);
    const int n = F.lane & 31, hh = F.lane >> 5;
    for (int it = GW_ID(F); it < 128 * 128; it += GW_N(F)) {
        const int col0 = (it >> 7) * 32, l0 = (it & 127) * 32;
        f32x16 acc;
#pragma unroll
        for (int i = 0; i < 16; ++i) acc[i] = 0.f;
#pragma unroll
        for (int ks = 0; ks < 4; ++ks) {
            const bf16x8 a = *(const GAS bf16x8*)(W3T + (size_t)(col0 + n) * FHID + 16 * ks + 8 * hh);
            const GAS f32x4* hp = (const GAS f32x4*)(HID2 + (size_t)(l0 + n) * FHID + 16 * ks + 8 * hh);
            const f32x4 h0 = hp[0], h1 = hp[1];
            v4u bw; bw.x = pk2(h0.x, h0.y); bw.y = pk2(h0.z, h0.w); bw.z = pk2(h1.x, h1.y); bw.w = pk2(h1.z, h1.w);
            acc = __builtin_amdgcn_mfma_f32_32x32x16_bf16(a, __builtin_bit_cast(bf16x8, bw), acc, 0, 0, 0);
        }
        const int l = l0 + n; const float t = (float)l / (float)(SEQ - 1);
        const int dir = (col0 >> 10) & 1, o = col0 >> 11;
        const float mind = -4.605170185988091f / 1.5f, maxd = -4.605170185988091f / 0.3f;
#pragma unroll
        for (int i = 0; i < 16; ++i) {
            const int c = (col0 & 1023) + (i & 3) + 8 * (i >> 2) + 4 * hh;
            const float delta = fabsf(mind + (maxd - mind) * ((float)c / 1023.0f));
            float v = acc[i] * __expf(-t * delta);
            bf16* tp = TAPS + ((size_t)c * 2 + o) * 8192;
            if (dir == 0) { if (l == 0) v += fbias[o * 1024 + c]; tp[4096 + l] = (bf16)f2bf(v); }
            else { if (l > 0) tp[4096 - l] = (bf16)f2bf(v); else tp[0] = 0; }
        }
    }
}

constexpr int HY_TAPS_BYTES = 4 * 16384, HY_ZB_ENT = 6080, HY_ZB_BYTES = HY_ZB_ENT * 2;
__device__ __forceinline__ unsigned hy_zb_off(int idx0  ) { const int q = idx0 >> 3; return (unsigned)((q ^ ((q >> 4) & 3)) << 4); }
template <int MASK>
__device__ __forceinline__ void hy_loadB(bf16x8 (&bf)[4], const LAS unsigned char* zb0, int g, int b, int n, int hh) {
    const int q0 = 124 - 4 * n + 2 * g + hh;
    const LAS unsigned char* pm = zb0 + ((q0 ^ ((q0 >> 4) & 3)) << 4) - 6144 + b * HY_ZB_BYTES;
#pragma unroll
    for (int tau = 0; tau < 4; ++tau) if (MASK & (1 << tau)) bf[tau] = *(const LAS bf16x8*)(pm + 2048 * (3 - tau));
}
__device__ __forceinline__ void hy_loadA(unsigned (&d)[5], const LAS bf16* taps, int g, int n, int hh) {
    const volatile LAS unsigned* dp = (const volatile LAS unsigned*)taps + ((1 + 8 * hh + n) >> 1) + 8 * g;
#pragma unroll
    for (int i = 0; i < 5; ++i) d[i] = dp[i];
}
template <int MASK>
__device__ __forceinline__ void hy_mma(f32x16 (&acc)[4], const bf16x8 a, const bf16x8 (&bf)[4]) {
#pragma unroll
    for (int tau = 0; tau < 4; ++tau) if (MASK & (1 << tau)) acc[tau] = __builtin_amdgcn_mfma_f32_32x32x16_bf16(a, bf[tau], acc[tau], 0, 0, 0);
}
#define HY_ALIGN(a, d) do { v4u aw_; aw_.x = __builtin_amdgcn_alignbyte(d[1], d[0], sh); aw_.y = __builtin_amdgcn_alignbyte(d[2], d[1], sh); aw_.z = __builtin_amdgcn_alignbyte(d[3], d[2], sh); aw_.w = __builtin_amdgcn_alignbyte(d[4], d[3], sh); a = __builtin_bit_cast(bf16x8, aw_); } while (0)
#define HY_INTERLEAVE(nv, nds) do { __builtin_amdgcn_sched_group_barrier(0x2, nv, 0); _Pragma("unroll") for (int i_ = 0; i_ < 5; ++i_) { __builtin_amdgcn_sched_group_barrier(0x8, 1, 0); __builtin_amdgcn_sched_group_barrier(0x100, nds, 0); __builtin_amdgcn_sched_group_barrier(0x2, 2, 0); } } while (0)
constexpr int HY_YOFF = 254;
template <int MX, int MY>
__device__ __forceinline__ void hy_segment(f32x16 (&acc)[2][4], const LAS bf16* taps, const LAS unsigned char* zb0, int i0, int i1, int n, int hh) {
    const unsigned sh = (n & 1) ? 0u : 2u;
    unsigned dx[5], dy[5]; bf16x8 ax, ay, x0[4], y0[4], x1[4], y1[4];
    hy_loadA(dx, taps, i0, n, hh); hy_loadA(dy, taps, i0 + HY_YOFF, n, hh); hy_loadB<MX>(x0, zb0, i0, 0, n, hh); hy_loadB<MY>(y0, zb0, i0 + HY_YOFF, 0, n, hh);
#pragma unroll 1
    for (int i = i0; i < i1; ++i) {
        HY_ALIGN(ax, dx); HY_ALIGN(ay, dy);
        hy_loadB<MX>(x1, zb0, i, 1, n, hh); hy_loadB<MY>(y1, zb0, i + HY_YOFF, 1, n, hh);
        hy_mma<MX>(acc[0], ax, x0); hy_mma<MY>(acc[0], ay, y0);
        HY_INTERLEAVE(8, 1); __builtin_amdgcn_sched_barrier(0);
        hy_loadA(dx, taps, i + 1, n, hh); hy_loadA(dy, taps, i + 1 + HY_YOFF, n, hh);
        hy_loadB<MX>(x0, zb0, i + 1, 0, n, hh); hy_loadB<MY>(y0, zb0, i + 1 + HY_YOFF, 0, n, hh);
        hy_mma<MX>(acc[1], ax, x1); hy_mma<MY>(acc[1], ay, y1);
        HY_INTERLEAVE(0, 3); __builtin_amdgcn_sched_barrier(0);
    }
}
__device__ __forceinline__ void hy_stage_taps(Frame& F, int c0, int o) {
    const bf16* TAPS = (const bf16*)(F.ws + WS_TAPS);
    int tid = F.tid; asm volatile("" : "+v"(tid));
#pragma unroll
    for (int j = 0; j < 8; ++j) { const int ch = tid + NTHREADS * j, ci = ch >> 10, w = ch & 1023;
        *((LAS v4u*)(F.lds) + ch) = *((const GAS v4u*)(TAPS + ((size_t)(c0 + ci) * 2 + o) * 8192) + w); }
}
struct ConvItem { const float* W; bf16* WTe; int N, row_base, k0, n0; };
__device__ __forceinline__ void conv_load64(float (&v)[64], const ConvItem& c, int lane) {
    const GAS float* src = (const GAS float*)(c.W + (size_t)c.k0 * c.N + c.n0 + lane);
#pragma unroll
    for (int kk = 0; kk < 64; ++kk) v[kk] = src[(size_t)kk * c.N];
}
__device__ __forceinline__ void conv_store64(const float (&v)[64], const ConvItem& c, int lane) {
    GAS v4u* dst = (GAS v4u*)c.WTe + (size_t)(c.k0 >> 3) * 2048 + c.row_base + lane;
#pragma unroll
    for (int j = 0; j < 8; ++j) { v4u o; o.x = pk2(v[8 * j], v[8 * j + 1]); o.y = pk2(v[8 * j + 2], v[8 * j + 3]); o.z = pk2(v[8 * j + 4], v[8 * j + 5]); o.w = pk2(v[8 * j + 6], v[8 * j + 7]); dst[(size_t)j * 2048] = o; }
}
constexpr int MOE_ITEMS_GU = 2 * NE * 32 * 16, MOE_ITEMS_D = NE * 16 * 32, MOE_ITEMS = MOE_ITEMS_GU + MOE_ITEMS_D;
#ifndef MOE_P0_ITEMS
#define MOE_P0_ITEMS 0
#endif
constexpr int MOE_HELP_ITEMS = MOE_ITEMS - MOE_P0_ITEMS;
__device__ __forceinline__ ConvItem moe_item(Frame& F, int it) {
    bf16* WguT = (bf16*)(F.ws + WS_WGU); bf16* WdT = (bf16*)(F.ws + WS_WD); ConvItem c;
    if (it < MOE_ITEMS_GU) { const int which = it >> 13, e = (it >> 9) & 15, kb = (it >> 4) & 31, nb = it & 15, f0 = 64 * nb;
        c.W = (which ? F.in[21] : F.in[20]) + (size_t)e * DM * FF; c.N = FF; c.WTe = WguT + (size_t)e * 2048 * DM; c.row_base = (f0 >> 7) * 256 + which * 128 + (f0 & 127); c.k0 = 64 * kb; c.n0 = f0;
    } else { const int r = it - MOE_ITEMS_GU, e = r >> 9, kb = (r >> 5) & 15, nb = r & 31;
        c.W = F.in[22] + (size_t)e * FF * DM; c.N = DM; c.WTe = WdT + (size_t)e * 2048 * FF; c.row_base = 64 * nb; c.k0 = 64 * kb; c.n0 = 64 * nb; }
    return c;
}
__device__ __forceinline__ void moe_conv_item(Frame& F, int it) { float v[64]; const ConvItem c = moe_item(F, it); conv_load64(v, c, F.lane); conv_store64(v, c, F.lane); }
__device__ __forceinline__ void moe_conv_range(Frame& F, int lo, int hi, int step) {
    if (lo >= hi) return;
    float va[64], vb[64];
    ConvItem ca = moe_item(F, lo), cb_; conv_load64(va, ca, F.lane);
    for (int it = lo; it < hi; it += 2 * step) {
        const bool hb = it + step < hi;
        if (hb) { cb_ = moe_item(F, it + step); conv_load64(vb, cb_, F.lane); }
        conv_store64(va, ca, F.lane);
        const bool ha = it + 2 * step < hi;
        if (ha) { ca = moe_item(F, it + 2 * step); conv_load64(va, ca, F.lane); }
        if (hb) conv_store64(vb, cb_, F.lane);
    }
}
__device__ __forceinline__ void hy_write_gates(Frame& F, int c0, int oo) {
    const bf16* XH = (const bf16*)(F.ws + WS_XT) + (size_t)1024 * MT; bf16* GC = (bf16*)(F.ws + WS_UC);
    const float* cw = F.in[6]; const float* cb = F.in[7];
    const int ht = F.tid - 256;
#pragma unroll 2
    for (int k = 0; k < 16; ++k) { const int id = ht + 256 * k, u = id & 511, b = (id >> 9) & 1, ci = id >> 10;
        const int gch = oo * 1024 + c0 + ci; const bf16* gs = XH + (size_t)gch * MT + b * SEQ;
        const float w0 = cw[gch], w1 = cw[3072 + gch], w2 = cw[6144 + gch], bb = cb[gch];
        const v4u w = *((const GAS v4u*)gs + u);
        float f[10];
        f[1] = bflo(w.x); f[2] = bfhi(w.x); f[3] = bflo(w.y); f[4] = bfhi(w.y); f[5] = bflo(w.z); f[6] = bfhi(w.z); f[7] = bflo(w.w); f[8] = bfhi(w.w);
        f[0] = u > 0 ? bf2f(gs[8 * u - 1]) : 0.f; f[9] = u < 511 ? bf2f(gs[8 * u + 8]) : 0.f;
        float z[8];
#pragma unroll
        for (int e = 0; e < 8; ++e) z[e] = bb + w0 * f[e] + w1 * f[e + 1] + w2 * f[e + 2];
        v4u r; r.x = pk2(z[0], z[1]); r.y = pk2(z[2], z[3]); r.z = pk2(z[4], z[5]); r.w = pk2(z[6], z[7]);
        *((GAS v4u*)(GC + ((size_t)((c0 + ci) * 2 + oo) * 2 + b) * SEQ) + u) = r; }
}
__device__ __forceinline__ void phase_hyena(Frame& F) {
    const bf16* XH = (const bf16*)(F.ws + WS_XT) + (size_t)1024 * MT;
    const float* cw = F.in[6]; const float* cb = F.in[7];
    bf16* HYT = (bf16*)(F.ws + WS_HYT); bf16* GC = (bf16*)(F.ws + WS_UC);
    const int n = F.lane & 31, hh = F.lane >> 5;
    const bool compute = F.wave < 4;
    const int nhelp = F.G * 4, hw = F.bid * 4 + (F.wave - 4);
    int sec = 0;
    for (int cg = F.bid; cg < 256; cg += F.G) {
        const int c0 = cg * 4;
        __syncthreads();
        hy_stage_taps(F, c0, 0);
        {
          const int ci = F.wave >> 1, b = F.wave & 1; LAS unsigned char* zb = F.lds + HY_TAPS_BYTES + F.wave * HY_ZB_BYTES;
          const int zch = 2048 + c0 + ci; const bf16* zsrc = XH + (size_t)zch * MT + b * SEQ;
          const float w0 = cw[zch], w1 = cw[3072 + zch], w2 = cw[6144 + zch], bb = cb[zch];
#pragma unroll
          for (int j = 0; j < 8; ++j) { const int u = F.lane + 64 * j; const v4u w = *((const GAS v4u*)zsrc + u);
              float f[10];
              f[1] = bflo(w.x); f[2] = bfhi(w.x); f[3] = bflo(w.y); f[4] = bfhi(w.y); f[5] = bflo(w.z); f[6] = bfhi(w.z); f[7] = bflo(w.w); f[8] = bfhi(w.w);
              f[0] = u > 0 ? bf2f(zsrc[8 * u - 1]) : 0.f; f[9] = u < 511 ? bf2f(zsrc[8 * u + 8]) : 0.f;
              float z[8];
#pragma unroll
              for (int e = 0; e < 8; ++e) z[e] = bb + w0 * f[e] + w1 * f[e + 1] + w2 * f[e + 2];
              v4u r; r.x = pk2(z[7], z[6]); r.y = pk2(z[5], z[4]); r.z = pk2(z[3], z[2]); r.w = pk2(z[1], z[0]);
              *(LAS v4u*)(zb + hy_zb_off(8 * (635 - u))) = r; }
          const v4u zero = {0u, 0u, 0u, 0u};
          for (int q = F.lane; q < 124; q += 64) { *(LAS v4u*)(zb + hy_zb_off(8 * q)) = zero; *(LAS v4u*)(zb + hy_zb_off(8 * (636 + q))) = zero; } }
        if (!compute) hy_write_gates(F, c0, 0);
        __syncthreads();
#pragma unroll 1
        for (int o = 0; o < 2; ++o) {
            if (compute) {
                const int ci = F.wave, c = c0 + ci;
                const LAS bf16* taps = (const LAS bf16*)(F.lds + ci * 16384);
                LAS unsigned char* zb0 = F.lds + HY_TAPS_BYTES + (2 * ci) * HY_ZB_BYTES;
                f32x16 acc[2][4];
#pragma unroll
                for (int b = 0; b < 2; ++b)
#pragma unroll
                    for (int tau = 0; tau < 4; ++tau)
#pragma unroll
                        for (int i = 0; i < 16; ++i) acc[b][tau][i] = 0.f;
                hy_segment<1, 15>(acc, taps, zb0, 0, 64, n, hh);
                hy_segment<3, 14>(acc, taps, zb0, 64, 128, n, hh);
                hy_segment<7, 12>(acc, taps, zb0, 128, 192, n, hh);
                hy_segment<15, 8>(acc, taps, zb0, 192, 254, n, hh);
                hy_segment<0, 8>(acc, taps, zb0, 254, 256, n, hh);
                LDS_WAIT();
                int n2 = n, h2 = hh; asm volatile("" : "+v"(n2), "+v"(h2));
#pragma unroll
                for (int b = 0; b < 2; ++b) {
                    const bf16* gate = GC + ((size_t)(c * 2 + o) * 2 + b) * SEQ;
                    LAS unsigned char* zb = zb0 + b * HY_ZB_BYTES; bf16* outp = HYT + (size_t)c * MT + b * SEQ;
                    v2u gw[4][4];
#pragma unroll
                    for (int tau = 0; tau < 4; ++tau)
#pragma unroll
                        for (int rg = 0; rg < 4; ++rg) gw[tau][rg] = *(const GAS v2u*)(gate + 1024 * tau + 32 * n2 + 8 * rg + 4 * h2);
#pragma unroll
                    for (int tau = 0; tau < 4; ++tau) {
#pragma unroll
                        for (int rg = 0; rg < 4; ++rg) { const int t0 = 1024 * tau + 32 * n2 + 8 * rg + 4 * h2;
                            const float z0 = bflo(gw[tau][rg].x) * acc[b][tau][4 * rg + 0], z1 = bfhi(gw[tau][rg].x) * acc[b][tau][4 * rg + 1], z2 = bflo(gw[tau][rg].y) * acc[b][tau][4 * rg + 2], z3 = bfhi(gw[tau][rg].y) * acc[b][tau][4 * rg + 3];
                            if (o == 0) { v2u w; w.x = pk2(z3, z2); w.y = pk2(z1, z0);
                                *(LAS v2u*)(zb + hy_zb_off(8 * (635 - (t0 >> 3))) + (h2 ? 0 : 8)) = w; }
                            else { v2u w; w.x = pk2(z0, z1); w.y = pk2(z2, z3); *(GAS v2u*)(outp + t0) = w; } } }
                }
            } else {
                if (o == 0) hy_write_gates(F, c0, 1);
                const int lo_it = MOE_P0_ITEMS + sec * (MOE_HELP_ITEMS / 2), hi_it = lo_it + MOE_HELP_ITEMS / 2;
                if (sec < 2) moe_conv_range(F, lo_it + hw, hi_it, nhelp);
            }
            ++sec;
            if (o == 0) {
                __syncthreads();
                hy_stage_taps(F, c0, 1);
                __syncthreads();
            }
        }
    }
    for (; sec < 2; ++sec) if (!compute) { const int lo_it = MOE_P0_ITEMS + sec * (MOE_HELP_ITEMS / 2), hi_it = lo_it + MOE_HELP_ITEMS / 2; moe_conv_range(F, lo_it + hw, hi_it, nhelp); }
    __syncthreads();
}

__device__ __forceinline__ void phase_attn(Frame& F) {
    const bf16* QK = (const bf16*)(F.ws + WS_QK); const bf16* VT = (const bf16*)(F.ws + WS_XT); bf16* MIXED = (bf16*)(F.ws + WS_MIXED);
    const float* rpb = F.in[5]; const float* og = F.in[15];
    LAS float* rp = (LAS float*)(F.lds + F.wave * 2048);
    const int n = F.lane & 31, hh = F.lane >> 5;
    for (int task = GW_ID(F); task < NB * NH * NROWS * 2; task += GW_N(F)) {
        const int wq = task & 1, r = (task >> 1) & 63, h = (task >> 7) & 7, b = task >> 10;
        for (int i = F.lane; i < 15 * 31; i += 64) rp[i] = rpb[h * 465 + i];
        const int mq = b * SEQ + r * GW + 32 * wq + n, qc = 32 * wq + n;
        int c0 = qc - WC / 2; c0 = c0 < 0 ? 0 : (c0 > GW - WC ? GW - WC : c0);
        int kr0 = r - WR / 2; kr0 = kr0 < 0 ? 0 : (kr0 > NROWS - WR ? NROWS - WR : kr0);
        bf16x8 qf[8];
#pragma unroll
        for (int ks = 0; ks < 8; ++ks) qf[ks] = *(const GAS bf16x8*)(QK + (size_t)mq * 2048 + h * HD + 16 * ks + 8 * hh);
        f32x16 O[4];
#pragma unroll
        for (int dt = 0; dt < 4; ++dt)
#pragma unroll
            for (int i = 0; i < 16; ++i) O[dt][i] = 0.f;
        float lsum = 0.f;
        LDS_WAIT();
#pragma unroll 1
        for (int tile = 0; tile < 16; ++tile) {
            const int kr = kr0 + (tile >> 1), kt = tile & 1, dr = kr - r + WR - 1;
            const int mk0 = b * SEQ + kr * GW + 32 * kt;
            f32x16 S;
#pragma unroll
            for (int i = 0; i < 16; ++i) S[i] = 0.f;
#pragma unroll
            for (int ks = 0; ks < 8; ++ks) { const bf16x8 kf = *(const GAS bf16x8*)(QK + (size_t)(mk0 + n) * 2048 + 1024 + h * HD + 16 * ks + 8 * hh);
                S = __builtin_amdgcn_mfma_f32_32x32x16_bf16(kf, qf[ks], S, 0, 0, 0); }
            float p[16];
#pragma unroll
            for (int i = 0; i < 16; ++i) { const int kc = 32 * kt + (i & 3) + 8 * (i >> 2) + 4 * hh; const bool valid = (kc >= c0) && (kc < c0 + WC);
                int dc = kc - qc + WC - 1; dc = dc < 0 ? 0 : (dc > 2 * WC - 2 ? 2 * WC - 2 : dc);
                const float e = __expf(S[i] * 0.08838834764831845f + rp[dr * 31 + dc]); p[i] = valid ? e : 0.f; lsum += p[i]; }
            v4u pw0, pw1;
            pw0.x = pk2(p[0], p[1]); pw0.y = pk2(p[2], p[3]); pw0.z = pk2(p[4], p[5]); pw0.w = pk2(p[6], p[7]);
            pw1.x = pk2(p[8], p[9]); pw1.y = pk2(p[10], p[11]); pw1.z = pk2(p[12], p[13]); pw1.w = pk2(p[14], p[15]);
            const bf16x8 pf0 = __builtin_bit_cast(bf16x8, pw0), pf1 = __builtin_bit_cast(bf16x8, pw1);
#pragma unroll
            for (int dt = 0; dt < 4; ++dt) {
                const bf16* vrow = VT + (size_t)(h * HD + 32 * dt + n) * MT + mk0 + 4 * hh;
                const v2u a0 = *(const GAS v2u*)(vrow), a1 = *(const GAS v2u*)(vrow + 8), a2 = *(const GAS v2u*)(vrow + 16), a3 = *(const GAS v2u*)(vrow + 24);
                v4u f0, f1; f0.x = a0.x; f0.y = a0.y; f0.z = a1.x; f0.w = a1.y; f1.x = a2.x; f1.y = a2.y; f1.z = a3.x; f1.w = a3.y;
                O[dt] = __builtin_amdgcn_mfma_f32_32x32x16_bf16(__builtin_bit_cast(bf16x8, f0), pf0, O[dt], 0, 0, 0);
                O[dt] = __builtin_amdgcn_mfma_f32_32x32x16_bf16(__builtin_bit_cast(bf16x8, f1), pf1, O[dt], 0, 0, 0);
            }
        }
        lsum += __shfl_xor(lsum, 32);
        const float il = 1.f / lsum;
        float ss = 0.f;
#pragma unroll
        for (int dt = 0; dt < 4; ++dt)
#pragma unroll
            for (int i = 0; i < 16; ++i) { O[dt][i] *= il; ss += O[dt][i] * O[dt][i]; }
        ss += __shfl_xor(ss, 32);
        const float rr = rsqrtf(ss * (1.f / HD) + EPS);
        bf16* orow = MIXED + (size_t)mq * DM + h * HD;
#pragma unroll
        for (int dt = 0; dt < 4; ++dt)
#pragma unroll
            for (int rg = 0; rg < 4; ++rg) { const int d = 32 * dt + 8 * rg + 4 * hh; const f32x4 gg = *(const GAS f32x4*)(og + h * HD + d);
                v2u w; w.x = pk2(O[dt][4 * rg + 0] * rr * gg.x, O[dt][4 * rg + 1] * rr * gg.y); w.y = pk2(O[dt][4 * rg + 2] * rr * gg.z, O[dt][4 * rg + 3] * rr * gg.w);
                *(GAS v2u*)(orow + d) = w; }
        LDS_WAIT();
    }
}


constexpr int AT_KBYTES = 16384, AT_VPITCH = 136, AT_VBYTES = 128 * AT_VPITCH, AT_STAGE = AT_KBYTES + AT_VBYTES, AT_RP_OFF = 2 * AT_STAGE;
__device__ __forceinline__ void phase_attn2(Frame& F) {
    const bf16* QK = (const bf16*)(F.ws + WS_QK); const bf16* VT = (const bf16*)(F.ws + WS_XT); bf16* MIXED = (bf16*)(F.ws + WS_MIXED);
    const float* rpb = F.in[5]; const float* og = F.in[15]; const float* qg = F.in[3]; const float* kg = F.in[4];
    LAS float* rp = (LAS float*)(F.lds + AT_RP_OFF + F.wave * 2048);
    LAS float* gtab = (LAS float*)(F.lds + AT_RP_OFF + 8 * 2048);
    if (F.tid < HD) gtab[F.tid] = qg[F.tid] * kg[F.tid];
    const int n = F.lane & 31, hh = F.lane >> 5;
    for (int unit = F.bid; unit < NB * NH * 16; unit += F.G) {
        const int rq = unit & 15, h = (unit >> 4) & 7, b = unit >> 7, r0 = 4 * rq;
        const int r = r0 + (F.wave >> 1), wq = F.wave & 1;
        int kmin = r0 - WR / 2; kmin = kmin < 0 ? 0 : (kmin > NROWS - WR ? NROWS - WR : kmin);
        int kmax = r0 + 3 - WR / 2; kmax = (kmax < 0 ? 0 : (kmax > NROWS - WR ? NROWS - WR : kmax)) + WR - 1;
        int kr0 = r - WR / 2; kr0 = kr0 < 0 ? 0 : (kr0 > NROWS - WR ? NROWS - WR : kr0);
        const int nrows = kmax - kmin + 1;
        __syncthreads();
        for (int i = F.lane; i < 15 * 31; i += 64) rp[i] = rpb[h * 465 + i];
        const int mq = b * SEQ + r * GW + 32 * wq + n, qc = 32 * wq + n;
        int c0 = qc - WC / 2; c0 = c0 < 0 ? 0 : (c0 > GW - WC ? GW - WC : c0);
        bf16x8 qf[8];
#pragma unroll
        for (int ks = 0; ks < 8; ++ks) qf[ks] = *(const GAS bf16x8*)(QK + (size_t)mq * 2048 + h * HD + 16 * ks + 8 * hh);
        float qscale;
        {
          f32x16 D;
#pragma unroll
          for (int i = 0; i < 16; ++i) D[i] = 0.f;
#pragma unroll
          for (int ks = 0; ks < 8; ++ks) D = __builtin_amdgcn_mfma_f32_32x32x16_bf16(qf[ks], qf[ks], D, 0, 0, 0);
          float dsel = 0.f; const int isel = (n & 3) + 4 * (n >> 3);
#pragma unroll
          for (int i = 0; i < 16; ++i) dsel = (i == isel) ? D[i] : dsel;
          const float other = __shfl_xor(dsel, 32);
          const float ssq = (((n >> 2) & 1) == hh) ? dsel : other;
          qscale = 0.08838834764831845f * rsqrtf(ssq * (1.f / HD) + EPS); }
        f32x16 O[4];
#pragma unroll
        for (int dt = 0; dt < 4; ++dt)
#pragma unroll
            for (int i = 0; i < 16; ++i) O[dt][i] = 0.f;
        float lsum = 0.f;
        v4u sk[2], sv[2];

        auto gload = [&](int kr) {
#pragma unroll
            for (int j = 0; j < 2; ++j) { const int id = F.tid + 512 * j;
                sk[j] = *(const GAS v4u*)(QK + (size_t)(b * SEQ + kr * GW + (id >> 4)) * 2048 + 1024 + h * HD + 8 * (id & 15));
                sv[j] = *(const GAS v4u*)(VT + (size_t)(h * HD + (id >> 3)) * MT + b * SEQ + kr * GW + 8 * (id & 7)); }
        };
        auto lstore = [&](int buf) {
            LAS unsigned char* kb = F.lds + buf * AT_STAGE; LAS unsigned char* vb = kb + AT_KBYTES;
#pragma unroll
            for (int j = 0; j < 2; ++j) { const int id = F.tid + 512 * j; const int key = id >> 4, c = id & 15;
                float f[8] = {bflo(sk[j].x), bfhi(sk[j].x), bflo(sk[j].y), bfhi(sk[j].y), bflo(sk[j].z), bfhi(sk[j].z), bflo(sk[j].w), bfhi(sk[j].w)};
                float ss = 0.f;
#pragma unroll
                for (int e = 0; e < 8; ++e) ss += f[e] * f[e];
                ss += __shfl_xor(ss, 1); ss += __shfl_xor(ss, 2); ss += __shfl_xor(ss, 4); ss += __shfl_xor(ss, 8);
                const float rk = rsqrtf(ss * (1.f / HD) + EPS);
                const f32x4 ga = *(const LAS f32x4*)(gtab + 8 * c), gb = *(const LAS f32x4*)(gtab + 8 * c + 4);
                v4u kn; kn.x = pk2(f[0] * rk * ga.x, f[1] * rk * ga.y); kn.y = pk2(f[2] * rk * ga.z, f[3] * rk * ga.w); kn.z = pk2(f[4] * rk * gb.x, f[5] * rk * gb.y); kn.w = pk2(f[6] * rk * gb.z, f[7] * rk * gb.w);
                *(LAS v4u*)(kb + key * 256 + ((c ^ (key & 15)) << 4)) = kn;
                const int d = id >> 3, cv = id & 7; LAS v2u* vp = (LAS v2u*)(vb + d * AT_VPITCH + cv * 16);
                v2u lo, hi; lo.x = sv[j].x; lo.y = sv[j].y; hi.x = sv[j].z; hi.y = sv[j].w; vp[0] = lo; vp[1] = hi; }
        };
        gload(kmin); lstore(0);
        __syncthreads();
#pragma unroll 1
        for (int j = 0; j < nrows; ++j) {
            const int kr = kmin + j, buf = j & 1;
            if (j + 1 < nrows) gload(kr + 1);
            if (kr >= kr0 && kr < kr0 + WR) {
                const LAS unsigned char* kb = F.lds + buf * AT_STAGE; const LAS unsigned char* vb = kb + AT_KBYTES;
                const int dr = kr - r + WR - 1;
                int c0v = c0, qcv = qc; asm volatile("" : "+v"(c0v), "+v"(qcv));
#pragma unroll
                for (int kt = 0; kt < 2; ++kt) {
                    f32x16 S;
#pragma unroll
                    for (int i = 0; i < 16; ++i) S[i] = 0.f;
                    const int key = 32 * kt + n;
#pragma unroll
                    for (int ks = 0; ks < 8; ++ks) { const bf16x8 kf = *(const LAS bf16x8*)(kb + key * 256 + (((2 * ks + hh) ^ (key & 15)) << 4));
                        S = __builtin_amdgcn_mfma_f32_32x32x16_bf16(kf, qf[ks], S, 0, 0, 0); }
                    float p[16];
#pragma unroll
                    for (int i = 0; i < 16; ++i) { const int kc = 32 * kt + (i & 3) + 8 * (i >> 2) + 4 * hh; const bool valid = (kc >= c0v) && (kc < c0v + WC);
                        int dc = kc - qcv + WC - 1; dc = dc < 0 ? 0 : (dc > 2 * WC - 2 ? 2 * WC - 2 : dc);
                        const float e = __expf(S[i] * qscale + rp[dr * 31 + dc]); p[i] = valid ? e : 0.f; lsum += p[i]; }
                    v4u pw0, pw1;
                    pw0.x = pk2(p[0], p[1]); pw0.y = pk2(p[2], p[3]); pw0.z = pk2(p[4], p[5]); pw0.w = pk2(p[6], p[7]);
                    pw1.x = pk2(p[8], p[9]); pw1.y = pk2(p[10], p[11]); pw1.z = pk2(p[12], p[13]); pw1.w = pk2(p[14], p[15]);
                    const bf16x8 pf0 = __builtin_bit_cast(bf16x8, pw0), pf1 = __builtin_bit_cast(bf16x8, pw1);
#pragma unroll
                    for (int dt = 0; dt < 4; ++dt) {
                        const LAS unsigned char* vrow = vb + (32 * dt + n) * AT_VPITCH + (32 * kt + 4 * hh) * 2;
                        const v2u a0 = *(const LAS v2u*)(vrow), a1 = *(const LAS v2u*)(vrow + 16), a2 = *(const LAS v2u*)(vrow + 32), a3 = *(const LAS v2u*)(vrow + 48);
                        v4u f0, f1; f0.x = a0.x; f0.y = a0.y; f0.z = a1.x; f0.w = a1.y; f1.x = a2.x; f1.y = a2.y; f1.z = a3.x; f1.w = a3.y;
                        O[dt] = __builtin_amdgcn_mfma_f32_32x32x16_bf16(__builtin_bit_cast(bf16x8, f0), pf0, O[dt], 0, 0, 0);
                        O[dt] = __builtin_amdgcn_mfma_f32_32x32x16_bf16(__builtin_bit_cast(bf16x8, f1), pf1, O[dt], 0, 0, 0);
                    }
                }
            }
            if (j + 1 < nrows) lstore(buf ^ 1);
            __syncthreads();
        }
        lsum += __shfl_xor(lsum, 32);
        const float il = 1.f / lsum;
        float ss = 0.f;
#pragma unroll
        for (int dt = 0; dt < 4; ++dt)
#pragma unroll
            for (int i = 0; i < 16; ++i) { O[dt][i] *= il; ss += O[dt][i] * O[dt][i]; }
        ss += __shfl_xor(ss, 32);
        const float rr = rsqrtf(ss * (1.f / HD) + EPS);
        bf16* orow = MIXED + (size_t)mq * DM + h * HD;
#pragma unroll
        for (int dt = 0; dt < 4; ++dt)
#pragma unroll
            for (int rg = 0; rg < 4; ++rg) { const int d = 32 * dt + 8 * rg + 4 * hh; const f32x4 gg = *(const GAS f32x4*)(og + h * HD + d);
                v2u w; w.x = pk2(O[dt][4 * rg + 0] * rr * gg.x, O[dt][4 * rg + 1] * rr * gg.y); w.y = pk2(O[dt][4 * rg + 2] * rr * gg.z, O[dt][4 * rg + 3] * rr * gg.w);
                *(GAS v2u*)(orow + d) = w; }
    }
    __syncthreads();
}

__device__ __forceinline__ void phase_p15(Frame& F) {
    bf16* QK = (bf16*)(F.ws + WS_QK); const float* qg = F.in[3]; const float* kg = F.in[4];
    for (int m = GW_ID(F); m < MT; m += GW_N(F)) {
        GAS v4u* rowp = (GAS v4u*)(QK + (size_t)m * 2048) + F.lane;
#pragma unroll
        for (int j = 0; j < 4; ++j) {
            v4u w = rowp[64 * j];
            float f[8] = {bflo(w.x), bfhi(w.x), bflo(w.y), bfhi(w.y), bflo(w.z), bfhi(w.z), bflo(w.w), bfhi(w.w)};
            float ss = 0.f;
#pragma unroll
            for (int e = 0; e < 8; ++e) ss += f[e] * f[e];
            ss += __shfl_xor(ss, 1); ss += __shfl_xor(ss, 2); ss += __shfl_xor(ss, 4); ss += __shfl_xor(ss, 8);
            const float r = rsqrtf(ss * (1.f / HD) + EPS);
            const int col = 512 * j + 8 * F.lane, d = col & 127; const float* g = (col < 1024 ? qg : kg) + d;
#pragma unroll
            for (int e = 0; e < 8; ++e) f[e] = f[e] * r * g[e];
            w.x = pk2(f[0], f[1]); w.y = pk2(f[2], f[3]); w.z = pk2(f[4], f[5]); w.w = pk2(f[6], f[7]);
            rowp[64 * j] = w;
        }
    }
    const bf16* XT = (const bf16*)(F.ws + WS_XT) + (size_t)1024 * MT; bf16* UC = (bf16*)(F.ws + WS_UC);
    const float* cw = F.in[6]; const float* cb = F.in[7];
    const size_t nchunks = (size_t)3072 * MT / 8;
    for (size_t i = (size_t)F.bid * NTHREADS + F.tid; i < nchunks; i += (size_t)F.G * NTHREADS) {
        const int ch = (int)(i >> 10), m0 = (int)(i & 1023) * 8, s0 = m0 & 4095;
        const bf16* up = XT + (size_t)ch * MT + m0;
        const v4u w = *(const GAS v4u*)up;
        float f[10];
        f[1] = bflo(w.x); f[2] = bfhi(w.x); f[3] = bflo(w.y); f[4] = bfhi(w.y); f[5] = bflo(w.z); f[6] = bfhi(w.z); f[7] = bflo(w.w); f[8] = bfhi(w.w);
        f[0] = s0 > 0 ? bf2f(up[-1]) : 0.f; f[9] = s0 + 8 < SEQ ? bf2f(up[8]) : 0.f;
        const float w0 = cw[ch], w1 = cw[3072 + ch], w2 = cw[6144 + ch], bb = cb[ch];
        float o[8];
#pragma unroll
        for (int e = 0; e < 8; ++e) o[e] = bb + w0 * f[e] + w1 * f[e + 1] + w2 * f[e + 2];
        v4u ov; ov.x = pk2(o[0], o[1]); ov.y = pk2(o[2], o[3]); ov.z = pk2(o[4], o[5]); ov.w = pk2(o[6], o[7]);
        *(GAS v4u*)(UC + (size_t)ch * MT + m0) = ov;
    }
}
__device__ __forceinline__ void phase_p25(Frame& F) {
    const bf16* HYT = (const bf16*)(F.ws + WS_HYT); bf16* MIXED = (bf16*)(F.ws + WS_MIXED); const float* hg = F.in[16];
    LAS float* tile = (LAS float*)F.lds;
    LAS float* rs = (LAS float*)(F.lds + 128 * 65 * 4);
    for (int it = F.bid; it < 8 * (MT / 64); it += F.G) {
        const int gi = it & 7, m0 = (it >> 3) * 64;
        { const int ch = F.tid >> 2, t0 = (F.tid & 3) * 16; const bf16* p = HYT + (size_t)(gi * 128 + ch) * MT + m0 + t0;
          const v4u a = *(const GAS v4u*)p, b = *(const GAS v4u*)(p + 8);
          LAS float* d = tile + ch * 65 + t0;
          d[0] = bflo(a.x); d[1] = bfhi(a.x); d[2] = bflo(a.y); d[3] = bfhi(a.y); d[4] = bflo(a.z); d[5] = bfhi(a.z); d[6] = bflo(a.w); d[7] = bfhi(a.w);
          d[8] = bflo(b.x); d[9] = bfhi(b.x); d[10] = bflo(b.y); d[11] = bfhi(b.y); d[12] = bflo(b.z); d[13] = bfhi(b.z); d[14] = bflo(b.w); d[15] = bfhi(b.w); }
        __syncthreads();
        {
          const int t = F.tid >> 3, c0 = (F.tid & 7) * 16; float ss = 0.f;
#pragma unroll
          for (int c = 0; c < 16; ++c) { const float v = tile[(c0 + c) * 65 + t]; ss += v * v; }
          ss += __shfl_xor(ss, 1); ss += __shfl_xor(ss, 2); ss += __shfl_xor(ss, 4);
          if ((F.tid & 7) == 0) rs[t] = rsqrtf(ss * (1.f / 128) + EPS); }
        __syncthreads();
        {
          const int t = F.tid >> 3, c0 = (F.tid & 7) * 16; const float r = rs[t]; float o[16];
#pragma unroll
          for (int c = 0; c < 16; ++c) o[c] = tile[(c0 + c) * 65 + t] * r * hg[gi * 128 + c0 + c];
          v4u a, b; a.x = pk2(o[0], o[1]); a.y = pk2(o[2], o[3]); a.z = pk2(o[4], o[5]); a.w = pk2(o[6], o[7]); b.x = pk2(o[8], o[9]); b.y = pk2(o[10], o[11]); b.z = pk2(o[12], o[13]); b.w = pk2(o[14], o[15]);
          bf16* q = MIXED + (size_t)(m0 + t) * DM + AW + gi * 128 + c0; *(GAS v4u*)q = a; *(GAS v4u*)(q + 8) = b; }
        __syncthreads();
    }
}
__device__ __forceinline__ void phase_p35(Frame& F) {
    LAS float* wrT = (LAS float*)F.lds;
    const float* wr = F.in[19]; const float* g = F.in[18];
    for (int i = F.tid; i < DM * NE; i += NTHREADS) { const int d = i >> 4, e = i & 15; wrT[e * DM + d] = wr[i]; }
    __syncthreads();
    bf16* HB = (bf16*)(F.ws + WS_HB); float* AFF = (float*)(F.ws + WS_AFF); const float* x1 = F.out;
    for (int m = GW_ID(F); m < MT; m += GW_N(F)) {
        const GAS f32x4* xr = (const GAS f32x4*)(x1 + (size_t)m * DM) + F.lane;
        f32x4 v[8]; float s = 0.f;
#pragma unroll
        for (int j = 0; j < 8; ++j) { v[j] = xr[64 * j]; s += (v[j].x * v[j].x + v[j].y * v[j].y) + (v[j].z * v[j].z + v[j].w * v[j].w); }
        const float r = rsqrtf(wave_sum(s) * (1.f / DM) + EPS);
        GAS v2u* o8 = (GAS v2u*)(HB + (size_t)m * DM) + F.lane;
#pragma unroll
        for (int j = 0; j < 8; ++j) { const f32x4 gg = *((const GAS f32x4*)g + F.lane + 64 * j); v[j].x *= r * gg.x; v[j].y *= r * gg.y; v[j].z *= r * gg.z; v[j].w *= r * gg.w;
            v2u o; o.x = pk2(v[j].x, v[j].y); o.y = pk2(v[j].z, v[j].w); o8[64 * j] = o; }
        float mine = 0.f;
#pragma unroll 1
        for (int e = 0; e < NE; ++e) { float a = 0.f;
#pragma unroll
            for (int j = 0; j < 8; ++j) { const f32x4 w = *((const LAS f32x4*)(wrT + e * DM) + F.lane + 64 * j); a += (v[j].x * w.x + v[j].y * w.y) + (v[j].z * w.z + v[j].w * w.w); }
            a = wave_sum(a); mine = (F.lane == e) ? a : mine; }
        float mx = mine;
        mx = fmaxf(mx, __shfl_xor(mx, 1)); mx = fmaxf(mx, __shfl_xor(mx, 2)); mx = fmaxf(mx, __shfl_xor(mx, 4)); mx = fmaxf(mx, __shfl_xor(mx, 8));
        const float ex = expf(mine - mx); float den = ex;
        den += __shfl_xor(den, 1); den += __shfl_xor(den, 2); den += __shfl_xor(den, 4); den += __shfl_xor(den, 8);
        const int b = m / SEQ, sidx = m % SEQ;
        if (F.lane < NE) AFF[((size_t)b * NE + F.lane) * SEQ + sidx] = ex / den;
    }
    __syncthreads();
}
__device__ __forceinline__ void phase_p4(Frame& F) {
    LAS unsigned* key = (LAS unsigned*)F.lds;
    LAS unsigned* hist = (LAS unsigned*)(F.lds + 16384);
    LAS unsigned* wsum = (LAS unsigned*)(F.lds + 16384 + 1024);
    const float* AFF = (const float*)(F.ws + WS_AFF); int* IDX = (int*)(F.ws + WS_IDX); float* GATE = (float*)(F.ws + WS_GATE); int* SEL = (int*)(F.ws + WS_SEL);
    for (int be = F.bid; be < NB * NE; be += F.G) {
        const int b = be / NE, e = be % NE;
        __syncthreads();
        const GAS v4u* ap = (const GAS v4u*)(AFF + (size_t)be * SEQ);
        const v4u k0 = ap[2 * F.tid], k1 = ap[2 * F.tid + 1];
        unsigned kk[8] = {k0.x, k0.y, k0.z, k0.w, k1.x, k1.y, k1.z, k1.w};
        unsigned prefix = 0u, mask = 0u, remaining = CAP;
#pragma unroll 1
        for (int pass = 0; pass < 4; ++pass) {
            const int shift = 24 - 8 * pass;
            if (F.tid < 256) hist[F.tid] = 0u;
            __syncthreads();
#pragma unroll
            for (int i = 0; i < 8; ++i) if ((kk[i] & mask) == prefix) __hip_atomic_fetch_add(&hist[(kk[i] >> shift) & 255u], 1u, __ATOMIC_RELAXED, __HIP_MEMORY_SCOPE_WORKGROUP);
            __syncthreads();
            if (F.tid < 256) {
                unsigned above = 0u;
                for (int j = F.tid + 1; j < 256; ++j) above += hist[j];
                const unsigned mine = hist[F.tid];
                if (above < remaining && remaining <= above + mine) { wsum[8] = (unsigned)F.tid; wsum[9] = above; }
            }
            __syncthreads();
            const unsigned d = wsum[8], above = wsum[9];
            prefix |= d << shift; mask |= 255u << shift; remaining -= above;
            __syncthreads();
        }
        const unsigned thr = prefix;
        unsigned cnt = 0u;
#pragma unroll
        for (int i = 0; i < 8; ++i) cnt += (kk[i] > thr ? 0x10000u : 0u) + (kk[i] == thr ? 1u : 0u);
        unsigned incl = cnt;
#pragma unroll
        for (int o = 1; o < 64; o <<= 1) { const unsigned t = __shfl_up(incl, o); if (F.lane >= o) incl += t; }
        if (F.lane == 63) wsum[F.wave] = incl;
        __syncthreads();
        unsigned base = 0u;
        for (int w = 0; w < F.wave; ++w) base += wsum[w];
        unsigned run = base + incl - cnt;
#pragma unroll
        for (int i = 0; i < 8; ++i) {
            const unsigned gt_before = run >> 16, tie_before = run & 0xffffu;
            const bool isgt = kk[i] > thr, istie = kk[i] == thr;
            const bool sel = isgt || (istie && tie_before < remaining);
            const unsigned slot = gt_before + (tie_before < remaining ? tie_before : remaining);
            const int s = 8 * F.tid + i, m = b * SEQ + s;
            if (sel) { IDX[be * CAP + slot] = m; GATE[be * CAP + slot] = __builtin_bit_cast(float, kk[i]); }
            SEL[(size_t)m * NE + e] = sel ? (int)slot : -1;
            run += (isgt ? 0x10000u : 0u) + (istie ? 1u : 0u);
        }
    }
    __syncthreads();
}
__device__ __forceinline__ void phase_p7(Frame& F) {
    const int* SEL = (const int*)(F.ws + WS_SEL); const float* GATE = (const float*)(F.ws + WS_GATE); const bf16* YE = (const bf16*)(F.ws + WS_YE);
    for (int m = GW_ID(F); m < MT; m += GW_N(F)) {
        const int b = m / SEQ;
        GAS f32x4* orow = (GAS f32x4*)(F.out + (size_t)m * DM);
        f32x4 acc[8];
#pragma unroll
        for (int j = 0; j < 8; ++j) acc[j] = orow[2 * F.lane + (j & 1) + 128 * (j >> 1)];
        for (int e = 0; e < NE; ++e) { const int slot = SEL[(size_t)m * NE + e]; if (slot >= 0) {
            const GAS v4u* yr = (const GAS v4u*)(YE + (size_t)((b * NE + e) * CAP + slot) * DM) + F.lane;
#pragma unroll
            for (int jj = 0; jj < 4; ++jj) { const v4u w = yr[64 * jj];
                acc[2 * jj].x += bflo(w.x); acc[2 * jj].y += bfhi(w.x); acc[2 * jj].z += bflo(w.y); acc[2 * jj].w += bfhi(w.y);
                acc[2 * jj + 1].x += bflo(w.z); acc[2 * jj + 1].y += bfhi(w.z); acc[2 * jj + 1].z += bflo(w.w); acc[2 * jj + 1].w += bfhi(w.w); } } }
#pragma unroll
        for (int j = 0; j < 8; ++j) orow[2 * F.lane + (j & 1) + 128 * (j >> 1)] = acc[j];
    }
    (void)GATE;
}

struct Args { const float* in[23]; float* out; unsigned char* ws; int ph_lo, ph_hi; };
enum Phase { PH_P0 = 0, PH_G1, PH_FILT, PH_ATTN, PH_P25, PH_OUT, PH_P35, PH_P4, PH_UP, PH_DOWN, PH_P7, PH_COUNT };

__global__ void __launch_bounds__(NTHREADS, 2) mk_fwd(Args args) {
    extern __shared__ __attribute__((aligned(16))) unsigned char lds_raw[];
    Frame F;
    F.lds = (LAS unsigned char*)lds_raw;
    F.tid = threadIdx.x; F.lane = F.tid & 63; F.wave = __builtin_amdgcn_readfirstlane(F.tid >> 6); F.G = gridDim.x; F.bid = blockIdx.x;
#pragma unroll
    for (int i = 0; i < 23; ++i) F.in[i] = args.in[i];
    F.out = args.out; F.ws = args.ws;
    const int lo = args.ph_lo, hi = args.ph_hi;
#define IN(k) (lo <= (k) && (k) < hi)
#define REPS(k) for (int rep_ = 0; rep_ < ((k) == REP_PHASE ? REP_N : 1); ++rep_)
#if MK_N_LAUNCHES == 1
    { volatile LAS unsigned* misc = (volatile LAS unsigned*)(F.lds + LDS_MISC_OFF); if (F.tid < 16) misc[F.tid] = 0u; }
    __syncthreads();
    XcdBarrier bar = xcd_barrier_post((unsigned*)(F.ws + WS_CTL) + 4096, (volatile LAS unsigned*)(F.lds + LDS_MISC_OFF) + 8);
#define SEAM(k) do { if (IN(k) && IN((k) + 1)) xcd_barrier(bar); } while (0)
#else
#define SEAM(k) do { } while (0)
#endif
    if (IN(PH_P0)) REPS(PH_P0) { phase_p0(F); for (int it = GW_ID(F); it < MOE_P0_ITEMS; it += GW_N(F)) moe_conv_item(F, it); } SEAM(PH_P0);
    if (IN(PH_G1)) REPS(PH_G1) {
        __syncthreads();
        { pg8::DenseOrder S; S.init(F.ws + WS_HB, F.ws + WS_WIN, MT, 2048, DM, 0, F.G, F.bid);
          pg8::EpiBf16 E{(pg8::bf16_t*)(F.ws + WS_QK), 2048, 0, nullptr};
          pg8::gemm_phase<pg8::EpiBf16, pg8::DenseOrder, true>(F.lds, DM, S, E); }
        { pg8::DenseOrder S; S.init(F.ws + WS_HB, F.ws + WS_WIN, MT, 4096, DM, 8, F.G, F.bid);
          pg8::EpiTransBf16 E{(pg8::bf16_t*)(F.ws + WS_XT), MT, 8};
          pg8::gemm_phase<pg8::EpiTransBf16, pg8::DenseOrder, true>(F.lds, DM, S, E); }
    } SEAM(PH_G1);
    if (IN(PH_FILT)) REPS(PH_FILT) { phase_filters(F); } SEAM(PH_FILT);
    if (IN(PH_ATTN)) { __syncthreads(); for (int rep_ = 0; rep_ < ((PH_ATTN == REP_PHASE && REP_SUB != 2) ? REP_N : 1); ++rep_) phase_hyena(F); for (int rep_ = 0; rep_ < ((PH_ATTN == REP_PHASE && REP_SUB != 1) ? REP_N : 1); ++rep_) phase_attn2(F); } SEAM(PH_ATTN);
    if (IN(PH_P25)) REPS(PH_P25) { __syncthreads(); phase_p25(F); } SEAM(PH_P25);
    if (IN(PH_OUT)) REPS(PH_OUT) {
        __syncthreads();
        pg8::DenseOrder S; S.init(F.ws + WS_MIXED, F.ws + WS_WOUT, MT, DM, DM, 0, F.G, F.bid);
        pg8::EpiResF32 E{F.in[0], F.out, DM};
        pg8::gemm_phase<pg8::EpiResF32, pg8::DenseOrder, false>(F.lds, DM, S, E);
    } SEAM(PH_OUT);
    if (IN(PH_P35)) REPS(PH_P35) { __syncthreads(); phase_p35(F); } SEAM(PH_P35);
    if (IN(PH_P4)) REPS(PH_P4) { __syncthreads(); phase_p4(F); } SEAM(PH_P4);
    if (IN(PH_UP)) REPS(PH_UP) {
        __syncthreads();
        pg8::MoeOrder S; S.init(F.ws + WS_HB, F.ws + WS_WGU, DM, F.G, F.bid, true);
        LAS int* ridx = (LAS int*)(F.lds + 131072);
        { const int* IDX = (const int*)(F.ws + WS_IDX); pg8::Unit u;
          for (int i = 0; S.next(i, u); ++i) if (F.tid < 256) ridx[i * 256 + F.tid] = IDX[u.g * CAP + u.pm * 256 + F.tid]; }
        __syncthreads();
        pg8::EpiSwiGLU E{(pg8::bf16_t*)(F.ws + WS_ACT)};
        pg8::gemm_phase<pg8::EpiSwiGLU, pg8::MoeOrder, true, true>(F.lds, DM, S, E, ridx);
    } SEAM(PH_UP);
    if (IN(PH_DOWN)) REPS(PH_DOWN) {
        __syncthreads();
        pg8::MoeOrder S; S.init(F.ws + WS_ACT, F.ws + WS_WD, FF, F.G, F.bid, false);
        pg8::EpiBf16 E{(pg8::bf16_t*)(F.ws + WS_YE), DM, 512, (const float*)(F.ws + WS_GATE)};
        pg8::gemm_phase<pg8::EpiBf16, pg8::MoeOrder, true>(F.lds, FF, S, E);
    } SEAM(PH_DOWN);
    if (IN(PH_P7)) { phase_p7(F); }
#undef IN
#undef SEAM
}

extern "C" void kernel_launch(void* const* d_in, const int* in_sizes, int n_in, void* d_out, int out_size, void* d_ws, size_t ws_size, hipStream_t stream) {
    static int grid = 0;
    if (grid == 0) {
        if (n_in != 23 || ws_size < WS_END) { fprintf(stderr, "kernel_launch: unexpected inputs (n_in %d, ws %zu)\n", n_in, ws_size); grid = -1; return; }
        if (hipFuncSetAttribute((const void*)mk_fwd, hipFuncAttributeMaxDynamicSharedMemorySize, LDS_BYTES) != hipSuccess) { fprintf(stderr, "kernel_launch: hipFuncSetAttribute failed\n"); grid = -1; return; }
        int dev = 0, cus = 0, per_cu = 0;
        hipGetDevice(&dev); hipDeviceGetAttribute(&cus, hipDeviceAttributeMultiprocessorCount, dev);
        hipOccupancyMaxActiveBlocksPerMultiprocessor(&per_cu, (const void*)mk_fwd, NTHREADS, LDS_BYTES);
        (void)hipGetLastError();
        if (per_cu < 1) { fprintf(stderr, "kernel_launch: occupancy query says %d blocks/CU\n", per_cu); }
        grid = cus;
    }
    if (grid < 0) return;
    Args a{};
    for (int i = 0; i < 23; ++i) a.in[i] = (const float*)d_in[i];
    a.out = (float*)d_out; a.ws = (unsigned char*)d_ws;
#if MK_N_LAUNCHES == 1
    if (hipMemsetAsync((char*)d_ws + WS_CTL, 0, CTL_ZERO_BYTES, stream) != hipSuccess) { fprintf(stderr, "kernel_launch: memset failed\n"); return; }
    a.ph_lo = 0; a.ph_hi = PH_COUNT;
    void* kargs[] = {&a};
    hipError_t e = hipLaunchCooperativeKernel((const void*)mk_fwd, dim3(grid), dim3(NTHREADS), kargs, LDS_BYTES, stream);
    if (e != hipSuccess) fprintf(stderr, "cooperative launch failed: %s (grid %d)\n", hipGetErrorString(e), grid);
#else
    for (int p = 0; p < PH_COUNT; ++p) { a.ph_lo = p; a.ph_hi = p + 1; hipLaunchKernelGGL(mk_fwd, dim3(grid), dim3(NTHREADS), LDS_BYTES, stream, a); }
#endif
}
```

```cpp
#include <hip/hip_runtime.h>
#include <hip/hip_cooperative_groups.h>
#include <cstdio>
#include <cstdint>
namespace cg = cooperative_groups;

#ifndef REP_PHASE
#define REP_PHASE -1
#define REP_N 1
#define REP_SUB 0
#endif
#ifndef MK_N_LAUNCHES
#define MK_N_LAUNCHES 1
#endif

namespace pg8 {
#define PG8_LAS __attribute__((address_space(3)))
typedef unsigned short bf16_t;
typedef short bf16x8 __attribute__((ext_vector_type(8)));
typedef float f32x4 __attribute__((ext_vector_type(4)));
typedef unsigned u32x4 __attribute__((ext_vector_type(4)));
typedef unsigned u32x2 __attribute__((ext_vector_type(2)));
constexpr int BM = 256, BK = 64, HALF = 128, HTB = HALF * BK * 2, STAGE_BYTES = 8 * HTB, NXCD = 8, WGM = 8;

__host__ __device__ __forceinline__ int lds_byte(int r, int c) { const int st = (r >> 4) * 2 + (c >> 5), rr = r & 15, cc = c & 31, ob = rr * 64 + cc * 2; return st * 1024 + (ob ^ (((ob >> 9) & 1) << 5)); }
__host__ __device__ __forceinline__ void stage_rc(int b, int& R, int& C) { const int st = b / 1024, sb = b % 1024, swz = sb ^ (((sb >> 9) & 1) << 5); R = (st >> 1) * 16 + swz / 64; C = (st & 1) * 32 + (swz % 64) / 2; }
__host__ __device__ __forceinline__ int perm32(int rho) { const int n = rho >> 4, i = rho & 15; return 8 * (i >> 2) + 4 * n + (i & 3); }

struct Unit { int pm, pn, g; const char* a; const char* b; };

__device__ __forceinline__ unsigned cvt_pk_bf16(float lo, float hi) { unsigned r; asm volatile("v_cvt_pk_bf16_f32 %0, %1, %2" : "=v"(r) : "v"(lo), "v"(hi)); return r; }

struct DenseOrder {
    static constexpr bool CHUNK_B = false;
    int nM, nN, nwg, G, c, K, pn0; const char* A; const char* Bt;
    __device__ void init(const void* A_, const void* Bt_, int M, int N, int K_, int pn0_, int G_, int c_) { A = (const char*)A_; Bt = (const char*)Bt_; nM = M / BM; nN = N / BM; nwg = nM * nN; G = G_; c = c_; K = K_; pn0 = pn0_; }
    __device__ bool next(int i, Unit& u) const {
        const long L = (long)i * G + c; if (L >= nwg) return false;
        int wgid = (int)L; { const int q = nwg / NXCD, r = nwg % NXCD, xcd = wgid % NXCD, off = wgid / NXCD; wgid = (xcd < r ? xcd * (q + 1) : r * (q + 1) + (xcd - r) * q) + off; }
        const int nig = WGM * nN, gid = wgid / nig, fm = gid * WGM, gsz = (nM - fm) < WGM ? (nM - fm) : WGM;
        u.pm = fm + ((wgid % nig) % gsz); u.pn = pn0 + (wgid % nig) / gsz; u.g = 0;
        u.a = A + (size_t)u.pm * BM * K * 2; u.b = Bt + (size_t)u.pn * BM * K * 2; return true;
    }
};
struct MoeOrder {
    static constexpr bool CHUNK_B = true;
    int G, c, K; bool gather; const char* A; const char* Bt;
    __device__ void init(const void* A_, const void* Bt_, int K_, int G_, int c_, bool gather_) { A = (const char*)A_; Bt = (const char*)Bt_; K = K_; G = G_; c = c_; gather = gather_; }
    __device__ bool next(int i, Unit& u) const {
        const int L = i * G + c; if (L >= 512) return false;
        const int pn = L & 7, pm = (L >> 3) & 1, b = (L >> 4) & 1, e = L >> 5;
        u.pm = pm; u.pn = pn; u.g = b * 16 + e;
        u.a = gather ? A : A + (size_t)(u.g * 512 + pm * BM) * K * 2; u.b = Bt + (size_t)e * 2048 * K * 2 + (size_t)pn * BM * 16; return true;
    }
};

struct EpiBf16 {
    static constexpr bool PERM = true, SWAP = false;
    bf16_t* O; int ldc; int grows; const float* rscale;
    __device__ __forceinline__ void operator()(const f32x4 (&acc)[2][2][4][2], const Unit& u, int wr, int wc, int fr, int fq) const {
        const int row0 = u.g * grows + u.pm * BM + wr * 64 + fr, col0 = u.pn * BM + wc * 32 + 8 * fq;
#pragma unroll
        for (int ai = 0; ai < 2; ++ai)
#pragma unroll
            for (int m = 0; m < 4; ++m) { const int row = row0 + ai * HALF + m * 16; bf16_t* rowp = O + (size_t)row * ldc + col0; const float sc = rscale ? rscale[row] : 1.f;
#pragma unroll
                for (int bj = 0; bj < 2; ++bj) { const f32x4 v0 = acc[ai][bj][m][0] * sc, v1 = acc[ai][bj][m][1] * sc;
                    u32x4 w; w.x = cvt_pk_bf16(v0[0], v0[1]); w.y = cvt_pk_bf16(v0[2], v0[3]); w.z = cvt_pk_bf16(v1[0], v1[1]); w.w = cvt_pk_bf16(v1[2], v1[3]);
                    *(u32x4*)(rowp + bj * HALF) = w; } }
    }
};
struct EpiSwiGLU {
    static constexpr bool PERM = true, SWAP = false;
    bf16_t* O;
    __device__ __forceinline__ void operator()(const f32x4 (&acc)[2][2][4][2], const Unit& u, int wr, int wc, int fr, int fq) const {
        const int row0 = u.g * 512 + u.pm * BM + wr * 64 + fr, col0 = u.pn * HALF + wc * 32 + 8 * fq;
#pragma unroll
        for (int ai = 0; ai < 2; ++ai)
#pragma unroll
            for (int m = 0; m < 4; ++m) { bf16_t* rowp = O + (size_t)(row0 + ai * HALF + m * 16) * 1024 + col0;
                float r[8];
#pragma unroll
                for (int n = 0; n < 2; ++n)
#pragma unroll
                    for (int e = 0; e < 4; ++e) { const float g = acc[ai][0][m][n][e], up = acc[ai][1][m][n][e]; r[n * 4 + e] = g / (1.f + __expf(-g)) * up; }
                u32x4 w; w.x = cvt_pk_bf16(r[0], r[1]); w.y = cvt_pk_bf16(r[2], r[3]); w.z = cvt_pk_bf16(r[4], r[5]); w.w = cvt_pk_bf16(r[6], r[7]);
                *(u32x4*)rowp = w; }
    }
};
struct EpiResF32 {
    static constexpr bool PERM = false, SWAP = false;
    const float* res; float* out; int ldc;
    __device__ __forceinline__ void operator()(const f32x4 (&acc)[2][2][4][2], const Unit& u, int wr, int wc, int fr, int fq) const {
        const int row0 = u.pm * BM + wr * 64 + fr, col0 = u.pn * BM + wc * 32 + 4 * fq;
#pragma unroll
        for (int ai = 0; ai < 2; ++ai)
#pragma unroll
            for (int m = 0; m < 4; ++m) { const size_t off = (size_t)(row0 + ai * HALF + m * 16) * ldc + col0;
#pragma unroll
                for (int bj = 0; bj < 2; ++bj)
#pragma unroll
                    for (int n = 0; n < 2; ++n) { const f32x4 r = *(const f32x4*)(res + off + bj * HALF + n * 16); *(f32x4*)(out + off + bj * HALF + n * 16) = r + acc[ai][bj][m][n]; } }
    }
};
struct EpiTransBf16 {
    static constexpr bool PERM = false, SWAP = true;
    bf16_t* O; int ldt; int pn_base;
    __device__ __forceinline__ void operator()(const f32x4 (&acc)[2][2][4][2], const Unit& u, int wr, int wc, int fr, int fq) const {
        const int ch0 = (u.pn - pn_base) * BM + wc * 32 + fr, t0 = u.pm * BM + wr * 64 + 4 * fq;
#pragma unroll
        for (int bj = 0; bj < 2; ++bj)
#pragma unroll
            for (int n = 0; n < 2; ++n) { bf16_t* chp = O + (size_t)(ch0 + bj * HALF + n * 16) * ldt + t0;
#pragma unroll
                for (int ai = 0; ai < 2; ++ai)
#pragma unroll
                    for (int m = 0; m < 4; ++m) { const f32x4 v = acc[ai][bj][m][n]; u32x2 w; w.x = cvt_pk_bf16(v[0], v[1]); w.y = cvt_pk_bf16(v[2], v[3]); *(u32x2*)(chp + ai * HALF + m * 16) = w; } }
    }
};

template <class Epi, class Sched, bool ALIGN_EPI = false, bool GATHER = false>
__device__ __forceinline__ void gemm_phase(PG8_LAS unsigned char* lds, const int K, const Sched& S, const Epi& E, const PG8_LAS int* ridx = nullptr) {
    const int tid = threadIdx.x, wid = __builtin_amdgcn_readfirstlane(tid >> 6), lane = tid & 63, wr = wid >> 2, wc = wid & 3, fr = lane & 15, fq = lane >> 4;
    const int nt = K / BK;
    unsigned vA0[2], vA1[2], vN0[2], vN1[2], voffB[2]; int stR[2], stC[2];
    const size_t kstep = (size_t)(BK * 2);
    const size_t hstep = (size_t)HALF * K * 2;
    const size_t kstepB = Sched::CHUNK_B ? (size_t)(BK / 8) * 2048 * 16 : kstep, hstepB = Sched::CHUNK_B ? (size_t)HALF * 16 : hstep;
#pragma unroll
    for (int i = 0; i < 2; ++i) { int R, C; stage_rc(tid * 16 + i * 8192, R, C); const int Rb = Epi::PERM ? ((R & ~31) + perm32(R & 31)) : R; stR[i] = R; stC[i] = C;
        voffB[i] = Sched::CHUNK_B ? (unsigned)(((C >> 3) * 2048 + Rb) * 16) : (unsigned)(Rb * K + C) * 2u;
        if constexpr (GATHER) { vA0[i] = (unsigned)(ridx[R] * K + C) * 2u; vA1[i] = (unsigned)(ridx[HALF + R] * K + C) * 2u; }
        else { vA0[i] = (unsigned)(R * K + C) * 2u; vA1[i] = vA0[i] + (unsigned)hstep; }
        vN0[i] = vA0[i]; vN1[i] = vA1[i]; }
    const unsigned ldsw = (unsigned)wid * 1024u;
    const int aoff = lds_byte(wr * 64 + fr, fq * 8), boff = lds_byte(wc * 32 + fr, fq * 8);
#define PG8_SA(b, h) (((b) * 2 + (h)) * HTB)
#define PG8_SB(b, h) ((4 + (b) * 2 + (h)) * HTB)
#define PG8_STAGE(bufoff, gbase, voff) do { _Pragma("unroll") for (int _i = 0; _i < 2; ++_i) \
        __builtin_amdgcn_global_load_lds((const unsigned*)((const char*)(gbase) + (voff)[_i]), (PG8_LAS unsigned*)(lds + (bufoff) + ldsw + _i * 8192), 16, 0, 0); } while (0)
#define PG8_LDA(dst, b, h) do { _Pragma("unroll") for (int m = 0; m < 4; ++m) _Pragma("unroll") for (int k = 0; k < 2; ++k) dst[m][k] = *(const PG8_LAS bf16x8*)(lds + PG8_SA(b, h) + aoff + m * 2048 + k * 1024); } while (0)
#define PG8_LDB(dst, b, h) do { _Pragma("unroll") for (int n = 0; n < 2; ++n) _Pragma("unroll") for (int k = 0; k < 2; ++k) dst[n][k] = *(const PG8_LAS bf16x8*)(lds + PG8_SB(b, h) + boff + n * 2048 + k * 1024); } while (0)
#define PG8_MMA(ai, bj, At, Bt) do { __builtin_amdgcn_s_setprio(1); _Pragma("unroll") for (int m = 0; m < 4; ++m) _Pragma("unroll") for (int n = 0; n < 2; ++n) _Pragma("unroll") for (int k = 0; k < 2; ++k) \
        acc[ai][bj][m][n] = Epi::SWAP ? __builtin_amdgcn_mfma_f32_16x16x32_bf16(At[m][k], Bt[n][k], acc[ai][bj][m][n], 0, 0, 0) : __builtin_amdgcn_mfma_f32_16x16x32_bf16(Bt[n][k], At[m][k], acc[ai][bj][m][n], 0, 0, 0); __builtin_amdgcn_s_setprio(0); } while (0)
#define PG8_WAIT_V(n) asm volatile("s_waitcnt vmcnt(" #n ")" ::: "memory")
#define PG8_WAIT_L(n) asm volatile("s_waitcnt lgkmcnt(" #n ")" ::: "memory")
#define PG8_BAR __builtin_amdgcn_s_barrier()
#define PG8_SCHED __builtin_amdgcn_sched_barrier(0)
    Unit cur, nxt; int ui = 0;
    if (!S.next(0, cur)) return;
    f32x4 acc[2][2][4][2];
#pragma unroll
    for (int a = 0; a < 2; ++a)
#pragma unroll
        for (int b = 0; b < 2; ++b)
#pragma unroll
            for (int m = 0; m < 4; ++m)
#pragma unroll
                for (int n = 0; n < 2; ++n) acc[a][b][m][n] = (f32x4){0.f, 0.f, 0.f, 0.f};
    bf16x8 At[4][2], B0[2][2], B1[2][2];
    const char* cA = cur.a; const char* cB = cur.b;
    PG8_STAGE(PG8_SB(0, 0), cB, voffB); PG8_STAGE(PG8_SB(0, 1), cB + hstepB, voffB); PG8_STAGE(PG8_SA(0, 0), cA, vA0); PG8_STAGE(PG8_SA(0, 1), cA, vA1);
    if (wr == 1) PG8_BAR;
    PG8_WAIT_V(2); PG8_BAR;
    PG8_STAGE(PG8_SB(1, 0), cB + kstepB, voffB); PG8_STAGE(PG8_SA(1, 0), cA + kstep, vA0); PG8_STAGE(PG8_SB(1, 1), cB + hstepB + kstepB, voffB);
    PG8_WAIT_V(6); PG8_BAR;
    for (;;) {
        const bool has_next = S.next(ui + 1, nxt);
        const char* nA = has_next ? nxt.a : cA; const char* nB = has_next ? nxt.b : cB;
        if constexpr (GATHER) { if (has_next) {
#pragma unroll
            for (int i = 0; i < 2; ++i) { vN0[i] = (unsigned)(ridx[(ui + 1) * 256 + stR[i]] * K + stC[i]) * 2u; vN1[i] = (unsigned)(ridx[(ui + 1) * 256 + HALF + stR[i]] * K + stC[i]) * 2u; } } }
        for (int t = 0; t < nt; t += 2) {
            const bool last = (t == nt - 2);
            const char* a1 = cA + (size_t)(t + 1) * kstep;
            const char* a2 = last ? nA : cA + (size_t)(t + 2) * kstep; const char* b2 = last ? nB : cB + (size_t)(t + 2) * kstepB;
            const char* a3 = a2 + kstep; const char* b3 = b2 + kstepB;
            unsigned w0[2], w1[2];
#pragma unroll
            for (int i = 0; i < 2; ++i) { w0[i] = last ? vN0[i] : vA0[i]; w1[i] = last ? vN1[i] : vA1[i]; }
            PG8_LDB(B0, 0, 0); PG8_LDB(B1, 0, 1); PG8_SCHED; PG8_LDA(At, 0, 0); PG8_STAGE(PG8_SA(1, 1), a1, vA1);
            PG8_WAIT_V(8); PG8_WAIT_L(0); PG8_BAR; PG8_MMA(0, 0, At, B0); PG8_MMA(0, 1, At, B1); PG8_BAR; PG8_SCHED;
            PG8_LDA(At, 0, 1); PG8_STAGE(PG8_SB(0, 0), b2, voffB); PG8_STAGE(PG8_SB(0, 1), b2 + hstepB, voffB); PG8_STAGE(PG8_SA(0, 0), a2, w0);
            PG8_WAIT_V(8); PG8_WAIT_L(0); PG8_BAR; PG8_MMA(1, 0, At, B0); PG8_MMA(1, 1, At, B1); PG8_BAR; PG8_SCHED;
            PG8_LDB(B0, 1, 0); PG8_LDB(B1, 1, 1); PG8_SCHED; PG8_LDA(At, 1, 0); PG8_STAGE(PG8_SA(0, 1), a2, w1);
            PG8_WAIT_V(8); PG8_WAIT_L(0); PG8_BAR; PG8_MMA(0, 0, At, B0); PG8_MMA(0, 1, At, B1); PG8_BAR; PG8_SCHED;
            PG8_LDA(At, 1, 1); PG8_STAGE(PG8_SB(1, 0), b3, voffB); PG8_STAGE(PG8_SB(1, 1), b3 + hstepB, voffB); PG8_STAGE(PG8_SA(1, 0), a3, w0);
            PG8_WAIT_V(8); PG8_WAIT_L(0); PG8_BAR; PG8_MMA(1, 0, At, B0); PG8_MMA(1, 1, At, B1); PG8_BAR; PG8_SCHED;
        }
        if constexpr (ALIGN_EPI) { if (wr == 0) PG8_BAR; }
        E(acc, cur, wr, wc, fr, fq);
        if (!has_next) break;
#pragma unroll
        for (int a = 0; a < 2; ++a)
#pragma unroll
            for (int b = 0; b < 2; ++b)
#pragma unroll
                for (int m = 0; m < 4; ++m)
#pragma unroll
                    for (int n = 0; n < 2; ++n) acc[a][b][m][n] = (f32x4){0.f, 0.f, 0.f, 0.f};
        cur = nxt; cA = nA; cB = nB; ++ui;
#pragma unroll
        for (int i = 0; i < 2; ++i) { vA0[i] = vN0[i]; vA1[i] = vN1[i]; }
        if constexpr (ALIGN_EPI) { if (wr == 1) PG8_BAR; }
    }
    PG8_WAIT_V(0);
    if constexpr (!ALIGN_EPI) { if (wr == 0) PG8_BAR; }
    PG8_BAR;
#undef PG8_SA
#undef PG8_SB
#undef PG8_STAGE
#undef PG8_LDA
#undef PG8_LDB
#undef PG8_MMA
#undef PG8_WAIT_V
#undef PG8_WAIT_L
#undef PG8_BAR
#undef PG8_SCHED
}
}

constexpr int NB = 2, SEQ = 4096, DM = 2048, MT = NB * SEQ;
constexpr int NH = 8, HD = 128, AW = 1024, HW = 1024, INW = 6144;
constexpr int GW = 64, NROWS = 64, WR = 8, WC = 16;
constexpr int NE = 16, CAP = 512, FF = 1024;
constexpr int FEMB = 33, FHID = 64;
constexpr float EPS = 1e-6f;
constexpr int NWAVES = 8, NTHREADS = 512;

constexpr size_t MiB = 1u << 20;
constexpr size_t WS_CTL = 0, CTL_ZERO_BYTES = 32768;
constexpr size_t WS_WIN = 2 * MiB;
constexpr size_t WS_WOUT = 26 * MiB;
constexpr size_t WS_WGU = 34 * MiB;
constexpr size_t WS_WD = 162 * MiB;
constexpr size_t WS_W3T = 226 * MiB;
constexpr size_t WS_HID2 = 227 * MiB;
constexpr size_t WS_HB = 228 * MiB;
constexpr size_t WS_QK = 260 * MiB;
constexpr size_t WS_XT = 292 * MiB;
constexpr size_t WS_UC = 356 * MiB;
constexpr size_t WS_TAPS = 404 * MiB;
constexpr size_t WS_HYT = 436 * MiB;
constexpr size_t WS_MIXED = 452 * MiB;
constexpr size_t WS_AFF = 484 * MiB;
constexpr size_t WS_IDX = 485 * MiB;
constexpr size_t WS_GATE = 486 * MiB;
constexpr size_t WS_SEL = 487 * MiB;
constexpr size_t WS_Z1T = 488 * MiB;
constexpr size_t WS_XG = WS_XT;
constexpr size_t WS_ACT = WS_UC;
constexpr size_t WS_YE = WS_TAPS;
constexpr size_t WS_END = 504 * MiB;

constexpr int LDS_BYTES = 163840, LDS_MISC_OFF = 163840 - 128;

#define GAS __attribute__((address_space(1)))
#define LAS __attribute__((address_space(3)))
typedef unsigned short bf16;
typedef unsigned v4u __attribute__((ext_vector_type(4)));
typedef unsigned v2u __attribute__((ext_vector_type(2)));
typedef float f32x4 __attribute__((ext_vector_type(4)));
#define LDS_WAIT() asm volatile("s_waitcnt lgkmcnt(0)" ::: "memory")
#define VM_WAIT() asm volatile("s_waitcnt vmcnt(0)" ::: "memory")
__device__ __forceinline__ unsigned f2bf(float f) { unsigned u = __builtin_bit_cast(unsigned, f); return (u + 0x7fffu + ((u >> 16) & 1u)) >> 16; }
__device__ __forceinline__ unsigned pk2(float lo, float hi) { unsigned r; asm("v_cvt_pk_bf16_f32 %0, %1, %2" : "=v"(r) : "v"(lo), "v"(hi)); return r; }
__device__ __forceinline__ float bf2f(unsigned h) { return __builtin_bit_cast(float, h << 16); }
__device__ __forceinline__ float bflo(unsigned w) { return __builtin_bit_cast(float, w << 16); }
__device__ __forceinline__ float bfhi(unsigned w) { return __builtin_bit_cast(float, w & 0xffff0000u); }
__device__ __forceinline__ float wave_sum(float v) {
#pragma unroll
    for (int o = 1; o < 64; o <<= 1) v += __shfl_xor(v, o);
    return v;
}


#define XB_TMO      128
#define XB_XCNT(j)  (256  + 64 * (j))
#define XB_XSUB(j)  (1280 + 64 * (j))
#define XB_XGEN(j)  (2304 + 64 * (j))
#define XB_TOP      3328
#define XB_TOPGEN   3392
#define XCD_BAR_WORDS 3456
#define XB_SPIN_CAP (1u << 22)
__device__ __forceinline__ unsigned xb_ld(unsigned* p)              { return __hip_atomic_load(p, __ATOMIC_RELAXED, __HIP_MEMORY_SCOPE_AGENT); }
__device__ __forceinline__ unsigned xb_add(unsigned* p, unsigned v) { return __hip_atomic_fetch_add(p, v, __ATOMIC_RELAXED, __HIP_MEMORY_SCOPE_AGENT); }
__device__ __forceinline__ unsigned xb_xcc_id() { return (unsigned)__builtin_amdgcn_s_getreg((3 << 11) | 20) & 0xFu; }
#define XB_SPIN(cond, bar) do { unsigned _sp = 0; while (cond) { __builtin_amdgcn_s_sleep(1); \
    if ((++_sp & 255u) == 0u) { if (xb_ld(&(bar)[XB_TMO])) break; if (_sp > XB_SPIN_CAP) { atomicAdd(&(bar)[XB_TMO], 1u); break; } } } } while (0)
struct XcdBarrier { unsigned* bar; unsigned x; volatile LAS unsigned* st; };
__device__ __forceinline__ XcdBarrier xcd_barrier_post(unsigned* bar, volatile LAS unsigned* st) {
    XcdBarrier b; b.bar = bar; b.x = xb_xcc_id(); b.st = st;
    if (threadIdx.x == 0) (void)xb_add(&bar[XB_XCNT(b.x)], 1u);
    return b;
}
__device__ __forceinline__ void xcd_barrier_complete(unsigned* bar, unsigned x, unsigned& nloc, unsigned& nx) {
    const unsigned G = gridDim.x * gridDim.y * gridDim.z;
    unsigned sum, cnt, mine, sp = 0u;
    for (;;) {
        sum = 0u; cnt = 0u; mine = 0u;
#pragma unroll
        for (unsigned j = 0; j < 16; ++j) { const unsigned c = xb_ld(&bar[XB_XCNT(j)]); sum += c; cnt += (c > 0u) ? 1u : 0u; mine = (j == x) ? c : mine; }
        if (sum == G) break;
        __builtin_amdgcn_s_sleep(1);
        if ((++sp & 255u) == 0u) { if (xb_ld(&bar[XB_TMO])) break; if (sp > XB_SPIN_CAP) { atomicAdd(&bar[XB_TMO], 1u); break; } }
    }
    nloc = mine > 0u ? mine : 1u; nx = cnt > 0u ? cnt : 1u;
}
__device__ __forceinline__ void xcd_barrier(const XcdBarrier& b) {
    asm volatile("s_waitcnt vmcnt(0)" ::: "memory");
    __syncthreads();
    if (threadIdx.x == 0) {
        unsigned* bar = b.bar;
        __builtin_amdgcn_s_waitcnt(0);
        unsigned nloc = b.st[0], nx = b.st[1];
        if (nloc == 0u) { xcd_barrier_complete(bar, b.x, nloc, nx); b.st[0] = nloc; b.st[1] = nx; }
        const unsigned old = xb_add(&bar[XB_XSUB(b.x)], 1u);
        const unsigned gen = old / nloc;
        if (old + 1u == (gen + 1u) * nloc) {
            __builtin_amdgcn_fence(__ATOMIC_RELEASE, "agent");
            asm volatile("s_waitcnt vmcnt(0)" ::: "memory");
            const unsigned og = xb_add(&bar[XB_TOP], 1u);
            const unsigned tg = og / nx;
            if (og + 1u == (tg + 1u) * nx) xb_add(&bar[XB_TOPGEN], 1u);
            else XB_SPIN(xb_ld(&bar[XB_TOPGEN]) == tg, bar);
            __builtin_amdgcn_fence(__ATOMIC_ACQUIRE, "agent");
            xb_add(&bar[XB_XGEN(b.x)], 1u);
            asm volatile("s_waitcnt vmcnt(0)" ::: "memory");
        } else {
            XB_SPIN(xb_ld(&bar[XB_XGEN(b.x)]) == gen, bar);
            __builtin_amdgcn_fence(__ATOMIC_ACQUIRE, "agent");
            asm volatile("s_waitcnt vmcnt(0)" ::: "memory");
        }
    }
    __syncthreads();
}

__device__ unsigned g_bar_words[XCD_BAR_WORDS + 64];
struct Frame {
    LAS unsigned char* lds;
    int tid, lane, wave, G, bid;
    const float* in[23]; float* out; unsigned char* ws;
};
#define GW_ID(F) ((F).bid * NWAVES + (F).wave)
#define GW_N(F) ((F).G * NWAVES)

__device__ __forceinline__ void p0_transpose_item(const float* W, int K, int N, bf16* WT, int row_base, int k0, int n0, LAS float* scr, int lane) {
#pragma unroll 8
    for (int i = 0; i < 32; ++i) { const int kk = 2 * i + (lane >> 5); scr[kk * 33 + (lane & 31)] = W[(size_t)(k0 + kk) * N + n0 + (lane & 31)]; }
    LDS_WAIT(); asm volatile("" ::: "memory");
    const int c = lane & 7;
#pragma unroll
    for (int j = 0; j < 4; ++j) { const int n = (lane >> 3) + 8 * j; const LAS float* s = scr + (8 * c) * 33 + n;
        v4u o; o.x = pk2(s[0 * 33], s[1 * 33]); o.y = pk2(s[2 * 33], s[3 * 33]); o.z = pk2(s[4 * 33], s[5 * 33]); o.w = pk2(s[6 * 33], s[7 * 33]);
        *(GAS v4u*)(WT + (size_t)(row_base + n) * K + k0 + 8 * c) = o; }
    LDS_WAIT(); asm volatile("" ::: "memory");
}
__device__ __forceinline__ void phase_p0(Frame& F) {
    LAS float* scr = (LAS float*)(F.lds + F.wave * 16384);
    const int gw = GW_ID(F), NGW = GW_N(F);
    bf16* WinT = (bf16*)(F.ws + WS_WIN); bf16* WoutT = (bf16*)(F.ws + WS_WOUT); bf16* W3T = (bf16*)(F.ws + WS_W3T);
    constexpr int I_IN = (DM / 64) * (INW / 32), I_OUT = (DM / 64) * (DM / 32), I_3 = 1 * (4096 / 32);
    constexpr int NITEMS = I_IN + I_OUT + I_3;
    for (int it = gw; it < NITEMS; it += NGW) {
        int r = it;
        if (r < I_IN) { const int nblk = INW / 32, kb = r / nblk, nb = r % nblk; p0_transpose_item(F.in[2], DM, INW, WinT, 32 * nb, 64 * kb, 32 * nb, scr, F.lane); continue; } r -= I_IN;
        if (r < I_OUT) { const int nblk = DM / 32, kb = r / nblk, nb = r % nblk; p0_transpose_item(F.in[17], DM, DM, WoutT, 32 * nb, 64 * kb, 32 * nb, scr, F.lane); continue; } r -= I_OUT;
        { const int nb = r; p0_transpose_item(F.in[12], FHID, 4096, W3T, 32 * nb, 0, 32 * nb, scr, F.lane); }
    }
    bf16* HB = (bf16*)(F.ws + WS_HB);
    const float* x = F.in[0]; const float* g = F.in[1];
    for (int m = gw; m < MT; m += NGW) {
        const GAS f32x4* xr = (const GAS f32x4*)(x + (size_t)m * DM) + F.lane;
        f32x4 v[8]; float s = 0.f;
#pragma unroll
        for (int j = 0; j < 8; ++j) { v[j] = xr[64 * j]; s += (v[j].x * v[j].x + v[j].y * v[j].y) + (v[j].z * v[j].z + v[j].w * v[j].w); }
        const float r = rsqrtf(wave_sum(s) * (1.f / DM) + EPS);
        GAS v2u* o8 = (GAS v2u*)(HB + (size_t)m * DM) + F.lane;
#pragma unroll
        for (int j = 0; j < 8; ++j) { const f32x4 gg = *((const GAS f32x4*)g + F.lane + 64 * j); v2u o; o.x = pk2(v[j].x * r * gg.x, v[j].y * r * gg.y); o.y = pk2(v[j].z * r * gg.z, v[j].w * r * gg.w); o8[64 * j] = o; }
    }
    float* HID2 = (float*)(F.ws + WS_HID2);
    LAS float* sc2 = (LAS float*)(F.lds + F.wave * 16384);
    const float* w1 = F.in[8]; const float* b1 = F.in[9]; const float* w2 = F.in[10]; const float* b2 = F.in[11]; const float* fr = F.in[13];
    for (int l = gw; l < SEQ; l += NGW) {
        const int j = F.lane;
        float zv = 0.f;
        if (j == 0) zv = (float)l / (float)(SEQ - 1);
        else if (j < FEMB) { const int k = (j - 1) & 15; const float f = 1e-4f + (float)k * ((15.0f - 1e-4f) / 15.0f); const float wv = 6.283185307179586f * (float)l / (float)SEQ; zv = (j <= 16) ? cosf(f * wv) : -sinf(f * wv); }
        sc2[j] = zv; LDS_WAIT(); asm volatile("" ::: "memory");
        float a = b1[j];
        for (int i = 0; i < FEMB; ++i) a += sc2[i] * w1[i * FHID + j];
        const float h1 = sinf(fr[j] * a);
        sc2[64 + j] = h1; LDS_WAIT(); asm volatile("" ::: "memory");
        float c = b2[j];
        for (int i = 0; i < FHID; ++i) c += sc2[64 + i] * w2[i * FHID + j];
        HID2[l * FHID + j] = sinf(fr[j] * c);
        LDS_WAIT(); asm volatile("" ::: "memory");
    }
}

__device__ __forceinline__ void phase_filters_naive(Frame& F) {
    const float* HID2 = (const float*)(F.ws + WS_HID2); const float* w3 = F.in[12]; const float* fbias = F.in[14]; bf16* TAPS = (bf16*)(F.ws + WS_TAPS);
    const size_t total = (size_t)SEQ * 4096;
    for (size_t i = (size_t)F.bid * NTHREADS + F.tid; i < total; i += (size_t)F.G * NTHREADS) {
        const int col = (int)(i & 4095), l = (int)(i >> 12);
        float a = 0.f;
        for (int k = 0; k < FHID; ++k) a += HID2[l * FHID + k] * w3[(size_t)k * 4096 + col];
        const int c = col & 1023, dir = (col >> 10) & 1, o = col >> 11;
        const float mind = -4.605170185988091f / 1.5f, maxd = -4.605170185988091f / 0.3f;
        const float delta = fabsf(mind + (maxd - mind) * ((float)c / 1023.0f));
        const float t = (float)l / (float)(SEQ - 1);
        float v = a * expf(-t * delta);
        bf16* tp = TAPS + ((size_t)c * 2 + o) * 8192;
        if (dir == 0) { if (l == 0) v += fbias[o * 1024 + c]; tp[4096 + l] = (bf16)f2bf(v); }
        else { if (l > 0) tp[4096 - l] = (bf16)f2bf(v); else tp[0] = 0; }
    }
}
__device__ __forceinline__ void phase_hyena_naive(Frame& F, int o) {
    const bf16* UC = (const bf16*)(F.ws + WS_UC); const bf16* TAPS = (const bf16*)(F.ws + WS_TAPS);
    bf16* Z1T = (bf16*)(F.ws + WS_Z1T); bf16* HYT = (bf16*)(F.ws + WS_HYT);
    const bf16* Zin = o == 0 ? UC + (size_t)2048 * MT : Z1T; const bf16* gate = UC + (size_t)(o * 1024) * MT; bf16* OUT = o == 0 ? Z1T : HYT;
    const size_t total = (size_t)1024 * MT;
    for (size_t i = (size_t)F.bid * NTHREADS + F.tid; i < total; i += (size_t)F.G * NTHREADS) {
        const int c = (int)(i >> 13), m = (int)(i & 8191), b = m >> 12, t = m & 4095;
        const bf16* z = Zin + (size_t)c * MT + b * SEQ; const bf16* tp = TAPS + ((size_t)c * 2 + o) * 8192 + 4096 + t;
        float acc = 0.f;
        for (int s = 0; s < SEQ; ++s) acc += bf2f(tp[-s]) * bf2f(z[s]);
        OUT[(size_t)c * MT + m] = (bf16)f2bf(bf2f(gate[(size_t)c * MT + m]) * acc);
    }
}
__device__ __forceinline__ void phase_attn_naive(Frame& F) {
    const bf16* QK = (const bf16*)(F.ws + WS_QK); const bf16* VT = (const bf16*)(F.ws + WS_XT); bf16* MIXED = (bf16*)(F.ws + WS_MIXED);
    const float* rpb = F.in[5]; const float* og = F.in[15];
    const int lane = F.lane;
    for (int w = GW_ID(F); w < MT * NH; w += GW_N(F)) {
        const int m = w >> 3, h = w & 7, b = m / SEQ, s = m % SEQ, r = s / GW, c = s % GW;
        int kr0 = r - WR / 2; kr0 = kr0 < 0 ? 0 : (kr0 > NROWS - WR ? NROWS - WR : kr0);
        int c0 = c - WC / 2; c0 = c0 < 0 ? 0 : (c0 > GW - WC ? GW - WC : c0);
        const bf16* q = QK + (size_t)m * 2048 + h * HD;
        const float q0 = bf2f(q[lane]), q1 = bf2f(q[lane + 64]);
        float mx = -INFINITY, l = 0.f, a0 = 0.f, a1 = 0.f;
        for (int i = 0; i < WR; ++i) for (int j = 0; j < WC; ++j) {
            const int kr = kr0 + i, kc = c0 + j; const size_t km = (size_t)b * SEQ + kr * GW + kc;
            const bf16* kp = QK + km * 2048 + 1024 + h * HD;
            const float d = wave_sum(q0 * bf2f(kp[lane]) + q1 * bf2f(kp[lane + 64]));
            const int dr = kr - r + WR - 1; int dc = kc - c + WC - 1; dc = dc < 0 ? 0 : (dc > 2 * WC - 2 ? 2 * WC - 2 : dc);
            const float sc = d * 0.08838834764831845f + rpb[(h * (2 * WR - 1) + dr) * (2 * WC - 1) + dc];
            const float mn = fmaxf(mx, sc), corr = __expf(mx - mn), pw = __expf(sc - mn);
            const float v0 = bf2f(VT[(size_t)(h * HD + lane) * MT + km]), v1 = bf2f(VT[(size_t)(h * HD + lane + 64) * MT + km]);
            l = l * corr + pw; a0 = a0 * corr + pw * v0; a1 = a1 * corr + pw * v1; mx = mn;
        }
        a0 /= l; a1 /= l;
        const float rr = rsqrtf(wave_sum(a0 * a0 + a1 * a1) * (1.f / HD) + EPS);
        bf16* o = MIXED + (size_t)m * DM + h * HD;
        o[lane] = (bf16)f2bf(a0 * rr * og[h * HD + lane]); o[lane + 64] = (bf16)f2bf(a1 * rr * og[h * HD + lane + 64]);
    }
}


typedef short bf16x8 __attribute__((ext_vector_type(8)));
typedef float f32x16 __attribute__((ext_vector_type(16)));
__device__ __forceinline__ void phase_filters(Frame& F) {
    const float* HID2 = (const float*)(F.ws + WS_HID2); const bf16* W3T = (const bf16*)(F.ws + WS_W3T); const float* fbias = F.in[14]; bf16* TAPS = (bf16*)(F.ws + WS_TAPS);
    const int n = F.lane & 31, hh = F.lane >> 5;
    const float mind = -4.605170185988091f / 1.5f, maxd = -4.605170185988091f / 0.3f;
    for (int task = GW_ID(F); task < 128 * 16; task += GW_N(F)) {
        const int l0 = (task & 127) * 32, cg = task >> 7;
        bf16x8 hb[4];
#pragma unroll
        for (int ks = 0; ks < 4; ++ks) { const GAS f32x4* hp = (const GAS f32x4*)(HID2 + (size_t)(l0 + n) * FHID + 16 * ks + 8 * hh); const f32x4 h0 = hp[0], h1 = hp[1];
            v4u bw; bw.x = pk2(h0.x, h0.y); bw.y = pk2(h0.z, h0.w); bw.z = pk2(h1.x, h1.y); bw.w = pk2(h1.z, h1.w); hb[ks] = __builtin_bit_cast(bf16x8, bw); }
        const int l = l0 + n; const float t = (float)l / (float)(SEQ - 1);
#pragma unroll 2
        for (int ct = 0; ct < 8; ++ct) {
            const int col0 = (cg * 8 + ct) * 32;
            f32x16 acc;
#pragma unroll
            for (int i = 0; i < 16; ++i) acc[i] = 0.f;
#pragma unroll
            for (int ks = 0; ks < 4; ++ks) { const bf16x8 a = *(const GAS bf16x8*)(W3T + (size_t)(col0 + n) * FHID + 16 * ks + 8 * hh);
                acc = __builtin_amdgcn_mfma_f32_32x32x16_bf16(a, hb[ks], acc, 0, 0, 0); }
            const int dir = (col0 >> 10) & 1, o = col0 >> 11;
#pragma unroll
            for (int i = 0; i < 16; ++i) {
                const int c = (col0 & 1023) + (i & 3) + 8 * (i >> 2) + 4 * hh;
                const float delta = fabsf(mind + (maxd - mind) * ((float)c / 1023.0f));
                float v = acc[i] * __expf(-t * delta);
                bf16* tp = TAPS + ((size_t)c * 2 + o) * 8192;
                if (dir == 0) { if (l == 0) v += fbias[o * 1024 + c]; tp[4096 + l] = (bf16)f2bf(v); }
                else { if (l > 0) tp[4096 - l] = (bf16)f2bf(v); else tp[0] = 0; }
            }
        }
    }
}

constexpr int HY_TAPS_BYTES = 4 * 16384, HY_ZB_ENT = 6080, HY_ZB_BYTES = HY_ZB_ENT * 2;
__device__ __forceinline__ unsigned hy_zb_off(int idx0  ) { const int q = idx0 >> 3; return (unsigned)((q ^ ((q >> 4) & 3)) << 4); }
template <int MASK>
__device__ __forceinline__ void hy_loadB(bf16x8 (&bf)[4], const LAS unsigned char* zb0, int g, int b, int n, int hh) {
    const int q0 = 124 - 4 * n + 2 * g + hh;
    const LAS unsigned char* pm = zb0 + ((q0 ^ ((q0 >> 4) & 3)) << 4) - 6144 + b * HY_ZB_BYTES;
#pragma unroll
    for (int tau = 0; tau < 4; ++tau) if (MASK & (1 << tau)) bf[tau] = *(const LAS bf16x8*)(pm + 2048 * (3 - tau));
}
__device__ __forceinline__ void hy_loadA(unsigned (&d)[5], const LAS bf16* taps, int g, int n, int hh) {
    const volatile LAS unsigned* dp = (const volatile LAS unsigned*)taps + ((1 + 8 * hh + n) >> 1) + 8 * g;
#pragma unroll
    for (int i = 0; i < 5; ++i) d[i] = dp[i];
}
template <int MASK>
__device__ __forceinline__ void hy_mma(f32x16 (&acc)[4], const bf16x8 a, const bf16x8 (&bf)[4]) {
#pragma unroll
    for (int tau = 0; tau < 4; ++tau) if (MASK & (1 << tau)) acc[tau] = __builtin_amdgcn_mfma_f32_32x32x16_bf16(a, bf[tau], acc[tau], 0, 0, 0);
}
#define HY_ALIGN(a, d) do { v4u aw_; aw_.x = __builtin_amdgcn_alignbyte(d[1], d[0], sh); aw_.y = __builtin_amdgcn_alignbyte(d[2], d[1], sh); aw_.z = __builtin_amdgcn_alignbyte(d[3], d[2], sh); aw_.w = __builtin_amdgcn_alignbyte(d[4], d[3], sh); a = __builtin_bit_cast(bf16x8, aw_); } while (0)
#define HY_INTERLEAVE(nv, nds) do { __builtin_amdgcn_sched_group_barrier(0x2, nv, 0); _Pragma("unroll") for (int i_ = 0; i_ < 5; ++i_) { __builtin_amdgcn_sched_group_barrier(0x8, 1, 0); __builtin_amdgcn_sched_group_barrier(0x100, nds, 0); __builtin_amdgcn_sched_group_barrier(0x2, 2, 0); } } while (0)
constexpr int HY_YOFF = 254;
template <int MX, int MY>
__device__ __forceinline__ void hy_segment(f32x16 (&acc)[2][4], const LAS bf16* taps, const LAS unsigned char* zb0, int i0, int i1, int n, int hh) {
    const unsigned sh = (n & 1) ? 0u : 2u;
    unsigned dx[5], dy[5]; bf16x8 ax, ay, x0[4], y0[4], x1[4], y1[4];
    hy_loadA(dx, taps, i0, n, hh); hy_loadA(dy, taps, i0 + HY_YOFF, n, hh); hy_loadB<MX>(x0, zb0, i0, 0, n, hh); hy_loadB<MY>(y0, zb0, i0 + HY_YOFF, 0, n, hh);
#pragma unroll 1
    for (int i = i0; i < i1; ++i) {
        HY_ALIGN(ax, dx); HY_ALIGN(ay, dy);
        hy_loadB<MX>(x1, zb0, i, 1, n, hh); hy_loadB<MY>(y1, zb0, i + HY_YOFF, 1, n, hh);
        hy_mma<MX>(acc[0], ax, x0); hy_mma<MY>(acc[0], ay, y0);
        HY_INTERLEAVE(8, 1); __builtin_amdgcn_sched_barrier(0);
        hy_loadA(dx, taps, i + 1, n, hh); hy_loadA(dy, taps, i + 1 + HY_YOFF, n, hh);
        hy_loadB<MX>(x0, zb0, i + 1, 0, n, hh); hy_loadB<MY>(y0, zb0, i + 1 + HY_YOFF, 0, n, hh);
        hy_mma<MX>(acc[1], ax, x1); hy_mma<MY>(acc[1], ay, y1);
        HY_INTERLEAVE(0, 3); __builtin_amdgcn_sched_barrier(0);
    }
}
__device__ __forceinline__ void hy_stage_taps(Frame& F, int c0, int o) {
    const bf16* TAPS = (const bf16*)(F.ws + WS_TAPS);
    int tid = F.tid; asm volatile("" : "+v"(tid));
#pragma unroll
    for (int j = 0; j < 8; ++j) { const int ch = tid + NTHREADS * j, ci = ch >> 10, w = ch & 1023;
        *((LAS v4u*)(F.lds) + ch) = *((const GAS v4u*)(TAPS + ((size_t)(c0 + ci) * 2 + o) * 8192) + w); }
}
struct ConvItem { const float* W; bf16* WTe; int N, row_base, k0, n0; };
__device__ __forceinline__ void conv_load64(float (&v)[64], const ConvItem& c, int lane) {
    const GAS float* src = (const GAS float*)(c.W + (size_t)c.k0 * c.N + c.n0 + lane);
#pragma unroll
    for (int kk = 0; kk < 64; ++kk) v[kk] = src[(size_t)kk * c.N];
}
__device__ __forceinline__ void conv_store64(const float (&v)[64], const ConvItem& c, int lane) {
    GAS v4u* dst = (GAS v4u*)c.WTe + (size_t)(c.k0 >> 3) * 2048 + c.row_base + lane;
#pragma unroll
    for (int j = 0; j < 8; ++j) { v4u o; o.x = pk2(v[8 * j], v[8 * j + 1]); o.y = pk2(v[8 * j + 2], v[8 * j + 3]); o.z = pk2(v[8 * j + 4], v[8 * j + 5]); o.w = pk2(v[8 * j + 6], v[8 * j + 7]); dst[(size_t)j * 2048] = o; }
}
constexpr int MOE_ITEMS_GU = 2 * NE * 32 * 16, MOE_ITEMS_D = NE * 16 * 32, MOE_ITEMS = MOE_ITEMS_GU + MOE_ITEMS_D;
#ifndef MOE_P0_ITEMS
#define MOE_P0_ITEMS 0
#endif
constexpr int MOE_HELP_ITEMS = MOE_ITEMS - MOE_P0_ITEMS;
__device__ __forceinline__ ConvItem moe_item(Frame& F, int it) {
    bf16* WguT = (bf16*)(F.ws + WS_WGU); bf16* WdT = (bf16*)(F.ws + WS_WD); ConvItem c;
    if (it < MOE_ITEMS_GU) { const int which = it >> 13, e = (it >> 9) & 15, kb = (it >> 4) & 31, nb = it & 15, f0 = 64 * nb;
        c.W = (which ? F.in[21] : F.in[20]) + (size_t)e * DM * FF; c.N = FF; c.WTe = WguT + (size_t)e * 2048 * DM; c.row_base = (f0 >> 7) * 256 + which * 128 + (f0 & 127); c.k0 = 64 * kb; c.n0 = f0;
    } else { const int r = it - MOE_ITEMS_GU, e = r >> 9, kb = (r >> 5) & 15, nb = r & 31;
        c.W = F.in[22] + (size_t)e * FF * DM; c.N = DM; c.WTe = WdT + (size_t)e * 2048 * FF; c.row_base = 64 * nb; c.k0 = 64 * kb; c.n0 = 64 * nb; }
    return c;
}
__device__ __forceinline__ void moe_conv_item(Frame& F, int it) { float v[64]; const ConvItem c = moe_item(F, it); conv_load64(v, c, F.lane); conv_store64(v, c, F.lane); }
__device__ __forceinline__ void moe_conv_range(Frame& F, int lo, int hi, int step) {
    if (lo >= hi) return;
    float va[64], vb[64];
    ConvItem ca = moe_item(F, lo), cb_; conv_load64(va, ca, F.lane);
    for (int it = lo; it < hi; it += 2 * step) {
        const bool hb = it + step < hi;
        if (hb) { cb_ = moe_item(F, it + step); conv_load64(vb, cb_, F.lane); }
        conv_store64(va, ca, F.lane);
        const bool ha = it + 2 * step < hi;
        if (ha) { ca = moe_item(F, it + 2 * step); conv_load64(va, ca, F.lane); }
        if (hb) conv_store64(vb, cb_, F.lane);
    }
}
__device__ __forceinline__ void hy_write_gates(Frame& F, int c0, int oo) {
    const bf16* XH = (const bf16*)(F.ws + WS_XT) + (size_t)1024 * MT; bf16* GC = (bf16*)(F.ws + WS_UC);
    const float* cw = F.in[6]; const float* cb = F.in[7];
    const int ht = F.tid - 256;
#pragma unroll 2
    for (int k = 0; k < 16; ++k) { const int id = ht + 256 * k, u = id & 511, b = (id >> 9) & 1, ci = id >> 10;
        const int gch = oo * 1024 + c0 + ci; const bf16* gs = XH + (size_t)gch * MT + b * SEQ;
        const float w0 = cw[gch], w1 = cw[3072 + gch], w2 = cw[6144 + gch], bb = cb[gch];
        const v4u w = *((const GAS v4u*)gs + u);
        float f[10];
        f[1] = bflo(w.x); f[2] = bfhi(w.x); f[3] = bflo(w.y); f[4] = bfhi(w.y); f[5] = bflo(w.z); f[6] = bfhi(w.z); f[7] = bflo(w.w); f[8] = bfhi(w.w);
        f[0] = u > 0 ? bf2f(gs[8 * u - 1]) : 0.f; f[9] = u < 511 ? bf2f(gs[8 * u + 8]) : 0.f;
        float z[8];
#pragma unroll
        for (int e = 0; e < 8; ++e) z[e] = bb + w0 * f[e] + w1 * f[e + 1] + w2 * f[e + 2];
        v4u r; r.x = pk2(z[0], z[1]); r.y = pk2(z[2], z[3]); r.z = pk2(z[4], z[5]); r.w = pk2(z[6], z[7]);
        *((GAS v4u*)(GC + ((size_t)((c0 + ci) * 2 + oo) * 2 + b) * SEQ) + u) = r; }
}
__device__ __forceinline__ void phase_hyena(Frame& F) {
    const bf16* XH = (const bf16*)(F.ws + WS_XT) + (size_t)1024 * MT;
    const float* cw = F.in[6]; const float* cb = F.in[7];
    bf16* HYT = (bf16*)(F.ws + WS_HYT); bf16* GC = (bf16*)(F.ws + WS_UC);
    const int n = F.lane & 31, hh = F.lane >> 5;
    const bool compute = F.wave < 4;
    const int nhelp = F.G * 4, hw = F.bid * 4 + (F.wave - 4);
    int sec = 0;
    for (int cg = F.bid; cg < 256; cg += F.G) {
        const int c0 = cg * 4;
        __syncthreads();
        hy_stage_taps(F, c0, 0);
        {
          const int ci = F.wave >> 1, b = F.wave & 1; LAS unsigned char* zb = F.lds + HY_TAPS_BYTES + F.wave * HY_ZB_BYTES;
          const int zch = 2048 + c0 + ci; const bf16* zsrc = XH + (size_t)zch * MT + b * SEQ;
          const float w0 = cw[zch], w1 = cw[3072 + zch], w2 = cw[6144 + zch], bb = cb[zch];
#pragma unroll
          for (int j = 0; j < 8; ++j) { const int u = F.lane + 64 * j; const v4u w = *((const GAS v4u*)zsrc + u);
              float f[10];
              f[1] = bflo(w.x); f[2] = bfhi(w.x); f[3] = bflo(w.y); f[4] = bfhi(w.y); f[5] = bflo(w.z); f[6] = bfhi(w.z); f[7] = bflo(w.w); f[8] = bfhi(w.w);
              f[0] = u > 0 ? bf2f(zsrc[8 * u - 1]) : 0.f; f[9] = u < 511 ? bf2f(zsrc[8 * u + 8]) : 0.f;
              float z[8];
#pragma unroll
              for (int e = 0; e < 8; ++e) z[e] = bb + w0 * f[e] + w1 * f[e + 1] + w2 * f[e + 2];
              v4u r; r.x = pk2(z[7], z[6]); r.y = pk2(z[5], z[4]); r.z = pk2(z[3], z[2]); r.w = pk2(z[1], z[0]);
              *(LAS v4u*)(zb + hy_zb_off(8 * (635 - u))) = r; }
          const v4u zero = {0u, 0u, 0u, 0u};
          for (int q = F.lane; q < 124; q += 64) { *(LAS v4u*)(zb + hy_zb_off(8 * q)) = zero; *(LAS v4u*)(zb + hy_zb_off(8 * (636 + q))) = zero; } }
        if (!compute) hy_write_gates(F, c0, 0);
        __syncthreads();
#pragma unroll 1
        for (int o = 0; o < 2; ++o) {
            if (compute) {
                const int ci = F.wave, c = c0 + ci;
                const LAS bf16* taps = (const LAS bf16*)(F.lds + ci * 16384);
                LAS unsigned char* zb0 = F.lds + HY_TAPS_BYTES + (2 * ci) * HY_ZB_BYTES;
                f32x16 acc[2][4];
#pragma unroll
                for (int b = 0; b < 2; ++b)
#pragma unroll
                    for (int tau = 0; tau < 4; ++tau)
#pragma unroll
                        for (int i = 0; i < 16; ++i) acc[b][tau][i] = 0.f;
                hy_segment<1, 15>(acc, taps, zb0, 0, 64, n, hh);
                hy_segment<3, 14>(acc, taps, zb0, 64, 128, n, hh);
                hy_segment<7, 12>(acc, taps, zb0, 128, 192, n, hh);
                hy_segment<15, 8>(acc, taps, zb0, 192, 254, n, hh);
                hy_segment<0, 8>(acc, taps, zb0, 254, 256, n, hh);
                LDS_WAIT();
                int n2 = n, h2 = hh; asm volatile("" : "+v"(n2), "+v"(h2));
#pragma unroll
                for (int b = 0; b < 2; ++b) {
                    const bf16* gate = GC + ((size_t)(c * 2 + o) * 2 + b) * SEQ;
                    LAS unsigned char* zb = zb0 + b * HY_ZB_BYTES; bf16* outp = HYT + (size_t)c * MT + b * SEQ;
                    v2u gw[4][4];
#pragma unroll
                    for (int tau = 0; tau < 4; ++tau)
#pragma unroll
                        for (int rg = 0; rg < 4; ++rg) gw[tau][rg] = *(const GAS v2u*)(gate + 1024 * tau + 32 * n2 + 8 * rg + 4 * h2);
#pragma unroll
                    for (int tau = 0; tau < 4; ++tau) {
#pragma unroll
                        for (int rg = 0; rg < 4; ++rg) { const int t0 = 1024 * tau + 32 * n2 + 8 * rg + 4 * h2;
                            const float z0 = bflo(gw[tau][rg].x) * acc[b][tau][4 * rg + 0], z1 = bfhi(gw[tau][rg].x) * acc[b][tau][4 * rg + 1], z2 = bflo(gw[tau][rg].y) * acc[b][tau][4 * rg + 2], z3 = bfhi(gw[tau][rg].y) * acc[b][tau][4 * rg + 3];
                            if (o == 0) { v2u w; w.x = pk2(z3, z2); w.y = pk2(z1, z0);
                                *(LAS v2u*)(zb + hy_zb_off(8 * (635 - (t0 >> 3))) + (h2 ? 0 : 8)) = w; }
                            else { v2u w; w.x = pk2(z0, z1); w.y = pk2(z2, z3); *(GAS v2u*)(outp + t0) = w; } } }
                }
            } else {
                if (o == 0) hy_write_gates(F, c0, 1);
                const int lo_it = MOE_P0_ITEMS + sec * (MOE_HELP_ITEMS / 2), hi_it = lo_it + MOE_HELP_ITEMS / 2;
                if (sec < 2) moe_conv_range(F, lo_it + hw, hi_it, nhelp);
            }
            ++sec;
            if (o == 0) {
                __syncthreads();
                hy_stage_taps(F, c0, 1);
                __syncthreads();
            }
        }
    }
    for (; sec < 2; ++sec) if (!compute) { const int lo_it = MOE_P0_ITEMS + sec * (MOE_HELP_ITEMS / 2), hi_it = lo_it + MOE_HELP_ITEMS / 2; moe_conv_range(F, lo_it + hw, hi_it, nhelp); }
    __syncthreads();
}

__device__ __forceinline__ void phase_attn(Frame& F) {
    const bf16* QK = (const bf16*)(F.ws + WS_QK); const bf16* VT = (const bf16*)(F.ws + WS_XT); bf16* MIXED = (bf16*)(F.ws + WS_MIXED);
    const float* rpb = F.in[5]; const float* og = F.in[15];
    LAS float* rp = (LAS float*)(F.lds + F.wave * 2048);
    const int n = F.lane & 31, hh = F.lane >> 5;
    for (int task = GW_ID(F); task < NB * NH * NROWS * 2; task += GW_N(F)) {
        const int wq = task & 1, r = (task >> 1) & 63, h = (task >> 7) & 7, b = task >> 10;
        for (int i = F.lane; i < 15 * 31; i += 64) rp[i] = rpb[h * 465 + i];
        const int mq = b * SEQ + r * GW + 32 * wq + n, qc = 32 * wq + n;
        int c0 = qc - WC / 2; c0 = c0 < 0 ? 0 : (c0 > GW - WC ? GW - WC : c0);
        int kr0 = r - WR / 2; kr0 = kr0 < 0 ? 0 : (kr0 > NROWS - WR ? NROWS - WR : kr0);
        bf16x8 qf[8];
#pragma unroll
        for (int ks = 0; ks < 8; ++ks) qf[ks] = *(const GAS bf16x8*)(QK + (size_t)mq * 2048 + h * HD + 16 * ks + 8 * hh);
        f32x16 O[4];
#pragma unroll
        for (int dt = 0; dt < 4; ++dt)
#pragma unroll
            for (int i = 0; i < 16; ++i) O[dt][i] = 0.f;
        float lsum = 0.f;
        LDS_WAIT();
#pragma unroll 1
        for (int tile = 0; tile < 16; ++tile) {
            const int kr = kr0 + (tile >> 1), kt = tile & 1, dr = kr - r + WR - 1;
            const int mk0 = b * SEQ + kr * GW + 32 * kt;
            f32x16 S;
#pragma unroll
            for (int i = 0; i < 16; ++i) S[i] = 0.f;
#pragma unroll
            for (int ks = 0; ks < 8; ++ks) { const bf16x8 kf = *(const GAS bf16x8*)(QK + (size_t)(mk0 + n) * 2048 + 1024 + h * HD + 16 * ks + 8 * hh);
                S = __builtin_amdgcn_mfma_f32_32x32x16_bf16(kf, qf[ks], S, 0, 0, 0); }
            float p[16];
#pragma unroll
            for (int i = 0; i < 16; ++i) { const int kc = 32 * kt + (i & 3) + 8 * (i >> 2) + 4 * hh; const bool valid = (kc >= c0) && (kc < c0 + WC);
                int dc = kc - qc + WC - 1; dc = dc < 0 ? 0 : (dc > 2 * WC - 2 ? 2 * WC - 2 : dc);
                const float e = __expf(S[i] * 0.08838834764831845f + rp[dr * 31 + dc]); p[i] = valid ? e : 0.f; lsum += p[i]; }
            v4u pw0, pw1;
            pw0.x = pk2(p[0], p[1]); pw0.y = pk2(p[2], p[3]); pw0.z = pk2(p[4], p[5]); pw0.w = pk2(p[6], p[7]);
            pw1.x = pk2(p[8], p[9]); pw1.y = pk2(p[10], p[11]); pw1.z = pk2(p[12], p[13]); pw1.w = pk2(p[14], p[15]);
            const bf16x8 pf0 = __builtin_bit_cast(bf16x8, pw0), pf1 = __builtin_bit_cast(bf16x8, pw1);
#pragma unroll
            for (int dt = 0; dt < 4; ++dt) {
                const bf16* vrow = VT + (size_t)(h * HD + 32 * dt + n) * MT + mk0 + 4 * hh;
                const v2u a0 = *(const GAS v2u*)(vrow), a1 = *(const GAS v2u*)(vrow + 8), a2 = *(const GAS v2u*)(vrow + 16), a3 = *(const GAS v2u*)(vrow + 24);
                v4u f0, f1; f0.x = a0.x; f0.y = a0.y; f0.z = a1.x; f0.w = a1.y; f1.x = a2.x; f1.y = a2.y; f1.z = a3.x; f1.w = a3.y;
                O[dt] = __builtin_amdgcn_mfma_f32_32x32x16_bf16(__builtin_bit_cast(bf16x8, f0), pf0, O[dt], 0, 0, 0);
                O[dt] = __builtin_amdgcn_mfma_f32_32x32x16_bf16(__builtin_bit_cast(bf16x8, f1), pf1, O[dt], 0, 0, 0);
            }
        }
        lsum += __shfl_xor(lsum, 32);
        const float il = 1.f / lsum;
        float ss = 0.f;
#pragma unroll
        for (int dt = 0; dt < 4; ++dt)
#pragma unroll
            for (int i = 0; i < 16; ++i) { O[dt][i] *= il; ss += O[dt][i] * O[dt][i]; }
        ss += __shfl_xor(ss, 32);
        const float rr = rsqrtf(ss * (1.f / HD) + EPS);
        bf16* orow = MIXED + (size_t)mq * DM + h * HD;
#pragma unroll
        for (int dt = 0; dt < 4; ++dt)
#pragma unroll
            for (int rg = 0; rg < 4; ++rg) { const int d = 32 * dt + 8 * rg + 4 * hh; const f32x4 gg = *(const GAS f32x4*)(og + h * HD + d);
                v2u w; w.x = pk2(O[dt][4 * rg + 0] * rr * gg.x, O[dt][4 * rg + 1] * rr * gg.y); w.y = pk2(O[dt][4 * rg + 2] * rr * gg.z, O[dt][4 * rg + 3] * rr * gg.w);
                *(GAS v2u*)(orow + d) = w; }
        LDS_WAIT();
    }
}


constexpr int AT_KBYTES = 16384, AT_VPITCH = 136, AT_VBYTES = 128 * AT_VPITCH, AT_STAGE = AT_KBYTES + AT_VBYTES, AT_RP_OFF = 2 * AT_STAGE;
__device__ __forceinline__ void phase_attn2(Frame& F) {
    const bf16* QK = (const bf16*)(F.ws + WS_QK); const bf16* VT = (const bf16*)(F.ws + WS_XT); bf16* MIXED = (bf16*)(F.ws + WS_MIXED);
    const float* rpb = F.in[5]; const float* og = F.in[15]; const float* qg = F.in[3]; const float* kg = F.in[4];
    LAS float* rp = (LAS float*)(F.lds + AT_RP_OFF + F.wave * 2048);
    LAS float* gtab = (LAS float*)(F.lds + AT_RP_OFF + 8 * 2048);
    if (F.tid < HD) gtab[F.tid] = qg[F.tid] * kg[F.tid];
    const int n = F.lane & 31, hh = F.lane >> 5;
    for (int unit = F.bid; unit < NB * NH * 16; unit += F.G) {
        const int rq = unit & 15, h = (unit >> 4) & 7, b = unit >> 7, r0 = 4 * rq;
        const int r = r0 + (F.wave >> 1), wq = F.wave & 1;
        int kmin = r0 - WR / 2; kmin = kmin < 0 ? 0 : (kmin > NROWS - WR ? NROWS - WR : kmin);
        int kmax = r0 + 3 - WR / 2; kmax = (kmax < 0 ? 0 : (kmax > NROWS - WR ? NROWS - WR : kmax)) + WR - 1;
        int kr0 = r - WR / 2; kr0 = kr0 < 0 ? 0 : (kr0 > NROWS - WR ? NROWS - WR : kr0);
        const int nrows = kmax - kmin + 1;
        __syncthreads();
        for (int i = F.lane; i < 15 * 31; i += 64) rp[i] = rpb[h * 465 + i];
        const int mq = b * SEQ + r * GW + 32 * wq + n, qc = 32 * wq + n;
        int c0 = qc - WC / 2; c0 = c0 < 0 ? 0 : (c0 > GW - WC ? GW - WC : c0);
        bf16x8 qf[8];
#pragma unroll
        for (int ks = 0; ks < 8; ++ks) qf[ks] = *(const GAS bf16x8*)(QK + (size_t)mq * 2048 + h * HD + 16 * ks + 8 * hh);
        float qscale;
        {
          f32x16 D;
#pragma unroll
          for (int i = 0; i < 16; ++i) D[i] = 0.f;
#pragma unroll
          for (int ks = 0; ks < 8; ++ks) D = __builtin_amdgcn_mfma_f32_32x32x16_bf16(qf[ks], qf[ks], D, 0, 0, 0);
          float dsel = 0.f; const int isel = (n & 3) + 4 * (n >> 3);
#pragma unroll
          for (int i = 0; i < 16; ++i) dsel = (i == isel) ? D[i] : dsel;
          const float other = __shfl_xor(dsel, 32);
          const float ssq = (((n >> 2) & 1) == hh) ? dsel : other;
          qscale = 0.08838834764831845f * rsqrtf(ssq * (1.f / HD) + EPS); }
        f32x16 O[4];
#pragma unroll
        for (int dt = 0; dt < 4; ++dt)
#pragma unroll
            for (int i = 0; i < 16; ++i) O[dt][i] = 0.f;
        float lsum = 0.f;
        v4u sk[2], sv[2];

        auto gload = [&](int kr) {
#pragma unroll
            for (int j = 0; j < 2; ++j) { const int id = F.tid + 512 * j;
                sk[j] = *(const GAS v4u*)(QK + (size_t)(b * SEQ + kr * GW + (id >> 4)) * 2048 + 1024 + h * HD + 8 * (id & 15));
                sv[j] = *(const GAS v4u*)(VT + (size_t)(h * HD + (id >> 3)) * MT + b * SEQ + kr * GW + 8 * (id & 7)); }
        };
        auto lstore = [&](int buf) {
            LAS unsigned char* kb = F.lds + buf * AT_STAGE; LAS unsigned char* vb = kb + AT_KBYTES;
#pragma unroll
            for (int j = 0; j < 2; ++j) { const int id = F.tid + 512 * j; const int key = id >> 4, c = id & 15;
                float f[8] = {bflo(sk[j].x), bfhi(sk[j].x), bflo(sk[j].y), bfhi(sk[j].y), bflo(sk[j].z), bfhi(sk[j].z), bflo(sk[j].w), bfhi(sk[j].w)};
                float ss = 0.f;
#pragma unroll
                for (int e = 0; e < 8; ++e) ss += f[e] * f[e];
                ss += __shfl_xor(ss, 1); ss += __shfl_xor(ss, 2); ss += __shfl_xor(ss, 4); ss += __shfl_xor(ss, 8);
                const float rk = rsqrtf(ss * (1.f / HD) + EPS);
                const f32x4 ga = *(const LAS f32x4*)(gtab + 8 * c), gb = *(const LAS f32x4*)(gtab + 8 * c + 4);
                v4u kn; kn.x = pk2(f[0] * rk * ga.x, f[1] * rk * ga.y); kn.y = pk2(f[2] * rk * ga.z, f[3] * rk * ga.w); kn.z = pk2(f[4] * rk * gb.x, f[5] * rk * gb.y); kn.w = pk2(f[6] * rk * gb.z, f[7] * rk * gb.w);
                *(LAS v4u*)(kb + key * 256 + ((c ^ (key & 15)) << 4)) = kn;
                const int d = id >> 3, cv = id & 7; LAS v2u* vp = (LAS v2u*)(vb + d * AT_VPITCH + cv * 16);
                v2u lo, hi; lo.x = sv[j].x; lo.y = sv[j].y; hi.x = sv[j].z; hi.y = sv[j].w; vp[0] = lo; vp[1] = hi; }
        };
        gload(kmin); lstore(0);
        __syncthreads();
#pragma unroll 1
        for (int j = 0; j < nrows; ++j) {
            const int kr = kmin + j, buf = j & 1;
            if (j + 1 < nrows) gload(kr + 1);
            if (kr >= kr0 && kr < kr0 + WR) {
                const LAS unsigned char* kb = F.lds + buf * AT_STAGE; const LAS unsigned char* vb = kb + AT_KBYTES;
                const int dr = kr - r + WR - 1;
                int c0v = c0, qcv = qc; asm volatile("" : "+v"(c0v), "+v"(qcv));
#pragma unroll
                for (int kt = 0; kt < 2; ++kt) {
                    f32x16 S;
#pragma unroll
                    for (int i = 0; i < 16; ++i) S[i] = 0.f;
                    const int key = 32 * kt + n;
#pragma unroll
                    for (int ks = 0; ks < 8; ++ks) { const bf16x8 kf = *(const LAS bf16x8*)(kb + key * 256 + (((2 * ks + hh) ^ (key & 15)) << 4));
                        S = __builtin_amdgcn_mfma_f32_32x32x16_bf16(kf, qf[ks], S, 0, 0, 0); }
                    float p[16];
#pragma unroll
                    for (int i = 0; i < 16; ++i) { const int kc = 32 * kt + (i & 3) + 8 * (i >> 2) + 4 * hh; const bool valid = (kc >= c0v) && (kc < c0v + WC);
                        int dc = kc - qcv + WC - 1; dc = dc < 0 ? 0 : (dc > 2 * WC - 2 ? 2 * WC - 2 : dc);
                        const float e = __expf(S[i] * qscale + rp[dr * 31 + dc]); p[i] = valid ? e : 0.f; lsum += p[i]; }
                    v4u pw0, pw1;
                    pw0.x = pk2(p[0], p[1]); pw0.y = pk2(p[2], p[3]); pw0.z = pk2(p[4], p[5]); pw0.w = pk2(p[6], p[7]);
                    pw1.x = pk2(p[8], p[9]); pw1.y = pk2(p[10], p[11]); pw1.z = pk2(p[12], p[13]); pw1.w = pk2(p[14], p[15]);
                    const bf16x8 pf0 = __builtin_bit_cast(bf16x8, pw0), pf1 = __builtin_bit_cast(bf16x8, pw1);
#pragma unroll
                    for (int dt = 0; dt < 4; ++dt) {
                        const LAS unsigned char* vrow = vb + (32 * dt + n) * AT_VPITCH + (32 * kt + 4 * hh) * 2;
                        const v2u a0 = *(const LAS v2u*)(vrow), a1 = *(const LAS v2u*)(vrow + 16), a2 = *(const LAS v2u*)(vrow + 32), a3 = *(const LAS v2u*)(vrow + 48);
                        v4u f0, f1; f0.x = a0.x; f0.y = a0.y; f0.z = a1.x; f0.w = a1.y; f1.x = a2.x; f1.y = a2.y; f1.z = a3.x; f1.w = a3.y;
                        O[dt] = __builtin_amdgcn_mfma_f32_32x32x16_bf16(__builtin_bit_cast(bf16x8, f0), pf0, O[dt], 0, 0, 0);
                        O[dt] = __builtin_amdgcn_mfma_f32_32x32x16_bf16(__builtin_bit_cast(bf16x8, f1), pf1, O[dt], 0, 0, 0);
                    }
                }
            }
            if (j + 1 < nrows) lstore(buf ^ 1);
            __syncthreads();
        }
        lsum += __shfl_xor(lsum, 32);
        const float il = 1.f / lsum;
        float ss = 0.f;
#pragma unroll
        for (int dt = 0; dt < 4; ++dt)
#pragma unroll
            for (int i = 0; i < 16; ++i) { O[dt][i] *= il; ss += O[dt][i] * O[dt][i]; }
        ss += __shfl_xor(ss, 32);
        const float rr = rsqrtf(ss * (1.f / HD) + EPS);
        bf16* orow = MIXED + (size_t)mq * DM + h * HD;
#pragma unroll
        for (int dt = 0; dt < 4; ++dt)
#pragma unroll
            for (int rg = 0; rg < 4; ++rg) { const int d = 32 * dt + 8 * rg + 4 * hh; const f32x4 gg = *(const GAS f32x4*)(og + h * HD + d);
                v2u w; w.x = pk2(O[dt][4 * rg + 0] * rr * gg.x, O[dt][4 * rg + 1] * rr * gg.y); w.y = pk2(O[dt][4 * rg + 2] * rr * gg.z, O[dt][4 * rg + 3] * rr * gg.w);
                *(GAS v2u*)(orow + d) = w; }
    }
    __syncthreads();
}

__device__ __forceinline__ void phase_p15(Frame& F) {
    bf16* QK = (bf16*)(F.ws + WS_QK); const float* qg = F.in[3]; const float* kg = F.in[4];
    for (int m = GW_ID(F); m < MT; m += GW_N(F)) {
        GAS v4u* rowp = (GAS v4u*)(QK + (size_t)m * 2048) + F.lane;
#pragma unroll
        for (int j = 0; j < 4; ++j) {
            v4u w = rowp[64 * j];
            float f[8] = {bflo(w.x), bfhi(w.x), bflo(w.y), bfhi(w.y), bflo(w.z), bfhi(w.z), bflo(w.w), bfhi(w.w)};
            float ss = 0.f;
#pragma unroll
            for (int e = 0; e < 8; ++e) ss += f[e] * f[e];
            ss += __shfl_xor(ss, 1); ss += __shfl_xor(ss, 2); ss += __shfl_xor(ss, 4); ss += __shfl_xor(ss, 8);
            const float r = rsqrtf(ss * (1.f / HD) + EPS);
            const int col = 512 * j + 8 * F.lane, d = col & 127; const float* g = (col < 1024 ? qg : kg) + d;
#pragma unroll
            for (int e = 0; e < 8; ++e) f[e] = f[e] * r * g[e];
            w.x = pk2(f[0], f[1]); w.y = pk2(f[2], f[3]); w.z = pk2(f[4], f[5]); w.w = pk2(f[6], f[7]);
            rowp[64 * j] = w;
        }
    }
    const bf16* XT = (const bf16*)(F.ws + WS_XT) + (size_t)1024 * MT; bf16* UC = (bf16*)(F.ws + WS_UC);
    const float* cw = F.in[6]; const float* cb = F.in[7];
    const size_t nchunks = (size_t)3072 * MT / 8;
    for (size_t i = (size_t)F.bid * NTHREADS + F.tid; i < nchunks; i += (size_t)F.G * NTHREADS) {
        const int ch = (int)(i >> 10), m0 = (int)(i & 1023) * 8, s0 = m0 & 4095;
        const bf16* up = XT + (size_t)ch * MT + m0;
        const v4u w = *(const GAS v4u*)up;
        float f[10];
        f[1] = bflo(w.x); f[2] = bfhi(w.x); f[3] = bflo(w.y); f[4] = bfhi(w.y); f[5] = bflo(w.z); f[6] = bfhi(w.z); f[7] = bflo(w.w); f[8] = bfhi(w.w);
        f[0] = s0 > 0 ? bf2f(up[-1]) : 0.f; f[9] = s0 + 8 < SEQ ? bf2f(up[8]) : 0.f;
        const float w0 = cw[ch], w1 = cw[3072 + ch], w2 = cw[6144 + ch], bb = cb[ch];
        float o[8];
#pragma unroll
        for (int e = 0; e < 8; ++e) o[e] = bb + w0 * f[e] + w1 * f[e + 1] + w2 * f[e + 2];
        v4u ov; ov.x = pk2(o[0], o[1]); ov.y = pk2(o[2], o[3]); ov.z = pk2(o[4], o[5]); ov.w = pk2(o[6], o[7]);
        *(GAS v4u*)(UC + (size_t)ch * MT + m0) = ov;
    }
}
__device__ __forceinline__ void phase_p25(Frame& F) {
    const bf16* HYT = (const bf16*)(F.ws + WS_HYT); bf16* MIXED = (bf16*)(F.ws + WS_MIXED); const float* hg = F.in[16];
    LAS float* tile = (LAS float*)F.lds;
    LAS float* rs = (LAS float*)(F.lds + 128 * 65 * 4);
    for (int it = F.bid; it < 8 * (MT / 64); it += F.G) {
        const int gi = it & 7, m0 = (it >> 3) * 64;
        { const int ch = F.tid >> 2, t0 = (F.tid & 3) * 16; const bf16* p = HYT + (size_t)(gi * 128 + ch) * MT + m0 + t0;
          const v4u a = *(const GAS v4u*)p, b = *(const GAS v4u*)(p + 8);
          LAS float* d = tile + ch * 65 + t0;
          d[0] = bflo(a.x); d[1] = bfhi(a.x); d[2] = bflo(a.y); d[3] = bfhi(a.y); d[4] = bflo(a.z); d[5] = bfhi(a.z); d[6] = bflo(a.w); d[7] = bfhi(a.w);
          d[8] = bflo(b.x); d[9] = bfhi(b.x); d[10] = bflo(b.y); d[11] = bfhi(b.y); d[12] = bflo(b.z); d[13] = bfhi(b.z); d[14] = bflo(b.w); d[15] = bfhi(b.w); }
        __syncthreads();
        {
          const int t = F.tid >> 3, c0 = (F.tid & 7) * 16; float ss = 0.f;
#pragma unroll
          for (int c = 0; c < 16; ++c) { const float v = tile[(c0 + c) * 65 + t]; ss += v * v; }
          ss += __shfl_xor(ss, 1); ss += __shfl_xor(ss, 2); ss += __shfl_xor(ss, 4);
          if ((F.tid & 7) == 0) rs[t] = rsqrtf(ss * (1.f / 128) + EPS); }
        __syncthreads();
        {
          const int t = F.tid >> 3, c0 = (F.tid & 7) * 16; const float r = rs[t]; float o[16];
#pragma unroll
          for (int c = 0; c < 16; ++c) o[c] = tile[(c0 + c) * 65 + t] * r * hg[gi * 128 + c0 + c];
          v4u a, b; a.x = pk2(o[0], o[1]); a.y = pk2(o[2], o[3]); a.z = pk2(o[4], o[5]); a.w = pk2(o[6], o[7]); b.x = pk2(o[8], o[9]); b.y = pk2(o[10], o[11]); b.z = pk2(o[12], o[13]); b.w = pk2(o[14], o[15]);
          bf16* q = MIXED + (size_t)(m0 + t) * DM + AW + gi * 128 + c0; *(GAS v4u*)q = a; *(GAS v4u*)(q + 8) = b; }
        __syncthreads();
    }
}
__device__ __forceinline__ void phase_p35(Frame& F) {
    LAS float* wrT = (LAS float*)F.lds;
    const float* wr = F.in[19]; const float* g = F.in[18];
    for (int i = F.tid; i < DM * NE; i += NTHREADS) { const int d = i >> 4, e = i & 15; wrT[e * DM + d] = wr[i]; }
    __syncthreads();
    bf16* HB = (bf16*)(F.ws + WS_HB); float* AFF = (float*)(F.ws + WS_AFF); const float* x1 = F.out;
    f32x4 vn[8];
    { const int m0 = GW_ID(F); if (m0 < MT) { const GAS f32x4* xr = (const GAS f32x4*)(x1 + (size_t)m0 * DM) + F.lane;
#pragma unroll
        for (int j = 0; j < 8; ++j) vn[j] = xr[64 * j]; } }
    for (int m = GW_ID(F); m < MT; m += GW_N(F)) {
        f32x4 v[8]; float s = 0.f;
#pragma unroll
        for (int j = 0; j < 8; ++j) { v[j] = vn[j]; s += (v[j].x * v[j].x + v[j].y * v[j].y) + (v[j].z * v[j].z + v[j].w * v[j].w); }
        if (m + GW_N(F) < MT) { const GAS f32x4* xr = (const GAS f32x4*)(x1 + (size_t)(m + GW_N(F)) * DM) + F.lane;
#pragma unroll
            for (int j = 0; j < 8; ++j) vn[j] = xr[64 * j]; }
        const float r = rsqrtf(wave_sum(s) * (1.f / DM) + EPS);
        GAS v2u* o8 = (GAS v2u*)(HB + (size_t)m * DM) + F.lane;
#pragma unroll
        for (int j = 0; j < 8; ++j) { const f32x4 gg = *((const GAS f32x4*)g + F.lane + 64 * j); v[j].x *= r * gg.x; v[j].y *= r * gg.y; v[j].z *= r * gg.z; v[j].w *= r * gg.w;
            v2u o; o.x = pk2(v[j].x, v[j].y); o.y = pk2(v[j].z, v[j].w); o8[64 * j] = o; }
        float mine = 0.f;
#pragma unroll 1
        for (int e = 0; e < NE; ++e) { float a = 0.f;
#pragma unroll
            for (int j = 0; j < 8; ++j) { const f32x4 w = *((const LAS f32x4*)(wrT + e * DM) + F.lane + 64 * j); a += (v[j].x * w.x + v[j].y * w.y) + (v[j].z * w.z + v[j].w * w.w); }
            a = wave_sum(a); mine = (F.lane == e) ? a : mine; }
        float mx = mine;
        mx = fmaxf(mx, __shfl_xor(mx, 1)); mx = fmaxf(mx, __shfl_xor(mx, 2)); mx = fmaxf(mx, __shfl_xor(mx, 4)); mx = fmaxf(mx, __shfl_xor(mx, 8));
        const float ex = expf(mine - mx); float den = ex;
        den += __shfl_xor(den, 1); den += __shfl_xor(den, 2); den += __shfl_xor(den, 4); den += __shfl_xor(den, 8);
        const int b = m / SEQ, sidx = m % SEQ;
        if (F.lane < NE) AFF[((size_t)b * NE + F.lane) * SEQ + sidx] = ex / den;
    }
    __syncthreads();
}
__device__ __forceinline__ void phase_p4(Frame& F) {
    LAS unsigned* key = (LAS unsigned*)F.lds;
    LAS unsigned* hist = (LAS unsigned*)(F.lds + 16384);
    LAS unsigned* wsum = (LAS unsigned*)(F.lds + 16384 + 1024);
    const float* AFF = (const float*)(F.ws + WS_AFF); int* IDX = (int*)(F.ws + WS_IDX); float* GATE = (float*)(F.ws + WS_GATE); int* SEL = (int*)(F.ws + WS_SEL);
    for (int be = F.bid; be < NB * NE; be += F.G) {
        const int b = be / NE, e = be % NE;
        __syncthreads();
        const GAS v4u* ap = (const GAS v4u*)(AFF + (size_t)be * SEQ);
        const v4u k0 = ap[2 * F.tid], k1 = ap[2 * F.tid + 1];
        unsigned kk[8] = {k0.x, k0.y, k0.z, k0.w, k1.x, k1.y, k1.z, k1.w};
        unsigned prefix = 0u, mask = 0u, remaining = CAP;
#pragma unroll 1
        for (int pass = 0; pass < 4; ++pass) {
            const int shift = 24 - 8 * pass;
            if (F.tid < 256) hist[F.tid] = 0u;
            __syncthreads();
#pragma unroll
            for (int i = 0; i < 8; ++i) if ((kk[i] & mask) == prefix) __hip_atomic_fetch_add(&hist[(kk[i] >> shift) & 255u], 1u, __ATOMIC_RELAXED, __HIP_MEMORY_SCOPE_WORKGROUP);
            __syncthreads();
            unsigned incl_ = 0u, mine_ = 0u;
            if (F.tid < 256) {
                mine_ = hist[255 - F.tid]; incl_ = mine_;
#pragma unroll
                for (int o = 1; o < 64; o <<= 1) { const unsigned t = __shfl_up(incl_, o); if (F.lane >= o) incl_ += t; }
                if (F.lane == 63) wsum[10 + F.wave] = incl_;
            }
            __syncthreads();
            if (F.tid < 256) {
                unsigned base = 0u;
                for (int w = 0; w < F.wave; ++w) base += wsum[10 + w];
                const unsigned above = base + incl_ - mine_;
                if (above < remaining && remaining <= above + mine_) { wsum[8] = (unsigned)(255 - F.tid); wsum[9] = above; }
            }
            __syncthreads();
            const unsigned d = wsum[8], above = wsum[9];
            prefix |= d << shift; mask |= 255u << shift; remaining -= above;
            __syncthreads();
        }
        const unsigned thr = prefix;
        unsigned cnt = 0u;
#pragma unroll
        for (int i = 0; i < 8; ++i) cnt += (kk[i] > thr ? 0x10000u : 0u) + (kk[i] == thr ? 1u : 0u);
        unsigned incl = cnt;
#pragma unroll
        for (int o = 1; o < 64; o <<= 1) { const unsigned t = __shfl_up(incl, o); if (F.lane >= o) incl += t; }
        if (F.lane == 63) wsum[F.wave] = incl;
        __syncthreads();
        unsigned base = 0u;
        for (int w = 0; w < F.wave; ++w) base += wsum[w];
        unsigned run = base + incl - cnt;
#pragma unroll
        for (int i = 0; i < 8; ++i) {
            const unsigned gt_before = run >> 16, tie_before = run & 0xffffu;
            const bool isgt = kk[i] > thr, istie = kk[i] == thr;
            const bool sel = isgt || (istie && tie_before < remaining);
            const unsigned slot = gt_before + (tie_before < remaining ? tie_before : remaining);
            const int s = 8 * F.tid + i, m = b * SEQ + s;
            if (sel) { IDX[be * CAP + slot] = m; GATE[be * CAP + slot] = __builtin_bit_cast(float, kk[i]); }
            SEL[(size_t)m * NE + e] = sel ? (int)slot : -1;
            run += (isgt ? 0x10000u : 0u) + (istie ? 1u : 0u);
        }
    }
    __syncthreads();
}
__device__ __forceinline__ void phase_p7(Frame& F) {
    const int* SEL = (const int*)(F.ws + WS_SEL); const float* GATE = (const float*)(F.ws + WS_GATE); const bf16* YE = (const bf16*)(F.ws + WS_YE);
    for (int m = GW_ID(F); m < MT; m += GW_N(F)) {
        const int b = m / SEQ;
        GAS f32x4* orow = (GAS f32x4*)(F.out + (size_t)m * DM);
        f32x4 acc[8];
#pragma unroll
        for (int j = 0; j < 8; ++j) acc[j] = orow[2 * F.lane + (j & 1) + 128 * (j >> 1)];
        for (int e = 0; e < NE; ++e) { const int slot = SEL[(size_t)m * NE + e]; if (slot >= 0) {
            const GAS v4u* yr = (const GAS v4u*)(YE + (size_t)((b * NE + e) * CAP + slot) * DM) + F.lane;
#pragma unroll
            for (int jj = 0; jj < 4; ++jj) { const v4u w = yr[64 * jj];
                acc[2 * jj].x += bflo(w.x); acc[2 * jj].y += bfhi(w.x); acc[2 * jj].z += bflo(w.y); acc[2 * jj].w += bfhi(w.y);
                acc[2 * jj + 1].x += bflo(w.z); acc[2 * jj + 1].y += bfhi(w.z); acc[2 * jj + 1].z += bflo(w.w); acc[2 * jj + 1].w += bfhi(w.w); } } }
#pragma unroll
        for (int j = 0; j < 8; ++j) orow[2 * F.lane + (j & 1) + 128 * (j >> 1)] = acc[j];
    }
    (void)GATE;
}

struct Args { const float* in[23]; float* out; unsigned char* ws; int ph_lo, ph_hi; };
enum Phase { PH_P0 = 0, PH_G1, PH_ATTN, PH_P25, PH_OUT, PH_P35, PH_P4, PH_UP, PH_DOWN, PH_P7, PH_COUNT };

__global__ void __launch_bounds__(NTHREADS, 2) mk_fwd(Args args) {
    extern __shared__ __attribute__((aligned(16))) unsigned char lds_raw[];
    Frame F;
    F.lds = (LAS unsigned char*)lds_raw;
    F.tid = threadIdx.x; F.lane = F.tid & 63; F.wave = __builtin_amdgcn_readfirstlane(F.tid >> 6); F.G = gridDim.x; F.bid = blockIdx.x;
#pragma unroll
    for (int i = 0; i < 23; ++i) F.in[i] = args.in[i];
    F.out = args.out; F.ws = args.ws;
    const int lo = args.ph_lo, hi = args.ph_hi;
#define IN(k) (lo <= (k) && (k) < hi)
#define REPS(k) for (int rep_ = 0; rep_ < ((k) == REP_PHASE ? REP_N : 1); ++rep_)
#if MK_N_LAUNCHES == 1
    { volatile LAS unsigned* misc = (volatile LAS unsigned*)(F.lds + LDS_MISC_OFF); if (F.tid < 16) misc[F.tid] = 0u; }
    __syncthreads();
    XcdBarrier bar = xcd_barrier_post(g_bar_words, (volatile LAS unsigned*)(F.lds + LDS_MISC_OFF) + 8);
#define SEAM(k) do { if (IN(k) && IN((k) + 1)) xcd_barrier(bar); } while (0)
#else
#define SEAM(k) do { } while (0)
#endif
    if (IN(PH_P0)) REPS(PH_P0) { phase_p0(F); for (int it = GW_ID(F); it < MOE_P0_ITEMS; it += GW_N(F)) moe_conv_item(F, it); } SEAM(PH_P0);
    if (IN(PH_G1)) REPS(PH_G1) {
        phase_filters(F);
        __syncthreads();
        { pg8::DenseOrder S; S.init(F.ws + WS_HB, F.ws + WS_WIN, MT, 2048, DM, 0, F.G, F.bid);
          pg8::EpiBf16 E{(pg8::bf16_t*)(F.ws + WS_QK), 2048, 0, nullptr};
          pg8::gemm_phase<pg8::EpiBf16, pg8::DenseOrder, true>(F.lds, DM, S, E); }
        { pg8::DenseOrder S; S.init(F.ws + WS_HB, F.ws + WS_WIN, MT, 4096, DM, 8, F.G, F.bid);
          pg8::EpiTransBf16 E{(pg8::bf16_t*)(F.ws + WS_XT), MT, 8};
          pg8::gemm_phase<pg8::EpiTransBf16, pg8::DenseOrder, true>(F.lds, DM, S, E); }
    } SEAM(PH_G1);
    if (IN(PH_ATTN)) { __syncthreads(); for (int rep_ = 0; rep_ < ((PH_ATTN == REP_PHASE && REP_SUB != 2) ? REP_N : 1); ++rep_) phase_hyena(F); for (int rep_ = 0; rep_ < ((PH_ATTN == REP_PHASE && REP_SUB != 1) ? REP_N : 1); ++rep_) phase_attn2(F); } SEAM(PH_ATTN);
    if (IN(PH_P25)) REPS(PH_P25) { __syncthreads(); phase_p25(F); } SEAM(PH_P25);
    if (IN(PH_OUT)) REPS(PH_OUT) {
        __syncthreads();
        pg8::DenseOrder S; S.init(F.ws + WS_MIXED, F.ws + WS_WOUT, MT, DM, DM, 0, F.G, F.bid);
        pg8::EpiResF32 E{F.in[0], F.out, DM};
        pg8::gemm_phase<pg8::EpiResF32, pg8::DenseOrder, false>(F.lds, DM, S, E);
    } SEAM(PH_OUT);
    if (IN(PH_P35)) REPS(PH_P35) { __syncthreads(); phase_p35(F); } SEAM(PH_P35);
    if (IN(PH_P4)) REPS(PH_P4) { __syncthreads(); phase_p4(F); } SEAM(PH_P4);
    if (IN(PH_UP)) REPS(PH_UP) {
        __syncthreads();
        pg8::MoeOrder S; S.init(F.ws + WS_HB, F.ws + WS_WGU, DM, F.G, F.bid, true);
        LAS int* ridx = (LAS int*)(F.lds + 131072);
        { const int* IDX = (const int*)(F.ws + WS_IDX); pg8::Unit u;
          for (int i = 0; S.next(i, u); ++i) if (F.tid < 256) ridx[i * 256 + F.tid] = IDX[u.g * CAP + u.pm * 256 + F.tid]; }
        __syncthreads();
        pg8::EpiSwiGLU E{(pg8::bf16_t*)(F.ws + WS_ACT)};
        pg8::gemm_phase<pg8::EpiSwiGLU, pg8::MoeOrder, true, true>(F.lds, DM, S, E, ridx);
    } SEAM(PH_UP);
    if (IN(PH_DOWN)) REPS(PH_DOWN) {
        __syncthreads();
        pg8::MoeOrder S; S.init(F.ws + WS_ACT, F.ws + WS_WD, FF, F.G, F.bid, false);
        pg8::EpiBf16 E{(pg8::bf16_t*)(F.ws + WS_YE), DM, 512, (const float*)(F.ws + WS_GATE)};
        pg8::gemm_phase<pg8::EpiBf16, pg8::MoeOrder, true>(F.lds, FF, S, E);
    } SEAM(PH_DOWN);
    if (IN(PH_P7)) { phase_p7(F); }
#if MK_N_LAUNCHES == 1
    __syncthreads();
    { volatile LAS unsigned* misc = (volatile LAS unsigned*)(F.lds + LDS_MISC_OFF);
      if (F.tid == 0) misc[0] = (xb_add(&g_bar_words[XCD_BAR_WORDS], 1u) + 1u == (unsigned)F.G) ? 1u : 0u;
      __syncthreads();
      if (misc[0] != 0u && F.tid < (XCD_BAR_WORDS + 64) / 64) __hip_atomic_store(&g_bar_words[64 * F.tid], 0u, __ATOMIC_RELAXED, __HIP_MEMORY_SCOPE_AGENT); }
#endif
#undef IN
#undef SEAM
}

extern "C" void kernel_launch(void* const* d_in, const int* in_sizes, int n_in, void* d_out, int out_size, void* d_ws, size_t ws_size, hipStream_t stream) {
    static int grid = 0;
    if (grid == 0) {
        if (n_in != 23 || ws_size < WS_END) { fprintf(stderr, "kernel_launch: unexpected inputs (n_in %d, ws %zu)\n", n_in, ws_size); grid = -1; return; }
        if (hipFuncSetAttribute((const void*)mk_fwd, hipFuncAttributeMaxDynamicSharedMemorySize, LDS_BYTES) != hipSuccess) { fprintf(stderr, "kernel_launch: hipFuncSetAttribute failed\n"); grid = -1; return; }
        int dev = 0, cus = 0, per_cu = 0;
        hipGetDevice(&dev); hipDeviceGetAttribute(&cus, hipDeviceAttributeMultiprocessorCount, dev);
        hipOccupancyMaxActiveBlocksPerMultiprocessor(&per_cu, (const void*)mk_fwd, NTHREADS, LDS_BYTES);
        (void)hipGetLastError();
        if (per_cu < 1) { fprintf(stderr, "kernel_launch: occupancy query says %d blocks/CU\n", per_cu); }
        grid = cus;
    }
    if (grid < 0) return;
    Args a{};
    for (int i = 0; i < 23; ++i) a.in[i] = (const float*)d_in[i];
    a.out = (float*)d_out; a.ws = (unsigned char*)d_ws;
#if MK_N_LAUNCHES == 1
    a.ph_lo = 0; a.ph_hi = PH_COUNT;
    hipLaunchKernelGGL(mk_fwd, dim3(grid), dim3(NTHREADS), LDS_BYTES, stream, a);
#else
    for (int p = 0; p < PH_COUNT; ++p) { a.ph_lo = p; a.ph_hi = p + 1; hipLaunchKernelGGL(mk_fwd, dim3(grid), dim3(NTHREADS), LDS_BYTES, stream, a); }
#endif
}
```

```cpp
#include <hip/hip_runtime.h>
#include <hip/hip_cooperative_groups.h>
#include <cstdio>
#include <cstdint>
namespace cg = cooperative_groups;

#ifndef REP_PHASE
#define REP_PHASE -1
#define REP_N 1
#define REP_SUB 0
#endif
#ifndef MK_N_LAUNCHES
#define MK_N_LAUNCHES 1
#endif

namespace pg8 {
#define PG8_LAS __attribute__((address_space(3)))
typedef unsigned short bf16_t;
typedef short bf16x8 __attribute__((ext_vector_type(8)));
typedef float f32x4 __attribute__((ext_vector_type(4)));
typedef unsigned u32x4 __attribute__((ext_vector_type(4)));
typedef unsigned u32x2 __attribute__((ext_vector_type(2)));
constexpr int BM = 256, BK = 64, HALF = 128, HTB = HALF * BK * 2, STAGE_BYTES = 8 * HTB, NXCD = 8, WGM = 8;

__host__ __device__ __forceinline__ int lds_byte(int r, int c) { const int st = (r >> 4) * 2 + (c >> 5), rr = r & 15, cc = c & 31, ob = rr * 64 + cc * 2; return st * 1024 + (ob ^ (((ob >> 9) & 1) << 5)); }
__host__ __device__ __forceinline__ void stage_rc(int b, int& R, int& C) { const int st = b / 1024, sb = b % 1024, swz = sb ^ (((sb >> 9) & 1) << 5); R = (st >> 1) * 16 + swz / 64; C = (st & 1) * 32 + (swz % 64) / 2; }
__host__ __device__ __forceinline__ int perm32(int rho) { const int n = rho >> 4, i = rho & 15; return 8 * (i >> 2) + 4 * n + (i & 3); }

struct Unit { int pm, pn, g; const char* a; const char* b; };

__device__ __forceinline__ unsigned cvt_pk_bf16(float lo, float hi) { unsigned r; asm volatile("v_cvt_pk_bf16_f32 %0, %1, %2" : "=v"(r) : "v"(lo), "v"(hi)); return r; }

struct DenseOrder {
    static constexpr bool CHUNK_B = false;
    int nM, nN, nwg, G, c, K, pn0; const char* A; const char* Bt;
    __device__ void init(const void* A_, const void* Bt_, int M, int N, int K_, int pn0_, int G_, int c_) { A = (const char*)A_; Bt = (const char*)Bt_; nM = M / BM; nN = N / BM; nwg = nM * nN; G = G_; c = c_; K = K_; pn0 = pn0_; }
    __device__ bool next(int i, Unit& u) const {
        const long L = (long)i * G + c; if (L >= nwg) return false;
        int wgid = (int)L; { const int q = nwg / NXCD, r = nwg % NXCD, xcd = wgid % NXCD, off = wgid / NXCD; wgid = (xcd < r ? xcd * (q + 1) : r * (q + 1) + (xcd - r) * q) + off; }
        const int nig = WGM * nN, gid = wgid / nig, fm = gid * WGM, gsz = (nM - fm) < WGM ? (nM - fm) : WGM;
        u.pm = fm + ((wgid % nig) % gsz); u.pn = pn0 + (wgid % nig) / gsz; u.g = 0;
        u.a = A + (size_t)u.pm * BM * K * 2; u.b = Bt + (size_t)u.pn * BM * K * 2; return true;
    }
};
struct MoeOrder {
    static constexpr bool CHUNK_B = true;
    int G, c, K; bool gather; const char* A; const char* Bt;
    __device__ void init(const void* A_, const void* Bt_, int K_, int G_, int c_, bool gather_) { A = (const char*)A_; Bt = (const char*)Bt_; K = K_; G = G_; c = c_; gather = gather_; }
    __device__ bool next(int i, Unit& u) const {
        const int L = i * G + c; if (L >= 512) return false;
        const int pn = L & 7, pm = (L >> 3) & 1, b = (L >> 4) & 1, e = L >> 5;
        u.pm = pm; u.pn = pn; u.g = b * 16 + e;
        u.a = gather ? A : A + (size_t)(u.g * 512 + pm * BM) * K * 2; u.b = Bt + (size_t)e * 2048 * K * 2 + (size_t)pn * BM * 16; return true;
    }
};

struct EpiBf16 {
    static constexpr bool PERM = true, SWAP = false;
    bf16_t* O; int ldc; int grows; const float* rscale;
    __device__ __forceinline__ void operator()(const f32x4 (&acc)[2][2][4][2], const Unit& u, int wr, int wc, int fr, int fq) const {
        const int row0 = u.g * grows + u.pm * BM + wr * 64 + fr, col0 = u.pn * BM + wc * 32 + 8 * fq;
#pragma unroll
        for (int ai = 0; ai < 2; ++ai)
#pragma unroll
            for (int m = 0; m < 4; ++m) { const int row = row0 + ai * HALF + m * 16; bf16_t* rowp = O + (size_t)row * ldc + col0; const float sc = rscale ? rscale[row] : 1.f;
#pragma unroll
                for (int bj = 0; bj < 2; ++bj) { const f32x4 v0 = acc[ai][bj][m][0] * sc, v1 = acc[ai][bj][m][1] * sc;
                    u32x4 w; w.x = cvt_pk_bf16(v0[0], v0[1]); w.y = cvt_pk_bf16(v0[2], v0[3]); w.z = cvt_pk_bf16(v1[0], v1[1]); w.w = cvt_pk_bf16(v1[2], v1[3]);
                    *(u32x4*)(rowp + bj * HALF) = w; } }
    }
};
struct EpiSwiGLU {
    static constexpr bool PERM = true, SWAP = false;
    bf16_t* O;
    __device__ __forceinline__ void operator()(const f32x4 (&acc)[2][2][4][2], const Unit& u, int wr, int wc, int fr, int fq) const {
        const int row0 = u.g * 512 + u.pm * BM + wr * 64 + fr, col0 = u.pn * HALF + wc * 32 + 8 * fq;
#pragma unroll
        for (int ai = 0; ai < 2; ++ai)
#pragma unroll
            for (int m = 0; m < 4; ++m) { bf16_t* rowp = O + (size_t)(row0 + ai * HALF + m * 16) * 1024 + col0;
                float r[8];
#pragma unroll
                for (int n = 0; n < 2; ++n)
#pragma unroll
                    for (int e = 0; e < 4; ++e) { const float g = acc[ai][0][m][n][e], up = acc[ai][1][m][n][e]; r[n * 4 + e] = g / (1.f + __expf(-g)) * up; }
                u32x4 w; w.x = cvt_pk_bf16(r[0], r[1]); w.y = cvt_pk_bf16(r[2], r[3]); w.z = cvt_pk_bf16(r[4], r[5]); w.w = cvt_pk_bf16(r[6], r[7]);
                *(u32x4*)rowp = w; }
    }
};
struct EpiResF32 {
    static constexpr bool PERM = false, SWAP = false;
    const float* res; float* out; int ldc;
    __device__ __forceinline__ void operator()(const f32x4 (&acc)[2][2][4][2], const Unit& u, int wr, int wc, int fr, int fq) const {
        const int row0 = u.pm * BM + wr * 64 + fr, col0 = u.pn * BM + wc * 32 + 4 * fq;
#pragma unroll
        for (int ai = 0; ai < 2; ++ai)
#pragma unroll
            for (int m = 0; m < 4; ++m) { const size_t off = (size_t)(row0 + ai * HALF + m * 16) * ldc + col0;
#pragma unroll
                for (int bj = 0; bj < 2; ++bj)
#pragma unroll
                    for (int n = 0; n < 2; ++n) { const f32x4 r = *(const f32x4*)(res + off + bj * HALF + n * 16); *(f32x4*)(out + off + bj * HALF + n * 16) = r + acc[ai][bj][m][n]; } }
    }
};
struct EpiTransBf16 {
    static constexpr bool PERM = false, SWAP = true;
    bf16_t* O; int ldt; int pn_base;
    __device__ __forceinline__ void operator()(const f32x4 (&acc)[2][2][4][2], const Unit& u, int wr, int wc, int fr, int fq) const {
        const int ch0 = (u.pn - pn_base) * BM + wc * 32 + fr, t0 = u.pm * BM + wr * 64 + 4 * fq;
#pragma unroll
        for (int bj = 0; bj < 2; ++bj)
#pragma unroll
            for (int n = 0; n < 2; ++n) { bf16_t* chp = O + (size_t)(ch0 + bj * HALF + n * 16) * ldt + t0;
#pragma unroll
                for (int ai = 0; ai < 2; ++ai)
#pragma unroll
                    for (int m = 0; m < 4; ++m) { const f32x4 v = acc[ai][bj][m][n]; u32x2 w; w.x = cvt_pk_bf16(v[0], v[1]); w.y = cvt_pk_bf16(v[2], v[3]); *(u32x2*)(chp + ai * HALF + m * 16) = w; } }
    }
};

template <class Epi, class Sched, bool ALIGN_EPI = false, bool GATHER = false>
__device__ __forceinline__ void gemm_phase(PG8_LAS unsigned char* lds, const int K, const Sched& S, const Epi& E, const PG8_LAS int* ridx = nullptr) {
    const int tid = threadIdx.x, wid = __builtin_amdgcn_readfirstlane(tid >> 6), lane = tid & 63, wr = wid >> 2, wc = wid & 3, fr = lane & 15, fq = lane >> 4;
    const int nt = K / BK;
    unsigned vA0[2], vA1[2], vN0[2], vN1[2], voffB[2]; int stR[2], stC[2];
    const size_t kstep = (size_t)(BK * 2);
    const size_t hstep = (size_t)HALF * K * 2;
    const size_t kstepB = Sched::CHUNK_B ? (size_t)(BK / 8) * 2048 * 16 : kstep, hstepB = Sched::CHUNK_B ? (size_t)HALF * 16 : hstep;
#pragma unroll
    for (int i = 0; i < 2; ++i) { int R, C; stage_rc(tid * 16 + i * 8192, R, C); const int Rb = Epi::PERM ? ((R & ~31) + perm32(R & 31)) : R; stR[i] = R; stC[i] = C;
        voffB[i] = Sched::CHUNK_B ? (unsigned)(((C >> 3) * 2048 + Rb) * 16) : (unsigned)(Rb * K + C) * 2u;
        if constexpr (GATHER) { vA0[i] = (unsigned)(ridx[R] * K + C) * 2u; vA1[i] = (unsigned)(ridx[HALF + R] * K + C) * 2u; }
        else { vA0[i] = (unsigned)(R * K + C) * 2u; vA1[i] = vA0[i] + (unsigned)hstep; }
        vN0[i] = vA0[i]; vN1[i] = vA1[i]; }
    const unsigned ldsw = (unsigned)wid * 1024u;
    const int aoff = lds_byte(wr * 64 + fr, fq * 8), boff = lds_byte(wc * 32 + fr, fq * 8);
#define PG8_SA(b, h) (((b) * 2 + (h)) * HTB)
#define PG8_SB(b, h) ((4 + (b) * 2 + (h)) * HTB)
#define PG8_STAGE(bufoff, gbase, voff) do { _Pragma("unroll") for (int _i = 0; _i < 2; ++_i) \
        __builtin_amdgcn_global_load_lds((const unsigned*)((const char*)(gbase) + (voff)[_i]), (PG8_LAS unsigned*)(lds + (bufoff) + ldsw + _i * 8192), 16, 0, 0); } while (0)
#define PG8_LDA(dst, b, h) do { _Pragma("unroll") for (int m = 0; m < 4; ++m) _Pragma("unroll") for (int k = 0; k < 2; ++k) dst[m][k] = *(const PG8_LAS bf16x8*)(lds + PG8_SA(b, h) + aoff + m * 2048 + k * 1024); } while (0)
#define PG8_LDB(dst, b, h) do { _Pragma("unroll") for (int n = 0; n < 2; ++n) _Pragma("unroll") for (int k = 0; k < 2; ++k) dst[n][k] = *(const PG8_LAS bf16x8*)(lds + PG8_SB(b, h) + boff + n * 2048 + k * 1024); } while (0)
#define PG8_MMA(ai, bj, At, Bt) do { __builtin_amdgcn_s_setprio(1); _Pragma("unroll") for (int m = 0; m < 4; ++m) _Pragma("unroll") for (int n = 0; n < 2; ++n) _Pragma("unroll") for (int k = 0; k < 2; ++k) \
        acc[ai][bj][m][n] = Epi::SWAP ? __builtin_amdgcn_mfma_f32_16x16x32_bf16(At[m][k], Bt[n][k], acc[ai][bj][m][n], 0, 0, 0) : __builtin_amdgcn_mfma_f32_16x16x32_bf16(Bt[n][k], At[m][k], acc[ai][bj][m][n], 0, 0, 0); __builtin_amdgcn_s_setprio(0); } while (0)
#define PG8_WAIT_V(n) asm volatile("s_waitcnt vmcnt(" #n ")" ::: "memory")
#define PG8_WAIT_L(n) asm volatile("s_waitcnt lgkmcnt(" #n ")" ::: "memory")
#define PG8_BAR __builtin_amdgcn_s_barrier()
#define PG8_SCHED __builtin_amdgcn_sched_barrier(0)
    Unit cur, nxt; int ui = 0;
    if (!S.next(0, cur)) return;
    f32x4 acc[2][2][4][2];
#pragma unroll
    for (int a = 0; a < 2; ++a)
#pragma unroll
        for (int b = 0; b < 2; ++b)
#pragma unroll
            for (int m = 0; m < 4; ++m)
#pragma unroll
                for (int n = 0; n < 2; ++n) acc[a][b][m][n] = (f32x4){0.f, 0.f, 0.f, 0.f};
    bf16x8 At[4][2], B0[2][2], B1[2][2];
    const char* cA = cur.a; const char* cB = cur.b;
    PG8_STAGE(PG8_SB(0, 0), cB, voffB); PG8_STAGE(PG8_SB(0, 1), cB + hstepB, voffB); PG8_STAGE(PG8_SA(0, 0), cA, vA0); PG8_STAGE(PG8_SA(0, 1), cA, vA1);
    if (wr == 1) PG8_BAR;
    PG8_WAIT_V(2); PG8_BAR;
    PG8_STAGE(PG8_SB(1, 0), cB + kstepB, voffB); PG8_STAGE(PG8_SA(1, 0), cA + kstep, vA0); PG8_STAGE(PG8_SB(1, 1), cB + hstepB + kstepB, voffB);
    PG8_WAIT_V(6); PG8_BAR;
    for (;;) {
        const bool has_next = S.next(ui + 1, nxt);
        const char* nA = has_next ? nxt.a : cA; const char* nB = has_next ? nxt.b : cB;
        if constexpr (GATHER) { if (has_next) {
#pragma unroll
            for (int i = 0; i < 2; ++i) { vN0[i] = (unsigned)(ridx[(ui + 1) * 256 + stR[i]] * K + stC[i]) * 2u; vN1[i] = (unsigned)(ridx[(ui + 1) * 256 + HALF + stR[i]] * K + stC[i]) * 2u; } } }
        for (int t = 0; t < nt; t += 2) {
            const bool last = (t == nt - 2);
            const char* a1 = cA + (size_t)(t + 1) * kstep;
            const char* a2 = last ? nA : cA + (size_t)(t + 2) * kstep; const char* b2 = last ? nB : cB + (size_t)(t + 2) * kstepB;
            const char* a3 = a2 + kstep; const char* b3 = b2 + kstepB;
            unsigned w0[2], w1[2];
#pragma unroll
            for (int i = 0; i < 2; ++i) { w0[i] = last ? vN0[i] : vA0[i]; w1[i] = last ? vN1[i] : vA1[i]; }
            PG8_LDB(B0, 0, 0); PG8_LDB(B1, 0, 1); PG8_SCHED; PG8_LDA(At, 0, 0); PG8_STAGE(PG8_SA(1, 1), a1, vA1);
            PG8_WAIT_V(8); PG8_WAIT_L(0); PG8_BAR; PG8_MMA(0, 0, At, B0); PG8_MMA(0, 1, At, B1); PG8_BAR; PG8_SCHED;
            PG8_LDA(At, 0, 1); PG8_STAGE(PG8_SB(0, 0), b2, voffB); PG8_STAGE(PG8_SB(0, 1), b2 + hstepB, voffB); PG8_STAGE(PG8_SA(0, 0), a2, w0);
            PG8_WAIT_V(8); PG8_WAIT_L(0); PG8_BAR; PG8_MMA(1, 0, At, B0); PG8_MMA(1, 1, At, B1); PG8_BAR; PG8_SCHED;
            PG8_LDB(B0, 1, 0); PG8_LDB(B1, 1, 1); PG8_SCHED; PG8_LDA(At, 1, 0); PG8_STAGE(PG8_SA(0, 1), a2, w1);
            PG8_WAIT_V(8); PG8_WAIT_L(0); PG8_BAR; PG8_MMA(0, 0, At, B0); PG8_MMA(0, 1, At, B1); PG8_BAR; PG8_SCHED;
            PG8_LDA(At, 1, 1); PG8_STAGE(PG8_SB(1, 0), b3, voffB); PG8_STAGE(PG8_SB(1, 1), b3 + hstepB, voffB); PG8_STAGE(PG8_SA(1, 0), a3, w0);
            PG8_WAIT_V(8); PG8_WAIT_L(0); PG8_BAR; PG8_MMA(1, 0, At, B0); PG8_MMA(1, 1, At, B1); PG8_BAR; PG8_SCHED;
        }
        if constexpr (ALIGN_EPI) { if (wr == 0) PG8_BAR; }
        E(acc, cur, wr, wc, fr, fq);
        if (!has_next) break;
#pragma unroll
        for (int a = 0; a < 2; ++a)
#pragma unroll
            for (int b = 0; b < 2; ++b)
#pragma unroll
                for (int m = 0; m < 4; ++m)
#pragma unroll
                    for (int n = 0; n < 2; ++n) acc[a][b][m][n] = (f32x4){0.f, 0.f, 0.f, 0.f};
        cur = nxt; cA = nA; cB = nB; ++ui;
#pragma unroll
        for (int i = 0; i < 2; ++i) { vA0[i] = vN0[i]; vA1[i] = vN1[i]; }
        if constexpr (ALIGN_EPI) { if (wr == 1) PG8_BAR; }
    }
    PG8_WAIT_V(0);
    if constexpr (!ALIGN_EPI) { if (wr == 0) PG8_BAR; }
    PG8_BAR;
#undef PG8_SA
#undef PG8_SB
#undef PG8_STAGE
#undef PG8_LDA
#undef PG8_LDB
#undef PG8_MMA
#undef PG8_WAIT_V
#undef PG8_WAIT_L
#undef PG8_BAR
#undef PG8_SCHED
}
}

constexpr int NB = 2, SEQ = 4096, DM = 2048, MT = NB * SEQ;
constexpr int NH = 8, HD = 128, AW = 1024, HW = 1024, INW = 6144;
constexpr int GW = 64, NROWS = 64, WR = 8, WC = 16;
constexpr int NE = 16, CAP = 512, FF = 1024;
constexpr int FEMB = 33, FHID = 64;
constexpr float EPS = 1e-6f;
constexpr int NWAVES = 8, NTHREADS = 512;

constexpr size_t MiB = 1u << 20;
constexpr size_t WS_CTL = 0, CTL_ZERO_BYTES = 32768;
constexpr size_t WS_WIN = 2 * MiB;
constexpr size_t WS_WOUT = 26 * MiB;
constexpr size_t WS_WGU = 34 * MiB;
constexpr size_t WS_WD = 162 * MiB;
constexpr size_t WS_W3T = 226 * MiB;
constexpr size_t WS_HID2 = 227 * MiB;
constexpr size_t WS_HB = 228 * MiB;
constexpr size_t WS_QK = 260 * MiB;
constexpr size_t WS_XT = 292 * MiB;
constexpr size_t WS_UC = 356 * MiB;
constexpr size_t WS_TAPS = 404 * MiB;
constexpr size_t WS_HYT = 436 * MiB;
constexpr size_t WS_MIXED = 452 * MiB;
constexpr size_t WS_AFF = 484 * MiB;
constexpr size_t WS_IDX = 485 * MiB;
constexpr size_t WS_GATE = 486 * MiB;
constexpr size_t WS_SEL = 487 * MiB;
constexpr size_t WS_Z1T = 488 * MiB;
constexpr size_t WS_XG = WS_XT;
constexpr size_t WS_ACT = WS_UC;
constexpr size_t WS_YE = WS_TAPS;
constexpr size_t WS_END = 504 * MiB;

constexpr int LDS_BYTES = 163840, LDS_MISC_OFF = 163840 - 128;

#define GAS __attribute__((address_space(1)))
#define LAS __attribute__((address_space(3)))
typedef unsigned short bf16;
typedef unsigned v4u __attribute__((ext_vector_type(4)));
typedef unsigned v2u __attribute__((ext_vector_type(2)));
typedef float f32x4 __attribute__((ext_vector_type(4)));
#define LDS_WAIT() asm volatile("s_waitcnt lgkmcnt(0)" ::: "memory")
#define VM_WAIT() asm volatile("s_waitcnt vmcnt(0)" ::: "memory")
__device__ __forceinline__ unsigned f2bf(float f) { unsigned u = __builtin_bit_cast(unsigned, f); return (u + 0x7fffu + ((u >> 16) & 1u)) >> 16; }
__device__ __forceinline__ unsigned pk2(float lo, float hi) { unsigned r; asm("v_cvt_pk_bf16_f32 %0, %1, %2" : "=v"(r) : "v"(lo), "v"(hi)); return r; }
__device__ __forceinline__ float bf2f(unsigned h) { return __builtin_bit_cast(float, h << 16); }
__device__ __forceinline__ float bflo(unsigned w) { return __builtin_bit_cast(float, w << 16); }
__device__ __forceinline__ float bfhi(unsigned w) { return __builtin_bit_cast(float, w & 0xffff0000u); }
__device__ __forceinline__ float wave_sum(float v) {
#pragma unroll
    for (int o = 1; o < 64; o <<= 1) v += __shfl_xor(v, o);
    return v;
}


#define XB_TMO      128
#define XB_XCNT(j)  (256  + 64 * (j))
#define XB_XSUB(j)  (1280 + 64 * (j))
#define XB_XGEN(j)  (2304 + 64 * (j))
#define XB_TOP      3328
#define XB_TOPGEN   3392
#define XCD_BAR_WORDS 3456
#define XB_SPIN_CAP (1u << 22)
__device__ __forceinline__ unsigned xb_ld(unsigned* p)              { return __hip_atomic_load(p, __ATOMIC_RELAXED, __HIP_MEMORY_SCOPE_AGENT); }
__device__ __forceinline__ unsigned xb_add(unsigned* p, unsigned v) { return __hip_atomic_fetch_add(p, v, __ATOMIC_RELAXED, __HIP_MEMORY_SCOPE_AGENT); }
__device__ __forceinline__ unsigned xb_xcc_id() { return (unsigned)__builtin_amdgcn_s_getreg((3 << 11) | 20) & 0xFu; }
#define XB_SPIN(cond, bar) do { unsigned _sp = 0; while (cond) { __builtin_amdgcn_s_sleep(1); \
    if ((++_sp & 255u) == 0u) { if (xb_ld(&(bar)[XB_TMO])) break; if (_sp > XB_SPIN_CAP) { atomicAdd(&(bar)[XB_TMO], 1u); break; } } } } while (0)
struct XcdBarrier { unsigned* bar; unsigned x; volatile LAS unsigned* st; };
__device__ __forceinline__ XcdBarrier xcd_barrier_post(unsigned* bar, volatile LAS unsigned* st) {
    XcdBarrier b; b.bar = bar; b.x = xb_xcc_id(); b.st = st;
    if (threadIdx.x == 0) (void)xb_add(&bar[XB_XCNT(b.x)], 1u);
    return b;
}
__device__ __forceinline__ void xcd_barrier_complete(unsigned* bar, unsigned x, unsigned& nloc, unsigned& nx) {
    const unsigned G = gridDim.x * gridDim.y * gridDim.z;
    unsigned sum, cnt, mine, sp = 0u;
    for (;;) {
        sum = 0u; cnt = 0u; mine = 0u;
#pragma unroll
        for (unsigned j = 0; j < 16; ++j) { const unsigned c = xb_ld(&bar[XB_XCNT(j)]); sum += c; cnt += (c > 0u) ? 1u : 0u; mine = (j == x) ? c : mine; }
        if (sum == G) break;
        __builtin_amdgcn_s_sleep(1);
        if ((++sp & 255u) == 0u) { if (xb_ld(&bar[XB_TMO])) break; if (sp > XB_SPIN_CAP) { atomicAdd(&bar[XB_TMO], 1u); break; } }
    }
    nloc = mine > 0u ? mine : 1u; nx = cnt > 0u ? cnt : 1u;
}
__device__ __forceinline__ void xcd_barrier(const XcdBarrier& b) {
    asm volatile("s_waitcnt vmcnt(0)" ::: "memory");
    __syncthreads();
    if (threadIdx.x == 0) {
        unsigned* bar = b.bar;
        __builtin_amdgcn_s_waitcnt(0);
        unsigned nloc = b.st[0], nx = b.st[1];
        if (nloc == 0u) { xcd_barrier_complete(bar, b.x, nloc, nx); b.st[0] = nloc; b.st[1] = nx; }
        const unsigned old = xb_add(&bar[XB_XSUB(b.x)], 1u);
        const unsigned gen = old / nloc;
        if (old + 1u == (gen + 1u) * nloc) {
            __builtin_amdgcn_fence(__ATOMIC_RELEASE, "agent");
            asm volatile("s_waitcnt vmcnt(0)" ::: "memory");
            const unsigned og = xb_add(&bar[XB_TOP], 1u);
            const unsigned tg = og / nx;
            if (og + 1u == (tg + 1u) * nx) xb_add(&bar[XB_TOPGEN], 1u);
            else XB_SPIN(xb_ld(&bar[XB_TOPGEN]) == tg, bar);
            __builtin_amdgcn_fence(__ATOMIC_ACQUIRE, "agent");
            xb_add(&bar[XB_XGEN(b.x)], 1u);
            asm volatile("s_waitcnt vmcnt(0)" ::: "memory");
        } else {
            XB_SPIN(xb_ld(&bar[XB_XGEN(b.x)]) == gen, bar);
            __builtin_amdgcn_fence(__ATOMIC_ACQUIRE, "agent");
            asm volatile("s_waitcnt vmcnt(0)" ::: "memory");
        }
    }
    __syncthreads();
}

__device__ unsigned g_bar_words[XCD_BAR_WORDS + 64];
struct Frame {
    LAS unsigned char* lds;
    int tid, lane, wave, G, bid;
    const float* in[23]; float* out; unsigned char* ws;
};
#define GW_ID(F) ((F).bid * NWAVES + (F).wave)
#define GW_N(F) ((F).G * NWAVES)

__device__ __forceinline__ void p0_transpose_item(const float* W, int K, int N, bf16* WT, int row_base, int k0, int n0, LAS float* scr, int lane) {
#pragma unroll 8
    for (int i = 0; i < 32; ++i) { const int kk = 2 * i + (lane >> 5); scr[kk * 33 + (lane & 31)] = W[(size_t)(k0 + kk) * N + n0 + (lane & 31)]; }
    LDS_WAIT(); asm volatile("" ::: "memory");
    const int c = lane & 7;
#pragma unroll
    for (int j = 0; j < 4; ++j) { const int n = (lane >> 3) + 8 * j; const LAS float* s = scr + (8 * c) * 33 + n;
        v4u o; o.x = pk2(s[0 * 33], s[1 * 33]); o.y = pk2(s[2 * 33], s[3 * 33]); o.z = pk2(s[4 * 33], s[5 * 33]); o.w = pk2(s[6 * 33], s[7 * 33]);
        *(GAS v4u*)(WT + (size_t)(row_base + n) * K + k0 + 8 * c) = o; }
    LDS_WAIT(); asm volatile("" ::: "memory");
}
__device__ __forceinline__ void phase_p0(Frame& F) {
    LAS float* scr = (LAS float*)(F.lds + F.wave * 16384);
    const int gw = GW_ID(F), NGW = GW_N(F);
    bf16* WinT = (bf16*)(F.ws + WS_WIN); bf16* WoutT = (bf16*)(F.ws + WS_WOUT); bf16* W3T = (bf16*)(F.ws + WS_W3T);
    constexpr int I_IN = (DM / 64) * (INW / 32), I_OUT = (DM / 64) * (DM / 32), I_3 = 1 * (4096 / 32);
    constexpr int NITEMS = I_IN + I_OUT + I_3;
    for (int it = gw; it < NITEMS; it += NGW) {
        int r = it;
        if (r < I_IN) { const int nblk = INW / 32, kb = r / nblk, nb = r % nblk; p0_transpose_item(F.in[2], DM, INW, WinT, 32 * nb, 64 * kb, 32 * nb, scr, F.lane); continue; } r -= I_IN;
        if (r < I_OUT) { const int nblk = DM / 32, kb = r / nblk, nb = r % nblk; p0_transpose_item(F.in[17], DM, DM, WoutT, 32 * nb, 64 * kb, 32 * nb, scr, F.lane); continue; } r -= I_OUT;
        { const int nb = r; p0_transpose_item(F.in[12], FHID, 4096, W3T, 32 * nb, 0, 32 * nb, scr, F.lane); }
    }
    bf16* HB = (bf16*)(F.ws + WS_HB);
    const float* x = F.in[0]; const float* g = F.in[1];
    for (int m = gw; m < MT; m += NGW) {
        const GAS f32x4* xr = (const GAS f32x4*)(x + (size_t)m * DM) + F.lane;
        f32x4 v[8]; float s = 0.f;
#pragma unroll
        for (int j = 0; j < 8; ++j) { v[j] = xr[64 * j]; s += (v[j].x * v[j].x + v[j].y * v[j].y) + (v[j].z * v[j].z + v[j].w * v[j].w); }
        const float r = rsqrtf(wave_sum(s) * (1.f / DM) + EPS);
        GAS v2u* o8 = (GAS v2u*)(HB + (size_t)m * DM) + F.lane;
#pragma unroll
        for (int j = 0; j < 8; ++j) { const f32x4 gg = *((const GAS f32x4*)g + F.lane + 64 * j); v2u o; o.x = pk2(v[j].x * r * gg.x, v[j].y * r * gg.y); o.y = pk2(v[j].z * r * gg.z, v[j].w * r * gg.w); o8[64 * j] = o; }
    }
    float* HID2 = (float*)(F.ws + WS_HID2);
    LAS float* sc2 = (LAS float*)(F.lds + F.wave * 16384);
    const float* w1 = F.in[8]; const float* b1 = F.in[9]; const float* w2 = F.in[10]; const float* b2 = F.in[11]; const float* fr = F.in[13];
    for (int l = gw; l < SEQ; l += NGW) {
        const int j = F.lane;
        float zv = 0.f;
        if (j == 0) zv = (float)l / (float)(SEQ - 1);
        else if (j < FEMB) { const int k = (j - 1) & 15; const float f = 1e-4f + (float)k * ((15.0f - 1e-4f) / 15.0f); const float wv = 6.283185307179586f * (float)l / (float)SEQ; zv = (j <= 16) ? cosf(f * wv) : -sinf(f * wv); }
        sc2[j] = zv; LDS_WAIT(); asm volatile("" ::: "memory");
        float a = b1[j];
        for (int i = 0; i < FEMB; ++i) a += sc2[i] * w1[i * FHID + j];
        const float h1 = sinf(fr[j] * a);
        sc2[64 + j] = h1; LDS_WAIT(); asm volatile("" ::: "memory");
        float c = b2[j];
        for (int i = 0; i < FHID; ++i) c += sc2[64 + i] * w2[i * FHID + j];
        HID2[l * FHID + j] = sinf(fr[j] * c);
        LDS_WAIT(); asm volatile("" ::: "memory");
    }
}

__device__ __forceinline__ void phase_filters_naive(Frame& F) {
    const float* HID2 = (const float*)(F.ws + WS_HID2); const float* w3 = F.in[12]; const float* fbias = F.in[14]; bf16* TAPS = (bf16*)(F.ws + WS_TAPS);
    const size_t total = (size_t)SEQ * 4096;
    for (size_t i = (size_t)F.bid * NTHREADS + F.tid; i < total; i += (size_t)F.G * NTHREADS) {
        const int col = (int)(i & 4095), l = (int)(i >> 12);
        float a = 0.f;
        for (int k = 0; k < FHID; ++k) a += HID2[l * FHID + k] * w3[(size_t)k * 4096 + col];
        const int c = col & 1023, dir = (col >> 10) & 1, o = col >> 11;
        const float mind = -4.605170185988091f / 1.5f, maxd = -4.605170185988091f / 0.3f;
        const float delta = fabsf(mind + (maxd - mind) * ((float)c / 1023.0f));
        const float t = (float)l / (float)(SEQ - 1);
        float v = a * expf(-t * delta);
        bf16* tp = TAPS + ((size_t)c * 2 + o) * 8192;
        if (dir == 0) { if (l == 0) v += fbias[o * 1024 + c]; tp[4096 + l] = (bf16)f2bf(v); }
        else { if (l > 0) tp[4096 - l] = (bf16)f2bf(v); else tp[0] = 0; }
    }
}
__device__ __forceinline__ void phase_hyena_naive(Frame& F, int o) {
    const bf16* UC = (const bf16*)(F.ws + WS_UC); const bf16* TAPS = (const bf16*)(F.ws + WS_TAPS);
    bf16* Z1T = (bf16*)(F.ws + WS_Z1T); bf16* HYT = (bf16*)(F.ws + WS_HYT);
    const bf16* Zin = o == 0 ? UC + (size_t)2048 * MT : Z1T; const bf16* gate = UC + (size_t)(o * 1024) * MT; bf16* OUT = o == 0 ? Z1T : HYT;
    const size_t total = (size_t)1024 * MT;
    for (size_t i = (size_t)F.bid * NTHREADS + F.tid; i < total; i += (size_t)F.G * NTHREADS) {
        const int c = (int)(i >> 13), m = (int)(i & 8191), b = m >> 12, t = m & 4095;
        const bf16* z = Zin + (size_t)c * MT + b * SEQ; const bf16* tp = TAPS + ((size_t)c * 2 + o) * 8192 + 4096 + t;
        float acc = 0.f;
        for (int s = 0; s < SEQ; ++s) acc += bf2f(tp[-s]) * bf2f(z[s]);
        OUT[(size_t)c * MT + m] = (bf16)f2bf(bf2f(gate[(size_t)c * MT + m]) * acc);
    }
}
__device__ __forceinline__ void phase_attn_naive(Frame& F) {
    const bf16* QK = (const bf16*)(F.ws + WS_QK); const bf16* VT = (const bf16*)(F.ws + WS_XT); bf16* MIXED = (bf16*)(F.ws + WS_MIXED);
    const float* rpb = F.in[5]; const float* og = F.in[15];
    const int lane = F.lane;
    for (int w = GW_ID(F); w < MT * NH; w += GW_N(F)) {
        const int m = w >> 3, h = w & 7, b = m / SEQ, s = m % SEQ, r = s / GW, c = s % GW;
        int kr0 = r - WR / 2; kr0 = kr0 < 0 ? 0 : (kr0 > NROWS - WR ? NROWS - WR : kr0);
        int c0 = c - WC / 2; c0 = c0 < 0 ? 0 : (c0 > GW - WC ? GW - WC : c0);
        const bf16* q = QK + (size_t)m * 2048 + h * HD;
        const float q0 = bf2f(q[lane]), q1 = bf2f(q[lane + 64]);
        float mx = -INFINITY, l = 0.f, a0 = 0.f, a1 = 0.f;
        for (int i = 0; i < WR; ++i) for (int j = 0; j < WC; ++j) {
            const int kr = kr0 + i, kc = c0 + j; const size_t km = (size_t)b * SEQ + kr * GW + kc;
            const bf16* kp = QK + km * 2048 + 1024 + h * HD;
            const float d = wave_sum(q0 * bf2f(kp[lane]) + q1 * bf2f(kp[lane + 64]));
            const int dr = kr - r + WR - 1; int dc = kc - c + WC - 1; dc = dc < 0 ? 0 : (dc > 2 * WC - 2 ? 2 * WC - 2 : dc);
            const float sc = d * 0.08838834764831845f + rpb[(h * (2 * WR - 1) + dr) * (2 * WC - 1) + dc];
            const float mn = fmaxf(mx, sc), corr = __expf(mx - mn), pw = __expf(sc - mn);
            const float v0 = bf2f(VT[(size_t)(h * HD + lane) * MT + km]), v1 = bf2f(VT[(size_t)(h * HD + lane + 64) * MT + km]);
            l = l * corr + pw; a0 = a0 * corr + pw * v0; a1 = a1 * corr + pw * v1; mx = mn;
        }
        a0 /= l; a1 /= l;
        const float rr = rsqrtf(wave_sum(a0 * a0 + a1 * a1) * (1.f / HD) + EPS);
        bf16* o = MIXED + (size_t)m * DM + h * HD;
        o[lane] = (bf16)f2bf(a0 * rr * og[h * HD + lane]); o[lane + 64] = (bf16)f2bf(a1 * rr * og[h * HD + lane + 64]);
    }
}


typedef short bf16x8 __attribute__((ext_vector_type(8)));
typedef float f32x16 __attribute__((ext_vector_type(16)));
__device__ __forceinline__ void phase_filters(Frame& F) {
    const float* HID2 = (const float*)(F.ws + WS_HID2); const bf16* W3T = (const bf16*)(F.ws + WS_W3T); const float* fbias = F.in[14]; bf16* TAPS = (bf16*)(F.ws + WS_TAPS);
    const int n = F.lane & 31, hh = F.lane >> 5;
    const float mind = -4.605170185988091f / 1.5f, maxd = -4.605170185988091f / 0.3f;
    for (int task = GW_ID(F); task < 128 * 16; task += GW_N(F)) {
        const int l0 = (task & 127) * 32, cg = task >> 7;
        bf16x8 hb[4];
#pragma unroll
        for (int ks = 0; ks < 4; ++ks) { const GAS f32x4* hp = (const GAS f32x4*)(HID2 + (size_t)(l0 + n) * FHID + 16 * ks + 8 * hh); const f32x4 h0 = hp[0], h1 = hp[1];
            v4u bw; bw.x = pk2(h0.x, h0.y); bw.y = pk2(h0.z, h0.w); bw.z = pk2(h1.x, h1.y); bw.w = pk2(h1.z, h1.w); hb[ks] = __builtin_bit_cast(bf16x8, bw); }
        const int l = l0 + n; const float t = (float)l / (float)(SEQ - 1);
#pragma unroll 2
        for (int ct = 0; ct < 8; ++ct) {
            const int col0 = (cg * 8 + ct) * 32;
            f32x16 acc;
#pragma unroll
            for (int i = 0; i < 16; ++i) acc[i] = 0.f;
#pragma unroll
            for (int ks = 0; ks < 4; ++ks) { const bf16x8 a = *(const GAS bf16x8*)(W3T + (size_t)(col0 + n) * FHID + 16 * ks + 8 * hh);
                acc = __builtin_amdgcn_mfma_f32_32x32x16_bf16(a, hb[ks], acc, 0, 0, 0); }
            const int dir = (col0 >> 10) & 1, o = col0 >> 11;
#pragma unroll
            for (int i = 0; i < 16; ++i) {
                const int c = (col0 & 1023) + (i & 3) + 8 * (i >> 2) + 4 * hh;
                const float delta = fabsf(mind + (maxd - mind) * ((float)c / 1023.0f));
                float v = acc[i] * __expf(-t * delta);
                bf16* tp = TAPS + ((size_t)c * 2 + o) * 8192;
                if (dir == 0) { if (l == 0) v += fbias[o * 1024 + c]; tp[4096 + l] = (bf16)f2bf(v); }
                else { if (l > 0) tp[4096 - l] = (bf16)f2bf(v); else tp[0] = 0; }
            }
        }
    }
}

constexpr int HY_TAPS_BYTES = 4 * 16384, HY_ZB_ENT = 6080, HY_ZB_BYTES = HY_ZB_ENT * 2;
__device__ __forceinline__ unsigned hy_zb_off(int idx0  ) { const int q = idx0 >> 3; return (unsigned)((q ^ ((q >> 4) & 3)) << 4); }
__device__ __forceinline__ const LAS unsigned char* hy_pm(const LAS unsigned char* zb0, int g, int n, int hh) {
    const int q0 = 124 - 4 * n + 2 * g + hh;
    unsigned p = (unsigned)(size_t)zb0 + (unsigned)(((q0 ^ ((q0 >> 4) & 3)) << 4) - 6144);
    asm volatile("" : "+v"(p));
    return (const LAS unsigned char*)(size_t)p;
}
template <int MASK>
__device__ __forceinline__ void hy_loadB(bf16x8 (&bf)[4], const LAS unsigned char* pm, int b) {
#pragma unroll
    for (int tau = 0; tau < 4; ++tau) if (MASK & (1 << tau)) bf[tau] = *(const LAS bf16x8*)(pm + 2048 * (3 - tau) + b * HY_ZB_BYTES);
}
__device__ __forceinline__ void hy_loadA(unsigned (&d)[5], const LAS bf16* taps, int g, int n, int hh) {
    const volatile LAS unsigned* dp = (const volatile LAS unsigned*)taps + ((1 + 8 * hh + n) >> 1) + 8 * g;
#pragma unroll
    for (int i = 0; i < 5; ++i) d[i] = dp[i];
}
template <int MASK>
__device__ __forceinline__ void hy_mma(f32x16 (&acc)[4], const bf16x8 a, const bf16x8 (&bf)[4]) {
#pragma unroll
    for (int tau = 0; tau < 4; ++tau) if (MASK & (1 << tau)) acc[tau] = __builtin_amdgcn_mfma_f32_32x32x16_bf16(a, bf[tau], acc[tau], 0, 0, 0);
}
#define HY_ALIGN(a, d) do { v4u aw_; aw_.x = __builtin_amdgcn_alignbyte(d[1], d[0], sh); aw_.y = __builtin_amdgcn_alignbyte(d[2], d[1], sh); aw_.z = __builtin_amdgcn_alignbyte(d[3], d[2], sh); aw_.w = __builtin_amdgcn_alignbyte(d[4], d[3], sh); a = __builtin_bit_cast(bf16x8, aw_); } while (0)
#define HY_INTERLEAVE(nv, nds) do { __builtin_amdgcn_sched_group_barrier(0x2, nv, 0); _Pragma("unroll") for (int i_ = 0; i_ < 5; ++i_) { __builtin_amdgcn_sched_group_barrier(0x8, 1, 0); __builtin_amdgcn_sched_group_barrier(0x100, nds, 0); __builtin_amdgcn_sched_group_barrier(0x2, 2, 0); } } while (0)
constexpr int HY_YOFF = 254;
template <int MX, int MY>
__device__ __forceinline__ void hy_segment(f32x16 (&acc)[2][4], const LAS bf16* taps, const LAS unsigned char* zb0, int i0, int i1, int n, int hh) {
    const unsigned sh = (n & 1) ? 0u : 2u;
    unsigned dx[5], dy[5]; bf16x8 ax, ay, x0[4], y0[4], x1[4], y1[4];
    const LAS unsigned char* pmx = hy_pm(zb0, i0, n, hh); const LAS unsigned char* pmy = hy_pm(zb0, i0 + HY_YOFF, n, hh);
    hy_loadA(dx, taps, i0, n, hh); hy_loadA(dy, taps, i0 + HY_YOFF, n, hh); hy_loadB<MX>(x0, pmx, 0); hy_loadB<MY>(y0, pmy, 0);
#pragma unroll 1
    for (int i = i0; i < i1; ++i) {
        HY_ALIGN(ax, dx); HY_ALIGN(ay, dy);
        hy_loadB<MX>(x1, pmx, 1); hy_loadB<MY>(y1, pmy, 1);
        hy_mma<MX>(acc[0], ax, x0); hy_mma<MY>(acc[0], ay, y0);
        HY_INTERLEAVE(8, 1); __builtin_amdgcn_sched_barrier(0);
        hy_loadA(dx, taps, i + 1, n, hh); hy_loadA(dy, taps, i + 1 + HY_YOFF, n, hh);
        pmx = hy_pm(zb0, i + 1, n, hh); pmy = hy_pm(zb0, i + 1 + HY_YOFF, n, hh);
        hy_loadB<MX>(x0, pmx, 0); hy_loadB<MY>(y0, pmy, 0);
        hy_mma<MX>(acc[1], ax, x1); hy_mma<MY>(acc[1], ay, y1);
        HY_INTERLEAVE(0, 3); __builtin_amdgcn_sched_barrier(0);
    }
}
__device__ __forceinline__ void hy_stage_taps(Frame& F, int c0, int o) {
    const bf16* TAPS = (const bf16*)(F.ws + WS_TAPS);
    int tid = F.tid; asm volatile("" : "+v"(tid));
#pragma unroll
    for (int j = 0; j < 8; ++j) { const int ch = tid + NTHREADS * j, ci = ch >> 10, w = ch & 1023;
        *((LAS v4u*)(F.lds) + ch) = *((const GAS v4u*)(TAPS + ((size_t)(c0 + ci) * 2 + o) * 8192) + w); }
}
struct ConvItem { const float* W; bf16* WTe; int N, row_base, k0, n0; };
__device__ __forceinline__ void conv_load64(float (&v)[64], const ConvItem& c, int lane) {
    const GAS float* src = (const GAS float*)(c.W + (size_t)c.k0 * c.N + c.n0 + lane);
#pragma unroll
    for (int kk = 0; kk < 64; ++kk) v[kk] = src[(size_t)kk * c.N];
}
__device__ __forceinline__ void conv_store64(const float (&v)[64], const ConvItem& c, int lane) {
    GAS v4u* dst = (GAS v4u*)c.WTe + (size_t)(c.k0 >> 3) * 2048 + c.row_base + lane;
#pragma unroll
    for (int j = 0; j < 8; ++j) { v4u o; o.x = pk2(v[8 * j], v[8 * j + 1]); o.y = pk2(v[8 * j + 2], v[8 * j + 3]); o.z = pk2(v[8 * j + 4], v[8 * j + 5]); o.w = pk2(v[8 * j + 6], v[8 * j + 7]); dst[(size_t)j * 2048] = o; }
}
constexpr int MOE_ITEMS_GU = 2 * NE * 32 * 16, MOE_ITEMS_D = NE * 16 * 32, MOE_ITEMS = MOE_ITEMS_GU + MOE_ITEMS_D;
#ifndef MOE_P0_ITEMS
#define MOE_P0_ITEMS 0
#endif
constexpr int MOE_HELP_ITEMS = MOE_ITEMS - MOE_P0_ITEMS;
__device__ __forceinline__ ConvItem moe_item(Frame& F, int it) {
    bf16* WguT = (bf16*)(F.ws + WS_WGU); bf16* WdT = (bf16*)(F.ws + WS_WD); ConvItem c;
    if (it < MOE_ITEMS_GU) { const int which = it >> 13, e = (it >> 9) & 15, kb = (it >> 4) & 31, nb = it & 15, f0 = 64 * nb;
        c.W = (which ? F.in[21] : F.in[20]) + (size_t)e * DM * FF; c.N = FF; c.WTe = WguT + (size_t)e * 2048 * DM; c.row_base = (f0 >> 7) * 256 + which * 128 + (f0 & 127); c.k0 = 64 * kb; c.n0 = f0;
    } else { const int r = it - MOE_ITEMS_GU, e = r >> 9, kb = (r >> 5) & 15, nb = r & 31;
        c.W = F.in[22] + (size_t)e * FF * DM; c.N = DM; c.WTe = WdT + (size_t)e * 2048 * FF; c.row_base = 64 * nb; c.k0 = 64 * kb; c.n0 = 64 * nb; }
    return c;
}
__device__ __forceinline__ void moe_conv_item(Frame& F, int it) { float v[64]; const ConvItem c = moe_item(F, it); conv_load64(v, c, F.lane); conv_store64(v, c, F.lane); }
__device__ __forceinline__ void moe_conv_range(Frame& F, int lo, int hi, int step) {
    if (lo >= hi) return;
    float va[64], vb[64];
    ConvItem ca = moe_item(F, lo), cb_; conv_load64(va, ca, F.lane);
    for (int it = lo; it < hi; it += 2 * step) {
        const bool hb = it + step < hi;
        if (hb) { cb_ = moe_item(F, it + step); conv_load64(vb, cb_, F.lane); }
        conv_store64(va, ca, F.lane);
        const bool ha = it + 2 * step < hi;
        if (ha) { ca = moe_item(F, it + 2 * step); conv_load64(va, ca, F.lane); }
        if (hb) conv_store64(vb, cb_, F.lane);
    }
}
__device__ __forceinline__ void hy_write_gates(Frame& F, int c0, int oo) {
    const bf16* XH = (const bf16*)(F.ws + WS_XT) + (size_t)1024 * MT; bf16* GC = (bf16*)(F.ws + WS_UC);
    const float* cw = F.in[6]; const float* cb = F.in[7];
    const int ht = F.tid - 256;
#pragma unroll 2
    for (int k = 0; k < 16; ++k) { const int id = ht + 256 * k, u = id & 511, b = (id >> 9) & 1, ci = id >> 10;
        const int gch = oo * 1024 + c0 + ci; const bf16* gs = XH + (size_t)gch * MT + b * SEQ;
        const float w0 = cw[gch], w1 = cw[3072 + gch], w2 = cw[6144 + gch], bb = cb[gch];
        const v4u w = *((const GAS v4u*)gs + u);
        float f[10];
        f[1] = bflo(w.x); f[2] = bfhi(w.x); f[3] = bflo(w.y); f[4] = bfhi(w.y); f[5] = bflo(w.z); f[6] = bfhi(w.z); f[7] = bflo(w.w); f[8] = bfhi(w.w);
        f[0] = u > 0 ? bf2f(gs[8 * u - 1]) : 0.f; f[9] = u < 511 ? bf2f(gs[8 * u + 8]) : 0.f;
        float z[8];
#pragma unroll
        for (int e = 0; e < 8; ++e) z[e] = bb + w0 * f[e] + w1 * f[e + 1] + w2 * f[e + 2];
        v4u r; r.x = pk2(z[0], z[1]); r.y = pk2(z[2], z[3]); r.z = pk2(z[4], z[5]); r.w = pk2(z[6], z[7]);
        *((GAS v4u*)(GC + ((size_t)((c0 + ci) * 2 + oo) * 2 + b) * SEQ) + u) = r; }
}
__device__ __forceinline__ void phase_hyena(Frame& F) {
    const bf16* XH = (const bf16*)(F.ws + WS_XT) + (size_t)1024 * MT;
    const float* cw = F.in[6]; const float* cb = F.in[7];
    bf16* HYT = (bf16*)(F.ws + WS_HYT); bf16* GC = (bf16*)(F.ws + WS_UC);
    const int n = F.lane & 31, hh = F.lane >> 5;
    const bool compute = F.wave < 4;
    const int nhelp = F.G * 4, hw = F.bid * 4 + (F.wave - 4);
    int sec = 0;
    for (int cg = F.bid; cg < 256; cg += F.G) {
        const int c0 = cg * 4;
        __syncthreads();
        hy_stage_taps(F, c0, 0);
        {
          const int ci = F.wave >> 1, b = F.wave & 1; LAS unsigned char* zb = F.lds + HY_TAPS_BYTES + F.wave * HY_ZB_BYTES;
          const int zch = 2048 + c0 + ci; const bf16* zsrc = XH + (size_t)zch * MT + b * SEQ;
          const float w0 = cw[zch], w1 = cw[3072 + zch], w2 = cw[6144 + zch], bb = cb[zch];
#pragma unroll
          for (int j = 0; j < 8; ++j) { const int u = F.lane + 64 * j; const v4u w = *((const GAS v4u*)zsrc + u);
              float f[10];
              f[1] = bflo(w.x); f[2] = bfhi(w.x); f[3] = bflo(w.y); f[4] = bfhi(w.y); f[5] = bflo(w.z); f[6] = bfhi(w.z); f[7] = bflo(w.w); f[8] = bfhi(w.w);
              f[0] = u > 0 ? bf2f(zsrc[8 * u - 1]) : 0.f; f[9] = u < 511 ? bf2f(zsrc[8 * u + 8]) : 0.f;
              float z[8];
#pragma unroll
              for (int e = 0; e < 8; ++e) z[e] = bb + w0 * f[e] + w1 * f[e + 1] + w2 * f[e + 2];
              v4u r; r.x = pk2(z[7], z[6]); r.y = pk2(z[5], z[4]); r.z = pk2(z[3], z[2]); r.w = pk2(z[1], z[0]);
              *(LAS v4u*)(zb + hy_zb_off(8 * (635 - u))) = r; }
          const v4u zero = {0u, 0u, 0u, 0u};
          for (int q = F.lane; q < 124; q += 64) { *(LAS v4u*)(zb + hy_zb_off(8 * q)) = zero; *(LAS v4u*)(zb + hy_zb_off(8 * (636 + q))) = zero; } }
        if (!compute) hy_write_gates(F, c0, 0);
        __syncthreads();
#pragma unroll 1
        for (int o = 0; o < 2; ++o) {
            if (compute) {
                const int ci = F.wave, c = c0 + ci;
                const LAS bf16* taps = (const LAS bf16*)(F.lds + ci * 16384);
                LAS unsigned char* zb0 = F.lds + HY_TAPS_BYTES + (2 * ci) * HY_ZB_BYTES;
                f32x16 acc[2][4];
#pragma unroll
                for (int b = 0; b < 2; ++b)
#pragma unroll
                    for (int tau = 0; tau < 4; ++tau)
#pragma unroll
                        for (int i = 0; i < 16; ++i) acc[b][tau][i] = 0.f;
                hy_segment<1, 15>(acc, taps, zb0, 0, 64, n, hh);
                hy_segment<3, 14>(acc, taps, zb0, 64, 128, n, hh);
                hy_segment<7, 12>(acc, taps, zb0, 128, 192, n, hh);
                hy_segment<15, 8>(acc, taps, zb0, 192, 254, n, hh);
                hy_segment<0, 8>(acc, taps, zb0, 254, 256, n, hh);
                LDS_WAIT();
                int n2 = n, h2 = hh; asm volatile("" : "+v"(n2), "+v"(h2));
#pragma unroll
                for (int b = 0; b < 2; ++b) {
                    const bf16* gate = GC + ((size_t)(c * 2 + o) * 2 + b) * SEQ;
                    LAS unsigned char* zb = zb0 + b * HY_ZB_BYTES; bf16* outp = HYT + (size_t)c * MT + b * SEQ;
                    v2u gw[4][4];
#pragma unroll
                    for (int tau = 0; tau < 4; ++tau)
#pragma unroll
                        for (int rg = 0; rg < 4; ++rg) gw[tau][rg] = *(const GAS v2u*)(gate + 1024 * tau + 32 * n2 + 8 * rg + 4 * h2);
#pragma unroll
                    for (int tau = 0; tau < 4; ++tau) {
#pragma unroll
                        for (int rg = 0; rg < 4; ++rg) { const int t0 = 1024 * tau + 32 * n2 + 8 * rg + 4 * h2;
                            const float z0 = bflo(gw[tau][rg].x) * acc[b][tau][4 * rg + 0], z1 = bfhi(gw[tau][rg].x) * acc[b][tau][4 * rg + 1], z2 = bflo(gw[tau][rg].y) * acc[b][tau][4 * rg + 2], z3 = bfhi(gw[tau][rg].y) * acc[b][tau][4 * rg + 3];
                            if (o == 0) { v2u w; w.x = pk2(z3, z2); w.y = pk2(z1, z0);
                                *(LAS v2u*)(zb + hy_zb_off(8 * (635 - (t0 >> 3))) + (h2 ? 0 : 8)) = w; }
                            else { v2u w; w.x = pk2(z0, z1); w.y = pk2(z2, z3); *(GAS v2u*)(outp + t0) = w; } } }
                }
            } else {
                if (o == 0) hy_write_gates(F, c0, 1);
                const int lo_it = MOE_P0_ITEMS + sec * (MOE_HELP_ITEMS / 2), hi_it = lo_it + MOE_HELP_ITEMS / 2;
                if (sec < 2) moe_conv_range(F, lo_it + hw, hi_it, nhelp);
            }
            ++sec;
            if (o == 0) {
                __syncthreads();
                hy_stage_taps(F, c0, 1);
                __syncthreads();
            }
        }
    }
    for (; sec < 2; ++sec) if (!compute) { const int lo_it = MOE_P0_ITEMS + sec * (MOE_HELP_ITEMS / 2), hi_it = lo_it + MOE_HELP_ITEMS / 2; moe_conv_range(F, lo_it + hw, hi_it, nhelp); }
    __syncthreads();
}

__device__ __forceinline__ void phase_attn(Frame& F) {
    const bf16* QK = (const bf16*)(F.ws + WS_QK); const bf16* VT = (const bf16*)(F.ws + WS_XT); bf16* MIXED = (bf16*)(F.ws + WS_MIXED);
    const float* rpb = F.in[5]; const float* og = F.in[15];
    LAS float* rp = (LAS float*)(F.lds + F.wave * 2048);
    const int n = F.lane & 31, hh = F.lane >> 5;
    for (int task = GW_ID(F); task < NB * NH * NROWS * 2; task += GW_N(F)) {
        const int wq = task & 1, r = (task >> 1) & 63, h = (task >> 7) & 7, b = task >> 10;
        for (int i = F.lane; i < 15 * 31; i += 64) rp[i] = rpb[h * 465 + i];
        const int mq = b * SEQ + r * GW + 32 * wq + n, qc = 32 * wq + n;
        int c0 = qc - WC / 2; c0 = c0 < 0 ? 0 : (c0 > GW - WC ? GW - WC : c0);
        int kr0 = r - WR / 2; kr0 = kr0 < 0 ? 0 : (kr0 > NROWS - WR ? NROWS - WR : kr0);
        bf16x8 qf[8];
#pragma unroll
        for (int ks = 0; ks < 8; ++ks) qf[ks] = *(const GAS bf16x8*)(QK + (size_t)mq * 2048 + h * HD + 16 * ks + 8 * hh);
        f32x16 O[4];
#pragma unroll
        for (int dt = 0; dt < 4; ++dt)
#pragma unroll
            for (int i = 0; i < 16; ++i) O[dt][i] = 0.f;
        float lsum = 0.f;
        LDS_WAIT();
#pragma unroll 1
        for (int tile = 0; tile < 16; ++tile) {
            const int kr = kr0 + (tile >> 1), kt = tile & 1, dr = kr - r + WR - 1;
            const int mk0 = b * SEQ + kr * GW + 32 * kt;
            f32x16 S;
#pragma unroll
            for (int i = 0; i < 16; ++i) S[i] = 0.f;
#pragma unroll
            for (int ks = 0; ks < 8; ++ks) { const bf16x8 kf = *(const GAS bf16x8*)(QK + (size_t)(mk0 + n) * 2048 + 1024 + h * HD + 16 * ks + 8 * hh);
                S = __builtin_amdgcn_mfma_f32_32x32x16_bf16(kf, qf[ks], S, 0, 0, 0); }
            float p[16];
#pragma unroll
            for (int i = 0; i < 16; ++i) { const int kc = 32 * kt + (i & 3) + 8 * (i >> 2) + 4 * hh; const bool valid = (kc >= c0) && (kc < c0 + WC);
                int dc = kc - qc + WC - 1; dc = dc < 0 ? 0 : (dc > 2 * WC - 2 ? 2 * WC - 2 : dc);
                const float e = __expf(S[i] * 0.08838834764831845f + rp[dr * 31 + dc]); p[i] = valid ? e : 0.f; lsum += p[i]; }
            v4u pw0, pw1;
            pw0.x = pk2(p[0], p[1]); pw0.y = pk2(p[2], p[3]); pw0.z = pk2(p[4], p[5]); pw0.w = pk2(p[6], p[7]);
            pw1.x = pk2(p[8], p[9]); pw1.y = pk2(p[10], p[11]); pw1.z = pk2(p[12], p[13]); pw1.w = pk2(p[14], p[15]);
            const bf16x8 pf0 = __builtin_bit_cast(bf16x8, pw0), pf1 = __builtin_bit_cast(bf16x8, pw1);
#pragma unroll
            for (int dt = 0; dt < 4; ++dt) {
                const bf16* vrow = VT + (size_t)(h * HD + 32 * dt + n) * MT + mk0 + 4 * hh;
                const v2u a0 = *(const GAS v2u*)(vrow), a1 = *(const GAS v2u*)(vrow + 8), a2 = *(const GAS v2u*)(vrow + 16), a3 = *(const GAS v2u*)(vrow + 24);
                v4u f0, f1; f0.x = a0.x; f0.y = a0.y; f0.z = a1.x; f0.w = a1.y; f1.x = a2.x; f1.y = a2.y; f1.z = a3.x; f1.w = a3.y;
                O[dt] = __builtin_amdgcn_mfma_f32_32x32x16_bf16(__builtin_bit_cast(bf16x8, f0), pf0, O[dt], 0, 0, 0);
                O[dt] = __builtin_amdgcn_mfma_f32_32x32x16_bf16(__builtin_bit_cast(bf16x8, f1), pf1, O[dt], 0, 0, 0);
            }
        }
        lsum += __shfl_xor(lsum, 32);
        const float il = 1.f / lsum;
        float ss = 0.f;
#pragma unroll
        for (int dt = 0; dt < 4; ++dt)
#pragma unroll
            for (int i = 0; i < 16; ++i) { O[dt][i] *= il; ss += O[dt][i] * O[dt][i]; }
        ss += __shfl_xor(ss, 32);
        const float rr = rsqrtf(ss * (1.f / HD) + EPS);
        bf16* orow = MIXED + (size_t)mq * DM + h * HD;
#pragma unroll
        for (int dt = 0; dt < 4; ++dt)
#pragma unroll
            for (int rg = 0; rg < 4; ++rg) { const int d = 32 * dt + 8 * rg + 4 * hh; const f32x4 gg = *(const GAS f32x4*)(og + h * HD + d);
                v2u w; w.x = pk2(O[dt][4 * rg + 0] * rr * gg.x, O[dt][4 * rg + 1] * rr * gg.y); w.y = pk2(O[dt][4 * rg + 2] * rr * gg.z, O[dt][4 * rg + 3] * rr * gg.w);
                *(GAS v2u*)(orow + d) = w; }
        LDS_WAIT();
    }
}


constexpr int AT_KBYTES = 16384, AT_VPITCH = 136, AT_VBYTES = 128 * AT_VPITCH, AT_STAGE = AT_KBYTES + AT_VBYTES, AT_RP_OFF = 2 * AT_STAGE;
__device__ __forceinline__ void phase_attn2(Frame& F) {
    const bf16* QK = (const bf16*)(F.ws + WS_QK); const bf16* VT = (const bf16*)(F.ws + WS_XT); bf16* MIXED = (bf16*)(F.ws + WS_MIXED);
    const float* rpb = F.in[5]; const float* og = F.in[15]; const float* qg = F.in[3]; const float* kg = F.in[4];
    LAS float* rp = (LAS float*)(F.lds + AT_RP_OFF + F.wave * 2048);
    LAS float* gtab = (LAS float*)(F.lds + AT_RP_OFF + 8 * 2048);
    if (F.tid < HD) gtab[F.tid] = qg[F.tid] * kg[F.tid];
    const int n = F.lane & 31, hh = F.lane >> 5;
    for (int unit = F.bid; unit < NB * NH * 16; unit += F.G) {
        const int rq = unit & 15, h = (unit >> 4) & 7, b = unit >> 7, r0 = 4 * rq;
        const int r = r0 + (F.wave >> 1), wq = F.wave & 1;
        int kmin = r0 - WR / 2; kmin = kmin < 0 ? 0 : (kmin > NROWS - WR ? NROWS - WR : kmin);
        int kmax = r0 + 3 - WR / 2; kmax = (kmax < 0 ? 0 : (kmax > NROWS - WR ? NROWS - WR : kmax)) + WR - 1;
        int kr0 = r - WR / 2; kr0 = kr0 < 0 ? 0 : (kr0 > NROWS - WR ? NROWS - WR : kr0);
        const int nrows = kmax - kmin + 1;
        __syncthreads();
        for (int i = F.lane; i < 15 * 31; i += 64) rp[i] = rpb[h * 465 + i];
        const int mq = b * SEQ + r * GW + 32 * wq + n, qc = 32 * wq + n;
        int c0 = qc - WC / 2; c0 = c0 < 0 ? 0 : (c0 > GW - WC ? GW - WC : c0);
        bf16x8 qf[8];
#pragma unroll
        for (int ks = 0; ks < 8; ++ks) qf[ks] = *(const GAS bf16x8*)(QK + (size_t)mq * 2048 + h * HD + 16 * ks + 8 * hh);
        float qscale;
        {
          f32x16 D;
#pragma unroll
          for (int i = 0; i < 16; ++i) D[i] = 0.f;
#pragma unroll
          for (int ks = 0; ks < 8; ++ks) D = __builtin_amdgcn_mfma_f32_32x32x16_bf16(qf[ks], qf[ks], D, 0, 0, 0);
          float dsel = 0.f; const int isel = (n & 3) + 4 * (n >> 3);
#pragma unroll
          for (int i = 0; i < 16; ++i) dsel = (i == isel) ? D[i] : dsel;
          const float other = __shfl_xor(dsel, 32);
          const float ssq = (((n >> 2) & 1) == hh) ? dsel : other;
          qscale = 0.08838834764831845f * rsqrtf(ssq * (1.f / HD) + EPS); }
        f32x16 O[4];
#pragma unroll
        for (int dt = 0; dt < 4; ++dt)
#pragma unroll
            for (int i = 0; i < 16; ++i) O[dt][i] = 0.f;
        float lsum = 0.f;
        v4u sk[2], sv[2];

        auto gload = [&](int kr) {
#pragma unroll
            for (int j = 0; j < 2; ++j) { const int id = F.tid + 512 * j;
                sk[j] = *(const GAS v4u*)(QK + (size_t)(b * SEQ + kr * GW + (id >> 4)) * 2048 + 1024 + h * HD + 8 * (id & 15));
                sv[j] = *(const GAS v4u*)(VT + (size_t)(h * HD + (id >> 3)) * MT + b * SEQ + kr * GW + 8 * (id & 7)); }
        };
        auto lstore = [&](int buf) {
            LAS unsigned char* kb = F.lds + buf * AT_STAGE; LAS unsigned char* vb = kb + AT_KBYTES;
#pragma unroll
            for (int j = 0; j < 2; ++j) { const int id = F.tid + 512 * j; const int key = id >> 4, c = id & 15;
                float f[8] = {bflo(sk[j].x), bfhi(sk[j].x), bflo(sk[j].y), bfhi(sk[j].y), bflo(sk[j].z), bfhi(sk[j].z), bflo(sk[j].w), bfhi(sk[j].w)};
                float ss = 0.f;
#pragma unroll
                for (int e = 0; e < 8; ++e) ss += f[e] * f[e];
                ss += __shfl_xor(ss, 1); ss += __shfl_xor(ss, 2); ss += __shfl_xor(ss, 4); ss += __shfl_xor(ss, 8);
                const float rk = rsqrtf(ss * (1.f / HD) + EPS);
                const f32x4 ga = *(const LAS f32x4*)(gtab + 8 * c), gb = *(const LAS f32x4*)(gtab + 8 * c + 4);
                v4u kn; kn.x = pk2(f[0] * rk * ga.x, f[1] * rk * ga.y); kn.y = pk2(f[2] * rk * ga.z, f[3] * rk * ga.w); kn.z = pk2(f[4] * rk * gb.x, f[5] * rk * gb.y); kn.w = pk2(f[6] * rk * gb.z, f[7] * rk * gb.w);
                *(LAS v4u*)(kb + key * 256 + ((c ^ (key & 15)) << 4)) = kn;
                const int d = id >> 3, cv = id & 7; LAS v2u* vp = (LAS v2u*)(vb + d * AT_VPITCH + cv * 16);
                v2u lo, hi; lo.x = sv[j].x; lo.y = sv[j].y; hi.x = sv[j].z; hi.y = sv[j].w; vp[0] = lo; vp[1] = hi; }
        };
        gload(kmin); lstore(0);
        __syncthreads();
#pragma unroll 1
        for (int j = 0; j < nrows; ++j) {
            const int kr = kmin + j, buf = j & 1;
            if (j + 1 < nrows) gload(kr + 1);
            if (kr >= kr0 && kr < kr0 + WR) {
                const LAS unsigned char* kb = F.lds + buf * AT_STAGE; const LAS unsigned char* vb = kb + AT_KBYTES;
                const int dr = kr - r + WR - 1;
                int c0v = c0, qcv = qc; asm volatile("" : "+v"(c0v), "+v"(qcv));
#pragma unroll
                for (int kt = 0; kt < 2; ++kt) {
                    f32x16 S;
#pragma unroll
                    for (int i = 0; i < 16; ++i) S[i] = 0.f;
                    const int key = 32 * kt + n;
#pragma unroll
                    for (int ks = 0; ks < 8; ++ks) { const bf16x8 kf = *(const LAS bf16x8*)(kb + key * 256 + (((2 * ks + hh) ^ (key & 15)) << 4));
                        S = __builtin_amdgcn_mfma_f32_32x32x16_bf16(kf, qf[ks], S, 0, 0, 0); }
                    float p[16];
#pragma unroll
                    for (int i = 0; i < 16; ++i) { const int kc = 32 * kt + (i & 3) + 8 * (i >> 2) + 4 * hh; const bool valid = (kc >= c0v) && (kc < c0v + WC);
                        int dc = kc - qcv + WC - 1; dc = dc < 0 ? 0 : (dc > 2 * WC - 2 ? 2 * WC - 2 : dc);
                        const float e = __expf(S[i] * qscale + rp[dr * 31 + dc]); p[i] = valid ? e : 0.f; lsum += p[i]; }
                    v4u pw0, pw1;
                    pw0.x = pk2(p[0], p[1]); pw0.y = pk2(p[2], p[3]); pw0.z = pk2(p[4], p[5]); pw0.w = pk2(p[6], p[7]);
                    pw1.x = pk2(p[8], p[9]); pw1.y = pk2(p[10], p[11]); pw1.z = pk2(p[12], p[13]); pw1.w = pk2(p[14], p[15]);
                    const bf16x8 pf0 = __builtin_bit_cast(bf16x8, pw0), pf1 = __builtin_bit_cast(bf16x8, pw1);
#pragma unroll
                    for (int dt = 0; dt < 4; ++dt) {
                        const LAS unsigned char* vrow = vb + (32 * dt + n) * AT_VPITCH + (32 * kt + 4 * hh) * 2;
                        const v2u a0 = *(const LAS v2u*)(vrow), a1 = *(const LAS v2u*)(vrow + 16), a2 = *(const LAS v2u*)(vrow + 32), a3 = *(const LAS v2u*)(vrow + 48);
                        v4u f0, f1; f0.x = a0.x; f0.y = a0.y; f0.z = a1.x; f0.w = a1.y; f1.x = a2.x; f1.y = a2.y; f1.z = a3.x; f1.w = a3.y;
                        O[dt] = __builtin_amdgcn_mfma_f32_32x32x16_bf16(__builtin_bit_cast(bf16x8, f0), pf0, O[dt], 0, 0, 0);
                        O[dt] = __builtin_amdgcn_mfma_f32_32x32x16_bf16(__builtin_bit_cast(bf16x8, f1), pf1, O[dt], 0, 0, 0);
                    }
                }
            }
            if (j + 1 < nrows) lstore(buf ^ 1);
            __syncthreads();
        }
        lsum += __shfl_xor(lsum, 32);
        const float il = 1.f / lsum;
        float ss = 0.f;
#pragma unroll
        for (int dt = 0; dt < 4; ++dt)
#pragma unroll
            for (int i = 0; i < 16; ++i) { O[dt][i] *= il; ss += O[dt][i] * O[dt][i]; }
        ss += __shfl_xor(ss, 32);
        const float rr = rsqrtf(ss * (1.f / HD) + EPS);
        bf16* orow = MIXED + (size_t)mq * DM + h * HD;
#pragma unroll
        for (int dt = 0; dt < 4; ++dt)
#pragma unroll
            for (int rg = 0; rg < 4; ++rg) { const int d = 32 * dt + 8 * rg + 4 * hh; const f32x4 gg = *(const GAS f32x4*)(og + h * HD + d);
                v2u w; w.x = pk2(O[dt][4 * rg + 0] * rr * gg.x, O[dt][4 * rg + 1] * rr * gg.y); w.y = pk2(O[dt][4 * rg + 2] * rr * gg.z, O[dt][4 * rg + 3] * rr * gg.w);
                *(GAS v2u*)(orow + d) = w; }
    }
    __syncthreads();
}

__device__ __forceinline__ void phase_p15(Frame& F) {
    bf16* QK = (bf16*)(F.ws + WS_QK); const float* qg = F.in[3]; const float* kg = F.in[4];
    for (int m = GW_ID(F); m < MT; m += GW_N(F)) {
        GAS v4u* rowp = (GAS v4u*)(QK + (size_t)m * 2048) + F.lane;
#pragma unroll
        for (int j = 0; j < 4; ++j) {
            v4u w = rowp[64 * j];
            float f[8] = {bflo(w.x), bfhi(w.x), bflo(w.y), bfhi(w.y), bflo(w.z), bfhi(w.z), bflo(w.w), bfhi(w.w)};
            float ss = 0.f;
#pragma unroll
            for (int e = 0; e < 8; ++e) ss += f[e] * f[e];
            ss += __shfl_xor(ss, 1); ss += __shfl_xor(ss, 2); ss += __shfl_xor(ss, 4); ss += __shfl_xor(ss, 8);
            const float r = rsqrtf(ss * (1.f / HD) + EPS);
            const int col = 512 * j + 8 * F.lane, d = col & 127; const float* g = (col < 1024 ? qg : kg) + d;
#pragma unroll
            for (int e = 0; e < 8; ++e) f[e] = f[e] * r * g[e];
            w.x = pk2(f[0], f[1]); w.y = pk2(f[2], f[3]); w.z = pk2(f[4], f[5]); w.w = pk2(f[6], f[7]);
            rowp[64 * j] = w;
        }
    }
    const bf16* XT = (const bf16*)(F.ws + WS_XT) + (size_t)1024 * MT; bf16* UC = (bf16*)(F.ws + WS_UC);
    const float* cw = F.in[6]; const float* cb = F.in[7];
    const size_t nchunks = (size_t)3072 * MT / 8;
    for (size_t i = (size_t)F.bid * NTHREADS + F.tid; i < nchunks; i += (size_t)F.G * NTHREADS) {
        const int ch = (int)(i >> 10), m0 = (int)(i & 1023) * 8, s0 = m0 & 4095;
        const bf16* up = XT + (size_t)ch * MT + m0;
        const v4u w = *(const GAS v4u*)up;
        float f[10];
        f[1] = bflo(w.x); f[2] = bfhi(w.x); f[3] = bflo(w.y); f[4] = bfhi(w.y); f[5] = bflo(w.z); f[6] = bfhi(w.z); f[7] = bflo(w.w); f[8] = bfhi(w.w);
        f[0] = s0 > 0 ? bf2f(up[-1]) : 0.f; f[9] = s0 + 8 < SEQ ? bf2f(up[8]) : 0.f;
        const float w0 = cw[ch], w1 = cw[3072 + ch], w2 = cw[6144 + ch], bb = cb[ch];
        float o[8];
#pragma unroll
        for (int e = 0; e < 8; ++e) o[e] = bb + w0 * f[e] + w1 * f[e + 1] + w2 * f[e + 2];
        v4u ov; ov.x = pk2(o[0], o[1]); ov.y = pk2(o[2], o[3]); ov.z = pk2(o[4], o[5]); ov.w = pk2(o[6], o[7]);
        *(GAS v4u*)(UC + (size_t)ch * MT + m0) = ov;
    }
}
__device__ __forceinline__ void phase_p25(Frame& F) {
    const bf16* HYT = (const bf16*)(F.ws + WS_HYT); bf16* MIXED = (bf16*)(F.ws + WS_MIXED); const float* hg = F.in[16];
    LAS float* tile = (LAS float*)F.lds;
    LAS float* rs = (LAS float*)(F.lds + 128 * 65 * 4);
    for (int it = F.bid; it < 8 * (MT / 64); it += F.G) {
        const int gi = it & 7, m0 = (it >> 3) * 64;
        { const int ch = F.tid >> 2, t0 = (F.tid & 3) * 16; const bf16* p = HYT + (size_t)(gi * 128 + ch) * MT + m0 + t0;
          const v4u a = *(const GAS v4u*)p, b = *(const GAS v4u*)(p + 8);
          LAS float* d = tile + ch * 65 + t0;
          d[0] = bflo(a.x); d[1] = bfhi(a.x); d[2] = bflo(a.y); d[3] = bfhi(a.y); d[4] = bflo(a.z); d[5] = bfhi(a.z); d[6] = bflo(a.w); d[7] = bfhi(a.w);
          d[8] = bflo(b.x); d[9] = bfhi(b.x); d[10] = bflo(b.y); d[11] = bfhi(b.y); d[12] = bflo(b.z); d[13] = bfhi(b.z); d[14] = bflo(b.w); d[15] = bfhi(b.w); }
        __syncthreads();
        {
          const int t = F.tid >> 3, c0 = (F.tid & 7) * 16; float ss = 0.f;
#pragma unroll
          for (int c = 0; c < 16; ++c) { const float v = tile[(c0 + c) * 65 + t]; ss += v * v; }
          ss += __shfl_xor(ss, 1); ss += __shfl_xor(ss, 2); ss += __shfl_xor(ss, 4);
          if ((F.tid & 7) == 0) rs[t] = rsqrtf(ss * (1.f / 128) + EPS); }
        __syncthreads();
        {
          const int t = F.tid >> 3, c0 = (F.tid & 7) * 16; const float r = rs[t]; float o[16];
#pragma unroll
          for (int c = 0; c < 16; ++c) o[c] = tile[(c0 + c) * 65 + t] * r * hg[gi * 128 + c0 + c];
          v4u a, b; a.x = pk2(o[0], o[1]); a.y = pk2(o[2], o[3]); a.z = pk2(o[4], o[5]); a.w = pk2(o[6], o[7]); b.x = pk2(o[8], o[9]); b.y = pk2(o[10], o[11]); b.z = pk2(o[12], o[13]); b.w = pk2(o[14], o[15]);
          bf16* q = MIXED + (size_t)(m0 + t) * DM + AW + gi * 128 + c0; *(GAS v4u*)q = a; *(GAS v4u*)(q + 8) = b; }
        __syncthreads();
    }
}
__device__ __forceinline__ void phase_p35(Frame& F) {
    LAS float* wrT = (LAS float*)F.lds;
    const float* wr = F.in[19]; const float* g = F.in[18];
    constexpr int WRS = DM + 4;
    for (int i = F.tid; i < DM * NE; i += NTHREADS) { const int d = i >> 4, e = i & 15; wrT[e * WRS + d] = wr[i]; }
    __syncthreads();
    bf16* HB = (bf16*)(F.ws + WS_HB); float* AFF = (float*)(F.ws + WS_AFF); const float* x1 = F.out;
    f32x4 vn[8];
    { const int m0 = GW_ID(F); if (m0 < MT) { const GAS f32x4* xr = (const GAS f32x4*)(x1 + (size_t)m0 * DM) + F.lane;
#pragma unroll
        for (int j = 0; j < 8; ++j) vn[j] = xr[64 * j]; } }
    for (int m = GW_ID(F); m < MT; m += GW_N(F)) {
        f32x4 v[8]; float s = 0.f;
#pragma unroll
        for (int j = 0; j < 8; ++j) { v[j] = vn[j]; s += (v[j].x * v[j].x + v[j].y * v[j].y) + (v[j].z * v[j].z + v[j].w * v[j].w); }
        if (m + GW_N(F) < MT) { const GAS f32x4* xr = (const GAS f32x4*)(x1 + (size_t)(m + GW_N(F)) * DM) + F.lane;
#pragma unroll
            for (int j = 0; j < 8; ++j) vn[j] = xr[64 * j]; }
        const float r = rsqrtf(wave_sum(s) * (1.f / DM) + EPS);
        GAS v2u* o8 = (GAS v2u*)(HB + (size_t)m * DM) + F.lane;
#pragma unroll
        for (int j = 0; j < 8; ++j) { const f32x4 gg = *((const GAS f32x4*)g + F.lane + 64 * j); v[j].x *= r * gg.x; v[j].y *= r * gg.y; v[j].z *= r * gg.z; v[j].w *= r * gg.w;
            v2u o; o.x = pk2(v[j].x, v[j].y); o.y = pk2(v[j].z, v[j].w); o8[64 * j] = o; }
        float mine = 0.f;
#pragma unroll 1
        for (int e = 0; e < NE; ++e) { float a = 0.f;
#pragma unroll
            for (int j = 0; j < 8; ++j) { const f32x4 w = *((const LAS f32x4*)(wrT + e * WRS) + F.lane + 64 * j); a += (v[j].x * w.x + v[j].y * w.y) + (v[j].z * w.z + v[j].w * w.w); }
            a = wave_sum(a); mine = (F.lane == e) ? a : mine; }
        float mx = mine;
        mx = fmaxf(mx, __shfl_xor(mx, 1)); mx = fmaxf(mx, __shfl_xor(mx, 2)); mx = fmaxf(mx, __shfl_xor(mx, 4)); mx = fmaxf(mx, __shfl_xor(mx, 8));
        const float ex = expf(mine - mx); float den = ex;
        den += __shfl_xor(den, 1); den += __shfl_xor(den, 2); den += __shfl_xor(den, 4); den += __shfl_xor(den, 8);
        const int b = m / SEQ, sidx = m % SEQ;
        if (F.lane < NE) AFF[((size_t)b * NE + F.lane) * SEQ + sidx] = ex / den;
    }
    __syncthreads();
}
__device__ __forceinline__ void phase_p4(Frame& F) {
    LAS unsigned* key = (LAS unsigned*)F.lds;
    LAS unsigned* hist = (LAS unsigned*)(F.lds + 16384);
    LAS unsigned* wsum = (LAS unsigned*)(F.lds + 16384 + 1024);
    const float* AFF = (const float*)(F.ws + WS_AFF); int* IDX = (int*)(F.ws + WS_IDX); float* GATE = (float*)(F.ws + WS_GATE); int* SEL = (int*)(F.ws + WS_SEL);
    for (int be = F.bid; be < NB * NE; be += F.G) {
        const int b = be / NE, e = be % NE;
        __syncthreads();
        const GAS v4u* ap = (const GAS v4u*)(AFF + (size_t)be * SEQ);
        const v4u k0 = ap[2 * F.tid], k1 = ap[2 * F.tid + 1];
        unsigned kk[8] = {k0.x, k0.y, k0.z, k0.w, k1.x, k1.y, k1.z, k1.w};
        unsigned prefix = 0u, mask = 0u, remaining = CAP;
#pragma unroll 1
        for (int pass = 0; pass < 4; ++pass) {
            const int shift = 24 - 8 * pass;
            if (F.tid < 256) hist[F.tid] = 0u;
            __syncthreads();
#pragma unroll
            for (int i = 0; i < 8; ++i) if ((kk[i] & mask) == prefix) __hip_atomic_fetch_add(&hist[(kk[i] >> shift) & 255u], 1u, __ATOMIC_RELAXED, __HIP_MEMORY_SCOPE_WORKGROUP);
            __syncthreads();
            unsigned incl_ = 0u, mine_ = 0u;
            if (F.tid < 256) {
                mine_ = hist[255 - F.tid]; incl_ = mine_;
#pragma unroll
                for (int o = 1; o < 64; o <<= 1) { const unsigned t = __shfl_up(incl_, o); if (F.lane >= o) incl_ += t; }
                if (F.lane == 63) wsum[10 + F.wave] = incl_;
            }
            __syncthreads();
            if (F.tid < 256) {
                unsigned base = 0u;
                for (int w = 0; w < F.wave; ++w) base += wsum[10 + w];
                const unsigned above = base + incl_ - mine_;
                if (above < remaining && remaining <= above + mine_) { wsum[8] = (unsigned)(255 - F.tid); wsum[9] = above; }
            }
            __syncthreads();
            const unsigned d = wsum[8], above = wsum[9];
            prefix |= d << shift; mask |= 255u << shift; remaining -= above;
            __syncthreads();
        }
        const unsigned thr = prefix;
        unsigned cnt = 0u;
#pragma unroll
        for (int i = 0; i < 8; ++i) cnt += (kk[i] > thr ? 0x10000u : 0u) + (kk[i] == thr ? 1u : 0u);
        unsigned incl = cnt;
#pragma unroll
        for (int o = 1; o < 64; o <<= 1) { const unsigned t = __shfl_up(incl, o); if (F.lane >= o) incl += t; }
        if (F.lane == 63) wsum[F.wave] = incl;
        __syncthreads();
        unsigned base = 0u;
        for (int w = 0; w < F.wave; ++w) base += wsum[w];
        unsigned run = base + incl - cnt;
#pragma unroll
        for (int i = 0; i < 8; ++i) {
            const unsigned gt_before = run >> 16, tie_before = run & 0xffffu;
            const bool isgt = kk[i] > thr, istie = kk[i] == thr;
            const bool sel = isgt || (istie && tie_before < remaining);
            const unsigned slot = gt_before + (tie_before < remaining ? tie_before : remaining);
            const int s = 8 * F.tid + i, m = b * SEQ + s;
            if (sel) { IDX[be * CAP + slot] = m; GATE[be * CAP + slot] = __builtin_bit_cast(float, kk[i]); }
            SEL[(size_t)m * NE + e] = sel ? (int)slot : -1;
            run += (isgt ? 0x10000u : 0u) + (istie ? 1u : 0u);
        }
    }
    __syncthreads();
}
__device__ __forceinline__ void phase_p7(Frame& F) {
    const int* SEL = (const int*)(F.ws + WS_SEL); const float* GATE = (const float*)(F.ws + WS_GATE); const bf16* YE = (const bf16*)(F.ws + WS_YE);
    for (int m = GW_ID(F); m < MT; m += GW_N(F)) {
        const int b = m / SEQ;
        GAS f32x4* orow = (GAS f32x4*)(F.out + (size_t)m * DM);
        f32x4 acc[8];
#pragma unroll
        for (int j = 0; j < 8; ++j) acc[j] = orow[2 * F.lane + (j & 1) + 128 * (j >> 1)];
        for (int e = 0; e < NE; ++e) { const int slot = SEL[(size_t)m * NE + e]; if (slot >= 0) {
            const GAS v4u* yr = (const GAS v4u*)(YE + (size_t)((b * NE + e) * CAP + slot) * DM) + F.lane;
#pragma unroll
            for (int jj = 0; jj < 4; ++jj) { const v4u w = yr[64 * jj];
                acc[2 * jj].x += bflo(w.x); acc[2 * jj].y += bfhi(w.x); acc[2 * jj].z += bflo(w.y); acc[2 * jj].w += bfhi(w.y);
                acc[2 * jj + 1].x += bflo(w.z); acc[2 * jj + 1].y += bfhi(w.z); acc[2 * jj + 1].z += bflo(w.w); acc[2 * jj + 1].w += bfhi(w.w); } } }
#pragma unroll
        for (int j = 0; j < 8; ++j) orow[2 * F.lane + (j & 1) + 128 * (j >> 1)] = acc[j];
    }
    (void)GATE;
}

struct Args { const float* in[23]; float* out; unsigned char* ws; int ph_lo, ph_hi; };
enum Phase { PH_P0 = 0, PH_G1, PH_ATTN, PH_P25, PH_OUT, PH_P35, PH_P4, PH_UP, PH_DOWN, PH_P7, PH_COUNT };

__global__ void __launch_bounds__(NTHREADS, 2) mk_fwd(Args args) {
    extern __shared__ __attribute__((aligned(16))) unsigned char lds_raw[];
    Frame F;
    F.lds = (LAS unsigned char*)lds_raw;
    F.tid = threadIdx.x; F.lane = F.tid & 63; F.wave = __builtin_amdgcn_readfirstlane(F.tid >> 6); F.G = gridDim.x; F.bid = blockIdx.x;
#pragma unroll
    for (int i = 0; i < 23; ++i) F.in[i] = args.in[i];
    F.out = args.out; F.ws = args.ws;
    const int lo = args.ph_lo, hi = args.ph_hi;
#define IN(k) (lo <= (k) && (k) < hi)
#define REPS(k) for (int rep_ = 0; rep_ < ((k) == REP_PHASE ? REP_N : 1); ++rep_)
#if MK_N_LAUNCHES == 1
    { volatile LAS unsigned* misc = (volatile LAS unsigned*)(F.lds + LDS_MISC_OFF); if (F.tid < 16) misc[F.tid] = 0u; }
    __syncthreads();
    XcdBarrier bar = xcd_barrier_post(g_bar_words, (volatile LAS unsigned*)(F.lds + LDS_MISC_OFF) + 8);
#define SEAM(k) do { if (IN(k) && IN((k) + 1)) xcd_barrier(bar); } while (0)
#else
#define SEAM(k) do { } while (0)
#endif
    if (IN(PH_P0)) REPS(PH_P0) { phase_p0(F); for (int it = GW_ID(F); it < MOE_P0_ITEMS; it += GW_N(F)) moe_conv_item(F, it); } SEAM(PH_P0);
    if (IN(PH_G1)) REPS(PH_G1) {
        phase_filters(F);
        __syncthreads();
        { pg8::DenseOrder S; S.init(F.ws + WS_HB, F.ws + WS_WIN, MT, 2048, DM, 0, F.G, F.bid);
          pg8::EpiBf16 E{(pg8::bf16_t*)(F.ws + WS_QK), 2048, 0, nullptr};
          pg8::gemm_phase<pg8::EpiBf16, pg8::DenseOrder, true>(F.lds, DM, S, E); }
        { pg8::DenseOrder S; S.init(F.ws + WS_HB, F.ws + WS_WIN, MT, 4096, DM, 8, F.G, F.bid);
          pg8::EpiTransBf16 E{(pg8::bf16_t*)(F.ws + WS_XT), MT, 8};
          pg8::gemm_phase<pg8::EpiTransBf16, pg8::DenseOrder, true>(F.lds, DM, S, E); }
    } SEAM(PH_G1);
    if (IN(PH_ATTN)) { __syncthreads(); for (int rep_ = 0; rep_ < ((PH_ATTN == REP_PHASE && REP_SUB != 2) ? REP_N : 1); ++rep_) phase_hyena(F); for (int rep_ = 0; rep_ < ((PH_ATTN == REP_PHASE && REP_SUB != 1) ? REP_N : 1); ++rep_) phase_attn2(F); } SEAM(PH_ATTN);
    if (IN(PH_P25)) REPS(PH_P25) { __syncthreads(); phase_p25(F); } SEAM(PH_P25);
    if (IN(PH_OUT)) REPS(PH_OUT) {
        __syncthreads();
        pg8::DenseOrder S; S.init(F.ws + WS_MIXED, F.ws + WS_WOUT, MT, DM, DM, 0, F.G, F.bid);
        pg8::EpiResF32 E{F.in[0], F.out, DM};
        pg8::gemm_phase<pg8::EpiResF32, pg8::DenseOrder, false>(F.lds, DM, S, E);
    } SEAM(PH_OUT);
    if (IN(PH_P35)) REPS(PH_P35) { __syncthreads(); phase_p35(F); } SEAM(PH_P35);
    if (IN(PH_P4)) REPS(PH_P4) { __syncthreads(); phase_p4(F); } SEAM(PH_P4);
    if (IN(PH_UP)) REPS(PH_UP) {
        __syncthreads();
        pg8::MoeOrder S; S.init(F.ws + WS_HB, F.ws + WS_WGU, DM, F.G, F.bid, true);
        LAS int* ridx = (LAS int*)(F.lds + 131072);
        { const int* IDX = (const int*)(F.ws + WS_IDX); pg8::Unit u;
          for (int i = 0; S.next(i, u); ++i) if (F.tid < 256) ridx[i * 256 + F.tid] = IDX[u.g * CAP + u.pm * 256 + F.tid]; }
        __syncthreads();
        pg8::EpiSwiGLU E{(pg8::bf16_t*)(F.ws + WS_ACT)};
        pg8::gemm_phase<pg8::EpiSwiGLU, pg8::MoeOrder, true, true>(F.lds, DM, S, E, ridx);
    } SEAM(PH_UP);
    if (IN(PH_DOWN)) REPS(PH_DOWN) {
        __syncthreads();
        pg8::MoeOrder S; S.init(F.ws + WS_ACT, F.ws + WS_WD, FF, F.G, F.bid, false);
        pg8::EpiBf16 E{(pg8::bf16_t*)(F.ws + WS_YE), DM, 512, (const float*)(F.ws + WS_GATE)};
        pg8::gemm_phase<pg8::EpiBf16, pg8::MoeOrder, true>(F.lds, FF, S, E);
    } SEAM(PH_DOWN);
    if (IN(PH_P7)) { phase_p7(F); }
#if MK_N_LAUNCHES == 1
    __syncthreads();
    { volatile LAS unsigned* misc = (volatile LAS unsigned*)(F.lds + LDS_MISC_OFF);
      if (F.tid == 0) misc[0] = (xb_add(&g_bar_words[XCD_BAR_WORDS], 1u) + 1u == (unsigned)F.G) ? 1u : 0u;
      __syncthreads();
      if (misc[0] != 0u && F.tid < (XCD_BAR_WORDS + 64) / 64) __hip_atomic_store(&g_bar_words[64 * F.tid], 0u, __ATOMIC_RELAXED, __HIP_MEMORY_SCOPE_AGENT); }
#endif
#undef IN
#undef SEAM
}

extern "C" void kernel_launch(void* const* d_in, const int* in_sizes, int n_in, void* d_out, int out_size, void* d_ws, size_t ws_size, hipStream_t stream) {
    static int grid = 0;
    if (grid == 0) {
        if (n_in != 23 || ws_size < WS_END) { fprintf(stderr, "kernel_launch: unexpected inputs (n_in %d, ws %zu)\n", n_in, ws_size); grid = -1; return; }
        if (hipFuncSetAttribute((const void*)mk_fwd, hipFuncAttributeMaxDynamicSharedMemorySize, LDS_BYTES) != hipSuccess) { fprintf(stderr, "kernel_launch: hipFuncSetAttribute failed\n"); grid = -1; return; }
        int dev = 0, cus = 0, per_cu = 0;
        hipGetDevice(&dev); hipDeviceGetAttribute(&cus, hipDeviceAttributeMultiprocessorCount, dev);
        hipOccupancyMaxActiveBlocksPerMultiprocessor(&per_cu, (const void*)mk_fwd, NTHREADS, LDS_BYTES);
        (void)hipGetLastError();
        if (per_cu < 1) { fprintf(stderr, "kernel_launch: occupancy query says %d blocks/CU\n", per_cu); }
        grid = cus;
    }
    if (grid < 0) return;
    Args a{};
    for (int i = 0; i < 23; ++i) a.in[i] = (const float*)d_in[i];
    a.out = (float*)d_out; a.ws = (unsigned char*)d_ws;
#if MK_N_LAUNCHES == 1
    a.ph_lo = 0; a.ph_hi = PH_COUNT;
    hipLaunchKernelGGL(mk_fwd, dim3(grid), dim3(NTHREADS), LDS_BYTES, stream, a);
#else
    for (int p = 0; p < PH_COUNT; ++p) { a.ph_lo = p; a.ph_hi = p + 1; hipLaunchKernelGGL(mk_fwd, dim3(grid), dim3(NTHREADS), LDS_BYTES, stream, a); }
#endif
}
```

```cpp
#include <hip/hip_runtime.h>
#include <hip/hip_cooperative_groups.h>
#include <cstdio>
#include <cstdint>
namespace cg = cooperative_groups;

#ifndef REP_PHASE
#define REP_PHASE -1
#define REP_N 1
#define REP_SUB 0
#endif
#ifndef MK_N_LAUNCHES
#define MK_N_LAUNCHES 1
#endif

namespace pg8 {
#define PG8_LAS __attribute__((address_space(3)))
typedef unsigned short bf16_t;
typedef short bf16x8 __attribute__((ext_vector_type(8)));
typedef float f32x4 __attribute__((ext_vector_type(4)));
typedef unsigned u32x4 __attribute__((ext_vector_type(4)));
typedef unsigned u32x2 __attribute__((ext_vector_type(2)));
constexpr int BM = 256, BK = 64, HALF = 128, HTB = HALF * BK * 2, STAGE_BYTES = 8 * HTB, NXCD = 8, WGM = 8;

__host__ __device__ __forceinline__ int lds_byte(int r, int c) { const int st = (r >> 4) * 2 + (c >> 5), rr = r & 15, cc = c & 31, ob = rr * 64 + cc * 2; return st * 1024 + (ob ^ (((ob >> 9) & 1) << 5)); }
__host__ __device__ __forceinline__ void stage_rc(int b, int& R, int& C) { const int st = b / 1024, sb = b % 1024, swz = sb ^ (((sb >> 9) & 1) << 5); R = (st >> 1) * 16 + swz / 64; C = (st & 1) * 32 + (swz % 64) / 2; }
__host__ __device__ __forceinline__ int perm32(int rho) { const int n = rho >> 4, i = rho & 15; return 8 * (i >> 2) + 4 * n + (i & 3); }

struct Unit { int pm, pn, g; const char* a; const char* b; };

__device__ __forceinline__ unsigned cvt_pk_bf16(float lo, float hi) { unsigned r; asm volatile("v_cvt_pk_bf16_f32 %0, %1, %2" : "=v"(r) : "v"(lo), "v"(hi)); return r; }

struct DenseOrder {
    static constexpr bool CHUNK_B = false;
    int nM, nN, nwg, G, c, K, pn0; const char* A; const char* Bt;
    __device__ void init(const void* A_, const void* Bt_, int M, int N, int K_, int pn0_, int G_, int c_) { A = (const char*)A_; Bt = (const char*)Bt_; nM = M / BM; nN = N / BM; nwg = nM * nN; G = G_; c = c_; K = K_; pn0 = pn0_; }
    __device__ bool next(int i, Unit& u) const {
        const long L = (long)i * G + c; if (L >= nwg) return false;
        int wgid = (int)L; { const int q = nwg / NXCD, r = nwg % NXCD, xcd = wgid % NXCD, off = wgid / NXCD; wgid = (xcd < r ? xcd * (q + 1) : r * (q + 1) + (xcd - r) * q) + off; }
        const int nig = WGM * nN, gid = wgid / nig, fm = gid * WGM, gsz = (nM - fm) < WGM ? (nM - fm) : WGM;
        u.pm = fm + ((wgid % nig) % gsz); u.pn = pn0 + (wgid % nig) / gsz; u.g = 0;
        u.a = A + (size_t)u.pm * BM * K * 2; u.b = Bt + (size_t)u.pn * BM * K * 2; return true;
    }
};
struct MoeOrder {
    static constexpr bool CHUNK_B = true;
    int G, c, K; bool gather; const char* A; const char* Bt;
    __device__ void init(const void* A_, const void* Bt_, int K_, int G_, int c_, bool gather_) { A = (const char*)A_; Bt = (const char*)Bt_; K = K_; G = G_; c = c_; gather = gather_; }
    __device__ bool next(int i, Unit& u) const {
        const int L = i * G + c; if (L >= 512) return false;
        const int pn = L & 7, pm = (L >> 3) & 1, b = (L >> 4) & 1, e = L >> 5;
        u.pm = pm; u.pn = pn; u.g = b * 16 + e;
        u.a = gather ? A : A + (size_t)(u.g * 512 + pm * BM) * K * 2; u.b = Bt + (size_t)e * 2048 * K * 2 + (size_t)pn * BM * 16; return true;
    }
};

struct EpiBf16 {
    static constexpr bool PERM = true, SWAP = false;
    bf16_t* O; int ldc; int grows; const float* rscale;
    __device__ __forceinline__ void operator()(const f32x4 (&acc)[2][2][4][2], const Unit& u, int wr, int wc, int fr, int fq) const {
        const int row0 = u.g * grows + u.pm * BM + wr * 64 + fr, col0 = u.pn * BM + wc * 32 + 8 * fq;
#pragma unroll
        for (int ai = 0; ai < 2; ++ai)
#pragma unroll
            for (int m = 0; m < 4; ++m) { const int row = row0 + ai * HALF + m * 16; bf16_t* rowp = O + (size_t)row * ldc + col0; const float sc = rscale ? rscale[row] : 1.f;
#pragma unroll
                for (int bj = 0; bj < 2; ++bj) { const f32x4 v0 = acc[ai][bj][m][0] * sc, v1 = acc[ai][bj][m][1] * sc;
                    u32x4 w; w.x = cvt_pk_bf16(v0[0], v0[1]); w.y = cvt_pk_bf16(v0[2], v0[3]); w.z = cvt_pk_bf16(v1[0], v1[1]); w.w = cvt_pk_bf16(v1[2], v1[3]);
                    *(u32x4*)(rowp + bj * HALF) = w; } }
    }
};
struct EpiSwiGLU {
    static constexpr bool PERM = true, SWAP = false;
    bf16_t* O;
    __device__ __forceinline__ void operator()(const f32x4 (&acc)[2][2][4][2], const Unit& u, int wr, int wc, int fr, int fq) const {
        const int row0 = u.g * 512 + u.pm * BM + wr * 64 + fr, col0 = u.pn * HALF + wc * 32 + 8 * fq;
#pragma unroll
        for (int ai = 0; ai < 2; ++ai)
#pragma unroll
            for (int m = 0; m < 4; ++m) { bf16_t* rowp = O + (size_t)(row0 + ai * HALF + m * 16) * 1024 + col0;
                float r[8];
#pragma unroll
                for (int n = 0; n < 2; ++n)
#pragma unroll
                    for (int e = 0; e < 4; ++e) { const float g = acc[ai][0][m][n][e], up = acc[ai][1][m][n][e]; r[n * 4 + e] = g / (1.f + __expf(-g)) * up; }
                u32x4 w; w.x = cvt_pk_bf16(r[0], r[1]); w.y = cvt_pk_bf16(r[2], r[3]); w.z = cvt_pk_bf16(r[4], r[5]); w.w = cvt_pk_bf16(r[6], r[7]);
                *(u32x4*)rowp = w; }
    }
};
struct EpiResF32 {
    static constexpr bool PERM = false, SWAP = false;
    const float* res; float* out; int ldc;
    __device__ __forceinline__ void operator()(const f32x4 (&acc)[2][2][4][2], const Unit& u, int wr, int wc, int fr, int fq) const {
        const int row0 = u.pm * BM + wr * 64 + fr, col0 = u.pn * BM + wc * 32 + 4 * fq;
#pragma unroll
        for (int ai = 0; ai < 2; ++ai)
#pragma unroll
            for (int m = 0; m < 4; ++m) { const size_t off = (size_t)(row0 + ai * HALF + m * 16) * ldc + col0;
#pragma unroll
                for (int bj = 0; bj < 2; ++bj)
#pragma unroll
                    for (int n = 0; n < 2; ++n) { const f32x4 r = *(const f32x4*)(res + off + bj * HALF + n * 16); *(f32x4*)(out + off + bj * HALF + n * 16) = r + acc[ai][bj][m][n]; } }
    }
};
struct EpiTransBf16 {
    static constexpr bool PERM = false, SWAP = true;
    bf16_t* O; int ldt; int pn_base;
    __device__ __forceinline__ void operator()(const f32x4 (&acc)[2][2][4][2], const Unit& u, int wr, int wc, int fr, int fq) const {
        const int ch0 = (u.pn - pn_base) * BM + wc * 32 + fr, t0 = u.pm * BM + wr * 64 + 4 * fq;
#pragma unroll
        for (int bj = 0; bj < 2; ++bj)
#pragma unroll
            for (int n = 0; n < 2; ++n) { bf16_t* chp = O + (size_t)(ch0 + bj * HALF + n * 16) * ldt + t0;
#pragma unroll
                for (int ai = 0; ai < 2; ++ai)
#pragma unroll
                    for (int m = 0; m < 4; ++m) { const f32x4 v = acc[ai][bj][m][n]; u32x2 w; w.x = cvt_pk_bf16(v[0], v[1]); w.y = cvt_pk_bf16(v[2], v[3]); *(u32x2*)(chp + ai * HALF + m * 16) = w; } }
    }
};

template <class Epi, class Sched, bool ALIGN_EPI = false, bool GATHER = false>
__device__ __forceinline__ void gemm_phase(PG8_LAS unsigned char* lds, const int K, const Sched& S, const Epi& E, const PG8_LAS int* ridx = nullptr) {
    const int tid = threadIdx.x, wid = __builtin_amdgcn_readfirstlane(tid >> 6), lane = tid & 63, wr = wid >> 2, wc = wid & 3, fr = lane & 15, fq = lane >> 4;
    const int nt = K / BK;
    unsigned vA0[2], vA1[2], vN0[2], vN1[2], voffB[2]; int stR[2], stC[2];
    const size_t kstep = (size_t)(BK * 2);
    const size_t hstep = (size_t)HALF * K * 2;
    const size_t kstepB = Sched::CHUNK_B ? (size_t)(BK / 8) * 2048 * 16 : kstep, hstepB = Sched::CHUNK_B ? (size_t)HALF * 16 : hstep;
#pragma unroll
    for (int i = 0; i < 2; ++i) { int R, C; stage_rc(tid * 16 + i * 8192, R, C); const int Rb = Epi::PERM ? ((R & ~31) + perm32(R & 31)) : R; stR[i] = R; stC[i] = C;
        voffB[i] = Sched::CHUNK_B ? (unsigned)(((C >> 3) * 2048 + Rb) * 16) : (unsigned)(Rb * K + C) * 2u;
        if constexpr (GATHER) { vA0[i] = (unsigned)(ridx[R] * K + C) * 2u; vA1[i] = (unsigned)(ridx[HALF + R] * K + C) * 2u; }
        else { vA0[i] = (unsigned)(R * K + C) * 2u; vA1[i] = vA0[i] + (unsigned)hstep; }
        vN0[i] = vA0[i]; vN1[i] = vA1[i]; }
    const unsigned ldsw = (unsigned)wid * 1024u;
    const int aoff = lds_byte(wr * 64 + fr, fq * 8), boff = lds_byte(wc * 32 + fr, fq * 8);
#define PG8_SA(b, h) (((b) * 2 + (h)) * HTB)
#define PG8_SB(b, h) ((4 + (b) * 2 + (h)) * HTB)
#define PG8_STAGE(bufoff, gbase, voff) do { _Pragma("unroll") for (int _i = 0; _i < 2; ++_i) \
        __builtin_amdgcn_global_load_lds((const unsigned*)((const char*)(gbase) + (voff)[_i]), (PG8_LAS unsigned*)(lds + (bufoff) + ldsw + _i * 8192), 16, 0, 0); } while (0)
#define PG8_LDA(dst, b, h) do { _Pragma("unroll") for (int m = 0; m < 4; ++m) _Pragma("unroll") for (int k = 0; k < 2; ++k) dst[m][k] = *(const PG8_LAS bf16x8*)(lds + PG8_SA(b, h) + aoff + m * 2048 + k * 1024); } while (0)
#define PG8_LDB(dst, b, h) do { _Pragma("unroll") for (int n = 0; n < 2; ++n) _Pragma("unroll") for (int k = 0; k < 2; ++k) dst[n][k] = *(const PG8_LAS bf16x8*)(lds + PG8_SB(b, h) + boff + n * 2048 + k * 1024); } while (0)
#define PG8_MMA(ai, bj, At, Bt) do { __builtin_amdgcn_s_setprio(1); _Pragma("unroll") for (int m = 0; m < 4; ++m) _Pragma("unroll") for (int n = 0; n < 2; ++n) _Pragma("unroll") for (int k = 0; k < 2; ++k) \
        acc[ai][bj][m][n] = Epi::SWAP ? __builtin_amdgcn_mfma_f32_16x16x32_bf16(At[m][k], Bt[n][k], acc[ai][bj][m][n], 0, 0, 0) : __builtin_amdgcn_mfma_f32_16x16x32_bf16(Bt[n][k], At[m][k], acc[ai][bj][m][n], 0, 0, 0); __builtin_amdgcn_s_setprio(0); } while (0)
#define PG8_WAIT_V(n) asm volatile("s_waitcnt vmcnt(" #n ")" ::: "memory")
#define PG8_WAIT_L(n) asm volatile("s_waitcnt lgkmcnt(" #n ")" ::: "memory")
#define PG8_BAR __builtin_amdgcn_s_barrier()
#define PG8_SCHED __builtin_amdgcn_sched_barrier(0)
    Unit cur, nxt; int ui = 0;
    if (!S.next(0, cur)) return;
    f32x4 acc[2][2][4][2];
#pragma unroll
    for (int a = 0; a < 2; ++a)
#pragma unroll
        for (int b = 0; b < 2; ++b)
#pragma unroll
            for (int m = 0; m < 4; ++m)
#pragma unroll
                for (int n = 0; n < 2; ++n) acc[a][b][m][n] = (f32x4){0.f, 0.f, 0.f, 0.f};
    bf16x8 At[4][2], B0[2][2], B1[2][2];
    const char* cA = cur.a; const char* cB = cur.b;
    PG8_STAGE(PG8_SB(0, 0), cB, voffB); PG8_STAGE(PG8_SB(0, 1), cB + hstepB, voffB); PG8_STAGE(PG8_SA(0, 0), cA, vA0); PG8_STAGE(PG8_SA(0, 1), cA, vA1);
    if (wr == 1) PG8_BAR;
    PG8_WAIT_V(2); PG8_BAR;
    PG8_STAGE(PG8_SB(1, 0), cB + kstepB, voffB); PG8_STAGE(PG8_SA(1, 0), cA + kstep, vA0); PG8_STAGE(PG8_SB(1, 1), cB + hstepB + kstepB, voffB);
    PG8_WAIT_V(6); PG8_BAR;
    for (;;) {
        const bool has_next = S.next(ui + 1, nxt);
        const char* nA = has_next ? nxt.a : cA; const char* nB = has_next ? nxt.b : cB;
        if constexpr (GATHER) { if (has_next) {
#pragma unroll
            for (int i = 0; i < 2; ++i) { vN0[i] = (unsigned)(ridx[(ui + 1) * 256 + stR[i]] * K + stC[i]) * 2u; vN1[i] = (unsigned)(ridx[(ui + 1) * 256 + HALF + stR[i]] * K + stC[i]) * 2u; } } }
        for (int t = 0; t < nt; t += 2) {
            const bool last = (t == nt - 2);
            const char* a1 = cA + (size_t)(t + 1) * kstep;
            const char* a2 = last ? nA : cA + (size_t)(t + 2) * kstep; const char* b2 = last ? nB : cB + (size_t)(t + 2) * kstepB;
            const char* a3 = a2 + kstep; const char* b3 = b2 + kstepB;
            unsigned w0[2], w1[2];
#pragma unroll
            for (int i = 0; i < 2; ++i) { w0[i] = last ? vN0[i] : vA0[i]; w1[i] = last ? vN1[i] : vA1[i]; }
            PG8_LDB(B0, 0, 0); PG8_LDB(B1, 0, 1); PG8_SCHED; PG8_LDA(At, 0, 0); PG8_STAGE(PG8_SA(1, 1), a1, vA1);
            PG8_WAIT_V(8); PG8_WAIT_L(0); PG8_BAR; PG8_MMA(0, 0, At, B0); PG8_MMA(0, 1, At, B1); PG8_BAR; PG8_SCHED;
            PG8_LDA(At, 0, 1); PG8_STAGE(PG8_SB(0, 0), b2, voffB); PG8_STAGE(PG8_SB(0, 1), b2 + hstepB, voffB); PG8_STAGE(PG8_SA(0, 0), a2, w0);
            PG8_WAIT_V(8); PG8_WAIT_L(0); PG8_BAR; PG8_MMA(1, 0, At, B0); PG8_MMA(1, 1, At, B1); PG8_BAR; PG8_SCHED;
            PG8_LDB(B0, 1, 0); PG8_LDB(B1, 1, 1); PG8_SCHED; PG8_LDA(At, 1, 0); PG8_STAGE(PG8_SA(0, 1), a2, w1);
            PG8_WAIT_V(8); PG8_WAIT_L(0); PG8_BAR; PG8_MMA(0, 0, At, B0); PG8_MMA(0, 1, At, B1); PG8_BAR; PG8_SCHED;
            PG8_LDA(At, 1, 1); PG8_STAGE(PG8_SB(1, 0), b3, voffB); PG8_STAGE(PG8_SB(1, 1), b3 + hstepB, voffB); PG8_STAGE(PG8_SA(1, 0), a3, w0);
            PG8_WAIT_V(8); PG8_WAIT_L(0); PG8_BAR; PG8_MMA(1, 0, At, B0); PG8_MMA(1, 1, At, B1); PG8_BAR; PG8_SCHED;
        }
        if constexpr (ALIGN_EPI) { if (wr == 0) PG8_BAR; }
        E(acc, cur, wr, wc, fr, fq);
        if (!has_next) break;
#pragma unroll
        for (int a = 0; a < 2; ++a)
#pragma unroll
            for (int b = 0; b < 2; ++b)
#pragma unroll
                for (int m = 0; m < 4; ++m)
#pragma unroll
                    for (int n = 0; n < 2; ++n) acc[a][b][m][n] = (f32x4){0.f, 0.f, 0.f, 0.f};
        cur = nxt; cA = nA; cB = nB; ++ui;
#pragma unroll
        for (int i = 0; i < 2; ++i) { vA0[i] = vN0[i]; vA1[i] = vN1[i]; }
        if constexpr (ALIGN_EPI) { if (wr == 1) PG8_BAR; }
    }
    PG8_WAIT_V(0);
    if constexpr (!ALIGN_EPI) { if (wr == 0) PG8_BAR; }
    PG8_BAR;
#undef PG8_SA
#undef PG8_SB
#undef PG8_STAGE
#undef PG8_LDA
#undef PG8_LDB
#undef PG8_MMA
#undef PG8_WAIT_V
#undef PG8_WAIT_L
#undef PG8_BAR
#undef PG8_SCHED
}
}

constexpr int NB = 2, SEQ = 4096, DM = 2048, MT = NB * SEQ;
constexpr int NH = 8, HD = 128, AW = 1024, HW = 1024, INW = 6144;
constexpr int GW = 64, NROWS = 64, WR = 8, WC = 16;
constexpr int NE = 16, CAP = 512, FF = 1024;
constexpr int FEMB = 33, FHID = 64;
constexpr float EPS = 1e-6f;
constexpr int NWAVES = 8, NTHREADS = 512;

constexpr size_t MiB = 1u << 20;
constexpr size_t WS_CTL = 0, CTL_ZERO_BYTES = 32768;
constexpr size_t WS_WIN = 2 * MiB;
constexpr size_t WS_WOUT = 26 * MiB;
constexpr size_t WS_WGU = 34 * MiB;
constexpr size_t WS_WD = 162 * MiB;
constexpr size_t WS_W3T = 226 * MiB;
constexpr size_t WS_HID2 = 227 * MiB;
constexpr size_t WS_HB = 228 * MiB;
constexpr size_t WS_QK = 260 * MiB;
constexpr size_t WS_XT = 292 * MiB;
constexpr size_t WS_UC = 356 * MiB;
constexpr size_t WS_TAPS = 404 * MiB;
constexpr size_t WS_HYT = 436 * MiB;
constexpr size_t WS_MIXED = 452 * MiB;
constexpr size_t WS_AFF = 484 * MiB;
constexpr size_t WS_IDX = 485 * MiB;
constexpr size_t WS_GATE = 486 * MiB;
constexpr size_t WS_SEL = 487 * MiB;
constexpr size_t WS_Z1T = 488 * MiB;
constexpr size_t WS_XG = WS_XT;
constexpr size_t WS_ACT = WS_UC;
constexpr size_t WS_YE = WS_TAPS;
constexpr size_t WS_END = 504 * MiB;

constexpr int LDS_BYTES = 163840, LDS_MISC_OFF = 163840 - 128;

#define GAS __attribute__((address_space(1)))
#define LAS __attribute__((address_space(3)))
typedef unsigned short bf16;
typedef unsigned v4u __attribute__((ext_vector_type(4)));
typedef unsigned v2u __attribute__((ext_vector_type(2)));
typedef float f32x4 __attribute__((ext_vector_type(4)));
#define LDS_WAIT() asm volatile("s_waitcnt lgkmcnt(0)" ::: "memory")
#define VM_WAIT() asm volatile("s_waitcnt vmcnt(0)" ::: "memory")
__device__ __forceinline__ unsigned f2bf(float f) { unsigned u = __builtin_bit_cast(unsigned, f); return (u + 0x7fffu + ((u >> 16) & 1u)) >> 16; }
__device__ __forceinline__ unsigned pk2(float lo, float hi) { unsigned r; asm("v_cvt_pk_bf16_f32 %0, %1, %2" : "=v"(r) : "v"(lo), "v"(hi)); return r; }
__device__ __forceinline__ float bf2f(unsigned h) { return __builtin_bit_cast(float, h << 16); }
__device__ __forceinline__ float bflo(unsigned w) { return __builtin_bit_cast(float, w << 16); }
__device__ __forceinline__ float bfhi(unsigned w) { return __builtin_bit_cast(float, w & 0xffff0000u); }
__device__ __forceinline__ float wave_sum(float v) {
#pragma unroll
    for (int o = 1; o < 64; o <<= 1) v += __shfl_xor(v, o);
    return v;
}


#define XB_TMO      128
#define XB_XCNT(j)  (256  + 64 * (j))
#define XB_XSUB(j)  (1280 + 64 * (j))
#define XB_XGEN(j)  (2304 + 64 * (j))
#define XB_TOP      3328
#define XB_TOPGEN   3392
#define XCD_BAR_WORDS 3456
#define XB_SPIN_CAP (1u << 22)
__device__ __forceinline__ unsigned xb_ld(unsigned* p)              { return __hip_atomic_load(p, __ATOMIC_RELAXED, __HIP_MEMORY_SCOPE_AGENT); }
__device__ __forceinline__ unsigned xb_add(unsigned* p, unsigned v) { return __hip_atomic_fetch_add(p, v, __ATOMIC_RELAXED, __HIP_MEMORY_SCOPE_AGENT); }
__device__ __forceinline__ unsigned xb_xcc_id() { return (unsigned)__builtin_amdgcn_s_getreg((3 << 11) | 20) & 0xFu; }
#define XB_SPIN(cond, bar) do { unsigned _sp = 0; while (cond) { __builtin_amdgcn_s_sleep(1); \
    if ((++_sp & 255u) == 0u) { if (xb_ld(&(bar)[XB_TMO])) break; if (_sp > XB_SPIN_CAP) { atomicAdd(&(bar)[XB_TMO], 1u); break; } } } } while (0)
struct XcdBarrier { unsigned* bar; unsigned x; volatile LAS unsigned* st; };
__device__ __forceinline__ XcdBarrier xcd_barrier_post(unsigned* bar, volatile LAS unsigned* st) {
    XcdBarrier b; b.bar = bar; b.x = xb_xcc_id(); b.st = st;
    if (threadIdx.x == 0) (void)xb_add(&bar[XB_XCNT(b.x)], 1u);
    return b;
}
__device__ __forceinline__ void xcd_barrier_complete(unsigned* bar, unsigned x, unsigned& nloc, unsigned& nx) {
    const unsigned G = gridDim.x * gridDim.y * gridDim.z;
    unsigned sum, cnt, mine, sp = 0u;
    for (;;) {
        sum = 0u; cnt = 0u; mine = 0u;
#pragma unroll
        for (unsigned j = 0; j < 16; ++j) { const unsigned c = xb_ld(&bar[XB_XCNT(j)]); sum += c; cnt += (c > 0u) ? 1u : 0u; mine = (j == x) ? c : mine; }
        if (sum == G) break;
        __builtin_amdgcn_s_sleep(1);
        if ((++sp & 255u) == 0u) { if (xb_ld(&bar[XB_TMO])) break; if (sp > XB_SPIN_CAP) { atomicAdd(&bar[XB_TMO], 1u); break; } }
    }
    nloc = mine > 0u ? mine : 1u; nx = cnt > 0u ? cnt : 1u;
}
__device__ __forceinline__ void xcd_barrier(const XcdBarrier& b) {
    asm volatile("s_waitcnt vmcnt(0)" ::: "memory");
    __syncthreads();
    if (threadIdx.x == 0) {
        unsigned* bar = b.bar;
        __builtin_amdgcn_s_waitcnt(0);
        unsigned nloc = b.st[0], nx = b.st[1];
        if (nloc == 0u) { xcd_barrier_complete(bar, b.x, nloc, nx); b.st[0] = nloc; b.st[1] = nx; }
        const unsigned old = xb_add(&bar[XB_XSUB(b.x)], 1u);
        const unsigned gen = old / nloc;
        if (old + 1u == (gen + 1u) * nloc) {
            __builtin_amdgcn_fence(__ATOMIC_RELEASE, "agent");
            asm volatile("s_waitcnt vmcnt(0)" ::: "memory");
            const unsigned og = xb_add(&bar[XB_TOP], 1u);
            const unsigned tg = og / nx;
            if (og + 1u == (tg + 1u) * nx) xb_add(&bar[XB_TOPGEN], 1u);
            else XB_SPIN(xb_ld(&bar[XB_TOPGEN]) == tg, bar);
            __builtin_amdgcn_fence(__ATOMIC_ACQUIRE, "agent");
            xb_add(&bar[XB_XGEN(b.x)], 1u);
            asm volatile("s_waitcnt vmcnt(0)" ::: "memory");
        } else {
            XB_SPIN(xb_ld(&bar[XB_XGEN(b.x)]) == gen, bar);
            __builtin_amdgcn_fence(__ATOMIC_ACQUIRE, "agent");
            asm volatile("s_waitcnt vmcnt(0)" ::: "memory");
        }
    }
    __syncthreads();
}

__device__ unsigned g_bar_words[XCD_BAR_WORDS + 64];
struct Frame {
    LAS unsigned char* lds;
    int tid, lane, wave, G, bid;
    const float* in[23]; float* out; unsigned char* ws;
};
#define GW_ID(F) ((F).bid * NWAVES + (F).wave)
#define GW_N(F) ((F).G * NWAVES)

__device__ __forceinline__ void p0_transpose_item(const float* W, int K, int N, bf16* WT, int row_base, int k0, int n0, LAS float* scr, int lane) {
    float t_[32];
#pragma unroll
    for (int i = 0; i < 32; ++i) { const int kk = 2 * i + (lane >> 5); t_[i] = W[(size_t)(k0 + kk) * N + n0 + (lane & 31)]; }
#pragma unroll
    for (int i = 0; i < 32; ++i) { const int kk = 2 * i + (lane >> 5); scr[kk * 33 + (lane & 31)] = t_[i]; }
    LDS_WAIT(); asm volatile("" ::: "memory");
    const int c = lane & 7;
#pragma unroll
    for (int j = 0; j < 4; ++j) { const int n = (lane >> 3) + 8 * j; const LAS float* s = scr + (8 * c) * 33 + n;
        v4u o; o.x = pk2(s[0 * 33], s[1 * 33]); o.y = pk2(s[2 * 33], s[3 * 33]); o.z = pk2(s[4 * 33], s[5 * 33]); o.w = pk2(s[6 * 33], s[7 * 33]);
        *(GAS v4u*)(WT + (size_t)(row_base + n) * K + k0 + 8 * c) = o; }
    LDS_WAIT(); asm volatile("" ::: "memory");
}
__device__ __forceinline__ void phase_p0(Frame& F) {
    LAS float* scr = (LAS float*)(F.lds + F.wave * 16384);
    const int gw = GW_ID(F), NGW = GW_N(F);
    bf16* WinT = (bf16*)(F.ws + WS_WIN); bf16* WoutT = (bf16*)(F.ws + WS_WOUT); bf16* W3T = (bf16*)(F.ws + WS_W3T);
    constexpr int I_IN = (DM / 64) * (INW / 32), I_OUT = (DM / 64) * (DM / 32), I_3 = 1 * (4096 / 32);
    constexpr int NITEMS = I_IN + I_OUT + I_3;
    for (int it = gw; it < NITEMS; it += NGW) {
        int r = it;
        if (r < I_IN) { const int nblk = INW / 32, kb = r / nblk, nb = r % nblk; p0_transpose_item(F.in[2], DM, INW, WinT, 32 * nb, 64 * kb, 32 * nb, scr, F.lane); continue; } r -= I_IN;
        if (r < I_OUT) { const int nblk = DM / 32, kb = r / nblk, nb = r % nblk; p0_transpose_item(F.in[17], DM, DM, WoutT, 32 * nb, 64 * kb, 32 * nb, scr, F.lane); continue; } r -= I_OUT;
        { const int nb = r; p0_transpose_item(F.in[12], FHID, 4096, W3T, 32 * nb, 0, 32 * nb, scr, F.lane); }
    }
    bf16* HB = (bf16*)(F.ws + WS_HB);
    const float* x = F.in[0]; const float* g = F.in[1];
    f32x4 vn[8];
    if (gw < MT) { const GAS f32x4* xr = (const GAS f32x4*)(x + (size_t)gw * DM) + F.lane;
#pragma unroll
        for (int j = 0; j < 8; ++j) vn[j] = xr[64 * j]; }
    for (int m = gw; m < MT; m += NGW) {
        f32x4 v[8]; float s = 0.f;
#pragma unroll
        for (int j = 0; j < 8; ++j) { v[j] = vn[j]; s += (v[j].x * v[j].x + v[j].y * v[j].y) + (v[j].z * v[j].z + v[j].w * v[j].w); }
        if (m + NGW < MT) { const GAS f32x4* xr = (const GAS f32x4*)(x + (size_t)(m + NGW) * DM) + F.lane;
#pragma unroll
            for (int j = 0; j < 8; ++j) vn[j] = xr[64 * j]; }
        const float r = rsqrtf(wave_sum(s) * (1.f / DM) + EPS);
        GAS v2u* o8 = (GAS v2u*)(HB + (size_t)m * DM) + F.lane;
#pragma unroll
        for (int j = 0; j < 8; ++j) { const f32x4 gg = *((const GAS f32x4*)g + F.lane + 64 * j); v2u o; o.x = pk2(v[j].x * r * gg.x, v[j].y * r * gg.y); o.y = pk2(v[j].z * r * gg.z, v[j].w * r * gg.w); o8[64 * j] = o; }
    }
    float* HID2 = (float*)(F.ws + WS_HID2);
    LAS float* sc2 = (LAS float*)(F.lds + F.wave * 16384);
    const float* w1 = F.in[8]; const float* b1 = F.in[9]; const float* w2 = F.in[10]; const float* b2 = F.in[11]; const float* fr = F.in[13];
    for (int l = gw; l < SEQ; l += NGW) {
        const int j = F.lane;
        float zv = 0.f;
        if (j == 0) zv = (float)l / (float)(SEQ - 1);
        else if (j < FEMB) { const int k = (j - 1) & 15; const float f = 1e-4f + (float)k * ((15.0f - 1e-4f) / 15.0f); const float wv = 6.283185307179586f * (float)l / (float)SEQ; zv = (j <= 16) ? cosf(f * wv) : -sinf(f * wv); }
        sc2[j] = zv; LDS_WAIT(); asm volatile("" ::: "memory");
        float a = b1[j];
        for (int i = 0; i < FEMB; ++i) a += sc2[i] * w1[i * FHID + j];
        const float h1 = sinf(fr[j] * a);
        sc2[64 + j] = h1; LDS_WAIT(); asm volatile("" ::: "memory");
        float c = b2[j];
        for (int i = 0; i < FHID; ++i) c += sc2[64 + i] * w2[i * FHID + j];
        HID2[l * FHID + j] = sinf(fr[j] * c);
        LDS_WAIT(); asm volatile("" ::: "memory");
    }
}

__device__ __forceinline__ void phase_filters_naive(Frame& F) {
    const float* HID2 = (const float*)(F.ws + WS_HID2); const float* w3 = F.in[12]; const float* fbias = F.in[14]; bf16* TAPS = (bf16*)(F.ws + WS_TAPS);
    const size_t total = (size_t)SEQ * 4096;
    for (size_t i = (size_t)F.bid * NTHREADS + F.tid; i < total; i += (size_t)F.G * NTHREADS) {
        const int col = (int)(i & 4095), l = (int)(i >> 12);
        float a = 0.f;
        for (int k = 0; k < FHID; ++k) a += HID2[l * FHID + k] * w3[(size_t)k * 4096 + col];
        const int c = col & 1023, dir = (col >> 10) & 1, o = col >> 11;
        const float mind = -4.605170185988091f / 1.5f, maxd = -4.605170185988091f / 0.3f;
        const float delta = fabsf(mind + (maxd - mind) * ((float)c / 1023.0f));
        const float t = (float)l / (float)(SEQ - 1);
        float v = a * expf(-t * delta);
        bf16* tp = TAPS + ((size_t)c * 2 + o) * 8192;
        if (dir == 0) { if (l == 0) v += fbias[o * 1024 + c]; tp[4096 + l] = (bf16)f2bf(v); }
        else { if (l > 0) tp[4096 - l] = (bf16)f2bf(v); else tp[0] = 0; }
    }
}
__device__ __forceinline__ void phase_hyena_naive(Frame& F, int o) {
    const bf16* UC = (const bf16*)(F.ws + WS_UC); const bf16* TAPS = (const bf16*)(F.ws + WS_TAPS);
    bf16* Z1T = (bf16*)(F.ws + WS_Z1T); bf16* HYT = (bf16*)(F.ws + WS_HYT);
    const bf16* Zin = o == 0 ? UC + (size_t)2048 * MT : Z1T; const bf16* gate = UC + (size_t)(o * 1024) * MT; bf16* OUT = o == 0 ? Z1T : HYT;
    const size_t total = (size_t)1024 * MT;
    for (size_t i = (size_t)F.bid * NTHREADS + F.tid; i < total; i += (size_t)F.G * NTHREADS) {
        const int c = (int)(i >> 13), m = (int)(i & 8191), b = m >> 12, t = m & 4095;
        const bf16* z = Zin + (size_t)c * MT + b * SEQ; const bf16* tp = TAPS + ((size_t)c * 2 + o) * 8192 + 4096 + t;
        float acc = 0.f;
        for (int s = 0; s < SEQ; ++s) acc += bf2f(tp[-s]) * bf2f(z[s]);
        OUT[(size_t)c * MT + m] = (bf16)f2bf(bf2f(gate[(size_t)c * MT + m]) * acc);
    }
}
__device__ __forceinline__ void phase_attn_naive(Frame& F) {
    const bf16* QK = (const bf16*)(F.ws + WS_QK); const bf16* VT = (const bf16*)(F.ws + WS_XT); bf16* MIXED = (bf16*)(F.ws + WS_MIXED);
    const float* rpb = F.in[5]; const float* og = F.in[15];
    const int lane = F.lane;
    for (int w = GW_ID(F); w < MT * NH; w += GW_N(F)) {
        const int m = w >> 3, h = w & 7, b = m / SEQ, s = m % SEQ, r = s / GW, c = s % GW;
        int kr0 = r - WR / 2; kr0 = kr0 < 0 ? 0 : (kr0 > NROWS - WR ? NROWS - WR : kr0);
        int c0 = c - WC / 2; c0 = c0 < 0 ? 0 : (c0 > GW - WC ? GW - WC : c0);
        const bf16* q = QK + (size_t)m * 2048 + h * HD;
        const float q0 = bf2f(q[lane]), q1 = bf2f(q[lane + 64]);
        float mx = -INFINITY, l = 0.f, a0 = 0.f, a1 = 0.f;
        for (int i = 0; i < WR; ++i) for (int j = 0; j < WC; ++j) {
            const int kr = kr0 + i, kc = c0 + j; const size_t km = (size_t)b * SEQ + kr * GW + kc;
            const bf16* kp = QK + km * 2048 + 1024 + h * HD;
            const float d = wave_sum(q0 * bf2f(kp[lane]) + q1 * bf2f(kp[lane + 64]));
            const int dr = kr - r + WR - 1; int dc = kc - c + WC - 1; dc = dc < 0 ? 0 : (dc > 2 * WC - 2 ? 2 * WC - 2 : dc);
            const float sc = d * 0.08838834764831845f + rpb[(h * (2 * WR - 1) + dr) * (2 * WC - 1) + dc];
            const float mn = fmaxf(mx, sc), corr = __expf(mx - mn), pw = __expf(sc - mn);
            const float v0 = bf2f(VT[(size_t)(h * HD + lane) * MT + km]), v1 = bf2f(VT[(size_t)(h * HD + lane + 64) * MT + km]);
            l = l * corr + pw; a0 = a0 * corr + pw * v0; a1 = a1 * corr + pw * v1; mx = mn;
        }
        a0 /= l; a1 /= l;
        const float rr = rsqrtf(wave_sum(a0 * a0 + a1 * a1) * (1.f / HD) + EPS);
        bf16* o = MIXED + (size_t)m * DM + h * HD;
        o[lane] = (bf16)f2bf(a0 * rr * og[h * HD + lane]); o[lane + 64] = (bf16)f2bf(a1 * rr * og[h * HD + lane + 64]);
    }
}


typedef short bf16x8 __attribute__((ext_vector_type(8)));
typedef float f32x16 __attribute__((ext_vector_type(16)));
__device__ __forceinline__ void phase_filters(Frame& F) {
    const float* HID2 = (const float*)(F.ws + WS_HID2); const bf16* W3T = (const bf16*)(F.ws + WS_W3T); const float* fbias = F.in[14]; bf16* TAPS = (bf16*)(F.ws + WS_TAPS);
    const int n = F.lane & 31, hh = F.lane >> 5;
    const float mind = -4.605170185988091f / 1.5f, maxd = -4.605170185988091f / 0.3f;
    LAS bf16* scr = (LAS bf16*)(F.lds + F.wave * 4096);
    for (int task = GW_ID(F); task < 128 * 16; task += GW_N(F)) {
        const int l0 = (task & 127) * 32, cg = task >> 7;
        const int dir = (cg >> 2) & 1, o = cg >> 3;
        const int l = l0 + dir + n;
        bf16x8 hb[4];
        { const int lr = l < SEQ ? l : SEQ - 1;
#pragma unroll
          for (int ks = 0; ks < 4; ++ks) { const GAS f32x4* hp = (const GAS f32x4*)(HID2 + (size_t)lr * FHID + 16 * ks + 8 * hh); const f32x4 h0 = hp[0], h1 = hp[1];
              v4u bw; bw.x = pk2(h0.x, h0.y); bw.y = pk2(h0.z, h0.w); bw.z = pk2(h1.x, h1.y); bw.w = pk2(h1.z, h1.w); hb[ks] = __builtin_bit_cast(bf16x8, bw); } }
        const float t = (float)l / (float)(SEQ - 1);
        const int pos = dir ? 31 - n : n;
        const int idx0 = dir ? 4064 - l0 : 4096 + l0;
#pragma unroll 2
        for (int ct = 0; ct < 8; ++ct) {
            const int col0 = (cg * 8 + ct) * 32;
            f32x16 acc;
#pragma unroll
            for (int i = 0; i < 16; ++i) acc[i] = 0.f;
#pragma unroll
            for (int ks = 0; ks < 4; ++ks) { const bf16x8 a = *(const GAS bf16x8*)(W3T + (size_t)(col0 + n) * FHID + 16 * ks + 8 * hh);
                acc = __builtin_amdgcn_mfma_f32_32x32x16_bf16(a, hb[ks], acc, 0, 0, 0); }
#pragma unroll
            for (int i = 0; i < 16; ++i) {
                const int chl = (i & 3) + 8 * (i >> 2) + 4 * hh, c = (col0 & 1023) + chl;
                const float delta = fabsf(mind + (maxd - mind) * ((float)c / 1023.0f));
                float v = acc[i] * __expf(-t * delta);
                if (dir == 0 && l == 0) v += fbias[o * 1024 + c];
                if (l >= SEQ) v = 0.f;
                scr[chl * 40 + pos] = (bf16)f2bf(v);
            }
            LDS_WAIT(); asm volatile("" ::: "memory");
#pragma unroll
            for (int j = 0; j < 2; ++j) { const int id = F.lane + 64 * j, chl = id >> 2, q = id & 3;
                const v4u w = *(const LAS v4u*)(scr + chl * 40 + 8 * q);
                *(GAS v4u*)(TAPS + ((size_t)((col0 & 1023) + chl) * 2 + o) * 8192 + idx0 + 8 * q) = w; }
            LDS_WAIT(); asm volatile("" ::: "memory");
        }
    }
}

constexpr int HY_TAPS_BYTES = 4 * 16384, HY_ZB_ENT = 6080, HY_ZB_BYTES = HY_ZB_ENT * 2;
__device__ __forceinline__ unsigned hy_zb_off(int idx0  ) { const int q = idx0 >> 3; return (unsigned)((q ^ ((q >> 4) & 3)) << 4); }
__device__ __forceinline__ const LAS unsigned char* hy_pm(const LAS unsigned char* zb0, int g, int n, int hh) {
    const int q0 = 124 - 4 * n + 2 * g + hh;
    unsigned p = (unsigned)(size_t)zb0 + (unsigned)(((q0 ^ ((q0 >> 4) & 3)) << 4) - 6144);
    asm volatile("" : "+v"(p));
    return (const LAS unsigned char*)(size_t)p;
}
template <int MASK>
__device__ __forceinline__ void hy_loadB(bf16x8 (&bf)[4], const LAS unsigned char* pm, int b) {
#pragma unroll
    for (int tau = 0; tau < 4; ++tau) if (MASK & (1 << tau)) bf[tau] = *(const LAS bf16x8*)(pm + 2048 * (3 - tau) + b * HY_ZB_BYTES);
}
__device__ __forceinline__ void hy_loadA(unsigned (&d)[5], const LAS bf16* taps, int g, int n, int hh) {
    const volatile LAS unsigned* dp = (const volatile LAS unsigned*)taps + ((1 + 8 * hh + n) >> 1) + 8 * g;
#pragma unroll
    for (int i = 0; i < 5; ++i) d[i] = dp[i];
}
template <int MASK>
__device__ __forceinline__ void hy_mma(f32x16 (&acc)[4], const bf16x8 a, const bf16x8 (&bf)[4]) {
#pragma unroll
    for (int tau = 0; tau < 4; ++tau) if (MASK & (1 << tau)) acc[tau] = __builtin_amdgcn_mfma_f32_32x32x16_bf16(a, bf[tau], acc[tau], 0, 0, 0);
}
#define HY_ALIGN(a, d) do { v4u aw_; aw_.x = __builtin_amdgcn_alignbyte(d[1], d[0], sh); aw_.y = __builtin_amdgcn_alignbyte(d[2], d[1], sh); aw_.z = __builtin_amdgcn_alignbyte(d[3], d[2], sh); aw_.w = __builtin_amdgcn_alignbyte(d[4], d[3], sh); a = __builtin_bit_cast(bf16x8, aw_); } while (0)
#define HY_INTERLEAVE(nv, nds) do { __builtin_amdgcn_sched_group_barrier(0x2, nv, 0); _Pragma("unroll") for (int i_ = 0; i_ < 5; ++i_) { __builtin_amdgcn_sched_group_barrier(0x8, 1, 0); __builtin_amdgcn_sched_group_barrier(0x100, nds, 0); __builtin_amdgcn_sched_group_barrier(0x2, 2, 0); } } while (0)
constexpr int HY_YOFF = 254;
template <int MX, int MY>
__device__ __forceinline__ void hy_segment(f32x16 (&acc)[2][4], const LAS bf16* taps, const LAS unsigned char* zb0, int i0, int i1, int n, int hh) {
    const unsigned sh = (n & 1) ? 0u : 2u;
    unsigned dx[5], dy[5]; bf16x8 ax, ay, x0[4], y0[4], x1[4], y1[4];
    const LAS unsigned char* pmx = hy_pm(zb0, i0, n, hh); const LAS unsigned char* pmy = hy_pm(zb0, i0 + HY_YOFF, n, hh);
    hy_loadA(dx, taps, i0, n, hh); hy_loadA(dy, taps, i0 + HY_YOFF, n, hh); hy_loadB<MX>(x0, pmx, 0); hy_loadB<MY>(y0, pmy, 0);
#pragma unroll 1
    for (int i = i0; i < i1; ++i) {
        HY_ALIGN(ax, dx); HY_ALIGN(ay, dy);
        hy_loadB<MX>(x1, pmx, 1); hy_loadB<MY>(y1, pmy, 1);
        hy_mma<MX>(acc[0], ax, x0); hy_mma<MY>(acc[0], ay, y0);
        HY_INTERLEAVE(8, 1); __builtin_amdgcn_sched_barrier(0);
        hy_loadA(dx, taps, i + 1, n, hh); hy_loadA(dy, taps, i + 1 + HY_YOFF, n, hh);
        pmx = hy_pm(zb0, i + 1, n, hh); pmy = hy_pm(zb0, i + 1 + HY_YOFF, n, hh);
        hy_loadB<MX>(x0, pmx, 0); hy_loadB<MY>(y0, pmy, 0);
        hy_mma<MX>(acc[1], ax, x1); hy_mma<MY>(acc[1], ay, y1);
        HY_INTERLEAVE(0, 3); __builtin_amdgcn_sched_barrier(0);
    }
}
__device__ __forceinline__ void hy_stage_taps(Frame& F, int c0, int o) {
    const bf16* TAPS = (const bf16*)(F.ws + WS_TAPS);
    int tid = F.tid; asm volatile("" : "+v"(tid));
#pragma unroll
    for (int j = 0; j < 8; ++j) { const int ch = tid + NTHREADS * j, ci = ch >> 10, w = ch & 1023;
        *((LAS v4u*)(F.lds) + ch) = *((const GAS v4u*)(TAPS + ((size_t)(c0 + ci) * 2 + o) * 8192) + w); }
}
struct ConvItem { const float* W; bf16* WTe; int N, row_base, k0, n0; };
__device__ __forceinline__ void conv_load64(float (&v)[64], const ConvItem& c, int lane) {
    const GAS float* src = (const GAS float*)(c.W + (size_t)c.k0 * c.N + c.n0 + lane);
#pragma unroll
    for (int kk = 0; kk < 64; ++kk) v[kk] = src[(size_t)kk * c.N];
}
__device__ __forceinline__ void conv_store64(const float (&v)[64], const ConvItem& c, int lane) {
    GAS v4u* dst = (GAS v4u*)c.WTe + (size_t)(c.k0 >> 3) * 2048 + c.row_base + lane;
#pragma unroll
    for (int j = 0; j < 8; ++j) { v4u o; o.x = pk2(v[8 * j], v[8 * j + 1]); o.y = pk2(v[8 * j + 2], v[8 * j + 3]); o.z = pk2(v[8 * j + 4], v[8 * j + 5]); o.w = pk2(v[8 * j + 6], v[8 * j + 7]); dst[(size_t)j * 2048] = o; }
}
constexpr int MOE_ITEMS_GU = 2 * NE * 32 * 16, MOE_ITEMS_D = NE * 16 * 32, MOE_ITEMS = MOE_ITEMS_GU + MOE_ITEMS_D;
#ifndef MOE_P0_ITEMS
#define MOE_P0_ITEMS 0
#endif
constexpr int MOE_HELP_ITEMS = MOE_ITEMS - MOE_P0_ITEMS;
__device__ __forceinline__ ConvItem moe_item(Frame& F, int it) {
    bf16* WguT = (bf16*)(F.ws + WS_WGU); bf16* WdT = (bf16*)(F.ws + WS_WD); ConvItem c;
    if (it < MOE_ITEMS_GU) { const int which = it >> 13, e = (it >> 9) & 15, kb = (it >> 4) & 31, nb = it & 15, f0 = 64 * nb;
        c.W = (which ? F.in[21] : F.in[20]) + (size_t)e * DM * FF; c.N = FF; c.WTe = WguT + (size_t)e * 2048 * DM; c.row_base = (f0 >> 7) * 256 + which * 128 + (f0 & 127); c.k0 = 64 * kb; c.n0 = f0;
    } else { const int r = it - MOE_ITEMS_GU, e = r >> 9, kb = (r >> 5) & 15, nb = r & 31;
        c.W = F.in[22] + (size_t)e * FF * DM; c.N = DM; c.WTe = WdT + (size_t)e * 2048 * FF; c.row_base = 64 * nb; c.k0 = 64 * kb; c.n0 = 64 * nb; }
    return c;
}
__device__ __forceinline__ void moe_conv_item(Frame& F, int it) { float v[64]; const ConvItem c = moe_item(F, it); conv_load64(v, c, F.lane); conv_store64(v, c, F.lane); }
__device__ __forceinline__ void moe_conv_range(Frame& F, int lo, int hi, int step) {
    if (lo >= hi) return;
    float va[64], vb[64];
    ConvItem ca = moe_item(F, lo), cb_; conv_load64(va, ca, F.lane);
    for (int it = lo; it < hi; it += 2 * step) {
        const bool hb = it + step < hi;
        if (hb) { cb_ = moe_item(F, it + step); conv_load64(vb, cb_, F.lane); }
        conv_store64(va, ca, F.lane);
        const bool ha = it + 2 * step < hi;
        if (ha) { ca = moe_item(F, it + 2 * step); conv_load64(va, ca, F.lane); }
        if (hb) conv_store64(vb, cb_, F.lane);
    }
}
__device__ __forceinline__ void hy_write_gates(Frame& F, int c0, int oo) {
    const bf16* XH = (const bf16*)(F.ws + WS_XT) + (size_t)1024 * MT; bf16* GC = (bf16*)(F.ws + WS_UC);
    const float* cw = F.in[6]; const float* cb = F.in[7];
    const int ht = F.tid - 256;
#pragma unroll 2
    for (int k = 0; k < 16; ++k) { const int id = ht + 256 * k, u = id & 511, b = (id >> 9) & 1, ci = id >> 10;
        const int gch = oo * 1024 + c0 + ci; const bf16* gs = XH + (size_t)gch * MT + b * SEQ;
        const float w0 = cw[gch], w1 = cw[3072 + gch], w2 = cw[6144 + gch], bb = cb[gch];
        const v4u w = *((const GAS v4u*)gs + u);
        float f[10];
        f[1] = bflo(w.x); f[2] = bfhi(w.x); f[3] = bflo(w.y); f[4] = bfhi(w.y); f[5] = bflo(w.z); f[6] = bfhi(w.z); f[7] = bflo(w.w); f[8] = bfhi(w.w);
        f[0] = u > 0 ? bf2f(gs[8 * u - 1]) : 0.f; f[9] = u < 511 ? bf2f(gs[8 * u + 8]) : 0.f;
        float z[8];
#pragma unroll
        for (int e = 0; e < 8; ++e) z[e] = bb + w0 * f[e] + w1 * f[e + 1] + w2 * f[e + 2];
        v4u r; r.x = pk2(z[0], z[1]); r.y = pk2(z[2], z[3]); r.z = pk2(z[4], z[5]); r.w = pk2(z[6], z[7]);
        *((GAS v4u*)(GC + ((size_t)((c0 + ci) * 2 + oo) * 2 + b) * SEQ) + u) = r; }
}
__device__ __forceinline__ void phase_hyena(Frame& F) {
    const bf16* XH = (const bf16*)(F.ws + WS_XT) + (size_t)1024 * MT;
    const float* cw = F.in[6]; const float* cb = F.in[7];
    bf16* HYT = (bf16*)(F.ws + WS_HYT); bf16* GC = (bf16*)(F.ws + WS_UC);
    const int n = F.lane & 31, hh = F.lane >> 5;
    const bool compute = F.wave < 4;
    const int nhelp = F.G * 4, hw = F.bid * 4 + (F.wave - 4);
    int sec = 0;
    for (int cg = F.bid; cg < 256; cg += F.G) {
        const int c0 = cg * 4;
        __syncthreads();
        hy_stage_taps(F, c0, 0);
        {
          const int ci = F.wave >> 1, b = F.wave & 1; LAS unsigned char* zb = F.lds + HY_TAPS_BYTES + F.wave * HY_ZB_BYTES;
          const int zch = 2048 + c0 + ci; const bf16* zsrc = XH + (size_t)zch * MT + b * SEQ;
          const float w0 = cw[zch], w1 = cw[3072 + zch], w2 = cw[6144 + zch], bb = cb[zch];
#pragma unroll
          for (int j = 0; j < 8; ++j) { const int u = F.lane + 64 * j; const v4u w = *((const GAS v4u*)zsrc + u);
              float f[10];
              f[1] = bflo(w.x); f[2] = bfhi(w.x); f[3] = bflo(w.y); f[4] = bfhi(w.y); f[5] = bflo(w.z); f[6] = bfhi(w.z); f[7] = bflo(w.w); f[8] = bfhi(w.w);
              f[0] = u > 0 ? bf2f(zsrc[8 * u - 1]) : 0.f; f[9] = u < 511 ? bf2f(zsrc[8 * u + 8]) : 0.f;
              float z[8];
#pragma unroll
              for (int e = 0; e < 8; ++e) z[e] = bb + w0 * f[e] + w1 * f[e + 1] + w2 * f[e + 2];
              v4u r; r.x = pk2(z[7], z[6]); r.y = pk2(z[5], z[4]); r.z = pk2(z[3], z[2]); r.w = pk2(z[1], z[0]);
              *(LAS v4u*)(zb + hy_zb_off(8 * (635 - u))) = r; }
          const v4u zero = {0u, 0u, 0u, 0u};
          for (int q = F.lane; q < 124; q += 64) { *(LAS v4u*)(zb + hy_zb_off(8 * q)) = zero; *(LAS v4u*)(zb + hy_zb_off(8 * (636 + q))) = zero; } }
        if (!compute) hy_write_gates(F, c0, 0);
        __syncthreads();
#pragma unroll 1
        for (int o = 0; o < 2; ++o) {
            if (compute) {
                const int ci = F.wave, c = c0 + ci;
                const LAS bf16* taps = (const LAS bf16*)(F.lds + ci * 16384);
                LAS unsigned char* zb0 = F.lds + HY_TAPS_BYTES + (2 * ci) * HY_ZB_BYTES;
                f32x16 acc[2][4];
#pragma unroll
                for (int b = 0; b < 2; ++b)
#pragma unroll
                    for (int tau = 0; tau < 4; ++tau)
#pragma unroll
                        for (int i = 0; i < 16; ++i) acc[b][tau][i] = 0.f;
                hy_segment<1, 15>(acc, taps, zb0, 0, 64, n, hh);
                hy_segment<3, 14>(acc, taps, zb0, 64, 128, n, hh);
                hy_segment<7, 12>(acc, taps, zb0, 128, 192, n, hh);
                hy_segment<15, 8>(acc, taps, zb0, 192, 254, n, hh);
                hy_segment<0, 8>(acc, taps, zb0, 254, 256, n, hh);
                LDS_WAIT();
                int n2 = n, h2 = hh; asm volatile("" : "+v"(n2), "+v"(h2));
#pragma unroll
                for (int b = 0; b < 2; ++b) {
                    const bf16* gate = GC + ((size_t)(c * 2 + o) * 2 + b) * SEQ;
                    LAS unsigned char* zb = zb0 + b * HY_ZB_BYTES; bf16* outp = HYT + (size_t)c * MT + b * SEQ;
                    v2u gw[4][4];
#pragma unroll
                    for (int tau = 0; tau < 4; ++tau)
#pragma unroll
                        for (int rg = 0; rg < 4; ++rg) gw[tau][rg] = *(const GAS v2u*)(gate + 1024 * tau + 32 * n2 + 8 * rg + 4 * h2);
#pragma unroll
                    for (int tau = 0; tau < 4; ++tau) {
#pragma unroll
                        for (int rg = 0; rg < 4; ++rg) { const int t0 = 1024 * tau + 32 * n2 + 8 * rg + 4 * h2;
                            const float z0 = bflo(gw[tau][rg].x) * acc[b][tau][4 * rg + 0], z1 = bfhi(gw[tau][rg].x) * acc[b][tau][4 * rg + 1], z2 = bflo(gw[tau][rg].y) * acc[b][tau][4 * rg + 2], z3 = bfhi(gw[tau][rg].y) * acc[b][tau][4 * rg + 3];
                            if (o == 0) { v2u w; w.x = pk2(z3, z2); w.y = pk2(z1, z0);
                                *(LAS v2u*)(zb + hy_zb_off(8 * (635 - (t0 >> 3))) + (h2 ? 0 : 8)) = w; }
                            else { v2u w; w.x = pk2(z0, z1); w.y = pk2(z2, z3); *(GAS v2u*)(outp + t0) = w; } } }
                }
            } else {
                if (o == 0) hy_write_gates(F, c0, 1);
                const int lo_it = MOE_P0_ITEMS + sec * (MOE_HELP_ITEMS / 2), hi_it = lo_it + MOE_HELP_ITEMS / 2;
                if (sec < 2) moe_conv_range(F, lo_it + hw, hi_it, nhelp);
            }
            ++sec;
            if (o == 0) {
                __syncthreads();
                hy_stage_taps(F, c0, 1);
                __syncthreads();
            }
        }
    }
    for (; sec < 2; ++sec) if (!compute) { const int lo_it = MOE_P0_ITEMS + sec * (MOE_HELP_ITEMS / 2), hi_it = lo_it + MOE_HELP_ITEMS / 2; moe_conv_range(F, lo_it + hw, hi_it, nhelp); }
    __syncthreads();
}

__device__ __forceinline__ void phase_attn(Frame& F) {
    const bf16* QK = (const bf16*)(F.ws + WS_QK); const bf16* VT = (const bf16*)(F.ws + WS_XT); bf16* MIXED = (bf16*)(F.ws + WS_MIXED);
    const float* rpb = F.in[5]; const float* og = F.in[15];
    LAS float* rp = (LAS float*)(F.lds + F.wave * 2048);
    const int n = F.lane & 31, hh = F.lane >> 5;
    for (int task = GW_ID(F); task < NB * NH * NROWS * 2; task += GW_N(F)) {
        const int wq = task & 1, r = (task >> 1) & 63, h = (task >> 7) & 7, b = task >> 10;
        for (int i = F.lane; i < 15 * 31; i += 64) rp[i] = rpb[h * 465 + i];
        const int mq = b * SEQ + r * GW + 32 * wq + n, qc = 32 * wq + n;
        int c0 = qc - WC / 2; c0 = c0 < 0 ? 0 : (c0 > GW - WC ? GW - WC : c0);
        int kr0 = r - WR / 2; kr0 = kr0 < 0 ? 0 : (kr0 > NROWS - WR ? NROWS - WR : kr0);
        bf16x8 qf[8];
#pragma unroll
        for (int ks = 0; ks < 8; ++ks) qf[ks] = *(const GAS bf16x8*)(QK + (size_t)mq * 2048 + h * HD + 16 * ks + 8 * hh);
        f32x16 O[4];
#pragma unroll
        for (int dt = 0; dt < 4; ++dt)
#pragma unroll
            for (int i = 0; i < 16; ++i) O[dt][i] = 0.f;
        float lsum = 0.f;
        LDS_WAIT();
#pragma unroll 1
        for (int tile = 0; tile < 16; ++tile) {
            const int kr = kr0 + (tile >> 1), kt = tile & 1, dr = kr - r + WR - 1;
            const int mk0 = b * SEQ + kr * GW + 32 * kt;
            f32x16 S;
#pragma unroll
            for (int i = 0; i < 16; ++i) S[i] = 0.f;
#pragma unroll
            for (int ks = 0; ks < 8; ++ks) { const bf16x8 kf = *(const GAS bf16x8*)(QK + (size_t)(mk0 + n) * 2048 + 1024 + h * HD + 16 * ks + 8 * hh);
                S = __builtin_amdgcn_mfma_f32_32x32x16_bf16(kf, qf[ks], S, 0, 0, 0); }
            float p[16];
#pragma unroll
            for (int i = 0; i < 16; ++i) { const int kc = 32 * kt + (i & 3) + 8 * (i >> 2) + 4 * hh; const bool valid = (kc >= c0) && (kc < c0 + WC);
                int dc = kc - qc + WC - 1; dc = dc < 0 ? 0 : (dc > 2 * WC - 2 ? 2 * WC - 2 : dc);
                const float e = __expf(S[i] * 0.08838834764831845f + rp[dr * 31 + dc]); p[i] = valid ? e : 0.f; lsum += p[i]; }
            v4u pw0, pw1;
            pw0.x = pk2(p[0], p[1]); pw0.y = pk2(p[2], p[3]); pw0.z = pk2(p[4], p[5]); pw0.w = pk2(p[6], p[7]);
            pw1.x = pk2(p[8], p[9]); pw1.y = pk2(p[10], p[11]); pw1.z = pk2(p[12], p[13]); pw1.w = pk2(p[14], p[15]);
            const bf16x8 pf0 = __builtin_bit_cast(bf16x8, pw0), pf1 = __builtin_bit_cast(bf16x8, pw1);
#pragma unroll
            for (int dt = 0; dt < 4; ++dt) {
                const bf16* vrow = VT + (size_t)(h * HD + 32 * dt + n) * MT + mk0 + 4 * hh;
                const v2u a0 = *(const GAS v2u*)(vrow), a1 = *(const GAS v2u*)(vrow + 8), a2 = *(const GAS v2u*)(vrow + 16), a3 = *(const GAS v2u*)(vrow + 24);
                v4u f0, f1; f0.x = a0.x; f0.y = a0.y; f0.z = a1.x; f0.w = a1.y; f1.x = a2.x; f1.y = a2.y; f1.z = a3.x; f1.w = a3.y;
                O[dt] = __builtin_amdgcn_mfma_f32_32x32x16_bf16(__builtin_bit_cast(bf16x8, f0), pf0, O[dt], 0, 0, 0);
                O[dt] = __builtin_amdgcn_mfma_f32_32x32x16_bf16(__builtin_bit_cast(bf16x8, f1), pf1, O[dt], 0, 0, 0);
            }
        }
        lsum += __shfl_xor(lsum, 32);
        const float il = 1.f / lsum;
        float ss = 0.f;
#pragma unroll
        for (int dt = 0; dt < 4; ++dt)
#pragma unroll
            for (int i = 0; i < 16; ++i) { O[dt][i] *= il; ss += O[dt][i] * O[dt][i]; }
        ss += __shfl_xor(ss, 32);
        const float rr = rsqrtf(ss * (1.f / HD) + EPS);
        bf16* orow = MIXED + (size_t)mq * DM + h * HD;
#pragma unroll
        for (int dt = 0; dt < 4; ++dt)
#pragma unroll
            for (int rg = 0; rg < 4; ++rg) { const int d = 32 * dt + 8 * rg + 4 * hh; const f32x4 gg = *(const GAS f32x4*)(og + h * HD + d);
                v2u w; w.x = pk2(O[dt][4 * rg + 0] * rr * gg.x, O[dt][4 * rg + 1] * rr * gg.y); w.y = pk2(O[dt][4 * rg + 2] * rr * gg.z, O[dt][4 * rg + 3] * rr * gg.w);
                *(GAS v2u*)(orow + d) = w; }
        LDS_WAIT();
    }
}


constexpr int AT_KBYTES = 16384, AT_VPITCH = 136, AT_VBYTES = 128 * AT_VPITCH, AT_STAGE = AT_KBYTES + AT_VBYTES, AT_RP_OFF = 2 * AT_STAGE;
__device__ __forceinline__ void phase_attn2(Frame& F) {
    const bf16* QK = (const bf16*)(F.ws + WS_QK); const bf16* VT = (const bf16*)(F.ws + WS_XT); bf16* MIXED = (bf16*)(F.ws + WS_MIXED);
    const float* rpb = F.in[5]; const float* og = F.in[15]; const float* qg = F.in[3]; const float* kg = F.in[4];
    LAS float* rt = (LAS float*)(F.lds + AT_RP_OFF);
    LAS float* gtab = (LAS float*)(F.lds + AT_RP_OFF + 8 * 2048);
    if (F.tid < HD) gtab[F.tid] = qg[F.tid] * kg[F.tid];
    const int n = F.lane & 31, hh = F.lane >> 5;
    for (int unit = F.bid; unit < NB * NH * 16; unit += F.G) {
        const int rq = unit & 15, h = (unit >> 4) & 7, b = unit >> 7, r0 = 4 * rq;
        const int r = r0 + (F.wave >> 1), wq = F.wave & 1;
        int kmin = r0 - WR / 2; kmin = kmin < 0 ? 0 : (kmin > NROWS - WR ? NROWS - WR : kmin);
        int kmax = r0 + 3 - WR / 2; kmax = (kmax < 0 ? 0 : (kmax > NROWS - WR ? NROWS - WR : kmax)) + WR - 1;
        int kr0 = r - WR / 2; kr0 = kr0 < 0 ? 0 : (kr0 > NROWS - WR ? NROWS - WR : kr0);
        const int nrows = kmax - kmin + 1;
        __syncthreads();
        for (int i = F.tid; i < 15 * 128; i += NTHREADS) { const int dr_ = i >> 7, dcx = (i & 127) - 48; rt[i] = (dcx >= 0 && dcx <= 30) ? rpb[h * 465 + dr_ * 31 + dcx] * 1.4426950408889634f : 0.f; }
        const int mq = b * SEQ + r * GW + 32 * wq + n, qc = 32 * wq + n;
        int c0 = qc - WC / 2; c0 = c0 < 0 ? 0 : (c0 > GW - WC ? GW - WC : c0);
        bf16x8 qf[8];
#pragma unroll
        for (int ks = 0; ks < 8; ++ks) qf[ks] = *(const GAS bf16x8*)(QK + (size_t)mq * 2048 + h * HD + 16 * ks + 8 * hh);
        float qscale;
        {
          f32x16 D;
#pragma unroll
          for (int i = 0; i < 16; ++i) D[i] = 0.f;
#pragma unroll
          for (int ks = 0; ks < 8; ++ks) D = __builtin_amdgcn_mfma_f32_32x32x16_bf16(qf[ks], qf[ks], D, 0, 0, 0);
          float dsel = 0.f; const int isel = (n & 3) + 4 * (n >> 3);
#pragma unroll
          for (int i = 0; i < 16; ++i) dsel = (i == isel) ? D[i] : dsel;
          const float other = __shfl_xor(dsel, 32);
          const float ssq = (((n >> 2) & 1) == hh) ? dsel : other;
          qscale = (0.08838834764831845f * 1.4426950408889634f) * rsqrtf(ssq * (1.f / HD) + EPS); }
        const unsigned long long wmask = (c0 >= 4 * hh) ? (0xFFFFull << (c0 - 4 * hh)) : (0xFFFFull >> (4 * hh - c0));
        const unsigned wm0 = (unsigned)wmask, wm1 = (unsigned)(wmask >> 32);
        const int rtl = 4 * hh - qc + 63;
        f32x16 O[4];
#pragma unroll
        for (int dt = 0; dt < 4; ++dt)
#pragma unroll
            for (int i = 0; i < 16; ++i) O[dt][i] = 0.f;
        float lsum = 0.f;
        v4u sk[2], sv[2];

        auto gload = [&](int kr) {
#pragma unroll
            for (int j = 0; j < 2; ++j) { const int id = F.tid + 512 * j;
                sk[j] = *(const GAS v4u*)(QK + (size_t)(b * SEQ + kr * GW + (id >> 4)) * 2048 + 1024 + h * HD + 8 * (id & 15));
                sv[j] = *(const GAS v4u*)(VT + (size_t)(h * HD + (id >> 3)) * MT + b * SEQ + kr * GW + 8 * (id & 7)); }
        };
        auto lstore = [&](int buf) {
            LAS unsigned char* kb = F.lds + buf * AT_STAGE; LAS unsigned char* vb = kb + AT_KBYTES;
#pragma unroll
            for (int j = 0; j < 2; ++j) { const int id = F.tid + 512 * j; const int key = id >> 4, c = id & 15;
                float f[8] = {bflo(sk[j].x), bfhi(sk[j].x), bflo(sk[j].y), bfhi(sk[j].y), bflo(sk[j].z), bfhi(sk[j].z), bflo(sk[j].w), bfhi(sk[j].w)};
                float ss = 0.f;
#pragma unroll
                for (int e = 0; e < 8; ++e) ss += f[e] * f[e];
                ss += __shfl_xor(ss, 1); ss += __shfl_xor(ss, 2); ss += __shfl_xor(ss, 4); ss += __shfl_xor(ss, 8);
                const float rk = rsqrtf(ss * (1.f / HD) + EPS);
                const f32x4 ga = *(const LAS f32x4*)(gtab + 8 * c), gb = *(const LAS f32x4*)(gtab + 8 * c + 4);
                v4u kn; kn.x = pk2(f[0] * rk * ga.x, f[1] * rk * ga.y); kn.y = pk2(f[2] * rk * ga.z, f[3] * rk * ga.w); kn.z = pk2(f[4] * rk * gb.x, f[5] * rk * gb.y); kn.w = pk2(f[6] * rk * gb.z, f[7] * rk * gb.w);
                *(LAS v4u*)(kb + key * 256 + ((c ^ (key & 15)) << 4)) = kn;
                const int d = id >> 3, cv = id & 7; LAS v2u* vp = (LAS v2u*)(vb + d * AT_VPITCH + cv * 16);
                v2u lo, hi; lo.x = sv[j].x; lo.y = sv[j].y; hi.x = sv[j].z; hi.y = sv[j].w; vp[0] = lo; vp[1] = hi; }
        };
        gload(kmin); lstore(0);
        __syncthreads();
#pragma unroll 1
        for (int j = 0; j < nrows; ++j) {
            const int kr = kmin + j, buf = j & 1;
            if (j + 1 < nrows) gload(kr + 1);
            if (kr >= kr0 && kr < kr0 + WR) {
                const LAS unsigned char* kb = F.lds + buf * AT_STAGE; const LAS unsigned char* vb = kb + AT_KBYTES;
                const int dr = kr - r + WR - 1;
                const LAS float* rrow = rt + dr * 128 + rtl;
#pragma unroll
                for (int kt = 0; kt < 2; ++kt) {
                    f32x16 S;
#pragma unroll
                    for (int i = 0; i < 16; ++i) S[i] = 0.f;
                    const int key = 32 * kt + n;
#pragma unroll
                    for (int ks = 0; ks < 8; ++ks) { const bf16x8 kf = *(const LAS bf16x8*)(kb + key * 256 + (((2 * ks + hh) ^ (key & 15)) << 4));
                        S = __builtin_amdgcn_mfma_f32_32x32x16_bf16(kf, qf[ks], S, 0, 0, 0); }
                    float p[16];
#pragma unroll
                    for (int i = 0; i < 16; ++i) { const int E = (i & 3) + 8 * (i >> 2);
                        const float e = __builtin_amdgcn_exp2f(S[i] * qscale + rrow[32 * kt + E]);
                        const unsigned keep = (unsigned)__builtin_amdgcn_sbfe((int)(kt ? wm1 : wm0), E, 1);
                        p[i] = __builtin_bit_cast(float, __builtin_bit_cast(unsigned, e) & keep); lsum += p[i]; }
                    v4u pw0, pw1;
                    pw0.x = pk2(p[0], p[1]); pw0.y = pk2(p[2], p[3]); pw0.z = pk2(p[4], p[5]); pw0.w = pk2(p[6], p[7]);
                    pw1.x = pk2(p[8], p[9]); pw1.y = pk2(p[10], p[11]); pw1.z = pk2(p[12], p[13]); pw1.w = pk2(p[14], p[15]);
                    const bf16x8 pf0 = __builtin_bit_cast(bf16x8, pw0), pf1 = __builtin_bit_cast(bf16x8, pw1);
#pragma unroll
                    for (int dt = 0; dt < 4; ++dt) {
                        const LAS unsigned char* vrow = vb + (32 * dt + n) * AT_VPITCH + (32 * kt + 4 * hh) * 2;
                        const v2u a0 = *(const LAS v2u*)(vrow), a1 = *(const LAS v2u*)(vrow + 16), a2 = *(const LAS v2u*)(vrow + 32), a3 = *(const LAS v2u*)(vrow + 48);
                        v4u f0, f1; f0.x = a0.x; f0.y = a0.y; f0.z = a1.x; f0.w = a1.y; f1.x = a2.x; f1.y = a2.y; f1.z = a3.x; f1.w = a3.y;
                        O[dt] = __builtin_amdgcn_mfma_f32_32x32x16_bf16(__builtin_bit_cast(bf16x8, f0), pf0, O[dt], 0, 0, 0);
                        O[dt] = __builtin_amdgcn_mfma_f32_32x32x16_bf16(__builtin_bit_cast(bf16x8, f1), pf1, O[dt], 0, 0, 0);
                    }
                }
            }
            if (j + 1 < nrows) lstore(buf ^ 1);
            __syncthreads();
        }
        lsum += __shfl_xor(lsum, 32);
        const float il = 1.f / lsum;
        float ss = 0.f;
#pragma unroll
        for (int dt = 0; dt < 4; ++dt)
#pragma unroll
            for (int i = 0; i < 16; ++i) { O[dt][i] *= il; ss += O[dt][i] * O[dt][i]; }
        ss += __shfl_xor(ss, 32);
        const float rr = rsqrtf(ss * (1.f / HD) + EPS);
        bf16* orow = MIXED + (size_t)mq * DM + h * HD;
#pragma unroll
        for (int dt = 0; dt < 4; ++dt)
#pragma unroll
            for (int rg = 0; rg < 4; ++rg) { const int d = 32 * dt + 8 * rg + 4 * hh; const f32x4 gg = *(const GAS f32x4*)(og + h * HD + d);
                v2u w; w.x = pk2(O[dt][4 * rg + 0] * rr * gg.x, O[dt][4 * rg + 1] * rr * gg.y); w.y = pk2(O[dt][4 * rg + 2] * rr * gg.z, O[dt][4 * rg + 3] * rr * gg.w);
                *(GAS v2u*)(orow + d) = w; }
    }
    __syncthreads();
}

__device__ __forceinline__ void phase_p15(Frame& F) {
    bf16* QK = (bf16*)(F.ws + WS_QK); const float* qg = F.in[3]; const float* kg = F.in[4];
    for (int m = GW_ID(F); m < MT; m += GW_N(F)) {
        GAS v4u* rowp = (GAS v4u*)(QK + (size_t)m * 2048) + F.lane;
#pragma unroll
        for (int j = 0; j < 4; ++j) {
            v4u w = rowp[64 * j];
            float f[8] = {bflo(w.x), bfhi(w.x), bflo(w.y), bfhi(w.y), bflo(w.z), bfhi(w.z), bflo(w.w), bfhi(w.w)};
            float ss = 0.f;
#pragma unroll
            for (int e = 0; e < 8; ++e) ss += f[e] * f[e];
            ss += __shfl_xor(ss, 1); ss += __shfl_xor(ss, 2); ss += __shfl_xor(ss, 4); ss += __shfl_xor(ss, 8);
            const float r = rsqrtf(ss * (1.f / HD) + EPS);
            const int col = 512 * j + 8 * F.lane, d = col & 127; const float* g = (col < 1024 ? qg : kg) + d;
#pragma unroll
            for (int e = 0; e < 8; ++e) f[e] = f[e] * r * g[e];
            w.x = pk2(f[0], f[1]); w.y = pk2(f[2], f[3]); w.z = pk2(f[4], f[5]); w.w = pk2(f[6], f[7]);
            rowp[64 * j] = w;
        }
    }
    const bf16* XT = (const bf16*)(F.ws + WS_XT) + (size_t)1024 * MT; bf16* UC = (bf16*)(F.ws + WS_UC);
    const float* cw = F.in[6]; const float* cb = F.in[7];
    const size_t nchunks = (size_t)3072 * MT / 8;
    for (size_t i = (size_t)F.bid * NTHREADS + F.tid; i < nchunks; i += (size_t)F.G * NTHREADS) {
        const int ch = (int)(i >> 10), m0 = (int)(i & 1023) * 8, s0 = m0 & 4095;
        const bf16* up = XT + (size_t)ch * MT + m0;
        const v4u w = *(const GAS v4u*)up;
        float f[10];
        f[1] = bflo(w.x); f[2] = bfhi(w.x); f[3] = bflo(w.y); f[4] = bfhi(w.y); f[5] = bflo(w.z); f[6] = bfhi(w.z); f[7] = bflo(w.w); f[8] = bfhi(w.w);
        f[0] = s0 > 0 ? bf2f(up[-1]) : 0.f; f[9] = s0 + 8 < SEQ ? bf2f(up[8]) : 0.f;
        const float w0 = cw[ch], w1 = cw[3072 + ch], w2 = cw[6144 + ch], bb = cb[ch];
        float o[8];
#pragma unroll
        for (int e = 0; e < 8; ++e) o[e] = bb + w0 * f[e] + w1 * f[e + 1] + w2 * f[e + 2];
        v4u ov; ov.x = pk2(o[0], o[1]); ov.y = pk2(o[2], o[3]); ov.z = pk2(o[4], o[5]); ov.w = pk2(o[6], o[7]);
        *(GAS v4u*)(UC + (size_t)ch * MT + m0) = ov;
    }
}
__device__ __forceinline__ void phase_p25(Frame& F) {
    const bf16* HYT = (const bf16*)(F.ws + WS_HYT); bf16* MIXED = (bf16*)(F.ws + WS_MIXED); const float* hg = F.in[16];
    LAS float* tile = (LAS float*)F.lds;
    LAS float* rs = (LAS float*)(F.lds + 128 * 65 * 4);
    for (int it = F.bid; it < 8 * (MT / 64); it += F.G) {
        const int gi = it & 7, m0 = (it >> 3) * 64;
        { const int ch = F.tid >> 2, t0 = (F.tid & 3) * 16; const bf16* p = HYT + (size_t)(gi * 128 + ch) * MT + m0 + t0;
          const v4u a = *(const GAS v4u*)p, b = *(const GAS v4u*)(p + 8);
          LAS float* d = tile + ch * 65 + t0;
          d[0] = bflo(a.x); d[1] = bfhi(a.x); d[2] = bflo(a.y); d[3] = bfhi(a.y); d[4] = bflo(a.z); d[5] = bfhi(a.z); d[6] = bflo(a.w); d[7] = bfhi(a.w);
          d[8] = bflo(b.x); d[9] = bfhi(b.x); d[10] = bflo(b.y); d[11] = bfhi(b.y); d[12] = bflo(b.z); d[13] = bfhi(b.z); d[14] = bflo(b.w); d[15] = bfhi(b.w); }
        __syncthreads();
        {
          const int t = F.tid >> 3, c0 = (F.tid & 7) * 16; float ss = 0.f;
#pragma unroll
          for (int c = 0; c < 16; ++c) { const float v = tile[(c0 + c) * 65 + t]; ss += v * v; }
          ss += __shfl_xor(ss, 1); ss += __shfl_xor(ss, 2); ss += __shfl_xor(ss, 4);
          if ((F.tid & 7) == 0) rs[t] = rsqrtf(ss * (1.f / 128) + EPS); }
        __syncthreads();
        {
          const int t = F.tid >> 3, c0 = (F.tid & 7) * 16; const float r = rs[t]; float o[16];
#pragma unroll
          for (int c = 0; c < 16; ++c) o[c] = tile[(c0 + c) * 65 + t] * r * hg[gi * 128 + c0 + c];
          v4u a, b; a.x = pk2(o[0], o[1]); a.y = pk2(o[2], o[3]); a.z = pk2(o[4], o[5]); a.w = pk2(o[6], o[7]); b.x = pk2(o[8], o[9]); b.y = pk2(o[10], o[11]); b.z = pk2(o[12], o[13]); b.w = pk2(o[14], o[15]);
          bf16* q = MIXED + (size_t)(m0 + t) * DM + AW + gi * 128 + c0; *(GAS v4u*)q = a; *(GAS v4u*)(q + 8) = b; }
        __syncthreads();
    }
}
__device__ __forceinline__ void phase_p35(Frame& F) {
    LAS float* wrT = (LAS float*)F.lds;
    const float* wr = F.in[19]; const float* g = F.in[18];
    constexpr int WRS = DM + 4;
    for (int i = F.tid; i < DM * NE; i += NTHREADS) { const int d = i >> 4, e = i & 15; wrT[e * WRS + d] = wr[i]; }
    __syncthreads();
    bf16* HB = (bf16*)(F.ws + WS_HB); float* AFF = (float*)(F.ws + WS_AFF); const float* x1 = F.out;
    f32x4 vn[8];
    { const int m0 = GW_ID(F); if (m0 < MT) { const GAS f32x4* xr = (const GAS f32x4*)(x1 + (size_t)m0 * DM) + F.lane;
#pragma unroll
        for (int j = 0; j < 8; ++j) vn[j] = xr[64 * j]; } }
    for (int m = GW_ID(F); m < MT; m += GW_N(F)) {
        f32x4 v[8]; float s = 0.f;
#pragma unroll
        for (int j = 0; j < 8; ++j) { v[j] = vn[j]; s += (v[j].x * v[j].x + v[j].y * v[j].y) + (v[j].z * v[j].z + v[j].w * v[j].w); }
        if (m + GW_N(F) < MT) { const GAS f32x4* xr = (const GAS f32x4*)(x1 + (size_t)(m + GW_N(F)) * DM) + F.lane;
#pragma unroll
            for (int j = 0; j < 8; ++j) vn[j] = xr[64 * j]; }
        const float r = rsqrtf(wave_sum(s) * (1.f / DM) + EPS);
        GAS v2u* o8 = (GAS v2u*)(HB + (size_t)m * DM) + F.lane;
#pragma unroll
        for (int j = 0; j < 8; ++j) { const f32x4 gg = *((const GAS f32x4*)g + F.lane + 64 * j); v[j].x *= r * gg.x; v[j].y *= r * gg.y; v[j].z *= r * gg.z; v[j].w *= r * gg.w;
            v2u o; o.x = pk2(v[j].x, v[j].y); o.y = pk2(v[j].z, v[j].w); o8[64 * j] = o; }
        float mine = 0.f;
#pragma unroll 1
        for (int e = 0; e < NE; ++e) { float a = 0.f;
#pragma unroll
            for (int j = 0; j < 8; ++j) { const f32x4 w = *((const LAS f32x4*)(wrT + e * WRS) + F.lane + 64 * j); a += (v[j].x * w.x + v[j].y * w.y) + (v[j].z * w.z + v[j].w * w.w); }
            a = wave_sum(a); mine = (F.lane == e) ? a : mine; }
        float mx = mine;
        mx = fmaxf(mx, __shfl_xor(mx, 1)); mx = fmaxf(mx, __shfl_xor(mx, 2)); mx = fmaxf(mx, __shfl_xor(mx, 4)); mx = fmaxf(mx, __shfl_xor(mx, 8));
        const float ex = expf(mine - mx); float den = ex;
        den += __shfl_xor(den, 1); den += __shfl_xor(den, 2); den += __shfl_xor(den, 4); den += __shfl_xor(den, 8);
        const int b = m / SEQ, sidx = m % SEQ;
        if (F.lane < NE) AFF[((size_t)b * NE + F.lane) * SEQ + sidx] = ex / den;
    }
    __syncthreads();
}
__device__ __forceinline__ void phase_p4(Frame& F) {
    LAS unsigned* key = (LAS unsigned*)F.lds;
    LAS unsigned* hist = (LAS unsigned*)(F.lds + 16384);
    LAS unsigned* wsum = (LAS unsigned*)(F.lds + 16384 + 1024);
    const float* AFF = (const float*)(F.ws + WS_AFF); int* IDX = (int*)(F.ws + WS_IDX); float* GATE = (float*)(F.ws + WS_GATE); int* SEL = (int*)(F.ws + WS_SEL);
    for (int be = F.bid; be < NB * NE; be += F.G) {
        const int b = be / NE, e = be % NE;
        __syncthreads();
        const GAS v4u* ap = (const GAS v4u*)(AFF + (size_t)be * SEQ);
        const v4u k0 = ap[2 * F.tid], k1 = ap[2 * F.tid + 1];
        unsigned kk[8] = {k0.x, k0.y, k0.z, k0.w, k1.x, k1.y, k1.z, k1.w};
        unsigned prefix = 0u, mask = 0u, remaining = CAP;
#pragma unroll 1
        for (int pass = 0; pass < 4; ++pass) {
            const int shift = 24 - 8 * pass;
            if (F.tid < 256) hist[F.tid] = 0u;
            __syncthreads();
#pragma unroll
            for (int i = 0; i < 8; ++i) if ((kk[i] & mask) == prefix) __hip_atomic_fetch_add(&hist[(kk[i] >> shift) & 255u], 1u, __ATOMIC_RELAXED, __HIP_MEMORY_SCOPE_WORKGROUP);
            __syncthreads();
            unsigned incl_ = 0u, mine_ = 0u;
            if (F.tid < 256) {
                mine_ = hist[255 - F.tid]; incl_ = mine_;
#pragma unroll
                for (int o = 1; o < 64; o <<= 1) { const unsigned t = __shfl_up(incl_, o); if (F.lane >= o) incl_ += t; }
                if (F.lane == 63) wsum[10 + F.wave] = incl_;
            }
            __syncthreads();
            if (F.tid < 256) {
                unsigned base = 0u;
                for (int w = 0; w < F.wave; ++w) base += wsum[10 + w];
                const unsigned above = base + incl_ - mine_;
                if (above < remaining && remaining <= above + mine_) { wsum[8] = (unsigned)(255 - F.tid); wsum[9] = above; }
            }
            __syncthreads();
            const unsigned d = wsum[8], above = wsum[9];
            prefix |= d << shift; mask |= 255u << shift; remaining -= above;
            __syncthreads();
        }
        const unsigned thr = prefix;
        unsigned cnt = 0u;
#pragma unroll
        for (int i = 0; i < 8; ++i) cnt += (kk[i] > thr ? 0x10000u : 0u) + (kk[i] == thr ? 1u : 0u);
        unsigned incl = cnt;
#pragma unroll
        for (int o = 1; o < 64; o <<= 1) { const unsigned t = __shfl_up(incl, o); if (F.lane >= o) incl += t; }
        if (F.lane == 63) wsum[F.wave] = incl;
        __syncthreads();
        unsigned base = 0u;
        for (int w = 0; w < F.wave; ++w) base += wsum[w];
        unsigned run = base + incl - cnt;
#pragma unroll
        for (int i = 0; i < 8; ++i) {
            const unsigned gt_before = run >> 16, tie_before = run & 0xffffu;
            const bool isgt = kk[i] > thr, istie = kk[i] == thr;
            const bool sel = isgt || (istie && tie_before < remaining);
            const unsigned slot = gt_before + (tie_before < remaining ? tie_before : remaining);
            const int s = 8 * F.tid + i, m = b * SEQ + s;
            if (sel) { IDX[be * CAP + slot] = m; GATE[be * CAP + slot] = __builtin_bit_cast(float, kk[i]); }
            SEL[(size_t)m * NE + e] = sel ? (int)slot : -1;
            run += (isgt ? 0x10000u : 0u) + (istie ? 1u : 0u);
        }
    }
    __syncthreads();
}
__device__ __forceinline__ void phase_p7(Frame& F) {
    const int* SEL = (const int*)(F.ws + WS_SEL); const float* GATE = (const float*)(F.ws + WS_GATE); const bf16* YE = (const bf16*)(F.ws + WS_YE);
    for (int m = GW_ID(F); m < MT; m += GW_N(F)) {
        const int b = m / SEQ;
        GAS f32x4* orow = (GAS f32x4*)(F.out + (size_t)m * DM);
        f32x4 acc[8];
#pragma unroll
        for (int j = 0; j < 8; ++j) acc[j] = orow[2 * F.lane + (j & 1) + 128 * (j >> 1)];
        for (int e = 0; e < NE; ++e) { const int slot = SEL[(size_t)m * NE + e]; if (slot >= 0) {
            const GAS v4u* yr = (const GAS v4u*)(YE + (size_t)((b * NE + e) * CAP + slot) * DM) + F.lane;
#pragma unroll
            for (int jj = 0; jj < 4; ++jj) { const v4u w = yr[64 * jj];
                acc[2 * jj].x += bflo(w.x); acc[2 * jj].y += bfhi(w.x); acc[2 * jj].z += bflo(w.y); acc[2 * jj].w += bfhi(w.y);
                acc[2 * jj + 1].x += bflo(w.z); acc[2 * jj + 1].y += bfhi(w.z); acc[2 * jj + 1].z += bflo(w.w); acc[2 * jj + 1].w += bfhi(w.w); } } }
#pragma unroll
        for (int j = 0; j < 8; ++j) orow[2 * F.lane + (j & 1) + 128 * (j >> 1)] = acc[j];
    }
    (void)GATE;
}

struct Args { const float* in[23]; float* out; unsigned char* ws; int ph_lo, ph_hi; };
enum Phase { PH_P0 = 0, PH_G1, PH_ATTN, PH_P25, PH_OUT, PH_P35, PH_P4, PH_UP, PH_DOWN, PH_P7, PH_COUNT };

__global__ void __launch_bounds__(NTHREADS, 2) mk_fwd(Args args) {
    extern __shared__ __attribute__((aligned(16))) unsigned char lds_raw[];
    Frame F;
    F.lds = (LAS unsigned char*)lds_raw;
    F.tid = threadIdx.x; F.lane = F.tid & 63; F.wave = __builtin_amdgcn_readfirstlane(F.tid >> 6); F.G = gridDim.x; F.bid = blockIdx.x;
#pragma unroll
    for (int i = 0; i < 23; ++i) F.in[i] = args.in[i];
    F.out = args.out; F.ws = args.ws;
    const int lo = args.ph_lo, hi = args.ph_hi;
#define IN(k) (lo <= (k) && (k) < hi)
#define REPS(k) for (int rep_ = 0; rep_ < ((k) == REP_PHASE ? REP_N : 1); ++rep_)
#if MK_N_LAUNCHES == 1
    { volatile LAS unsigned* misc = (volatile LAS unsigned*)(F.lds + LDS_MISC_OFF); if (F.tid < 16) misc[F.tid] = 0u; }
    __syncthreads();
    XcdBarrier bar = xcd_barrier_post(g_bar_words, (volatile LAS unsigned*)(F.lds + LDS_MISC_OFF) + 8);
#define SEAM(k) do { if (IN(k) && IN((k) + 1)) xcd_barrier(bar); } while (0)
#else
#define SEAM(k) do { } while (0)
#endif
    if (IN(PH_P0)) REPS(PH_P0) { phase_p0(F); for (int it = GW_ID(F); it < MOE_P0_ITEMS; it += GW_N(F)) moe_conv_item(F, it); } SEAM(PH_P0);
    if (IN(PH_G1)) REPS(PH_G1) {
        phase_filters(F);
        __syncthreads();
        { pg8::DenseOrder S; S.init(F.ws + WS_HB, F.ws + WS_WIN, MT, 2048, DM, 0, F.G, F.bid);
          pg8::EpiBf16 E{(pg8::bf16_t*)(F.ws + WS_QK), 2048, 0, nullptr};
          pg8::gemm_phase<pg8::EpiBf16, pg8::DenseOrder, true>(F.lds, DM, S, E); }
        { pg8::DenseOrder S; S.init(F.ws + WS_HB, F.ws + WS_WIN, MT, 4096, DM, 8, F.G, F.bid);
          pg8::EpiTransBf16 E{(pg8::bf16_t*)(F.ws + WS_XT), MT, 8};
          pg8::gemm_phase<pg8::EpiTransBf16, pg8::DenseOrder, true>(F.lds, DM, S, E); }
    } SEAM(PH_G1);
    if (IN(PH_ATTN)) { __syncthreads(); for (int rep_ = 0; rep_ < ((PH_ATTN == REP_PHASE && REP_SUB != 2) ? REP_N : 1); ++rep_) phase_hyena(F); for (int rep_ = 0; rep_ < ((PH_ATTN == REP_PHASE && REP_SUB != 1) ? REP_N : 1); ++rep_) phase_attn2(F); } SEAM(PH_ATTN);
    if (IN(PH_P25)) REPS(PH_P25) { __syncthreads(); phase_p25(F); } SEAM(PH_P25);
    if (IN(PH_OUT)) REPS(PH_OUT) {
        __syncthreads();
        pg8::DenseOrder S; S.init(F.ws + WS_MIXED, F.ws + WS_WOUT, MT, DM, DM, 0, F.G, F.bid);
        pg8::EpiResF32 E{F.in[0], F.out, DM};
        pg8::gemm_phase<pg8::EpiResF32, pg8::DenseOrder, false>(F.lds, DM, S, E);
    } SEAM(PH_OUT);
    if (IN(PH_P35)) REPS(PH_P35) { __syncthreads(); phase_p35(F); } SEAM(PH_P35);
    if (IN(PH_P4)) REPS(PH_P4) { __syncthreads(); phase_p4(F); } SEAM(PH_P4);
    if (IN(PH_UP)) REPS(PH_UP) {
        __syncthreads();
        pg8::MoeOrder S; S.init(F.ws + WS_HB, F.ws + WS_WGU, DM, F.G, F.bid, true);
        LAS int* ridx = (LAS int*)(F.lds + 131072);
        { const int* IDX = (const int*)(F.ws + WS_IDX); pg8::Unit u;
          for (int i = 0; S.next(i, u); ++i) if (F.tid < 256) ridx[i * 256 + F.tid] = IDX[u.g * CAP + u.pm * 256 + F.tid]; }
        __syncthreads();
        pg8::EpiSwiGLU E{(pg8::bf16_t*)(F.ws + WS_ACT)};
        pg8::gemm_phase<pg8::EpiSwiGLU, pg8::MoeOrder, true, true>(F.lds, DM, S, E, ridx);
    } SEAM(PH_UP);
    if (IN(PH_DOWN)) REPS(PH_DOWN) {
        __syncthreads();
        pg8::MoeOrder S; S.init(F.ws + WS_ACT, F.ws + WS_WD, FF, F.G, F.bid, false);
        pg8::EpiBf16 E{(pg8::bf16_t*)(F.ws + WS_YE), DM, 512, (const float*)(F.ws + WS_GATE)};
        pg8::gemm_phase<pg8::EpiBf16, pg8::MoeOrder, true>(F.lds, FF, S, E);
    } SEAM(PH_DOWN);
    if (IN(PH_P7)) { phase_p7(F); }
#if MK_N_LAUNCHES == 1
    __syncthreads();
    { volatile LAS unsigned* misc = (volatile LAS unsigned*)(F.lds + LDS_MISC_OFF);
      if (F.tid == 0) misc[0] = (xb_add(&g_bar_words[XCD_BAR_WORDS], 1u) + 1u == (unsigned)F.G) ? 1u : 0u;
      __syncthreads();
      if (misc[0] != 0u && F.tid < (XCD_BAR_WORDS + 64) / 64) __hip_atomic_store(&g_bar_words[64 * F.tid], 0u, __ATOMIC_RELAXED, __HIP_MEMORY_SCOPE_AGENT); }
#endif
#undef IN
#undef SEAM
}

extern "C" void kernel_launch(void* const* d_in, const int* in_sizes, int n_in, void* d_out, int out_size, void* d_ws, size_t ws_size, hipStream_t stream) {
    static int grid = 0;
    if (grid == 0) {
        if (n_in != 23 || ws_size < WS_END) { fprintf(stderr, "kernel_launch: unexpected inputs (n_in %d, ws %zu)\n", n_in, ws_size); grid = -1; return; }
        if (hipFuncSetAttribute((const void*)mk_fwd, hipFuncAttributeMaxDynamicSharedMemorySize, LDS_BYTES) != hipSuccess) { fprintf(stderr, "kernel_launch: hipFuncSetAttribute failed\n"); grid = -1; return; }
        int dev = 0, cus = 0, per_cu = 0;
        hipGetDevice(&dev); hipDeviceGetAttribute(&cus, hipDeviceAttributeMultiprocessorCount, dev);
        hipOccupancyMaxActiveBlocksPerMultiprocessor(&per_cu, (const void*)mk_fwd, NTHREADS, LDS_BYTES);
        (void)hipGetLastError();
        if (per_cu < 1) { fprintf(stderr, "kernel_launch: occupancy query says %d blocks/CU\n", per_cu); }
        grid = cus;
    }
    if (grid < 0) return;
    Args a{};
    for (int i = 0; i < 23; ++i) a.in[i] = (const float*)d_in[i];
    a.out = (float*)d_out; a.ws = (unsigned char*)d_ws;
#if MK_N_LAUNCHES == 1
    a.ph_lo = 0; a.ph_hi = PH_COUNT;
    hipLaunchKernelGGL(mk_fwd, dim3(grid), dim3(NTHREADS), LDS_BYTES, stream, a);
#else
    for (int p = 0; p < PH_COUNT; ++p) { a.ph_lo = p; a.ph_hi = p + 1; hipLaunchKernelGGL(mk_fwd, dim3(grid), dim3(NTHREADS), LDS_BYTES, stream, a); }
#endif
}
```

```cpp
#include <hip/hip_runtime.h>
#include <hip/hip_cooperative_groups.h>
#include <cstdio>
#include <cstdint>
namespace cg = cooperative_groups;

#ifndef REP_PHASE
#define REP_PHASE -1
#define REP_N 1
#define REP_SUB 0
#endif
#ifndef MK_N_LAUNCHES
#define MK_N_LAUNCHES 1
#endif

namespace pg8 {
#define PG8_LAS __attribute__((address_space(3)))
typedef unsigned short bf16_t;
typedef short bf16x8 __attribute__((ext_vector_type(8)));
typedef float f32x4 __attribute__((ext_vector_type(4)));
typedef unsigned u32x4 __attribute__((ext_vector_type(4)));
typedef unsigned u32x2 __attribute__((ext_vector_type(2)));
constexpr int BM = 256, BK = 64, HALF = 128, HTB = HALF * BK * 2, STAGE_BYTES = 8 * HTB, NXCD = 8, WGM = 8;

__host__ __device__ __forceinline__ int lds_byte(int r, int c) { const int st = (r >> 4) * 2 + (c >> 5), rr = r & 15, cc = c & 31, ob = rr * 64 + cc * 2; return st * 1024 + (ob ^ (((ob >> 9) & 1) << 5)); }
__host__ __device__ __forceinline__ void stage_rc(int b, int& R, int& C) { const int st = b / 1024, sb = b % 1024, swz = sb ^ (((sb >> 9) & 1) << 5); R = (st >> 1) * 16 + swz / 64; C = (st & 1) * 32 + (swz % 64) / 2; }
__host__ __device__ __forceinline__ int perm32(int rho) { const int n = rho >> 4, i = rho & 15; return 8 * (i >> 2) + 4 * n + (i & 3); }

struct Unit { int pm, pn, g; const char* a; const char* b; };

__device__ __forceinline__ unsigned cvt_pk_bf16(float lo, float hi) { unsigned r; asm volatile("v_cvt_pk_bf16_f32 %0, %1, %2" : "=v"(r) : "v"(lo), "v"(hi)); return r; }

struct DenseOrder {
    static constexpr bool CHUNK_B = false;
    int nM, nN, nwg, G, c, K, pn0; const char* A; const char* Bt;
    __device__ void init(const void* A_, const void* Bt_, int M, int N, int K_, int pn0_, int G_, int c_) { A = (const char*)A_; Bt = (const char*)Bt_; nM = M / BM; nN = N / BM; nwg = nM * nN; G = G_; c = c_; K = K_; pn0 = pn0_; }
    __device__ bool next(int i, Unit& u) const {
        const long L = (long)i * G + c; if (L >= nwg) return false;
        int wgid = (int)L; { const int q = nwg / NXCD, r = nwg % NXCD, xcd = wgid % NXCD, off = wgid / NXCD; wgid = (xcd < r ? xcd * (q + 1) : r * (q + 1) + (xcd - r) * q) + off; }
        const int nig = WGM * nN, gid = wgid / nig, fm = gid * WGM, gsz = (nM - fm) < WGM ? (nM - fm) : WGM;
        u.pm = fm + ((wgid % nig) % gsz); u.pn = pn0 + (wgid % nig) / gsz; u.g = 0;
        u.a = A + (size_t)u.pm * BM * K * 2; u.b = Bt + (size_t)u.pn * BM * K * 2; return true;
    }
};
struct MoeOrder {
    static constexpr bool CHUNK_B = true;
    int G, c, K; bool gather; const char* A; const char* Bt;
    __device__ void init(const void* A_, const void* Bt_, int K_, int G_, int c_, bool gather_) { A = (const char*)A_; Bt = (const char*)Bt_; K = K_; G = G_; c = c_; gather = gather_; }
    __device__ bool next(int i, Unit& u) const {
        const int L = i * G + c; if (L >= 512) return false;
        const int pn = L & 7, pm = (L >> 3) & 1, b = (L >> 4) & 1, e = L >> 5;
        u.pm = pm; u.pn = pn; u.g = b * 16 + e;
        u.a = gather ? A : A + (size_t)(u.g * 512 + pm * BM) * K * 2; u.b = Bt + (size_t)e * 2048 * K * 2 + (size_t)pn * BM * 16; return true;
    }
};

struct EpiBf16 {
    static constexpr bool PERM = true, SWAP = false;
    bf16_t* O; int ldc; int grows; const float* rscale;
    __device__ __forceinline__ void operator()(const f32x4 (&acc)[2][2][4][2], const Unit& u, int wr, int wc, int fr, int fq) const {
        const int row0 = u.g * grows + u.pm * BM + wr * 64 + fr, col0 = u.pn * BM + wc * 32 + 8 * fq;
#pragma unroll
        for (int ai = 0; ai < 2; ++ai)
#pragma unroll
            for (int m = 0; m < 4; ++m) { const int row = row0 + ai * HALF + m * 16; bf16_t* rowp = O + (size_t)row * ldc + col0; const float sc = rscale ? rscale[row] : 1.f;
#pragma unroll
                for (int bj = 0; bj < 2; ++bj) { const f32x4 v0 = acc[ai][bj][m][0] * sc, v1 = acc[ai][bj][m][1] * sc;
                    u32x4 w; w.x = cvt_pk_bf16(v0[0], v0[1]); w.y = cvt_pk_bf16(v0[2], v0[3]); w.z = cvt_pk_bf16(v1[0], v1[1]); w.w = cvt_pk_bf16(v1[2], v1[3]);
                    *(u32x4*)(rowp + bj * HALF) = w; } }
    }
};
struct EpiSwiGLU {
    static constexpr bool PERM = true, SWAP = false;
    bf16_t* O;
    __device__ __forceinline__ void operator()(const f32x4 (&acc)[2][2][4][2], const Unit& u, int wr, int wc, int fr, int fq) const {
        const int row0 = u.g * 512 + u.pm * BM + wr * 64 + fr, col0 = u.pn * HALF + wc * 32 + 8 * fq;
#pragma unroll
        for (int ai = 0; ai < 2; ++ai)
#pragma unroll
            for (int m = 0; m < 4; ++m) { bf16_t* rowp = O + (size_t)(row0 + ai * HALF + m * 16) * 1024 + col0;
                float r[8];
#pragma unroll
                for (int n = 0; n < 2; ++n)
#pragma unroll
                    for (int e = 0; e < 4; ++e) { const float g = acc[ai][0][m][n][e], up = acc[ai][1][m][n][e]; r[n * 4 + e] = g / (1.f + __expf(-g)) * up; }
                u32x4 w; w.x = cvt_pk_bf16(r[0], r[1]); w.y = cvt_pk_bf16(r[2], r[3]); w.z = cvt_pk_bf16(r[4], r[5]); w.w = cvt_pk_bf16(r[6], r[7]);
                *(u32x4*)rowp = w; }
    }
};
struct EpiResF32 {
    static constexpr bool PERM = false, SWAP = false;
    const float* res; float* out; int ldc;
    __device__ __forceinline__ void operator()(const f32x4 (&acc)[2][2][4][2], const Unit& u, int wr, int wc, int fr, int fq) const {
        const int row0 = u.pm * BM + wr * 64 + fr, col0 = u.pn * BM + wc * 32 + 4 * fq;
#pragma unroll
        for (int ai = 0; ai < 2; ++ai)
#pragma unroll
            for (int m = 0; m < 4; ++m) { const size_t off = (size_t)(row0 + ai * HALF + m * 16) * ldc + col0;
#pragma unroll
                for (int bj = 0; bj < 2; ++bj)
#pragma unroll
                    for (int n = 0; n < 2; ++n) { const f32x4 r = *(const f32x4*)(res + off + bj * HALF + n * 16); *(f32x4*)(out + off + bj * HALF + n * 16) = r + acc[ai][bj][m][n]; } }
    }
};
struct EpiTransBf16 {
    static constexpr bool PERM = false, SWAP = true;
    bf16_t* O; int ldt; int pn_base;
    __device__ __forceinline__ void operator()(const f32x4 (&acc)[2][2][4][2], const Unit& u, int wr, int wc, int fr, int fq) const {
        const int ch0 = (u.pn - pn_base) * BM + wc * 32 + fr, t0 = u.pm * BM + wr * 64 + 4 * fq;
#pragma unroll
        for (int bj = 0; bj < 2; ++bj)
#pragma unroll
            for (int n = 0; n < 2; ++n) { bf16_t* chp = O + (size_t)(ch0 + bj * HALF + n * 16) * ldt + t0;
#pragma unroll
                for (int ai = 0; ai < 2; ++ai)
#pragma unroll
                    for (int m = 0; m < 4; ++m) { const f32x4 v = acc[ai][bj][m][n]; u32x2 w; w.x = cvt_pk_bf16(v[0], v[1]); w.y = cvt_pk_bf16(v[2], v[3]); *(u32x2*)(chp + ai * HALF + m * 16) = w; } }
    }
};

template <class Epi, class Sched, bool ALIGN_EPI = false, bool GATHER = false>
__device__ __forceinline__ void gemm_phase(PG8_LAS unsigned char* lds, const int K, const Sched& S, const Epi& E, const PG8_LAS int* ridx = nullptr) {
    const int tid = threadIdx.x, wid = __builtin_amdgcn_readfirstlane(tid >> 6), lane = tid & 63, wr = wid >> 2, wc = wid & 3, fr = lane & 15, fq = lane >> 4;
    const int nt = K / BK;
    unsigned vA0[2], vA1[2], vN0[2], vN1[2], voffB[2]; int stR[2], stC[2];
    const size_t kstep = (size_t)(BK * 2);
    const size_t hstep = (size_t)HALF * K * 2;
    const size_t kstepB = Sched::CHUNK_B ? (size_t)(BK / 8) * 2048 * 16 : kstep, hstepB = Sched::CHUNK_B ? (size_t)HALF * 16 : hstep;
#pragma unroll
    for (int i = 0; i < 2; ++i) { int R, C; stage_rc(tid * 16 + i * 8192, R, C); const int Rb = Epi::PERM ? ((R & ~31) + perm32(R & 31)) : R; stR[i] = R; stC[i] = C;
        voffB[i] = Sched::CHUNK_B ? (unsigned)(((C >> 3) * 2048 + Rb) * 16) : (unsigned)(Rb * K + C) * 2u;
        if constexpr (GATHER) { vA0[i] = (unsigned)(ridx[R] * K + C) * 2u; vA1[i] = (unsigned)(ridx[HALF + R] * K + C) * 2u; }
        else { vA0[i] = (unsigned)(R * K + C) * 2u; vA1[i] = vA0[i] + (unsigned)hstep; }
        vN0[i] = vA0[i]; vN1[i] = vA1[i]; }
    const unsigned ldsw = (unsigned)wid * 1024u;
    const int aoff = lds_byte(wr * 64 + fr, fq * 8), boff = lds_byte(wc * 32 + fr, fq * 8);
#define PG8_SA(b, h) (((b) * 2 + (h)) * HTB)
#define PG8_SB(b, h) ((4 + (b) * 2 + (h)) * HTB)
#define PG8_STAGE(bufoff, gbase, voff) do { _Pragma("unroll") for (int _i = 0; _i < 2; ++_i) \
        __builtin_amdgcn_global_load_lds((const unsigned*)((const char*)(gbase) + (voff)[_i]), (PG8_LAS unsigned*)(lds + (bufoff) + ldsw + _i * 8192), 16, 0, 0); } while (0)
#define PG8_LDA(dst, b, h) do { _Pragma("unroll") for (int m = 0; m < 4; ++m) _Pragma("unroll") for (int k = 0; k < 2; ++k) dst[m][k] = *(const PG8_LAS bf16x8*)(lds + PG8_SA(b, h) + aoff + m * 2048 + k * 1024); } while (0)
#define PG8_LDB(dst, b, h) do { _Pragma("unroll") for (int n = 0; n < 2; ++n) _Pragma("unroll") for (int k = 0; k < 2; ++k) dst[n][k] = *(const PG8_LAS bf16x8*)(lds + PG8_SB(b, h) + boff + n * 2048 + k * 1024); } while (0)
#define PG8_MMA(ai, bj, At, Bt) do { __builtin_amdgcn_s_setprio(1); _Pragma("unroll") for (int m = 0; m < 4; ++m) _Pragma("unroll") for (int n = 0; n < 2; ++n) _Pragma("unroll") for (int k = 0; k < 2; ++k) \
        acc[ai][bj][m][n] = Epi::SWAP ? __builtin_amdgcn_mfma_f32_16x16x32_bf16(At[m][k], Bt[n][k], acc[ai][bj][m][n], 0, 0, 0) : __builtin_amdgcn_mfma_f32_16x16x32_bf16(Bt[n][k], At[m][k], acc[ai][bj][m][n], 0, 0, 0); __builtin_amdgcn_s_setprio(0); } while (0)
#define PG8_WAIT_V(n) asm volatile("s_waitcnt vmcnt(" #n ")" ::: "memory")
#define PG8_WAIT_L(n) asm volatile("s_waitcnt lgkmcnt(" #n ")" ::: "memory")
#define PG8_BAR __builtin_amdgcn_s_barrier()
#define PG8_SCHED __builtin_amdgcn_sched_barrier(0)
    Unit cur, nxt; int ui = 0;
    if (!S.next(0, cur)) return;
    f32x4 acc[2][2][4][2];
#pragma unroll
    for (int a = 0; a < 2; ++a)
#pragma unroll
        for (int b = 0; b < 2; ++b)
#pragma unroll
            for (int m = 0; m < 4; ++m)
#pragma unroll
                for (int n = 0; n < 2; ++n) acc[a][b][m][n] = (f32x4){0.f, 0.f, 0.f, 0.f};
    bf16x8 At[4][2], B0[2][2], B1[2][2];
    const char* cA = cur.a; const char* cB = cur.b;
    PG8_STAGE(PG8_SB(0, 0), cB, voffB); PG8_STAGE(PG8_SB(0, 1), cB + hstepB, voffB); PG8_STAGE(PG8_SA(0, 0), cA, vA0); PG8_STAGE(PG8_SA(0, 1), cA, vA1);
    if (wr == 1) PG8_BAR;
    PG8_WAIT_V(2); PG8_BAR;
    PG8_STAGE(PG8_SB(1, 0), cB + kstepB, voffB); PG8_STAGE(PG8_SA(1, 0), cA + kstep, vA0); PG8_STAGE(PG8_SB(1, 1), cB + hstepB + kstepB, voffB);
    PG8_WAIT_V(6); PG8_BAR;
    for (;;) {
        const bool has_next = S.next(ui + 1, nxt);
        const char* nA = has_next ? nxt.a : cA; const char* nB = has_next ? nxt.b : cB;
        if constexpr (GATHER) { if (has_next) {
#pragma unroll
            for (int i = 0; i < 2; ++i) { vN0[i] = (unsigned)(ridx[(ui + 1) * 256 + stR[i]] * K + stC[i]) * 2u; vN1[i] = (unsigned)(ridx[(ui + 1) * 256 + HALF + stR[i]] * K + stC[i]) * 2u; } } }
        for (int t = 0; t < nt; t += 2) {
            const bool last = (t == nt - 2);
            const char* a1 = cA + (size_t)(t + 1) * kstep;
            const char* a2 = last ? nA : cA + (size_t)(t + 2) * kstep; const char* b2 = last ? nB : cB + (size_t)(t + 2) * kstepB;
            const char* a3 = a2 + kstep; const char* b3 = b2 + kstepB;
            unsigned w0[2], w1[2];
#pragma unroll
            for (int i = 0; i < 2; ++i) { w0[i] = last ? vN0[i] : vA0[i]; w1[i] = last ? vN1[i] : vA1[i]; }
            PG8_LDB(B0, 0, 0); PG8_LDB(B1, 0, 1); PG8_SCHED; PG8_LDA(At, 0, 0); PG8_STAGE(PG8_SA(1, 1), a1, vA1);
            PG8_WAIT_V(8); PG8_WAIT_L(0); PG8_BAR; PG8_MMA(0, 0, At, B0); PG8_MMA(0, 1, At, B1); PG8_BAR; PG8_SCHED;
            PG8_LDA(At, 0, 1); PG8_STAGE(PG8_SB(0, 0), b2, voffB); PG8_STAGE(PG8_SB(0, 1), b2 + hstepB, voffB); PG8_STAGE(PG8_SA(0, 0), a2, w0);
            PG8_WAIT_V(8); PG8_WAIT_L(0); PG8_BAR; PG8_MMA(1, 0, At, B0); PG8_MMA(1, 1, At, B1); PG8_BAR; PG8_SCHED;
            PG8_LDB(B0, 1, 0); PG8_LDB(B1, 1, 1); PG8_SCHED; PG8_LDA(At, 1, 0); PG8_STAGE(PG8_SA(0, 1), a2, w1);
            PG8_WAIT_V(8); PG8_WAIT_L(0); PG8_BAR; PG8_MMA(0, 0, At, B0); PG8_MMA(0, 1, At, B1); PG8_BAR; PG8_SCHED;
            PG8_LDA(At, 1, 1); PG8_STAGE(PG8_SB(1, 0), b3, voffB); PG8_STAGE(PG8_SB(1, 1), b3 + hstepB, voffB); PG8_STAGE(PG8_SA(1, 0), a3, w0);
            PG8_WAIT_V(8); PG8_WAIT_L(0); PG8_BAR; PG8_MMA(1, 0, At, B0); PG8_MMA(1, 1, At, B1); PG8_BAR; PG8_SCHED;
        }
        if constexpr (ALIGN_EPI) { if (wr == 0) PG8_BAR; }
        E(acc, cur, wr, wc, fr, fq);
        if (!has_next) break;
#pragma unroll
        for (int a = 0; a < 2; ++a)
#pragma unroll
            for (int b = 0; b < 2; ++b)
#pragma unroll
                for (int m = 0; m < 4; ++m)
#pragma unroll
                    for (int n = 0; n < 2; ++n) acc[a][b][m][n] = (f32x4){0.f, 0.f, 0.f, 0.f};
        cur = nxt; cA = nA; cB = nB; ++ui;
#pragma unroll
        for (int i = 0; i < 2; ++i) { vA0[i] = vN0[i]; vA1[i] = vN1[i]; }
        if constexpr (ALIGN_EPI) { if (wr == 1) PG8_BAR; }
    }
    PG8_WAIT_V(0);
    if constexpr (!ALIGN_EPI) { if (wr == 0) PG8_BAR; }
    PG8_BAR;
#undef PG8_SA
#undef PG8_SB
#undef PG8_STAGE
#undef PG8_LDA
#undef PG8_LDB
#undef PG8_MMA
#undef PG8_WAIT_V
#undef PG8_WAIT_L
#undef PG8_BAR
#undef PG8_SCHED
}
}

constexpr int NB = 2, SEQ = 4096, DM = 2048, MT = NB * SEQ;
constexpr int NH = 8, HD = 128, AW = 1024, HW = 1024, INW = 6144;
constexpr int GW = 64, NROWS = 64, WR = 8, WC = 16;
constexpr int NE = 16, CAP = 512, FF = 1024;
constexpr int FEMB = 33, FHID = 64;
constexpr float EPS = 1e-6f;
constexpr int NWAVES = 8, NTHREADS = 512;

constexpr size_t MiB = 1u << 20;
constexpr size_t WS_CTL = 0, CTL_ZERO_BYTES = 32768;
constexpr size_t WS_WIN = 2 * MiB;
constexpr size_t WS_WOUT = 26 * MiB;
constexpr size_t WS_WGU = 34 * MiB;
constexpr size_t WS_WD = 162 * MiB;
constexpr size_t WS_W3T = 226 * MiB;
constexpr size_t WS_HID2 = 227 * MiB;
constexpr size_t WS_HB = 228 * MiB;
constexpr size_t WS_QK = 260 * MiB;
constexpr size_t WS_XT = 292 * MiB;
constexpr size_t WS_UC = 356 * MiB;
constexpr size_t WS_TAPS = 404 * MiB;
constexpr size_t WS_HYT = 436 * MiB;
constexpr size_t WS_MIXED = 452 * MiB;
constexpr size_t WS_AFF = 484 * MiB;
constexpr size_t WS_IDX = 485 * MiB;
constexpr size_t WS_GATE = 486 * MiB;
constexpr size_t WS_SEL = 487 * MiB;
constexpr size_t WS_Z1T = 488 * MiB;
constexpr size_t WS_XG = WS_XT;
constexpr size_t WS_ACT = WS_UC;
constexpr size_t WS_YE = WS_TAPS;
constexpr size_t WS_END = 504 * MiB;

constexpr int LDS_BYTES = 163840, LDS_MISC_OFF = 163840 - 128;

#define GAS __attribute__((address_space(1)))
#define LAS __attribute__((address_space(3)))
typedef unsigned short bf16;
typedef unsigned v4u __attribute__((ext_vector_type(4)));
typedef unsigned v2u __attribute__((ext_vector_type(2)));
typedef float f32x4 __attribute__((ext_vector_type(4)));
#define LDS_WAIT() asm volatile("s_waitcnt lgkmcnt(0)" ::: "memory")
#define VM_WAIT() asm volatile("s_waitcnt vmcnt(0)" ::: "memory")
__device__ __forceinline__ unsigned f2bf(float f) { unsigned u = __builtin_bit_cast(unsigned, f); return (u + 0x7fffu + ((u >> 16) & 1u)) >> 16; }
__device__ __forceinline__ unsigned pk2(float lo, float hi) { unsigned r; asm("v_cvt_pk_bf16_f32 %0, %1, %2" : "=v"(r) : "v"(lo), "v"(hi)); return r; }
__device__ __forceinline__ float bf2f(unsigned h) { return __builtin_bit_cast(float, h << 16); }
__device__ __forceinline__ float bflo(unsigned w) { return __builtin_bit_cast(float, w << 16); }
__device__ __forceinline__ float bfhi(unsigned w) { return __builtin_bit_cast(float, w & 0xffff0000u); }
__device__ __forceinline__ float wave_sum(float v) {
#pragma unroll
    for (int o = 1; o < 64; o <<= 1) v += __shfl_xor(v, o);
    return v;
}


#define XB_TMO      128
#define XB_XCNT(j)  (256  + 64 * (j))
#define XB_XSUB(j)  (1280 + 64 * (j))
#define XB_XGEN(j)  (2304 + 64 * (j))
#define XB_TOP      3328
#define XB_TOPGEN   3392
#define XCD_BAR_WORDS 3456
#define XB_SPIN_CAP (1u << 22)
__device__ __forceinline__ unsigned xb_ld(unsigned* p)              { return __hip_atomic_load(p, __ATOMIC_RELAXED, __HIP_MEMORY_SCOPE_AGENT); }
__device__ __forceinline__ unsigned xb_add(unsigned* p, unsigned v) { return __hip_atomic_fetch_add(p, v, __ATOMIC_RELAXED, __HIP_MEMORY_SCOPE_AGENT); }
__device__ __forceinline__ unsigned xb_xcc_id() { return (unsigned)__builtin_amdgcn_s_getreg((3 << 11) | 20) & 0xFu; }
#define XB_SPIN(cond, bar) do { unsigned _sp = 0; while (cond) { __builtin_amdgcn_s_sleep(1); \
    if ((++_sp & 255u) == 0u) { if (xb_ld(&(bar)[XB_TMO])) break; if (_sp > XB_SPIN_CAP) { atomicAdd(&(bar)[XB_TMO], 1u); break; } } } } while (0)
struct XcdBarrier { unsigned* bar; unsigned x; volatile LAS unsigned* st; };
__device__ __forceinline__ XcdBarrier xcd_barrier_post(unsigned* bar, volatile LAS unsigned* st) {
    XcdBarrier b; b.bar = bar; b.x = xb_xcc_id(); b.st = st;
    if (threadIdx.x == 0) (void)xb_add(&bar[XB_XCNT(b.x)], 1u);
    return b;
}
__device__ __forceinline__ void xcd_barrier_complete(unsigned* bar, unsigned x, unsigned& nloc, unsigned& nx) {
    const unsigned G = gridDim.x * gridDim.y * gridDim.z;
    unsigned sum, cnt, mine, sp = 0u;
    for (;;) {
        sum = 0u; cnt = 0u; mine = 0u;
#pragma unroll
        for (unsigned j = 0; j < 16; ++j) { const unsigned c = xb_ld(&bar[XB_XCNT(j)]); sum += c; cnt += (c > 0u) ? 1u : 0u; mine = (j == x) ? c : mine; }
        if (sum == G) break;
        __builtin_amdgcn_s_sleep(1);
        if ((++sp & 255u) == 0u) { if (xb_ld(&bar[XB_TMO])) break; if (sp > XB_SPIN_CAP) { atomicAdd(&bar[XB_TMO], 1u); break; } }
    }
    nloc = mine > 0u ? mine : 1u; nx = cnt > 0u ? cnt : 1u;
}
__device__ __forceinline__ void xcd_barrier(const XcdBarrier& b) {
    asm volatile("s_waitcnt vmcnt(0)" ::: "memory");
    __syncthreads();
    if (threadIdx.x == 0) {
        unsigned* bar = b.bar;
        __builtin_amdgcn_s_waitcnt(0);
        unsigned nloc = b.st[0], nx = b.st[1];
        if (nloc == 0u) { xcd_barrier_complete(bar, b.x, nloc, nx); b.st[0] = nloc; b.st[1] = nx; }
        const unsigned old = xb_add(&bar[XB_XSUB(b.x)], 1u);
        const unsigned gen = old / nloc;
        if (old + 1u == (gen + 1u) * nloc) {
            __builtin_amdgcn_fence(__ATOMIC_RELEASE, "agent");
            asm volatile("s_waitcnt vmcnt(0)" ::: "memory");
            const unsigned og = xb_add(&bar[XB_TOP], 1u);
            const unsigned tg = og / nx;
            if (og + 1u == (tg + 1u) * nx) xb_add(&bar[XB_TOPGEN], 1u);
            else XB_SPIN(xb_ld(&bar[XB_TOPGEN]) == tg, bar);
            __builtin_amdgcn_fence(__ATOMIC_ACQUIRE, "agent");
            xb_add(&bar[XB_XGEN(b.x)], 1u);
            asm volatile("s_waitcnt vmcnt(0)" ::: "memory");
        } else {
            XB_SPIN(xb_ld(&bar[XB_XGEN(b.x)]) == gen, bar);
            __builtin_amdgcn_fence(__ATOMIC_ACQUIRE, "agent");
            asm volatile("s_waitcnt vmcnt(0)" ::: "memory");
        }
    }
    __syncthreads();
}

__device__ unsigned g_bar_words[XCD_BAR_WORDS + 64];
struct Frame {
    LAS unsigned char* lds;
    int tid, lane, wave, G, bid;
    const float* in[23]; float* out; unsigned char* ws;
};
#define GW_ID(F) ((F).bid * NWAVES + (F).wave)
#define GW_N(F) ((F).G * NWAVES)

__device__ __forceinline__ void p0_transpose_item(const float* W, int K, int N, bf16* WT, int row_base, int k0, int n0, LAS float* scr, int lane) {
    float t_[32];
#pragma unroll
    for (int i = 0; i < 32; ++i) { const int kk = 2 * i + (lane >> 5); t_[i] = W[(size_t)(k0 + kk) * N + n0 + (lane & 31)]; }
#pragma unroll
    for (int i = 0; i < 32; ++i) { const int kk = 2 * i + (lane >> 5); scr[kk * 33 + (lane & 31)] = t_[i]; }
    LDS_WAIT(); asm volatile("" ::: "memory");
    const int c = lane & 7;
#pragma unroll
    for (int j = 0; j < 4; ++j) { const int n = (lane >> 3) + 8 * j; const LAS float* s = scr + (8 * c) * 33 + n;
        v4u o; o.x = pk2(s[0 * 33], s[1 * 33]); o.y = pk2(s[2 * 33], s[3 * 33]); o.z = pk2(s[4 * 33], s[5 * 33]); o.w = pk2(s[6 * 33], s[7 * 33]);
        *(GAS v4u*)(WT + (size_t)(row_base + n) * K + k0 + 8 * c) = o; }
    LDS_WAIT(); asm volatile("" ::: "memory");
}
__device__ __forceinline__ void phase_p0(Frame& F) {
    LAS float* scr = (LAS float*)(F.lds + F.wave * 16384);
    const int gw = GW_ID(F), NGW = GW_N(F);
    bf16* WinT = (bf16*)(F.ws + WS_WIN); bf16* WoutT = (bf16*)(F.ws + WS_WOUT); bf16* W3T = (bf16*)(F.ws + WS_W3T);
    constexpr int I_IN = (DM / 64) * (INW / 32), I_OUT = (DM / 64) * (DM / 32), I_3 = 1 * (4096 / 32);
    constexpr int NITEMS = I_IN + I_OUT + I_3;
    for (int it = gw; it < NITEMS; it += NGW) {
        int r = it;
        if (r < I_IN) { const int nblk = INW / 32, kb = r / nblk, nb = r % nblk; p0_transpose_item(F.in[2], DM, INW, WinT, 32 * nb, 64 * kb, 32 * nb, scr, F.lane); continue; } r -= I_IN;
        if (r < I_OUT) { const int nblk = DM / 32, kb = r / nblk, nb = r % nblk; p0_transpose_item(F.in[17], DM, DM, WoutT, 32 * nb, 64 * kb, 32 * nb, scr, F.lane); continue; } r -= I_OUT;
        { const int nb = r; p0_transpose_item(F.in[12], FHID, 4096, W3T, 32 * nb, 0, 32 * nb, scr, F.lane); }
    }
    bf16* HB = (bf16*)(F.ws + WS_HB);
    const float* x = F.in[0]; const float* g = F.in[1];
    f32x4 vn[8];
    if (gw < MT) { const GAS f32x4* xr = (const GAS f32x4*)(x + (size_t)gw * DM) + F.lane;
#pragma unroll
        for (int j = 0; j < 8; ++j) vn[j] = xr[64 * j]; }
    for (int m = gw; m < MT; m += NGW) {
        f32x4 v[8]; float s = 0.f;
#pragma unroll
        for (int j = 0; j < 8; ++j) { v[j] = vn[j]; s += (v[j].x * v[j].x + v[j].y * v[j].y) + (v[j].z * v[j].z + v[j].w * v[j].w); }
        if (m + NGW < MT) { const GAS f32x4* xr = (const GAS f32x4*)(x + (size_t)(m + NGW) * DM) + F.lane;
#pragma unroll
            for (int j = 0; j < 8; ++j) vn[j] = xr[64 * j]; }
        const float r = rsqrtf(wave_sum(s) * (1.f / DM) + EPS);
        GAS v2u* o8 = (GAS v2u*)(HB + (size_t)m * DM) + F.lane;
#pragma unroll
        for (int j = 0; j < 8; ++j) { const f32x4 gg = *((const GAS f32x4*)g + F.lane + 64 * j); v2u o; o.x = pk2(v[j].x * r * gg.x, v[j].y * r * gg.y); o.y = pk2(v[j].z * r * gg.z, v[j].w * r * gg.w); o8[64 * j] = o; }
    }
    float* HID2 = (float*)(F.ws + WS_HID2);
    LAS float* sc2 = (LAS float*)(F.lds + F.wave * 16384);
    const float* w1 = F.in[8]; const float* b1 = F.in[9]; const float* w2 = F.in[10]; const float* b2 = F.in[11]; const float* fr = F.in[13];
    for (int l = gw; l < SEQ; l += NGW) {
        const int j = F.lane;
        float zv = 0.f;
        if (j == 0) zv = (float)l / (float)(SEQ - 1);
        else if (j < FEMB) { const int k = (j - 1) & 15; const float f = 1e-4f + (float)k * ((15.0f - 1e-4f) / 15.0f); const float wv = 6.283185307179586f * (float)l / (float)SEQ; zv = (j <= 16) ? cosf(f * wv) : -sinf(f * wv); }
        sc2[j] = zv; LDS_WAIT(); asm volatile("" ::: "memory");
        float a = b1[j];
        for (int i = 0; i < FEMB; ++i) a += sc2[i] * w1[i * FHID + j];
        const float h1 = sinf(fr[j] * a);
        sc2[64 + j] = h1; LDS_WAIT(); asm volatile("" ::: "memory");
        float c = b2[j];
        for (int i = 0; i < FHID; ++i) c += sc2[64 + i] * w2[i * FHID + j];
        HID2[l * FHID + j] = sinf(fr[j] * c);
        LDS_WAIT(); asm volatile("" ::: "memory");
    }
}

typedef short bf16x8 __attribute__((ext_vector_type(8)));
typedef float f32x16 __attribute__((ext_vector_type(16)));
__device__ __forceinline__ void phase_filters(Frame& F) {
    const float* HID2 = (const float*)(F.ws + WS_HID2); const bf16* W3T = (const bf16*)(F.ws + WS_W3T); const float* fbias = F.in[14]; bf16* TAPS = (bf16*)(F.ws + WS_TAPS);
    const int n = F.lane & 31, hh = F.lane >> 5;
    const float mind = -4.605170185988091f / 1.5f, maxd = -4.605170185988091f / 0.3f;
    LAS bf16* scr = (LAS bf16*)(F.lds + F.wave * 4096);
    for (int task = GW_ID(F); task < 128 * 16; task += GW_N(F)) {
        const int l0 = (task & 127) * 32, cg = task >> 7;
        const int dir = (cg >> 2) & 1, o = cg >> 3;
        const int l = l0 + dir + n;
        bf16x8 hb[4];
        { const int lr = l < SEQ ? l : SEQ - 1;
#pragma unroll
          for (int ks = 0; ks < 4; ++ks) { const GAS f32x4* hp = (const GAS f32x4*)(HID2 + (size_t)lr * FHID + 16 * ks + 8 * hh); const f32x4 h0 = hp[0], h1 = hp[1];
              v4u bw; bw.x = pk2(h0.x, h0.y); bw.y = pk2(h0.z, h0.w); bw.z = pk2(h1.x, h1.y); bw.w = pk2(h1.z, h1.w); hb[ks] = __builtin_bit_cast(bf16x8, bw); } }
        const float t = (float)l / (float)(SEQ - 1);
        const int pos = dir ? 31 - n : n;
        const int idx0 = dir ? 4064 - l0 : 4096 + l0;
#pragma unroll 2
        for (int ct = 0; ct < 8; ++ct) {
            const int col0 = (cg * 8 + ct) * 32;
            f32x16 acc;
#pragma unroll
            for (int i = 0; i < 16; ++i) acc[i] = 0.f;
#pragma unroll
            for (int ks = 0; ks < 4; ++ks) { const bf16x8 a = *(const GAS bf16x8*)(W3T + (size_t)(col0 + n) * FHID + 16 * ks + 8 * hh);
                acc = __builtin_amdgcn_mfma_f32_32x32x16_bf16(a, hb[ks], acc, 0, 0, 0); }
#pragma unroll
            for (int i = 0; i < 16; ++i) {
                const int chl = (i & 3) + 8 * (i >> 2) + 4 * hh, c = (col0 & 1023) + chl;
                const float delta = fabsf(mind + (maxd - mind) * ((float)c / 1023.0f));
                float v = acc[i] * __expf(-t * delta);
                if (dir == 0 && l == 0) v += fbias[o * 1024 + c];
                if (l >= SEQ) v = 0.f;
                scr[chl * 40 + pos] = (bf16)f2bf(v);
            }
            LDS_WAIT(); asm volatile("" ::: "memory");
#pragma unroll
            for (int j = 0; j < 2; ++j) { const int id = F.lane + 64 * j, chl = id >> 2, q = id & 3;
                const v4u w = *(const LAS v4u*)(scr + chl * 40 + 8 * q);
                *(GAS v4u*)(TAPS + ((size_t)((col0 & 1023) + chl) * 2 + o) * 8192 + idx0 + 8 * q) = w; }
            LDS_WAIT(); asm volatile("" ::: "memory");
        }
    }
}

constexpr int HY_TAPS_BYTES = 4 * 16384, HY_ZB_ENT = 6080, HY_ZB_BYTES = HY_ZB_ENT * 2;
__device__ __forceinline__ unsigned hy_zb_off(int idx0  ) { const int q = idx0 >> 3; return (unsigned)((q ^ ((q >> 4) & 3)) << 4); }
__device__ __forceinline__ const LAS unsigned char* hy_pm(const LAS unsigned char* zb0, int g, int n, int hh) {
    const int q0 = 124 - 4 * n + 2 * g + hh;
    unsigned p = (unsigned)(size_t)zb0 + (unsigned)(((q0 ^ ((q0 >> 4) & 3)) << 4) - 6144);
    asm volatile("" : "+v"(p));
    return (const LAS unsigned char*)(size_t)p;
}
template <int MASK>
__device__ __forceinline__ void hy_loadB(bf16x8 (&bf)[4], const LAS unsigned char* pm, int b) {
#pragma unroll
    for (int tau = 0; tau < 4; ++tau) if (MASK & (1 << tau)) bf[tau] = *(const LAS bf16x8*)(pm + 2048 * (3 - tau) + b * HY_ZB_BYTES);
}
__device__ __forceinline__ void hy_loadA(unsigned (&d)[5], const LAS bf16* taps, int g, int n, int hh) {
    const volatile LAS unsigned* dp = (const volatile LAS unsigned*)taps + ((1 + 8 * hh + n) >> 1) + 8 * g;
#pragma unroll
    for (int i = 0; i < 5; ++i) d[i] = dp[i];
}
template <int MASK>
__device__ __forceinline__ void hy_mma(f32x16 (&acc)[4], const bf16x8 a, const bf16x8 (&bf)[4]) {
#pragma unroll
    for (int tau = 0; tau < 4; ++tau) if (MASK & (1 << tau)) acc[tau] = __builtin_amdgcn_mfma_f32_32x32x16_bf16(a, bf[tau], acc[tau], 0, 0, 0);
}
#define HY_ALIGN(a, d) do { v4u aw_; aw_.x = __builtin_amdgcn_alignbyte(d[1], d[0], sh); aw_.y = __builtin_amdgcn_alignbyte(d[2], d[1], sh); aw_.z = __builtin_amdgcn_alignbyte(d[3], d[2], sh); aw_.w = __builtin_amdgcn_alignbyte(d[4], d[3], sh); a = __builtin_bit_cast(bf16x8, aw_); } while (0)
#define HY_INTERLEAVE(nv, nds) do { __builtin_amdgcn_sched_group_barrier(0x2, nv, 0); _Pragma("unroll") for (int i_ = 0; i_ < 5; ++i_) { __builtin_amdgcn_sched_group_barrier(0x8, 1, 0); __builtin_amdgcn_sched_group_barrier(0x100, nds, 0); __builtin_amdgcn_sched_group_barrier(0x2, 2, 0); } } while (0)
constexpr int HY_YOFF = 254;
template <int MX, int MY>
__device__ __forceinline__ void hy_segment(f32x16 (&acc)[2][4], const LAS bf16* taps, const LAS unsigned char* zb0, int i0, int i1, int n, int hh) {
    const unsigned sh = (n & 1) ? 0u : 2u;
    unsigned dx[5], dy[5]; bf16x8 ax, ay, x0[4], y0[4], x1[4], y1[4];
    const LAS unsigned char* pmx = hy_pm(zb0, i0, n, hh); const LAS unsigned char* pmy = hy_pm(zb0, i0 + HY_YOFF, n, hh);
    hy_loadA(dx, taps, i0, n, hh); hy_loadA(dy, taps, i0 + HY_YOFF, n, hh); hy_loadB<MX>(x0, pmx, 0); hy_loadB<MY>(y0, pmy, 0);
#pragma unroll 1
    for (int i = i0; i < i1; ++i) {
        HY_ALIGN(ax, dx); HY_ALIGN(ay, dy);
        hy_loadB<MX>(x1, pmx, 1); hy_loadB<MY>(y1, pmy, 1);
        hy_mma<MX>(acc[0], ax, x0); hy_mma<MY>(acc[0], ay, y0);
        HY_INTERLEAVE(8, 1); __builtin_amdgcn_sched_barrier(0);
        hy_loadA(dx, taps, i + 1, n, hh); hy_loadA(dy, taps, i + 1 + HY_YOFF, n, hh);
        pmx = hy_pm(zb0, i + 1, n, hh); pmy = hy_pm(zb0, i + 1 + HY_YOFF, n, hh);
        hy_loadB<MX>(x0, pmx, 0); hy_loadB<MY>(y0, pmy, 0);
        hy_mma<MX>(acc[1], ax, x1); hy_mma<MY>(acc[1], ay, y1);
        HY_INTERLEAVE(0, 3); __builtin_amdgcn_sched_barrier(0);
    }
}
__device__ __forceinline__ void hy_stage_taps(Frame& F, int c0, int o) {
    const bf16* TAPS = (const bf16*)(F.ws + WS_TAPS);
    int tid = F.tid; asm volatile("" : "+v"(tid));
#pragma unroll
    for (int j = 0; j < 8; ++j) { const int ch = tid + NTHREADS * j, ci = ch >> 10, w = ch & 1023;
        *((LAS v4u*)(F.lds) + ch) = *((const GAS v4u*)(TAPS + ((size_t)(c0 + ci) * 2 + o) * 8192) + w); }
}
struct ConvItem { const float* W; bf16* WTe; int N, row_base, k0, n0; };
__device__ __forceinline__ void conv_load64(float (&v)[64], const ConvItem& c, int lane) {
    const GAS float* src = (const GAS float*)(c.W + (size_t)c.k0 * c.N + c.n0 + lane);
#pragma unroll
    for (int kk = 0; kk < 64; ++kk) v[kk] = src[(size_t)kk * c.N];
}
__device__ __forceinline__ void conv_store64(const float (&v)[64], const ConvItem& c, int lane) {
    GAS v4u* dst = (GAS v4u*)c.WTe + (size_t)(c.k0 >> 3) * 2048 + c.row_base + lane;
#pragma unroll
    for (int j = 0; j < 8; ++j) { v4u o; o.x = pk2(v[8 * j], v[8 * j + 1]); o.y = pk2(v[8 * j + 2], v[8 * j + 3]); o.z = pk2(v[8 * j + 4], v[8 * j + 5]); o.w = pk2(v[8 * j + 6], v[8 * j + 7]); dst[(size_t)j * 2048] = o; }
}
constexpr int MOE_ITEMS_GU = 2 * NE * 32 * 16, MOE_ITEMS_D = NE * 16 * 32, MOE_ITEMS = MOE_ITEMS_GU + MOE_ITEMS_D;
#ifndef MOE_P0_ITEMS
#define MOE_P0_ITEMS 0
#endif
constexpr int MOE_HELP_ITEMS = MOE_ITEMS - MOE_P0_ITEMS;
__device__ __forceinline__ ConvItem moe_item(Frame& F, int it) {
    bf16* WguT = (bf16*)(F.ws + WS_WGU); bf16* WdT = (bf16*)(F.ws + WS_WD); ConvItem c;
    if (it < MOE_ITEMS_GU) { const int which = it >> 13, e = (it >> 9) & 15, kb = (it >> 4) & 31, nb = it & 15, f0 = 64 * nb;
        c.W = (which ? F.in[21] : F.in[20]) + (size_t)e * DM * FF; c.N = FF; c.WTe = WguT + (size_t)e * 2048 * DM; c.row_base = (f0 >> 7) * 256 + which * 128 + (f0 & 127); c.k0 = 64 * kb; c.n0 = f0;
    } else { const int r = it - MOE_ITEMS_GU, e = r >> 9, kb = (r >> 5) & 15, nb = r & 31;
        c.W = F.in[22] + (size_t)e * FF * DM; c.N = DM; c.WTe = WdT + (size_t)e * 2048 * FF; c.row_base = 64 * nb; c.k0 = 64 * kb; c.n0 = 64 * nb; }
    return c;
}
__device__ __forceinline__ void moe_conv_item(Frame& F, int it) { float v[64]; const ConvItem c = moe_item(F, it); conv_load64(v, c, F.lane); conv_store64(v, c, F.lane); }
__device__ __forceinline__ void moe_conv_range(Frame& F, int lo, int hi, int step) {
    if (lo >= hi) return;
    float va[64], vb[64];
    ConvItem ca = moe_item(F, lo), cb_; conv_load64(va, ca, F.lane);
    for (int it = lo; it < hi; it += 2 * step) {
        const bool hb = it + step < hi;
        if (hb) { cb_ = moe_item(F, it + step); conv_load64(vb, cb_, F.lane); }
        conv_store64(va, ca, F.lane);
        const bool ha = it + 2 * step < hi;
        if (ha) { ca = moe_item(F, it + 2 * step); conv_load64(va, ca, F.lane); }
        if (hb) conv_store64(vb, cb_, F.lane);
    }
}
__device__ __forceinline__ void hy_write_gates(Frame& F, int c0, int oo) {
    const bf16* XH = (const bf16*)(F.ws + WS_XT) + (size_t)1024 * MT; bf16* GC = (bf16*)(F.ws + WS_UC);
    const float* cw = F.in[6]; const float* cb = F.in[7];
    const int ht = F.tid - 256;
#pragma unroll 2
    for (int k = 0; k < 16; ++k) { const int id = ht + 256 * k, u = id & 511, b = (id >> 9) & 1, ci = id >> 10;
        const int gch = oo * 1024 + c0 + ci; const bf16* gs = XH + (size_t)gch * MT + b * SEQ;
        const float w0 = cw[gch], w1 = cw[3072 + gch], w2 = cw[6144 + gch], bb = cb[gch];
        const v4u w = *((const GAS v4u*)gs + u);
        float f[10];
        f[1] = bflo(w.x); f[2] = bfhi(w.x); f[3] = bflo(w.y); f[4] = bfhi(w.y); f[5] = bflo(w.z); f[6] = bfhi(w.z); f[7] = bflo(w.w); f[8] = bfhi(w.w);
        f[0] = u > 0 ? bf2f(gs[8 * u - 1]) : 0.f; f[9] = u < 511 ? bf2f(gs[8 * u + 8]) : 0.f;
        float z[8];
#pragma unroll
        for (int e = 0; e < 8; ++e) z[e] = bb + w0 * f[e] + w1 * f[e + 1] + w2 * f[e + 2];
        v4u r; r.x = pk2(z[0], z[1]); r.y = pk2(z[2], z[3]); r.z = pk2(z[4], z[5]); r.w = pk2(z[6], z[7]);
        *((GAS v4u*)(GC + ((size_t)((c0 + ci) * 2 + oo) * 2 + b) * SEQ) + u) = r; }
}
__device__ __forceinline__ void phase_hyena(Frame& F) {
    const bf16* XH = (const bf16*)(F.ws + WS_XT) + (size_t)1024 * MT;
    const float* cw = F.in[6]; const float* cb = F.in[7];
    bf16* HYT = (bf16*)(F.ws + WS_HYT); bf16* GC = (bf16*)(F.ws + WS_UC);
    const int n = F.lane & 31, hh = F.lane >> 5;
    const bool compute = F.wave < 4;
    const int nhelp = F.G * 4, hw = F.bid * 4 + (F.wave - 4);
    int sec = 0;
    for (int cg = F.bid; cg < 256; cg += F.G) {
        const int c0 = cg * 4;
        __syncthreads();
        hy_stage_taps(F, c0, 0);
        {
          const int ci = F.wave >> 1, b = F.wave & 1; LAS unsigned char* zb = F.lds + HY_TAPS_BYTES + F.wave * HY_ZB_BYTES;
          const int zch = 2048 + c0 + ci; const bf16* zsrc = XH + (size_t)zch * MT + b * SEQ;
          const float w0 = cw[zch], w1 = cw[3072 + zch], w2 = cw[6144 + zch], bb = cb[zch];
#pragma unroll
          for (int j = 0; j < 8; ++j) { const int u = F.lane + 64 * j; const v4u w = *((const GAS v4u*)zsrc + u);
              float f[10];
              f[1] = bflo(w.x); f[2] = bfhi(w.x); f[3] = bflo(w.y); f[4] = bfhi(w.y); f[5] = bflo(w.z); f[6] = bfhi(w.z); f[7] = bflo(w.w); f[8] = bfhi(w.w);
              f[0] = u > 0 ? bf2f(zsrc[8 * u - 1]) : 0.f; f[9] = u < 511 ? bf2f(zsrc[8 * u + 8]) : 0.f;
              float z[8];
#pragma unroll
              for (int e = 0; e < 8; ++e) z[e] = bb + w0 * f[e] + w1 * f[e + 1] + w2 * f[e + 2];
              v4u r; r.x = pk2(z[7], z[6]); r.y = pk2(z[5], z[4]); r.z = pk2(z[3], z[2]); r.w = pk2(z[1], z[0]);
              *(LAS v4u*)(zb + hy_zb_off(8 * (635 - u))) = r; }
          const v4u zero = {0u, 0u, 0u, 0u};
          for (int q = F.lane; q < 124; q += 64) { *(LAS v4u*)(zb + hy_zb_off(8 * q)) = zero; *(LAS v4u*)(zb + hy_zb_off(8 * (636 + q))) = zero; } }
        if (!compute) hy_write_gates(F, c0, 0);
        __syncthreads();
#pragma unroll 1
        for (int o = 0; o < 2; ++o) {
            if (compute) {
                const int ci = F.wave, c = c0 + ci;
                const LAS bf16* taps = (const LAS bf16*)(F.lds + ci * 16384);
                LAS unsigned char* zb0 = F.lds + HY_TAPS_BYTES + (2 * ci) * HY_ZB_BYTES;
                f32x16 acc[2][4];
#pragma unroll
                for (int b = 0; b < 2; ++b)
#pragma unroll
                    for (int tau = 0; tau < 4; ++tau)
#pragma unroll
                        for (int i = 0; i < 16; ++i) acc[b][tau][i] = 0.f;
                hy_segment<1, 15>(acc, taps, zb0, 0, 64, n, hh);
                hy_segment<3, 14>(acc, taps, zb0, 64, 128, n, hh);
                hy_segment<7, 12>(acc, taps, zb0, 128, 192, n, hh);
                hy_segment<15, 8>(acc, taps, zb0, 192, 254, n, hh);
                hy_segment<0, 8>(acc, taps, zb0, 254, 256, n, hh);
                LDS_WAIT();
                int n2 = n, h2 = hh; asm volatile("" : "+v"(n2), "+v"(h2));
#pragma unroll
                for (int b = 0; b < 2; ++b) {
                    const bf16* gate = GC + ((size_t)(c * 2 + o) * 2 + b) * SEQ;
                    LAS unsigned char* zb = zb0 + b * HY_ZB_BYTES; bf16* outp = HYT + (size_t)c * MT + b * SEQ;
                    v2u gw[4][4];
#pragma unroll
                    for (int tau = 0; tau < 4; ++tau)
#pragma unroll
                        for (int rg = 0; rg < 4; ++rg) gw[tau][rg] = *(const GAS v2u*)(gate + 1024 * tau + 32 * n2 + 8 * rg + 4 * h2);
#pragma unroll
                    for (int tau = 0; tau < 4; ++tau) {
#pragma unroll
                        for (int rg = 0; rg < 4; ++rg) { const int t0 = 1024 * tau + 32 * n2 + 8 * rg + 4 * h2;
                            const float z0 = bflo(gw[tau][rg].x) * acc[b][tau][4 * rg + 0], z1 = bfhi(gw[tau][rg].x) * acc[b][tau][4 * rg + 1], z2 = bflo(gw[tau][rg].y) * acc[b][tau][4 * rg + 2], z3 = bfhi(gw[tau][rg].y) * acc[b][tau][4 * rg + 3];
                            if (o == 0) { v2u w; w.x = pk2(z3, z2); w.y = pk2(z1, z0);
                                *(LAS v2u*)(zb + hy_zb_off(8 * (635 - (t0 >> 3))) + (h2 ? 0 : 8)) = w; }
                            else { v2u w; w.x = pk2(z0, z1); w.y = pk2(z2, z3); *(GAS v2u*)(outp + t0) = w; } } }
                }
            } else {
                if (o == 0) hy_write_gates(F, c0, 1);
                const int lo_it = MOE_P0_ITEMS + sec * (MOE_HELP_ITEMS / 2), hi_it = lo_it + MOE_HELP_ITEMS / 2;
                if (sec < 2) moe_conv_range(F, lo_it + hw, hi_it, nhelp);
            }
            ++sec;
            if (o == 0) {
                __syncthreads();
                hy_stage_taps(F, c0, 1);
                __syncthreads();
            }
        }
    }
    for (; sec < 2; ++sec) if (!compute) { const int lo_it = MOE_P0_ITEMS + sec * (MOE_HELP_ITEMS / 2), hi_it = lo_it + MOE_HELP_ITEMS / 2; moe_conv_range(F, lo_it + hw, hi_it, nhelp); }
    __syncthreads();
}

constexpr int AT_KBYTES = 16384, AT_VPITCH = 136, AT_VBYTES = 128 * AT_VPITCH, AT_STAGE = AT_KBYTES + AT_VBYTES, AT_RP_OFF = 2 * AT_STAGE;
__device__ __forceinline__ void phase_attn2(Frame& F) {
    const bf16* QK = (const bf16*)(F.ws + WS_QK); const bf16* VT = (const bf16*)(F.ws + WS_XT); bf16* MIXED = (bf16*)(F.ws + WS_MIXED);
    const float* rpb = F.in[5]; const float* og = F.in[15]; const float* qg = F.in[3]; const float* kg = F.in[4];
    LAS float* rt = (LAS float*)(F.lds + AT_RP_OFF);
    LAS float* gtab = (LAS float*)(F.lds + AT_RP_OFF + 8 * 2048);
    if (F.tid < HD) gtab[F.tid] = qg[F.tid] * kg[F.tid];
    const int n = F.lane & 31, hh = F.lane >> 5;
    for (int unit = F.bid; unit < NB * NH * 16; unit += F.G) {
        const int rq = unit & 15, h = (unit >> 4) & 7, b = unit >> 7, r0 = 4 * rq;
        const int r = r0 + (F.wave >> 1), wq = F.wave & 1;
        int kmin = r0 - WR / 2; kmin = kmin < 0 ? 0 : (kmin > NROWS - WR ? NROWS - WR : kmin);
        int kmax = r0 + 3 - WR / 2; kmax = (kmax < 0 ? 0 : (kmax > NROWS - WR ? NROWS - WR : kmax)) + WR - 1;
        int kr0 = r - WR / 2; kr0 = kr0 < 0 ? 0 : (kr0 > NROWS - WR ? NROWS - WR : kr0);
        const int nrows = kmax - kmin + 1;
        __syncthreads();
        for (int i = F.tid; i < 15 * 128; i += NTHREADS) { const int dr_ = i >> 7, dcx = (i & 127) - 48; rt[i] = (dcx >= 0 && dcx <= 30) ? rpb[h * 465 + dr_ * 31 + dcx] * 1.4426950408889634f : 0.f; }
        const int mq = b * SEQ + r * GW + 32 * wq + n, qc = 32 * wq + n;
        int c0 = qc - WC / 2; c0 = c0 < 0 ? 0 : (c0 > GW - WC ? GW - WC : c0);
        bf16x8 qf[8];
#pragma unroll
        for (int ks = 0; ks < 8; ++ks) qf[ks] = *(const GAS bf16x8*)(QK + (size_t)mq * 2048 + h * HD + 16 * ks + 8 * hh);
        float qscale;
        {
          f32x16 D;
#pragma unroll
          for (int i = 0; i < 16; ++i) D[i] = 0.f;
#pragma unroll
          for (int ks = 0; ks < 8; ++ks) D = __builtin_amdgcn_mfma_f32_32x32x16_bf16(qf[ks], qf[ks], D, 0, 0, 0);
          float dsel = 0.f; const int isel = (n & 3) + 4 * (n >> 3);
#pragma unroll
          for (int i = 0; i < 16; ++i) dsel = (i == isel) ? D[i] : dsel;
          const float other = __shfl_xor(dsel, 32);
          const float ssq = (((n >> 2) & 1) == hh) ? dsel : other;
          qscale = (0.08838834764831845f * 1.4426950408889634f) * rsqrtf(ssq * (1.f / HD) + EPS); }
        const unsigned long long wmask = (c0 >= 4 * hh) ? (0xFFFFull << (c0 - 4 * hh)) : (0xFFFFull >> (4 * hh - c0));
        const unsigned wm0 = (unsigned)wmask, wm1 = (unsigned)(wmask >> 32);
        const int rtl = 4 * hh - qc + 63;
        f32x16 O[4];
#pragma unroll
        for (int dt = 0; dt < 4; ++dt)
#pragma unroll
            for (int i = 0; i < 16; ++i) O[dt][i] = 0.f;
        float lsum = 0.f;
        v4u sk[2], sv[2];

        auto gload = [&](int kr) {
#pragma unroll
            for (int j = 0; j < 2; ++j) { const int id = F.tid + 512 * j;
                sk[j] = *(const GAS v4u*)(QK + (size_t)(b * SEQ + kr * GW + (id >> 4)) * 2048 + 1024 + h * HD + 8 * (id & 15));
                sv[j] = *(const GAS v4u*)(VT + (size_t)(h * HD + (id >> 3)) * MT + b * SEQ + kr * GW + 8 * (id & 7)); }
        };
        auto lstore = [&](int buf) {
            LAS unsigned char* kb = F.lds + buf * AT_STAGE; LAS unsigned char* vb = kb + AT_KBYTES;
#pragma unroll
            for (int j = 0; j < 2; ++j) { const int id = F.tid + 512 * j; const int key = id >> 4, c = id & 15;
                float f[8] = {bflo(sk[j].x), bfhi(sk[j].x), bflo(sk[j].y), bfhi(sk[j].y), bflo(sk[j].z), bfhi(sk[j].z), bflo(sk[j].w), bfhi(sk[j].w)};
                float ss = 0.f;
#pragma unroll
                for (int e = 0; e < 8; ++e) ss += f[e] * f[e];
                ss += __shfl_xor(ss, 1); ss += __shfl_xor(ss, 2); ss += __shfl_xor(ss, 4); ss += __shfl_xor(ss, 8);
                const float rk = rsqrtf(ss * (1.f / HD) + EPS);
                const f32x4 ga = *(const LAS f32x4*)(gtab + 8 * c), gb = *(const LAS f32x4*)(gtab + 8 * c + 4);
                v4u kn; kn.x = pk2(f[0] * rk * ga.x, f[1] * rk * ga.y); kn.y = pk2(f[2] * rk * ga.z, f[3] * rk * ga.w); kn.z = pk2(f[4] * rk * gb.x, f[5] * rk * gb.y); kn.w = pk2(f[6] * rk * gb.z, f[7] * rk * gb.w);
                *(LAS v4u*)(kb + key * 256 + ((c ^ (key & 15)) << 4)) = kn;
                const int d = id >> 3, cv = id & 7; LAS v2u* vp = (LAS v2u*)(vb + d * AT_VPITCH + cv * 16);
                v2u lo, hi; lo.x = sv[j].x; lo.y = sv[j].y; hi.x = sv[j].z; hi.y = sv[j].w; vp[0] = lo; vp[1] = hi; }
        };
        gload(kmin); lstore(0);
        __syncthreads();
#pragma unroll 1
        for (int j = 0; j < nrows; ++j) {
            const int kr = kmin + j, buf = j & 1;
            if (j + 1 < nrows) gload(kr + 1);
            if (kr >= kr0 && kr < kr0 + WR) {
                const LAS unsigned char* kb = F.lds + buf * AT_STAGE; const LAS unsigned char* vb = kb + AT_KBYTES;
                const int dr = kr - r + WR - 1;
                const LAS float* rrow = rt + dr * 128 + rtl;
#pragma unroll
                for (int kt = 0; kt < 2; ++kt) {
                    f32x16 S;
#pragma unroll
                    for (int i = 0; i < 16; ++i) S[i] = 0.f;
                    const int key = 32 * kt + n;
#pragma unroll
                    for (int ks = 0; ks < 8; ++ks) { const bf16x8 kf = *(const LAS bf16x8*)(kb + key * 256 + (((2 * ks + hh) ^ (key & 15)) << 4));
                        S = __builtin_amdgcn_mfma_f32_32x32x16_bf16(kf, qf[ks], S, 0, 0, 0); }
                    float p[16];
#pragma unroll
                    for (int i = 0; i < 16; ++i) { const int E = (i & 3) + 8 * (i >> 2);
                        const float e = __builtin_amdgcn_exp2f(S[i] * qscale + rrow[32 * kt + E]);
                        const unsigned keep = (unsigned)__builtin_amdgcn_sbfe((int)(kt ? wm1 : wm0), E, 1);
                        p[i] = __builtin_bit_cast(float, __builtin_bit_cast(unsigned, e) & keep); lsum += p[i]; }
                    v4u pw0, pw1;
                    pw0.x = pk2(p[0], p[1]); pw0.y = pk2(p[2], p[3]); pw0.z = pk2(p[4], p[5]); pw0.w = pk2(p[6], p[7]);
                    pw1.x = pk2(p[8], p[9]); pw1.y = pk2(p[10], p[11]); pw1.z = pk2(p[12], p[13]); pw1.w = pk2(p[14], p[15]);
                    const bf16x8 pf0 = __builtin_bit_cast(bf16x8, pw0), pf1 = __builtin_bit_cast(bf16x8, pw1);
#pragma unroll
                    for (int dt = 0; dt < 4; ++dt) {
                        const LAS unsigned char* vrow = vb + (32 * dt + n) * AT_VPITCH + (32 * kt + 4 * hh) * 2;
                        const v2u a0 = *(const LAS v2u*)(vrow), a1 = *(const LAS v2u*)(vrow + 16), a2 = *(const LAS v2u*)(vrow + 32), a3 = *(const LAS v2u*)(vrow + 48);
                        v4u f0, f1; f0.x = a0.x; f0.y = a0.y; f0.z = a1.x; f0.w = a1.y; f1.x = a2.x; f1.y = a2.y; f1.z = a3.x; f1.w = a3.y;
                        O[dt] = __builtin_amdgcn_mfma_f32_32x32x16_bf16(__builtin_bit_cast(bf16x8, f0), pf0, O[dt], 0, 0, 0);
                        O[dt] = __builtin_amdgcn_mfma_f32_32x32x16_bf16(__builtin_bit_cast(bf16x8, f1), pf1, O[dt], 0, 0, 0);
                    }
                }
            }
            if (j + 1 < nrows) lstore(buf ^ 1);
            __syncthreads();
        }
        lsum += __shfl_xor(lsum, 32);
        const float il = 1.f / lsum;
        float ss = 0.f;
#pragma unroll
        for (int dt = 0; dt < 4; ++dt)
#pragma unroll
            for (int i = 0; i < 16; ++i) { O[dt][i] *= il; ss += O[dt][i] * O[dt][i]; }
        ss += __shfl_xor(ss, 32);
        const float rr = rsqrtf(ss * (1.f / HD) + EPS);
        bf16* orow = MIXED + (size_t)mq * DM + h * HD;
#pragma unroll
        for (int dt = 0; dt < 4; ++dt)
#pragma unroll
            for (int rg = 0; rg < 4; ++rg) { const int d = 32 * dt + 8 * rg + 4 * hh; const f32x4 gg = *(const GAS f32x4*)(og + h * HD + d);
                v2u w; w.x = pk2(O[dt][4 * rg + 0] * rr * gg.x, O[dt][4 * rg + 1] * rr * gg.y); w.y = pk2(O[dt][4 * rg + 2] * rr * gg.z, O[dt][4 * rg + 3] * rr * gg.w);
                *(GAS v2u*)(orow + d) = w; }
    }
    __syncthreads();
}

__device__ __forceinline__ void phase_p25(Frame& F) {
    const bf16* HYT = (const bf16*)(F.ws + WS_HYT); bf16* MIXED = (bf16*)(F.ws + WS_MIXED); const float* hg = F.in[16];
    LAS float* tile = (LAS float*)F.lds;
    LAS float* rs = (LAS float*)(F.lds + 128 * 65 * 4);
    for (int it = F.bid; it < 8 * (MT / 64); it += F.G) {
        const int gi = it & 7, m0 = (it >> 3) * 64;
        { const int ch = F.tid >> 2, t0 = (F.tid & 3) * 16; const bf16* p = HYT + (size_t)(gi * 128 + ch) * MT + m0 + t0;
          const v4u a = *(const GAS v4u*)p, b = *(const GAS v4u*)(p + 8);
          LAS float* d = tile + ch * 65 + t0;
          d[0] = bflo(a.x); d[1] = bfhi(a.x); d[2] = bflo(a.y); d[3] = bfhi(a.y); d[4] = bflo(a.z); d[5] = bfhi(a.z); d[6] = bflo(a.w); d[7] = bfhi(a.w);
          d[8] = bflo(b.x); d[9] = bfhi(b.x); d[10] = bflo(b.y); d[11] = bfhi(b.y); d[12] = bflo(b.z); d[13] = bfhi(b.z); d[14] = bflo(b.w); d[15] = bfhi(b.w); }
        __syncthreads();
        {
          const int t = F.tid >> 3, c0 = (F.tid & 7) * 16; float ss = 0.f;
#pragma unroll
          for (int c = 0; c < 16; ++c) { const float v = tile[(c0 + c) * 65 + t]; ss += v * v; }
          ss += __shfl_xor(ss, 1); ss += __shfl_xor(ss, 2); ss += __shfl_xor(ss, 4);
          if ((F.tid & 7) == 0) rs[t] = rsqrtf(ss * (1.f / 128) + EPS); }
        __syncthreads();
        {
          const int t = F.tid >> 3, c0 = (F.tid & 7) * 16; const float r = rs[t]; float o[16];
#pragma unroll
          for (int c = 0; c < 16; ++c) o[c] = tile[(c0 + c) * 65 + t] * r * hg[gi * 128 + c0 + c];
          v4u a, b; a.x = pk2(o[0], o[1]); a.y = pk2(o[2], o[3]); a.z = pk2(o[4], o[5]); a.w = pk2(o[6], o[7]); b.x = pk2(o[8], o[9]); b.y = pk2(o[10], o[11]); b.z = pk2(o[12], o[13]); b.w = pk2(o[14], o[15]);
          bf16* q = MIXED + (size_t)(m0 + t) * DM + AW + gi * 128 + c0; *(GAS v4u*)q = a; *(GAS v4u*)(q + 8) = b; }
        __syncthreads();
    }
}
__device__ __forceinline__ void phase_p35(Frame& F) {
    LAS float* wrT = (LAS float*)F.lds;
    const float* wr = F.in[19]; const float* g = F.in[18];
    constexpr int WRS = DM + 4;
    for (int i = F.tid; i < DM * NE; i += NTHREADS) { const int d = i >> 4, e = i & 15; wrT[e * WRS + d] = wr[i]; }
    __syncthreads();
    bf16* HB = (bf16*)(F.ws + WS_HB); float* AFF = (float*)(F.ws + WS_AFF); const float* x1 = F.out;
    f32x4 vn[8];
    { const int m0 = GW_ID(F); if (m0 < MT) { const GAS f32x4* xr = (const GAS f32x4*)(x1 + (size_t)m0 * DM) + F.lane;
#pragma unroll
        for (int j = 0; j < 8; ++j) vn[j] = xr[64 * j]; } }
    for (int m = GW_ID(F); m < MT; m += GW_N(F)) {
        f32x4 v[8]; float s = 0.f;
#pragma unroll
        for (int j = 0; j < 8; ++j) { v[j] = vn[j]; s += (v[j].x * v[j].x + v[j].y * v[j].y) + (v[j].z * v[j].z + v[j].w * v[j].w); }
        if (m + GW_N(F) < MT) { const GAS f32x4* xr = (const GAS f32x4*)(x1 + (size_t)(m + GW_N(F)) * DM) + F.lane;
#pragma unroll
            for (int j = 0; j < 8; ++j) vn[j] = xr[64 * j]; }
        const float r = rsqrtf(wave_sum(s) * (1.f / DM) + EPS);
        GAS v2u* o8 = (GAS v2u*)(HB + (size_t)m * DM) + F.lane;
#pragma unroll
        for (int j = 0; j < 8; ++j) { const f32x4 gg = *((const GAS f32x4*)g + F.lane + 64 * j); v[j].x *= r * gg.x; v[j].y *= r * gg.y; v[j].z *= r * gg.z; v[j].w *= r * gg.w;
            v2u o; o.x = pk2(v[j].x, v[j].y); o.y = pk2(v[j].z, v[j].w); o8[64 * j] = o; }
        float mine = 0.f;
#pragma unroll 1
        for (int e = 0; e < NE; ++e) { float a = 0.f;
#pragma unroll
            for (int j = 0; j < 8; ++j) { const f32x4 w = *((const LAS f32x4*)(wrT + e * WRS) + F.lane + 64 * j); a += (v[j].x * w.x + v[j].y * w.y) + (v[j].z * w.z + v[j].w * w.w); }
            a = wave_sum(a); mine = (F.lane == e) ? a : mine; }
        float mx = mine;
        mx = fmaxf(mx, __shfl_xor(mx, 1)); mx = fmaxf(mx, __shfl_xor(mx, 2)); mx = fmaxf(mx, __shfl_xor(mx, 4)); mx = fmaxf(mx, __shfl_xor(mx, 8));
        const float ex = expf(mine - mx); float den = ex;
        den += __shfl_xor(den, 1); den += __shfl_xor(den, 2); den += __shfl_xor(den, 4); den += __shfl_xor(den, 8);
        const int b = m / SEQ, sidx = m % SEQ;
        if (F.lane < NE) AFF[((size_t)b * NE + F.lane) * SEQ + sidx] = ex / den;
    }
    __syncthreads();
}
__device__ __forceinline__ void phase_p4(Frame& F) {
    LAS unsigned* key = (LAS unsigned*)F.lds;
    LAS unsigned* hist = (LAS unsigned*)(F.lds + 16384);
    LAS unsigned* wsum = (LAS unsigned*)(F.lds + 16384 + 1024);
    const float* AFF = (const float*)(F.ws + WS_AFF); int* IDX = (int*)(F.ws + WS_IDX); float* GATE = (float*)(F.ws + WS_GATE); int* SEL = (int*)(F.ws + WS_SEL);
    for (int be = F.bid; be < NB * NE; be += F.G) {
        const int b = be / NE, e = be % NE;
        __syncthreads();
        const GAS v4u* ap = (const GAS v4u*)(AFF + (size_t)be * SEQ);
        const v4u k0 = ap[2 * F.tid], k1 = ap[2 * F.tid + 1];
        unsigned kk[8] = {k0.x, k0.y, k0.z, k0.w, k1.x, k1.y, k1.z, k1.w};
        unsigned prefix = 0u, mask = 0u, remaining = CAP;
#pragma unroll 1
        for (int pass = 0; pass < 4; ++pass) {
            const int shift = 24 - 8 * pass;
            if (F.tid < 256) hist[F.tid] = 0u;
            __syncthreads();
#pragma unroll
            for (int i = 0; i < 8; ++i) if ((kk[i] & mask) == prefix) __hip_atomic_fetch_add(&hist[(kk[i] >> shift) & 255u], 1u, __ATOMIC_RELAXED, __HIP_MEMORY_SCOPE_WORKGROUP);
            __syncthreads();
            unsigned incl_ = 0u, mine_ = 0u;
            if (F.tid < 256) {
                mine_ = hist[255 - F.tid]; incl_ = mine_;
#pragma unroll
                for (int o = 1; o < 64; o <<= 1) { const unsigned t = __shfl_up(incl_, o); if (F.lane >= o) incl_ += t; }
                if (F.lane == 63) wsum[10 + F.wave] = incl_;
            }
            __syncthreads();
            if (F.tid < 256) {
                unsigned base = 0u;
                for (int w = 0; w < F.wave; ++w) base += wsum[10 + w];
                const unsigned above = base + incl_ - mine_;
                if (above < remaining && remaining <= above + mine_) { wsum[8] = (unsigned)(255 - F.tid); wsum[9] = above; }
            }
            __syncthreads();
            const unsigned d = wsum[8], above = wsum[9];
            prefix |= d << shift; mask |= 255u << shift; remaining -= above;
            __syncthreads();
        }
        const unsigned thr = prefix;
        unsigned cnt = 0u;
#pragma unroll
        for (int i = 0; i < 8; ++i) cnt += (kk[i] > thr ? 0x10000u : 0u) + (kk[i] == thr ? 1u : 0u);
        unsigned incl = cnt;
#pragma unroll
        for (int o = 1; o < 64; o <<= 1) { const unsigned t = __shfl_up(incl, o); if (F.lane >= o) incl += t; }
        if (F.lane == 63) wsum[F.wave] = incl;
        __syncthreads();
        unsigned base = 0u;
        for (int w = 0; w < F.wave; ++w) base += wsum[w];
        unsigned run = base + incl - cnt;
#pragma unroll
        for (int i = 0; i < 8; ++i) {
            const unsigned gt_before = run >> 16, tie_before = run & 0xffffu;
            const bool isgt = kk[i] > thr, istie = kk[i] == thr;
            const bool sel = isgt || (istie && tie_before < remaining);
            const unsigned slot = gt_before + (tie_before < remaining ? tie_before : remaining);
            const int s = 8 * F.tid + i, m = b * SEQ + s;
            if (sel) { IDX[be * CAP + slot] = m; GATE[be * CAP + slot] = __builtin_bit_cast(float, kk[i]); }
            SEL[(size_t)m * NE + e] = sel ? (int)slot : -1;
            run += (isgt ? 0x10000u : 0u) + (istie ? 1u : 0u);
        }
    }
    __syncthreads();
}
__device__ __forceinline__ void phase_p7(Frame& F) {
    const int* SEL = (const int*)(F.ws + WS_SEL); const float* GATE = (const float*)(F.ws + WS_GATE); const bf16* YE = (const bf16*)(F.ws + WS_YE);
    for (int m = GW_ID(F); m < MT; m += GW_N(F)) {
        const int b = m / SEQ;
        GAS f32x4* orow = (GAS f32x4*)(F.out + (size_t)m * DM);
        f32x4 acc[8];
#pragma unroll
        for (int j = 0; j < 8; ++j) acc[j] = orow[2 * F.lane + (j & 1) + 128 * (j >> 1)];
        for (int e = 0; e < NE; ++e) { const int slot = SEL[(size_t)m * NE + e]; if (slot >= 0) {
            const GAS v4u* yr = (const GAS v4u*)(YE + (size_t)((b * NE + e) * CAP + slot) * DM) + F.lane;
#pragma unroll
            for (int jj = 0; jj < 4; ++jj) { const v4u w = yr[64 * jj];
                acc[2 * jj].x += bflo(w.x); acc[2 * jj].y += bfhi(w.x); acc[2 * jj].z += bflo(w.y); acc[2 * jj].w += bfhi(w.y);
                acc[2 * jj + 1].x += bflo(w.z); acc[2 * jj + 1].y += bfhi(w.z); acc[2 * jj + 1].z += bflo(w.w); acc[2 * jj + 1].w += bfhi(w.w); } } }
#pragma unroll
        for (int j = 0; j < 8; ++j) orow[2 * F.lane + (j & 1) + 128 * (j >> 1)] = acc[j];
    }
    (void)GATE;
}

struct Args { const float* in[23]; float* out; unsigned char* ws; int ph_lo, ph_hi; };
enum Phase { PH_P0 = 0, PH_G1, PH_ATTN, PH_P25, PH_OUT, PH_P35, PH_P4, PH_UP, PH_DOWN, PH_P7, PH_COUNT };

__global__ void __launch_bounds__(NTHREADS, 2) mk_fwd(Args args) {
    extern __shared__ __attribute__((aligned(16))) unsigned char lds_raw[];
    Frame F;
    F.lds = (LAS unsigned char*)lds_raw;
    F.tid = threadIdx.x; F.lane = F.tid & 63; F.wave = __builtin_amdgcn_readfirstlane(F.tid >> 6); F.G = gridDim.x; F.bid = blockIdx.x;
#pragma unroll
    for (int i = 0; i < 23; ++i) F.in[i] = args.in[i];
    F.out = args.out; F.ws = args.ws;
    const int lo = args.ph_lo, hi = args.ph_hi;
#define IN(k) (lo <= (k) && (k) < hi)
#define REPS(k) for (int rep_ = 0; rep_ < ((k) == REP_PHASE ? REP_N : 1); ++rep_)
#if MK_N_LAUNCHES == 1
    { volatile LAS unsigned* misc = (volatile LAS unsigned*)(F.lds + LDS_MISC_OFF); if (F.tid < 16) misc[F.tid] = 0u; }
    __syncthreads();
    XcdBarrier bar = xcd_barrier_post(g_bar_words, (volatile LAS unsigned*)(F.lds + LDS_MISC_OFF) + 8);
#define SEAM(k) do { if (IN(k) && IN((k) + 1)) xcd_barrier(bar); } while (0)
#else
#define SEAM(k) do { } while (0)
#endif
    if (IN(PH_P0)) REPS(PH_P0) { phase_p0(F); for (int it = GW_ID(F); it < MOE_P0_ITEMS; it += GW_N(F)) moe_conv_item(F, it); } SEAM(PH_P0);
    if (IN(PH_G1)) REPS(PH_G1) {
        phase_filters(F);
        __syncthreads();
        { pg8::DenseOrder S; S.init(F.ws + WS_HB, F.ws + WS_WIN, MT, 2048, DM, 0, F.G, F.bid);
          pg8::EpiBf16 E{(pg8::bf16_t*)(F.ws + WS_QK), 2048, 0, nullptr};
          pg8::gemm_phase<pg8::EpiBf16, pg8::DenseOrder, true>(F.lds, DM, S, E); }
        { pg8::DenseOrder S; S.init(F.ws + WS_HB, F.ws + WS_WIN, MT, 4096, DM, 8, F.G, F.bid);
          pg8::EpiTransBf16 E{(pg8::bf16_t*)(F.ws + WS_XT), MT, 8};
          pg8::gemm_phase<pg8::EpiTransBf16, pg8::DenseOrder, true>(F.lds, DM, S, E); }
    } SEAM(PH_G1);
    if (IN(PH_ATTN)) { __syncthreads(); for (int rep_ = 0; rep_ < ((PH_ATTN == REP_PHASE && REP_SUB != 2) ? REP_N : 1); ++rep_) phase_hyena(F); for (int rep_ = 0; rep_ < ((PH_ATTN == REP_PHASE && REP_SUB != 1) ? REP_N : 1); ++rep_) phase_attn2(F); } SEAM(PH_ATTN);
    if (IN(PH_P25)) REPS(PH_P25) { __syncthreads(); phase_p25(F); } SEAM(PH_P25);
    if (IN(PH_OUT)) REPS(PH_OUT) {
        __syncthreads();
        pg8::DenseOrder S; S.init(F.ws + WS_MIXED, F.ws + WS_WOUT, MT, DM, DM, 0, F.G, F.bid);
        pg8::EpiResF32 E{F.in[0], F.out, DM};
        pg8::gemm_phase<pg8::EpiResF32, pg8::DenseOrder, false>(F.lds, DM, S, E);
    } SEAM(PH_OUT);
    if (IN(PH_P35)) REPS(PH_P35) { __syncthreads(); phase_p35(F); } SEAM(PH_P35);
    if (IN(PH_P4)) REPS(PH_P4) { __syncthreads(); phase_p4(F); } SEAM(PH_P4);
    if (IN(PH_UP)) REPS(PH_UP) {
        __syncthreads();
        pg8::MoeOrder S; S.init(F.ws + WS_HB, F.ws + WS_WGU, DM, F.G, F.bid, true);
        LAS int* ridx = (LAS int*)(F.lds + 131072);
        { const int* IDX = (const int*)(F.ws + WS_IDX); pg8::Unit u;
          for (int i = 0; S.next(i, u); ++i) if (F.tid < 256) ridx[i * 256 + F.tid] = IDX[u.g * CAP + u.pm * 256 + F.tid]; }
        __syncthreads();
        pg8::EpiSwiGLU E{(pg8::bf16_t*)(F.ws + WS_ACT)};
        pg8::gemm_phase<pg8::EpiSwiGLU, pg8::MoeOrder, true, true>(F.lds, DM, S, E, ridx);
    } SEAM(PH_UP);
    if (IN(PH_DOWN)) REPS(PH_DOWN) {
        __syncthreads();
        pg8::MoeOrder S; S.init(F.ws + WS_ACT, F.ws + WS_WD, FF, F.G, F.bid, false);
        pg8::EpiBf16 E{(pg8::bf16_t*)(F.ws + WS_YE), DM, 512, (const float*)(F.ws + WS_GATE)};
        pg8::gemm_phase<pg8::EpiBf16, pg8::MoeOrder, true>(F.lds, FF, S, E);
    } SEAM(PH_DOWN);
    if (IN(PH_P7)) { phase_p7(F); }
#if MK_N_LAUNCHES == 1
    __syncthreads();
    { volatile LAS unsigned* misc = (volatile LAS unsigned*)(F.lds + LDS_MISC_OFF);
      if (F.tid == 0) misc[0] = (xb_add(&g_bar_words[XCD_BAR_WORDS], 1u) + 1u == (unsigned)F.G) ? 1u : 0u;
      __syncthreads();
      if (misc[0] != 0u && F.tid < (XCD_BAR_WORDS + 64) / 64) __hip_atomic_store(&g_bar_words[64 * F.tid], 0u, __ATOMIC_RELAXED, __HIP_MEMORY_SCOPE_AGENT); }
#endif
#undef IN
#undef SEAM
}

extern "C" void kernel_launch(void* const* d_in, const int* in_sizes, int n_in, void* d_out, int out_size, void* d_ws, size_t ws_size, hipStream_t stream) {
    static int grid = 0;
    if (grid == 0) {
        if (n_in != 23 || ws_size < WS_END) { fprintf(stderr, "kernel_launch: unexpected inputs (n_in %d, ws %zu)\n", n_in, ws_size); grid = -1; return; }
        if (hipFuncSetAttribute((const void*)mk_fwd, hipFuncAttributeMaxDynamicSharedMemorySize, LDS_BYTES) != hipSuccess) { fprintf(stderr, "kernel_launch: hipFuncSetAttribute failed\n"); grid = -1; return; }
        int dev = 0, cus = 0, per_cu = 0;
        hipGetDevice(&dev); hipDeviceGetAttribute(&cus, hipDeviceAttributeMultiprocessorCount, dev);
        hipOccupancyMaxActiveBlocksPerMultiprocessor(&per_cu, (const void*)mk_fwd, NTHREADS, LDS_BYTES);
        (void)hipGetLastError();
        if (per_cu < 1) { fprintf(stderr, "kernel_launch: occupancy query says %d blocks/CU\n", per_cu); }
        grid = cus;
    }
    if (grid < 0) return;
    Args a{};
    for (int i = 0; i < 23; ++i) a.in[i] = (const float*)d_in[i];
    a.out = (float*)d_out; a.ws = (unsigned char*)d_ws;
#if MK_N_LAUNCHES == 1
    a.ph_lo = 0; a.ph_hi = PH_COUNT;
    hipLaunchKernelGGL(mk_fwd, dim3(grid), dim3(NTHREADS), LDS_BYTES, stream, a);
#else
    for (int p = 0; p < PH_COUNT; ++p) { a.ph_lo = p; a.ph_hi = p + 1; hipLaunchKernelGGL(mk_fwd, dim3(grid), dim3(NTHREADS), LDS_BYTES, stream, a); }
#endif
}
```

```cpp
#include <hip/hip_runtime.h>
#include <hip/hip_cooperative_groups.h>
#include <cstdio>
#include <cstdint>
namespace cg = cooperative_groups;

#ifndef REP_PHASE
#define REP_PHASE -1
#define REP_N 1
#define REP_SUB 0
#endif
#ifndef MK_N_LAUNCHES
#define MK_N_LAUNCHES 1
#endif

namespace pg8 {
#define PG8_LAS __attribute__((address_space(3)))
typedef unsigned short bf16_t;
typedef short bf16x8 __attribute__((ext_vector_type(8)));
typedef float f32x4 __attribute__((ext_vector_type(4)));
typedef unsigned u32x4 __attribute__((ext_vector_type(4)));
typedef unsigned u32x2 __attribute__((ext_vector_type(2)));
constexpr int BM = 256, BK = 64, HALF = 128, HTB = HALF * BK * 2, STAGE_BYTES = 8 * HTB, NXCD = 8, WGM = 8;

__host__ __device__ __forceinline__ int lds_byte(int r, int c) { const int st = (r >> 4) * 2 + (c >> 5), rr = r & 15, cc = c & 31, ob = rr * 64 + cc * 2; return st * 1024 + (ob ^ (((ob >> 9) & 1) << 5)); }
__host__ __device__ __forceinline__ void stage_rc(int b, int& R, int& C) { const int st = b / 1024, sb = b % 1024, swz = sb ^ (((sb >> 9) & 1) << 5); R = (st >> 1) * 16 + swz / 64; C = (st & 1) * 32 + (swz % 64) / 2; }
__host__ __device__ __forceinline__ int perm32(int rho) { const int n = rho >> 4, i = rho & 15; return 8 * (i >> 2) + 4 * n + (i & 3); }

struct Unit { int pm, pn, g; const char* a; const char* b; };

__device__ __forceinline__ unsigned cvt_pk_bf16(float lo, float hi) { unsigned r; asm volatile("v_cvt_pk_bf16_f32 %0, %1, %2" : "=v"(r) : "v"(lo), "v"(hi)); return r; }

struct DenseOrder {
    static constexpr bool CHUNK_B = false;
    int nM, nN, nwg, G, c, K, pn0; const char* A; const char* Bt;
    __device__ void init(const void* A_, const void* Bt_, int M, int N, int K_, int pn0_, int G_, int c_) { A = (const char*)A_; Bt = (const char*)Bt_; nM = M / BM; nN = N / BM; nwg = nM * nN; G = G_; c = c_; K = K_; pn0 = pn0_; }
    __device__ bool next(int i, Unit& u) const {
        const long L = (long)i * G + c; if (L >= nwg) return false;
        int wgid = (int)L; { const int q = nwg / NXCD, r = nwg % NXCD, xcd = wgid % NXCD, off = wgid / NXCD; wgid = (xcd < r ? xcd * (q + 1) : r * (q + 1) + (xcd - r) * q) + off; }
        const int nig = WGM * nN, gid = wgid / nig, fm = gid * WGM, gsz = (nM - fm) < WGM ? (nM - fm) : WGM;
        u.pm = fm + ((wgid % nig) % gsz); u.pn = pn0 + (wgid % nig) / gsz; u.g = 0;
        u.a = A + (size_t)u.pm * BM * K * 2; u.b = Bt + (size_t)u.pn * BM * K * 2; return true;
    }
};
struct MoeOrder {
    static constexpr bool CHUNK_B = true;
    int G, c, K; bool gather; const char* A; const char* Bt;
    __device__ void init(const void* A_, const void* Bt_, int K_, int G_, int c_, bool gather_) { A = (const char*)A_; Bt = (const char*)Bt_; K = K_; G = G_; c = c_; gather = gather_; }
    __device__ bool next(int i, Unit& u) const {
        const int L = i * G + c; if (L >= 512) return false;
        const int pn = L & 7, pm = (L >> 3) & 1, b = (L >> 4) & 1, e = L >> 5;
        u.pm = pm; u.pn = pn; u.g = b * 16 + e;
        u.a = gather ? A : A + (size_t)(u.g * 512 + pm * BM) * K * 2; u.b = Bt + (size_t)e * 2048 * K * 2 + (size_t)pn * BM * 16; return true;
    }
};

struct EpiBf16 {
    static constexpr bool PERM = true, SWAP = false, INIT = false;
    bf16_t* O; int ldc; int grows; const float* rscale;
    __device__ __forceinline__ void operator()(const f32x4 (&acc)[2][2][4][2], const Unit& u, int wr, int wc, int fr, int fq) const {
        const int row0 = u.g * grows + u.pm * BM + wr * 64 + fr, col0 = u.pn * BM + wc * 32 + 8 * fq;
#pragma unroll
        for (int ai = 0; ai < 2; ++ai)
#pragma unroll
            for (int m = 0; m < 4; ++m) { const int row = row0 + ai * HALF + m * 16; bf16_t* rowp = O + (size_t)row * ldc + col0; const float sc = rscale ? rscale[row] : 1.f;
#pragma unroll
                for (int bj = 0; bj < 2; ++bj) { const f32x4 v0 = acc[ai][bj][m][0] * sc, v1 = acc[ai][bj][m][1] * sc;
                    u32x4 w; w.x = cvt_pk_bf16(v0[0], v0[1]); w.y = cvt_pk_bf16(v0[2], v0[3]); w.z = cvt_pk_bf16(v1[0], v1[1]); w.w = cvt_pk_bf16(v1[2], v1[3]);
                    *(u32x4*)(rowp + bj * HALF) = w; } }
    }
};
struct EpiSwiGLU {
    static constexpr bool PERM = true, SWAP = false, INIT = false;
    bf16_t* O;
    __device__ __forceinline__ void operator()(const f32x4 (&acc)[2][2][4][2], const Unit& u, int wr, int wc, int fr, int fq) const {
        const int row0 = u.g * 512 + u.pm * BM + wr * 64 + fr, col0 = u.pn * HALF + wc * 32 + 8 * fq;
#pragma unroll
        for (int ai = 0; ai < 2; ++ai)
#pragma unroll
            for (int m = 0; m < 4; ++m) { bf16_t* rowp = O + (size_t)(row0 + ai * HALF + m * 16) * 1024 + col0;
                float r[8];
#pragma unroll
                for (int n = 0; n < 2; ++n)
#pragma unroll
                    for (int e = 0; e < 4; ++e) { const float g = acc[ai][0][m][n][e], up = acc[ai][1][m][n][e]; r[n * 4 + e] = g / (1.f + __expf(-g)) * up; }
                u32x4 w; w.x = cvt_pk_bf16(r[0], r[1]); w.y = cvt_pk_bf16(r[2], r[3]); w.z = cvt_pk_bf16(r[4], r[5]); w.w = cvt_pk_bf16(r[6], r[7]);
                *(u32x4*)rowp = w; }
    }
};
struct EpiResF32 {
    static constexpr bool PERM = false, SWAP = false, INIT = true;
    const float* res; float* out; int ldc;
    __device__ __forceinline__ void init(f32x4 (&acc)[2][2][4][2], const Unit& u, int wr, int wc, int fr, int fq) const {
        const int row0 = u.pm * BM + wr * 64 + fr, col0 = u.pn * BM + wc * 32 + 4 * fq;
#pragma unroll
        for (int ai = 0; ai < 2; ++ai)
#pragma unroll
            for (int m = 0; m < 4; ++m) { const size_t off = (size_t)(row0 + ai * HALF + m * 16) * ldc + col0;
#pragma unroll
                for (int bj = 0; bj < 2; ++bj)
#pragma unroll
                    for (int n = 0; n < 2; ++n) acc[ai][bj][m][n] = *(const f32x4*)(res + off + bj * HALF + n * 16); }
    }
    __device__ __forceinline__ void operator()(const f32x4 (&acc)[2][2][4][2], const Unit& u, int wr, int wc, int fr, int fq) const {
        const int row0 = u.pm * BM + wr * 64 + fr, col0 = u.pn * BM + wc * 32 + 4 * fq;
#pragma unroll
        for (int ai = 0; ai < 2; ++ai)
#pragma unroll
            for (int m = 0; m < 4; ++m) { const size_t off = (size_t)(row0 + ai * HALF + m * 16) * ldc + col0;
#pragma unroll
                for (int bj = 0; bj < 2; ++bj)
#pragma unroll
                    for (int n = 0; n < 2; ++n) *(f32x4*)(out + off + bj * HALF + n * 16) = acc[ai][bj][m][n]; }
    }
};
struct EpiTransBf16 {
    static constexpr bool PERM = false, SWAP = true, INIT = false;
    bf16_t* O; int ldt; int pn_base;
    __device__ __forceinline__ void operator()(const f32x4 (&acc)[2][2][4][2], const Unit& u, int wr, int wc, int fr, int fq) const {
        const int ch0 = (u.pn - pn_base) * BM + wc * 32 + fr, t0 = u.pm * BM + wr * 64 + 4 * fq;
#pragma unroll
        for (int bj = 0; bj < 2; ++bj)
#pragma unroll
            for (int n = 0; n < 2; ++n) { bf16_t* chp = O + (size_t)(ch0 + bj * HALF + n * 16) * ldt + t0;
#pragma unroll
                for (int ai = 0; ai < 2; ++ai)
#pragma unroll
                    for (int m = 0; m < 4; ++m) { const f32x4 v = acc[ai][bj][m][n]; u32x2 w; w.x = cvt_pk_bf16(v[0], v[1]); w.y = cvt_pk_bf16(v[2], v[3]); *(u32x2*)(chp + ai * HALF + m * 16) = w; } }
    }
};

template <class Epi, class Sched, bool ALIGN_EPI = false, bool GATHER = false>
__device__ __forceinline__ void gemm_phase(PG8_LAS unsigned char* lds, const int K, const Sched& S, const Epi& E, const PG8_LAS int* ridx = nullptr) {
    const int tid = threadIdx.x, wid = __builtin_amdgcn_readfirstlane(tid >> 6), lane = tid & 63, wr = wid >> 2, wc = wid & 3, fr = lane & 15, fq = lane >> 4;
    const int nt = K / BK;
    unsigned vA0[2], vA1[2], vN0[2], vN1[2], voffB[2]; int stR[2], stC[2];
    const size_t kstep = (size_t)(BK * 2);
    const size_t hstep = (size_t)HALF * K * 2;
    const size_t kstepB = Sched::CHUNK_B ? (size_t)(BK / 8) * 2048 * 16 : kstep, hstepB = Sched::CHUNK_B ? (size_t)HALF * 16 : hstep;
#pragma unroll
    for (int i = 0; i < 2; ++i) { int R, C; stage_rc(tid * 16 + i * 8192, R, C); const int Rb = Epi::PERM ? ((R & ~31) + perm32(R & 31)) : R; stR[i] = R; stC[i] = C;
        voffB[i] = Sched::CHUNK_B ? (unsigned)(((C >> 3) * 2048 + Rb) * 16) : (unsigned)(Rb * K + C) * 2u;
        if constexpr (GATHER) { vA0[i] = (unsigned)(ridx[R] * K + C) * 2u; vA1[i] = (unsigned)(ridx[HALF + R] * K + C) * 2u; }
        else { vA0[i] = (unsigned)(R * K + C) * 2u; vA1[i] = vA0[i] + (unsigned)hstep; }
        vN0[i] = vA0[i]; vN1[i] = vA1[i]; }
    const unsigned ldsw = (unsigned)wid * 1024u;
    const int aoff = lds_byte(wr * 64 + fr, fq * 8), boff = lds_byte(wc * 32 + fr, fq * 8);
#define PG8_SA(b, h) (((b) * 2 + (h)) * HTB)
#define PG8_SB(b, h) ((4 + (b) * 2 + (h)) * HTB)
#define PG8_STAGE(bufoff, gbase, voff) do { _Pragma("unroll") for (int _i = 0; _i < 2; ++_i) \
        __builtin_amdgcn_global_load_lds((const unsigned*)((const char*)(gbase) + (voff)[_i]), (PG8_LAS unsigned*)(lds + (bufoff) + ldsw + _i * 8192), 16, 0, 0); } while (0)
#define PG8_LDA(dst, b, h) do { _Pragma("unroll") for (int m = 0; m < 4; ++m) _Pragma("unroll") for (int k = 0; k < 2; ++k) dst[m][k] = *(const PG8_LAS bf16x8*)(lds + PG8_SA(b, h) + aoff + m * 2048 + k * 1024); } while (0)
#define PG8_LDB(dst, b, h) do { _Pragma("unroll") for (int n = 0; n < 2; ++n) _Pragma("unroll") for (int k = 0; k < 2; ++k) dst[n][k] = *(const PG8_LAS bf16x8*)(lds + PG8_SB(b, h) + boff + n * 2048 + k * 1024); } while (0)
#define PG8_MMA(ai, bj, At, Bt) do { __builtin_amdgcn_s_setprio(1); _Pragma("unroll") for (int m = 0; m < 4; ++m) _Pragma("unroll") for (int n = 0; n < 2; ++n) _Pragma("unroll") for (int k = 0; k < 2; ++k) \
        acc[ai][bj][m][n] = Epi::SWAP ? __builtin_amdgcn_mfma_f32_16x16x32_bf16(At[m][k], Bt[n][k], acc[ai][bj][m][n], 0, 0, 0) : __builtin_amdgcn_mfma_f32_16x16x32_bf16(Bt[n][k], At[m][k], acc[ai][bj][m][n], 0, 0, 0); __builtin_amdgcn_s_setprio(0); } while (0)
#define PG8_WAIT_V(n) asm volatile("s_waitcnt vmcnt(" #n ")" ::: "memory")
#define PG8_WAIT_L(n) asm volatile("s_waitcnt lgkmcnt(" #n ")" ::: "memory")
#define PG8_BAR __builtin_amdgcn_s_barrier()
#define PG8_SCHED __builtin_amdgcn_sched_barrier(0)
    Unit cur, nxt; int ui = 0;
    if (!S.next(0, cur)) return;
    f32x4 acc[2][2][4][2];
    if constexpr (Epi::INIT) E.init(acc, cur, wr, wc, fr, fq);
    else {
#pragma unroll
    for (int a = 0; a < 2; ++a)
#pragma unroll
        for (int b = 0; b < 2; ++b)
#pragma unroll
            for (int m = 0; m < 4; ++m)
#pragma unroll
                for (int n = 0; n < 2; ++n) acc[a][b][m][n] = (f32x4){0.f, 0.f, 0.f, 0.f};
    }
    bf16x8 At[4][2], B0[2][2], B1[2][2];
    const char* cA = cur.a; const char* cB = cur.b;
    PG8_STAGE(PG8_SB(0, 0), cB, voffB); PG8_STAGE(PG8_SB(0, 1), cB + hstepB, voffB); PG8_STAGE(PG8_SA(0, 0), cA, vA0); PG8_STAGE(PG8_SA(0, 1), cA, vA1);
    if (wr == 1) PG8_BAR;
    PG8_WAIT_V(2); PG8_BAR;
    PG8_STAGE(PG8_SB(1, 0), cB + kstepB, voffB); PG8_STAGE(PG8_SA(1, 0), cA + kstep, vA0); PG8_STAGE(PG8_SB(1, 1), cB + hstepB + kstepB, voffB);
    PG8_WAIT_V(6); PG8_BAR;
    for (;;) {
        const bool has_next = S.next(ui + 1, nxt);
        const char* nA = has_next ? nxt.a : cA; const char* nB = has_next ? nxt.b : cB;
        if constexpr (GATHER) { if (has_next) {
#pragma unroll
            for (int i = 0; i < 2; ++i) { vN0[i] = (unsigned)(ridx[(ui + 1) * 256 + stR[i]] * K + stC[i]) * 2u; vN1[i] = (unsigned)(ridx[(ui + 1) * 256 + HALF + stR[i]] * K + stC[i]) * 2u; } } }
        for (int t = 0; t < nt; t += 2) {
            const bool last = (t == nt - 2);
            const char* a1 = cA + (size_t)(t + 1) * kstep;
            const char* a2 = last ? nA : cA + (size_t)(t + 2) * kstep; const char* b2 = last ? nB : cB + (size_t)(t + 2) * kstepB;
            const char* a3 = a2 + kstep; const char* b3 = b2 + kstepB;
            unsigned w0[2], w1[2];
#pragma unroll
            for (int i = 0; i < 2; ++i) { w0[i] = last ? vN0[i] : vA0[i]; w1[i] = last ? vN1[i] : vA1[i]; }
            PG8_LDB(B0, 0, 0); PG8_LDB(B1, 0, 1); PG8_SCHED; PG8_LDA(At, 0, 0); PG8_STAGE(PG8_SA(1, 1), a1, vA1);
            PG8_WAIT_V(8); PG8_WAIT_L(0); PG8_BAR; PG8_MMA(0, 0, At, B0); PG8_MMA(0, 1, At, B1); PG8_BAR; PG8_SCHED;
            PG8_LDA(At, 0, 1); PG8_STAGE(PG8_SB(0, 0), b2, voffB); PG8_STAGE(PG8_SB(0, 1), b2 + hstepB, voffB); PG8_STAGE(PG8_SA(0, 0), a2, w0);
            PG8_WAIT_V(8); PG8_WAIT_L(0); PG8_BAR; PG8_MMA(1, 0, At, B0); PG8_MMA(1, 1, At, B1); PG8_BAR; PG8_SCHED;
            PG8_LDB(B0, 1, 0); PG8_LDB(B1, 1, 1); PG8_SCHED; PG8_LDA(At, 1, 0); PG8_STAGE(PG8_SA(0, 1), a2, w1);
            PG8_WAIT_V(8); PG8_WAIT_L(0); PG8_BAR; PG8_MMA(0, 0, At, B0); PG8_MMA(0, 1, At, B1); PG8_BAR; PG8_SCHED;
            PG8_LDA(At, 1, 1); PG8_STAGE(PG8_SB(1, 0), b3, voffB); PG8_STAGE(PG8_SB(1, 1), b3 + hstepB, voffB); PG8_STAGE(PG8_SA(1, 0), a3, w0);
            PG8_WAIT_V(8); PG8_WAIT_L(0); PG8_BAR; PG8_MMA(1, 0, At, B0); PG8_MMA(1, 1, At, B1); PG8_BAR; PG8_SCHED;
        }
        if constexpr (ALIGN_EPI) { if (wr == 0) PG8_BAR; }
        E(acc, cur, wr, wc, fr, fq);
        if (!has_next) break;
        if constexpr (Epi::INIT) E.init(acc, nxt, wr, wc, fr, fq);
        else {
#pragma unroll
        for (int a = 0; a < 2; ++a)
#pragma unroll
            for (int b = 0; b < 2; ++b)
#pragma unroll
                for (int m = 0; m < 4; ++m)
#pragma unroll
                    for (int n = 0; n < 2; ++n) acc[a][b][m][n] = (f32x4){0.f, 0.f, 0.f, 0.f};
        }
        cur = nxt; cA = nA; cB = nB; ++ui;
#pragma unroll
        for (int i = 0; i < 2; ++i) { vA0[i] = vN0[i]; vA1[i] = vN1[i]; }
        if constexpr (ALIGN_EPI) { if (wr == 1) PG8_BAR; }
    }
    PG8_WAIT_V(0);
    if constexpr (!ALIGN_EPI) { if (wr == 0) PG8_BAR; }
    PG8_BAR;
#undef PG8_SA
#undef PG8_SB
#undef PG8_STAGE
#undef PG8_LDA
#undef PG8_LDB
#undef PG8_MMA
#undef PG8_WAIT_V
#undef PG8_WAIT_L
#undef PG8_BAR
#undef PG8_SCHED
}
}

constexpr int NB = 2, SEQ = 4096, DM = 2048, MT = NB * SEQ;
constexpr int NH = 8, HD = 128, AW = 1024, HW = 1024, INW = 6144;
constexpr int GW = 64, NROWS = 64, WR = 8, WC = 16;
constexpr int NE = 16, CAP = 512, FF = 1024;
constexpr int FEMB = 33, FHID = 64;
constexpr float EPS = 1e-6f;
constexpr int NWAVES = 8, NTHREADS = 512;

constexpr size_t MiB = 1u << 20;
constexpr size_t WS_CTL = 0, CTL_ZERO_BYTES = 32768;
constexpr size_t WS_WIN = 2 * MiB;
constexpr size_t WS_WOUT = 26 * MiB;
constexpr size_t WS_WGU = 34 * MiB;
constexpr size_t WS_WD = 162 * MiB;
constexpr size_t WS_W3T = 226 * MiB;
constexpr size_t WS_HID2 = 227 * MiB;
constexpr size_t WS_HB = 228 * MiB;
constexpr size_t WS_QK = 260 * MiB;
constexpr size_t WS_XT = 292 * MiB;
constexpr size_t WS_UC = 356 * MiB;
constexpr size_t WS_TAPS = 404 * MiB;
constexpr size_t WS_HYT = 436 * MiB;
constexpr size_t WS_MIXED = 452 * MiB;
constexpr size_t WS_AFF = 484 * MiB;
constexpr size_t WS_IDX = 485 * MiB;
constexpr size_t WS_GATE = 486 * MiB;
constexpr size_t WS_SEL = 487 * MiB;
constexpr size_t WS_Z1T = 488 * MiB;
constexpr size_t WS_XG = WS_XT;
constexpr size_t WS_ACT = WS_UC;
constexpr size_t WS_YE = WS_TAPS;
constexpr size_t WS_END = 504 * MiB;

constexpr int LDS_BYTES = 163840, LDS_MISC_OFF = 163840 - 128;

#define GAS __attribute__((address_space(1)))
#define LAS __attribute__((address_space(3)))
typedef unsigned short bf16;
typedef unsigned v4u __attribute__((ext_vector_type(4)));
typedef unsigned v2u __attribute__((ext_vector_type(2)));
typedef float f32x4 __attribute__((ext_vector_type(4)));
#define LDS_WAIT() asm volatile("s_waitcnt lgkmcnt(0)" ::: "memory")
#define VM_WAIT() asm volatile("s_waitcnt vmcnt(0)" ::: "memory")
__device__ __forceinline__ unsigned f2bf(float f) { unsigned u = __builtin_bit_cast(unsigned, f); return (u + 0x7fffu + ((u >> 16) & 1u)) >> 16; }
__device__ __forceinline__ unsigned pk2(float lo, float hi) { unsigned r; asm("v_cvt_pk_bf16_f32 %0, %1, %2" : "=v"(r) : "v"(lo), "v"(hi)); return r; }
__device__ __forceinline__ float bf2f(unsigned h) { return __builtin_bit_cast(float, h << 16); }
__device__ __forceinline__ float bflo(unsigned w) { return __builtin_bit_cast(float, w << 16); }
__device__ __forceinline__ float bfhi(unsigned w) { return __builtin_bit_cast(float, w & 0xffff0000u); }
__device__ __forceinline__ float wave_sum(float v) {
#pragma unroll
    for (int o = 1; o < 64; o <<= 1) v += __shfl_xor(v, o);
    return v;
}


#define XB_TMO      128
#define XB_XCNT(j)  (256  + 64 * (j))
#define XB_XSUB(j)  (1280 + 64 * (j))
#define XB_XGEN(j)  (2304 + 64 * (j))
#define XB_TOP      3328
#define XB_TOPGEN   3392
#define XCD_BAR_WORDS 3456
#define XB_SPIN_CAP (1u << 22)
__device__ __forceinline__ unsigned xb_ld(unsigned* p)              { return __hip_atomic_load(p, __ATOMIC_RELAXED, __HIP_MEMORY_SCOPE_AGENT); }
__device__ __forceinline__ unsigned xb_add(unsigned* p, unsigned v) { return __hip_atomic_fetch_add(p, v, __ATOMIC_RELAXED, __HIP_MEMORY_SCOPE_AGENT); }
__device__ __forceinline__ unsigned xb_xcc_id() { return (unsigned)__builtin_amdgcn_s_getreg((3 << 11) | 20) & 0xFu; }
#define XB_SPIN(cond, bar) do { unsigned _sp = 0; while (cond) { __builtin_amdgcn_s_sleep(1); \
    if ((++_sp & 255u) == 0u) { if (xb_ld(&(bar)[XB_TMO])) break; if (_sp > XB_SPIN_CAP) { atomicAdd(&(bar)[XB_TMO], 1u); break; } } } } while (0)
struct XcdBarrier { unsigned* bar; unsigned x; volatile LAS unsigned* st; };
__device__ __forceinline__ XcdBarrier xcd_barrier_post(unsigned* bar, volatile LAS unsigned* st) {
    XcdBarrier b; b.bar = bar; b.x = xb_xcc_id(); b.st = st;
    if (threadIdx.x == 0) (void)xb_add(&bar[XB_XCNT(b.x)], 1u);
    return b;
}
__device__ __forceinline__ void xcd_barrier_complete(unsigned* bar, unsigned x, unsigned& nloc, unsigned& nx) {
    const unsigned G = gridDim.x * gridDim.y * gridDim.z;
    unsigned sum, cnt, mine, sp = 0u;
    for (;;) {
        sum = 0u; cnt = 0u; mine = 0u;
#pragma unroll
        for (unsigned j = 0; j < 16; ++j) { const unsigned c = xb_ld(&bar[XB_XCNT(j)]); sum += c; cnt += (c > 0u) ? 1u : 0u; mine = (j == x) ? c : mine; }
        if (sum == G) break;
        __builtin_amdgcn_s_sleep(1);
        if ((++sp & 255u) == 0u) { if (xb_ld(&bar[XB_TMO])) break; if (sp > XB_SPIN_CAP) { atomicAdd(&bar[XB_TMO], 1u); break; } }
    }
    nloc = mine > 0u ? mine : 1u; nx = cnt > 0u ? cnt : 1u;
}
__device__ __forceinline__ void xcd_barrier(const XcdBarrier& b) {
    asm volatile("s_waitcnt vmcnt(0)" ::: "memory");
    __syncthreads();
    if (threadIdx.x == 0) {
        unsigned* bar = b.bar;
        __builtin_amdgcn_s_waitcnt(0);
        unsigned nloc = b.st[0], nx = b.st[1];
        if (nloc == 0u) { xcd_barrier_complete(bar, b.x, nloc, nx); b.st[0] = nloc; b.st[1] = nx; }
        const unsigned old = xb_add(&bar[XB_XSUB(b.x)], 1u);
        const unsigned gen = old / nloc;
        if (old + 1u == (gen + 1u) * nloc) {
            __builtin_amdgcn_fence(__ATOMIC_RELEASE, "agent");
            asm volatile("s_waitcnt vmcnt(0)" ::: "memory");
            const unsigned og = xb_add(&bar[XB_TOP], 1u);
            const unsigned tg = og / nx;
            if (og + 1u == (tg + 1u) * nx) xb_add(&bar[XB_TOPGEN], 1u);
            else XB_SPIN(xb_ld(&bar[XB_TOPGEN]) == tg, bar);
            __builtin_amdgcn_fence(__ATOMIC_ACQUIRE, "agent");
            xb_add(&bar[XB_XGEN(b.x)], 1u);
            asm volatile("s_waitcnt vmcnt(0)" ::: "memory");
        } else {
            XB_SPIN(xb_ld(&bar[XB_XGEN(b.x)]) == gen, bar);
            __builtin_amdgcn_fence(__ATOMIC_ACQUIRE, "agent");
            asm volatile("s_waitcnt vmcnt(0)" ::: "memory");
        }
    }
    __syncthreads();
}

__device__ unsigned g_bar_words[XCD_BAR_WORDS + 64];
struct Frame {
    LAS unsigned char* lds;
    int tid, lane, wave, G, bid;
    const float* in[23]; float* out; unsigned char* ws;
};
#define GW_ID(F) ((F).bid * NWAVES + (F).wave)
#define GW_N(F) ((F).G * NWAVES)

__device__ __forceinline__ void p0_transpose_item(const float* W, int K, int N, bf16* WT, int row_base, int k0, int n0, LAS float* scr, int lane) {
    float t_[32];
#pragma unroll
    for (int i = 0; i < 32; ++i) { const int kk = 2 * i + (lane >> 5); t_[i] = W[(size_t)(k0 + kk) * N + n0 + (lane & 31)]; }
#pragma unroll
    for (int i = 0; i < 32; ++i) { const int kk = 2 * i + (lane >> 5); scr[kk * 33 + (lane & 31)] = t_[i]; }
    LDS_WAIT(); asm volatile("" ::: "memory");
    const int c = lane & 7;
#pragma unroll
    for (int j = 0; j < 4; ++j) { const int n = (lane >> 3) + 8 * j; const LAS float* s = scr + (8 * c) * 33 + n;
        v4u o; o.x = pk2(s[0 * 33], s[1 * 33]); o.y = pk2(s[2 * 33], s[3 * 33]); o.z = pk2(s[4 * 33], s[5 * 33]); o.w = pk2(s[6 * 33], s[7 * 33]);
        *(GAS v4u*)(WT + (size_t)(row_base + n) * K + k0 + 8 * c) = o; }
    LDS_WAIT(); asm volatile("" ::: "memory");
}
__device__ __forceinline__ void phase_p0(Frame& F) {
    LAS float* scr = (LAS float*)(F.lds + F.wave * 16384);
    const int gw = GW_ID(F), NGW = GW_N(F);
    bf16* WinT = (bf16*)(F.ws + WS_WIN); bf16* WoutT = (bf16*)(F.ws + WS_WOUT); bf16* W3T = (bf16*)(F.ws + WS_W3T);
    constexpr int I_IN = (DM / 64) * (INW / 32), I_OUT = (DM / 64) * (DM / 32), I_3 = 1 * (4096 / 32);
    constexpr int NITEMS = I_IN + I_OUT + I_3;
    for (int it = gw; it < NITEMS; it += NGW) {
        int r = it;
        if (r < I_IN) { const int nblk = INW / 32, kb = r / nblk, nb = r % nblk; p0_transpose_item(F.in[2], DM, INW, WinT, 32 * nb, 64 * kb, 32 * nb, scr, F.lane); continue; } r -= I_IN;
        if (r < I_OUT) { const int nblk = DM / 32, kb = r / nblk, nb = r % nblk; p0_transpose_item(F.in[17], DM, DM, WoutT, 32 * nb, 64 * kb, 32 * nb, scr, F.lane); continue; } r -= I_OUT;
        { const int nb = r; p0_transpose_item(F.in[12], FHID, 4096, W3T, 32 * nb, 0, 32 * nb, scr, F.lane); }
    }
    bf16* HB = (bf16*)(F.ws + WS_HB);
    const float* x = F.in[0]; const float* g = F.in[1];
    f32x4 vn[8];
    if (gw < MT) { const GAS f32x4* xr = (const GAS f32x4*)(x + (size_t)gw * DM) + F.lane;
#pragma unroll
        for (int j = 0; j < 8; ++j) vn[j] = xr[64 * j]; }
    for (int m = gw; m < MT; m += NGW) {
        f32x4 v[8]; float s = 0.f;
#pragma unroll
        for (int j = 0; j < 8; ++j) { v[j] = vn[j]; s += (v[j].x * v[j].x + v[j].y * v[j].y) + (v[j].z * v[j].z + v[j].w * v[j].w); }
        if (m + NGW < MT) { const GAS f32x4* xr = (const GAS f32x4*)(x + (size_t)(m + NGW) * DM) + F.lane;
#pragma unroll
            for (int j = 0; j < 8; ++j) vn[j] = xr[64 * j]; }
        const float r = rsqrtf(wave_sum(s) * (1.f / DM) + EPS);
        GAS v2u* o8 = (GAS v2u*)(HB + (size_t)m * DM) + F.lane;
#pragma unroll
        for (int j = 0; j < 8; ++j) { const f32x4 gg = *((const GAS f32x4*)g + F.lane + 64 * j); v2u o; o.x = pk2(v[j].x * r * gg.x, v[j].y * r * gg.y); o.y = pk2(v[j].z * r * gg.z, v[j].w * r * gg.w); o8[64 * j] = o; }
    }
    float* HID2 = (float*)(F.ws + WS_HID2);
    LAS float* sc2 = (LAS float*)(F.lds + F.wave * 16384);
    const float* w1 = F.in[8]; const float* b1 = F.in[9]; const float* w2 = F.in[10]; const float* b2 = F.in[11]; const float* fr = F.in[13];
    for (int l = gw; l < SEQ; l += NGW) {
        const int j = F.lane;
        float zv = 0.f;
        if (j == 0) zv = (float)l / (float)(SEQ - 1);
        else if (j < FEMB) { const int k = (j - 1) & 15; const float f = 1e-4f + (float)k * ((15.0f - 1e-4f) / 15.0f); const float wv = 6.283185307179586f * (float)l / (float)SEQ; zv = (j <= 16) ? cosf(f * wv) : -sinf(f * wv); }
        sc2[j] = zv; LDS_WAIT(); asm volatile("" ::: "memory");
        float a = b1[j];
        for (int i = 0; i < FEMB; ++i) a += sc2[i] * w1[i * FHID + j];
        const float h1 = sinf(fr[j] * a);
        sc2[64 + j] = h1; LDS_WAIT(); asm volatile("" ::: "memory");
        float c = b2[j];
        for (int i = 0; i < FHID; ++i) c += sc2[64 + i] * w2[i * FHID + j];
        HID2[l * FHID + j] = sinf(fr[j] * c);
        LDS_WAIT(); asm volatile("" ::: "memory");
    }
}

typedef short bf16x8 __attribute__((ext_vector_type(8)));
typedef float f32x16 __attribute__((ext_vector_type(16)));
__device__ __forceinline__ void phase_filters(Frame& F) {
    const float* HID2 = (const float*)(F.ws + WS_HID2); const bf16* W3T = (const bf16*)(F.ws + WS_W3T); const float* fbias = F.in[14]; bf16* TAPS = (bf16*)(F.ws + WS_TAPS);
    const int n = F.lane & 31, hh = F.lane >> 5;
    const float mind = -4.605170185988091f / 1.5f, maxd = -4.605170185988091f / 0.3f;
    LAS bf16* scr = (LAS bf16*)(F.lds + F.wave * 4096);
    for (int task = GW_ID(F); task < 128 * 16; task += GW_N(F)) {
        const int l0 = (task & 127) * 32, cg = task >> 7;
        const int dir = (cg >> 2) & 1, o = cg >> 3;
        const int l = l0 + dir + n;
        bf16x8 hb[4];
        { const int lr = l < SEQ ? l : SEQ - 1;
#pragma unroll
          for (int ks = 0; ks < 4; ++ks) { const GAS f32x4* hp = (const GAS f32x4*)(HID2 + (size_t)lr * FHID + 16 * ks + 8 * hh); const f32x4 h0 = hp[0], h1 = hp[1];
              v4u bw; bw.x = pk2(h0.x, h0.y); bw.y = pk2(h0.z, h0.w); bw.z = pk2(h1.x, h1.y); bw.w = pk2(h1.z, h1.w); hb[ks] = __builtin_bit_cast(bf16x8, bw); } }
        const float t = (float)l / (float)(SEQ - 1);
        const int pos = dir ? 31 - n : n;
        const int idx0 = dir ? 4064 - l0 : 4096 + l0;
#pragma unroll 2
        for (int ct = 0; ct < 8; ++ct) {
            const int col0 = (cg * 8 + ct) * 32;
            f32x16 acc;
#pragma unroll
            for (int i = 0; i < 16; ++i) acc[i] = 0.f;
#pragma unroll
            for (int ks = 0; ks < 4; ++ks) { const bf16x8 a = *(const GAS bf16x8*)(W3T + (size_t)(col0 + n) * FHID + 16 * ks + 8 * hh);
                acc = __builtin_amdgcn_mfma_f32_32x32x16_bf16(a, hb[ks], acc, 0, 0, 0); }
#pragma unroll
            for (int i = 0; i < 16; ++i) {
                const int chl = (i & 3) + 8 * (i >> 2) + 4 * hh, c = (col0 & 1023) + chl;
                const float delta = fabsf(mind + (maxd - mind) * ((float)c / 1023.0f));
                float v = acc[i] * __expf(-t * delta);
                if (dir == 0 && l == 0) v += fbias[o * 1024 + c];
                if (l >= SEQ) v = 0.f;
                scr[chl * 40 + pos] = (bf16)f2bf(v);
            }
            LDS_WAIT(); asm volatile("" ::: "memory");
#pragma unroll
            for (int j = 0; j < 2; ++j) { const int id = F.lane + 64 * j, chl = id >> 2, q = id & 3;
                const v4u w = *(const LAS v4u*)(scr + chl * 40 + 8 * q);
                *(GAS v4u*)(TAPS + ((size_t)((col0 & 1023) + chl) * 2 + o) * 8192 + idx0 + 8 * q) = w; }
            LDS_WAIT(); asm volatile("" ::: "memory");
        }
    }
}

constexpr int HY_TAPS_BYTES = 4 * 16384, HY_ZB_ENT = 6080, HY_ZB_BYTES = HY_ZB_ENT * 2;
__device__ __forceinline__ unsigned hy_zb_off(int idx0  ) { const int q = idx0 >> 3; return (unsigned)((q ^ ((q >> 4) & 3)) << 4); }
__device__ __forceinline__ const LAS unsigned char* hy_pm(const LAS unsigned char* zb0, int g, int n, int hh) {
    const int q0 = 124 - 4 * n + 2 * g + hh;
    unsigned p = (unsigned)(size_t)zb0 + (unsigned)(((q0 ^ ((q0 >> 4) & 3)) << 4) - 6144);
    asm volatile("" : "+v"(p));
    return (const LAS unsigned char*)(size_t)p;
}
template <int MASK>
__device__ __forceinline__ void hy_loadB(bf16x8 (&bf)[4], const LAS unsigned char* pm, int b) {
#pragma unroll
    for (int tau = 0; tau < 4; ++tau) if (MASK & (1 << tau)) bf[tau] = *(const LAS bf16x8*)(pm + 2048 * (3 - tau) + b * HY_ZB_BYTES);
}
__device__ __forceinline__ void hy_loadA(unsigned (&d)[5], const LAS bf16* taps, int g, int n, int hh) {
    const volatile LAS unsigned* dp = (const volatile LAS unsigned*)taps + ((1 + 8 * hh + n) >> 1) + 8 * g;
#pragma unroll
    for (int i = 0; i < 5; ++i) d[i] = dp[i];
}
template <int MASK>
__device__ __forceinline__ void hy_mma(f32x16 (&acc)[4], const bf16x8 a, const bf16x8 (&bf)[4]) {
#pragma unroll
    for (int tau = 0; tau < 4; ++tau) if (MASK & (1 << tau)) acc[tau] = __builtin_amdgcn_mfma_f32_32x32x16_bf16(a, bf[tau], acc[tau], 0, 0, 0);
}
#define HY_ALIGN(a, d) do { v4u aw_; aw_.x = __builtin_amdgcn_alignbyte(d[1], d[0], sh); aw_.y = __builtin_amdgcn_alignbyte(d[2], d[1], sh); aw_.z = __builtin_amdgcn_alignbyte(d[3], d[2], sh); aw_.w = __builtin_amdgcn_alignbyte(d[4], d[3], sh); a = __builtin_bit_cast(bf16x8, aw_); } while (0)
#define HY_INTERLEAVE(nv, nds) do { __builtin_amdgcn_sched_group_barrier(0x2, nv, 0); _Pragma("unroll") for (int i_ = 0; i_ < 5; ++i_) { __builtin_amdgcn_sched_group_barrier(0x8, 1, 0); __builtin_amdgcn_sched_group_barrier(0x100, nds, 0); __builtin_amdgcn_sched_group_barrier(0x2, 2, 0); } } while (0)
constexpr int HY_YOFF = 254;
template <int MX, int MY>
__device__ __forceinline__ void hy_segment(f32x16 (&acc)[2][4], const LAS bf16* taps, const LAS unsigned char* zb0, int i0, int i1, int n, int hh) {
    const unsigned sh = (n & 1) ? 0u : 2u;
    unsigned dx[5], dy[5]; bf16x8 ax, ay, x0[4], y0[4], x1[4], y1[4];
    const LAS unsigned char* pmx = hy_pm(zb0, i0, n, hh); const LAS unsigned char* pmy = hy_pm(zb0, i0 + HY_YOFF, n, hh);
    hy_loadA(dx, taps, i0, n, hh); hy_loadA(dy, taps, i0 + HY_YOFF, n, hh); hy_loadB<MX>(x0, pmx, 0); hy_loadB<MY>(y0, pmy, 0);
#pragma unroll 1
    for (int i = i0; i < i1; ++i) {
        HY_ALIGN(ax, dx); HY_ALIGN(ay, dy);
        hy_loadB<MX>(x1, pmx, 1); hy_loadB<MY>(y1, pmy, 1);
        hy_mma<MX>(acc[0], ax, x0); hy_mma<MY>(acc[0], ay, y0);
        HY_INTERLEAVE(8, 1); __builtin_amdgcn_sched_barrier(0);
        hy_loadA(dx, taps, i + 1, n, hh); hy_loadA(dy, taps, i + 1 + HY_YOFF, n, hh);
        pmx = hy_pm(zb0, i + 1, n, hh); pmy = hy_pm(zb0, i + 1 + HY_YOFF, n, hh);
        hy_loadB<MX>(x0, pmx, 0); hy_loadB<MY>(y0, pmy, 0);
        hy_mma<MX>(acc[1], ax, x1); hy_mma<MY>(acc[1], ay, y1);
        HY_INTERLEAVE(0, 3); __builtin_amdgcn_sched_barrier(0);
    }
}
__device__ __forceinline__ void hy_stage_taps(Frame& F, int c0, int o) {
    const bf16* TAPS = (const bf16*)(F.ws + WS_TAPS);
    int tid = F.tid; asm volatile("" : "+v"(tid));
#pragma unroll
    for (int j = 0; j < 8; ++j) { const int ch = tid + NTHREADS * j, ci = ch >> 10, w = ch & 1023;
        *((LAS v4u*)(F.lds) + ch) = *((const GAS v4u*)(TAPS + ((size_t)(c0 + ci) * 2 + o) * 8192) + w); }
}
struct ConvItem { const float* W; bf16* WTe; int N, row_base, k0, n0; };
__device__ __forceinline__ void conv_load64(float (&v)[64], const ConvItem& c, int lane) {
    const GAS float* src = (const GAS float*)(c.W + (size_t)c.k0 * c.N + c.n0 + lane);
#pragma unroll
    for (int kk = 0; kk < 64; ++kk) v[kk] = src[(size_t)kk * c.N];
}
__device__ __forceinline__ void conv_store64(const float (&v)[64], const ConvItem& c, int lane) {
    GAS v4u* dst = (GAS v4u*)c.WTe + (size_t)(c.k0 >> 3) * 2048 + c.row_base + lane;
#pragma unroll
    for (int j = 0; j < 8; ++j) { v4u o; o.x = pk2(v[8 * j], v[8 * j + 1]); o.y = pk2(v[8 * j + 2], v[8 * j + 3]); o.z = pk2(v[8 * j + 4], v[8 * j + 5]); o.w = pk2(v[8 * j + 6], v[8 * j + 7]); dst[(size_t)j * 2048] = o; }
}
constexpr int MOE_ITEMS_GU = 2 * NE * 32 * 16, MOE_ITEMS_D = NE * 16 * 32, MOE_ITEMS = MOE_ITEMS_GU + MOE_ITEMS_D;
#ifndef MOE_P0_ITEMS
#define MOE_P0_ITEMS 0
#endif
constexpr int MOE_HELP_ITEMS = MOE_ITEMS - MOE_P0_ITEMS;
__device__ __forceinline__ ConvItem moe_item(Frame& F, int it) {
    bf16* WguT = (bf16*)(F.ws + WS_WGU); bf16* WdT = (bf16*)(F.ws + WS_WD); ConvItem c;
    if (it < MOE_ITEMS_GU) { const int which = it >> 13, e = (it >> 9) & 15, kb = (it >> 4) & 31, nb = it & 15, f0 = 64 * nb;
        c.W = (which ? F.in[21] : F.in[20]) + (size_t)e * DM * FF; c.N = FF; c.WTe = WguT + (size_t)e * 2048 * DM; c.row_base = (f0 >> 7) * 256 + which * 128 + (f0 & 127); c.k0 = 64 * kb; c.n0 = f0;
    } else { const int r = it - MOE_ITEMS_GU, e = r >> 9, kb = (r >> 5) & 15, nb = r & 31;
        c.W = F.in[22] + (size_t)e * FF * DM; c.N = DM; c.WTe = WdT + (size_t)e * 2048 * FF; c.row_base = 64 * nb; c.k0 = 64 * kb; c.n0 = 64 * nb; }
    return c;
}
__device__ __forceinline__ void moe_conv_item(Frame& F, int it) { float v[64]; const ConvItem c = moe_item(F, it); conv_load64(v, c, F.lane); conv_store64(v, c, F.lane); }
__device__ __forceinline__ void moe_conv_range(Frame& F, int lo, int hi, int step) {
    if (lo >= hi) return;
    float va[64], vb[64];
    ConvItem ca = moe_item(F, lo), cb_; conv_load64(va, ca, F.lane);
    for (int it = lo; it < hi; it += 2 * step) {
        const bool hb = it + step < hi;
        if (hb) { cb_ = moe_item(F, it + step); conv_load64(vb, cb_, F.lane); }
        conv_store64(va, ca, F.lane);
        const bool ha = it + 2 * step < hi;
        if (ha) { ca = moe_item(F, it + 2 * step); conv_load64(va, ca, F.lane); }
        if (hb) conv_store64(vb, cb_, F.lane);
    }
}
__device__ __forceinline__ void hy_write_gates(Frame& F, int c0, int oo) {
    const bf16* XH = (const bf16*)(F.ws + WS_XT) + (size_t)1024 * MT; bf16* GC = (bf16*)(F.ws + WS_UC);
    const float* cw = F.in[6]; const float* cb = F.in[7];
    const int ht = F.tid - 256;
#pragma unroll 2
    for (int k = 0; k < 16; ++k) { const int id = ht + 256 * k, u = id & 511, b = (id >> 9) & 1, ci = id >> 10;
        const int gch = oo * 1024 + c0 + ci; const bf16* gs = XH + (size_t)gch * MT + b * SEQ;
        const float w0 = cw[gch], w1 = cw[3072 + gch], w2 = cw[6144 + gch], bb = cb[gch];
        const v4u w = *((const GAS v4u*)gs + u);
        float f[10];
        f[1] = bflo(w.x); f[2] = bfhi(w.x); f[3] = bflo(w.y); f[4] = bfhi(w.y); f[5] = bflo(w.z); f[6] = bfhi(w.z); f[7] = bflo(w.w); f[8] = bfhi(w.w);
        f[0] = u > 0 ? bf2f(gs[8 * u - 1]) : 0.f; f[9] = u < 511 ? bf2f(gs[8 * u + 8]) : 0.f;
        float z[8];
#pragma unroll
        for (int e = 0; e < 8; ++e) z[e] = bb + w0 * f[e] + w1 * f[e + 1] + w2 * f[e + 2];
        v4u r; r.x = pk2(z[0], z[1]); r.y = pk2(z[2], z[3]); r.z = pk2(z[4], z[5]); r.w = pk2(z[6], z[7]);
        *((GAS v4u*)(GC + ((size_t)((c0 + ci) * 2 + oo) * 2 + b) * SEQ) + u) = r; }
}
__device__ __forceinline__ void phase_hyena(Frame& F) {
    const bf16* XH = (const bf16*)(F.ws + WS_XT) + (size_t)1024 * MT;
    const float* cw = F.in[6]; const float* cb = F.in[7];
    bf16* HYT = (bf16*)(F.ws + WS_HYT); bf16* GC = (bf16*)(F.ws + WS_UC);
    const int n = F.lane & 31, hh = F.lane >> 5;
    const bool compute = F.wave < 4;
    const int nhelp = F.G * 4, hw = F.bid * 4 + (F.wave - 4);
    int sec = 0;
    for (int cg = F.bid; cg < 256; cg += F.G) {
        const int c0 = cg * 4;
        __syncthreads();
        hy_stage_taps(F, c0, 0);
        {
          const int ci = F.wave >> 1, b = F.wave & 1; LAS unsigned char* zb = F.lds + HY_TAPS_BYTES + F.wave * HY_ZB_BYTES;
          const int zch = 2048 + c0 + ci; const bf16* zsrc = XH + (size_t)zch * MT + b * SEQ;
          const float w0 = cw[zch], w1 = cw[3072 + zch], w2 = cw[6144 + zch], bb = cb[zch];
#pragma unroll
          for (int j = 0; j < 8; ++j) { const int u = F.lane + 64 * j; const v4u w = *((const GAS v4u*)zsrc + u);
              float f[10];
              f[1] = bflo(w.x); f[2] = bfhi(w.x); f[3] = bflo(w.y); f[4] = bfhi(w.y); f[5] = bflo(w.z); f[6] = bfhi(w.z); f[7] = bflo(w.w); f[8] = bfhi(w.w);
              f[0] = u > 0 ? bf2f(zsrc[8 * u - 1]) : 0.f; f[9] = u < 511 ? bf2f(zsrc[8 * u + 8]) : 0.f;
              float z[8];
#pragma unroll
              for (int e = 0; e < 8; ++e) z[e] = bb + w0 * f[e] + w1 * f[e + 1] + w2 * f[e + 2];
              v4u r; r.x = pk2(z[7], z[6]); r.y = pk2(z[5], z[4]); r.z = pk2(z[3], z[2]); r.w = pk2(z[1], z[0]);
              *(LAS v4u*)(zb + hy_zb_off(8 * (635 - u))) = r; }
          const v4u zero = {0u, 0u, 0u, 0u};
          for (int q = F.lane; q < 124; q += 64) { *(LAS v4u*)(zb + hy_zb_off(8 * q)) = zero; *(LAS v4u*)(zb + hy_zb_off(8 * (636 + q))) = zero; } }
        if (!compute) hy_write_gates(F, c0, 0);
        __syncthreads();
#pragma unroll 1
        for (int o = 0; o < 2; ++o) {
            if (compute) {
                const int ci = F.wave, c = c0 + ci;
                const LAS bf16* taps = (const LAS bf16*)(F.lds + ci * 16384);
                LAS unsigned char* zb0 = F.lds + HY_TAPS_BYTES + (2 * ci) * HY_ZB_BYTES;
                f32x16 acc[2][4];
#pragma unroll
                for (int b = 0; b < 2; ++b)
#pragma unroll
                    for (int tau = 0; tau < 4; ++tau)
#pragma unroll
                        for (int i = 0; i < 16; ++i) acc[b][tau][i] = 0.f;
                hy_segment<1, 15>(acc, taps, zb0, 0, 64, n, hh);
                hy_segment<3, 14>(acc, taps, zb0, 64, 128, n, hh);
                hy_segment<7, 12>(acc, taps, zb0, 128, 192, n, hh);
                hy_segment<15, 8>(acc, taps, zb0, 192, 254, n, hh);
                hy_segment<0, 8>(acc, taps, zb0, 254, 256, n, hh);
                LDS_WAIT();
                int n2 = n, h2 = hh; asm volatile("" : "+v"(n2), "+v"(h2));
#pragma unroll
                for (int b = 0; b < 2; ++b) {
                    const bf16* gate = GC + ((size_t)(c * 2 + o) * 2 + b) * SEQ;
                    LAS unsigned char* zb = zb0 + b * HY_ZB_BYTES; bf16* outp = HYT + (size_t)c * MT + b * SEQ;
                    v2u gw[4][4];
#pragma unroll
                    for (int tau = 0; tau < 4; ++tau)
#pragma unroll
                        for (int rg = 0; rg < 4; ++rg) gw[tau][rg] = *(const GAS v2u*)(gate + 1024 * tau + 32 * n2 + 8 * rg + 4 * h2);
#pragma unroll
                    for (int tau = 0; tau < 4; ++tau) {
#pragma unroll
                        for (int rg = 0; rg < 4; ++rg) { const int t0 = 1024 * tau + 32 * n2 + 8 * rg + 4 * h2;
                            const float z0 = bflo(gw[tau][rg].x) * acc[b][tau][4 * rg + 0], z1 = bfhi(gw[tau][rg].x) * acc[b][tau][4 * rg + 1], z2 = bflo(gw[tau][rg].y) * acc[b][tau][4 * rg + 2], z3 = bfhi(gw[tau][rg].y) * acc[b][tau][4 * rg + 3];
                            if (o == 0) { v2u w; w.x = pk2(z3, z2); w.y = pk2(z1, z0);
                                *(LAS v2u*)(zb + hy_zb_off(8 * (635 - (t0 >> 3))) + (h2 ? 0 : 8)) = w; }
                            else { v2u w; w.x = pk2(z0, z1); w.y = pk2(z2, z3); *(GAS v2u*)(outp + t0) = w; } } }
                }
            } else {
                if (o == 0) hy_write_gates(F, c0, 1);
                const int lo_it = MOE_P0_ITEMS + sec * (MOE_HELP_ITEMS / 2), hi_it = lo_it + MOE_HELP_ITEMS / 2;
                if (sec < 2) moe_conv_range(F, lo_it + hw, hi_it, nhelp);
            }
            ++sec;
            if (o == 0) {
                __syncthreads();
                hy_stage_taps(F, c0, 1);
                __syncthreads();
            }
        }
    }
    for (; sec < 2; ++sec) if (!compute) { const int lo_it = MOE_P0_ITEMS + sec * (MOE_HELP_ITEMS / 2), hi_it = lo_it + MOE_HELP_ITEMS / 2; moe_conv_range(F, lo_it + hw, hi_it, nhelp); }
    __syncthreads();
}

constexpr int AT_KBYTES = 16384, AT_VPITCH = 136, AT_VBYTES = 128 * AT_VPITCH, AT_STAGE = AT_KBYTES + AT_VBYTES, AT_RP_OFF = 2 * AT_STAGE;
__device__ __forceinline__ void phase_attn2(Frame& F) {
    const bf16* QK = (const bf16*)(F.ws + WS_QK); const bf16* VT = (const bf16*)(F.ws + WS_XT); bf16* MIXED = (bf16*)(F.ws + WS_MIXED);
    const float* rpb = F.in[5]; const float* og = F.in[15]; const float* qg = F.in[3]; const float* kg = F.in[4];
    LAS float* rt = (LAS float*)(F.lds + AT_RP_OFF);
    LAS float* gtab = (LAS float*)(F.lds + AT_RP_OFF + 8 * 2048);
    if (F.tid < HD) gtab[F.tid] = qg[F.tid] * kg[F.tid];
    const int n = F.lane & 31, hh = F.lane >> 5;
    for (int unit = F.bid; unit < NB * NH * 16; unit += F.G) {
        const int rq = unit & 15, h = (unit >> 4) & 7, b = unit >> 7, r0 = 4 * rq;
        const int r = r0 + (F.wave >> 1), wq = F.wave & 1;
        int kmin = r0 - WR / 2; kmin = kmin < 0 ? 0 : (kmin > NROWS - WR ? NROWS - WR : kmin);
        int kmax = r0 + 3 - WR / 2; kmax = (kmax < 0 ? 0 : (kmax > NROWS - WR ? NROWS - WR : kmax)) + WR - 1;
        int kr0 = r - WR / 2; kr0 = kr0 < 0 ? 0 : (kr0 > NROWS - WR ? NROWS - WR : kr0);
        const int nrows = kmax - kmin + 1;
        __syncthreads();
        for (int i = F.tid; i < 15 * 128; i += NTHREADS) { const int dr_ = i >> 7, dcx = (i & 127) - 48; rt[i] = (dcx >= 0 && dcx <= 30) ? rpb[h * 465 + dr_ * 31 + dcx] * 1.4426950408889634f : 0.f; }
        const int mq = b * SEQ + r * GW + 32 * wq + n, qc = 32 * wq + n;
        int c0 = qc - WC / 2; c0 = c0 < 0 ? 0 : (c0 > GW - WC ? GW - WC : c0);
        bf16x8 qf[8];
#pragma unroll
        for (int ks = 0; ks < 8; ++ks) qf[ks] = *(const GAS bf16x8*)(QK + (size_t)mq * 2048 + h * HD + 16 * ks + 8 * hh);
        float qscale;
        {
          f32x16 D;
#pragma unroll
          for (int i = 0; i < 16; ++i) D[i] = 0.f;
#pragma unroll
          for (int ks = 0; ks < 8; ++ks) D = __builtin_amdgcn_mfma_f32_32x32x16_bf16(qf[ks], qf[ks], D, 0, 0, 0);
          float dsel = 0.f; const int isel = (n & 3) + 4 * (n >> 3);
#pragma unroll
          for (int i = 0; i < 16; ++i) dsel = (i == isel) ? D[i] : dsel;
          const float other = __shfl_xor(dsel, 32);
          const float ssq = (((n >> 2) & 1) == hh) ? dsel : other;
          qscale = (0.08838834764831845f * 1.4426950408889634f) * rsqrtf(ssq * (1.f / HD) + EPS); }
        const unsigned long long wmask = (c0 >= 4 * hh) ? (0xFFFFull << (c0 - 4 * hh)) : (0xFFFFull >> (4 * hh - c0));
        const unsigned wm0 = (unsigned)wmask, wm1 = (unsigned)(wmask >> 32);
        const int rtl = 4 * hh - qc + 63;
        f32x16 O[4];
#pragma unroll
        for (int dt = 0; dt < 4; ++dt)
#pragma unroll
            for (int i = 0; i < 16; ++i) O[dt][i] = 0.f;
        float lsum = 0.f;
        v4u sk[2], sv[2];

        auto gload = [&](int kr) {
#pragma unroll
            for (int j = 0; j < 2; ++j) { const int id = F.tid + 512 * j;
                sk[j] = *(const GAS v4u*)(QK + (size_t)(b * SEQ + kr * GW + (id >> 4)) * 2048 + 1024 + h * HD + 8 * (id & 15));
                sv[j] = *(const GAS v4u*)(VT + (size_t)(h * HD + (id >> 3)) * MT + b * SEQ + kr * GW + 8 * (id & 7)); }
        };
        auto lstore = [&](int buf) {
            LAS unsigned char* kb = F.lds + buf * AT_STAGE; LAS unsigned char* vb = kb + AT_KBYTES;
#pragma unroll
            for (int j = 0; j < 2; ++j) { const int id = F.tid + 512 * j; const int key = id >> 4, c = id & 15;
                float f[8] = {bflo(sk[j].x), bfhi(sk[j].x), bflo(sk[j].y), bfhi(sk[j].y), bflo(sk[j].z), bfhi(sk[j].z), bflo(sk[j].w), bfhi(sk[j].w)};
                float ss = 0.f;
#pragma unroll
                for (int e = 0; e < 8; ++e) ss += f[e] * f[e];
                ss += __shfl_xor(ss, 1); ss += __shfl_xor(ss, 2); ss += __shfl_xor(ss, 4); ss += __shfl_xor(ss, 8);
                const float rk = rsqrtf(ss * (1.f / HD) + EPS);
                const f32x4 ga = *(const LAS f32x4*)(gtab + 8 * c), gb = *(const LAS f32x4*)(gtab + 8 * c + 4);
                v4u kn; kn.x = pk2(f[0] * rk * ga.x, f[1] * rk * ga.y); kn.y = pk2(f[2] * rk * ga.z, f[3] * rk * ga.w); kn.z = pk2(f[4] * rk * gb.x, f[5] * rk * gb.y); kn.w = pk2(f[6] * rk * gb.z, f[7] * rk * gb.w);
                *(LAS v4u*)(kb + key * 256 + ((c ^ (key & 15)) << 4)) = kn;
                const int d = id >> 3, cv = id & 7; LAS v2u* vp = (LAS v2u*)(vb + d * AT_VPITCH + cv * 16);
                v2u lo, hi; lo.x = sv[j].x; lo.y = sv[j].y; hi.x = sv[j].z; hi.y = sv[j].w; vp[0] = lo; vp[1] = hi; }
        };
        gload(kmin); lstore(0);
        __syncthreads();
#pragma unroll 1
        for (int j = 0; j < nrows; ++j) {
            const int kr = kmin + j, buf = j & 1;
            if (j + 1 < nrows) gload(kr + 1);
            if (kr >= kr0 && kr < kr0 + WR) {
                const LAS unsigned char* kb = F.lds + buf * AT_STAGE; const LAS unsigned char* vb = kb + AT_KBYTES;
                const int dr = kr - r + WR - 1;
                const LAS float* rrow = rt + dr * 128 + rtl;
#pragma unroll
                for (int kt = 0; kt < 2; ++kt) {
                    f32x16 S;
#pragma unroll
                    for (int i = 0; i < 16; ++i) S[i] = 0.f;
                    const int key = 32 * kt + n;
#pragma unroll
                    for (int ks = 0; ks < 8; ++ks) { const bf16x8 kf = *(const LAS bf16x8*)(kb + key * 256 + (((2 * ks + hh) ^ (key & 15)) << 4));
                        S = __builtin_amdgcn_mfma_f32_32x32x16_bf16(kf, qf[ks], S, 0, 0, 0); }
                    float p[16];
#pragma unroll
                    for (int i = 0; i < 16; ++i) { const int E = (i & 3) + 8 * (i >> 2);
                        const float e = __builtin_amdgcn_exp2f(S[i] * qscale + rrow[32 * kt + E]);
                        const unsigned keep = (unsigned)__builtin_amdgcn_sbfe((int)(kt ? wm1 : wm0), E, 1);
                        p[i] = __builtin_bit_cast(float, __builtin_bit_cast(unsigned, e) & keep); lsum += p[i]; }
                    v4u pw0, pw1;
                    pw0.x = pk2(p[0], p[1]); pw0.y = pk2(p[2], p[3]); pw0.z = pk2(p[4], p[5]); pw0.w = pk2(p[6], p[7]);
                    pw1.x = pk2(p[8], p[9]); pw1.y = pk2(p[10], p[11]); pw1.z = pk2(p[12], p[13]); pw1.w = pk2(p[14], p[15]);
                    const bf16x8 pf0 = __builtin_bit_cast(bf16x8, pw0), pf1 = __builtin_bit_cast(bf16x8, pw1);
#pragma unroll
                    for (int dt = 0; dt < 4; ++dt) {
                        const LAS unsigned char* vrow = vb + (32 * dt + n) * AT_VPITCH + (32 * kt + 4 * hh) * 2;
                        const v2u a0 = *(const LAS v2u*)(vrow), a1 = *(const LAS v2u*)(vrow + 16), a2 = *(const LAS v2u*)(vrow + 32), a3 = *(const LAS v2u*)(vrow + 48);
                        v4u f0, f1; f0.x = a0.x; f0.y = a0.y; f0.z = a1.x; f0.w = a1.y; f1.x = a2.x; f1.y = a2.y; f1.z = a3.x; f1.w = a3.y;
                        O[dt] = __builtin_amdgcn_mfma_f32_32x32x16_bf16(__builtin_bit_cast(bf16x8, f0), pf0, O[dt], 0, 0, 0);
                        O[dt] = __builtin_amdgcn_mfma_f32_32x32x16_bf16(__builtin_bit_cast(bf16x8, f1), pf1, O[dt], 0, 0, 0);
                    }
                }
            }
            if (j + 1 < nrows) lstore(buf ^ 1);
            __syncthreads();
        }
        lsum += __shfl_xor(lsum, 32);
        const float il = 1.f / lsum;
        float ss = 0.f;
#pragma unroll
        for (int dt = 0; dt < 4; ++dt)
#pragma unroll
            for (int i = 0; i < 16; ++i) { O[dt][i] *= il; ss += O[dt][i] * O[dt][i]; }
        ss += __shfl_xor(ss, 32);
        const float rr = rsqrtf(ss * (1.f / HD) + EPS);
        bf16* orow = MIXED + (size_t)mq * DM + h * HD;
#pragma unroll
        for (int dt = 0; dt < 4; ++dt)
#pragma unroll
            for (int rg = 0; rg < 4; ++rg) { const int d = 32 * dt + 8 * rg + 4 * hh; const f32x4 gg = *(const GAS f32x4*)(og + h * HD + d);
                v2u w; w.x = pk2(O[dt][4 * rg + 0] * rr * gg.x, O[dt][4 * rg + 1] * rr * gg.y); w.y = pk2(O[dt][4 * rg + 2] * rr * gg.z, O[dt][4 * rg + 3] * rr * gg.w);
                *(GAS v2u*)(orow + d) = w; }
    }
    __syncthreads();
}

__device__ __forceinline__ void phase_p25(Frame& F) {
    const bf16* HYT = (const bf16*)(F.ws + WS_HYT); bf16* MIXED = (bf16*)(F.ws + WS_MIXED); const float* hg = F.in[16];
    LAS float* tile = (LAS float*)F.lds;
    LAS float* rs = (LAS float*)(F.lds + 128 * 65 * 4);
    for (int it = F.bid; it < 8 * (MT / 64); it += F.G) {
        const int gi = it & 7, m0 = (it >> 3) * 64;
        { const int ch = F.tid >> 2, t0 = (F.tid & 3) * 16; const bf16* p = HYT + (size_t)(gi * 128 + ch) * MT + m0 + t0;
          const v4u a = *(const GAS v4u*)p, b = *(const GAS v4u*)(p + 8);
          LAS float* d = tile + ch * 65 + t0;
          d[0] = bflo(a.x); d[1] = bfhi(a.x); d[2] = bflo(a.y); d[3] = bfhi(a.y); d[4] = bflo(a.z); d[5] = bfhi(a.z); d[6] = bflo(a.w); d[7] = bfhi(a.w);
          d[8] = bflo(b.x); d[9] = bfhi(b.x); d[10] = bflo(b.y); d[11] = bfhi(b.y); d[12] = bflo(b.z); d[13] = bfhi(b.z); d[14] = bflo(b.w); d[15] = bfhi(b.w); }
        __syncthreads();
        {
          const int t = F.tid >> 3, c0 = (F.tid & 7) * 16; float ss = 0.f;
#pragma unroll
          for (int c = 0; c < 16; ++c) { const float v = tile[(c0 + c) * 65 + t]; ss += v * v; }
          ss += __shfl_xor(ss, 1); ss += __shfl_xor(ss, 2); ss += __shfl_xor(ss, 4);
          if ((F.tid & 7) == 0) rs[t] = rsqrtf(ss * (1.f / 128) + EPS); }
        __syncthreads();
        {
          const int t = F.tid >> 3, c0 = (F.tid & 7) * 16; const float r = rs[t]; float o[16];
#pragma unroll
          for (int c = 0; c < 16; ++c) o[c] = tile[(c0 + c) * 65 + t] * r * hg[gi * 128 + c0 + c];
          v4u a, b; a.x = pk2(o[0], o[1]); a.y = pk2(o[2], o[3]); a.z = pk2(o[4], o[5]); a.w = pk2(o[6], o[7]); b.x = pk2(o[8], o[9]); b.y = pk2(o[10], o[11]); b.z = pk2(o[12], o[13]); b.w = pk2(o[14], o[15]);
          bf16* q = MIXED + (size_t)(m0 + t) * DM + AW + gi * 128 + c0; *(GAS v4u*)q = a; *(GAS v4u*)(q + 8) = b; }
        __syncthreads();
    }
}
__device__ __forceinline__ void phase_p35(Frame& F) {
    LAS float* wrT = (LAS float*)F.lds;
    const float* wr = F.in[19]; const float* g = F.in[18];
    constexpr int WRS = DM + 4;
    for (int i = F.tid; i < DM * NE; i += NTHREADS) { const int d = i >> 4, e = i & 15; wrT[e * WRS + d] = wr[i]; }
    __syncthreads();
    bf16* HB = (bf16*)(F.ws + WS_HB); float* AFF = (float*)(F.ws + WS_AFF); const float* x1 = F.out;
    f32x4 vn[8];
    { const int m0 = GW_ID(F); if (m0 < MT) { const GAS f32x4* xr = (const GAS f32x4*)(x1 + (size_t)m0 * DM) + F.lane;
#pragma unroll
        for (int j = 0; j < 8; ++j) vn[j] = xr[64 * j]; } }
    for (int m = GW_ID(F); m < MT; m += GW_N(F)) {
        f32x4 v[8]; float s = 0.f;
#pragma unroll
        for (int j = 0; j < 8; ++j) { v[j] = vn[j]; s += (v[j].x * v[j].x + v[j].y * v[j].y) + (v[j].z * v[j].z + v[j].w * v[j].w); }
        if (m + GW_N(F) < MT) { const GAS f32x4* xr = (const GAS f32x4*)(x1 + (size_t)(m + GW_N(F)) * DM) + F.lane;
#pragma unroll
            for (int j = 0; j < 8; ++j) vn[j] = xr[64 * j]; }
        const float r = rsqrtf(wave_sum(s) * (1.f / DM) + EPS);
        GAS v2u* o8 = (GAS v2u*)(HB + (size_t)m * DM) + F.lane;
#pragma unroll
        for (int j = 0; j < 8; ++j) { const f32x4 gg = *((const GAS f32x4*)g + F.lane + 64 * j); v[j].x *= r * gg.x; v[j].y *= r * gg.y; v[j].z *= r * gg.z; v[j].w *= r * gg.w;
            v2u o; o.x = pk2(v[j].x, v[j].y); o.y = pk2(v[j].z, v[j].w); o8[64 * j] = o; }
        float mine = 0.f;
#pragma unroll 1
        for (int e = 0; e < NE; ++e) { float a = 0.f;
#pragma unroll
            for (int j = 0; j < 8; ++j) { const f32x4 w = *((const LAS f32x4*)(wrT + e * WRS) + F.lane + 64 * j); a += (v[j].x * w.x + v[j].y * w.y) + (v[j].z * w.z + v[j].w * w.w); }
            a = wave_sum(a); mine = (F.lane == e) ? a : mine; }
        float mx = mine;
        mx = fmaxf(mx, __shfl_xor(mx, 1)); mx = fmaxf(mx, __shfl_xor(mx, 2)); mx = fmaxf(mx, __shfl_xor(mx, 4)); mx = fmaxf(mx, __shfl_xor(mx, 8));
        const float ex = expf(mine - mx); float den = ex;
        den += __shfl_xor(den, 1); den += __shfl_xor(den, 2); den += __shfl_xor(den, 4); den += __shfl_xor(den, 8);
        const int b = m / SEQ, sidx = m % SEQ;
        if (F.lane < NE) AFF[((size_t)b * NE + F.lane) * SEQ + sidx] = ex / den;
    }
    __syncthreads();
}
__device__ __forceinline__ void phase_p4(Frame& F) {
    LAS unsigned* key = (LAS unsigned*)F.lds;
    LAS unsigned* hist = (LAS unsigned*)(F.lds + 16384);
    LAS unsigned* wsum = (LAS unsigned*)(F.lds + 16384 + 1024);
    const float* AFF = (const float*)(F.ws + WS_AFF); int* IDX = (int*)(F.ws + WS_IDX); float* GATE = (float*)(F.ws + WS_GATE); int* SEL = (int*)(F.ws + WS_SEL);
    for (int be = F.bid; be < NB * NE; be += F.G) {
        const int b = be / NE, e = be % NE;
        __syncthreads();
        const GAS v4u* ap = (const GAS v4u*)(AFF + (size_t)be * SEQ);
        const v4u k0 = ap[2 * F.tid], k1 = ap[2 * F.tid + 1];
        unsigned kk[8] = {k0.x, k0.y, k0.z, k0.w, k1.x, k1.y, k1.z, k1.w};
        unsigned prefix = 0u, mask = 0u, remaining = CAP;
#pragma unroll 1
        for (int pass = 0; pass < 4; ++pass) {
            const int shift = 24 - 8 * pass;
            if (F.tid < 256) hist[F.tid] = 0u;
            __syncthreads();
#pragma unroll
            for (int i = 0; i < 8; ++i) if ((kk[i] & mask) == prefix) __hip_atomic_fetch_add(&hist[(kk[i] >> shift) & 255u], 1u, __ATOMIC_RELAXED, __HIP_MEMORY_SCOPE_WORKGROUP);
            __syncthreads();
            unsigned incl_ = 0u, mine_ = 0u;
            if (F.tid < 256) {
                mine_ = hist[255 - F.tid]; incl_ = mine_;
#pragma unroll
                for (int o = 1; o < 64; o <<= 1) { const unsigned t = __shfl_up(incl_, o); if (F.lane >= o) incl_ += t; }
                if (F.lane == 63) wsum[10 + F.wave] = incl_;
            }
            __syncthreads();
            if (F.tid < 256) {
                unsigned base = 0u;
                for (int w = 0; w < F.wave; ++w) base += wsum[10 + w];
                const unsigned above = base + incl_ - mine_;
                if (above < remaining && remaining <= above + mine_) { wsum[8] = (unsigned)(255 - F.tid); wsum[9] = above; }
            }
            __syncthreads();
            const unsigned d = wsum[8], above = wsum[9];
            prefix |= d << shift; mask |= 255u << shift; remaining -= above;
            __syncthreads();
        }
        const unsigned thr = prefix;
        unsigned cnt = 0u;
#pragma unroll
        for (int i = 0; i < 8; ++i) cnt += (kk[i] > thr ? 0x10000u : 0u) + (kk[i] == thr ? 1u : 0u);
        unsigned incl = cnt;
#pragma unroll
        for (int o = 1; o < 64; o <<= 1) { const unsigned t = __shfl_up(incl, o); if (F.lane >= o) incl += t; }
        if (F.lane == 63) wsum[F.wave] = incl;
        __syncthreads();
        unsigned base = 0u;
        for (int w = 0; w < F.wave; ++w) base += wsum[w];
        unsigned run = base + incl - cnt;
#pragma unroll
        for (int i = 0; i < 8; ++i) {
            const unsigned gt_before = run >> 16, tie_before = run & 0xffffu;
            const bool isgt = kk[i] > thr, istie = kk[i] == thr;
            const bool sel = isgt || (istie && tie_before < remaining);
            const unsigned slot = gt_before + (tie_before < remaining ? tie_before : remaining);
            const int s = 8 * F.tid + i, m = b * SEQ + s;
            if (sel) { IDX[be * CAP + slot] = m; GATE[be * CAP + slot] = __builtin_bit_cast(float, kk[i]); }
            SEL[(size_t)m * NE + e] = sel ? (int)slot : -1;
            run += (isgt ? 0x10000u : 0u) + (istie ? 1u : 0u);
        }
    }
    __syncthreads();
}
__device__ __forceinline__ void phase_p7(Frame& F) {
    const int* SEL = (const int*)(F.ws + WS_SEL); const float* GATE = (const float*)(F.ws + WS_GATE); const bf16* YE = (const bf16*)(F.ws + WS_YE);
    for (int m = GW_ID(F); m < MT; m += GW_N(F)) {
        const int b = m / SEQ;
        GAS f32x4* orow = (GAS f32x4*)(F.out + (size_t)m * DM);
        f32x4 acc[8];
#pragma unroll
        for (int j = 0; j < 8; ++j) acc[j] = orow[2 * F.lane + (j & 1) + 128 * (j >> 1)];
        for (int e = 0; e < NE; ++e) { const int slot = SEL[(size_t)m * NE + e]; if (slot >= 0) {
            const GAS v4u* yr = (const GAS v4u*)(YE + (size_t)((b * NE + e) * CAP + slot) * DM) + F.lane;
#pragma unroll
            for (int jj = 0; jj < 4; ++jj) { const v4u w = yr[64 * jj];
                acc[2 * jj].x += bflo(w.x); acc[2 * jj].y += bfhi(w.x); acc[2 * jj].z += bflo(w.y); acc[2 * jj].w += bfhi(w.y);
                acc[2 * jj + 1].x += bflo(w.z); acc[2 * jj + 1].y += bfhi(w.z); acc[2 * jj + 1].z += bflo(w.w); acc[2 * jj + 1].w += bfhi(w.w); } } }
#pragma unroll
        for (int j = 0; j < 8; ++j) orow[2 * F.lane + (j & 1) + 128 * (j >> 1)] = acc[j];
    }
    (void)GATE;
}

struct Args { const float* in[23]; float* out; unsigned char* ws; int ph_lo, ph_hi; };
enum Phase { PH_P0 = 0, PH_G1, PH_ATTN, PH_P25, PH_OUT, PH_P35, PH_P4, PH_UP, PH_DOWN, PH_P7, PH_COUNT };

__global__ void __launch_bounds__(NTHREADS, 2) mk_fwd(Args args) {
    extern __shared__ __attribute__((aligned(16))) unsigned char lds_raw[];
    Frame F;
    F.lds = (LAS unsigned char*)lds_raw;
    F.tid = threadIdx.x; F.lane = F.tid & 63; F.wave = __builtin_amdgcn_readfirstlane(F.tid >> 6); F.G = gridDim.x; F.bid = blockIdx.x;
#pragma unroll
    for (int i = 0; i < 23; ++i) F.in[i] = args.in[i];
    F.out = args.out; F.ws = args.ws;
    const int lo = args.ph_lo, hi = args.ph_hi;
#define IN(k) (lo <= (k) && (k) < hi)
#define REPS(k) for (int rep_ = 0; rep_ < ((k) == REP_PHASE ? REP_N : 1); ++rep_)
#if MK_N_LAUNCHES == 1
    { volatile LAS unsigned* misc = (volatile LAS unsigned*)(F.lds + LDS_MISC_OFF); if (F.tid < 16) misc[F.tid] = 0u; }
    __syncthreads();
    XcdBarrier bar = xcd_barrier_post(g_bar_words, (volatile LAS unsigned*)(F.lds + LDS_MISC_OFF) + 8);
#define SEAM(k) do { if (IN(k) && IN((k) + 1)) xcd_barrier(bar); } while (0)
#else
#define SEAM(k) do { } while (0)
#endif
    if (IN(PH_P0)) REPS(PH_P0) { phase_p0(F); for (int it = GW_ID(F); it < MOE_P0_ITEMS; it += GW_N(F)) moe_conv_item(F, it); } SEAM(PH_P0);
    if (IN(PH_G1)) REPS(PH_G1) {
        phase_filters(F);
        __syncthreads();
        { pg8::DenseOrder S; S.init(F.ws + WS_HB, F.ws + WS_WIN, MT, 2048, DM, 0, F.G, F.bid);
          pg8::EpiBf16 E{(pg8::bf16_t*)(F.ws + WS_QK), 2048, 0, nullptr};
          pg8::gemm_phase<pg8::EpiBf16, pg8::DenseOrder, true>(F.lds, DM, S, E); }
        { pg8::DenseOrder S; S.init(F.ws + WS_HB, F.ws + WS_WIN, MT, 4096, DM, 8, F.G, F.bid);
          pg8::EpiTransBf16 E{(pg8::bf16_t*)(F.ws + WS_XT), MT, 8};
          pg8::gemm_phase<pg8::EpiTransBf16, pg8::DenseOrder, true>(F.lds, DM, S, E); }
    } SEAM(PH_G1);
    if (IN(PH_ATTN)) { __syncthreads(); for (int rep_ = 0; rep_ < ((PH_ATTN == REP_PHASE && REP_SUB != 2) ? REP_N : 1); ++rep_) phase_hyena(F); for (int rep_ = 0; rep_ < ((PH_ATTN == REP_PHASE && REP_SUB != 1) ? REP_N : 1); ++rep_) phase_attn2(F); } SEAM(PH_ATTN);
    if (IN(PH_P25)) REPS(PH_P25) { __syncthreads(); phase_p25(F); } SEAM(PH_P25);
    if (IN(PH_OUT)) REPS(PH_OUT) {
        __syncthreads();
        pg8::DenseOrder S; S.init(F.ws + WS_MIXED, F.ws + WS_WOUT, MT, DM, DM, 0, F.G, F.bid);
        pg8::EpiResF32 E{F.in[0], F.out, DM};
        pg8::gemm_phase<pg8::EpiResF32, pg8::DenseOrder, false>(F.lds, DM, S, E);
    } SEAM(PH_OUT);
    if (IN(PH_P35)) REPS(PH_P35) { __syncthreads(); phase_p35(F); } SEAM(PH_P35);
    if (IN(PH_P4)) REPS(PH_P4) { __syncthreads(); phase_p4(F); } SEAM(PH_P4);
    if (IN(PH_UP)) REPS(PH_UP) {
        __syncthreads();
        pg8::MoeOrder S; S.init(F.ws + WS_HB, F.ws + WS_WGU, DM, F.G, F.bid, true);
        LAS int* ridx = (LAS int*)(F.lds + 131072);
        { const int* IDX = (const int*)(F.ws + WS_IDX); pg8::Unit u;
          for (int i = 0; S.next(i, u); ++i) if (F.tid < 256) ridx[i * 256 + F.tid] = IDX[u.g * CAP + u.pm * 256 + F.tid]; }
        __syncthreads();
        pg8::EpiSwiGLU E{(pg8::bf16_t*)(F.ws + WS_ACT)};
        pg8::gemm_phase<pg8::EpiSwiGLU, pg8::MoeOrder, true, true>(F.lds, DM, S, E, ridx);
    } SEAM(PH_UP);
    if (IN(PH_DOWN)) REPS(PH_DOWN) {
        __syncthreads();
        pg8::MoeOrder S; S.init(F.ws + WS_ACT, F.ws + WS_WD, FF, F.G, F.bid, false);
        pg8::EpiBf16 E{(pg8::bf16_t*)(F.ws + WS_YE), DM, 512, (const float*)(F.ws + WS_GATE)};
        pg8::gemm_phase<pg8::EpiBf16, pg8::MoeOrder, true>(F.lds, FF, S, E);
    } SEAM(PH_DOWN);
    if (IN(PH_P7)) { phase_p7(F); }
#if MK_N_LAUNCHES == 1
    __syncthreads();
    { volatile LAS unsigned* misc = (volatile LAS unsigned*)(F.lds + LDS_MISC_OFF);
      if (F.tid == 0) misc[0] = (xb_add(&g_bar_words[XCD_BAR_WORDS], 1u) + 1u == (unsigned)F.G) ? 1u : 0u;
      __syncthreads();
      if (misc[0] != 0u && F.tid < (XCD_BAR_WORDS + 64) / 64) __hip_atomic_store(&g_bar_words[64 * F.tid], 0u, __ATOMIC_RELAXED, __HIP_MEMORY_SCOPE_AGENT); }
#endif
#undef IN
#undef SEAM
}

extern "C" void kernel_launch(void* const* d_in, const int* in_sizes, int n_in, void* d_out, int out_size, void* d_ws, size_t ws_size, hipStream_t stream) {
    static int grid = 0;
    if (grid == 0) {
        if (n_in != 23 || ws_size < WS_END) { fprintf(stderr, "kernel_launch: unexpected inputs (n_in %d, ws %zu)\n", n_in, ws_size); grid = -1; return; }
        if (hipFuncSetAttribute((const void*)mk_fwd, hipFuncAttributeMaxDynamicSharedMemorySize, LDS_BYTES) != hipSuccess) { fprintf(stderr, "kernel_launch: hipFuncSetAttribute failed\n"); grid = -1; return; }
        int dev = 0, cus = 0, per_cu = 0;
        hipGetDevice(&dev); hipDeviceGetAttribute(&cus, hipDeviceAttributeMultiprocessorCount, dev);
        hipOccupancyMaxActiveBlocksPerMultiprocessor(&per_cu, (const void*)mk_fwd, NTHREADS, LDS_BYTES);
        (void)hipGetLastError();
        if (per_cu < 1) { fprintf(stderr, "kernel_launch: occupancy query says %d blocks/CU\n", per_cu); }
        grid = cus;
    }
    if (grid < 0) return;
    Args a{};
    for (int i = 0; i < 23; ++i) a.in[i] = (const float*)d_in[i];
    a.out = (float*)d_out; a.ws = (unsigned char*)d_ws;
#if MK_N_LAUNCHES == 1
    a.ph_lo = 0; a.ph_hi = PH_COUNT;
    hipLaunchKernelGGL(mk_fwd, dim3(grid), dim3(NTHREADS), LDS_BYTES, stream, a);
#else
    for (int p = 0; p < PH_COUNT; ++p) { a.ph_lo = p; a.ph_hi = p + 1; hipLaunchKernelGGL(mk_fwd, dim3(grid), dim3(NTHREADS), LDS_BYTES, stream, a); }
#endif
}
```

```cpp
#include <hip/hip_runtime.h>
#include <hip/hip_cooperative_groups.h>
#include <cstdio>
#include <cstdint>
namespace cg = cooperative_groups;

#ifndef REP_PHASE
#define REP_PHASE -1
#define REP_N 1
#define REP_SUB 0
#endif
#ifndef MK_N_LAUNCHES
#define MK_N_LAUNCHES 1
#endif

namespace pg8 {
#define PG8_LAS __attribute__((address_space(3)))
typedef unsigned short bf16_t;
typedef short bf16x8 __attribute__((ext_vector_type(8)));
typedef float f32x4 __attribute__((ext_vector_type(4)));
typedef unsigned u32x4 __attribute__((ext_vector_type(4)));
typedef unsigned u32x2 __attribute__((ext_vector_type(2)));
constexpr int BM = 256, BK = 64, HALF = 128, HTB = HALF * BK * 2, STAGE_BYTES = 8 * HTB, NXCD = 8, WGM = 8;

__host__ __device__ __forceinline__ int lds_byte(int r, int c) { const int st = (r >> 4) * 2 + (c >> 5), rr = r & 15, cc = c & 31, ob = rr * 64 + cc * 2; return st * 1024 + (ob ^ (((ob >> 9) & 1) << 5)); }
__host__ __device__ __forceinline__ void stage_rc(int b, int& R, int& C) { const int st = b / 1024, sb = b % 1024, swz = sb ^ (((sb >> 9) & 1) << 5); R = (st >> 1) * 16 + swz / 64; C = (st & 1) * 32 + (swz % 64) / 2; }
__host__ __device__ __forceinline__ int perm32(int rho) { const int n = rho >> 4, i = rho & 15; return 8 * (i >> 2) + 4 * n + (i & 3); }

struct Unit { int pm, pn, g; const char* a; const char* b; };

__device__ __forceinline__ unsigned cvt_pk_bf16(float lo, float hi) { unsigned r; asm volatile("v_cvt_pk_bf16_f32 %0, %1, %2" : "=v"(r) : "v"(lo), "v"(hi)); return r; }

struct DenseOrder {
    static constexpr bool CHUNK_B = false;
    int nM, nN, nwg, G, c, K, pn0; const char* A; const char* Bt;
    __device__ void init(const void* A_, const void* Bt_, int M, int N, int K_, int pn0_, int G_, int c_) { A = (const char*)A_; Bt = (const char*)Bt_; nM = M / BM; nN = N / BM; nwg = nM * nN; G = G_; c = c_; K = K_; pn0 = pn0_; }
    __device__ bool next(int i, Unit& u) const {
        const long L = (long)i * G + c; if (L >= nwg) return false;
        int wgid = (int)L; { const int q = nwg / NXCD, r = nwg % NXCD, xcd = wgid % NXCD, off = wgid / NXCD; wgid = (xcd < r ? xcd * (q + 1) : r * (q + 1) + (xcd - r) * q) + off; }
        const int nig = WGM * nN, gid = wgid / nig, fm = gid * WGM, gsz = (nM - fm) < WGM ? (nM - fm) : WGM;
        u.pm = fm + ((wgid % nig) % gsz); u.pn = pn0 + (wgid % nig) / gsz; u.g = 0;
        u.a = A + (size_t)u.pm * BM * K * 2; u.b = Bt + (size_t)u.pn * BM * K * 2; return true;
    }
};
struct MoeOrder {
    static constexpr bool CHUNK_B = true;
    int G, c, K; bool gather; const char* A; const char* Bt;
    __device__ void init(const void* A_, const void* Bt_, int K_, int G_, int c_, bool gather_) { A = (const char*)A_; Bt = (const char*)Bt_; K = K_; G = G_; c = c_; gather = gather_; }
    __device__ bool next(int i, Unit& u) const {
        const int L = i * G + c; if (L >= 512) return false;
        int pn, pm, b, e;
        if ((G & 7) == 0 && G >= 64) { const int per = G >> 3, x = c & 7, u = (c >> 3) + i * per;
            pn = u & 7; pm = (u >> 3) & 1; b = (u >> 4) & 1; e = x + 8 * (u >> 5); if (e >= 16) return false; }
        else { pn = L & 7; pm = (L >> 3) & 1; b = (L >> 4) & 1; e = L >> 5; }
        u.pm = pm; u.pn = pn; u.g = b * 16 + e;
        u.a = gather ? A : A + (size_t)(u.g * 512 + pm * BM) * K * 2; u.b = Bt + (size_t)e * 2048 * K * 2 + (size_t)pn * BM * 16; return true;
    }
};

struct EpiBf16 {
    static constexpr bool PERM = true, SWAP = false, INIT = false;
    bf16_t* O; int ldc; int grows; const float* rscale;
    __device__ __forceinline__ void operator()(const f32x4 (&acc)[2][2][4][2], const Unit& u, int wr, int wc, int fr, int fq) const {
        const int row0 = u.g * grows + u.pm * BM + wr * 64 + fr, col0 = u.pn * BM + wc * 32 + 8 * fq;
#pragma unroll
        for (int ai = 0; ai < 2; ++ai)
#pragma unroll
            for (int m = 0; m < 4; ++m) { const int row = row0 + ai * HALF + m * 16; bf16_t* rowp = O + (size_t)row * ldc + col0; const float sc = rscale ? rscale[row] : 1.f;
#pragma unroll
                for (int bj = 0; bj < 2; ++bj) { const f32x4 v0 = acc[ai][bj][m][0] * sc, v1 = acc[ai][bj][m][1] * sc;
                    u32x4 w; w.x = cvt_pk_bf16(v0[0], v0[1]); w.y = cvt_pk_bf16(v0[2], v0[3]); w.z = cvt_pk_bf16(v1[0], v1[1]); w.w = cvt_pk_bf16(v1[2], v1[3]);
                    *(u32x4*)(rowp + bj * HALF) = w; } }
    }
};
struct EpiSwiGLU {
    static constexpr bool PERM = true, SWAP = false, INIT = false;
    bf16_t* O;
    __device__ __forceinline__ void operator()(const f32x4 (&acc)[2][2][4][2], const Unit& u, int wr, int wc, int fr, int fq) const {
        const int row0 = u.g * 512 + u.pm * BM + wr * 64 + fr, col0 = u.pn * HALF + wc * 32 + 8 * fq;
#pragma unroll
        for (int ai = 0; ai < 2; ++ai)
#pragma unroll
            for (int m = 0; m < 4; ++m) { bf16_t* rowp = O + (size_t)(row0 + ai * HALF + m * 16) * 1024 + col0;
                float r[8];
#pragma unroll
                for (int n = 0; n < 2; ++n)
#pragma unroll
                    for (int e = 0; e < 4; ++e) { const float g = acc[ai][0][m][n][e], up = acc[ai][1][m][n][e]; r[n * 4 + e] = g / (1.f + __expf(-g)) * up; }
                u32x4 w; w.x = cvt_pk_bf16(r[0], r[1]); w.y = cvt_pk_bf16(r[2], r[3]); w.z = cvt_pk_bf16(r[4], r[5]); w.w = cvt_pk_bf16(r[6], r[7]);
                *(u32x4*)rowp = w; }
    }
};
struct EpiResF32 {
    static constexpr bool PERM = false, SWAP = false, INIT = true;
    const float* res; float* out; int ldc;
    __device__ __forceinline__ void init(f32x4 (&acc)[2][2][4][2], const Unit& u, int wr, int wc, int fr, int fq) const {
        const int row0 = u.pm * BM + wr * 64 + fr, col0 = u.pn * BM + wc * 32 + 4 * fq;
#pragma unroll
        for (int ai = 0; ai < 2; ++ai)
#pragma unroll
            for (int m = 0; m < 4; ++m) { const size_t off = (size_t)(row0 + ai * HALF + m * 16) * ldc + col0;
#pragma unroll
                for (int bj = 0; bj < 2; ++bj)
#pragma unroll
                    for (int n = 0; n < 2; ++n) acc[ai][bj][m][n] = *(const f32x4*)(res + off + bj * HALF + n * 16); }
    }
    __device__ __forceinline__ void operator()(const f32x4 (&acc)[2][2][4][2], const Unit& u, int wr, int wc, int fr, int fq) const {
        const int row0 = u.pm * BM + wr * 64 + fr, col0 = u.pn * BM + wc * 32 + 4 * fq;
#pragma unroll
        for (int ai = 0; ai < 2; ++ai)
#pragma unroll
            for (int m = 0; m < 4; ++m) { const size_t off = (size_t)(row0 + ai * HALF + m * 16) * ldc + col0;
#pragma unroll
                for (int bj = 0; bj < 2; ++bj)
#pragma unroll
                    for (int n = 0; n < 2; ++n) *(f32x4*)(out + off + bj * HALF + n * 16) = acc[ai][bj][m][n]; }
    }
};
struct EpiTransBf16 {
    static constexpr bool PERM = false, SWAP = true, INIT = false;
    bf16_t* O; int ldt; int pn_base;
    __device__ __forceinline__ void operator()(const f32x4 (&acc)[2][2][4][2], const Unit& u, int wr, int wc, int fr, int fq) const {
        const int ch0 = (u.pn - pn_base) * BM + wc * 32 + fr, t0 = u.pm * BM + wr * 64 + 4 * fq;
#pragma unroll
        for (int bj = 0; bj < 2; ++bj)
#pragma unroll
            for (int n = 0; n < 2; ++n) { bf16_t* chp = O + (size_t)(ch0 + bj * HALF + n * 16) * ldt + t0;
#pragma unroll
                for (int ai = 0; ai < 2; ++ai)
#pragma unroll
                    for (int m = 0; m < 4; ++m) { const f32x4 v = acc[ai][bj][m][n]; u32x2 w; w.x = cvt_pk_bf16(v[0], v[1]); w.y = cvt_pk_bf16(v[2], v[3]); *(u32x2*)(chp + ai * HALF + m * 16) = w; } }
    }
};

template <class Epi, class Sched, bool ALIGN_EPI = false, bool GATHER = false>
__device__ __forceinline__ void gemm_phase(PG8_LAS unsigned char* lds, const int K, const Sched& S, const Epi& E, const PG8_LAS int* ridx = nullptr) {
    const int tid = threadIdx.x, wid = __builtin_amdgcn_readfirstlane(tid >> 6), lane = tid & 63, wr = wid >> 2, wc = wid & 3, fr = lane & 15, fq = lane >> 4;
    const int nt = K / BK;
    unsigned vA0[2], vA1[2], vN0[2], vN1[2], voffB[2]; int stR[2], stC[2];
    const size_t kstep = (size_t)(BK * 2);
    const size_t hstep = (size_t)HALF * K * 2;
    const size_t kstepB = Sched::CHUNK_B ? (size_t)(BK / 8) * 2048 * 16 : kstep, hstepB = Sched::CHUNK_B ? (size_t)HALF * 16 : hstep;
#pragma unroll
    for (int i = 0; i < 2; ++i) { int R, C; stage_rc(tid * 16 + i * 8192, R, C); const int Rb = Epi::PERM ? ((R & ~31) + perm32(R & 31)) : R; stR[i] = R; stC[i] = C;
        voffB[i] = Sched::CHUNK_B ? (unsigned)(((C >> 3) * 2048 + Rb) * 16) : (unsigned)(Rb * K + C) * 2u;
        if constexpr (GATHER) { vA0[i] = (unsigned)(ridx[R] * K + C) * 2u; vA1[i] = (unsigned)(ridx[HALF + R] * K + C) * 2u; }
        else { vA0[i] = (unsigned)(R * K + C) * 2u; vA1[i] = vA0[i] + (unsigned)hstep; }
        vN0[i] = vA0[i]; vN1[i] = vA1[i]; }
    const unsigned ldsw = (unsigned)wid * 1024u;
    const int aoff = lds_byte(wr * 64 + fr, fq * 8), boff = lds_byte(wc * 32 + fr, fq * 8);
#define PG8_SA(b, h) (((b) * 2 + (h)) * HTB)
#define PG8_SB(b, h) ((4 + (b) * 2 + (h)) * HTB)
#define PG8_STAGE(bufoff, gbase, voff) do { _Pragma("unroll") for (int _i = 0; _i < 2; ++_i) \
        __builtin_amdgcn_global_load_lds((const unsigned*)((const char*)(gbase) + (voff)[_i]), (PG8_LAS unsigned*)(lds + (bufoff) + ldsw + _i * 8192), 16, 0, 0); } while (0)
#define PG8_LDA(dst, b, h) do { _Pragma("unroll") for (int m = 0; m < 4; ++m) _Pragma("unroll") for (int k = 0; k < 2; ++k) dst[m][k] = *(const PG8_LAS bf16x8*)(lds + PG8_SA(b, h) + aoff + m * 2048 + k * 1024); } while (0)
#define PG8_LDB(dst, b, h) do { _Pragma("unroll") for (int n = 0; n < 2; ++n) _Pragma("unroll") for (int k = 0; k < 2; ++k) dst[n][k] = *(const PG8_LAS bf16x8*)(lds + PG8_SB(b, h) + boff + n * 2048 + k * 1024); } while (0)
#define PG8_MMA(ai, bj, At, Bt) do { __builtin_amdgcn_s_setprio(1); _Pragma("unroll") for (int m = 0; m < 4; ++m) _Pragma("unroll") for (int n = 0; n < 2; ++n) _Pragma("unroll") for (int k = 0; k < 2; ++k) \
        acc[ai][bj][m][n] = Epi::SWAP ? __builtin_amdgcn_mfma_f32_16x16x32_bf16(At[m][k], Bt[n][k], acc[ai][bj][m][n], 0, 0, 0) : __builtin_amdgcn_mfma_f32_16x16x32_bf16(Bt[n][k], At[m][k], acc[ai][bj][m][n], 0, 0, 0); __builtin_amdgcn_s_setprio(0); } while (0)
#define PG8_WAIT_V(n) asm volatile("s_waitcnt vmcnt(" #n ")" ::: "memory")
#define PG8_WAIT_L(n) asm volatile("s_waitcnt lgkmcnt(" #n ")" ::: "memory")
#define PG8_BAR __builtin_amdgcn_s_barrier()
#define PG8_SCHED __builtin_amdgcn_sched_barrier(0)
    Unit cur, nxt; int ui = 0;
    if (!S.next(0, cur)) return;
    f32x4 acc[2][2][4][2];
    if constexpr (Epi::INIT) E.init(acc, cur, wr, wc, fr, fq);
    else {
#pragma unroll
    for (int a = 0; a < 2; ++a)
#pragma unroll
        for (int b = 0; b < 2; ++b)
#pragma unroll
            for (int m = 0; m < 4; ++m)
#pragma unroll
                for (int n = 0; n < 2; ++n) acc[a][b][m][n] = (f32x4){0.f, 0.f, 0.f, 0.f};
    }
    bf16x8 At[4][2], B0[2][2], B1[2][2];
    const char* cA = cur.a; const char* cB = cur.b;
    PG8_STAGE(PG8_SB(0, 0), cB, voffB); PG8_STAGE(PG8_SB(0, 1), cB + hstepB, voffB); PG8_STAGE(PG8_SA(0, 0), cA, vA0); PG8_STAGE(PG8_SA(0, 1), cA, vA1);
    if (wr == 1) PG8_BAR;
    PG8_WAIT_V(2); PG8_BAR;
    PG8_STAGE(PG8_SB(1, 0), cB + kstepB, voffB); PG8_STAGE(PG8_SA(1, 0), cA + kstep, vA0); PG8_STAGE(PG8_SB(1, 1), cB + hstepB + kstepB, voffB);
    PG8_WAIT_V(6); PG8_BAR;
    for (;;) {
        const bool has_next = S.next(ui + 1, nxt);
        const char* nA = has_next ? nxt.a : cA; const char* nB = has_next ? nxt.b : cB;
        if constexpr (GATHER) { if (has_next) {
#pragma unroll
            for (int i = 0; i < 2; ++i) { vN0[i] = (unsigned)(ridx[(ui + 1) * 256 + stR[i]] * K + stC[i]) * 2u; vN1[i] = (unsigned)(ridx[(ui + 1) * 256 + HALF + stR[i]] * K + stC[i]) * 2u; } } }
        for (int t = 0; t < nt; t += 2) {
            const bool last = (t == nt - 2);
            const char* a1 = cA + (size_t)(t + 1) * kstep;
            const char* a2 = last ? nA : cA + (size_t)(t + 2) * kstep; const char* b2 = last ? nB : cB + (size_t)(t + 2) * kstepB;
            const char* a3 = a2 + kstep; const char* b3 = b2 + kstepB;
            unsigned w0[2], w1[2];
#pragma unroll
            for (int i = 0; i < 2; ++i) { w0[i] = last ? vN0[i] : vA0[i]; w1[i] = last ? vN1[i] : vA1[i]; }
            PG8_LDB(B0, 0, 0); PG8_LDB(B1, 0, 1); PG8_SCHED; PG8_LDA(At, 0, 0); PG8_STAGE(PG8_SA(1, 1), a1, vA1);
            PG8_WAIT_V(8); PG8_WAIT_L(0); PG8_BAR; PG8_MMA(0, 0, At, B0); PG8_MMA(0, 1, At, B1); PG8_BAR; PG8_SCHED;
            PG8_LDA(At, 0, 1); PG8_STAGE(PG8_SB(0, 0), b2, voffB); PG8_STAGE(PG8_SB(0, 1), b2 + hstepB, voffB); PG8_STAGE(PG8_SA(0, 0), a2, w0);
            PG8_WAIT_V(8); PG8_WAIT_L(0); PG8_BAR; PG8_MMA(1, 0, At, B0); PG8_MMA(1, 1, At, B1); PG8_BAR; PG8_SCHED;
            PG8_LDB(B0, 1, 0); PG8_LDB(B1, 1, 1); PG8_SCHED; PG8_LDA(At, 1, 0); PG8_STAGE(PG8_SA(0, 1), a2, w1);
            PG8_WAIT_V(8); PG8_WAIT_L(0); PG8_BAR; PG8_MMA(0, 0, At, B0); PG8_MMA(0, 1, At, B1); PG8_BAR; PG8_SCHED;
            PG8_LDA(At, 1, 1); PG8_STAGE(PG8_SB(1, 0), b3, voffB); PG8_STAGE(PG8_SB(1, 1), b3 + hstepB, voffB); PG8_STAGE(PG8_SA(1, 0), a3, w0);
            PG8_WAIT_V(8); PG8_WAIT_L(0); PG8_BAR; PG8_MMA(1, 0, At, B0); PG8_MMA(1, 1, At, B1); PG8_BAR; PG8_SCHED;
        }
        if constexpr (ALIGN_EPI) { if (wr == 0) PG8_BAR; }
        E(acc, cur, wr, wc, fr, fq);
        if (!has_next) break;
        if constexpr (Epi::INIT) E.init(acc, nxt, wr, wc, fr, fq);
        else {
#pragma unroll
        for (int a = 0; a < 2; ++a)
#pragma unroll
            for (int b = 0; b < 2; ++b)
#pragma unroll
                for (int m = 0; m < 4; ++m)
#pragma unroll
                    for (int n = 0; n < 2; ++n) acc[a][b][m][n] = (f32x4){0.f, 0.f, 0.f, 0.f};
        }
        cur = nxt; cA = nA; cB = nB; ++ui;
#pragma unroll
        for (int i = 0; i < 2; ++i) { vA0[i] = vN0[i]; vA1[i] = vN1[i]; }
        if constexpr (ALIGN_EPI) { if (wr == 1) PG8_BAR; }
    }
    PG8_WAIT_V(0);
    if constexpr (!ALIGN_EPI) { if (wr == 0) PG8_BAR; }
    PG8_BAR;
#undef PG8_SA
#undef PG8_SB
#undef PG8_STAGE
#undef PG8_LDA
#undef PG8_LDB
#undef PG8_MMA
#undef PG8_WAIT_V
#undef PG8_WAIT_L
#undef PG8_BAR
#undef PG8_SCHED
}
}

constexpr int NB = 2, SEQ = 4096, DM = 2048, MT = NB * SEQ;
constexpr int NH = 8, HD = 128, AW = 1024, HW = 1024, INW = 6144;
constexpr int GW = 64, NROWS = 64, WR = 8, WC = 16;
constexpr int NE = 16, CAP = 512, FF = 1024;
constexpr int FEMB = 33, FHID = 64;
constexpr float EPS = 1e-6f;
constexpr int NWAVES = 8, NTHREADS = 512;

constexpr size_t MiB = 1u << 20;
constexpr size_t WS_CTL = 0, CTL_ZERO_BYTES = 32768;
constexpr size_t WS_WIN = 2 * MiB;
constexpr size_t WS_WOUT = 26 * MiB;
constexpr size_t WS_WGU = 34 * MiB;
constexpr size_t WS_WD = 162 * MiB;
constexpr size_t WS_W3T = 226 * MiB;
constexpr size_t WS_HID2 = 227 * MiB;
constexpr size_t WS_HB = 228 * MiB;
constexpr size_t WS_QK = 260 * MiB;
constexpr size_t WS_XT = 292 * MiB;
constexpr size_t WS_UC = 356 * MiB;
constexpr size_t WS_TAPS = 404 * MiB;
constexpr size_t WS_HYT = 436 * MiB;
constexpr size_t WS_MIXED = 452 * MiB;
constexpr size_t WS_AFF = 484 * MiB;
constexpr size_t WS_IDX = 485 * MiB;
constexpr size_t WS_GATE = 486 * MiB;
constexpr size_t WS_SEL = 487 * MiB;
constexpr size_t WS_Z1T = 488 * MiB;
constexpr size_t WS_XG = WS_XT;
constexpr size_t WS_ACT = WS_UC;
constexpr size_t WS_YE = WS_TAPS;
constexpr size_t WS_END = 504 * MiB;

constexpr int LDS_BYTES = 163840, LDS_MISC_OFF = 163840 - 128;

#define GAS __attribute__((address_space(1)))
#define LAS __attribute__((address_space(3)))
typedef unsigned short bf16;
typedef unsigned v4u __attribute__((ext_vector_type(4)));
typedef unsigned v2u __attribute__((ext_vector_type(2)));
typedef float f32x4 __attribute__((ext_vector_type(4)));
#define LDS_WAIT() asm volatile("s_waitcnt lgkmcnt(0)" ::: "memory")
#define VM_WAIT() asm volatile("s_waitcnt vmcnt(0)" ::: "memory")
__device__ __forceinline__ unsigned f2bf(float f) { unsigned u = __builtin_bit_cast(unsigned, f); return (u + 0x7fffu + ((u >> 16) & 1u)) >> 16; }
__device__ __forceinline__ unsigned pk2(float lo, float hi) { unsigned r; asm("v_cvt_pk_bf16_f32 %0, %1, %2" : "=v"(r) : "v"(lo), "v"(hi)); return r; }
__device__ __forceinline__ float bf2f(unsigned h) { return __builtin_bit_cast(float, h << 16); }
__device__ __forceinline__ float bflo(unsigned w) { return __builtin_bit_cast(float, w << 16); }
__device__ __forceinline__ float bfhi(unsigned w) { return __builtin_bit_cast(float, w & 0xffff0000u); }
__device__ __forceinline__ float wave_sum(float v) {
#pragma unroll
    for (int o = 1; o < 64; o <<= 1) v += __shfl_xor(v, o);
    return v;
}


#define XB_TMO      128
#define XB_XCNT(j)  (256  + 64 * (j))
#define XB_XSUB(j)  (1280 + 64 * (j))
#define XB_XGEN(j)  (2304 + 64 * (j))
#define XB_TOP      3328
#define XB_TOPGEN   3392
#define XCD_BAR_WORDS 3456
#define XB_SPIN_CAP (1u << 22)
__device__ __forceinline__ unsigned xb_ld(unsigned* p)              { return __hip_atomic_load(p, __ATOMIC_RELAXED, __HIP_MEMORY_SCOPE_AGENT); }
__device__ __forceinline__ unsigned xb_add(unsigned* p, unsigned v) { return __hip_atomic_fetch_add(p, v, __ATOMIC_RELAXED, __HIP_MEMORY_SCOPE_AGENT); }
__device__ __forceinline__ unsigned xb_xcc_id() { return (unsigned)__builtin_amdgcn_s_getreg((3 << 11) | 20) & 0xFu; }
#define XB_SPIN(cond, bar) do { unsigned _sp = 0; while (cond) { __builtin_amdgcn_s_sleep(1); \
    if ((++_sp & 255u) == 0u) { if (xb_ld(&(bar)[XB_TMO])) break; if (_sp > XB_SPIN_CAP) { atomicAdd(&(bar)[XB_TMO], 1u); break; } } } } while (0)
struct XcdBarrier { unsigned* bar; unsigned x; volatile LAS unsigned* st; };
__device__ __forceinline__ XcdBarrier xcd_barrier_post(unsigned* bar, volatile LAS unsigned* st) {
    XcdBarrier b; b.bar = bar; b.x = xb_xcc_id(); b.st = st;
    if (threadIdx.x == 0) (void)xb_add(&bar[XB_XCNT(b.x)], 1u);
    return b;
}
__device__ __forceinline__ void xcd_barrier_complete(unsigned* bar, unsigned x, unsigned& nloc, unsigned& nx) {
    const unsigned G = gridDim.x * gridDim.y * gridDim.z;
    unsigned sum, cnt, mine, sp = 0u;
    for (;;) {
        sum = 0u; cnt = 0u; mine = 0u;
#pragma unroll
        for (unsigned j = 0; j < 16; ++j) { const unsigned c = xb_ld(&bar[XB_XCNT(j)]); sum += c; cnt += (c > 0u) ? 1u : 0u; mine = (j == x) ? c : mine; }
        if (sum == G) break;
        __builtin_amdgcn_s_sleep(1);
        if ((++sp & 255u) == 0u) { if (xb_ld(&bar[XB_TMO])) break; if (sp > XB_SPIN_CAP) { atomicAdd(&bar[XB_TMO], 1u); break; } }
    }
    nloc = mine > 0u ? mine : 1u; nx = cnt > 0u ? cnt : 1u;
}
__device__ __forceinline__ void xcd_barrier(const XcdBarrier& b) {
    asm volatile("s_waitcnt vmcnt(0)" ::: "memory");
    __syncthreads();
    if (threadIdx.x == 0) {
        unsigned* bar = b.bar;
        __builtin_amdgcn_s_waitcnt(0);
        unsigned nloc = b.st[0], nx = b.st[1];
        if (nloc == 0u) { xcd_barrier_complete(bar, b.x, nloc, nx); b.st[0] = nloc; b.st[1] = nx; }
        const unsigned old = xb_add(&bar[XB_XSUB(b.x)], 1u);
        const unsigned gen = old / nloc;
        if (old + 1u == (gen + 1u) * nloc) {
            __builtin_amdgcn_fence(__ATOMIC_RELEASE, "agent");
            asm volatile("s_waitcnt vmcnt(0)" ::: "memory");
            const unsigned og = xb_add(&bar[XB_TOP], 1u);
            const unsigned tg = og / nx;
            if (og + 1u == (tg + 1u) * nx) xb_add(&bar[XB_TOPGEN], 1u);
            else XB_SPIN(xb_ld(&bar[XB_TOPGEN]) == tg, bar);
            __builtin_amdgcn_fence(__ATOMIC_ACQUIRE, "agent");
            xb_add(&bar[XB_XGEN(b.x)], 1u);
            asm volatile("s_waitcnt vmcnt(0)" ::: "memory");
        } else {
            XB_SPIN(xb_ld(&bar[XB_XGEN(b.x)]) == gen, bar);
            __builtin_amdgcn_fence(__ATOMIC_ACQUIRE, "agent");
            asm volatile("s_waitcnt vmcnt(0)" ::: "memory");
        }
    }
    __syncthreads();
}

__device__ unsigned g_bar_words[XCD_BAR_WORDS + 64];
struct Frame {
    LAS unsigned char* lds;
    int tid, lane, wave, G, bid;
    const float* in[23]; float* out; unsigned char* ws;
};
#define GW_ID(F) ((F).bid * NWAVES + (F).wave)
#define GW_N(F) ((F).G * NWAVES)

__device__ __forceinline__ void p0_transpose_item(const float* W, int K, int N, bf16* WT, int row_base, int k0, int n0, LAS float* scr, int lane) {
    float t_[32];
#pragma unroll
    for (int i = 0; i < 32; ++i) { const int kk = 2 * i + (lane >> 5); t_[i] = W[(size_t)(k0 + kk) * N + n0 + (lane & 31)]; }
#pragma unroll
    for (int i = 0; i < 32; ++i) { const int kk = 2 * i + (lane >> 5); scr[kk * 33 + (lane & 31)] = t_[i]; }
    LDS_WAIT(); asm volatile("" ::: "memory");
    const int c = lane & 7;
#pragma unroll
    for (int j = 0; j < 4; ++j) { const int n = (lane >> 3) + 8 * j; const LAS float* s = scr + (8 * c) * 33 + n;
        v4u o; o.x = pk2(s[0 * 33], s[1 * 33]); o.y = pk2(s[2 * 33], s[3 * 33]); o.z = pk2(s[4 * 33], s[5 * 33]); o.w = pk2(s[6 * 33], s[7 * 33]);
        *(GAS v4u*)(WT + (size_t)(row_base + n) * K + k0 + 8 * c) = o; }
    LDS_WAIT(); asm volatile("" ::: "memory");
}
__device__ __forceinline__ void phase_p0(Frame& F) {
    LAS float* scr = (LAS float*)(F.lds + F.wave * 16384);
    const int gw = GW_ID(F), NGW = GW_N(F);
    bf16* WinT = (bf16*)(F.ws + WS_WIN); bf16* WoutT = (bf16*)(F.ws + WS_WOUT); bf16* W3T = (bf16*)(F.ws + WS_W3T);
    constexpr int I_IN = (DM / 64) * (INW / 32), I_OUT = (DM / 64) * (DM / 32), I_3 = 1 * (4096 / 32);
    constexpr int NITEMS = I_IN + I_OUT + I_3;
    for (int it = gw; it < NITEMS; it += NGW) {
        int r = it;
        if (r < I_IN) { const int nblk = INW / 32, kb = r / nblk, nb = r % nblk; p0_transpose_item(F.in[2], DM, INW, WinT, 32 * nb, 64 * kb, 32 * nb, scr, F.lane); continue; } r -= I_IN;
        if (r < I_OUT) { const int nblk = DM / 32, kb = r / nblk, nb = r % nblk; p0_transpose_item(F.in[17], DM, DM, WoutT, 32 * nb, 64 * kb, 32 * nb, scr, F.lane); continue; } r -= I_OUT;
        { const int nb = r; p0_transpose_item(F.in[12], FHID, 4096, W3T, 32 * nb, 0, 32 * nb, scr, F.lane); }
    }
    bf16* HB = (bf16*)(F.ws + WS_HB);
    const float* x = F.in[0]; const float* g = F.in[1];
    f32x4 vn[8];
    if (gw < MT) { const GAS f32x4* xr = (const GAS f32x4*)(x + (size_t)gw * DM) + F.lane;
#pragma unroll
        for (int j = 0; j < 8; ++j) vn[j] = xr[64 * j]; }
    for (int m = gw; m < MT; m += NGW) {
        f32x4 v[8]; float s = 0.f;
#pragma unroll
        for (int j = 0; j < 8; ++j) { v[j] = vn[j]; s += (v[j].x * v[j].x + v[j].y * v[j].y) + (v[j].z * v[j].z + v[j].w * v[j].w); }
        if (m + NGW < MT) { const GAS f32x4* xr = (const GAS f32x4*)(x + (size_t)(m + NGW) * DM) + F.lane;
#pragma unroll
            for (int j = 0; j < 8; ++j) vn[j] = xr[64 * j]; }
        const float r = rsqrtf(wave_sum(s) * (1.f / DM) + EPS);
        GAS v2u* o8 = (GAS v2u*)(HB + (size_t)m * DM) + F.lane;
#pragma unroll
        for (int j = 0; j < 8; ++j) { const f32x4 gg = *((const GAS f32x4*)g + F.lane + 64 * j); v2u o; o.x = pk2(v[j].x * r * gg.x, v[j].y * r * gg.y); o.y = pk2(v[j].z * r * gg.z, v[j].w * r * gg.w); o8[64 * j] = o; }
    }
    float* HID2 = (float*)(F.ws + WS_HID2);
    LAS float* sc2 = (LAS float*)(F.lds + F.wave * 16384);
    const float* w1 = F.in[8]; const float* b1 = F.in[9]; const float* w2 = F.in[10]; const float* b2 = F.in[11]; const float* fr = F.in[13];
    for (int l = gw; l < SEQ; l += NGW) {
        const int j = F.lane;
        float zv = 0.f;
        if (j == 0) zv = (float)l / (float)(SEQ - 1);
        else if (j < FEMB) { const int k = (j - 1) & 15; const float f = 1e-4f + (float)k * ((15.0f - 1e-4f) / 15.0f); const float wv = 6.283185307179586f * (float)l / (float)SEQ; zv = (j <= 16) ? cosf(f * wv) : -sinf(f * wv); }
        sc2[j] = zv; LDS_WAIT(); asm volatile("" ::: "memory");
        float a = b1[j];
        for (int i = 0; i < FEMB; ++i) a += sc2[i] * w1[i * FHID + j];
        const float h1 = sinf(fr[j] * a);
        sc2[64 + j] = h1; LDS_WAIT(); asm volatile("" ::: "memory");
        float c = b2[j];
        for (int i = 0; i < FHID; ++i) c += sc2[64 + i] * w2[i * FHID + j];
        HID2[l * FHID + j] = sinf(fr[j] * c);
        LDS_WAIT(); asm volatile("" ::: "memory");
    }
}

typedef short bf16x8 __attribute__((ext_vector_type(8)));
typedef float f32x16 __attribute__((ext_vector_type(16)));
__device__ __forceinline__ void phase_filters(Frame& F) {
    const float* HID2 = (const float*)(F.ws + WS_HID2); const bf16* W3T = (const bf16*)(F.ws + WS_W3T); const float* fbias = F.in[14]; bf16* TAPS = (bf16*)(F.ws + WS_TAPS);
    const int n = F.lane & 31, hh = F.lane >> 5;
    const float mind = -4.605170185988091f / 1.5f, maxd = -4.605170185988091f / 0.3f;
    LAS bf16* scr = (LAS bf16*)(F.lds + F.wave * 4096);
    for (int task = GW_ID(F); task < 128 * 16; task += GW_N(F)) {
        const int l0 = (task & 127) * 32, cg = task >> 7;
        const int dir = (cg >> 2) & 1, o = cg >> 3;
        const int l = l0 + dir + n;
        bf16x8 hb[4];
        { const int lr = l < SEQ ? l : SEQ - 1;
#pragma unroll
          for (int ks = 0; ks < 4; ++ks) { const GAS f32x4* hp = (const GAS f32x4*)(HID2 + (size_t)lr * FHID + 16 * ks + 8 * hh); const f32x4 h0 = hp[0], h1 = hp[1];
              v4u bw; bw.x = pk2(h0.x, h0.y); bw.y = pk2(h0.z, h0.w); bw.z = pk2(h1.x, h1.y); bw.w = pk2(h1.z, h1.w); hb[ks] = __builtin_bit_cast(bf16x8, bw); } }
        const float t = (float)l / (float)(SEQ - 1);
        const int pos = dir ? 31 - n : n;
        const int idx0 = dir ? 4064 - l0 : 4096 + l0;
#pragma unroll 2
        for (int ct = 0; ct < 8; ++ct) {
            const int col0 = (cg * 8 + ct) * 32;
            f32x16 acc;
#pragma unroll
            for (int i = 0; i < 16; ++i) acc[i] = 0.f;
#pragma unroll
            for (int ks = 0; ks < 4; ++ks) { const bf16x8 a = *(const GAS bf16x8*)(W3T + (size_t)(col0 + n) * FHID + 16 * ks + 8 * hh);
                acc = __builtin_amdgcn_mfma_f32_32x32x16_bf16(a, hb[ks], acc, 0, 0, 0); }
#pragma unroll
            for (int i = 0; i < 16; ++i) {
                const int chl = (i & 3) + 8 * (i >> 2) + 4 * hh, c = (col0 & 1023) + chl;
                const float delta = fabsf(mind + (maxd - mind) * ((float)c / 1023.0f));
                float v = acc[i] * __expf(-t * delta);
                if (dir == 0 && l == 0) v += fbias[o * 1024 + c];
                if (l >= SEQ) v = 0.f;
                scr[chl * 40 + pos] = (bf16)f2bf(v);
            }
            LDS_WAIT(); asm volatile("" ::: "memory");
#pragma unroll
            for (int j = 0; j < 2; ++j) { const int id = F.lane + 64 * j, chl = id >> 2, q = id & 3;
                const v4u w = *(const LAS v4u*)(scr + chl * 40 + 8 * q);
                *(GAS v4u*)(TAPS + ((size_t)((col0 & 1023) + chl) * 2 + o) * 8192 + idx0 + 8 * q) = w; }
            LDS_WAIT(); asm volatile("" ::: "memory");
        }
    }
}

constexpr int HY_TAPS_BYTES = 4 * 16384, HY_ZB_ENT = 6080, HY_ZB_BYTES = HY_ZB_ENT * 2;
__device__ __forceinline__ unsigned hy_zb_off(int idx0  ) { const int q = idx0 >> 3; return (unsigned)((q ^ ((q >> 4) & 3)) << 4); }
__device__ __forceinline__ const LAS unsigned char* hy_pm(const LAS unsigned char* zb0, int g, int n, int hh) {
    const int q0 = 124 - 4 * n + 2 * g + hh;
    unsigned p = (unsigned)(size_t)zb0 + (unsigned)(((q0 ^ ((q0 >> 4) & 3)) << 4) - 6144);
    asm volatile("" : "+v"(p));
    return (const LAS unsigned char*)(size_t)p;
}
template <int MASK>
__device__ __forceinline__ void hy_loadB(bf16x8 (&bf)[4], const LAS unsigned char* pm, int b) {
#pragma unroll
    for (int tau = 0; tau < 4; ++tau) if (MASK & (1 << tau)) bf[tau] = *(const LAS bf16x8*)(pm + 2048 * (3 - tau) + b * HY_ZB_BYTES);
}
__device__ __forceinline__ void hy_loadA(unsigned (&d)[5], const LAS bf16* taps, int g, int n, int hh) {
    const volatile LAS unsigned* dp = (const volatile LAS unsigned*)taps + ((1 + 8 * hh + n) >> 1) + 8 * g;
#pragma unroll
    for (int i = 0; i < 5; ++i) d[i] = dp[i];
}
template <int MASK>
__device__ __forceinline__ void hy_mma(f32x16 (&acc)[4], const bf16x8 a, const bf16x8 (&bf)[4]) {
#pragma unroll
    for (int tau = 0; tau < 4; ++tau) if (MASK & (1 << tau)) acc[tau] = __builtin_amdgcn_mfma_f32_32x32x16_bf16(a, bf[tau], acc[tau], 0, 0, 0);
}
#define HY_ALIGN(a, d) do { v4u aw_; aw_.x = __builtin_amdgcn_alignbyte(d[1], d[0], sh); aw_.y = __builtin_amdgcn_alignbyte(d[2], d[1], sh); aw_.z = __builtin_amdgcn_alignbyte(d[3], d[2], sh); aw_.w = __builtin_amdgcn_alignbyte(d[4], d[3], sh); a = __builtin_bit_cast(bf16x8, aw_); } while (0)
#define HY_INTERLEAVE(nv, nds) do { __builtin_amdgcn_sched_group_barrier(0x2, nv, 0); _Pragma("unroll") for (int i_ = 0; i_ < 5; ++i_) { __builtin_amdgcn_sched_group_barrier(0x8, 1, 0); __builtin_amdgcn_sched_group_barrier(0x100, nds, 0); __builtin_amdgcn_sched_group_barrier(0x2, 2, 0); } } while (0)
constexpr int HY_YOFF = 254;
template <int MX, int MY>
__device__ __forceinline__ void hy_segment(f32x16 (&acc)[2][4], const LAS bf16* taps, const LAS unsigned char* zb0, int i0, int i1, int n, int hh) {
    const unsigned sh = (n & 1) ? 0u : 2u;
    unsigned dx[5], dy[5]; bf16x8 ax, ay, x0[4], y0[4], x1[4], y1[4];
    const LAS unsigned char* pmx = hy_pm(zb0, i0, n, hh); const LAS unsigned char* pmy = hy_pm(zb0, i0 + HY_YOFF, n, hh);
    hy_loadA(dx, taps, i0, n, hh); hy_loadA(dy, taps, i0 + HY_YOFF, n, hh); hy_loadB<MX>(x0, pmx, 0); hy_loadB<MY>(y0, pmy, 0);
#pragma unroll 1
    for (int i = i0; i < i1; ++i) {
        HY_ALIGN(ax, dx); HY_ALIGN(ay, dy);
        hy_loadB<MX>(x1, pmx, 1); hy_loadB<MY>(y1, pmy, 1);
        hy_mma<MX>(acc[0], ax, x0); hy_mma<MY>(acc[0], ay, y0);
        HY_INTERLEAVE(8, 1); __builtin_amdgcn_sched_barrier(0);
        hy_loadA(dx, taps, i + 1, n, hh); hy_loadA(dy, taps, i + 1 + HY_YOFF, n, hh);
        pmx = hy_pm(zb0, i + 1, n, hh); pmy = hy_pm(zb0, i + 1 + HY_YOFF, n, hh);
        hy_loadB<MX>(x0, pmx, 0); hy_loadB<MY>(y0, pmy, 0);
        hy_mma<MX>(acc[1], ax, x1); hy_mma<MY>(acc[1], ay, y1);
        HY_INTERLEAVE(0, 3); __builtin_amdgcn_sched_barrier(0);
    }
}
__device__ __forceinline__ void hy_stage_taps(Frame& F, int c0, int o) {
    const bf16* TAPS = (const bf16*)(F.ws + WS_TAPS);
    int tid = F.tid; asm volatile("" : "+v"(tid));
#pragma unroll
    for (int j = 0; j < 8; ++j) { const int ch = tid + NTHREADS * j, ci = ch >> 10, w = ch & 1023;
        *((LAS v4u*)(F.lds) + ch) = *((const GAS v4u*)(TAPS + ((size_t)(c0 + ci) * 2 + o) * 8192) + w); }
}
struct ConvItem { const float* W; bf16* WTe; int N, row_base, k0, n0; };
__device__ __forceinline__ void conv_load64(float (&v)[64], const ConvItem& c, int lane) {
    const GAS float* src = (const GAS float*)(c.W + (size_t)c.k0 * c.N + c.n0 + lane);
#pragma unroll
    for (int kk = 0; kk < 64; ++kk) v[kk] = src[(size_t)kk * c.N];
}
__device__ __forceinline__ void conv_store64(const float (&v)[64], const ConvItem& c, int lane) {
    GAS v4u* dst = (GAS v4u*)c.WTe + (size_t)(c.k0 >> 3) * 2048 + c.row_base + lane;
#pragma unroll
    for (int j = 0; j < 8; ++j) { v4u o; o.x = pk2(v[8 * j], v[8 * j + 1]); o.y = pk2(v[8 * j + 2], v[8 * j + 3]); o.z = pk2(v[8 * j + 4], v[8 * j + 5]); o.w = pk2(v[8 * j + 6], v[8 * j + 7]); dst[(size_t)j * 2048] = o; }
}
constexpr int MOE_ITEMS_GU = 2 * NE * 32 * 16, MOE_ITEMS_D = NE * 16 * 32, MOE_ITEMS = MOE_ITEMS_GU + MOE_ITEMS_D;
#ifndef MOE_P0_ITEMS
#define MOE_P0_ITEMS 0
#endif
constexpr int MOE_HELP_ITEMS = MOE_ITEMS - MOE_P0_ITEMS;
__device__ __forceinline__ ConvItem moe_item(Frame& F, int it) {
    bf16* WguT = (bf16*)(F.ws + WS_WGU); bf16* WdT = (bf16*)(F.ws + WS_WD); ConvItem c;
    if (it < MOE_ITEMS_GU) { const int which = it >> 13, e = (it >> 9) & 15, kb = (it >> 4) & 31, nb = it & 15, f0 = 64 * nb;
        c.W = (which ? F.in[21] : F.in[20]) + (size_t)e * DM * FF; c.N = FF; c.WTe = WguT + (size_t)e * 2048 * DM; c.row_base = (f0 >> 7) * 256 + which * 128 + (f0 & 127); c.k0 = 64 * kb; c.n0 = f0;
    } else { const int r = it - MOE_ITEMS_GU, e = r >> 9, kb = (r >> 5) & 15, nb = r & 31;
        c.W = F.in[22] + (size_t)e * FF * DM; c.N = DM; c.WTe = WdT + (size_t)e * 2048 * FF; c.row_base = 64 * nb; c.k0 = 64 * kb; c.n0 = 64 * nb; }
    return c;
}
__device__ __forceinline__ void moe_conv_item(Frame& F, int it) { float v[64]; const ConvItem c = moe_item(F, it); conv_load64(v, c, F.lane); conv_store64(v, c, F.lane); }
__device__ __forceinline__ void moe_conv_range(Frame& F, int lo, int hi, int step) {
    if (lo >= hi) return;
    float va[64], vb[64];
    ConvItem ca = moe_item(F, lo), cb_; conv_load64(va, ca, F.lane);
    for (int it = lo; it < hi; it += 2 * step) {
        const bool hb = it + step < hi;
        if (hb) { cb_ = moe_item(F, it + step); conv_load64(vb, cb_, F.lane); }
        conv_store64(va, ca, F.lane);
        const bool ha = it + 2 * step < hi;
        if (ha) { ca = moe_item(F, it + 2 * step); conv_load64(va, ca, F.lane); }
        if (hb) conv_store64(vb, cb_, F.lane);
    }
}
__device__ __forceinline__ void hy_write_gates(Frame& F, int c0, int oo) {
    const bf16* XH = (const bf16*)(F.ws + WS_XT) + (size_t)1024 * MT; bf16* GC = (bf16*)(F.ws + WS_UC);
    const float* cw = F.in[6]; const float* cb = F.in[7];
    const int ht = F.tid - 256;
#pragma unroll 2
    for (int k = 0; k < 16; ++k) { const int id = ht + 256 * k, u = id & 511, b = (id >> 9) & 1, ci = id >> 10;
        const int gch = oo * 1024 + c0 + ci; const bf16* gs = XH + (size_t)gch * MT + b * SEQ;
        const float w0 = cw[gch], w1 = cw[3072 + gch], w2 = cw[6144 + gch], bb = cb[gch];
        const v4u w = *((const GAS v4u*)gs + u);
        float f[10];
        f[1] = bflo(w.x); f[2] = bfhi(w.x); f[3] = bflo(w.y); f[4] = bfhi(w.y); f[5] = bflo(w.z); f[6] = bfhi(w.z); f[7] = bflo(w.w); f[8] = bfhi(w.w);
        f[0] = u > 0 ? bf2f(gs[8 * u - 1]) : 0.f; f[9] = u < 511 ? bf2f(gs[8 * u + 8]) : 0.f;
        float z[8];
#pragma unroll
        for (int e = 0; e < 8; ++e) z[e] = bb + w0 * f[e] + w1 * f[e + 1] + w2 * f[e + 2];
        v4u r; r.x = pk2(z[0], z[1]); r.y = pk2(z[2], z[3]); r.z = pk2(z[4], z[5]); r.w = pk2(z[6], z[7]);
        *((GAS v4u*)(GC + ((size_t)((c0 + ci) * 2 + oo) * 2 + b) * SEQ) + u) = r; }
}
__device__ __forceinline__ void phase_hyena(Frame& F) {
    const bf16* XH = (const bf16*)(F.ws + WS_XT) + (size_t)1024 * MT;
    const float* cw = F.in[6]; const float* cb = F.in[7];
    bf16* HYT = (bf16*)(F.ws + WS_HYT); bf16* GC = (bf16*)(F.ws + WS_UC);
    const int n = F.lane & 31, hh = F.lane >> 5;
    const bool compute = F.wave < 4;
    const int nhelp = F.G * 4, hw = F.bid * 4 + (F.wave - 4);
    int sec = 0;
    for (int cg = F.bid; cg < 256; cg += F.G) {
        const int c0 = cg * 4;
        __syncthreads();
        hy_stage_taps(F, c0, 0);
        {
          const int ci = F.wave >> 1, b = F.wave & 1; LAS unsigned char* zb = F.lds + HY_TAPS_BYTES + F.wave * HY_ZB_BYTES;
          const int zch = 2048 + c0 + ci; const bf16* zsrc = XH + (size_t)zch * MT + b * SEQ;
          const float w0 = cw[zch], w1 = cw[3072 + zch], w2 = cw[6144 + zch], bb = cb[zch];
#pragma unroll
          for (int j = 0; j < 8; ++j) { const int u = F.lane + 64 * j; const v4u w = *((const GAS v4u*)zsrc + u);
              float f[10];
              f[1] = bflo(w.x); f[2] = bfhi(w.x); f[3] = bflo(w.y); f[4] = bfhi(w.y); f[5] = bflo(w.z); f[6] = bfhi(w.z); f[7] = bflo(w.w); f[8] = bfhi(w.w);
              f[0] = u > 0 ? bf2f(zsrc[8 * u - 1]) : 0.f; f[9] = u < 511 ? bf2f(zsrc[8 * u + 8]) : 0.f;
              float z[8];
#pragma unroll
              for (int e = 0; e < 8; ++e) z[e] = bb + w0 * f[e] + w1 * f[e + 1] + w2 * f[e + 2];
              v4u r; r.x = pk2(z[7], z[6]); r.y = pk2(z[5], z[4]); r.z = pk2(z[3], z[2]); r.w = pk2(z[1], z[0]);
              *(LAS v4u*)(zb + hy_zb_off(8 * (635 - u))) = r; }
          const v4u zero = {0u, 0u, 0u, 0u};
          for (int q = F.lane; q < 124; q += 64) { *(LAS v4u*)(zb + hy_zb_off(8 * q)) = zero; *(LAS v4u*)(zb + hy_zb_off(8 * (636 + q))) = zero; } }
        if (!compute) hy_write_gates(F, c0, 0);
        __syncthreads();
#pragma unroll 1
        for (int o = 0; o < 2; ++o) {
            if (compute) {
                const int ci = F.wave, c = c0 + ci;
                const LAS bf16* taps = (const LAS bf16*)(F.lds + ci * 16384);
                LAS unsigned char* zb0 = F.lds + HY_TAPS_BYTES + (2 * ci) * HY_ZB_BYTES;
                f32x16 acc[2][4];
#pragma unroll
                for (int b = 0; b < 2; ++b)
#pragma unroll
                    for (int tau = 0; tau < 4; ++tau)
#pragma unroll
                        for (int i = 0; i < 16; ++i) acc[b][tau][i] = 0.f;
                hy_segment<1, 15>(acc, taps, zb0, 0, 64, n, hh);
                hy_segment<3, 14>(acc, taps, zb0, 64, 128, n, hh);
                hy_segment<7, 12>(acc, taps, zb0, 128, 192, n, hh);
                hy_segment<15, 8>(acc, taps, zb0, 192, 254, n, hh);
                hy_segment<0, 8>(acc, taps, zb0, 254, 256, n, hh);
                LDS_WAIT();
                int n2 = n, h2 = hh; asm volatile("" : "+v"(n2), "+v"(h2));
#pragma unroll
                for (int b = 0; b < 2; ++b) {
                    const bf16* gate = GC + ((size_t)(c * 2 + o) * 2 + b) * SEQ;
                    LAS unsigned char* zb = zb0 + b * HY_ZB_BYTES; bf16* outp = HYT + (size_t)c * MT + b * SEQ;
                    v2u gw[4][4];
#pragma unroll
                    for (int tau = 0; tau < 4; ++tau)
#pragma unroll
                        for (int rg = 0; rg < 4; ++rg) gw[tau][rg] = *(const GAS v2u*)(gate + 1024 * tau + 32 * n2 + 8 * rg + 4 * h2);
#pragma unroll
                    for (int tau = 0; tau < 4; ++tau) {
#pragma unroll
                        for (int rg = 0; rg < 4; ++rg) { const int t0 = 1024 * tau + 32 * n2 + 8 * rg + 4 * h2;
                            const float z0 = bflo(gw[tau][rg].x) * acc[b][tau][4 * rg + 0], z1 = bfhi(gw[tau][rg].x) * acc[b][tau][4 * rg + 1], z2 = bflo(gw[tau][rg].y) * acc[b][tau][4 * rg + 2], z3 = bfhi(gw[tau][rg].y) * acc[b][tau][4 * rg + 3];
                            if (o == 0) { v2u w; w.x = pk2(z3, z2); w.y = pk2(z1, z0);
                                *(LAS v2u*)(zb + hy_zb_off(8 * (635 - (t0 >> 3))) + (h2 ? 0 : 8)) = w; }
                            else { v2u w; w.x = pk2(z0, z1); w.y = pk2(z2, z3); *(GAS v2u*)(outp + t0) = w; } } }
                }
            } else {
                if (o == 0) hy_write_gates(F, c0, 1);
                const int lo_it = MOE_P0_ITEMS + sec * (MOE_HELP_ITEMS / 2), hi_it = lo_it + MOE_HELP_ITEMS / 2;
                if (sec < 2) moe_conv_range(F, lo_it + hw, hi_it, nhelp);
            }
            ++sec;
            if (o == 0) {
                __syncthreads();
                hy_stage_taps(F, c0, 1);
                __syncthreads();
            }
        }
    }
    for (; sec < 2; ++sec) if (!compute) { const int lo_it = MOE_P0_ITEMS + sec * (MOE_HELP_ITEMS / 2), hi_it = lo_it + MOE_HELP_ITEMS / 2; moe_conv_range(F, lo_it + hw, hi_it, nhelp); }
    __syncthreads();
}

constexpr int AT_KBYTES = 16384, AT_VPITCH = 136, AT_VBYTES = 128 * AT_VPITCH, AT_STAGE = AT_KBYTES + AT_VBYTES, AT_RP_OFF = 2 * AT_STAGE;
__device__ __forceinline__ void phase_attn2(Frame& F) {
    const bf16* QK = (const bf16*)(F.ws + WS_QK); const bf16* VT = (const bf16*)(F.ws + WS_XT); bf16* MIXED = (bf16*)(F.ws + WS_MIXED);
    const float* rpb = F.in[5]; const float* og = F.in[15]; const float* qg = F.in[3]; const float* kg = F.in[4];
    LAS float* rt = (LAS float*)(F.lds + AT_RP_OFF);
    LAS float* gtab = (LAS float*)(F.lds + AT_RP_OFF + 8 * 2048);
    if (F.tid < HD) gtab[F.tid] = qg[F.tid] * kg[F.tid];
    const int n = F.lane & 31, hh = F.lane >> 5;
    for (int unit = F.bid; unit < NB * NH * 16; unit += F.G) {
        const int rq = unit & 15, h = (unit >> 4) & 7, b = unit >> 7, r0 = 4 * rq;
        const int r = r0 + (F.wave >> 1), wq = F.wave & 1;
        int kmin = r0 - WR / 2; kmin = kmin < 0 ? 0 : (kmin > NROWS - WR ? NROWS - WR : kmin);
        int kmax = r0 + 3 - WR / 2; kmax = (kmax < 0 ? 0 : (kmax > NROWS - WR ? NROWS - WR : kmax)) + WR - 1;
        int kr0 = r - WR / 2; kr0 = kr0 < 0 ? 0 : (kr0 > NROWS - WR ? NROWS - WR : kr0);
        const int nrows = kmax - kmin + 1;
        __syncthreads();
        for (int i = F.tid; i < 15 * 128; i += NTHREADS) { const int dr_ = i >> 7, dcx = (i & 127) - 48; rt[i] = (dcx >= 0 && dcx <= 30) ? rpb[h * 465 + dr_ * 31 + dcx] * 1.4426950408889634f : 0.f; }
        const int mq = b * SEQ + r * GW + 32 * wq + n, qc = 32 * wq + n;
        int c0 = qc - WC / 2; c0 = c0 < 0 ? 0 : (c0 > GW - WC ? GW - WC : c0);
        bf16x8 qf[8];
#pragma unroll
        for (int ks = 0; ks < 8; ++ks) qf[ks] = *(const GAS bf16x8*)(QK + (size_t)mq * 2048 + h * HD + 16 * ks + 8 * hh);
        float qscale;
        {
          f32x16 D;
#pragma unroll
          for (int i = 0; i < 16; ++i) D[i] = 0.f;
#pragma unroll
          for (int ks = 0; ks < 8; ++ks) D = __builtin_amdgcn_mfma_f32_32x32x16_bf16(qf[ks], qf[ks], D, 0, 0, 0);
          float dsel = 0.f; const int isel = (n & 3) + 4 * (n >> 3);
#pragma unroll
          for (int i = 0; i < 16; ++i) dsel = (i == isel) ? D[i] : dsel;
          const float other = __shfl_xor(dsel, 32);
          const float ssq = (((n >> 2) & 1) == hh) ? dsel : other;
          qscale = (0.08838834764831845f * 1.4426950408889634f) * rsqrtf(ssq * (1.f / HD) + EPS); }
        const unsigned long long wmask = (c0 >= 4 * hh) ? (0xFFFFull << (c0 - 4 * hh)) : (0xFFFFull >> (4 * hh - c0));
        const unsigned wm0 = (unsigned)wmask, wm1 = (unsigned)(wmask >> 32);
        const int rtl = 4 * hh - qc + 63;
        f32x16 O[4];
#pragma unroll
        for (int dt = 0; dt < 4; ++dt)
#pragma unroll
            for (int i = 0; i < 16; ++i) O[dt][i] = 0.f;
        float lsum = 0.f;
        v4u sk[2], sv[2];

        auto gload = [&](int kr) {
#pragma unroll
            for (int j = 0; j < 2; ++j) { const int id = F.tid + 512 * j;
                sk[j] = *(const GAS v4u*)(QK + (size_t)(b * SEQ + kr * GW + (id >> 4)) * 2048 + 1024 + h * HD + 8 * (id & 15));
                sv[j] = *(const GAS v4u*)(VT + (size_t)(h * HD + (id >> 3)) * MT + b * SEQ + kr * GW + 8 * (id & 7)); }
        };
        auto lstore = [&](int buf) {
            LAS unsigned char* kb = F.lds + buf * AT_STAGE; LAS unsigned char* vb = kb + AT_KBYTES;
#pragma unroll
            for (int j = 0; j < 2; ++j) { const int id = F.tid + 512 * j; const int key = id >> 4, c = id & 15;
                float f[8] = {bflo(sk[j].x), bfhi(sk[j].x), bflo(sk[j].y), bfhi(sk[j].y), bflo(sk[j].z), bfhi(sk[j].z), bflo(sk[j].w), bfhi(sk[j].w)};
                float ss = 0.f;
#pragma unroll
                for (int e = 0; e < 8; ++e) ss += f[e] * f[e];
                ss += __shfl_xor(ss, 1); ss += __shfl_xor(ss, 2); ss += __shfl_xor(ss, 4); ss += __shfl_xor(ss, 8);
                const float rk = rsqrtf(ss * (1.f / HD) + EPS);
                const f32x4 ga = *(const LAS f32x4*)(gtab + 8 * c), gb = *(const LAS f32x4*)(gtab + 8 * c + 4);
                v4u kn; kn.x = pk2(f[0] * rk * ga.x, f[1] * rk * ga.y); kn.y = pk2(f[2] * rk * ga.z, f[3] * rk * ga.w); kn.z = pk2(f[4] * rk * gb.x, f[5] * rk * gb.y); kn.w = pk2(f[6] * rk * gb.z, f[7] * rk * gb.w);
                *(LAS v4u*)(kb + key * 256 + ((c ^ (key & 15)) << 4)) = kn;
                const int d = id >> 3, cv = id & 7; LAS v2u* vp = (LAS v2u*)(vb + d * AT_VPITCH + cv * 16);
                v2u lo, hi; lo.x = sv[j].x; lo.y = sv[j].y; hi.x = sv[j].z; hi.y = sv[j].w; vp[0] = lo; vp[1] = hi; }
        };
        gload(kmin); lstore(0);
        __syncthreads();
#pragma unroll 1
        for (int j = 0; j < nrows; ++j) {
            const int kr = kmin + j, buf = j & 1;
            if (j + 1 < nrows) gload(kr + 1);
            if (kr >= kr0 && kr < kr0 + WR) {
                const LAS unsigned char* kb = F.lds + buf * AT_STAGE; const LAS unsigned char* vb = kb + AT_KBYTES;
                const int dr = kr - r + WR - 1;
                const LAS float* rrow = rt + dr * 128 + rtl;
#pragma unroll
                for (int kt = 0; kt < 2; ++kt) {
                    f32x16 S;
#pragma unroll
                    for (int i = 0; i < 16; ++i) S[i] = 0.f;
                    const int key = 32 * kt + n;
#pragma unroll
                    for (int ks = 0; ks < 8; ++ks) { const bf16x8 kf = *(const LAS bf16x8*)(kb + key * 256 + (((2 * ks + hh) ^ (key & 15)) << 4));
                        S = __builtin_amdgcn_mfma_f32_32x32x16_bf16(kf, qf[ks], S, 0, 0, 0); }
                    float p[16];
#pragma unroll
                    for (int i = 0; i < 16; ++i) { const int E = (i & 3) + 8 * (i >> 2);
                        const float e = __builtin_amdgcn_exp2f(S[i] * qscale + rrow[32 * kt + E]);
                        const unsigned keep = (unsigned)__builtin_amdgcn_sbfe((int)(kt ? wm1 : wm0), E, 1);
                        p[i] = __builtin_bit_cast(float, __builtin_bit_cast(unsigned, e) & keep); lsum += p[i]; }
                    v4u pw0, pw1;
                    pw0.x = pk2(p[0], p[1]); pw0.y = pk2(p[2], p[3]); pw0.z = pk2(p[4], p[5]); pw0.w = pk2(p[6], p[7]);
                    pw1.x = pk2(p[8], p[9]); pw1.y = pk2(p[10], p[11]); pw1.z = pk2(p[12], p[13]); pw1.w = pk2(p[14], p[15]);
                    const bf16x8 pf0 = __builtin_bit_cast(bf16x8, pw0), pf1 = __builtin_bit_cast(bf16x8, pw1);
#pragma unroll
                    for (int dt = 0; dt < 4; ++dt) {
                        const LAS unsigned char* vrow = vb + (32 * dt + n) * AT_VPITCH + (32 * kt + 4 * hh) * 2;
                        const v2u a0 = *(const LAS v2u*)(vrow), a1 = *(const LAS v2u*)(vrow + 16), a2 = *(const LAS v2u*)(vrow + 32), a3 = *(const LAS v2u*)(vrow + 48);
                        v4u f0, f1; f0.x = a0.x; f0.y = a0.y; f0.z = a1.x; f0.w = a1.y; f1.x = a2.x; f1.y = a2.y; f1.z = a3.x; f1.w = a3.y;
                        O[dt] = __builtin_amdgcn_mfma_f32_32x32x16_bf16(__builtin_bit_cast(bf16x8, f0), pf0, O[dt], 0, 0, 0);
                        O[dt] = __builtin_amdgcn_mfma_f32_32x32x16_bf16(__builtin_bit_cast(bf16x8, f1), pf1, O[dt], 0, 0, 0);
                    }
                }
            }
            if (j + 1 < nrows) lstore(buf ^ 1);
            __syncthreads();
        }
        lsum += __shfl_xor(lsum, 32);
        const float il = 1.f / lsum;
        float ss = 0.f;
#pragma unroll
        for (int dt = 0; dt < 4; ++dt)
#pragma unroll
            for (int i = 0; i < 16; ++i) { O[dt][i] *= il; ss += O[dt][i] * O[dt][i]; }
        ss += __shfl_xor(ss, 32);
        const float rr = rsqrtf(ss * (1.f / HD) + EPS);
        bf16* orow = MIXED + (size_t)mq * DM + h * HD;
#pragma unroll
        for (int dt = 0; dt < 4; ++dt)
#pragma unroll
            for (int rg = 0; rg < 4; ++rg) { const int d = 32 * dt + 8 * rg + 4 * hh; const f32x4 gg = *(const GAS f32x4*)(og + h * HD + d);
                v2u w; w.x = pk2(O[dt][4 * rg + 0] * rr * gg.x, O[dt][4 * rg + 1] * rr * gg.y); w.y = pk2(O[dt][4 * rg + 2] * rr * gg.z, O[dt][4 * rg + 3] * rr * gg.w);
                *(GAS v2u*)(orow + d) = w; }
    }
    __syncthreads();
}

__device__ __forceinline__ void phase_p25(Frame& F) {
    const bf16* HYT = (const bf16*)(F.ws + WS_HYT); bf16* MIXED = (bf16*)(F.ws + WS_MIXED); const float* hg = F.in[16];
    LAS float* tile = (LAS float*)F.lds;
    LAS float* rs = (LAS float*)(F.lds + 128 * 65 * 4);
    for (int it = F.bid; it < 8 * (MT / 64); it += F.G) {
        const int gi = it & 7, m0 = (it >> 3) * 64;
        { const int ch = F.tid >> 2, t0 = (F.tid & 3) * 16; const bf16* p = HYT + (size_t)(gi * 128 + ch) * MT + m0 + t0;
          const v4u a = *(const GAS v4u*)p, b = *(const GAS v4u*)(p + 8);
          LAS float* d = tile + ch * 65 + t0;
          d[0] = bflo(a.x); d[1] = bfhi(a.x); d[2] = bflo(a.y); d[3] = bfhi(a.y); d[4] = bflo(a.z); d[5] = bfhi(a.z); d[6] = bflo(a.w); d[7] = bfhi(a.w);
          d[8] = bflo(b.x); d[9] = bfhi(b.x); d[10] = bflo(b.y); d[11] = bfhi(b.y); d[12] = bflo(b.z); d[13] = bfhi(b.z); d[14] = bflo(b.w); d[15] = bfhi(b.w); }
        __syncthreads();
        {
          const int t = F.tid >> 3, c0 = (F.tid & 7) * 16; float ss = 0.f;
#pragma unroll
          for (int c = 0; c < 16; ++c) { const float v = tile[(c0 + c) * 65 + t]; ss += v * v; }
          ss += __shfl_xor(ss, 1); ss += __shfl_xor(ss, 2); ss += __shfl_xor(ss, 4);
          if ((F.tid & 7) == 0) rs[t] = rsqrtf(ss * (1.f / 128) + EPS); }
        __syncthreads();
        {
          const int t = F.tid >> 3, c0 = (F.tid & 7) * 16; const float r = rs[t]; float o[16];
#pragma unroll
          for (int c = 0; c < 16; ++c) o[c] = tile[(c0 + c) * 65 + t] * r * hg[gi * 128 + c0 + c];
          v4u a, b; a.x = pk2(o[0], o[1]); a.y = pk2(o[2], o[3]); a.z = pk2(o[4], o[5]); a.w = pk2(o[6], o[7]); b.x = pk2(o[8], o[9]); b.y = pk2(o[10], o[11]); b.z = pk2(o[12], o[13]); b.w = pk2(o[14], o[15]);
          bf16* q = MIXED + (size_t)(m0 + t) * DM + AW + gi * 128 + c0; *(GAS v4u*)q = a; *(GAS v4u*)(q + 8) = b; }
        __syncthreads();
    }
}
__device__ __forceinline__ void phase_p35(Frame& F) {
    LAS float* wrT = (LAS float*)F.lds;
    const float* wr = F.in[19]; const float* g = F.in[18];
    constexpr int WRS = DM + 4;
    for (int i = F.tid; i < DM * NE; i += NTHREADS) { const int d = i >> 4, e = i & 15; wrT[e * WRS + d] = wr[i]; }
    __syncthreads();
    bf16* HB = (bf16*)(F.ws + WS_HB); float* AFF = (float*)(F.ws + WS_AFF); const float* x1 = F.out;
    f32x4 vn[8];
    { const int m0 = GW_ID(F); if (m0 < MT) { const GAS f32x4* xr = (const GAS f32x4*)(x1 + (size_t)m0 * DM) + F.lane;
#pragma unroll
        for (int j = 0; j < 8; ++j) vn[j] = xr[64 * j]; } }
    for (int m = GW_ID(F); m < MT; m += GW_N(F)) {
        f32x4 v[8]; float s = 0.f;
#pragma unroll
        for (int j = 0; j < 8; ++j) { v[j] = vn[j]; s += (v[j].x * v[j].x + v[j].y * v[j].y) + (v[j].z * v[j].z + v[j].w * v[j].w); }
        if (m + GW_N(F) < MT) { const GAS f32x4* xr = (const GAS f32x4*)(x1 + (size_t)(m + GW_N(F)) * DM) + F.lane;
#pragma unroll
            for (int j = 0; j < 8; ++j) vn[j] = xr[64 * j]; }
        const float r = rsqrtf(wave_sum(s) * (1.f / DM) + EPS);
        GAS v2u* o8 = (GAS v2u*)(HB + (size_t)m * DM) + F.lane;
#pragma unroll
        for (int j = 0; j < 8; ++j) { const f32x4 gg = *((const GAS f32x4*)g + F.lane + 64 * j); v[j].x *= r * gg.x; v[j].y *= r * gg.y; v[j].z *= r * gg.z; v[j].w *= r * gg.w;
            v2u o; o.x = pk2(v[j].x, v[j].y); o.y = pk2(v[j].z, v[j].w); o8[64 * j] = o; }
        float mine = 0.f;
#pragma unroll 1
        for (int e = 0; e < NE; ++e) { float a = 0.f;
#pragma unroll
            for (int j = 0; j < 8; ++j) { const f32x4 w = *((const LAS f32x4*)(wrT + e * WRS) + F.lane + 64 * j); a += (v[j].x * w.x + v[j].y * w.y) + (v[j].z * w.z + v[j].w * w.w); }
            a = wave_sum(a); mine = (F.lane == e) ? a : mine; }
        float mx = mine;
        mx = fmaxf(mx, __shfl_xor(mx, 1)); mx = fmaxf(mx, __shfl_xor(mx, 2)); mx = fmaxf(mx, __shfl_xor(mx, 4)); mx = fmaxf(mx, __shfl_xor(mx, 8));
        const float ex = expf(mine - mx); float den = ex;
        den += __shfl_xor(den, 1); den += __shfl_xor(den, 2); den += __shfl_xor(den, 4); den += __shfl_xor(den, 8);
        const int b = m / SEQ, sidx = m % SEQ;
        if (F.lane < NE) AFF[((size_t)b * NE + F.lane) * SEQ + sidx] = ex / den;
    }
    __syncthreads();
}
__device__ __forceinline__ void phase_p4(Frame& F) {
    LAS unsigned* key = (LAS unsigned*)F.lds;
    LAS unsigned* hist = (LAS unsigned*)(F.lds + 16384);
    LAS unsigned* wsum = (LAS unsigned*)(F.lds + 16384 + 1024);
    const float* AFF = (const float*)(F.ws + WS_AFF); int* IDX = (int*)(F.ws + WS_IDX); float* GATE = (float*)(F.ws + WS_GATE); int* SEL = (int*)(F.ws + WS_SEL);
    for (int be = F.bid; be < NB * NE; be += F.G) {
        const int b = be / NE, e = be % NE;
        __syncthreads();
        const GAS v4u* ap = (const GAS v4u*)(AFF + (size_t)be * SEQ);
        const v4u k0 = ap[2 * F.tid], k1 = ap[2 * F.tid + 1];
        unsigned kk[8] = {k0.x, k0.y, k0.z, k0.w, k1.x, k1.y, k1.z, k1.w};
        unsigned prefix = 0u, mask = 0u, remaining = CAP;
#pragma unroll 1
        for (int pass = 0; pass < 4; ++pass) {
            const int shift = 24 - 8 * pass;
            if (F.tid < 256) hist[F.tid] = 0u;
            __syncthreads();
#pragma unroll
            for (int i = 0; i < 8; ++i) if ((kk[i] & mask) == prefix) __hip_atomic_fetch_add(&hist[(kk[i] >> shift) & 255u], 1u, __ATOMIC_RELAXED, __HIP_MEMORY_SCOPE_WORKGROUP);
            __syncthreads();
            unsigned incl_ = 0u, mine_ = 0u;
            if (F.tid < 256) {
                mine_ = hist[255 - F.tid]; incl_ = mine_;
#pragma unroll
                for (int o = 1; o < 64; o <<= 1) { const unsigned t = __shfl_up(incl_, o); if (F.lane >= o) incl_ += t; }
                if (F.lane == 63) wsum[10 + F.wave] = incl_;
            }
            __syncthreads();
            if (F.tid < 256) {
                unsigned base = 0u;
                for (int w = 0; w < F.wave; ++w) base += wsum[10 + w];
                const unsigned above = base + incl_ - mine_;
                if (above < remaining && remaining <= above + mine_) { wsum[8] = (unsigned)(255 - F.tid); wsum[9] = above; }
            }
            __syncthreads();
            const unsigned d = wsum[8], above = wsum[9];
            prefix |= d << shift; mask |= 255u << shift; remaining -= above;
            __syncthreads();
        }
        const unsigned thr = prefix;
        unsigned cnt = 0u;
#pragma unroll
        for (int i = 0; i < 8; ++i) cnt += (kk[i] > thr ? 0x10000u : 0u) + (kk[i] == thr ? 1u : 0u);
        unsigned incl = cnt;
#pragma unroll
        for (int o = 1; o < 64; o <<= 1) { const unsigned t = __shfl_up(incl, o); if (F.lane >= o) incl += t; }
        if (F.lane == 63) wsum[F.wave] = incl;
        __syncthreads();
        unsigned base = 0u;
        for (int w = 0; w < F.wave; ++w) base += wsum[w];
        unsigned run = base + incl - cnt;
#pragma unroll
        for (int i = 0; i < 8; ++i) {
            const unsigned gt_before = run >> 16, tie_before = run & 0xffffu;
            const bool isgt = kk[i] > thr, istie = kk[i] == thr;
            const bool sel = isgt || (istie && tie_before < remaining);
            const unsigned slot = gt_before + (tie_before < remaining ? tie_before : remaining);
            const int s = 8 * F.tid + i, m = b * SEQ + s;
            if (sel) { IDX[be * CAP + slot] = m; GATE[be * CAP + slot] = __builtin_bit_cast(float, kk[i]); }
            SEL[(size_t)m * NE + e] = sel ? (int)slot : -1;
            run += (isgt ? 0x10000u : 0u) + (istie ? 1u : 0u);
        }
    }
    __syncthreads();
}
__device__ __forceinline__ void phase_p7(Frame& F) {
    const int* SEL = (const int*)(F.ws + WS_SEL); const float* GATE = (const float*)(F.ws + WS_GATE); const bf16* YE = (const bf16*)(F.ws + WS_YE);
    for (int m = GW_ID(F); m < MT; m += GW_N(F)) {
        const int b = m / SEQ;
        GAS f32x4* orow = (GAS f32x4*)(F.out + (size_t)m * DM);
        f32x4 acc[8];
#pragma unroll
        for (int j = 0; j < 8; ++j) acc[j] = orow[2 * F.lane + (j & 1) + 128 * (j >> 1)];
        for (int e = 0; e < NE; ++e) { const int slot = SEL[(size_t)m * NE + e]; if (slot >= 0) {
            const GAS v4u* yr = (const GAS v4u*)(YE + (size_t)((b * NE + e) * CAP + slot) * DM) + F.lane;
#pragma unroll
            for (int jj = 0; jj < 4; ++jj) { const v4u w = yr[64 * jj];
                acc[2 * jj].x += bflo(w.x); acc[2 * jj].y += bfhi(w.x); acc[2 * jj].z += bflo(w.y); acc[2 * jj].w += bfhi(w.y);
                acc[2 * jj + 1].x += bflo(w.z); acc[2 * jj + 1].y += bfhi(w.z); acc[2 * jj + 1].z += bflo(w.w); acc[2 * jj + 1].w += bfhi(w.w); } } }
#pragma unroll
        for (int j = 0; j < 8; ++j) orow[2 * F.lane + (j & 1) + 128 * (j >> 1)] = acc[j];
    }
    (void)GATE;
}

struct Args { const float* in[23]; float* out; unsigned char* ws; int ph_lo, ph_hi; };
enum Phase { PH_P0 = 0, PH_G1, PH_ATTN, PH_P25, PH_OUT, PH_P35, PH_P4, PH_UP, PH_DOWN, PH_P7, PH_COUNT };

__global__ void __launch_bounds__(NTHREADS, 2) mk_fwd(Args args) {
    extern __shared__ __attribute__((aligned(16))) unsigned char lds_raw[];
    Frame F;
    F.lds = (LAS unsigned char*)lds_raw;
    F.tid = threadIdx.x; F.lane = F.tid & 63; F.wave = __builtin_amdgcn_readfirstlane(F.tid >> 6); F.G = gridDim.x; F.bid = blockIdx.x;
#pragma unroll
    for (int i = 0; i < 23; ++i) F.in[i] = args.in[i];
    F.out = args.out; F.ws = args.ws;
    const int lo = args.ph_lo, hi = args.ph_hi;
#define IN(k) (lo <= (k) && (k) < hi)
#define REPS(k) for (int rep_ = 0; rep_ < ((k) == REP_PHASE ? REP_N : 1); ++rep_)
#if MK_N_LAUNCHES == 1
    { volatile LAS unsigned* misc = (volatile LAS unsigned*)(F.lds + LDS_MISC_OFF); if (F.tid < 16) misc[F.tid] = 0u; }
    __syncthreads();
    XcdBarrier bar = xcd_barrier_post(g_bar_words, (volatile LAS unsigned*)(F.lds + LDS_MISC_OFF) + 8);
#define SEAM(k) do { if (IN(k) && IN((k) + 1)) xcd_barrier(bar); } while (0)
#else
#define SEAM(k) do { } while (0)
#endif
    if (IN(PH_P0)) REPS(PH_P0) { phase_p0(F); for (int it = GW_ID(F); it < MOE_P0_ITEMS; it += GW_N(F)) moe_conv_item(F, it); } SEAM(PH_P0);
    if (IN(PH_G1)) REPS(PH_G1) {
        phase_filters(F);
        __syncthreads();
        { pg8::DenseOrder S; S.init(F.ws + WS_HB, F.ws + WS_WIN, MT, 2048, DM, 0, F.G, F.bid);
          pg8::EpiBf16 E{(pg8::bf16_t*)(F.ws + WS_QK), 2048, 0, nullptr};
          pg8::gemm_phase<pg8::EpiBf16, pg8::DenseOrder, true>(F.lds, DM, S, E); }
        { pg8::DenseOrder S; S.init(F.ws + WS_HB, F.ws + WS_WIN, MT, 4096, DM, 8, F.G, F.bid);
          pg8::EpiTransBf16 E{(pg8::bf16_t*)(F.ws + WS_XT), MT, 8};
          pg8::gemm_phase<pg8::EpiTransBf16, pg8::DenseOrder, true>(F.lds, DM, S, E); }
    } SEAM(PH_G1);
    if (IN(PH_ATTN)) { __syncthreads(); for (int rep_ = 0; rep_ < ((PH_ATTN == REP_PHASE && REP_SUB != 2) ? REP_N : 1); ++rep_) phase_hyena(F); for (int rep_ = 0; rep_ < ((PH_ATTN == REP_PHASE && REP_SUB != 1) ? REP_N : 1); ++rep_) phase_attn2(F); } SEAM(PH_ATTN);
    if (IN(PH_P25)) REPS(PH_P25) { __syncthreads(); phase_p25(F); } SEAM(PH_P25);
    if (IN(PH_OUT)) REPS(PH_OUT) {
        __syncthreads();
        pg8::DenseOrder S; S.init(F.ws + WS_MIXED, F.ws + WS_WOUT, MT, DM, DM, 0, F.G, F.bid);
        pg8::EpiResF32 E{F.in[0], F.out, DM};
        pg8::gemm_phase<pg8::EpiResF32, pg8::DenseOrder, false>(F.lds, DM, S, E);
    } SEAM(PH_OUT);
    if (IN(PH_P35)) REPS(PH_P35) { __syncthreads(); phase_p35(F); } SEAM(PH_P35);
    if (IN(PH_P4)) REPS(PH_P4) { __syncthreads(); phase_p4(F); } SEAM(PH_P4);
    if (IN(PH_UP)) REPS(PH_UP) {
        __syncthreads();
        pg8::MoeOrder S; S.init(F.ws + WS_HB, F.ws + WS_WGU, DM, F.G, F.bid, true);
        LAS int* ridx = (LAS int*)(F.lds + 131072);
        { const int* IDX = (const int*)(F.ws + WS_IDX); pg8::Unit u;
          for (int i = 0; S.next(i, u); ++i) if (F.tid < 256) ridx[i * 256 + F.tid] = IDX[u.g * CAP + u.pm * 256 + F.tid]; }
        __syncthreads();
        pg8::EpiSwiGLU E{(pg8::bf16_t*)(F.ws + WS_ACT)};
        pg8::gemm_phase<pg8::EpiSwiGLU, pg8::MoeOrder, true, true>(F.lds, DM, S, E, ridx);
    } SEAM(PH_UP);
    if (IN(PH_DOWN)) REPS(PH_DOWN) {
        __syncthreads();
        pg8::MoeOrder S; S.init(F.ws + WS_ACT, F.ws + WS_WD, FF, F.G, F.bid, false);
        pg8::EpiBf16 E{(pg8::bf16_t*)(F.ws + WS_YE), DM, 512, (const float*)(F.ws + WS_GATE)};
        pg8::gemm_phase<pg8::EpiBf16, pg8::MoeOrder, true>(F.lds, FF, S, E);
    } SEAM(PH_DOWN);
    if (IN(PH_P7)) { phase_p7(F); }
#if MK_N_LAUNCHES == 1
    __syncthreads();
    { volatile LAS unsigned* misc = (volatile LAS unsigned*)(F.lds + LDS_MISC_OFF);
      if (F.tid == 0) misc[0] = (xb_add(&g_bar_words[XCD_BAR_WORDS], 1u) + 1u == (unsigned)F.G) ? 1u : 0u;
      __syncthreads();
      if (misc[0] != 0u && F.tid < (XCD_BAR_WORDS + 64) / 64) __hip_atomic_store(&g_bar_words[64 * F.tid], 0u, __ATOMIC_RELAXED, __HIP_MEMORY_SCOPE_AGENT); }
#endif
#undef IN
#undef SEAM
}

extern "C" void kernel_launch(void* const* d_in, const int* in_sizes, int n_in, void* d_out, int out_size, void* d_ws, size_t ws_size, hipStream_t stream) {
    static int grid = 0;
    if (grid == 0) {
        if (n_in != 23 || ws_size < WS_END) { fprintf(stderr, "kernel_launch: unexpected inputs (n_in %d, ws %zu)\n", n_in, ws_size); grid = -1; return; }
        if (hipFuncSetAttribute((const void*)mk_fwd, hipFuncAttributeMaxDynamicSharedMemorySize, LDS_BYTES) != hipSuccess) { fprintf(stderr, "kernel_launch: hipFuncSetAttribute failed\n"); grid = -1; return; }
        int dev = 0, cus = 0, per_cu = 0;
        hipGetDevice(&dev); hipDeviceGetAttribute(&cus, hipDeviceAttributeMultiprocessorCount, dev);
        hipOccupancyMaxActiveBlocksPerMultiprocessor(&per_cu, (const void*)mk_fwd, NTHREADS, LDS_BYTES);
        (void)hipGetLastError();
        if (per_cu < 1) { fprintf(stderr, "kernel_launch: occupancy query says %d blocks/CU\n", per_cu); }
        grid = cus;
    }
    if (grid < 0) return;
    Args a{};
    for (int i = 0; i < 23; ++i) a.in[i] = (const float*)d_in[i];
    a.out = (float*)d_out; a.ws = (unsigned char*)d_ws;
#if MK_N_LAUNCHES == 1
    a.ph_lo = 0; a.ph_hi = PH_COUNT;
    hipLaunchKernelGGL(mk_fwd, dim3(grid), dim3(NTHREADS), LDS_BYTES, stream, a);
#else
    for (int p = 0; p < PH_COUNT; ++p) { a.ph_lo = p; a.ph_hi = p + 1; hipLaunchKernelGGL(mk_fwd, dim3(grid), dim3(NTHREADS), LDS_BYTES, stream, a); }
#endif
}
```

```cpp
#include <hip/hip_runtime.h>
#include <hip/hip_cooperative_groups.h>
#include <cstdio>
#include <cstdint>
namespace cg = cooperative_groups;

#ifndef REP_PHASE
#define REP_PHASE -1
#define REP_N 1
#define REP_SUB 0
#endif
#ifndef MK_N_LAUNCHES
#define MK_N_LAUNCHES 1
#endif

namespace pg8 {
#define PG8_LAS __attribute__((address_space(3)))
typedef unsigned short bf16_t;
typedef short bf16x8 __attribute__((ext_vector_type(8)));
typedef float f32x4 __attribute__((ext_vector_type(4)));
typedef unsigned u32x4 __attribute__((ext_vector_type(4)));
typedef unsigned u32x2 __attribute__((ext_vector_type(2)));
constexpr int BM = 256, BK = 64, HALF = 128, HTB = HALF * BK * 2, STAGE_BYTES = 8 * HTB, NXCD = 8, WGM = 8;

__host__ __device__ __forceinline__ int lds_byte(int r, int c) { const int st = (r >> 4) * 2 + (c >> 5), rr = r & 15, cc = c & 31, ob = rr * 64 + cc * 2; return st * 1024 + (ob ^ (((ob >> 9) & 1) << 5)); }
__host__ __device__ __forceinline__ void stage_rc(int b, int& R, int& C) { const int st = b / 1024, sb = b % 1024, swz = sb ^ (((sb >> 9) & 1) << 5); R = (st >> 1) * 16 + swz / 64; C = (st & 1) * 32 + (swz % 64) / 2; }
__host__ __device__ __forceinline__ int perm32(int rho) { const int n = rho >> 4, i = rho & 15; return 8 * (i >> 2) + 4 * n + (i & 3); }

struct Unit { int pm, pn, g; const char* a; const char* b; };

__device__ __forceinline__ unsigned cvt_pk_bf16(float lo, float hi) { unsigned r; asm volatile("v_cvt_pk_bf16_f32 %0, %1, %2" : "=v"(r) : "v"(lo), "v"(hi)); return r; }

struct DenseOrder {
    static constexpr bool CHUNK_B = false;
    int nM, nN, nwg, G, c, K, pn0; const char* A; const char* Bt;
    __device__ void init(const void* A_, const void* Bt_, int M, int N, int K_, int pn0_, int G_, int c_) { A = (const char*)A_; Bt = (const char*)Bt_; nM = M / BM; nN = N / BM; nwg = nM * nN; G = G_; c = c_; K = K_; pn0 = pn0_; }
    __device__ bool next(int i, Unit& u) const {
        const long L = (long)i * G + c; if (L >= nwg) return false;
        int wgid = (int)L; { const int q = nwg / NXCD, r = nwg % NXCD, xcd = wgid % NXCD, off = wgid / NXCD; wgid = (xcd < r ? xcd * (q + 1) : r * (q + 1) + (xcd - r) * q) + off; }
        const int nig = WGM * nN, gid = wgid / nig, fm = gid * WGM, gsz = (nM - fm) < WGM ? (nM - fm) : WGM;
        u.pm = fm + ((wgid % nig) % gsz); u.pn = pn0 + (wgid % nig) / gsz; u.g = 0;
        u.a = A + (size_t)u.pm * BM * K * 2; u.b = Bt + (size_t)u.pn * BM * K * 2; return true;
    }
};
struct MoeOrder {
    static constexpr bool CHUNK_B = true;
    int G, c, K; bool gather; const char* A; const char* Bt;
    __device__ void init(const void* A_, const void* Bt_, int K_, int G_, int c_, bool gather_) { A = (const char*)A_; Bt = (const char*)Bt_; K = K_; G = G_; c = c_; gather = gather_; }
    __device__ bool next(int i, Unit& u) const {
        const int L = i * G + c; if (L >= 512) return false;
        int pn, pm, b, e;
        if ((G & 7) == 0 && G >= 64) { const int per = G >> 3, x = c & 7, u = (c >> 3) + i * per;
            pn = u & 7; pm = (u >> 3) & 1; b = (u >> 4) & 1; e = x + 8 * (u >> 5); if (e >= 16) return false; }
        else { pn = L & 7; pm = (L >> 3) & 1; b = (L >> 4) & 1; e = L >> 5; }
        u.pm = pm; u.pn = pn; u.g = b * 16 + e;
        u.a = gather ? A : A + (size_t)(u.g * 512 + pm * BM) * K * 2; u.b = Bt + (size_t)e * 2048 * K * 2 + (size_t)pn * BM * 16; return true;
    }
};

struct EpiBf16 {
    static constexpr bool PERM = true, SWAP = false, INIT = false;
    bf16_t* O; int ldc; int grows; const float* rscale;
    __device__ __forceinline__ void operator()(const f32x4 (&acc)[2][2][4][2], const Unit& u, int wr, int wc, int fr, int fq) const {
        const int row0 = u.g * grows + u.pm * BM + wr * 64 + fr, col0 = u.pn * BM + wc * 32 + 8 * fq;
#pragma unroll
        for (int ai = 0; ai < 2; ++ai)
#pragma unroll
            for (int m = 0; m < 4; ++m) { const int row = row0 + ai * HALF + m * 16; bf16_t* rowp = O + (size_t)row * ldc + col0; const float sc = rscale ? rscale[row] : 1.f;
#pragma unroll
                for (int bj = 0; bj < 2; ++bj) { const f32x4 v0 = acc[ai][bj][m][0] * sc, v1 = acc[ai][bj][m][1] * sc;
                    u32x4 w; w.x = cvt_pk_bf16(v0[0], v0[1]); w.y = cvt_pk_bf16(v0[2], v0[3]); w.z = cvt_pk_bf16(v1[0], v1[1]); w.w = cvt_pk_bf16(v1[2], v1[3]);
                    *(u32x4*)(rowp + bj * HALF) = w; } }
    }
};
struct EpiSwiGLU {
    static constexpr bool PERM = true, SWAP = false, INIT = false;
    bf16_t* O;
    __device__ __forceinline__ void operator()(const f32x4 (&acc)[2][2][4][2], const Unit& u, int wr, int wc, int fr, int fq) const {
        const int row0 = u.g * 512 + u.pm * BM + wr * 64 + fr, col0 = u.pn * HALF + wc * 32 + 8 * fq;
#pragma unroll
        for (int ai = 0; ai < 2; ++ai)
#pragma unroll
            for (int m = 0; m < 4; ++m) { bf16_t* rowp = O + (size_t)(row0 + ai * HALF + m * 16) * 1024 + col0;
                float r[8];
#pragma unroll
                for (int n = 0; n < 2; ++n)
#pragma unroll
                    for (int e = 0; e < 4; ++e) { const float g = acc[ai][0][m][n][e], up = acc[ai][1][m][n][e]; r[n * 4 + e] = g / (1.f + __expf(-g)) * up; }
                u32x4 w; w.x = cvt_pk_bf16(r[0], r[1]); w.y = cvt_pk_bf16(r[2], r[3]); w.z = cvt_pk_bf16(r[4], r[5]); w.w = cvt_pk_bf16(r[6], r[7]);
                *(u32x4*)rowp = w; }
    }
};
struct EpiResF32 {
    static constexpr bool PERM = false, SWAP = false, INIT = true;
    const float* res; float* out; int ldc;
    __device__ __forceinline__ void init(f32x4 (&acc)[2][2][4][2], const Unit& u, int wr, int wc, int fr, int fq) const {
        const int row0 = u.pm * BM + wr * 64 + fr, col0 = u.pn * BM + wc * 32 + 4 * fq;
#pragma unroll
        for (int ai = 0; ai < 2; ++ai)
#pragma unroll
            for (int m = 0; m < 4; ++m) { const size_t off = (size_t)(row0 + ai * HALF + m * 16) * ldc + col0;
#pragma unroll
                for (int bj = 0; bj < 2; ++bj)
#pragma unroll
                    for (int n = 0; n < 2; ++n) acc[ai][bj][m][n] = *(const f32x4*)(res + off + bj * HALF + n * 16); }
    }
    __device__ __forceinline__ void operator()(const f32x4 (&acc)[2][2][4][2], const Unit& u, int wr, int wc, int fr, int fq) const {
        const int row0 = u.pm * BM + wr * 64 + fr, col0 = u.pn * BM + wc * 32 + 4 * fq;
#pragma unroll
        for (int ai = 0; ai < 2; ++ai)
#pragma unroll
            for (int m = 0; m < 4; ++m) { const size_t off = (size_t)(row0 + ai * HALF + m * 16) * ldc + col0;
#pragma unroll
                for (int bj = 0; bj < 2; ++bj)
#pragma unroll
                    for (int n = 0; n < 2; ++n) *(f32x4*)(out + off + bj * HALF + n * 16) = acc[ai][bj][m][n]; }
    }
};
struct EpiTransBf16 {
    static constexpr bool PERM = false, SWAP = true, INIT = false;
    bf16_t* O; int ldt; int pn_base;
    __device__ __forceinline__ void operator()(const f32x4 (&acc)[2][2][4][2], const Unit& u, int wr, int wc, int fr, int fq) const {
        const int ch0 = (u.pn - pn_base) * BM + wc * 32 + fr, t0 = u.pm * BM + wr * 64 + 4 * fq;
#pragma unroll
        for (int bj = 0; bj < 2; ++bj)
#pragma unroll
            for (int n = 0; n < 2; ++n) { bf16_t* chp = O + (size_t)(ch0 + bj * HALF + n * 16) * ldt + t0;
#pragma unroll
                for (int ai = 0; ai < 2; ++ai)
#pragma unroll
                    for (int m = 0; m < 4; ++m) { const f32x4 v = acc[ai][bj][m][n]; u32x2 w; w.x = cvt_pk_bf16(v[0], v[1]); w.y = cvt_pk_bf16(v[2], v[3]); *(u32x2*)(chp + ai * HALF + m * 16) = w; } }
    }
};

template <class Epi, class Sched, bool ALIGN_EPI = false, bool GATHER = false>
__device__ __forceinline__ void gemm_phase(PG8_LAS unsigned char* lds, const int K, const Sched& S, const Epi& E, const PG8_LAS int* ridx = nullptr) {
    const int tid = threadIdx.x, wid = __builtin_amdgcn_readfirstlane(tid >> 6), lane = tid & 63, wr = wid >> 2, wc = wid & 3, fr = lane & 15, fq = lane >> 4;
    const int nt = K / BK;
    unsigned vA0[2], vA1[2], vN0[2], vN1[2], voffB[2]; int stR[2], stC[2];
    const size_t kstep = (size_t)(BK * 2);
    const size_t hstep = (size_t)HALF * K * 2;
    const size_t kstepB = Sched::CHUNK_B ? (size_t)(BK / 8) * 2048 * 16 : kstep, hstepB = Sched::CHUNK_B ? (size_t)HALF * 16 : hstep;
#pragma unroll
    for (int i = 0; i < 2; ++i) { int R, C; stage_rc(tid * 16 + i * 8192, R, C); const int Rb = Epi::PERM ? ((R & ~31) + perm32(R & 31)) : R; stR[i] = R; stC[i] = C;
        voffB[i] = Sched::CHUNK_B ? (unsigned)(((C >> 3) * 2048 + Rb) * 16) : (unsigned)(Rb * K + C) * 2u;
        if constexpr (GATHER) { vA0[i] = (unsigned)(ridx[R] * K + C) * 2u; vA1[i] = (unsigned)(ridx[HALF + R] * K + C) * 2u; }
        else { vA0[i] = (unsigned)(R * K + C) * 2u; vA1[i] = vA0[i] + (unsigned)hstep; }
        vN0[i] = vA0[i]; vN1[i] = vA1[i]; }
    const unsigned ldsw = (unsigned)wid * 1024u;
    const int aoff = lds_byte(wr * 64 + fr, fq * 8), boff = lds_byte(wc * 32 + fr, fq * 8);
#define PG8_SA(b, h) (((b) * 2 + (h)) * HTB)
#define PG8_SB(b, h) ((4 + (b) * 2 + (h)) * HTB)
#define PG8_STAGE(bufoff, gbase, voff) do { _Pragma("unroll") for (int _i = 0; _i < 2; ++_i) \
        __builtin_amdgcn_global_load_lds((const unsigned*)((const char*)(gbase) + (voff)[_i]), (PG8_LAS unsigned*)(lds + (bufoff) + ldsw + _i * 8192), 16, 0, 0); } while (0)
#define PG8_LDA(dst, b, h) do { _Pragma("unroll") for (int m = 0; m < 4; ++m) _Pragma("unroll") for (int k = 0; k < 2; ++k) dst[m][k] = *(const PG8_LAS bf16x8*)(lds + PG8_SA(b, h) + aoff + m * 2048 + k * 1024); } while (0)
#define PG8_LDB(dst, b, h) do { _Pragma("unroll") for (int n = 0; n < 2; ++n) _Pragma("unroll") for (int k = 0; k < 2; ++k) dst[n][k] = *(const PG8_LAS bf16x8*)(lds + PG8_SB(b, h) + boff + n * 2048 + k * 1024); } while (0)
#define PG8_MMA(ai, bj, At, Bt) do { __builtin_amdgcn_s_setprio(1); _Pragma("unroll") for (int m = 0; m < 4; ++m) _Pragma("unroll") for (int n = 0; n < 2; ++n) _Pragma("unroll") for (int k = 0; k < 2; ++k) \
        acc[ai][bj][m][n] = Epi::SWAP ? __builtin_amdgcn_mfma_f32_16x16x32_bf16(At[m][k], Bt[n][k], acc[ai][bj][m][n], 0, 0, 0) : __builtin_amdgcn_mfma_f32_16x16x32_bf16(Bt[n][k], At[m][k], acc[ai][bj][m][n], 0, 0, 0); __builtin_amdgcn_s_setprio(0); } while (0)
#define PG8_WAIT_V(n) asm volatile("s_waitcnt vmcnt(" #n ")" ::: "memory")
#define PG8_WAIT_L(n) asm volatile("s_waitcnt lgkmcnt(" #n ")" ::: "memory")
#define PG8_BAR __builtin_amdgcn_s_barrier()
#define PG8_SCHED __builtin_amdgcn_sched_barrier(0)
    Unit cur, nxt; int ui = 0;
    if (!S.next(0, cur)) return;
    f32x4 acc[2][2][4][2];
    if constexpr (Epi::INIT) E.init(acc, cur, wr, wc, fr, fq);
    else {
#pragma unroll
    for (int a = 0; a < 2; ++a)
#pragma unroll
        for (int b = 0; b < 2; ++b)
#pragma unroll
            for (int m = 0; m < 4; ++m)
#pragma unroll
                for (int n = 0; n < 2; ++n) acc[a][b][m][n] = (f32x4){0.f, 0.f, 0.f, 0.f};
    }
    bf16x8 At[4][2], B0[2][2], B1[2][2];
    const char* cA = cur.a; const char* cB = cur.b;
    PG8_STAGE(PG8_SB(0, 0), cB, voffB); PG8_STAGE(PG8_SB(0, 1), cB + hstepB, voffB); PG8_STAGE(PG8_SA(0, 0), cA, vA0); PG8_STAGE(PG8_SA(0, 1), cA, vA1);
    if (wr == 1) PG8_BAR;
    PG8_WAIT_V(2); PG8_BAR;
    PG8_STAGE(PG8_SB(1, 0), cB + kstepB, voffB); PG8_STAGE(PG8_SA(1, 0), cA + kstep, vA0); PG8_STAGE(PG8_SB(1, 1), cB + hstepB + kstepB, voffB);
    PG8_WAIT_V(6); PG8_BAR;
    for (;;) {
        const bool has_next = S.next(ui + 1, nxt);
        const char* nA = has_next ? nxt.a : cA; const char* nB = has_next ? nxt.b : cB;
        if constexpr (GATHER) { if (has_next) {
#pragma unroll
            for (int i = 0; i < 2; ++i) { vN0[i] = (unsigned)(ridx[(ui + 1) * 256 + stR[i]] * K + stC[i]) * 2u; vN1[i] = (unsigned)(ridx[(ui + 1) * 256 + HALF + stR[i]] * K + stC[i]) * 2u; } } }
        for (int t = 0; t < nt; t += 2) {
            const bool last = (t == nt - 2);
            const char* a1 = cA + (size_t)(t + 1) * kstep;
            const char* a2 = last ? nA : cA + (size_t)(t + 2) * kstep; const char* b2 = last ? nB : cB + (size_t)(t + 2) * kstepB;
            const char* a3 = a2 + kstep; const char* b3 = b2 + kstepB;
            unsigned w0[2], w1[2];
#pragma unroll
            for (int i = 0; i < 2; ++i) { w0[i] = last ? vN0[i] : vA0[i]; w1[i] = last ? vN1[i] : vA1[i]; }
            PG8_LDB(B0, 0, 0); PG8_LDB(B1, 0, 1); PG8_SCHED; PG8_LDA(At, 0, 0); PG8_STAGE(PG8_SA(1, 1), a1, vA1);
            PG8_WAIT_V(8); PG8_WAIT_L(0); PG8_BAR; PG8_MMA(0, 0, At, B0); PG8_MMA(0, 1, At, B1); PG8_BAR; PG8_SCHED;
            PG8_LDA(At, 0, 1); PG8_STAGE(PG8_SB(0, 0), b2, voffB); PG8_STAGE(PG8_SB(0, 1), b2 + hstepB, voffB); PG8_STAGE(PG8_SA(0, 0), a2, w0);
            PG8_WAIT_V(8); PG8_WAIT_L(0); PG8_BAR; PG8_MMA(1, 0, At, B0); PG8_MMA(1, 1, At, B1); PG8_BAR; PG8_SCHED;
            PG8_LDB(B0, 1, 0); PG8_LDB(B1, 1, 1); PG8_SCHED; PG8_LDA(At, 1, 0); PG8_STAGE(PG8_SA(0, 1), a2, w1);
            PG8_WAIT_V(8); PG8_WAIT_L(0); PG8_BAR; PG8_MMA(0, 0, At, B0); PG8_MMA(0, 1, At, B1); PG8_BAR; PG8_SCHED;
            PG8_LDA(At, 1, 1); PG8_STAGE(PG8_SB(1, 0), b3, voffB); PG8_STAGE(PG8_SB(1, 1), b3 + hstepB, voffB); PG8_STAGE(PG8_SA(1, 0), a3, w0);
            PG8_WAIT_V(8); PG8_WAIT_L(0); PG8_BAR; PG8_MMA(1, 0, At, B0); PG8_MMA(1, 1, At, B1); PG8_BAR; PG8_SCHED;
        }
        if constexpr (ALIGN_EPI) { if (wr == 0) PG8_BAR; }
        E(acc, cur, wr, wc, fr, fq);
        if (!has_next) break;
        if constexpr (Epi::INIT) E.init(acc, nxt, wr, wc, fr, fq);
        else {
#pragma unroll
        for (int a = 0; a < 2; ++a)
#pragma unroll
            for (int b = 0; b < 2; ++b)
#pragma unroll
                for (int m = 0; m < 4; ++m)
#pragma unroll
                    for (int n = 0; n < 2; ++n) acc[a][b][m][n] = (f32x4){0.f, 0.f, 0.f, 0.f};
        }
        cur = nxt; cA = nA; cB = nB; ++ui;
#pragma unroll
        for (int i = 0; i < 2; ++i) { vA0[i] = vN0[i]; vA1[i] = vN1[i]; }
        if constexpr (ALIGN_EPI) { if (wr == 1) PG8_BAR; }
    }
    PG8_WAIT_V(0);
    if constexpr (!ALIGN_EPI) { if (wr == 0) PG8_BAR; }
    PG8_BAR;
#undef PG8_SA
#undef PG8_SB
#undef PG8_STAGE
#undef PG8_LDA
#undef PG8_LDB
#undef PG8_MMA
#undef PG8_WAIT_V
#undef PG8_WAIT_L
#undef PG8_BAR
#undef PG8_SCHED
}
}

constexpr int NB = 2, SEQ = 4096, DM = 2048, MT = NB * SEQ;
constexpr int NH = 8, HD = 128, AW = 1024, HW = 1024, INW = 6144;
constexpr int GW = 64, NROWS = 64, WR = 8, WC = 16;
constexpr int NE = 16, CAP = 512, FF = 1024;
constexpr int FEMB = 33, FHID = 64;
constexpr float EPS = 1e-6f;
constexpr int NWAVES = 8, NTHREADS = 512;

constexpr size_t MiB = 1u << 20;
constexpr size_t WS_CTL = 0, CTL_ZERO_BYTES = 32768;
constexpr size_t WS_WIN = 2 * MiB;
constexpr size_t WS_WOUT = 26 * MiB;
constexpr size_t WS_WGU = 34 * MiB;
constexpr size_t WS_WD = 162 * MiB;
constexpr size_t WS_W3T = 226 * MiB;
constexpr size_t WS_HID2 = 227 * MiB;
constexpr size_t WS_HB = 228 * MiB;
constexpr size_t WS_QK = 260 * MiB;
constexpr size_t WS_XT = 292 * MiB;
constexpr size_t WS_UC = 356 * MiB;
constexpr size_t WS_TAPS = 404 * MiB;
constexpr size_t WS_HYT = 436 * MiB;
constexpr size_t WS_MIXED = 452 * MiB;
constexpr size_t WS_AFF = 484 * MiB;
constexpr size_t WS_IDX = 485 * MiB;
constexpr size_t WS_GATE = 486 * MiB;
constexpr size_t WS_SEL = 487 * MiB;
constexpr size_t WS_Z1T = 488 * MiB;
constexpr size_t WS_XG = WS_XT;
constexpr size_t WS_ACT = WS_UC;
constexpr size_t WS_YE = WS_TAPS;
constexpr size_t WS_END = 504 * MiB;

constexpr int LDS_BYTES = 163840, LDS_MISC_OFF = 163840 - 128;

#define GAS __attribute__((address_space(1)))
#define LAS __attribute__((address_space(3)))
typedef unsigned short bf16;
typedef unsigned v4u __attribute__((ext_vector_type(4)));
typedef unsigned v2u __attribute__((ext_vector_type(2)));
typedef float f32x4 __attribute__((ext_vector_type(4)));
#define LDS_WAIT() asm volatile("s_waitcnt lgkmcnt(0)" ::: "memory")
#define VM_WAIT() asm volatile("s_waitcnt vmcnt(0)" ::: "memory")
__device__ __forceinline__ unsigned f2bf(float f) { unsigned u = __builtin_bit_cast(unsigned, f); return (u + 0x7fffu + ((u >> 16) & 1u)) >> 16; }
__device__ __forceinline__ unsigned pk2(float lo, float hi) { unsigned r; asm("v_cvt_pk_bf16_f32 %0, %1, %2" : "=v"(r) : "v"(lo), "v"(hi)); return r; }
__device__ __forceinline__ float bf2f(unsigned h) { return __builtin_bit_cast(float, h << 16); }
__device__ __forceinline__ float bflo(unsigned w) { return __builtin_bit_cast(float, w << 16); }
__device__ __forceinline__ float bfhi(unsigned w) { return __builtin_bit_cast(float, w & 0xffff0000u); }
__device__ __forceinline__ float wave_sum(float v) {
#pragma unroll
    for (int o = 1; o < 64; o <<= 1) v += __shfl_xor(v, o);
    return v;
}


#define XB_TMO      128
#define XB_XCNT(j)  (256  + 64 * (j))
#define XB_XSUB(j)  (1280 + 64 * (j))
#define XB_XGEN(j)  (2304 + 64 * (j))
#define XB_TOP      3328
#define XB_TOPGEN   3392
#define XCD_BAR_WORDS 3456
#define XB_SPIN_CAP (1u << 22)
__device__ __forceinline__ unsigned xb_ld(unsigned* p)              { return __hip_atomic_load(p, __ATOMIC_RELAXED, __HIP_MEMORY_SCOPE_AGENT); }
__device__ __forceinline__ unsigned xb_add(unsigned* p, unsigned v) { return __hip_atomic_fetch_add(p, v, __ATOMIC_RELAXED, __HIP_MEMORY_SCOPE_AGENT); }
__device__ __forceinline__ unsigned xb_xcc_id() { return (unsigned)__builtin_amdgcn_s_getreg((3 << 11) | 20) & 0xFu; }
#define XB_SPIN(cond, bar) do { unsigned _sp = 0; while (cond) { __builtin_amdgcn_s_sleep(1); \
    if ((++_sp & 255u) == 0u) { if (xb_ld(&(bar)[XB_TMO])) break; if (_sp > XB_SPIN_CAP) { atomicAdd(&(bar)[XB_TMO], 1u); break; } } } } while (0)
struct XcdBarrier { unsigned* bar; unsigned x; volatile LAS unsigned* st; };
__device__ __forceinline__ XcdBarrier xcd_barrier_post(unsigned* bar, volatile LAS unsigned* st) {
    XcdBarrier b; b.bar = bar; b.x = xb_xcc_id(); b.st = st;
    if (threadIdx.x == 0) (void)xb_add(&bar[XB_XCNT(b.x)], 1u);
    return b;
}
__device__ __forceinline__ void xcd_barrier_complete(unsigned* bar, unsigned x, unsigned& nloc, unsigned& nx) {
    const unsigned G = gridDim.x * gridDim.y * gridDim.z;
    unsigned sum, cnt, mine, sp = 0u;
    for (;;) {
        sum = 0u; cnt = 0u; mine = 0u;
#pragma unroll
        for (unsigned j = 0; j < 16; ++j) { const unsigned c = xb_ld(&bar[XB_XCNT(j)]); sum += c; cnt += (c > 0u) ? 1u : 0u; mine = (j == x) ? c : mine; }
        if (sum == G) break;
        __builtin_amdgcn_s_sleep(1);
        if ((++sp & 255u) == 0u) { if (xb_ld(&bar[XB_TMO])) break; if (sp > XB_SPIN_CAP) { atomicAdd(&bar[XB_TMO], 1u); break; } }
    }
    nloc = mine > 0u ? mine : 1u; nx = cnt > 0u ? cnt : 1u;
}
__device__ __forceinline__ void xcd_barrier(const XcdBarrier& b) {
    asm volatile("s_waitcnt vmcnt(0)" ::: "memory");
    __syncthreads();
    if (threadIdx.x == 0) {
        unsigned* bar = b.bar;
        __builtin_amdgcn_s_waitcnt(0);
        unsigned nloc = b.st[0], nx = b.st[1];
        if (nloc == 0u) { xcd_barrier_complete(bar, b.x, nloc, nx); b.st[0] = nloc; b.st[1] = nx; }
        const unsigned old = xb_add(&bar[XB_XSUB(b.x)], 1u);
        const unsigned gen = old / nloc;
        if (old + 1u == (gen + 1u) * nloc) {
            __builtin_amdgcn_fence(__ATOMIC_RELEASE, "agent");
            asm volatile("s_waitcnt vmcnt(0)" ::: "memory");
            const unsigned og = xb_add(&bar[XB_TOP], 1u);
            const unsigned tg = og / nx;
            if (og + 1u == (tg + 1u) * nx) xb_add(&bar[XB_TOPGEN], 1u);
            else XB_SPIN(xb_ld(&bar[XB_TOPGEN]) == tg, bar);
            __builtin_amdgcn_fence(__ATOMIC_ACQUIRE, "agent");
            xb_add(&bar[XB_XGEN(b.x)], 1u);
            asm volatile("s_waitcnt vmcnt(0)" ::: "memory");
        } else {
            XB_SPIN(xb_ld(&bar[XB_XGEN(b.x)]) == gen, bar);
            __builtin_amdgcn_fence(__ATOMIC_ACQUIRE, "agent");
            asm volatile("s_waitcnt vmcnt(0)" ::: "memory");
        }
    }
    __syncthreads();
}

__device__ unsigned g_bar_words[XCD_BAR_WORDS + 64];
struct Frame {
    LAS unsigned char* lds;
    int tid, lane, wave, G, bid;
    const float* in[23]; float* out; unsigned char* ws;
};
#define GW_ID(F) ((F).bid * NWAVES + (F).wave)
#define GW_N(F) ((F).G * NWAVES)

__device__ __forceinline__ void p0_transpose_item(const float* W, int K, int N, bf16* WT, int row_base, int k0, int n0, LAS float* scr, int lane) {
    float t_[32];
#pragma unroll
    for (int i = 0; i < 32; ++i) { const int kk = 2 * i + (lane >> 5); t_[i] = W[(size_t)(k0 + kk) * N + n0 + (lane & 31)]; }
#pragma unroll
    for (int i = 0; i < 32; ++i) { const int kk = 2 * i + (lane >> 5); scr[kk * 33 + (lane & 31)] = t_[i]; }
    LDS_WAIT(); asm volatile("" ::: "memory");
    const int c = lane & 7;
#pragma unroll
    for (int j = 0; j < 4; ++j) { const int n = (lane >> 3) + 8 * j; const LAS float* s = scr + (8 * c) * 33 + n;
        v4u o; o.x = pk2(s[0 * 33], s[1 * 33]); o.y = pk2(s[2 * 33], s[3 * 33]); o.z = pk2(s[4 * 33], s[5 * 33]); o.w = pk2(s[6 * 33], s[7 * 33]);
        *(GAS v4u*)(WT + (size_t)(row_base + n) * K + k0 + 8 * c) = o; }
    LDS_WAIT(); asm volatile("" ::: "memory");
}
__device__ __forceinline__ void phase_p0(Frame& F) {
    LAS float* scr = (LAS float*)(F.lds + F.wave * 16384);
    const int gw = GW_ID(F), NGW = GW_N(F);
    bf16* WinT = (bf16*)(F.ws + WS_WIN); bf16* WoutT = (bf16*)(F.ws + WS_WOUT); bf16* W3T = (bf16*)(F.ws + WS_W3T);
    constexpr int I_IN = (DM / 64) * (INW / 32), I_OUT = (DM / 64) * (DM / 32), I_3 = 1 * (4096 / 32);
    constexpr int NITEMS = I_IN + I_OUT + I_3;
    for (int it = gw; it < NITEMS; it += NGW) {
        int r = it;
        if (r < I_IN) { const int nblk = INW / 32, kb = r / nblk, nb = r % nblk; p0_transpose_item(F.in[2], DM, INW, WinT, 32 * nb, 64 * kb, 32 * nb, scr, F.lane); continue; } r -= I_IN;
        if (r < I_OUT) { const int nblk = DM / 32, kb = r / nblk, nb = r % nblk; p0_transpose_item(F.in[17], DM, DM, WoutT, 32 * nb, 64 * kb, 32 * nb, scr, F.lane); continue; } r -= I_OUT;
        { const int nb = r; p0_transpose_item(F.in[12], FHID, 4096, W3T, 32 * nb, 0, 32 * nb, scr, F.lane); }
    }
    bf16* HB = (bf16*)(F.ws + WS_HB);
    const float* x = F.in[0]; const float* g = F.in[1];
    f32x4 vn[8];
    if (gw < MT) { const GAS f32x4* xr = (const GAS f32x4*)(x + (size_t)gw * DM) + F.lane;
#pragma unroll
        for (int j = 0; j < 8; ++j) vn[j] = xr[64 * j]; }
    for (int m = gw; m < MT; m += NGW) {
        f32x4 v[8]; float s = 0.f;
#pragma unroll
        for (int j = 0; j < 8; ++j) { v[j] = vn[j]; s += (v[j].x * v[j].x + v[j].y * v[j].y) + (v[j].z * v[j].z + v[j].w * v[j].w); }
        if (m + NGW < MT) { const GAS f32x4* xr = (const GAS f32x4*)(x + (size_t)(m + NGW) * DM) + F.lane;
#pragma unroll
            for (int j = 0; j < 8; ++j) vn[j] = xr[64 * j]; }
        const float r = rsqrtf(wave_sum(s) * (1.f / DM) + EPS);
        GAS v2u* o8 = (GAS v2u*)(HB + (size_t)m * DM) + F.lane;
#pragma unroll
        for (int j = 0; j < 8; ++j) { const f32x4 gg = *((const GAS f32x4*)g + F.lane + 64 * j); v2u o; o.x = pk2(v[j].x * r * gg.x, v[j].y * r * gg.y); o.y = pk2(v[j].z * r * gg.z, v[j].w * r * gg.w); o8[64 * j] = o; }
    }
    float* HID2 = (float*)(F.ws + WS_HID2);
    LAS float* sc2 = (LAS float*)(F.lds + F.wave * 16384);
    const float* w1 = F.in[8]; const float* b1 = F.in[9]; const float* w2 = F.in[10]; const float* b2 = F.in[11]; const float* fr = F.in[13];
    for (int l = gw; l < SEQ; l += NGW) {
        const int j = F.lane;
        float zv = 0.f;
        if (j == 0) zv = (float)l / (float)(SEQ - 1);
        else if (j < FEMB) { const int k = (j - 1) & 15; const float f = 1e-4f + (float)k * ((15.0f - 1e-4f) / 15.0f); const float wv = 6.283185307179586f * (float)l / (float)SEQ; zv = (j <= 16) ? cosf(f * wv) : -sinf(f * wv); }
        sc2[j] = zv; LDS_WAIT(); asm volatile("" ::: "memory");
        float a = b1[j];
        for (int i = 0; i < FEMB; ++i) a += sc2[i] * w1[i * FHID + j];
        const float h1 = sinf(fr[j] * a);
        sc2[64 + j] = h1; LDS_WAIT(); asm volatile("" ::: "memory");
        float c = b2[j];
        for (int i = 0; i < FHID; ++i) c += sc2[64 + i] * w2[i * FHID + j];
        HID2[l * FHID + j] = sinf(fr[j] * c);
        LDS_WAIT(); asm volatile("" ::: "memory");
    }
}

typedef short bf16x8 __attribute__((ext_vector_type(8)));
typedef float f32x16 __attribute__((ext_vector_type(16)));
__device__ __forceinline__ void phase_filters(Frame& F) {
    const float* HID2 = (const float*)(F.ws + WS_HID2); const bf16* W3T = (const bf16*)(F.ws + WS_W3T); const float* fbias = F.in[14]; bf16* TAPS = (bf16*)(F.ws + WS_TAPS);
    const int n = F.lane & 31, hh = F.lane >> 5;
    const float mind = -4.605170185988091f / 1.5f, maxd = -4.605170185988091f / 0.3f;
    LAS bf16* scr = (LAS bf16*)(F.lds + F.wave * 4096);
    for (int task = GW_ID(F); task < 128 * 16; task += GW_N(F)) {
        const int l0 = (task & 127) * 32, cg = task >> 7;
        const int dir = (cg >> 2) & 1, o = cg >> 3;
        const int l = l0 + dir + n;
        bf16x8 hb[4];
        { const int lr = l < SEQ ? l : SEQ - 1;
#pragma unroll
          for (int ks = 0; ks < 4; ++ks) { const GAS f32x4* hp = (const GAS f32x4*)(HID2 + (size_t)lr * FHID + 16 * ks + 8 * hh); const f32x4 h0 = hp[0], h1 = hp[1];
              v4u bw; bw.x = pk2(h0.x, h0.y); bw.y = pk2(h0.z, h0.w); bw.z = pk2(h1.x, h1.y); bw.w = pk2(h1.z, h1.w); hb[ks] = __builtin_bit_cast(bf16x8, bw); } }
        const float t = (float)l / (float)(SEQ - 1);
        const int pos = dir ? 31 - n : n;
        const int idx0 = dir ? 4064 - l0 : 4096 + l0;
#pragma unroll 2
        for (int ct = 0; ct < 8; ++ct) {
            const int col0 = (cg * 8 + ct) * 32;
            f32x16 acc;
#pragma unroll
            for (int i = 0; i < 16; ++i) acc[i] = 0.f;
#pragma unroll
            for (int ks = 0; ks < 4; ++ks) { const bf16x8 a = *(const GAS bf16x8*)(W3T + (size_t)(col0 + n) * FHID + 16 * ks + 8 * hh);
                acc = __builtin_amdgcn_mfma_f32_32x32x16_bf16(a, hb[ks], acc, 0, 0, 0); }
#pragma unroll
            for (int i = 0; i < 16; ++i) {
                const int chl = (i & 3) + 8 * (i >> 2) + 4 * hh, c = (col0 & 1023) + chl;
                const float delta = fabsf(mind + (maxd - mind) * ((float)c / 1023.0f));
                float v = acc[i] * __expf(-t * delta);
                if (dir == 0 && l == 0) v += fbias[o * 1024 + c];
                if (l >= SEQ) v = 0.f;
                scr[chl * 40 + pos] = (bf16)f2bf(v);
            }
            LDS_WAIT(); asm volatile("" ::: "memory");
#pragma unroll
            for (int j = 0; j < 2; ++j) { const int id = F.lane + 64 * j, chl = id >> 2, q = id & 3;
                const v4u w = *(const LAS v4u*)(scr + chl * 40 + 8 * q);
                *(GAS v4u*)(TAPS + ((size_t)((col0 & 1023) + chl) * 2 + o) * 8192 + idx0 + 8 * q) = w; }
            LDS_WAIT(); asm volatile("" ::: "memory");
        }
    }
}

constexpr int HY_TAPS_BYTES = 4 * 16384, HY_ZB_ENT = 6080, HY_ZB_BYTES = 12288;
__device__ __forceinline__ unsigned hy_zb_off(int idx0  ) { const int q = idx0 >> 3; return (unsigned)((q ^ ((q >> 4) & 3)) << 4); }
__device__ __forceinline__ const LAS unsigned char* hy_pm(const LAS unsigned char* zbl  , int g, int ip, int hh) {
    const int q0 = 124 - 4 * ip + 2 * g + hh;
    unsigned p = (unsigned)(size_t)zbl + (unsigned)(((q0 ^ ((q0 >> 4) & 3)) << 4) - 7168);
    asm volatile("" : "+v"(p));
    return (const LAS unsigned char*)(size_t)p;
}
template <int MASK>
__device__ __forceinline__ void hy_loadB(bf16x8 (&bf)[8], const LAS unsigned char* pm) {
#pragma unroll
    for (int tau = 0; tau < 8; ++tau) if (MASK & (1 << tau)) bf[tau] = *(const LAS bf16x8*)(pm + 1024 * (7 - tau));
}
__device__ __forceinline__ void hy_loadA(unsigned (&d)[5], const LAS bf16* taps, int g, int n, int hh) {
    const volatile LAS unsigned* dp = (const volatile LAS unsigned*)taps + ((1 + 8 * hh + n) >> 1) + 8 * g;
#pragma unroll
    for (int i = 0; i < 5; ++i) d[i] = dp[i];
}
template <int MASK>
__device__ __forceinline__ void hy_mma(f32x16 (&acc)[8], const bf16x8 a, const bf16x8 (&bf)[8]) {
#pragma unroll
    for (int tau = 0; tau < 8; ++tau) if (MASK & (1 << tau)) acc[tau] = __builtin_amdgcn_mfma_f32_32x32x16_bf16(a, bf[tau], acc[tau], 0, 0, 0);
}
#define HY_ALIGN(a, d) do { v4u aw_; aw_.x = __builtin_amdgcn_alignbyte(d[1], d[0], sh); aw_.y = __builtin_amdgcn_alignbyte(d[2], d[1], sh); aw_.z = __builtin_amdgcn_alignbyte(d[3], d[2], sh); aw_.w = __builtin_amdgcn_alignbyte(d[4], d[3], sh); a = __builtin_bit_cast(bf16x8, aw_); } while (0)
#define HY_INTERLEAVE() do { __builtin_amdgcn_sched_group_barrier(0x2, 4, 0); _Pragma("unroll") for (int i_ = 0; i_ < 9; ++i_) { __builtin_amdgcn_sched_group_barrier(0x8, 1, 0); __builtin_amdgcn_sched_group_barrier(0x100, 3, 0); __builtin_amdgcn_sched_group_barrier(0x2, 3, 0); } } while (0)
constexpr int HY_YOFF = 254;
template <int MASK>
__device__ __forceinline__ void hy_mma_reload(f32x16 (&acc)[8], const bf16x8 a, bf16x8 (&bf)[8], const LAS unsigned char* pm_next) {
#pragma unroll
    for (int tau = 0; tau < 8; ++tau) if (MASK & (1 << tau)) {
        acc[tau] = __builtin_amdgcn_mfma_f32_32x32x16_bf16(a, bf[tau], acc[tau], 0, 0, 0);
        bf[tau] = *(const LAS bf16x8*)(pm_next + 1024 * (7 - tau));
    }
}
template <int MX, int MY>
__device__ __forceinline__ void hy_segment(f32x16 (&acc)[8], const LAS bf16* taps, const LAS unsigned char* zbl, int i0, int i1, int n, int hh) {
    const unsigned sh = (n & 1) ? 0u : 2u;
    const int ip = n & 15;
    unsigned dx[5], dy[5]; bf16x8 a, x0[8], y0[8];
    hy_loadA(dx, taps, i0, n, hh); hy_loadA(dy, taps, i0 + HY_YOFF, n, hh); hy_loadB<MX>(x0, hy_pm(zbl, i0, ip, hh)); hy_loadB<MY>(y0, hy_pm(zbl, i0 + HY_YOFF, ip, hh));
#pragma unroll 1
    for (int i = i0; i < i1; ++i) {
        if (MX) { HY_ALIGN(a, dx); hy_loadA(dx, taps, i + 1, n, hh); hy_mma_reload<MX>(acc, a, x0, hy_pm(zbl, i + 1, ip, hh)); }
        HY_ALIGN(a, dy); hy_loadA(dy, taps, i + 1 + HY_YOFF, n, hh); hy_mma_reload<MY>(acc, a, y0, hy_pm(zbl, i + 1 + HY_YOFF, ip, hh));
        HY_INTERLEAVE(); __builtin_amdgcn_sched_barrier(0);
    }
}
__device__ __forceinline__ void hy_stage_taps(Frame& F, int c0, int o) {
    const bf16* TAPS = (const bf16*)(F.ws + WS_TAPS);
    int tid = F.tid; asm volatile("" : "+v"(tid));
#pragma unroll
    for (int j = 0; j < 8; ++j) { const int ch = tid + NTHREADS * j, ci = ch >> 10, w = ch & 1023;
        *((LAS v4u*)(F.lds) + ch) = *((const GAS v4u*)(TAPS + ((size_t)(c0 + ci) * 2 + o) * 8192) + w); }
}
struct ConvItem { const float* W; bf16* WTe; int N, row_base, k0, n0; };
__device__ __forceinline__ void conv_load64(float (&v)[64], const ConvItem& c, int lane) {
    const GAS float* src = (const GAS float*)(c.W + (size_t)c.k0 * c.N + c.n0 + lane);
#pragma unroll
    for (int kk = 0; kk < 64; ++kk) v[kk] = src[(size_t)kk * c.N];
}
__device__ __forceinline__ void conv_store64(const float (&v)[64], const ConvItem& c, int lane) {
    GAS v4u* dst = (GAS v4u*)c.WTe + (size_t)(c.k0 >> 3) * 2048 + c.row_base + lane;
#pragma unroll
    for (int j = 0; j < 8; ++j) { v4u o; o.x = pk2(v[8 * j], v[8 * j + 1]); o.y = pk2(v[8 * j + 2], v[8 * j + 3]); o.z = pk2(v[8 * j + 4], v[8 * j + 5]); o.w = pk2(v[8 * j + 6], v[8 * j + 7]); dst[(size_t)j * 2048] = o; }
}
constexpr int MOE_ITEMS_GU = 2 * NE * 32 * 16, MOE_ITEMS_D = NE * 16 * 32, MOE_ITEMS = MOE_ITEMS_GU + MOE_ITEMS_D;
#ifndef MOE_P0_ITEMS
#define MOE_P0_ITEMS 0
#endif
#ifndef MOE_P4_ITEMS
#define MOE_P4_ITEMS 3584
#endif
constexpr int MOE_HELP_ITEMS = MOE_ITEMS - MOE_P0_ITEMS - MOE_P4_ITEMS;
__device__ __forceinline__ ConvItem moe_item(Frame& F, int it) {
    bf16* WguT = (bf16*)(F.ws + WS_WGU); bf16* WdT = (bf16*)(F.ws + WS_WD); ConvItem c;
    if (it < MOE_ITEMS_GU) { const int which = it >> 13, e = (it >> 9) & 15, kb = (it >> 4) & 31, nb = it & 15, f0 = 64 * nb;
        c.W = (which ? F.in[21] : F.in[20]) + (size_t)e * DM * FF; c.N = FF; c.WTe = WguT + (size_t)e * 2048 * DM; c.row_base = (f0 >> 7) * 256 + which * 128 + (f0 & 127); c.k0 = 64 * kb; c.n0 = f0;
    } else { const int r = it - MOE_ITEMS_GU, e = r >> 9, kb = (r >> 5) & 15, nb = r & 31;
        c.W = F.in[22] + (size_t)e * FF * DM; c.N = DM; c.WTe = WdT + (size_t)e * 2048 * FF; c.row_base = 64 * nb; c.k0 = 64 * kb; c.n0 = 64 * nb; }
    return c;
}
__device__ __forceinline__ void conv_range_moe_tail(Frame& F);
__device__ __forceinline__ void moe_conv_item(Frame& F, int it) { float v[64]; const ConvItem c = moe_item(F, it); conv_load64(v, c, F.lane); conv_store64(v, c, F.lane); }
__device__ __forceinline__ void moe_conv_range(Frame& F, int lo, int hi, int step) {
    if (lo >= hi) return;
    float va[64], vb[64];
    ConvItem ca = moe_item(F, lo), cb_; conv_load64(va, ca, F.lane);
    for (int it = lo; it < hi; it += 2 * step) {
        const bool hb = it + step < hi;
        if (hb) { cb_ = moe_item(F, it + step); conv_load64(vb, cb_, F.lane); }
        conv_store64(va, ca, F.lane);
        const bool ha = it + 2 * step < hi;
        if (ha) { ca = moe_item(F, it + 2 * step); conv_load64(va, ca, F.lane); }
        if (hb) conv_store64(vb, cb_, F.lane);
    }
}
__device__ __forceinline__ void conv_range_moe_tail(Frame& F) {
    const int w = (F.bid - NB * NE) * NWAVES + F.wave, nw = (F.G - NB * NE) * NWAVES;
    moe_conv_range(F, MOE_ITEMS - MOE_P4_ITEMS + w, MOE_ITEMS, nw);
}
__device__ __forceinline__ void hy_write_gates(Frame& F, int c0, int oo) {
    const bf16* XH = (const bf16*)(F.ws + WS_XT) + (size_t)1024 * MT; bf16* GC = (bf16*)(F.ws + WS_UC);
    const float* cw = F.in[6]; const float* cb = F.in[7];
    int ht = F.tid - 256; asm volatile("" : "+v"(ht));
#pragma unroll 2
    for (int k = 0; k < 16; ++k) { const int id = ht + 256 * k, u = id & 511, b = (id >> 9) & 1, ci = id >> 10;
        const int gch = oo * 1024 + c0 + ci; const bf16* gs = XH + (size_t)gch * MT + b * SEQ;
        const float w0 = cw[gch], w1 = cw[3072 + gch], w2 = cw[6144 + gch], bb = cb[gch];
        const v4u w = *((const GAS v4u*)gs + u);
        float f[10];
        f[1] = bflo(w.x); f[2] = bfhi(w.x); f[3] = bflo(w.y); f[4] = bfhi(w.y); f[5] = bflo(w.z); f[6] = bfhi(w.z); f[7] = bflo(w.w); f[8] = bfhi(w.w);
        f[0] = u > 0 ? bf2f(gs[8 * u - 1]) : 0.f; f[9] = u < 511 ? bf2f(gs[8 * u + 8]) : 0.f;
        float z[8];
#pragma unroll
        for (int e = 0; e < 8; ++e) z[e] = bb + w0 * f[e] + w1 * f[e + 1] + w2 * f[e + 2];
        v4u r; r.x = pk2(z[0], z[1]); r.y = pk2(z[2], z[3]); r.z = pk2(z[4], z[5]); r.w = pk2(z[6], z[7]);
        *((GAS v4u*)(GC + ((size_t)((c0 + ci) * 2 + oo) * 2 + b) * SEQ) + u) = r; }
}
__device__ __forceinline__ void phase_hyena(Frame& F) {
    const bf16* XH = (const bf16*)(F.ws + WS_XT) + (size_t)1024 * MT;
    const float* cw = F.in[6]; const float* cb = F.in[7];
    bf16* HYT = (bf16*)(F.ws + WS_HYT); bf16* GC = (bf16*)(F.ws + WS_UC);
    const int n = F.lane & 31, hh = F.lane >> 5;
    const bool compute = F.wave < 4;
    const int nhelp = F.G * 4, hw = F.bid * 4 + (F.wave - 4);
    int sec = 0;
    for (int cg = F.bid; cg < 256; cg += F.G) {
        const int c0 = cg * 4;
        __syncthreads();
        hy_stage_taps(F, c0, 0);
        {
          int lane_ = F.lane; asm volatile("" : "+v"(lane_));
          const int ci = F.wave >> 1, b = F.wave & 1; LAS unsigned char* zb = F.lds + HY_TAPS_BYTES + F.wave * HY_ZB_BYTES;
          const int zch = 2048 + c0 + ci; const bf16* zsrc = XH + (size_t)zch * MT + b * SEQ;
          const float w0 = cw[zch], w1 = cw[3072 + zch], w2 = cw[6144 + zch], bb = cb[zch];
#pragma unroll
          for (int j = 0; j < 8; ++j) { const int u = lane_ + 64 * j; const v4u w = *((const GAS v4u*)zsrc + u);
              float f[10];
              f[1] = bflo(w.x); f[2] = bfhi(w.x); f[3] = bflo(w.y); f[4] = bfhi(w.y); f[5] = bflo(w.z); f[6] = bfhi(w.z); f[7] = bflo(w.w); f[8] = bfhi(w.w);
              f[0] = u > 0 ? bf2f(zsrc[8 * u - 1]) : 0.f; f[9] = u < 511 ? bf2f(zsrc[8 * u + 8]) : 0.f;
              float z[8];
#pragma unroll
              for (int e = 0; e < 8; ++e) z[e] = bb + w0 * f[e] + w1 * f[e + 1] + w2 * f[e + 2];
              v4u r; r.x = pk2(z[7], z[6]); r.y = pk2(z[5], z[4]); r.z = pk2(z[3], z[2]); r.w = pk2(z[1], z[0]);
              *(LAS v4u*)(zb + hy_zb_off(8 * (635 - u))) = r; }
          const v4u zero = {0u, 0u, 0u, 0u};
          for (int q = lane_; q < 124; q += 64) { *(LAS v4u*)(zb + hy_zb_off(8 * q)) = zero; *(LAS v4u*)(zb + hy_zb_off(8 * (636 + q))) = zero; } }
        if (!compute) hy_write_gates(F, c0, 0);
        __syncthreads();
#pragma unroll 1
        for (int o = 0; o < 2; ++o) {
            if (compute) {
                const int ci = F.wave, c = c0 + ci;
                const LAS bf16* taps = (const LAS bf16*)(F.lds + ci * 16384);
                const int ip = n & 15, bl = n >> 4;
                LAS unsigned char* zbl = F.lds + HY_TAPS_BYTES + (2 * ci + bl) * HY_ZB_BYTES;
                f32x16 acc[8];
#pragma unroll
                for (int tau = 0; tau < 8; ++tau)
#pragma unroll
                    for (int i = 0; i < 16; ++i) acc[tau][i] = 0.f;
                hy_segment<0x01, 0xFF>(acc, taps, zbl, 0, 32, n, hh);
                hy_segment<0x03, 0xFE>(acc, taps, zbl, 32, 64, n, hh);
                hy_segment<0x07, 0xFC>(acc, taps, zbl, 64, 96, n, hh);
                hy_segment<0x0F, 0xF8>(acc, taps, zbl, 96, 128, n, hh);
                hy_segment<0x1F, 0xF0>(acc, taps, zbl, 128, 160, n, hh);
                hy_segment<0x3F, 0xE0>(acc, taps, zbl, 160, 192, n, hh);
                hy_segment<0x7F, 0xC0>(acc, taps, zbl, 192, 224, n, hh);
                hy_segment<0xFF, 0x80>(acc, taps, zbl, 224, 254, n, hh);
                hy_segment<0x00, 0x80>(acc, taps, zbl, 254, 256, n, hh);
                LDS_WAIT();
                int ip2 = ip, h2 = hh, b2 = bl; asm volatile("" : "+v"(ip2), "+v"(h2), "+v"(b2));
                {
                    const bf16* gate = GC + ((size_t)(c * 2 + o) * 2 + b2) * SEQ;
                    LAS unsigned char* zb = F.lds + HY_TAPS_BYTES + (2 * ci + b2) * HY_ZB_BYTES; bf16* outp = HYT + (size_t)c * MT + b2 * SEQ;
#pragma unroll
                    for (int th = 0; th < 2; ++th) {
                        v2u gw[4][4];
#pragma unroll
                        for (int tq = 0; tq < 4; ++tq)
#pragma unroll
                            for (int rg = 0; rg < 4; ++rg) gw[tq][rg] = *(const GAS v2u*)(gate + 512 * (4 * th + tq) + 32 * ip2 + 8 * rg + 4 * h2);
#pragma unroll
                        for (int tq = 0; tq < 4; ++tq) {
#pragma unroll
                            for (int rg = 0; rg < 4; ++rg) { const int tau = 4 * th + tq, t0 = 512 * tau + 32 * ip2 + 8 * rg + 4 * h2;
                                const float z0 = bflo(gw[tq][rg].x) * acc[tau][4 * rg + 0], z1 = bfhi(gw[tq][rg].x) * acc[tau][4 * rg + 1], z2 = bflo(gw[tq][rg].y) * acc[tau][4 * rg + 2], z3 = bfhi(gw[tq][rg].y) * acc[tau][4 * rg + 3];
                                if (o == 0) { v2u w; w.x = pk2(z3, z2); w.y = pk2(z1, z0);
                                    *(LAS v2u*)(zb + hy_zb_off(8 * (635 - (t0 >> 3))) + (h2 ? 0 : 8)) = w; }
                                else { v2u w; w.x = pk2(z0, z1); w.y = pk2(z2, z3); *(GAS v2u*)(outp + t0) = w; } } }
                    }
                }
            } else {
                if (o == 0) hy_write_gates(F, c0, 1);
                const int lo_it = MOE_P0_ITEMS + sec * (MOE_HELP_ITEMS / 2), hi_it = lo_it + MOE_HELP_ITEMS / 2;
                if (sec < 2) moe_conv_range(F, lo_it + hw, hi_it, nhelp);
            }
            ++sec;
            if (o == 0) {
                __syncthreads();
                hy_stage_taps(F, c0, 1);
                __syncthreads();
            }
        }
    }
    for (; sec < 2; ++sec) if (!compute) { const int lo_it = MOE_P0_ITEMS + sec * (MOE_HELP_ITEMS / 2), hi_it = lo_it + MOE_HELP_ITEMS / 2; moe_conv_range(F, lo_it + hw, hi_it, nhelp); }
    __syncthreads();
}

constexpr int AT_KBYTES = 16384, AT_VPITCH = 136, AT_VBYTES = 128 * AT_VPITCH, AT_STAGE = AT_KBYTES + AT_VBYTES, AT_RP_OFF = 2 * AT_STAGE;
__device__ __forceinline__ void phase_attn2(Frame& F) {
    const bf16* QK = (const bf16*)(F.ws + WS_QK); const bf16* VT = (const bf16*)(F.ws + WS_XT); bf16* MIXED = (bf16*)(F.ws + WS_MIXED);
    const float* rpb = F.in[5]; const float* og = F.in[15]; const float* qg = F.in[3]; const float* kg = F.in[4];
    LAS float* rt = (LAS float*)(F.lds + AT_RP_OFF);
    LAS float* gtab = (LAS float*)(F.lds + AT_RP_OFF + 8 * 2048);
    if (F.tid < HD) gtab[F.tid] = qg[F.tid] * kg[F.tid];
    const int n = F.lane & 31, hh = F.lane >> 5;
    for (int unit = F.bid; unit < NB * NH * 16; unit += F.G) {
        const int rq = unit & 15, h = (unit >> 4) & 7, b = unit >> 7, r0 = 4 * rq;
        const int r = r0 + (F.wave >> 1), wq = F.wave & 1;
        int kmin = r0 - WR / 2; kmin = kmin < 0 ? 0 : (kmin > NROWS - WR ? NROWS - WR : kmin);
        int kmax = r0 + 3 - WR / 2; kmax = (kmax < 0 ? 0 : (kmax > NROWS - WR ? NROWS - WR : kmax)) + WR - 1;
        int kr0 = r - WR / 2; kr0 = kr0 < 0 ? 0 : (kr0 > NROWS - WR ? NROWS - WR : kr0);
        const int nrows = kmax - kmin + 1;
        __syncthreads();
        for (int i = F.tid; i < 15 * 128; i += NTHREADS) { const int dr_ = i >> 7, dcx = (i & 127) - 48; rt[i] = (dcx >= 0 && dcx <= 30) ? rpb[h * 465 + dr_ * 31 + dcx] * 1.4426950408889634f : 0.f; }
        const int mq = b * SEQ + r * GW + 32 * wq + n, qc = 32 * wq + n;
        int c0 = qc - WC / 2; c0 = c0 < 0 ? 0 : (c0 > GW - WC ? GW - WC : c0);
        bf16x8 qf[8];
#pragma unroll
        for (int ks = 0; ks < 8; ++ks) qf[ks] = *(const GAS bf16x8*)(QK + (size_t)mq * 2048 + h * HD + 16 * ks + 8 * hh);
        float qscale;
        {
          f32x16 D;
#pragma unroll
          for (int i = 0; i < 16; ++i) D[i] = 0.f;
#pragma unroll
          for (int ks = 0; ks < 8; ++ks) D = __builtin_amdgcn_mfma_f32_32x32x16_bf16(qf[ks], qf[ks], D, 0, 0, 0);
          float dsel = 0.f; const int isel = (n & 3) + 4 * (n >> 3);
#pragma unroll
          for (int i = 0; i < 16; ++i) dsel = (i == isel) ? D[i] : dsel;
          const float other = __shfl_xor(dsel, 32);
          const float ssq = (((n >> 2) & 1) == hh) ? dsel : other;
          qscale = (0.08838834764831845f * 1.4426950408889634f) * rsqrtf(ssq * (1.f / HD) + EPS); }
        const unsigned long long wmask = (c0 >= 4 * hh) ? (0xFFFFull << (c0 - 4 * hh)) : (0xFFFFull >> (4 * hh - c0));
        const unsigned wm0 = (unsigned)wmask, wm1 = (unsigned)(wmask >> 32);
        const int rtl = 4 * hh - qc + 63;
        f32x16 O[4];
#pragma unroll
        for (int dt = 0; dt < 4; ++dt)
#pragma unroll
            for (int i = 0; i < 16; ++i) O[dt][i] = 0.f;
        float lsum = 0.f;
        v4u sk[2], sv[2];

        auto gload = [&](int kr) {
#pragma unroll
            for (int j = 0; j < 2; ++j) { const int id = F.tid + 512 * j;
                sk[j] = *(const GAS v4u*)(QK + (size_t)(b * SEQ + kr * GW + (id >> 4)) * 2048 + 1024 + h * HD + 8 * (id & 15));
                sv[j] = *(const GAS v4u*)(VT + (size_t)(h * HD + (id >> 3)) * MT + b * SEQ + kr * GW + 8 * (id & 7)); }
        };
        auto lstore = [&](int buf) {
            LAS unsigned char* kb = F.lds + buf * AT_STAGE; LAS unsigned char* vb = kb + AT_KBYTES;
#pragma unroll
            for (int j = 0; j < 2; ++j) { const int id = F.tid + 512 * j; const int key = id >> 4, c = id & 15;
                float f[8] = {bflo(sk[j].x), bfhi(sk[j].x), bflo(sk[j].y), bfhi(sk[j].y), bflo(sk[j].z), bfhi(sk[j].z), bflo(sk[j].w), bfhi(sk[j].w)};
                float ss = 0.f;
#pragma unroll
                for (int e = 0; e < 8; ++e) ss += f[e] * f[e];
                ss += __shfl_xor(ss, 1); ss += __shfl_xor(ss, 2); ss += __shfl_xor(ss, 4); ss += __shfl_xor(ss, 8);
                const float rk = rsqrtf(ss * (1.f / HD) + EPS);
                const f32x4 ga = *(const LAS f32x4*)(gtab + 8 * c), gb = *(const LAS f32x4*)(gtab + 8 * c + 4);
                v4u kn; kn.x = pk2(f[0] * rk * ga.x, f[1] * rk * ga.y); kn.y = pk2(f[2] * rk * ga.z, f[3] * rk * ga.w); kn.z = pk2(f[4] * rk * gb.x, f[5] * rk * gb.y); kn.w = pk2(f[6] * rk * gb.z, f[7] * rk * gb.w);
                *(LAS v4u*)(kb + key * 256 + ((c ^ (key & 15)) << 4)) = kn;
                const int d = id >> 3, cv = id & 7; LAS v2u* vp = (LAS v2u*)(vb + d * AT_VPITCH + cv * 16);
                v2u lo, hi; lo.x = sv[j].x; lo.y = sv[j].y; hi.x = sv[j].z; hi.y = sv[j].w; vp[0] = lo; vp[1] = hi; }
        };
        gload(kmin); lstore(0);
        __syncthreads();
#pragma unroll 1
        for (int j = 0; j < nrows; ++j) {
            const int kr = kmin + j, buf = j & 1;
            if (j + 1 < nrows) gload(kr + 1);
            if (kr >= kr0 && kr < kr0 + WR) {
                const LAS unsigned char* kb = F.lds + buf * AT_STAGE; const LAS unsigned char* vb = kb + AT_KBYTES;
                const int dr = kr - r + WR - 1;
                const LAS float* rrow = rt + dr * 128 + rtl;
#pragma unroll
                for (int kt = 0; kt < 2; ++kt) {
                    f32x16 S;
#pragma unroll
                    for (int i = 0; i < 16; ++i) S[i] = 0.f;
                    const int key = 32 * kt + n;
#pragma unroll
                    for (int ks = 0; ks < 8; ++ks) { const bf16x8 kf = *(const LAS bf16x8*)(kb + key * 256 + (((2 * ks + hh) ^ (key & 15)) << 4));
                        S = __builtin_amdgcn_mfma_f32_32x32x16_bf16(kf, qf[ks], S, 0, 0, 0); }
                    float p[16];
#pragma unroll
                    for (int i = 0; i < 16; ++i) { const int E = (i & 3) + 8 * (i >> 2);
                        const float e = __builtin_amdgcn_exp2f(S[i] * qscale + rrow[32 * kt + E]);
                        const unsigned keep = (unsigned)__builtin_amdgcn_sbfe((int)(kt ? wm1 : wm0), E, 1);
                        p[i] = __builtin_bit_cast(float, __builtin_bit_cast(unsigned, e) & keep); lsum += p[i]; }
                    v4u pw0, pw1;
                    pw0.x = pk2(p[0], p[1]); pw0.y = pk2(p[2], p[3]); pw0.z = pk2(p[4], p[5]); pw0.w = pk2(p[6], p[7]);
                    pw1.x = pk2(p[8], p[9]); pw1.y = pk2(p[10], p[11]); pw1.z = pk2(p[12], p[13]); pw1.w = pk2(p[14], p[15]);
                    const bf16x8 pf0 = __builtin_bit_cast(bf16x8, pw0), pf1 = __builtin_bit_cast(bf16x8, pw1);
#pragma unroll
                    for (int dt = 0; dt < 4; ++dt) {
                        const LAS unsigned char* vrow = vb + (32 * dt + n) * AT_VPITCH + (32 * kt + 4 * hh) * 2;
                        const v2u a0 = *(const LAS v2u*)(vrow), a1 = *(const LAS v2u*)(vrow + 16), a2 = *(const LAS v2u*)(vrow + 32), a3 = *(const LAS v2u*)(vrow + 48);
                        v4u f0, f1; f0.x = a0.x; f0.y = a0.y; f0.z = a1.x; f0.w = a1.y; f1.x = a2.x; f1.y = a2.y; f1.z = a3.x; f1.w = a3.y;
                        O[dt] = __builtin_amdgcn_mfma_f32_32x32x16_bf16(__builtin_bit_cast(bf16x8, f0), pf0, O[dt], 0, 0, 0);
                        O[dt] = __builtin_amdgcn_mfma_f32_32x32x16_bf16(__builtin_bit_cast(bf16x8, f1), pf1, O[dt], 0, 0, 0);
                    }
                }
            }
            if (j + 1 < nrows) lstore(buf ^ 1);
            __syncthreads();
        }
        lsum += __shfl_xor(lsum, 32);
        const float il = 1.f / lsum;
        float ss = 0.f;
#pragma unroll
        for (int dt = 0; dt < 4; ++dt)
#pragma unroll
            for (int i = 0; i < 16; ++i) { O[dt][i] *= il; ss += O[dt][i] * O[dt][i]; }
        ss += __shfl_xor(ss, 32);
        const float rr = rsqrtf(ss * (1.f / HD) + EPS);
        bf16* orow = MIXED + (size_t)mq * DM + h * HD;
#pragma unroll
        for (int dt = 0; dt < 4; ++dt)
#pragma unroll
            for (int rg = 0; rg < 4; ++rg) { const int d = 32 * dt + 8 * rg + 4 * hh; const f32x4 gg = *(const GAS f32x4*)(og + h * HD + d);
                v2u w; w.x = pk2(O[dt][4 * rg + 0] * rr * gg.x, O[dt][4 * rg + 1] * rr * gg.y); w.y = pk2(O[dt][4 * rg + 2] * rr * gg.z, O[dt][4 * rg + 3] * rr * gg.w);
                *(GAS v2u*)(orow + d) = w; }
    }
    __syncthreads();
}

__device__ __forceinline__ void phase_p25(Frame& F) {
    const bf16* HYT = (const bf16*)(F.ws + WS_HYT); bf16* MIXED = (bf16*)(F.ws + WS_MIXED); const float* hg = F.in[16];
    LAS float* tile = (LAS float*)F.lds;
    LAS float* rs = (LAS float*)(F.lds + 128 * 65 * 4);
    for (int it = F.bid; it < 8 * (MT / 64); it += F.G) {
        const int gi = it & 7, m0 = (it >> 3) * 64;
        { const int ch = F.tid >> 2, t0 = (F.tid & 3) * 16; const bf16* p = HYT + (size_t)(gi * 128 + ch) * MT + m0 + t0;
          const v4u a = *(const GAS v4u*)p, b = *(const GAS v4u*)(p + 8);
          LAS float* d = tile + ch * 65 + t0;
          d[0] = bflo(a.x); d[1] = bfhi(a.x); d[2] = bflo(a.y); d[3] = bfhi(a.y); d[4] = bflo(a.z); d[5] = bfhi(a.z); d[6] = bflo(a.w); d[7] = bfhi(a.w);
          d[8] = bflo(b.x); d[9] = bfhi(b.x); d[10] = bflo(b.y); d[11] = bfhi(b.y); d[12] = bflo(b.z); d[13] = bfhi(b.z); d[14] = bflo(b.w); d[15] = bfhi(b.w); }
        __syncthreads();
        {
          const int t = F.tid >> 3, c0 = (F.tid & 7) * 16; float ss = 0.f;
#pragma unroll
          for (int c = 0; c < 16; ++c) { const float v = tile[(c0 + c) * 65 + t]; ss += v * v; }
          ss += __shfl_xor(ss, 1); ss += __shfl_xor(ss, 2); ss += __shfl_xor(ss, 4);
          if ((F.tid & 7) == 0) rs[t] = rsqrtf(ss * (1.f / 128) + EPS); }
        __syncthreads();
        {
          const int t = F.tid >> 3, c0 = (F.tid & 7) * 16; const float r = rs[t]; float o[16];
#pragma unroll
          for (int c = 0; c < 16; ++c) o[c] = tile[(c0 + c) * 65 + t] * r * hg[gi * 128 + c0 + c];
          v4u a, b; a.x = pk2(o[0], o[1]); a.y = pk2(o[2], o[3]); a.z = pk2(o[4], o[5]); a.w = pk2(o[6], o[7]); b.x = pk2(o[8], o[9]); b.y = pk2(o[10], o[11]); b.z = pk2(o[12], o[13]); b.w = pk2(o[14], o[15]);
          bf16* q = MIXED + (size_t)(m0 + t) * DM + AW + gi * 128 + c0; *(GAS v4u*)q = a; *(GAS v4u*)(q + 8) = b; }
        __syncthreads();
    }
}
__device__ __forceinline__ void phase_p35(Frame& F) {
    LAS float* wrT = (LAS float*)F.lds;
    const float* wr = F.in[19]; const float* g = F.in[18];
    constexpr int WRS = DM + 4;
    for (int i = F.tid; i < DM * NE; i += NTHREADS) { const int d = i >> 4, e = i & 15; wrT[e * WRS + d] = wr[i]; }
    __syncthreads();
    bf16* HB = (bf16*)(F.ws + WS_HB); float* AFF = (float*)(F.ws + WS_AFF); const float* x1 = F.out;
    f32x4 vn[8];
    { const int m0 = GW_ID(F); if (m0 < MT) { const GAS f32x4* xr = (const GAS f32x4*)(x1 + (size_t)m0 * DM) + F.lane;
#pragma unroll
        for (int j = 0; j < 8; ++j) vn[j] = xr[64 * j]; } }
    for (int m = GW_ID(F); m < MT; m += GW_N(F)) {
        f32x4 v[8]; float s = 0.f;
#pragma unroll
        for (int j = 0; j < 8; ++j) { v[j] = vn[j]; s += (v[j].x * v[j].x + v[j].y * v[j].y) + (v[j].z * v[j].z + v[j].w * v[j].w); }
        if (m + GW_N(F) < MT) { const GAS f32x4* xr = (const GAS f32x4*)(x1 + (size_t)(m + GW_N(F)) * DM) + F.lane;
#pragma unroll
            for (int j = 0; j < 8; ++j) vn[j] = xr[64 * j]; }
        const float r = rsqrtf(wave_sum(s) * (1.f / DM) + EPS);
        GAS v2u* o8 = (GAS v2u*)(HB + (size_t)m * DM) + F.lane;
#pragma unroll
        for (int j = 0; j < 8; ++j) { const f32x4 gg = *((const GAS f32x4*)g + F.lane + 64 * j); v[j].x *= r * gg.x; v[j].y *= r * gg.y; v[j].z *= r * gg.z; v[j].w *= r * gg.w;
            v2u o; o.x = pk2(v[j].x, v[j].y); o.y = pk2(v[j].z, v[j].w); o8[64 * j] = o; }
        float mine = 0.f;
#pragma unroll 1
        for (int e = 0; e < NE; ++e) { float a = 0.f;
#pragma unroll
            for (int j = 0; j < 8; ++j) { const f32x4 w = *((const LAS f32x4*)(wrT + e * WRS) + F.lane + 64 * j); a += (v[j].x * w.x + v[j].y * w.y) + (v[j].z * w.z + v[j].w * w.w); }
            a = wave_sum(a); mine = (F.lane == e) ? a : mine; }
        float mx = mine;
        mx = fmaxf(mx, __shfl_xor(mx, 1)); mx = fmaxf(mx, __shfl_xor(mx, 2)); mx = fmaxf(mx, __shfl_xor(mx, 4)); mx = fmaxf(mx, __shfl_xor(mx, 8));
        const float ex = expf(mine - mx); float den = ex;
        den += __shfl_xor(den, 1); den += __shfl_xor(den, 2); den += __shfl_xor(den, 4); den += __shfl_xor(den, 8);
        const int b = m / SEQ, sidx = m % SEQ;
        if (F.lane < NE) AFF[((size_t)b * NE + F.lane) * SEQ + sidx] = ex / den;
    }
    __syncthreads();
}
__device__ __forceinline__ void phase_p4(Frame& F) {
    LAS unsigned* key = (LAS unsigned*)F.lds;
    LAS unsigned* hist = (LAS unsigned*)(F.lds + 16384);
    LAS unsigned* wsum = (LAS unsigned*)(F.lds + 16384 + 1024);
    const float* AFF = (const float*)(F.ws + WS_AFF); int* IDX = (int*)(F.ws + WS_IDX); float* GATE = (float*)(F.ws + WS_GATE); int* SEL = (int*)(F.ws + WS_SEL);
    for (int be = F.bid; be < NB * NE; be += F.G) {
        const int b = be / NE, e = be % NE;
        __syncthreads();
        const GAS v4u* ap = (const GAS v4u*)(AFF + (size_t)be * SEQ);
        const v4u k0 = ap[2 * F.tid], k1 = ap[2 * F.tid + 1];
        unsigned kk[8] = {k0.x, k0.y, k0.z, k0.w, k1.x, k1.y, k1.z, k1.w};
        unsigned prefix = 0u, mask = 0u, remaining = CAP;
#pragma unroll 1
        for (int pass = 0; pass < 4; ++pass) {
            const int shift = 24 - 8 * pass;
            if (F.tid < 256) hist[F.tid] = 0u;
            __syncthreads();
#pragma unroll
            for (int i = 0; i < 8; ++i) if ((kk[i] & mask) == prefix) __hip_atomic_fetch_add(&hist[(kk[i] >> shift) & 255u], 1u, __ATOMIC_RELAXED, __HIP_MEMORY_SCOPE_WORKGROUP);
            __syncthreads();
            unsigned incl_ = 0u, mine_ = 0u;
            if (F.tid < 256) {
                mine_ = hist[255 - F.tid]; incl_ = mine_;
#pragma unroll
                for (int o = 1; o < 64; o <<= 1) { const unsigned t = __shfl_up(incl_, o); if (F.lane >= o) incl_ += t; }
                if (F.lane == 63) wsum[10 + F.wave] = incl_;
            }
            __syncthreads();
            if (F.tid < 256) {
                unsigned base = 0u;
                for (int w = 0; w < F.wave; ++w) base += wsum[10 + w];
                const unsigned above = base + incl_ - mine_;
                if (above < remaining && remaining <= above + mine_) { wsum[8] = (unsigned)(255 - F.tid); wsum[9] = above; }
            }
            __syncthreads();
            const unsigned d = wsum[8], above = wsum[9];
            prefix |= d << shift; mask |= 255u << shift; remaining -= above;
            __syncthreads();
        }
        const unsigned thr = prefix;
        unsigned cnt = 0u;
#pragma unroll
        for (int i = 0; i < 8; ++i) cnt += (kk[i] > thr ? 0x10000u : 0u) + (kk[i] == thr ? 1u : 0u);
        unsigned incl = cnt;
#pragma unroll
        for (int o = 1; o < 64; o <<= 1) { const unsigned t = __shfl_up(incl, o); if (F.lane >= o) incl += t; }
        if (F.lane == 63) wsum[F.wave] = incl;
        __syncthreads();
        unsigned base = 0u;
        for (int w = 0; w < F.wave; ++w) base += wsum[w];
        unsigned run = base + incl - cnt;
#pragma unroll
        for (int i = 0; i < 8; ++i) {
            const unsigned gt_before = run >> 16, tie_before = run & 0xffffu;
            const bool isgt = kk[i] > thr, istie = kk[i] == thr;
            const bool sel = isgt || (istie && tie_before < remaining);
            const unsigned slot = gt_before + (tie_before < remaining ? tie_before : remaining);
            const int s = 8 * F.tid + i, m = b * SEQ + s;
            if (sel) { IDX[be * CAP + slot] = m; GATE[be * CAP + slot] = __builtin_bit_cast(float, kk[i]); }
            SEL[(size_t)m * NE + e] = sel ? (int)slot : -1;
            run += (isgt ? 0x10000u : 0u) + (istie ? 1u : 0u);
        }
    }
    __syncthreads();
}
__device__ __forceinline__ void phase_p7(Frame& F) {
    const int* SEL = (const int*)(F.ws + WS_SEL); const float* GATE = (const float*)(F.ws + WS_GATE); const bf16* YE = (const bf16*)(F.ws + WS_YE);
    for (int m = GW_ID(F); m < MT; m += GW_N(F)) {
        const int b = m / SEQ;
        GAS f32x4* orow = (GAS f32x4*)(F.out + (size_t)m * DM);
        f32x4 acc[8];
#pragma unroll
        for (int j = 0; j < 8; ++j) acc[j] = orow[2 * F.lane + (j & 1) + 128 * (j >> 1)];
        for (int e = 0; e < NE; ++e) { const int slot = SEL[(size_t)m * NE + e]; if (slot >= 0) {
            const GAS v4u* yr = (const GAS v4u*)(YE + (size_t)((b * NE + e) * CAP + slot) * DM) + F.lane;
#pragma unroll
            for (int jj = 0; jj < 4; ++jj) { const v4u w = yr[64 * jj];
                acc[2 * jj].x += bflo(w.x); acc[2 * jj].y += bfhi(w.x); acc[2 * jj].z += bflo(w.y); acc[2 * jj].w += bfhi(w.y);
                acc[2 * jj + 1].x += bflo(w.z); acc[2 * jj + 1].y += bfhi(w.z); acc[2 * jj + 1].z += bflo(w.w); acc[2 * jj + 1].w += bfhi(w.w); } } }
#pragma unroll
        for (int j = 0; j < 8; ++j) orow[2 * F.lane + (j & 1) + 128 * (j >> 1)] = acc[j];
    }
    (void)GATE;
}

struct Args { const float* in[23]; float* out; unsigned char* ws; int ph_lo, ph_hi; };
enum Phase { PH_P0 = 0, PH_G1, PH_ATTN, PH_P25, PH_OUT, PH_P35, PH_P4, PH_UP, PH_DOWN, PH_P7, PH_COUNT };

__global__ void __launch_bounds__(NTHREADS, 2) mk_fwd(Args args) {
    extern __shared__ __attribute__((aligned(16))) unsigned char lds_raw[];
    Frame F;
    F.lds = (LAS unsigned char*)lds_raw;
    F.tid = threadIdx.x; F.lane = F.tid & 63; F.wave = __builtin_amdgcn_readfirstlane(F.tid >> 6); F.G = gridDim.x; F.bid = blockIdx.x;
#pragma unroll
    for (int i = 0; i < 23; ++i) F.in[i] = args.in[i];
    F.out = args.out; F.ws = args.ws;
    const int lo = args.ph_lo, hi = args.ph_hi;
#define IN(k) (lo <= (k) && (k) < hi)
#define REPS(k) for (int rep_ = 0; rep_ < ((k) == REP_PHASE ? REP_N : 1); ++rep_)
#if MK_N_LAUNCHES == 1
    { volatile LAS unsigned* misc = (volatile LAS unsigned*)(F.lds + LDS_MISC_OFF); if (F.tid < 16) misc[F.tid] = 0u; }
    __syncthreads();
    XcdBarrier bar = xcd_barrier_post(g_bar_words, (volatile LAS unsigned*)(F.lds + LDS_MISC_OFF) + 8);
#define SEAM(k) do { if (IN(k) && IN((k) + 1)) xcd_barrier(bar); } while (0)
#else
#define SEAM(k) do { } while (0)
#endif
    if (IN(PH_P0)) REPS(PH_P0) { phase_p0(F); for (int it = GW_ID(F); it < MOE_P0_ITEMS; it += GW_N(F)) moe_conv_item(F, it); } SEAM(PH_P0);
    if (IN(PH_G1)) REPS(PH_G1) {
        phase_filters(F);
        __syncthreads();
        { pg8::DenseOrder S; S.init(F.ws + WS_HB, F.ws + WS_WIN, MT, 2048, DM, 0, F.G, F.bid);
          pg8::EpiBf16 E{(pg8::bf16_t*)(F.ws + WS_QK), 2048, 0, nullptr};
          pg8::gemm_phase<pg8::EpiBf16, pg8::DenseOrder, true>(F.lds, DM, S, E); }
        { pg8::DenseOrder S; S.init(F.ws + WS_HB, F.ws + WS_WIN, MT, 4096, DM, 8, F.G, F.bid);
          pg8::EpiTransBf16 E{(pg8::bf16_t*)(F.ws + WS_XT), MT, 8};
          pg8::gemm_phase<pg8::EpiTransBf16, pg8::DenseOrder, true>(F.lds, DM, S, E); }
    } SEAM(PH_G1);
    if (IN(PH_ATTN)) { __syncthreads(); for (int rep_ = 0; rep_ < ((PH_ATTN == REP_PHASE && REP_SUB != 2) ? REP_N : 1); ++rep_) phase_hyena(F); for (int rep_ = 0; rep_ < ((PH_ATTN == REP_PHASE && REP_SUB != 1) ? REP_N : 1); ++rep_) phase_attn2(F); } SEAM(PH_ATTN);
    if (IN(PH_P25)) REPS(PH_P25) { __syncthreads(); phase_p25(F); } SEAM(PH_P25);
    if (IN(PH_OUT)) REPS(PH_OUT) {
        __syncthreads();
        pg8::DenseOrder S; S.init(F.ws + WS_MIXED, F.ws + WS_WOUT, MT, DM, DM, 0, F.G, F.bid);
        pg8::EpiResF32 E{F.in[0], F.out, DM};
        pg8::gemm_phase<pg8::EpiResF32, pg8::DenseOrder, false>(F.lds, DM, S, E);
    } SEAM(PH_OUT);
    if (IN(PH_P35)) REPS(PH_P35) { __syncthreads(); phase_p35(F); } SEAM(PH_P35);
    if (IN(PH_P4)) REPS(PH_P4) { __syncthreads(); phase_p4(F);
        if (F.G > NB * NE) { if (F.bid >= NB * NE) conv_range_moe_tail(F); }
        else moe_conv_range(F, MOE_ITEMS - MOE_P4_ITEMS + GW_ID(F), MOE_ITEMS, GW_N(F)); } SEAM(PH_P4);
    if (IN(PH_UP)) REPS(PH_UP) {
        __syncthreads();
        pg8::MoeOrder S; S.init(F.ws + WS_HB, F.ws + WS_WGU, DM, F.G, F.bid, true);
        LAS int* ridx = (LAS int*)(F.lds + 131072);
        { const int* IDX = (const int*)(F.ws + WS_IDX); pg8::Unit u;
          for (int i = 0; S.next(i, u); ++i) if (F.tid < 256) ridx[i * 256 + F.tid] = IDX[u.g * CAP + u.pm * 256 + F.tid]; }
        __syncthreads();
        pg8::EpiSwiGLU E{(pg8::bf16_t*)(F.ws + WS_ACT)};
        pg8::gemm_phase<pg8::EpiSwiGLU, pg8::MoeOrder, true, true>(F.lds, DM, S, E, ridx);
    } SEAM(PH_UP);
    if (IN(PH_DOWN)) REPS(PH_DOWN) {
        __syncthreads();
        pg8::MoeOrder S; S.init(F.ws + WS_ACT, F.ws + WS_WD, FF, F.G, F.bid, false);
        pg8::EpiBf16 E{(pg8::bf16_t*)(F.ws + WS_YE), DM, 512, (const float*)(F.ws + WS_GATE)};
        pg8::gemm_phase<pg8::EpiBf16, pg8::MoeOrder, true>(F.lds, FF, S, E);
    } SEAM(PH_DOWN);
    if (IN(PH_P7)) { phase_p7(F); }
#if MK_N_LAUNCHES == 1
    __syncthreads();
    { volatile LAS unsigned* misc = (volatile LAS unsigned*)(F.lds + LDS_MISC_OFF);
      if (F.tid == 0) misc[0] = (xb_add(&g_bar_words[XCD_BAR_WORDS], 1u) + 1u == (unsigned)F.G) ? 1u : 0u;
      __syncthreads();
      if (misc[0] != 0u && F.tid < (XCD_BAR_WORDS + 64) / 64) __hip_atomic_store(&g_bar_words[64 * F.tid], 0u, __ATOMIC_RELAXED, __HIP_MEMORY_SCOPE_AGENT); }
#endif
#undef IN
#undef SEAM
}

extern "C" void kernel_launch(void* const* d_in, const int* in_sizes, int n_in, void* d_out, int out_size, void* d_ws, size_t ws_size, hipStream_t stream) {
    static int grid = 0;
    if (grid == 0) {
        if (n_in != 23 || ws_size < WS_END) { fprintf(stderr, "kernel_launch: unexpected inputs (n_in %d, ws %zu)\n", n_in, ws_size); grid = -1; return; }
        if (hipFuncSetAttribute((const void*)mk_fwd, hipFuncAttributeMaxDynamicSharedMemorySize, LDS_BYTES) != hipSuccess) { fprintf(stderr, "kernel_launch: hipFuncSetAttribute failed\n"); grid = -1; return; }
        int dev = 0, cus = 0, per_cu = 0;
        hipGetDevice(&dev); hipDeviceGetAttribute(&cus, hipDeviceAttributeMultiprocessorCount, dev);
        hipOccupancyMaxActiveBlocksPerMultiprocessor(&per_cu, (const void*)mk_fwd, NTHREADS, LDS_BYTES);
        (void)hipGetLastError();
        if (per_cu < 1) { fprintf(stderr, "kernel_launch: occupancy query says %d blocks/CU\n", per_cu); }
        grid = cus;
    }
    if (grid < 0) return;
    Args a{};
    for (int i = 0; i < 23; ++i) a.in[i] = (const float*)d_in[i];
    a.out = (float*)d_out; a.ws = (unsigned char*)d_ws;
#if MK_N_LAUNCHES == 1
    a.ph_lo = 0; a.ph_hi = PH_COUNT;
    hipLaunchKernelGGL(mk_fwd, dim3(grid), dim3(NTHREADS), LDS_BYTES, stream, a);
#else
    for (int p = 0; p < PH_COUNT; ++p) { a.ph_lo = p; a.ph_hi = p + 1; hipLaunchKernelGGL(mk_fwd, dim3(grid), dim3(NTHREADS), LDS_BYTES, stream, a); }
#endif
}
```

```cpp
#include <hip/hip_runtime.h>
#include <hip/hip_cooperative_groups.h>
#include <cstdio>
#include <cstdint>
namespace cg = cooperative_groups;

#ifndef REP_PHASE
#define REP_PHASE -1
#define REP_N 1
#define REP_SUB 0
#endif
#ifndef MK_N_LAUNCHES
#define MK_N_LAUNCHES 1
#endif

namespace pg8 {
#define PG8_LAS __attribute__((address_space(3)))
typedef unsigned short bf16_t;
typedef short bf16x8 __attribute__((ext_vector_type(8)));
typedef float f32x4 __attribute__((ext_vector_type(4)));
typedef unsigned u32x4 __attribute__((ext_vector_type(4)));
typedef unsigned u32x2 __attribute__((ext_vector_type(2)));
constexpr int BM = 256, BK = 64, HALF = 128, HTB = HALF * BK * 2, STAGE_BYTES = 8 * HTB, NXCD = 8, WGM = 8;

__host__ __device__ __forceinline__ int lds_byte(int r, int c) { const int st = (r >> 4) * 2 + (c >> 5), rr = r & 15, cc = c & 31, ob = rr * 64 + cc * 2; return st * 1024 + (ob ^ (((ob >> 9) & 1) << 5)); }
__host__ __device__ __forceinline__ void stage_rc(int b, int& R, int& C) { const int st = b / 1024, sb = b % 1024, swz = sb ^ (((sb >> 9) & 1) << 5); R = (st >> 1) * 16 + swz / 64; C = (st & 1) * 32 + (swz % 64) / 2; }
__host__ __device__ __forceinline__ int perm32(int rho) { const int n = rho >> 4, i = rho & 15; return 8 * (i >> 2) + 4 * n + (i & 3); }

struct Unit { int pm, pn, g; const char* a; const char* b; };

__device__ __forceinline__ unsigned cvt_pk_bf16(float lo, float hi) { unsigned r; asm volatile("v_cvt_pk_bf16_f32 %0, %1, %2" : "=v"(r) : "v"(lo), "v"(hi)); return r; }

struct DenseOrder {
    static constexpr bool CHUNK_B = false;
    int nM, nN, nwg, G, c, K, pn0; const char* A; const char* Bt;
    __device__ void init(const void* A_, const void* Bt_, int M, int N, int K_, int pn0_, int G_, int c_) { A = (const char*)A_; Bt = (const char*)Bt_; nM = M / BM; nN = N / BM; nwg = nM * nN; G = G_; c = c_; K = K_; pn0 = pn0_; }
    __device__ bool next(int i, Unit& u) const {
        const long L = (long)i * G + c; if (L >= nwg) return false;
        int wgid = (int)L; { const int q = nwg / NXCD, r = nwg % NXCD, xcd = wgid % NXCD, off = wgid / NXCD; wgid = (xcd < r ? xcd * (q + 1) : r * (q + 1) + (xcd - r) * q) + off; }
        const int nig = WGM * nN, gid = wgid / nig, fm = gid * WGM, gsz = (nM - fm) < WGM ? (nM - fm) : WGM;
        u.pm = fm + ((wgid % nig) % gsz); u.pn = pn0 + (wgid % nig) / gsz; u.g = 0;
        u.a = A + (size_t)u.pm * BM * K * 2; u.b = Bt + (size_t)u.pn * BM * K * 2; return true;
    }
};
struct MoeOrder {
    static constexpr bool CHUNK_B = true;
    int G, c, K; bool gather; const char* A; const char* Bt;
    __device__ void init(const void* A_, const void* Bt_, int K_, int G_, int c_, bool gather_) { A = (const char*)A_; Bt = (const char*)Bt_; K = K_; G = G_; c = c_; gather = gather_; }
    __device__ bool next(int i, Unit& u) const {
        const int L = i * G + c; if (L >= 512) return false;
        int pn, pm, b, e;
        if ((G & 7) == 0 && G >= 64) { const int per = G >> 3, x = c & 7, u = (c >> 3) + i * per;
            pn = u & 7; pm = (u >> 3) & 1; b = (u >> 4) & 1; e = x + 8 * (u >> 5); if (e >= 16) return false; }
        else { pn = L & 7; pm = (L >> 3) & 1; b = (L >> 4) & 1; e = L >> 5; }
        u.pm = pm; u.pn = pn; u.g = b * 16 + e;
        u.a = gather ? A : A + (size_t)(u.g * 512 + pm * BM) * K * 2; u.b = Bt + (size_t)e * 2048 * K * 2 + (size_t)pn * BM * 16; return true;
    }
};

struct EpiBf16 {
    static constexpr bool PERM = true, SWAP = false, INIT = false;
    bf16_t* O; int ldc; int grows; const float* rscale;
    __device__ __forceinline__ void operator()(const f32x4 (&acc)[2][2][4][2], const Unit& u, int wr, int wc, int fr, int fq) const {
        const int row0 = u.g * grows + u.pm * BM + wr * 64 + fr, col0 = u.pn * BM + wc * 32 + 8 * fq;
#pragma unroll
        for (int ai = 0; ai < 2; ++ai)
#pragma unroll
            for (int m = 0; m < 4; ++m) { const int row = row0 + ai * HALF + m * 16; bf16_t* rowp = O + (size_t)row * ldc + col0; const float sc = rscale ? rscale[row] : 1.f;
#pragma unroll
                for (int bj = 0; bj < 2; ++bj) { const f32x4 v0 = acc[ai][bj][m][0] * sc, v1 = acc[ai][bj][m][1] * sc;
                    u32x4 w; w.x = cvt_pk_bf16(v0[0], v0[1]); w.y = cvt_pk_bf16(v0[2], v0[3]); w.z = cvt_pk_bf16(v1[0], v1[1]); w.w = cvt_pk_bf16(v1[2], v1[3]);
                    *(u32x4*)(rowp + bj * HALF) = w; } }
    }
};
struct EpiSwiGLU {
    static constexpr bool PERM = true, SWAP = false, INIT = false;
    bf16_t* O;
    __device__ __forceinline__ void operator()(const f32x4 (&acc)[2][2][4][2], const Unit& u, int wr, int wc, int fr, int fq) const {
        const int row0 = u.g * 512 + u.pm * BM + wr * 64 + fr, col0 = u.pn * HALF + wc * 32 + 8 * fq;
#pragma unroll
        for (int ai = 0; ai < 2; ++ai)
#pragma unroll
            for (int m = 0; m < 4; ++m) { bf16_t* rowp = O + (size_t)(row0 + ai * HALF + m * 16) * 1024 + col0;
                float r[8];
#pragma unroll
                for (int n = 0; n < 2; ++n)
#pragma unroll
                    for (int e = 0; e < 4; ++e) { const float g = acc[ai][0][m][n][e], up = acc[ai][1][m][n][e]; r[n * 4 + e] = g / (1.f + __expf(-g)) * up; }
                u32x4 w; w.x = cvt_pk_bf16(r[0], r[1]); w.y = cvt_pk_bf16(r[2], r[3]); w.z = cvt_pk_bf16(r[4], r[5]); w.w = cvt_pk_bf16(r[6], r[7]);
                *(u32x4*)rowp = w; }
    }
};
struct EpiResF32 {
    static constexpr bool PERM = false, SWAP = false, INIT = true;
    const float* res; float* out; int ldc;
    __device__ __forceinline__ void init(f32x4 (&acc)[2][2][4][2], const Unit& u, int wr, int wc, int fr, int fq) const {
        const int row0 = u.pm * BM + wr * 64 + fr, col0 = u.pn * BM + wc * 32 + 4 * fq;
#pragma unroll
        for (int ai = 0; ai < 2; ++ai)
#pragma unroll
            for (int m = 0; m < 4; ++m) { const size_t off = (size_t)(row0 + ai * HALF + m * 16) * ldc + col0;
#pragma unroll
                for (int bj = 0; bj < 2; ++bj)
#pragma unroll
                    for (int n = 0; n < 2; ++n) acc[ai][bj][m][n] = *(const f32x4*)(res + off + bj * HALF + n * 16); }
    }
    __device__ __forceinline__ void operator()(const f32x4 (&acc)[2][2][4][2], const Unit& u, int wr, int wc, int fr, int fq) const {
        const int row0 = u.pm * BM + wr * 64 + fr, col0 = u.pn * BM + wc * 32 + 4 * fq;
#pragma unroll
        for (int ai = 0; ai < 2; ++ai)
#pragma unroll
            for (int m = 0; m < 4; ++m) { const size_t off = (size_t)(row0 + ai * HALF + m * 16) * ldc + col0;
#pragma unroll
                for (int bj = 0; bj < 2; ++bj)
#pragma unroll
                    for (int n = 0; n < 2; ++n) *(f32x4*)(out + off + bj * HALF + n * 16) = acc[ai][bj][m][n]; }
    }
};
struct EpiTransBf16 {
    static constexpr bool PERM = false, SWAP = true, INIT = false;
    bf16_t* O; int ldt; int pn_base;
    __device__ __forceinline__ void operator()(const f32x4 (&acc)[2][2][4][2], const Unit& u, int wr, int wc, int fr, int fq) const {
        const int ch0 = (u.pn - pn_base) * BM + wc * 32 + fr, t0 = u.pm * BM + wr * 64 + 4 * fq;
#pragma unroll
        for (int bj = 0; bj < 2; ++bj)
#pragma unroll
            for (int n = 0; n < 2; ++n) { bf16_t* chp = O + (size_t)(ch0 + bj * HALF + n * 16) * ldt + t0;
#pragma unroll
                for (int ai = 0; ai < 2; ++ai)
#pragma unroll
                    for (int m = 0; m < 4; ++m) { const f32x4 v = acc[ai][bj][m][n]; u32x2 w; w.x = cvt_pk_bf16(v[0], v[1]); w.y = cvt_pk_bf16(v[2], v[3]); *(u32x2*)(chp + ai * HALF + m * 16) = w; } }
    }
};

template <class Epi, class Sched, bool ALIGN_EPI = false, bool GATHER = false>
__device__ __forceinline__ void gemm_phase(PG8_LAS unsigned char* lds, const int K, const Sched& S, const Epi& E, const PG8_LAS int* ridx = nullptr) {
    const int tid = threadIdx.x, wid = __builtin_amdgcn_readfirstlane(tid >> 6), lane = tid & 63, wr = wid >> 2, wc = wid & 3, fr = lane & 15, fq = lane >> 4;
    const int nt = K / BK;
    unsigned vA0[2], vA1[2], vN0[2], vN1[2], voffB[2]; int stR[2], stC[2];
    const size_t kstep = (size_t)(BK * 2);
    const size_t hstep = (size_t)HALF * K * 2;
    const size_t kstepB = Sched::CHUNK_B ? (size_t)(BK / 8) * 2048 * 16 : kstep, hstepB = Sched::CHUNK_B ? (size_t)HALF * 16 : hstep;
#pragma unroll
    for (int i = 0; i < 2; ++i) { int R, C; stage_rc(tid * 16 + i * 8192, R, C); const int Rb = Epi::PERM ? ((R & ~31) + perm32(R & 31)) : R; stR[i] = R; stC[i] = C;
        voffB[i] = Sched::CHUNK_B ? (unsigned)(((C >> 3) * 2048 + Rb) * 16) : (unsigned)(Rb * K + C) * 2u;
        if constexpr (GATHER) { vA0[i] = (unsigned)(ridx[R] * K + C) * 2u; vA1[i] = (unsigned)(ridx[HALF + R] * K + C) * 2u; }
        else { vA0[i] = (unsigned)(R * K + C) * 2u; vA1[i] = vA0[i] + (unsigned)hstep; }
        vN0[i] = vA0[i]; vN1[i] = vA1[i]; }
    const unsigned ldsw = (unsigned)wid * 1024u;
    const int aoff = lds_byte(wr * 64 + fr, fq * 8), boff = lds_byte(wc * 32 + fr, fq * 8);
#define PG8_SA(b, h) (((b) * 2 + (h)) * HTB)
#define PG8_SB(b, h) ((4 + (b) * 2 + (h)) * HTB)
#define PG8_STAGE(bufoff, gbase, voff) do { _Pragma("unroll") for (int _i = 0; _i < 2; ++_i) \
        __builtin_amdgcn_global_load_lds((const unsigned*)((const char*)(gbase) + (voff)[_i]), (PG8_LAS unsigned*)(lds + (bufoff) + ldsw + _i * 8192), 16, 0, 0); } while (0)
#define PG8_LDA(dst, b, h) do { _Pragma("unroll") for (int m = 0; m < 4; ++m) _Pragma("unroll") for (int k = 0; k < 2; ++k) dst[m][k] = *(const PG8_LAS bf16x8*)(lds + PG8_SA(b, h) + aoff + m * 2048 + k * 1024); } while (0)
#define PG8_LDB(dst, b, h) do { _Pragma("unroll") for (int n = 0; n < 2; ++n) _Pragma("unroll") for (int k = 0; k < 2; ++k) dst[n][k] = *(const PG8_LAS bf16x8*)(lds + PG8_SB(b, h) + boff + n * 2048 + k * 1024); } while (0)
#define PG8_MMA(ai, bj, At, Bt) do { __builtin_amdgcn_s_setprio(1); _Pragma("unroll") for (int m = 0; m < 4; ++m) _Pragma("unroll") for (int n = 0; n < 2; ++n) _Pragma("unroll") for (int k = 0; k < 2; ++k) \
        acc[ai][bj][m][n] = Epi::SWAP ? __builtin_amdgcn_mfma_f32_16x16x32_bf16(At[m][k], Bt[n][k], acc[ai][bj][m][n], 0, 0, 0) : __builtin_amdgcn_mfma_f32_16x16x32_bf16(Bt[n][k], At[m][k], acc[ai][bj][m][n], 0, 0, 0); __builtin_amdgcn_s_setprio(0); } while (0)
#define PG8_WAIT_V(n) asm volatile("s_waitcnt vmcnt(" #n ")" ::: "memory")
#define PG8_WAIT_L(n) asm volatile("s_waitcnt lgkmcnt(" #n ")" ::: "memory")
#define PG8_BAR __builtin_amdgcn_s_barrier()
#define PG8_SCHED __builtin_amdgcn_sched_barrier(0)
    Unit cur, nxt; int ui = 0;
    if (!S.next(0, cur)) return;
    f32x4 acc[2][2][4][2];
    if constexpr (Epi::INIT) E.init(acc, cur, wr, wc, fr, fq);
    else {
#pragma unroll
    for (int a = 0; a < 2; ++a)
#pragma unroll
        for (int b = 0; b < 2; ++b)
#pragma unroll
            for (int m = 0; m < 4; ++m)
#pragma unroll
                for (int n = 0; n < 2; ++n) acc[a][b][m][n] = (f32x4){0.f, 0.f, 0.f, 0.f};
    }
    bf16x8 At[4][2], B0[2][2], B1[2][2];
    const char* cA = cur.a; const char* cB = cur.b;
    PG8_STAGE(PG8_SB(0, 0), cB, voffB); PG8_STAGE(PG8_SB(0, 1), cB + hstepB, voffB); PG8_STAGE(PG8_SA(0, 0), cA, vA0); PG8_STAGE(PG8_SA(0, 1), cA, vA1);
    if (wr == 1) PG8_BAR;
    PG8_WAIT_V(2); PG8_BAR;
    PG8_STAGE(PG8_SB(1, 0), cB + kstepB, voffB); PG8_STAGE(PG8_SA(1, 0), cA + kstep, vA0); PG8_STAGE(PG8_SB(1, 1), cB + hstepB + kstepB, voffB);
    PG8_WAIT_V(6); PG8_BAR;
    for (;;) {
        const bool has_next = S.next(ui + 1, nxt);
        const char* nA = has_next ? nxt.a : cA; const char* nB = has_next ? nxt.b : cB;
        if constexpr (GATHER) { if (has_next) {
#pragma unroll
            for (int i = 0; i < 2; ++i) { vN0[i] = (unsigned)(ridx[(ui + 1) * 256 + stR[i]] * K + stC[i]) * 2u; vN1[i] = (unsigned)(ridx[(ui + 1) * 256 + HALF + stR[i]] * K + stC[i]) * 2u; } } }
        for (int t = 0; t < nt; t += 2) {
            const bool last = (t == nt - 2);
            const char* a1 = cA + (size_t)(t + 1) * kstep;
            const char* a2 = last ? nA : cA + (size_t)(t + 2) * kstep; const char* b2 = last ? nB : cB + (size_t)(t + 2) * kstepB;
            const char* a3 = a2 + kstep; const char* b3 = b2 + kstepB;
            unsigned w0[2], w1[2];
#pragma unroll
            for (int i = 0; i < 2; ++i) { w0[i] = last ? vN0[i] : vA0[i]; w1[i] = last ? vN1[i] : vA1[i]; }
            PG8_LDB(B0, 0, 0); PG8_LDB(B1, 0, 1); PG8_SCHED; PG8_LDA(At, 0, 0); PG8_STAGE(PG8_SA(1, 1), a1, vA1);
            PG8_WAIT_V(8); PG8_WAIT_L(0); PG8_BAR; PG8_MMA(0, 0, At, B0); PG8_MMA(0, 1, At, B1); PG8_BAR; PG8_SCHED;
            PG8_LDA(At, 0, 1); PG8_STAGE(PG8_SB(0, 0), b2, voffB); PG8_STAGE(PG8_SB(0, 1), b2 + hstepB, voffB); PG8_STAGE(PG8_SA(0, 0), a2, w0);
            PG8_WAIT_V(8); PG8_WAIT_L(0); PG8_BAR; PG8_MMA(1, 0, At, B0); PG8_MMA(1, 1, At, B1); PG8_BAR; PG8_SCHED;
            PG8_LDB(B0, 1, 0); PG8_LDB(B1, 1, 1); PG8_SCHED; PG8_LDA(At, 1, 0); PG8_STAGE(PG8_SA(0, 1), a2, w1);
            PG8_WAIT_V(8); PG8_WAIT_L(0); PG8_BAR; PG8_MMA(0, 0, At, B0); PG8_MMA(0, 1, At, B1); PG8_BAR; PG8_SCHED;
            PG8_LDA(At, 1, 1); PG8_STAGE(PG8_SB(1, 0), b3, voffB); PG8_STAGE(PG8_SB(1, 1), b3 + hstepB, voffB); PG8_STAGE(PG8_SA(1, 0), a3, w0);
            PG8_WAIT_V(8); PG8_WAIT_L(0); PG8_BAR; PG8_MMA(1, 0, At, B0); PG8_MMA(1, 1, At, B1); PG8_BAR; PG8_SCHED;
        }
        if constexpr (ALIGN_EPI) { if (wr == 0) PG8_BAR; }
        E(acc, cur, wr, wc, fr, fq);
        if (!has_next) break;
        if constexpr (Epi::INIT) E.init(acc, nxt, wr, wc, fr, fq);
        else {
#pragma unroll
        for (int a = 0; a < 2; ++a)
#pragma unroll
            for (int b = 0; b < 2; ++b)
#pragma unroll
                for (int m = 0; m < 4; ++m)
#pragma unroll
                    for (int n = 0; n < 2; ++n) acc[a][b][m][n] = (f32x4){0.f, 0.f, 0.f, 0.f};
        }
        cur = nxt; cA = nA; cB = nB; ++ui;
#pragma unroll
        for (int i = 0; i < 2; ++i) { vA0[i] = vN0[i]; vA1[i] = vN1[i]; }
        if constexpr (ALIGN_EPI) { if (wr == 1) PG8_BAR; }
    }
    PG8_WAIT_V(0);
    if constexpr (!ALIGN_EPI) { if (wr == 0) PG8_BAR; }
    PG8_BAR;
#undef PG8_SA
#undef PG8_SB
#undef PG8_STAGE
#undef PG8_LDA
#undef PG8_LDB
#undef PG8_MMA
#undef PG8_WAIT_V
#undef PG8_WAIT_L
#undef PG8_BAR
#undef PG8_SCHED
}
}

constexpr int NB = 2, SEQ = 4096, DM = 2048, MT = NB * SEQ;
constexpr int NH = 8, HD = 128, AW = 1024, HW = 1024, INW = 6144;
constexpr int GW = 64, NROWS = 64, WR = 8, WC = 16;
constexpr int NE = 16, CAP = 512, FF = 1024;
constexpr int FEMB = 33, FHID = 64;
constexpr float EPS = 1e-6f;
constexpr int NWAVES = 8, NTHREADS = 512;

constexpr size_t MiB = 1u << 20;
constexpr size_t WS_CTL = 0, CTL_ZERO_BYTES = 32768;
constexpr size_t WS_WIN = 2 * MiB;
constexpr size_t WS_WOUT = 26 * MiB;
constexpr size_t WS_WGU = 34 * MiB;
constexpr size_t WS_WD = 162 * MiB;
constexpr size_t WS_W3T = 226 * MiB;
constexpr size_t WS_HID2 = 227 * MiB;
constexpr size_t WS_HB = 228 * MiB;
constexpr size_t WS_QK = 260 * MiB;
constexpr size_t WS_XT = 292 * MiB;
constexpr size_t WS_UC = 356 * MiB;
constexpr size_t WS_TAPS = 404 * MiB;
constexpr size_t WS_HYT = 436 * MiB;
constexpr size_t WS_MIXED = 452 * MiB;
constexpr size_t WS_AFF = 484 * MiB;
constexpr size_t WS_IDX = 485 * MiB;
constexpr size_t WS_GATE = 486 * MiB;
constexpr size_t WS_SEL = 487 * MiB;
constexpr size_t WS_Z1T = 488 * MiB;
constexpr size_t WS_XG = WS_XT;
constexpr size_t WS_ACT = WS_UC;
constexpr size_t WS_YE = WS_TAPS;
constexpr size_t WS_END = 504 * MiB;

constexpr int LDS_BYTES = 163840, LDS_MISC_OFF = 163840 - 128;

#define GAS __attribute__((address_space(1)))
#define LAS __attribute__((address_space(3)))
typedef unsigned short bf16;
typedef unsigned v4u __attribute__((ext_vector_type(4)));
typedef unsigned v2u __attribute__((ext_vector_type(2)));
typedef float f32x4 __attribute__((ext_vector_type(4)));
#define LDS_WAIT() asm volatile("s_waitcnt lgkmcnt(0)" ::: "memory")
#define VM_WAIT() asm volatile("s_waitcnt vmcnt(0)" ::: "memory")
__device__ __forceinline__ unsigned f2bf(float f) { unsigned u = __builtin_bit_cast(unsigned, f); return (u + 0x7fffu + ((u >> 16) & 1u)) >> 16; }
__device__ __forceinline__ unsigned pk2(float lo, float hi) { unsigned r; asm("v_cvt_pk_bf16_f32 %0, %1, %2" : "=v"(r) : "v"(lo), "v"(hi)); return r; }
__device__ __forceinline__ float bf2f(unsigned h) { return __builtin_bit_cast(float, h << 16); }
__device__ __forceinline__ float bflo(unsigned w) { return __builtin_bit_cast(float, w << 16); }
__device__ __forceinline__ float bfhi(unsigned w) { return __builtin_bit_cast(float, w & 0xffff0000u); }
__device__ __forceinline__ float wave_sum(float v) {
#pragma unroll
    for (int o = 1; o < 64; o <<= 1) v += __shfl_xor(v, o);
    return v;
}


#define XB_TMO      128
#define XB_XCNT(j)  (256  + 64 * (j))
#define XB_XSUB(j)  (1280 + 64 * (j))
#define XB_XGEN(j)  (2304 + 64 * (j))
#define XB_TOP      3328
#define XB_TOPGEN   3392
#define XCD_BAR_WORDS 3456
#define XB_SPIN_CAP (1u << 22)
__device__ __forceinline__ unsigned xb_ld(unsigned* p)              { return __hip_atomic_load(p, __ATOMIC_RELAXED, __HIP_MEMORY_SCOPE_AGENT); }
__device__ __forceinline__ unsigned xb_add(unsigned* p, unsigned v) { return __hip_atomic_fetch_add(p, v, __ATOMIC_RELAXED, __HIP_MEMORY_SCOPE_AGENT); }
__device__ __forceinline__ unsigned xb_xcc_id() { return (unsigned)__builtin_amdgcn_s_getreg((3 << 11) | 20) & 0xFu; }
#define XB_SPIN(cond, bar) do { unsigned _sp = 0; while (cond) { __builtin_amdgcn_s_sleep(1); \
    if ((++_sp & 255u) == 0u) { if (xb_ld(&(bar)[XB_TMO])) break; if (_sp > XB_SPIN_CAP) { atomicAdd(&(bar)[XB_TMO], 1u); break; } } } } while (0)
struct XcdBarrier { unsigned* bar; unsigned x; volatile LAS unsigned* st; };
__device__ __forceinline__ XcdBarrier xcd_barrier_post(unsigned* bar, volatile LAS unsigned* st) {
    XcdBarrier b; b.bar = bar; b.x = xb_xcc_id(); b.st = st;
    if (threadIdx.x == 0) (void)xb_add(&bar[XB_XCNT(b.x)], 1u);
    return b;
}
__device__ __forceinline__ void xcd_barrier_complete(unsigned* bar, unsigned x, unsigned& nloc, unsigned& nx) {
    const unsigned G = gridDim.x * gridDim.y * gridDim.z;
    unsigned sum, cnt, mine, sp = 0u;
    for (;;) {
        sum = 0u; cnt = 0u; mine = 0u;
#pragma unroll
        for (unsigned j = 0; j < 16; ++j) { const unsigned c = xb_ld(&bar[XB_XCNT(j)]); sum += c; cnt += (c > 0u) ? 1u : 0u; mine = (j == x) ? c : mine; }
        if (sum == G) break;
        __builtin_amdgcn_s_sleep(1);
        if ((++sp & 255u) == 0u) { if (xb_ld(&bar[XB_TMO])) break; if (sp > XB_SPIN_CAP) { atomicAdd(&bar[XB_TMO], 1u); break; } }
    }
    nloc = mine > 0u ? mine : 1u; nx = cnt > 0u ? cnt : 1u;
}
__device__ __forceinline__ void xcd_barrier(const XcdBarrier& b) {
    asm volatile("s_waitcnt vmcnt(0)" ::: "memory");
    __syncthreads();
    if (threadIdx.x == 0) {
        unsigned* bar = b.bar;
        __builtin_amdgcn_s_waitcnt(0);
        unsigned nloc = b.st[0], nx = b.st[1];
        if (nloc == 0u) { xcd_barrier_complete(bar, b.x, nloc, nx); b.st[0] = nloc; b.st[1] = nx; }
        const unsigned old = xb_add(&bar[XB_XSUB(b.x)], 1u);
        const unsigned gen = old / nloc;
        if (old + 1u == (gen + 1u) * nloc) {
            __builtin_amdgcn_fence(__ATOMIC_RELEASE, "agent");
            asm volatile("s_waitcnt vmcnt(0)" ::: "memory");
            const unsigned og = xb_add(&bar[XB_TOP], 1u);
            const unsigned tg = og / nx;
            if (og + 1u == (tg + 1u) * nx) xb_add(&bar[XB_TOPGEN], 1u);
            else XB_SPIN(xb_ld(&bar[XB_TOPGEN]) == tg, bar);
            __builtin_amdgcn_fence(__ATOMIC_ACQUIRE, "agent");
            xb_add(&bar[XB_XGEN(b.x)], 1u);
            asm volatile("s_waitcnt vmcnt(0)" ::: "memory");
        } else {
            XB_SPIN(xb_ld(&bar[XB_XGEN(b.x)]) == gen, bar);
            __builtin_amdgcn_fence(__ATOMIC_ACQUIRE, "agent");
            asm volatile("s_waitcnt vmcnt(0)" ::: "memory");
        }
    }
    __syncthreads();
}

__device__ unsigned g_bar_words[XCD_BAR_WORDS + 64];
struct Frame {
    LAS unsigned char* lds;
    int tid, lane, wave, G, bid;
    const float* in[23]; float* out; unsigned char* ws;
};
#define GW_ID(F) ((F).bid * NWAVES + (F).wave)
#define GW_N(F) ((F).G * NWAVES)

__device__ __forceinline__ void p0_transpose_item(const float* W, int K, int N, bf16* WT, int row_base, int k0, int n0, LAS float* scr, int lane) {
    float t_[32];
#pragma unroll
    for (int i = 0; i < 32; ++i) { const int kk = 2 * i + (lane >> 5); t_[i] = W[(size_t)(k0 + kk) * N + n0 + (lane & 31)]; }
#pragma unroll
    for (int i = 0; i < 32; ++i) { const int kk = 2 * i + (lane >> 5); scr[kk * 33 + (lane & 31)] = t_[i]; }
    LDS_WAIT(); asm volatile("" ::: "memory");
    const int c = lane & 7;
#pragma unroll
    for (int j = 0; j < 4; ++j) { const int n = (lane >> 3) + 8 * j; const LAS float* s = scr + (8 * c) * 33 + n;
        v4u o; o.x = pk2(s[0 * 33], s[1 * 33]); o.y = pk2(s[2 * 33], s[3 * 33]); o.z = pk2(s[4 * 33], s[5 * 33]); o.w = pk2(s[6 * 33], s[7 * 33]);
        *(GAS v4u*)(WT + (size_t)(row_base + n) * K + k0 + 8 * c) = o; }
    LDS_WAIT(); asm volatile("" ::: "memory");
}
__device__ __forceinline__ void phase_p0(Frame& F) {
    LAS float* scr = (LAS float*)(F.lds + F.wave * 16384);
    const int gw = GW_ID(F), NGW = GW_N(F);
    bf16* WinT = (bf16*)(F.ws + WS_WIN); bf16* WoutT = (bf16*)(F.ws + WS_WOUT); bf16* W3T = (bf16*)(F.ws + WS_W3T);
    constexpr int I_IN = (DM / 64) * (INW / 32), I_OUT = (DM / 64) * (DM / 32), I_3 = 1 * (4096 / 32);
    constexpr int NITEMS = I_IN + I_OUT + I_3;
    for (int it = gw; it < NITEMS; it += NGW) {
        int r = it;
        if (r < I_IN) { const int nblk = INW / 32, kb = r / nblk, nb = r % nblk; p0_transpose_item(F.in[2], DM, INW, WinT, 32 * nb, 64 * kb, 32 * nb, scr, F.lane); continue; } r -= I_IN;
        if (r < I_OUT) { const int nblk = DM / 32, kb = r / nblk, nb = r % nblk; p0_transpose_item(F.in[17], DM, DM, WoutT, 32 * nb, 64 * kb, 32 * nb, scr, F.lane); continue; } r -= I_OUT;
        { const int nb = r; p0_transpose_item(F.in[12], FHID, 4096, W3T, 32 * nb, 0, 32 * nb, scr, F.lane); }
    }
    bf16* HB = (bf16*)(F.ws + WS_HB);
    const float* x = F.in[0]; const float* g = F.in[1];
    f32x4 vn[8];
    if (gw < MT) { const GAS f32x4* xr = (const GAS f32x4*)(x + (size_t)gw * DM) + F.lane;
#pragma unroll
        for (int j = 0; j < 8; ++j) vn[j] = xr[64 * j]; }
    for (int m = gw; m < MT; m += NGW) {
        f32x4 v[8]; float s = 0.f;
#pragma unroll
        for (int j = 0; j < 8; ++j) { v[j] = vn[j]; s += (v[j].x * v[j].x + v[j].y * v[j].y) + (v[j].z * v[j].z + v[j].w * v[j].w); }
        if (m + NGW < MT) { const GAS f32x4* xr = (const GAS f32x4*)(x + (size_t)(m + NGW) * DM) + F.lane;
#pragma unroll
            for (int j = 0; j < 8; ++j) vn[j] = xr[64 * j]; }
        const float r = rsqrtf(wave_sum(s) * (1.f / DM) + EPS);
        GAS v2u* o8 = (GAS v2u*)(HB + (size_t)m * DM) + F.lane;
#pragma unroll
        for (int j = 0; j < 8; ++j) { const f32x4 gg = *((const GAS f32x4*)g + F.lane + 64 * j); v2u o; o.x = pk2(v[j].x * r * gg.x, v[j].y * r * gg.y); o.y = pk2(v[j].z * r * gg.z, v[j].w * r * gg.w); o8[64 * j] = o; }
    }
    float* HID2 = (float*)(F.ws + WS_HID2);
    LAS float* sc2 = (LAS float*)(F.lds + F.wave * 16384);
    const float* w1 = F.in[8]; const float* b1 = F.in[9]; const float* w2 = F.in[10]; const float* b2 = F.in[11]; const float* fr = F.in[13];
    float w1c[FEMB], w2c[FHID];
    { const int j = F.lane;
#pragma unroll
      for (int i = 0; i < FEMB; ++i) w1c[i] = w1[i * FHID + j];
#pragma unroll
      for (int i = 0; i < FHID; ++i) w2c[i] = w2[i * FHID + j]; }
    for (int l = gw; l < SEQ; l += NGW) {
        const int j = F.lane;
        float zv = 0.f;
        if (j == 0) zv = (float)l / (float)(SEQ - 1);
        else if (j < FEMB) { const int k = (j - 1) & 15; const float f = 1e-4f + (float)k * ((15.0f - 1e-4f) / 15.0f); const float wv = 6.283185307179586f * (float)l / (float)SEQ; zv = (j <= 16) ? cosf(f * wv) : -sinf(f * wv); }
        sc2[j] = zv; LDS_WAIT(); asm volatile("" ::: "memory");
        float a = b1[j];
#pragma unroll
        for (int i = 0; i < FEMB; ++i) a += sc2[i] * w1c[i];
        const float h1 = sinf(fr[j] * a);
        sc2[64 + j] = h1; LDS_WAIT(); asm volatile("" ::: "memory");
        float c = b2[j];
#pragma unroll
        for (int i = 0; i < FHID; ++i) c += sc2[64 + i] * w2c[i];
        HID2[l * FHID + j] = sinf(fr[j] * c);
        LDS_WAIT(); asm volatile("" ::: "memory");
    }
}

typedef short bf16x8 __attribute__((ext_vector_type(8)));
typedef float f32x16 __attribute__((ext_vector_type(16)));
__device__ __forceinline__ void phase_filters(Frame& F) {
    const float* HID2 = (const float*)(F.ws + WS_HID2); const bf16* W3T = (const bf16*)(F.ws + WS_W3T); const float* fbias = F.in[14]; bf16* TAPS = (bf16*)(F.ws + WS_TAPS);
    const int n = F.lane & 31, hh = F.lane >> 5;
    const float mind = -4.605170185988091f / 1.5f, maxd = -4.605170185988091f / 0.3f;
    LAS bf16* scr = (LAS bf16*)(F.lds + F.wave * 4096);
    for (int task = GW_ID(F); task < 128 * 16; task += GW_N(F)) {
        const int l0 = (task & 127) * 32, cg = task >> 7;
        const int dir = (cg >> 2) & 1, o = cg >> 3;
        const int l = l0 + dir + n;
        bf16x8 hb[4];
        { const int lr = l < SEQ ? l : SEQ - 1;
#pragma unroll
          for (int ks = 0; ks < 4; ++ks) { const GAS f32x4* hp = (const GAS f32x4*)(HID2 + (size_t)lr * FHID + 16 * ks + 8 * hh); const f32x4 h0 = hp[0], h1 = hp[1];
              v4u bw; bw.x = pk2(h0.x, h0.y); bw.y = pk2(h0.z, h0.w); bw.z = pk2(h1.x, h1.y); bw.w = pk2(h1.z, h1.w); hb[ks] = __builtin_bit_cast(bf16x8, bw); } }
        const float t = (float)l / (float)(SEQ - 1);
        const int pos = dir ? 31 - n : n;
        const int idx0 = dir ? 4064 - l0 : 4096 + l0;
#pragma unroll 2
        for (int ct = 0; ct < 8; ++ct) {
            const int col0 = (cg * 8 + ct) * 32;
            f32x16 acc;
#pragma unroll
            for (int i = 0; i < 16; ++i) acc[i] = 0.f;
#pragma unroll
            for (int ks = 0; ks < 4; ++ks) { const bf16x8 a = *(const GAS bf16x8*)(W3T + (size_t)(col0 + n) * FHID + 16 * ks + 8 * hh);
                acc = __builtin_amdgcn_mfma_f32_32x32x16_bf16(a, hb[ks], acc, 0, 0, 0); }
#pragma unroll
            for (int i = 0; i < 16; ++i) {
                const int chl = (i & 3) + 8 * (i >> 2) + 4 * hh, c = (col0 & 1023) + chl;
                const float delta = fabsf(mind + (maxd - mind) * ((float)c / 1023.0f));
                float v = acc[i] * __expf(-t * delta);
                if (dir == 0 && l == 0) v += fbias[o * 1024 + c];
                if (l >= SEQ) v = 0.f;
                scr[chl * 40 + pos] = (bf16)f2bf(v);
            }
            LDS_WAIT(); asm volatile("" ::: "memory");
#pragma unroll
            for (int j = 0; j < 2; ++j) { const int id = F.lane + 64 * j, chl = id >> 2, q = id & 3;
                const v4u w = *(const LAS v4u*)(scr + chl * 40 + 8 * q);
                *(GAS v4u*)(TAPS + ((size_t)((col0 & 1023) + chl) * 2 + o) * 8192 + idx0 + 8 * q) = w; }
            LDS_WAIT(); asm volatile("" ::: "memory");
        }
    }
}

constexpr int HY_TAPS_BYTES = 4 * 16384, HY_ZB_ENT = 6080, HY_ZB_BYTES = 12288;
__device__ __forceinline__ unsigned hy_zb_off(int idx0  ) { const int q = idx0 >> 3; return (unsigned)((q ^ ((q >> 4) & 3)) << 4); }
__device__ __forceinline__ const LAS unsigned char* hy_pm(const LAS unsigned char* zbl  , int g, int ip, int hh) {
    const int q0 = 124 - 4 * ip + 2 * g + hh;
    unsigned p = (unsigned)(size_t)zbl + (unsigned)(((q0 ^ ((q0 >> 4) & 3)) << 4) - 7168);
    asm volatile("" : "+v"(p));
    return (const LAS unsigned char*)(size_t)p;
}
template <int MASK>
__device__ __forceinline__ void hy_loadB(bf16x8 (&bf)[8], const LAS unsigned char* pm) {
#pragma unroll
    for (int tau = 0; tau < 8; ++tau) if (MASK & (1 << tau)) bf[tau] = *(const LAS bf16x8*)(pm + 1024 * (7 - tau));
}
__device__ __forceinline__ void hy_loadA(unsigned (&d)[5], const LAS bf16* taps, int g, int n, int hh) {
    const volatile LAS unsigned* dp = (const volatile LAS unsigned*)taps + ((1 + 8 * hh + n) >> 1) + 8 * g;
#pragma unroll
    for (int i = 0; i < 5; ++i) d[i] = dp[i];
}
template <int MASK>
__device__ __forceinline__ void hy_mma(f32x16 (&acc)[8], const bf16x8 a, const bf16x8 (&bf)[8]) {
#pragma unroll
    for (int tau = 0; tau < 8; ++tau) if (MASK & (1 << tau)) acc[tau] = __builtin_amdgcn_mfma_f32_32x32x16_bf16(a, bf[tau], acc[tau], 0, 0, 0);
}
#define HY_ALIGN(a, d) do { v4u aw_; aw_.x = __builtin_amdgcn_alignbyte(d[1], d[0], sh); aw_.y = __builtin_amdgcn_alignbyte(d[2], d[1], sh); aw_.z = __builtin_amdgcn_alignbyte(d[3], d[2], sh); aw_.w = __builtin_amdgcn_alignbyte(d[4], d[3], sh); a = __builtin_bit_cast(bf16x8, aw_); } while (0)
#define HY_INTERLEAVE() do { __builtin_amdgcn_sched_group_barrier(0x2, 4, 0); _Pragma("unroll") for (int i_ = 0; i_ < 9; ++i_) { __builtin_amdgcn_sched_group_barrier(0x8, 1, 0); __builtin_amdgcn_sched_group_barrier(0x100, 3, 0); __builtin_amdgcn_sched_group_barrier(0x2, 3, 0); } } while (0)
constexpr int HY_YOFF = 254;
template <int MASK>
__device__ __forceinline__ void hy_mma_reload(f32x16 (&acc)[8], const bf16x8 a, bf16x8 (&bf)[8], const LAS unsigned char* pm_next) {
#pragma unroll
    for (int tau = 0; tau < 8; ++tau) if (MASK & (1 << tau)) {
        acc[tau] = __builtin_amdgcn_mfma_f32_32x32x16_bf16(a, bf[tau], acc[tau], 0, 0, 0);
        bf[tau] = *(const LAS bf16x8*)(pm_next + 1024 * (7 - tau));
    }
}
template <int MX, int MY>
__device__ __forceinline__ void hy_segment(f32x16 (&acc)[8], const LAS bf16* taps, const LAS unsigned char* zbl, int i0, int i1, int n, int hh) {
    const unsigned sh = (n & 1) ? 0u : 2u;
    const int ip = n & 15;
    unsigned dx[5], dy[5]; bf16x8 a, x0[8], y0[8];
    hy_loadA(dx, taps, i0, n, hh); hy_loadA(dy, taps, i0 + HY_YOFF, n, hh); hy_loadB<MX>(x0, hy_pm(zbl, i0, ip, hh)); hy_loadB<MY>(y0, hy_pm(zbl, i0 + HY_YOFF, ip, hh));
#pragma unroll 1
    for (int i = i0; i < i1; ++i) {
        if (MX) { HY_ALIGN(a, dx); hy_loadA(dx, taps, i + 1, n, hh); hy_mma_reload<MX>(acc, a, x0, hy_pm(zbl, i + 1, ip, hh)); }
        HY_ALIGN(a, dy); hy_loadA(dy, taps, i + 1 + HY_YOFF, n, hh); hy_mma_reload<MY>(acc, a, y0, hy_pm(zbl, i + 1 + HY_YOFF, ip, hh));
        HY_INTERLEAVE(); __builtin_amdgcn_sched_barrier(0);
    }
}
__device__ __forceinline__ void hy_stage_taps(Frame& F, int c0, int o) {
    const bf16* TAPS = (const bf16*)(F.ws + WS_TAPS);
    int tid = F.tid; asm volatile("" : "+v"(tid));
#pragma unroll
    for (int j = 0; j < 8; ++j) { const int ch = tid + NTHREADS * j, ci = ch >> 10, w = ch & 1023;
        *((LAS v4u*)(F.lds) + ch) = *((const GAS v4u*)(TAPS + ((size_t)(c0 + ci) * 2 + o) * 8192) + w); }
}
struct ConvItem { const float* W; bf16* WTe; int N, row_base, k0, n0; };
__device__ __forceinline__ void conv_load64(float (&v)[64], const ConvItem& c, int lane) {
    const GAS float* src = (const GAS float*)(c.W + (size_t)c.k0 * c.N + c.n0 + lane);
#pragma unroll
    for (int kk = 0; kk < 64; ++kk) v[kk] = src[(size_t)kk * c.N];
}
__device__ __forceinline__ void conv_store64(const float (&v)[64], const ConvItem& c, int lane) {
    GAS v4u* dst = (GAS v4u*)c.WTe + (size_t)(c.k0 >> 3) * 2048 + c.row_base + lane;
#pragma unroll
    for (int j = 0; j < 8; ++j) { v4u o; o.x = pk2(v[8 * j], v[8 * j + 1]); o.y = pk2(v[8 * j + 2], v[8 * j + 3]); o.z = pk2(v[8 * j + 4], v[8 * j + 5]); o.w = pk2(v[8 * j + 6], v[8 * j + 7]); dst[(size_t)j * 2048] = o; }
}
constexpr int MOE_ITEMS_GU = 2 * NE * 32 * 16, MOE_ITEMS_D = NE * 16 * 32, MOE_ITEMS = MOE_ITEMS_GU + MOE_ITEMS_D;
#ifndef MOE_P0_ITEMS
#define MOE_P0_ITEMS 0
#endif
#ifndef MOE_P4_ITEMS
#define MOE_P4_ITEMS 3584
#endif
constexpr int MOE_HELP_ITEMS = MOE_ITEMS - MOE_P0_ITEMS - MOE_P4_ITEMS;
__device__ __forceinline__ ConvItem moe_item(Frame& F, int it) {
    bf16* WguT = (bf16*)(F.ws + WS_WGU); bf16* WdT = (bf16*)(F.ws + WS_WD); ConvItem c;
    if (it < MOE_ITEMS_GU) { const int which = it >> 13, e = (it >> 9) & 15, kb = (it >> 4) & 31, nb = it & 15, f0 = 64 * nb;
        c.W = (which ? F.in[21] : F.in[20]) + (size_t)e * DM * FF; c.N = FF; c.WTe = WguT + (size_t)e * 2048 * DM; c.row_base = (f0 >> 7) * 256 + which * 128 + (f0 & 127); c.k0 = 64 * kb; c.n0 = f0;
    } else { const int r = it - MOE_ITEMS_GU, e = r >> 9, kb = (r >> 5) & 15, nb = r & 31;
        c.W = F.in[22] + (size_t)e * FF * DM; c.N = DM; c.WTe = WdT + (size_t)e * 2048 * FF; c.row_base = 64 * nb; c.k0 = 64 * kb; c.n0 = 64 * nb; }
    return c;
}
__device__ __forceinline__ void conv_range_moe_tail(Frame& F);
__device__ __forceinline__ void moe_conv_item(Frame& F, int it) { float v[64]; const ConvItem c = moe_item(F, it); conv_load64(v, c, F.lane); conv_store64(v, c, F.lane); }
__device__ __forceinline__ void moe_conv_range(Frame& F, int lo, int hi, int step) {
    if (lo >= hi) return;
    float va[64], vb[64];
    ConvItem ca = moe_item(F, lo), cb_; conv_load64(va, ca, F.lane);
    for (int it = lo; it < hi; it += 2 * step) {
        const bool hb = it + step < hi;
        if (hb) { cb_ = moe_item(F, it + step); conv_load64(vb, cb_, F.lane); }
        conv_store64(va, ca, F.lane);
        const bool ha = it + 2 * step < hi;
        if (ha) { ca = moe_item(F, it + 2 * step); conv_load64(va, ca, F.lane); }
        if (hb) conv_store64(vb, cb_, F.lane);
    }
}
__device__ __forceinline__ void conv_range_moe_tail(Frame& F) {
    const int w = (F.bid - NB * NE) * NWAVES + F.wave, nw = (F.G - NB * NE) * NWAVES;
    moe_conv_range(F, MOE_ITEMS - MOE_P4_ITEMS + w, MOE_ITEMS, nw);
}
__device__ __forceinline__ void hy_write_gates(Frame& F, int c0, int oo) {
    const bf16* XH = (const bf16*)(F.ws + WS_XT) + (size_t)1024 * MT; bf16* GC = (bf16*)(F.ws + WS_UC);
    const float* cw = F.in[6]; const float* cb = F.in[7];
    int ht = F.tid - 256; asm volatile("" : "+v"(ht));
#pragma unroll 2
    for (int k = 0; k < 16; ++k) { const int id = ht + 256 * k, u = id & 511, b = (id >> 9) & 1, ci = id >> 10;
        const int gch = oo * 1024 + c0 + ci; const bf16* gs = XH + (size_t)gch * MT + b * SEQ;
        const float w0 = cw[gch], w1 = cw[3072 + gch], w2 = cw[6144 + gch], bb = cb[gch];
        const v4u w = *((const GAS v4u*)gs + u);
        float f[10];
        f[1] = bflo(w.x); f[2] = bfhi(w.x); f[3] = bflo(w.y); f[4] = bfhi(w.y); f[5] = bflo(w.z); f[6] = bfhi(w.z); f[7] = bflo(w.w); f[8] = bfhi(w.w);
        { const float l_ = bf2f(gs[u > 0 ? 8 * u - 1 : 0]), r_ = bf2f(gs[u < 511 ? 8 * u + 8 : 8 * u + 7]); f[0] = u > 0 ? l_ : 0.f; f[9] = u < 511 ? r_ : 0.f; }
        float z[8];
#pragma unroll
        for (int e = 0; e < 8; ++e) z[e] = bb + w0 * f[e] + w1 * f[e + 1] + w2 * f[e + 2];
        v4u r; r.x = pk2(z[0], z[1]); r.y = pk2(z[2], z[3]); r.z = pk2(z[4], z[5]); r.w = pk2(z[6], z[7]);
        *((GAS v4u*)(GC + ((size_t)((c0 + ci) * 2 + oo) * 2 + b) * SEQ) + u) = r; }
}
__device__ __forceinline__ void phase_hyena(Frame& F) {
    const bf16* XH = (const bf16*)(F.ws + WS_XT) + (size_t)1024 * MT;
    const float* cw = F.in[6]; const float* cb = F.in[7];
    bf16* HYT = (bf16*)(F.ws + WS_HYT); bf16* GC = (bf16*)(F.ws + WS_UC);
    const int n = F.lane & 31, hh = F.lane >> 5;
    const bool compute = F.wave < 4;
    const int nhelp = F.G * 4, hw = F.bid * 4 + (F.wave - 4);
    int sec = 0;
    for (int cg = F.bid; cg < 256; cg += F.G) {
        const int c0 = cg * 4;
        __syncthreads();
        hy_stage_taps(F, c0, 0);
        {
          int lane_ = F.lane; asm volatile("" : "+v"(lane_));
          const int ci = F.wave >> 1, b = F.wave & 1; LAS unsigned char* zb = F.lds + HY_TAPS_BYTES + F.wave * HY_ZB_BYTES;
          const int zch = 2048 + c0 + ci; const bf16* zsrc = XH + (size_t)zch * MT + b * SEQ;
          const float w0 = cw[zch], w1 = cw[3072 + zch], w2 = cw[6144 + zch], bb = cb[zch];
#pragma unroll
          for (int j = 0; j < 8; ++j) { const int u = lane_ + 64 * j; const v4u w = *((const GAS v4u*)zsrc + u);
              float f[10];
              f[1] = bflo(w.x); f[2] = bfhi(w.x); f[3] = bflo(w.y); f[4] = bfhi(w.y); f[5] = bflo(w.z); f[6] = bfhi(w.z); f[7] = bflo(w.w); f[8] = bfhi(w.w);
              { const float l_ = bf2f(zsrc[u > 0 ? 8 * u - 1 : 0]), r_ = bf2f(zsrc[u < 511 ? 8 * u + 8 : 8 * u + 7]); f[0] = u > 0 ? l_ : 0.f; f[9] = u < 511 ? r_ : 0.f; }
              float z[8];
#pragma unroll
              for (int e = 0; e < 8; ++e) z[e] = bb + w0 * f[e] + w1 * f[e + 1] + w2 * f[e + 2];
              v4u r; r.x = pk2(z[7], z[6]); r.y = pk2(z[5], z[4]); r.z = pk2(z[3], z[2]); r.w = pk2(z[1], z[0]);
              *(LAS v4u*)(zb + hy_zb_off(8 * (635 - u))) = r; }
          const v4u zero = {0u, 0u, 0u, 0u};
          for (int q = lane_; q < 124; q += 64) { *(LAS v4u*)(zb + hy_zb_off(8 * q)) = zero; *(LAS v4u*)(zb + hy_zb_off(8 * (636 + q))) = zero; } }
        if (!compute) hy_write_gates(F, c0, 0);
        __syncthreads();
#pragma unroll 1
        for (int o = 0; o < 2; ++o) {
            if (compute) {
                const int ci = F.wave, c = c0 + ci;
                const LAS bf16* taps = (const LAS bf16*)(F.lds + ci * 16384);
                const int ip = n & 15, bl = n >> 4;
                LAS unsigned char* zbl = F.lds + HY_TAPS_BYTES + (2 * ci + bl) * HY_ZB_BYTES;
                f32x16 acc[8];
#pragma unroll
                for (int tau = 0; tau < 8; ++tau)
#pragma unroll
                    for (int i = 0; i < 16; ++i) acc[tau][i] = 0.f;
                hy_segment<0x01, 0xFF>(acc, taps, zbl, 0, 32, n, hh);
                hy_segment<0x03, 0xFE>(acc, taps, zbl, 32, 64, n, hh);
                hy_segment<0x07, 0xFC>(acc, taps, zbl, 64, 96, n, hh);
                hy_segment<0x0F, 0xF8>(acc, taps, zbl, 96, 128, n, hh);
                hy_segment<0x1F, 0xF0>(acc, taps, zbl, 128, 160, n, hh);
                hy_segment<0x3F, 0xE0>(acc, taps, zbl, 160, 192, n, hh);
                hy_segment<0x7F, 0xC0>(acc, taps, zbl, 192, 224, n, hh);
                hy_segment<0xFF, 0x80>(acc, taps, zbl, 224, 254, n, hh);
                hy_segment<0x00, 0x80>(acc, taps, zbl, 254, 256, n, hh);
                LDS_WAIT();
                int ip2 = ip, h2 = hh, b2 = bl; asm volatile("" : "+v"(ip2), "+v"(h2), "+v"(b2));
                {
                    const bf16* gate = GC + ((size_t)(c * 2 + o) * 2 + b2) * SEQ;
                    LAS unsigned char* zb = F.lds + HY_TAPS_BYTES + (2 * ci + b2) * HY_ZB_BYTES; bf16* outp = HYT + (size_t)c * MT + b2 * SEQ;
#pragma unroll
                    for (int th = 0; th < 2; ++th) {
                        v2u gw[4][4];
#pragma unroll
                        for (int tq = 0; tq < 4; ++tq)
#pragma unroll
                            for (int rg = 0; rg < 4; ++rg) gw[tq][rg] = *(const GAS v2u*)(gate + 512 * (4 * th + tq) + 32 * ip2 + 8 * rg + 4 * h2);
#pragma unroll
                        for (int tq = 0; tq < 4; ++tq) {
#pragma unroll
                            for (int rg = 0; rg < 4; ++rg) { const int tau = 4 * th + tq, t0 = 512 * tau + 32 * ip2 + 8 * rg + 4 * h2;
                                const float z0 = bflo(gw[tq][rg].x) * acc[tau][4 * rg + 0], z1 = bfhi(gw[tq][rg].x) * acc[tau][4 * rg + 1], z2 = bflo(gw[tq][rg].y) * acc[tau][4 * rg + 2], z3 = bfhi(gw[tq][rg].y) * acc[tau][4 * rg + 3];
                                if (o == 0) { v2u w; w.x = pk2(z3, z2); w.y = pk2(z1, z0);
                                    *(LAS v2u*)(zb + hy_zb_off(8 * (635 - (t0 >> 3))) + (h2 ? 0 : 8)) = w; }
                                else { v2u w; w.x = pk2(z0, z1); w.y = pk2(z2, z3); *(GAS v2u*)(outp + t0) = w; } } }
                    }
                }
            } else {
                if (o == 0) hy_write_gates(F, c0, 1);
                const int lo_it = MOE_P0_ITEMS + sec * (MOE_HELP_ITEMS / 2), hi_it = lo_it + MOE_HELP_ITEMS / 2;
                if (sec < 2) moe_conv_range(F, lo_it + hw, hi_it, nhelp);
            }
            ++sec;
            if (o == 0) {
                __syncthreads();
                hy_stage_taps(F, c0, 1);
                __syncthreads();
            }
        }
    }
    for (; sec < 2; ++sec) if (!compute) { const int lo_it = MOE_P0_ITEMS + sec * (MOE_HELP_ITEMS / 2), hi_it = lo_it + MOE_HELP_ITEMS / 2; moe_conv_range(F, lo_it + hw, hi_it, nhelp); }
    __syncthreads();
}

constexpr int AT_KBYTES = 16384, AT_VPITCH = 136, AT_VBYTES = 128 * AT_VPITCH, AT_STAGE = AT_KBYTES + AT_VBYTES, AT_RP_OFF = 2 * AT_STAGE;
__device__ __forceinline__ void phase_attn2(Frame& F) {
    const bf16* QK = (const bf16*)(F.ws + WS_QK); const bf16* VT = (const bf16*)(F.ws + WS_XT); bf16* MIXED = (bf16*)(F.ws + WS_MIXED);
    const float* rpb = F.in[5]; const float* og = F.in[15]; const float* qg = F.in[3]; const float* kg = F.in[4];
    LAS float* rt = (LAS float*)(F.lds + AT_RP_OFF);
    LAS float* gtab = (LAS float*)(F.lds + AT_RP_OFF + 8 * 2048);
    if (F.tid < HD) gtab[F.tid] = qg[F.tid] * kg[F.tid];
    const int n = F.lane & 31, hh = F.lane >> 5;
    for (int unit = F.bid; unit < NB * NH * 16; unit += F.G) {
        const int rq = unit & 15, h = (unit >> 4) & 7, b = unit >> 7, r0 = 4 * rq;
        const int r = r0 + (F.wave >> 1), wq = F.wave & 1;
        int kmin = r0 - WR / 2; kmin = kmin < 0 ? 0 : (kmin > NROWS - WR ? NROWS - WR : kmin);
        int kmax = r0 + 3 - WR / 2; kmax = (kmax < 0 ? 0 : (kmax > NROWS - WR ? NROWS - WR : kmax)) + WR - 1;
        int kr0 = r - WR / 2; kr0 = kr0 < 0 ? 0 : (kr0 > NROWS - WR ? NROWS - WR : kr0);
        const int nrows = kmax - kmin + 1;
        __syncthreads();
#pragma unroll
        for (int k_ = 0; k_ < 4; ++k_) { const int i = F.tid + NTHREADS * k_; if (i < 15 * 128) { const int dr_ = i >> 7, dcx = (i & 127) - 48, dcc = dcx < 0 ? 0 : (dcx > 30 ? 30 : dcx);
            const float v = rpb[h * 465 + dr_ * 31 + dcc] * 1.4426950408889634f; rt[i] = (dcx == dcc) ? v : 0.f; } }
        const int mq = b * SEQ + r * GW + 32 * wq + n, qc = 32 * wq + n;
        int c0 = qc - WC / 2; c0 = c0 < 0 ? 0 : (c0 > GW - WC ? GW - WC : c0);
        bf16x8 qf[8];
#pragma unroll
        for (int ks = 0; ks < 8; ++ks) qf[ks] = *(const GAS bf16x8*)(QK + (size_t)mq * 2048 + h * HD + 16 * ks + 8 * hh);
        float qscale;
        {
          f32x16 D;
#pragma unroll
          for (int i = 0; i < 16; ++i) D[i] = 0.f;
#pragma unroll
          for (int ks = 0; ks < 8; ++ks) D = __builtin_amdgcn_mfma_f32_32x32x16_bf16(qf[ks], qf[ks], D, 0, 0, 0);
          float dsel = 0.f; const int isel = (n & 3) + 4 * (n >> 3);
#pragma unroll
          for (int i = 0; i < 16; ++i) dsel = (i == isel) ? D[i] : dsel;
          const float other = __shfl_xor(dsel, 32);
          const float ssq = (((n >> 2) & 1) == hh) ? dsel : other;
          qscale = (0.08838834764831845f * 1.4426950408889634f) * rsqrtf(ssq * (1.f / HD) + EPS); }
        const unsigned long long wmask = (c0 >= 4 * hh) ? (0xFFFFull << (c0 - 4 * hh)) : (0xFFFFull >> (4 * hh - c0));
        const unsigned wm0 = (unsigned)wmask, wm1 = (unsigned)(wmask >> 32);
        const int rtl = 4 * hh - qc + 63;
        f32x16 O[4];
#pragma unroll
        for (int dt = 0; dt < 4; ++dt)
#pragma unroll
            for (int i = 0; i < 16; ++i) O[dt][i] = 0.f;
        float lsum = 0.f;
        v4u sk[2], sv[2];

        auto gload = [&](int kr) {
#pragma unroll
            for (int j = 0; j < 2; ++j) { const int id = F.tid + 512 * j;
                sk[j] = *(const GAS v4u*)(QK + (size_t)(b * SEQ + kr * GW + (id >> 4)) * 2048 + 1024 + h * HD + 8 * (id & 15));
                sv[j] = *(const GAS v4u*)(VT + (size_t)(h * HD + (id >> 3)) * MT + b * SEQ + kr * GW + 8 * (id & 7)); }
        };
        auto lstore = [&](int buf) {
            LAS unsigned char* kb = F.lds + buf * AT_STAGE; LAS unsigned char* vb = kb + AT_KBYTES;
#pragma unroll
            for (int j = 0; j < 2; ++j) { const int id = F.tid + 512 * j; const int key = id >> 4, c = id & 15;
                float f[8] = {bflo(sk[j].x), bfhi(sk[j].x), bflo(sk[j].y), bfhi(sk[j].y), bflo(sk[j].z), bfhi(sk[j].z), bflo(sk[j].w), bfhi(sk[j].w)};
                float ss = 0.f;
#pragma unroll
                for (int e = 0; e < 8; ++e) ss += f[e] * f[e];
                ss += __shfl_xor(ss, 1); ss += __shfl_xor(ss, 2); ss += __shfl_xor(ss, 4); ss += __shfl_xor(ss, 8);
                const float rk = rsqrtf(ss * (1.f / HD) + EPS);
                const f32x4 ga = *(const LAS f32x4*)(gtab + 8 * c), gb = *(const LAS f32x4*)(gtab + 8 * c + 4);
                v4u kn; kn.x = pk2(f[0] * rk * ga.x, f[1] * rk * ga.y); kn.y = pk2(f[2] * rk * ga.z, f[3] * rk * ga.w); kn.z = pk2(f[4] * rk * gb.x, f[5] * rk * gb.y); kn.w = pk2(f[6] * rk * gb.z, f[7] * rk * gb.w);
                *(LAS v4u*)(kb + key * 256 + ((c ^ (key & 15)) << 4)) = kn;
                const int d = id >> 3, cv = id & 7; LAS v2u* vp = (LAS v2u*)(vb + d * AT_VPITCH + cv * 16);
                v2u lo, hi; lo.x = sv[j].x; lo.y = sv[j].y; hi.x = sv[j].z; hi.y = sv[j].w; vp[0] = lo; vp[1] = hi; }
        };
        gload(kmin); lstore(0);
        __syncthreads();
#pragma unroll 1
        for (int j = 0; j < nrows; ++j) {
            const int kr = kmin + j, buf = j & 1;
            if (j + 1 < nrows) gload(kr + 1);
            if (kr >= kr0 && kr < kr0 + WR) {
                const LAS unsigned char* kb = F.lds + buf * AT_STAGE; const LAS unsigned char* vb = kb + AT_KBYTES;
                const int dr = kr - r + WR - 1;
                const LAS float* rrow = rt + dr * 128 + rtl;
#pragma unroll
                for (int kt = 0; kt < 2; ++kt) {
                    f32x16 S;
#pragma unroll
                    for (int i = 0; i < 16; ++i) S[i] = 0.f;
                    const int key = 32 * kt + n;
#pragma unroll
                    for (int ks = 0; ks < 8; ++ks) { const bf16x8 kf = *(const LAS bf16x8*)(kb + key * 256 + (((2 * ks + hh) ^ (key & 15)) << 4));
                        S = __builtin_amdgcn_mfma_f32_32x32x16_bf16(kf, qf[ks], S, 0, 0, 0); }
                    float p[16];
#pragma unroll
                    for (int i = 0; i < 16; ++i) { const int E = (i & 3) + 8 * (i >> 2);
                        const float e = __builtin_amdgcn_exp2f(S[i] * qscale + rrow[32 * kt + E]);
                        const unsigned keep = (unsigned)__builtin_amdgcn_sbfe((int)(kt ? wm1 : wm0), E, 1);
                        p[i] = __builtin_bit_cast(float, __builtin_bit_cast(unsigned, e) & keep); lsum += p[i]; }
                    v4u pw0, pw1;
                    pw0.x = pk2(p[0], p[1]); pw0.y = pk2(p[2], p[3]); pw0.z = pk2(p[4], p[5]); pw0.w = pk2(p[6], p[7]);
                    pw1.x = pk2(p[8], p[9]); pw1.y = pk2(p[10], p[11]); pw1.z = pk2(p[12], p[13]); pw1.w = pk2(p[14], p[15]);
                    const bf16x8 pf0 = __builtin_bit_cast(bf16x8, pw0), pf1 = __builtin_bit_cast(bf16x8, pw1);
#pragma unroll
                    for (int dt = 0; dt < 4; ++dt) {
                        const LAS unsigned char* vrow = vb + (32 * dt + n) * AT_VPITCH + (32 * kt + 4 * hh) * 2;
                        const v2u a0 = *(const LAS v2u*)(vrow), a1 = *(const LAS v2u*)(vrow + 16), a2 = *(const LAS v2u*)(vrow + 32), a3 = *(const LAS v2u*)(vrow + 48);
                        v4u f0, f1; f0.x = a0.x; f0.y = a0.y; f0.z = a1.x; f0.w = a1.y; f1.x = a2.x; f1.y = a2.y; f1.z = a3.x; f1.w = a3.y;
                        O[dt] = __builtin_amdgcn_mfma_f32_32x32x16_bf16(__builtin_bit_cast(bf16x8, f0), pf0, O[dt], 0, 0, 0);
                        O[dt] = __builtin_amdgcn_mfma_f32_32x32x16_bf16(__builtin_bit_cast(bf16x8, f1), pf1, O[dt], 0, 0, 0);
                    }
                }
            }
            if (j + 1 < nrows) lstore(buf ^ 1);
            __syncthreads();
        }
        lsum += __shfl_xor(lsum, 32);
        const float il = 1.f / lsum;
        float ss = 0.f;
#pragma unroll
        for (int dt = 0; dt < 4; ++dt)
#pragma unroll
            for (int i = 0; i < 16; ++i) { O[dt][i] *= il; ss += O[dt][i] * O[dt][i]; }
        ss += __shfl_xor(ss, 32);
        const float rr = rsqrtf(ss * (1.f / HD) + EPS);
        bf16* orow = MIXED + (size_t)mq * DM + h * HD;
#pragma unroll
        for (int dt = 0; dt < 4; ++dt)
#pragma unroll
            for (int rg = 0; rg < 4; ++rg) { const int d = 32 * dt + 8 * rg + 4 * hh; const f32x4 gg = *(const GAS f32x4*)(og + h * HD + d);
                v2u w; w.x = pk2(O[dt][4 * rg + 0] * rr * gg.x, O[dt][4 * rg + 1] * rr * gg.y); w.y = pk2(O[dt][4 * rg + 2] * rr * gg.z, O[dt][4 * rg + 3] * rr * gg.w);
                *(GAS v2u*)(orow + d) = w; }
    }
    __syncthreads();
}

__device__ __forceinline__ void phase_p25(Frame& F) {
    const bf16* HYT = (const bf16*)(F.ws + WS_HYT); bf16* MIXED = (bf16*)(F.ws + WS_MIXED); const float* hg = F.in[16];
    LAS float* tile = (LAS float*)F.lds;
    LAS float* rs = (LAS float*)(F.lds + 128 * 65 * 4);
    for (int it = F.bid; it < 8 * (MT / 64); it += F.G) {
        const int gi = it & 7, m0 = (it >> 3) * 64;
        { const int ch = F.tid >> 2, t0 = (F.tid & 3) * 16; const bf16* p = HYT + (size_t)(gi * 128 + ch) * MT + m0 + t0;
          const v4u a = *(const GAS v4u*)p, b = *(const GAS v4u*)(p + 8);
          LAS float* d = tile + ch * 65 + t0;
          d[0] = bflo(a.x); d[1] = bfhi(a.x); d[2] = bflo(a.y); d[3] = bfhi(a.y); d[4] = bflo(a.z); d[5] = bfhi(a.z); d[6] = bflo(a.w); d[7] = bfhi(a.w);
          d[8] = bflo(b.x); d[9] = bfhi(b.x); d[10] = bflo(b.y); d[11] = bfhi(b.y); d[12] = bflo(b.z); d[13] = bfhi(b.z); d[14] = bflo(b.w); d[15] = bfhi(b.w); }
        __syncthreads();
        {
          const int t = F.tid >> 3, c0 = (F.tid & 7) * 16; float ss = 0.f;
#pragma unroll
          for (int c = 0; c < 16; ++c) { const float v = tile[(c0 + c) * 65 + t]; ss += v * v; }
          ss += __shfl_xor(ss, 1); ss += __shfl_xor(ss, 2); ss += __shfl_xor(ss, 4);
          if ((F.tid & 7) == 0) rs[t] = rsqrtf(ss * (1.f / 128) + EPS); }
        __syncthreads();
        {
          const int t = F.tid >> 3, c0 = (F.tid & 7) * 16; const float r = rs[t]; float o[16];
#pragma unroll
          for (int c = 0; c < 16; ++c) o[c] = tile[(c0 + c) * 65 + t] * r * hg[gi * 128 + c0 + c];
          v4u a, b; a.x = pk2(o[0], o[1]); a.y = pk2(o[2], o[3]); a.z = pk2(o[4], o[5]); a.w = pk2(o[6], o[7]); b.x = pk2(o[8], o[9]); b.y = pk2(o[10], o[11]); b.z = pk2(o[12], o[13]); b.w = pk2(o[14], o[15]);
          bf16* q = MIXED + (size_t)(m0 + t) * DM + AW + gi * 128 + c0; *(GAS v4u*)q = a; *(GAS v4u*)(q + 8) = b; }
        __syncthreads();
    }
}
__device__ __forceinline__ void phase_p35(Frame& F) {
    LAS float* wrT = (LAS float*)F.lds;
    const float* wr = F.in[19]; const float* g = F.in[18];
    constexpr int WRS = DM + 4;
    for (int i = F.tid; i < DM * NE; i += NTHREADS) { const int d = i >> 4, e = i & 15; wrT[e * WRS + d] = wr[i]; }
    __syncthreads();
    bf16* HB = (bf16*)(F.ws + WS_HB); float* AFF = (float*)(F.ws + WS_AFF); const float* x1 = F.out;
    f32x4 vn[8];
    { const int m0 = GW_ID(F); if (m0 < MT) { const GAS f32x4* xr = (const GAS f32x4*)(x1 + (size_t)m0 * DM) + F.lane;
#pragma unroll
        for (int j = 0; j < 8; ++j) vn[j] = xr[64 * j]; } }
    for (int m = GW_ID(F); m < MT; m += GW_N(F)) {
        f32x4 v[8]; float s = 0.f;
#pragma unroll
        for (int j = 0; j < 8; ++j) { v[j] = vn[j]; s += (v[j].x * v[j].x + v[j].y * v[j].y) + (v[j].z * v[j].z + v[j].w * v[j].w); }
        if (m + GW_N(F) < MT) { const GAS f32x4* xr = (const GAS f32x4*)(x1 + (size_t)(m + GW_N(F)) * DM) + F.lane;
#pragma unroll
            for (int j = 0; j < 8; ++j) vn[j] = xr[64 * j]; }
        const float r = rsqrtf(wave_sum(s) * (1.f / DM) + EPS);
        GAS v2u* o8 = (GAS v2u*)(HB + (size_t)m * DM) + F.lane;
#pragma unroll
        for (int j = 0; j < 8; ++j) { const f32x4 gg = *((const GAS f32x4*)g + F.lane + 64 * j); v[j].x *= r * gg.x; v[j].y *= r * gg.y; v[j].z *= r * gg.z; v[j].w *= r * gg.w;
            v2u o; o.x = pk2(v[j].x, v[j].y); o.y = pk2(v[j].z, v[j].w); o8[64 * j] = o; }
        float mine = 0.f;
#pragma unroll 1
        for (int e = 0; e < NE; ++e) { float a = 0.f;
#pragma unroll
            for (int j = 0; j < 8; ++j) { const f32x4 w = *((const LAS f32x4*)(wrT + e * WRS) + F.lane + 64 * j); a += (v[j].x * w.x + v[j].y * w.y) + (v[j].z * w.z + v[j].w * w.w); }
            a = wave_sum(a); mine = (F.lane == e) ? a : mine; }
        float mx = mine;
        mx = fmaxf(mx, __shfl_xor(mx, 1)); mx = fmaxf(mx, __shfl_xor(mx, 2)); mx = fmaxf(mx, __shfl_xor(mx, 4)); mx = fmaxf(mx, __shfl_xor(mx, 8));
        const float ex = expf(mine - mx); float den = ex;
        den += __shfl_xor(den, 1); den += __shfl_xor(den, 2); den += __shfl_xor(den, 4); den += __shfl_xor(den, 8);
        const int b = m / SEQ, sidx = m % SEQ;
        if (F.lane < NE) AFF[((size_t)b * NE + F.lane) * SEQ + sidx] = ex / den;
    }
    __syncthreads();
}
__device__ __forceinline__ void phase_p4(Frame& F) {
    LAS unsigned* key = (LAS unsigned*)F.lds;
    LAS unsigned* hist = (LAS unsigned*)(F.lds + 16384);
    LAS unsigned* wsum = (LAS unsigned*)(F.lds + 16384 + 1024);
    const float* AFF = (const float*)(F.ws + WS_AFF); int* IDX = (int*)(F.ws + WS_IDX); float* GATE = (float*)(F.ws + WS_GATE); int* SEL = (int*)(F.ws + WS_SEL);
    for (int be = F.bid; be < NB * NE; be += F.G) {
        const int b = be / NE, e = be % NE;
        __syncthreads();
        const GAS v4u* ap = (const GAS v4u*)(AFF + (size_t)be * SEQ);
        const v4u k0 = ap[2 * F.tid], k1 = ap[2 * F.tid + 1];
        unsigned kk[8] = {k0.x, k0.y, k0.z, k0.w, k1.x, k1.y, k1.z, k1.w};
        unsigned prefix = 0u, mask = 0u, remaining = CAP;
#pragma unroll 1
        for (int pass = 0; pass < 4; ++pass) {
            const int shift = 24 - 8 * pass;
            if (F.tid < 256) hist[F.tid] = 0u;
            __syncthreads();
#pragma unroll
            for (int i = 0; i < 8; ++i) if ((kk[i] & mask) == prefix) __hip_atomic_fetch_add(&hist[(kk[i] >> shift) & 255u], 1u, __ATOMIC_RELAXED, __HIP_MEMORY_SCOPE_WORKGROUP);
            __syncthreads();
            unsigned incl_ = 0u, mine_ = 0u;
            if (F.tid < 256) {
                mine_ = hist[255 - F.tid]; incl_ = mine_;
#pragma unroll
                for (int o = 1; o < 64; o <<= 1) { const unsigned t = __shfl_up(incl_, o); if (F.lane >= o) incl_ += t; }
                if (F.lane == 63) wsum[10 + F.wave] = incl_;
            }
            __syncthreads();
            if (F.tid < 256) {
                unsigned base = 0u;
                for (int w = 0; w < F.wave; ++w) base += wsum[10 + w];
                const unsigned above = base + incl_ - mine_;
                if (above < remaining && remaining <= above + mine_) { wsum[8] = (unsigned)(255 - F.tid); wsum[9] = above; }
            }
            __syncthreads();
            const unsigned d = wsum[8], above = wsum[9];
            prefix |= d << shift; mask |= 255u << shift; remaining -= above;
            __syncthreads();
        }
        const unsigned thr = prefix;
        unsigned cnt = 0u;
#pragma unroll
        for (int i = 0; i < 8; ++i) cnt += (kk[i] > thr ? 0x10000u : 0u) + (kk[i] == thr ? 1u : 0u);
        unsigned incl = cnt;
#pragma unroll
        for (int o = 1; o < 64; o <<= 1) { const unsigned t = __shfl_up(incl, o); if (F.lane >= o) incl += t; }
        if (F.lane == 63) wsum[F.wave] = incl;
        __syncthreads();
        unsigned base = 0u;
        for (int w = 0; w < F.wave; ++w) base += wsum[w];
        unsigned run = base + incl - cnt;
#pragma unroll
        for (int i = 0; i < 8; ++i) {
            const unsigned gt_before = run >> 16, tie_before = run & 0xffffu;
            const bool isgt = kk[i] > thr, istie = kk[i] == thr;
            const bool sel = isgt || (istie && tie_before < remaining);
            const unsigned slot = gt_before + (tie_before < remaining ? tie_before : remaining);
            const int s = 8 * F.tid + i, m = b * SEQ + s;
            if (sel) { IDX[be * CAP + slot] = m; GATE[be * CAP + slot] = __builtin_bit_cast(float, kk[i]); }
            SEL[(size_t)m * NE + e] = sel ? (int)slot : -1;
            run += (isgt ? 0x10000u : 0u) + (istie ? 1u : 0u);
        }
    }
    __syncthreads();
}
__device__ __forceinline__ void phase_p7(Frame& F) {
    const int* SEL = (const int*)(F.ws + WS_SEL); const bf16* YE = (const bf16*)(F.ws + WS_YE);
    for (int m = GW_ID(F); m < MT; m += GW_N(F)) {
        const int b = m / SEQ;
        GAS f32x4* orow = (GAS f32x4*)(F.out + (size_t)m * DM);
        const int sel = SEL[(size_t)m * NE + (F.lane & 15)];
        f32x4 acc[8];
#pragma unroll
        for (int j = 0; j < 8; ++j) acc[j] = orow[2 * F.lane + (j & 1) + 128 * (j >> 1)];
        unsigned mask = (unsigned)(__ballot(sel >= 0) & 0xFFFFull);
        while (mask) {
            const int e0 = __builtin_ctz(mask); mask &= mask - 1u;
            const bool two = mask != 0u; const int e1 = two ? __builtin_ctz(mask) : e0; if (two) mask &= mask - 1u;
            const int s0 = __builtin_amdgcn_readlane(sel, e0), s1 = __builtin_amdgcn_readlane(sel, e1);
            const GAS v4u* y0 = (const GAS v4u*)(YE + (size_t)((b * NE + e0) * CAP + s0) * DM) + F.lane;
            const GAS v4u* y1 = (const GAS v4u*)(YE + (size_t)((b * NE + e1) * CAP + s1) * DM) + F.lane;
            v4u w0[4], w1[4];
#pragma unroll
            for (int jj = 0; jj < 4; ++jj) { w0[jj] = y0[64 * jj]; w1[jj] = y1[64 * jj]; }
            const float k1 = two ? 1.f : 0.f;
#pragma unroll
            for (int jj = 0; jj < 4; ++jj) {
                acc[2 * jj].x += bflo(w0[jj].x) + k1 * bflo(w1[jj].x); acc[2 * jj].y += bfhi(w0[jj].x) + k1 * bfhi(w1[jj].x); acc[2 * jj].z += bflo(w0[jj].y) + k1 * bflo(w1[jj].y); acc[2 * jj].w += bfhi(w0[jj].y) + k1 * bfhi(w1[jj].y);
                acc[2 * jj + 1].x += bflo(w0[jj].z) + k1 * bflo(w1[jj].z); acc[2 * jj + 1].y += bfhi(w0[jj].z) + k1 * bfhi(w1[jj].z); acc[2 * jj + 1].z += bflo(w0[jj].w) + k1 * bflo(w1[jj].w); acc[2 * jj + 1].w += bfhi(w0[jj].w) + k1 * bfhi(w1[jj].w); }
        }
#pragma unroll
        for (int j = 0; j < 8; ++j) orow[2 * F.lane + (j & 1) + 128 * (j >> 1)] = acc[j];
    }
}

struct Args { const float* in[23]; float* out; unsigned char* ws; int ph_lo, ph_hi; };
enum Phase { PH_P0 = 0, PH_G1, PH_ATTN, PH_P25, PH_OUT, PH_P35, PH_P4, PH_UP, PH_DOWN, PH_P7, PH_COUNT };

__global__ void __launch_bounds__(NTHREADS, 2) mk_fwd(Args args) {
    extern __shared__ __attribute__((aligned(16))) unsigned char lds_raw[];
    Frame F;
    F.lds = (LAS unsigned char*)lds_raw;
    F.tid = threadIdx.x; F.lane = F.tid & 63; F.wave = __builtin_amdgcn_readfirstlane(F.tid >> 6); F.G = gridDim.x; F.bid = blockIdx.x;
#pragma unroll
    for (int i = 0; i < 23; ++i) F.in[i] = args.in[i];
    F.out = args.out; F.ws = args.ws;
    const int lo = args.ph_lo, hi = args.ph_hi;
#define IN(k) (lo <= (k) && (k) < hi)
#define REPS(k) for (int rep_ = 0; rep_ < ((k) == REP_PHASE ? REP_N : 1); ++rep_)
#if MK_N_LAUNCHES == 1
    { volatile LAS unsigned* misc = (volatile LAS unsigned*)(F.lds + LDS_MISC_OFF); if (F.tid < 16) misc[F.tid] = 0u; }
    __syncthreads();
    XcdBarrier bar = xcd_barrier_post(g_bar_words, (volatile LAS unsigned*)(F.lds + LDS_MISC_OFF) + 8);
#define SEAM(k) do { if (IN(k) && IN((k) + 1)) xcd_barrier(bar); } while (0)
#else
#define SEAM(k) do { } while (0)
#endif
    if (IN(PH_P0)) REPS(PH_P0) { phase_p0(F); for (int it = GW_ID(F); it < MOE_P0_ITEMS; it += GW_N(F)) moe_conv_item(F, it); } SEAM(PH_P0);
    if (IN(PH_G1)) REPS(PH_G1) {
        phase_filters(F);
        __syncthreads();
        { pg8::DenseOrder S; S.init(F.ws + WS_HB, F.ws + WS_WIN, MT, 2048, DM, 0, F.G, F.bid);
          pg8::EpiBf16 E{(pg8::bf16_t*)(F.ws + WS_QK), 2048, 0, nullptr};
          pg8::gemm_phase<pg8::EpiBf16, pg8::DenseOrder, true>(F.lds, DM, S, E); }
        { pg8::DenseOrder S; S.init(F.ws + WS_HB, F.ws + WS_WIN, MT, 4096, DM, 8, F.G, F.bid);
          pg8::EpiTransBf16 E{(pg8::bf16_t*)(F.ws + WS_XT), MT, 8};
          pg8::gemm_phase<pg8::EpiTransBf16, pg8::DenseOrder, true>(F.lds, DM, S, E); }
    } SEAM(PH_G1);
    if (IN(PH_ATTN)) { __syncthreads(); for (int rep_ = 0; rep_ < ((PH_ATTN == REP_PHASE && REP_SUB != 2) ? REP_N : 1); ++rep_) phase_hyena(F); for (int rep_ = 0; rep_ < ((PH_ATTN == REP_PHASE && REP_SUB != 1) ? REP_N : 1); ++rep_) phase_attn2(F); } SEAM(PH_ATTN);
    if (IN(PH_P25)) REPS(PH_P25) { __syncthreads(); phase_p25(F); } SEAM(PH_P25);
    if (IN(PH_OUT)) REPS(PH_OUT) {
        __syncthreads();
        pg8::DenseOrder S; S.init(F.ws + WS_MIXED, F.ws + WS_WOUT, MT, DM, DM, 0, F.G, F.bid);
        pg8::EpiResF32 E{F.in[0], F.out, DM};
        pg8::gemm_phase<pg8::EpiResF32, pg8::DenseOrder, false>(F.lds, DM, S, E);
    } SEAM(PH_OUT);
    if (IN(PH_P35)) REPS(PH_P35) { __syncthreads(); phase_p35(F); } SEAM(PH_P35);
    if (IN(PH_P4)) REPS(PH_P4) { __syncthreads(); phase_p4(F);
        if (F.G > NB * NE) { if (F.bid >= NB * NE) conv_range_moe_tail(F); }
        else moe_conv_range(F, MOE_ITEMS - MOE_P4_ITEMS + GW_ID(F), MOE_ITEMS, GW_N(F)); } SEAM(PH_P4);
    if (IN(PH_UP)) REPS(PH_UP) {
        __syncthreads();
        pg8::MoeOrder S; S.init(F.ws + WS_HB, F.ws + WS_WGU, DM, F.G, F.bid, true);
        LAS int* ridx = (LAS int*)(F.lds + 131072);
        { const int* IDX = (const int*)(F.ws + WS_IDX); pg8::Unit u;
          for (int i = 0; S.next(i, u); ++i) if (F.tid < 256) ridx[i * 256 + F.tid] = IDX[u.g * CAP + u.pm * 256 + F.tid]; }
        __syncthreads();
        pg8::EpiSwiGLU E{(pg8::bf16_t*)(F.ws + WS_ACT)};
        pg8::gemm_phase<pg8::EpiSwiGLU, pg8::MoeOrder, true, true>(F.lds, DM, S, E, ridx);
    } SEAM(PH_UP);
    if (IN(PH_DOWN)) REPS(PH_DOWN) {
        __syncthreads();
        pg8::MoeOrder S; S.init(F.ws + WS_ACT, F.ws + WS_WD, FF, F.G, F.bid, false);
        pg8::EpiBf16 E{(pg8::bf16_t*)(F.ws + WS_YE), DM, 512, (const float*)(F.ws + WS_GATE)};
        pg8::gemm_phase<pg8::EpiBf16, pg8::MoeOrder, true>(F.lds, FF, S, E);
    } SEAM(PH_DOWN);
    if (IN(PH_P7)) { phase_p7(F); }
#if MK_N_LAUNCHES == 1
    __syncthreads();
    { volatile LAS unsigned* misc = (volatile LAS unsigned*)(F.lds + LDS_MISC_OFF);
      if (F.tid == 0) misc[0] = (xb_add(&g_bar_words[XCD_BAR_WORDS], 1u) + 1u == (unsigned)F.G) ? 1u : 0u;
      __syncthreads();
      if (misc[0] != 0u && F.tid < (XCD_BAR_WORDS + 64) / 64) __hip_atomic_store(&g_bar_words[64 * F.tid], 0u, __ATOMIC_RELAXED, __HIP_MEMORY_SCOPE_AGENT); }
#endif
#undef IN
#undef SEAM
}

extern "C" void kernel_launch(void* const* d_in, const int* in_sizes, int n_in, void* d_out, int out_size, void* d_ws, size_t ws_size, hipStream_t stream) {
    static int grid = 0;
    if (grid == 0) {
        if (n_in != 23 || ws_size < WS_END) { fprintf(stderr, "kernel_launch: unexpected inputs (n_in %d, ws %zu)\n", n_in, ws_size); grid = -1; return; }
        if (hipFuncSetAttribute((const void*)mk_fwd, hipFuncAttributeMaxDynamicSharedMemorySize, LDS_BYTES) != hipSuccess) { fprintf(stderr, "kernel_launch: hipFuncSetAttribute failed\n"); grid = -1; return; }
        int dev = 0, cus = 0, per_cu = 0;
        hipGetDevice(&dev); hipDeviceGetAttribute(&cus, hipDeviceAttributeMultiprocessorCount, dev);
        hipOccupancyMaxActiveBlocksPerMultiprocessor(&per_cu, (const void*)mk_fwd, NTHREADS, LDS_BYTES);
        (void)hipGetLastError();
        if (per_cu < 1) { fprintf(stderr, "kernel_launch: occupancy query says %d blocks/CU\n", per_cu); }
        grid = cus;
    }
    if (grid < 0) return;
    Args a{};
    for (int i = 0; i < 23; ++i) a.in[i] = (const float*)d_in[i];
    a.out = (float*)d_out; a.ws = (unsigned char*)d_ws;
#if MK_N_LAUNCHES == 1
    a.ph_lo = 0; a.ph_hi = PH_COUNT;
    hipLaunchKernelGGL(mk_fwd, dim3(grid), dim3(NTHREADS), LDS_BYTES, stream, a);
#else
    for (int p = 0; p < PH_COUNT; ++p) { a.ph_lo = p; a.ph_hi = p + 1; hipLaunchKernelGGL(mk_fwd, dim3(grid), dim3(NTHREADS), LDS_BYTES, stream, a); }
#endif
}
```

```cpp
#include <hip/hip_runtime.h>
#include <hip/hip_cooperative_groups.h>
#include <cstdio>
#include <cstdint>
namespace cg = cooperative_groups;

#ifndef REP_PHASE
#define REP_PHASE -1
#define REP_N 1
#define REP_SUB 0
#endif
#ifndef MK_N_LAUNCHES
#define MK_N_LAUNCHES 1
#endif

namespace pg8 {
#define PG8_LAS __attribute__((address_space(3)))
typedef unsigned short bf16_t;
typedef short bf16x8 __attribute__((ext_vector_type(8)));
typedef float f32x4 __attribute__((ext_vector_type(4)));
typedef unsigned u32x4 __attribute__((ext_vector_type(4)));
typedef unsigned u32x2 __attribute__((ext_vector_type(2)));
constexpr int BM = 256, BK = 64, HALF = 128, HTB = HALF * BK * 2, STAGE_BYTES = 8 * HTB, NXCD = 8, WGM = 8;

__host__ __device__ __forceinline__ int lds_byte(int r, int c) { const int st = (r >> 4) * 2 + (c >> 5), rr = r & 15, cc = c & 31, ob = rr * 64 + cc * 2; return st * 1024 + (ob ^ (((ob >> 9) & 1) << 5)); }
__host__ __device__ __forceinline__ void stage_rc(int b, int& R, int& C) { const int st = b / 1024, sb = b % 1024, swz = sb ^ (((sb >> 9) & 1) << 5); R = (st >> 1) * 16 + swz / 64; C = (st & 1) * 32 + (swz % 64) / 2; }
__host__ __device__ __forceinline__ int perm32(int rho) { const int n = rho >> 4, i = rho & 15; return 8 * (i >> 2) + 4 * n + (i & 3); }

struct Unit { int pm, pn, g; const char* a; const char* b; };

__device__ __forceinline__ unsigned cvt_pk_bf16(float lo, float hi) { unsigned r; asm volatile("v_cvt_pk_bf16_f32 %0, %1, %2" : "=v"(r) : "v"(lo), "v"(hi)); return r; }

struct DenseOrder {
    static constexpr bool CHUNK_B = false;
    int nM, nN, nwg, G, c, K, pn0; const char* A; const char* Bt;
    __device__ void init(const void* A_, const void* Bt_, int M, int N, int K_, int pn0_, int G_, int c_) { A = (const char*)A_; Bt = (const char*)Bt_; nM = M / BM; nN = N / BM; nwg = nM * nN; G = G_; c = c_; K = K_; pn0 = pn0_; }
    __device__ bool next(int i, Unit& u) const {
        const long L = (long)i * G + c; if (L >= nwg) return false;
        int wgid = (int)L; { const int q = nwg / NXCD, r = nwg % NXCD, xcd = wgid % NXCD, off = wgid / NXCD; wgid = (xcd < r ? xcd * (q + 1) : r * (q + 1) + (xcd - r) * q) + off; }
        const int nig = WGM * nN, gid = wgid / nig, fm = gid * WGM, gsz = (nM - fm) < WGM ? (nM - fm) : WGM;
        u.pm = fm + ((wgid % nig) % gsz); u.pn = pn0 + (wgid % nig) / gsz; u.g = 0;
        u.a = A + (size_t)u.pm * BM * K * 2; u.b = Bt + (size_t)u.pn * BM * K * 2; return true;
    }
};
struct MoeOrder {
    static constexpr bool CHUNK_B = true;
    int G, c, K; bool gather; const char* A; const char* Bt;
    __device__ void init(const void* A_, const void* Bt_, int K_, int G_, int c_, bool gather_) { A = (const char*)A_; Bt = (const char*)Bt_; K = K_; G = G_; c = c_; gather = gather_; }
    __device__ bool next(int i, Unit& u) const {
        const int L = i * G + c; if (L >= 512) return false;
        int pn, pm, b, e;
        if ((G & 7) == 0 && G >= 64) { const int per = G >> 3, x = c & 7, u = (c >> 3) + i * per;
            pn = u & 7; pm = (u >> 3) & 1; b = (u >> 4) & 1; e = x + 8 * (u >> 5); if (e >= 16) return false; }
        else { pn = L & 7; pm = (L >> 3) & 1; b = (L >> 4) & 1; e = L >> 5; }
        u.pm = pm; u.pn = pn; u.g = b * 16 + e;
        u.a = gather ? A : A + (size_t)(u.g * 512 + pm * BM) * K * 2; u.b = Bt + (size_t)e * 2048 * K * 2 + (size_t)pn * BM * 16; return true;
    }
};

struct EpiBf16 {
    static constexpr bool PERM = true, SWAP = false, INIT = false;
    bf16_t* O; int ldc; int grows; const float* rscale;
    __device__ __forceinline__ void operator()(const f32x4 (&acc)[2][2][4][2], const Unit& u, int wr, int wc, int fr, int fq) const {
        const int row0 = u.g * grows + u.pm * BM + wr * 64 + fr, col0 = u.pn * BM + wc * 32 + 8 * fq;
        float scv[2][4];
#pragma unroll
        for (int ai = 0; ai < 2; ++ai)
#pragma unroll
            for (int m = 0; m < 4; ++m) scv[ai][m] = rscale ? rscale[row0 + ai * HALF + m * 16] : 1.f;
#pragma unroll
        for (int ai = 0; ai < 2; ++ai)
#pragma unroll
            for (int m = 0; m < 4; ++m) { const int row = row0 + ai * HALF + m * 16; bf16_t* rowp = O + (size_t)row * ldc + col0; const float sc = scv[ai][m];
#pragma unroll
                for (int bj = 0; bj < 2; ++bj) { const f32x4 v0 = acc[ai][bj][m][0] * sc, v1 = acc[ai][bj][m][1] * sc;
                    u32x4 w; w.x = cvt_pk_bf16(v0[0], v0[1]); w.y = cvt_pk_bf16(v0[2], v0[3]); w.z = cvt_pk_bf16(v1[0], v1[1]); w.w = cvt_pk_bf16(v1[2], v1[3]);
                    *(u32x4*)(rowp + bj * HALF) = w; } }
    }
};
struct EpiSwiGLU {
    static constexpr bool PERM = true, SWAP = false, INIT = false;
    bf16_t* O;
    __device__ __forceinline__ void operator()(const f32x4 (&acc)[2][2][4][2], const Unit& u, int wr, int wc, int fr, int fq) const {
        const int row0 = u.g * 512 + u.pm * BM + wr * 64 + fr, col0 = u.pn * HALF + wc * 32 + 8 * fq;
#pragma unroll
        for (int ai = 0; ai < 2; ++ai)
#pragma unroll
            for (int m = 0; m < 4; ++m) { bf16_t* rowp = O + (size_t)(row0 + ai * HALF + m * 16) * 1024 + col0;
                float r[8];
#pragma unroll
                for (int n = 0; n < 2; ++n)
#pragma unroll
                    for (int e = 0; e < 4; ++e) { const float g = acc[ai][0][m][n][e], up = acc[ai][1][m][n][e]; r[n * 4 + e] = g / (1.f + __expf(-g)) * up; }
                u32x4 w; w.x = cvt_pk_bf16(r[0], r[1]); w.y = cvt_pk_bf16(r[2], r[3]); w.z = cvt_pk_bf16(r[4], r[5]); w.w = cvt_pk_bf16(r[6], r[7]);
                *(u32x4*)rowp = w; }
    }
};
struct EpiResF32 {
    static constexpr bool PERM = false, SWAP = false, INIT = true;
    const float* res; float* out; int ldc;
    __device__ __forceinline__ void init(f32x4 (&acc)[2][2][4][2], const Unit& u, int wr, int wc, int fr, int fq) const {
        const int row0 = u.pm * BM + wr * 64 + fr, col0 = u.pn * BM + wc * 32 + 4 * fq;
#pragma unroll
        for (int ai = 0; ai < 2; ++ai)
#pragma unroll
            for (int m = 0; m < 4; ++m) { const size_t off = (size_t)(row0 + ai * HALF + m * 16) * ldc + col0;
#pragma unroll
                for (int bj = 0; bj < 2; ++bj)
#pragma unroll
                    for (int n = 0; n < 2; ++n) acc[ai][bj][m][n] = *(const f32x4*)(res + off + bj * HALF + n * 16); }
    }
    __device__ __forceinline__ void operator()(const f32x4 (&acc)[2][2][4][2], const Unit& u, int wr, int wc, int fr, int fq) const {
        const int row0 = u.pm * BM + wr * 64 + fr, col0 = u.pn * BM + wc * 32 + 4 * fq;
#pragma unroll
        for (int ai = 0; ai < 2; ++ai)
#pragma unroll
            for (int m = 0; m < 4; ++m) { const size_t off = (size_t)(row0 + ai * HALF + m * 16) * ldc + col0;
#pragma unroll
                for (int bj = 0; bj < 2; ++bj)
#pragma unroll
                    for (int n = 0; n < 2; ++n) *(f32x4*)(out + off + bj * HALF + n * 16) = acc[ai][bj][m][n]; }
    }
};
struct EpiTransBf16 {
    static constexpr bool PERM = false, SWAP = true, INIT = false;
    bf16_t* O; int ldt; int pn_base;
    __device__ __forceinline__ void operator()(const f32x4 (&acc)[2][2][4][2], const Unit& u, int wr, int wc, int fr, int fq) const {
        const int ch0 = (u.pn - pn_base) * BM + wc * 32 + fr, t0 = u.pm * BM + wr * 64 + 4 * fq;
#pragma unroll
        for (int bj = 0; bj < 2; ++bj)
#pragma unroll
            for (int n = 0; n < 2; ++n) { bf16_t* chp = O + (size_t)(ch0 + bj * HALF + n * 16) * ldt + t0;
#pragma unroll
                for (int ai = 0; ai < 2; ++ai)
#pragma unroll
                    for (int m = 0; m < 4; ++m) { const f32x4 v = acc[ai][bj][m][n]; u32x2 w; w.x = cvt_pk_bf16(v[0], v[1]); w.y = cvt_pk_bf16(v[2], v[3]); *(u32x2*)(chp + ai * HALF + m * 16) = w; } }
    }
};

template <class Epi, class Sched, bool ALIGN_EPI = false, bool GATHER = false>
__device__ __forceinline__ void gemm_phase(PG8_LAS unsigned char* lds, const int K, const Sched& S, const Epi& E, const PG8_LAS int* ridx = nullptr) {
    const int tid = threadIdx.x, wid = __builtin_amdgcn_readfirstlane(tid >> 6), lane = tid & 63, wr = wid >> 2, wc = wid & 3, fr = lane & 15, fq = lane >> 4;
    const int nt = K / BK;
    unsigned vA0[2], vA1[2], vN0[2], vN1[2], voffB[2]; int stR[2], stC[2];
    const size_t kstep = (size_t)(BK * 2);
    const size_t hstep = (size_t)HALF * K * 2;
    const size_t kstepB = Sched::CHUNK_B ? (size_t)(BK / 8) * 2048 * 16 : kstep, hstepB = Sched::CHUNK_B ? (size_t)HALF * 16 : hstep;
#pragma unroll
    for (int i = 0; i < 2; ++i) { int R, C; stage_rc(tid * 16 + i * 8192, R, C); const int Rb = Epi::PERM ? ((R & ~31) + perm32(R & 31)) : R; stR[i] = R; stC[i] = C;
        voffB[i] = Sched::CHUNK_B ? (unsigned)(((C >> 3) * 2048 + Rb) * 16) : (unsigned)(Rb * K + C) * 2u;
        if constexpr (GATHER) { vA0[i] = (unsigned)(ridx[R] * K + C) * 2u; vA1[i] = (unsigned)(ridx[HALF + R] * K + C) * 2u; }
        else { vA0[i] = (unsigned)(R * K + C) * 2u; vA1[i] = vA0[i] + (unsigned)hstep; }
        vN0[i] = vA0[i]; vN1[i] = vA1[i]; }
    const unsigned ldsw = (unsigned)wid * 1024u;
    const int aoff = lds_byte(wr * 64 + fr, fq * 8), boff = lds_byte(wc * 32 + fr, fq * 8);
#define PG8_SA(b, h) (((b) * 2 + (h)) * HTB)
#define PG8_SB(b, h) ((4 + (b) * 2 + (h)) * HTB)
#define PG8_STAGE(bufoff, gbase, voff) do { _Pragma("unroll") for (int _i = 0; _i < 2; ++_i) \
        __builtin_amdgcn_global_load_lds((const unsigned*)((const char*)(gbase) + (voff)[_i]), (PG8_LAS unsigned*)(lds + (bufoff) + ldsw + _i * 8192), 16, 0, 0); } while (0)
#define PG8_LDA(dst, b, h) do { _Pragma("unroll") for (int m = 0; m < 4; ++m) _Pragma("unroll") for (int k = 0; k < 2; ++k) dst[m][k] = *(const PG8_LAS bf16x8*)(lds + PG8_SA(b, h) + aoff + m * 2048 + k * 1024); } while (0)
#define PG8_LDB(dst, b, h) do { _Pragma("unroll") for (int n = 0; n < 2; ++n) _Pragma("unroll") for (int k = 0; k < 2; ++k) dst[n][k] = *(const PG8_LAS bf16x8*)(lds + PG8_SB(b, h) + boff + n * 2048 + k * 1024); } while (0)
#define PG8_MMA(ai, bj, At, Bt) do { __builtin_amdgcn_s_setprio(1); _Pragma("unroll") for (int m = 0; m < 4; ++m) _Pragma("unroll") for (int n = 0; n < 2; ++n) _Pragma("unroll") for (int k = 0; k < 2; ++k) \
        acc[ai][bj][m][n] = Epi::SWAP ? __builtin_amdgcn_mfma_f32_16x16x32_bf16(At[m][k], Bt[n][k], acc[ai][bj][m][n], 0, 0, 0) : __builtin_amdgcn_mfma_f32_16x16x32_bf16(Bt[n][k], At[m][k], acc[ai][bj][m][n], 0, 0, 0); __builtin_amdgcn_s_setprio(0); } while (0)
#define PG8_WAIT_V(n) asm volatile("s_waitcnt vmcnt(" #n ")" ::: "memory")
#define PG8_WAIT_L(n) asm volatile("s_waitcnt lgkmcnt(" #n ")" ::: "memory")
#define PG8_BAR __builtin_amdgcn_s_barrier()
#define PG8_SCHED __builtin_amdgcn_sched_barrier(0)
    Unit cur, nxt; int ui = 0;
    if (!S.next(0, cur)) return;
    f32x4 acc[2][2][4][2];
    if constexpr (Epi::INIT) E.init(acc, cur, wr, wc, fr, fq);
    else {
#pragma unroll
    for (int a = 0; a < 2; ++a)
#pragma unroll
        for (int b = 0; b < 2; ++b)
#pragma unroll
            for (int m = 0; m < 4; ++m)
#pragma unroll
                for (int n = 0; n < 2; ++n) acc[a][b][m][n] = (f32x4){0.f, 0.f, 0.f, 0.f};
    }
    bf16x8 At[4][2], B0[2][2], B1[2][2];
    const char* cA = cur.a; const char* cB = cur.b;
    PG8_STAGE(PG8_SB(0, 0), cB, voffB); PG8_STAGE(PG8_SB(0, 1), cB + hstepB, voffB); PG8_STAGE(PG8_SA(0, 0), cA, vA0); PG8_STAGE(PG8_SA(0, 1), cA, vA1);
    if (wr == 1) PG8_BAR;
    PG8_WAIT_V(2); PG8_BAR;
    PG8_STAGE(PG8_SB(1, 0), cB + kstepB, voffB); PG8_STAGE(PG8_SA(1, 0), cA + kstep, vA0); PG8_STAGE(PG8_SB(1, 1), cB + hstepB + kstepB, voffB);
    PG8_WAIT_V(6); PG8_BAR;
    for (;;) {
        const bool has_next = S.next(ui + 1, nxt);
        const char* nA = has_next ? nxt.a : cA; const char* nB = has_next ? nxt.b : cB;
        if constexpr (GATHER) { if (has_next) {
#pragma unroll
            for (int i = 0; i < 2; ++i) { vN0[i] = (unsigned)(ridx[(ui + 1) * 256 + stR[i]] * K + stC[i]) * 2u; vN1[i] = (unsigned)(ridx[(ui + 1) * 256 + HALF + stR[i]] * K + stC[i]) * 2u; } } }
        for (int t = 0; t < nt; t += 2) {
            const bool last = (t == nt - 2);
            const char* a1 = cA + (size_t)(t + 1) * kstep;
            const char* a2 = last ? nA : cA + (size_t)(t + 2) * kstep; const char* b2 = last ? nB : cB + (size_t)(t + 2) * kstepB;
            const char* a3 = a2 + kstep; const char* b3 = b2 + kstepB;
            unsigned w0[2], w1[2];
#pragma unroll
            for (int i = 0; i < 2; ++i) { w0[i] = last ? vN0[i] : vA0[i]; w1[i] = last ? vN1[i] : vA1[i]; }
            PG8_LDB(B0, 0, 0); PG8_LDB(B1, 0, 1); PG8_SCHED; PG8_LDA(At, 0, 0); PG8_STAGE(PG8_SA(1, 1), a1, vA1);
            PG8_WAIT_V(8); PG8_WAIT_L(0); PG8_BAR; PG8_MMA(0, 0, At, B0); PG8_MMA(0, 1, At, B1); PG8_BAR; PG8_SCHED;
            PG8_LDA(At, 0, 1); PG8_STAGE(PG8_SB(0, 0), b2, voffB); PG8_STAGE(PG8_SB(0, 1), b2 + hstepB, voffB); PG8_STAGE(PG8_SA(0, 0), a2, w0);
            PG8_WAIT_V(8); PG8_WAIT_L(0); PG8_BAR; PG8_MMA(1, 0, At, B0); PG8_MMA(1, 1, At, B1); PG8_BAR; PG8_SCHED;
            PG8_LDB(B0, 1, 0); PG8_LDB(B1, 1, 1); PG8_SCHED; PG8_LDA(At, 1, 0); PG8_STAGE(PG8_SA(0, 1), a2, w1);
            PG8_WAIT_V(8); PG8_WAIT_L(0); PG8_BAR; PG8_MMA(0, 0, At, B0); PG8_MMA(0, 1, At, B1); PG8_BAR; PG8_SCHED;
            PG8_LDA(At, 1, 1); PG8_STAGE(PG8_SB(1, 0), b3, voffB); PG8_STAGE(PG8_SB(1, 1), b3 + hstepB, voffB); PG8_STAGE(PG8_SA(1, 0), a3, w0);
            PG8_WAIT_V(8); PG8_WAIT_L(0); PG8_BAR; PG8_MMA(1, 0, At, B0); PG8_MMA(1, 1, At, B1); PG8_BAR; PG8_SCHED;
        }
        if constexpr (ALIGN_EPI) { if (wr == 0) PG8_BAR; }
        E(acc, cur, wr, wc, fr, fq);
        if (!has_next) break;
        if constexpr (Epi::INIT) E.init(acc, nxt, wr, wc, fr, fq);
        else {
#pragma unroll
        for (int a = 0; a < 2; ++a)
#pragma unroll
            for (int b = 0; b < 2; ++b)
#pragma unroll
                for (int m = 0; m < 4; ++m)
#pragma unroll
                    for (int n = 0; n < 2; ++n) acc[a][b][m][n] = (f32x4){0.f, 0.f, 0.f, 0.f};
        }
        cur = nxt; cA = nA; cB = nB; ++ui;
#pragma unroll
        for (int i = 0; i < 2; ++i) { vA0[i] = vN0[i]; vA1[i] = vN1[i]; }
        if constexpr (ALIGN_EPI) { if (wr == 1) PG8_BAR; }
    }
    PG8_WAIT_V(0);
    if constexpr (!ALIGN_EPI) { if (wr == 0) PG8_BAR; }
    PG8_BAR;
#undef PG8_SA
#undef PG8_SB
#undef PG8_STAGE
#undef PG8_LDA
#undef PG8_LDB
#undef PG8_MMA
#undef PG8_WAIT_V
#undef PG8_WAIT_L
#undef PG8_BAR
#undef PG8_SCHED
}
}

constexpr int NB = 2, SEQ = 4096, DM = 2048, MT = NB * SEQ;
constexpr int NH = 8, HD = 128, AW = 1024, HW = 1024, INW = 6144;
constexpr int GW = 64, NROWS = 64, WR = 8, WC = 16;
constexpr int NE = 16, CAP = 512, FF = 1024;
constexpr int FEMB = 33, FHID = 64;
constexpr float EPS = 1e-6f;
constexpr int NWAVES = 8, NTHREADS = 512;

constexpr size_t MiB = 1u << 20;
constexpr size_t WS_CTL = 0, CTL_ZERO_BYTES = 32768;
constexpr size_t WS_WIN = 2 * MiB;
constexpr size_t WS_WOUT = 26 * MiB;
constexpr size_t WS_WGU = 34 * MiB;
constexpr size_t WS_WD = 162 * MiB;
constexpr size_t WS_W3T = 226 * MiB;
constexpr size_t WS_HID2 = 227 * MiB;
constexpr size_t WS_HB = 228 * MiB;
constexpr size_t WS_QK = 260 * MiB;
constexpr size_t WS_XT = 292 * MiB;
constexpr size_t WS_UC = 356 * MiB;
constexpr size_t WS_TAPS = 404 * MiB;
constexpr size_t WS_HYT = 436 * MiB;
constexpr size_t WS_MIXED = 452 * MiB;
constexpr size_t WS_AFF = 484 * MiB;
constexpr size_t WS_IDX = 485 * MiB;
constexpr size_t WS_GATE = 486 * MiB;
constexpr size_t WS_SEL = 487 * MiB;
constexpr size_t WS_Z1T = 488 * MiB;
constexpr size_t WS_XG = WS_XT;
constexpr size_t WS_ACT = WS_UC;
constexpr size_t WS_YE = WS_TAPS;
constexpr size_t WS_END = 504 * MiB;

constexpr int LDS_BYTES = 163840, LDS_MISC_OFF = 163840 - 128;

#define GAS __attribute__((address_space(1)))
#define LAS __attribute__((address_space(3)))
typedef unsigned short bf16;
typedef unsigned v4u __attribute__((ext_vector_type(4)));
typedef unsigned v2u __attribute__((ext_vector_type(2)));
typedef float f32x4 __attribute__((ext_vector_type(4)));
#define LDS_WAIT() asm volatile("s_waitcnt lgkmcnt(0)" ::: "memory")
#define VM_WAIT() asm volatile("s_waitcnt vmcnt(0)" ::: "memory")
__device__ __forceinline__ unsigned f2bf(float f) { unsigned u = __builtin_bit_cast(unsigned, f); return (u + 0x7fffu + ((u >> 16) & 1u)) >> 16; }
__device__ __forceinline__ unsigned pk2(float lo, float hi) { unsigned r; asm("v_cvt_pk_bf16_f32 %0, %1, %2" : "=v"(r) : "v"(lo), "v"(hi)); return r; }
__device__ __forceinline__ float bf2f(unsigned h) { return __builtin_bit_cast(float, h << 16); }
__device__ __forceinline__ float bflo(unsigned w) { return __builtin_bit_cast(float, w << 16); }
__device__ __forceinline__ float bfhi(unsigned w) { return __builtin_bit_cast(float, w & 0xffff0000u); }
__device__ __forceinline__ float wave_sum(float v) {
#pragma unroll
    for (int o = 1; o < 64; o <<= 1) v += __shfl_xor(v, o);
    return v;
}


#define XB_TMO      128
#define XB_XCNT(j)  (256  + 64 * (j))
#define XB_XSUB(j)  (1280 + 64 * (j))
#define XB_XGEN(j)  (2304 + 64 * (j))
#define XB_TOP      3328
#define XB_TOPGEN   3392
#define XCD_BAR_WORDS 3456
#define XB_SPIN_CAP (1u << 22)
__device__ __forceinline__ unsigned xb_ld(unsigned* p)              { return __hip_atomic_load(p, __ATOMIC_RELAXED, __HIP_MEMORY_SCOPE_AGENT); }
__device__ __forceinline__ unsigned xb_add(unsigned* p, unsigned v) { return __hip_atomic_fetch_add(p, v, __ATOMIC_RELAXED, __HIP_MEMORY_SCOPE_AGENT); }
__device__ __forceinline__ unsigned xb_xcc_id() { return (unsigned)__builtin_amdgcn_s_getreg((3 << 11) | 20) & 0xFu; }
#define XB_SPIN(cond, bar) do { unsigned _sp = 0; while (cond) { __builtin_amdgcn_s_sleep(1); \
    if ((++_sp & 255u) == 0u) { if (xb_ld(&(bar)[XB_TMO])) break; if (_sp > XB_SPIN_CAP) { atomicAdd(&(bar)[XB_TMO], 1u); break; } } } } while (0)
struct XcdBarrier { unsigned* bar; unsigned x; volatile LAS unsigned* st; };
__device__ __forceinline__ XcdBarrier xcd_barrier_post(unsigned* bar, volatile LAS unsigned* st) {
    XcdBarrier b; b.bar = bar; b.x = xb_xcc_id(); b.st = st;
    if (threadIdx.x == 0) (void)xb_add(&bar[XB_XCNT(b.x)], 1u);
    return b;
}
__device__ __forceinline__ void xcd_barrier_complete(unsigned* bar, unsigned x, unsigned& nloc, unsigned& nx) {
    const unsigned G = gridDim.x * gridDim.y * gridDim.z;
    unsigned sum, cnt, mine, sp = 0u;
    for (;;) {
        sum = 0u; cnt = 0u; mine = 0u;
#pragma unroll
        for (unsigned j = 0; j < 16; ++j) { const unsigned c = xb_ld(&bar[XB_XCNT(j)]); sum += c; cnt += (c > 0u) ? 1u : 0u; mine = (j == x) ? c : mine; }
        if (sum == G) break;
        __builtin_amdgcn_s_sleep(1);
        if ((++sp & 255u) == 0u) { if (xb_ld(&bar[XB_TMO])) break; if (sp > XB_SPIN_CAP) { atomicAdd(&bar[XB_TMO], 1u); break; } }
    }
    nloc = mine > 0u ? mine : 1u; nx = cnt > 0u ? cnt : 1u;
}
__device__ __forceinline__ void xcd_barrier(const XcdBarrier& b) {
    asm volatile("s_waitcnt vmcnt(0)" ::: "memory");
    __syncthreads();
    if (threadIdx.x == 0) {
        unsigned* bar = b.bar;
        __builtin_amdgcn_s_waitcnt(0);
        unsigned nloc = b.st[0], nx = b.st[1];
        if (nloc == 0u) { xcd_barrier_complete(bar, b.x, nloc, nx); b.st[0] = nloc; b.st[1] = nx; }
        const unsigned old = xb_add(&bar[XB_XSUB(b.x)], 1u);
        const unsigned gen = old / nloc;
        if (old + 1u == (gen + 1u) * nloc) {
            __builtin_amdgcn_fence(__ATOMIC_RELEASE, "agent");
            asm volatile("s_waitcnt vmcnt(0)" ::: "memory");
            const unsigned og = xb_add(&bar[XB_TOP], 1u);
            const unsigned tg = og / nx;
            if (og + 1u == (tg + 1u) * nx) xb_add(&bar[XB_TOPGEN], 1u);
            else XB_SPIN(xb_ld(&bar[XB_TOPGEN]) == tg, bar);
            __builtin_amdgcn_fence(__ATOMIC_ACQUIRE, "agent");
            xb_add(&bar[XB_XGEN(b.x)], 1u);
            asm volatile("s_waitcnt vmcnt(0)" ::: "memory");
        } else {
            XB_SPIN(xb_ld(&bar[XB_XGEN(b.x)]) == gen, bar);
            __builtin_amdgcn_fence(__ATOMIC_ACQUIRE, "agent");
            asm volatile("s_waitcnt vmcnt(0)" ::: "memory");
        }
    }
    __syncthreads();
}

__device__ unsigned g_bar_words[XCD_BAR_WORDS + 64];
struct Frame {
    LAS unsigned char* lds;
    int tid, lane, wave, G, bid;
    const float* in[23]; float* out; unsigned char* ws;
};
#define GW_ID(F) ((F).bid * NWAVES + (F).wave)
#define GW_N(F) ((F).G * NWAVES)

__device__ __forceinline__ void p0_transpose_item(const float* W, int K, int N, bf16* WT, int row_base, int k0, int n0, LAS float* scr, int lane) {
    float t_[32];
#pragma unroll
    for (int i = 0; i < 32; ++i) { const int kk = 2 * i + (lane >> 5); t_[i] = W[(size_t)(k0 + kk) * N + n0 + (lane & 31)]; }
#pragma unroll
    for (int i = 0; i < 32; ++i) { const int kk = 2 * i + (lane >> 5); scr[kk * 33 + (lane & 31)] = t_[i]; }
    LDS_WAIT(); asm volatile("" ::: "memory");
    const int c = lane & 7;
#pragma unroll
    for (int j = 0; j < 4; ++j) { const int n = (lane >> 3) + 8 * j; const LAS float* s = scr + (8 * c) * 33 + n;
        v4u o; o.x = pk2(s[0 * 33], s[1 * 33]); o.y = pk2(s[2 * 33], s[3 * 33]); o.z = pk2(s[4 * 33], s[5 * 33]); o.w = pk2(s[6 * 33], s[7 * 33]);
        *(GAS v4u*)(WT + (size_t)(row_base + n) * K + k0 + 8 * c) = o; }
    LDS_WAIT(); asm volatile("" ::: "memory");
}
__device__ __forceinline__ void phase_p0(Frame& F) {
    LAS float* scr = (LAS float*)(F.lds + F.wave * 16384);
    const int gw = GW_ID(F), NGW = GW_N(F);
    bf16* WinT = (bf16*)(F.ws + WS_WIN); bf16* WoutT = (bf16*)(F.ws + WS_WOUT); bf16* W3T = (bf16*)(F.ws + WS_W3T);
    constexpr int I_IN = (DM / 64) * (INW / 32), I_OUT = (DM / 64) * (DM / 32), I_3 = 1 * (4096 / 32);
    constexpr int NITEMS = I_IN + I_OUT + I_3;
    for (int it = gw; it < NITEMS; it += NGW) {
        int r = it;
        if (r < I_IN) { const int nblk = INW / 32, kb = r / nblk, nb = r % nblk; p0_transpose_item(F.in[2], DM, INW, WinT, 32 * nb, 64 * kb, 32 * nb, scr, F.lane); continue; } r -= I_IN;
        if (r < I_OUT) { const int nblk = DM / 32, kb = r / nblk, nb = r % nblk; p0_transpose_item(F.in[17], DM, DM, WoutT, 32 * nb, 64 * kb, 32 * nb, scr, F.lane); continue; } r -= I_OUT;
        { const int nb = r; p0_transpose_item(F.in[12], FHID, 4096, W3T, 32 * nb, 0, 32 * nb, scr, F.lane); }
    }
    bf16* HB = (bf16*)(F.ws + WS_HB);
    const float* x = F.in[0]; const float* g = F.in[1];
    f32x4 gv[8];
#pragma unroll
    for (int j = 0; j < 8; ++j) gv[j] = *((const GAS f32x4*)g + F.lane + 64 * j);
    f32x4 vn[8];
    if (gw < MT) { const GAS f32x4* xr = (const GAS f32x4*)(x + (size_t)gw * DM) + F.lane;
#pragma unroll
        for (int j = 0; j < 8; ++j) vn[j] = xr[64 * j]; }
    for (int m = gw; m < MT; m += NGW) {
        f32x4 v[8]; float s = 0.f;
#pragma unroll
        for (int j = 0; j < 8; ++j) { v[j] = vn[j]; s += (v[j].x * v[j].x + v[j].y * v[j].y) + (v[j].z * v[j].z + v[j].w * v[j].w); }
        if (m + NGW < MT) { const GAS f32x4* xr = (const GAS f32x4*)(x + (size_t)(m + NGW) * DM) + F.lane;
#pragma unroll
            for (int j = 0; j < 8; ++j) vn[j] = xr[64 * j]; }
        const float r = rsqrtf(wave_sum(s) * (1.f / DM) + EPS);
        GAS v2u* o8 = (GAS v2u*)(HB + (size_t)m * DM) + F.lane;
#pragma unroll
        for (int j = 0; j < 8; ++j) { const f32x4 gg = gv[j]; v2u o; o.x = pk2(v[j].x * r * gg.x, v[j].y * r * gg.y); o.y = pk2(v[j].z * r * gg.z, v[j].w * r * gg.w); o8[64 * j] = o; }
    }
    float* HID2 = (float*)(F.ws + WS_HID2);
    LAS float* sc2 = (LAS float*)(F.lds + F.wave * 16384);
    const float* w1 = F.in[8]; const float* b1 = F.in[9]; const float* w2 = F.in[10]; const float* b2 = F.in[11]; const float* fr = F.in[13];
    float w1c[FEMB], w2c[FHID];
    { const int j = F.lane;
#pragma unroll
      for (int i = 0; i < FEMB; ++i) w1c[i] = w1[i * FHID + j];
#pragma unroll
      for (int i = 0; i < FHID; ++i) w2c[i] = w2[i * FHID + j]; }
    for (int l = gw; l < SEQ; l += NGW) {
        const int j = F.lane;
        float zv = 0.f;
        if (j == 0) zv = (float)l / (float)(SEQ - 1);
        else if (j < FEMB) { const int k = (j - 1) & 15; const float f = 1e-4f + (float)k * ((15.0f - 1e-4f) / 15.0f); const float wv = 6.283185307179586f * (float)l / (float)SEQ; zv = (j <= 16) ? cosf(f * wv) : -sinf(f * wv); }
        sc2[j] = zv; LDS_WAIT(); asm volatile("" ::: "memory");
        float a = b1[j];
#pragma unroll
        for (int i = 0; i < FEMB; ++i) a += sc2[i] * w1c[i];
        const float h1 = sinf(fr[j] * a);
        sc2[64 + j] = h1; LDS_WAIT(); asm volatile("" ::: "memory");
        float c = b2[j];
#pragma unroll
        for (int i = 0; i < FHID; ++i) c += sc2[64 + i] * w2c[i];
        HID2[l * FHID + j] = sinf(fr[j] * c);
        LDS_WAIT(); asm volatile("" ::: "memory");
    }
}

typedef short bf16x8 __attribute__((ext_vector_type(8)));
typedef float f32x16 __attribute__((ext_vector_type(16)));
__device__ __forceinline__ void phase_filters(Frame& F) {
    const float* HID2 = (const float*)(F.ws + WS_HID2); const bf16* W3T = (const bf16*)(F.ws + WS_W3T); const float* fbias = F.in[14]; bf16* TAPS = (bf16*)(F.ws + WS_TAPS);
    const int n = F.lane & 31, hh = F.lane >> 5;
    const float mind = -4.605170185988091f / 1.5f, maxd = -4.605170185988091f / 0.3f;
    LAS bf16* scr = (LAS bf16*)(F.lds + F.wave * 4096);
    for (int task = GW_ID(F); task < 128 * 16; task += GW_N(F)) {
        const int l0 = (task & 127) * 32, cg = task >> 7;
        const int dir = (cg >> 2) & 1, o = cg >> 3;
        const int l = l0 + dir + n;
        bf16x8 hb[4];
        { const int lr = l < SEQ ? l : SEQ - 1;
#pragma unroll
          for (int ks = 0; ks < 4; ++ks) { const GAS f32x4* hp = (const GAS f32x4*)(HID2 + (size_t)lr * FHID + 16 * ks + 8 * hh); const f32x4 h0 = hp[0], h1 = hp[1];
              v4u bw; bw.x = pk2(h0.x, h0.y); bw.y = pk2(h0.z, h0.w); bw.z = pk2(h1.x, h1.y); bw.w = pk2(h1.z, h1.w); hb[ks] = __builtin_bit_cast(bf16x8, bw); } }
        const float t = (float)l / (float)(SEQ - 1);
        const int pos = dir ? 31 - n : n;
        const int idx0 = dir ? 4064 - l0 : 4096 + l0;
        bf16x8 an[4];
#pragma unroll
        for (int ks = 0; ks < 4; ++ks) an[ks] = *(const GAS bf16x8*)(W3T + (size_t)(cg * 8 * 32 + n) * FHID + 16 * ks + 8 * hh);
#pragma unroll 2
        for (int ct = 0; ct < 8; ++ct) {
            const int col0 = (cg * 8 + ct) * 32;
            f32x16 acc;
#pragma unroll
            for (int i = 0; i < 16; ++i) acc[i] = 0.f;
            bf16x8 ac[4];
#pragma unroll
            for (int ks = 0; ks < 4; ++ks) ac[ks] = an[ks];
            { const int coln = (cg * 8 + (ct < 7 ? ct + 1 : ct)) * 32;
#pragma unroll
              for (int ks = 0; ks < 4; ++ks) an[ks] = *(const GAS bf16x8*)(W3T + (size_t)(coln + n) * FHID + 16 * ks + 8 * hh); }
#pragma unroll
            for (int ks = 0; ks < 4; ++ks) acc = __builtin_amdgcn_mfma_f32_32x32x16_bf16(ac[ks], hb[ks], acc, 0, 0, 0);
#pragma unroll
            for (int i = 0; i < 16; ++i) {
                const int chl = (i & 3) + 8 * (i >> 2) + 4 * hh, c = (col0 & 1023) + chl;
                const float delta = fabsf(mind + (maxd - mind) * ((float)c / 1023.0f));
                float v = acc[i] * __expf(-t * delta);
                if (l >= SEQ) v = 0.f;
                scr[chl * 40 + pos] = (bf16)f2bf(v);
            }
            LDS_WAIT(); asm volatile("" ::: "memory");
#pragma unroll
            for (int j = 0; j < 2; ++j) { const int id = F.lane + 64 * j, chl = id >> 2, q = id & 3;
                const v4u w = *(const LAS v4u*)(scr + chl * 40 + 8 * q);
                *(GAS v4u*)(TAPS + ((size_t)((col0 & 1023) + chl) * 2 + o) * 8192 + idx0 + 8 * q) = w; }
            LDS_WAIT(); asm volatile("" ::: "memory");
        }
    }
}

constexpr int HY_TAPS_BYTES = 4 * 16384, HY_ZB_ENT = 6080, HY_ZB_BYTES = 12288;
__device__ __forceinline__ unsigned hy_zb_off(int idx0  ) { const int q = idx0 >> 3; return (unsigned)((q ^ ((q >> 4) & 3)) << 4); }
__device__ __forceinline__ const LAS unsigned char* hy_pm(const LAS unsigned char* zbl  , int g, int ip, int hh) {
    const int q0 = 124 - 4 * ip + 2 * g + hh;
    unsigned p = (unsigned)(size_t)zbl + (unsigned)(((q0 ^ ((q0 >> 4) & 3)) << 4) - 7168);
    asm volatile("" : "+v"(p));
    return (const LAS unsigned char*)(size_t)p;
}
template <int MASK>
__device__ __forceinline__ void hy_loadB(bf16x8 (&bf)[8], const LAS unsigned char* pm) {
#pragma unroll
    for (int tau = 0; tau < 8; ++tau) if (MASK & (1 << tau)) bf[tau] = *(const LAS bf16x8*)(pm + 1024 * (7 - tau));
}
__device__ __forceinline__ void hy_loadA(unsigned (&d)[5], const LAS bf16* taps, int g, int n, int hh) {
    const volatile LAS unsigned* dp = (const volatile LAS unsigned*)taps + ((1 + 8 * hh + n) >> 1) + 8 * g;
#pragma unroll
    for (int i = 0; i < 5; ++i) d[i] = dp[i];
}
template <int MASK>
__device__ __forceinline__ void hy_mma(f32x16 (&acc)[8], const bf16x8 a, const bf16x8 (&bf)[8]) {
#pragma unroll
    for (int tau = 0; tau < 8; ++tau) if (MASK & (1 << tau)) acc[tau] = __builtin_amdgcn_mfma_f32_32x32x16_bf16(a, bf[tau], acc[tau], 0, 0, 0);
}
#define HY_ALIGN(a, d) do { v4u aw_; aw_.x = __builtin_amdgcn_alignbyte(d[1], d[0], sh); aw_.y = __builtin_amdgcn_alignbyte(d[2], d[1], sh); aw_.z = __builtin_amdgcn_alignbyte(d[3], d[2], sh); aw_.w = __builtin_amdgcn_alignbyte(d[4], d[3], sh); a = __builtin_bit_cast(bf16x8, aw_); } while (0)
#define HY_INTERLEAVE() do { __builtin_amdgcn_sched_group_barrier(0x2, 4, 0); _Pragma("unroll") for (int i_ = 0; i_ < 9; ++i_) { __builtin_amdgcn_sched_group_barrier(0x8, 1, 0); __builtin_amdgcn_sched_group_barrier(0x100, 3, 0); __builtin_amdgcn_sched_group_barrier(0x2, 3, 0); } } while (0)
constexpr int HY_YOFF = 254;
template <int MASK>
__device__ __forceinline__ void hy_mma_reload(f32x16 (&acc)[8], const bf16x8 a, bf16x8 (&bf)[8], const LAS unsigned char* pm_next) {
#pragma unroll
    for (int tau = 0; tau < 8; ++tau) if (MASK & (1 << tau)) {
        acc[tau] = __builtin_amdgcn_mfma_f32_32x32x16_bf16(a, bf[tau], acc[tau], 0, 0, 0);
        bf[tau] = *(const LAS bf16x8*)(pm_next + 1024 * (7 - tau));
    }
}
template <int MX, int MY>
__device__ __forceinline__ void hy_segment(f32x16 (&acc)[8], const LAS bf16* taps, const LAS unsigned char* zbl, int i0, int i1, int n, int hh) {
    const unsigned sh = (n & 1) ? 0u : 2u;
    const int ip = n & 15;
    unsigned dx[5], dy[5]; bf16x8 a, x0[8], y0[8];
    hy_loadA(dx, taps, i0, n, hh); hy_loadA(dy, taps, i0 + HY_YOFF, n, hh); hy_loadB<MX>(x0, hy_pm(zbl, i0, ip, hh)); hy_loadB<MY>(y0, hy_pm(zbl, i0 + HY_YOFF, ip, hh));
#pragma unroll 1
    for (int i = i0; i < i1; ++i) {
        if (MX) { HY_ALIGN(a, dx); hy_loadA(dx, taps, i + 1, n, hh); hy_mma_reload<MX>(acc, a, x0, hy_pm(zbl, i + 1, ip, hh)); }
        HY_ALIGN(a, dy); hy_loadA(dy, taps, i + 1 + HY_YOFF, n, hh); hy_mma_reload<MY>(acc, a, y0, hy_pm(zbl, i + 1 + HY_YOFF, ip, hh));
        HY_INTERLEAVE(); __builtin_amdgcn_sched_barrier(0);
    }
}
__device__ __forceinline__ void hy_stage_taps(Frame& F, int c0, int o) {
    const bf16* TAPS = (const bf16*)(F.ws + WS_TAPS);
    int tid = F.tid; asm volatile("" : "+v"(tid));
#pragma unroll
    for (int j = 0; j < 8; ++j) { const int ch = tid + NTHREADS * j, ci = ch >> 10, w = ch & 1023;
        v4u t = *((const GAS v4u*)(TAPS + ((size_t)(c0 + ci) * 2 + o) * 8192) + w);
        if (w == 512) { const float fb = F.in[14][o * 1024 + c0 + ci]; t.x = (t.x & 0xffff0000u) | f2bf(bflo(t.x) + fb); }
        *((LAS v4u*)(F.lds) + ch) = t; }
}
struct ConvItem { const float* W; bf16* WTe; int N, row_base, k0, n0; };
__device__ __forceinline__ void conv_load64(float (&v)[64], const ConvItem& c, int lane) {
    const GAS float* src = (const GAS float*)(c.W + (size_t)c.k0 * c.N + c.n0 + lane);
#pragma unroll
    for (int kk = 0; kk < 64; ++kk) v[kk] = src[(size_t)kk * c.N];
}
__device__ __forceinline__ void conv_store64(const float (&v)[64], const ConvItem& c, int lane) {
    GAS v4u* dst = (GAS v4u*)c.WTe + (size_t)(c.k0 >> 3) * 2048 + c.row_base + lane;
#pragma unroll
    for (int j = 0; j < 8; ++j) { v4u o; o.x = pk2(v[8 * j], v[8 * j + 1]); o.y = pk2(v[8 * j + 2], v[8 * j + 3]); o.z = pk2(v[8 * j + 4], v[8 * j + 5]); o.w = pk2(v[8 * j + 6], v[8 * j + 7]); dst[(size_t)j * 2048] = o; }
}
constexpr int MOE_ITEMS_GU = 2 * NE * 32 * 16, MOE_ITEMS_D = NE * 16 * 32, MOE_ITEMS = MOE_ITEMS_GU + MOE_ITEMS_D;
#ifndef MOE_P0_ITEMS
#define MOE_P0_ITEMS 0
#endif
#ifndef MOE_P4_ITEMS
#define MOE_P4_ITEMS 3584
#endif
constexpr int MOE_HELP_ITEMS = MOE_ITEMS - MOE_P0_ITEMS - MOE_P4_ITEMS;
__device__ __forceinline__ ConvItem moe_item(Frame& F, int it) {
    bf16* WguT = (bf16*)(F.ws + WS_WGU); bf16* WdT = (bf16*)(F.ws + WS_WD); ConvItem c;
    if (it < MOE_ITEMS_GU) { const int which = it >> 13, e = (it >> 9) & 15, kb = (it >> 4) & 31, nb = it & 15, f0 = 64 * nb;
        c.W = (which ? F.in[21] : F.in[20]) + (size_t)e * DM * FF; c.N = FF; c.WTe = WguT + (size_t)e * 2048 * DM; c.row_base = (f0 >> 7) * 256 + which * 128 + (f0 & 127); c.k0 = 64 * kb; c.n0 = f0;
    } else { const int r = it - MOE_ITEMS_GU, e = r >> 9, kb = (r >> 5) & 15, nb = r & 31;
        c.W = F.in[22] + (size_t)e * FF * DM; c.N = DM; c.WTe = WdT + (size_t)e * 2048 * FF; c.row_base = 64 * nb; c.k0 = 64 * kb; c.n0 = 64 * nb; }
    return c;
}
__device__ __forceinline__ void conv_range_moe_tail(Frame& F);
__device__ __forceinline__ void moe_conv_item(Frame& F, int it) { float v[64]; const ConvItem c = moe_item(F, it); conv_load64(v, c, F.lane); conv_store64(v, c, F.lane); }
__device__ __forceinline__ void moe_conv_range(Frame& F, int lo, int hi, int step) {
    if (lo >= hi) return;
    float va[64], vb[64];
    ConvItem ca = moe_item(F, lo), cb_; conv_load64(va, ca, F.lane);
    for (int it = lo; it < hi; it += 2 * step) {
        const bool hb = it + step < hi;
        if (hb) { cb_ = moe_item(F, it + step); conv_load64(vb, cb_, F.lane); }
        conv_store64(va, ca, F.lane);
        const bool ha = it + 2 * step < hi;
        if (ha) { ca = moe_item(F, it + 2 * step); conv_load64(va, ca, F.lane); }
        if (hb) conv_store64(vb, cb_, F.lane);
    }
}
__device__ __forceinline__ void conv_range_moe_tail(Frame& F) {
    const int w = (F.bid - NB * NE) * NWAVES + F.wave, nw = (F.G - NB * NE) * NWAVES;
    moe_conv_range(F, MOE_ITEMS - MOE_P4_ITEMS + w, MOE_ITEMS, nw);
}
__device__ __forceinline__ void hy_write_gates(Frame& F, int c0, int oo) {
    const bf16* XH = (const bf16*)(F.ws + WS_XT) + (size_t)1024 * MT; bf16* GC = (bf16*)(F.ws + WS_UC);
    const float* cw = F.in[6]; const float* cb = F.in[7];
    int ht = F.tid - 256; asm volatile("" : "+v"(ht));
#pragma unroll 2
    for (int k = 0; k < 16; ++k) { const int id = ht + 256 * k, u = id & 511, b = (id >> 9) & 1, ci = id >> 10;
        const int gch = oo * 1024 + c0 + ci; const bf16* gs = XH + (size_t)gch * MT + b * SEQ;
        const float w0 = cw[gch], w1 = cw[3072 + gch], w2 = cw[6144 + gch], bb = cb[gch];
        const v4u w = *((const GAS v4u*)gs + u);
        float f[10];
        f[1] = bflo(w.x); f[2] = bfhi(w.x); f[3] = bflo(w.y); f[4] = bfhi(w.y); f[5] = bflo(w.z); f[6] = bfhi(w.z); f[7] = bflo(w.w); f[8] = bfhi(w.w);
        { const float l_ = bf2f(gs[u > 0 ? 8 * u - 1 : 0]), r_ = bf2f(gs[u < 511 ? 8 * u + 8 : 8 * u + 7]); f[0] = u > 0 ? l_ : 0.f; f[9] = u < 511 ? r_ : 0.f; }
        float z[8];
#pragma unroll
        for (int e = 0; e < 8; ++e) z[e] = bb + w0 * f[e] + w1 * f[e + 1] + w2 * f[e + 2];
        v4u r; r.x = pk2(z[0], z[1]); r.y = pk2(z[2], z[3]); r.z = pk2(z[4], z[5]); r.w = pk2(z[6], z[7]);
        *((GAS v4u*)(GC + ((size_t)((c0 + ci) * 2 + oo) * 2 + b) * SEQ) + u) = r; }
}
__device__ __forceinline__ void phase_hyena(Frame& F) {
    const bf16* XH = (const bf16*)(F.ws + WS_XT) + (size_t)1024 * MT;
    const float* cw = F.in[6]; const float* cb = F.in[7];
    bf16* HYT = (bf16*)(F.ws + WS_HYT); bf16* GC = (bf16*)(F.ws + WS_UC);
    const int n = F.lane & 31, hh = F.lane >> 5;
    const bool compute = F.wave < 4;
    const int nhelp = F.G * 4, hw = F.bid * 4 + (F.wave - 4);
    int sec = 0;
    for (int cg = F.bid; cg < 256; cg += F.G) {
        const int c0 = cg * 4;
        __syncthreads();
        hy_stage_taps(F, c0, 0);
        {
          int lane_ = F.lane; asm volatile("" : "+v"(lane_));
          const int ci = F.wave >> 1, b = F.wave & 1; LAS unsigned char* zb = F.lds + HY_TAPS_BYTES + F.wave * HY_ZB_BYTES;
          const int zch = 2048 + c0 + ci; const bf16* zsrc = XH + (size_t)zch * MT + b * SEQ;
          const float w0 = cw[zch], w1 = cw[3072 + zch], w2 = cw[6144 + zch], bb = cb[zch];
#pragma unroll
          for (int j = 0; j < 8; ++j) { const int u = lane_ + 64 * j; const v4u w = *((const GAS v4u*)zsrc + u);
              float f[10];
              f[1] = bflo(w.x); f[2] = bfhi(w.x); f[3] = bflo(w.y); f[4] = bfhi(w.y); f[5] = bflo(w.z); f[6] = bfhi(w.z); f[7] = bflo(w.w); f[8] = bfhi(w.w);
              { const float l_ = bf2f(zsrc[u > 0 ? 8 * u - 1 : 0]), r_ = bf2f(zsrc[u < 511 ? 8 * u + 8 : 8 * u + 7]); f[0] = u > 0 ? l_ : 0.f; f[9] = u < 511 ? r_ : 0.f; }
              float z[8];
#pragma unroll
              for (int e = 0; e < 8; ++e) z[e] = bb + w0 * f[e] + w1 * f[e + 1] + w2 * f[e + 2];
              v4u r; r.x = pk2(z[7], z[6]); r.y = pk2(z[5], z[4]); r.z = pk2(z[3], z[2]); r.w = pk2(z[1], z[0]);
              *(LAS v4u*)(zb + hy_zb_off(8 * (635 - u))) = r; }
          const v4u zero = {0u, 0u, 0u, 0u};
          for (int q = lane_; q < 124; q += 64) { *(LAS v4u*)(zb + hy_zb_off(8 * q)) = zero; *(LAS v4u*)(zb + hy_zb_off(8 * (636 + q))) = zero; } }
        if (!compute) hy_write_gates(F, c0, 0);
        __syncthreads();
#pragma unroll 1
        for (int o = 0; o < 2; ++o) {
            if (compute) {
                const int ci = F.wave, c = c0 + ci;
                const LAS bf16* taps = (const LAS bf16*)(F.lds + ci * 16384);
                const int ip = n & 15, bl = n >> 4;
                LAS unsigned char* zbl = F.lds + HY_TAPS_BYTES + (2 * ci + bl) * HY_ZB_BYTES;
                f32x16 acc[8];
#pragma unroll
                for (int tau = 0; tau < 8; ++tau)
#pragma unroll
                    for (int i = 0; i < 16; ++i) acc[tau][i] = 0.f;
                hy_segment<0x01, 0xFF>(acc, taps, zbl, 0, 32, n, hh);
                hy_segment<0x03, 0xFE>(acc, taps, zbl, 32, 64, n, hh);
                hy_segment<0x07, 0xFC>(acc, taps, zbl, 64, 96, n, hh);
                hy_segment<0x0F, 0xF8>(acc, taps, zbl, 96, 128, n, hh);
                hy_segment<0x1F, 0xF0>(acc, taps, zbl, 128, 160, n, hh);
                hy_segment<0x3F, 0xE0>(acc, taps, zbl, 160, 192, n, hh);
                hy_segment<0x7F, 0xC0>(acc, taps, zbl, 192, 224, n, hh);
                hy_segment<0xFF, 0x80>(acc, taps, zbl, 224, 254, n, hh);
                hy_segment<0x00, 0x80>(acc, taps, zbl, 254, 256, n, hh);
                LDS_WAIT();
                int ip2 = ip, h2 = hh, b2 = bl; asm volatile("" : "+v"(ip2), "+v"(h2), "+v"(b2));
                {
                    const bf16* gate = GC + ((size_t)(c * 2 + o) * 2 + b2) * SEQ;
                    LAS unsigned char* zb = F.lds + HY_TAPS_BYTES + (2 * ci + b2) * HY_ZB_BYTES; bf16* outp = HYT + (size_t)c * MT + b2 * SEQ;
#pragma unroll
                    for (int th = 0; th < 2; ++th) {
                        v2u gw[4][4];
#pragma unroll
                        for (int tq = 0; tq < 4; ++tq)
#pragma unroll
                            for (int rg = 0; rg < 4; ++rg) gw[tq][rg] = *(const GAS v2u*)(gate + 512 * (4 * th + tq) + 32 * ip2 + 8 * rg + 4 * h2);
#pragma unroll
                        for (int tq = 0; tq < 4; ++tq) {
#pragma unroll
                            for (int rg = 0; rg < 4; ++rg) { const int tau = 4 * th + tq, t0 = 512 * tau + 32 * ip2 + 8 * rg + 4 * h2;
                                const float z0 = bflo(gw[tq][rg].x) * acc[tau][4 * rg + 0], z1 = bfhi(gw[tq][rg].x) * acc[tau][4 * rg + 1], z2 = bflo(gw[tq][rg].y) * acc[tau][4 * rg + 2], z3 = bfhi(gw[tq][rg].y) * acc[tau][4 * rg + 3];
                                if (o == 0) { v2u w; w.x = pk2(z3, z2); w.y = pk2(z1, z0);
                                    *(LAS v2u*)(zb + hy_zb_off(8 * (635 - (t0 >> 3))) + (h2 ? 0 : 8)) = w; }
                                else { v2u w; w.x = pk2(z0, z1); w.y = pk2(z2, z3); *(GAS v2u*)(outp + t0) = w; } } }
                    }
                }
            } else {
                if (o == 0) hy_write_gates(F, c0, 1);
                const int lo_it = MOE_P0_ITEMS + sec * (MOE_HELP_ITEMS / 2), hi_it = lo_it + MOE_HELP_ITEMS / 2;
                if (sec < 2) moe_conv_range(F, lo_it + hw, hi_it, nhelp);
            }
            ++sec;
            if (o == 0) {
                __syncthreads();
                hy_stage_taps(F, c0, 1);
                __syncthreads();
            }
        }
    }
    for (; sec < 2; ++sec) if (!compute) { const int lo_it = MOE_P0_ITEMS + sec * (MOE_HELP_ITEMS / 2), hi_it = lo_it + MOE_HELP_ITEMS / 2; moe_conv_range(F, lo_it + hw, hi_it, nhelp); }
    __syncthreads();
}

constexpr int AT_KBYTES = 16384, AT_VPITCH = 136, AT_VBYTES = 128 * AT_VPITCH, AT_STAGE = AT_KBYTES + AT_VBYTES, AT_RP_OFF = 2 * AT_STAGE;
__device__ __forceinline__ void phase_attn2(Frame& F) {
    const bf16* QK = (const bf16*)(F.ws + WS_QK); const bf16* VT = (const bf16*)(F.ws + WS_XT); bf16* MIXED = (bf16*)(F.ws + WS_MIXED);
    const float* rpb = F.in[5]; const float* og = F.in[15]; const float* qg = F.in[3]; const float* kg = F.in[4];
    LAS float* rt = (LAS float*)(F.lds + AT_RP_OFF);
    LAS float* gtab = (LAS float*)(F.lds + AT_RP_OFF + 8 * 2048);
    LAS float* ogt = gtab + HD;
    if (F.tid < HD) gtab[F.tid] = qg[F.tid] * kg[F.tid];
    const int n = F.lane & 31, hh = F.lane >> 5;
    for (int unit = F.bid; unit < NB * NH * 16; unit += F.G) {
        const int rq = unit & 15, h = (unit >> 4) & 7, b = unit >> 7, r0 = 4 * rq;
        const int r = r0 + (F.wave >> 1), wq = F.wave & 1;
        int kmin = r0 - WR / 2; kmin = kmin < 0 ? 0 : (kmin > NROWS - WR ? NROWS - WR : kmin);
        int kmax = r0 + 3 - WR / 2; kmax = (kmax < 0 ? 0 : (kmax > NROWS - WR ? NROWS - WR : kmax)) + WR - 1;
        int kr0 = r - WR / 2; kr0 = kr0 < 0 ? 0 : (kr0 > NROWS - WR ? NROWS - WR : kr0);
        const int nrows = kmax - kmin + 1;
        __syncthreads();
        if (F.tid < HD) ogt[F.tid] = og[h * HD + F.tid];
#pragma unroll
        for (int k_ = 0; k_ < 4; ++k_) { const int i = F.tid + NTHREADS * k_; if (i < 15 * 128) { const int dr_ = i >> 7, dcx = (i & 127) - 48, dcc = dcx < 0 ? 0 : (dcx > 30 ? 30 : dcx);
            const float v = rpb[h * 465 + dr_ * 31 + dcc] * 1.4426950408889634f; rt[i] = (dcx == dcc) ? v : 0.f; } }
        const int mq = b * SEQ + r * GW + 32 * wq + n, qc = 32 * wq + n;
        int c0 = qc - WC / 2; c0 = c0 < 0 ? 0 : (c0 > GW - WC ? GW - WC : c0);
        bf16x8 qf[8];
#pragma unroll
        for (int ks = 0; ks < 8; ++ks) qf[ks] = *(const GAS bf16x8*)(QK + (size_t)mq * 2048 + h * HD + 16 * ks + 8 * hh);
        float qscale;
        {
          f32x16 D;
#pragma unroll
          for (int i = 0; i < 16; ++i) D[i] = 0.f;
#pragma unroll
          for (int ks = 0; ks < 8; ++ks) D = __builtin_amdgcn_mfma_f32_32x32x16_bf16(qf[ks], qf[ks], D, 0, 0, 0);
          float dsel = 0.f; const int isel = (n & 3) + 4 * (n >> 3);
#pragma unroll
          for (int i = 0; i < 16; ++i) dsel = (i == isel) ? D[i] : dsel;
          const float other = __shfl_xor(dsel, 32);
          const float ssq = (((n >> 2) & 1) == hh) ? dsel : other;
          qscale = (0.08838834764831845f * 1.4426950408889634f) * rsqrtf(ssq * (1.f / HD) + EPS); }
        const unsigned long long wmask = (c0 >= 4 * hh) ? (0xFFFFull << (c0 - 4 * hh)) : (0xFFFFull >> (4 * hh - c0));
        const unsigned wm0 = (unsigned)wmask, wm1 = (unsigned)(wmask >> 32);
        const int rtl = 4 * hh - qc + 63;
        f32x16 O[4];
#pragma unroll
        for (int dt = 0; dt < 4; ++dt)
#pragma unroll
            for (int i = 0; i < 16; ++i) O[dt][i] = 0.f;
        float lsum = 0.f;
        v4u sk[2], sv[2];

        auto gload = [&](int kr) {
#pragma unroll
            for (int j = 0; j < 2; ++j) { const int id = F.tid + 512 * j;
                sk[j] = *(const GAS v4u*)(QK + (size_t)(b * SEQ + kr * GW + (id >> 4)) * 2048 + 1024 + h * HD + 8 * (id & 15));
                sv[j] = *(const GAS v4u*)(VT + (size_t)(h * HD + (id >> 3)) * MT + b * SEQ + kr * GW + 8 * (id & 7)); }
        };
        auto lstore = [&](int buf) {
            LAS unsigned char* kb = F.lds + buf * AT_STAGE; LAS unsigned char* vb = kb + AT_KBYTES;
#pragma unroll
            for (int j = 0; j < 2; ++j) { const int id = F.tid + 512 * j; const int key = id >> 4, c = id & 15;
                float f[8] = {bflo(sk[j].x), bfhi(sk[j].x), bflo(sk[j].y), bfhi(sk[j].y), bflo(sk[j].z), bfhi(sk[j].z), bflo(sk[j].w), bfhi(sk[j].w)};
                float ss = 0.f;
#pragma unroll
                for (int e = 0; e < 8; ++e) ss += f[e] * f[e];
                ss += __shfl_xor(ss, 1); ss += __shfl_xor(ss, 2); ss += __shfl_xor(ss, 4); ss += __shfl_xor(ss, 8);
                const float rk = rsqrtf(ss * (1.f / HD) + EPS);
                const f32x4 ga = *(const LAS f32x4*)(gtab + 8 * c), gb = *(const LAS f32x4*)(gtab + 8 * c + 4);
                v4u kn; kn.x = pk2(f[0] * rk * ga.x, f[1] * rk * ga.y); kn.y = pk2(f[2] * rk * ga.z, f[3] * rk * ga.w); kn.z = pk2(f[4] * rk * gb.x, f[5] * rk * gb.y); kn.w = pk2(f[6] * rk * gb.z, f[7] * rk * gb.w);
                *(LAS v4u*)(kb + key * 256 + ((c ^ (key & 15)) << 4)) = kn;
                const int d = id >> 3, cv = id & 7; LAS v2u* vp = (LAS v2u*)(vb + d * AT_VPITCH + cv * 16);
                v2u lo, hi; lo.x = sv[j].x; lo.y = sv[j].y; hi.x = sv[j].z; hi.y = sv[j].w; vp[0] = lo; vp[1] = hi; }
        };
        gload(kmin); lstore(0);
        __syncthreads();
#pragma unroll 1
        for (int j = 0; j < nrows; ++j) {
            const int kr = kmin + j, buf = j & 1;
            if (j + 1 < nrows) gload(kr + 1);
            if (kr >= kr0 && kr < kr0 + WR) {
                const LAS unsigned char* kb = F.lds + buf * AT_STAGE; const LAS unsigned char* vb = kb + AT_KBYTES;
                const int dr = kr - r + WR - 1;
                const LAS float* rrow = rt + dr * 128 + rtl;
#pragma unroll
                for (int kt = 0; kt < 2; ++kt) {
                    f32x16 S;
#pragma unroll
                    for (int i = 0; i < 16; ++i) S[i] = 0.f;
                    const int key = 32 * kt + n;
#pragma unroll
                    for (int ks = 0; ks < 8; ++ks) { const bf16x8 kf = *(const LAS bf16x8*)(kb + key * 256 + (((2 * ks + hh) ^ (key & 15)) << 4));
                        S = __builtin_amdgcn_mfma_f32_32x32x16_bf16(kf, qf[ks], S, 0, 0, 0); }
                    float p[16];
#pragma unroll
                    for (int i = 0; i < 16; ++i) { const int E = (i & 3) + 8 * (i >> 2);
                        const float e = __builtin_amdgcn_exp2f(S[i] * qscale + rrow[32 * kt + E]);
                        const unsigned keep = (unsigned)__builtin_amdgcn_sbfe((int)(kt ? wm1 : wm0), E, 1);
                        p[i] = __builtin_bit_cast(float, __builtin_bit_cast(unsigned, e) & keep); lsum += p[i]; }
                    v4u pw0, pw1;
                    pw0.x = pk2(p[0], p[1]); pw0.y = pk2(p[2], p[3]); pw0.z = pk2(p[4], p[5]); pw0.w = pk2(p[6], p[7]);
                    pw1.x = pk2(p[8], p[9]); pw1.y = pk2(p[10], p[11]); pw1.z = pk2(p[12], p[13]); pw1.w = pk2(p[14], p[15]);
                    const bf16x8 pf0 = __builtin_bit_cast(bf16x8, pw0), pf1 = __builtin_bit_cast(bf16x8, pw1);
#pragma unroll
                    for (int dt = 0; dt < 4; ++dt) {
                        const LAS unsigned char* vrow = vb + (32 * dt + n) * AT_VPITCH + (32 * kt + 4 * hh) * 2;
                        const v2u a0 = *(const LAS v2u*)(vrow), a1 = *(const LAS v2u*)(vrow + 16), a2 = *(const LAS v2u*)(vrow + 32), a3 = *(const LAS v2u*)(vrow + 48);
                        v4u f0, f1; f0.x = a0.x; f0.y = a0.y; f0.z = a1.x; f0.w = a1.y; f1.x = a2.x; f1.y = a2.y; f1.z = a3.x; f1.w = a3.y;
                        O[dt] = __builtin_amdgcn_mfma_f32_32x32x16_bf16(__builtin_bit_cast(bf16x8, f0), pf0, O[dt], 0, 0, 0);
                        O[dt] = __builtin_amdgcn_mfma_f32_32x32x16_bf16(__builtin_bit_cast(bf16x8, f1), pf1, O[dt], 0, 0, 0);
                    }
                }
            }
            if (j + 1 < nrows) lstore(buf ^ 1);
            __syncthreads();
        }
        lsum += __shfl_xor(lsum, 32);
        const float il = 1.f / lsum;
        float ss = 0.f;
#pragma unroll
        for (int dt = 0; dt < 4; ++dt)
#pragma unroll
            for (int i = 0; i < 16; ++i) { O[dt][i] *= il; ss += O[dt][i] * O[dt][i]; }
        ss += __shfl_xor(ss, 32);
        const float rr = rsqrtf(ss * (1.f / HD) + EPS);
        bf16* orow = MIXED + (size_t)mq * DM + h * HD;
#pragma unroll
        for (int dt = 0; dt < 4; ++dt)
#pragma unroll
            for (int rg = 0; rg < 4; ++rg) { const int d = 32 * dt + 8 * rg + 4 * hh; const f32x4 gg = *(const LAS f32x4*)(ogt + d);
                v2u w; w.x = pk2(O[dt][4 * rg + 0] * rr * gg.x, O[dt][4 * rg + 1] * rr * gg.y); w.y = pk2(O[dt][4 * rg + 2] * rr * gg.z, O[dt][4 * rg + 3] * rr * gg.w);
                *(GAS v2u*)(orow + d) = w; }
    }
    __syncthreads();
}

__device__ __forceinline__ void phase_p25(Frame& F) {
    const bf16* HYT = (const bf16*)(F.ws + WS_HYT); bf16* MIXED = (bf16*)(F.ws + WS_MIXED); const float* hg = F.in[16];
    LAS float* tile = (LAS float*)F.lds;
    LAS float* rs = (LAS float*)(F.lds + 128 * 65 * 4);
    for (int it = F.bid; it < 8 * (MT / 64); it += F.G) {
        const int gi = it & 7, m0 = (it >> 3) * 64;
        { const int ch = F.tid >> 2, t0 = (F.tid & 3) * 16; const bf16* p = HYT + (size_t)(gi * 128 + ch) * MT + m0 + t0;
          const v4u a = *(const GAS v4u*)p, b = *(const GAS v4u*)(p + 8);
          LAS float* d = tile + ch * 65 + t0;
          d[0] = bflo(a.x); d[1] = bfhi(a.x); d[2] = bflo(a.y); d[3] = bfhi(a.y); d[4] = bflo(a.z); d[5] = bfhi(a.z); d[6] = bflo(a.w); d[7] = bfhi(a.w);
          d[8] = bflo(b.x); d[9] = bfhi(b.x); d[10] = bflo(b.y); d[11] = bfhi(b.y); d[12] = bflo(b.z); d[13] = bfhi(b.z); d[14] = bflo(b.w); d[15] = bfhi(b.w); }
        __syncthreads();
        {
          const int t = F.tid >> 3, c0 = (F.tid & 7) * 16; float ss = 0.f;
#pragma unroll
          for (int c = 0; c < 16; ++c) { const float v = tile[(c0 + c) * 65 + t]; ss += v * v; }
          ss += __shfl_xor(ss, 1); ss += __shfl_xor(ss, 2); ss += __shfl_xor(ss, 4);
          if ((F.tid & 7) == 0) rs[t] = rsqrtf(ss * (1.f / 128) + EPS); }
        __syncthreads();
        {
          const int t = F.tid >> 3, c0 = (F.tid & 7) * 16; const float r = rs[t]; float o[16];
#pragma unroll
          for (int c = 0; c < 16; ++c) o[c] = tile[(c0 + c) * 65 + t] * r * hg[gi * 128 + c0 + c];
          v4u a, b; a.x = pk2(o[0], o[1]); a.y = pk2(o[2], o[3]); a.z = pk2(o[4], o[5]); a.w = pk2(o[6], o[7]); b.x = pk2(o[8], o[9]); b.y = pk2(o[10], o[11]); b.z = pk2(o[12], o[13]); b.w = pk2(o[14], o[15]);
          bf16* q = MIXED + (size_t)(m0 + t) * DM + AW + gi * 128 + c0; *(GAS v4u*)q = a; *(GAS v4u*)(q + 8) = b; }
        __syncthreads();
    }
}
__device__ __forceinline__ void phase_p35(Frame& F) {
    LAS float* wrT = (LAS float*)F.lds;
    const float* wr = F.in[19]; const float* g = F.in[18];
    constexpr int WRS = DM + 4;
    for (int i = F.tid; i < DM * NE; i += NTHREADS) { const int d = i >> 4, e = i & 15; wrT[e * WRS + d] = wr[i]; }
    __syncthreads();
    bf16* HB = (bf16*)(F.ws + WS_HB); float* AFF = (float*)(F.ws + WS_AFF); const float* x1 = F.out;
    f32x4 gv[8];
#pragma unroll
    for (int j = 0; j < 8; ++j) gv[j] = *((const GAS f32x4*)g + F.lane + 64 * j);
    f32x4 vn[8];
    { const int m0 = GW_ID(F); if (m0 < MT) { const GAS f32x4* xr = (const GAS f32x4*)(x1 + (size_t)m0 * DM) + F.lane;
#pragma unroll
        for (int j = 0; j < 8; ++j) vn[j] = xr[64 * j]; } }
    for (int m = GW_ID(F); m < MT; m += GW_N(F)) {
        f32x4 v[8]; float s = 0.f;
#pragma unroll
        for (int j = 0; j < 8; ++j) { v[j] = vn[j]; s += (v[j].x * v[j].x + v[j].y * v[j].y) + (v[j].z * v[j].z + v[j].w * v[j].w); }
        if (m + GW_N(F) < MT) { const GAS f32x4* xr = (const GAS f32x4*)(x1 + (size_t)(m + GW_N(F)) * DM) + F.lane;
#pragma unroll
            for (int j = 0; j < 8; ++j) vn[j] = xr[64 * j]; }
        const float r = rsqrtf(wave_sum(s) * (1.f / DM) + EPS);
        GAS v2u* o8 = (GAS v2u*)(HB + (size_t)m * DM) + F.lane;
#pragma unroll
        for (int j = 0; j < 8; ++j) { const f32x4 gg = gv[j]; v[j].x *= r * gg.x; v[j].y *= r * gg.y; v[j].z *= r * gg.z; v[j].w *= r * gg.w;
            v2u o; o.x = pk2(v[j].x, v[j].y); o.y = pk2(v[j].z, v[j].w); o8[64 * j] = o; }
        float mine = 0.f;
#pragma unroll 1
        for (int e = 0; e < NE; ++e) { float a = 0.f;
#pragma unroll
            for (int j = 0; j < 8; ++j) { const f32x4 w = *((const LAS f32x4*)(wrT + e * WRS) + F.lane + 64 * j); a += (v[j].x * w.x + v[j].y * w.y) + (v[j].z * w.z + v[j].w * w.w); }
            a = wave_sum(a); mine = (F.lane == e) ? a : mine; }
        float mx = mine;
        mx = fmaxf(mx, __shfl_xor(mx, 1)); mx = fmaxf(mx, __shfl_xor(mx, 2)); mx = fmaxf(mx, __shfl_xor(mx, 4)); mx = fmaxf(mx, __shfl_xor(mx, 8));
        const float ex = expf(mine - mx); float den = ex;
        den += __shfl_xor(den, 1); den += __shfl_xor(den, 2); den += __shfl_xor(den, 4); den += __shfl_xor(den, 8);
        const int b = m / SEQ, sidx = m % SEQ;
        if (F.lane < NE) AFF[((size_t)b * NE + F.lane) * SEQ + sidx] = ex / den;
    }
    __syncthreads();
}
__device__ __forceinline__ void phase_p4(Frame& F) {
    LAS unsigned* key = (LAS unsigned*)F.lds;
    LAS unsigned* hist = (LAS unsigned*)(F.lds + 16384);
    LAS unsigned* wsum = (LAS unsigned*)(F.lds + 16384 + 1024);
    const float* AFF = (const float*)(F.ws + WS_AFF); int* IDX = (int*)(F.ws + WS_IDX); float* GATE = (float*)(F.ws + WS_GATE); int* SEL = (int*)(F.ws + WS_SEL);
    for (int be = F.bid; be < NB * NE; be += F.G) {
        const int b = be / NE, e = be % NE;
        __syncthreads();
        const GAS v4u* ap = (const GAS v4u*)(AFF + (size_t)be * SEQ);
        const v4u k0 = ap[2 * F.tid], k1 = ap[2 * F.tid + 1];
        unsigned kk[8] = {k0.x, k0.y, k0.z, k0.w, k1.x, k1.y, k1.z, k1.w};
        unsigned prefix = 0u, mask = 0u, remaining = CAP;
#pragma unroll 1
        for (int pass = 0; pass < 4; ++pass) {
            const int shift = 24 - 8 * pass;
            if (F.tid < 256) hist[F.tid] = 0u;
            __syncthreads();
#pragma unroll
            for (int i = 0; i < 8; ++i) if ((kk[i] & mask) == prefix) __hip_atomic_fetch_add(&hist[(kk[i] >> shift) & 255u], 1u, __ATOMIC_RELAXED, __HIP_MEMORY_SCOPE_WORKGROUP);
            __syncthreads();
            unsigned incl_ = 0u, mine_ = 0u;
            if (F.tid < 256) {
                mine_ = hist[255 - F.tid]; incl_ = mine_;
#pragma unroll
                for (int o = 1; o < 64; o <<= 1) { const unsigned t = __shfl_up(incl_, o); if (F.lane >= o) incl_ += t; }
                if (F.lane == 63) wsum[10 + F.wave] = incl_;
            }
            __syncthreads();
            if (F.tid < 256) {
                unsigned base = 0u;
                for (int w = 0; w < F.wave; ++w) base += wsum[10 + w];
                const unsigned above = base + incl_ - mine_;
                if (above < remaining && remaining <= above + mine_) { wsum[8] = (unsigned)(255 - F.tid); wsum[9] = above; }
            }
            __syncthreads();
            const unsigned d = wsum[8], above = wsum[9];
            prefix |= d << shift; mask |= 255u << shift; remaining -= above;
            __syncthreads();
        }
        const unsigned thr = prefix;
        unsigned cnt = 0u;
#pragma unroll
        for (int i = 0; i < 8; ++i) cnt += (kk[i] > thr ? 0x10000u : 0u) + (kk[i] == thr ? 1u : 0u);
        unsigned incl = cnt;
#pragma unroll
        for (int o = 1; o < 64; o <<= 1) { const unsigned t = __shfl_up(incl, o); if (F.lane >= o) incl += t; }
        if (F.lane == 63) wsum[F.wave] = incl;
        __syncthreads();
        unsigned base = 0u;
        for (int w = 0; w < F.wave; ++w) base += wsum[w];
        unsigned run = base + incl - cnt;
#pragma unroll
        for (int i = 0; i < 8; ++i) {
            const unsigned gt_before = run >> 16, tie_before = run & 0xffffu;
            const bool isgt = kk[i] > thr, istie = kk[i] == thr;
            const bool sel = isgt || (istie && tie_before < remaining);
            const unsigned slot = gt_before + (tie_before < remaining ? tie_before : remaining);
            const int s = 8 * F.tid + i, m = b * SEQ + s;
            if (sel) { IDX[be * CAP + slot] = m; GATE[be * CAP + slot] = __builtin_bit_cast(float, kk[i]); }
            SEL[(size_t)m * NE + e] = sel ? (int)slot : -1;
            run += (isgt ? 0x10000u : 0u) + (istie ? 1u : 0u);
        }
    }
    __syncthreads();
}
__device__ __forceinline__ void phase_p7(Frame& F) {
    const int* SEL = (const int*)(F.ws + WS_SEL); const bf16* YE = (const bf16*)(F.ws + WS_YE);
    for (int m = GW_ID(F); m < MT; m += GW_N(F)) {
        const int b = m / SEQ;
        GAS f32x4* orow = (GAS f32x4*)(F.out + (size_t)m * DM);
        const int sel = SEL[(size_t)m * NE + (F.lane & 15)];
        f32x4 acc[8];
#pragma unroll
        for (int j = 0; j < 8; ++j) acc[j] = orow[2 * F.lane + (j & 1) + 128 * (j >> 1)];
        unsigned mask = (unsigned)(__ballot(sel >= 0) & 0xFFFFull);
        while (mask) {
            const int e0 = __builtin_ctz(mask); mask &= mask - 1u;
            const bool two = mask != 0u; const int e1 = two ? __builtin_ctz(mask) : e0; if (two) mask &= mask - 1u;
            const int s0 = __builtin_amdgcn_readlane(sel, e0), s1 = __builtin_amdgcn_readlane(sel, e1);
            const GAS v4u* y0 = (const GAS v4u*)(YE + (size_t)((b * NE + e0) * CAP + s0) * DM) + F.lane;
            const GAS v4u* y1 = (const GAS v4u*)(YE + (size_t)((b * NE + e1) * CAP + s1) * DM) + F.lane;
            v4u w0[4], w1[4];
#pragma unroll
            for (int jj = 0; jj < 4; ++jj) { w0[jj] = y0[64 * jj]; w1[jj] = y1[64 * jj]; }
            const float k1 = two ? 1.f : 0.f;
#pragma unroll
            for (int jj = 0; jj < 4; ++jj) {
                acc[2 * jj].x += bflo(w0[jj].x) + k1 * bflo(w1[jj].x); acc[2 * jj].y += bfhi(w0[jj].x) + k1 * bfhi(w1[jj].x); acc[2 * jj].z += bflo(w0[jj].y) + k1 * bflo(w1[jj].y); acc[2 * jj].w += bfhi(w0[jj].y) + k1 * bfhi(w1[jj].y);
                acc[2 * jj + 1].x += bflo(w0[jj].z) + k1 * bflo(w1[jj].z); acc[2 * jj + 1].y += bfhi(w0[jj].z) + k1 * bfhi(w1[jj].z); acc[2 * jj + 1].z += bflo(w0[jj].w) + k1 * bflo(w1[jj].w); acc[2 * jj + 1].w += bfhi(w0[jj].w) + k1 * bfhi(w1[jj].w); }
        }
#pragma unroll
        for (int j = 0; j < 8; ++j) orow[2 * F.lane + (j & 1) + 128 * (j >> 1)] = acc[j];
    }
}

struct Args { const float* in[23]; float* out; unsigned char* ws; int ph_lo, ph_hi; };
enum Phase { PH_P0 = 0, PH_G1, PH_ATTN, PH_P25, PH_OUT, PH_P35, PH_P4, PH_UP, PH_DOWN, PH_P7, PH_COUNT };

__global__ void __launch_bounds__(NTHREADS, 2) mk_fwd(Args args) {
    extern __shared__ __attribute__((aligned(16))) unsigned char lds_raw[];
    Frame F;
    F.lds = (LAS unsigned char*)lds_raw;
    F.tid = threadIdx.x; F.lane = F.tid & 63; F.wave = __builtin_amdgcn_readfirstlane(F.tid >> 6); F.G = gridDim.x; F.bid = blockIdx.x;
#pragma unroll
    for (int i = 0; i < 23; ++i) F.in[i] = args.in[i];
    F.out = args.out; F.ws = args.ws;
    const int lo = args.ph_lo, hi = args.ph_hi;
#define IN(k) (lo <= (k) && (k) < hi)
#define REPS(k) for (int rep_ = 0; rep_ < ((k) == REP_PHASE ? REP_N : 1); ++rep_)
#if MK_N_LAUNCHES == 1
    { volatile LAS unsigned* misc = (volatile LAS unsigned*)(F.lds + LDS_MISC_OFF); if (F.tid < 16) misc[F.tid] = 0u; }
    __syncthreads();
    XcdBarrier bar = xcd_barrier_post(g_bar_words, (volatile LAS unsigned*)(F.lds + LDS_MISC_OFF) + 8);
#define SEAM(k) do { if (IN(k) && IN((k) + 1)) xcd_barrier(bar); } while (0)
#else
#define SEAM(k) do { } while (0)
#endif
    if (IN(PH_P0)) REPS(PH_P0) { phase_p0(F); for (int it = GW_ID(F); it < MOE_P0_ITEMS; it += GW_N(F)) moe_conv_item(F, it); } SEAM(PH_P0);
    if (IN(PH_G1)) REPS(PH_G1) {
        phase_filters(F);
        __syncthreads();
        { pg8::DenseOrder S; S.init(F.ws + WS_HB, F.ws + WS_WIN, MT, 2048, DM, 0, F.G, F.bid);
          pg8::EpiBf16 E{(pg8::bf16_t*)(F.ws + WS_QK), 2048, 0, nullptr};
          pg8::gemm_phase<pg8::EpiBf16, pg8::DenseOrder, true>(F.lds, DM, S, E); }
        { pg8::DenseOrder S; S.init(F.ws + WS_HB, F.ws + WS_WIN, MT, 4096, DM, 8, F.G, F.bid);
          pg8::EpiTransBf16 E{(pg8::bf16_t*)(F.ws + WS_XT), MT, 8};
          pg8::gemm_phase<pg8::EpiTransBf16, pg8::DenseOrder, true>(F.lds, DM, S, E); }
    } SEAM(PH_G1);
    if (IN(PH_ATTN)) { __syncthreads(); for (int rep_ = 0; rep_ < ((PH_ATTN == REP_PHASE && REP_SUB != 2) ? REP_N : 1); ++rep_) phase_hyena(F); for (int rep_ = 0; rep_ < ((PH_ATTN == REP_PHASE && REP_SUB != 1) ? REP_N : 1); ++rep_) phase_attn2(F); } SEAM(PH_ATTN);
    if (IN(PH_P25)) REPS(PH_P25) { __syncthreads(); phase_p25(F); } SEAM(PH_P25);
    if (IN(PH_OUT)) REPS(PH_OUT) {
        __syncthreads();
        pg8::DenseOrder S; S.init(F.ws + WS_MIXED, F.ws + WS_WOUT, MT, DM, DM, 0, F.G, F.bid);
        pg8::EpiResF32 E{F.in[0], F.out, DM};
        pg8::gemm_phase<pg8::EpiResF32, pg8::DenseOrder, false>(F.lds, DM, S, E);
    } SEAM(PH_OUT);
    if (IN(PH_P35)) REPS(PH_P35) { __syncthreads(); phase_p35(F); } SEAM(PH_P35);
    if (IN(PH_P4)) REPS(PH_P4) { __syncthreads(); phase_p4(F);
        if (F.G > NB * NE) { if (F.bid >= NB * NE) conv_range_moe_tail(F); }
        else moe_conv_range(F, MOE_ITEMS - MOE_P4_ITEMS + GW_ID(F), MOE_ITEMS, GW_N(F)); } SEAM(PH_P4);
    if (IN(PH_UP)) REPS(PH_UP) {
        __syncthreads();
        pg8::MoeOrder S; S.init(F.ws + WS_HB, F.ws + WS_WGU, DM, F.G, F.bid, true);
        LAS int* ridx = (LAS int*)(F.lds + 131072);
        { const int* IDX = (const int*)(F.ws + WS_IDX); pg8::Unit u;
          for (int i = 0; S.next(i, u); ++i) if (F.tid < 256) ridx[i * 256 + F.tid] = IDX[u.g * CAP + u.pm * 256 + F.tid]; }
        __syncthreads();
        pg8::EpiSwiGLU E{(pg8::bf16_t*)(F.ws + WS_ACT)};
        pg8::gemm_phase<pg8::EpiSwiGLU, pg8::MoeOrder, true, true>(F.lds, DM, S, E, ridx);
    } SEAM(PH_UP);
    if (IN(PH_DOWN)) REPS(PH_DOWN) {
        __syncthreads();
        pg8::MoeOrder S; S.init(F.ws + WS_ACT, F.ws + WS_WD, FF, F.G, F.bid, false);
        pg8::EpiBf16 E{(pg8::bf16_t*)(F.ws + WS_YE), DM, 512, (const float*)(F.ws + WS_GATE)};
        pg8::gemm_phase<pg8::EpiBf16, pg8::MoeOrder, true>(F.lds, FF, S, E);
    } SEAM(PH_DOWN);
    if (IN(PH_P7)) { phase_p7(F); }
#if MK_N_LAUNCHES == 1
    __syncthreads();
    { volatile LAS unsigned* misc = (volatile LAS unsigned*)(F.lds + LDS_MISC_OFF);
      if (F.tid == 0) misc[0] = (xb_add(&g_bar_words[XCD_BAR_WORDS], 1u) + 1u == (unsigned)F.G) ? 1u : 0u;
      __syncthreads();
      if (misc[0] != 0u && F.tid < (XCD_BAR_WORDS + 64) / 64) __hip_atomic_store(&g_bar_words[64 * F.tid], 0u, __ATOMIC_RELAXED, __HIP_MEMORY_SCOPE_AGENT); }
#endif
#undef IN
#undef SEAM
}

extern "C" void kernel_launch(void* const* d_in, const int* in_sizes, int n_in, void* d_out, int out_size, void* d_ws, size_t ws_size, hipStream_t stream) {
    static int grid = 0;
    if (grid == 0) {
        if (n_in != 23 || ws_size < WS_END) { fprintf(stderr, "kernel_launch: unexpected inputs (n_in %d, ws %zu)\n", n_in, ws_size); grid = -1; return; }
        if (hipFuncSetAttribute((const void*)mk_fwd, hipFuncAttributeMaxDynamicSharedMemorySize, LDS_BYTES) != hipSuccess) { fprintf(stderr, "kernel_launch: hipFuncSetAttribute failed\n"); grid = -1; return; }
        int dev = 0, cus = 0, per_cu = 0;
        hipGetDevice(&dev); hipDeviceGetAttribute(&cus, hipDeviceAttributeMultiprocessorCount, dev);
        hipOccupancyMaxActiveBlocksPerMultiprocessor(&per_cu, (const void*)mk_fwd, NTHREADS, LDS_BYTES);
        (void)hipGetLastError();
        if (per_cu < 1) { fprintf(stderr, "kernel_launch: occupancy query says %d blocks/CU\n", per_cu); }
        grid = cus;
    }
    if (grid < 0) return;
    Args a{};
    for (int i = 0; i < 23; ++i) a.in[i] = (const float*)d_in[i];
    a.out = (float*)d_out; a.ws = (unsigned char*)d_ws;
#if MK_N_LAUNCHES == 1
    a.ph_lo = 0; a.ph_hi = PH_COUNT;
    hipLaunchKernelGGL(mk_fwd, dim3(grid), dim3(NTHREADS), LDS_BYTES, stream, a);
#else
    for (int p = 0; p < PH_COUNT; ++p) { a.ph_lo = p; a.ph_hi = p + 1; hipLaunchKernelGGL(mk_fwd, dim3(grid), dim3(NTHREADS), LDS_BYTES, stream, a); }
#endif
}
```

```cpp
#include <hip/hip_runtime.h>
#include <hip/hip_cooperative_groups.h>
#include <cstdio>
#include <cstdint>
namespace cg = cooperative_groups;

#ifndef REP_PHASE
#define REP_PHASE -1
#define REP_N 1
#define REP_SUB 0
#endif
#ifndef MK_N_LAUNCHES
#define MK_N_LAUNCHES 1
#endif

namespace pg8 {
#define PG8_LAS __attribute__((address_space(3)))
typedef unsigned short bf16_t;
typedef short bf16x8 __attribute__((ext_vector_type(8)));
typedef float f32x4 __attribute__((ext_vector_type(4)));
typedef unsigned u32x4 __attribute__((ext_vector_type(4)));
typedef unsigned u32x2 __attribute__((ext_vector_type(2)));
constexpr int BM = 256, BK = 64, HALF = 128, HTB = HALF * BK * 2, STAGE_BYTES = 8 * HTB, NXCD = 8, WGM = 8;

__host__ __device__ __forceinline__ int lds_byte(int r, int c) { const int st = (r >> 4) * 2 + (c >> 5), rr = r & 15, cc = c & 31, ob = rr * 64 + cc * 2; return st * 1024 + (ob ^ (((ob >> 9) & 1) << 5)); }
__host__ __device__ __forceinline__ void stage_rc(int b, int& R, int& C) { const int st = b / 1024, sb = b % 1024, swz = sb ^ (((sb >> 9) & 1) << 5); R = (st >> 1) * 16 + swz / 64; C = (st & 1) * 32 + (swz % 64) / 2; }
__host__ __device__ __forceinline__ int perm32(int rho) { const int n = rho >> 4, i = rho & 15; return 8 * (i >> 2) + 4 * n + (i & 3); }

struct Unit { int pm, pn, g; const char* a; const char* b; };

__device__ __forceinline__ unsigned cvt_pk_bf16(float lo, float hi) { unsigned r; asm volatile("v_cvt_pk_bf16_f32 %0, %1, %2" : "=v"(r) : "v"(lo), "v"(hi)); return r; }

struct DenseOrder {
    static constexpr bool CHUNK_B = false;
    int nM, nN, nwg, G, c, K, pn0; const char* A; const char* Bt;
    __device__ void init(const void* A_, const void* Bt_, int M, int N, int K_, int pn0_, int G_, int c_) { A = (const char*)A_; Bt = (const char*)Bt_; nM = M / BM; nN = N / BM; nwg = nM * nN; G = G_; c = c_; K = K_; pn0 = pn0_; }
    __device__ bool next(int i, Unit& u) const {
        const long L = (long)i * G + c; if (L >= nwg) return false;
        int wgid = (int)L; { const int q = nwg / NXCD, r = nwg % NXCD, xcd = wgid % NXCD, off = wgid / NXCD; wgid = (xcd < r ? xcd * (q + 1) : r * (q + 1) + (xcd - r) * q) + off; }
        const int nig = WGM * nN, gid = wgid / nig, fm = gid * WGM, gsz = (nM - fm) < WGM ? (nM - fm) : WGM;
        u.pm = fm + ((wgid % nig) % gsz); u.pn = pn0 + (wgid % nig) / gsz; u.g = 0;
        u.a = A + (size_t)u.pm * BM * K * 2; u.b = Bt + (size_t)u.pn * BM * K * 2; return true;
    }
};
struct MoeOrder {
    static constexpr bool CHUNK_B = true;
    int G, c, K; bool gather; const char* A; const char* Bt;
    __device__ void init(const void* A_, const void* Bt_, int K_, int G_, int c_, bool gather_) { A = (const char*)A_; Bt = (const char*)Bt_; K = K_; G = G_; c = c_; gather = gather_; }
    __device__ bool next(int i, Unit& u) const {
        const int L = i * G + c; if (L >= 512) return false;
        int pn, pm, b, e;
        if ((G & 7) == 0 && G >= 64) { const int per = G >> 3, x = c & 7, u = (c >> 3) + i * per;
            pn = u & 7; pm = (u >> 3) & 1; b = (u >> 4) & 1; e = x + 8 * (u >> 5); if (e >= 16) return false; }
        else { pn = L & 7; pm = (L >> 3) & 1; b = (L >> 4) & 1; e = L >> 5; }
        u.pm = pm; u.pn = pn; u.g = b * 16 + e;
        u.a = gather ? A : A + (size_t)(u.g * 512 + pm * BM) * K * 2; u.b = Bt + (size_t)e * 2048 * K * 2 + (size_t)pn * BM * 16; return true;
    }
};

struct EpiBf16 {
    static constexpr bool PERM = true, SWAP = false, INIT = false;
    bf16_t* O; int ldc; int grows; const float* rscale;
    __device__ __forceinline__ void operator()(const f32x4 (&acc)[2][2][4][2], const Unit& u, int wr, int wc, int fr, int fq) const {
        const int row0 = u.g * grows + u.pm * BM + wr * 64 + fr, col0 = u.pn * BM + wc * 32 + 8 * fq;
        float scv[2][4];
#pragma unroll
        for (int ai = 0; ai < 2; ++ai)
#pragma unroll
            for (int m = 0; m < 4; ++m) scv[ai][m] = rscale ? rscale[row0 + ai * HALF + m * 16] : 1.f;
#pragma unroll
        for (int ai = 0; ai < 2; ++ai)
#pragma unroll
            for (int m = 0; m < 4; ++m) { const int row = row0 + ai * HALF + m * 16; bf16_t* rowp = O + (size_t)row * ldc + col0; const float sc = scv[ai][m];
#pragma unroll
                for (int bj = 0; bj < 2; ++bj) { const f32x4 v0 = acc[ai][bj][m][0] * sc, v1 = acc[ai][bj][m][1] * sc;
                    u32x4 w; w.x = cvt_pk_bf16(v0[0], v0[1]); w.y = cvt_pk_bf16(v0[2], v0[3]); w.z = cvt_pk_bf16(v1[0], v1[1]); w.w = cvt_pk_bf16(v1[2], v1[3]);
                    *(u32x4*)(rowp + bj * HALF) = w; } }
    }
};
struct EpiSwiGLU {
    static constexpr bool PERM = true, SWAP = false, INIT = false;
    bf16_t* O;
    __device__ __forceinline__ void operator()(const f32x4 (&acc)[2][2][4][2], const Unit& u, int wr, int wc, int fr, int fq) const {
        const int row0 = u.g * 512 + u.pm * BM + wr * 64 + fr, col0 = u.pn * HALF + wc * 32 + 8 * fq;
#pragma unroll
        for (int ai = 0; ai < 2; ++ai)
#pragma unroll
            for (int m = 0; m < 4; ++m) { bf16_t* rowp = O + (size_t)(row0 + ai * HALF + m * 16) * 1024 + col0;
                float r[8];
#pragma unroll
                for (int n = 0; n < 2; ++n)
#pragma unroll
                    for (int e = 0; e < 4; ++e) { const float g = acc[ai][0][m][n][e], up = acc[ai][1][m][n][e]; r[n * 4 + e] = g / (1.f + __expf(-g)) * up; }
                u32x4 w; w.x = cvt_pk_bf16(r[0], r[1]); w.y = cvt_pk_bf16(r[2], r[3]); w.z = cvt_pk_bf16(r[4], r[5]); w.w = cvt_pk_bf16(r[6], r[7]);
                *(u32x4*)rowp = w; }
    }
};
struct EpiResF32 {
    static constexpr bool PERM = false, SWAP = false, INIT = true;
    const float* res; float* out; int ldc;
    __device__ __forceinline__ void init(f32x4 (&acc)[2][2][4][2], const Unit& u, int wr, int wc, int fr, int fq) const {
        const int row0 = u.pm * BM + wr * 64 + fr, col0 = u.pn * BM + wc * 32 + 4 * fq;
#pragma unroll
        for (int ai = 0; ai < 2; ++ai)
#pragma unroll
            for (int m = 0; m < 4; ++m) { const size_t off = (size_t)(row0 + ai * HALF + m * 16) * ldc + col0;
#pragma unroll
                for (int bj = 0; bj < 2; ++bj)
#pragma unroll
                    for (int n = 0; n < 2; ++n) acc[ai][bj][m][n] = *(const f32x4*)(res + off + bj * HALF + n * 16); }
    }
    __device__ __forceinline__ void operator()(const f32x4 (&acc)[2][2][4][2], const Unit& u, int wr, int wc, int fr, int fq) const {
        const int row0 = u.pm * BM + wr * 64 + fr, col0 = u.pn * BM + wc * 32 + 4 * fq;
#pragma unroll
        for (int ai = 0; ai < 2; ++ai)
#pragma unroll
            for (int m = 0; m < 4; ++m) { const size_t off = (size_t)(row0 + ai * HALF + m * 16) * ldc + col0;
#pragma unroll
                for (int bj = 0; bj < 2; ++bj)
#pragma unroll
                    for (int n = 0; n < 2; ++n) *(f32x4*)(out + off + bj * HALF + n * 16) = acc[ai][bj][m][n]; }
    }
};
struct EpiTransBf16 {
    static constexpr bool PERM = false, SWAP = true, INIT = false;
    bf16_t* O; int ldt; int pn_base;
    __device__ __forceinline__ void operator()(const f32x4 (&acc)[2][2][4][2], const Unit& u, int wr, int wc, int fr, int fq) const {
        const int ch0 = (u.pn - pn_base) * BM + wc * 32 + fr, t0 = u.pm * BM + wr * 64 + 4 * fq;
#pragma unroll
        for (int bj = 0; bj < 2; ++bj)
#pragma unroll
            for (int n = 0; n < 2; ++n) { bf16_t* chp = O + (size_t)(ch0 + bj * HALF + n * 16) * ldt + t0;
#pragma unroll
                for (int ai = 0; ai < 2; ++ai)
#pragma unroll
                    for (int m = 0; m < 4; ++m) { const f32x4 v = acc[ai][bj][m][n]; u32x2 w; w.x = cvt_pk_bf16(v[0], v[1]); w.y = cvt_pk_bf16(v[2], v[3]); *(u32x2*)(chp + ai * HALF + m * 16) = w; } }
    }
};

template <class Epi, class Sched, bool ALIGN_EPI = false, bool GATHER = false>
__device__ __forceinline__ void gemm_phase(PG8_LAS unsigned char* lds, const int K, const Sched& S, const Epi& E, const PG8_LAS int* ridx = nullptr) {
    const int tid = threadIdx.x, wid = __builtin_amdgcn_readfirstlane(tid >> 6), lane = tid & 63, wr = wid >> 2, wc = wid & 3, fr = lane & 15, fq = lane >> 4;
    const int nt = K / BK;
    unsigned vA0[2], vA1[2], vN0[2], vN1[2], voffB[2]; int stR[2], stC[2];
    const size_t kstep = (size_t)(BK * 2);
    const size_t hstep = (size_t)HALF * K * 2;
    const size_t kstepB = Sched::CHUNK_B ? (size_t)(BK / 8) * 2048 * 16 : kstep, hstepB = Sched::CHUNK_B ? (size_t)HALF * 16 : hstep;
#pragma unroll
    for (int i = 0; i < 2; ++i) { int R, C; stage_rc(tid * 16 + i * 8192, R, C); stR[i] = R; stC[i] = C;
        int RB = R, CB = C;
        if constexpr (Sched::CHUNK_B) { const int b = tid * 16 + i * 8192, st = b >> 10, l = (b & 1023) >> 4; RB = (st >> 1) * 16 + (l & 15); CB = (st & 1) * 32 + (l >> 4) * 8; }
        const int Rb = Epi::PERM ? ((RB & ~31) + perm32(RB & 31)) : RB;
        voffB[i] = Sched::CHUNK_B ? (unsigned)(((CB >> 3) * 2048 + Rb) * 16) : (unsigned)(Rb * K + CB) * 2u;
        if constexpr (GATHER) { vA0[i] = (unsigned)(ridx[R] * K + C) * 2u; vA1[i] = (unsigned)(ridx[HALF + R] * K + C) * 2u; }
        else { vA0[i] = (unsigned)(R * K + C) * 2u; vA1[i] = vA0[i] + (unsigned)hstep; }
        vN0[i] = vA0[i]; vN1[i] = vA1[i]; }
    const unsigned ldsw = (unsigned)wid * 1024u;
    const int aoff = lds_byte(wr * 64 + fr, fq * 8), boff = Sched::CHUNK_B ? (wc * 4096 + fq * 256 + fr * 16) : lds_byte(wc * 32 + fr, fq * 8);
#define PG8_SA(b, h) (((b) * 2 + (h)) * HTB)
#define PG8_SB(b, h) ((4 + (b) * 2 + (h)) * HTB)
#define PG8_STAGE(bufoff, gbase, voff) do { _Pragma("unroll") for (int _i = 0; _i < 2; ++_i) \
        __builtin_amdgcn_global_load_lds((const unsigned*)((const char*)(gbase) + (voff)[_i]), (PG8_LAS unsigned*)(lds + (bufoff) + ldsw + _i * 8192), 16, 0, 0); } while (0)
#define PG8_LDA(dst, b, h) do { _Pragma("unroll") for (int m = 0; m < 4; ++m) _Pragma("unroll") for (int k = 0; k < 2; ++k) dst[m][k] = *(const PG8_LAS bf16x8*)(lds + PG8_SA(b, h) + aoff + m * 2048 + k * 1024); } while (0)
#define PG8_LDB(dst, b, h) do { _Pragma("unroll") for (int n = 0; n < 2; ++n) _Pragma("unroll") for (int k = 0; k < 2; ++k) dst[n][k] = *(const PG8_LAS bf16x8*)(lds + PG8_SB(b, h) + boff + n * 2048 + k * 1024); } while (0)
#define PG8_MMA(ai, bj, At, Bt) do { __builtin_amdgcn_s_setprio(1); _Pragma("unroll") for (int m = 0; m < 4; ++m) _Pragma("unroll") for (int n = 0; n < 2; ++n) _Pragma("unroll") for (int k = 0; k < 2; ++k) \
        acc[ai][bj][m][n] = Epi::SWAP ? __builtin_amdgcn_mfma_f32_16x16x32_bf16(At[m][k], Bt[n][k], acc[ai][bj][m][n], 0, 0, 0) : __builtin_amdgcn_mfma_f32_16x16x32_bf16(Bt[n][k], At[m][k], acc[ai][bj][m][n], 0, 0, 0); __builtin_amdgcn_s_setprio(0); } while (0)
#define PG8_WAIT_V(n) asm volatile("s_waitcnt vmcnt(" #n ")" ::: "memory")
#define PG8_WAIT_L(n) asm volatile("s_waitcnt lgkmcnt(" #n ")" ::: "memory")
#define PG8_BAR __builtin_amdgcn_s_barrier()
#define PG8_SCHED __builtin_amdgcn_sched_barrier(0)
    Unit cur, nxt; int ui = 0;
    if (!S.next(0, cur)) return;
    f32x4 acc[2][2][4][2];
    if constexpr (Epi::INIT) E.init(acc, cur, wr, wc, fr, fq);
    else {
#pragma unroll
    for (int a = 0; a < 2; ++a)
#pragma unroll
        for (int b = 0; b < 2; ++b)
#pragma unroll
            for (int m = 0; m < 4; ++m)
#pragma unroll
                for (int n = 0; n < 2; ++n) acc[a][b][m][n] = (f32x4){0.f, 0.f, 0.f, 0.f};
    }
    bf16x8 At[4][2], B0[2][2], B1[2][2];
    const char* cA = cur.a; const char* cB = cur.b;
    PG8_STAGE(PG8_SB(0, 0), cB, voffB); PG8_STAGE(PG8_SB(0, 1), cB + hstepB, voffB); PG8_STAGE(PG8_SA(0, 0), cA, vA0); PG8_STAGE(PG8_SA(0, 1), cA, vA1);
    if (wr == 1) PG8_BAR;
    PG8_WAIT_V(2); PG8_BAR;
    PG8_STAGE(PG8_SB(1, 0), cB + kstepB, voffB); PG8_STAGE(PG8_SA(1, 0), cA + kstep, vA0); PG8_STAGE(PG8_SB(1, 1), cB + hstepB + kstepB, voffB);
    PG8_WAIT_V(6); PG8_BAR;
    for (;;) {
        const bool has_next = S.next(ui + 1, nxt);
        const char* nA = has_next ? nxt.a : cA; const char* nB = has_next ? nxt.b : cB;
        if constexpr (GATHER) { if (has_next) {
#pragma unroll
            for (int i = 0; i < 2; ++i) { vN0[i] = (unsigned)(ridx[(ui + 1) * 256 + stR[i]] * K + stC[i]) * 2u; vN1[i] = (unsigned)(ridx[(ui + 1) * 256 + HALF + stR[i]] * K + stC[i]) * 2u; } } }
        for (int t = 0; t < nt; t += 2) {
            const bool last = (t == nt - 2);
            const char* a1 = cA + (size_t)(t + 1) * kstep;
            const char* a2 = last ? nA : cA + (size_t)(t + 2) * kstep; const char* b2 = last ? nB : cB + (size_t)(t + 2) * kstepB;
            const char* a3 = a2 + kstep; const char* b3 = b2 + kstepB;
            unsigned w0[2], w1[2];
#pragma unroll
            for (int i = 0; i < 2; ++i) { w0[i] = last ? vN0[i] : vA0[i]; w1[i] = last ? vN1[i] : vA1[i]; }
            PG8_LDB(B0, 0, 0); PG8_LDB(B1, 0, 1); PG8_SCHED; PG8_LDA(At, 0, 0); PG8_STAGE(PG8_SA(1, 1), a1, vA1);
            PG8_WAIT_V(8); PG8_WAIT_L(0); PG8_BAR; PG8_MMA(0, 0, At, B0); PG8_MMA(0, 1, At, B1); PG8_BAR; PG8_SCHED;
            PG8_LDA(At, 0, 1); PG8_STAGE(PG8_SB(0, 0), b2, voffB); PG8_STAGE(PG8_SB(0, 1), b2 + hstepB, voffB); PG8_STAGE(PG8_SA(0, 0), a2, w0);
            PG8_WAIT_V(8); PG8_WAIT_L(0); PG8_BAR; PG8_MMA(1, 0, At, B0); PG8_MMA(1, 1, At, B1); PG8_BAR; PG8_SCHED;
            PG8_LDB(B0, 1, 0); PG8_LDB(B1, 1, 1); PG8_SCHED; PG8_LDA(At, 1, 0); PG8_STAGE(PG8_SA(0, 1), a2, w1);
            PG8_WAIT_V(8); PG8_WAIT_L(0); PG8_BAR; PG8_MMA(0, 0, At, B0); PG8_MMA(0, 1, At, B1); PG8_BAR; PG8_SCHED;
            PG8_LDA(At, 1, 1); PG8_STAGE(PG8_SB(1, 0), b3, voffB); PG8_STAGE(PG8_SB(1, 1), b3 + hstepB, voffB); PG8_STAGE(PG8_SA(1, 0), a3, w0);
            PG8_WAIT_V(8); PG8_WAIT_L(0); PG8_BAR; PG8_MMA(1, 0, At, B0); PG8_MMA(1, 1, At, B1); PG8_BAR; PG8_SCHED;
        }
        if constexpr (ALIGN_EPI) { if (wr == 0) PG8_BAR; }
        E(acc, cur, wr, wc, fr, fq);
        if (!has_next) break;
        if constexpr (Epi::INIT) E.init(acc, nxt, wr, wc, fr, fq);
        else {
#pragma unroll
        for (int a = 0; a < 2; ++a)
#pragma unroll
            for (int b = 0; b < 2; ++b)
#pragma unroll
                for (int m = 0; m < 4; ++m)
#pragma unroll
                    for (int n = 0; n < 2; ++n) acc[a][b][m][n] = (f32x4){0.f, 0.f, 0.f, 0.f};
        }
        cur = nxt; cA = nA; cB = nB; ++ui;
#pragma unroll
        for (int i = 0; i < 2; ++i) { vA0[i] = vN0[i]; vA1[i] = vN1[i]; }
        if constexpr (ALIGN_EPI) { if (wr == 1) PG8_BAR; }
    }
    PG8_WAIT_V(0);
    if constexpr (!ALIGN_EPI) { if (wr == 0) PG8_BAR; }
    PG8_BAR;
#undef PG8_SA
#undef PG8_SB
#undef PG8_STAGE
#undef PG8_LDA
#undef PG8_LDB
#undef PG8_MMA
#undef PG8_WAIT_V
#undef PG8_WAIT_L
#undef PG8_BAR
#undef PG8_SCHED
}
}

constexpr int NB = 2, SEQ = 4096, DM = 2048, MT = NB * SEQ;
constexpr int NH = 8, HD = 128, AW = 1024, HW = 1024, INW = 6144;
constexpr int GW = 64, NROWS = 64, WR = 8, WC = 16;
constexpr int NE = 16, CAP = 512, FF = 1024;
constexpr int FEMB = 33, FHID = 64;
constexpr float EPS = 1e-6f;
constexpr int NWAVES = 8, NTHREADS = 512;

constexpr size_t MiB = 1u << 20;
constexpr size_t WS_CTL = 0, CTL_ZERO_BYTES = 32768;
constexpr size_t WS_WIN = 2 * MiB;
constexpr size_t WS_WOUT = 26 * MiB;
constexpr size_t WS_WGU = 34 * MiB;
constexpr size_t WS_WD = 162 * MiB;
constexpr size_t WS_W3T = 226 * MiB;
constexpr size_t WS_HID2 = 227 * MiB;
constexpr size_t WS_HB = 228 * MiB;
constexpr size_t WS_QK = 260 * MiB;
constexpr size_t WS_XT = 292 * MiB;
constexpr size_t WS_UC = 356 * MiB;
constexpr size_t WS_TAPS = 404 * MiB;
constexpr size_t WS_HYT = 436 * MiB;
constexpr size_t WS_MIXED = 452 * MiB;
constexpr size_t WS_AFF = 484 * MiB;
constexpr size_t WS_IDX = 485 * MiB;
constexpr size_t WS_GATE = 486 * MiB;
constexpr size_t WS_SEL = 487 * MiB;
constexpr size_t WS_Z1T = 488 * MiB;
constexpr size_t WS_XG = WS_XT;
constexpr size_t WS_ACT = WS_UC;
constexpr size_t WS_YE = WS_TAPS;
constexpr size_t WS_END = 504 * MiB;

constexpr int LDS_BYTES = 163840, LDS_MISC_OFF = 163840 - 128;

#define GAS __attribute__((address_space(1)))
#define LAS __attribute__((address_space(3)))
typedef unsigned short bf16;
typedef unsigned v4u __attribute__((ext_vector_type(4)));
typedef unsigned v2u __attribute__((ext_vector_type(2)));
typedef float f32x4 __attribute__((ext_vector_type(4)));
#define LDS_WAIT() asm volatile("s_waitcnt lgkmcnt(0)" ::: "memory")
#define VM_WAIT() asm volatile("s_waitcnt vmcnt(0)" ::: "memory")
__device__ __forceinline__ unsigned f2bf(float f) { unsigned u = __builtin_bit_cast(unsigned, f); return (u + 0x7fffu + ((u >> 16) & 1u)) >> 16; }
__device__ __forceinline__ unsigned pk2(float lo, float hi) { unsigned r; asm("v_cvt_pk_bf16_f32 %0, %1, %2" : "=v"(r) : "v"(lo), "v"(hi)); return r; }
__device__ __forceinline__ float bf2f(unsigned h) { return __builtin_bit_cast(float, h << 16); }
__device__ __forceinline__ float bflo(unsigned w) { return __builtin_bit_cast(float, w << 16); }
__device__ __forceinline__ float bfhi(unsigned w) { return __builtin_bit_cast(float, w & 0xffff0000u); }
__device__ __forceinline__ float wave_sum(float v) {
#pragma unroll
    for (int o = 1; o < 64; o <<= 1) v += __shfl_xor(v, o);
    return v;
}


#define XB_TMO      128
#define XB_XCNT(j)  (256  + 64 * (j))
#define XB_XSUB(j)  (1280 + 64 * (j))
#define XB_XGEN(j)  (2304 + 64 * (j))
#define XB_TOP      3328
#define XB_TOPGEN   3392
#define XCD_BAR_WORDS 3456
#define XB_SPIN_CAP (1u << 22)
__device__ __forceinline__ unsigned xb_ld(unsigned* p)              { return __hip_atomic_load(p, __ATOMIC_RELAXED, __HIP_MEMORY_SCOPE_AGENT); }
__device__ __forceinline__ unsigned xb_add(unsigned* p, unsigned v) { return __hip_atomic_fetch_add(p, v, __ATOMIC_RELAXED, __HIP_MEMORY_SCOPE_AGENT); }
__device__ __forceinline__ unsigned xb_xcc_id() { return (unsigned)__builtin_amdgcn_s_getreg((3 << 11) | 20) & 0xFu; }
#define XB_SPIN(cond, bar) do { unsigned _sp = 0; while (cond) { __builtin_amdgcn_s_sleep(1); \
    if ((++_sp & 255u) == 0u) { if (xb_ld(&(bar)[XB_TMO])) break; if (_sp > XB_SPIN_CAP) { atomicAdd(&(bar)[XB_TMO], 1u); break; } } } } while (0)
struct XcdBarrier { unsigned* bar; unsigned x; volatile LAS unsigned* st; };
__device__ __forceinline__ XcdBarrier xcd_barrier_post(unsigned* bar, volatile LAS unsigned* st) {
    XcdBarrier b; b.bar = bar; b.x = xb_xcc_id(); b.st = st;
    if (threadIdx.x == 0) (void)xb_add(&bar[XB_XCNT(b.x)], 1u);
    return b;
}
__device__ __forceinline__ void xcd_barrier_complete(unsigned* bar, unsigned x, unsigned& nloc, unsigned& nx) {
    const unsigned G = gridDim.x * gridDim.y * gridDim.z;
    unsigned sum, cnt, mine, sp = 0u;
    for (;;) {
        sum = 0u; cnt = 0u; mine = 0u;
#pragma unroll
        for (unsigned j = 0; j < 16; ++j) { const unsigned c = xb_ld(&bar[XB_XCNT(j)]); sum += c; cnt += (c > 0u) ? 1u : 0u; mine = (j == x) ? c : mine; }
        if (sum == G) break;
        __builtin_amdgcn_s_sleep(1);
        if ((++sp & 255u) == 0u) { if (xb_ld(&bar[XB_TMO])) break; if (sp > XB_SPIN_CAP) { atomicAdd(&bar[XB_TMO], 1u); break; } }
    }
    nloc = mine > 0u ? mine : 1u; nx = cnt > 0u ? cnt : 1u;
}
__device__ __forceinline__ void xcd_barrier(const XcdBarrier& b) {
    asm volatile("s_waitcnt vmcnt(0)" ::: "memory");
    __syncthreads();
    if (threadIdx.x == 0) {
        unsigned* bar = b.bar;
        __builtin_amdgcn_s_waitcnt(0);
        unsigned nloc = b.st[0], nx = b.st[1];
        if (nloc == 0u) { xcd_barrier_complete(bar, b.x, nloc, nx); b.st[0] = nloc; b.st[1] = nx; }
        const unsigned old = xb_add(&bar[XB_XSUB(b.x)], 1u);
        const unsigned gen = old / nloc;
        if (old + 1u == (gen + 1u) * nloc) {
            __builtin_amdgcn_fence(__ATOMIC_RELEASE, "agent");
            asm volatile("s_waitcnt vmcnt(0)" ::: "memory");
            const unsigned og = xb_add(&bar[XB_TOP], 1u);
            const unsigned tg = og / nx;
            if (og + 1u == (tg + 1u) * nx) xb_add(&bar[XB_TOPGEN], 1u);
            else XB_SPIN(xb_ld(&bar[XB_TOPGEN]) == tg, bar);
            __builtin_amdgcn_fence(__ATOMIC_ACQUIRE, "agent");
            xb_add(&bar[XB_XGEN(b.x)], 1u);
            asm volatile("s_waitcnt vmcnt(0)" ::: "memory");
        } else {
            XB_SPIN(xb_ld(&bar[XB_XGEN(b.x)]) == gen, bar);
            __builtin_amdgcn_fence(__ATOMIC_ACQUIRE, "agent");
            asm volatile("s_waitcnt vmcnt(0)" ::: "memory");
        }
    }
    __syncthreads();
}

__device__ unsigned g_bar_words[XCD_BAR_WORDS + 64];
struct Frame {
    LAS unsigned char* lds;
    int tid, lane, wave, G, bid;
    const float* in[23]; float* out; unsigned char* ws;
};
#define GW_ID(F) ((F).bid * NWAVES + (F).wave)
#define GW_N(F) ((F).G * NWAVES)

__device__ __forceinline__ void p0_transpose_item(const float* W, int K, int N, bf16* WT, int row_base, int k0, int n0, LAS float* scr, int lane) {
    float t_[32];
#pragma unroll
    for (int i = 0; i < 32; ++i) { const int kk = 2 * i + (lane >> 5); t_[i] = W[(size_t)(k0 + kk) * N + n0 + (lane & 31)]; }
#pragma unroll
    for (int i = 0; i < 32; ++i) { const int kk = 2 * i + (lane >> 5); scr[kk * 33 + (lane & 31)] = t_[i]; }
    LDS_WAIT(); asm volatile("" ::: "memory");
    const int c = lane & 7;
#pragma unroll
    for (int j = 0; j < 4; ++j) { const int n = (lane >> 3) + 8 * j; const LAS float* s = scr + (8 * c) * 33 + n;
        v4u o; o.x = pk2(s[0 * 33], s[1 * 33]); o.y = pk2(s[2 * 33], s[3 * 33]); o.z = pk2(s[4 * 33], s[5 * 33]); o.w = pk2(s[6 * 33], s[7 * 33]);
        *(GAS v4u*)(WT + (size_t)(row_base + n) * K + k0 + 8 * c) = o; }
    LDS_WAIT(); asm volatile("" ::: "memory");
}
__device__ __forceinline__ void phase_p0(Frame& F) {
    LAS float* scr = (LAS float*)(F.lds + F.wave * 16384);
    const int gw = GW_ID(F), NGW = GW_N(F);
    bf16* WinT = (bf16*)(F.ws + WS_WIN); bf16* WoutT = (bf16*)(F.ws + WS_WOUT); bf16* W3T = (bf16*)(F.ws + WS_W3T);
    constexpr int I_IN = (DM / 64) * (INW / 32), I_OUT = (DM / 64) * (DM / 32), I_3 = 1 * (4096 / 32);
    constexpr int NITEMS = I_IN + I_OUT + I_3;
    for (int it = gw; it < NITEMS; it += NGW) {
        int r = it;
        if (r < I_IN) { const int nblk = INW / 32, kb = r / nblk, nb = r % nblk; p0_transpose_item(F.in[2], DM, INW, WinT, 32 * nb, 64 * kb, 32 * nb, scr, F.lane); continue; } r -= I_IN;
        if (r < I_OUT) { const int nblk = DM / 32, kb = r / nblk, nb = r % nblk; p0_transpose_item(F.in[17], DM, DM, WoutT, 32 * nb, 64 * kb, 32 * nb, scr, F.lane); continue; } r -= I_OUT;
        { const int nb = r; p0_transpose_item(F.in[12], FHID, 4096, W3T, 32 * nb, 0, 32 * nb, scr, F.lane); }
    }
    bf16* HB = (bf16*)(F.ws + WS_HB);
    const float* x = F.in[0]; const float* g = F.in[1];
    f32x4 gv[8];
#pragma unroll
    for (int j = 0; j < 8; ++j) gv[j] = *((const GAS f32x4*)g + F.lane + 64 * j);
    f32x4 vn[8];
    if (gw < MT) { const GAS f32x4* xr = (const GAS f32x4*)(x + (size_t)gw * DM) + F.lane;
#pragma unroll
        for (int j = 0; j < 8; ++j) vn[j] = xr[64 * j]; }
    for (int m = gw; m < MT; m += NGW) {
        f32x4 v[8]; float s = 0.f;
#pragma unroll
        for (int j = 0; j < 8; ++j) { v[j] = vn[j]; s += (v[j].x * v[j].x + v[j].y * v[j].y) + (v[j].z * v[j].z + v[j].w * v[j].w); }
        if (m + NGW < MT) { const GAS f32x4* xr = (const GAS f32x4*)(x + (size_t)(m + NGW) * DM) + F.lane;
#pragma unroll
            for (int j = 0; j < 8; ++j) vn[j] = xr[64 * j]; }
        const float r = rsqrtf(wave_sum(s) * (1.f / DM) + EPS);
        GAS v2u* o8 = (GAS v2u*)(HB + (size_t)m * DM) + F.lane;
#pragma unroll
        for (int j = 0; j < 8; ++j) { const f32x4 gg = gv[j]; v2u o; o.x = pk2(v[j].x * r * gg.x, v[j].y * r * gg.y); o.y = pk2(v[j].z * r * gg.z, v[j].w * r * gg.w); o8[64 * j] = o; }
    }
    float* HID2 = (float*)(F.ws + WS_HID2);
    LAS float* sc2 = (LAS float*)(F.lds + F.wave * 16384);
    const float* w1 = F.in[8]; const float* b1 = F.in[9]; const float* w2 = F.in[10]; const float* b2 = F.in[11]; const float* fr = F.in[13];
    float w1c[FEMB], w2c[FHID];
    { const int j = F.lane;
#pragma unroll
      for (int i = 0; i < FEMB; ++i) w1c[i] = w1[i * FHID + j];
#pragma unroll
      for (int i = 0; i < FHID; ++i) w2c[i] = w2[i * FHID + j]; }
    for (int l = gw; l < SEQ; l += NGW) {
        const int j = F.lane;
        float zv = 0.f;
        if (j == 0) zv = (float)l / (float)(SEQ - 1);
        else if (j < FEMB) { const int k = (j - 1) & 15; const float f = 1e-4f + (float)k * ((15.0f - 1e-4f) / 15.0f); const float wv = 6.283185307179586f * (float)l / (float)SEQ; zv = (j <= 16) ? cosf(f * wv) : -sinf(f * wv); }
        sc2[j] = zv; LDS_WAIT(); asm volatile("" ::: "memory");
        float a = b1[j];
#pragma unroll
        for (int i = 0; i < FEMB; ++i) a += sc2[i] * w1c[i];
        const float h1 = sinf(fr[j] * a);
        sc2[64 + j] = h1; LDS_WAIT(); asm volatile("" ::: "memory");
        float c = b2[j];
#pragma unroll
        for (int i = 0; i < FHID; ++i) c += sc2[64 + i] * w2c[i];
        HID2[l * FHID + j] = sinf(fr[j] * c);
        LDS_WAIT(); asm volatile("" ::: "memory");
    }
}

typedef short bf16x8 __attribute__((ext_vector_type(8)));
typedef float f32x16 __attribute__((ext_vector_type(16)));
__device__ __forceinline__ void phase_filters(Frame& F) {
    const float* HID2 = (const float*)(F.ws + WS_HID2); const bf16* W3T = (const bf16*)(F.ws + WS_W3T); const float* fbias = F.in[14]; bf16* TAPS = (bf16*)(F.ws + WS_TAPS);
    const int n = F.lane & 31, hh = F.lane >> 5;
    const float mind = -4.605170185988091f / 1.5f, maxd = -4.605170185988091f / 0.3f;
    LAS bf16* scr = (LAS bf16*)(F.lds + F.wave * 4096);
    for (int task = GW_ID(F); task < 128 * 16; task += GW_N(F)) {
        const int l0 = (task & 127) * 32, cg = task >> 7;
        const int dir = (cg >> 2) & 1, o = cg >> 3;
        const int l = l0 + dir + n;
        bf16x8 hb[4];
        { const int lr = l < SEQ ? l : SEQ - 1;
#pragma unroll
          for (int ks = 0; ks < 4; ++ks) { const GAS f32x4* hp = (const GAS f32x4*)(HID2 + (size_t)lr * FHID + 16 * ks + 8 * hh); const f32x4 h0 = hp[0], h1 = hp[1];
              v4u bw; bw.x = pk2(h0.x, h0.y); bw.y = pk2(h0.z, h0.w); bw.z = pk2(h1.x, h1.y); bw.w = pk2(h1.z, h1.w); hb[ks] = __builtin_bit_cast(bf16x8, bw); } }
        const float t = (float)l / (float)(SEQ - 1);
        const int pos = dir ? 31 - n : n;
        const int idx0 = dir ? 4064 - l0 : 4096 + l0;
        bf16x8 an[4];
#pragma unroll
        for (int ks = 0; ks < 4; ++ks) an[ks] = *(const GAS bf16x8*)(W3T + (size_t)(cg * 8 * 32 + n) * FHID + 16 * ks + 8 * hh);
#pragma unroll 2
        for (int ct = 0; ct < 8; ++ct) {
            const int col0 = (cg * 8 + ct) * 32;
            f32x16 acc;
#pragma unroll
            for (int i = 0; i < 16; ++i) acc[i] = 0.f;
            bf16x8 ac[4];
#pragma unroll
            for (int ks = 0; ks < 4; ++ks) ac[ks] = an[ks];
            { const int coln = (cg * 8 + (ct < 7 ? ct + 1 : ct)) * 32;
#pragma unroll
              for (int ks = 0; ks < 4; ++ks) an[ks] = *(const GAS bf16x8*)(W3T + (size_t)(coln + n) * FHID + 16 * ks + 8 * hh); }
#pragma unroll
            for (int ks = 0; ks < 4; ++ks) acc = __builtin_amdgcn_mfma_f32_32x32x16_bf16(ac[ks], hb[ks], acc, 0, 0, 0);
#pragma unroll
            for (int i = 0; i < 16; ++i) {
                const int chl = (i & 3) + 8 * (i >> 2) + 4 * hh, c = (col0 & 1023) + chl;
                const float delta = fabsf(mind + (maxd - mind) * ((float)c / 1023.0f));
                float v = acc[i] * __expf(-t * delta);
                if (l >= SEQ) v = 0.f;
                scr[chl * 40 + pos] = (bf16)f2bf(v);
            }
            LDS_WAIT(); asm volatile("" ::: "memory");
#pragma unroll
            for (int j = 0; j < 2; ++j) { const int id = F.lane + 64 * j, chl = id >> 2, q = id & 3;
                const v4u w = *(const LAS v4u*)(scr + chl * 40 + 8 * q);
                *(GAS v4u*)(TAPS + ((size_t)((col0 & 1023) + chl) * 2 + o) * 8192 + idx0 + 8 * q) = w; }
            LDS_WAIT(); asm volatile("" ::: "memory");
        }
    }
}

constexpr int HY_TAPS_BYTES = 4 * 16384, HY_ZB_ENT = 6080, HY_ZB_BYTES = 12288;
__device__ __forceinline__ unsigned hy_zb_off(int idx0  ) { const int q = idx0 >> 3; return (unsigned)((q ^ ((q >> 4) & 3)) << 4); }
__device__ __forceinline__ const LAS unsigned char* hy_pm(const LAS unsigned char* zbl  , int g, int ip, int hh) {
    const int q0 = 124 - 4 * ip + 2 * g + hh;
    unsigned p = (unsigned)(size_t)zbl + (unsigned)(((q0 ^ ((q0 >> 4) & 3)) << 4) - 7168);
    asm volatile("" : "+v"(p));
    return (const LAS unsigned char*)(size_t)p;
}
template <int MASK>
__device__ __forceinline__ void hy_loadB(bf16x8 (&bf)[8], const LAS unsigned char* pm) {
#pragma unroll
    for (int tau = 0; tau < 8; ++tau) if (MASK & (1 << tau)) bf[tau] = *(const LAS bf16x8*)(pm + 1024 * (7 - tau));
}
__device__ __forceinline__ void hy_loadA(unsigned (&d)[5], const LAS bf16* taps, int g, int n, int hh) {
    const volatile LAS unsigned* dp = (const volatile LAS unsigned*)taps + ((1 + 8 * hh + n) >> 1) + 8 * g;
#pragma unroll
    for (int i = 0; i < 5; ++i) d[i] = dp[i];
}
template <int MASK>
__device__ __forceinline__ void hy_mma(f32x16 (&acc)[8], const bf16x8 a, const bf16x8 (&bf)[8]) {
#pragma unroll
    for (int tau = 0; tau < 8; ++tau) if (MASK & (1 << tau)) acc[tau] = __builtin_amdgcn_mfma_f32_32x32x16_bf16(a, bf[tau], acc[tau], 0, 0, 0);
}
#define HY_ALIGN(a, d) do { v4u aw_; aw_.x = __builtin_amdgcn_alignbyte(d[1], d[0], sh); aw_.y = __builtin_amdgcn_alignbyte(d[2], d[1], sh); aw_.z = __builtin_amdgcn_alignbyte(d[3], d[2], sh); aw_.w = __builtin_amdgcn_alignbyte(d[4], d[3], sh); a = __builtin_bit_cast(bf16x8, aw_); } while (0)
#define HY_INTERLEAVE() do { __builtin_amdgcn_sched_group_barrier(0x2, 4, 0); _Pragma("unroll") for (int i_ = 0; i_ < 9; ++i_) { __builtin_amdgcn_sched_group_barrier(0x8, 1, 0); __builtin_amdgcn_sched_group_barrier(0x100, 3, 0); __builtin_amdgcn_sched_group_barrier(0x2, 3, 0); } } while (0)
constexpr int HY_YOFF = 254;
template <int MASK>
__device__ __forceinline__ void hy_mma_reload(f32x16 (&acc)[8], const bf16x8 a, bf16x8 (&bf)[8], const LAS unsigned char* pm_next) {
#pragma unroll
    for (int tau = 0; tau < 8; ++tau) if (MASK & (1 << tau)) {
        acc[tau] = __builtin_amdgcn_mfma_f32_32x32x16_bf16(a, bf[tau], acc[tau], 0, 0, 0);
        bf[tau] = *(const LAS bf16x8*)(pm_next + 1024 * (7 - tau));
    }
}
template <int MX, int MY>
__device__ __forceinline__ void hy_segment(f32x16 (&acc)[8], const LAS bf16* taps, const LAS unsigned char* zbl, int i0, int i1, int n, int hh) {
    const unsigned sh = (n & 1) ? 0u : 2u;
    const int ip = n & 15;
    unsigned dx[5], dy[5]; bf16x8 a, x0[8], y0[8];
    hy_loadA(dx, taps, i0, n, hh); hy_loadA(dy, taps, i0 + HY_YOFF, n, hh); hy_loadB<MX>(x0, hy_pm(zbl, i0, ip, hh)); hy_loadB<MY>(y0, hy_pm(zbl, i0 + HY_YOFF, ip, hh));
#pragma unroll 1
    for (int i = i0; i < i1; ++i) {
        if (MX) { HY_ALIGN(a, dx); hy_loadA(dx, taps, i + 1, n, hh); hy_mma_reload<MX>(acc, a, x0, hy_pm(zbl, i + 1, ip, hh)); }
        HY_ALIGN(a, dy); hy_loadA(dy, taps, i + 1 + HY_YOFF, n, hh); hy_mma_reload<MY>(acc, a, y0, hy_pm(zbl, i + 1 + HY_YOFF, ip, hh));
        HY_INTERLEAVE(); __builtin_amdgcn_sched_barrier(0);
    }
}
__device__ __forceinline__ void hy_stage_taps(Frame& F, int c0, int o) {
    const bf16* TAPS = (const bf16*)(F.ws + WS_TAPS);
    int tid = F.tid; asm volatile("" : "+v"(tid));
#pragma unroll
    for (int j = 0; j < 8; ++j) { const int ch = tid + NTHREADS * j, ci = ch >> 10, w = ch & 1023;
        v4u t = *((const GAS v4u*)(TAPS + ((size_t)(c0 + ci) * 2 + o) * 8192) + w);
        if (w == 512) { const float fb = F.in[14][o * 1024 + c0 + ci]; t.x = (t.x & 0xffff0000u) | f2bf(bflo(t.x) + fb); }
        *((LAS v4u*)(F.lds) + ch) = t; }
}
struct ConvItem { const float* W; bf16* WTe; int N, row_base, k0, n0; };
__device__ __forceinline__ void conv_load64(float (&v)[64], const ConvItem& c, int lane) {
    const GAS float* src = (const GAS float*)(c.W + (size_t)c.k0 * c.N + c.n0 + lane);
#pragma unroll
    for (int kk = 0; kk < 64; ++kk) v[kk] = src[(size_t)kk * c.N];
}
__device__ __forceinline__ void conv_store64(const float (&v)[64], const ConvItem& c, int lane) {
    GAS v4u* dst = (GAS v4u*)c.WTe + (size_t)(c.k0 >> 3) * 2048 + c.row_base + lane;
#pragma unroll
    for (int j = 0; j < 8; ++j) { v4u o; o.x = pk2(v[8 * j], v[8 * j + 1]); o.y = pk2(v[8 * j + 2], v[8 * j + 3]); o.z = pk2(v[8 * j + 4], v[8 * j + 5]); o.w = pk2(v[8 * j + 6], v[8 * j + 7]); dst[(size_t)j * 2048] = o; }
}
constexpr int MOE_ITEMS_GU = 2 * NE * 32 * 16, MOE_ITEMS_D = NE * 16 * 32, MOE_ITEMS = MOE_ITEMS_GU + MOE_ITEMS_D;
#ifndef MOE_P0_ITEMS
#define MOE_P0_ITEMS 0
#endif
#ifndef MOE_P4_ITEMS
#define MOE_P4_ITEMS 3584
#endif
constexpr int MOE_HELP_ITEMS = MOE_ITEMS - MOE_P0_ITEMS - MOE_P4_ITEMS;
__device__ __forceinline__ ConvItem moe_item(Frame& F, int it) {
    bf16* WguT = (bf16*)(F.ws + WS_WGU); bf16* WdT = (bf16*)(F.ws + WS_WD); ConvItem c;
    if (it < MOE_ITEMS_GU) { const int which = it >> 13, e = (it >> 9) & 15, kb = (it >> 4) & 31, nb = it & 15, f0 = 64 * nb;
        c.W = (which ? F.in[21] : F.in[20]) + (size_t)e * DM * FF; c.N = FF; c.WTe = WguT + (size_t)e * 2048 * DM; c.row_base = (f0 >> 7) * 256 + which * 128 + (f0 & 127); c.k0 = 64 * kb; c.n0 = f0;
    } else { const int r = it - MOE_ITEMS_GU, e = r >> 9, kb = (r >> 5) & 15, nb = r & 31;
        c.W = F.in[22] + (size_t)e * FF * DM; c.N = DM; c.WTe = WdT + (size_t)e * 2048 * FF; c.row_base = 64 * nb; c.k0 = 64 * kb; c.n0 = 64 * nb; }
    return c;
}
__device__ __forceinline__ void conv_range_moe_tail(Frame& F);
__device__ __forceinline__ void moe_conv_item(Frame& F, int it) { float v[64]; const ConvItem c = moe_item(F, it); conv_load64(v, c, F.lane); conv_store64(v, c, F.lane); }
__device__ __forceinline__ void moe_conv_range(Frame& F, int lo, int hi, int step) {
    if (lo >= hi) return;
    float va[64], vb[64];
    ConvItem ca = moe_item(F, lo), cb_; conv_load64(va, ca, F.lane);
    for (int it = lo; it < hi; it += 2 * step) {
        const bool hb = it + step < hi;
        if (hb) { cb_ = moe_item(F, it + step); conv_load64(vb, cb_, F.lane); }
        conv_store64(va, ca, F.lane);
        const bool ha = it + 2 * step < hi;
        if (ha) { ca = moe_item(F, it + 2 * step); conv_load64(va, ca, F.lane); }
        if (hb) conv_store64(vb, cb_, F.lane);
    }
}
__device__ __forceinline__ void conv_range_moe_tail(Frame& F) {
    const int w = (F.bid - NB * NE) * NWAVES + F.wave, nw = (F.G - NB * NE) * NWAVES;
    moe_conv_range(F, MOE_ITEMS - MOE_P4_ITEMS + w, MOE_ITEMS, nw);
}
__device__ __forceinline__ void hy_write_gates(Frame& F, int c0, int oo) {
    const bf16* XH = (const bf16*)(F.ws + WS_XT) + (size_t)1024 * MT; bf16* GC = (bf16*)(F.ws + WS_UC);
    const float* cw = F.in[6]; const float* cb = F.in[7];
    int ht = F.tid - 256; asm volatile("" : "+v"(ht));
#pragma unroll 2
    for (int k = 0; k < 16; ++k) { const int id = ht + 256 * k, u = id & 511, b = (id >> 9) & 1, ci = id >> 10;
        const int gch = oo * 1024 + c0 + ci; const bf16* gs = XH + (size_t)gch * MT + b * SEQ;
        const float w0 = cw[gch], w1 = cw[3072 + gch], w2 = cw[6144 + gch], bb = cb[gch];
        const v4u w = *((const GAS v4u*)gs + u);
        float f[10];
        f[1] = bflo(w.x); f[2] = bfhi(w.x); f[3] = bflo(w.y); f[4] = bfhi(w.y); f[5] = bflo(w.z); f[6] = bfhi(w.z); f[7] = bflo(w.w); f[8] = bfhi(w.w);
        { const float l_ = bf2f(gs[u > 0 ? 8 * u - 1 : 0]), r_ = bf2f(gs[u < 511 ? 8 * u + 8 : 8 * u + 7]); f[0] = u > 0 ? l_ : 0.f; f[9] = u < 511 ? r_ : 0.f; }
        float z[8];
#pragma unroll
        for (int e = 0; e < 8; ++e) z[e] = bb + w0 * f[e] + w1 * f[e + 1] + w2 * f[e + 2];
        v4u r; r.x = pk2(z[0], z[1]); r.y = pk2(z[2], z[3]); r.z = pk2(z[4], z[5]); r.w = pk2(z[6], z[7]);
        *((GAS v4u*)(GC + ((size_t)((c0 + ci) * 2 + oo) * 2 + b) * SEQ) + u) = r; }
}
__device__ __forceinline__ void phase_hyena(Frame& F) {
    const bf16* XH = (const bf16*)(F.ws + WS_XT) + (size_t)1024 * MT;
    const float* cw = F.in[6]; const float* cb = F.in[7];
    bf16* HYT = (bf16*)(F.ws + WS_HYT); bf16* GC = (bf16*)(F.ws + WS_UC);
    const int n = F.lane & 31, hh = F.lane >> 5;
    const bool compute = F.wave < 4;
    const int nhelp = F.G * 4, hw = F.bid * 4 + (F.wave - 4);
    int sec = 0;
    for (int cg = F.bid; cg < 256; cg += F.G) {
        const int c0 = cg * 4;
        __syncthreads();
        hy_stage_taps(F, c0, 0);
        {
          int lane_ = F.lane; asm volatile("" : "+v"(lane_));
          const int ci = F.wave >> 1, b = F.wave & 1; LAS unsigned char* zb = F.lds + HY_TAPS_BYTES + F.wave * HY_ZB_BYTES;
          const int zch = 2048 + c0 + ci; const bf16* zsrc = XH + (size_t)zch * MT + b * SEQ;
          const float w0 = cw[zch], w1 = cw[3072 + zch], w2 = cw[6144 + zch], bb = cb[zch];
#pragma unroll
          for (int j = 0; j < 8; ++j) { const int u = lane_ + 64 * j; const v4u w = *((const GAS v4u*)zsrc + u);
              float f[10];
              f[1] = bflo(w.x); f[2] = bfhi(w.x); f[3] = bflo(w.y); f[4] = bfhi(w.y); f[5] = bflo(w.z); f[6] = bfhi(w.z); f[7] = bflo(w.w); f[8] = bfhi(w.w);
              { const float l_ = bf2f(zsrc[u > 0 ? 8 * u - 1 : 0]), r_ = bf2f(zsrc[u < 511 ? 8 * u + 8 : 8 * u + 7]); f[0] = u > 0 ? l_ : 0.f; f[9] = u < 511 ? r_ : 0.f; }
              float z[8];
#pragma unroll
              for (int e = 0; e < 8; ++e) z[e] = bb + w0 * f[e] + w1 * f[e + 1] + w2 * f[e + 2];
              v4u r; r.x = pk2(z[7], z[6]); r.y = pk2(z[5], z[4]); r.z = pk2(z[3], z[2]); r.w = pk2(z[1], z[0]);
              *(LAS v4u*)(zb + hy_zb_off(8 * (635 - u))) = r; }
          const v4u zero = {0u, 0u, 0u, 0u};
          for (int q = lane_; q < 124; q += 64) { *(LAS v4u*)(zb + hy_zb_off(8 * q)) = zero; *(LAS v4u*)(zb + hy_zb_off(8 * (636 + q))) = zero; } }
        if (!compute) hy_write_gates(F, c0, 0);
        __syncthreads();
#pragma unroll 1
        for (int o = 0; o < 2; ++o) {
            if (compute) {
                const int ci = F.wave, c = c0 + ci;
                const LAS bf16* taps = (const LAS bf16*)(F.lds + ci * 16384);
                const int ip = n & 15, bl = n >> 4;
                LAS unsigned char* zbl = F.lds + HY_TAPS_BYTES + (2 * ci + bl) * HY_ZB_BYTES;
                f32x16 acc[8];
#pragma unroll
                for (int tau = 0; tau < 8; ++tau)
#pragma unroll
                    for (int i = 0; i < 16; ++i) acc[tau][i] = 0.f;
                hy_segment<0x01, 0xFF>(acc, taps, zbl, 0, 32, n, hh);
                hy_segment<0x03, 0xFE>(acc, taps, zbl, 32, 64, n, hh);
                hy_segment<0x07, 0xFC>(acc, taps, zbl, 64, 96, n, hh);
                hy_segment<0x0F, 0xF8>(acc, taps, zbl, 96, 128, n, hh);
                hy_segment<0x1F, 0xF0>(acc, taps, zbl, 128, 160, n, hh);
                hy_segment<0x3F, 0xE0>(acc, taps, zbl, 160, 192, n, hh);
                hy_segment<0x7F, 0xC0>(acc, taps, zbl, 192, 224, n, hh);
                hy_segment<0xFF, 0x80>(acc, taps, zbl, 224, 254, n, hh);
                hy_segment<0x00, 0x80>(acc, taps, zbl, 254, 256, n, hh);
                LDS_WAIT();
                int ip2 = ip, h2 = hh, b2 = bl; asm volatile("" : "+v"(ip2), "+v"(h2), "+v"(b2));
                {
                    const bf16* gate = GC + ((size_t)(c * 2 + o) * 2 + b2) * SEQ;
                    LAS unsigned char* zb = F.lds + HY_TAPS_BYTES + (2 * ci + b2) * HY_ZB_BYTES; bf16* outp = HYT + (size_t)c * MT + b2 * SEQ;
#pragma unroll
                    for (int th = 0; th < 2; ++th) {
                        v2u gw[4][4];
#pragma unroll
                        for (int tq = 0; tq < 4; ++tq)
#pragma unroll
                            for (int rg = 0; rg < 4; ++rg) gw[tq][rg] = *(const GAS v2u*)(gate + 512 * (4 * th + tq) + 32 * ip2 + 8 * rg + 4 * h2);
#pragma unroll
                        for (int tq = 0; tq < 4; ++tq) {
#pragma unroll
                            for (int rg = 0; rg < 4; ++rg) { const int tau = 4 * th + tq, t0 = 512 * tau + 32 * ip2 + 8 * rg + 4 * h2;
                                const float z0 = bflo(gw[tq][rg].x) * acc[tau][4 * rg + 0], z1 = bfhi(gw[tq][rg].x) * acc[tau][4 * rg + 1], z2 = bflo(gw[tq][rg].y) * acc[tau][4 * rg + 2], z3 = bfhi(gw[tq][rg].y) * acc[tau][4 * rg + 3];
                                if (o == 0) { v2u w; w.x = pk2(z3, z2); w.y = pk2(z1, z0);
                                    *(LAS v2u*)(zb + hy_zb_off(8 * (635 - (t0 >> 3))) + (h2 ? 0 : 8)) = w; }
                                else { v2u w; w.x = pk2(z0, z1); w.y = pk2(z2, z3); *(GAS v2u*)(outp + t0) = w; } } }
                    }
                }
            } else {
                if (o == 0) hy_write_gates(F, c0, 1);
                const int lo_it = MOE_P0_ITEMS + sec * (MOE_HELP_ITEMS / 2), hi_it = lo_it + MOE_HELP_ITEMS / 2;
                if (sec < 2) moe_conv_range(F, lo_it + hw, hi_it, nhelp);
            }
            ++sec;
            if (o == 0) {
                __syncthreads();
                hy_stage_taps(F, c0, 1);
                __syncthreads();
            }
        }
    }
    for (; sec < 2; ++sec) if (!compute) { const int lo_it = MOE_P0_ITEMS + sec * (MOE_HELP_ITEMS / 2), hi_it = lo_it + MOE_HELP_ITEMS / 2; moe_conv_range(F, lo_it + hw, hi_it, nhelp); }
    __syncthreads();
}

constexpr int AT_KBYTES = 16384, AT_VPITCH = 136, AT_VBYTES = 128 * AT_VPITCH, AT_STAGE = AT_KBYTES + AT_VBYTES, AT_RP_OFF = 2 * AT_STAGE;
__device__ __forceinline__ void phase_attn2(Frame& F) {
    const bf16* QK = (const bf16*)(F.ws + WS_QK); const bf16* VT = (const bf16*)(F.ws + WS_XT); bf16* MIXED = (bf16*)(F.ws + WS_MIXED);
    const float* rpb = F.in[5]; const float* og = F.in[15]; const float* qg = F.in[3]; const float* kg = F.in[4];
    LAS float* rt = (LAS float*)(F.lds + AT_RP_OFF);
    LAS float* gtab = (LAS float*)(F.lds + AT_RP_OFF + 8 * 2048);
    LAS float* ogt = gtab + HD;
    if (F.tid < HD) gtab[F.tid] = qg[F.tid] * kg[F.tid];
    const int n = F.lane & 31, hh = F.lane >> 5;
    for (int unit = F.bid; unit < NB * NH * 16; unit += F.G) {
        const int rq = unit & 15, h = (unit >> 4) & 7, b = unit >> 7, r0 = 4 * rq;
        const int r = r0 + (F.wave >> 1), wq = F.wave & 1;
        int kmin = r0 - WR / 2; kmin = kmin < 0 ? 0 : (kmin > NROWS - WR ? NROWS - WR : kmin);
        int kmax = r0 + 3 - WR / 2; kmax = (kmax < 0 ? 0 : (kmax > NROWS - WR ? NROWS - WR : kmax)) + WR - 1;
        int kr0 = r - WR / 2; kr0 = kr0 < 0 ? 0 : (kr0 > NROWS - WR ? NROWS - WR : kr0);
        const int nrows = kmax - kmin + 1;
        __syncthreads();
        if (F.tid < HD) ogt[F.tid] = og[h * HD + F.tid];
#pragma unroll
        for (int k_ = 0; k_ < 4; ++k_) { const int i = F.tid + NTHREADS * k_; if (i < 15 * 128) { const int dr_ = i >> 7, dcx = (i & 127) - 48, dcc = dcx < 0 ? 0 : (dcx > 30 ? 30 : dcx);
            const float v = rpb[h * 465 + dr_ * 31 + dcc] * 1.4426950408889634f; rt[i] = (dcx == dcc) ? v : 0.f; } }
        const int mq = b * SEQ + r * GW + 32 * wq + n, qc = 32 * wq + n;
        int c0 = qc - WC / 2; c0 = c0 < 0 ? 0 : (c0 > GW - WC ? GW - WC : c0);
        bf16x8 qf[8];
#pragma unroll
        for (int ks = 0; ks < 8; ++ks) qf[ks] = *(const GAS bf16x8*)(QK + (size_t)mq * 2048 + h * HD + 16 * ks + 8 * hh);
        float qscale;
        {
          f32x16 D;
#pragma unroll
          for (int i = 0; i < 16; ++i) D[i] = 0.f;
#pragma unroll
          for (int ks = 0; ks < 8; ++ks) D = __builtin_amdgcn_mfma_f32_32x32x16_bf16(qf[ks], qf[ks], D, 0, 0, 0);
          float dsel = 0.f; const int isel = (n & 3) + 4 * (n >> 3);
#pragma unroll
          for (int i = 0; i < 16; ++i) dsel = (i == isel) ? D[i] : dsel;
          const float other = __shfl_xor(dsel, 32);
          const float ssq = (((n >> 2) & 1) == hh) ? dsel : other;
          qscale = (0.08838834764831845f * 1.4426950408889634f) * rsqrtf(ssq * (1.f / HD) + EPS); }
        const unsigned long long wmask = (c0 >= 4 * hh) ? (0xFFFFull << (c0 - 4 * hh)) : (0xFFFFull >> (4 * hh - c0));
        const unsigned wm0 = (unsigned)wmask, wm1 = (unsigned)(wmask >> 32);
        const int rtl = 4 * hh - qc + 63;
        f32x16 O[4];
#pragma unroll
        for (int dt = 0; dt < 4; ++dt)
#pragma unroll
            for (int i = 0; i < 16; ++i) O[dt][i] = 0.f;
        float lsum = 0.f;
        v4u sk[2], sv[2];

        auto gload = [&](int kr) {
#pragma unroll
            for (int j = 0; j < 2; ++j) { const int id = F.tid + 512 * j;
                sk[j] = *(const GAS v4u*)(QK + (size_t)(b * SEQ + kr * GW + (id >> 4)) * 2048 + 1024 + h * HD + 8 * (id & 15));
                sv[j] = *(const GAS v4u*)(VT + (size_t)(h * HD + (id >> 3)) * MT + b * SEQ + kr * GW + 8 * (id & 7)); }
        };
        auto lstore = [&](int buf) {
            LAS unsigned char* kb = F.lds + buf * AT_STAGE; LAS unsigned char* vb = kb + AT_KBYTES;
#pragma unroll
            for (int j = 0; j < 2; ++j) { const int id = F.tid + 512 * j; const int key = id >> 4, c = id & 15;
                float f[8] = {bflo(sk[j].x), bfhi(sk[j].x), bflo(sk[j].y), bfhi(sk[j].y), bflo(sk[j].z), bfhi(sk[j].z), bflo(sk[j].w), bfhi(sk[j].w)};
                float ss = 0.f;
#pragma unroll
                for (int e = 0; e < 8; ++e) ss += f[e] * f[e];
                ss += __shfl_xor(ss, 1); ss += __shfl_xor(ss, 2); ss += __shfl_xor(ss, 4); ss += __shfl_xor(ss, 8);
                const float rk = rsqrtf(ss * (1.f / HD) + EPS);
                const f32x4 ga = *(const LAS f32x4*)(gtab + 8 * c), gb = *(const LAS f32x4*)(gtab + 8 * c + 4);
                v4u kn; kn.x = pk2(f[0] * rk * ga.x, f[1] * rk * ga.y); kn.y = pk2(f[2] * rk * ga.z, f[3] * rk * ga.w); kn.z = pk2(f[4] * rk * gb.x, f[5] * rk * gb.y); kn.w = pk2(f[6] * rk * gb.z, f[7] * rk * gb.w);
                *(LAS v4u*)(kb + key * 256 + ((c ^ (key & 15)) << 4)) = kn;
                const int d = id >> 3, cv = id & 7; LAS v2u* vp = (LAS v2u*)(vb + d * AT_VPITCH + cv * 16);
                v2u lo, hi; lo.x = sv[j].x; lo.y = sv[j].y; hi.x = sv[j].z; hi.y = sv[j].w; vp[0] = lo; vp[1] = hi; }
        };
        gload(kmin); lstore(0);
        __syncthreads();
#pragma unroll 1
        for (int j = 0; j < nrows; ++j) {
            const int kr = kmin + j, buf = j & 1;
            if (j + 1 < nrows) gload(kr + 1);
            if (kr >= kr0 && kr < kr0 + WR) {
                const LAS unsigned char* kb = F.lds + buf * AT_STAGE; const LAS unsigned char* vb = kb + AT_KBYTES;
                const int dr = kr - r + WR - 1;
                const LAS float* rrow = rt + dr * 128 + rtl;
#pragma unroll
                for (int kt = 0; kt < 2; ++kt) {
                    f32x16 S;
#pragma unroll
                    for (int i = 0; i < 16; ++i) S[i] = 0.f;
                    const int key = 32 * kt + n;
#pragma unroll
                    for (int ks = 0; ks < 8; ++ks) { const bf16x8 kf = *(const LAS bf16x8*)(kb + key * 256 + (((2 * ks + hh) ^ (key & 15)) << 4));
                        S = __builtin_amdgcn_mfma_f32_32x32x16_bf16(kf, qf[ks], S, 0, 0, 0); }
                    float p[16];
#pragma unroll
                    for (int i = 0; i < 16; ++i) { const int E = (i & 3) + 8 * (i >> 2);
                        const float e = __builtin_amdgcn_exp2f(S[i] * qscale + rrow[32 * kt + E]);
                        const unsigned keep = (unsigned)__builtin_amdgcn_sbfe((int)(kt ? wm1 : wm0), E, 1);
                        p[i] = __builtin_bit_cast(float, __builtin_bit_cast(unsigned, e) & keep); lsum += p[i]; }
                    v4u pw0, pw1;
                    pw0.x = pk2(p[0], p[1]); pw0.y = pk2(p[2], p[3]); pw0.z = pk2(p[4], p[5]); pw0.w = pk2(p[6], p[7]);
                    pw1.x = pk2(p[8], p[9]); pw1.y = pk2(p[10], p[11]); pw1.z = pk2(p[12], p[13]); pw1.w = pk2(p[14], p[15]);
                    const bf16x8 pf0 = __builtin_bit_cast(bf16x8, pw0), pf1 = __builtin_bit_cast(bf16x8, pw1);
#pragma unroll
                    for (int dt = 0; dt < 4; ++dt) {
                        const LAS unsigned char* vrow = vb + (32 * dt + n) * AT_VPITCH + (32 * kt + 4 * hh) * 2;
                        const v2u a0 = *(const LAS v2u*)(vrow), a1 = *(const LAS v2u*)(vrow + 16), a2 = *(const LAS v2u*)(vrow + 32), a3 = *(const LAS v2u*)(vrow + 48);
                        v4u f0, f1; f0.x = a0.x; f0.y = a0.y; f0.z = a1.x; f0.w = a1.y; f1.x = a2.x; f1.y = a2.y; f1.z = a3.x; f1.w = a3.y;
                        O[dt] = __builtin_amdgcn_mfma_f32_32x32x16_bf16(__builtin_bit_cast(bf16x8, f0), pf0, O[dt], 0, 0, 0);
                        O[dt] = __builtin_amdgcn_mfma_f32_32x32x16_bf16(__builtin_bit_cast(bf16x8, f1), pf1, O[dt], 0, 0, 0);
                    }
                }
            }
            if (j + 1 < nrows) lstore(buf ^ 1);
            __syncthreads();
        }
        lsum += __shfl_xor(lsum, 32);
        const float il = 1.f / lsum;
        float ss = 0.f;
#pragma unroll
        for (int dt = 0; dt < 4; ++dt)
#pragma unroll
            for (int i = 0; i < 16; ++i) { O[dt][i] *= il; ss += O[dt][i] * O[dt][i]; }
        ss += __shfl_xor(ss, 32);
        const float rr = rsqrtf(ss * (1.f / HD) + EPS);
        bf16* orow = MIXED + (size_t)mq * DM + h * HD;
#pragma unroll
        for (int dt = 0; dt < 4; ++dt)
#pragma unroll
            for (int rg = 0; rg < 4; ++rg) { const int d = 32 * dt + 8 * rg + 4 * hh; const f32x4 gg = *(const LAS f32x4*)(ogt + d);
                v2u w; w.x = pk2(O[dt][4 * rg + 0] * rr * gg.x, O[dt][4 * rg + 1] * rr * gg.y); w.y = pk2(O[dt][4 * rg + 2] * rr * gg.z, O[dt][4 * rg + 3] * rr * gg.w);
                *(GAS v2u*)(orow + d) = w; }
    }
    __syncthreads();
}

__device__ __forceinline__ void phase_p25(Frame& F) {
    const bf16* HYT = (const bf16*)(F.ws + WS_HYT); bf16* MIXED = (bf16*)(F.ws + WS_MIXED); const float* hg = F.in[16];
    LAS float* tile = (LAS float*)F.lds;
    LAS float* rs = (LAS float*)(F.lds + 128 * 65 * 4);
    for (int it = F.bid; it < 8 * (MT / 64); it += F.G) {
        const int gi = it & 7, m0 = (it >> 3) * 64;
        { const int ch = F.tid >> 2, t0 = (F.tid & 3) * 16; const bf16* p = HYT + (size_t)(gi * 128 + ch) * MT + m0 + t0;
          const v4u a = *(const GAS v4u*)p, b = *(const GAS v4u*)(p + 8);
          LAS float* d = tile + ch * 65 + t0;
          d[0] = bflo(a.x); d[1] = bfhi(a.x); d[2] = bflo(a.y); d[3] = bfhi(a.y); d[4] = bflo(a.z); d[5] = bfhi(a.z); d[6] = bflo(a.w); d[7] = bfhi(a.w);
          d[8] = bflo(b.x); d[9] = bfhi(b.x); d[10] = bflo(b.y); d[11] = bfhi(b.y); d[12] = bflo(b.z); d[13] = bfhi(b.z); d[14] = bflo(b.w); d[15] = bfhi(b.w); }
        __syncthreads();
        {
          const int t = F.tid >> 3, c0 = (F.tid & 7) * 16; float ss = 0.f;
#pragma unroll
          for (int c = 0; c < 16; ++c) { const float v = tile[(c0 + c) * 65 + t]; ss += v * v; }
          ss += __shfl_xor(ss, 1); ss += __shfl_xor(ss, 2); ss += __shfl_xor(ss, 4);
          if ((F.tid & 7) == 0) rs[t] = rsqrtf(ss * (1.f / 128) + EPS); }
        __syncthreads();
        {
          const int t = F.tid >> 3, c0 = (F.tid & 7) * 16; const float r = rs[t]; float o[16];
#pragma unroll
          for (int c = 0; c < 16; ++c) o[c] = tile[(c0 + c) * 65 + t] * r * hg[gi * 128 + c0 + c];
          v4u a, b; a.x = pk2(o[0], o[1]); a.y = pk2(o[2], o[3]); a.z = pk2(o[4], o[5]); a.w = pk2(o[6], o[7]); b.x = pk2(o[8], o[9]); b.y = pk2(o[10], o[11]); b.z = pk2(o[12], o[13]); b.w = pk2(o[14], o[15]);
          bf16* q = MIXED + (size_t)(m0 + t) * DM + AW + gi * 128 + c0; *(GAS v4u*)q = a; *(GAS v4u*)(q + 8) = b; }
        __syncthreads();
    }
}
__device__ __forceinline__ void phase_p35(Frame& F) {
    LAS float* wrT = (LAS float*)F.lds;
    const float* wr = F.in[19]; const float* g = F.in[18];
    constexpr int WRS = DM + 4;
    for (int i = F.tid; i < DM * NE; i += NTHREADS) { const int d = i >> 4, e = i & 15; wrT[e * WRS + d] = wr[i]; }
    __syncthreads();
    bf16* HB = (bf16*)(F.ws + WS_HB); float* AFF = (float*)(F.ws + WS_AFF); const float* x1 = F.out;
    f32x4 gv[8];
#pragma unroll
    for (int j = 0; j < 8; ++j) gv[j] = *((const GAS f32x4*)g + F.lane + 64 * j);
    f32x4 vn[8];
    { const int m0 = GW_ID(F); if (m0 < MT) { const GAS f32x4* xr = (const GAS f32x4*)(x1 + (size_t)m0 * DM) + F.lane;
#pragma unroll
        for (int j = 0; j < 8; ++j) vn[j] = xr[64 * j]; } }
    for (int m = GW_ID(F); m < MT; m += GW_N(F)) {
        f32x4 v[8]; float s = 0.f;
#pragma unroll
        for (int j = 0; j < 8; ++j) { v[j] = vn[j]; s += (v[j].x * v[j].x + v[j].y * v[j].y) + (v[j].z * v[j].z + v[j].w * v[j].w); }
        if (m + GW_N(F) < MT) { const GAS f32x4* xr = (const GAS f32x4*)(x1 + (size_t)(m + GW_N(F)) * DM) + F.lane;
#pragma unroll
            for (int j = 0; j < 8; ++j) vn[j] = xr[64 * j]; }
        const float r = rsqrtf(wave_sum(s) * (1.f / DM) + EPS);
        GAS v2u* o8 = (GAS v2u*)(HB + (size_t)m * DM) + F.lane;
#pragma unroll
        for (int j = 0; j < 8; ++j) { const f32x4 gg = gv[j]; v[j].x *= r * gg.x; v[j].y *= r * gg.y; v[j].z *= r * gg.z; v[j].w *= r * gg.w;
            v2u o; o.x = pk2(v[j].x, v[j].y); o.y = pk2(v[j].z, v[j].w); o8[64 * j] = o; }
        float mine = 0.f;
#pragma unroll 1
        for (int e = 0; e < NE; ++e) { float a = 0.f;
#pragma unroll
            for (int j = 0; j < 8; ++j) { const f32x4 w = *((const LAS f32x4*)(wrT + e * WRS) + F.lane + 64 * j); a += (v[j].x * w.x + v[j].y * w.y) + (v[j].z * w.z + v[j].w * w.w); }
            a = wave_sum(a); mine = (F.lane == e) ? a : mine; }
        float mx = mine;
        mx = fmaxf(mx, __shfl_xor(mx, 1)); mx = fmaxf(mx, __shfl_xor(mx, 2)); mx = fmaxf(mx, __shfl_xor(mx, 4)); mx = fmaxf(mx, __shfl_xor(mx, 8));
        const float ex = expf(mine - mx); float den = ex;
        den += __shfl_xor(den, 1); den += __shfl_xor(den, 2); den += __shfl_xor(den, 4); den += __shfl_xor(den, 8);
        const int b = m / SEQ, sidx = m % SEQ;
        if (F.lane < NE) AFF[((size_t)b * NE + F.lane) * SEQ + sidx] = ex / den;
    }
    __syncthreads();
}
__device__ __forceinline__ void phase_p4(Frame& F) {
    LAS unsigned* key = (LAS unsigned*)F.lds;
    LAS unsigned* hist = (LAS unsigned*)(F.lds + 16384);
    LAS unsigned* wsum = (LAS unsigned*)(F.lds + 16384 + 1024);
    const float* AFF = (const float*)(F.ws + WS_AFF); int* IDX = (int*)(F.ws + WS_IDX); float* GATE = (float*)(F.ws + WS_GATE); int* SEL = (int*)(F.ws + WS_SEL);
    for (int be = F.bid; be < NB * NE; be += F.G) {
        const int b = be / NE, e = be % NE;
        __syncthreads();
        const GAS v4u* ap = (const GAS v4u*)(AFF + (size_t)be * SEQ);
        const v4u k0 = ap[2 * F.tid], k1 = ap[2 * F.tid + 1];
        unsigned kk[8] = {k0.x, k0.y, k0.z, k0.w, k1.x, k1.y, k1.z, k1.w};
        unsigned prefix = 0u, mask = 0u, remaining = CAP;
#pragma unroll 1
        for (int pass = 0; pass < 4; ++pass) {
            const int shift = 24 - 8 * pass;
            if (F.tid < 256) hist[F.tid] = 0u;
            __syncthreads();
#pragma unroll
            for (int i = 0; i < 8; ++i) if ((kk[i] & mask) == prefix) __hip_atomic_fetch_add(&hist[(kk[i] >> shift) & 255u], 1u, __ATOMIC_RELAXED, __HIP_MEMORY_SCOPE_WORKGROUP);
            __syncthreads();
            unsigned incl_ = 0u, mine_ = 0u;
            if (F.tid < 256) {
                mine_ = hist[255 - F.tid]; incl_ = mine_;
#pragma unroll
                for (int o = 1; o < 64; o <<= 1) { const unsigned t = __shfl_up(incl_, o); if (F.lane >= o) incl_ += t; }
                if (F.lane == 63) wsum[10 + F.wave] = incl_;
            }
            __syncthreads();
            if (F.tid < 256) {
                unsigned base = 0u;
                for (int w = 0; w < F.wave; ++w) base += wsum[10 + w];
                const unsigned above = base + incl_ - mine_;
                if (above < remaining && remaining <= above + mine_) { wsum[8] = (unsigned)(255 - F.tid); wsum[9] = above; }
            }
            __syncthreads();
            const unsigned d = wsum[8], above = wsum[9];
            prefix |= d << shift; mask |= 255u << shift; remaining -= above;
            __syncthreads();
        }
        const unsigned thr = prefix;
        unsigned cnt = 0u;
#pragma unroll
        for (int i = 0; i < 8; ++i) cnt += (kk[i] > thr ? 0x10000u : 0u) + (kk[i] == thr ? 1u : 0u);
        unsigned incl = cnt;
#pragma unroll
        for (int o = 1; o < 64; o <<= 1) { const unsigned t = __shfl_up(incl, o); if (F.lane >= o) incl += t; }
        if (F.lane == 63) wsum[F.wave] = incl;
        __syncthreads();
        unsigned base = 0u;
        for (int w = 0; w < F.wave; ++w) base += wsum[w];
        unsigned run = base + incl - cnt;
#pragma unroll
        for (int i = 0; i < 8; ++i) {
            const unsigned gt_before = run >> 16, tie_before = run & 0xffffu;
            const bool isgt = kk[i] > thr, istie = kk[i] == thr;
            const bool sel = isgt || (istie && tie_before < remaining);
            const unsigned slot = gt_before + (tie_before < remaining ? tie_before : remaining);
            const int s = 8 * F.tid + i, m = b * SEQ + s;
            if (sel) { IDX[be * CAP + slot] = m; GATE[be * CAP + slot] = __builtin_bit_cast(float, kk[i]); }
            SEL[(size_t)m * NE + e] = sel ? (int)slot : -1;
            run += (isgt ? 0x10000u : 0u) + (istie ? 1u : 0u);
        }
    }
    __syncthreads();
}
__device__ __forceinline__ void phase_p7(Frame& F) {
    const int* SEL = (const int*)(F.ws + WS_SEL); const bf16* YE = (const bf16*)(F.ws + WS_YE);
    for (int m = GW_ID(F); m < MT; m += GW_N(F)) {
        const int b = m / SEQ;
        GAS f32x4* orow = (GAS f32x4*)(F.out + (size_t)m * DM);
        const int sel = SEL[(size_t)m * NE + (F.lane & 15)];
        f32x4 acc[8];
#pragma unroll
        for (int j = 0; j < 8; ++j) acc[j] = orow[2 * F.lane + (j & 1) + 128 * (j >> 1)];
        unsigned mask = (unsigned)(__ballot(sel >= 0) & 0xFFFFull);
        while (mask) {
            const int e0 = __builtin_ctz(mask); mask &= mask - 1u;
            const bool two = mask != 0u; const int e1 = two ? __builtin_ctz(mask) : e0; if (two) mask &= mask - 1u;
            const int s0 = __builtin_amdgcn_readlane(sel, e0), s1 = __builtin_amdgcn_readlane(sel, e1);
            const GAS v4u* y0 = (const GAS v4u*)(YE + (size_t)((b * NE + e0) * CAP + s0) * DM) + F.lane;
            const GAS v4u* y1 = (const GAS v4u*)(YE + (size_t)((b * NE + e1) * CAP + s1) * DM) + F.lane;
            v4u w0[4], w1[4];
#pragma unroll
            for (int jj = 0; jj < 4; ++jj) { w0[jj] = y0[64 * jj]; w1[jj] = y1[64 * jj]; }
            const float k1 = two ? 1.f : 0.f;
#pragma unroll
            for (int jj = 0; jj < 4; ++jj) {
                acc[2 * jj].x += bflo(w0[jj].x) + k1 * bflo(w1[jj].x); acc[2 * jj].y += bfhi(w0[jj].x) + k1 * bfhi(w1[jj].x); acc[2 * jj].z += bflo(w0[jj].y) + k1 * bflo(w1[jj].y); acc[2 * jj].w += bfhi(w0[jj].y) + k1 * bfhi(w1[jj].y);
                acc[2 * jj + 1].x += bflo(w0[jj].z) + k1 * bflo(w1[jj].z); acc[2 * jj + 1].y += bfhi(w0[jj].z) + k1 * bfhi(w1[jj].z); acc[2 * jj + 1].z += bflo(w0[jj].w) + k1 * bflo(w1[jj].w); acc[2 * jj + 1].w += bfhi(w0[jj].w) + k1 * bfhi(w1[jj].w); }
        }
#pragma unroll
        for (int j = 0; j < 8; ++j) orow[2 * F.lane + (j & 1) + 128 * (j >> 1)] = acc[j];
    }
}

struct Args { const float* in[23]; float* out; unsigned char* ws; int ph_lo, ph_hi; };
enum Phase { PH_P0 = 0, PH_G1, PH_ATTN, PH_P25, PH_OUT, PH_P35, PH_P4, PH_UP, PH_DOWN, PH_P7, PH_COUNT };

__global__ void __launch_bounds__(NTHREADS, 2) mk_fwd(Args args) {
    extern __shared__ __attribute__((aligned(16))) unsigned char lds_raw[];
    Frame F;
    F.lds = (LAS unsigned char*)lds_raw;
    F.tid = threadIdx.x; F.lane = F.tid & 63; F.wave = __builtin_amdgcn_readfirstlane(F.tid >> 6); F.G = gridDim.x; F.bid = blockIdx.x;
#pragma unroll
    for (int i = 0; i < 23; ++i) F.in[i] = args.in[i];
    F.out = args.out; F.ws = args.ws;
    const int lo = args.ph_lo, hi = args.ph_hi;
#define IN(k) (lo <= (k) && (k) < hi)
#define REPS(k) for (int rep_ = 0; rep_ < ((k) == REP_PHASE ? REP_N : 1); ++rep_)
#if MK_N_LAUNCHES == 1
    { volatile LAS unsigned* misc = (volatile LAS unsigned*)(F.lds + LDS_MISC_OFF); if (F.tid < 16) misc[F.tid] = 0u; }
    __syncthreads();
    XcdBarrier bar = xcd_barrier_post(g_bar_words, (volatile LAS unsigned*)(F.lds + LDS_MISC_OFF) + 8);
#define SEAM(k) do { if (IN(k) && IN((k) + 1)) xcd_barrier(bar); } while (0)
#else
#define SEAM(k) do { } while (0)
#endif
    if (IN(PH_P0)) REPS(PH_P0) { phase_p0(F); for (int it = GW_ID(F); it < MOE_P0_ITEMS; it += GW_N(F)) moe_conv_item(F, it); } SEAM(PH_P0);
    if (IN(PH_G1)) REPS(PH_G1) {
        phase_filters(F);
        __syncthreads();
        { pg8::DenseOrder S; S.init(F.ws + WS_HB, F.ws + WS_WIN, MT, 2048, DM, 0, F.G, F.bid);
          pg8::EpiBf16 E{(pg8::bf16_t*)(F.ws + WS_QK), 2048, 0, nullptr};
          pg8::gemm_phase<pg8::EpiBf16, pg8::DenseOrder, true>(F.lds, DM, S, E); }
        { pg8::DenseOrder S; S.init(F.ws + WS_HB, F.ws + WS_WIN, MT, 4096, DM, 8, F.G, F.bid);
          pg8::EpiTransBf16 E{(pg8::bf16_t*)(F.ws + WS_XT), MT, 8};
          pg8::gemm_phase<pg8::EpiTransBf16, pg8::DenseOrder, true>(F.lds, DM, S, E); }
    } SEAM(PH_G1);
    if (IN(PH_ATTN)) { __syncthreads(); for (int rep_ = 0; rep_ < ((PH_ATTN == REP_PHASE && REP_SUB != 2) ? REP_N : 1); ++rep_) phase_hyena(F); for (int rep_ = 0; rep_ < ((PH_ATTN == REP_PHASE && REP_SUB != 1) ? REP_N : 1); ++rep_) phase_attn2(F); } SEAM(PH_ATTN);
    if (IN(PH_P25)) REPS(PH_P25) { __syncthreads(); phase_p25(F); } SEAM(PH_P25);
    if (IN(PH_OUT)) REPS(PH_OUT) {
        __syncthreads();
        pg8::DenseOrder S; S.init(F.ws + WS_MIXED, F.ws + WS_WOUT, MT, DM, DM, 0, F.G, F.bid);
        pg8::EpiResF32 E{F.in[0], F.out, DM};
        pg8::gemm_phase<pg8::EpiResF32, pg8::DenseOrder, false>(F.lds, DM, S, E);
    } SEAM(PH_OUT);
    if (IN(PH_P35)) REPS(PH_P35) { __syncthreads(); phase_p35(F); } SEAM(PH_P35);
    if (IN(PH_P4)) REPS(PH_P4) { __syncthreads(); phase_p4(F);
        if (F.G > NB * NE) { if (F.bid >= NB * NE) conv_range_moe_tail(F); }
        else moe_conv_range(F, MOE_ITEMS - MOE_P4_ITEMS + GW_ID(F), MOE_ITEMS, GW_N(F)); } SEAM(PH_P4);
    if (IN(PH_UP)) REPS(PH_UP) {
        __syncthreads();
        pg8::MoeOrder S; S.init(F.ws + WS_HB, F.ws + WS_WGU, DM, F.G, F.bid, true);
        LAS int* ridx = (LAS int*)(F.lds + 131072);
        { const int* IDX = (const int*)(F.ws + WS_IDX); pg8::Unit u;
          for (int i = 0; S.next(i, u); ++i) if (F.tid < 256) ridx[i * 256 + F.tid] = IDX[u.g * CAP + u.pm * 256 + F.tid]; }
        __syncthreads();
        pg8::EpiSwiGLU E{(pg8::bf16_t*)(F.ws + WS_ACT)};
        pg8::gemm_phase<pg8::EpiSwiGLU, pg8::MoeOrder, true, true>(F.lds, DM, S, E, ridx);
    } SEAM(PH_UP);
    if (IN(PH_DOWN)) REPS(PH_DOWN) {
        __syncthreads();
        pg8::MoeOrder S; S.init(F.ws + WS_ACT, F.ws + WS_WD, FF, F.G, F.bid, false);
        pg8::EpiBf16 E{(pg8::bf16_t*)(F.ws + WS_YE), DM, 512, (const float*)(F.ws + WS_GATE)};
        pg8::gemm_phase<pg8::EpiBf16, pg8::MoeOrder, true>(F.lds, FF, S, E);
    } SEAM(PH_DOWN);
    if (IN(PH_P7)) { phase_p7(F); }
#if MK_N_LAUNCHES == 1
    __syncthreads();
    { volatile LAS unsigned* misc = (volatile LAS unsigned*)(F.lds + LDS_MISC_OFF);
      if (F.tid == 0) misc[0] = (xb_add(&g_bar_words[XCD_BAR_WORDS], 1u) + 1u == (unsigned)F.G) ? 1u : 0u;
      __syncthreads();
      if (misc[0] != 0u && F.tid < (XCD_BAR_WORDS + 64) / 64) __hip_atomic_store(&g_bar_words[64 * F.tid], 0u, __ATOMIC_RELAXED, __HIP_MEMORY_SCOPE_AGENT); }
#endif
#undef IN
#undef SEAM
}

extern "C" void kernel_launch(void* const* d_in, const int* in_sizes, int n_in, void* d_out, int out_size, void* d_ws, size_t ws_size, hipStream_t stream) {
    static int grid = 0;
    if (grid == 0) {
        if (n_in != 23 || ws_size < WS_END) { fprintf(stderr, "kernel_launch: unexpected inputs (n_in %d, ws %zu)\n", n_in, ws_size); grid = -1; return; }
        if (hipFuncSetAttribute((const void*)mk_fwd, hipFuncAttributeMaxDynamicSharedMemorySize, LDS_BYTES) != hipSuccess) { fprintf(stderr, "kernel_launch: hipFuncSetAttribute failed\n"); grid = -1; return; }
        int dev = 0, cus = 0, per_cu = 0;
        hipGetDevice(&dev); hipDeviceGetAttribute(&cus, hipDeviceAttributeMultiprocessorCount, dev);
        hipOccupancyMaxActiveBlocksPerMultiprocessor(&per_cu, (const void*)mk_fwd, NTHREADS, LDS_BYTES);
        (void)hipGetLastError();
        if (per_cu < 1) { fprintf(stderr, "kernel_launch: occupancy query says %d blocks/CU\n", per_cu); }
        grid = cus;
    }
    if (grid < 0) return;
    Args a{};
    for (int i = 0; i < 23; ++i) a.in[i] = (const float*)d_in[i];
    a.out = (float*)d_out; a.ws = (unsigned char*)d_ws;
#if MK_N_LAUNCHES == 1
    a.ph_lo = 0; a.ph_hi = PH_COUNT;
    hipLaunchKernelGGL(mk_fwd, dim3(grid), dim3(NTHREADS), LDS_BYTES, stream, a);
#else
    for (int p = 0; p < PH_COUNT; ++p) { a.ph_lo = p; a.ph_hi = p + 1; hipLaunchKernelGGL(mk_fwd, dim3(grid), dim3(NTHREADS), LDS_BYTES, stream, a); }
#endif
}
```

```cpp
#include <hip/hip_runtime.h>
#include <hip/hip_cooperative_groups.h>
#include <cstdio>
#include <cstdint>
namespace cg = cooperative_groups;

#ifndef REP_PHASE
#define REP_PHASE -1
#define REP_N 1
#define REP_SUB 0
#endif
#ifndef MK_N_LAUNCHES
#define MK_N_LAUNCHES 1
#endif

namespace pg8 {
#define PG8_LAS __attribute__((address_space(3)))
typedef unsigned short bf16_t;
typedef short bf16x8 __attribute__((ext_vector_type(8)));
typedef float f32x4 __attribute__((ext_vector_type(4)));
typedef unsigned u32x4 __attribute__((ext_vector_type(4)));
typedef unsigned u32x2 __attribute__((ext_vector_type(2)));
constexpr int BM = 256, BK = 64, HALF = 128, HTB = HALF * BK * 2, STAGE_BYTES = 8 * HTB, NXCD = 8, WGM = 8;

__host__ __device__ __forceinline__ int lds_byte(int r, int c) { const int st = (r >> 4) * 2 + (c >> 5), rr = r & 15, cc = c & 31, ob = rr * 64 + cc * 2; return st * 1024 + (ob ^ (((ob >> 9) & 1) << 5)); }
__host__ __device__ __forceinline__ void stage_rc(int b, int& R, int& C) { const int st = b / 1024, sb = b % 1024, swz = sb ^ (((sb >> 9) & 1) << 5); R = (st >> 1) * 16 + swz / 64; C = (st & 1) * 32 + (swz % 64) / 2; }
__host__ __device__ __forceinline__ int perm32(int rho) { const int n = rho >> 4, i = rho & 15; return 8 * (i >> 2) + 4 * n + (i & 3); }

struct Unit { int pm, pn, g; const char* a; const char* b; };

__device__ __forceinline__ unsigned cvt_pk_bf16(float lo, float hi) { unsigned r; asm volatile("v_cvt_pk_bf16_f32 %0, %1, %2" : "=v"(r) : "v"(lo), "v"(hi)); return r; }

struct DenseOrder {
    static constexpr bool CHUNK_B = false;
    int nM, nN, nwg, G, c, K, pn0; const char* A; const char* Bt;
    __device__ void init(const void* A_, const void* Bt_, int M, int N, int K_, int pn0_, int G_, int c_) { A = (const char*)A_; Bt = (const char*)Bt_; nM = M / BM; nN = N / BM; nwg = nM * nN; G = G_; c = c_; K = K_; pn0 = pn0_; }
    __device__ bool next(int i, Unit& u) const {
        const long L = (long)i * G + c; if (L >= nwg) return false;
        int wgid = (int)L; { const int q = nwg / NXCD, r = nwg % NXCD, xcd = wgid % NXCD, off = wgid / NXCD; wgid = (xcd < r ? xcd * (q + 1) : r * (q + 1) + (xcd - r) * q) + off; }
        const int nig = WGM * nN, gid = wgid / nig, fm = gid * WGM, gsz = (nM - fm) < WGM ? (nM - fm) : WGM;
        u.pm = fm + ((wgid % nig) % gsz); u.pn = pn0 + (wgid % nig) / gsz; u.g = 0;
        u.a = A + (size_t)u.pm * BM * K * 2; u.b = Bt + (size_t)u.pn * BM * K * 2; return true;
    }
};
struct MoeOrder {
    static constexpr bool CHUNK_B = true;
    int G, c, K; bool gather; const char* A; const char* Bt;
    __device__ void init(const void* A_, const void* Bt_, int K_, int G_, int c_, bool gather_) { A = (const char*)A_; Bt = (const char*)Bt_; K = K_; G = G_; c = c_; gather = gather_; }
    __device__ bool next(int i, Unit& u) const {
        const int L = i * G + c; if (L >= 512) return false;
        int pn, pm, b, e;
        if ((G & 7) == 0 && G >= 64) { const int per = G >> 3, x = c & 7, u = (c >> 3) + i * per;
            pn = u & 7; pm = (u >> 3) & 1; b = (u >> 4) & 1; e = x + 8 * (u >> 5); if (e >= 16) return false; }
        else { pn = L & 7; pm = (L >> 3) & 1; b = (L >> 4) & 1; e = L >> 5; }
        u.pm = pm; u.pn = pn; u.g = b * 16 + e;
        u.a = gather ? A : A + (size_t)(u.g * 512 + pm * BM) * K * 2; u.b = Bt + (size_t)e * 2048 * K * 2 + (size_t)pn * BM * 16; return true;
    }
};

struct EpiBf16 {
    static constexpr bool PERM = true, SWAP = false, INIT = false;
    bf16_t* O; int ldc; int grows; const float* rscale;
    __device__ __forceinline__ void operator()(const f32x4 (&acc)[2][2][4][2], const Unit& u, int wr, int wc, int fr, int fq) const {
        const int row0 = u.g * grows + u.pm * BM + wr * 64 + fr, col0 = u.pn * BM + wc * 32 + 8 * fq;
        float scv[2][4];
#pragma unroll
        for (int ai = 0; ai < 2; ++ai)
#pragma unroll
            for (int m = 0; m < 4; ++m) scv[ai][m] = rscale ? rscale[row0 + ai * HALF + m * 16] : 1.f;
#pragma unroll
        for (int ai = 0; ai < 2; ++ai)
#pragma unroll
            for (int m = 0; m < 4; ++m) { const int row = row0 + ai * HALF + m * 16; bf16_t* rowp = O + (size_t)row * ldc + col0; const float sc = scv[ai][m];
#pragma unroll
                for (int bj = 0; bj < 2; ++bj) { const f32x4 v0 = acc[ai][bj][m][0] * sc, v1 = acc[ai][bj][m][1] * sc;
                    u32x4 w; w.x = cvt_pk_bf16(v0[0], v0[1]); w.y = cvt_pk_bf16(v0[2], v0[3]); w.z = cvt_pk_bf16(v1[0], v1[1]); w.w = cvt_pk_bf16(v1[2], v1[3]);
                    *(u32x4*)(rowp + bj * HALF) = w; } }
    }
};
struct EpiSwiGLU {
    static constexpr bool PERM = true, SWAP = false, INIT = false;
    bf16_t* O;
    __device__ __forceinline__ void operator()(const f32x4 (&acc)[2][2][4][2], const Unit& u, int wr, int wc, int fr, int fq) const {
        const int row0 = u.g * 512 + u.pm * BM + wr * 64 + fr, col0 = u.pn * HALF + wc * 32 + 8 * fq;
#pragma unroll
        for (int ai = 0; ai < 2; ++ai)
#pragma unroll
            for (int m = 0; m < 4; ++m) { bf16_t* rowp = O + (size_t)(row0 + ai * HALF + m * 16) * 1024 + col0;
                float r[8];
#pragma unroll
                for (int n = 0; n < 2; ++n)
#pragma unroll
                    for (int e = 0; e < 4; ++e) { const float g = acc[ai][0][m][n][e], up = acc[ai][1][m][n][e]; r[n * 4 + e] = g * __builtin_amdgcn_rcpf(1.f + __builtin_amdgcn_exp2f(-1.4426950408889634f * g)) * up; }
                u32x4 w; w.x = cvt_pk_bf16(r[0], r[1]); w.y = cvt_pk_bf16(r[2], r[3]); w.z = cvt_pk_bf16(r[4], r[5]); w.w = cvt_pk_bf16(r[6], r[7]);
                *(u32x4*)rowp = w; }
    }
};
struct EpiResF32 {
    static constexpr bool PERM = false, SWAP = false, INIT = true;
    const float* res; float* out; int ldc;
    __device__ __forceinline__ void init(f32x4 (&acc)[2][2][4][2], const Unit& u, int wr, int wc, int fr, int fq) const {
        const int row0 = u.pm * BM + wr * 64 + fr, col0 = u.pn * BM + wc * 32 + 4 * fq;
#pragma unroll
        for (int ai = 0; ai < 2; ++ai)
#pragma unroll
            for (int m = 0; m < 4; ++m) { const size_t off = (size_t)(row0 + ai * HALF + m * 16) * ldc + col0;
#pragma unroll
                for (int bj = 0; bj < 2; ++bj)
#pragma unroll
                    for (int n = 0; n < 2; ++n) acc[ai][bj][m][n] = *(const f32x4*)(res + off + bj * HALF + n * 16); }
    }
    __device__ __forceinline__ void operator()(const f32x4 (&acc)[2][2][4][2], const Unit& u, int wr, int wc, int fr, int fq) const {
        const int row0 = u.pm * BM + wr * 64 + fr, col0 = u.pn * BM + wc * 32 + 4 * fq;
#pragma unroll
        for (int ai = 0; ai < 2; ++ai)
#pragma unroll
            for (int m = 0; m < 4; ++m) { const size_t off = (size_t)(row0 + ai * HALF + m * 16) * ldc + col0;
#pragma unroll
                for (int bj = 0; bj < 2; ++bj)
#pragma unroll
                    for (int n = 0; n < 2; ++n) *(f32x4*)(out + off + bj * HALF + n * 16) = acc[ai][bj][m][n]; }
    }
};
struct EpiTransBf16 {
    static constexpr bool PERM = false, SWAP = true, INIT = false;
    bf16_t* O; int ldt; int pn_base;
    __device__ __forceinline__ void operator()(const f32x4 (&acc)[2][2][4][2], const Unit& u, int wr, int wc, int fr, int fq) const {
        const int ch0 = (u.pn - pn_base) * BM + wc * 32 + fr, t0 = u.pm * BM + wr * 64 + 4 * fq;
#pragma unroll
        for (int bj = 0; bj < 2; ++bj)
#pragma unroll
            for (int n = 0; n < 2; ++n) { bf16_t* chp = O + (size_t)(ch0 + bj * HALF + n * 16) * ldt + t0;
#pragma unroll
                for (int ai = 0; ai < 2; ++ai)
#pragma unroll
                    for (int m = 0; m < 4; ++m) { const f32x4 v = acc[ai][bj][m][n]; u32x2 w; w.x = cvt_pk_bf16(v[0], v[1]); w.y = cvt_pk_bf16(v[2], v[3]); *(u32x2*)(chp + ai * HALF + m * 16) = w; } }
    }
};

template <class Epi, class Sched, bool ALIGN_EPI = false, bool GATHER = false>
__device__ __forceinline__ void gemm_phase(PG8_LAS unsigned char* lds, const int K, const Sched& S, const Epi& E, const PG8_LAS int* ridx = nullptr) {
    const int tid = threadIdx.x, wid = __builtin_amdgcn_readfirstlane(tid >> 6), lane = tid & 63, wr = wid >> 2, wc = wid & 3, fr = lane & 15, fq = lane >> 4;
    const int nt = K / BK;
    unsigned vA0[2], vA1[2], vN0[2], vN1[2], voffB[2]; int stR[2], stC[2];
    const size_t kstep = (size_t)(BK * 2);
    const size_t hstep = (size_t)HALF * K * 2;
    const size_t kstepB = Sched::CHUNK_B ? (size_t)(BK / 8) * 2048 * 16 : kstep, hstepB = Sched::CHUNK_B ? (size_t)HALF * 16 : hstep;
#pragma unroll
    for (int i = 0; i < 2; ++i) { int R, C; stage_rc(tid * 16 + i * 8192, R, C); stR[i] = R; stC[i] = C;
        int RB = R, CB = C;
        if constexpr (Sched::CHUNK_B) { const int b = tid * 16 + i * 8192, st = b >> 10, l = (b & 1023) >> 4; RB = (st >> 1) * 16 + (l & 15); CB = (st & 1) * 32 + (l >> 4) * 8; }
        const int Rb = Epi::PERM ? ((RB & ~31) + perm32(RB & 31)) : RB;
        voffB[i] = Sched::CHUNK_B ? (unsigned)(((CB >> 3) * 2048 + Rb) * 16) : (unsigned)(Rb * K + CB) * 2u;
        if constexpr (GATHER) { vA0[i] = (unsigned)(ridx[R] * K + C) * 2u; vA1[i] = (unsigned)(ridx[HALF + R] * K + C) * 2u; }
        else { vA0[i] = (unsigned)(R * K + C) * 2u; vA1[i] = vA0[i] + (unsigned)hstep; }
        vN0[i] = vA0[i]; vN1[i] = vA1[i]; }
    const unsigned ldsw = (unsigned)wid * 1024u;
    const int aoff = lds_byte(wr * 64 + fr, fq * 8), boff = Sched::CHUNK_B ? (wc * 4096 + fq * 256 + fr * 16) : lds_byte(wc * 32 + fr, fq * 8);
#define PG8_SA(b, h) (((b) * 2 + (h)) * HTB)
#define PG8_SB(b, h) ((4 + (b) * 2 + (h)) * HTB)
#define PG8_STAGE(bufoff, gbase, voff) do { _Pragma("unroll") for (int _i = 0; _i < 2; ++_i) \
        __builtin_amdgcn_global_load_lds((const unsigned*)((const char*)(gbase) + (voff)[_i]), (PG8_LAS unsigned*)(lds + (bufoff) + ldsw + _i * 8192), 16, 0, 0); } while (0)
#define PG8_LDA(dst, b, h) do { _Pragma("unroll") for (int m = 0; m < 4; ++m) _Pragma("unroll") for (int k = 0; k < 2; ++k) dst[m][k] = *(const PG8_LAS bf16x8*)(lds + PG8_SA(b, h) + aoff + m * 2048 + k * 1024); } while (0)
#define PG8_LDB(dst, b, h) do { _Pragma("unroll") for (int n = 0; n < 2; ++n) _Pragma("unroll") for (int k = 0; k < 2; ++k) dst[n][k] = *(const PG8_LAS bf16x8*)(lds + PG8_SB(b, h) + boff + n * 2048 + k * 1024); } while (0)
#define PG8_MMA(ai, bj, At, Bt) do { __builtin_amdgcn_s_setprio(1); _Pragma("unroll") for (int m = 0; m < 4; ++m) _Pragma("unroll") for (int n = 0; n < 2; ++n) _Pragma("unroll") for (int k = 0; k < 2; ++k) \
        acc[ai][bj][m][n] = Epi::SWAP ? __builtin_amdgcn_mfma_f32_16x16x32_bf16(At[m][k], Bt[n][k], acc[ai][bj][m][n], 0, 0, 0) : __builtin_amdgcn_mfma_f32_16x16x32_bf16(Bt[n][k], At[m][k], acc[ai][bj][m][n], 0, 0, 0); __builtin_amdgcn_s_setprio(0); } while (0)
#define PG8_WAIT_V(n) asm volatile("s_waitcnt vmcnt(" #n ")" ::: "memory")
#define PG8_WAIT_L(n) asm volatile("s_waitcnt lgkmcnt(" #n ")" ::: "memory")
#define PG8_BAR __builtin_amdgcn_s_barrier()
#define PG8_SCHED __builtin_amdgcn_sched_barrier(0)
    Unit cur, nxt; int ui = 0;
    if (!S.next(0, cur)) return;
    f32x4 acc[2][2][4][2];
    if constexpr (Epi::INIT) E.init(acc, cur, wr, wc, fr, fq);
    else {
#pragma unroll
    for (int a = 0; a < 2; ++a)
#pragma unroll
        for (int b = 0; b < 2; ++b)
#pragma unroll
            for (int m = 0; m < 4; ++m)
#pragma unroll
                for (int n = 0; n < 2; ++n) acc[a][b][m][n] = (f32x4){0.f, 0.f, 0.f, 0.f};
    }
    bf16x8 At[4][2], B0[2][2], B1[2][2];
    const char* cA = cur.a; const char* cB = cur.b;
    PG8_STAGE(PG8_SB(0, 0), cB, voffB); PG8_STAGE(PG8_SB(0, 1), cB + hstepB, voffB); PG8_STAGE(PG8_SA(0, 0), cA, vA0); PG8_STAGE(PG8_SA(0, 1), cA, vA1);
    if (wr == 1) PG8_BAR;
    PG8_WAIT_V(2); PG8_BAR;
    PG8_STAGE(PG8_SB(1, 0), cB + kstepB, voffB); PG8_STAGE(PG8_SA(1, 0), cA + kstep, vA0); PG8_STAGE(PG8_SB(1, 1), cB + hstepB + kstepB, voffB);
    PG8_WAIT_V(6); PG8_BAR;
    for (;;) {
        const bool has_next = S.next(ui + 1, nxt);
        const char* nA = has_next ? nxt.a : cA; const char* nB = has_next ? nxt.b : cB;
        if constexpr (GATHER) { if (has_next) {
#pragma unroll
            for (int i = 0; i < 2; ++i) { vN0[i] = (unsigned)(ridx[(ui + 1) * 256 + stR[i]] * K + stC[i]) * 2u; vN1[i] = (unsigned)(ridx[(ui + 1) * 256 + HALF + stR[i]] * K + stC[i]) * 2u; } } }
        for (int t = 0; t < nt; t += 2) {
            const bool last = (t == nt - 2);
            const char* a1 = cA + (size_t)(t + 1) * kstep;
            const char* a2 = last ? nA : cA + (size_t)(t + 2) * kstep; const char* b2 = last ? nB : cB + (size_t)(t + 2) * kstepB;
            const char* a3 = a2 + kstep; const char* b3 = b2 + kstepB;
            unsigned w0[2], w1[2];
#pragma unroll
            for (int i = 0; i < 2; ++i) { w0[i] = last ? vN0[i] : vA0[i]; w1[i] = last ? vN1[i] : vA1[i]; }
            PG8_LDB(B0, 0, 0); PG8_LDB(B1, 0, 1); PG8_SCHED; PG8_LDA(At, 0, 0); PG8_STAGE(PG8_SA(1, 1), a1, vA1);
            PG8_WAIT_V(8); PG8_WAIT_L(0); PG8_BAR; PG8_MMA(0, 0, At, B0); PG8_MMA(0, 1, At, B1); PG8_BAR; PG8_SCHED;
            PG8_LDA(At, 0, 1); PG8_STAGE(PG8_SB(0, 0), b2, voffB); PG8_STAGE(PG8_SB(0, 1), b2 + hstepB, voffB); PG8_STAGE(PG8_SA(0, 0), a2, w0);
            PG8_WAIT_V(8); PG8_WAIT_L(0); PG8_BAR; PG8_MMA(1, 0, At, B0); PG8_MMA(1, 1, At, B1); PG8_BAR; PG8_SCHED;
            PG8_LDB(B0, 1, 0); PG8_LDB(B1, 1, 1); PG8_SCHED; PG8_LDA(At, 1, 0); PG8_STAGE(PG8_SA(0, 1), a2, w1);
            PG8_WAIT_V(8); PG8_WAIT_L(0); PG8_BAR; PG8_MMA(0, 0, At, B0); PG8_MMA(0, 1, At, B1); PG8_BAR; PG8_SCHED;
            PG8_LDA(At, 1, 1); PG8_STAGE(PG8_SB(1, 0), b3, voffB); PG8_STAGE(PG8_SB(1, 1), b3 + hstepB, voffB); PG8_STAGE(PG8_SA(1, 0), a3, w0);
            PG8_WAIT_V(8); PG8_WAIT_L(0); PG8_BAR; PG8_MMA(1, 0, At, B0); PG8_MMA(1, 1, At, B1); PG8_BAR; PG8_SCHED;
        }
        if constexpr (ALIGN_EPI) { if (wr == 0) PG8_BAR; }
        E(acc, cur, wr, wc, fr, fq);
        if (!has_next) break;
        if constexpr (Epi::INIT) E.init(acc, nxt, wr, wc, fr, fq);
        else {
#pragma unroll
        for (int a = 0; a < 2; ++a)
#pragma unroll
            for (int b = 0; b < 2; ++b)
#pragma unroll
                for (int m = 0; m < 4; ++m)
#pragma unroll
                    for (int n = 0; n < 2; ++n) acc[a][b][m][n] = (f32x4){0.f, 0.f, 0.f, 0.f};
        }
        cur = nxt; cA = nA; cB = nB; ++ui;
#pragma unroll
        for (int i = 0; i < 2; ++i) { vA0[i] = vN0[i]; vA1[i] = vN1[i]; }
        if constexpr (ALIGN_EPI) { if (wr == 1) PG8_BAR; }
    }
    PG8_WAIT_V(0);
    if constexpr (!ALIGN_EPI) { if (wr == 0) PG8_BAR; }
    PG8_BAR;
#undef PG8_SA
#undef PG8_SB
#undef PG8_STAGE
#undef PG8_LDA
#undef PG8_LDB
#undef PG8_MMA
#undef PG8_WAIT_V
#undef PG8_WAIT_L
#undef PG8_BAR
#undef PG8_SCHED
}
}

constexpr int NB = 2, SEQ = 4096, DM = 2048, MT = NB * SEQ;
constexpr int NH = 8, HD = 128, AW = 1024, HW = 1024, INW = 6144;
constexpr int GW = 64, NROWS = 64, WR = 8, WC = 16;
constexpr int NE = 16, CAP = 512, FF = 1024;
constexpr int FEMB = 33, FHID = 64;
constexpr float EPS = 1e-6f;
constexpr int NWAVES = 8, NTHREADS = 512;

constexpr size_t MiB = 1u << 20;
constexpr size_t WS_CTL = 0, CTL_ZERO_BYTES = 32768;
constexpr size_t WS_WIN = 2 * MiB;
constexpr size_t WS_WOUT = 26 * MiB;
constexpr size_t WS_WGU = 34 * MiB;
constexpr size_t WS_WD = 162 * MiB;
constexpr size_t WS_W3T = 226 * MiB;
constexpr size_t WS_HID2 = 227 * MiB;
constexpr size_t WS_HB = 228 * MiB;
constexpr size_t WS_QK = 260 * MiB;
constexpr size_t WS_XT = 292 * MiB;
constexpr size_t WS_UC = 356 * MiB;
constexpr size_t WS_TAPS = 404 * MiB;
constexpr size_t WS_HYT = 436 * MiB;
constexpr size_t WS_MIXED = 452 * MiB;
constexpr size_t WS_AFF = 484 * MiB;
constexpr size_t WS_IDX = 485 * MiB;
constexpr size_t WS_GATE = 486 * MiB;
constexpr size_t WS_SEL = 487 * MiB;
constexpr size_t WS_Z1T = 488 * MiB;
constexpr size_t WS_XG = WS_XT;
constexpr size_t WS_ACT = WS_UC;
constexpr size_t WS_YE = WS_TAPS;
constexpr size_t WS_END = 504 * MiB;

constexpr int LDS_BYTES = 163840, LDS_MISC_OFF = 163840 - 128;

#define GAS __attribute__((address_space(1)))
#define LAS __attribute__((address_space(3)))
typedef unsigned short bf16;
typedef unsigned v4u __attribute__((ext_vector_type(4)));
typedef unsigned v2u __attribute__((ext_vector_type(2)));
typedef float f32x4 __attribute__((ext_vector_type(4)));
#define LDS_WAIT() asm volatile("s_waitcnt lgkmcnt(0)" ::: "memory")
#define VM_WAIT() asm volatile("s_waitcnt vmcnt(0)" ::: "memory")
__device__ __forceinline__ unsigned f2bf(float f) { unsigned u = __builtin_bit_cast(unsigned, f); return (u + 0x7fffu + ((u >> 16) & 1u)) >> 16; }
__device__ __forceinline__ unsigned pk2(float lo, float hi) { unsigned r; asm("v_cvt_pk_bf16_f32 %0, %1, %2" : "=v"(r) : "v"(lo), "v"(hi)); return r; }
__device__ __forceinline__ float bf2f(unsigned h) { return __builtin_bit_cast(float, h << 16); }
__device__ __forceinline__ float bflo(unsigned w) { return __builtin_bit_cast(float, w << 16); }
__device__ __forceinline__ float bfhi(unsigned w) { return __builtin_bit_cast(float, w & 0xffff0000u); }
template <int CTRL> __device__ __forceinline__ float dpp_f(float v) { return __builtin_bit_cast(float, __builtin_amdgcn_update_dpp(0, __builtin_bit_cast(int, v), CTRL, 0xf, 0xf, true)); }
#define DPP_XOR1 0xB1
#define DPP_XOR2 0x4E
#define DPP_HMIRROR 0x141
#define DPP_ROR(n) (0x120 + (n))
__device__ __forceinline__ float row16_sum(float v) { v += dpp_f<DPP_ROR(8)>(v); v += dpp_f<DPP_ROR(4)>(v); v += dpp_f<DPP_ROR(2)>(v); v += dpp_f<DPP_ROR(1)>(v); return v; }
__device__ __forceinline__ float row16_max(float v) { v = fmaxf(v, dpp_f<DPP_ROR(8)>(v)); v = fmaxf(v, dpp_f<DPP_ROR(4)>(v)); v = fmaxf(v, dpp_f<DPP_ROR(2)>(v)); v = fmaxf(v, dpp_f<DPP_ROR(1)>(v)); return v; }
__device__ __forceinline__ float wave_sum(float v) { v = row16_sum(v); v += __shfl_xor(v, 16); v += __shfl_xor(v, 32); return v; }


#define XB_TMO      128
#define XB_XCNT(j)  (256  + 64 * (j))
#define XB_XSUB(j)  (1280 + 64 * (j))
#define XB_XGEN(j)  (2304 + 64 * (j))
#define XB_TOP      3328
#define XB_TOPGEN   3392
#define XCD_BAR_WORDS 3456
#define XB_SPIN_CAP (1u << 22)
__device__ __forceinline__ unsigned xb_ld(unsigned* p)              { return __hip_atomic_load(p, __ATOMIC_RELAXED, __HIP_MEMORY_SCOPE_AGENT); }
__device__ __forceinline__ unsigned xb_add(unsigned* p, unsigned v) { return __hip_atomic_fetch_add(p, v, __ATOMIC_RELAXED, __HIP_MEMORY_SCOPE_AGENT); }
__device__ __forceinline__ unsigned xb_xcc_id() { return (unsigned)__builtin_amdgcn_s_getreg((3 << 11) | 20) & 0xFu; }
#define XB_SPIN(cond, bar) do { unsigned _sp = 0; while (cond) { __builtin_amdgcn_s_sleep(1); \
    if ((++_sp & 255u) == 0u) { if (xb_ld(&(bar)[XB_TMO])) break; if (_sp > XB_SPIN_CAP) { atomicAdd(&(bar)[XB_TMO], 1u); break; } } } } while (0)
struct XcdBarrier { unsigned* bar; unsigned x; volatile LAS unsigned* st; };
__device__ __forceinline__ XcdBarrier xcd_barrier_post(unsigned* bar, volatile LAS unsigned* st) {
    XcdBarrier b; b.bar = bar; b.x = xb_xcc_id(); b.st = st;
    if (threadIdx.x == 0) (void)xb_add(&bar[XB_XCNT(b.x)], 1u);
    return b;
}
__device__ __forceinline__ void xcd_barrier_complete(unsigned* bar, unsigned x, unsigned& nloc, unsigned& nx) {
    const unsigned G = gridDim.x * gridDim.y * gridDim.z;
    unsigned sum, cnt, mine, sp = 0u;
    for (;;) {
        sum = 0u; cnt = 0u; mine = 0u;
#pragma unroll
        for (unsigned j = 0; j < 16; ++j) { const unsigned c = xb_ld(&bar[XB_XCNT(j)]); sum += c; cnt += (c > 0u) ? 1u : 0u; mine = (j == x) ? c : mine; }
        if (sum == G) break;
        __builtin_amdgcn_s_sleep(1);
        if ((++sp & 255u) == 0u) { if (xb_ld(&bar[XB_TMO])) break; if (sp > XB_SPIN_CAP) { atomicAdd(&bar[XB_TMO], 1u); break; } }
    }
    nloc = mine > 0u ? mine : 1u; nx = cnt > 0u ? cnt : 1u;
}
__device__ __forceinline__ void xcd_barrier(const XcdBarrier& b) {
    asm volatile("s_waitcnt vmcnt(0)" ::: "memory");
    __syncthreads();
    if (threadIdx.x == 0) {
        unsigned* bar = b.bar;
        __builtin_amdgcn_s_waitcnt(0);
        unsigned nloc = b.st[0], nx = b.st[1];
        if (nloc == 0u) { xcd_barrier_complete(bar, b.x, nloc, nx); b.st[0] = nloc; b.st[1] = nx; }
        const unsigned old = xb_add(&bar[XB_XSUB(b.x)], 1u);
        const unsigned gen = old / nloc;
        if (old + 1u == (gen + 1u) * nloc) {
            __builtin_amdgcn_fence(__ATOMIC_RELEASE, "agent");
            asm volatile("s_waitcnt vmcnt(0)" ::: "memory");
            const unsigned og = xb_add(&bar[XB_TOP], 1u);
            const unsigned tg = og / nx;
            if (og + 1u == (tg + 1u) * nx) xb_add(&bar[XB_TOPGEN], 1u);
            else XB_SPIN(xb_ld(&bar[XB_TOPGEN]) == tg, bar);
            __builtin_amdgcn_fence(__ATOMIC_ACQUIRE, "agent");
            xb_add(&bar[XB_XGEN(b.x)], 1u);
            asm volatile("s_waitcnt vmcnt(0)" ::: "memory");
        } else {
            XB_SPIN(xb_ld(&bar[XB_XGEN(b.x)]) == gen, bar);
            __builtin_amdgcn_fence(__ATOMIC_ACQUIRE, "agent");
            asm volatile("s_waitcnt vmcnt(0)" ::: "memory");
        }
    }
    __syncthreads();
}

__device__ unsigned g_bar_words[XCD_BAR_WORDS + 64];
struct Frame {
    LAS unsigned char* lds;
    int tid, lane, wave, G, bid;
    const float* in[23]; float* out; unsigned char* ws;
};
#define GW_ID(F) ((F).bid * NWAVES + (F).wave)
#define GW_N(F) ((F).G * NWAVES)

__device__ __forceinline__ void p0_transpose_item(const float* W, int K, int N, bf16* WT, int row_base, int k0, int n0, LAS float* scr, int lane) {
    float t_[32];
#pragma unroll
    for (int i = 0; i < 32; ++i) { const int kk = 2 * i + (lane >> 5); t_[i] = W[(size_t)(k0 + kk) * N + n0 + (lane & 31)]; }
#pragma unroll
    for (int i = 0; i < 32; ++i) { const int kk = 2 * i + (lane >> 5); scr[kk * 33 + (lane & 31)] = t_[i]; }
    LDS_WAIT(); asm volatile("" ::: "memory");
    const int c = lane & 7;
#pragma unroll
    for (int j = 0; j < 4; ++j) { const int n = (lane >> 3) + 8 * j; const LAS float* s = scr + (8 * c) * 33 + n;
        v4u o; o.x = pk2(s[0 * 33], s[1 * 33]); o.y = pk2(s[2 * 33], s[3 * 33]); o.z = pk2(s[4 * 33], s[5 * 33]); o.w = pk2(s[6 * 33], s[7 * 33]);
        *(GAS v4u*)(WT + (size_t)(row_base + n) * K + k0 + 8 * c) = o; }
    LDS_WAIT(); asm volatile("" ::: "memory");
}
__device__ __forceinline__ void phase_p0(Frame& F) {
    LAS float* scr = (LAS float*)(F.lds + F.wave * 16384);
    const int gw = GW_ID(F), NGW = GW_N(F);
    bf16* WinT = (bf16*)(F.ws + WS_WIN); bf16* WoutT = (bf16*)(F.ws + WS_WOUT); bf16* W3T = (bf16*)(F.ws + WS_W3T);
    constexpr int I_IN = (DM / 64) * (INW / 32), I_OUT = (DM / 64) * (DM / 32), I_3 = 1 * (4096 / 32);
    constexpr int NITEMS = I_IN + I_OUT + I_3;
    for (int it = gw; it < NITEMS; it += NGW) {
        int r = it;
        if (r < I_IN) { const int nblk = INW / 32, kb = r / nblk, nb = r % nblk; p0_transpose_item(F.in[2], DM, INW, WinT, 32 * nb, 64 * kb, 32 * nb, scr, F.lane); continue; } r -= I_IN;
        if (r < I_OUT) { const int nblk = DM / 32, kb = r / nblk, nb = r % nblk; p0_transpose_item(F.in[17], DM, DM, WoutT, 32 * nb, 64 * kb, 32 * nb, scr, F.lane); continue; } r -= I_OUT;
        { const int nb = r; p0_transpose_item(F.in[12], FHID, 4096, W3T, 32 * nb, 0, 32 * nb, scr, F.lane); }
    }
    bf16* HB = (bf16*)(F.ws + WS_HB);
    const float* x = F.in[0]; const float* g = F.in[1];
    f32x4 gv[8];
#pragma unroll
    for (int j = 0; j < 8; ++j) gv[j] = *((const GAS f32x4*)g + F.lane + 64 * j);
    f32x4 vn[8];
    if (gw < MT) { const GAS f32x4* xr = (const GAS f32x4*)(x + (size_t)gw * DM) + F.lane;
#pragma unroll
        for (int j = 0; j < 8; ++j) vn[j] = xr[64 * j]; }
    for (int m = gw; m < MT; m += NGW) {
        f32x4 v[8]; float s = 0.f;
#pragma unroll
        for (int j = 0; j < 8; ++j) { v[j] = vn[j]; s += (v[j].x * v[j].x + v[j].y * v[j].y) + (v[j].z * v[j].z + v[j].w * v[j].w); }
        if (m + NGW < MT) { const GAS f32x4* xr = (const GAS f32x4*)(x + (size_t)(m + NGW) * DM) + F.lane;
#pragma unroll
            for (int j = 0; j < 8; ++j) vn[j] = xr[64 * j]; }
        const float r = rsqrtf(wave_sum(s) * (1.f / DM) + EPS);
        GAS v2u* o8 = (GAS v2u*)(HB + (size_t)m * DM) + F.lane;
#pragma unroll
        for (int j = 0; j < 8; ++j) { const f32x4 gg = gv[j]; v2u o; o.x = pk2(v[j].x * r * gg.x, v[j].y * r * gg.y); o.y = pk2(v[j].z * r * gg.z, v[j].w * r * gg.w); o8[64 * j] = o; }
    }
    float* HID2 = (float*)(F.ws + WS_HID2);
    LAS float* sc2 = (LAS float*)(F.lds + F.wave * 16384);
    const float* w1 = F.in[8]; const float* b1 = F.in[9]; const float* w2 = F.in[10]; const float* b2 = F.in[11]; const float* fr = F.in[13];
    float w1c[FEMB], w2c[FHID];
    { const int j = F.lane;
#pragma unroll
      for (int i = 0; i < FEMB; ++i) w1c[i] = w1[i * FHID + j];
#pragma unroll
      for (int i = 0; i < FHID; ++i) w2c[i] = w2[i * FHID + j]; }
    for (int l = gw; l < SEQ; l += NGW) {
        const int j = F.lane;
        float zv = 0.f;
        if (j == 0) zv = (float)l / (float)(SEQ - 1);
        else if (j < FEMB) { const int k = (j - 1) & 15; const float f = 1e-4f + (float)k * ((15.0f - 1e-4f) / 15.0f); const float wv = 6.283185307179586f * (float)l / (float)SEQ; zv = (j <= 16) ? cosf(f * wv) : -sinf(f * wv); }
        sc2[j] = zv; LDS_WAIT(); asm volatile("" ::: "memory");
        float a = b1[j];
#pragma unroll
        for (int i = 0; i < FEMB; ++i) a += sc2[i] * w1c[i];
        const float h1 = sinf(fr[j] * a);
        sc2[64 + j] = h1; LDS_WAIT(); asm volatile("" ::: "memory");
        float c = b2[j];
#pragma unroll
        for (int i = 0; i < FHID; ++i) c += sc2[64 + i] * w2c[i];
        HID2[l * FHID + j] = sinf(fr[j] * c);
        LDS_WAIT(); asm volatile("" ::: "memory");
    }
}

typedef short bf16x8 __attribute__((ext_vector_type(8)));
typedef float f32x16 __attribute__((ext_vector_type(16)));
__device__ __forceinline__ void phase_filters(Frame& F) {
    const float* HID2 = (const float*)(F.ws + WS_HID2); const bf16* W3T = (const bf16*)(F.ws + WS_W3T); const float* fbias = F.in[14]; bf16* TAPS = (bf16*)(F.ws + WS_TAPS);
    const int n = F.lane & 31, hh = F.lane >> 5;
    const float mind = -4.605170185988091f / 1.5f, maxd = -4.605170185988091f / 0.3f;
    LAS bf16* scr = (LAS bf16*)(F.lds + F.wave * 4096);
    for (int task = GW_ID(F); task < 128 * 16; task += GW_N(F)) {
        const int l0 = (task & 127) * 32, cg = task >> 7;
        const int dir = (cg >> 2) & 1, o = cg >> 3;
        const int l = l0 + dir + n;
        bf16x8 hb[4];
        { const int lr = l < SEQ ? l : SEQ - 1;
#pragma unroll
          for (int ks = 0; ks < 4; ++ks) { const GAS f32x4* hp = (const GAS f32x4*)(HID2 + (size_t)lr * FHID + 16 * ks + 8 * hh); const f32x4 h0 = hp[0], h1 = hp[1];
              v4u bw; bw.x = pk2(h0.x, h0.y); bw.y = pk2(h0.z, h0.w); bw.z = pk2(h1.x, h1.y); bw.w = pk2(h1.z, h1.w); hb[ks] = __builtin_bit_cast(bf16x8, bw); } }
        const float t = (float)l / (float)(SEQ - 1);
        const int pos = dir ? 31 - n : n;
        const int idx0 = dir ? 4064 - l0 : 4096 + l0;
        bf16x8 an[4];
#pragma unroll
        for (int ks = 0; ks < 4; ++ks) an[ks] = *(const GAS bf16x8*)(W3T + (size_t)(cg * 8 * 32 + n) * FHID + 16 * ks + 8 * hh);
#pragma unroll 2
        for (int ct = 0; ct < 8; ++ct) {
            const int col0 = (cg * 8 + ct) * 32;
            f32x16 acc;
#pragma unroll
            for (int i = 0; i < 16; ++i) acc[i] = 0.f;
            bf16x8 ac[4];
#pragma unroll
            for (int ks = 0; ks < 4; ++ks) ac[ks] = an[ks];
            { const int coln = (cg * 8 + (ct < 7 ? ct + 1 : ct)) * 32;
#pragma unroll
              for (int ks = 0; ks < 4; ++ks) an[ks] = *(const GAS bf16x8*)(W3T + (size_t)(coln + n) * FHID + 16 * ks + 8 * hh); }
#pragma unroll
            for (int ks = 0; ks < 4; ++ks) acc = __builtin_amdgcn_mfma_f32_32x32x16_bf16(ac[ks], hb[ks], acc, 0, 0, 0);
#pragma unroll
            for (int i = 0; i < 16; ++i) {
                const int chl = (i & 3) + 8 * (i >> 2) + 4 * hh, c = (col0 & 1023) + chl;
                const float delta = fabsf(mind + (maxd - mind) * ((float)c / 1023.0f));
                float v = acc[i] * __expf(-t * delta);
                if (l >= SEQ) v = 0.f;
                scr[chl * 40 + pos] = (bf16)f2bf(v);
            }
            LDS_WAIT(); asm volatile("" ::: "memory");
#pragma unroll
            for (int j = 0; j < 2; ++j) { const int id = F.lane + 64 * j, chl = id >> 2, q = id & 3;
                const v4u w = *(const LAS v4u*)(scr + chl * 40 + 8 * q);
                *(GAS v4u*)(TAPS + ((size_t)((col0 & 1023) + chl) * 2 + o) * 8192 + idx0 + 8 * q) = w; }
            LDS_WAIT(); asm volatile("" ::: "memory");
        }
    }
}

constexpr int HY_TAPS_BYTES = 4 * 16384, HY_ZB_ENT = 6080, HY_ZB_BYTES = 12288;
__device__ __forceinline__ unsigned hy_zb_off(int idx0  ) { const int q = idx0 >> 3; return (unsigned)((q ^ ((q >> 4) & 3)) << 4); }
__device__ __forceinline__ const LAS unsigned char* hy_pm(const LAS unsigned char* zbl  , int g, int ip, int hh) {
    const int q0 = 124 - 4 * ip + 2 * g + hh;
    unsigned p = (unsigned)(size_t)zbl + (unsigned)(((q0 ^ ((q0 >> 4) & 3)) << 4) - 7168);
    asm volatile("" : "+v"(p));
    return (const LAS unsigned char*)(size_t)p;
}
template <int MASK>
__device__ __forceinline__ void hy_loadB(bf16x8 (&bf)[8], const LAS unsigned char* pm) {
#pragma unroll
    for (int tau = 0; tau < 8; ++tau) if (MASK & (1 << tau)) bf[tau] = *(const LAS bf16x8*)(pm + 1024 * (7 - tau));
}
__device__ __forceinline__ void hy_loadA(unsigned (&d)[5], const LAS bf16* taps, int g, int n, int hh) {
    const volatile LAS unsigned* dp = (const volatile LAS unsigned*)taps + ((1 + 8 * hh + n) >> 1) + 8 * g;
#pragma unroll
    for (int i = 0; i < 5; ++i) d[i] = dp[i];
}
template <int MASK>
__device__ __forceinline__ void hy_mma(f32x16 (&acc)[8], const bf16x8 a, const bf16x8 (&bf)[8]) {
#pragma unroll
    for (int tau = 0; tau < 8; ++tau) if (MASK & (1 << tau)) acc[tau] = __builtin_amdgcn_mfma_f32_32x32x16_bf16(a, bf[tau], acc[tau], 0, 0, 0);
}
#define HY_ALIGN(a, d) do { v4u aw_; aw_.x = __builtin_amdgcn_alignbyte(d[1], d[0], sh); aw_.y = __builtin_amdgcn_alignbyte(d[2], d[1], sh); aw_.z = __builtin_amdgcn_alignbyte(d[3], d[2], sh); aw_.w = __builtin_amdgcn_alignbyte(d[4], d[3], sh); a = __builtin_bit_cast(bf16x8, aw_); } while (0)
#define HY_INTERLEAVE() do { __builtin_amdgcn_sched_group_barrier(0x2, 4, 0); _Pragma("unroll") for (int i_ = 0; i_ < 9; ++i_) { __builtin_amdgcn_sched_group_barrier(0x8, 1, 0); __builtin_amdgcn_sched_group_barrier(0x100, 3, 0); __builtin_amdgcn_sched_group_barrier(0x2, 3, 0); } } while (0)
constexpr int HY_YOFF = 254;
template <int MASK>
__device__ __forceinline__ void hy_mma_reload(f32x16 (&acc)[8], const bf16x8 a, bf16x8 (&bf)[8], const LAS unsigned char* pm_next) {
#pragma unroll
    for (int tau = 0; tau < 8; ++tau) if (MASK & (1 << tau)) {
        acc[tau] = __builtin_amdgcn_mfma_f32_32x32x16_bf16(a, bf[tau], acc[tau], 0, 0, 0);
        bf[tau] = *(const LAS bf16x8*)(pm_next + 1024 * (7 - tau));
    }
}
template <int MX, int MY>
__device__ __forceinline__ void hy_segment(f32x16 (&acc)[8], const LAS bf16* taps, const LAS unsigned char* zbl, int i0, int i1, int n, int hh) {
    const unsigned sh = (n & 1) ? 0u : 2u;
    const int ip = n & 15;
    unsigned dx[5], dy[5]; bf16x8 a, x0[8], y0[8];
    hy_loadA(dx, taps, i0, n, hh); hy_loadA(dy, taps, i0 + HY_YOFF, n, hh); hy_loadB<MX>(x0, hy_pm(zbl, i0, ip, hh)); hy_loadB<MY>(y0, hy_pm(zbl, i0 + HY_YOFF, ip, hh));
#pragma unroll 1
    for (int i = i0; i < i1; ++i) {
        if (MX) { HY_ALIGN(a, dx); hy_loadA(dx, taps, i + 1, n, hh); hy_mma_reload<MX>(acc, a, x0, hy_pm(zbl, i + 1, ip, hh)); }
        HY_ALIGN(a, dy); hy_loadA(dy, taps, i + 1 + HY_YOFF, n, hh); hy_mma_reload<MY>(acc, a, y0, hy_pm(zbl, i + 1 + HY_YOFF, ip, hh));
        HY_INTERLEAVE(); __builtin_amdgcn_sched_barrier(0);
    }
}
__device__ __forceinline__ void hy_stage_taps(Frame& F, int c0, int o) {
    const bf16* TAPS = (const bf16*)(F.ws + WS_TAPS);
    int tid = F.tid; asm volatile("" : "+v"(tid));
#pragma unroll
    for (int j = 0; j < 8; ++j) { const int ch = tid + NTHREADS * j, ci = ch >> 10, w = ch & 1023;
        v4u t = *((const GAS v4u*)(TAPS + ((size_t)(c0 + ci) * 2 + o) * 8192) + w);
        if (w == 512) { const float fb = F.in[14][o * 1024 + c0 + ci]; t.x = (t.x & 0xffff0000u) | f2bf(bflo(t.x) + fb); }
        *((LAS v4u*)(F.lds) + ch) = t; }
}
struct ConvItem { const float* W; bf16* WTe; int N, row_base, k0, n0; };
__device__ __forceinline__ void conv_load64(float (&v)[64], const ConvItem& c, int lane) {
    const GAS float* src = (const GAS float*)(c.W + (size_t)c.k0 * c.N + c.n0 + lane);
#pragma unroll
    for (int kk = 0; kk < 64; ++kk) v[kk] = src[(size_t)kk * c.N];
}
__device__ __forceinline__ void conv_store64(const float (&v)[64], const ConvItem& c, int lane) {
    GAS v4u* dst = (GAS v4u*)c.WTe + (size_t)(c.k0 >> 3) * 2048 + c.row_base + lane;
#pragma unroll
    for (int j = 0; j < 8; ++j) { v4u o; o.x = pk2(v[8 * j], v[8 * j + 1]); o.y = pk2(v[8 * j + 2], v[8 * j + 3]); o.z = pk2(v[8 * j + 4], v[8 * j + 5]); o.w = pk2(v[8 * j + 6], v[8 * j + 7]); dst[(size_t)j * 2048] = o; }
}
constexpr int MOE_ITEMS_GU = 2 * NE * 32 * 16, MOE_ITEMS_D = NE * 16 * 32, MOE_ITEMS = MOE_ITEMS_GU + MOE_ITEMS_D;
#ifndef MOE_P0_ITEMS
#define MOE_P0_ITEMS 0
#endif
#ifndef MOE_P4_ITEMS
#define MOE_P4_ITEMS 3584
#endif
constexpr int MOE_HELP_ITEMS = MOE_ITEMS - MOE_P0_ITEMS - MOE_P4_ITEMS;
__device__ __forceinline__ ConvItem moe_item(Frame& F, int it) {
    bf16* WguT = (bf16*)(F.ws + WS_WGU); bf16* WdT = (bf16*)(F.ws + WS_WD); ConvItem c;
    if (it < MOE_ITEMS_GU) { const int which = it >> 13, e = (it >> 9) & 15, kb = (it >> 4) & 31, nb = it & 15, f0 = 64 * nb;
        c.W = (which ? F.in[21] : F.in[20]) + (size_t)e * DM * FF; c.N = FF; c.WTe = WguT + (size_t)e * 2048 * DM; c.row_base = (f0 >> 7) * 256 + which * 128 + (f0 & 127); c.k0 = 64 * kb; c.n0 = f0;
    } else { const int r = it - MOE_ITEMS_GU, e = r >> 9, kb = (r >> 5) & 15, nb = r & 31;
        c.W = F.in[22] + (size_t)e * FF * DM; c.N = DM; c.WTe = WdT + (size_t)e * 2048 * FF; c.row_base = 64 * nb; c.k0 = 64 * kb; c.n0 = 64 * nb; }
    return c;
}
__device__ __forceinline__ void conv_range_moe_tail(Frame& F);
__device__ __forceinline__ void moe_conv_item(Frame& F, int it) { float v[64]; const ConvItem c = moe_item(F, it); conv_load64(v, c, F.lane); conv_store64(v, c, F.lane); }
__device__ __forceinline__ void moe_conv_range(Frame& F, int lo, int hi, int step) {
    if (lo >= hi) return;
    float va[64], vb[64];
    ConvItem ca = moe_item(F, lo), cb_; conv_load64(va, ca, F.lane);
    for (int it = lo; it < hi; it += 2 * step) {
        const bool hb = it + step < hi;
        if (hb) { cb_ = moe_item(F, it + step); conv_load64(vb, cb_, F.lane); }
        conv_store64(va, ca, F.lane);
        const bool ha = it + 2 * step < hi;
        if (ha) { ca = moe_item(F, it + 2 * step); conv_load64(va, ca, F.lane); }
        if (hb) conv_store64(vb, cb_, F.lane);
    }
}
__device__ __forceinline__ void conv_range_moe_tail(Frame& F) {
    const int w = (F.bid - NB * NE) * NWAVES + F.wave, nw = (F.G - NB * NE) * NWAVES;
    moe_conv_range(F, MOE_ITEMS - MOE_P4_ITEMS + w, MOE_ITEMS, nw);
}
__device__ __forceinline__ void hy_write_gates(Frame& F, int c0, int oo) {
    const bf16* XH = (const bf16*)(F.ws + WS_XT) + (size_t)1024 * MT; bf16* GC = (bf16*)(F.ws + WS_UC);
    const float* cw = F.in[6]; const float* cb = F.in[7];
    int ht = F.tid - 256; asm volatile("" : "+v"(ht));
#pragma unroll 2
    for (int k = 0; k < 16; ++k) { const int id = ht + 256 * k, u = id & 511, b = (id >> 9) & 1, ci = id >> 10;
        const int gch = oo * 1024 + c0 + ci; const bf16* gs = XH + (size_t)gch * MT + b * SEQ;
        const float w0 = cw[gch], w1 = cw[3072 + gch], w2 = cw[6144 + gch], bb = cb[gch];
        const v4u w = *((const GAS v4u*)gs + u);
        float f[10];
        f[1] = bflo(w.x); f[2] = bfhi(w.x); f[3] = bflo(w.y); f[4] = bfhi(w.y); f[5] = bflo(w.z); f[6] = bfhi(w.z); f[7] = bflo(w.w); f[8] = bfhi(w.w);
        { const float l_ = bf2f(gs[u > 0 ? 8 * u - 1 : 0]), r_ = bf2f(gs[u < 511 ? 8 * u + 8 : 8 * u + 7]); f[0] = u > 0 ? l_ : 0.f; f[9] = u < 511 ? r_ : 0.f; }
        float z[8];
#pragma unroll
        for (int e = 0; e < 8; ++e) z[e] = bb + w0 * f[e] + w1 * f[e + 1] + w2 * f[e + 2];
        v4u r; r.x = pk2(z[0], z[1]); r.y = pk2(z[2], z[3]); r.z = pk2(z[4], z[5]); r.w = pk2(z[6], z[7]);
        *((GAS v4u*)(GC + ((size_t)((c0 + ci) * 2 + oo) * 2 + b) * SEQ) + u) = r; }
}
__device__ __forceinline__ void phase_hyena(Frame& F) {
    const bf16* XH = (const bf16*)(F.ws + WS_XT) + (size_t)1024 * MT;
    const float* cw = F.in[6]; const float* cb = F.in[7];
    bf16* HYT = (bf16*)(F.ws + WS_HYT); bf16* GC = (bf16*)(F.ws + WS_UC);
    const int n = F.lane & 31, hh = F.lane >> 5;
    const bool compute = F.wave < 4;
    const int nhelp = F.G * 4, hw = F.bid * 4 + (F.wave - 4);
    int sec = 0;
    for (int cg = F.bid; cg < 256; cg += F.G) {
        const int c0 = cg * 4;
        __syncthreads();
        hy_stage_taps(F, c0, 0);
        {
          int lane_ = F.lane; asm volatile("" : "+v"(lane_));
          const int ci = F.wave >> 1, b = F.wave & 1; LAS unsigned char* zb = F.lds + HY_TAPS_BYTES + F.wave * HY_ZB_BYTES;
          const int zch = 2048 + c0 + ci; const bf16* zsrc = XH + (size_t)zch * MT + b * SEQ;
          const float w0 = cw[zch], w1 = cw[3072 + zch], w2 = cw[6144 + zch], bb = cb[zch];
#pragma unroll
          for (int j = 0; j < 8; ++j) { const int u = lane_ + 64 * j; const v4u w = *((const GAS v4u*)zsrc + u);
              float f[10];
              f[1] = bflo(w.x); f[2] = bfhi(w.x); f[3] = bflo(w.y); f[4] = bfhi(w.y); f[5] = bflo(w.z); f[6] = bfhi(w.z); f[7] = bflo(w.w); f[8] = bfhi(w.w);
              { const float l_ = bf2f(zsrc[u > 0 ? 8 * u - 1 : 0]), r_ = bf2f(zsrc[u < 511 ? 8 * u + 8 : 8 * u + 7]); f[0] = u > 0 ? l_ : 0.f; f[9] = u < 511 ? r_ : 0.f; }
              float z[8];
#pragma unroll
              for (int e = 0; e < 8; ++e) z[e] = bb + w0 * f[e] + w1 * f[e + 1] + w2 * f[e + 2];
              v4u r; r.x = pk2(z[7], z[6]); r.y = pk2(z[5], z[4]); r.z = pk2(z[3], z[2]); r.w = pk2(z[1], z[0]);
              *(LAS v4u*)(zb + hy_zb_off(8 * (635 - u))) = r; }
          const v4u zero = {0u, 0u, 0u, 0u};
          for (int q = lane_; q < 124; q += 64) { *(LAS v4u*)(zb + hy_zb_off(8 * q)) = zero; *(LAS v4u*)(zb + hy_zb_off(8 * (636 + q))) = zero; } }
        if (!compute) hy_write_gates(F, c0, 0);
        __syncthreads();
#pragma unroll 1
        for (int o = 0; o < 2; ++o) {
            if (compute) {
                const int ci = F.wave, c = c0 + ci;
                const LAS bf16* taps = (const LAS bf16*)(F.lds + ci * 16384);
                const int ip = n & 15, bl = n >> 4;
                LAS unsigned char* zbl = F.lds + HY_TAPS_BYTES + (2 * ci + bl) * HY_ZB_BYTES;
                f32x16 acc[8];
#pragma unroll
                for (int tau = 0; tau < 8; ++tau)
#pragma unroll
                    for (int i = 0; i < 16; ++i) acc[tau][i] = 0.f;
                hy_segment<0x01, 0xFF>(acc, taps, zbl, 0, 32, n, hh);
                hy_segment<0x03, 0xFE>(acc, taps, zbl, 32, 64, n, hh);
                hy_segment<0x07, 0xFC>(acc, taps, zbl, 64, 96, n, hh);
                hy_segment<0x0F, 0xF8>(acc, taps, zbl, 96, 128, n, hh);
                hy_segment<0x1F, 0xF0>(acc, taps, zbl, 128, 160, n, hh);
                hy_segment<0x3F, 0xE0>(acc, taps, zbl, 160, 192, n, hh);
                hy_segment<0x7F, 0xC0>(acc, taps, zbl, 192, 224, n, hh);
                hy_segment<0xFF, 0x80>(acc, taps, zbl, 224, 254, n, hh);
                hy_segment<0x00, 0x80>(acc, taps, zbl, 254, 256, n, hh);
                LDS_WAIT();
                int ip2 = ip, h2 = hh, b2 = bl; asm volatile("" : "+v"(ip2), "+v"(h2), "+v"(b2));
                {
                    const bf16* gate = GC + ((size_t)(c * 2 + o) * 2 + b2) * SEQ;
                    LAS unsigned char* zb = F.lds + HY_TAPS_BYTES + (2 * ci + b2) * HY_ZB_BYTES; bf16* outp = HYT + (size_t)c * MT + b2 * SEQ;
#pragma unroll
                    for (int th = 0; th < 2; ++th) {
                        v2u gw[4][4];
#pragma unroll
                        for (int tq = 0; tq < 4; ++tq)
#pragma unroll
                            for (int rg = 0; rg < 4; ++rg) gw[tq][rg] = *(const GAS v2u*)(gate + 512 * (4 * th + tq) + 32 * ip2 + 8 * rg + 4 * h2);
#pragma unroll
                        for (int tq = 0; tq < 4; ++tq) {
#pragma unroll
                            for (int rg = 0; rg < 4; ++rg) { const int tau = 4 * th + tq, t0 = 512 * tau + 32 * ip2 + 8 * rg + 4 * h2;
                                const float z0 = bflo(gw[tq][rg].x) * acc[tau][4 * rg + 0], z1 = bfhi(gw[tq][rg].x) * acc[tau][4 * rg + 1], z2 = bflo(gw[tq][rg].y) * acc[tau][4 * rg + 2], z3 = bfhi(gw[tq][rg].y) * acc[tau][4 * rg + 3];
                                if (o == 0) { v2u w; w.x = pk2(z3, z2); w.y = pk2(z1, z0);
                                    *(LAS v2u*)(zb + hy_zb_off(8 * (635 - (t0 >> 3))) + (h2 ? 0 : 8)) = w; }
                                else { v2u w; w.x = pk2(z0, z1); w.y = pk2(z2, z3); *(GAS v2u*)(outp + t0) = w; } } }
                    }
                }
            } else {
                if (o == 0) hy_write_gates(F, c0, 1);
                const int lo_it = MOE_P0_ITEMS + sec * (MOE_HELP_ITEMS / 2), hi_it = lo_it + MOE_HELP_ITEMS / 2;
                if (sec < 2) moe_conv_range(F, lo_it + hw, hi_it, nhelp);
            }
            ++sec;
            if (o == 0) {
                __syncthreads();
                hy_stage_taps(F, c0, 1);
                __syncthreads();
            }
        }
    }
    for (; sec < 2; ++sec) if (!compute) { const int lo_it = MOE_P0_ITEMS + sec * (MOE_HELP_ITEMS / 2), hi_it = lo_it + MOE_HELP_ITEMS / 2; moe_conv_range(F, lo_it + hw, hi_it, nhelp); }
    __syncthreads();
}

constexpr int AT_KBYTES = 16384, AT_VPITCH = 136, AT_VBYTES = 128 * AT_VPITCH, AT_STAGE = AT_KBYTES + AT_VBYTES, AT_RP_OFF = 2 * AT_STAGE;
__device__ __forceinline__ void phase_attn2(Frame& F) {
    const bf16* QK = (const bf16*)(F.ws + WS_QK); const bf16* VT = (const bf16*)(F.ws + WS_XT); bf16* MIXED = (bf16*)(F.ws + WS_MIXED);
    const float* rpb = F.in[5]; const float* og = F.in[15]; const float* qg = F.in[3]; const float* kg = F.in[4];
    LAS float* rt = (LAS float*)(F.lds + AT_RP_OFF);
    LAS float* gtab = (LAS float*)(F.lds + AT_RP_OFF + 8 * 2048);
    LAS float* ogt = gtab + HD;
    if (F.tid < HD) gtab[F.tid] = qg[F.tid] * kg[F.tid];
    const int n = F.lane & 31, hh = F.lane >> 5;
    for (int unit = F.bid; unit < NB * NH * 16; unit += F.G) {
        const int rq = unit & 15, h = (unit >> 4) & 7, b = unit >> 7, r0 = 4 * rq;
        const int r = r0 + (F.wave >> 1), wq = F.wave & 1;
        int kmin = r0 - WR / 2; kmin = kmin < 0 ? 0 : (kmin > NROWS - WR ? NROWS - WR : kmin);
        int kmax = r0 + 3 - WR / 2; kmax = (kmax < 0 ? 0 : (kmax > NROWS - WR ? NROWS - WR : kmax)) + WR - 1;
        int kr0 = r - WR / 2; kr0 = kr0 < 0 ? 0 : (kr0 > NROWS - WR ? NROWS - WR : kr0);
        const int nrows = kmax - kmin + 1;
        __syncthreads();
        if (F.tid < HD) ogt[F.tid] = og[h * HD + F.tid];
#pragma unroll
        for (int k_ = 0; k_ < 4; ++k_) { const int i = F.tid + NTHREADS * k_; if (i < 15 * 128) { const int dr_ = i >> 7, dcx = (i & 127) - 48, dcc = dcx < 0 ? 0 : (dcx > 30 ? 30 : dcx);
            const float v = rpb[h * 465 + dr_ * 31 + dcc] * 1.4426950408889634f; rt[i] = (dcx == dcc) ? v : 0.f; } }
        const int mq = b * SEQ + r * GW + 32 * wq + n, qc = 32 * wq + n;
        int c0 = qc - WC / 2; c0 = c0 < 0 ? 0 : (c0 > GW - WC ? GW - WC : c0);
        bf16x8 qf[8];
#pragma unroll
        for (int ks = 0; ks < 8; ++ks) qf[ks] = *(const GAS bf16x8*)(QK + (size_t)mq * 2048 + h * HD + 16 * ks + 8 * hh);
        float qscale;
        {
          f32x16 D;
#pragma unroll
          for (int i = 0; i < 16; ++i) D[i] = 0.f;
#pragma unroll
          for (int ks = 0; ks < 8; ++ks) D = __builtin_amdgcn_mfma_f32_32x32x16_bf16(qf[ks], qf[ks], D, 0, 0, 0);
          float dsel = 0.f; const int isel = (n & 3) + 4 * (n >> 3);
#pragma unroll
          for (int i = 0; i < 16; ++i) dsel = (i == isel) ? D[i] : dsel;
          const float other = __shfl_xor(dsel, 32);
          const float ssq = (((n >> 2) & 1) == hh) ? dsel : other;
          qscale = (0.08838834764831845f * 1.4426950408889634f) * rsqrtf(ssq * (1.f / HD) + EPS); }
        const unsigned long long wmask = (c0 >= 4 * hh) ? (0xFFFFull << (c0 - 4 * hh)) : (0xFFFFull >> (4 * hh - c0));
        const unsigned wm0 = (unsigned)wmask, wm1 = (unsigned)(wmask >> 32);
        const int rtl = 4 * hh - qc + 63;
        f32x16 O[4];
#pragma unroll
        for (int dt = 0; dt < 4; ++dt)
#pragma unroll
            for (int i = 0; i < 16; ++i) O[dt][i] = 0.f;
        float lsum = 0.f;
        v4u sk[2], sv[2];

        auto gload = [&](int kr) {
#pragma unroll
            for (int j = 0; j < 2; ++j) { const int id = F.tid + 512 * j;
                sk[j] = *(const GAS v4u*)(QK + (size_t)(b * SEQ + kr * GW + (id >> 4)) * 2048 + 1024 + h * HD + 8 * (id & 15));
                sv[j] = *(const GAS v4u*)(VT + (size_t)(h * HD + (id >> 3)) * MT + b * SEQ + kr * GW + 8 * (id & 7)); }
        };
        auto lstore = [&](int buf) {
            LAS unsigned char* kb = F.lds + buf * AT_STAGE; LAS unsigned char* vb = kb + AT_KBYTES;
#pragma unroll
            for (int j = 0; j < 2; ++j) { const int id = F.tid + 512 * j; const int key = id >> 4, c = id & 15;
                float f[8] = {bflo(sk[j].x), bfhi(sk[j].x), bflo(sk[j].y), bfhi(sk[j].y), bflo(sk[j].z), bfhi(sk[j].z), bflo(sk[j].w), bfhi(sk[j].w)};
                float ss = 0.f;
#pragma unroll
                for (int e = 0; e < 8; ++e) ss += f[e] * f[e];
                ss = row16_sum(ss);
                const float rk = rsqrtf(ss * (1.f / HD) + EPS);
                const f32x4 ga = *(const LAS f32x4*)(gtab + 8 * c), gb = *(const LAS f32x4*)(gtab + 8 * c + 4);
                v4u kn; kn.x = pk2(f[0] * rk * ga.x, f[1] * rk * ga.y); kn.y = pk2(f[2] * rk * ga.z, f[3] * rk * ga.w); kn.z = pk2(f[4] * rk * gb.x, f[5] * rk * gb.y); kn.w = pk2(f[6] * rk * gb.z, f[7] * rk * gb.w);
                *(LAS v4u*)(kb + key * 256 + ((c ^ (key & 15)) << 4)) = kn;
                const int d = id >> 3, cv = id & 7; LAS v2u* vp = (LAS v2u*)(vb + d * AT_VPITCH + cv * 16);
                v2u lo, hi; lo.x = sv[j].x; lo.y = sv[j].y; hi.x = sv[j].z; hi.y = sv[j].w; vp[0] = lo; vp[1] = hi; }
        };
        gload(kmin); lstore(0);
        __syncthreads();
#pragma unroll 1
        for (int j = 0; j < nrows; ++j) {
            const int kr = kmin + j, buf = j & 1;
            if (j + 1 < nrows) gload(kr + 1);
            int n_ = n, hh_ = hh; asm volatile("" : "+v"(n_), "+v"(hh_));
            if (kr >= kr0 && kr < kr0 + WR) {
                const LAS unsigned char* kb = F.lds + buf * AT_STAGE; const LAS unsigned char* vb = kb + AT_KBYTES;
                const int dr = kr - r + WR - 1;
                const LAS float* rrow = rt + dr * 128 + (4 * hh_ - (32 * wq + n_) + 63);
#pragma unroll
                for (int kt = 0; kt < 2; ++kt) {
                    f32x16 S;
#pragma unroll
                    for (int i = 0; i < 16; ++i) S[i] = 0.f;
                    const int key = 32 * kt + n_;
                    bf16x8 kf[8]; float bia[16];
#pragma unroll
                    for (int ks = 0; ks < 8; ++ks) kf[ks] = *(const LAS bf16x8*)(kb + key * 256 + (((2 * ks + hh_) ^ (key & 15)) << 4));
                    __builtin_amdgcn_sched_barrier(0);
#pragma unroll
                    for (int ks = 0; ks < 8; ++ks) S = __builtin_amdgcn_mfma_f32_32x32x16_bf16(kf[ks], qf[ks], S, 0, 0, 0);
#pragma unroll
                    for (int i = 0; i < 16; ++i) bia[i] = rrow[32 * kt + (i & 3) + 8 * (i >> 2)];
                    v2u va[4][4];
#pragma unroll
                    for (int dt = 0; dt < 4; ++dt) { const LAS unsigned char* vrow = vb + (32 * dt + n_) * AT_VPITCH + (32 * kt + 4 * hh_) * 2;
#pragma unroll
                        for (int q = 0; q < 4; ++q) va[dt][q] = *(const LAS v2u*)(vrow + 16 * q); }
                    __builtin_amdgcn_sched_barrier(0);
                    float p[16];
#pragma unroll
                    for (int i = 0; i < 16; ++i) { const int E = (i & 3) + 8 * (i >> 2);
                        const float e = __builtin_amdgcn_exp2f(S[i] * qscale + bia[i]);
                        const unsigned keep = (unsigned)__builtin_amdgcn_sbfe((int)(kt ? wm1 : wm0), E, 1);
                        p[i] = __builtin_bit_cast(float, __builtin_bit_cast(unsigned, e) & keep); lsum += p[i]; }
                    v4u pw0, pw1;
                    pw0.x = pk2(p[0], p[1]); pw0.y = pk2(p[2], p[3]); pw0.z = pk2(p[4], p[5]); pw0.w = pk2(p[6], p[7]);
                    pw1.x = pk2(p[8], p[9]); pw1.y = pk2(p[10], p[11]); pw1.z = pk2(p[12], p[13]); pw1.w = pk2(p[14], p[15]);
                    const bf16x8 pf0 = __builtin_bit_cast(bf16x8, pw0), pf1 = __builtin_bit_cast(bf16x8, pw1);
#pragma unroll
                    for (int dt = 0; dt < 4; ++dt) {
                        const v2u a0 = va[dt][0], a1 = va[dt][1], a2 = va[dt][2], a3 = va[dt][3];
                        v4u f0, f1; f0.x = a0.x; f0.y = a0.y; f0.z = a1.x; f0.w = a1.y; f1.x = a2.x; f1.y = a2.y; f1.z = a3.x; f1.w = a3.y;
                        O[dt] = __builtin_amdgcn_mfma_f32_32x32x16_bf16(__builtin_bit_cast(bf16x8, f0), pf0, O[dt], 0, 0, 0);
                        O[dt] = __builtin_amdgcn_mfma_f32_32x32x16_bf16(__builtin_bit_cast(bf16x8, f1), pf1, O[dt], 0, 0, 0);
                    }
                }
            }
            if (j + 1 < nrows) lstore(buf ^ 1);
            __syncthreads();
        }
        lsum += __shfl_xor(lsum, 32);
        const float il = 1.f / lsum;
        float ss = 0.f;
#pragma unroll
        for (int dt = 0; dt < 4; ++dt)
#pragma unroll
            for (int i = 0; i < 16; ++i) { O[dt][i] *= il; ss += O[dt][i] * O[dt][i]; }
        ss += __shfl_xor(ss, 32);
        const float rr = rsqrtf(ss * (1.f / HD) + EPS);
        bf16* orow = MIXED + (size_t)mq * DM + h * HD;
#pragma unroll
        for (int dt = 0; dt < 4; ++dt)
#pragma unroll
            for (int rg = 0; rg < 4; ++rg) { const int d = 32 * dt + 8 * rg + 4 * hh; const f32x4 gg = *(const LAS f32x4*)(ogt + d);
                v2u w; w.x = pk2(O[dt][4 * rg + 0] * rr * gg.x, O[dt][4 * rg + 1] * rr * gg.y); w.y = pk2(O[dt][4 * rg + 2] * rr * gg.z, O[dt][4 * rg + 3] * rr * gg.w);
                *(GAS v2u*)(orow + d) = w; }
    }
    __syncthreads();
}

__device__ __forceinline__ void phase_p25(Frame& F) {
    const bf16* HYT = (const bf16*)(F.ws + WS_HYT); bf16* MIXED = (bf16*)(F.ws + WS_MIXED); const float* hg = F.in[16];
    LAS float* tile = (LAS float*)F.lds;
    LAS float* rs = (LAS float*)(F.lds + 128 * 65 * 4);
    for (int it = F.bid; it < 8 * (MT / 64); it += F.G) {
        const int gi = it & 7, m0 = (it >> 3) * 64;
        { const int ch = F.tid >> 2, t0 = (F.tid & 3) * 16; const bf16* p = HYT + (size_t)(gi * 128 + ch) * MT + m0 + t0;
          const v4u a = *(const GAS v4u*)p, b = *(const GAS v4u*)(p + 8);
          LAS float* d = tile + ch * 65 + t0;
          d[0] = bflo(a.x); d[1] = bfhi(a.x); d[2] = bflo(a.y); d[3] = bfhi(a.y); d[4] = bflo(a.z); d[5] = bfhi(a.z); d[6] = bflo(a.w); d[7] = bfhi(a.w);
          d[8] = bflo(b.x); d[9] = bfhi(b.x); d[10] = bflo(b.y); d[11] = bfhi(b.y); d[12] = bflo(b.z); d[13] = bfhi(b.z); d[14] = bflo(b.w); d[15] = bfhi(b.w); }
        __syncthreads();
        {
          const int t = F.tid >> 3, c0 = (F.tid & 7) * 16; float ss = 0.f;
#pragma unroll
          for (int c = 0; c < 16; ++c) { const float v = tile[(c0 + c) * 65 + t]; ss += v * v; }
          ss += dpp_f<DPP_XOR1>(ss); ss += dpp_f<DPP_XOR2>(ss); ss += dpp_f<DPP_HMIRROR>(ss);
          if ((F.tid & 7) == 0) rs[t] = rsqrtf(ss * (1.f / 128) + EPS); }
        __syncthreads();
        {
          const int t = F.tid >> 3, c0 = (F.tid & 7) * 16; const float r = rs[t]; float o[16];
#pragma unroll
          for (int c = 0; c < 16; ++c) o[c] = tile[(c0 + c) * 65 + t] * r * hg[gi * 128 + c0 + c];
          v4u a, b; a.x = pk2(o[0], o[1]); a.y = pk2(o[2], o[3]); a.z = pk2(o[4], o[5]); a.w = pk2(o[6], o[7]); b.x = pk2(o[8], o[9]); b.y = pk2(o[10], o[11]); b.z = pk2(o[12], o[13]); b.w = pk2(o[14], o[15]);
          bf16* q = MIXED + (size_t)(m0 + t) * DM + AW + gi * 128 + c0; *(GAS v4u*)q = a; *(GAS v4u*)(q + 8) = b; }
        __syncthreads();
    }
}
__device__ __forceinline__ void phase_p35(Frame& F) {
    LAS float* wrT = (LAS float*)F.lds;
    const float* wr = F.in[19]; const float* g = F.in[18];
    constexpr int WRS = DM + 4;
    for (int i = F.tid; i < DM * NE; i += NTHREADS) { const int d = i >> 4, e = i & 15; wrT[e * WRS + d] = wr[i]; }
    __syncthreads();
    bf16* HB = (bf16*)(F.ws + WS_HB); float* AFF = (float*)(F.ws + WS_AFF); const float* x1 = F.out;
    f32x4 gv[8];
#pragma unroll
    for (int j = 0; j < 8; ++j) gv[j] = *((const GAS f32x4*)g + F.lane + 64 * j);
    f32x4 vn[8];
    { const int m0 = GW_ID(F); if (m0 < MT) { const GAS f32x4* xr = (const GAS f32x4*)(x1 + (size_t)m0 * DM) + F.lane;
#pragma unroll
        for (int j = 0; j < 8; ++j) vn[j] = xr[64 * j]; } }
    for (int m = GW_ID(F); m < MT; m += GW_N(F)) {
        f32x4 v[8]; float s = 0.f;
#pragma unroll
        for (int j = 0; j < 8; ++j) { v[j] = vn[j]; s += (v[j].x * v[j].x + v[j].y * v[j].y) + (v[j].z * v[j].z + v[j].w * v[j].w); }
        if (m + GW_N(F) < MT) { const GAS f32x4* xr = (const GAS f32x4*)(x1 + (size_t)(m + GW_N(F)) * DM) + F.lane;
#pragma unroll
            for (int j = 0; j < 8; ++j) vn[j] = xr[64 * j]; }
        const float r = rsqrtf(wave_sum(s) * (1.f / DM) + EPS);
        GAS v2u* o8 = (GAS v2u*)(HB + (size_t)m * DM) + F.lane;
#pragma unroll
        for (int j = 0; j < 8; ++j) { const f32x4 gg = gv[j]; v[j].x *= r * gg.x; v[j].y *= r * gg.y; v[j].z *= r * gg.z; v[j].w *= r * gg.w;
            v2u o; o.x = pk2(v[j].x, v[j].y); o.y = pk2(v[j].z, v[j].w); o8[64 * j] = o; }
        float a[NE];
#pragma unroll
        for (int e = 0; e < NE; ++e) { float s_ = 0.f;
#pragma unroll
            for (int j = 0; j < 8; ++j) { const f32x4 w = *((const LAS f32x4*)(wrT + e * WRS) + F.lane + 64 * j); s_ += (v[j].x * w.x + v[j].y * w.y) + (v[j].z * w.z + v[j].w * w.w); }
            a[e] = s_; }
        const bool lb0 = F.lane & 1, lb1 = F.lane & 2, lb2 = F.lane & 4, lb3 = F.lane & 8;
        float c8[8], c4[4], c2[2], mine;
#pragma unroll
        for (int j = 0; j < 8; ++j) c8[j] = (lb2 ? a[j + 8] : a[j]) + dpp_f<DPP_HMIRROR>(lb2 ? a[j] : a[j + 8]);
#pragma unroll
        for (int j = 0; j < 4; ++j) c4[j] = (lb0 ? c8[j + 4] : c8[j]) + dpp_f<DPP_XOR1>(lb0 ? c8[j] : c8[j + 4]);
#pragma unroll
        for (int j = 0; j < 2; ++j) c2[j] = (lb1 ? c4[j + 2] : c4[j]) + dpp_f<DPP_XOR2>(lb1 ? c4[j] : c4[j + 2]);
        mine = (lb3 ? c2[1] : c2[0]) + dpp_f<DPP_ROR(8)>(lb3 ? c2[0] : c2[1]);
        mine += __shfl_xor(mine, 16); mine += __shfl_xor(mine, 32);
        const int my_e = (lb2 ? 8 : 0) + (lb0 ? 4 : 0) + (lb1 ? 2 : 0) + (lb3 ? 1 : 0);
        const float mx = row16_max(mine);
        const float ex = expf(mine - mx);
        const float den = row16_sum(ex);
        const int b = m / SEQ, sidx = m % SEQ;
        if (F.lane < NE) AFF[((size_t)b * NE + my_e) * SEQ + sidx] = ex / den;
    }
    __syncthreads();
}
__device__ __forceinline__ void phase_p4(Frame& F) {
    LAS unsigned* key = (LAS unsigned*)F.lds;
    LAS unsigned* hist = (LAS unsigned*)(F.lds + 16384);
    LAS unsigned* wsum = (LAS unsigned*)(F.lds + 16384 + 1024);
    const float* AFF = (const float*)(F.ws + WS_AFF); int* IDX = (int*)(F.ws + WS_IDX); float* GATE = (float*)(F.ws + WS_GATE); int* SEL = (int*)(F.ws + WS_SEL);
    for (int be = F.bid; be < NB * NE; be += F.G) {
        const int b = be / NE, e = be % NE;
        __syncthreads();
        const GAS v4u* ap = (const GAS v4u*)(AFF + (size_t)be * SEQ);
        const v4u k0 = ap[2 * F.tid], k1 = ap[2 * F.tid + 1];
        unsigned kk[8] = {k0.x, k0.y, k0.z, k0.w, k1.x, k1.y, k1.z, k1.w};
        unsigned prefix = 0u, mask = 0u, remaining = CAP;
#pragma unroll 1
        for (int pass = 0; pass < 4; ++pass) {
            const int shift = 24 - 8 * pass;
            if (F.tid < 256) hist[F.tid] = 0u;
            __syncthreads();
#pragma unroll
            for (int i = 0; i < 8; ++i) if ((kk[i] & mask) == prefix) __hip_atomic_fetch_add(&hist[(kk[i] >> shift) & 255u], 1u, __ATOMIC_RELAXED, __HIP_MEMORY_SCOPE_WORKGROUP);
            __syncthreads();
            unsigned incl_ = 0u, mine_ = 0u;
            if (F.tid < 256) {
                mine_ = hist[255 - F.tid]; incl_ = mine_;
#pragma unroll
                for (int o = 1; o < 64; o <<= 1) { const unsigned t = __shfl_up(incl_, o); if (F.lane >= o) incl_ += t; }
                if (F.lane == 63) wsum[10 + F.wave] = incl_;
            }
            __syncthreads();
            if (F.tid < 256) {
                unsigned base = 0u;
                for (int w = 0; w < F.wave; ++w) base += wsum[10 + w];
                const unsigned above = base + incl_ - mine_;
                if (above < remaining && remaining <= above + mine_) { wsum[8] = (unsigned)(255 - F.tid); wsum[9] = above; }
            }
            __syncthreads();
            const unsigned d = wsum[8], above = wsum[9];
            prefix |= d << shift; mask |= 255u << shift; remaining -= above;
            __syncthreads();
        }
        const unsigned thr = prefix;
        unsigned cnt = 0u;
#pragma unroll
        for (int i = 0; i < 8; ++i) cnt += (kk[i] > thr ? 0x10000u : 0u) + (kk[i] == thr ? 1u : 0u);
        unsigned incl = cnt;
#pragma unroll
        for (int o = 1; o < 64; o <<= 1) { const unsigned t = __shfl_up(incl, o); if (F.lane >= o) incl += t; }
        if (F.lane == 63) wsum[F.wave] = incl;
        __syncthreads();
        unsigned base = 0u;
        for (int w = 0; w < F.wave; ++w) base += wsum[w];
        unsigned run = base + incl - cnt;
#pragma unroll
        for (int i = 0; i < 8; ++i) {
            const unsigned gt_before = run >> 16, tie_before = run & 0xffffu;
            const bool isgt = kk[i] > thr, istie = kk[i] == thr;
            const bool sel = isgt || (istie && tie_before < remaining);
            const unsigned slot = gt_before + (tie_before < remaining ? tie_before : remaining);
            const int s = 8 * F.tid + i, m = b * SEQ + s;
            if (sel) { IDX[be * CAP + slot] = m; GATE[be * CAP + slot] = __builtin_bit_cast(float, kk[i]); }
            SEL[(size_t)m * NE + e] = sel ? (int)slot : -1;
            run += (isgt ? 0x10000u : 0u) + (istie ? 1u : 0u);
        }
    }
    __syncthreads();
}
__device__ __forceinline__ void phase_p7(Frame& F) {
    const int* SEL = (const int*)(F.ws + WS_SEL); const bf16* YE = (const bf16*)(F.ws + WS_YE);
    for (int m = GW_ID(F); m < MT; m += GW_N(F)) {
        const int b = m / SEQ;
        GAS f32x4* orow = (GAS f32x4*)(F.out + (size_t)m * DM);
        const int sel = SEL[(size_t)m * NE + (F.lane & 15)];
        f32x4 acc[8];
#pragma unroll
        for (int j = 0; j < 8; ++j) acc[j] = orow[2 * F.lane + (j & 1) + 128 * (j >> 1)];
        unsigned mask = (unsigned)(__ballot(sel >= 0) & 0xFFFFull);
        while (mask) {
            const int e0 = __builtin_ctz(mask); mask &= mask - 1u;
            const bool two = mask != 0u; const int e1 = two ? __builtin_ctz(mask) : e0; if (two) mask &= mask - 1u;
            const int s0 = __builtin_amdgcn_readlane(sel, e0), s1 = __builtin_amdgcn_readlane(sel, e1);
            const GAS v4u* y0 = (const GAS v4u*)(YE + (size_t)((b * NE + e0) * CAP + s0) * DM) + F.lane;
            const GAS v4u* y1 = (const GAS v4u*)(YE + (size_t)((b * NE + e1) * CAP + s1) * DM) + F.lane;
            v4u w0[4], w1[4];
#pragma unroll
            for (int jj = 0; jj < 4; ++jj) { w0[jj] = y0[64 * jj]; w1[jj] = y1[64 * jj]; }
            const float k1 = two ? 1.f : 0.f;
#pragma unroll
            for (int jj = 0; jj < 4; ++jj) {
                acc[2 * jj].x += bflo(w0[jj].x) + k1 * bflo(w1[jj].x); acc[2 * jj].y += bfhi(w0[jj].x) + k1 * bfhi(w1[jj].x); acc[2 * jj].z += bflo(w0[jj].y) + k1 * bflo(w1[jj].y); acc[2 * jj].w += bfhi(w0[jj].y) + k1 * bfhi(w1[jj].y);
                acc[2 * jj + 1].x += bflo(w0[jj].z) + k1 * bflo(w1[jj].z); acc[2 * jj + 1].y += bfhi(w0[jj].z) + k1 * bfhi(w1[jj].z); acc[2 * jj + 1].z += bflo(w0[jj].w) + k1 * bflo(w1[jj].w); acc[2 * jj + 1].w += bfhi(w0[jj].w) + k1 * bfhi(w1[jj].w); }
        }
#pragma unroll
        for (int j = 0; j < 8; ++j) orow[2 * F.lane + (j & 1) + 128 * (j >> 1)] = acc[j];
    }
}

struct Args { const float* in[23]; float* out; unsigned char* ws; int ph_lo, ph_hi; };
enum Phase { PH_P0 = 0, PH_G1, PH_ATTN, PH_P25, PH_OUT, PH_P35, PH_P4, PH_UP, PH_DOWN, PH_P7, PH_COUNT };

__global__ void __launch_bounds__(NTHREADS, 2) mk_fwd(Args args) {
    extern __shared__ __attribute__((aligned(16))) unsigned char lds_raw[];
    Frame F;
    F.lds = (LAS unsigned char*)lds_raw;
    F.tid = threadIdx.x; F.lane = F.tid & 63; F.wave = __builtin_amdgcn_readfirstlane(F.tid >> 6); F.G = gridDim.x; F.bid = blockIdx.x;
#pragma unroll
    for (int i = 0; i < 23; ++i) F.in[i] = args.in[i];
    F.out = args.out; F.ws = args.ws;
    const int lo = args.ph_lo, hi = args.ph_hi;
#define IN(k) (lo <= (k) && (k) < hi)
#define REPS(k) for (int rep_ = 0; rep_ < ((k) == REP_PHASE ? REP_N : 1); ++rep_)
#if MK_N_LAUNCHES == 1
    { volatile LAS unsigned* misc = (volatile LAS unsigned*)(F.lds + LDS_MISC_OFF); if (F.tid < 16) misc[F.tid] = 0u; }
    __syncthreads();
    XcdBarrier bar = xcd_barrier_post(g_bar_words, (volatile LAS unsigned*)(F.lds + LDS_MISC_OFF) + 8);
#define SEAM(k) do { if (IN(k) && IN((k) + 1)) xcd_barrier(bar); } while (0)
#else
#define SEAM(k) do { } while (0)
#endif
    if (IN(PH_P0)) REPS(PH_P0) { phase_p0(F); for (int it = GW_ID(F); it < MOE_P0_ITEMS; it += GW_N(F)) moe_conv_item(F, it); } SEAM(PH_P0);
    if (IN(PH_G1)) REPS(PH_G1) {
        phase_filters(F);
        __syncthreads();
        { pg8::DenseOrder S; S.init(F.ws + WS_HB, F.ws + WS_WIN, MT, 2048, DM, 0, F.G, F.bid);
          pg8::EpiBf16 E{(pg8::bf16_t*)(F.ws + WS_QK), 2048, 0, nullptr};
          pg8::gemm_phase<pg8::EpiBf16, pg8::DenseOrder, true>(F.lds, DM, S, E); }
        { pg8::DenseOrder S; S.init(F.ws + WS_HB, F.ws + WS_WIN, MT, 4096, DM, 8, F.G, F.bid);
          pg8::EpiTransBf16 E{(pg8::bf16_t*)(F.ws + WS_XT), MT, 8};
          pg8::gemm_phase<pg8::EpiTransBf16, pg8::DenseOrder, true>(F.lds, DM, S, E); }
    } SEAM(PH_G1);
    if (IN(PH_ATTN)) { __syncthreads(); for (int rep_ = 0; rep_ < ((PH_ATTN == REP_PHASE && REP_SUB != 2) ? REP_N : 1); ++rep_) phase_hyena(F); for (int rep_ = 0; rep_ < ((PH_ATTN == REP_PHASE && REP_SUB != 1) ? REP_N : 1); ++rep_) phase_attn2(F); } SEAM(PH_ATTN);
    if (IN(PH_P25)) REPS(PH_P25) { __syncthreads(); phase_p25(F); } SEAM(PH_P25);
    if (IN(PH_OUT)) REPS(PH_OUT) {
        __syncthreads();
        pg8::DenseOrder S; S.init(F.ws + WS_MIXED, F.ws + WS_WOUT, MT, DM, DM, 0, F.G, F.bid);
        pg8::EpiResF32 E{F.in[0], F.out, DM};
        pg8::gemm_phase<pg8::EpiResF32, pg8::DenseOrder, false>(F.lds, DM, S, E);
    } SEAM(PH_OUT);
    if (IN(PH_P35)) REPS(PH_P35) { __syncthreads(); phase_p35(F); } SEAM(PH_P35);
    if (IN(PH_P4)) REPS(PH_P4) { __syncthreads(); phase_p4(F);
        if (F.G > NB * NE) { if (F.bid >= NB * NE) conv_range_moe_tail(F); }
        else moe_conv_range(F, MOE_ITEMS - MOE_P4_ITEMS + GW_ID(F), MOE_ITEMS, GW_N(F)); } SEAM(PH_P4);
    if (IN(PH_UP)) REPS(PH_UP) {
        __syncthreads();
        pg8::MoeOrder S; S.init(F.ws + WS_HB, F.ws + WS_WGU, DM, F.G, F.bid, true);
        LAS int* ridx = (LAS int*)(F.lds + 131072);
        { const int* IDX = (const int*)(F.ws + WS_IDX); pg8::Unit u; int t_ = threadIdx.x; asm volatile("" : "+v"(t_));
          for (int i = 0; S.next(i, u); ++i) if (t_ < 256) ridx[i * 256 + t_] = IDX[u.g * CAP + u.pm * 256 + t_]; }
        __syncthreads();
        pg8::EpiSwiGLU E{(pg8::bf16_t*)(F.ws + WS_ACT)};
        pg8::gemm_phase<pg8::EpiSwiGLU, pg8::MoeOrder, true, true>(F.lds, DM, S, E, ridx);
    } SEAM(PH_UP);
    if (IN(PH_DOWN)) REPS(PH_DOWN) {
        __syncthreads();
        pg8::MoeOrder S; S.init(F.ws + WS_ACT, F.ws + WS_WD, FF, F.G, F.bid, false);
        pg8::EpiBf16 E{(pg8::bf16_t*)(F.ws + WS_YE), DM, 512, (const float*)(F.ws + WS_GATE)};
        pg8::gemm_phase<pg8::EpiBf16, pg8::MoeOrder, true>(F.lds, FF, S, E);
    } SEAM(PH_DOWN);
    if (IN(PH_P7)) { phase_p7(F); }
#if MK_N_LAUNCHES == 1
    __syncthreads();
    { volatile LAS unsigned* misc = (volatile LAS unsigned*)(F.lds + LDS_MISC_OFF);
      if (F.tid == 0) misc[0] = (xb_add(&g_bar_words[XCD_BAR_WORDS], 1u) + 1u == (unsigned)F.G) ? 1u : 0u;
      __syncthreads();
      if (misc[0] != 0u && F.tid < (XCD_BAR_WORDS + 64) / 64) __hip_atomic_store(&g_bar_words[64 * F.tid], 0u, __ATOMIC_RELAXED, __HIP_MEMORY_SCOPE_AGENT); }
#endif
#undef IN
#undef SEAM
}

extern "C" void kernel_launch(void* const* d_in, const int* in_sizes, int n_in, void* d_out, int out_size, void* d_ws, size_t ws_size, hipStream_t stream) {
    static int grid = 0;
    if (grid == 0) {
        if (n_in != 23 || ws_size < WS_END) { fprintf(stderr, "kernel_launch: unexpected inputs (n_in %d, ws %zu)\n", n_in, ws_size); grid = -1; return; }
        if (hipFuncSetAttribute((const void*)mk_fwd, hipFuncAttributeMaxDynamicSharedMemorySize, LDS_BYTES) != hipSuccess) { fprintf(stderr, "kernel_launch: hipFuncSetAttribute failed\n"); grid = -1; return; }
        int dev = 0, cus = 0, per_cu = 0;
        hipGetDevice(&dev); hipDeviceGetAttribute(&cus, hipDeviceAttributeMultiprocessorCount, dev);
        hipOccupancyMaxActiveBlocksPerMultiprocessor(&per_cu, (const void*)mk_fwd, NTHREADS, LDS_BYTES);
        (void)hipGetLastError();
        if (per_cu < 1) { fprintf(stderr, "kernel_launch: occupancy query says %d blocks/CU\n", per_cu); }
        grid = cus;
    }
    if (grid < 0) return;
    Args a{};
    for (int i = 0; i < 23; ++i) a.in[i] = (const float*)d_in[i];
    a.out = (float*)d_out; a.ws = (unsigned char*)d_ws;
#if MK_N_LAUNCHES == 1
    a.ph_lo = 0; a.ph_hi = PH_COUNT;
    hipLaunchKernelGGL(mk_fwd, dim3(grid), dim3(NTHREADS), LDS_BYTES, stream, a);
#else
    for (int p = 0; p < PH_COUNT; ++p) { a.ph_lo = p; a.ph_hi = p + 1; hipLaunchKernelGGL(mk_fwd, dim3(grid), dim3(NTHREADS), LDS_BYTES, stream, a); }
#endif
}
```

```cpp
#include <hip/hip_runtime.h>
#include <type_traits>
#include <hip/hip_cooperative_groups.h>
#include <cstdio>
#include <cstdint>
namespace cg = cooperative_groups;

#ifndef REP_PHASE
#define REP_PHASE -1
#define REP_N 1
#define REP_SUB 0
#endif
#ifndef AMP_REGION
#define AMP_REGION 0
#define AMP_K 3
#endif
#define AMP_BEGIN(id) unsigned long long amp_b_##id = 0; if (AMP_REGION == (id)) amp_b_##id = __builtin_amdgcn_s_memtime();
#define AMP_END(id) if (AMP_REGION == (id)) { asm volatile("s_waitcnt vmcnt(0) lgkmcnt(0)" ::: "memory"); const unsigned long long e_ = __builtin_amdgcn_s_memtime(); const unsigned long long d_ = e_ - amp_b_##id; \
    while (__builtin_amdgcn_s_memtime() - e_ < (unsigned long long)AMP_K * d_) __builtin_amdgcn_s_sleep(8); }
#define AMP_SPIN(t0) do { const unsigned long long e_ = __builtin_amdgcn_s_memtime(); const unsigned long long d_ = e_ - (t0); while (__builtin_amdgcn_s_memtime() - e_ < (unsigned long long)AMP_K * d_) __builtin_amdgcn_s_sleep(8); } while (0)
#ifndef MK_N_LAUNCHES
#define MK_N_LAUNCHES 1
#endif

namespace pg8 {
#define PG8_LAS __attribute__((address_space(3)))
typedef unsigned short bf16_t;
typedef short bf16x8 __attribute__((ext_vector_type(8)));
typedef float f32x4 __attribute__((ext_vector_type(4)));
typedef unsigned u32x4 __attribute__((ext_vector_type(4)));
typedef unsigned u32x2 __attribute__((ext_vector_type(2)));
constexpr int BM = 256, BK = 64, HALF = 128, HTB = HALF * BK * 2, STAGE_BYTES = 8 * HTB, NXCD = 8, WGM = 8;

__host__ __device__ __forceinline__ int lds_byte(int r, int c) { const int st = (r >> 4) * 2 + (c >> 5), rr = r & 15, cc = c & 31, ob = rr * 64 + cc * 2; return st * 1024 + (ob ^ (((ob >> 9) & 1) << 5)); }
__host__ __device__ __forceinline__ void stage_rc(int b, int& R, int& C) { const int st = b / 1024, sb = b % 1024, swz = sb ^ (((sb >> 9) & 1) << 5); R = (st >> 1) * 16 + swz / 64; C = (st & 1) * 32 + (swz % 64) / 2; }
__host__ __device__ __forceinline__ int perm32(int rho) { const int n = rho >> 4, i = rho & 15; return 8 * (i >> 2) + 4 * n + (i & 3); }

struct Unit { int pm, pn, g; const char* a; const char* b; };

__device__ __forceinline__ u32x4 lanes_rq_to_4rq(u32x4 v, int lane) { const int s = ((lane >> 2) + 16 * (lane & 3)) << 2; u32x4 o;
    o.x = __builtin_amdgcn_ds_bpermute(s, v.x); o.y = __builtin_amdgcn_ds_bpermute(s, v.y); o.z = __builtin_amdgcn_ds_bpermute(s, v.z); o.w = __builtin_amdgcn_ds_bpermute(s, v.w); return o; }
__device__ __forceinline__ u32x4 lanes_4rq_to_rq(u32x4 v, int lane) { const int s = (4 * (lane & 15) + (lane >> 4)) << 2; u32x4 o;
    o.x = __builtin_amdgcn_ds_bpermute(s, v.x); o.y = __builtin_amdgcn_ds_bpermute(s, v.y); o.z = __builtin_amdgcn_ds_bpermute(s, v.z); o.w = __builtin_amdgcn_ds_bpermute(s, v.w); return o; }
__device__ __forceinline__ unsigned cvt_pk_bf16(float lo, float hi) { unsigned r; asm volatile("v_cvt_pk_bf16_f32 %0, %1, %2" : "=v"(r) : "v"(lo), "v"(hi)); return r; }

struct DenseOrder {
    static constexpr bool CHUNK_B = true;
    int nM, nN, nwg, G, c, K, pn0, bn; const char* A; const char* Bt;
    __device__ void init(const void* A_, const void* Bt_, int M, int N, int K_, int pn0_, int bn_, int G_, int c_) { A = (const char*)A_; Bt = (const char*)Bt_; nM = M / BM; nN = N / BM; nwg = nM * nN; G = G_; c = c_; K = K_; pn0 = pn0_; bn = bn_; }
    __device__ bool next(int i, Unit& u) const {
        const long L = (long)i * G + c; if (L >= nwg) return false;
        int wgid = (int)L; { const int q = nwg / NXCD, r = nwg % NXCD, xcd = wgid % NXCD, off = wgid / NXCD; wgid = (xcd < r ? xcd * (q + 1) : r * (q + 1) + (xcd - r) * q) + off; }
        const int nig = WGM * nN, gid = wgid / nig, fm = gid * WGM, gsz = (nM - fm) < WGM ? (nM - fm) : WGM;
        u.pm = fm + ((wgid % nig) % gsz); u.pn = pn0 + (wgid % nig) / gsz; u.g = 0;
        u.a = A + (size_t)u.pm * BM * K * 2; u.b = Bt + (size_t)u.pn * BM * 16; return true;
    }
};
struct MoeOrder {
    static constexpr bool CHUNK_B = true;
    int G, c, K; bool gather; const char* A; const char* Bt; static constexpr int bn = 2048;
    __device__ void init(const void* A_, const void* Bt_, int K_, int G_, int c_, bool gather_) { A = (const char*)A_; Bt = (const char*)Bt_; K = K_; G = G_; c = c_; gather = gather_; }
    __device__ bool next(int i, Unit& u) const {
        const int L = i * G + c; if (L >= 512) return false;
        int pn, pm, b, e;
        if ((G & 7) == 0 && G >= 64) { const int per = G >> 3, x = c & 7, u = (c >> 3) + i * per;
            pn = u & 7; pm = (u >> 3) & 1; b = (u >> 4) & 1; e = x + 8 * (u >> 5); if (e >= 16) return false; }
        else { pn = L & 7; pm = (L >> 3) & 1; b = (L >> 4) & 1; e = L >> 5; }
        u.pm = pm; u.pn = pn; u.g = b * 16 + e;
        u.a = gather ? A : A + (size_t)(u.g * 512 + pm * BM) * K * 2; u.b = Bt + (size_t)e * 2048 * K * 2 + (size_t)pn * BM * 16; return true;
    }
};

struct EpiBf16 {
    static constexpr bool PERM = true, SWAP = false, INIT = false, APERM = false;
    bf16_t* O; int ldc; int grows; const float* rscale;
    __device__ __forceinline__ void operator()(const f32x4 (&acc)[2][2][4][2], const Unit& u, int wr, int wc, int fr, int fq) const {
        const int row0 = u.g * grows + u.pm * BM + wr * 64 + fr, col0 = u.pn * BM + wc * 32 + 8 * fq;
        float scv[2][4];
#pragma unroll
        for (int ai = 0; ai < 2; ++ai)
#pragma unroll
            for (int m = 0; m < 4; ++m) scv[ai][m] = rscale ? rscale[row0 + ai * HALF + m * 16] : 1.f;
        const int lane = fr + 16 * fq, rowT = row0 - fr + (lane >> 2), colT = col0 - 8 * fq + 8 * (lane & 3);
#pragma unroll
        for (int ai = 0; ai < 2; ++ai)
#pragma unroll
            for (int m = 0; m < 4; ++m) { bf16_t* rowp = O + (size_t)(rowT + ai * HALF + m * 16) * ldc + colT; const float sc = scv[ai][m];
#pragma unroll
                for (int bj = 0; bj < 2; ++bj) { const f32x4 v0 = acc[ai][bj][m][0] * sc, v1 = acc[ai][bj][m][1] * sc;
                    u32x4 w; w.x = cvt_pk_bf16(v0[0], v0[1]); w.y = cvt_pk_bf16(v0[2], v0[3]); w.z = cvt_pk_bf16(v1[0], v1[1]); w.w = cvt_pk_bf16(v1[2], v1[3]);
                    *(u32x4*)(rowp + bj * HALF) = lanes_rq_to_4rq(w, lane); } }
    }
};
struct EpiSwiGLU {
    static constexpr bool PERM = true, SWAP = false, INIT = false, APERM = false;
    bf16_t* O;
    __device__ __forceinline__ void operator()(const f32x4 (&acc)[2][2][4][2], const Unit& u, int wr, int wc, int fr, int fq) const {
        const int row0 = u.g * 512 + u.pm * BM + wr * 64 + fr, col0 = u.pn * HALF + wc * 32 + 8 * fq;
#pragma unroll
        for (int ai = 0; ai < 2; ++ai)
#pragma unroll
            for (int m = 0; m < 4; ++m) { bf16_t* rowp = O + (size_t)(row0 + ai * HALF + m * 16) * 1024 + col0;
                float r[8];
#pragma unroll
                for (int n = 0; n < 2; ++n)
#pragma unroll
                    for (int e = 0; e < 4; ++e) { const float g = acc[ai][0][m][n][e], up = acc[ai][1][m][n][e]; r[n * 4 + e] = g * __builtin_amdgcn_rcpf(1.f + __builtin_amdgcn_exp2f(-1.4426950408889634f * g)) * up; }
                u32x4 w; w.x = cvt_pk_bf16(r[0], r[1]); w.y = cvt_pk_bf16(r[2], r[3]); w.z = cvt_pk_bf16(r[4], r[5]); w.w = cvt_pk_bf16(r[6], r[7]);
                *(u32x4*)rowp = w; }
    }
};
struct EpiResF32 {
    static constexpr bool PERM = false, SWAP = false, INIT = true, APERM = false;
    const float* res; float* out; int ldc;
    __device__ __forceinline__ void init(f32x4 (&acc)[2][2][4][2], const Unit& u, int wr, int wc, int fr, int fq) const {
        const int lane = fr + 16 * fq, row0 = u.pm * BM + wr * 64 + (lane >> 2), col0 = u.pn * BM + wc * 32 + 4 * (lane & 3);
#pragma unroll
        for (int ai = 0; ai < 2; ++ai)
#pragma unroll
            for (int m = 0; m < 4; ++m) { const size_t off = (size_t)(row0 + ai * HALF + m * 16) * ldc + col0;
#pragma unroll
                for (int bj = 0; bj < 2; ++bj)
#pragma unroll
                    for (int n = 0; n < 2; ++n) acc[ai][bj][m][n] = __builtin_bit_cast(f32x4, lanes_4rq_to_rq(__builtin_nontemporal_load((const u32x4*)(res + off + bj * HALF + n * 16)), lane)); }
    }
    __device__ __forceinline__ void operator()(const f32x4 (&acc)[2][2][4][2], const Unit& u, int wr, int wc, int fr, int fq) const {
        const int lane = fr + 16 * fq, row0 = u.pm * BM + wr * 64 + (lane >> 2), col0 = u.pn * BM + wc * 32 + 4 * (lane & 3);
#pragma unroll
        for (int ai = 0; ai < 2; ++ai)
#pragma unroll
            for (int m = 0; m < 4; ++m) { const size_t off = (size_t)(row0 + ai * HALF + m * 16) * ldc + col0;
#pragma unroll
                for (int bj = 0; bj < 2; ++bj)
#pragma unroll
                    for (int n = 0; n < 2; ++n) *(u32x4*)(out + off + bj * HALF + n * 16) = lanes_rq_to_4rq(__builtin_bit_cast(u32x4, acc[ai][bj][m][n]), lane); }
    }
};
struct EpiTransBf16 {
    static constexpr bool PERM = false, SWAP = true, INIT = false, APERM = true;
    bf16_t* O; int ldt; int pn_base;
    __device__ __forceinline__ void operator()(const f32x4 (&acc)[2][2][4][2], const Unit& u, int wr, int wc, int fr, int fq) const {
        const int ch0 = (u.pn - pn_base) * BM + wc * 32 + fr, t0 = u.pm * BM + wr * 64 + 16 * fq;
#pragma unroll
        for (int bj = 0; bj < 2; ++bj)
#pragma unroll
            for (int n = 0; n < 2; ++n) { bf16_t* chp = O + (size_t)(ch0 + bj * HALF + n * 16) * ldt + t0;
#pragma unroll
                for (int ai = 0; ai < 2; ++ai)
#pragma unroll
                    for (int h = 0; h < 2; ++h) { const f32x4 v0 = acc[ai][bj][2 * h][n], v1 = acc[ai][bj][2 * h + 1][n];
                        u32x4 w; w.x = cvt_pk_bf16(v0[0], v0[1]); w.y = cvt_pk_bf16(v0[2], v0[3]); w.z = cvt_pk_bf16(v1[0], v1[1]); w.w = cvt_pk_bf16(v1[2], v1[3]);
                        *(u32x4*)(chp + ai * HALF + 8 * h) = w; } }
    }
};

template <class Epi, class Sched, bool ALIGN_EPI = false, bool GATHER = false, int SITE = 0>
__device__ __forceinline__ void gemm_phase(PG8_LAS unsigned char* lds, const int K, const Sched& S, const Epi& E, const PG8_LAS int* ridx = nullptr) {
    const int tid = threadIdx.x, wid = __builtin_amdgcn_readfirstlane(tid >> 6), lane = tid & 63, wr = wid >> 2, wc = wid & 3, fr = lane & 15, fq = lane >> 4;
    const int nt = K / BK;
    unsigned vA0[2], vA1[2], vN0[2], vN1[2], voffB[2]; int stR[2], stC[2];
    const size_t kstep = (size_t)(BK * 2);
    const size_t hstep = (size_t)HALF * K * 2;
    const size_t kstepB = Sched::CHUNK_B ? (size_t)(BK / 8) * S.bn * 16 : kstep, hstepB = Sched::CHUNK_B ? (size_t)HALF * 16 : hstep;
#pragma unroll
    for (int i = 0; i < 2; ++i) { int R, C; stage_rc(tid * 16 + i * 8192, R, C); stR[i] = R; stC[i] = C;
        int RB = R, CB = C;
        if constexpr (Sched::CHUNK_B) { const int b = tid * 16 + i * 8192, st = b >> 10, l = (b & 1023) >> 4; RB = (st >> 1) * 16 + (l & 15); CB = (st & 1) * 32 + (l >> 4) * 8; }
        const int Rb = Epi::PERM ? ((RB & ~31) + perm32(RB & 31)) : RB;
        voffB[i] = Sched::CHUNK_B ? (unsigned)(((CB >> 3) * S.bn + Rb) * 16) : (unsigned)(Rb * K + CB) * 2u;
        if constexpr (GATHER) { vA0[i] = (unsigned)(ridx[R] * K + C) * 2u; vA1[i] = (unsigned)(ridx[HALF + R] * K + C) * 2u; }
        else { const int Ra = Epi::APERM ? ((R & ~63) | (R & 3) | (((R >> 2) & 3) << 4) | (((R >> 4) & 3) << 2)) : R; vA0[i] = (unsigned)(Ra * K + C) * 2u; vA1[i] = vA0[i] + (unsigned)hstep; }
        vN0[i] = vA0[i]; vN1[i] = vA1[i]; }
    const unsigned ldsw = (unsigned)wid * 1024u;
    const int aoff = lds_byte(wr * 64 + fr, fq * 8), boff = Sched::CHUNK_B ? (wc * 4096 + fq * 256 + fr * 16) : lds_byte(wc * 32 + fr, fq * 8);
#define PG8_SA(b, h) (((b) * 2 + (h)) * HTB)
#define PG8_SB(b, h) ((4 + (b) * 2 + (h)) * HTB)
#define PG8_STAGE(bufoff, gbase, voff) do { _Pragma("unroll") for (int _i = 0; _i < 2; ++_i) \
        __builtin_amdgcn_global_load_lds((const unsigned*)((const char*)(gbase) + (voff)[_i]), (PG8_LAS unsigned*)(lds + (bufoff) + ldsw + _i * 8192), 16, 0, 0); } while (0)
#define PG8_LDA(dst, b, h) do { _Pragma("unroll") for (int m = 0; m < 4; ++m) _Pragma("unroll") for (int k = 0; k < 2; ++k) dst[m][k] = *(const PG8_LAS bf16x8*)(lds + PG8_SA(b, h) + aoff + m * 2048 + k * 1024); } while (0)
#define PG8_LDB(dst, b, h) do { _Pragma("unroll") for (int n = 0; n < 2; ++n) _Pragma("unroll") for (int k = 0; k < 2; ++k) dst[n][k] = *(const PG8_LAS bf16x8*)(lds + PG8_SB(b, h) + boff + n * 2048 + k * 1024); } while (0)
#define PG8_MMA(ai, bj, At, Bt) do { __builtin_amdgcn_s_setprio(1); _Pragma("unroll") for (int m = 0; m < 4; ++m) _Pragma("unroll") for (int n = 0; n < 2; ++n) _Pragma("unroll") for (int k = 0; k < 2; ++k) \
        acc[ai][bj][m][n] = Epi::SWAP ? __builtin_amdgcn_mfma_f32_16x16x32_bf16(At[m][k], Bt[n][k], acc[ai][bj][m][n], 0, 0, 0) : __builtin_amdgcn_mfma_f32_16x16x32_bf16(Bt[n][k], At[m][k], acc[ai][bj][m][n], 0, 0, 0); __builtin_amdgcn_s_setprio(0); } while (0)
#define PG8_WAIT_V(n) asm volatile("s_waitcnt vmcnt(" #n ")" ::: "memory")
#define PG8_WAIT_L(n) asm volatile("s_waitcnt lgkmcnt(" #n ")" ::: "memory")
#define PG8_BAR __builtin_amdgcn_s_barrier()
#define PG8_SCHED __builtin_amdgcn_sched_barrier(0)
    Unit cur, nxt; int ui = 0;
    if (!S.next(0, cur)) return;
    f32x4 acc[2][2][4][2];
    if constexpr (Epi::INIT) E.init(acc, cur, wr, wc, fr, fq);
    else {
#pragma unroll
    for (int a = 0; a < 2; ++a)
#pragma unroll
        for (int b = 0; b < 2; ++b)
#pragma unroll
            for (int m = 0; m < 4; ++m)
#pragma unroll
                for (int n = 0; n < 2; ++n) acc[a][b][m][n] = (f32x4){0.f, 0.f, 0.f, 0.f};
    }
    bf16x8 At[4][2], B0[2][2], B1[2][2];
    const char* cA = cur.a; const char* cB = cur.b;
    PG8_STAGE(PG8_SB(0, 0), cB, voffB); PG8_STAGE(PG8_SB(0, 1), cB + hstepB, voffB); PG8_STAGE(PG8_SA(0, 0), cA, vA0); PG8_STAGE(PG8_SA(0, 1), cA, vA1);
    if (wr == 1) PG8_BAR;
    PG8_WAIT_V(2); PG8_BAR;
    PG8_STAGE(PG8_SB(1, 0), cB + kstepB, voffB); PG8_STAGE(PG8_SA(1, 0), cA + kstep, vA0); PG8_STAGE(PG8_SB(1, 1), cB + hstepB + kstepB, voffB);
    PG8_WAIT_V(6); PG8_BAR;
    for (;;) {
        const bool has_next = S.next(ui + 1, nxt);
        const char* nA = has_next ? nxt.a : cA; const char* nB = has_next ? nxt.b : cB;
        if constexpr (GATHER) { if (has_next) {
#pragma unroll
            for (int i = 0; i < 2; ++i) { vN0[i] = (unsigned)(ridx[(ui + 1) * 256 + stR[i]] * K + stC[i]) * 2u; vN1[i] = (unsigned)(ridx[(ui + 1) * 256 + HALF + stR[i]] * K + stC[i]) * 2u; } } }
        unsigned long long amp_t0 = 0; if (AMP_REGION == 100 + SITE || AMP_REGION == 110 + SITE) amp_t0 = __builtin_amdgcn_s_memtime();
        asm volatile(".p2align 6");
        for (int t = 0; t < nt; t += 2) {
            const bool last = (t == nt - 2);
            const char* a1 = cA + (size_t)(t + 1) * kstep;
            const char* a2 = last ? nA : cA + (size_t)(t + 2) * kstep; const char* b2 = last ? nB : cB + (size_t)(t + 2) * kstepB;
            const char* a3 = a2 + kstep; const char* b3 = b2 + kstepB;
            unsigned w0[2], w1[2];
#pragma unroll
            for (int i = 0; i < 2; ++i) { w0[i] = last ? vN0[i] : vA0[i]; w1[i] = last ? vN1[i] : vA1[i]; }
            PG8_LDB(B0, 0, 0); PG8_LDB(B1, 0, 1); PG8_SCHED; PG8_LDA(At, 0, 0); PG8_STAGE(PG8_SA(1, 1), a1, vA1);
            PG8_WAIT_V(8); PG8_WAIT_L(0); PG8_BAR; PG8_MMA(0, 0, At, B0); PG8_MMA(0, 1, At, B1); PG8_BAR; PG8_SCHED;
            PG8_LDA(At, 0, 1); PG8_STAGE(PG8_SB(0, 0), b2, voffB); PG8_STAGE(PG8_SB(0, 1), b2 + hstepB, voffB); PG8_STAGE(PG8_SA(0, 0), a2, w0);
            PG8_WAIT_V(8); PG8_WAIT_L(0); PG8_BAR; PG8_MMA(1, 0, At, B0); PG8_MMA(1, 1, At, B1); PG8_BAR; PG8_SCHED;
            PG8_LDB(B0, 1, 0); PG8_LDB(B1, 1, 1); PG8_SCHED; PG8_LDA(At, 1, 0); PG8_STAGE(PG8_SA(0, 1), a2, w1);
            PG8_WAIT_V(8); PG8_WAIT_L(0); PG8_BAR; PG8_MMA(0, 0, At, B0); PG8_MMA(0, 1, At, B1); PG8_BAR; PG8_SCHED;
            PG8_LDA(At, 1, 1); PG8_STAGE(PG8_SB(1, 0), b3, voffB); PG8_STAGE(PG8_SB(1, 1), b3 + hstepB, voffB); PG8_STAGE(PG8_SA(1, 0), a3, w0);
            PG8_WAIT_V(8); PG8_WAIT_L(0); PG8_BAR; PG8_MMA(1, 0, At, B0); PG8_MMA(1, 1, At, B1); PG8_BAR; PG8_SCHED;
        }
        if constexpr (ALIGN_EPI) { if (wr == 0) PG8_BAR; }
        if (AMP_REGION == 100 + SITE) AMP_SPIN(amp_t0);
        if (AMP_REGION == 110 + SITE) amp_t0 = __builtin_amdgcn_s_memtime();
        E(acc, cur, wr, wc, fr, fq);
        if (AMP_REGION == 110 + SITE) { asm volatile("s_waitcnt vmcnt(0)" ::: "memory"); AMP_SPIN(amp_t0); }
        if (!has_next) break;
        if constexpr (Epi::INIT) E.init(acc, nxt, wr, wc, fr, fq);
        else {
#pragma unroll
        for (int a = 0; a < 2; ++a)
#pragma unroll
            for (int b = 0; b < 2; ++b)
#pragma unroll
                for (int m = 0; m < 4; ++m)
#pragma unroll
                    for (int n = 0; n < 2; ++n) acc[a][b][m][n] = (f32x4){0.f, 0.f, 0.f, 0.f};
        }
        cur = nxt; cA = nA; cB = nB; ++ui;
#pragma unroll
        for (int i = 0; i < 2; ++i) { vA0[i] = vN0[i]; vA1[i] = vN1[i]; }
        if constexpr (ALIGN_EPI) { if (wr == 1) PG8_BAR; }
    }
    PG8_WAIT_V(0);
    if constexpr (!ALIGN_EPI) { if (wr == 0) PG8_BAR; }
    PG8_BAR;
#undef PG8_SA
#undef PG8_SB
#undef PG8_STAGE
#undef PG8_LDA
#undef PG8_LDB
#undef PG8_MMA
#undef PG8_WAIT_V
#undef PG8_WAIT_L
#undef PG8_BAR
#undef PG8_SCHED
}
}

constexpr int NB = 2, SEQ = 4096, DM = 2048, MT = NB * SEQ;
constexpr int NH = 8, HD = 128, AW = 1024, HW = 1024, INW = 6144;
constexpr int GW = 64, NROWS = 64, WR = 8, WC = 16;
constexpr int NE = 16, CAP = 512, FF = 1024;
constexpr int FEMB = 33, FHID = 64;
constexpr float EPS = 1e-6f;
constexpr int NWAVES = 8, NTHREADS = 512;

constexpr size_t MiB = 1u << 20;
constexpr size_t WS_CTL = 0, CTL_ZERO_BYTES = 32768;
constexpr size_t WS_WIN = 2 * MiB;
constexpr size_t WS_WOUT = 26 * MiB;
constexpr size_t WS_WGU = 34 * MiB;
constexpr size_t WS_WD = 162 * MiB;
constexpr size_t WS_W3T = 226 * MiB;
constexpr size_t WS_HID2 = 227 * MiB;
constexpr size_t WS_HB = 228 * MiB;
constexpr size_t WS_QK = 260 * MiB;
constexpr size_t WS_XT = 292 * MiB;
constexpr size_t WS_UC = 356 * MiB;
constexpr size_t WS_TAPS = 404 * MiB;
constexpr size_t WS_HYT = 436 * MiB;
constexpr size_t WS_MIXED = 452 * MiB;
constexpr size_t WS_AFF = 484 * MiB;
constexpr size_t WS_IDX = 485 * MiB;
constexpr size_t WS_GATE = 486 * MiB;
constexpr size_t WS_SEL = 487 * MiB;
constexpr size_t WS_Z1T = 488 * MiB;
constexpr size_t WS_XG = WS_XT;
constexpr size_t WS_ACT = WS_UC;
constexpr size_t WS_YE = WS_TAPS;
constexpr size_t WS_END = 504 * MiB;

constexpr int LDS_BYTES = 163840, LDS_MISC_OFF = 163840 - 128;

#define GAS __attribute__((address_space(1)))
#define LAS __attribute__((address_space(3)))
typedef unsigned short bf16;
typedef unsigned v4u __attribute__((ext_vector_type(4)));
typedef unsigned v2u __attribute__((ext_vector_type(2)));
typedef float f32x4 __attribute__((ext_vector_type(4)));
#define LDS_WAIT() asm volatile("s_waitcnt lgkmcnt(0)" ::: "memory")
#define VM_WAIT() asm volatile("s_waitcnt vmcnt(0)" ::: "memory")
__device__ __forceinline__ unsigned f2bf(float f) { unsigned u = __builtin_bit_cast(unsigned, f); return (u + 0x7fffu + ((u >> 16) & 1u)) >> 16; }
__device__ __forceinline__ unsigned pk2(float lo, float hi) { unsigned r; asm("v_cvt_pk_bf16_f32 %0, %1, %2" : "=v"(r) : "v"(lo), "v"(hi)); return r; }
__device__ __forceinline__ float bf2f(unsigned h) { return __builtin_bit_cast(float, h << 16); }
__device__ __forceinline__ float bflo(unsigned w) { return __builtin_bit_cast(float, w << 16); }
__device__ __forceinline__ float bfhi(unsigned w) { return __builtin_bit_cast(float, w & 0xffff0000u); }
template <int CTRL> __device__ __forceinline__ float dpp_f(float v) { return __builtin_bit_cast(float, __builtin_amdgcn_update_dpp(0, __builtin_bit_cast(int, v), CTRL, 0xf, 0xf, true)); }
#define DPP_XOR1 0xB1
#define DPP_XOR2 0x4E
#define DPP_HMIRROR 0x141
#define DPP_ROR(n) (0x120 + (n))
__device__ __forceinline__ float row16_sum(float v) { v += dpp_f<DPP_ROR(8)>(v); v += dpp_f<DPP_ROR(4)>(v); v += dpp_f<DPP_ROR(2)>(v); v += dpp_f<DPP_ROR(1)>(v); return v; }
__device__ __forceinline__ float row16_max(float v) { v = fmaxf(v, dpp_f<DPP_ROR(8)>(v)); v = fmaxf(v, dpp_f<DPP_ROR(4)>(v)); v = fmaxf(v, dpp_f<DPP_ROR(2)>(v)); v = fmaxf(v, dpp_f<DPP_ROR(1)>(v)); return v; }
__device__ __forceinline__ float wave_sum(float v) { v = row16_sum(v); v += __shfl_xor(v, 16); v += __shfl_xor(v, 32); return v; }


#define XB_TMO      128
#define XB_XCNT(j)  (256  + 64 * (j))
#define XB_XSUB(j)  (1280 + 64 * (j))
#define XB_XGEN(j)  (2304 + 64 * (j))
#define XB_TOP      3328
#define XB_TOPGEN   3392
#define XCD_BAR_WORDS 3456
#define XB_SPIN_CAP (1u << 22)
__device__ __forceinline__ unsigned xb_ld(unsigned* p)              { return __hip_atomic_load(p, __ATOMIC_RELAXED, __HIP_MEMORY_SCOPE_AGENT); }
__device__ __forceinline__ unsigned xb_add(unsigned* p, unsigned v) { return __hip_atomic_fetch_add(p, v, __ATOMIC_RELAXED, __HIP_MEMORY_SCOPE_AGENT); }
__device__ __forceinline__ unsigned xb_xcc_id() { return (unsigned)__builtin_amdgcn_s_getreg((3 << 11) | 20) & 0xFu; }
#define XB_SPIN(cond, bar) do { unsigned _sp = 0; while (cond) { __builtin_amdgcn_s_sleep(1); \
    if ((++_sp & 255u) == 0u) { if (xb_ld(&(bar)[XB_TMO])) break; if (_sp > XB_SPIN_CAP) { atomicAdd(&(bar)[XB_TMO], 1u); break; } } } } while (0)
struct XcdBarrier { unsigned* bar; unsigned x; volatile LAS unsigned* st; };
__device__ __forceinline__ XcdBarrier xcd_barrier_post(unsigned* bar, volatile LAS unsigned* st) {
    XcdBarrier b; b.bar = bar; b.x = xb_xcc_id(); b.st = st;
    if (threadIdx.x == 0) (void)xb_add(&bar[XB_XCNT(b.x)], 1u);
    return b;
}
__device__ __forceinline__ void xcd_barrier_complete(unsigned* bar, unsigned x, unsigned& nloc, unsigned& nx) {
    const unsigned G = gridDim.x * gridDim.y * gridDim.z;
    unsigned sum, cnt, mine, sp = 0u;
    for (;;) {
        sum = 0u; cnt = 0u; mine = 0u;
#pragma unroll
        for (unsigned j = 0; j < 16; ++j) { const unsigned c = xb_ld(&bar[XB_XCNT(j)]); sum += c; cnt += (c > 0u) ? 1u : 0u; mine = (j == x) ? c : mine; }
        if (sum == G) break;
        __builtin_amdgcn_s_sleep(1);
        if ((++sp & 255u) == 0u) { if (xb_ld(&bar[XB_TMO])) break; if (sp > XB_SPIN_CAP) { atomicAdd(&bar[XB_TMO], 1u); break; } }
    }
    nloc = mine > 0u ? mine : 1u; nx = cnt > 0u ? cnt : 1u;
}
__device__ __forceinline__ void xcd_barrier(const XcdBarrier& b) {
    asm volatile("s_waitcnt vmcnt(0)" ::: "memory");
    __syncthreads();
    if (threadIdx.x == 0) {
        unsigned* bar = b.bar;
        __builtin_amdgcn_s_waitcnt(0);
        unsigned nloc = b.st[0], nx = b.st[1];
        if (nloc == 0u) { xcd_barrier_complete(bar, b.x, nloc, nx); b.st[0] = nloc; b.st[1] = nx; }
        const unsigned old = xb_add(&bar[XB_XSUB(b.x)], 1u);
        const unsigned gen = old / nloc;
        if (old + 1u == (gen + 1u) * nloc) {
            __builtin_amdgcn_fence(__ATOMIC_RELEASE, "agent");
            asm volatile("s_waitcnt vmcnt(0)" ::: "memory");
            const unsigned og = xb_add(&bar[XB_TOP], 1u);
            const unsigned tg = og / nx;
            if (og + 1u == (tg + 1u) * nx) xb_add(&bar[XB_TOPGEN], 1u);
            else XB_SPIN(xb_ld(&bar[XB_TOPGEN]) == tg, bar);
            __builtin_amdgcn_fence(__ATOMIC_ACQUIRE, "agent");
            xb_add(&bar[XB_XGEN(b.x)], 1u);
            asm volatile("s_waitcnt vmcnt(0)" ::: "memory");
        } else {
            XB_SPIN(xb_ld(&bar[XB_XGEN(b.x)]) == gen, bar);
            __builtin_amdgcn_fence(__ATOMIC_ACQUIRE, "agent");
            asm volatile("s_waitcnt vmcnt(0)" ::: "memory");
        }
    }
    __syncthreads();
}

__device__ unsigned g_bar_words[XCD_BAR_WORDS + 64];
struct Frame {
    LAS unsigned char* lds;
    int tid, lane, wave, G, bid;
    const float* in[23]; float* out; unsigned char* ws;
};
#define GW_ID(F) ((F).bid * NWAVES + (F).wave)
#define GW_N(F) ((F).G * NWAVES)

struct ConvItem { const float* W; bf16* WTe; int N, row_base, k0, n0, bN; };
__device__ __forceinline__ void conv_load64(float (&v)[64], const ConvItem& c, int lane) {
    const GAS float* src = (const GAS float*)(c.W + (size_t)c.k0 * c.N + c.n0 + lane);
#pragma unroll
    for (int kk = 0; kk < 64; ++kk) v[kk] = __builtin_nontemporal_load(src + (size_t)kk * c.N);
}
template <bool NT = false>
__device__ __forceinline__ void conv_store64(const float (&v)[64], const ConvItem& c, int lane) {
    GAS v4u* dst = (GAS v4u*)c.WTe + (size_t)(c.k0 >> 3) * c.bN + c.row_base + lane;
#pragma unroll
    for (int j = 0; j < 8; ++j) { v4u o; o.x = pk2(v[8 * j], v[8 * j + 1]); o.y = pk2(v[8 * j + 2], v[8 * j + 3]); o.z = pk2(v[8 * j + 4], v[8 * j + 5]); o.w = pk2(v[8 * j + 6], v[8 * j + 7]); if (NT) __builtin_nontemporal_store(o, dst + (size_t)j * c.bN); else dst[(size_t)j * c.bN] = o; }
}
__device__ __forceinline__ void p0_transpose_item(const float* W, int K, int N, bf16* WT, int row_base, int k0, int n0, LAS float* scr, int lane) {
    float t_[32];
#pragma unroll
    for (int i = 0; i < 32; ++i) { const int kk = 2 * i + (lane >> 5); t_[i] = W[(size_t)(k0 + kk) * N + n0 + (lane & 31)]; }
#pragma unroll
    for (int i = 0; i < 32; ++i) { const int kk = 2 * i + (lane >> 5); scr[kk * 33 + (lane & 31)] = t_[i]; }
    LDS_WAIT(); asm volatile("" ::: "memory");
    const int c = lane & 7;
#pragma unroll
    for (int j = 0; j < 4; ++j) { const int n = (lane >> 3) + 8 * j; const LAS float* s = scr + (8 * c) * 33 + n;
        v4u o; o.x = pk2(s[0 * 33], s[1 * 33]); o.y = pk2(s[2 * 33], s[3 * 33]); o.z = pk2(s[4 * 33], s[5 * 33]); o.w = pk2(s[6 * 33], s[7 * 33]);
        *((GAS v4u*)WT + ((size_t)((row_base >> 5) * 4 + (c >> 1)) * 64 + n + 32 * (c & 1))) = o; }
    LDS_WAIT(); asm volatile("" ::: "memory");
}
__device__ __forceinline__ void phase_p0(Frame& F) {
    LAS float* scr = (LAS float*)(F.lds + F.wave * 16384);
    const int gw = GW_ID(F), NGW = GW_N(F);
    bf16* WinT = (bf16*)(F.ws + WS_WIN); bf16* W3T = (bf16*)(F.ws + WS_W3T);
    constexpr int I_IN = (DM / 64) * (INW / 64);
    auto dense_item = [&](int it) { ConvItem c; const int kb = it / (INW / 64), nb = it % (INW / 64); c.W = F.in[2]; c.N = INW; c.WTe = WinT; c.bN = INW;
        c.row_base = 64 * nb; c.k0 = 64 * kb; c.n0 = 64 * nb; return c; };
    for (int it = gw; it < I_IN; it += 2 * NGW) {
        float va[64], vb[64];
        const bool hb_ = it + NGW < I_IN;
        const ConvItem ca = dense_item(it), cb_ = dense_item(hb_ ? it + NGW : it);
        conv_load64(va, ca, F.lane); if (hb_) conv_load64(vb, cb_, F.lane);
        conv_store64(va, ca, F.lane); if (hb_) conv_store64(vb, cb_, F.lane);
    }
    for (int nb = gw; nb < 4096 / 32; nb += NGW) p0_transpose_item(F.in[12], FHID, 4096, W3T, 32 * nb, 0, 32 * nb, scr, F.lane);
    bf16* HB = (bf16*)(F.ws + WS_HB);
    const float* x = F.in[0]; const float* g = F.in[1];
    f32x4 gv[8];
#pragma unroll
    for (int j = 0; j < 8; ++j) gv[j] = *((const GAS f32x4*)g + F.lane + 64 * j);
    f32x4 vn[8];
    if (gw < MT) { const GAS f32x4* xr = (const GAS f32x4*)(x + (size_t)gw * DM) + F.lane;
#pragma unroll
        for (int j = 0; j < 8; ++j) vn[j] = __builtin_nontemporal_load(xr + 64 * j); }
    for (int m = gw; m < MT; m += NGW) {
        f32x4 v[8]; float s = 0.f;
#pragma unroll
        for (int j = 0; j < 8; ++j) { v[j] = vn[j]; s += (v[j].x * v[j].x + v[j].y * v[j].y) + (v[j].z * v[j].z + v[j].w * v[j].w); }
        if (m + NGW < MT) { const GAS f32x4* xr = (const GAS f32x4*)(x + (size_t)(m + NGW) * DM) + F.lane;
#pragma unroll
            for (int j = 0; j < 8; ++j) vn[j] = __builtin_nontemporal_load(xr + 64 * j); }
        const float r = rsqrtf(wave_sum(s) * (1.f / DM) + EPS);
        GAS v2u* o8 = (GAS v2u*)(HB + (size_t)m * DM) + F.lane;
#pragma unroll
        for (int j = 0; j < 8; ++j) { const f32x4 gg = gv[j]; v2u o; o.x = pk2(v[j].x * r * gg.x, v[j].y * r * gg.y); o.y = pk2(v[j].z * r * gg.z, v[j].w * r * gg.w); o8[64 * j] = o; }
    }
    float* HID2 = (float*)(F.ws + WS_HID2);
    LAS float* sc2 = (LAS float*)(F.lds + F.wave * 16384);
    const float* w1 = F.in[8]; const float* b1 = F.in[9]; const float* w2 = F.in[10]; const float* b2 = F.in[11]; const float* fr = F.in[13];
    float w1c[FEMB], w2c[FHID];
    { const int j = F.lane;
#pragma unroll
      for (int i = 0; i < FEMB; ++i) w1c[i] = w1[i * FHID + j];
#pragma unroll
      for (int i = 0; i < FHID; ++i) w2c[i] = w2[i * FHID + j]; }
    for (int l = gw; l < SEQ; l += NGW) {
        const int j = F.lane;
        float zv = 0.f;
        if (j == 0) zv = (float)l / (float)(SEQ - 1);
        else if (j < FEMB) { const int k = (j - 1) & 15; const float f = 1e-4f + (float)k * ((15.0f - 1e-4f) / 15.0f); const float wv = 6.283185307179586f * (float)l / (float)SEQ; zv = (j <= 16) ? cosf(f * wv) : -sinf(f * wv); }
        sc2[j] = zv; LDS_WAIT(); asm volatile("" ::: "memory");
        float a = b1[j];
#pragma unroll
        for (int i = 0; i < FEMB; ++i) a += sc2[i] * w1c[i];
        const float h1 = sinf(fr[j] * a);
        sc2[64 + j] = h1; LDS_WAIT(); asm volatile("" ::: "memory");
        float c = b2[j];
#pragma unroll
        for (int i = 0; i < FHID; ++i) c += sc2[64 + i] * w2c[i];
        HID2[l * FHID + j] = sinf(fr[j] * c);
        LDS_WAIT(); asm volatile("" ::: "memory");
    }
}

typedef short bf16x8 __attribute__((ext_vector_type(8)));
typedef float f32x16 __attribute__((ext_vector_type(16)));
__device__ __forceinline__ void phase_filters(Frame& F) {
    const float* HID2 = (const float*)(F.ws + WS_HID2); const bf16* W3T = (const bf16*)(F.ws + WS_W3T); const float* fbias = F.in[14]; bf16* TAPS = (bf16*)(F.ws + WS_TAPS);
    const int n = F.lane & 31, hh = F.lane >> 5;
    const float mind = -4.605170185988091f / 1.5f, maxd = -4.605170185988091f / 0.3f;
    LAS bf16* scr = (LAS bf16*)(F.lds + F.wave * 4096);
    for (int task = GW_ID(F); task < 128 * 16; task += GW_N(F)) {
        const int l0 = (task & 127) * 32, cg = task >> 7;
        const int dir = (cg >> 2) & 1, o = cg >> 3;
        const int l = l0 + dir + n;
        bf16x8 hb[4];
        { const int lr = l < SEQ ? l : SEQ - 1;
#pragma unroll
          for (int ks = 0; ks < 4; ++ks) { const GAS f32x4* hp = (const GAS f32x4*)(HID2 + (size_t)lr * FHID + 16 * ks + 8 * hh); const f32x4 h0 = hp[0], h1 = hp[1];
              v4u bw; bw.x = pk2(h0.x, h0.y); bw.y = pk2(h0.z, h0.w); bw.z = pk2(h1.x, h1.y); bw.w = pk2(h1.z, h1.w); hb[ks] = __builtin_bit_cast(bf16x8, bw); } }
        const float dstep = (maxd - mind) * (1.f / 1023.0f);
        const float t2 = (l < SEQ) ? ((float)l / (float)(SEQ - 1)) * 1.4426950408889634f : 1e30f;
        float sstep[16];
#pragma unroll
        for (int i = 0; i < 16; ++i) sstep[i] = t2 * dstep * (float)((i & 3) + 8 * (i >> 2));
        const int pos = dir ? 31 - n : n;
        const int idx0 = dir ? 4064 - l0 : 4096 + l0;
        bf16x8 an[4];
#pragma unroll
        for (int ks = 0; ks < 4; ++ks) an[ks] = *((const GAS bf16x8*)W3T + (size_t)(cg * 8 * 4 + ks) * 64 + F.lane);
#pragma unroll 2
        for (int ct = 0; ct < 8; ++ct) {
            const int col0 = (cg * 8 + ct) * 32;
            f32x16 acc;
#pragma unroll
            for (int i = 0; i < 16; ++i) acc[i] = 0.f;
            bf16x8 ac[4];
#pragma unroll
            for (int ks = 0; ks < 4; ++ks) ac[ks] = an[ks];
            { const int coln = (cg * 8 + (ct < 7 ? ct + 1 : ct)) * 32;
#pragma unroll
              for (int ks = 0; ks < 4; ++ks) an[ks] = *((const GAS bf16x8*)W3T + (size_t)((coln >> 5) * 4 + ks) * 64 + F.lane); }
#pragma unroll
            for (int ks = 0; ks < 4; ++ks) acc = __builtin_amdgcn_mfma_f32_32x32x16_bf16(ac[ks], hb[ks], acc, 0, 0, 0);
            const float ebase = t2 * (mind + dstep * (float)((col0 & 1023) + 4 * hh));
#pragma unroll
            for (int i = 0; i < 16; ++i) {
                const int chl = (i & 3) + 8 * (i >> 2) + 4 * hh;
                const float v = acc[i] * __builtin_amdgcn_exp2f(ebase + sstep[i]);
                scr[chl * 40 + pos] = (bf16)pg8::cvt_pk_bf16(v, 0.f);
            }
            LDS_WAIT(); asm volatile("" ::: "memory");
#pragma unroll
            for (int j = 0; j < 2; ++j) { const int id = F.lane + 64 * j, chl = id >> 2, q = id & 3;
                const v4u w = *(const LAS v4u*)(scr + chl * 40 + 8 * q);
                *(GAS v4u*)(TAPS + ((size_t)((col0 & 1023) + chl) * 2 + o) * 8192 + idx0 + 8 * q) = w; }
            LDS_WAIT(); asm volatile("" ::: "memory");
        }
    }
}

constexpr int HY_TAPS_BYTES = 4 * 16384, HY_ZB_ENT = 6080, HY_ZB_BYTES = 12288;
__device__ __forceinline__ unsigned hy_zb_off(int idx0  ) { const int q = idx0 >> 3; return (unsigned)((q ^ ((q >> 4) & 3)) << 4); }
__device__ __forceinline__ const LAS unsigned char* hy_pm(const LAS unsigned char* zbl  , int g, int ip, int hh) {
    const int q0 = 124 - 4 * ip + 2 * g + hh;
    unsigned p = (unsigned)(size_t)zbl + (unsigned)(((q0 ^ ((q0 >> 4) & 3)) << 4) - 7168);
    asm volatile("" : "+v"(p));
    return (const LAS unsigned char*)(size_t)p;
}
template <int MASK>
__device__ __forceinline__ void hy_loadB(bf16x8 (&bf)[8], const LAS unsigned char* pm) {
#pragma unroll
    for (int tau = 0; tau < 8; ++tau) if (MASK & (1 << tau)) bf[tau] = *(const LAS bf16x8*)(pm + 1024 * (7 - tau));
}
typedef unsigned hy_u2a4 __attribute__((ext_vector_type(2), aligned(4)));
__device__ __forceinline__ void hy_loadA(unsigned (&d)[5], const LAS bf16* taps, int g, int n, int hh) {
    const volatile LAS unsigned* dp = (const volatile LAS unsigned*)taps + ((1 + 8 * hh + n) >> 1) + 8 * g;
    const hy_u2a4 p01 = *(const volatile LAS hy_u2a4*)dp, p23 = *(const volatile LAS hy_u2a4*)(dp + 2);
    d[0] = p01.x; d[1] = p01.y; d[2] = p23.x; d[3] = p23.y; d[4] = dp[4];
}
template <int MASK>
__device__ __forceinline__ void hy_mma(f32x16 (&acc)[8], const bf16x8 a, const bf16x8 (&bf)[8]) {
#pragma unroll
    for (int tau = 0; tau < 8; ++tau) if (MASK & (1 << tau)) acc[tau] = __builtin_amdgcn_mfma_f32_32x32x16_bf16(a, bf[tau], acc[tau], 0, 0, 0);
}
#define HY_ALIGN(a, d) do { v4u aw_; aw_.x = __builtin_amdgcn_alignbyte(d[1], d[0], sh); aw_.y = __builtin_amdgcn_alignbyte(d[2], d[1], sh); aw_.z = __builtin_amdgcn_alignbyte(d[3], d[2], sh); aw_.w = __builtin_amdgcn_alignbyte(d[4], d[3], sh); a = __builtin_bit_cast(bf16x8, aw_); } while (0)
#define HY_INTERLEAVE() do { __builtin_amdgcn_sched_group_barrier(0x2, 4, 0); _Pragma("unroll") for (int i_ = 0; i_ < 9; ++i_) { __builtin_amdgcn_sched_group_barrier(0x8, 1, 0); __builtin_amdgcn_sched_group_barrier(0x100, 3, 0); __builtin_amdgcn_sched_group_barrier(0x2, 3, 0); } } while (0)
constexpr int HY_YOFF = 254;
template <int MASK>
__device__ __forceinline__ void hy_mma_reload(f32x16 (&acc)[8], const bf16x8 a, bf16x8 (&bf)[8], const LAS unsigned char* pm_next) {
#pragma unroll
    for (int tau = 0; tau < 8; ++tau) if (MASK & (1 << tau)) {
        acc[tau] = __builtin_amdgcn_mfma_f32_32x32x16_bf16(a, bf[tau], acc[tau], 0, 0, 0);
        bf[tau] = *(const LAS bf16x8*)(pm_next + 1024 * (7 - tau));
    }
}
template <int MX, int MY>
__device__ __forceinline__ void hy_segment(f32x16 (&acc)[8], const LAS bf16* taps, const LAS unsigned char* zbl, int i0, int i1, int n, int hh) {
    const unsigned sh = (n & 1) ? 0u : 2u;
    const int ip = n & 15;
    unsigned dx[5], dy[5]; bf16x8 a, x0[8], y0[8];
    hy_loadA(dx, taps, i0, n, hh); hy_loadA(dy, taps, i0 + HY_YOFF, n, hh); hy_loadB<MX>(x0, hy_pm(zbl, i0, ip, hh)); hy_loadB<MY>(y0, hy_pm(zbl, i0 + HY_YOFF, ip, hh));
    asm volatile(".p2align 6");
#pragma unroll 1
    for (int i = i0; i < i1; ++i) {
        if (MX) { HY_ALIGN(a, dx); hy_loadA(dx, taps, i + 1, n, hh); hy_mma_reload<MX>(acc, a, x0, hy_pm(zbl, i + 1, ip, hh)); }
        HY_ALIGN(a, dy); hy_loadA(dy, taps, i + 1 + HY_YOFF, n, hh); hy_mma_reload<MY>(acc, a, y0, hy_pm(zbl, i + 1 + HY_YOFF, ip, hh));
        HY_INTERLEAVE(); __builtin_amdgcn_sched_barrier(0);
    }
}
__device__ __forceinline__ void hy_taps_load(Frame& F, int c0, int o, v4u (&t)[8], float (&fb)[8]) {
    const bf16* TAPS = (const bf16*)(F.ws + WS_TAPS);
    int tid = F.tid; asm volatile("" : "+v"(tid));
#pragma unroll
    for (int j = 0; j < 8; ++j) { const int ch = tid + NTHREADS * j, ci = ch >> 10, w = ch & 1023;
        t[j] = __builtin_nontemporal_load((const GAS v4u*)(TAPS + ((size_t)(c0 + ci) * 2 + o) * 8192) + w);
        fb[j] = F.in[14][o * 1024 + c0 + ci]; }
}
__device__ __forceinline__ void hy_taps_store(Frame& F, v4u (&t)[8], const float (&fb)[8]) {
    int tid = F.tid; asm volatile("" : "+v"(tid));
#pragma unroll
    for (int j = 0; j < 8; ++j) { const int ch = tid + NTHREADS * j, w = ch & 1023;
        const unsigned patched = (t[j].x & 0xffff0000u) | f2bf(bflo(t[j].x) + fb[j]);
        t[j].x = (w == 512) ? patched : t[j].x;
        *((LAS v4u*)(F.lds) + ch) = t[j]; }
}
__device__ __forceinline__ void hy_taps_load16(Frame& F, int c0, int o, v4u (&t)[16], float (&fb)[4]) {
    const bf16* TAPS = (const bf16*)(F.ws + WS_TAPS);
    int ht = F.tid - 256; asm volatile("" : "+v"(ht));
#pragma unroll
    for (int q = 0; q < 4; ++q) fb[q] = F.in[14][o * 1024 + c0 + q];
#pragma unroll
    for (int j = 0; j < 16; ++j) { const int ch = ht + 256 * j, ci = ch >> 10, w = ch & 1023;
        t[j] = __builtin_nontemporal_load((const GAS v4u*)(TAPS + ((size_t)(c0 + ci) * 2 + o) * 8192) + w); }
}
__device__ __forceinline__ void hy_taps_store16(Frame& F, v4u (&t)[16], const float (&fb)[4]) {
    int ht = F.tid - 256; asm volatile("" : "+v"(ht));
#pragma unroll
    for (int j = 0; j < 16; ++j) { const int ch = ht + 256 * j, w = ch & 1023;
        const unsigned patched = (t[j].x & 0xffff0000u) | f2bf(bflo(t[j].x) + fb[j >> 2]);
        t[j].x = (w == 512) ? patched : t[j].x;
        *((LAS v4u*)(F.lds) + ch) = t[j]; }
}
__device__ __forceinline__ void hy_stage_taps(Frame& F, int c0, int o) {
    const bf16* TAPS = (const bf16*)(F.ws + WS_TAPS);
    int tid = F.tid; asm volatile("" : "+v"(tid));
    v4u t[8]; float fb[8];
#pragma unroll
    for (int j = 0; j < 8; ++j) { const int ch = tid + NTHREADS * j, ci = ch >> 10, w = ch & 1023;
        t[j] = __builtin_nontemporal_load((const GAS v4u*)(TAPS + ((size_t)(c0 + ci) * 2 + o) * 8192) + w);
        fb[j] = F.in[14][o * 1024 + c0 + ci]; }
#pragma unroll
    for (int j = 0; j < 8; ++j) { const int ch = tid + NTHREADS * j, w = ch & 1023;
        const unsigned patched = (t[j].x & 0xffff0000u) | f2bf(bflo(t[j].x) + fb[j]);
        t[j].x = (w == 512) ? patched : t[j].x;
        *((LAS v4u*)(F.lds) + ch) = t[j]; }
}
constexpr int MOE_ITEMS_GU = 2 * NE * 32 * 16, MOE_ITEMS_D = NE * 16 * 32, MOE_ITEMS = MOE_ITEMS_GU + MOE_ITEMS_D;
#ifndef MOE_P0_ITEMS
#define MOE_P0_ITEMS 0
#endif
#ifndef MOE_P4_ITEMS
#define MOE_P4_ITEMS 3584
#endif
constexpr int MOE_HELP_ITEMS = MOE_ITEMS - MOE_P0_ITEMS - MOE_P4_ITEMS;
__device__ __forceinline__ ConvItem moe_item(Frame& F, int it) {
    bf16* WguT = (bf16*)(F.ws + WS_WGU); bf16* WdT = (bf16*)(F.ws + WS_WD); ConvItem c; c.bN = 2048;
    if (it < MOE_ITEMS_GU) { const int which = it >> 13, e = (it >> 9) & 15, kb = (it >> 4) & 31, nb = it & 15, f0 = 64 * nb;
        c.W = (which ? F.in[21] : F.in[20]) + (size_t)e * DM * FF; c.N = FF; c.WTe = WguT + (size_t)e * 2048 * DM; c.row_base = (f0 >> 7) * 256 + which * 128 + (f0 & 127); c.k0 = 64 * kb; c.n0 = f0;
    } else { const int r = it - MOE_ITEMS_GU, e = r >> 9, kb = (r >> 5) & 15, nb = r & 31;
        c.W = F.in[22] + (size_t)e * FF * DM; c.N = DM; c.WTe = WdT + (size_t)e * 2048 * FF; c.row_base = 64 * nb; c.k0 = 64 * kb; c.n0 = 64 * nb; }
    return c;
}
__device__ __forceinline__ void conv_range_moe_tail(Frame& F);
__device__ __forceinline__ void moe_conv_item(Frame& F, int it) { float v[64]; const ConvItem c = moe_item(F, it); conv_load64(v, c, F.lane); conv_store64<true>(v, c, F.lane); }
__device__ __forceinline__ void moe_conv_range(Frame& F, int lo, int hi, int step) {
    if (lo >= hi) return;
    float va[64], vb[64], vc[64];
    ConvItem ca = moe_item(F, lo), cb_ = ca, cc_ = ca; conv_load64(va, ca, F.lane);
    if (lo + step < hi) { cb_ = moe_item(F, lo + step); conv_load64(vb, cb_, F.lane); }
    for (int it = lo; it < hi; it += 3 * step) {
        const bool hb = it + step < hi, hc = it + 2 * step < hi;
        if (hc) { cc_ = moe_item(F, it + 2 * step); conv_load64(vc, cc_, F.lane); }
        conv_store64<true>(va, ca, F.lane);
        if (it + 3 * step < hi) { ca = moe_item(F, it + 3 * step); conv_load64(va, ca, F.lane); }
        if (hb) conv_store64<true>(vb, cb_, F.lane);
        if (it + 4 * step < hi) { cb_ = moe_item(F, it + 4 * step); conv_load64(vb, cb_, F.lane); }
        if (hc) conv_store64<true>(vc, cc_, F.lane);
    }
}
__device__ __forceinline__ void conv_range_moe_tail(Frame& F) {
    const int w = (F.bid - NB * NE) * NWAVES + F.wave, nw = (F.G - NB * NE) * NWAVES;
    moe_conv_range(F, MOE_ITEMS - MOE_P4_ITEMS + w, MOE_ITEMS, nw);
}
__device__ __forceinline__ void hy_write_gates(Frame& F, int c0, int oo) {
    const bf16* XH = (const bf16*)(F.ws + WS_XT) + (size_t)1024 * MT; bf16* GC = (bf16*)(F.ws + WS_UC);
    const float* cw = F.in[6]; const float* cb = F.in[7];
    int ht = F.tid - 256; asm volatile("" : "+v"(ht));
#pragma unroll 1
    for (int kb = 0; kb < 16; kb += 4) {
        v4u wv[4]; unsigned short lf[4], rt_[4]; float c0w[4], c1w[4], c2w[4], cbb[4];
#pragma unroll
        for (int q = 0; q < 4; ++q) { const int id = ht + 256 * (kb + q), u = id & 511, b = (id >> 9) & 1, ci = id >> 10;
            const int gch = oo * 1024 + c0 + ci; const bf16* gs = XH + (size_t)gch * MT + b * SEQ;
            c0w[q] = cw[gch]; c1w[q] = cw[3072 + gch]; c2w[q] = cw[6144 + gch]; cbb[q] = cb[gch];
            wv[q] = __builtin_nontemporal_load((const GAS v4u*)gs + u);
            lf[q] = gs[u > 0 ? 8 * u - 1 : 0]; rt_[q] = gs[u < 511 ? 8 * u + 8 : 8 * u + 7]; }
#pragma unroll
        for (int q = 0; q < 4; ++q) { const int id = ht + 256 * (kb + q), u = id & 511, b = (id >> 9) & 1, ci = id >> 10;
            const v4u w = wv[q]; const float w0 = c0w[q], w1 = c1w[q], w2 = c2w[q], bb = cbb[q];
            float f[10];
            f[1] = bflo(w.x); f[2] = bfhi(w.x); f[3] = bflo(w.y); f[4] = bfhi(w.y); f[5] = bflo(w.z); f[6] = bfhi(w.z); f[7] = bflo(w.w); f[8] = bfhi(w.w);
            f[0] = u > 0 ? bf2f(lf[q]) : 0.f; f[9] = u < 511 ? bf2f(rt_[q]) : 0.f;
            float z[8];
#pragma unroll
            for (int e = 0; e < 8; ++e) z[e] = bb + w0 * f[e] + w1 * f[e + 1] + w2 * f[e + 2];
            v4u r; r.x = pk2(z[0], z[1]); r.y = pk2(z[2], z[3]); r.z = pk2(z[4], z[5]); r.w = pk2(z[6], z[7]);
            *((GAS v4u*)(GC + ((size_t)((c0 + ci) * 2 + oo) * 2 + b) * SEQ) + u) = r; }
    }
}
__device__ __forceinline__ void phase_hyena(Frame& F) {
    const bf16* XH = (const bf16*)(F.ws + WS_XT) + (size_t)1024 * MT;
    const float* cw = F.in[6]; const float* cb = F.in[7];
    bf16* HYT = (bf16*)(F.ws + WS_HYT); bf16* GC = (bf16*)(F.ws + WS_UC);
    const int n = F.lane & 31, hh = F.lane >> 5;
    const bool compute = F.wave < 4;
    const int nhelp = F.G * 4, hw = F.bid * 4 + (F.wave - 4);
    int sec = 0;
    for (int cg = F.bid; cg < 256; cg += F.G) {
        const int c0 = cg * 4;
        __syncthreads();
        {
          v4u tt[8]; float tfb[8]; hy_taps_load(F, c0, 0, tt, tfb);
          int lane_ = F.lane; asm volatile("" : "+v"(lane_));
          const int ci = F.wave >> 1, b = F.wave & 1; LAS unsigned char* zb = F.lds + HY_TAPS_BYTES + F.wave * HY_ZB_BYTES;
          const int zch = 2048 + c0 + ci; const bf16* zsrc = XH + (size_t)zch * MT + b * SEQ;
          const float w0 = cw[zch], w1 = cw[3072 + zch], w2 = cw[6144 + zch], bb = cb[zch];
          v4u wv[8]; unsigned short lf[8], rt_[8];
#pragma unroll
          for (int j = 0; j < 8; ++j) { const int u = lane_ + 64 * j; wv[j] = __builtin_nontemporal_load((const GAS v4u*)zsrc + u);
              lf[j] = zsrc[u > 0 ? 8 * u - 1 : 0]; rt_[j] = zsrc[u < 511 ? 8 * u + 8 : 8 * u + 7]; }
          int tg = F.tid; asm volatile("" : "+v"(tg));
          v4u gv_[8]; unsigned short gl_[8], gr_[8]; float g0_[4], g1_[4], g2_[4], gb_[4];
#pragma unroll
          for (int q = 0; q < 4; ++q) { const int gch = c0 + q; g0_[q] = cw[gch]; g1_[q] = cw[3072 + gch]; g2_[q] = cw[6144 + gch]; gb_[q] = cb[gch]; }
#pragma unroll
          for (int k = 0; k < 8; ++k) { const int id = tg + NTHREADS * k, u = id & 511, bq = (id >> 9) & 1, cq = id >> 10;
              const int gch = c0 + cq; const bf16* gs = XH + (size_t)gch * MT + bq * SEQ;
              gv_[k] = __builtin_nontemporal_load((const GAS v4u*)gs + u);
              gl_[k] = gs[u > 0 ? 8 * u - 1 : 0]; gr_[k] = gs[u < 511 ? 8 * u + 8 : 8 * u + 7]; }
          hy_taps_store(F, tt, tfb);
#pragma unroll
          for (int j = 0; j < 8; ++j) { const int u = lane_ + 64 * j; const v4u w = wv[j];
              float f[10];
              f[1] = bflo(w.x); f[2] = bfhi(w.x); f[3] = bflo(w.y); f[4] = bfhi(w.y); f[5] = bflo(w.z); f[6] = bfhi(w.z); f[7] = bflo(w.w); f[8] = bfhi(w.w);
              f[0] = u > 0 ? bf2f(lf[j]) : 0.f; f[9] = u < 511 ? bf2f(rt_[j]) : 0.f;
              float z[8];
#pragma unroll
              for (int e = 0; e < 8; ++e) z[e] = bb + w0 * f[e] + w1 * f[e + 1] + w2 * f[e + 2];
              v4u r; r.x = pk2(z[7], z[6]); r.y = pk2(z[5], z[4]); r.z = pk2(z[3], z[2]); r.w = pk2(z[1], z[0]);
              *(LAS v4u*)(zb + hy_zb_off(8 * (635 - u))) = r; }
          const v4u zero = {0u, 0u, 0u, 0u};
          for (int q = lane_; q < 124; q += 64) { *(LAS v4u*)(zb + hy_zb_off(8 * q)) = zero; *(LAS v4u*)(zb + hy_zb_off(8 * (636 + q))) = zero; }
#pragma unroll
          for (int k = 0; k < 8; ++k) { const int id = tg + NTHREADS * k, u = id & 511, bq = (id >> 9) & 1, cq = id >> 10; const v4u w = gv_[k];
              float f[10];
              f[1] = bflo(w.x); f[2] = bfhi(w.x); f[3] = bflo(w.y); f[4] = bfhi(w.y); f[5] = bflo(w.z); f[6] = bfhi(w.z); f[7] = bflo(w.w); f[8] = bfhi(w.w);
              f[0] = u > 0 ? bf2f(gl_[k]) : 0.f; f[9] = u < 511 ? bf2f(gr_[k]) : 0.f;
              float z[8];
#pragma unroll
              for (int e = 0; e < 8; ++e) z[e] = gb_[k >> 1] + g0_[k >> 1] * f[e] + g1_[k >> 1] * f[e + 1] + g2_[k >> 1] * f[e + 2];
              v4u r; r.x = pk2(z[0], z[1]); r.y = pk2(z[2], z[3]); r.z = pk2(z[4], z[5]); r.w = pk2(z[6], z[7]);
              *((GAS v4u*)(GC + ((size_t)((c0 + cq) * 2 + 0) * 2 + bq) * SEQ) + u) = r; } }
        __syncthreads();
#pragma unroll 1
        for (int o = 0; o < 2; ++o) {
            if (compute) {
                const int ci = F.wave, c = c0 + ci;
                const LAS bf16* taps = (const LAS bf16*)(F.lds + ci * 16384);
                const int ip = n & 15, bl = n >> 4;
                LAS unsigned char* zbl = F.lds + HY_TAPS_BYTES + (2 * ci + bl) * HY_ZB_BYTES;
                f32x16 acc[8];
#pragma unroll
                for (int tau = 0; tau < 8; ++tau)
#pragma unroll
                    for (int i = 0; i < 16; ++i) acc[tau][i] = 0.f;
                hy_segment<0x01, 0xFF>(acc, taps, zbl, 0, 32, n, hh);
                hy_segment<0x03, 0xFE>(acc, taps, zbl, 32, 64, n, hh);
                hy_segment<0x07, 0xFC>(acc, taps, zbl, 64, 96, n, hh);
                hy_segment<0x0F, 0xF8>(acc, taps, zbl, 96, 128, n, hh);
                hy_segment<0x1F, 0xF0>(acc, taps, zbl, 128, 160, n, hh);
                hy_segment<0x3F, 0xE0>(acc, taps, zbl, 160, 192, n, hh);
                hy_segment<0x7F, 0xC0>(acc, taps, zbl, 192, 224, n, hh);
                hy_segment<0xFF, 0x80>(acc, taps, zbl, 224, 254, n, hh);
                int ip2 = ip, h2 = hh, b2 = bl; asm volatile("" : "+v"(ip2), "+v"(h2), "+v"(b2));
                const bf16* gate = GC + ((size_t)(c * 2 + o) * 2 + b2) * SEQ;
                v2u gwa[2][4][4];
#pragma unroll
                for (int tq = 0; tq < 4; ++tq)
#pragma unroll
                    for (int rg = 0; rg < 4; ++rg) gwa[0][tq][rg] = *(const GAS v2u*)(gate + 512 * tq + 32 * ip2 + 8 * rg + 4 * h2);
                hy_segment<0x00, 0x80>(acc, taps, zbl, 254, 256, n, hh);
#pragma unroll
                for (int tq = 0; tq < 4; ++tq)
#pragma unroll
                    for (int rg = 0; rg < 4; ++rg) gwa[1][tq][rg] = *(const GAS v2u*)(gate + 512 * (4 + tq) + 32 * ip2 + 8 * rg + 4 * h2);
                LDS_WAIT();
                {
                    LAS unsigned char* zb = F.lds + HY_TAPS_BYTES + (2 * ci + b2) * HY_ZB_BYTES; bf16* outp = HYT + (size_t)c * MT + b2 * SEQ;
#pragma unroll
                    for (int th = 0; th < 2; ++th) {
                        const v2u (&gw)[4][4] = gwa[th];
#pragma unroll
                        for (int tq = 0; tq < 4; ++tq) {
#pragma unroll
                            for (int rg = 0; rg < 4; ++rg) { const int tau = 4 * th + tq, t0 = 512 * tau + 32 * ip2 + 8 * rg + 4 * h2;
                                const float z0 = bflo(gw[tq][rg].x) * acc[tau][4 * rg + 0], z1 = bfhi(gw[tq][rg].x) * acc[tau][4 * rg + 1], z2 = bflo(gw[tq][rg].y) * acc[tau][4 * rg + 2], z3 = bfhi(gw[tq][rg].y) * acc[tau][4 * rg + 3];
                                if (o == 0) { v2u w; w.x = pk2(z3, z2); w.y = pk2(z1, z0);
                                    *(LAS v2u*)(zb + hy_zb_off(8 * (635 - (t0 >> 3))) + (h2 ? 0 : 8)) = w; }
                                else { v2u w; w.x = pk2(z0, z1); w.y = pk2(z2, z3); *(GAS v2u*)(outp + t0) = w; } } }
                    }
                }
            } else {
                if (o == 0) hy_write_gates(F, c0, 1);
                const int lo_it = MOE_P0_ITEMS + sec * (MOE_HELP_ITEMS / 2), hi_it = lo_it + MOE_HELP_ITEMS / 2;
                if (sec < 2) moe_conv_range(F, lo_it + hw, hi_it, nhelp);
            }
            ++sec;
            if (o == 0) {
                v4u tt1[8]; float tfb1[8];
                hy_taps_load(F, c0, 1, tt1, tfb1);
                __syncthreads();
                hy_taps_store(F, tt1, tfb1);
                __syncthreads();
            }
        }
    }
    for (; sec < 2; ++sec) if (!compute) { const int lo_it = MOE_P0_ITEMS + sec * (MOE_HELP_ITEMS / 2), hi_it = lo_it + MOE_HELP_ITEMS / 2; moe_conv_range(F, lo_it + hw, hi_it, nhelp); }
    __syncthreads();
}

constexpr int AT_KBYTES = 16384, AT_VPITCH = 136, AT_VBYTES = 128 * AT_VPITCH, AT_STAGE = AT_KBYTES + AT_VBYTES, AT_RP_OFF = 2 * AT_STAGE;
__device__ __forceinline__ void phase_attn2(Frame& F) {
    const bf16* QK = (const bf16*)(F.ws + WS_QK); const bf16* VT = (const bf16*)(F.ws + WS_XT); bf16* MIXED = (bf16*)(F.ws + WS_MIXED);
    const float* rpb = F.in[5]; const float* og = F.in[15]; const float* qg = F.in[3]; const float* kg = F.in[4];
    LAS float* rt = (LAS float*)(F.lds + AT_RP_OFF);
    LAS float* gtab = (LAS float*)(F.lds + AT_RP_OFF + 8 * 2048);
    LAS float* ogt = gtab + HD;
    if (F.tid < HD) gtab[F.tid] = qg[F.tid] * kg[F.tid];
    const int n = F.lane & 31, hh = F.lane >> 5;
    for (int unit = F.bid; unit < NB * NH * 16; unit += F.G) {
        const int rq = unit & 15, h = (unit >> 4) & 7, b = unit >> 7, r0 = 4 * rq;
        const int r = r0 + (F.wave >> 1), wq = F.wave & 1;
        int kmin = r0 - WR / 2; kmin = kmin < 0 ? 0 : (kmin > NROWS - WR ? NROWS - WR : kmin);
        int kmax = r0 + 3 - WR / 2; kmax = (kmax < 0 ? 0 : (kmax > NROWS - WR ? NROWS - WR : kmax)) + WR - 1;
        int kr0 = r - WR / 2; kr0 = kr0 < 0 ? 0 : (kr0 > NROWS - WR ? NROWS - WR : kr0);
        const int nrows = kmax - kmin + 1;
        __syncthreads();
        const int mq = b * SEQ + r * GW + 32 * wq + n, qc = 32 * wq + n;
        int c0 = qc - WC / 2; c0 = c0 < 0 ? 0 : (c0 > GW - WC ? GW - WC : c0);
        bf16x8 qf[8];
#pragma unroll
        for (int ks = 0; ks < 8; ++ks) qf[ks] = *(const GAS bf16x8*)(QK + (size_t)mq * 2048 + h * HD + 16 * ks + 8 * hh);
        { const float ogv = og[h * HD + (F.tid & (HD - 1))];
          float rv[4];
#pragma unroll
          for (int k_ = 0; k_ < 4; ++k_) { const int i0 = F.tid + NTHREADS * k_, i = i0 < 15 * 128 ? i0 : 15 * 128 - 1; const int dr_ = i >> 7, dcx = (i & 127) - 48, dcc = dcx < 0 ? 0 : (dcx > 30 ? 30 : dcx);
              rv[k_] = rpb[h * 465 + dr_ * 31 + dcc]; }
          if (F.tid < HD) ogt[F.tid] = ogv;
#pragma unroll
          for (int k_ = 0; k_ < 4; ++k_) { const int i = F.tid + NTHREADS * k_; const int dcx = (i & 127) - 48;
              if (i < 15 * 128) rt[i] = (dcx >= 0 && dcx <= 30) ? rv[k_] * 1.4426950408889634f : 0.f; } }
        float qscale;
        {
          f32x16 D;
#pragma unroll
          for (int i = 0; i < 16; ++i) D[i] = 0.f;
#pragma unroll
          for (int ks = 0; ks < 8; ++ks) D = __builtin_amdgcn_mfma_f32_32x32x16_bf16(qf[ks], qf[ks], D, 0, 0, 0);
          float dsel = 0.f; const int isel = (n & 3) + 4 * (n >> 3);
#pragma unroll
          for (int i = 0; i < 16; ++i) dsel = (i == isel) ? D[i] : dsel;
          const float other = __shfl_xor(dsel, 32);
          const float ssq = (((n >> 2) & 1) == hh) ? dsel : other;
          qscale = (0.08838834764831845f * 1.4426950408889634f) * rsqrtf(ssq * (1.f / HD) + EPS); }
        const unsigned long long wmask = (c0 >= 4 * hh) ? (0xFFFFull << (c0 - 4 * hh)) : (0xFFFFull >> (4 * hh - c0));
        const unsigned wm0 = (unsigned)wmask, wm1 = (unsigned)(wmask >> 32);
        const int rtl = 4 * hh - qc + 63;
        f32x16 O[4];
#pragma unroll
        for (int dt = 0; dt < 4; ++dt)
#pragma unroll
            for (int i = 0; i < 16; ++i) O[dt][i] = 0.f;
        float lsum = 0.f;
        v4u sk[2], sv[2];

        auto gload = [&](int kr) {
#pragma unroll
            for (int j = 0; j < 2; ++j) { const int id = F.tid + 512 * j;
                sk[j] = *(const GAS v4u*)(QK + (size_t)(b * SEQ + kr * GW + (id >> 4)) * 2048 + 1024 + h * HD + 8 * (id & 15));
                sv[j] = *(const GAS v4u*)(VT + (size_t)(h * HD + (id >> 3)) * MT + b * SEQ + kr * GW + 8 * (id & 7)); }
        };
        auto lstore = [&](int buf) {
            LAS unsigned char* kb = F.lds + buf * AT_STAGE; LAS unsigned char* vb = kb + AT_KBYTES;
#pragma unroll
            for (int j = 0; j < 2; ++j) { const int id = F.tid + 512 * j; const int key = id >> 4, c = id & 15;
                float f[8] = {bflo(sk[j].x), bfhi(sk[j].x), bflo(sk[j].y), bfhi(sk[j].y), bflo(sk[j].z), bfhi(sk[j].z), bflo(sk[j].w), bfhi(sk[j].w)};
                float ss = 0.f;
#pragma unroll
                for (int e = 0; e < 8; ++e) ss += f[e] * f[e];
                ss = row16_sum(ss);
                const float rk = rsqrtf(ss * (1.f / HD) + EPS);
                const f32x4 ga = *(const LAS f32x4*)(gtab + 8 * c), gb = *(const LAS f32x4*)(gtab + 8 * c + 4);
                v4u kn; kn.x = pk2(f[0] * rk * ga.x, f[1] * rk * ga.y); kn.y = pk2(f[2] * rk * ga.z, f[3] * rk * ga.w); kn.z = pk2(f[4] * rk * gb.x, f[5] * rk * gb.y); kn.w = pk2(f[6] * rk * gb.z, f[7] * rk * gb.w);
                *(LAS v4u*)(kb + key * 256 + ((c ^ (key & 15)) << 4)) = kn;
                const int d = id >> 3, cv = id & 7; LAS v2u* vp = (LAS v2u*)(vb + d * AT_VPITCH + cv * 16);
                v2u lo, hi; lo.x = sv[j].x; lo.y = sv[j].y; hi.x = sv[j].z; hi.y = sv[j].w; vp[0] = lo; vp[1] = hi; }
        };
        gload(kmin); lstore(0);
        __syncthreads();
#pragma unroll 1
        for (int j = 0; j < nrows; ++j) {
            const int kr = kmin + j, buf = j & 1;
            if (j + 1 < nrows) gload(kr + 1);
            int n_ = n, hh_ = hh; asm volatile("" : "+v"(n_), "+v"(hh_));
            if (kr >= kr0 && kr < kr0 + WR) {
                const LAS unsigned char* kb = F.lds + buf * AT_STAGE; const LAS unsigned char* vb = kb + AT_KBYTES;
                const int dr = kr - r + WR - 1;
                const LAS float* rrow = rt + dr * 128 + (4 * hh_ - (32 * wq + n_) + 63);
                {
                    const int kt = wq;
                    f32x16 S;
#pragma unroll
                    for (int i = 0; i < 16; ++i) S[i] = 0.f;
                    const int key = 32 * kt + n_;
                    bf16x8 kf[8]; float bia[16];
#pragma unroll
                    for (int ks = 0; ks < 8; ++ks) kf[ks] = *(const LAS bf16x8*)(kb + key * 256 + (((2 * ks + hh_) ^ (key & 15)) << 4));
                    __builtin_amdgcn_sched_barrier(0);
#pragma unroll
                    for (int ks = 0; ks < 8; ++ks) S = __builtin_amdgcn_mfma_f32_32x32x16_bf16(kf[ks], qf[ks], S, 0, 0, 0);
                    const LAS float* rk_ = rrow + 32 * kt;
#pragma unroll
                    for (int i = 0; i < 16; ++i) bia[i] = rk_[(i & 3) + 8 * (i >> 2)];
                    v2u va[4][4];
#pragma unroll
                    for (int dt = 0; dt < 4; ++dt) { const LAS unsigned char* vrow = vb + (32 * dt + n_) * AT_VPITCH + (32 * kt + 4 * hh_) * 2;
#pragma unroll
                        for (int q = 0; q < 4; ++q) va[dt][q] = *(const LAS v2u*)(vrow + 16 * q); }
                    __builtin_amdgcn_sched_barrier(0);
                    const unsigned wmk = kt ? wm1 : wm0;
                    float p[16];
#pragma unroll
                    for (int i = 0; i < 16; ++i) { const int E = (i & 3) + 8 * (i >> 2);
                        const float e = __builtin_amdgcn_exp2f(S[i] * qscale + bia[i]);
                        const unsigned keep = (unsigned)__builtin_amdgcn_sbfe((int)wmk, E, 1);
                        p[i] = __builtin_bit_cast(float, __builtin_bit_cast(unsigned, e) & keep); lsum += p[i]; }
                    v4u pw0, pw1;
                    pw0.x = pk2(p[0], p[1]); pw0.y = pk2(p[2], p[3]); pw0.z = pk2(p[4], p[5]); pw0.w = pk2(p[6], p[7]);
                    pw1.x = pk2(p[8], p[9]); pw1.y = pk2(p[10], p[11]); pw1.z = pk2(p[12], p[13]); pw1.w = pk2(p[14], p[15]);
                    const bf16x8 pf0 = __builtin_bit_cast(bf16x8, pw0), pf1 = __builtin_bit_cast(bf16x8, pw1);
#pragma unroll
                    for (int dt = 0; dt < 4; ++dt) {
                        const v2u a0 = va[dt][0], a1 = va[dt][1], a2 = va[dt][2], a3 = va[dt][3];
                        v4u f0, f1; f0.x = a0.x; f0.y = a0.y; f0.z = a1.x; f0.w = a1.y; f1.x = a2.x; f1.y = a2.y; f1.z = a3.x; f1.w = a3.y;
                        O[dt] = __builtin_amdgcn_mfma_f32_32x32x16_bf16(__builtin_bit_cast(bf16x8, f0), pf0, O[dt], 0, 0, 0);
                        O[dt] = __builtin_amdgcn_mfma_f32_32x32x16_bf16(__builtin_bit_cast(bf16x8, f1), pf1, O[dt], 0, 0, 0);
                    }
                }
                {
                    const int kt = 1 - wq, Eb = wq ? 24 : 0;
                    f32x16 S;
#pragma unroll
                    for (int i = 0; i < 16; ++i) S[i] = 0.f;
                    const int key = 32 * kt + n_;
                    bf16x8 kf[8];
#pragma unroll
                    for (int ks = 0; ks < 8; ++ks) kf[ks] = *(const LAS bf16x8*)(kb + key * 256 + (((2 * ks + hh_) ^ (key & 15)) << 4));
                    __builtin_amdgcn_sched_barrier(0);
#pragma unroll
                    for (int ks = 0; ks < 8; ++ks) S = __builtin_amdgcn_mfma_f32_32x32x16_bf16(kf[ks], qf[ks], S, 0, 0, 0);
                    const LAS float* rk_ = rrow + 32 * kt + Eb;
                    float bia[4];
#pragma unroll
                    for (int i = 0; i < 4; ++i) bia[i] = rk_[i];
                    v2u va[4][2];
#pragma unroll
                    for (int dt = 0; dt < 4; ++dt) { const LAS unsigned char* vrow = vb + (32 * dt + n_) * AT_VPITCH + (32 * kt + 4 * hh_) * 2 + 32 * wq;
#pragma unroll
                        for (int q = 0; q < 2; ++q) va[dt][q] = *(const LAS v2u*)(vrow + 16 * q); }
                    __builtin_amdgcn_sched_barrier(0);
                    const unsigned wmk = kt ? wm1 : wm0;
                    float p[4];
#pragma unroll
                    for (int i = 0; i < 4; ++i) { const float s_ = wq ? S[12 + i] : S[i];
                        const float e = __builtin_amdgcn_exp2f(s_ * qscale + bia[i]);
                        const unsigned keep = (unsigned)__builtin_amdgcn_sbfe((int)(wmk >> Eb), i, 1);
                        p[i] = __builtin_bit_cast(float, __builtin_bit_cast(unsigned, e) & keep); lsum += p[i]; }
                    const unsigned pa = pk2(p[0], p[1]), pb = pk2(p[2], p[3]);
                    v4u pw; pw.x = wq ? 0u : pa; pw.y = wq ? 0u : pb; pw.z = wq ? pa : 0u; pw.w = wq ? pb : 0u;
                    const bf16x8 pf = __builtin_bit_cast(bf16x8, pw);
#pragma unroll
                    for (int dt = 0; dt < 4; ++dt) { v4u f; f.x = va[dt][0].x; f.y = va[dt][0].y; f.z = va[dt][1].x; f.w = va[dt][1].y;
                        O[dt] = __builtin_amdgcn_mfma_f32_32x32x16_bf16(__builtin_bit_cast(bf16x8, f), pf, O[dt], 0, 0, 0); }
                }
            }
            if (j + 1 < nrows) lstore(buf ^ 1);
            __syncthreads();
        }
        lsum += __shfl_xor(lsum, 32);
        const float il = 1.f / lsum;
        float ss = 0.f;
#pragma unroll
        for (int dt = 0; dt < 4; ++dt)
#pragma unroll
            for (int i = 0; i < 16; ++i) { O[dt][i] *= il; ss += O[dt][i] * O[dt][i]; }
        ss += __shfl_xor(ss, 32);
        const float rr = rsqrtf(ss * (1.f / HD) + EPS);
        bf16* orow = MIXED + (size_t)mq * DM + h * HD;
#pragma unroll
        for (int dt = 0; dt < 4; ++dt)
#pragma unroll
            for (int rg = 0; rg < 4; ++rg) { const int d = 32 * dt + 8 * rg + 4 * hh; const f32x4 gg = *(const LAS f32x4*)(ogt + d);
                v2u w; w.x = pk2(O[dt][4 * rg + 0] * rr * gg.x, O[dt][4 * rg + 1] * rr * gg.y); w.y = pk2(O[dt][4 * rg + 2] * rr * gg.z, O[dt][4 * rg + 3] * rr * gg.w);
                *(GAS v2u*)(orow + d) = w; }
    }
    __syncthreads();
}

__device__ __forceinline__ void phase_p25(Frame& F) {
    const bf16* HYT = (const bf16*)(F.ws + WS_HYT); bf16* MIXED = (bf16*)(F.ws + WS_MIXED); const float* hg = F.in[16];
    LAS float* tile = (LAS float*)F.lds;
    LAS float* rs = (LAS float*)(F.lds + 128 * 65 * 4);
    for (int it = F.bid; it < 8 * (MT / 64); it += F.G) {
        const int gi = it & 7, m0 = (it >> 3) * 64;
        { const int ch = F.tid >> 2, t0 = (F.tid & 3) * 16; const bf16* p = HYT + (size_t)(gi * 128 + ch) * MT + m0 + t0;
          const v4u a = *(const GAS v4u*)p, b = *(const GAS v4u*)(p + 8);
          LAS float* d = tile + ch * 65 + t0;
          d[0] = bflo(a.x); d[1] = bfhi(a.x); d[2] = bflo(a.y); d[3] = bfhi(a.y); d[4] = bflo(a.z); d[5] = bfhi(a.z); d[6] = bflo(a.w); d[7] = bfhi(a.w);
          d[8] = bflo(b.x); d[9] = bfhi(b.x); d[10] = bflo(b.y); d[11] = bfhi(b.y); d[12] = bflo(b.z); d[13] = bfhi(b.z); d[14] = bflo(b.w); d[15] = bfhi(b.w); }
        __syncthreads();
        {
          const int t = F.tid >> 3, c0 = (F.tid & 7) * 16; float ss = 0.f;
#pragma unroll
          for (int c = 0; c < 16; ++c) { const float v = tile[(c0 + c) * 65 + t]; ss += v * v; }
          ss += dpp_f<DPP_XOR1>(ss); ss += dpp_f<DPP_XOR2>(ss); ss += dpp_f<DPP_HMIRROR>(ss);
          if ((F.tid & 7) == 0) rs[t] = rsqrtf(ss * (1.f / 128) + EPS); }
        __syncthreads();
        {
          const int t = F.tid >> 3, c0 = (F.tid & 7) * 16; const float r = rs[t]; float o[16];
#pragma unroll
          for (int c = 0; c < 16; ++c) o[c] = tile[(c0 + c) * 65 + t] * r * hg[gi * 128 + c0 + c];
          v4u a, b; a.x = pk2(o[0], o[1]); a.y = pk2(o[2], o[3]); a.z = pk2(o[4], o[5]); a.w = pk2(o[6], o[7]); b.x = pk2(o[8], o[9]); b.y = pk2(o[10], o[11]); b.z = pk2(o[12], o[13]); b.w = pk2(o[14], o[15]);
          bf16* q = MIXED + (size_t)(m0 + t) * DM + AW + gi * 128 + c0; *(GAS v4u*)q = a; *(GAS v4u*)(q + 8) = b; }
        __syncthreads();
    }
}
__device__ __forceinline__ void phase_p35(Frame& F) {
    LAS float* wrT = (LAS float*)F.lds;
    const float* wr = F.in[19]; const float* g = F.in[18];
    constexpr int WRS = DM + 4;
    for (int i = F.tid; i < DM * NE; i += NTHREADS) { const int d = i >> 4, e = i & 15; wrT[e * WRS + d] = wr[i]; }
    __syncthreads();
    bf16* HB = (bf16*)(F.ws + WS_HB); float* AFF = (float*)(F.ws + WS_AFF); const float* x1 = F.out;
    f32x4 gv[8];
#pragma unroll
    for (int j = 0; j < 8; ++j) gv[j] = *((const GAS f32x4*)g + F.lane + 64 * j);
    f32x4 vn[8];
    { const int m0 = GW_ID(F); if (m0 < MT) { const GAS f32x4* xr = (const GAS f32x4*)(x1 + (size_t)m0 * DM) + F.lane;
#pragma unroll
        for (int j = 0; j < 8; ++j) vn[j] = __builtin_nontemporal_load(xr + 64 * j); } }
    for (int m = GW_ID(F); m < MT; m += GW_N(F)) {
        f32x4 v[8]; float s = 0.f;
#pragma unroll
        for (int j = 0; j < 8; ++j) { v[j] = vn[j]; s += (v[j].x * v[j].x + v[j].y * v[j].y) + (v[j].z * v[j].z + v[j].w * v[j].w); }
        if (m + GW_N(F) < MT) { const GAS f32x4* xr = (const GAS f32x4*)(x1 + (size_t)(m + GW_N(F)) * DM) + F.lane;
#pragma unroll
            for (int j = 0; j < 8; ++j) vn[j] = __builtin_nontemporal_load(xr + 64 * j); }
        const float r = rsqrtf(wave_sum(s) * (1.f / DM) + EPS);
        GAS v2u* o8 = (GAS v2u*)(HB + (size_t)m * DM) + F.lane;
#pragma unroll
        for (int j = 0; j < 8; ++j) { const f32x4 gg = gv[j]; v[j].x *= r * gg.x; v[j].y *= r * gg.y; v[j].z *= r * gg.z; v[j].w *= r * gg.w;
            v2u o; o.x = pk2(v[j].x, v[j].y); o.y = pk2(v[j].z, v[j].w); o8[64 * j] = o; }
        float a[NE];
        { f32x4 wA[8], wB[8];
          auto ldw = [&](f32x4 (&w)[8], int e) {
#pragma unroll
              for (int j = 0; j < 8; ++j) w[j] = *((const LAS f32x4*)(wrT + e * WRS) + F.lane + 64 * j); };
          auto dot = [&](const f32x4 (&w)[8]) { float s_ = 0.f;
#pragma unroll
              for (int j = 0; j < 8; ++j) s_ += (v[j].x * w[j].x + v[j].y * w[j].y) + (v[j].z * w[j].z + v[j].w * w[j].w);
              return s_; };
          ldw(wA, 0);
#pragma unroll
          for (int e = 0; e < NE; e += 2) {
              ldw(wB, e + 1); __builtin_amdgcn_sched_barrier(0);
              a[e] = dot(wA);
              if (e + 2 < NE) ldw(wA, e + 2);
              __builtin_amdgcn_sched_barrier(0);
              a[e + 1] = dot(wB); } }
        const bool lb0 = F.lane & 1, lb1 = F.lane & 2, lb2 = F.lane & 4, lb3 = F.lane & 8;
        float c8[8], c4[4], c2[2], mine;
#pragma unroll
        for (int j = 0; j < 8; ++j) c8[j] = (lb2 ? a[j + 8] : a[j]) + dpp_f<DPP_HMIRROR>(lb2 ? a[j] : a[j + 8]);
#pragma unroll
        for (int j = 0; j < 4; ++j) c4[j] = (lb0 ? c8[j + 4] : c8[j]) + dpp_f<DPP_XOR1>(lb0 ? c8[j] : c8[j + 4]);
#pragma unroll
        for (int j = 0; j < 2; ++j) c2[j] = (lb1 ? c4[j + 2] : c4[j]) + dpp_f<DPP_XOR2>(lb1 ? c4[j] : c4[j + 2]);
        mine = (lb3 ? c2[1] : c2[0]) + dpp_f<DPP_ROR(8)>(lb3 ? c2[0] : c2[1]);
        mine += __shfl_xor(mine, 16); mine += __shfl_xor(mine, 32);
        const int my_e = (lb2 ? 8 : 0) + (lb0 ? 4 : 0) + (lb1 ? 2 : 0) + (lb3 ? 1 : 0);
        const float mx = row16_max(mine);
        const float ex = expf(mine - mx);
        const float den = row16_sum(ex);
        const int b = m / SEQ, sidx = m % SEQ;
        if (F.lane < NE) AFF[((size_t)b * NE + my_e) * SEQ + sidx] = ex / den;
    }
    __syncthreads();
}
__device__ __forceinline__ void phase_p4(Frame& F) {
    LAS unsigned* key = (LAS unsigned*)F.lds;
    LAS unsigned* hist = (LAS unsigned*)(F.lds + 16384);
    LAS unsigned* wsum = (LAS unsigned*)(F.lds + 16384 + 1024);
    const float* AFF = (const float*)(F.ws + WS_AFF); int* IDX = (int*)(F.ws + WS_IDX); float* GATE = (float*)(F.ws + WS_GATE); int* SEL = (int*)(F.ws + WS_SEL);
    for (int be = F.bid; be < NB * NE; be += F.G) {
        const int b = be / NE, e = be % NE;
        __syncthreads();
        const GAS v4u* ap = (const GAS v4u*)(AFF + (size_t)be * SEQ);
        const v4u k0 = ap[2 * F.tid], k1 = ap[2 * F.tid + 1];
        unsigned kk[8] = {k0.x, k0.y, k0.z, k0.w, k1.x, k1.y, k1.z, k1.w};
        unsigned prefix = 0u, mask = 0u, remaining = CAP;
#pragma unroll 1
        for (int pass = 0; pass < 4; ++pass) {
            const int shift = 24 - 8 * pass;
            if (F.tid < 256) hist[F.tid] = 0u;
            __syncthreads();
#pragma unroll
            for (int i = 0; i < 8; ++i) if ((kk[i] & mask) == prefix) __hip_atomic_fetch_add(&hist[(kk[i] >> shift) & 255u], 1u, __ATOMIC_RELAXED, __HIP_MEMORY_SCOPE_WORKGROUP);
            __syncthreads();
            unsigned incl_ = 0u, mine_ = 0u;
            if (F.tid < 256) {
                mine_ = hist[255 - F.tid]; incl_ = mine_;
#pragma unroll
                for (int o = 1; o < 64; o <<= 1) { const unsigned t = __shfl_up(incl_, o); if (F.lane >= o) incl_ += t; }
                if (F.lane == 63) wsum[10 + F.wave] = incl_;
            }
            __syncthreads();
            if (F.tid < 256) {
                unsigned base = 0u;
                for (int w = 0; w < F.wave; ++w) base += wsum[10 + w];
                const unsigned above = base + incl_ - mine_;
                if (above < remaining && remaining <= above + mine_) { wsum[8] = (unsigned)(255 - F.tid); wsum[9] = above; }
            }
            __syncthreads();
            const unsigned d = wsum[8], above = wsum[9];
            prefix |= d << shift; mask |= 255u << shift; remaining -= above;
            __syncthreads();
        }
        const unsigned thr = prefix;
        unsigned cnt = 0u;
#pragma unroll
        for (int i = 0; i < 8; ++i) cnt += (kk[i] > thr ? 0x10000u : 0u) + (kk[i] == thr ? 1u : 0u);
        unsigned incl = cnt;
#pragma unroll
        for (int o = 1; o < 64; o <<= 1) { const unsigned t = __shfl_up(incl, o); if (F.lane >= o) incl += t; }
        if (F.lane == 63) wsum[F.wave] = incl;
        __syncthreads();
        unsigned base = 0u;
        for (int w = 0; w < F.wave; ++w) base += wsum[w];
        unsigned run = base + incl - cnt;
#pragma unroll
        for (int i = 0; i < 8; ++i) {
            const unsigned gt_before = run >> 16, tie_before = run & 0xffffu;
            const bool isgt = kk[i] > thr, istie = kk[i] == thr;
            const bool sel = isgt || (istie && tie_before < remaining);
            const unsigned slot = gt_before + (tie_before < remaining ? tie_before : remaining);
            const int s = 8 * F.tid + i, m = b * SEQ + s;
            if (sel) { IDX[be * CAP + slot] = m; GATE[be * CAP + slot] = __builtin_bit_cast(float, kk[i]); }
            SEL[(size_t)m * NE + e] = sel ? (int)slot : -1;
            run += (isgt ? 0x10000u : 0u) + (istie ? 1u : 0u);
        }
    }
    __syncthreads();
}
__device__ __forceinline__ void phase_p7(Frame& F) {
    const int* SEL = (const int*)(F.ws + WS_SEL); const bf16* YE = (const bf16*)(F.ws + WS_YE);
    for (int m = GW_ID(F); m < MT; m += GW_N(F)) {
        const int b = m / SEQ;
        GAS f32x4* orow = (GAS f32x4*)(F.out + (size_t)m * DM);
        const int sel = SEL[(size_t)m * NE + (F.lane & 15)];
        f32x4 acc[8];
#pragma unroll
        for (int j = 0; j < 8; ++j) acc[j] = orow[2 * F.lane + (j & 1) + 128 * (j >> 1)];
        unsigned mask = (unsigned)(__ballot(sel >= 0) & 0xFFFFull);
        while (mask) {
            const int e0 = __builtin_ctz(mask); mask &= mask - 1u;
            const bool two = mask != 0u; const int e1 = two ? __builtin_ctz(mask) : e0; if (two) mask &= mask - 1u;
            const int s0 = __builtin_amdgcn_readlane(sel, e0), s1 = __builtin_amdgcn_readlane(sel, e1);
            const GAS v4u* y0 = (const GAS v4u*)(YE + (size_t)((b * NE + e0) * CAP + s0) * DM) + F.lane;
            const GAS v4u* y1 = (const GAS v4u*)(YE + (size_t)((b * NE + e1) * CAP + s1) * DM) + F.lane;
            v4u w0[4], w1[4];
#pragma unroll
            for (int jj = 0; jj < 4; ++jj) { w0[jj] = __builtin_nontemporal_load(y0 + 64 * jj); w1[jj] = __builtin_nontemporal_load(y1 + 64 * jj); }
            const float k1 = two ? 1.f : 0.f;
#pragma unroll
            for (int jj = 0; jj < 4; ++jj) {
                acc[2 * jj].x += bflo(w0[jj].x) + k1 * bflo(w1[jj].x); acc[2 * jj].y += bfhi(w0[jj].x) + k1 * bfhi(w1[jj].x); acc[2 * jj].z += bflo(w0[jj].y) + k1 * bflo(w1[jj].y); acc[2 * jj].w += bfhi(w0[jj].y) + k1 * bfhi(w1[jj].y);
                acc[2 * jj + 1].x += bflo(w0[jj].z) + k1 * bflo(w1[jj].z); acc[2 * jj + 1].y += bfhi(w0[jj].z) + k1 * bfhi(w1[jj].z); acc[2 * jj + 1].z += bflo(w0[jj].w) + k1 * bflo(w1[jj].w); acc[2 * jj + 1].w += bfhi(w0[jj].w) + k1 * bfhi(w1[jj].w); }
        }
#pragma unroll
        for (int j = 0; j < 8; ++j) orow[2 * F.lane + (j & 1) + 128 * (j >> 1)] = acc[j];
    }
}

struct Args { const float* in[23]; float* out; unsigned char* ws; int ph_lo, ph_hi; };
enum Phase { PH_P0 = 0, PH_G1, PH_ATTN, PH_P25, PH_OUT, PH_P35, PH_P4, PH_UP, PH_DOWN, PH_P7, PH_COUNT };

__global__ void __launch_bounds__(NTHREADS, 2) mk_fwd(Args args) {
    extern __shared__ __attribute__((aligned(16))) unsigned char lds_raw[];
    Frame F;
    F.lds = (LAS unsigned char*)lds_raw;
    F.tid = threadIdx.x; F.lane = F.tid & 63; F.wave = __builtin_amdgcn_readfirstlane(F.tid >> 6); F.G = gridDim.x; F.bid = blockIdx.x;
#pragma unroll
    for (int i = 0; i < 23; ++i) F.in[i] = args.in[i];
    F.out = args.out; F.ws = args.ws;
    const int lo = args.ph_lo, hi = args.ph_hi;
#define IN(k) (lo <= (k) && (k) < hi)
#define REPS(k) for (int rep_ = 0; rep_ < ((k) == REP_PHASE ? REP_N : 1); ++rep_)
#if MK_N_LAUNCHES == 1
    { volatile LAS unsigned* misc = (volatile LAS unsigned*)(F.lds + LDS_MISC_OFF); if (F.tid < 16) misc[F.tid] = 0u; }
    __syncthreads();
    XcdBarrier bar = xcd_barrier_post(g_bar_words, (volatile LAS unsigned*)(F.lds + LDS_MISC_OFF) + 8);
#define SEAM(k) do { if (IN(k) && IN((k) + 1)) xcd_barrier(bar); } while (0)
#else
#define SEAM(k) do { } while (0)
#endif
    if (IN(PH_P0)) REPS(PH_P0) { phase_p0(F); for (int it = GW_ID(F); it < MOE_P0_ITEMS; it += GW_N(F)) moe_conv_item(F, it); } SEAM(PH_P0);
    if (IN(PH_G1)) REPS(PH_G1) {
        { constexpr int I_OUT = (DM / 64) * (DM / 64);
          float vw[64]; const int itw = GW_ID(F); const bool hasw = itw < I_OUT;
          ConvItem cw; { const int it_ = hasw ? itw : 0, kb = it_ / (DM / 64), nb = it_ % (DM / 64); cw.W = F.in[17]; cw.N = DM; cw.WTe = (bf16*)(F.ws + WS_WOUT); cw.bN = DM; cw.row_base = 64 * nb; cw.k0 = 64 * kb; cw.n0 = 64 * nb; }
          if (hasw) conv_load64(vw, cw, F.lane);
          phase_filters(F);
          if (hasw) conv_store64<true>(vw, cw, F.lane);
          for (int it_ = itw + GW_N(F); it_ < I_OUT; it_ += GW_N(F)) { ConvItem c2 = cw; const int kb = it_ / (DM / 64), nb = it_ % (DM / 64); c2.row_base = 64 * nb; c2.k0 = 64 * kb; c2.n0 = 64 * nb; conv_load64(vw, c2, F.lane); conv_store64<true>(vw, c2, F.lane); } }
        __syncthreads();
        { pg8::DenseOrder S; S.init(F.ws + WS_HB, F.ws + WS_WIN, MT, 2048, DM, 0, INW, F.G, F.bid);
          pg8::EpiBf16 E{(pg8::bf16_t*)(F.ws + WS_QK), 2048, 0, nullptr};
          pg8::gemm_phase<pg8::EpiBf16, pg8::DenseOrder, true, false, 1>(F.lds, DM, S, E); }
        { pg8::DenseOrder S; S.init(F.ws + WS_HB, F.ws + WS_WIN, MT, 4096, DM, 8, INW, F.G, F.bid);
          pg8::EpiTransBf16 E{(pg8::bf16_t*)(F.ws + WS_XT), MT, 8};
          pg8::gemm_phase<pg8::EpiTransBf16, pg8::DenseOrder, true, false, 2>(F.lds, DM, S, E); }
    } SEAM(PH_G1);
    if (IN(PH_ATTN)) { __syncthreads();
        { const v4u z4 = {0u, 0u, 0u, 0u};
          for (int i = F.tid; i < (int)(LDS_MISC_OFF / 16); i += NTHREADS) *((LAS v4u*)F.lds + i) = z4; }
        for (int rep_ = 0; rep_ < ((PH_ATTN == REP_PHASE && REP_SUB != 2) ? REP_N : 1); ++rep_) phase_hyena(F); for (int rep_ = 0; rep_ < ((PH_ATTN == REP_PHASE && REP_SUB != 1) ? REP_N : 1); ++rep_) phase_attn2(F); } SEAM(PH_ATTN);
    if (IN(PH_P25)) REPS(PH_P25) { __syncthreads(); phase_p25(F); } SEAM(PH_P25);
    if (IN(PH_OUT)) REPS(PH_OUT) {
        __syncthreads();
        pg8::DenseOrder S; S.init(F.ws + WS_MIXED, F.ws + WS_WOUT, MT, DM, DM, 0, DM, F.G, F.bid);
        pg8::EpiResF32 E{F.in[0], F.out, DM};
        pg8::gemm_phase<pg8::EpiResF32, pg8::DenseOrder, false, false, 3>(F.lds, DM, S, E);
    } SEAM(PH_OUT);
    if (IN(PH_P35)) REPS(PH_P35) { __syncthreads(); phase_p35(F); } SEAM(PH_P35);
    if (IN(PH_P4)) REPS(PH_P4) { __syncthreads(); phase_p4(F);
        if (F.G > NB * NE) { if (F.bid >= NB * NE) conv_range_moe_tail(F); }
        else moe_conv_range(F, MOE_ITEMS - MOE_P4_ITEMS + GW_ID(F), MOE_ITEMS, GW_N(F)); } SEAM(PH_P4);
    if (IN(PH_UP)) REPS(PH_UP) {
        __syncthreads();
        pg8::MoeOrder S; S.init(F.ws + WS_HB, F.ws + WS_WGU, DM, F.G, F.bid, true);
        LAS int* ridx = (LAS int*)(F.lds + 131072);
        { const int* IDX = (const int*)(F.ws + WS_IDX); pg8::Unit u; int t_ = threadIdx.x; asm volatile("" : "+v"(t_));
          for (int i = 0; S.next(i, u); ++i) if (t_ < 256) ridx[i * 256 + t_] = IDX[u.g * CAP + u.pm * 256 + t_]; }
        __syncthreads();
        pg8::EpiSwiGLU E{(pg8::bf16_t*)(F.ws + WS_ACT)};
        pg8::gemm_phase<pg8::EpiSwiGLU, pg8::MoeOrder, true, true, 4>(F.lds, DM, S, E, ridx);
    } SEAM(PH_UP);
    if (IN(PH_DOWN)) REPS(PH_DOWN) {
        __syncthreads();
        pg8::MoeOrder S; S.init(F.ws + WS_ACT, F.ws + WS_WD, FF, F.G, F.bid, false);
        pg8::EpiBf16 E{(pg8::bf16_t*)(F.ws + WS_YE), DM, 512, (const float*)(F.ws + WS_GATE)};
        pg8::gemm_phase<pg8::EpiBf16, pg8::MoeOrder, true, false, 5>(F.lds, FF, S, E);
    } SEAM(PH_DOWN);
    if (IN(PH_P7)) { phase_p7(F); }
#if MK_N_LAUNCHES == 1
    __syncthreads();
    { volatile LAS unsigned* misc = (volatile LAS unsigned*)(F.lds + LDS_MISC_OFF);
      if (F.tid == 0) misc[0] = (xb_add(&g_bar_words[XCD_BAR_WORDS], 1u) + 1u == (unsigned)F.G) ? 1u : 0u;
      __syncthreads();
      if (misc[0] != 0u && F.tid < (XCD_BAR_WORDS + 64) / 64) __hip_atomic_store(&g_bar_words[64 * F.tid], 0u, __ATOMIC_RELAXED, __HIP_MEMORY_SCOPE_AGENT); }
#endif
#undef IN
#undef SEAM
}

extern "C" void kernel_launch(void* const* d_in, const int* in_sizes, int n_in, void* d_out, int out_size, void* d_ws, size_t ws_size, hipStream_t stream) {
    static int grid = 0;
    if (grid == 0) {
        if (n_in != 23 || ws_size < WS_END) { fprintf(stderr, "kernel_launch: unexpected inputs (n_in %d, ws %zu)\n", n_in, ws_size); grid = -1; return; }
        if (hipFuncSetAttribute((const void*)mk_fwd, hipFuncAttributeMaxDynamicSharedMemorySize, LDS_BYTES) != hipSuccess) { fprintf(stderr, "kernel_launch: hipFuncSetAttribute failed\n"); grid = -1; return; }
        int dev = 0, cus = 0, per_cu = 0;
        hipGetDevice(&dev); hipDeviceGetAttribute(&cus, hipDeviceAttributeMultiprocessorCount, dev);
        hipOccupancyMaxActiveBlocksPerMultiprocessor(&per_cu, (const void*)mk_fwd, NTHREADS, LDS_BYTES);
        (void)hipGetLastError();
        if (per_cu < 1) { fprintf(stderr, "kernel_launch: occupancy query says %d blocks/CU\n", per_cu); }
        grid = cus;
    }
    if (grid < 0) return;
    Args a{};
    for (int i = 0; i < 23; ++i) a.in[i] = (const float*)d_in[i];
    a.out = (float*)d_out; a.ws = (unsigned char*)d_ws;
#if MK_N_LAUNCHES == 1
    a.ph_lo = 0; a.ph_hi = PH_COUNT;
    hipLaunchKernelGGL(mk_fwd, dim3(grid), dim3(NTHREADS), LDS_BYTES, stream, a);
#else
    for (int p = 0; p < PH_COUNT; ++p) { a.ph_lo = p; a.ph_hi = p + 1; hipLaunchKernelGGL(mk_fwd, dim3(grid), dim3(NTHREADS), LDS_BYTES, stream, a); }
#endif
}
```
